# Optimizing an MI355X kernel written in HIP

```python
import jax
import jax.numpy as jnp
from jax import lax
import numpy as np

D_MODEL = 1024
BATCH = 4
SEQ = 8192
DEPTH = 2

N_GROUPS = 4
GROUP_WIDTH = D_MODEL // N_GROUPS
MIX_WIDTH = N_GROUPS * GROUP_WIDTH
ROPE_THETA = 10000.0
NORM_EPS = 1e-6
NEG_INF = -1e30
FORCE_SCORE = 1e9
Q_BLOCK = 128

LRU_WIDTH = GROUP_WIDTH
LRU_HEADS = 4
LRU_HEAD_DIM = LRU_WIDTH // LRU_HEADS
CONV_WIDTH = 4
LRU_C = 8.0

NSA_HEADS = 4
NSA_HEAD_DIM = GROUP_WIDTH // NSA_HEADS
CMP_LEN = 32
CMP_STRIDE = 16
CMP_HIDDEN = 256
SEL_LEN = 64
SEL_TOPN = 16
WINDOW = 512

GLA_HEADS = 4
GLA_DV = GROUP_WIDTH // GLA_HEADS
GLA_DK = GLA_DV // 2
GLA_GATE_RANK = 16
GLA_TAU = 16.0
GLA_CHUNK = 64

MLA_HEADS = 4
MLA_V_DIM = GROUP_WIDTH // MLA_HEADS
MLA_NOPE_DIM = 64
MLA_ROPE_DIM = 32
MLA_QK_DIM = MLA_NOPE_DIM + MLA_ROPE_DIM
MLA_Q_RANK = 192
MLA_KV_RANK = 128

_FF_RAW = -(-8 * D_MODEL // 3)
D_FF = -(-_FF_RAW // 256) * 256

IN_SPLITS = (
    LRU_WIDTH, LRU_WIDTH,
    NSA_HEADS * NSA_HEAD_DIM, 6 * NSA_HEAD_DIM, NSA_HEADS * 3,
    GLA_HEADS * GLA_DK, GLA_HEADS * GLA_DK, GLA_HEADS * GLA_DV,
    GLA_GATE_RANK, GLA_HEADS * GLA_DV,
    MLA_Q_RANK, MLA_KV_RANK, MLA_ROPE_DIM,
)
IN_COLS = sum(IN_SPLITS)

kernel_name = 'hybrid_hymba_rglru_nsa_gla_mla'


def rmsnorm(x, gain):
    xf = x.astype(jnp.float32)
    y = xf * lax.rsqrt(jnp.mean(xf * xf, axis=-1, keepdims=True) + NORM_EPS)
    return (y * gain.astype(jnp.float32)).astype(x.dtype)


def rope(x, positions):
    d = x.shape[-1]
    inv_freq = ROPE_THETA ** (-jnp.arange(0, d, 2, dtype=jnp.float32) / d)
    ang = positions.astype(jnp.float32)[..., None] * inv_freq
    cos = jnp.cos(ang)[:, :, None, :]
    sin = jnp.sin(ang)[:, :, None, :]
    xf = x.astype(jnp.float32)
    x1, x2 = xf[..., : d // 2], xf[..., d // 2:]
    return jnp.concatenate([x1 * cos - x2 * sin, x2 * cos + x1 * sin], axis=-1).astype(x.dtype)


def masked_softmax(s, mask):
    s = jnp.where(mask, s, NEG_INF)
    m = jnp.max(s, axis=-1, keepdims=True)
    p = jnp.where(mask, jnp.exp(s - m), 0.0)
    return p / jnp.maximum(jnp.sum(p, axis=-1, keepdims=True), 1e-30)


def rglru_mixer(xa, gate, conv_w, conv_b, wa, ba, wx, bx, lam):
    dtype = xa.dtype
    B, S, W = xa.shape
    xf = xa.astype(jnp.float32)
    xc = lax.conv_general_dilated(
        xf, conv_w.astype(jnp.float32)[:, None, :], window_strides=(1,),
        padding=[(CONV_WIDTH - 1, 0)], dimension_numbers=('NWC', 'WIO', 'NWC'),
        feature_group_count=W) + conv_b.astype(jnp.float32)
    xh = xc.reshape(B, S, LRU_HEADS, LRU_HEAD_DIM)
    r = jax.nn.sigmoid(jnp.einsum('bshi,hij->bshj', xh, wa.astype(jnp.float32)).reshape(B, S, W) + ba)
    i = jax.nn.sigmoid(jnp.einsum('bshi,hij->bshj', xh, wx.astype(jnp.float32)).reshape(B, S, W) + bx)
    log_a = -LRU_C * r * jax.nn.softplus(-lam.astype(jnp.float32))
    a = jnp.exp(log_a)
    u = jnp.sqrt(-jnp.expm1(2.0 * log_a)) * (i * xc)

    def combine(left, right):
        a1, b1 = left
        a2, b2 = right
        return a1 * a2, a2 * b1 + b2

    _, h = lax.associative_scan(combine, (a, u), axis=1)
    y = h * jax.nn.gelu(gate.astype(jnp.float32))
    return y.astype(dtype)


def nsa_mixer(q, kv, gates, positions, cmp_pos, cmp_w1, cmp_b1, cmp_w2):
    dtype = q.dtype
    f32 = jnp.float32
    B, S, _ = q.shape
    H, Dh = NSA_HEADS, NSA_HEAD_DIM
    q = rope(q.reshape(B, S, H, Dh), positions).astype(f32)
    k_c, v_c, k_s, v_s, k_w, v_w = jnp.split(kv.astype(f32), 6, axis=-1)
    k_c, k_s, k_w = [rope(k[:, :, None, :], positions)[:, :, 0] for k in (k_c, k_s, k_w)]

    n_cmp = (S - CMP_LEN) // CMP_STRIDE + 1
    tok_idx = jnp.arange(n_cmp)[:, None] * CMP_STRIDE + jnp.arange(CMP_LEN)[None, :]

    def compress(t, j):
        blk = t[:, tok_idx] + cmp_pos[j].astype(f32)
        hid = jax.nn.gelu(blk.reshape(B, n_cmp, CMP_LEN * Dh) @ cmp_w1[j].astype(f32) + cmp_b1[j].astype(f32))
        return hid @ cmp_w2[j].astype(f32)

    k_cmp = compress(k_c, 0)
    v_cmp = compress(v_c, 1)
    cmp_start = jnp.arange(n_cmp) * CMP_STRIDE
    cmp_end = cmp_start + CMP_LEN - 1

    n_sel = S // SEL_LEN
    topn = min(SEL_TOPN, n_sel)
    sel_j = jnp.arange(n_sel)
    sel_start = sel_j * SEL_LEN
    overlap = ((cmp_start[:, None] < sel_start[None, :] + SEL_LEN)
               & (cmp_start[:, None] + CMP_LEN > sel_start[None, :])).astype(f32)
    k_sel_blk = k_s.reshape(B, n_sel, SEL_LEN, Dh)
    v_sel_blk = v_s.reshape(B, n_sel, SEL_LEN, Dh)

    k_win_pad = jnp.pad(k_w, ((0, 0), (WINDOW, 0), (0, 0)))
    v_win_pad = jnp.pad(v_w, ((0, 0), (WINDOW, 0), (0, 0)))

    g = jax.nn.sigmoid(gates.astype(f32)).reshape(B, S, H, 3)
    scale = Dh ** -0.5
    n_qb = S // Q_BLOCK
    q_blocks = (q * scale).reshape(B, n_qb, Q_BLOCK, H, Dh).transpose(1, 0, 2, 3, 4)
    g_blocks = g.reshape(B, n_qb, Q_BLOCK, H, 3).transpose(1, 0, 2, 3, 4)
    starts = jnp.arange(n_qb, dtype=jnp.int32) * Q_BLOCK

    def block(args):
        qb, gb, s0 = args
        t = s0 + jnp.arange(Q_BLOCK, dtype=jnp.int32)
        s_c = jnp.einsum('bqhd,bnd->bhqn', qb, k_cmp)
        p_c = masked_softmax(s_c, cmp_end[None, :] <= t[:, None])
        o_c = jnp.einsum('bhqn,bnd->bqhd', p_c, v_cmp)
        imp = jnp.einsum('bhqn,ns->bqs', p_c, overlap)
        cur = t // SEL_LEN
        valid = sel_start[None, :] <= t[:, None]
        forced = (sel_j[None, :] == 0) | (sel_j[None, :] == cur[:, None]) | (sel_j[None, :] == cur[:, None] - 1)
        score = jnp.where(forced, FORCE_SCORE, jnp.where(valid, imp, NEG_INF))
        _, idx = lax.top_k(score, topn)
        ks = jax.vmap(lambda kb, ix: kb[ix])(k_sel_blk, idx)
        vs = jax.vmap(lambda vb, ix: vb[ix])(v_sel_blk, idx)
        key_pos = idx[..., None] * SEL_LEN + jnp.arange(SEL_LEN)
        m_s = (key_pos <= t[None, :, None, None]).reshape(B, 1, Q_BLOCK, topn * SEL_LEN)
        s_s = jnp.einsum('bqhd,bqnld->bhqnl', qb, ks).reshape(B, H, Q_BLOCK, topn * SEL_LEN)
        p_s = masked_softmax(s_s, m_s)
        o_s = jnp.einsum('bhqm,bqmd->bqhd', p_s, vs.reshape(B, Q_BLOCK, topn * SEL_LEN, Dh))
        kw = lax.dynamic_slice_in_dim(k_win_pad, s0, WINDOW + Q_BLOCK, axis=1)
        vw = lax.dynamic_slice_in_dim(v_win_pad, s0, WINDOW + Q_BLOCK, axis=1)
        kpos = s0 - WINDOW + jnp.arange(WINDOW + Q_BLOCK, dtype=jnp.int32)
        m_w = (kpos[None, :] <= t[:, None]) & (kpos[None, :] > t[:, None] - WINDOW) & (kpos[None, :] >= 0)
        s_w = jnp.einsum('bqhd,bkd->bhqk', qb, kw)
        p_w = masked_softmax(s_w, m_w)
        o_w = jnp.einsum('bhqk,bkd->bqhd', p_w, vw)
        return gb[..., 0:1] * o_c + gb[..., 1:2] * o_s + gb[..., 2:3] * o_w

    out = lax.map(block, (q_blocks, g_blocks, starts))
    return out.transpose(1, 0, 2, 3, 4).reshape(B, S, H * Dh).astype(dtype)


def gla_mixer(q, k, v, g_lr, og, w_g2, b_g2, norm_g):
    dtype = q.dtype
    f32 = jnp.float32
    B, S, _ = q.shape
    H, C = GLA_HEADS, GLA_CHUNK
    n_c = S // C
    log_a = jax.nn.log_sigmoid(g_lr.astype(f32) @ w_g2.astype(f32) + b_g2.astype(f32)) / GLA_TAU

    def to_chunks(t, d):
        return t.astype(f32).reshape(B, n_c, C, H, d).transpose(1, 0, 3, 2, 4)

    qc = to_chunks(q, GLA_DK) * (GLA_DK ** -0.5)
    kc = to_chunks(k, GLA_DK)
    vc = to_chunks(v, GLA_DV)
    gc = to_chunks(log_a, GLA_DK)
    causal = jnp.tril(jnp.ones((C, C), dtype=bool))

    def step(state, xs):
        qi, ki, vi, gi = xs
        b = jnp.cumsum(gi, axis=2)
        o_inter = jnp.einsum('bhck,bhkv->bhcv', qi * jnp.exp(b), state)
        diff = b[:, :, :, None, :] - b[:, :, None, :, :]
        decay = jnp.exp(jnp.where(causal[:, :, None], diff, NEG_INF))
        attn = jnp.einsum('bhik,bhjk,bhijk->bhij', qi, ki, decay)
        o = o_inter + jnp.einsum('bhij,bhjv->bhiv', attn, vi)
        b_last = b[:, :, -1:, :]
        state = (jnp.exp(b_last[:, :, 0, :])[..., None] * state
                 + jnp.einsum('bhjk,bhjv->bhkv', ki * jnp.exp(b_last - b), vi))
        return state, o

    s_init = jnp.zeros((B, H, GLA_DK, GLA_DV), f32)
    _, o = lax.scan(step, s_init, (qc, kc, vc, gc))
    o = o.transpose(1, 0, 3, 2, 4).reshape(B, S, H, GLA_DV)
    o = rmsnorm(o, norm_g) * jax.nn.silu(og.astype(f32).reshape(B, S, H, GLA_DV))
    return o.reshape(B, S, H * GLA_DV).astype(dtype)


def mla_mixer(c_q, c_kv, k_rope, positions, q_norm, kv_norm, w_uq, w_ukv):
    dtype = c_q.dtype
    f32 = jnp.float32
    B, S, _ = c_q.shape
    H = MLA_HEADS
    q = (rmsnorm(c_q, q_norm) @ w_uq).reshape(B, S, H, MLA_QK_DIM)
    q = jnp.concatenate([q[..., :MLA_NOPE_DIM], rope(q[..., MLA_NOPE_DIM:], positions)], axis=-1)
    kv = (rmsnorm(c_kv, kv_norm) @ w_ukv).reshape(B, S, H, MLA_NOPE_DIM + MLA_V_DIM)
    kr = rope(k_rope[:, :, None, :], positions)
    k = jnp.concatenate([kv[..., :MLA_NOPE_DIM], jnp.broadcast_to(kr, (B, S, H, MLA_ROPE_DIM))], axis=-1).astype(f32)
    v = kv[..., MLA_NOPE_DIM:].astype(f32)
    n_qb = S // Q_BLOCK
    q_blocks = (q.astype(f32) * (MLA_QK_DIM ** -0.5)).reshape(B, n_qb, Q_BLOCK, H, MLA_QK_DIM).transpose(1, 0, 2, 3, 4)
    starts = jnp.arange(n_qb, dtype=jnp.int32) * Q_BLOCK
    key_idx = jnp.arange(S, dtype=jnp.int32)

    def block(args):
        qb, s0 = args
        t = s0 + jnp.arange(Q_BLOCK, dtype=jnp.int32)
        s = jnp.einsum('bqhd,bkhd->bhqk', qb, k)
        p = masked_softmax(s, key_idx[None, :] <= t[:, None])
        return jnp.einsum('bhqk,bkhd->bqhd', p, v)

    o = lax.map(block, (q_blocks, starts))
    return o.transpose(1, 0, 2, 3, 4).reshape(B, S, H * MLA_V_DIM).astype(dtype)


def setup_inputs(seed: int = 0) -> dict:
    key = jax.random.key(seed)
    ks = jax.random.split(key, 32)
    f32 = jnp.float32

    def nrm(k, shape, scale):
        return jax.random.normal(k, shape, f32) * scale

    def gain(k, shape):
        return 1.0 + 0.02 * jax.random.normal(k, shape, f32)

    u = jax.random.uniform(ks[10], (DEPTH, LRU_WIDTH), f32, minval=0.9, maxval=0.999)
    s = u ** (1.0 / LRU_C)
    lru_lambda = jnp.log(s) - jnp.log1p(-s)
    positions = (jnp.arange(SEQ, dtype=jnp.int32)[None, :]
                 + jax.random.randint(ks[1], (BATCH, 1), 0, SEQ, dtype=jnp.int32))
    return {
        'x': nrm(ks[0], (BATCH, SEQ, D_MODEL), 1.0),
        'positions': positions,
        'norm_mix': gain(ks[2], (DEPTH, D_MODEL)),
        'w_in': nrm(ks[3], (DEPTH, D_MODEL, IN_COLS), D_MODEL ** -0.5),
        'conv_w': nrm(ks[4], (DEPTH, CONV_WIDTH, LRU_WIDTH), CONV_WIDTH ** -0.5),
        'conv_b': nrm(ks[5], (DEPTH, LRU_WIDTH), 0.02),
        'lru_wa': nrm(ks[6], (DEPTH, LRU_HEADS, LRU_HEAD_DIM, LRU_HEAD_DIM), LRU_HEAD_DIM ** -0.5),
        'lru_ba': nrm(ks[7], (DEPTH, LRU_WIDTH), 0.02),
        'lru_wx': nrm(ks[8], (DEPTH, LRU_HEADS, LRU_HEAD_DIM, LRU_HEAD_DIM), LRU_HEAD_DIM ** -0.5),
        'lru_bx': nrm(ks[9], (DEPTH, LRU_WIDTH), 0.02),
        'lru_lambda': lru_lambda,
        'cmp_pos': nrm(ks[11], (DEPTH, 2, CMP_LEN, NSA_HEAD_DIM), 0.02),
        'cmp_w1': nrm(ks[12], (DEPTH, 2, CMP_LEN * NSA_HEAD_DIM, CMP_HIDDEN), (CMP_LEN * NSA_HEAD_DIM) ** -0.5),
        'cmp_b1': nrm(ks[13], (DEPTH, 2, CMP_HIDDEN), 0.02),
        'cmp_w2': nrm(ks[14], (DEPTH, 2, CMP_HIDDEN, NSA_HEAD_DIM), CMP_HIDDEN ** -0.5),
        'gla_wg2': nrm(ks[15], (DEPTH, GLA_GATE_RANK, GLA_HEADS * GLA_DK), GLA_GATE_RANK ** -0.5),
        'gla_bg2': nrm(ks[16], (DEPTH, GLA_HEADS * GLA_DK), 0.02),
        'gla_norm': gain(ks[17], (DEPTH, GLA_DV)),
        'mla_q_norm': gain(ks[18], (DEPTH, MLA_Q_RANK)),
        'mla_kv_norm': gain(ks[19], (DEPTH, MLA_KV_RANK)),
        'mla_w_uq': nrm(ks[20], (DEPTH, MLA_Q_RANK, MLA_HEADS * MLA_QK_DIM), MLA_Q_RANK ** -0.5),
        'mla_w_ukv': nrm(ks[21], (DEPTH, MLA_KV_RANK, MLA_HEADS * (MLA_NOPE_DIM + MLA_V_DIM)), MLA_KV_RANK ** -0.5),
        'group_norm': gain(ks[22], (DEPTH, MIX_WIDTH)),
        'w_out': nrm(ks[23], (DEPTH, MIX_WIDTH, D_MODEL), MIX_WIDTH ** -0.5),
        'norm_ffn': gain(ks[24], (DEPTH, D_MODEL)),
        'w_gate_up': nrm(ks[25], (DEPTH, D_MODEL, 2 * D_FF), D_MODEL ** -0.5),
        'w_down': nrm(ks[26], (DEPTH, D_FF, D_MODEL), D_FF ** -0.5),
        'final_norm': gain(ks[27], (D_MODEL,)),
    }


def reference(x, positions, norm_mix, w_in, conv_w, conv_b, lru_wa, lru_ba, lru_wx, lru_bx,
              lru_lambda, cmp_pos, cmp_w1, cmp_b1, cmp_w2, gla_wg2, gla_bg2, gla_norm,
              mla_q_norm, mla_kv_norm, mla_w_uq, mla_w_ukv, group_norm, w_out, norm_ffn,
              w_gate_up, w_down, final_norm):
    B, S, _ = x.shape
    offsets = [int(o) for o in np.cumsum(IN_SPLITS)[:-1]]
    for l in range(DEPTH):
        h = rmsnorm(x, norm_mix[l])
        (a_x, a_gate, b_q, b_kv, b_gate, c_q, c_k, c_v, c_glr, c_og,
         d_cq, d_ckv, d_kr) = jnp.split(h @ w_in[l], offsets, axis=-1)
        y_a = rglru_mixer(a_x, a_gate, conv_w[l], conv_b[l], lru_wa[l], lru_ba[l],
                          lru_wx[l], lru_bx[l], lru_lambda[l])
        y_b = nsa_mixer(b_q, b_kv, b_gate, positions, cmp_pos[l], cmp_w1[l], cmp_b1[l], cmp_w2[l])
        y_c = gla_mixer(c_q, c_k, c_v, c_glr, c_og, gla_wg2[l], gla_bg2[l], gla_norm[l])
        y_d = mla_mixer(d_cq, d_ckv, d_kr, positions, mla_q_norm[l], mla_kv_norm[l],
                        mla_w_uq[l], mla_w_ukv[l])
        y = jnp.stack([y_a, y_b, y_c, y_d], axis=2)
        y = rmsnorm(y, group_norm[l].reshape(N_GROUPS, GROUP_WIDTH)).reshape(B, S, MIX_WIDTH)
        x = x + y @ w_out[l]
        h = rmsnorm(x, norm_ffn[l])
        gate, up = jnp.split(h @ w_gate_up[l], 2, axis=-1)
        x = x + (jax.nn.silu(gate) * up) @ w_down[l]
    return rmsnorm(x, final_norm)
```

```cpp
#include <hip/hip_runtime.h>
#include <cstdio>
#include <cstdint>

#ifndef MK_N_LAUNCHES
#define MK_N_LAUNCHES 16
#endif

#define LAS __attribute__((address_space(3)))
#define DI __device__ __forceinline__
typedef unsigned short bf16_t;
typedef short bf16x8 __attribute__((ext_vector_type(8)));
typedef float f32x4 __attribute__((ext_vector_type(4)));
typedef unsigned u32x4 __attribute__((ext_vector_type(4)));
typedef unsigned u32x2 __attribute__((ext_vector_type(2)));

constexpr int NB = 4, SEQ = 8192, M = NB * SEQ, DM = 1024, NIN = 2304, NINS = 2300, FF = 2816, NGU = 2 * FF;
constexpr float EPS = 1e-6f;
constexpr int C_AX = 0, C_AG = 256, C_BQ = 512, C_KC = 768, C_VC = 832, C_KS = 896, C_VS = 960, C_KW = 1024, C_VW = 1088, C_BG = 1152,
              C_CQ = 1164, C_CK = 1292, C_CV = 1420, C_GLR = 1676, C_OG = 1692, C_DCQ = 1948, C_DCKV = 2140, C_DKR = 2268;
constexpr size_t MiB = 1u << 20;
constexpr size_t WS_CTL = 0, CTL_ZERO_BYTES = 1 * MiB;
constexpr size_t WS_ACC = 64 * 1024;
constexpr size_t WS_SSQ0 = 1 * MiB;
constexpr size_t WS_HB = 1 * MiB + 256 * 1024;
constexpr size_t WS_WIN = 2 * MiB, WS_WOUT = 11 * MiB, WS_WGU = 15 * MiB, WS_WDN = 37 * MiB;
constexpr size_t WS_CS64 = 64 * MiB, WS_CS32 = 72 * MiB;
constexpr size_t WS_XB = 80 * MiB, WS_Y = 144 * MiB, WS_PB = 208 * MiB, WS_ACT = 208 * MiB;
constexpr size_t WS_LA = 384 * MiB, WS_LH = 386 * MiB, WS_CIN = 388 * MiB;
constexpr size_t WS_KVC = 392 * MiB, WS_DEC = 408 * MiB, WS_SST = 410 * MiB;
constexpr size_t WS_MQ = 428 * MiB, WS_MKN = 452 * MiB, WS_MV = 468 * MiB, WS_MKR = 484 * MiB;
constexpr size_t WS_KCMP = 488 * MiB, WS_VCMP = 489 * MiB, WS_END = 490 * MiB;
constexpr int CW_QUEUE = 64;
constexpr int CW_BAR = 4096;
constexpr int LDS_BYTES = 163840 - 256;
constexpr int LDS_CTL = LDS_BYTES - 64;
constexpr int NTHR = 512;

struct Args { const float* in[28]; float* out; unsigned char* ws; int ph_lo, ph_hi; };

DI float bf2f(bf16_t h) { return __uint_as_float(((unsigned)h) << 16); }
DI float bflo(unsigned u) { return __uint_as_float(u << 16); }
DI float bfhi(unsigned u) { return __uint_as_float(u & 0xffff0000u); }
DI bf16_t f2bf(float f) { unsigned u = __float_as_uint(f); return (bf16_t)((u + 0x7fffu + ((u >> 16) & 1u)) >> 16); }
DI unsigned pk2(float lo, float hi) { return (unsigned)f2bf(lo) | ((unsigned)f2bf(hi) << 16); }
DI float wave_sum(float v) {
#pragma unroll
    for (int o = 1; o < 64; o <<= 1) v += __shfl_xor(v, o);
    return v;
}
DI float wave_max(float v) {
#pragma unroll
    for (int o = 1; o < 64; o <<= 1) v = fmaxf(v, __shfl_xor(v, o));
    return v;
}
DI int wave_min_i(int v) {
#pragma unroll
    for (int o = 1; o < 64; o <<= 1) { int w = __shfl_xor(v, o); v = w < v ? w : v; }
    return v;
}
DI float sigmoidf_(float x) { return 1.f / (1.f + __expf(-x)); }
DI float gelu_tanh(float x) { const float u = 0.7978845608028654f * (x + 0.044715f * x * x * x); return 0.5f * x * (1.f + tanhf(u)); }
#define WSYNC() do { asm volatile("s_waitcnt lgkmcnt(0)" ::: "memory"); __builtin_amdgcn_wave_barrier(); } while (0)

namespace pg8 {
constexpr int BM = 256, BK = 64, HALF = 128, HTB = HALF * BK * 2, NXCD = 8, WGM = 8;
__host__ __device__ __forceinline__ int lds_byte(int r, int c) { const int st = (r >> 4) * 2 + (c >> 5), rr = r & 15, cc = c & 31, ob = rr * 64 + cc * 2; return st * 1024 + (ob ^ (((ob >> 9) & 1) << 5)); }
__host__ __device__ __forceinline__ void stage_rc(int b, int& R, int& C) { const int st = b / 1024, sb = b % 1024, swz = sb ^ (((sb >> 9) & 1) << 5); R = (st >> 1) * 16 + swz / 64; C = (st & 1) * 32 + (swz % 64) / 2; }
__host__ __device__ __forceinline__ int perm32(int rho) { const int n = rho >> 4, i = rho & 15; return 8 * (i >> 2) + 4 * n + (i & 3); }
struct Unit { int pm, pn; };
struct Gemm { const bf16_t* A; const bf16_t* Bt; int M, N, K; };
struct StaticOrder {
    int nM, nN, nwg, G, c;
    __host__ __device__ void init(int M_, int N_, int G_, int c_) { nM = M_ / BM; nN = N_ / BM; nwg = nM * nN; G = G_; c = c_; }
    __host__ __device__ bool next(int i, Unit& u) const {
        const long L = (long)i * G + c; if (L >= nwg) return false;
        int wgid = (int)L; { const int q = nwg / NXCD, r = nwg % NXCD, xcd = wgid % NXCD, off = wgid / NXCD; wgid = (xcd < r ? xcd * (q + 1) : r * (q + 1) + (xcd - r) * q) + off; }
        const int nig = WGM * nN, gid = wgid / nig, fm = gid * WGM, gsz = (nM - fm) < WGM ? (nM - fm) : WGM;
        u.pm = fm + ((wgid % nig) % gsz); u.pn = (wgid % nig) / gsz; return true;
    }
    __device__ __forceinline__ void a_ready(const Unit&) const {}
    __device__ __forceinline__ void done(const Unit&) const {}
};
DI unsigned cvt_pk_bf16(float lo, float hi) { unsigned r; asm volatile("v_cvt_pk_bf16_f32 %0, %1, %2" : "=v"(r) : "v"(lo), "v"(hi)); return r; }

struct EpiInProj {
    static constexpr bool PERM = true, AFTER_DRAIN = false;
    bf16_t* O; int ldc; const float* ssq;
    DI void operator()(const f32x4 (&acc)[2][2][4][2], const Unit& u, int wr, int wc, int fr, int fq) const {
        const int row0 = u.pm * BM + wr * 64 + fr, col0 = u.pn * BM + wc * 32 + 8 * fq;
#pragma unroll
        for (int ai = 0; ai < 2; ++ai)
#pragma unroll
            for (int m = 0; m < 4; ++m) {
                const int row = row0 + ai * HALF + m * 16;
                const float rinv = rsqrtf(ssq[row] * (1.f / DM) + EPS);
                bf16_t* rowp = O + (size_t)row * ldc + col0;
#pragma unroll
                for (int bj = 0; bj < 2; ++bj) {
                    f32x4 v0 = acc[ai][bj][m][0] * rinv, v1 = acc[ai][bj][m][1] * rinv;
                    u32x4 w; w.x = cvt_pk_bf16(v0[0], v0[1]); w.y = cvt_pk_bf16(v0[2], v0[3]); w.z = cvt_pk_bf16(v1[0], v1[1]); w.w = cvt_pk_bf16(v1[2], v1[3]);
                    *(u32x4*)(rowp + bj * HALF) = w;
                }
            }
    }
};
struct EpiResid {
    static constexpr bool PERM = true, AFTER_DRAIN = false;
    const float* xin; float* xout; bf16_t* xb; float* ssq_out;
    DI void operator()(const f32x4 (&acc)[2][2][4][2], const Unit& u, int wr, int wc, int fr, int fq) const {
        const int row0 = u.pm * BM + wr * 64 + fr, col0 = u.pn * BM + wc * 32 + 8 * fq;
#pragma unroll
        for (int ai = 0; ai < 2; ++ai)
#pragma unroll
            for (int m = 0; m < 4; ++m) {
                const int row = row0 + ai * HALF + m * 16;
                float part = 0.f;
#pragma unroll
                for (int bj = 0; bj < 2; ++bj) {
                    const size_t off = (size_t)row * DM + col0 + bj * HALF;
                    const f32x4 r0 = *(const f32x4*)(xin + off), r1 = *(const f32x4*)(xin + off + 4);
                    const f32x4 v0 = acc[ai][bj][m][0] + r0, v1 = acc[ai][bj][m][1] + r1;
                    *(f32x4*)(xout + off) = v0; *(f32x4*)(xout + off + 4) = v1;
                    u32x4 w; w.x = cvt_pk_bf16(v0[0], v0[1]); w.y = cvt_pk_bf16(v0[2], v0[3]); w.z = cvt_pk_bf16(v1[0], v1[1]); w.w = cvt_pk_bf16(v1[2], v1[3]);
                    *(u32x4*)(xb + off) = w;
                    part += v0[0] * v0[0] + v0[1] * v0[1] + v0[2] * v0[2] + v0[3] * v0[3] + v1[0] * v1[0] + v1[1] * v1[1] + v1[2] * v1[2] + v1[3] * v1[3];
                }
                part += __shfl_xor(part, 16); part += __shfl_xor(part, 32);
                if (fq == 0) atomicAdd(ssq_out + row, part);
            }
    }
};
struct EpiSwiglu {
    static constexpr bool PERM = true, AFTER_DRAIN = false;
    bf16_t* act; const float* ssq;
    DI void operator()(const f32x4 (&acc)[2][2][4][2], const Unit& u, int wr, int wc, int fr, int fq) const {
        const int row0 = u.pm * BM + wr * 64 + fr, j0 = u.pn * 128 + wc * 16 + 4 * fq;
#pragma unroll
        for (int ai = 0; ai < 2; ++ai)
#pragma unroll
            for (int m = 0; m < 4; ++m) {
                const int row = row0 + ai * HALF + m * 16;
                const float rinv = rsqrtf(ssq[row] * (1.f / DM) + EPS);
#pragma unroll
                for (int bj = 0; bj < 2; ++bj) {
                    const f32x4 g = acc[ai][bj][m][0] * rinv, up = acc[ai][bj][m][1] * rinv;
                    float a[4];
#pragma unroll
                    for (int i = 0; i < 4; ++i) a[i] = g[i] / (1.f + __expf(-g[i])) * up[i];
                    u32x2 w; w.x = cvt_pk_bf16(a[0], a[1]); w.y = cvt_pk_bf16(a[2], a[3]);
                    *(u32x2*)(act + (size_t)row * FF + j0 + bj * 64) = w;
                }
            }
    }
};

template <class Epi, class Sched, bool ALIGN_EPI = false, bool SP2 = false>
DI void gemm_phase(LAS unsigned char* lds, const Gemm g, const Sched& S, const Epi& E) {
    int tid_ = threadIdx.x; asm volatile("" : "+v"(tid_));
    const int tid = tid_, wid = __builtin_amdgcn_readfirstlane(tid >> 6), lane = tid & 63, wr = wid >> 2, wc = wid & 3, fr = lane & 15, fq = lane >> 4;
    const int K = g.K, nt = K / BK;
    unsigned voffA[2], voffB[2];
#pragma unroll
    for (int i = 0; i < 2; ++i) { int R, C; stage_rc(tid * 16 + i * 8192, R, C); const int Rb = Epi::PERM ? ((R & ~31) + perm32(R & 31)) : R;
        voffA[i] = (unsigned)(R * K + C) * 2u; voffB[i] = (unsigned)(Rb * K + C) * 2u; }
    const size_t kstep = (size_t)(BK * 2);
    const size_t hstep = (size_t)HALF * K * 2;
    const size_t tstep = 2 * hstep;
    const unsigned ldsw = (unsigned)wid * 1024u;
    const int aoff = lds_byte(wr * 64 + fr, fq * 8), boff = lds_byte(wc * 32 + fr, fq * 8);
#define PG8_SA(b, h) (((b) * 2 + (h)) * HTB)
#define PG8_SB(b, h) ((4 + (b) * 2 + (h)) * HTB)
#define PG8_STAGE(bufoff, gbase, voff) do { _Pragma("unroll") for (int _i = 0; _i < 2; ++_i) \
        __builtin_amdgcn_global_load_lds((const unsigned*)((const char*)(gbase) + (voff)[_i]), (LAS unsigned*)(lds + (bufoff) + ldsw + _i * 8192), 16, 0, 0); } while (0)
#define PG8_LDA(dst, b, h) do { _Pragma("unroll") for (int m = 0; m < 4; ++m) _Pragma("unroll") for (int k = 0; k < 2; ++k) dst[m][k] = *(const LAS bf16x8*)(lds + PG8_SA(b, h) + aoff + m * 2048 + k * 1024); } while (0)
#define PG8_LDB(dst, b, h) do { _Pragma("unroll") for (int n = 0; n < 2; ++n) _Pragma("unroll") for (int k = 0; k < 2; ++k) dst[n][k] = *(const LAS bf16x8*)(lds + PG8_SB(b, h) + boff + n * 2048 + k * 1024); } while (0)
#define PG8_MMA(ai, bj, At, Bt) do { __builtin_amdgcn_s_setprio(1); _Pragma("unroll") for (int m = 0; m < 4; ++m) _Pragma("unroll") for (int n = 0; n < 2; ++n) _Pragma("unroll") for (int k = 0; k < 2; ++k) \
        acc[ai][bj][m][n] = __builtin_amdgcn_mfma_f32_16x16x32_bf16(Bt[n][k], At[m][k], acc[ai][bj][m][n], 0, 0, 0); __builtin_amdgcn_s_setprio(0); } while (0)
#define PG8_WAIT_V(n) asm volatile("s_waitcnt vmcnt(" #n ")" ::: "memory")
#define PG8_WAIT_L(n) asm volatile("s_waitcnt lgkmcnt(" #n ")" ::: "memory")
#define PG8_BAR __builtin_amdgcn_s_barrier()
#define PG8_SCHED __builtin_amdgcn_sched_barrier(0)
    Unit cur, nxt; int ui = 0;
    if (!S.next(0, cur)) return;
    f32x4 acc[2][2][4][2];
#pragma unroll
    for (int a = 0; a < 2; ++a)
#pragma unroll
        for (int b = 0; b < 2; ++b)
#pragma unroll
            for (int m = 0; m < 4; ++m)
#pragma unroll
                for (int n = 0; n < 2; ++n) acc[a][b][m][n] = (f32x4){0.f, 0.f, 0.f, 0.f};
    bf16x8 At[4][2], B0[2][2], B1[2][2];
    const char* cA = (const char*)g.A + (size_t)cur.pm * tstep; const char* cB = (const char*)g.Bt + (size_t)cur.pn * tstep;
    S.a_ready(cur);
    if constexpr (SP2) {
        PG8_STAGE(PG8_SB(0, 0), cB, voffB); PG8_STAGE(PG8_SB(0, 1), cB + hstep, voffB); PG8_STAGE(PG8_SA(0, 0), cA, voffA); PG8_STAGE(PG8_SA(0, 1), cA + hstep, voffA);
        if (wr == 1) PG8_BAR;
        PG8_WAIT_V(2); PG8_BAR;
        PG8_STAGE(PG8_SB(1, 0), cB + kstep, voffB); PG8_STAGE(PG8_SA(1, 0), cA + kstep, voffA); PG8_STAGE(PG8_SB(1, 1), cB + hstep + kstep, voffB);
        PG8_WAIT_V(6); PG8_BAR;
    } else {
        PG8_STAGE(PG8_SB(0, 0), cB, voffB); PG8_STAGE(PG8_SA(0, 0), cA, voffA); PG8_STAGE(PG8_SB(0, 1), cB + hstep, voffB); PG8_STAGE(PG8_SA(0, 1), cA + hstep, voffA);
        if (wr == 1) PG8_BAR;
        PG8_WAIT_V(4); PG8_BAR;
        PG8_STAGE(PG8_SB(1, 0), cB + kstep, voffB); PG8_STAGE(PG8_SA(1, 0), cA + kstep, voffA); PG8_STAGE(PG8_SB(1, 1), cB + hstep + kstep, voffB);
        PG8_WAIT_V(6); PG8_BAR;
    }
    for (;;) {
        const bool has_next = S.next(ui + 1, nxt);
        const char* nA = has_next ? (const char*)g.A + (size_t)nxt.pm * tstep : cA; const char* nB = has_next ? (const char*)g.Bt + (size_t)nxt.pn * tstep : cB;
        for (int t = 0; t < nt; t += 2) {
            const bool last = (t == nt - 2);
            const char* a1 = cA + (size_t)(t + 1) * kstep;
            const char* a2 = last ? nA : cA + (size_t)(t + 2) * kstep; const char* b2 = last ? nB : cB + (size_t)(t + 2) * kstep;
            const char* a3 = a2 + kstep; const char* b3 = b2 + kstep;
            if (last && has_next) S.a_ready(nxt);
            if constexpr (SP2) {
            PG8_LDB(B0, 0, 0); PG8_LDB(B1, 0, 1); PG8_SCHED; PG8_LDA(At, 0, 0); PG8_STAGE(PG8_SA(1, 1), a1 + hstep, voffA);
            PG8_WAIT_V(8); PG8_WAIT_L(0); PG8_BAR; PG8_MMA(0, 0, At, B0); PG8_MMA(0, 1, At, B1); PG8_BAR; PG8_SCHED;
            PG8_LDA(At, 0, 1); PG8_STAGE(PG8_SB(0, 0), b2, voffB); PG8_STAGE(PG8_SB(0, 1), b2 + hstep, voffB); PG8_STAGE(PG8_SA(0, 0), a2, voffA);
            PG8_WAIT_V(8); PG8_WAIT_L(0); PG8_BAR; PG8_MMA(1, 0, At, B0); PG8_MMA(1, 1, At, B1); PG8_BAR; PG8_SCHED;
            PG8_LDB(B0, 1, 0); PG8_LDB(B1, 1, 1); PG8_SCHED; PG8_LDA(At, 1, 0); PG8_STAGE(PG8_SA(0, 1), a2 + hstep, voffA);
            PG8_WAIT_V(8); PG8_WAIT_L(0); PG8_BAR; PG8_MMA(0, 0, At, B0); PG8_MMA(0, 1, At, B1); PG8_BAR; PG8_SCHED;
            PG8_LDA(At, 1, 1); PG8_STAGE(PG8_SB(1, 0), b3, voffB); PG8_STAGE(PG8_SB(1, 1), b3 + hstep, voffB); PG8_STAGE(PG8_SA(1, 0), a3, voffA);
            PG8_WAIT_V(8); PG8_WAIT_L(0); PG8_BAR; PG8_MMA(1, 0, At, B0); PG8_MMA(1, 1, At, B1); PG8_BAR; PG8_SCHED;
            } else {
            PG8_LDB(B0, 0, 0); PG8_SCHED; PG8_LDA(At, 0, 0); PG8_STAGE(PG8_SA(1, 1), a1 + hstep, voffA);
            PG8_WAIT_L(8); PG8_BAR; PG8_WAIT_L(0); PG8_MMA(0, 0, At, B0); PG8_BAR; PG8_SCHED;
            PG8_LDB(B1, 0, 1); PG8_STAGE(PG8_SB(0, 0), b2, voffB);
            PG8_BAR; PG8_WAIT_L(0); PG8_MMA(0, 1, At, B1); PG8_BAR;
            PG8_LDA(At, 0, 1); PG8_STAGE(PG8_SA(0, 0), a2, voffA);
            PG8_BAR; PG8_WAIT_L(0); PG8_MMA(1, 0, At, B0); PG8_BAR; PG8_SCHED;
            PG8_STAGE(PG8_SB(0, 1), b2 + hstep, voffB);
            PG8_WAIT_V(6); PG8_BAR; PG8_MMA(1, 1, At, B1); PG8_BAR;
            PG8_LDB(B0, 1, 0); PG8_SCHED; PG8_LDA(At, 1, 0); PG8_STAGE(PG8_SA(0, 1), a2 + hstep, voffA);
            PG8_WAIT_L(8); PG8_BAR; PG8_WAIT_L(0); PG8_MMA(0, 0, At, B0); PG8_BAR; PG8_SCHED;
            PG8_LDB(B1, 1, 1); PG8_STAGE(PG8_SB(1, 0), b3, voffB);
            PG8_BAR; PG8_WAIT_L(0); PG8_MMA(0, 1, At, B1); PG8_BAR;
            PG8_LDA(At, 1, 1); PG8_STAGE(PG8_SA(1, 0), a3, voffA);
            PG8_BAR; PG8_WAIT_L(0); PG8_MMA(1, 0, At, B0); PG8_BAR; PG8_SCHED;
            PG8_STAGE(PG8_SB(1, 1), b3 + hstep, voffB);
            PG8_WAIT_V(6); PG8_BAR; PG8_MMA(1, 1, At, B1); PG8_BAR;
            }
        }
        if constexpr (ALIGN_EPI) { if (wr == 0) PG8_BAR; }
        if constexpr (!Epi::AFTER_DRAIN) { E(acc, cur, wr, wc, fr, fq); S.done(cur); }
        if (!has_next) break;
#pragma unroll
        for (int a = 0; a < 2; ++a)
#pragma unroll
            for (int b = 0; b < 2; ++b)
#pragma unroll
                for (int m = 0; m < 4; ++m)
#pragma unroll
                    for (int n = 0; n < 2; ++n) acc[a][b][m][n] = (f32x4){0.f, 0.f, 0.f, 0.f};
        cur = nxt; cA = nA; cB = nB; ++ui;
        if constexpr (ALIGN_EPI) { if (wr == 1) PG8_BAR; }
    }
    PG8_WAIT_V(0);
    if constexpr (!ALIGN_EPI) { if (wr == 0) PG8_BAR; }
    PG8_BAR;
#undef PG8_SA
#undef PG8_SB
#undef PG8_STAGE
#undef PG8_LDA
#undef PG8_LDB
#undef PG8_MMA
#undef PG8_WAIT_V
#undef PG8_WAIT_L
#undef PG8_BAR
#undef PG8_SCHED
}
}

#define XB_TMO      128
#define XB_XCNT(j)  (256  + 64 * (j))
#define XB_XSUB(j)  (1280 + 64 * (j))
#define XB_XGEN(j)  (2304 + 64 * (j))
#define XB_TOP      3328
#define XB_TOPGEN   3392
#define XCD_BAR_WORDS 3456
#define XB_SPIN_CAP (1u << 18)
__device__ __forceinline__ unsigned xb_ld(unsigned* p)              { return __hip_atomic_load(p, __ATOMIC_RELAXED, __HIP_MEMORY_SCOPE_AGENT); }
__device__ __forceinline__ unsigned xb_add(unsigned* p, unsigned v) { return __hip_atomic_fetch_add(p, v, __ATOMIC_RELAXED, __HIP_MEMORY_SCOPE_AGENT); }
__device__ __forceinline__ unsigned xb_xcc_id() { return (unsigned)__builtin_amdgcn_s_getreg((3 << 11) | 20) & 0xFu; }
#define XB_SPIN(cond, bar) do { unsigned _sp = 0; while (cond) { __builtin_amdgcn_s_sleep(1); \
    if ((++_sp & 255u) == 0u) { if (xb_ld(&(bar)[XB_TMO])) break; if (_sp > XB_SPIN_CAP) { atomicAdd(&(bar)[XB_TMO], 1u); break; } } } } while (0)
struct XcdBarrier { unsigned* bar; unsigned x; volatile LAS unsigned* st; };
__device__ __forceinline__ XcdBarrier xcd_barrier_post(unsigned* bar, volatile LAS unsigned* st) {
    XcdBarrier b; b.bar = bar; b.x = xb_xcc_id(); b.st = st;
    if (threadIdx.x == 0) (void)xb_add(&bar[XB_XCNT(b.x)], 1u);
    return b;
}
__device__ __forceinline__ void xcd_barrier_complete(unsigned* bar, unsigned x, unsigned& nloc, unsigned& nx) {
    const unsigned G = gridDim.x * gridDim.y * gridDim.z;
    unsigned sum, cnt, mine, sp = 0u;
    for (;;) {
        sum = 0u; cnt = 0u; mine = 0u;
#pragma unroll
        for (unsigned j = 0; j < 16; ++j) { const unsigned c = xb_ld(&bar[XB_XCNT(j)]); sum += c; cnt += (c > 0u) ? 1u : 0u; mine = (j == x) ? c : mine; }
        if (sum == G) break;
        __builtin_amdgcn_s_sleep(1);
        if ((++sp & 255u) == 0u) { if (xb_ld(&bar[XB_TMO])) break; if (sp > XB_SPIN_CAP) { atomicAdd(&bar[XB_TMO], 1u); break; } }
    }
    nloc = mine > 0u ? mine : 1u; nx = cnt > 0u ? cnt : 1u;
}
__device__ __forceinline__ void xcd_barrier(const XcdBarrier& b) {
    asm volatile("s_waitcnt vmcnt(0)" ::: "memory");
    __syncthreads();
    if (threadIdx.x == 0) {
        unsigned* bar = b.bar;
        __builtin_amdgcn_s_waitcnt(0);
        unsigned nloc = b.st[0], nx = b.st[1];
        if (nloc == 0u) { xcd_barrier_complete(bar, b.x, nloc, nx); b.st[0] = nloc; b.st[1] = nx; }
        const unsigned old = xb_add(&bar[XB_XSUB(b.x)], 1u);
        const unsigned gen = old / nloc;
        if (old + 1u == (gen + 1u) * nloc) {
            __builtin_amdgcn_fence(__ATOMIC_RELEASE, "agent");
            asm volatile("s_waitcnt vmcnt(0)" ::: "memory");
            const unsigned og = xb_add(&bar[XB_TOP], 1u);
            const unsigned tg = og / nx;
            if (og + 1u == (tg + 1u) * nx) xb_add(&bar[XB_TOPGEN], 1u);
            else XB_SPIN(xb_ld(&bar[XB_TOPGEN]) == tg, bar);
            __builtin_amdgcn_fence(__ATOMIC_ACQUIRE, "agent");
            xb_add(&bar[XB_XGEN(b.x)], 1u);
            asm volatile("s_waitcnt vmcnt(0)" ::: "memory");
        } else {
            XB_SPIN(xb_ld(&bar[XB_XGEN(b.x)]) == gen, bar);
            __builtin_amdgcn_fence(__ATOMIC_ACQUIRE, "agent");
            asm volatile("s_waitcnt vmcnt(0)" ::: "memory");
        }
    }
    __syncthreads();
}

template <int MAP>
DI int colmap(int v, int Nsrc) {
    if (MAP == 0) return v < Nsrc ? v : -1;
    const int g8 = v >> 3, e = v & 7, j = 4 * g8 + (e & 3); return (e < 4) ? j : FF + j;
}
template <int MAP>
DI void p0_transpose_item(const float* W, int K, int Nsrc, const float* gain, bf16_t* WT, LAS float* scr, int kb, int nb, int lane) {
    const int k0 = 64 * kb, n0 = 32 * nb;
    const int sc = colmap<MAP>(n0 + (lane & 31), Nsrc);
#pragma unroll 8
    for (int i = 0; i < 32; ++i) { const int kk = 2 * i + (lane >> 5); float w = 0.f; if (sc >= 0) w = W[(size_t)(k0 + kk) * Nsrc + sc]; if (gain) w *= gain[k0 + kk]; scr[kk * 33 + (lane & 31)] = w; }
    WSYNC();
    const int c = lane & 7;
#pragma unroll
    for (int j = 0; j < 4; ++j) { const int n = (lane >> 3) + 8 * j; const LAS float* s = scr + (8 * c) * 33 + n;
        u32x4 o; o.x = pk2(s[0 * 33], s[1 * 33]); o.y = pk2(s[2 * 33], s[3 * 33]); o.z = pk2(s[4 * 33], s[5 * 33]); o.w = pk2(s[6 * 33], s[7 * 33]);
        *(u32x4*)(WT + (size_t)(n0 + n) * K + k0 + 8 * c) = o; }
    WSYNC();
}

__global__ void __launch_bounds__(NTHR, 2) fwd(Args args) {
    extern __shared__ __attribute__((aligned(16))) unsigned char lds_raw[];
    LAS unsigned char* lds = (LAS unsigned char*)lds_raw;
    LAS float* ldsf = (LAS float*)lds;
    volatile LAS unsigned* LCTL = (volatile LAS unsigned*)(lds + LDS_CTL);
    const int tid0 = threadIdx.x, wave = __builtin_amdgcn_readfirstlane(tid0 >> 6);
    const int G = gridDim.x, bid = blockIdx.x;
#define LAUNDER_TID() int tid = tid0; asm volatile("" : "+v"(tid)); const int lane = tid & 63; (void)lane
    unsigned char* ws = args.ws;
    unsigned* ctl = (unsigned*)(ws + WS_CTL);
    float* acc_base = (float*)(ws + WS_ACC);
    float* ssq0 = (float*)(ws + WS_SSQ0);
    float* hb = (float*)(ws + WS_HB);
    bf16_t* XB = (bf16_t*)(ws + WS_XB); bf16_t* Y = (bf16_t*)(ws + WS_Y); bf16_t* PB = (bf16_t*)(ws + WS_PB); bf16_t* ACT = (bf16_t*)(ws + WS_ACT);
    const float2* cs64 = (const float2*)(ws + WS_CS64); const float2* cs32 = (const float2*)(ws + WS_CS32);
    float* LA = (float*)(ws + WS_LA); float* LH = (float*)(ws + WS_LH); float* CIN = (float*)(ws + WS_CIN);
    float* KVC = (float*)(ws + WS_KVC); float* DEC = (float*)(ws + WS_DEC); float* SST = (float*)(ws + WS_SST);
    bf16_t* MQ = (bf16_t*)(ws + WS_MQ); bf16_t* MKN = (bf16_t*)(ws + WS_MKN); bf16_t* MV = (bf16_t*)(ws + WS_MV); bf16_t* MKR = (bf16_t*)(ws + WS_MKR);
    float* KCMP = (float*)(ws + WS_KCMP); float* VCMP = (float*)(ws + WS_VCMP);
    const int* positions = (const int*)args.in[1];

    { LAUNDER_TID(); if (tid < 16) LCTL[tid] = 0u; }
    __syncthreads();
    const int lo = args.ph_lo, hi = args.ph_hi;
    XcdBarrier bar; bar.bar = ctl + CW_BAR; bar.x = 0; bar.st = LCTL;
    if (hi - lo > 1) bar = xcd_barrier_post(ctl + CW_BAR, LCTL);
#define IN(k) (lo <= (k) && (k) < hi)
#define SEAM(k) do { if (IN(k) && IN((k) + 1)) xcd_barrier(bar); } while (0)

    if (IN(0)) {
        LAUNDER_TID();
        const int gw = bid * 8 + wave, NGW = G * 8;
        LAS float* scr = ldsf + wave * 4096;
        constexpr int I_IN = 16 * 72, I_OUT = 16 * 32, I_GU = 16 * 176, I_DN = 44 * 32, I_L = I_IN + I_OUT + I_GU + I_DN;
        for (int it = gw; it < 2 * I_L; it += NGW) {
            const int l = it / I_L; int r = it % I_L;
            if (r < I_IN) { p0_transpose_item<0>(args.in[3] + (size_t)l * DM * NINS, DM, NINS, args.in[2] + l * DM, (bf16_t*)(ws + WS_WIN) + (size_t)l * NIN * DM, scr, r / 72, r % 72, lane); continue; } r -= I_IN;
            if (r < I_OUT) { p0_transpose_item<0>(args.in[23] + (size_t)l * DM * DM, DM, DM, args.in[22] + l * DM, (bf16_t*)(ws + WS_WOUT) + (size_t)l * DM * DM, scr, r / 32, r % 32, lane); continue; } r -= I_OUT;
            if (r < I_GU) { p0_transpose_item<1>(args.in[25] + (size_t)l * DM * NGU, DM, NGU, args.in[24] + l * DM, (bf16_t*)(ws + WS_WGU) + (size_t)l * NGU * DM, scr, r / 176, r % 176, lane); continue; } r -= I_GU;
            p0_transpose_item<0>(args.in[26] + (size_t)l * FF * DM, FF, DM, nullptr, (bf16_t*)(ws + WS_WDN) + (size_t)l * DM * FF, scr, r / 32, r % 32, lane);
        }
        for (int m = gw; m < M; m += NGW) {
            const f32x4* xr = (const f32x4*)(args.in[0] + (size_t)m * DM) + lane;
            f32x4 v[4]; float s = 0.f;
#pragma unroll
            for (int j = 0; j < 4; ++j) { v[j] = xr[64 * j]; s += v[j][0] * v[j][0] + v[j][1] * v[j][1] + v[j][2] * v[j][2] + v[j][3] * v[j][3]; }
            s = wave_sum(s);
            u32x2* o8 = (u32x2*)(XB + (size_t)m * DM) + lane;
#pragma unroll
            for (int j = 0; j < 4; ++j) { u32x2 w; w.x = pk2(v[j][0], v[j][1]); w.y = pk2(v[j][2], v[j][3]); o8[64 * j] = w; }
            if (lane == 0) ssq0[m] = s;
        }
        for (int e = bid * NTHR + tid; e < M * 32; e += G * NTHR) {
            const int m = e >> 5, i = e & 31; const float pos = (float)positions[m];
            const float invf = powf(10000.f, -(float)(2 * i) / 64.f); float sn, cs; sincosf(pos * invf, &sn, &cs);
            ((float2*)(ws + WS_CS64))[e] = make_float2(cs, sn);
            if (i < 16) { const float invf2 = powf(10000.f, -(float)(2 * i) / 32.f); sincosf(pos * invf2, &sn, &cs); ((float2*)(ws + WS_CS32))[m * 16 + i] = make_float2(cs, sn); }
        }
        for (int e = bid * NTHR + tid; e < 2 * 2 * 256; e += G * NTHR) {
            const int lj = e >> 8, c = e & 255; float a = args.in[13][e];
            const float* pp = args.in[11] + (size_t)lj * 2048; const float* w1 = args.in[12] + (size_t)lj * 2048 * 256 + c;
            for (int i = 0; i < 2048; ++i) a += pp[i] * w1[(size_t)i * 256];
            hb[e] = a;
        }
    }
    SEAM(0);

    for (int l = 0; l < 2; ++l) {
        const int pb = 1 + 7 * l;
        const float* ssq_mix = (l == 0) ? ssq0 : acc_base + 2 * M;
        float* ssq_out = acc_base + (size_t)l * M;
        float* ssq_down = acc_base + (size_t)(2 + l) * M;
        float* ssq_d = acc_base + (size_t)(4 + l) * M;
        if (IN(pb)) {
            pg8::Gemm g{XB, (const bf16_t*)(ws + WS_WIN) + (size_t)l * NIN * DM, M, NIN, DM}; pg8::StaticOrder S; S.init(M, NIN, G, bid);
            pg8::EpiInProj E{PB, NIN, ssq_mix};
            pg8::gemm_phase<pg8::EpiInProj, pg8::StaticOrder, true, true>(lds, g, S, E);
        }
        SEAM(pb);
        if (IN(pb + 1)) {
        LAUNDER_TID();
            constexpr int N_J1 = 1024, N_J2 = 512, N_J3 = 2048, N_J4 = 512, N_J4B = 512, N_P2 = N_J1 + N_J2 + N_J3 + N_J4 + N_J4B;
            for (int it = bid; it < N_P2; it += G) {
                int r = it;
                if (r < N_J1) {
                    const int b = r >> 8, tb = r & 255, t0 = tb * 32, ch = tid & 255, half = tid >> 8;
                    LAS float* xa = ldsf; LAS float* xc = ldsf + 35 * 256;
                    for (int e = tid; e < 35 * 256; e += NTHR) { const int rr = e >> 8, c = e & 255, t = t0 - 3 + rr; float v = 0.f; if (t >= 0) v = bf2f(PB[(size_t)(b * SEQ + t) * NIN + C_AX + c]); xa[e] = v; }
                    __syncthreads();
                    { const float cw0 = args.in[4][(l * 4 + 0) * 256 + ch], cw1 = args.in[4][(l * 4 + 1) * 256 + ch], cw2 = args.in[4][(l * 4 + 2) * 256 + ch], cw3 = args.in[4][(l * 4 + 3) * 256 + ch], cb = args.in[5][l * 256 + ch];
                      for (int tt = 0; tt < 16; ++tt) { const int rr = half * 16 + tt; xc[rr * 256 + ch] = cb + cw0 * xa[rr * 256 + ch] + cw1 * xa[(rr + 1) * 256 + ch] + cw2 * xa[(rr + 2) * 256 + ch] + cw3 * xa[(rr + 3) * 256 + ch]; } }
                    __syncthreads();
                    const int h = ch >> 6, cc = ch & 63;
                    LAS float* gR = ldsf + 67 * 256; LAS float* gI = gR + 32 * 256;
#pragma unroll 1
                    for (int pass = 0; pass < 2; ++pass) {
                        float wv[64]; const float* wsrc = (pass == 0 ? args.in[6] : args.in[8]) + ((size_t)(l * 4 + h) * 64) * 64 + cc; const float bias = (pass == 0 ? args.in[7] : args.in[9])[l * 256 + ch];
#pragma unroll
                        for (int i = 0; i < 64; ++i) wv[i] = wsrc[i * 64];
#pragma unroll 1
                        for (int tt = 0; tt < 16; ++tt) { const LAS f32x4* xr = (const LAS f32x4*)(xc + (half * 16 + tt) * 256 + h * 64); float a = bias;
#pragma unroll
                            for (int i4 = 0; i4 < 16; ++i4) { const f32x4 x = xr[i4]; a += x[0] * wv[4 * i4] + x[1] * wv[4 * i4 + 1] + x[2] * wv[4 * i4 + 2] + x[3] * wv[4 * i4 + 3]; }
                            (pass == 0 ? gR : gI)[(half * 16 + tt) * 256 + ch] = sigmoidf_(a); }
                    }
                    const float sp = log1pf(expf(-args.in[10][l * 256 + ch]));
                    float hst = 0.f, Ac = 1.f;
#pragma unroll 1
                    for (int tt = 0; tt < 16; ++tt) {
                        const int rr = half * 16 + tt;
                        const float rg = gR[rr * 256 + ch], ig = gI[rr * 256 + ch], la = -8.f * rg * sp, av = expf(la), mult = sqrtf(-expm1f(2.f * la));
                        const float u = mult * (ig * xc[rr * 256 + ch]);
                        hst = av * hst + u; Ac *= av;
                    }
                    const size_t so = ((size_t)(b * 512 + tb * 2 + half)) * 256 + ch;
                    LA[so] = Ac; LH[so] = hst;
                    __syncthreads();
                    continue;
                }
                r -= N_J1;
                if (r < N_J2) {
                    const int b = r >> 7, c = r & 127; const size_t row0 = (size_t)b * SEQ + 64 * c;
                    LAS float* glr = ldsf; LAS float* bb = ldsf + 1024; LAS float* kt = bb + 8192; LAS float* vv = kt + 8192;
                    for (int e = tid; e < 1024; e += NTHR) glr[e] = bf2f(PB[(row0 + (e >> 4)) * NIN + C_GLR + (e & 15)]);
                    __syncthreads();
                    for (int e = tid; e < 8192; e += NTHR) { const int t = e >> 7, kk = e & 127; float z = args.in[16][l * 128 + kk];
#pragma unroll
                        for (int q = 0; q < 16; ++q) z += glr[t * 16 + q] * args.in[15][(l * 16 + q) * 128 + kk];
                        bb[e] = (fminf(z, 0.f) - log1pf(expf(-fabsf(z)))) * (1.f / 16.f); }
                    __syncthreads();
                    if (tid < 128) { float run = 0.f; for (int t = 0; t < 64; ++t) { run += bb[t * 128 + tid]; bb[t * 128 + tid] = run; } }
                    __syncthreads();
                    for (int e = tid; e < 8192; e += NTHR) { const int t = e >> 7, kk = e & 127; kt[e] = bf2f(PB[(row0 + t) * NIN + C_CK + kk]) * expf(bb[63 * 128 + kk] - bb[e]); }
                    for (int e = tid; e < 16384; e += NTHR) vv[e] = bf2f(PB[(row0 + (e >> 8)) * NIN + C_CV + (e & 255)]);
                    __syncthreads();
                    { const int h = tid >> 7, k = (tid >> 2) & 31, v0 = (tid & 3) * 16; float a16[16];
#pragma unroll
                      for (int i = 0; i < 16; ++i) a16[i] = 0.f;
                      for (int t = 0; t < 64; ++t) { const float kv = kt[t * 128 + h * 32 + k]; const LAS f32x4* vp = (const LAS f32x4*)(vv + t * 256 + h * 64 + v0);
#pragma unroll
                          for (int i = 0; i < 4; ++i) { const f32x4 x = vp[i]; a16[4 * i] += kv * x[0]; a16[4 * i + 1] += kv * x[1]; a16[4 * i + 2] += kv * x[2]; a16[4 * i + 3] += kv * x[3]; } }
                      float* o = KVC + ((size_t)(b * 128 + c) * 4 + h) * 2048 + k * 64 + v0;
#pragma unroll
                      for (int i = 0; i < 16; ++i) o[i] = a16[i];
                      if (tid < 128) DEC[(size_t)(b * 128 + c) * 128 + tid] = expf(bb[63 * 128 + tid]); }
                    __syncthreads();
                    continue;
                }
                r -= N_J2;
                if (r < N_J3) {
                    const size_t row0 = (size_t)r * 16;
                    LAS float* xq = ldsf; LAS float* xkv = ldsf + 3072; LAS float* outb = ldsf + 5120;
                    for (int q = 0; q < 2; ++q) { const int tok = wave * 2 + q; const bf16_t* pr = PB + (row0 + tok) * NIN;
                        const float a0 = bf2f(pr[C_DCQ + lane]), a1 = bf2f(pr[C_DCQ + 64 + lane]), a2 = bf2f(pr[C_DCQ + 128 + lane]);
                        const float rq = rsqrtf(wave_sum(a0 * a0 + a1 * a1 + a2 * a2) * (1.f / 192.f) + EPS);
                        xq[lane * 16 + tok] = a0 * rq * args.in[18][l * 192 + lane]; xq[(lane + 64) * 16 + tok] = a1 * rq * args.in[18][l * 192 + 64 + lane]; xq[(lane + 128) * 16 + tok] = a2 * rq * args.in[18][l * 192 + 128 + lane];
                        const float c0 = bf2f(pr[C_DCKV + lane]), c1 = bf2f(pr[C_DCKV + 64 + lane]);
                        const float rk = rsqrtf(wave_sum(c0 * c0 + c1 * c1) * (1.f / 128.f) + EPS);
                        xkv[lane * 16 + tok] = c0 * rk * args.in[19][l * 128 + lane]; xkv[(lane + 64) * 16 + tok] = c1 * rk * args.in[19][l * 128 + 64 + lane]; }
                    __syncthreads();
                    for (int cidx = tid; cidx < 896; cidx += NTHR) {
                        const bool isq = cidx < 384; const int col = isq ? cidx : cidx - 384, KK = isq ? 192 : 128, NN = isq ? 384 : 512;
                        const float* W = isq ? args.in[20] + (size_t)l * 192 * 384 : args.in[21] + (size_t)l * 128 * 512; const LAS float* x = isq ? xq : xkv;
                        float a16[16];
#pragma unroll
                        for (int i = 0; i < 16; ++i) a16[i] = 0.f;
                        for (int kk = 0; kk < KK; ++kk) { const float w = W[(size_t)kk * NN + col]; const LAS f32x4* xp = (const LAS f32x4*)(x + kk * 16);
#pragma unroll
                            for (int i = 0; i < 4; ++i) { const f32x4 xx = xp[i]; a16[4 * i] += w * xx[0]; a16[4 * i + 1] += w * xx[1]; a16[4 * i + 2] += w * xx[2]; a16[4 * i + 3] += w * xx[3]; } }
#pragma unroll
                        for (int i = 0; i < 16; ++i) outb[i * 896 + cidx] = a16[i];
                    }
                    __syncthreads();
                    const float SCQ = 0.10206207261596575f;
                    for (int e = tid; e < 16 * 384; e += NTHR) { const int tok = e / 384, c = e % 384, h = c / 96, d = c % 96; float val;
                        if (d < 64) val = outb[tok * 896 + c];
                        else { const int i = (d - 64) & 15; const float x1 = outb[tok * 896 + h * 96 + 64 + i], x2 = outb[tok * 896 + h * 96 + 80 + i]; const float2 cs = cs32[(row0 + tok) * 16 + i];
                            val = (d < 80) ? x1 * cs.x - x2 * cs.y : x2 * cs.x + x1 * cs.y; }
                        MQ[(row0 + tok) * 384 + c] = f2bf(val * SCQ); }
                    for (int e = tid; e < 16 * 512; e += NTHR) { const int tok = e >> 9, c = e & 511, h = c >> 7, d = c & 127; const bf16_t v = f2bf(outb[tok * 896 + 384 + c]);
                        if (d < 64) MKN[(row0 + tok) * 256 + h * 64 + d] = v; else MV[(row0 + tok) * 256 + h * 64 + d - 64] = v; }
                    { const int tok = tid >> 5, d = tid & 31, i = d & 15; const bf16_t* pr = PB + (row0 + tok) * NIN + C_DKR; const float x1 = bf2f(pr[i]), x2 = bf2f(pr[16 + i]); const float2 cs = cs32[(row0 + tok) * 16 + i];
                      MKR[(row0 + tok) * 32 + d] = f2bf(d < 16 ? x1 * cs.x - x2 * cs.y : x2 * cs.x + x1 * cs.y); }
                    __syncthreads();
                    continue;
                }
                r -= N_J3;
                if (r < N_J4) {
                    const size_t row0 = (size_t)r * 64;
                    for (int e = tid; e < 64 * 192; e += NTHR) { const int tok = e / 192, p = e % 192, i = p & 31; const int base = p < 128 ? C_BQ + (p >> 5) * 64 : (p < 160 ? C_KS : C_KW); const float sc = p < 128 ? 0.125f : 1.f;
                        bf16_t* pr = PB + (row0 + tok) * NIN + base; const float x1 = bf2f(pr[i]), x2 = bf2f(pr[32 + i]); const float2 cs = cs64[(row0 + tok) * 32 + i];
                        pr[i] = f2bf((x1 * cs.x - x2 * cs.y) * sc); pr[32 + i] = f2bf((x2 * cs.x + x1 * cs.y) * sc); }
                    continue;
                }
                r -= N_J4;
                {
                    const int j = r & 1, nb = (r >> 1) & 63, b = r >> 7; const int colb = j == 0 ? C_KC : C_VC;
                    LAS float* T = ldsf; LAS float* hid = ldsf + 144 * 64;
                    for (int e = tid; e < 144 * 64; e += NTHR) { const int rr = e >> 6, d = e & 63, t = 128 * nb + rr; float v = 0.f;
                        if (t < SEQ) { const bf16_t* pr = PB + ((size_t)b * SEQ + t) * NIN + colb;
                            if (j == 0) { const int i = d & 31; const float x1 = bf2f(pr[i]), x2 = bf2f(pr[32 + i]); const float2 cs = cs64[((size_t)b * SEQ + t) * 32 + i]; v = d < 32 ? x1 * cs.x - x2 * cs.y : x2 * cs.x + x1 * cs.y; }
                            else v = bf2f(pr[d]); }
                        T[e] = v; }
                    __syncthreads();
                    { const int c = tid & 255, half = tid >> 8; const float* w1 = args.in[12] + (size_t)(l * 2 + j) * 2048 * 256 + c;
                      const float hb0 = hb[(l * 2 + j) * 256 + c]; float a0 = hb0, a1 = hb0, a2 = hb0, a3 = hb0;
                      const LAS float* Tb = T + (16 * half * 4) * 64;
                      for (int i = 0; i < 2048; ++i) { const float w = w1[(size_t)i * 256]; a0 += Tb[i] * w; a1 += Tb[i + 1024] * w; a2 += Tb[i + 2048] * w; a3 += Tb[i + 3072] * w; }
                      hid[(half * 4 + 0) * 256 + c] = gelu_tanh(a0); hid[(half * 4 + 1) * 256 + c] = gelu_tanh(a1); hid[(half * 4 + 2) * 256 + c] = gelu_tanh(a2); hid[(half * 4 + 3) * 256 + c] = gelu_tanh(a3); }
                    __syncthreads();
                    { const int nl = tid >> 6, dd = tid & 63, n = 8 * nb + nl; const float* w2 = args.in[14] + (size_t)(l * 2 + j) * 256 * 64 + dd; float o = 0.f;
                      for (int c = 0; c < 256; ++c) o += hid[nl * 256 + c] * w2[c * 64];
                      if (n < 511) (j == 0 ? KCMP : VCMP)[((size_t)b * 512 + n) * 64 + dd] = o; }
                    __syncthreads();
                }
            }
        }
        SEAM(pb + 1);
        if (IN(pb + 2)) {
        LAUNDER_TID();
            constexpr int Q_J5 = 2, Q_J6 = 64, Q_NSA = 512, Q_MLA = 2048, Q_TOT = Q_J5 + Q_J6 + Q_NSA + Q_MLA;
            for (;;) {
                if (tid == 0) LCTL[2] = __hip_atomic_fetch_add(ctl + CW_QUEUE + 64 * l, 1u, __ATOMIC_RELAXED, __HIP_MEMORY_SCOPE_AGENT);
                __syncthreads();
                int r = __builtin_amdgcn_readfirstlane((int)LCTL[2]);
                __syncthreads();
                if (r >= Q_TOT) break;
                if (r < Q_J5) {
                    const int e = r * NTHR + tid, b = e >> 8, ch = e & 255; float carry = 0.f;
                    for (int c0 = 0; c0 < 512; c0 += 8) { float av[8], hv[8];
#pragma unroll
                        for (int q = 0; q < 8; ++q) { const size_t so = ((size_t)(b * 512 + c0 + q)) * 256 + ch; av[q] = LA[so]; hv[q] = LH[so]; }
#pragma unroll
                        for (int q = 0; q < 8; ++q) { CIN[((size_t)(b * 512 + c0 + q)) * 256 + ch] = carry; carry = av[q] * carry + hv[q]; } }
                    continue;
                }
                r -= Q_J5;
                if (r < Q_J6) {
                    const int e = r * NTHR + tid, b = e >> 13, rem = e & 8191; float Sv = 0.f;
                    for (int c0 = 0; c0 < 128; c0 += 8) { float kv[8], dv[8];
#pragma unroll
                        for (int q = 0; q < 8; ++q) { kv[q] = KVC[(size_t)(b * 128 + c0 + q) * 8192 + rem]; dv[q] = DEC[(size_t)(b * 128 + c0 + q) * 128 + (rem >> 6)]; }
#pragma unroll
                        for (int q = 0; q < 8; ++q) { SST[(size_t)(b * 128 + c0 + q) * 8192 + rem] = Sv; Sv = dv[q] * Sv + kv[q]; } }
                    continue;
                }
                r -= Q_J6;
                if (r < Q_NSA) {
                    const int b = r >> 7, tb = r & 127;
                    LAS float* qf = ldsf + wave * 2560; LAS float* pc = qf + 256; LAS float* ps = pc + 2048;
                    const LAS f32x4* qf4 = (const LAS f32x4*)qf; const LAS f32x4* pc4 = (const LAS f32x4*)pc; const LAS f32x4* ps4 = (const LAS f32x4*)ps;
                    for (int i = 0; i < 8; ++i) {
                        const int t = 64 * tb + 8 * wave + i; const size_t row = (size_t)b * SEQ + t; const bf16_t* prow = PB + row * NIN;
#pragma unroll
                        for (int h = 0; h < 4; ++h) qf[h * 64 + lane] = bf2f(prow[C_BQ + h * 64 + lane]);
                        WSYNC();
                        const int nv = t >= 31 ? ((t - 31) >> 4) + 1 : 0;
                        float sc[8][4];
#pragma unroll
                        for (int rr = 0; rr < 8; ++rr) {
                            float d0 = 0.f, d1 = 0.f, d2 = 0.f, d3 = 0.f; const int n = lane + 64 * rr;
                            if (64 * rr < nv) { const int nc = n < 510 ? n : 510; const f32x4* kr = (const f32x4*)(KCMP + ((size_t)b * 512 + nc) * 64);
#pragma unroll 4
                                for (int d4 = 0; d4 < 16; ++d4) { const f32x4 kk = kr[d4]; const f32x4 q0 = qf4[d4], q1 = qf4[16 + d4], q2 = qf4[32 + d4], q3 = qf4[48 + d4];
                                    d0 += q0[0] * kk[0] + q0[1] * kk[1] + q0[2] * kk[2] + q0[3] * kk[3]; d1 += q1[0] * kk[0] + q1[1] * kk[1] + q1[2] * kk[2] + q1[3] * kk[3];
                                    d2 += q2[0] * kk[0] + q2[1] * kk[1] + q2[2] * kk[2] + q2[3] * kk[3]; d3 += q3[0] * kk[0] + q3[1] * kk[1] + q3[2] * kk[2] + q3[3] * kk[3]; } }
                            const bool valid = n < nv;
                            sc[rr][0] = valid ? d0 : -1e30f; sc[rr][1] = valid ? d1 : -1e30f; sc[rr][2] = valid ? d2 : -1e30f; sc[rr][3] = valid ? d3 : -1e30f;
                        }
#pragma unroll
                        for (int h = 0; h < 4; ++h) {
                            float mx = sc[0][h];
#pragma unroll
                            for (int rr = 1; rr < 8; ++rr) mx = fmaxf(mx, sc[rr][h]);
                            mx = wave_max(mx); float sum = 0.f;
#pragma unroll
                            for (int rr = 0; rr < 8; ++rr) { const float p = (lane + 64 * rr < nv) ? __expf(sc[rr][h] - mx) : 0.f; sc[rr][h] = p; sum += p; }
                            sum = wave_sum(sum); const float inv = 1.f / fmaxf(sum, 1e-30f);
#pragma unroll
                            for (int rr = 0; rr < 8; ++rr) pc[(lane + 64 * rr) * 4 + h] = sc[rr][h] * inv;
                        }
                        WSYNC();
                        float oc0 = 0.f, oc1 = 0.f, oc2 = 0.f, oc3 = 0.f;
                        for (int n = 0; n < nv; ++n) { const f32x4 pp = pc4[n]; const float v = VCMP[((size_t)b * 512 + n) * 64 + lane]; oc0 += pp[0] * v; oc1 += pp[1] * v; oc2 += pp[2] * v; oc3 += pp[3] * v; }
                        const int cur = t >> 6; float s0, s1;
                        { float im0 = 0.f, im1 = 0.f;
#pragma unroll
                          for (int q = -1; q < 4; ++q) { const int n0 = 4 * lane + q, n1 = 4 * (lane + 64) + q;
                              if (n0 >= 0) { const f32x4 pp = pc4[n0]; im0 += pp[0] + pp[1] + pp[2] + pp[3]; }
                              { const f32x4 pp = pc4[n1]; im1 += pp[0] + pp[1] + pp[2] + pp[3]; } }
                          const int j0 = lane, j1 = lane + 64;
                          s0 = (j0 == 0 || j0 == cur || j0 == cur - 1) ? 1e9f : (j0 <= cur ? im0 : -1e30f);
                          s1 = (j1 == cur || j1 == cur - 1) ? 1e9f : (j1 <= cur ? im1 : -1e30f); }
                        bool sel0 = false, sel1 = false;
                        for (int k = 0; k < 16; ++k) {
                            const float mx = wave_max(fmaxf(s0, s1));
                            const int cand = (s0 == mx) ? lane : ((s1 == mx) ? lane + 64 : (1 << 20));
                            const int win = wave_min_i(cand);
                            if (win == lane) { sel0 = true; s0 = -3e38f; } if (win == lane + 64) { sel1 = true; s1 = -3e38f; }
                        }
                        const unsigned long long m0 = __ballot(sel0), m1 = __ballot(sel1);
                        float mS[4], lS[4], oS[4], mW[4], lW[4], oW[4];
#pragma unroll
                        for (int h = 0; h < 4; ++h) { mS[h] = -1e30f; lS[h] = 0.f; oS[h] = 0.f; mW[h] = -1e30f; lW[h] = 0.f; oW[h] = 0.f; }
#define NSA_BLOCK(KCOL, VCOL, key0, lov, mm, ll, oo) do { \
                        const int kpos_ = (key0) + lane; const bool valid_ = kpos_ >= (lov) && kpos_ <= t; \
                        const u32x4* kr_ = (const u32x4*)(PB + ((size_t)b * SEQ + kpos_) * NIN + (KCOL)); \
                        float d_[4] = {0.f, 0.f, 0.f, 0.f}; \
                        _Pragma("unroll 2") for (int c8 = 0; c8 < 8; ++c8) { const u32x4 kk = kr_[c8]; float kf[8] = {bflo(kk.x), bfhi(kk.x), bflo(kk.y), bfhi(kk.y), bflo(kk.z), bfhi(kk.z), bflo(kk.w), bfhi(kk.w)}; \
                            _Pragma("unroll") for (int h = 0; h < 4; ++h) { const f32x4 qa = qf4[h * 16 + 2 * c8], qb = qf4[h * 16 + 2 * c8 + 1]; \
                                d_[h] += qa[0] * kf[0] + qa[1] * kf[1] + qa[2] * kf[2] + qa[3] * kf[3] + qb[0] * kf[4] + qb[1] * kf[5] + qb[2] * kf[6] + qb[3] * kf[7]; } } \
                        _Pragma("unroll") for (int h = 0; h < 4; ++h) { const float s_ = valid_ ? d_[h] : -1e30f; const float mn_ = fmaxf(mm[h], wave_max(s_)); const float al_ = __expf(mm[h] - mn_); \
                            const float p_ = valid_ ? __expf(s_ - mn_) : 0.f; ll[h] = ll[h] * al_ + wave_sum(p_); oo[h] *= al_; mm[h] = mn_; ps[lane * 4 + h] = p_; } \
                        WSYNC(); \
                        { const bf16_t* vr_ = PB + ((size_t)b * SEQ + (key0)) * NIN + (VCOL) + lane; \
                          _Pragma("unroll 4") for (int kk = 0; kk < 64; ++kk) { const f32x4 pp = ps4[kk]; const float v = bf2f(vr_[(size_t)kk * NIN]); oo[0] += pp[0] * v; oo[1] += pp[1] * v; oo[2] += pp[2] * v; oo[3] += pp[3] * v; } } \
                        WSYNC(); } while (0)
                        for (int j = 0; j <= cur; ++j) {
                            const bool s = j < 64 ? ((m0 >> j) & 1ull) : ((m1 >> (j - 64)) & 1ull);
                            if (!s) continue;
                            NSA_BLOCK(C_KS, C_VS, 64 * j, 0, mS, lS, oS);
                        }
                        { const int wlo = t - 511 > 0 ? t - 511 : 0;
                          for (int j = wlo >> 6; j <= cur; ++j) NSA_BLOCK(C_KW, C_VW, 64 * j, wlo, mW, lW, oW); }
#undef NSA_BLOCK
                        float o[4]; const float occ[4] = {oc0, oc1, oc2, oc3}; float ss = 0.f;
#pragma unroll
                        for (int h = 0; h < 4; ++h) { const float g0 = sigmoidf_(bf2f(prow[C_BG + h * 3])), g1 = sigmoidf_(bf2f(prow[C_BG + h * 3 + 1])), g2 = sigmoidf_(bf2f(prow[C_BG + h * 3 + 2]));
                            o[h] = g0 * occ[h] + g1 * oS[h] / fmaxf(lS[h], 1e-30f) + g2 * oW[h] / fmaxf(lW[h], 1e-30f); ss += o[h] * o[h]; }
                        const float rinv = rsqrtf(wave_sum(ss) * (1.f / 256.f) + EPS);
#pragma unroll
                        for (int h = 0; h < 4; ++h) Y[row * DM + 256 + h * 64 + lane] = f2bf(o[h] * rinv);
                        WSYNC();
                    }
                    __syncthreads();
                    continue;
                }
                r -= Q_NSA;
                {
                    const int qb = 127 - (r >> 4), bh = r & 15, b = bh >> 2, h = bh & 3;
                    const int t = 64 * qb + lane; const size_t row = (size_t)b * SEQ + t; const int ks = wave & 3, dh = wave >> 2;
                    float q[96], o[32];
                    { const u32x4* qp = (const u32x4*)(MQ + row * 384 + h * 96);
#pragma unroll
                      for (int c = 0; c < 12; ++c) { const u32x4 w = qp[c]; q[8 * c] = bflo(w.x); q[8 * c + 1] = bfhi(w.x); q[8 * c + 2] = bflo(w.y); q[8 * c + 3] = bfhi(w.y); q[8 * c + 4] = bflo(w.z); q[8 * c + 5] = bfhi(w.z); q[8 * c + 6] = bflo(w.w); q[8 * c + 7] = bfhi(w.w); } }
#pragma unroll
                    for (int d = 0; d < 32; ++d) o[d] = 0.f;
                    float mrun = -1e30f, lsum = 0.f;
                    for (int j = ks; j <= qb; j += 4) {
#pragma unroll 1
                        for (int kk = 0; kk < 64; ++kk) {
                            const size_t krow = (size_t)b * SEQ + 64 * j + kk;
                            const u32x4* kn = (const u32x4*)(MKN + krow * 256 + h * 64); const u32x4* kr = (const u32x4*)(MKR + krow * 32);
                            float dot = 0.f;
#pragma unroll
                            for (int i = 0; i < 8; ++i) { const u32x4 w = kn[i]; dot += q[8 * i] * bflo(w.x) + q[8 * i + 1] * bfhi(w.x) + q[8 * i + 2] * bflo(w.y) + q[8 * i + 3] * bfhi(w.y) + q[8 * i + 4] * bflo(w.z) + q[8 * i + 5] * bfhi(w.z) + q[8 * i + 6] * bflo(w.w) + q[8 * i + 7] * bfhi(w.w); }
#pragma unroll
                            for (int i = 0; i < 4; ++i) { const u32x4 w = kr[i]; dot += q[64 + 8 * i] * bflo(w.x) + q[65 + 8 * i] * bfhi(w.x) + q[66 + 8 * i] * bflo(w.y) + q[67 + 8 * i] * bfhi(w.y) + q[68 + 8 * i] * bflo(w.z) + q[69 + 8 * i] * bfhi(w.z) + q[70 + 8 * i] * bflo(w.w) + q[71 + 8 * i] * bfhi(w.w); }
                            const bool valid = (j < qb) || (kk <= lane);
                            const float s = valid ? dot : -1e30f;
                            const float mb = fmaxf(mrun, s), alpha = __expf(mrun - mb), p = valid ? __expf(s - mb) : 0.f;
                            lsum = lsum * alpha + p; mrun = mb;
                            const u32x4* vr = (const u32x4*)(MV + krow * 256 + h * 64 + dh * 32);
#pragma unroll
                            for (int i = 0; i < 4; ++i) { const u32x4 w = vr[i];
                                o[8 * i] = o[8 * i] * alpha + p * bflo(w.x); o[8 * i + 1] = o[8 * i + 1] * alpha + p * bfhi(w.x); o[8 * i + 2] = o[8 * i + 2] * alpha + p * bflo(w.y); o[8 * i + 3] = o[8 * i + 3] * alpha + p * bfhi(w.y);
                                o[8 * i + 4] = o[8 * i + 4] * alpha + p * bflo(w.z); o[8 * i + 5] = o[8 * i + 5] * alpha + p * bfhi(w.z); o[8 * i + 6] = o[8 * i + 6] * alpha + p * bflo(w.w); o[8 * i + 7] = o[8 * i + 7] * alpha + p * bfhi(w.w); }
                        }
                    }
                    LAS float* obuf = ldsf; LAS float* mbuf = ldsf + 16384; LAS float* lbuf = mbuf + 256;
#pragma unroll
                    for (int d4 = 0; d4 < 8; ++d4) *(LAS f32x4*)(obuf + (ks * 64 + lane) * 64 + dh * 32 + 4 * d4) = (f32x4){o[4 * d4], o[4 * d4 + 1], o[4 * d4 + 2], o[4 * d4 + 3]};
                    if (dh == 0) { mbuf[ks * 64 + lane] = mrun; lbuf[ks * 64 + lane] = lsum; }
                    __syncthreads();
                    { const int part = tid & 7, qi = tid >> 3; float Mx = -1e30f;
#pragma unroll
                      for (int w = 0; w < 4; ++w) Mx = fmaxf(Mx, mbuf[w * 64 + qi]);
                      float L = 0.f, acc8[8] = {0.f, 0.f, 0.f, 0.f, 0.f, 0.f, 0.f, 0.f};
#pragma unroll
                      for (int w = 0; w < 4; ++w) { const float e = __expf(mbuf[w * 64 + qi] - Mx); L += e * lbuf[w * 64 + qi];
                          const f32x4 a = *(const LAS f32x4*)(obuf + (w * 64 + qi) * 64 + 8 * part), c = *(const LAS f32x4*)(obuf + (w * 64 + qi) * 64 + 8 * part + 4);
                          acc8[0] += e * a[0]; acc8[1] += e * a[1]; acc8[2] += e * a[2]; acc8[3] += e * a[3]; acc8[4] += e * c[0]; acc8[5] += e * c[1]; acc8[6] += e * c[2]; acc8[7] += e * c[3]; }
                      const float inv = 1.f / fmaxf(L, 1e-30f); float pp = 0.f;
#pragma unroll
                      for (int i = 0; i < 8; ++i) { acc8[i] *= inv; pp += acc8[i] * acc8[i]; }
                      const size_t orow = (size_t)b * SEQ + 64 * qb + qi;
                      u32x4 w; w.x = pk2(acc8[0], acc8[1]); w.y = pk2(acc8[2], acc8[3]); w.z = pk2(acc8[4], acc8[5]); w.w = pk2(acc8[6], acc8[7]);
                      *(u32x4*)(Y + orow * DM + 768 + h * 64 + 8 * part) = w;
                      pp += __shfl_xor(pp, 1); pp += __shfl_xor(pp, 2); pp += __shfl_xor(pp, 4);
                      if (part == 0) atomicAdd(ssq_d + orow, pp); }
                    __syncthreads();
                }
            }
        }
        SEAM(pb + 2);
        if (IN(pb + 3)) {
        LAUNDER_TID();
            constexpr int N_J9 = 1024, N_J10 = 512, N_J11 = 256, N_P4 = N_J9 + N_J10 + N_J11;
            for (int it = bid; it < N_P4; it += G) {
                int r = it;
                if (r < N_J9) {
                    const int b = r >> 8, tb = r & 255, t0 = tb * 32, ch = tid & 255, half = tid >> 8;
                    LAS float* xa = ldsf; LAS float* xc = ldsf + 35 * 256;
                    for (int e = tid; e < 35 * 256; e += NTHR) { const int rr = e >> 8, c = e & 255, t = t0 - 3 + rr; float v = 0.f; if (t >= 0) v = bf2f(PB[(size_t)(b * SEQ + t) * NIN + C_AX + c]); xa[e] = v; }
                    __syncthreads();
                    { const float cw0 = args.in[4][(l * 4 + 0) * 256 + ch], cw1 = args.in[4][(l * 4 + 1) * 256 + ch], cw2 = args.in[4][(l * 4 + 2) * 256 + ch], cw3 = args.in[4][(l * 4 + 3) * 256 + ch], cb = args.in[5][l * 256 + ch];
                      for (int tt = 0; tt < 16; ++tt) { const int rr = half * 16 + tt; xc[rr * 256 + ch] = cb + cw0 * xa[rr * 256 + ch] + cw1 * xa[(rr + 1) * 256 + ch] + cw2 * xa[(rr + 2) * 256 + ch] + cw3 * xa[(rr + 3) * 256 + ch]; } }
                    __syncthreads();
                    const int h = ch >> 6, cc = ch & 63;
                    LAS float* gR = ldsf + 67 * 256; LAS float* gI = gR + 32 * 256;
#pragma unroll 1
                    for (int pass = 0; pass < 2; ++pass) {
                        float wv[64]; const float* wsrc = (pass == 0 ? args.in[6] : args.in[8]) + ((size_t)(l * 4 + h) * 64) * 64 + cc; const float bias = (pass == 0 ? args.in[7] : args.in[9])[l * 256 + ch];
#pragma unroll
                        for (int i = 0; i < 64; ++i) wv[i] = wsrc[i * 64];
#pragma unroll 1
                        for (int tt = 0; tt < 16; ++tt) { const LAS f32x4* xr = (const LAS f32x4*)(xc + (half * 16 + tt) * 256 + h * 64); float a = bias;
#pragma unroll
                            for (int i4 = 0; i4 < 16; ++i4) { const f32x4 x = xr[i4]; a += x[0] * wv[4 * i4] + x[1] * wv[4 * i4 + 1] + x[2] * wv[4 * i4 + 2] + x[3] * wv[4 * i4 + 3]; }
                            (pass == 0 ? gR : gI)[(half * 16 + tt) * 256 + ch] = sigmoidf_(a); }
                    }
                    const float sp = log1pf(expf(-args.in[10][l * 256 + ch]));
                    float hst = CIN[((size_t)(b * 512 + tb * 2 + half)) * 256 + ch];
#pragma unroll 1
                    for (int tt = 0; tt < 16; ++tt) {
                        const int rr = half * 16 + tt;
                        const float rg = gR[rr * 256 + ch], ig = gI[rr * 256 + ch], la = -8.f * rg * sp, av = expf(la), mult = sqrtf(-expm1f(2.f * la));
                        const float u = mult * (ig * xc[rr * 256 + ch]);
                        hst = av * hst + u;
                        const float gate = bf2f(PB[((size_t)b * SEQ + t0 + rr) * NIN + C_AG + ch]);
                        xa[rr * 256 + ch] = hst * gelu_tanh(gate);
                    }
                    __syncthreads();
                    for (int q = 0; q < 4; ++q) { const int rr = wave * 4 + q; const f32x4 v = ((const LAS f32x4*)(xa + rr * 256))[lane];
                        const float rinv = rsqrtf(wave_sum(v[0] * v[0] + v[1] * v[1] + v[2] * v[2] + v[3] * v[3]) * (1.f / 256.f) + EPS);
                        u32x2 w; w.x = pk2(v[0] * rinv, v[1] * rinv); w.y = pk2(v[2] * rinv, v[3] * rinv);
                        *(u32x2*)(Y + ((size_t)b * SEQ + t0 + rr) * DM + 4 * lane) = w; }
                    __syncthreads();
                    continue;
                }
                r -= N_J9;
                if (r < N_J10) {
                    const int b = r >> 7, c = r & 127; const size_t row0 = (size_t)b * SEQ + 64 * c;
                    LAS float* glr = ldsf; LAS float* bh = ldsf + 1024; LAS float* qh = bh + 2048; LAS float* kh = qh + 2048; LAS float* vh = kh + 2048; LAS float* Ah = vh + 4096; LAS float* Sh = Ah + 4096; LAS float* oall = Sh + 2048;
                    for (int e = tid; e < 1024; e += NTHR) glr[e] = bf2f(PB[(row0 + (e >> 4)) * NIN + C_GLR + (e & 15)]);
                    __syncthreads();
                    for (int h = 0; h < 4; ++h) {
                        for (int e = tid; e < 2048; e += NTHR) { const int t = e >> 5, k = e & 31, kk = h * 32 + k; float z = args.in[16][l * 128 + kk];
#pragma unroll
                            for (int q = 0; q < 16; ++q) z += glr[t * 16 + q] * args.in[15][(l * 16 + q) * 128 + kk];
                            bh[e] = (fminf(z, 0.f) - log1pf(expf(-fabsf(z)))) * (1.f / 16.f);
                            qh[e] = bf2f(PB[(row0 + t) * NIN + C_CQ + kk]) * 0.17677669529663687f; kh[e] = bf2f(PB[(row0 + t) * NIN + C_CK + kk]); }
                        for (int e = tid; e < 4096; e += NTHR) vh[e] = bf2f(PB[(row0 + (e >> 6)) * NIN + C_CV + h * 64 + (e & 63)]);
                        for (int e = tid; e < 2048; e += NTHR) Sh[e] = SST[((size_t)(b * 128 + c) * 4 + h) * 2048 + e];
                        __syncthreads();
                        if (tid < 32) { float run = 0.f; for (int t = 0; t < 64; ++t) { run += bh[t * 32 + tid]; bh[t * 32 + tid] = run; } }
                        __syncthreads();
                        for (int e = tid; e < 4096; e += NTHR) { const int i = e >> 6, j = e & 63; float a = 0.f;
                            if (j <= i) {
#pragma unroll 8
                                for (int k = 0; k < 32; ++k) a += qh[i * 32 + k] * kh[j * 32 + k] * __expf(bh[i * 32 + k] - bh[j * 32 + k]); }
                            Ah[e] = a; }
                        __syncthreads();
                        for (int e = tid; e < 2048; e += NTHR) qh[e] *= __expf(bh[e]);
                        __syncthreads();
                        { const int i = tid >> 3, v0 = (tid & 7) * 8; float a8[8] = {0.f, 0.f, 0.f, 0.f, 0.f, 0.f, 0.f, 0.f};
                          for (int k = 0; k < 32; ++k) { const float qe = qh[i * 32 + k]; const LAS f32x4* sp4 = (const LAS f32x4*)(Sh + k * 64 + v0); const f32x4 s0 = sp4[0], s1 = sp4[1];
                              a8[0] += qe * s0[0]; a8[1] += qe * s0[1]; a8[2] += qe * s0[2]; a8[3] += qe * s0[3]; a8[4] += qe * s1[0]; a8[5] += qe * s1[1]; a8[6] += qe * s1[2]; a8[7] += qe * s1[3]; }
                          for (int j = 0; j <= i; ++j) { const float aa = Ah[i * 64 + j]; const LAS f32x4* vp4 = (const LAS f32x4*)(vh + j * 64 + v0); const f32x4 s0 = vp4[0], s1 = vp4[1];
                              a8[0] += aa * s0[0]; a8[1] += aa * s0[1]; a8[2] += aa * s0[2]; a8[3] += aa * s0[3]; a8[4] += aa * s1[0]; a8[5] += aa * s1[1]; a8[6] += aa * s1[2]; a8[7] += aa * s1[3]; }
#pragma unroll
                          for (int q = 0; q < 8; ++q) oall[i * 256 + h * 64 + v0 + q] = a8[q]; }
                        __syncthreads();
                    }
                    for (int q = 0; q < 8; ++q) { const int t = wave * 8 + q; const f32x4 v = ((const LAS f32x4*)(oall + t * 256))[lane];
                        float ssh = v[0] * v[0] + v[1] * v[1] + v[2] * v[2] + v[3] * v[3];
                        ssh += __shfl_xor(ssh, 1); ssh += __shfl_xor(ssh, 2); ssh += __shfl_xor(ssh, 4); ssh += __shfl_xor(ssh, 8);
                        const float rh = rsqrtf(ssh * (1.f / 64.f) + EPS); float y[4]; float ss = 0.f;
                        const bf16_t* og = PB + (row0 + t) * NIN + C_OG + 4 * lane;
#pragma unroll
                        for (int i = 0; i < 4; ++i) { const float g = bf2f(og[i]); y[i] = v[i] * rh * args.in[17][l * 64 + ((4 * lane + i) & 63)] * (g / (1.f + __expf(-g))); ss += y[i] * y[i]; }
                        const float rinv = rsqrtf(wave_sum(ss) * (1.f / 256.f) + EPS);
                        u32x2 w; w.x = pk2(y[0] * rinv, y[1] * rinv); w.y = pk2(y[2] * rinv, y[3] * rinv);
                        *(u32x2*)(Y + (row0 + t) * DM + 512 + 4 * lane) = w; }
                    __syncthreads();
                    continue;
                }
                r -= N_J10;
                {
                    for (int e = tid; e < 128 * 32; e += NTHR) { const size_t row = (size_t)r * 128 + (e >> 5); const int c8 = e & 31;
                        const float rinv = rsqrtf(ssq_d[row] * (1.f / 256.f) + EPS);
                        u32x4* p = (u32x4*)(Y + row * DM + 768 + 8 * c8); u32x4 w = *p;
                        w.x = pk2(bflo(w.x) * rinv, bfhi(w.x) * rinv); w.y = pk2(bflo(w.y) * rinv, bfhi(w.y) * rinv); w.z = pk2(bflo(w.z) * rinv, bfhi(w.z) * rinv); w.w = pk2(bflo(w.w) * rinv, bfhi(w.w) * rinv);
                        *p = w; }
                }
            }
        }
        SEAM(pb + 3);
        if (IN(pb + 4)) {
            pg8::Gemm g{Y, (const bf16_t*)(ws + WS_WOUT) + (size_t)l * DM * DM, M, DM, DM}; pg8::StaticOrder S; S.init(M, DM, G, bid);
            pg8::EpiResid E{l == 0 ? args.in[0] : (const float*)args.out, args.out, XB, ssq_out};
            pg8::gemm_phase<pg8::EpiResid, pg8::StaticOrder, true, true>(lds, g, S, E);
        }
        SEAM(pb + 4);
        if (IN(pb + 5)) {
            pg8::Gemm g{XB, (const bf16_t*)(ws + WS_WGU) + (size_t)l * NGU * DM, M, NGU, DM}; pg8::StaticOrder S; S.init(M, NGU, G, bid);
            pg8::EpiSwiglu E{ACT, ssq_out};
            pg8::gemm_phase<pg8::EpiSwiglu, pg8::StaticOrder, true, true>(lds, g, S, E);
        }
        SEAM(pb + 5);
        if (IN(pb + 6)) {
            pg8::Gemm g{ACT, (const bf16_t*)(ws + WS_WDN) + (size_t)l * DM * FF, M, DM, FF}; pg8::StaticOrder S; S.init(M, DM, G, bid);
            pg8::EpiResid E{(const float*)args.out, args.out, XB, ssq_down};
            pg8::gemm_phase<pg8::EpiResid, pg8::StaticOrder, true, true>(lds, g, S, E);
        }
        SEAM(pb + 6);
    }
    if (IN(15)) {
        LAUNDER_TID();
        const float* ssqf = acc_base + 3 * (size_t)M; const int gw = bid * 8 + wave, NGW = G * 8;
        for (int m = gw; m < M; m += NGW) {
            const float rinv = rsqrtf(ssqf[m] * (1.f / DM) + EPS);
            f32x4* xr = (f32x4*)(args.out + (size_t)m * DM) + lane; const f32x4* gn = (const f32x4*)args.in[27] + lane;
#pragma unroll
            for (int j = 0; j < 4; ++j) { f32x4 v = xr[64 * j]; const f32x4 g = gn[64 * j]; v = v * rinv * g; xr[64 * j] = v; }
        }
    }
#undef IN
#undef SEAM
}

extern "C" void kernel_launch(void* const* d_in, const int* in_sizes, int n_in, void* d_out, int out_size, void* d_ws, size_t ws_size, hipStream_t stream) {
    static int grid = 0;
    if (grid == 0) {
        if (n_in != 28 || in_sizes[0] != M * DM || out_size != M * DM || ws_size < WS_END) { fprintf(stderr, "kernel_launch: unexpected shapes (n_in %d, ws %zu)\n", n_in, ws_size); grid = -1; return; }
        int dev = 0, cus = 0;
        if (hipGetDevice(&dev) != hipSuccess || hipDeviceGetAttribute(&cus, hipDeviceAttributeMultiprocessorCount, dev) != hipSuccess) { grid = -1; return; }
        if (hipFuncSetAttribute((const void*)fwd, hipFuncAttributeMaxDynamicSharedMemorySize, LDS_BYTES) != hipSuccess) { fprintf(stderr, "kernel_launch: hipFuncSetAttribute failed\n"); grid = -1; return; }
        int per_cu = 0;
        if (hipOccupancyMaxActiveBlocksPerMultiprocessor(&per_cu, (const void*)fwd, NTHR, LDS_BYTES) != hipSuccess || per_cu < 1) fprintf(stderr, "kernel_launch: occupancy query says %d\n", per_cu);
        (void)hipGetLastError();
        grid = cus;
    }
    if (grid < 0) return;
    (void)hipMemsetAsync((char*)d_ws + WS_CTL, 0, CTL_ZERO_BYTES, stream);
    Args a{};
    for (int i = 0; i < 28; ++i) a.in[i] = (const float*)d_in[i];
    a.out = (float*)d_out; a.ws = (unsigned char*)d_ws;
    if (MK_N_LAUNCHES == 1) { a.ph_lo = 0; a.ph_hi = 16; hipLaunchKernelGGL(fwd, dim3(grid), dim3(NTHR), LDS_BYTES, stream, a); }
    else for (int p = 0; p < 16; ++p) { a.ph_lo = p; a.ph_hi = p + 1; hipLaunchKernelGGL(fwd, dim3(grid), dim3(NTHR), LDS_BYTES, stream, a); }
}
```

```cpp
#include <hip/hip_runtime.h>
#include <cstdio>
#include <cstdint>

#ifndef MK_N_LAUNCHES
#define MK_N_LAUNCHES 1
#endif

#define LAS __attribute__((address_space(3)))
#define DI __device__ __forceinline__
typedef unsigned short bf16_t;
typedef short bf16x8 __attribute__((ext_vector_type(8)));
typedef float f32x4 __attribute__((ext_vector_type(4)));
typedef unsigned u32x4 __attribute__((ext_vector_type(4)));
typedef unsigned u32x2 __attribute__((ext_vector_type(2)));

constexpr int NB = 4, SEQ = 8192, M = NB * SEQ, DM = 1024, NIN = 2304, NINS = 2300, FF = 2816, NGU = 2 * FF;
constexpr float EPS = 1e-6f;
constexpr int C_AX = 0, C_AG = 256, C_BQ = 512, C_KC = 768, C_VC = 832, C_KS = 896, C_VS = 960, C_KW = 1024, C_VW = 1088, C_BG = 1152,
              C_CQ = 1164, C_CK = 1292, C_CV = 1420, C_GLR = 1676, C_OG = 1692, C_DCQ = 1948, C_DCKV = 2140, C_DKR = 2268;
constexpr size_t MiB = 1u << 20;
constexpr size_t WS_CTL = 0, CTL_ZERO_BYTES = 1 * MiB;
constexpr size_t WS_ACC = 64 * 1024;
constexpr size_t WS_SSQ0 = 1 * MiB;
constexpr size_t WS_HB = 1 * MiB + 256 * 1024;
constexpr size_t WS_WIN = 2 * MiB, WS_WOUT = 11 * MiB, WS_WGU = 15 * MiB, WS_WDN = 37 * MiB;
constexpr size_t WS_CS64 = 64 * MiB, WS_CS32 = 72 * MiB;
constexpr size_t WS_XB = 80 * MiB, WS_Y = 144 * MiB, WS_PB = 208 * MiB, WS_ACT = 208 * MiB;
constexpr size_t WS_LA = 384 * MiB, WS_LH = 386 * MiB, WS_CIN = 388 * MiB;
constexpr size_t WS_KVC = 392 * MiB, WS_DEC = 408 * MiB, WS_SST = 410 * MiB;
constexpr size_t WS_MQ = 428 * MiB, WS_MKN = 452 * MiB, WS_MV = 468 * MiB, WS_MKR = 484 * MiB;
constexpr size_t WS_KCMP = 488 * MiB, WS_VCMP = 489 * MiB, WS_END = 490 * MiB;
constexpr int CW_QUEUE = 64;
constexpr int CW_BAR = 4096;
constexpr int LDS_BYTES = 163840 - 256;
constexpr int LDS_CTL = LDS_BYTES - 64;
constexpr int NTHR = 512;

struct Args { const float* in[28]; float* out; unsigned char* ws; int ph_lo, ph_hi; };

DI float bf2f(bf16_t h) { return __uint_as_float(((unsigned)h) << 16); }
DI float bflo(unsigned u) { return __uint_as_float(u << 16); }
DI float bfhi(unsigned u) { return __uint_as_float(u & 0xffff0000u); }
DI bf16_t f2bf(float f) { unsigned u = __float_as_uint(f); return (bf16_t)((u + 0x7fffu + ((u >> 16) & 1u)) >> 16); }
DI unsigned pk2(float lo, float hi) { return (unsigned)f2bf(lo) | ((unsigned)f2bf(hi) << 16); }
DI float wave_sum(float v) {
#pragma unroll
    for (int o = 1; o < 64; o <<= 1) v += __shfl_xor(v, o);
    return v;
}
DI float wave_max(float v) {
#pragma unroll
    for (int o = 1; o < 64; o <<= 1) v = fmaxf(v, __shfl_xor(v, o));
    return v;
}
DI int wave_min_i(int v) {
#pragma unroll
    for (int o = 1; o < 64; o <<= 1) { int w = __shfl_xor(v, o); v = w < v ? w : v; }
    return v;
}
DI float sigmoidf_(float x) { return 1.f / (1.f + __expf(-x)); }
DI float gelu_tanh(float x) { const float u = 0.7978845608028654f * (x + 0.044715f * x * x * x); return 0.5f * x * (1.f + tanhf(u)); }
#define WSYNC() do { asm volatile("s_waitcnt lgkmcnt(0)" ::: "memory"); __builtin_amdgcn_wave_barrier(); } while (0)

namespace pg8 {
constexpr int BM = 256, BK = 64, HALF = 128, HTB = HALF * BK * 2, NXCD = 8, WGM = 8;
__host__ __device__ __forceinline__ int lds_byte(int r, int c) { const int st = (r >> 4) * 2 + (c >> 5), rr = r & 15, cc = c & 31, ob = rr * 64 + cc * 2; return st * 1024 + (ob ^ (((ob >> 9) & 1) << 5)); }
__host__ __device__ __forceinline__ void stage_rc(int b, int& R, int& C) { const int st = b / 1024, sb = b % 1024, swz = sb ^ (((sb >> 9) & 1) << 5); R = (st >> 1) * 16 + swz / 64; C = (st & 1) * 32 + (swz % 64) / 2; }
__host__ __device__ __forceinline__ int perm32(int rho) { const int n = rho >> 4, i = rho & 15; return 8 * (i >> 2) + 4 * n + (i & 3); }
struct Unit { int pm, pn; };
struct Gemm { const bf16_t* A; const bf16_t* Bt; int M, N, K; };
struct StaticOrder {
    int nM, nN, nwg, G, c;
    __host__ __device__ void init(int M_, int N_, int G_, int c_) { nM = M_ / BM; nN = N_ / BM; nwg = nM * nN; G = G_; c = c_; }
    __host__ __device__ bool next(int i, Unit& u) const {
        const long L = (long)i * G + c; if (L >= nwg) return false;
        int wgid = (int)L; { const int q = nwg / NXCD, r = nwg % NXCD, xcd = wgid % NXCD, off = wgid / NXCD; wgid = (xcd < r ? xcd * (q + 1) : r * (q + 1) + (xcd - r) * q) + off; }
        const int nig = WGM * nN, gid = wgid / nig, fm = gid * WGM, gsz = (nM - fm) < WGM ? (nM - fm) : WGM;
        u.pm = fm + ((wgid % nig) % gsz); u.pn = (wgid % nig) / gsz; return true;
    }
    __device__ __forceinline__ void a_ready(const Unit&) const {}
    __device__ __forceinline__ void done(const Unit&) const {}
};
DI unsigned cvt_pk_bf16(float lo, float hi) { unsigned r; asm volatile("v_cvt_pk_bf16_f32 %0, %1, %2" : "=v"(r) : "v"(lo), "v"(hi)); return r; }

struct EpiInProj {
    static constexpr bool PERM = true, AFTER_DRAIN = false;
    bf16_t* O; int ldc; const float* ssq;
    DI void operator()(const f32x4 (&acc)[2][2][4][2], const Unit& u, int wr, int wc, int fr, int fq) const {
        const int row0 = u.pm * BM + wr * 64 + fr, col0 = u.pn * BM + wc * 32 + 8 * fq;
#pragma unroll
        for (int ai = 0; ai < 2; ++ai)
#pragma unroll
            for (int m = 0; m < 4; ++m) {
                const int row = row0 + ai * HALF + m * 16;
                const float rinv = rsqrtf(ssq[row] * (1.f / DM) + EPS);
                bf16_t* rowp = O + (size_t)row * ldc + col0;
#pragma unroll
                for (int bj = 0; bj < 2; ++bj) {
                    f32x4 v0 = acc[ai][bj][m][0] * rinv, v1 = acc[ai][bj][m][1] * rinv;
                    u32x4 w; w.x = cvt_pk_bf16(v0[0], v0[1]); w.y = cvt_pk_bf16(v0[2], v0[3]); w.z = cvt_pk_bf16(v1[0], v1[1]); w.w = cvt_pk_bf16(v1[2], v1[3]);
                    *(u32x4*)(rowp + bj * HALF) = w;
                }
            }
    }
};
struct EpiResid {
    static constexpr bool PERM = true, AFTER_DRAIN = false;
    const float* xin; float* xout; bf16_t* xb; float* ssq_out;
    DI void operator()(const f32x4 (&acc)[2][2][4][2], const Unit& u, int wr, int wc, int fr, int fq) const {
        const int row0 = u.pm * BM + wr * 64 + fr, col0 = u.pn * BM + wc * 32 + 8 * fq;
#pragma unroll
        for (int ai = 0; ai < 2; ++ai)
#pragma unroll
            for (int m = 0; m < 4; ++m) {
                const int row = row0 + ai * HALF + m * 16;
                float part = 0.f;
#pragma unroll
                for (int bj = 0; bj < 2; ++bj) {
                    const size_t off = (size_t)row * DM + col0 + bj * HALF;
                    const f32x4 r0 = *(const f32x4*)(xin + off), r1 = *(const f32x4*)(xin + off + 4);
                    const f32x4 v0 = acc[ai][bj][m][0] + r0, v1 = acc[ai][bj][m][1] + r1;
                    *(f32x4*)(xout + off) = v0; *(f32x4*)(xout + off + 4) = v1;
                    u32x4 w; w.x = cvt_pk_bf16(v0[0], v0[1]); w.y = cvt_pk_bf16(v0[2], v0[3]); w.z = cvt_pk_bf16(v1[0], v1[1]); w.w = cvt_pk_bf16(v1[2], v1[3]);
                    *(u32x4*)(xb + off) = w;
                    part += v0[0] * v0[0] + v0[1] * v0[1] + v0[2] * v0[2] + v0[3] * v0[3] + v1[0] * v1[0] + v1[1] * v1[1] + v1[2] * v1[2] + v1[3] * v1[3];
                }
                part += __shfl_xor(part, 16); part += __shfl_xor(part, 32);
                if (fq == 0) atomicAdd(ssq_out + row, part);
            }
    }
};
struct EpiSwiglu {
    static constexpr bool PERM = true, AFTER_DRAIN = false;
    bf16_t* act; const float* ssq;
    DI void operator()(const f32x4 (&acc)[2][2][4][2], const Unit& u, int wr, int wc, int fr, int fq) const {
        const int row0 = u.pm * BM + wr * 64 + fr, j0 = u.pn * 128 + wc * 16 + 4 * fq;
#pragma unroll
        for (int ai = 0; ai < 2; ++ai)
#pragma unroll
            for (int m = 0; m < 4; ++m) {
                const int row = row0 + ai * HALF + m * 16;
                const float rinv = rsqrtf(ssq[row] * (1.f / DM) + EPS);
#pragma unroll
                for (int bj = 0; bj < 2; ++bj) {
                    const f32x4 g = acc[ai][bj][m][0] * rinv, up = acc[ai][bj][m][1] * rinv;
                    float a[4];
#pragma unroll
                    for (int i = 0; i < 4; ++i) a[i] = g[i] / (1.f + __expf(-g[i])) * up[i];
                    u32x2 w; w.x = cvt_pk_bf16(a[0], a[1]); w.y = cvt_pk_bf16(a[2], a[3]);
                    *(u32x2*)(act + (size_t)row * FF + j0 + bj * 64) = w;
                }
            }
    }
};

template <class Epi, class Sched, bool ALIGN_EPI = false, bool SP2 = false>
DI void gemm_phase(LAS unsigned char* lds, const Gemm g, const Sched& S, const Epi& E) {
    int tid_ = threadIdx.x; asm volatile("" : "+v"(tid_));
    const int tid = tid_, wid = __builtin_amdgcn_readfirstlane(tid >> 6), lane = tid & 63, wr = wid >> 2, wc = wid & 3, fr = lane & 15, fq = lane >> 4;
    const int K = g.K, nt = K / BK;
    unsigned voffA[2], voffB[2];
#pragma unroll
    for (int i = 0; i < 2; ++i) { int R, C; stage_rc(tid * 16 + i * 8192, R, C); const int Rb = Epi::PERM ? ((R & ~31) + perm32(R & 31)) : R;
        voffA[i] = (unsigned)(R * K + C) * 2u; voffB[i] = (unsigned)(Rb * K + C) * 2u; }
    const size_t kstep = (size_t)(BK * 2);
    const size_t hstep = (size_t)HALF * K * 2;
    const size_t tstep = 2 * hstep;
    const unsigned ldsw = (unsigned)wid * 1024u;
    const int aoff = lds_byte(wr * 64 + fr, fq * 8), boff = lds_byte(wc * 32 + fr, fq * 8);
#define PG8_SA(b, h) (((b) * 2 + (h)) * HTB)
#define PG8_SB(b, h) ((4 + (b) * 2 + (h)) * HTB)
#define PG8_STAGE(bufoff, gbase, voff) do { _Pragma("unroll") for (int _i = 0; _i < 2; ++_i) \
        __builtin_amdgcn_global_load_lds((const unsigned*)((const char*)(gbase) + (voff)[_i]), (LAS unsigned*)(lds + (bufoff) + ldsw + _i * 8192), 16, 0, 0); } while (0)
#define PG8_LDA(dst, b, h) do { _Pragma("unroll") for (int m = 0; m < 4; ++m) _Pragma("unroll") for (int k = 0; k < 2; ++k) dst[m][k] = *(const LAS bf16x8*)(lds + PG8_SA(b, h) + aoff + m * 2048 + k * 1024); } while (0)
#define PG8_LDB(dst, b, h) do { _Pragma("unroll") for (int n = 0; n < 2; ++n) _Pragma("unroll") for (int k = 0; k < 2; ++k) dst[n][k] = *(const LAS bf16x8*)(lds + PG8_SB(b, h) + boff + n * 2048 + k * 1024); } while (0)
#define PG8_MMA(ai, bj, At, Bt) do { __builtin_amdgcn_s_setprio(1); _Pragma("unroll") for (int m = 0; m < 4; ++m) _Pragma("unroll") for (int n = 0; n < 2; ++n) _Pragma("unroll") for (int k = 0; k < 2; ++k) \
        acc[ai][bj][m][n] = __builtin_amdgcn_mfma_f32_16x16x32_bf16(Bt[n][k], At[m][k], acc[ai][bj][m][n], 0, 0, 0); __builtin_amdgcn_s_setprio(0); } while (0)
#define PG8_WAIT_V(n) asm volatile("s_waitcnt vmcnt(" #n ")" ::: "memory")
#define PG8_WAIT_L(n) asm volatile("s_waitcnt lgkmcnt(" #n ")" ::: "memory")
#define PG8_BAR __builtin_amdgcn_s_barrier()
#define PG8_SCHED __builtin_amdgcn_sched_barrier(0)
    Unit cur, nxt; int ui = 0;
    if (!S.next(0, cur)) return;
    f32x4 acc[2][2][4][2];
#pragma unroll
    for (int a = 0; a < 2; ++a)
#pragma unroll
        for (int b = 0; b < 2; ++b)
#pragma unroll
            for (int m = 0; m < 4; ++m)
#pragma unroll
                for (int n = 0; n < 2; ++n) acc[a][b][m][n] = (f32x4){0.f, 0.f, 0.f, 0.f};
    bf16x8 At[4][2], B0[2][2], B1[2][2];
    const char* cA = (const char*)g.A + (size_t)cur.pm * tstep; const char* cB = (const char*)g.Bt + (size_t)cur.pn * tstep;
    S.a_ready(cur);
    if constexpr (SP2) {
        PG8_STAGE(PG8_SB(0, 0), cB, voffB); PG8_STAGE(PG8_SB(0, 1), cB + hstep, voffB); PG8_STAGE(PG8_SA(0, 0), cA, voffA); PG8_STAGE(PG8_SA(0, 1), cA + hstep, voffA);
        if (wr == 1) PG8_BAR;
        PG8_WAIT_V(2); PG8_BAR;
        PG8_STAGE(PG8_SB(1, 0), cB + kstep, voffB); PG8_STAGE(PG8_SA(1, 0), cA + kstep, voffA); PG8_STAGE(PG8_SB(1, 1), cB + hstep + kstep, voffB);
        PG8_WAIT_V(6); PG8_BAR;
    } else {
        PG8_STAGE(PG8_SB(0, 0), cB, voffB); PG8_STAGE(PG8_SA(0, 0), cA, voffA); PG8_STAGE(PG8_SB(0, 1), cB + hstep, voffB); PG8_STAGE(PG8_SA(0, 1), cA + hstep, voffA);
        if (wr == 1) PG8_BAR;
        PG8_WAIT_V(4); PG8_BAR;
        PG8_STAGE(PG8_SB(1, 0), cB + kstep, voffB); PG8_STAGE(PG8_SA(1, 0), cA + kstep, voffA); PG8_STAGE(PG8_SB(1, 1), cB + hstep + kstep, voffB);
        PG8_WAIT_V(6); PG8_BAR;
    }
    for (;;) {
        const bool has_next = S.next(ui + 1, nxt);
        const char* nA = has_next ? (const char*)g.A + (size_t)nxt.pm * tstep : cA; const char* nB = has_next ? (const char*)g.Bt + (size_t)nxt.pn * tstep : cB;
        for (int t = 0; t < nt; t += 2) {
            const bool last = (t == nt - 2);
            const char* a1 = cA + (size_t)(t + 1) * kstep;
            const char* a2 = last ? nA : cA + (size_t)(t + 2) * kstep; const char* b2 = last ? nB : cB + (size_t)(t + 2) * kstep;
            const char* a3 = a2 + kstep; const char* b3 = b2 + kstep;
            if (last && has_next) S.a_ready(nxt);
            if constexpr (SP2) {
            PG8_LDB(B0, 0, 0); PG8_LDB(B1, 0, 1); PG8_SCHED; PG8_LDA(At, 0, 0); PG8_STAGE(PG8_SA(1, 1), a1 + hstep, voffA);
            PG8_WAIT_V(8); PG8_WAIT_L(0); PG8_BAR; PG8_MMA(0, 0, At, B0); PG8_MMA(0, 1, At, B1); PG8_BAR; PG8_SCHED;
            PG8_LDA(At, 0, 1); PG8_STAGE(PG8_SB(0, 0), b2, voffB); PG8_STAGE(PG8_SB(0, 1), b2 + hstep, voffB); PG8_STAGE(PG8_SA(0, 0), a2, voffA);
            PG8_WAIT_V(8); PG8_WAIT_L(0); PG8_BAR; PG8_MMA(1, 0, At, B0); PG8_MMA(1, 1, At, B1); PG8_BAR; PG8_SCHED;
            PG8_LDB(B0, 1, 0); PG8_LDB(B1, 1, 1); PG8_SCHED; PG8_LDA(At, 1, 0); PG8_STAGE(PG8_SA(0, 1), a2 + hstep, voffA);
            PG8_WAIT_V(8); PG8_WAIT_L(0); PG8_BAR; PG8_MMA(0, 0, At, B0); PG8_MMA(0, 1, At, B1); PG8_BAR; PG8_SCHED;
            PG8_LDA(At, 1, 1); PG8_STAGE(PG8_SB(1, 0), b3, voffB); PG8_STAGE(PG8_SB(1, 1), b3 + hstep, voffB); PG8_STAGE(PG8_SA(1, 0), a3, voffA);
            PG8_WAIT_V(8); PG8_WAIT_L(0); PG8_BAR; PG8_MMA(1, 0, At, B0); PG8_MMA(1, 1, At, B1); PG8_BAR; PG8_SCHED;
            } else {
            PG8_LDB(B0, 0, 0); PG8_SCHED; PG8_LDA(At, 0, 0); PG8_STAGE(PG8_SA(1, 1), a1 + hstep, voffA);
            PG8_WAIT_L(8); PG8_BAR; PG8_WAIT_L(0); PG8_MMA(0, 0, At, B0); PG8_BAR; PG8_SCHED;
            PG8_LDB(B1, 0, 1); PG8_STAGE(PG8_SB(0, 0), b2, voffB);
            PG8_BAR; PG8_WAIT_L(0); PG8_MMA(0, 1, At, B1); PG8_BAR;
            PG8_LDA(At, 0, 1); PG8_STAGE(PG8_SA(0, 0), a2, voffA);
            PG8_BAR; PG8_WAIT_L(0); PG8_MMA(1, 0, At, B0); PG8_BAR; PG8_SCHED;
            PG8_STAGE(PG8_SB(0, 1), b2 + hstep, voffB);
            PG8_WAIT_V(6); PG8_BAR; PG8_MMA(1, 1, At, B1); PG8_BAR;
            PG8_LDB(B0, 1, 0); PG8_SCHED; PG8_LDA(At, 1, 0); PG8_STAGE(PG8_SA(0, 1), a2 + hstep, voffA);
            PG8_WAIT_L(8); PG8_BAR; PG8_WAIT_L(0); PG8_MMA(0, 0, At, B0); PG8_BAR; PG8_SCHED;
            PG8_LDB(B1, 1, 1); PG8_STAGE(PG8_SB(1, 0), b3, voffB);
            PG8_BAR; PG8_WAIT_L(0); PG8_MMA(0, 1, At, B1); PG8_BAR;
            PG8_LDA(At, 1, 1); PG8_STAGE(PG8_SA(1, 0), a3, voffA);
            PG8_BAR; PG8_WAIT_L(0); PG8_MMA(1, 0, At, B0); PG8_BAR; PG8_SCHED;
            PG8_STAGE(PG8_SB(1, 1), b3 + hstep, voffB);
            PG8_WAIT_V(6); PG8_BAR; PG8_MMA(1, 1, At, B1); PG8_BAR;
            }
        }
        if constexpr (ALIGN_EPI) { if (wr == 0) PG8_BAR; }
        if constexpr (!Epi::AFTER_DRAIN) { E(acc, cur, wr, wc, fr, fq); S.done(cur); }
        if (!has_next) break;
#pragma unroll
        for (int a = 0; a < 2; ++a)
#pragma unroll
            for (int b = 0; b < 2; ++b)
#pragma unroll
                for (int m = 0; m < 4; ++m)
#pragma unroll
                    for (int n = 0; n < 2; ++n) acc[a][b][m][n] = (f32x4){0.f, 0.f, 0.f, 0.f};
        cur = nxt; cA = nA; cB = nB; ++ui;
        if constexpr (ALIGN_EPI) { if (wr == 1) PG8_BAR; }
    }
    PG8_WAIT_V(0);
    if constexpr (!ALIGN_EPI) { if (wr == 0) PG8_BAR; }
    PG8_BAR;
#undef PG8_SA
#undef PG8_SB
#undef PG8_STAGE
#undef PG8_LDA
#undef PG8_LDB
#undef PG8_MMA
#undef PG8_WAIT_V
#undef PG8_WAIT_L
#undef PG8_BAR
#undef PG8_SCHED
}
}

#define XB_TMO      128
#define XB_XCNT(j)  (256  + 64 * (j))
#define XB_XSUB(j)  (1280 + 64 * (j))
#define XB_XGEN(j)  (2304 + 64 * (j))
#define XB_TOP      3328
#define XB_TOPGEN   3392
#define XCD_BAR_WORDS 3456
#define XB_SPIN_CAP (1u << 18)
__device__ __forceinline__ unsigned xb_ld(unsigned* p)              { return __hip_atomic_load(p, __ATOMIC_RELAXED, __HIP_MEMORY_SCOPE_AGENT); }
__device__ __forceinline__ unsigned xb_add(unsigned* p, unsigned v) { return __hip_atomic_fetch_add(p, v, __ATOMIC_RELAXED, __HIP_MEMORY_SCOPE_AGENT); }
__device__ __forceinline__ unsigned xb_xcc_id() { return (unsigned)__builtin_amdgcn_s_getreg((3 << 11) | 20) & 0xFu; }
#define XB_SPIN(cond, bar) do { unsigned _sp = 0; while (cond) { __builtin_amdgcn_s_sleep(1); \
    if ((++_sp & 255u) == 0u) { if (xb_ld(&(bar)[XB_TMO])) break; if (_sp > XB_SPIN_CAP) { atomicAdd(&(bar)[XB_TMO], 1u); break; } } } } while (0)
struct XcdBarrier { unsigned* bar; unsigned x; volatile LAS unsigned* st; };
__device__ __forceinline__ XcdBarrier xcd_barrier_post(unsigned* bar, volatile LAS unsigned* st) {
    XcdBarrier b; b.bar = bar; b.x = xb_xcc_id(); b.st = st;
    if (threadIdx.x == 0) (void)xb_add(&bar[XB_XCNT(b.x)], 1u);
    return b;
}
__device__ __forceinline__ void xcd_barrier_complete(unsigned* bar, unsigned x, unsigned& nloc, unsigned& nx) {
    const unsigned G = gridDim.x * gridDim.y * gridDim.z;
    unsigned sum, cnt, mine, sp = 0u;
    for (;;) {
        sum = 0u; cnt = 0u; mine = 0u;
#pragma unroll
        for (unsigned j = 0; j < 16; ++j) { const unsigned c = xb_ld(&bar[XB_XCNT(j)]); sum += c; cnt += (c > 0u) ? 1u : 0u; mine = (j == x) ? c : mine; }
        if (sum == G) break;
        __builtin_amdgcn_s_sleep(1);
        if ((++sp & 255u) == 0u) { if (xb_ld(&bar[XB_TMO])) break; if (sp > XB_SPIN_CAP) { atomicAdd(&bar[XB_TMO], 1u); break; } }
    }
    nloc = mine > 0u ? mine : 1u; nx = cnt > 0u ? cnt : 1u;
}
__device__ __forceinline__ void xcd_barrier(const XcdBarrier& b) {
    asm volatile("s_waitcnt vmcnt(0)" ::: "memory");
    __syncthreads();
    if (threadIdx.x == 0) {
        unsigned* bar = b.bar;
        __builtin_amdgcn_s_waitcnt(0);
        unsigned nloc = b.st[0], nx = b.st[1];
        if (nloc == 0u) { xcd_barrier_complete(bar, b.x, nloc, nx); b.st[0] = nloc; b.st[1] = nx; }
        const unsigned old = xb_add(&bar[XB_XSUB(b.x)], 1u);
        const unsigned gen = old / nloc;
        if (old + 1u == (gen + 1u) * nloc) {
            __builtin_amdgcn_fence(__ATOMIC_RELEASE, "agent");
            asm volatile("s_waitcnt vmcnt(0)" ::: "memory");
            const unsigned og = xb_add(&bar[XB_TOP], 1u);
            const unsigned tg = og / nx;
            if (og + 1u == (tg + 1u) * nx) xb_add(&bar[XB_TOPGEN], 1u);
            else XB_SPIN(xb_ld(&bar[XB_TOPGEN]) == tg, bar);
            __builtin_amdgcn_fence(__ATOMIC_ACQUIRE, "agent");
            xb_add(&bar[XB_XGEN(b.x)], 1u);
            asm volatile("s_waitcnt vmcnt(0)" ::: "memory");
        } else {
            XB_SPIN(xb_ld(&bar[XB_XGEN(b.x)]) == gen, bar);
            __builtin_amdgcn_fence(__ATOMIC_ACQUIRE, "agent");
            asm volatile("s_waitcnt vmcnt(0)" ::: "memory");
        }
    }
    __syncthreads();
}

template <int MAP>
DI int colmap(int v, int Nsrc) {
    if (MAP == 0) return v < Nsrc ? v : -1;
    const int g8 = v >> 3, e = v & 7, j = 4 * g8 + (e & 3); return (e < 4) ? j : FF + j;
}
template <int MAP>
DI void p0_transpose_item(const float* W, int K, int Nsrc, const float* gain, bf16_t* WT, LAS float* scr, int kb, int nb, int lane) {
    const int k0 = 64 * kb, n0 = 32 * nb;
    const int sc = colmap<MAP>(n0 + (lane & 31), Nsrc);
#pragma unroll 8
    for (int i = 0; i < 32; ++i) { const int kk = 2 * i + (lane >> 5); float w = 0.f; if (sc >= 0) w = W[(size_t)(k0 + kk) * Nsrc + sc]; if (gain) w *= gain[k0 + kk]; scr[kk * 33 + (lane & 31)] = w; }
    WSYNC();
    const int c = lane & 7;
#pragma unroll
    for (int j = 0; j < 4; ++j) { const int n = (lane >> 3) + 8 * j; const LAS float* s = scr + (8 * c) * 33 + n;
        u32x4 o; o.x = pk2(s[0 * 33], s[1 * 33]); o.y = pk2(s[2 * 33], s[3 * 33]); o.z = pk2(s[4 * 33], s[5 * 33]); o.w = pk2(s[6 * 33], s[7 * 33]);
        *(u32x4*)(WT + (size_t)(n0 + n) * K + k0 + 8 * c) = o; }
    WSYNC();
}

__global__ void __launch_bounds__(NTHR, 2) fwd(Args args) {
    extern __shared__ __attribute__((aligned(16))) unsigned char lds_raw[];
    LAS unsigned char* lds = (LAS unsigned char*)lds_raw;
    LAS float* ldsf = (LAS float*)lds;
    volatile LAS unsigned* LCTL = (volatile LAS unsigned*)(lds + LDS_CTL);
    const int tid0 = threadIdx.x, wave = __builtin_amdgcn_readfirstlane(tid0 >> 6);
    const int G = gridDim.x, bid = blockIdx.x;
#define LAUNDER_TID() int tid = tid0; asm volatile("" : "+v"(tid)); const int lane = tid & 63; (void)lane
    unsigned char* ws = args.ws;
    unsigned* ctl = (unsigned*)(ws + WS_CTL);
    float* acc_base = (float*)(ws + WS_ACC);
    float* ssq0 = (float*)(ws + WS_SSQ0);
    float* hb = (float*)(ws + WS_HB);
    bf16_t* XB = (bf16_t*)(ws + WS_XB); bf16_t* Y = (bf16_t*)(ws + WS_Y); bf16_t* PB = (bf16_t*)(ws + WS_PB); bf16_t* ACT = (bf16_t*)(ws + WS_ACT);
    const float2* cs64 = (const float2*)(ws + WS_CS64); const float2* cs32 = (const float2*)(ws + WS_CS32);
    float* LA = (float*)(ws + WS_LA); float* LH = (float*)(ws + WS_LH); float* CIN = (float*)(ws + WS_CIN);
    float* KVC = (float*)(ws + WS_KVC); float* DEC = (float*)(ws + WS_DEC); float* SST = (float*)(ws + WS_SST);
    bf16_t* MQ = (bf16_t*)(ws + WS_MQ); bf16_t* MKN = (bf16_t*)(ws + WS_MKN); bf16_t* MV = (bf16_t*)(ws + WS_MV); bf16_t* MKR = (bf16_t*)(ws + WS_MKR);
    float* KCMP = (float*)(ws + WS_KCMP); float* VCMP = (float*)(ws + WS_VCMP);
    const int* positions = (const int*)args.in[1];

    { LAUNDER_TID(); if (tid < 16) LCTL[tid] = 0u; }
    __syncthreads();
    const int lo = args.ph_lo, hi = args.ph_hi;
    XcdBarrier bar; bar.bar = ctl + CW_BAR; bar.x = 0; bar.st = LCTL;
    if (hi - lo > 1) bar = xcd_barrier_post(ctl + CW_BAR, LCTL);
#define IN(k) (lo <= (k) && (k) < hi)
#define SEAM(k) do { if (IN(k) && IN((k) + 1)) xcd_barrier(bar); } while (0)

    if (IN(0)) {
        LAUNDER_TID();
        const int gw = bid * 8 + wave, NGW = G * 8;
        LAS float* scr = ldsf + wave * 4096;
        constexpr int I_IN = 16 * 72, I_OUT = 16 * 32, I_GU = 16 * 176, I_DN = 44 * 32, I_L = I_IN + I_OUT + I_GU + I_DN;
        for (int it = gw; it < 2 * I_L; it += NGW) {
            const int l = it / I_L; int r = it % I_L;
            if (r < I_IN) { p0_transpose_item<0>(args.in[3] + (size_t)l * DM * NINS, DM, NINS, args.in[2] + l * DM, (bf16_t*)(ws + WS_WIN) + (size_t)l * NIN * DM, scr, r / 72, r % 72, lane); continue; } r -= I_IN;
            if (r < I_OUT) { p0_transpose_item<0>(args.in[23] + (size_t)l * DM * DM, DM, DM, args.in[22] + l * DM, (bf16_t*)(ws + WS_WOUT) + (size_t)l * DM * DM, scr, r / 32, r % 32, lane); continue; } r -= I_OUT;
            if (r < I_GU) { p0_transpose_item<1>(args.in[25] + (size_t)l * DM * NGU, DM, NGU, args.in[24] + l * DM, (bf16_t*)(ws + WS_WGU) + (size_t)l * NGU * DM, scr, r / 176, r % 176, lane); continue; } r -= I_GU;
            p0_transpose_item<0>(args.in[26] + (size_t)l * FF * DM, FF, DM, nullptr, (bf16_t*)(ws + WS_WDN) + (size_t)l * DM * FF, scr, r / 32, r % 32, lane);
        }
        for (int m = gw; m < M; m += NGW) {
            const f32x4* xr = (const f32x4*)(args.in[0] + (size_t)m * DM) + lane;
            f32x4 v[4]; float s = 0.f;
#pragma unroll
            for (int j = 0; j < 4; ++j) { v[j] = xr[64 * j]; s += v[j][0] * v[j][0] + v[j][1] * v[j][1] + v[j][2] * v[j][2] + v[j][3] * v[j][3]; }
            s = wave_sum(s);
            u32x2* o8 = (u32x2*)(XB + (size_t)m * DM) + lane;
#pragma unroll
            for (int j = 0; j < 4; ++j) { u32x2 w; w.x = pk2(v[j][0], v[j][1]); w.y = pk2(v[j][2], v[j][3]); o8[64 * j] = w; }
            if (lane == 0) ssq0[m] = s;
        }
        for (int e = bid * NTHR + tid; e < M * 32; e += G * NTHR) {
            const int m = e >> 5, i = e & 31; const float pos = (float)positions[m];
            const float invf = powf(10000.f, -(float)(2 * i) / 64.f); float sn, cs; sincosf(pos * invf, &sn, &cs);
            ((float2*)(ws + WS_CS64))[e] = make_float2(cs, sn);
            if (i < 16) { const float invf2 = powf(10000.f, -(float)(2 * i) / 32.f); sincosf(pos * invf2, &sn, &cs); ((float2*)(ws + WS_CS32))[m * 16 + i] = make_float2(cs, sn); }
        }
        for (int e = bid * NTHR + tid; e < 2 * 2 * 256; e += G * NTHR) {
            const int lj = e >> 8, c = e & 255; float a = args.in[13][e];
            const float* pp = args.in[11] + (size_t)lj * 2048; const float* w1 = args.in[12] + (size_t)lj * 2048 * 256 + c;
            for (int i = 0; i < 2048; ++i) a += pp[i] * w1[(size_t)i * 256];
            hb[e] = a;
        }
    }
    SEAM(0);

    for (int l = 0; l < 2; ++l) {
        const int pb = 1 + 7 * l;
        const float* ssq_mix = (l == 0) ? ssq0 : acc_base + 2 * M;
        float* ssq_out = acc_base + (size_t)l * M;
        float* ssq_down = acc_base + (size_t)(2 + l) * M;
        float* ssq_d = acc_base + (size_t)(4 + l) * M;
        if (IN(pb)) {
            pg8::Gemm g{XB, (const bf16_t*)(ws + WS_WIN) + (size_t)l * NIN * DM, M, NIN, DM}; pg8::StaticOrder S; S.init(M, NIN, G, bid);
            pg8::EpiInProj E{PB, NIN, ssq_mix};
            pg8::gemm_phase<pg8::EpiInProj, pg8::StaticOrder, true, true>(lds, g, S, E);
        }
        SEAM(pb);
        if (IN(pb + 1)) {
        LAUNDER_TID();
            constexpr int N_J1 = 1024, N_J2 = 512, N_J3 = 2048, N_J4 = 512, N_J4B = 512, N_P2 = N_J1 + N_J2 + N_J3 + N_J4 + N_J4B;
            for (int it = bid; it < N_P2; it += G) {
                int r = it;
                if (r < N_J1) {
                    const int b = r >> 8, tb = r & 255, t0 = tb * 32, ch = tid & 255, half = tid >> 8;
                    LAS float* xa = ldsf; LAS float* xc = ldsf + 35 * 256;
                    for (int e = tid; e < 35 * 256; e += NTHR) { const int rr = e >> 8, c = e & 255, t = t0 - 3 + rr; float v = 0.f; if (t >= 0) v = bf2f(PB[(size_t)(b * SEQ + t) * NIN + C_AX + c]); xa[e] = v; }
                    __syncthreads();
                    { const float cw0 = args.in[4][(l * 4 + 0) * 256 + ch], cw1 = args.in[4][(l * 4 + 1) * 256 + ch], cw2 = args.in[4][(l * 4 + 2) * 256 + ch], cw3 = args.in[4][(l * 4 + 3) * 256 + ch], cb = args.in[5][l * 256 + ch];
                      for (int tt = 0; tt < 16; ++tt) { const int rr = half * 16 + tt; xc[rr * 256 + ch] = cb + cw0 * xa[rr * 256 + ch] + cw1 * xa[(rr + 1) * 256 + ch] + cw2 * xa[(rr + 2) * 256 + ch] + cw3 * xa[(rr + 3) * 256 + ch]; } }
                    __syncthreads();
                    const int h = ch >> 6, cc = ch & 63;
                    LAS float* gR = ldsf + 67 * 256; LAS float* gI = gR + 32 * 256;
#pragma unroll 1
                    for (int pass = 0; pass < 2; ++pass) {
                        float wv[64]; const float* wsrc = (pass == 0 ? args.in[6] : args.in[8]) + ((size_t)(l * 4 + h) * 64) * 64 + cc; const float bias = (pass == 0 ? args.in[7] : args.in[9])[l * 256 + ch];
#pragma unroll
                        for (int i = 0; i < 64; ++i) wv[i] = wsrc[i * 64];
#pragma unroll 1
                        for (int tt = 0; tt < 16; ++tt) { const LAS f32x4* xr = (const LAS f32x4*)(xc + (half * 16 + tt) * 256 + h * 64); float a = bias;
#pragma unroll
                            for (int i4 = 0; i4 < 16; ++i4) { const f32x4 x = xr[i4]; a += x[0] * wv[4 * i4] + x[1] * wv[4 * i4 + 1] + x[2] * wv[4 * i4 + 2] + x[3] * wv[4 * i4 + 3]; }
                            (pass == 0 ? gR : gI)[(half * 16 + tt) * 256 + ch] = sigmoidf_(a); }
                    }
                    const float sp = log1pf(expf(-args.in[10][l * 256 + ch]));
                    float hst = 0.f, Ac = 1.f;
#pragma unroll 1
                    for (int tt = 0; tt < 16; ++tt) {
                        const int rr = half * 16 + tt;
                        const float rg = gR[rr * 256 + ch], ig = gI[rr * 256 + ch], la = -8.f * rg * sp, av = expf(la), mult = sqrtf(-expm1f(2.f * la));
                        const float u = mult * (ig * xc[rr * 256 + ch]);
                        hst = av * hst + u; Ac *= av;
                    }
                    const size_t so = ((size_t)(b * 512 + tb * 2 + half)) * 256 + ch;
                    LA[so] = Ac; LH[so] = hst;
                    __syncthreads();
                    continue;
                }
                r -= N_J1;
                if (r < N_J2) {
                    const int b = r >> 7, c = r & 127; const size_t row0 = (size_t)b * SEQ + 64 * c;
                    LAS float* glr = ldsf; LAS float* bb = ldsf + 1024; LAS float* kt = bb + 8192; LAS float* vv = kt + 8192;
                    for (int e = tid; e < 1024; e += NTHR) glr[e] = bf2f(PB[(row0 + (e >> 4)) * NIN + C_GLR + (e & 15)]);
                    __syncthreads();
                    for (int e = tid; e < 8192; e += NTHR) { const int t = e >> 7, kk = e & 127; float z = args.in[16][l * 128 + kk];
#pragma unroll
                        for (int q = 0; q < 16; ++q) z += glr[t * 16 + q] * args.in[15][(l * 16 + q) * 128 + kk];
                        bb[e] = (fminf(z, 0.f) - log1pf(expf(-fabsf(z)))) * (1.f / 16.f); }
                    __syncthreads();
                    if (tid < 128) { float run = 0.f; for (int t = 0; t < 64; ++t) { run += bb[t * 128 + tid]; bb[t * 128 + tid] = run; } }
                    __syncthreads();
                    for (int e = tid; e < 8192; e += NTHR) { const int t = e >> 7, kk = e & 127; kt[e] = bf2f(PB[(row0 + t) * NIN + C_CK + kk]) * expf(bb[63 * 128 + kk] - bb[e]); }
                    for (int e = tid; e < 16384; e += NTHR) vv[e] = bf2f(PB[(row0 + (e >> 8)) * NIN + C_CV + (e & 255)]);
                    __syncthreads();
                    { const int h = tid >> 7, k = (tid >> 2) & 31, v0 = (tid & 3) * 16; float a16[16];
#pragma unroll
                      for (int i = 0; i < 16; ++i) a16[i] = 0.f;
                      for (int t = 0; t < 64; ++t) { const float kv = kt[t * 128 + h * 32 + k]; const LAS f32x4* vp = (const LAS f32x4*)(vv + t * 256 + h * 64 + v0);
#pragma unroll
                          for (int i = 0; i < 4; ++i) { const f32x4 x = vp[i]; a16[4 * i] += kv * x[0]; a16[4 * i + 1] += kv * x[1]; a16[4 * i + 2] += kv * x[2]; a16[4 * i + 3] += kv * x[3]; } }
                      float* o = KVC + ((size_t)(b * 128 + c) * 4 + h) * 2048 + k * 64 + v0;
#pragma unroll
                      for (int i = 0; i < 16; ++i) o[i] = a16[i];
                      if (tid < 128) DEC[(size_t)(b * 128 + c) * 128 + tid] = expf(bb[63 * 128 + tid]); }
                    __syncthreads();
                    continue;
                }
                r -= N_J2;
                if (r < N_J3) {
                    const size_t row0 = (size_t)r * 16;
                    LAS float* xq = ldsf; LAS float* xkv = ldsf + 3072; LAS float* outb = ldsf + 5120;
                    for (int q = 0; q < 2; ++q) { const int tok = wave * 2 + q; const bf16_t* pr = PB + (row0 + tok) * NIN;
                        const float a0 = bf2f(pr[C_DCQ + lane]), a1 = bf2f(pr[C_DCQ + 64 + lane]), a2 = bf2f(pr[C_DCQ + 128 + lane]);
                        const float rq = rsqrtf(wave_sum(a0 * a0 + a1 * a1 + a2 * a2) * (1.f / 192.f) + EPS);
                        xq[lane * 16 + tok] = a0 * rq * args.in[18][l * 192 + lane]; xq[(lane + 64) * 16 + tok] = a1 * rq * args.in[18][l * 192 + 64 + lane]; xq[(lane + 128) * 16 + tok] = a2 * rq * args.in[18][l * 192 + 128 + lane];
                        const float c0 = bf2f(pr[C_DCKV + lane]), c1 = bf2f(pr[C_DCKV + 64 + lane]);
                        const float rk = rsqrtf(wave_sum(c0 * c0 + c1 * c1) * (1.f / 128.f) + EPS);
                        xkv[lane * 16 + tok] = c0 * rk * args.in[19][l * 128 + lane]; xkv[(lane + 64) * 16 + tok] = c1 * rk * args.in[19][l * 128 + 64 + lane]; }
                    __syncthreads();
                    for (int cidx = tid; cidx < 896; cidx += NTHR) {
                        const bool isq = cidx < 384; const int col = isq ? cidx : cidx - 384, KK = isq ? 192 : 128, NN = isq ? 384 : 512;
                        const float* W = isq ? args.in[20] + (size_t)l * 192 * 384 : args.in[21] + (size_t)l * 128 * 512; const LAS float* x = isq ? xq : xkv;
                        float a16[16];
#pragma unroll
                        for (int i = 0; i < 16; ++i) a16[i] = 0.f;
                        for (int kk = 0; kk < KK; ++kk) { const float w = W[(size_t)kk * NN + col]; const LAS f32x4* xp = (const LAS f32x4*)(x + kk * 16);
#pragma unroll
                            for (int i = 0; i < 4; ++i) { const f32x4 xx = xp[i]; a16[4 * i] += w * xx[0]; a16[4 * i + 1] += w * xx[1]; a16[4 * i + 2] += w * xx[2]; a16[4 * i + 3] += w * xx[3]; } }
#pragma unroll
                        for (int i = 0; i < 16; ++i) outb[i * 896 + cidx] = a16[i];
                    }
                    __syncthreads();
                    const float SCQ = 0.10206207261596575f;
                    for (int e = tid; e < 16 * 384; e += NTHR) { const int tok = e / 384, c = e % 384, h = c / 96, d = c % 96; float val;
                        if (d < 64) val = outb[tok * 896 + c];
                        else { const int i = (d - 64) & 15; const float x1 = outb[tok * 896 + h * 96 + 64 + i], x2 = outb[tok * 896 + h * 96 + 80 + i]; const float2 cs = cs32[(row0 + tok) * 16 + i];
                            val = (d < 80) ? x1 * cs.x - x2 * cs.y : x2 * cs.x + x1 * cs.y; }
                        MQ[(row0 + tok) * 384 + c] = f2bf(val * SCQ); }
                    for (int e = tid; e < 16 * 512; e += NTHR) { const int tok = e >> 9, c = e & 511, h = c >> 7, d = c & 127; const bf16_t v = f2bf(outb[tok * 896 + 384 + c]);
                        if (d < 64) MKN[(row0 + tok) * 256 + h * 64 + d] = v; else MV[(row0 + tok) * 256 + h * 64 + d - 64] = v; }
                    { const int tok = tid >> 5, d = tid & 31, i = d & 15; const bf16_t* pr = PB + (row0 + tok) * NIN + C_DKR; const float x1 = bf2f(pr[i]), x2 = bf2f(pr[16 + i]); const float2 cs = cs32[(row0 + tok) * 16 + i];
                      MKR[(row0 + tok) * 32 + d] = f2bf(d < 16 ? x1 * cs.x - x2 * cs.y : x2 * cs.x + x1 * cs.y); }
                    __syncthreads();
                    continue;
                }
                r -= N_J3;
                if (r < N_J4) {
                    const size_t row0 = (size_t)r * 64;
                    for (int e = tid; e < 64 * 192; e += NTHR) { const int tok = e / 192, p = e % 192, i = p & 31; const int base = p < 128 ? C_BQ + (p >> 5) * 64 : (p < 160 ? C_KS : C_KW); const float sc = p < 128 ? 0.125f : 1.f;
                        bf16_t* pr = PB + (row0 + tok) * NIN + base; const float x1 = bf2f(pr[i]), x2 = bf2f(pr[32 + i]); const float2 cs = cs64[(row0 + tok) * 32 + i];
                        pr[i] = f2bf((x1 * cs.x - x2 * cs.y) * sc); pr[32 + i] = f2bf((x2 * cs.x + x1 * cs.y) * sc); }
                    continue;
                }
                r -= N_J4;
                {
                    const int j = r & 1, nb = (r >> 1) & 63, b = r >> 7; const int colb = j == 0 ? C_KC : C_VC;
                    LAS float* T = ldsf; LAS float* hid = ldsf + 144 * 64;
                    for (int e = tid; e < 144 * 64; e += NTHR) { const int rr = e >> 6, d = e & 63, t = 128 * nb + rr; float v = 0.f;
                        if (t < SEQ) { const bf16_t* pr = PB + ((size_t)b * SEQ + t) * NIN + colb;
                            if (j == 0) { const int i = d & 31; const float x1 = bf2f(pr[i]), x2 = bf2f(pr[32 + i]); const float2 cs = cs64[((size_t)b * SEQ + t) * 32 + i]; v = d < 32 ? x1 * cs.x - x2 * cs.y : x2 * cs.x + x1 * cs.y; }
                            else v = bf2f(pr[d]); }
                        T[e] = v; }
                    __syncthreads();
                    { const int c = tid & 255, half = tid >> 8; const float* w1 = args.in[12] + (size_t)(l * 2 + j) * 2048 * 256 + c;
                      const float hb0 = hb[(l * 2 + j) * 256 + c]; float a0 = hb0, a1 = hb0, a2 = hb0, a3 = hb0;
                      const LAS float* Tb = T + (16 * half * 4) * 64;
                      for (int i = 0; i < 2048; ++i) { const float w = w1[(size_t)i * 256]; a0 += Tb[i] * w; a1 += Tb[i + 1024] * w; a2 += Tb[i + 2048] * w; a3 += Tb[i + 3072] * w; }
                      hid[(half * 4 + 0) * 256 + c] = gelu_tanh(a0); hid[(half * 4 + 1) * 256 + c] = gelu_tanh(a1); hid[(half * 4 + 2) * 256 + c] = gelu_tanh(a2); hid[(half * 4 + 3) * 256 + c] = gelu_tanh(a3); }
                    __syncthreads();
                    { const int nl = tid >> 6, dd = tid & 63, n = 8 * nb + nl; const float* w2 = args.in[14] + (size_t)(l * 2 + j) * 256 * 64 + dd; float o = 0.f;
                      for (int c = 0; c < 256; ++c) o += hid[nl * 256 + c] * w2[c * 64];
                      if (n < 511) (j == 0 ? KCMP : VCMP)[((size_t)b * 512 + n) * 64 + dd] = o; }
                    __syncthreads();
                }
            }
        }
        SEAM(pb + 1);
        if (IN(pb + 2)) {
        LAUNDER_TID();
            constexpr int Q_J5 = 2, Q_J6 = 64, Q_NSA = 512, Q_MLA = 2048, Q_TOT = Q_J5 + Q_J6 + Q_NSA + Q_MLA;
            for (;;) {
                if (tid == 0) LCTL[2] = __hip_atomic_fetch_add(ctl + CW_QUEUE + 64 * l, 1u, __ATOMIC_RELAXED, __HIP_MEMORY_SCOPE_AGENT);
                __syncthreads();
                int r = __builtin_amdgcn_readfirstlane((int)LCTL[2]);
                __syncthreads();
                if (r >= Q_TOT) break;
                if (r < Q_J5) {
                    const int e = r * NTHR + tid, b = e >> 8, ch = e & 255; float carry = 0.f;
                    for (int c0 = 0; c0 < 512; c0 += 8) { float av[8], hv[8];
#pragma unroll
                        for (int q = 0; q < 8; ++q) { const size_t so = ((size_t)(b * 512 + c0 + q)) * 256 + ch; av[q] = LA[so]; hv[q] = LH[so]; }
#pragma unroll
                        for (int q = 0; q < 8; ++q) { CIN[((size_t)(b * 512 + c0 + q)) * 256 + ch] = carry; carry = av[q] * carry + hv[q]; } }
                    continue;
                }
                r -= Q_J5;
                if (r < Q_J6) {
                    const int e = r * NTHR + tid, b = e >> 13, rem = e & 8191; float Sv = 0.f;
                    for (int c0 = 0; c0 < 128; c0 += 8) { float kv[8], dv[8];
#pragma unroll
                        for (int q = 0; q < 8; ++q) { kv[q] = KVC[(size_t)(b * 128 + c0 + q) * 8192 + rem]; dv[q] = DEC[(size_t)(b * 128 + c0 + q) * 128 + (rem >> 6)]; }
#pragma unroll
                        for (int q = 0; q < 8; ++q) { SST[(size_t)(b * 128 + c0 + q) * 8192 + rem] = Sv; Sv = dv[q] * Sv + kv[q]; } }
                    continue;
                }
                r -= Q_J6;
                if (r < Q_NSA) {
                    const int b = r >> 7, tb = r & 127;
                    LAS float* qf = ldsf + wave * 2560; LAS float* pc = qf + 256; LAS float* ps = pc + 2048;
                    const LAS f32x4* qf4 = (const LAS f32x4*)qf; const LAS f32x4* pc4 = (const LAS f32x4*)pc; const LAS f32x4* ps4 = (const LAS f32x4*)ps;
                    for (int i = 0; i < 8; ++i) {
                        const int t = 64 * tb + 8 * wave + i; const size_t row = (size_t)b * SEQ + t; const bf16_t* prow = PB + row * NIN;
#pragma unroll
                        for (int h = 0; h < 4; ++h) qf[h * 64 + lane] = bf2f(prow[C_BQ + h * 64 + lane]);
                        WSYNC();
                        const int nv = t >= 31 ? ((t - 31) >> 4) + 1 : 0;
                        float sc[8][4];
#pragma unroll
                        for (int rr = 0; rr < 8; ++rr) {
                            float d0 = 0.f, d1 = 0.f, d2 = 0.f, d3 = 0.f; const int n = lane + 64 * rr;
                            if (64 * rr < nv) { const int nc = n < 510 ? n : 510; const f32x4* kr = (const f32x4*)(KCMP + ((size_t)b * 512 + nc) * 64);
#pragma unroll 4
                                for (int d4 = 0; d4 < 16; ++d4) { const f32x4 kk = kr[d4]; const f32x4 q0 = qf4[d4], q1 = qf4[16 + d4], q2 = qf4[32 + d4], q3 = qf4[48 + d4];
                                    d0 += q0[0] * kk[0] + q0[1] * kk[1] + q0[2] * kk[2] + q0[3] * kk[3]; d1 += q1[0] * kk[0] + q1[1] * kk[1] + q1[2] * kk[2] + q1[3] * kk[3];
                                    d2 += q2[0] * kk[0] + q2[1] * kk[1] + q2[2] * kk[2] + q2[3] * kk[3]; d3 += q3[0] * kk[0] + q3[1] * kk[1] + q3[2] * kk[2] + q3[3] * kk[3]; } }
                            const bool valid = n < nv;
                            sc[rr][0] = valid ? d0 : -1e30f; sc[rr][1] = valid ? d1 : -1e30f; sc[rr][2] = valid ? d2 : -1e30f; sc[rr][3] = valid ? d3 : -1e30f;
                        }
#pragma unroll
                        for (int h = 0; h < 4; ++h) {
                            float mx = sc[0][h];
#pragma unroll
                            for (int rr = 1; rr < 8; ++rr) mx = fmaxf(mx, sc[rr][h]);
                            mx = wave_max(mx); float sum = 0.f;
#pragma unroll
                            for (int rr = 0; rr < 8; ++rr) { const float p = (lane + 64 * rr < nv) ? __expf(sc[rr][h] - mx) : 0.f; sc[rr][h] = p; sum += p; }
                            sum = wave_sum(sum); const float inv = 1.f / fmaxf(sum, 1e-30f);
#pragma unroll
                            for (int rr = 0; rr < 8; ++rr) pc[(lane + 64 * rr) * 4 + h] = sc[rr][h] * inv;
                        }
                        WSYNC();
                        float oc0 = 0.f, oc1 = 0.f, oc2 = 0.f, oc3 = 0.f;
                        for (int n = 0; n < nv; ++n) { const f32x4 pp = pc4[n]; const float v = VCMP[((size_t)b * 512 + n) * 64 + lane]; oc0 += pp[0] * v; oc1 += pp[1] * v; oc2 += pp[2] * v; oc3 += pp[3] * v; }
                        const int cur = t >> 6; float s0, s1;
                        { float im0 = 0.f, im1 = 0.f;
#pragma unroll
                          for (int q = -1; q < 4; ++q) { const int n0 = 4 * lane + q, n1 = 4 * (lane + 64) + q;
                              if (n0 >= 0) { const f32x4 pp = pc4[n0]; im0 += pp[0] + pp[1] + pp[2] + pp[3]; }
                              { const f32x4 pp = pc4[n1]; im1 += pp[0] + pp[1] + pp[2] + pp[3]; } }
                          const int j0 = lane, j1 = lane + 64;
                          s0 = (j0 == 0 || j0 == cur || j0 == cur - 1) ? 1e9f : (j0 <= cur ? im0 : -1e30f);
                          s1 = (j1 == cur || j1 == cur - 1) ? 1e9f : (j1 <= cur ? im1 : -1e30f); }
                        bool sel0 = false, sel1 = false;
                        for (int k = 0; k < 16; ++k) {
                            const float mx = wave_max(fmaxf(s0, s1));
                            const int cand = (s0 == mx) ? lane : ((s1 == mx) ? lane + 64 : (1 << 20));
                            const int win = wave_min_i(cand);
                            if (win == lane) { sel0 = true; s0 = -3e38f; } if (win == lane + 64) { sel1 = true; s1 = -3e38f; }
                        }
                        const unsigned long long m0 = __ballot(sel0), m1 = __ballot(sel1);
                        float mS[4], lS[4], oS[4], mW[4], lW[4], oW[4];
#pragma unroll
                        for (int h = 0; h < 4; ++h) { mS[h] = -1e30f; lS[h] = 0.f; oS[h] = 0.f; mW[h] = -1e30f; lW[h] = 0.f; oW[h] = 0.f; }
#define NSA_BLOCK(KCOL, VCOL, key0, lov, mm, ll, oo) do { \
                        const int kpos_ = (key0) + lane; const bool valid_ = kpos_ >= (lov) && kpos_ <= t; \
                        const u32x4* kr_ = (const u32x4*)(PB + ((size_t)b * SEQ + kpos_) * NIN + (KCOL)); \
                        float d_[4] = {0.f, 0.f, 0.f, 0.f}; \
                        _Pragma("unroll 2") for (int c8 = 0; c8 < 8; ++c8) { const u32x4 kk = kr_[c8]; float kf[8] = {bflo(kk.x), bfhi(kk.x), bflo(kk.y), bfhi(kk.y), bflo(kk.z), bfhi(kk.z), bflo(kk.w), bfhi(kk.w)}; \
                            _Pragma("unroll") for (int h = 0; h < 4; ++h) { const f32x4 qa = qf4[h * 16 + 2 * c8], qb = qf4[h * 16 + 2 * c8 + 1]; \
                                d_[h] += qa[0] * kf[0] + qa[1] * kf[1] + qa[2] * kf[2] + qa[3] * kf[3] + qb[0] * kf[4] + qb[1] * kf[5] + qb[2] * kf[6] + qb[3] * kf[7]; } } \
                        _Pragma("unroll") for (int h = 0; h < 4; ++h) { const float s_ = valid_ ? d_[h] : -1e30f; const float mn_ = fmaxf(mm[h], wave_max(s_)); const float al_ = __expf(mm[h] - mn_); \
                            const float p_ = valid_ ? __expf(s_ - mn_) : 0.f; ll[h] = ll[h] * al_ + wave_sum(p_); oo[h] *= al_; mm[h] = mn_; ps[lane * 4 + h] = p_; } \
                        WSYNC(); \
                        { const bf16_t* vr_ = PB + ((size_t)b * SEQ + (key0)) * NIN + (VCOL) + lane; \
                          _Pragma("unroll 4") for (int kk = 0; kk < 64; ++kk) { const f32x4 pp = ps4[kk]; const float v = bf2f(vr_[(size_t)kk * NIN]); oo[0] += pp[0] * v; oo[1] += pp[1] * v; oo[2] += pp[2] * v; oo[3] += pp[3] * v; } } \
                        WSYNC(); } while (0)
                        for (int j = 0; j <= cur; ++j) {
                            const bool s = j < 64 ? ((m0 >> j) & 1ull) : ((m1 >> (j - 64)) & 1ull);
                            if (!s) continue;
                            NSA_BLOCK(C_KS, C_VS, 64 * j, 0, mS, lS, oS);
                        }
                        { const int wlo = t - 511 > 0 ? t - 511 : 0;
                          for (int j = wlo >> 6; j <= cur; ++j) NSA_BLOCK(C_KW, C_VW, 64 * j, wlo, mW, lW, oW); }
#undef NSA_BLOCK
                        float o[4]; const float occ[4] = {oc0, oc1, oc2, oc3}; float ss = 0.f;
#pragma unroll
                        for (int h = 0; h < 4; ++h) { const float g0 = sigmoidf_(bf2f(prow[C_BG + h * 3])), g1 = sigmoidf_(bf2f(prow[C_BG + h * 3 + 1])), g2 = sigmoidf_(bf2f(prow[C_BG + h * 3 + 2]));
                            o[h] = g0 * occ[h] + g1 * oS[h] / fmaxf(lS[h], 1e-30f) + g2 * oW[h] / fmaxf(lW[h], 1e-30f); ss += o[h] * o[h]; }
                        const float rinv = rsqrtf(wave_sum(ss) * (1.f / 256.f) + EPS);
#pragma unroll
                        for (int h = 0; h < 4; ++h) Y[row * DM + 256 + h * 64 + lane] = f2bf(o[h] * rinv);
                        WSYNC();
                    }
                    __syncthreads();
                    continue;
                }
                r -= Q_NSA;
                {
                    const int qb = 127 - (r >> 4), bh = r & 15, b = bh >> 2, h = bh & 3;
                    const int t = 64 * qb + lane; const size_t row = (size_t)b * SEQ + t; const int ks = wave & 3, dh = wave >> 2;
                    float q[96], o[32];
                    { const u32x4* qp = (const u32x4*)(MQ + row * 384 + h * 96);
#pragma unroll
                      for (int c = 0; c < 12; ++c) { const u32x4 w = qp[c]; q[8 * c] = bflo(w.x); q[8 * c + 1] = bfhi(w.x); q[8 * c + 2] = bflo(w.y); q[8 * c + 3] = bfhi(w.y); q[8 * c + 4] = bflo(w.z); q[8 * c + 5] = bfhi(w.z); q[8 * c + 6] = bflo(w.w); q[8 * c + 7] = bfhi(w.w); } }
#pragma unroll
                    for (int d = 0; d < 32; ++d) o[d] = 0.f;
                    float mrun = -1e30f, lsum = 0.f;
                    for (int j = ks; j <= qb; j += 4) {
#pragma unroll 1
                        for (int kk = 0; kk < 64; ++kk) {
                            const size_t krow = (size_t)b * SEQ + 64 * j + kk;
                            const u32x4* kn = (const u32x4*)(MKN + krow * 256 + h * 64); const u32x4* kr = (const u32x4*)(MKR + krow * 32);
                            float dot = 0.f;
#pragma unroll
                            for (int i = 0; i < 8; ++i) { const u32x4 w = kn[i]; dot += q[8 * i] * bflo(w.x) + q[8 * i + 1] * bfhi(w.x) + q[8 * i + 2] * bflo(w.y) + q[8 * i + 3] * bfhi(w.y) + q[8 * i + 4] * bflo(w.z) + q[8 * i + 5] * bfhi(w.z) + q[8 * i + 6] * bflo(w.w) + q[8 * i + 7] * bfhi(w.w); }
#pragma unroll
                            for (int i = 0; i < 4; ++i) { const u32x4 w = kr[i]; dot += q[64 + 8 * i] * bflo(w.x) + q[65 + 8 * i] * bfhi(w.x) + q[66 + 8 * i] * bflo(w.y) + q[67 + 8 * i] * bfhi(w.y) + q[68 + 8 * i] * bflo(w.z) + q[69 + 8 * i] * bfhi(w.z) + q[70 + 8 * i] * bflo(w.w) + q[71 + 8 * i] * bfhi(w.w); }
                            const bool valid = (j < qb) || (kk <= lane);
                            const float s = valid ? dot : -1e30f;
                            const float mb = fmaxf(mrun, s), alpha = __expf(mrun - mb), p = valid ? __expf(s - mb) : 0.f;
                            lsum = lsum * alpha + p; mrun = mb;
                            const u32x4* vr = (const u32x4*)(MV + krow * 256 + h * 64 + dh * 32);
#pragma unroll
                            for (int i = 0; i < 4; ++i) { const u32x4 w = vr[i];
                                o[8 * i] = o[8 * i] * alpha + p * bflo(w.x); o[8 * i + 1] = o[8 * i + 1] * alpha + p * bfhi(w.x); o[8 * i + 2] = o[8 * i + 2] * alpha + p * bflo(w.y); o[8 * i + 3] = o[8 * i + 3] * alpha + p * bfhi(w.y);
                                o[8 * i + 4] = o[8 * i + 4] * alpha + p * bflo(w.z); o[8 * i + 5] = o[8 * i + 5] * alpha + p * bfhi(w.z); o[8 * i + 6] = o[8 * i + 6] * alpha + p * bflo(w.w); o[8 * i + 7] = o[8 * i + 7] * alpha + p * bfhi(w.w); }
                        }
                    }
                    LAS float* obuf = ldsf; LAS float* mbuf = ldsf + 16384; LAS float* lbuf = mbuf + 256;
#pragma unroll
                    for (int d4 = 0; d4 < 8; ++d4) *(LAS f32x4*)(obuf + (ks * 64 + lane) * 64 + dh * 32 + 4 * d4) = (f32x4){o[4 * d4], o[4 * d4 + 1], o[4 * d4 + 2], o[4 * d4 + 3]};
                    if (dh == 0) { mbuf[ks * 64 + lane] = mrun; lbuf[ks * 64 + lane] = lsum; }
                    __syncthreads();
                    { const int part = tid & 7, qi = tid >> 3; float Mx = -1e30f;
#pragma unroll
                      for (int w = 0; w < 4; ++w) Mx = fmaxf(Mx, mbuf[w * 64 + qi]);
                      float L = 0.f, acc8[8] = {0.f, 0.f, 0.f, 0.f, 0.f, 0.f, 0.f, 0.f};
#pragma unroll
                      for (int w = 0; w < 4; ++w) { const float e = __expf(mbuf[w * 64 + qi] - Mx); L += e * lbuf[w * 64 + qi];
                          const f32x4 a = *(const LAS f32x4*)(obuf + (w * 64 + qi) * 64 + 8 * part), c = *(const LAS f32x4*)(obuf + (w * 64 + qi) * 64 + 8 * part + 4);
                          acc8[0] += e * a[0]; acc8[1] += e * a[1]; acc8[2] += e * a[2]; acc8[3] += e * a[3]; acc8[4] += e * c[0]; acc8[5] += e * c[1]; acc8[6] += e * c[2]; acc8[7] += e * c[3]; }
                      const float inv = 1.f / fmaxf(L, 1e-30f); float pp = 0.f;
#pragma unroll
                      for (int i = 0; i < 8; ++i) { acc8[i] *= inv; pp += acc8[i] * acc8[i]; }
                      const size_t orow = (size_t)b * SEQ + 64 * qb + qi;
                      u32x4 w; w.x = pk2(acc8[0], acc8[1]); w.y = pk2(acc8[2], acc8[3]); w.z = pk2(acc8[4], acc8[5]); w.w = pk2(acc8[6], acc8[7]);
                      *(u32x4*)(Y + orow * DM + 768 + h * 64 + 8 * part) = w;
                      pp += __shfl_xor(pp, 1); pp += __shfl_xor(pp, 2); pp += __shfl_xor(pp, 4);
                      if (part == 0) atomicAdd(ssq_d + orow, pp); }
                    __syncthreads();
                }
            }
        }
        SEAM(pb + 2);
        if (IN(pb + 3)) {
        LAUNDER_TID();
            constexpr int N_J9 = 1024, N_J10 = 512, N_J11 = 256, N_P4 = N_J9 + N_J10 + N_J11;
            for (int it = bid; it < N_P4; it += G) {
                int r = it;
                if (r < N_J9) {
                    const int b = r >> 8, tb = r & 255, t0 = tb * 32, ch = tid & 255, half = tid >> 8;
                    LAS float* xa = ldsf; LAS float* xc = ldsf + 35 * 256;
                    for (int e = tid; e < 35 * 256; e += NTHR) { const int rr = e >> 8, c = e & 255, t = t0 - 3 + rr; float v = 0.f; if (t >= 0) v = bf2f(PB[(size_t)(b * SEQ + t) * NIN + C_AX + c]); xa[e] = v; }
                    __syncthreads();
                    { const float cw0 = args.in[4][(l * 4 + 0) * 256 + ch], cw1 = args.in[4][(l * 4 + 1) * 256 + ch], cw2 = args.in[4][(l * 4 + 2) * 256 + ch], cw3 = args.in[4][(l * 4 + 3) * 256 + ch], cb = args.in[5][l * 256 + ch];
                      for (int tt = 0; tt < 16; ++tt) { const int rr = half * 16 + tt; xc[rr * 256 + ch] = cb + cw0 * xa[rr * 256 + ch] + cw1 * xa[(rr + 1) * 256 + ch] + cw2 * xa[(rr + 2) * 256 + ch] + cw3 * xa[(rr + 3) * 256 + ch]; } }
                    __syncthreads();
                    const int h = ch >> 6, cc = ch & 63;
                    LAS float* gR = ldsf + 67 * 256; LAS float* gI = gR + 32 * 256;
#pragma unroll 1
                    for (int pass = 0; pass < 2; ++pass) {
                        float wv[64]; const float* wsrc = (pass == 0 ? args.in[6] : args.in[8]) + ((size_t)(l * 4 + h) * 64) * 64 + cc; const float bias = (pass == 0 ? args.in[7] : args.in[9])[l * 256 + ch];
#pragma unroll
                        for (int i = 0; i < 64; ++i) wv[i] = wsrc[i * 64];
#pragma unroll 1
                        for (int tt = 0; tt < 16; ++tt) { const LAS f32x4* xr = (const LAS f32x4*)(xc + (half * 16 + tt) * 256 + h * 64); float a = bias;
#pragma unroll
                            for (int i4 = 0; i4 < 16; ++i4) { const f32x4 x = xr[i4]; a += x[0] * wv[4 * i4] + x[1] * wv[4 * i4 + 1] + x[2] * wv[4 * i4 + 2] + x[3] * wv[4 * i4 + 3]; }
                            (pass == 0 ? gR : gI)[(half * 16 + tt) * 256 + ch] = sigmoidf_(a); }
                    }
                    const float sp = log1pf(expf(-args.in[10][l * 256 + ch]));
                    float hst = CIN[((size_t)(b * 512 + tb * 2 + half)) * 256 + ch];
#pragma unroll 1
                    for (int tt = 0; tt < 16; ++tt) {
                        const int rr = half * 16 + tt;
                        const float rg = gR[rr * 256 + ch], ig = gI[rr * 256 + ch], la = -8.f * rg * sp, av = expf(la), mult = sqrtf(-expm1f(2.f * la));
                        const float u = mult * (ig * xc[rr * 256 + ch]);
                        hst = av * hst + u;
                        const float gate = bf2f(PB[((size_t)b * SEQ + t0 + rr) * NIN + C_AG + ch]);
                        xa[rr * 256 + ch] = hst * gelu_tanh(gate);
                    }
                    __syncthreads();
                    for (int q = 0; q < 4; ++q) { const int rr = wave * 4 + q; const f32x4 v = ((const LAS f32x4*)(xa + rr * 256))[lane];
                        const float rinv = rsqrtf(wave_sum(v[0] * v[0] + v[1] * v[1] + v[2] * v[2] + v[3] * v[3]) * (1.f / 256.f) + EPS);
                        u32x2 w; w.x = pk2(v[0] * rinv, v[1] * rinv); w.y = pk2(v[2] * rinv, v[3] * rinv);
                        *(u32x2*)(Y + ((size_t)b * SEQ + t0 + rr) * DM + 4 * lane) = w; }
                    __syncthreads();
                    continue;
                }
                r -= N_J9;
                if (r < N_J10) {
                    const int b = r >> 7, c = r & 127; const size_t row0 = (size_t)b * SEQ + 64 * c;
                    LAS float* glr = ldsf; LAS float* bh = ldsf + 1024; LAS float* qh = bh + 2048; LAS float* kh = qh + 2048; LAS float* vh = kh + 2048; LAS float* Ah = vh + 4096; LAS float* Sh = Ah + 4096; LAS float* oall = Sh + 2048;
                    for (int e = tid; e < 1024; e += NTHR) glr[e] = bf2f(PB[(row0 + (e >> 4)) * NIN + C_GLR + (e & 15)]);
                    __syncthreads();
                    for (int h = 0; h < 4; ++h) {
                        for (int e = tid; e < 2048; e += NTHR) { const int t = e >> 5, k = e & 31, kk = h * 32 + k; float z = args.in[16][l * 128 + kk];
#pragma unroll
                            for (int q = 0; q < 16; ++q) z += glr[t * 16 + q] * args.in[15][(l * 16 + q) * 128 + kk];
                            bh[e] = (fminf(z, 0.f) - log1pf(expf(-fabsf(z)))) * (1.f / 16.f);
                            qh[e] = bf2f(PB[(row0 + t) * NIN + C_CQ + kk]) * 0.17677669529663687f; kh[e] = bf2f(PB[(row0 + t) * NIN + C_CK + kk]); }
                        for (int e = tid; e < 4096; e += NTHR) vh[e] = bf2f(PB[(row0 + (e >> 6)) * NIN + C_CV + h * 64 + (e & 63)]);
                        for (int e = tid; e < 2048; e += NTHR) Sh[e] = SST[((size_t)(b * 128 + c) * 4 + h) * 2048 + e];
                        __syncthreads();
                        if (tid < 32) { float run = 0.f; for (int t = 0; t < 64; ++t) { run += bh[t * 32 + tid]; bh[t * 32 + tid] = run; } }
                        __syncthreads();
                        for (int e = tid; e < 4096; e += NTHR) { const int i = e >> 6, j = e & 63; float a = 0.f;
                            if (j <= i) {
#pragma unroll 8
                                for (int k = 0; k < 32; ++k) a += qh[i * 32 + k] * kh[j * 32 + k] * __expf(bh[i * 32 + k] - bh[j * 32 + k]); }
                            Ah[e] = a; }
                        __syncthreads();
                        for (int e = tid; e < 2048; e += NTHR) qh[e] *= __expf(bh[e]);
                        __syncthreads();
                        { const int i = tid >> 3, v0 = (tid & 7) * 8; float a8[8] = {0.f, 0.f, 0.f, 0.f, 0.f, 0.f, 0.f, 0.f};
                          for (int k = 0; k < 32; ++k) { const float qe = qh[i * 32 + k]; const LAS f32x4* sp4 = (const LAS f32x4*)(Sh + k * 64 + v0); const f32x4 s0 = sp4[0], s1 = sp4[1];
                              a8[0] += qe * s0[0]; a8[1] += qe * s0[1]; a8[2] += qe * s0[2]; a8[3] += qe * s0[3]; a8[4] += qe * s1[0]; a8[5] += qe * s1[1]; a8[6] += qe * s1[2]; a8[7] += qe * s1[3]; }
                          for (int j = 0; j <= i; ++j) { const float aa = Ah[i * 64 + j]; const LAS f32x4* vp4 = (const LAS f32x4*)(vh + j * 64 + v0); const f32x4 s0 = vp4[0], s1 = vp4[1];
                              a8[0] += aa * s0[0]; a8[1] += aa * s0[1]; a8[2] += aa * s0[2]; a8[3] += aa * s0[3]; a8[4] += aa * s1[0]; a8[5] += aa * s1[1]; a8[6] += aa * s1[2]; a8[7] += aa * s1[3]; }
#pragma unroll
                          for (int q = 0; q < 8; ++q) oall[i * 256 + h * 64 + v0 + q] = a8[q]; }
                        __syncthreads();
                    }
                    for (int q = 0; q < 8; ++q) { const int t = wave * 8 + q; const f32x4 v = ((const LAS f32x4*)(oall + t * 256))[lane];
                        float ssh = v[0] * v[0] + v[1] * v[1] + v[2] * v[2] + v[3] * v[3];
                        ssh += __shfl_xor(ssh, 1); ssh += __shfl_xor(ssh, 2); ssh += __shfl_xor(ssh, 4); ssh += __shfl_xor(ssh, 8);
                        const float rh = rsqrtf(ssh * (1.f / 64.f) + EPS); float y[4]; float ss = 0.f;
                        const bf16_t* og = PB + (row0 + t) * NIN + C_OG + 4 * lane;
#pragma unroll
                        for (int i = 0; i < 4; ++i) { const float g = bf2f(og[i]); y[i] = v[i] * rh * args.in[17][l * 64 + ((4 * lane + i) & 63)] * (g / (1.f + __expf(-g))); ss += y[i] * y[i]; }
                        const float rinv = rsqrtf(wave_sum(ss) * (1.f / 256.f) + EPS);
                        u32x2 w; w.x = pk2(y[0] * rinv, y[1] * rinv); w.y = pk2(y[2] * rinv, y[3] * rinv);
                        *(u32x2*)(Y + (row0 + t) * DM + 512 + 4 * lane) = w; }
                    __syncthreads();
                    continue;
                }
                r -= N_J10;
                {
                    for (int e = tid; e < 128 * 32; e += NTHR) { const size_t row = (size_t)r * 128 + (e >> 5); const int c8 = e & 31;
                        const float rinv = rsqrtf(ssq_d[row] * (1.f / 256.f) + EPS);
                        u32x4* p = (u32x4*)(Y + row * DM + 768 + 8 * c8); u32x4 w = *p;
                        w.x = pk2(bflo(w.x) * rinv, bfhi(w.x) * rinv); w.y = pk2(bflo(w.y) * rinv, bfhi(w.y) * rinv); w.z = pk2(bflo(w.z) * rinv, bfhi(w.z) * rinv); w.w = pk2(bflo(w.w) * rinv, bfhi(w.w) * rinv);
                        *p = w; }
                }
            }
        }
        SEAM(pb + 3);
        if (IN(pb + 4)) {
            pg8::Gemm g{Y, (const bf16_t*)(ws + WS_WOUT) + (size_t)l * DM * DM, M, DM, DM}; pg8::StaticOrder S; S.init(M, DM, G, bid);
            pg8::EpiResid E{l == 0 ? args.in[0] : (const float*)args.out, args.out, XB, ssq_out};
            pg8::gemm_phase<pg8::EpiResid, pg8::StaticOrder, true, true>(lds, g, S, E);
        }
        SEAM(pb + 4);
        if (IN(pb + 5)) {
            pg8::Gemm g{XB, (const bf16_t*)(ws + WS_WGU) + (size_t)l * NGU * DM, M, NGU, DM}; pg8::StaticOrder S; S.init(M, NGU, G, bid);
            pg8::EpiSwiglu E{ACT, ssq_out};
            pg8::gemm_phase<pg8::EpiSwiglu, pg8::StaticOrder, true, true>(lds, g, S, E);
        }
        SEAM(pb + 5);
        if (IN(pb + 6)) {
            pg8::Gemm g{ACT, (const bf16_t*)(ws + WS_WDN) + (size_t)l * DM * FF, M, DM, FF}; pg8::StaticOrder S; S.init(M, DM, G, bid);
            pg8::EpiResid E{(const float*)args.out, args.out, XB, ssq_down};
            pg8::gemm_phase<pg8::EpiResid, pg8::StaticOrder, true, true>(lds, g, S, E);
        }
        SEAM(pb + 6);
    }
    if (IN(15)) {
        LAUNDER_TID();
        const float* ssqf = acc_base + 3 * (size_t)M; const int gw = bid * 8 + wave, NGW = G * 8;
        for (int m = gw; m < M; m += NGW) {
            const float rinv = rsqrtf(ssqf[m] * (1.f / DM) + EPS);
            f32x4* xr = (f32x4*)(args.out + (size_t)m * DM) + lane; const f32x4* gn = (const f32x4*)args.in[27] + lane;
#pragma unroll
            for (int j = 0; j < 4; ++j) { f32x4 v = xr[64 * j]; const f32x4 g = gn[64 * j]; v = v * rinv * g; xr[64 * j] = v; }
        }
    }
#undef IN
#undef SEAM
}

extern "C" void kernel_launch(void* const* d_in, const int* in_sizes, int n_in, void* d_out, int out_size, void* d_ws, size_t ws_size, hipStream_t stream) {
    static int grid = 0;
    if (grid == 0) {
        if (n_in != 28 || in_sizes[0] != M * DM || out_size != M * DM || ws_size < WS_END) { fprintf(stderr, "kernel_launch: unexpected shapes (n_in %d, ws %zu)\n", n_in, ws_size); grid = -1; return; }
        int dev = 0, cus = 0;
        if (hipGetDevice(&dev) != hipSuccess || hipDeviceGetAttribute(&cus, hipDeviceAttributeMultiprocessorCount, dev) != hipSuccess) { grid = -1; return; }
        if (hipFuncSetAttribute((const void*)fwd, hipFuncAttributeMaxDynamicSharedMemorySize, LDS_BYTES) != hipSuccess) { fprintf(stderr, "kernel_launch: hipFuncSetAttribute failed\n"); grid = -1; return; }
        int per_cu = 0;
        if (hipOccupancyMaxActiveBlocksPerMultiprocessor(&per_cu, (const void*)fwd, NTHR, LDS_BYTES) != hipSuccess || per_cu < 1) fprintf(stderr, "kernel_launch: occupancy query says %d\n", per_cu);
        (void)hipGetLastError();
        grid = cus;
    }
    if (grid < 0) return;
    (void)hipMemsetAsync((char*)d_ws + WS_CTL, 0, CTL_ZERO_BYTES, stream);
    Args a{};
    for (int i = 0; i < 28; ++i) a.in[i] = (const float*)d_in[i];
    a.out = (float*)d_out; a.ws = (unsigned char*)d_ws;
    if (MK_N_LAUNCHES == 1) { a.ph_lo = 0; a.ph_hi = 16; hipLaunchKernelGGL(fwd, dim3(grid), dim3(NTHR), LDS_BYTES, stream, a); }
    else for (int p = 0; p < 16; ++p) { a.ph_lo = p; a.ph_hi = p + 1; hipLaunchKernelGGL(fwd, dim3(grid), dim3(NTHR), LDS_BYTES, stream, a); }
}
```

```cpp
#include <hip/hip_runtime.h>
#include <cstdio>
#include <cstdint>

#ifndef MK_N_LAUNCHES
#define MK_N_LAUNCHES 1
#endif

#define LAS __attribute__((address_space(3)))
#define DI __device__ __forceinline__
typedef unsigned short bf16_t;
typedef short bf16x8 __attribute__((ext_vector_type(8)));
typedef float f32x4 __attribute__((ext_vector_type(4)));
typedef unsigned u32x4 __attribute__((ext_vector_type(4)));
typedef unsigned u32x2 __attribute__((ext_vector_type(2)));

constexpr int NB = 4, SEQ = 8192, M = NB * SEQ, DM = 1024, NIN = 2304, NINS = 2300, FF = 2816, NGU = 2 * FF;
constexpr float EPS = 1e-6f;
constexpr int C_AX = 0, C_AG = 256, C_BQ = 512, C_KC = 768, C_VC = 832, C_KS = 896, C_VS = 960, C_KW = 1024, C_VW = 1088, C_BG = 1152,
              C_CQ = 1164, C_CK = 1292, C_CV = 1420, C_GLR = 1676, C_OG = 1692, C_DCQ = 1948, C_DCKV = 2140, C_DKR = 2268;
constexpr size_t MiB = 1u << 20;
constexpr size_t WS_CTL = 0, CTL_ZERO_BYTES = 1 * MiB;
constexpr size_t WS_ACC = 64 * 1024;
constexpr size_t WS_SSQ0 = 1 * MiB;
constexpr size_t WS_HB = 1 * MiB + 256 * 1024;
constexpr size_t WS_WIN = 2 * MiB, WS_WOUT = 11 * MiB, WS_WGU = 15 * MiB, WS_WDN = 37 * MiB;
constexpr size_t WS_CS64 = 64 * MiB, WS_CS32 = 72 * MiB;
constexpr size_t WS_XB = 80 * MiB, WS_Y = 144 * MiB, WS_PB = 208 * MiB, WS_ACT = 208 * MiB;
constexpr size_t WS_LA = 384 * MiB, WS_LH = 386 * MiB, WS_CIN = 388 * MiB;
constexpr size_t WS_KVC = 392 * MiB, WS_DEC = 408 * MiB, WS_SST = 410 * MiB;
constexpr size_t WS_MQ = 428 * MiB, WS_MKN = 452 * MiB, WS_MV = 468 * MiB, WS_MKR = 484 * MiB;
constexpr size_t WS_VST = 490 * MiB, WS_VWT = 494 * MiB, WS_KCMPB = 498 * MiB, WS_VCMPT = 499 * MiB, WS_END = 500 * MiB;
constexpr int CW_QUEUE = 64;
constexpr int CW_BAR = 4096;
constexpr int LDS_BYTES = 163840 - 256;
constexpr int LDS_CTL = LDS_BYTES - 64;
constexpr int NTHR = 512;

struct Args { const float* in[28]; float* out; unsigned char* ws; int ph_lo, ph_hi; };

DI float bf2f(bf16_t h) { return __uint_as_float(((unsigned)h) << 16); }
DI float bflo(unsigned u) { return __uint_as_float(u << 16); }
DI float bfhi(unsigned u) { return __uint_as_float(u & 0xffff0000u); }
DI bf16_t f2bf(float f) { unsigned u = __float_as_uint(f); return (bf16_t)((u + 0x7fffu + ((u >> 16) & 1u)) >> 16); }
DI unsigned pk2(float lo, float hi) { return (unsigned)f2bf(lo) | ((unsigned)f2bf(hi) << 16); }
DI float wave_sum(float v) {
#pragma unroll
    for (int o = 1; o < 64; o <<= 1) v += __shfl_xor(v, o);
    return v;
}
DI float wave_max(float v) {
#pragma unroll
    for (int o = 1; o < 64; o <<= 1) v = fmaxf(v, __shfl_xor(v, o));
    return v;
}
DI int wave_min_i(int v) {
#pragma unroll
    for (int o = 1; o < 64; o <<= 1) { int w = __shfl_xor(v, o); v = w < v ? w : v; }
    return v;
}
DI float sigmoidf_(float x) { return 1.f / (1.f + __expf(-x)); }
DI float gelu_tanh(float x) { const float u = 0.7978845608028654f * (x + 0.044715f * x * x * x); return 0.5f * x * (1.f + tanhf(u)); }
#define WSYNC() do { asm volatile("s_waitcnt lgkmcnt(0)" ::: "memory"); __builtin_amdgcn_wave_barrier(); } while (0)

namespace pg8 {
constexpr int BM = 256, BK = 64, HALF = 128, HTB = HALF * BK * 2, NXCD = 8, WGM = 8;
__host__ __device__ __forceinline__ int lds_byte(int r, int c) { const int st = (r >> 4) * 2 + (c >> 5), rr = r & 15, cc = c & 31, ob = rr * 64 + cc * 2; return st * 1024 + (ob ^ (((ob >> 9) & 1) << 5)); }
__host__ __device__ __forceinline__ void stage_rc(int b, int& R, int& C) { const int st = b / 1024, sb = b % 1024, swz = sb ^ (((sb >> 9) & 1) << 5); R = (st >> 1) * 16 + swz / 64; C = (st & 1) * 32 + (swz % 64) / 2; }
__host__ __device__ __forceinline__ int perm32(int rho) { const int n = rho >> 4, i = rho & 15; return 8 * (i >> 2) + 4 * n + (i & 3); }
struct Unit { int pm, pn; };
struct Gemm { const bf16_t* A; const bf16_t* Bt; int M, N, K; };
struct StaticOrder {
    int nM, nN, nwg, G, c;
    __host__ __device__ void init(int M_, int N_, int G_, int c_) { nM = M_ / BM; nN = N_ / BM; nwg = nM * nN; G = G_; c = c_; }
    __host__ __device__ bool next(int i, Unit& u) const {
        const long L = (long)i * G + c; if (L >= nwg) return false;
        int wgid = (int)L; { const int q = nwg / NXCD, r = nwg % NXCD, xcd = wgid % NXCD, off = wgid / NXCD; wgid = (xcd < r ? xcd * (q + 1) : r * (q + 1) + (xcd - r) * q) + off; }
        const int nig = WGM * nN, gid = wgid / nig, fm = gid * WGM, gsz = (nM - fm) < WGM ? (nM - fm) : WGM;
        u.pm = fm + ((wgid % nig) % gsz); u.pn = (wgid % nig) / gsz; return true;
    }
    __device__ __forceinline__ void a_ready(const Unit&) const {}
    __device__ __forceinline__ void done(const Unit&) const {}
};
DI unsigned cvt_pk_bf16(float lo, float hi) { unsigned r; asm volatile("v_cvt_pk_bf16_f32 %0, %1, %2" : "=v"(r) : "v"(lo), "v"(hi)); return r; }

struct EpiInProj {
    static constexpr bool PERM = true, AFTER_DRAIN = false;
    bf16_t* O; int ldc; const float* ssq;
    DI void operator()(const f32x4 (&acc)[2][2][4][2], const Unit& u, int wr, int wc, int fr, int fq) const {
        const int row0 = u.pm * BM + wr * 64 + fr, col0 = u.pn * BM + wc * 32 + 8 * fq;
#pragma unroll
        for (int ai = 0; ai < 2; ++ai)
#pragma unroll
            for (int m = 0; m < 4; ++m) {
                const int row = row0 + ai * HALF + m * 16;
                const float rinv = rsqrtf(ssq[row] * (1.f / DM) + EPS);
                bf16_t* rowp = O + (size_t)row * ldc + col0;
#pragma unroll
                for (int bj = 0; bj < 2; ++bj) {
                    f32x4 v0 = acc[ai][bj][m][0] * rinv, v1 = acc[ai][bj][m][1] * rinv;
                    u32x4 w; w.x = cvt_pk_bf16(v0[0], v0[1]); w.y = cvt_pk_bf16(v0[2], v0[3]); w.z = cvt_pk_bf16(v1[0], v1[1]); w.w = cvt_pk_bf16(v1[2], v1[3]);
                    *(u32x4*)(rowp + bj * HALF) = w;
                }
            }
    }
};
struct EpiResid {
    static constexpr bool PERM = true, AFTER_DRAIN = false;
    const float* xin; float* xout; bf16_t* xb; float* ssq_out;
    DI void operator()(const f32x4 (&acc)[2][2][4][2], const Unit& u, int wr, int wc, int fr, int fq) const {
        const int row0 = u.pm * BM + wr * 64 + fr, col0 = u.pn * BM + wc * 32 + 8 * fq;
#pragma unroll
        for (int ai = 0; ai < 2; ++ai)
#pragma unroll
            for (int m = 0; m < 4; ++m) {
                const int row = row0 + ai * HALF + m * 16;
                float part = 0.f;
#pragma unroll
                for (int bj = 0; bj < 2; ++bj) {
                    const size_t off = (size_t)row * DM + col0 + bj * HALF;
                    const f32x4 r0 = *(const f32x4*)(xin + off), r1 = *(const f32x4*)(xin + off + 4);
                    const f32x4 v0 = acc[ai][bj][m][0] + r0, v1 = acc[ai][bj][m][1] + r1;
                    *(f32x4*)(xout + off) = v0; *(f32x4*)(xout + off + 4) = v1;
                    u32x4 w; w.x = cvt_pk_bf16(v0[0], v0[1]); w.y = cvt_pk_bf16(v0[2], v0[3]); w.z = cvt_pk_bf16(v1[0], v1[1]); w.w = cvt_pk_bf16(v1[2], v1[3]);
                    *(u32x4*)(xb + off) = w;
                    part += v0[0] * v0[0] + v0[1] * v0[1] + v0[2] * v0[2] + v0[3] * v0[3] + v1[0] * v1[0] + v1[1] * v1[1] + v1[2] * v1[2] + v1[3] * v1[3];
                }
                part += __shfl_xor(part, 16); part += __shfl_xor(part, 32);
                if (fq == 0) atomicAdd(ssq_out + row, part);
            }
    }
};
struct EpiSwiglu {
    static constexpr bool PERM = true, AFTER_DRAIN = false;
    bf16_t* act; const float* ssq;
    DI void operator()(const f32x4 (&acc)[2][2][4][2], const Unit& u, int wr, int wc, int fr, int fq) const {
        const int row0 = u.pm * BM + wr * 64 + fr, j0 = u.pn * 128 + wc * 16 + 4 * fq;
#pragma unroll
        for (int ai = 0; ai < 2; ++ai)
#pragma unroll
            for (int m = 0; m < 4; ++m) {
                const int row = row0 + ai * HALF + m * 16;
                const float rinv = rsqrtf(ssq[row] * (1.f / DM) + EPS);
#pragma unroll
                for (int bj = 0; bj < 2; ++bj) {
                    const f32x4 g = acc[ai][bj][m][0] * rinv, up = acc[ai][bj][m][1] * rinv;
                    float a[4];
#pragma unroll
                    for (int i = 0; i < 4; ++i) a[i] = g[i] / (1.f + __expf(-g[i])) * up[i];
                    u32x2 w; w.x = cvt_pk_bf16(a[0], a[1]); w.y = cvt_pk_bf16(a[2], a[3]);
                    *(u32x2*)(act + (size_t)row * FF + j0 + bj * 64) = w;
                }
            }
    }
};

template <class Epi, class Sched, bool ALIGN_EPI = false, bool SP2 = false>
DI void gemm_phase(LAS unsigned char* lds, const Gemm g, const Sched& S, const Epi& E) {
    int tid_ = threadIdx.x; asm volatile("" : "+v"(tid_));
    const int tid = tid_, wid = __builtin_amdgcn_readfirstlane(tid >> 6), lane = tid & 63, wr = wid >> 2, wc = wid & 3, fr = lane & 15, fq = lane >> 4;
    const int K = g.K, nt = K / BK;
    unsigned voffA[2], voffB[2];
#pragma unroll
    for (int i = 0; i < 2; ++i) { int R, C; stage_rc(tid * 16 + i * 8192, R, C); const int Rb = Epi::PERM ? ((R & ~31) + perm32(R & 31)) : R;
        voffA[i] = (unsigned)(R * K + C) * 2u; voffB[i] = (unsigned)(Rb * K + C) * 2u; }
    const size_t kstep = (size_t)(BK * 2);
    const size_t hstep = (size_t)HALF * K * 2;
    const size_t tstep = 2 * hstep;
    const unsigned ldsw = (unsigned)wid * 1024u;
    const int aoff = lds_byte(wr * 64 + fr, fq * 8), boff = lds_byte(wc * 32 + fr, fq * 8);
#define PG8_SA(b, h) (((b) * 2 + (h)) * HTB)
#define PG8_SB(b, h) ((4 + (b) * 2 + (h)) * HTB)
#define PG8_STAGE(bufoff, gbase, voff) do { _Pragma("unroll") for (int _i = 0; _i < 2; ++_i) \
        __builtin_amdgcn_global_load_lds((const unsigned*)((const char*)(gbase) + (voff)[_i]), (LAS unsigned*)(lds + (bufoff) + ldsw + _i * 8192), 16, 0, 0); } while (0)
#define PG8_LDA(dst, b, h) do { _Pragma("unroll") for (int m = 0; m < 4; ++m) _Pragma("unroll") for (int k = 0; k < 2; ++k) dst[m][k] = *(const LAS bf16x8*)(lds + PG8_SA(b, h) + aoff + m * 2048 + k * 1024); } while (0)
#define PG8_LDB(dst, b, h) do { _Pragma("unroll") for (int n = 0; n < 2; ++n) _Pragma("unroll") for (int k = 0; k < 2; ++k) dst[n][k] = *(const LAS bf16x8*)(lds + PG8_SB(b, h) + boff + n * 2048 + k * 1024); } while (0)
#define PG8_MMA(ai, bj, At, Bt) do { __builtin_amdgcn_s_setprio(1); _Pragma("unroll") for (int m = 0; m < 4; ++m) _Pragma("unroll") for (int n = 0; n < 2; ++n) _Pragma("unroll") for (int k = 0; k < 2; ++k) \
        acc[ai][bj][m][n] = __builtin_amdgcn_mfma_f32_16x16x32_bf16(Bt[n][k], At[m][k], acc[ai][bj][m][n], 0, 0, 0); __builtin_amdgcn_s_setprio(0); } while (0)
#define PG8_WAIT_V(n) asm volatile("s_waitcnt vmcnt(" #n ")" ::: "memory")
#define PG8_WAIT_L(n) asm volatile("s_waitcnt lgkmcnt(" #n ")" ::: "memory")
#define PG8_BAR __builtin_amdgcn_s_barrier()
#define PG8_SCHED __builtin_amdgcn_sched_barrier(0)
    Unit cur, nxt; int ui = 0;
    if (!S.next(0, cur)) return;
    f32x4 acc[2][2][4][2];
#pragma unroll
    for (int a = 0; a < 2; ++a)
#pragma unroll
        for (int b = 0; b < 2; ++b)
#pragma unroll
            for (int m = 0; m < 4; ++m)
#pragma unroll
                for (int n = 0; n < 2; ++n) acc[a][b][m][n] = (f32x4){0.f, 0.f, 0.f, 0.f};
    bf16x8 At[4][2], B0[2][2], B1[2][2];
    const char* cA = (const char*)g.A + (size_t)cur.pm * tstep; const char* cB = (const char*)g.Bt + (size_t)cur.pn * tstep;
    S.a_ready(cur);
    if constexpr (SP2) {
        PG8_STAGE(PG8_SB(0, 0), cB, voffB); PG8_STAGE(PG8_SB(0, 1), cB + hstep, voffB); PG8_STAGE(PG8_SA(0, 0), cA, voffA); PG8_STAGE(PG8_SA(0, 1), cA + hstep, voffA);
        if (wr == 1) PG8_BAR;
        PG8_WAIT_V(2); PG8_BAR;
        PG8_STAGE(PG8_SB(1, 0), cB + kstep, voffB); PG8_STAGE(PG8_SA(1, 0), cA + kstep, voffA); PG8_STAGE(PG8_SB(1, 1), cB + hstep + kstep, voffB);
        PG8_WAIT_V(6); PG8_BAR;
    } else {
        PG8_STAGE(PG8_SB(0, 0), cB, voffB); PG8_STAGE(PG8_SA(0, 0), cA, voffA); PG8_STAGE(PG8_SB(0, 1), cB + hstep, voffB); PG8_STAGE(PG8_SA(0, 1), cA + hstep, voffA);
        if (wr == 1) PG8_BAR;
        PG8_WAIT_V(4); PG8_BAR;
        PG8_STAGE(PG8_SB(1, 0), cB + kstep, voffB); PG8_STAGE(PG8_SA(1, 0), cA + kstep, voffA); PG8_STAGE(PG8_SB(1, 1), cB + hstep + kstep, voffB);
        PG8_WAIT_V(6); PG8_BAR;
    }
    for (;;) {
        const bool has_next = S.next(ui + 1, nxt);
        const char* nA = has_next ? (const char*)g.A + (size_t)nxt.pm * tstep : cA; const char* nB = has_next ? (const char*)g.Bt + (size_t)nxt.pn * tstep : cB;
        for (int t = 0; t < nt; t += 2) {
            const bool last = (t == nt - 2);
            const char* a1 = cA + (size_t)(t + 1) * kstep;
            const char* a2 = last ? nA : cA + (size_t)(t + 2) * kstep; const char* b2 = last ? nB : cB + (size_t)(t + 2) * kstep;
            const char* a3 = a2 + kstep; const char* b3 = b2 + kstep;
            if (last && has_next) S.a_ready(nxt);
            if constexpr (SP2) {
            PG8_LDB(B0, 0, 0); PG8_LDB(B1, 0, 1); PG8_SCHED; PG8_LDA(At, 0, 0); PG8_STAGE(PG8_SA(1, 1), a1 + hstep, voffA);
            PG8_WAIT_V(8); PG8_WAIT_L(0); PG8_BAR; PG8_MMA(0, 0, At, B0); PG8_MMA(0, 1, At, B1); PG8_BAR; PG8_SCHED;
            PG8_LDA(At, 0, 1); PG8_STAGE(PG8_SB(0, 0), b2, voffB); PG8_STAGE(PG8_SB(0, 1), b2 + hstep, voffB); PG8_STAGE(PG8_SA(0, 0), a2, voffA);
            PG8_WAIT_V(8); PG8_WAIT_L(0); PG8_BAR; PG8_MMA(1, 0, At, B0); PG8_MMA(1, 1, At, B1); PG8_BAR; PG8_SCHED;
            PG8_LDB(B0, 1, 0); PG8_LDB(B1, 1, 1); PG8_SCHED; PG8_LDA(At, 1, 0); PG8_STAGE(PG8_SA(0, 1), a2 + hstep, voffA);
            PG8_WAIT_V(8); PG8_WAIT_L(0); PG8_BAR; PG8_MMA(0, 0, At, B0); PG8_MMA(0, 1, At, B1); PG8_BAR; PG8_SCHED;
            PG8_LDA(At, 1, 1); PG8_STAGE(PG8_SB(1, 0), b3, voffB); PG8_STAGE(PG8_SB(1, 1), b3 + hstep, voffB); PG8_STAGE(PG8_SA(1, 0), a3, voffA);
            PG8_WAIT_V(8); PG8_WAIT_L(0); PG8_BAR; PG8_MMA(1, 0, At, B0); PG8_MMA(1, 1, At, B1); PG8_BAR; PG8_SCHED;
            } else {
            PG8_LDB(B0, 0, 0); PG8_SCHED; PG8_LDA(At, 0, 0); PG8_STAGE(PG8_SA(1, 1), a1 + hstep, voffA);
            PG8_WAIT_L(8); PG8_BAR; PG8_WAIT_L(0); PG8_MMA(0, 0, At, B0); PG8_BAR; PG8_SCHED;
            PG8_LDB(B1, 0, 1); PG8_STAGE(PG8_SB(0, 0), b2, voffB);
            PG8_BAR; PG8_WAIT_L(0); PG8_MMA(0, 1, At, B1); PG8_BAR;
            PG8_LDA(At, 0, 1); PG8_STAGE(PG8_SA(0, 0), a2, voffA);
            PG8_BAR; PG8_WAIT_L(0); PG8_MMA(1, 0, At, B0); PG8_BAR; PG8_SCHED;
            PG8_STAGE(PG8_SB(0, 1), b2 + hstep, voffB);
            PG8_WAIT_V(6); PG8_BAR; PG8_MMA(1, 1, At, B1); PG8_BAR;
            PG8_LDB(B0, 1, 0); PG8_SCHED; PG8_LDA(At, 1, 0); PG8_STAGE(PG8_SA(0, 1), a2 + hstep, voffA);
            PG8_WAIT_L(8); PG8_BAR; PG8_WAIT_L(0); PG8_MMA(0, 0, At, B0); PG8_BAR; PG8_SCHED;
            PG8_LDB(B1, 1, 1); PG8_STAGE(PG8_SB(1, 0), b3, voffB);
            PG8_BAR; PG8_WAIT_L(0); PG8_MMA(0, 1, At, B1); PG8_BAR;
            PG8_LDA(At, 1, 1); PG8_STAGE(PG8_SA(1, 0), a3, voffA);
            PG8_BAR; PG8_WAIT_L(0); PG8_MMA(1, 0, At, B0); PG8_BAR; PG8_SCHED;
            PG8_STAGE(PG8_SB(1, 1), b3 + hstep, voffB);
            PG8_WAIT_V(6); PG8_BAR; PG8_MMA(1, 1, At, B1); PG8_BAR;
            }
        }
        if constexpr (ALIGN_EPI) { if (wr == 0) PG8_BAR; }
        if constexpr (!Epi::AFTER_DRAIN) { E(acc, cur, wr, wc, fr, fq); S.done(cur); }
        if (!has_next) break;
#pragma unroll
        for (int a = 0; a < 2; ++a)
#pragma unroll
            for (int b = 0; b < 2; ++b)
#pragma unroll
                for (int m = 0; m < 4; ++m)
#pragma unroll
                    for (int n = 0; n < 2; ++n) acc[a][b][m][n] = (f32x4){0.f, 0.f, 0.f, 0.f};
        cur = nxt; cA = nA; cB = nB; ++ui;
        if constexpr (ALIGN_EPI) { if (wr == 1) PG8_BAR; }
    }
    PG8_WAIT_V(0);
    if constexpr (!ALIGN_EPI) { if (wr == 0) PG8_BAR; }
    PG8_BAR;
#undef PG8_SA
#undef PG8_SB
#undef PG8_STAGE
#undef PG8_LDA
#undef PG8_LDB
#undef PG8_MMA
#undef PG8_WAIT_V
#undef PG8_WAIT_L
#undef PG8_BAR
#undef PG8_SCHED
}
}

#define XB_TMO      128
#define XB_XCNT(j)  (256  + 64 * (j))
#define XB_XSUB(j)  (1280 + 64 * (j))
#define XB_XGEN(j)  (2304 + 64 * (j))
#define XB_TOP      3328
#define XB_TOPGEN   3392
#define XCD_BAR_WORDS 3456
#define XB_SPIN_CAP (1u << 18)
__device__ __forceinline__ unsigned xb_ld(unsigned* p)              { return __hip_atomic_load(p, __ATOMIC_RELAXED, __HIP_MEMORY_SCOPE_AGENT); }
__device__ __forceinline__ unsigned xb_add(unsigned* p, unsigned v) { return __hip_atomic_fetch_add(p, v, __ATOMIC_RELAXED, __HIP_MEMORY_SCOPE_AGENT); }
__device__ __forceinline__ unsigned xb_xcc_id() { return (unsigned)__builtin_amdgcn_s_getreg((3 << 11) | 20) & 0xFu; }
#define XB_SPIN(cond, bar) do { unsigned _sp = 0; while (cond) { __builtin_amdgcn_s_sleep(1); \
    if ((++_sp & 255u) == 0u) { if (xb_ld(&(bar)[XB_TMO])) break; if (_sp > XB_SPIN_CAP) { atomicAdd(&(bar)[XB_TMO], 1u); break; } } } } while (0)
struct XcdBarrier { unsigned* bar; unsigned x; volatile LAS unsigned* st; };
__device__ __forceinline__ XcdBarrier xcd_barrier_post(unsigned* bar, volatile LAS unsigned* st) {
    XcdBarrier b; b.bar = bar; b.x = xb_xcc_id(); b.st = st;
    if (threadIdx.x == 0) (void)xb_add(&bar[XB_XCNT(b.x)], 1u);
    return b;
}
__device__ __forceinline__ void xcd_barrier_complete(unsigned* bar, unsigned x, unsigned& nloc, unsigned& nx) {
    const unsigned G = gridDim.x * gridDim.y * gridDim.z;
    unsigned sum, cnt, mine, sp = 0u;
    for (;;) {
        sum = 0u; cnt = 0u; mine = 0u;
#pragma unroll
        for (unsigned j = 0; j < 16; ++j) { const unsigned c = xb_ld(&bar[XB_XCNT(j)]); sum += c; cnt += (c > 0u) ? 1u : 0u; mine = (j == x) ? c : mine; }
        if (sum == G) break;
        __builtin_amdgcn_s_sleep(1);
        if ((++sp & 255u) == 0u) { if (xb_ld(&bar[XB_TMO])) break; if (sp > XB_SPIN_CAP) { atomicAdd(&bar[XB_TMO], 1u); break; } }
    }
    nloc = mine > 0u ? mine : 1u; nx = cnt > 0u ? cnt : 1u;
}
__device__ __forceinline__ void xcd_barrier(const XcdBarrier& b) {
    asm volatile("s_waitcnt vmcnt(0)" ::: "memory");
    __syncthreads();
    if (threadIdx.x == 0) {
        unsigned* bar = b.bar;
        __builtin_amdgcn_s_waitcnt(0);
        unsigned nloc = b.st[0], nx = b.st[1];
        if (nloc == 0u) { xcd_barrier_complete(bar, b.x, nloc, nx); b.st[0] = nloc; b.st[1] = nx; }
        const unsigned old = xb_add(&bar[XB_XSUB(b.x)], 1u);
        const unsigned gen = old / nloc;
        if (old + 1u == (gen + 1u) * nloc) {
            __builtin_amdgcn_fence(__ATOMIC_RELEASE, "agent");
            asm volatile("s_waitcnt vmcnt(0)" ::: "memory");
            const unsigned og = xb_add(&bar[XB_TOP], 1u);
            const unsigned tg = og / nx;
            if (og + 1u == (tg + 1u) * nx) xb_add(&bar[XB_TOPGEN], 1u);
            else XB_SPIN(xb_ld(&bar[XB_TOPGEN]) == tg, bar);
            __builtin_amdgcn_fence(__ATOMIC_ACQUIRE, "agent");
            xb_add(&bar[XB_XGEN(b.x)], 1u);
            asm volatile("s_waitcnt vmcnt(0)" ::: "memory");
        } else {
            XB_SPIN(xb_ld(&bar[XB_XGEN(b.x)]) == gen, bar);
            __builtin_amdgcn_fence(__ATOMIC_ACQUIRE, "agent");
            asm volatile("s_waitcnt vmcnt(0)" ::: "memory");
        }
    }
    __syncthreads();
}

template <int MAP>
DI int colmap(int v, int Nsrc) {
    if (MAP == 0) return v < Nsrc ? v : -1;
    const int g8 = v >> 3, e = v & 7, j = 4 * g8 + (e & 3); return (e < 4) ? j : FF + j;
}
template <int MAP>
DI void p0_transpose_item(const float* W, int K, int Nsrc, const float* gain, bf16_t* WT, LAS float* scr, int kb, int nb, int lane) {
    const int k0 = 64 * kb, n0 = 32 * nb;
    const int sc = colmap<MAP>(n0 + (lane & 31), Nsrc);
#pragma unroll 8
    for (int i = 0; i < 32; ++i) { const int kk = 2 * i + (lane >> 5); float w = 0.f; if (sc >= 0) w = W[(size_t)(k0 + kk) * Nsrc + sc]; if (gain) w *= gain[k0 + kk]; scr[kk * 33 + (lane & 31)] = w; }
    WSYNC();
    const int c = lane & 7;
#pragma unroll
    for (int j = 0; j < 4; ++j) { const int n = (lane >> 3) + 8 * j; const LAS float* s = scr + (8 * c) * 33 + n;
        u32x4 o; o.x = pk2(s[0 * 33], s[1 * 33]); o.y = pk2(s[2 * 33], s[3 * 33]); o.z = pk2(s[4 * 33], s[5 * 33]); o.w = pk2(s[6 * 33], s[7 * 33]);
        *(u32x4*)(WT + (size_t)(n0 + n) * K + k0 + 8 * c) = o; }
    WSYNC();
}


typedef float f32x16 __attribute__((ext_vector_type(16)));
typedef float f32x2v __attribute__((ext_vector_type(2)));
typedef __bf16 bf16x2_t __attribute__((ext_vector_type(2)));
constexpr int KSTR = 208, VSTR = 136;
constexpr int AL_K0 = 0, AL_K1 = 64 * KSTR, AL_V0 = 2 * 64 * KSTR, AL_V1 = AL_V0 + 64 * VSTR, AL_IMP = 45056, AL_SELM = AL_IMP + 32768, AL_OACC = AL_SELM + 1024;
constexpr float NEGB = -1e30f, LOG2E = 1.4426950408889634f;
DI unsigned cvtpk(float lo, float hi) { f32x2v v = {lo, hi}; bf16x2_t b = __builtin_convertvector(v, bf16x2_t); return __builtin_bit_cast(unsigned, b); }
DI f32x16 mfma32(bf16x8 a, bf16x8 b, f32x16 c) { return __builtin_amdgcn_mfma_f32_32x32x16_bf16(a, b, c, 0, 0, 0); }
DI float xhalf_max(float v) { auto rr = __builtin_amdgcn_permlane32_swap(__float_as_uint(v), __float_as_uint(v), false, false); return fmaxf(__uint_as_float(rr[0]), __uint_as_float(rr[1])); }
DI float xhalf_sum(float v) { auto rr = __builtin_amdgcn_permlane32_swap(__float_as_uint(v), __float_as_uint(v), false, false); return __uint_as_float(rr[0]) + __uint_as_float(rr[1]); }
DI float ex2(float x) { return __builtin_amdgcn_exp2f(x); }
template <int KSTEPS>
DI void qk_tile(const LAS unsigned char* Kt, const bf16x8 (&qf)[KSTEPS], int r32, int hi, f32x16& s0, f32x16& s1) {
    const LAS unsigned char* p0 = Kt + r32 * KSTR + hi * 16;
#pragma unroll
    for (int i = 0; i < 16; ++i) { s0[i] = 0.f; s1[i] = 0.f; }
#pragma unroll
    for (int ks = 0; ks < KSTEPS; ++ks) {
        const bf16x8 a0 = *(const LAS bf16x8*)(p0 + ks * 32), a1 = *(const LAS bf16x8*)(p0 + 32 * KSTR + ks * 32);
        s0 = mfma32(a0, qf[ks], s0); s1 = mfma32(a1, qf[ks], s1);
    }
}
DI void mask_tile(f32x16& s0, f32x16& s1, int klo, int khi, int hi) {
    const int lo_ = klo - 4 * hi, hi_ = khi - 4 * hi;
#pragma unroll
    for (int i = 0; i < 16; ++i) { const int kb = (i & 3) + 8 * (i >> 2); if (kb < lo_ || kb > hi_) s0[i] = NEGB; if (kb + 32 < lo_ || kb + 32 > hi_) s1[i] = NEGB; }
}
DI float tile_max(const f32x16& s0, const f32x16& s1) {
    float mx = fmaxf(s0[0], s1[0]);
#pragma unroll
    for (int i = 1; i < 16; ++i) mx = fmaxf(mx, fmaxf(s0[i], s1[i]));
    return xhalf_max(mx);
}
template <int BASE> DI bf16x8 pack8(const f32x16& s) { u32x4 p; p.x = cvtpk(s[BASE], s[BASE + 1]); p.y = cvtpk(s[BASE + 2], s[BASE + 3]); p.z = cvtpk(s[BASE + 4], s[BASE + 5]); p.w = cvtpk(s[BASE + 6], s[BASE + 7]); return __builtin_bit_cast(bf16x8, p); }
DI bf16x8 vfrag(const LAS unsigned char* p) { const u32x2 a = *(const LAS u32x2*)p, b = *(const LAS u32x2*)(p + 16); u32x4 w; w.x = a.x; w.y = a.y; w.z = b.x; w.w = b.y; return __builtin_bit_cast(bf16x8, w); }
DI void pv_tile(const f32x16& s0, const f32x16& s1, const LAS unsigned char* Vt, f32x16 (&o)[2], int r32, int hi) {
    const bf16x8 p00 = pack8<0>(s0), p01 = pack8<8>(s0), p10 = pack8<0>(s1), p11 = pack8<8>(s1);
#pragma unroll
    for (int dt = 0; dt < 2; ++dt) { const LAS unsigned char* vp = Vt + (32 * dt + r32) * VSTR + 8 * hi;
        o[dt] = mfma32(vfrag(vp), p00, o[dt]); o[dt] = mfma32(vfrag(vp + 32), p01, o[dt]); o[dt] = mfma32(vfrag(vp + 64), p10, o[dt]); o[dt] = mfma32(vfrag(vp + 96), p11, o[dt]); }
}
DI void softmax_pv(f32x16& s0, f32x16& s1, const LAS unsigned char* Vt, f32x16 (&o)[2], float& m, float& l, int r32, int hi) {
    const float mx = tile_max(s0, s1), mn = fmaxf(m, mx), ms = mn < -1e29f ? 0.f : mn, alpha = ex2(m - ms);
    m = mn; float psum = 0.f;
#pragma unroll
    for (int i = 0; i < 16; ++i) { s0[i] = ex2(s0[i] - ms); s1[i] = ex2(s1[i] - ms); psum += s0[i] + s1[i]; }
    l = l * alpha + psum;
#pragma unroll
    for (int i = 0; i < 16; ++i) { o[0][i] *= alpha; o[1][i] *= alpha; }
    pv_tile(s0, s1, Vt, o, r32, hi);
}
template <class LoadF, class StoreF, class StepF>
DI void attn_pipeline(int jbeg, int jend, LoadF ld, StoreF st, StepF step) {
    if (jbeg > jend) return;
    ld(jbeg); st(0); __syncthreads();
    for (int j = jbeg; j <= jend; ++j) { const int cb = (j - jbeg) & 1;
        if (j < jend) ld(j + 1);
        step(j, cb);
        if (j < jend) st(cb ^ 1);
        __syncthreads(); }
}

DI const float* inp(const Args& a, int k) { asm volatile("" : "+s"(k)); return a.in[k]; }
__global__ void __launch_bounds__(NTHR, 2) fwd(Args args) {
    extern __shared__ __attribute__((aligned(16))) unsigned char lds_raw[];
    LAS unsigned char* lds = (LAS unsigned char*)lds_raw;
    LAS float* ldsf = (LAS float*)lds;
    volatile LAS unsigned* LCTL = (volatile LAS unsigned*)(lds + LDS_CTL);
    const int tid0 = threadIdx.x, wave = __builtin_amdgcn_readfirstlane(tid0 >> 6);
    const int G = gridDim.x, bid = blockIdx.x;
#define LAUNDER_TID() int tid = tid0; asm volatile("" : "+v"(tid)); const int lane = tid & 63; (void)lane
    unsigned char* ws = args.ws;
    unsigned* ctl = (unsigned*)(ws + WS_CTL);
    float* acc_base = (float*)(ws + WS_ACC);
    float* ssq0 = (float*)(ws + WS_SSQ0);
    float* hb = (float*)(ws + WS_HB);
    bf16_t* XB = (bf16_t*)(ws + WS_XB); bf16_t* Y = (bf16_t*)(ws + WS_Y); bf16_t* PB = (bf16_t*)(ws + WS_PB); bf16_t* ACT = (bf16_t*)(ws + WS_ACT);
    const float2* cs64 = (const float2*)(ws + WS_CS64); const float2* cs32 = (const float2*)(ws + WS_CS32);
    float* LA = (float*)(ws + WS_LA); float* LH = (float*)(ws + WS_LH); float* CIN = (float*)(ws + WS_CIN);
    float* KVC = (float*)(ws + WS_KVC); float* DEC = (float*)(ws + WS_DEC); float* SST = (float*)(ws + WS_SST);
    bf16_t* MQ = (bf16_t*)(ws + WS_MQ); bf16_t* MKN = (bf16_t*)(ws + WS_MKN); bf16_t* MVT = (bf16_t*)(ws + WS_MV); bf16_t* MKR = (bf16_t*)(ws + WS_MKR);
    bf16_t* VST = (bf16_t*)(ws + WS_VST); bf16_t* VWT = (bf16_t*)(ws + WS_VWT); bf16_t* KCMPB = (bf16_t*)(ws + WS_KCMPB); bf16_t* VCMPT = (bf16_t*)(ws + WS_VCMPT);
    const int* positions = (const int*)inp(args, 1);

    { LAUNDER_TID(); if (tid < 16) LCTL[tid] = 0u; }
    __syncthreads();
    const int lo = args.ph_lo, hi = args.ph_hi;
    XcdBarrier bar; bar.bar = ctl + CW_BAR; bar.x = 0; bar.st = LCTL;
    if (hi - lo > 1) bar = xcd_barrier_post(ctl + CW_BAR, LCTL);
#define IN(k) (lo <= (k) && (k) < hi)
#define SEAM(k) do { if (IN(k) && IN((k) + 1)) xcd_barrier(bar); } while (0)

    if (IN(0)) {
        LAUNDER_TID();
        const int gw = bid * 8 + wave, NGW = G * 8;
        LAS float* scr = ldsf + wave * 4096;
        constexpr int I_IN = 16 * 72, I_OUT = 16 * 32, I_GU = 16 * 176, I_DN = 44 * 32, I_L = I_IN + I_OUT + I_GU + I_DN;
        for (int it = gw; it < 2 * I_L; it += NGW) {
            const int l = it / I_L; int r = it % I_L;
            if (r < I_IN) { p0_transpose_item<0>(inp(args, 3) + (size_t)l * DM * NINS, DM, NINS, inp(args, 2) + l * DM, (bf16_t*)(ws + WS_WIN) + (size_t)l * NIN * DM, scr, r / 72, r % 72, lane); continue; } r -= I_IN;
            if (r < I_OUT) { p0_transpose_item<0>(inp(args, 23) + (size_t)l * DM * DM, DM, DM, inp(args, 22) + l * DM, (bf16_t*)(ws + WS_WOUT) + (size_t)l * DM * DM, scr, r / 32, r % 32, lane); continue; } r -= I_OUT;
            if (r < I_GU) { p0_transpose_item<1>(inp(args, 25) + (size_t)l * DM * NGU, DM, NGU, inp(args, 24) + l * DM, (bf16_t*)(ws + WS_WGU) + (size_t)l * NGU * DM, scr, r / 176, r % 176, lane); continue; } r -= I_GU;
            p0_transpose_item<0>(inp(args, 26) + (size_t)l * FF * DM, FF, DM, nullptr, (bf16_t*)(ws + WS_WDN) + (size_t)l * DM * FF, scr, r / 32, r % 32, lane);
        }
        for (int m = gw; m < M; m += NGW) {
            const f32x4* xr = (const f32x4*)(inp(args, 0) + (size_t)m * DM) + lane;
            f32x4 v[4]; float s = 0.f;
#pragma unroll
            for (int j = 0; j < 4; ++j) { v[j] = xr[64 * j]; s += v[j][0] * v[j][0] + v[j][1] * v[j][1] + v[j][2] * v[j][2] + v[j][3] * v[j][3]; }
            s = wave_sum(s);
            u32x2* o8 = (u32x2*)(XB + (size_t)m * DM) + lane;
#pragma unroll
            for (int j = 0; j < 4; ++j) { u32x2 w; w.x = pk2(v[j][0], v[j][1]); w.y = pk2(v[j][2], v[j][3]); o8[64 * j] = w; }
            if (lane == 0) ssq0[m] = s;
        }
        for (int e = bid * NTHR + tid; e < M * 32; e += G * NTHR) {
            const int m = e >> 5, i = e & 31; const float pos = (float)positions[m];
            const float invf = powf(10000.f, -(float)(2 * i) / 64.f); float sn, cs; sincosf(pos * invf, &sn, &cs);
            ((float2*)(ws + WS_CS64))[e] = make_float2(cs, sn);
            if (i < 16) { const float invf2 = powf(10000.f, -(float)(2 * i) / 32.f); sincosf(pos * invf2, &sn, &cs); ((float2*)(ws + WS_CS32))[m * 16 + i] = make_float2(cs, sn); }
        }
        for (int e = bid * NTHR + tid; e < 2 * 2 * 256; e += G * NTHR) {
            const int lj = e >> 8, c = e & 255; float a = inp(args, 13)[e];
            const float* pp = inp(args, 11) + (size_t)lj * 2048; const float* w1 = inp(args, 12) + (size_t)lj * 2048 * 256 + c;
            for (int i = 0; i < 2048; ++i) a += pp[i] * w1[(size_t)i * 256];
            hb[e] = a;
        }
    }
    SEAM(0);

    for (int l = 0; l < 2; ++l) {
        const int pb = 1 + 7 * l;
        const float* ssq_mix = (l == 0) ? ssq0 : acc_base + 2 * M;
        float* ssq_out = acc_base + (size_t)l * M;
        float* ssq_down = acc_base + (size_t)(2 + l) * M;
        float* ssq_d = acc_base + (size_t)(4 + l) * M;
        if (IN(pb)) {
            pg8::Gemm g{XB, (const bf16_t*)(ws + WS_WIN) + (size_t)l * NIN * DM, M, NIN, DM}; pg8::StaticOrder S; S.init(M, NIN, G, bid);
            pg8::EpiInProj E{PB, NIN, ssq_mix};
            pg8::gemm_phase<pg8::EpiInProj, pg8::StaticOrder, true, true>(lds, g, S, E);
        }
        SEAM(pb);
        if (IN(pb + 1)) {
        LAUNDER_TID();
            constexpr int N_J1 = 1024, N_J2 = 512, N_J3 = 2048, N_J4 = 512, N_J4B = 512, N_P2 = N_J1 + N_J2 + N_J3 + N_J4 + N_J4B;
            for (int it = bid; it < N_P2; it += G) {
                int r = it;
                if (r < N_J1) {
                    const int b = r >> 8, tb = r & 255, t0 = tb * 32, ch = tid & 255, half = tid >> 8;
                    LAS float* xa = ldsf; LAS float* xc = ldsf + 35 * 256;
                    for (int e = tid; e < 35 * 256; e += NTHR) { const int rr = e >> 8, c = e & 255, t = t0 - 3 + rr; float v = 0.f; if (t >= 0) v = bf2f(PB[(size_t)(b * SEQ + t) * NIN + C_AX + c]); xa[e] = v; }
                    __syncthreads();
                    { const float cw0 = inp(args, 4)[(l * 4 + 0) * 256 + ch], cw1 = inp(args, 4)[(l * 4 + 1) * 256 + ch], cw2 = inp(args, 4)[(l * 4 + 2) * 256 + ch], cw3 = inp(args, 4)[(l * 4 + 3) * 256 + ch], cb = inp(args, 5)[l * 256 + ch];
                      for (int tt = 0; tt < 16; ++tt) { const int rr = half * 16 + tt; xc[rr * 256 + ch] = cb + cw0 * xa[rr * 256 + ch] + cw1 * xa[(rr + 1) * 256 + ch] + cw2 * xa[(rr + 2) * 256 + ch] + cw3 * xa[(rr + 3) * 256 + ch]; } }
                    __syncthreads();
                    const int h = ch >> 6, cc = ch & 63;
                    LAS float* gR = ldsf + 67 * 256; LAS float* gI = gR + 32 * 256;
#pragma unroll 1
                    for (int pass = 0; pass < 2; ++pass) {
                        float wv[64]; const float* wsrc = (pass == 0 ? inp(args, 6) : inp(args, 8)) + ((size_t)(l * 4 + h) * 64) * 64 + cc; const float bias = (pass == 0 ? inp(args, 7) : inp(args, 9))[l * 256 + ch];
#pragma unroll
                        for (int i = 0; i < 64; ++i) wv[i] = wsrc[i * 64];
#pragma unroll 1
                        for (int tt = 0; tt < 16; ++tt) { const LAS f32x4* xr = (const LAS f32x4*)(xc + (half * 16 + tt) * 256 + h * 64); float a = bias;
#pragma unroll
                            for (int i4 = 0; i4 < 16; ++i4) { const f32x4 x = xr[i4]; a += x[0] * wv[4 * i4] + x[1] * wv[4 * i4 + 1] + x[2] * wv[4 * i4 + 2] + x[3] * wv[4 * i4 + 3]; }
                            (pass == 0 ? gR : gI)[(half * 16 + tt) * 256 + ch] = sigmoidf_(a); }
                    }
                    const float sp = log1pf(expf(-inp(args, 10)[l * 256 + ch]));
                    float hst = 0.f, Ac = 1.f;
#pragma unroll 1
                    for (int tt = 0; tt < 16; ++tt) {
                        const int rr = half * 16 + tt;
                        const float rg = gR[rr * 256 + ch], ig = gI[rr * 256 + ch], la = -8.f * rg * sp, av = expf(la), mult = sqrtf(-expm1f(2.f * la));
                        const float u = mult * (ig * xc[rr * 256 + ch]);
                        hst = av * hst + u; Ac *= av;
                    }
                    const size_t so = ((size_t)(b * 512 + tb * 2 + half)) * 256 + ch;
                    LA[so] = Ac; LH[so] = hst;
                    __syncthreads();
                    continue;
                }
                r -= N_J1;
                if (r < N_J2) {
                    const int b = r >> 7, c = r & 127; const size_t row0 = (size_t)b * SEQ + 64 * c;
                    LAS float* glr = ldsf; LAS float* bb = ldsf + 1024; LAS float* kt = bb + 8192; LAS float* vv = kt + 8192;
                    for (int e = tid; e < 1024; e += NTHR) glr[e] = bf2f(PB[(row0 + (e >> 4)) * NIN + C_GLR + (e & 15)]);
                    __syncthreads();
                    for (int e = tid; e < 8192; e += NTHR) { const int t = e >> 7, kk = e & 127; float z = inp(args, 16)[l * 128 + kk];
#pragma unroll
                        for (int q = 0; q < 16; ++q) z += glr[t * 16 + q] * inp(args, 15)[(l * 16 + q) * 128 + kk];
                        bb[e] = (fminf(z, 0.f) - log1pf(expf(-fabsf(z)))) * (1.f / 16.f); }
                    __syncthreads();
                    if (tid < 128) { float run = 0.f; for (int t = 0; t < 64; ++t) { run += bb[t * 128 + tid]; bb[t * 128 + tid] = run; } }
                    __syncthreads();
                    for (int e = tid; e < 8192; e += NTHR) { const int t = e >> 7, kk = e & 127; kt[e] = bf2f(PB[(row0 + t) * NIN + C_CK + kk]) * expf(bb[63 * 128 + kk] - bb[e]); }
                    for (int e = tid; e < 16384; e += NTHR) vv[e] = bf2f(PB[(row0 + (e >> 8)) * NIN + C_CV + (e & 255)]);
                    __syncthreads();
                    { const int h = tid >> 7, k = (tid >> 2) & 31, v0 = (tid & 3) * 16; float a16[16];
#pragma unroll
                      for (int i = 0; i < 16; ++i) a16[i] = 0.f;
                      for (int t = 0; t < 64; ++t) { const float kv = kt[t * 128 + h * 32 + k]; const LAS f32x4* vp = (const LAS f32x4*)(vv + t * 256 + h * 64 + v0);
#pragma unroll
                          for (int i = 0; i < 4; ++i) { const f32x4 x = vp[i]; a16[4 * i] += kv * x[0]; a16[4 * i + 1] += kv * x[1]; a16[4 * i + 2] += kv * x[2]; a16[4 * i + 3] += kv * x[3]; } }
                      float* o = KVC + ((size_t)(b * 128 + c) * 4 + h) * 2048 + k * 64 + v0;
#pragma unroll
                      for (int i = 0; i < 16; ++i) o[i] = a16[i];
                      if (tid < 128) DEC[(size_t)(b * 128 + c) * 128 + tid] = expf(bb[63 * 128 + tid]); }
                    __syncthreads();
                    continue;
                }
                r -= N_J2;
                if (r < N_J3) {
                    const size_t row0 = (size_t)r * 16;
                    LAS float* xq = ldsf; LAS float* xkv = ldsf + 3072; LAS float* outb = ldsf + 5120;
                    for (int q = 0; q < 2; ++q) { const int tok = wave * 2 + q; const bf16_t* pr = PB + (row0 + tok) * NIN;
                        const float a0 = bf2f(pr[C_DCQ + lane]), a1 = bf2f(pr[C_DCQ + 64 + lane]), a2 = bf2f(pr[C_DCQ + 128 + lane]);
                        const float rq = rsqrtf(wave_sum(a0 * a0 + a1 * a1 + a2 * a2) * (1.f / 192.f) + EPS);
                        xq[lane * 16 + tok] = a0 * rq * inp(args, 18)[l * 192 + lane]; xq[(lane + 64) * 16 + tok] = a1 * rq * inp(args, 18)[l * 192 + 64 + lane]; xq[(lane + 128) * 16 + tok] = a2 * rq * inp(args, 18)[l * 192 + 128 + lane];
                        const float c0 = bf2f(pr[C_DCKV + lane]), c1 = bf2f(pr[C_DCKV + 64 + lane]);
                        const float rk = rsqrtf(wave_sum(c0 * c0 + c1 * c1) * (1.f / 128.f) + EPS);
                        xkv[lane * 16 + tok] = c0 * rk * inp(args, 19)[l * 128 + lane]; xkv[(lane + 64) * 16 + tok] = c1 * rk * inp(args, 19)[l * 128 + 64 + lane]; }
                    __syncthreads();
                    for (int cidx = tid; cidx < 896; cidx += NTHR) {
                        const bool isq = cidx < 384; const int col = isq ? cidx : cidx - 384, KK = isq ? 192 : 128, NN = isq ? 384 : 512;
                        const float* W = isq ? inp(args, 20) + (size_t)l * 192 * 384 : inp(args, 21) + (size_t)l * 128 * 512; const LAS float* x = isq ? xq : xkv;
                        float a16[16];
#pragma unroll
                        for (int i = 0; i < 16; ++i) a16[i] = 0.f;
                        for (int kk = 0; kk < KK; ++kk) { const float w = W[(size_t)kk * NN + col]; const LAS f32x4* xp = (const LAS f32x4*)(x + kk * 16);
#pragma unroll
                            for (int i = 0; i < 4; ++i) { const f32x4 xx = xp[i]; a16[4 * i] += w * xx[0]; a16[4 * i + 1] += w * xx[1]; a16[4 * i + 2] += w * xx[2]; a16[4 * i + 3] += w * xx[3]; } }
#pragma unroll
                        for (int i = 0; i < 16; ++i) outb[i * 896 + cidx] = a16[i];
                    }
                    __syncthreads();
                    const float SCQ = 0.10206207261596575f * LOG2E;
                    for (int e = tid; e < 16 * 384; e += NTHR) { const int tok = e / 384, c = e % 384, h = c / 96, d = c % 96; float val;
                        if (d < 64) val = outb[tok * 896 + c];
                        else { const int i = (d - 64) & 15; const float x1 = outb[tok * 896 + h * 96 + 64 + i], x2 = outb[tok * 896 + h * 96 + 80 + i]; const float2 cs = cs32[(row0 + tok) * 16 + i];
                            val = (d < 80) ? x1 * cs.x - x2 * cs.y : x2 * cs.x + x1 * cs.y; }
                        MQ[(row0 + tok) * 384 + c] = f2bf(val * SCQ); }
                    for (int e = tid; e < 16 * 512; e += NTHR) { const int tok = e >> 9, c = e & 511, h = c >> 7, d = c & 127; const bf16_t v = f2bf(outb[tok * 896 + 384 + c]);
                        if (d < 64) MKN[(row0 + tok) * 256 + h * 64 + d] = v; }
                    { const int e = tid >> 1, hf = tid & 1, h = e >> 6, d = e & 63; const LAS float* ob = outb + (hf * 8) * 896 + 384 + h * 128 + 64 + d;
                      u32x4 w; w.x = pk2(ob[0], ob[896]); w.y = pk2(ob[2 * 896], ob[3 * 896]); w.z = pk2(ob[4 * 896], ob[5 * 896]); w.w = pk2(ob[6 * 896], ob[7 * 896]);
                      const size_t bb = row0 / SEQ, t0 = row0 % SEQ; *(u32x4*)(MVT + ((bb * 4 + h) * 64 + d) * SEQ + t0 + hf * 8) = w; }
                    { const int tok = tid >> 5, d = tid & 31, i = d & 15; const bf16_t* pr = PB + (row0 + tok) * NIN + C_DKR; const float x1 = bf2f(pr[i]), x2 = bf2f(pr[16 + i]); const float2 cs = cs32[(row0 + tok) * 16 + i];
                      MKR[(row0 + tok) * 32 + d] = f2bf(d < 16 ? x1 * cs.x - x2 * cs.y : x2 * cs.x + x1 * cs.y); }
                    __syncthreads();
                    continue;
                }
                r -= N_J3;
                if (r < N_J4) {
                    const size_t row0 = (size_t)r * 64;
                    for (int e = tid; e < 64 * 192; e += NTHR) { const int tok = e / 192, p = e % 192, i = p & 31; const int base = p < 128 ? C_BQ + (p >> 5) * 64 : (p < 160 ? C_KS : C_KW); const float sc = p < 128 ? 0.125f * LOG2E : 1.f;
                        bf16_t* pr = PB + (row0 + tok) * NIN + base; const float x1 = bf2f(pr[i]), x2 = bf2f(pr[32 + i]); const float2 cs = cs64[(row0 + tok) * 32 + i];
                        pr[i] = f2bf((x1 * cs.x - x2 * cs.y) * sc); pr[32 + i] = f2bf((x2 * cs.x + x1 * cs.y) * sc); }
                    { LAS bf16_t* tl = (LAS bf16_t*)lds; const size_t bb = row0 / SEQ, t0 = row0 % SEQ;
                      for (int mtx = 0; mtx < 2; ++mtx) { const int tok = tid >> 3, c = tid & 7; const u32x4 w = *(const u32x4*)(PB + (row0 + tok) * NIN + (mtx ? C_VW : C_VS) + c * 8);
                          LAS bf16_t* dst = tl + mtx * 64 * 72 + tok * 72 + c * 8; dst[0] = (bf16_t)w.x; dst[1] = (bf16_t)(w.x >> 16); dst[2] = (bf16_t)w.y; dst[3] = (bf16_t)(w.y >> 16); dst[4] = (bf16_t)w.z; dst[5] = (bf16_t)(w.z >> 16); dst[6] = (bf16_t)w.w; dst[7] = (bf16_t)(w.w >> 16); }
                      __syncthreads();
                      for (int mtx = 0; mtx < 2; ++mtx) { const int d = tid >> 3, c8 = tid & 7; const LAS bf16_t* s = tl + mtx * 64 * 72 + (c8 * 8) * 72 + d;
                          u32x4 w; w.x = (unsigned)s[0] | ((unsigned)s[72] << 16); w.y = (unsigned)s[2 * 72] | ((unsigned)s[3 * 72] << 16); w.z = (unsigned)s[4 * 72] | ((unsigned)s[5 * 72] << 16); w.w = (unsigned)s[6 * 72] | ((unsigned)s[7 * 72] << 16);
                          *(u32x4*)((mtx ? VWT : VST) + (bb * 64 + d) * SEQ + t0 + c8 * 8) = w; }
                      __syncthreads(); }
                    continue;
                }
                r -= N_J4;
                {
                    const int j = r & 1, nb = (r >> 1) & 63, b = r >> 7; const int colb = j == 0 ? C_KC : C_VC;
                    LAS float* T = ldsf; LAS float* hid = ldsf + 144 * 64;
                    for (int e = tid; e < 144 * 64; e += NTHR) { const int rr = e >> 6, d = e & 63, t = 128 * nb + rr; float v = 0.f;
                        if (t < SEQ) { const bf16_t* pr = PB + ((size_t)b * SEQ + t) * NIN + colb;
                            if (j == 0) { const int i = d & 31; const float x1 = bf2f(pr[i]), x2 = bf2f(pr[32 + i]); const float2 cs = cs64[((size_t)b * SEQ + t) * 32 + i]; v = d < 32 ? x1 * cs.x - x2 * cs.y : x2 * cs.x + x1 * cs.y; }
                            else v = bf2f(pr[d]); }
                        T[e] = v; }
                    __syncthreads();
                    { const int c = tid & 255, half = tid >> 8; const float* w1 = inp(args, 12) + (size_t)(l * 2 + j) * 2048 * 256 + c;
                      const float hb0 = hb[(l * 2 + j) * 256 + c]; float a0 = hb0, a1 = hb0, a2 = hb0, a3 = hb0;
                      const LAS float* Tb = T + (16 * half * 4) * 64;
                      for (int i = 0; i < 2048; ++i) { const float w = w1[(size_t)i * 256]; a0 += Tb[i] * w; a1 += Tb[i + 1024] * w; a2 += Tb[i + 2048] * w; a3 += Tb[i + 3072] * w; }
                      hid[(half * 4 + 0) * 256 + c] = gelu_tanh(a0); hid[(half * 4 + 1) * 256 + c] = gelu_tanh(a1); hid[(half * 4 + 2) * 256 + c] = gelu_tanh(a2); hid[(half * 4 + 3) * 256 + c] = gelu_tanh(a3); }
                    __syncthreads();
                    { const int nl = tid >> 6, dd = tid & 63, n = 8 * nb + nl; const float* w2 = inp(args, 14) + (size_t)(l * 2 + j) * 256 * 64 + dd; float o = 0.f;
                      for (int c = 0; c < 256; ++c) o += hid[nl * 256 + c] * w2[c * 64];
                      const bf16_t ob = f2bf(n < 511 ? o : 0.f);
                      if (j == 0) KCMPB[((size_t)b * 512 + n) * 64 + dd] = ob; else VCMPT[((size_t)b * 64 + dd) * 512 + n] = ob; }
                    __syncthreads();
                }
            }
        }
        SEAM(pb + 1);
        if (IN(pb + 2)) {
        LAUNDER_TID();
            constexpr int Q_J5 = 2, Q_J6 = 64, Q_ATT = 1024, Q_TOT = Q_J5 + Q_J6 + Q_ATT;
            for (;;) {
                if (tid == 0) LCTL[2] = __hip_atomic_fetch_add(ctl + CW_QUEUE + 64 * l, 1u, __ATOMIC_RELAXED, __HIP_MEMORY_SCOPE_AGENT);
                __syncthreads();
                int r = __builtin_amdgcn_readfirstlane((int)LCTL[2]);
                __syncthreads();
                if (r >= Q_TOT) break;
                if (r < Q_J5) {
                    const int e = r * NTHR + tid, b = e >> 8, ch = e & 255; float carry = 0.f;
                    for (int c0 = 0; c0 < 512; c0 += 8) { float av[8], hv[8];
#pragma unroll
                        for (int q = 0; q < 8; ++q) { const size_t so = ((size_t)(b * 512 + c0 + q)) * 256 + ch; av[q] = LA[so]; hv[q] = LH[so]; }
#pragma unroll
                        for (int q = 0; q < 8; ++q) { CIN[((size_t)(b * 512 + c0 + q)) * 256 + ch] = carry; carry = av[q] * carry + hv[q]; } }
                    continue;
                }
                r -= Q_J5;
                if (r < Q_J6) {
                    const int e = r * NTHR + tid, b = e >> 13, rem = e & 8191; float Sv = 0.f;
                    for (int c0 = 0; c0 < 128; c0 += 8) { float kv[8], dv[8];
#pragma unroll
                        for (int q = 0; q < 8; ++q) { kv[q] = KVC[(size_t)(b * 128 + c0 + q) * 8192 + rem]; dv[q] = DEC[(size_t)(b * 128 + c0 + q) * 128 + (rem >> 6)]; }
#pragma unroll
                        for (int q = 0; q < 8; ++q) { SST[(size_t)(b * 128 + c0 + q) * 8192 + rem] = Sv; Sv = dv[q] * Sv + kv[q]; } }
                    continue;
                }
                r -= Q_J6;
                const int r32 = lane & 31, hi = lane >> 5;
                const int grp = r >> 5, within = r & 31;
                if (within >= 16) {
                    const int idx = within - 16, b = idx & 3, tb = 127 - (4 * grp + (idx >> 2));
                    const int tl = 8 * wave + (r32 >> 2), head = r32 & 3, T = 64 * tb + tl; const size_t row = (size_t)b * SEQ + T; const bf16_t* prow = PB + row * NIN;
                    bf16x8 qf[4];
#pragma unroll
                    for (int ks = 0; ks < 4; ++ks) qf[ks] = *(const bf16x8*)(prow + C_BQ + head * 64 + 16 * ks + 8 * hi);
                    const float g0 = sigmoidf_(bf2f(prow[C_BG + head * 3])), g1 = sigmoidf_(bf2f(prow[C_BG + head * 3 + 1])), g2 = sigmoidf_(bf2f(prow[C_BG + head * 3 + 2]));
                    LAS float* impb = (LAS float*)(lds + AL_IMP) + wave * 1024; LAS unsigned* selm = (LAS unsigned*)(lds + AL_SELM) + wave * 32;
                    u32x4 rk, rv;
                    const int skey = tid >> 3, sch = tid & 7;
                    auto stK = [&](int buf) { *(LAS u32x4*)(lds + (buf ? AL_K1 : AL_K0) + skey * KSTR + sch * 16) = rk; };
                    auto stKV = [&](int buf) { *(LAS u32x4*)(lds + (buf ? AL_K1 : AL_K0) + skey * KSTR + sch * 16) = rk;
                        LAS unsigned char* vd = lds + (buf ? AL_V1 : AL_V0) + skey * VSTR + sch * 16; u32x2 a, c; a.x = rv.x; a.y = rv.y; c.x = rv.z; c.y = rv.w; *(LAS u32x2*)vd = a; *(LAS u32x2*)(vd + 8) = c; };
                    f32x16 oacc[2], ob[2];
                    const int nv = T >= 31 ? ((T - 31) >> 4) + 1 : 0, ntc = (4 * tb + 3 + 63) >> 6;
                    float mC = NEGB, lC = 0.f;
                    { const bf16_t* kb_ = KCMPB + (size_t)b * 512 * 64;
                      attn_pipeline(0, ntc - 1, [&](int j) { rk = *(const u32x4*)(kb_ + (size_t)(64 * j + skey) * 64 + sch * 8); }, stK,
                        [&](int j, int cb) { f32x16 s0, s1; qk_tile<4>(lds + (cb ? AL_K1 : AL_K0), qf, r32, hi, s0, s1); mask_tile(s0, s1, 0, nv - 1 - 64 * j, hi);
                            const float mx = tile_max(s0, s1), mn = fmaxf(mC, mx), ms = mn < -1e29f ? 0.f : mn, alpha = ex2(mC - ms); mC = mn; float ps = 0.f;
#pragma unroll
                            for (int i = 0; i < 16; ++i) ps += ex2(s0[i] - ms) + ex2(s1[i] - ms);
                            lC = lC * alpha + ps; }); }
                    { const float invC = 1.f / fmaxf(xhalf_sum(lC), 1e-30f), msC = mC < -1e29f ? 0.f : mC; float carry = 0.f;
#pragma unroll
                      for (int i = 0; i < 16; ++i) { ob[0][i] = 0.f; ob[1][i] = 0.f; }
                      const bf16_t* kb_ = KCMPB + (size_t)b * 512 * 64; const bf16_t* vb_ = VCMPT + (size_t)b * 64 * 512;
                      attn_pipeline(0, ntc - 1, [&](int j) { rk = *(const u32x4*)(kb_ + (size_t)(64 * j + skey) * 64 + sch * 8); rv = *(const u32x4*)(vb_ + (size_t)skey * 512 + 64 * j + sch * 8); }, stKV,
                        [&](int j, int cb) { f32x16 s0, s1; qk_tile<4>(lds + (cb ? AL_K1 : AL_K0), qf, r32, hi, s0, s1); mask_tile(s0, s1, 0, nv - 1 - 64 * j, hi);
#pragma unroll
                            for (int i = 0; i < 16; ++i) { s0[i] = ex2(s0[i] - msC) * invC; s1[i] = ex2(s1[i] - msC) * invC; }
                            float gs[8], pl[8];
#pragma unroll
                            for (int q = 0; q < 4; ++q) { gs[q] = (s0[4 * q] + s0[4 * q + 1]) + (s0[4 * q + 2] + s0[4 * q + 3]); gs[4 + q] = (s1[4 * q] + s1[4 * q + 1]) + (s1[4 * q + 2] + s1[4 * q + 3]);
                                pl[q] = __shfl_xor(s0[4 * q + 3], 32); pl[4 + q] = __shfl_xor(s1[4 * q + 3], 32); }
#pragma unroll
                            for (int q = 0; q < 8; ++q) { const float prev = hi ? pl[q] : (q > 0 ? pl[q > 0 ? q - 1 : 0] : carry); float x = gs[q] + prev; x += __shfl_xor(x, 1); x += __shfl_xor(x, 2);
                                if ((r32 & 3) == 0) impb[(r32 >> 2) * 128 + 16 * j + 2 * q + hi] = x; }
                            carry = pl[7];
                            pv_tile(s0, s1, lds + (cb ? AL_V1 : AL_V0), ob, r32, hi); }); }
                    LAS float* oav = (LAS float*)(lds + AL_OACC) + tid;
#pragma unroll
                    for (int i = 0; i < 16; ++i) { oav[i * 512] = g0 * ob[0][i]; oav[(16 + i) * 512] = g0 * ob[1][i]; }
                    WSYNC();
                    for (int tk = 0; tk < 8; ++tk) {
                        const int cur = tb, j0 = lane, j1 = lane + 64; const float im0 = impb[tk * 128 + j0], im1 = impb[tk * 128 + j1];
                        float s0 = (j0 == 0 || j0 == cur || j0 == cur - 1) ? 1e9f : (j0 <= cur ? im0 : -1e30f);
                        float s1 = (j1 == cur || j1 == cur - 1) ? 1e9f : (j1 <= cur ? im1 : -1e30f);
                        bool sel0 = false, sel1 = false;
                        for (int k = 0; k < 16; ++k) {
                            const float mx = wave_max(fmaxf(s0, s1));
                            const int cand = (s0 == mx) ? j0 : ((s1 == mx) ? j1 : (1 << 20));
                            const int win = wave_min_i(cand);
                            if (win == j0) { sel0 = true; s0 = -3e38f; } if (win == j1) { sel1 = true; s1 = -3e38f; }
                        }
                        const unsigned long long m0 = __ballot(sel0), m1 = __ballot(sel1);
                        if (lane == 0) { selm[tk * 4] = (unsigned)m0; selm[tk * 4 + 1] = (unsigned)(m0 >> 32); selm[tk * 4 + 2] = (unsigned)m1; selm[tk * 4 + 3] = (unsigned)(m1 >> 32); }
                    }
                    WSYNC();
                    const unsigned sm0 = selm[(r32 >> 2) * 4], sm1 = selm[(r32 >> 2) * 4 + 1], sm2 = selm[(r32 >> 2) * 4 + 2], sm3 = selm[(r32 >> 2) * 4 + 3];
                    { float mB = NEGB, lB = 0.f;
#pragma unroll
                      for (int i = 0; i < 16; ++i) { ob[0][i] = 0.f; ob[1][i] = 0.f; }
                      const bf16_t* kb_ = PB + (size_t)b * SEQ * NIN + C_KS; const bf16_t* vb_ = VST + (size_t)b * 64 * SEQ;
                      attn_pipeline(0, tb, [&](int j) { rk = *(const u32x4*)(kb_ + (size_t)(64 * j + skey) * NIN + sch * 8); rv = *(const u32x4*)(vb_ + (size_t)skey * SEQ + 64 * j + sch * 8); }, stKV,
                        [&](int j, int cb) { const unsigned wsel = j < 32 ? sm0 : (j < 64 ? sm1 : (j < 96 ? sm2 : sm3)); const bool bit = (wsel >> (j & 31)) & 1u;
                            if (__any(bit)) { f32x16 s0, s1; qk_tile<4>(lds + (cb ? AL_K1 : AL_K0), qf, r32, hi, s0, s1);
                                if (j == tb || !__all(bit)) mask_tile(s0, s1, bit ? 0 : 64, j == tb ? tl : 63, hi);
                                softmax_pv(s0, s1, lds + (cb ? AL_V1 : AL_V0), ob, mB, lB, r32, hi); } });
                      const float sc = g1 / fmaxf(xhalf_sum(lB), 1e-30f);
#pragma unroll
                      for (int i = 0; i < 16; ++i) { oav[i * 512] += sc * ob[0][i]; oav[(16 + i) * 512] += sc * ob[1][i]; } }
                    { float mB = NEGB, lB = 0.f;
#pragma unroll
                      for (int i = 0; i < 16; ++i) { ob[0][i] = 0.f; ob[1][i] = 0.f; }
                      const bf16_t* kb_ = PB + (size_t)b * SEQ * NIN + C_KW; const bf16_t* vb_ = VWT + (size_t)b * 64 * SEQ;
                      attn_pipeline(tb >= 8 ? tb - 8 : 0, tb, [&](int j) { rk = *(const u32x4*)(kb_ + (size_t)(64 * j + skey) * NIN + sch * 8); rv = *(const u32x4*)(vb_ + (size_t)skey * SEQ + 64 * j + sch * 8); }, stKV,
                        [&](int j, int cb) { f32x16 s0, s1; qk_tile<4>(lds + (cb ? AL_K1 : AL_K0), qf, r32, hi, s0, s1);
                            if (j == tb || j == tb - 8) mask_tile(s0, s1, j == tb - 8 ? tl + 1 : 0, j == tb ? tl : 63, hi);
                            softmax_pv(s0, s1, lds + (cb ? AL_V1 : AL_V0), ob, mB, lB, r32, hi); });
                      const float sc = g2 / fmaxf(xhalf_sum(lB), 1e-30f);
#pragma unroll
                      for (int i = 0; i < 16; ++i) { oacc[0][i] = oav[i * 512] + sc * ob[0][i]; oacc[1][i] = oav[(16 + i) * 512] + sc * ob[1][i]; } }
                    { float ss = 0.f;
#pragma unroll
                      for (int i = 0; i < 16; ++i) ss += oacc[0][i] * oacc[0][i] + oacc[1][i] * oacc[1][i];
                      ss = xhalf_sum(ss); ss += __shfl_xor(ss, 1); ss += __shfl_xor(ss, 2);
                      const float rinv = rsqrtf(ss * (1.f / 256.f) + EPS);
#pragma unroll
                      for (int dt = 0; dt < 2; ++dt)
#pragma unroll
                          for (int g = 0; g < 4; ++g) { u32x2 w; w.x = cvtpk(oacc[dt][4 * g] * rinv, oacc[dt][4 * g + 1] * rinv); w.y = cvtpk(oacc[dt][4 * g + 2] * rinv, oacc[dt][4 * g + 3] * rinv);
                              *(u32x2*)(Y + row * DM + 256 + head * 64 + 32 * dt + 8 * g + 4 * hi) = w; } }
                    __syncthreads();
                    continue;
                }
                {
                    const int qb = 31 - grp, b = within >> 2, h = within & 3;
                    const int T = 256 * qb + 32 * wave + r32; const size_t row = (size_t)b * SEQ + T;
                    bf16x8 qf[6];
#pragma unroll
                    for (int ks = 0; ks < 6; ++ks) qf[ks] = *(const bf16x8*)(MQ + row * 384 + h * 96 + 16 * ks + 8 * hi);
                    f32x16 o[2];
#pragma unroll
                    for (int i = 0; i < 16; ++i) { o[0][i] = 0.f; o[1][i] = 0.f; }
                    float m = NEGB, l = 0.f;
                    const int jd = 4 * qb + (wave >> 1), jend = 4 * qb + 3;
                    const bf16_t* kn = MKN + (size_t)b * SEQ * 256 + h * 64; const bf16_t* kr = MKR + (size_t)b * SEQ * 32; const bf16_t* vt = MVT + (size_t)(b * 4 + h) * 64 * SEQ;
                    const int key0 = tid / 12, ch0 = tid % 12, key1 = (512 + tid) / 12, ch1 = (512 + tid) % 12, vd_ = tid >> 3, vc8 = tid & 7;
                    u32x4 r0, r1, rv;
                    attn_pipeline(0, jend,
                        [&](int j) { r0 = ch0 < 8 ? *(const u32x4*)(kn + (size_t)(64 * j + key0) * 256 + ch0 * 8) : *(const u32x4*)(kr + (size_t)(64 * j + key0) * 32 + (ch0 - 8) * 8);
                            if (tid < 256) r1 = ch1 < 8 ? *(const u32x4*)(kn + (size_t)(64 * j + key1) * 256 + ch1 * 8) : *(const u32x4*)(kr + (size_t)(64 * j + key1) * 32 + (ch1 - 8) * 8);
                            rv = *(const u32x4*)(vt + (size_t)vd_ * SEQ + 64 * j + vc8 * 8); },
                        [&](int buf) { *(LAS u32x4*)(lds + (buf ? AL_K1 : AL_K0) + key0 * KSTR + ch0 * 16) = r0;
                            if (tid < 256) *(LAS u32x4*)(lds + (buf ? AL_K1 : AL_K0) + key1 * KSTR + ch1 * 16) = r1;
                            LAS unsigned char* vd = lds + (buf ? AL_V1 : AL_V0) + vd_ * VSTR + vc8 * 16; u32x2 a, c; a.x = rv.x; a.y = rv.y; c.x = rv.z; c.y = rv.w; *(LAS u32x2*)vd = a; *(LAS u32x2*)(vd + 8) = c; },
                        [&](int j, int cb) { if (j <= jd) { f32x16 s0, s1; qk_tile<6>(lds + (cb ? AL_K1 : AL_K0), qf, r32, hi, s0, s1);
                                if (j == jd) mask_tile(s0, s1, 0, 32 * (wave & 1) + r32, hi);
                                softmax_pv(s0, s1, lds + (cb ? AL_V1 : AL_V0), o, m, l, r32, hi); } });
                    { const float inv = 1.f / fmaxf(xhalf_sum(l), 1e-30f); float ss = 0.f;
#pragma unroll
                      for (int dt = 0; dt < 2; ++dt)
#pragma unroll
                          for (int g = 0; g < 4; ++g) { const float v0 = o[dt][4 * g] * inv, v1 = o[dt][4 * g + 1] * inv, v2 = o[dt][4 * g + 2] * inv, v3 = o[dt][4 * g + 3] * inv; ss += v0 * v0 + v1 * v1 + v2 * v2 + v3 * v3;
                              u32x2 w; w.x = cvtpk(v0, v1); w.y = cvtpk(v2, v3); *(u32x2*)(Y + row * DM + 768 + h * 64 + 32 * dt + 8 * g + 4 * hi) = w; }
                      ss = xhalf_sum(ss); if (hi == 0) atomicAdd(ssq_d + row, ss); }
                    __syncthreads();
                }
            }
        }
        SEAM(pb + 2);
        if (IN(pb + 3)) {
        LAUNDER_TID();
            constexpr int N_J9 = 1024, N_J10 = 512, N_J11 = 256, N_P4 = N_J9 + N_J10 + N_J11;
            for (int it = bid; it < N_P4; it += G) {
                int r = it;
                if (r < N_J9) {
                    const int b = r >> 8, tb = r & 255, t0 = tb * 32, ch = tid & 255, half = tid >> 8;
                    LAS float* xa = ldsf; LAS float* xc = ldsf + 35 * 256;
                    for (int e = tid; e < 35 * 256; e += NTHR) { const int rr = e >> 8, c = e & 255, t = t0 - 3 + rr; float v = 0.f; if (t >= 0) v = bf2f(PB[(size_t)(b * SEQ + t) * NIN + C_AX + c]); xa[e] = v; }
                    __syncthreads();
                    { const float cw0 = inp(args, 4)[(l * 4 + 0) * 256 + ch], cw1 = inp(args, 4)[(l * 4 + 1) * 256 + ch], cw2 = inp(args, 4)[(l * 4 + 2) * 256 + ch], cw3 = inp(args, 4)[(l * 4 + 3) * 256 + ch], cb = inp(args, 5)[l * 256 + ch];
                      for (int tt = 0; tt < 16; ++tt) { const int rr = half * 16 + tt; xc[rr * 256 + ch] = cb + cw0 * xa[rr * 256 + ch] + cw1 * xa[(rr + 1) * 256 + ch] + cw2 * xa[(rr + 2) * 256 + ch] + cw3 * xa[(rr + 3) * 256 + ch]; } }
                    __syncthreads();
                    const int h = ch >> 6, cc = ch & 63;
                    LAS float* gR = ldsf + 67 * 256; LAS float* gI = gR + 32 * 256;
#pragma unroll 1
                    for (int pass = 0; pass < 2; ++pass) {
                        float wv[64]; const float* wsrc = (pass == 0 ? inp(args, 6) : inp(args, 8)) + ((size_t)(l * 4 + h) * 64) * 64 + cc; const float bias = (pass == 0 ? inp(args, 7) : inp(args, 9))[l * 256 + ch];
#pragma unroll
                        for (int i = 0; i < 64; ++i) wv[i] = wsrc[i * 64];
#pragma unroll 1
                        for (int tt = 0; tt < 16; ++tt) { const LAS f32x4* xr = (const LAS f32x4*)(xc + (half * 16 + tt) * 256 + h * 64); float a = bias;
#pragma unroll
                            for (int i4 = 0; i4 < 16; ++i4) { const f32x4 x = xr[i4]; a += x[0] * wv[4 * i4] + x[1] * wv[4 * i4 + 1] + x[2] * wv[4 * i4 + 2] + x[3] * wv[4 * i4 + 3]; }
                            (pass == 0 ? gR : gI)[(half * 16 + tt) * 256 + ch] = sigmoidf_(a); }
                    }
                    const float sp = log1pf(expf(-inp(args, 10)[l * 256 + ch]));
                    float hst = CIN[((size_t)(b * 512 + tb * 2 + half)) * 256 + ch];
#pragma unroll 1
                    for (int tt = 0; tt < 16; ++tt) {
                        const int rr = half * 16 + tt;
                        const float rg = gR[rr * 256 + ch], ig = gI[rr * 256 + ch], la = -8.f * rg * sp, av = expf(la), mult = sqrtf(-expm1f(2.f * la));
                        const float u = mult * (ig * xc[rr * 256 + ch]);
                        hst = av * hst + u;
                        const float gate = bf2f(PB[((size_t)b * SEQ + t0 + rr) * NIN + C_AG + ch]);
                        xa[rr * 256 + ch] = hst * gelu_tanh(gate);
                    }
                    __syncthreads();
                    for (int q = 0; q < 4; ++q) { const int rr = wave * 4 + q; const f32x4 v = ((const LAS f32x4*)(xa + rr * 256))[lane];
                        const float rinv = rsqrtf(wave_sum(v[0] * v[0] + v[1] * v[1] + v[2] * v[2] + v[3] * v[3]) * (1.f / 256.f) + EPS);
                        u32x2 w; w.x = pk2(v[0] * rinv, v[1] * rinv); w.y = pk2(v[2] * rinv, v[3] * rinv);
                        *(u32x2*)(Y + ((size_t)b * SEQ + t0 + rr) * DM + 4 * lane) = w; }
                    __syncthreads();
                    continue;
                }
                r -= N_J9;
                if (r < N_J10) {
                    const int b = r >> 7, c = r & 127; const size_t row0 = (size_t)b * SEQ + 64 * c;
                    LAS float* glr = ldsf; LAS float* bh = ldsf + 1024; LAS float* qh = bh + 2048; LAS float* kh = qh + 2048; LAS float* vh = kh + 2048; LAS float* Ah = vh + 4096; LAS float* Sh = Ah + 4096; LAS float* oall = Sh + 2048;
                    for (int e = tid; e < 1024; e += NTHR) glr[e] = bf2f(PB[(row0 + (e >> 4)) * NIN + C_GLR + (e & 15)]);
                    __syncthreads();
                    for (int h = 0; h < 4; ++h) {
                        for (int e = tid; e < 2048; e += NTHR) { const int t = e >> 5, k = e & 31, kk = h * 32 + k; float z = inp(args, 16)[l * 128 + kk];
#pragma unroll
                            for (int q = 0; q < 16; ++q) z += glr[t * 16 + q] * inp(args, 15)[(l * 16 + q) * 128 + kk];
                            bh[e] = (fminf(z, 0.f) - log1pf(expf(-fabsf(z)))) * (1.f / 16.f);
                            qh[e] = bf2f(PB[(row0 + t) * NIN + C_CQ + kk]) * 0.17677669529663687f; kh[e] = bf2f(PB[(row0 + t) * NIN + C_CK + kk]); }
                        for (int e = tid; e < 4096; e += NTHR) vh[e] = bf2f(PB[(row0 + (e >> 6)) * NIN + C_CV + h * 64 + (e & 63)]);
                        for (int e = tid; e < 2048; e += NTHR) Sh[e] = SST[((size_t)(b * 128 + c) * 4 + h) * 2048 + e];
                        __syncthreads();
                        if (tid < 32) { float run = 0.f; for (int t = 0; t < 64; ++t) { run += bh[t * 32 + tid]; bh[t * 32 + tid] = run; } }
                        __syncthreads();
                        for (int e = tid; e < 4096; e += NTHR) { const int i = e >> 6, j = e & 63; float a = 0.f;
                            if (j <= i) {
#pragma unroll 8
                                for (int k = 0; k < 32; ++k) a += qh[i * 32 + k] * kh[j * 32 + k] * __expf(bh[i * 32 + k] - bh[j * 32 + k]); }
                            Ah[e] = a; }
                        __syncthreads();
                        for (int e = tid; e < 2048; e += NTHR) qh[e] *= __expf(bh[e]);
                        __syncthreads();
                        { const int i = tid >> 3, v0 = (tid & 7) * 8; float a8[8] = {0.f, 0.f, 0.f, 0.f, 0.f, 0.f, 0.f, 0.f};
                          for (int k = 0; k < 32; ++k) { const float qe = qh[i * 32 + k]; const LAS f32x4* sp4 = (const LAS f32x4*)(Sh + k * 64 + v0); const f32x4 s0 = sp4[0], s1 = sp4[1];
                              a8[0] += qe * s0[0]; a8[1] += qe * s0[1]; a8[2] += qe * s0[2]; a8[3] += qe * s0[3]; a8[4] += qe * s1[0]; a8[5] += qe * s1[1]; a8[6] += qe * s1[2]; a8[7] += qe * s1[3]; }
                          for (int j = 0; j <= i; ++j) { const float aa = Ah[i * 64 + j]; const LAS f32x4* vp4 = (const LAS f32x4*)(vh + j * 64 + v0); const f32x4 s0 = vp4[0], s1 = vp4[1];
                              a8[0] += aa * s0[0]; a8[1] += aa * s0[1]; a8[2] += aa * s0[2]; a8[3] += aa * s0[3]; a8[4] += aa * s1[0]; a8[5] += aa * s1[1]; a8[6] += aa * s1[2]; a8[7] += aa * s1[3]; }
#pragma unroll
                          for (int q = 0; q < 8; ++q) oall[i * 256 + h * 64 + v0 + q] = a8[q]; }
                        __syncthreads();
                    }
                    for (int q = 0; q < 8; ++q) { const int t = wave * 8 + q; const f32x4 v = ((const LAS f32x4*)(oall + t * 256))[lane];
                        float ssh = v[0] * v[0] + v[1] * v[1] + v[2] * v[2] + v[3] * v[3];
                        ssh += __shfl_xor(ssh, 1); ssh += __shfl_xor(ssh, 2); ssh += __shfl_xor(ssh, 4); ssh += __shfl_xor(ssh, 8);
                        const float rh = rsqrtf(ssh * (1.f / 64.f) + EPS); float y[4]; float ss = 0.f;
                        const bf16_t* og = PB + (row0 + t) * NIN + C_OG + 4 * lane;
#pragma unroll
                        for (int i = 0; i < 4; ++i) { const float g = bf2f(og[i]); y[i] = v[i] * rh * inp(args, 17)[l * 64 + ((4 * lane + i) & 63)] * (g / (1.f + __expf(-g))); ss += y[i] * y[i]; }
                        const float rinv = rsqrtf(wave_sum(ss) * (1.f / 256.f) + EPS);
                        u32x2 w; w.x = pk2(y[0] * rinv, y[1] * rinv); w.y = pk2(y[2] * rinv, y[3] * rinv);
                        *(u32x2*)(Y + (row0 + t) * DM + 512 + 4 * lane) = w; }
                    __syncthreads();
                    continue;
                }
                r -= N_J10;
                {
                    for (int e = tid; e < 128 * 32; e += NTHR) { const size_t row = (size_t)r * 128 + (e >> 5); const int c8 = e & 31;
                        const float rinv = rsqrtf(ssq_d[row] * (1.f / 256.f) + EPS);
                        u32x4* p = (u32x4*)(Y + row * DM + 768 + 8 * c8); u32x4 w = *p;
                        w.x = pk2(bflo(w.x) * rinv, bfhi(w.x) * rinv); w.y = pk2(bflo(w.y) * rinv, bfhi(w.y) * rinv); w.z = pk2(bflo(w.z) * rinv, bfhi(w.z) * rinv); w.w = pk2(bflo(w.w) * rinv, bfhi(w.w) * rinv);
                        *p = w; }
                }
            }
        }
        SEAM(pb + 3);
        if (IN(pb + 4)) {
            pg8::Gemm g{Y, (const bf16_t*)(ws + WS_WOUT) + (size_t)l * DM * DM, M, DM, DM}; pg8::StaticOrder S; S.init(M, DM, G, bid);
            pg8::EpiResid E{l == 0 ? inp(args, 0) : (const float*)args.out, args.out, XB, ssq_out};
            pg8::gemm_phase<pg8::EpiResid, pg8::StaticOrder, true, true>(lds, g, S, E);
        }
        SEAM(pb + 4);
        if (IN(pb + 5)) {
            pg8::Gemm g{XB, (const bf16_t*)(ws + WS_WGU) + (size_t)l * NGU * DM, M, NGU, DM}; pg8::StaticOrder S; S.init(M, NGU, G, bid);
            pg8::EpiSwiglu E{ACT, ssq_out};
            pg8::gemm_phase<pg8::EpiSwiglu, pg8::StaticOrder, true, true>(lds, g, S, E);
        }
        SEAM(pb + 5);
        if (IN(pb + 6)) {
            pg8::Gemm g{ACT, (const bf16_t*)(ws + WS_WDN) + (size_t)l * DM * FF, M, DM, FF}; pg8::StaticOrder S; S.init(M, DM, G, bid);
            pg8::EpiResid E{(const float*)args.out, args.out, XB, ssq_down};
            pg8::gemm_phase<pg8::EpiResid, pg8::StaticOrder, true, true>(lds, g, S, E);
        }
        SEAM(pb + 6);
    }
    if (IN(15)) {
        LAUNDER_TID();
        const float* ssqf = acc_base + 3 * (size_t)M; const int gw = bid * 8 + wave, NGW = G * 8;
        for (int m = gw; m < M; m += NGW) {
            const float rinv = rsqrtf(ssqf[m] * (1.f / DM) + EPS);
            f32x4* xr = (f32x4*)(args.out + (size_t)m * DM) + lane; const f32x4* gn = (const f32x4*)inp(args, 27) + lane;
#pragma unroll
            for (int j = 0; j < 4; ++j) { f32x4 v = xr[64 * j]; const f32x4 g = gn[64 * j]; v = v * rinv * g; xr[64 * j] = v; }
        }
    }
#undef IN
#undef SEAM
}

extern "C" void kernel_launch(void* const* d_in, const int* in_sizes, int n_in, void* d_out, int out_size, void* d_ws, size_t ws_size, hipStream_t stream) {
    static int grid = 0;
    if (grid == 0) {
        if (n_in != 28 || in_sizes[0] != M * DM || out_size != M * DM || ws_size < WS_END) { fprintf(stderr, "kernel_launch: unexpected shapes (n_in %d, ws %zu)\n", n_in, ws_size); grid = -1; return; }
        int dev = 0, cus = 0;
        if (hipGetDevice(&dev) != hipSuccess || hipDeviceGetAttribute(&cus, hipDeviceAttributeMultiprocessorCount, dev) != hipSuccess) { grid = -1; return; }
        if (hipFuncSetAttribute((const void*)fwd, hipFuncAttributeMaxDynamicSharedMemorySize, LDS_BYTES) != hipSuccess) { fprintf(stderr, "kernel_launch: hipFuncSetAttribute failed\n"); grid = -1; return; }
        int per_cu = 0;
        if (hipOccupancyMaxActiveBlocksPerMultiprocessor(&per_cu, (const void*)fwd, NTHR, LDS_BYTES) != hipSuccess || per_cu < 1) fprintf(stderr, "kernel_launch: occupancy query says %d\n", per_cu);
        (void)hipGetLastError();
        grid = cus;
    }
    if (grid < 0) return;
    (void)hipMemsetAsync((char*)d_ws + WS_CTL, 0, CTL_ZERO_BYTES, stream);
    Args a{};
    for (int i = 0; i < 28; ++i) a.in[i] = (const float*)d_in[i];
    a.out = (float*)d_out; a.ws = (unsigned char*)d_ws;
    if (MK_N_LAUNCHES == 1) { a.ph_lo = 0; a.ph_hi = 16; hipLaunchKernelGGL(fwd, dim3(grid), dim3(NTHR), LDS_BYTES, stream, a); }
    else for (int p = 0; p < 16; ++p) { a.ph_lo = p; a.ph_hi = p + 1; hipLaunchKernelGGL(fwd, dim3(grid), dim3(NTHR), LDS_BYTES, stream, a); }
}
```

```cpp
#include <hip/hip_runtime.h>
#include <cstdio>
#include <cstdint>

#ifndef MK_N_LAUNCHES
#define MK_N_LAUNCHES 1
#endif

#define REP_P0 1
#define REP_G16 1
#define REP_P2 1
#define REP_ATT 1
#define REP_P4 1
#define LAS __attribute__((address_space(3)))
#define DI __device__ __forceinline__
typedef unsigned short bf16_t;
typedef short bf16x8 __attribute__((ext_vector_type(8)));
typedef float f32x4 __attribute__((ext_vector_type(4)));
typedef unsigned u32x4 __attribute__((ext_vector_type(4)));
typedef unsigned u32x2 __attribute__((ext_vector_type(2)));

constexpr int NB = 4, SEQ = 8192, M = NB * SEQ, DM = 1024, NIN = 2304, NINS = 2300, FF = 2816, NGU = 2 * FF;
constexpr float EPS = 1e-6f;
constexpr int C_AX = 0, C_AG = 256, C_BQ = 512, C_KC = 768, C_VC = 832, C_KS = 896, C_VS = 960, C_KW = 1024, C_VW = 1088, C_BG = 1152,
              C_CQ = 1164, C_CK = 1292, C_CV = 1420, C_GLR = 1676, C_OG = 1692, C_DCQ = 1948, C_DCKV = 2140, C_DKR = 2268;
constexpr size_t MiB = 1u << 20;
constexpr size_t WS_CTL = 0, CTL_ZERO_BYTES = 1 * MiB;
constexpr size_t WS_ACC = 64 * 1024;
constexpr size_t WS_SSQ0 = 1 * MiB;
constexpr size_t WS_HB = 1 * MiB + 256 * 1024;
constexpr size_t WS_WIN = 2 * MiB, WS_WOUT = 11 * MiB, WS_WGU = 15 * MiB, WS_WDN = 37 * MiB;
constexpr size_t WS_WUQT = 48 * MiB, WS_WUKVT = 48 * MiB + 512 * 1024, WS_W2T = 49 * MiB, WS_W1T = 50 * MiB;
constexpr size_t WS_CS64 = 64 * MiB, WS_CS32 = 72 * MiB;
constexpr size_t WS_XB = 80 * MiB, WS_Y = 144 * MiB, WS_PB = 208 * MiB, WS_ACT = 208 * MiB;
constexpr size_t WS_LA = 384 * MiB, WS_LH = 386 * MiB, WS_CIN = 388 * MiB;
constexpr size_t WS_KVC = 392 * MiB, WS_DEC = 408 * MiB, WS_SST = 410 * MiB;
constexpr size_t WS_MQ = 428 * MiB, WS_MKN = 452 * MiB, WS_MV = 468 * MiB, WS_MKR = 484 * MiB;
constexpr size_t WS_VST = 490 * MiB, WS_VWT = 494 * MiB, WS_KCMPB = 498 * MiB, WS_VCMPT = 499 * MiB, WS_END = 500 * MiB;
constexpr int CW_QUEUE = 64;
constexpr int CW_BAR = 4096;
constexpr int LDS_BYTES = 163840 - 256;
constexpr int LDS_CTL = LDS_BYTES - 64;
constexpr int NTHR = 512;

struct Args { const float* in[28]; float* out; unsigned char* ws; int ph_lo, ph_hi; };

DI float bf2f(bf16_t h) { return __uint_as_float(((unsigned)h) << 16); }
DI float bflo(unsigned u) { return __uint_as_float(u << 16); }
DI float bfhi(unsigned u) { return __uint_as_float(u & 0xffff0000u); }
DI bf16_t f2bf(float f) { unsigned u = __float_as_uint(f); return (bf16_t)((u + 0x7fffu + ((u >> 16) & 1u)) >> 16); }
DI unsigned pk2(float lo, float hi) { return (unsigned)f2bf(lo) | ((unsigned)f2bf(hi) << 16); }
DI float wave_sum(float v) {
#pragma unroll
    for (int o = 1; o < 64; o <<= 1) v += __shfl_xor(v, o);
    return v;
}
DI float wave_max(float v) {
#pragma unroll
    for (int o = 1; o < 64; o <<= 1) v = fmaxf(v, __shfl_xor(v, o));
    return v;
}
DI int wave_min_i(int v) {
#pragma unroll
    for (int o = 1; o < 64; o <<= 1) { int w = __shfl_xor(v, o); v = w < v ? w : v; }
    return v;
}
DI float sigmoidf_(float x) { return 1.f / (1.f + __expf(-x)); }
DI float gelu_tanh(float x) { const float u = 0.7978845608028654f * (x + 0.044715f * x * x * x); return 0.5f * x * (1.f + tanhf(u)); }
#define WSYNC() do { asm volatile("s_waitcnt lgkmcnt(0)" ::: "memory"); __builtin_amdgcn_wave_barrier(); } while (0)

namespace pg8 {
constexpr int BM = 256, BK = 64, HALF = 128, HTB = HALF * BK * 2, NXCD = 8, WGM = 8;
__host__ __device__ __forceinline__ int lds_byte(int r, int c) { const int st = (r >> 4) * 2 + (c >> 5), rr = r & 15, cc = c & 31, ob = rr * 64 + cc * 2; return st * 1024 + (ob ^ (((ob >> 9) & 1) << 5)); }
__host__ __device__ __forceinline__ void stage_rc(int b, int& R, int& C) { const int st = b / 1024, sb = b % 1024, swz = sb ^ (((sb >> 9) & 1) << 5); R = (st >> 1) * 16 + swz / 64; C = (st & 1) * 32 + (swz % 64) / 2; }
__host__ __device__ __forceinline__ int perm32(int rho) { const int n = rho >> 4, i = rho & 15; return 8 * (i >> 2) + 4 * n + (i & 3); }
struct Unit { int pm, pn; };
struct Gemm { const bf16_t* A; const bf16_t* Bt; int M, N, K; };
struct StaticOrder {
    int nM, nN, nwg, G, c;
    __host__ __device__ void init(int M_, int N_, int G_, int c_) { nM = M_ / BM; nN = N_ / BM; nwg = nM * nN; G = G_; c = c_; }
    __host__ __device__ bool next(int i, Unit& u) const {
        const long L = (long)i * G + c; if (L >= nwg) return false;
        int wgid = (int)L; { const int q = nwg / NXCD, r = nwg % NXCD, xcd = wgid % NXCD, off = wgid / NXCD; wgid = (xcd < r ? xcd * (q + 1) : r * (q + 1) + (xcd - r) * q) + off; }
        const int nig = WGM * nN, gid = wgid / nig, fm = gid * WGM, gsz = (nM - fm) < WGM ? (nM - fm) : WGM;
        u.pm = fm + ((wgid % nig) % gsz); u.pn = (wgid % nig) / gsz; return true;
    }
    __device__ __forceinline__ void a_ready(const Unit&) const {}
    __device__ __forceinline__ void done(const Unit&) const {}
};
DI unsigned cvt_pk_bf16(float lo, float hi) { unsigned r; asm volatile("v_cvt_pk_bf16_f32 %0, %1, %2" : "=v"(r) : "v"(lo), "v"(hi)); return r; }

struct EpiInProj {
    static constexpr bool PERM = true, AFTER_DRAIN = false;
    bf16_t* O; int ldc; const float* ssq;
    DI void operator()(const f32x4 (&acc)[2][2][4][2], const Unit& u, int wr, int wc, int fr, int fq) const {
        const int row0 = u.pm * BM + wr * 64 + fr, col0 = u.pn * BM + wc * 32 + 8 * fq;
#pragma unroll
        for (int ai = 0; ai < 2; ++ai)
#pragma unroll
            for (int m = 0; m < 4; ++m) {
                const int row = row0 + ai * HALF + m * 16;
                const float rinv = rsqrtf(ssq[row] * (1.f / DM) + EPS);
                bf16_t* rowp = O + (size_t)row * ldc + col0;
#pragma unroll
                for (int bj = 0; bj < 2; ++bj) {
                    f32x4 v0 = acc[ai][bj][m][0] * rinv, v1 = acc[ai][bj][m][1] * rinv;
                    u32x4 w; w.x = cvt_pk_bf16(v0[0], v0[1]); w.y = cvt_pk_bf16(v0[2], v0[3]); w.z = cvt_pk_bf16(v1[0], v1[1]); w.w = cvt_pk_bf16(v1[2], v1[3]);
                    *(u32x4*)(rowp + bj * HALF) = w;
                }
            }
    }
};
struct EpiResid {
    static constexpr bool PERM = true, AFTER_DRAIN = false;
    const float* xin; float* xout; bf16_t* xb; float* ssq_out;
    DI void operator()(const f32x4 (&acc)[2][2][4][2], const Unit& u, int wr, int wc, int fr, int fq) const {
        const int row0 = u.pm * BM + wr * 64 + fr, col0 = u.pn * BM + wc * 32 + 8 * fq;
#pragma unroll
        for (int ai = 0; ai < 2; ++ai)
#pragma unroll
            for (int m = 0; m < 4; ++m) {
                const int row = row0 + ai * HALF + m * 16;
                float part = 0.f;
#pragma unroll
                for (int bj = 0; bj < 2; ++bj) {
                    const size_t off = (size_t)row * DM + col0 + bj * HALF;
                    const f32x4 r0 = *(const f32x4*)(xin + off), r1 = *(const f32x4*)(xin + off + 4);
                    const f32x4 v0 = acc[ai][bj][m][0] + r0, v1 = acc[ai][bj][m][1] + r1;
                    *(f32x4*)(xout + off) = v0; *(f32x4*)(xout + off + 4) = v1;
                    u32x4 w; w.x = cvt_pk_bf16(v0[0], v0[1]); w.y = cvt_pk_bf16(v0[2], v0[3]); w.z = cvt_pk_bf16(v1[0], v1[1]); w.w = cvt_pk_bf16(v1[2], v1[3]);
                    *(u32x4*)(xb + off) = w;
                    part += v0[0] * v0[0] + v0[1] * v0[1] + v0[2] * v0[2] + v0[3] * v0[3] + v1[0] * v1[0] + v1[1] * v1[1] + v1[2] * v1[2] + v1[3] * v1[3];
                }
                part += __shfl_xor(part, 16); part += __shfl_xor(part, 32);
                if (fq == 0) atomicAdd(ssq_out + row, part);
            }
    }
};
struct EpiSwiglu {
    static constexpr bool PERM = true, AFTER_DRAIN = false;
    bf16_t* act; const float* ssq;
    DI void operator()(const f32x4 (&acc)[2][2][4][2], const Unit& u, int wr, int wc, int fr, int fq) const {
        const int row0 = u.pm * BM + wr * 64 + fr, j0 = u.pn * 128 + wc * 16 + 4 * fq;
#pragma unroll
        for (int ai = 0; ai < 2; ++ai)
#pragma unroll
            for (int m = 0; m < 4; ++m) {
                const int row = row0 + ai * HALF + m * 16;
                const float rinv = rsqrtf(ssq[row] * (1.f / DM) + EPS);
#pragma unroll
                for (int bj = 0; bj < 2; ++bj) {
                    const f32x4 g = acc[ai][bj][m][0] * rinv, up = acc[ai][bj][m][1] * rinv;
                    float a[4];
#pragma unroll
                    for (int i = 0; i < 4; ++i) a[i] = g[i] / (1.f + __expf(-g[i])) * up[i];
                    u32x2 w; w.x = cvt_pk_bf16(a[0], a[1]); w.y = cvt_pk_bf16(a[2], a[3]);
                    *(u32x2*)(act + (size_t)row * FF + j0 + bj * 64) = w;
                }
            }
    }
};

template <class Epi, class Sched, bool ALIGN_EPI = false, bool SP2 = false>
DI void gemm_phase(LAS unsigned char* lds, const Gemm g, const Sched& S, const Epi& E) {
    int tid_ = threadIdx.x; asm volatile("" : "+v"(tid_));
    const int tid = tid_, wid = __builtin_amdgcn_readfirstlane(tid >> 6), lane = tid & 63, wr = wid >> 2, wc = wid & 3, fr = lane & 15, fq = lane >> 4;
    const int K = g.K, nt = K / BK;
    unsigned voffA[2], voffB[2];
#pragma unroll
    for (int i = 0; i < 2; ++i) { int R, C; stage_rc(tid * 16 + i * 8192, R, C); const int Rb = Epi::PERM ? ((R & ~31) + perm32(R & 31)) : R;
        voffA[i] = (unsigned)(R * K + C) * 2u; voffB[i] = (unsigned)(Rb * K + C) * 2u; }
    const size_t kstep = (size_t)(BK * 2);
    const size_t hstep = (size_t)HALF * K * 2;
    const size_t tstep = 2 * hstep;
    const unsigned ldsw = (unsigned)wid * 1024u;
    const int aoff = lds_byte(wr * 64 + fr, fq * 8), boff = lds_byte(wc * 32 + fr, fq * 8);
#define PG8_SA(b, h) (((b) * 2 + (h)) * HTB)
#define PG8_SB(b, h) ((4 + (b) * 2 + (h)) * HTB)
#define PG8_STAGE(bufoff, gbase, voff) do { _Pragma("unroll") for (int _i = 0; _i < 2; ++_i) \
        __builtin_amdgcn_global_load_lds((const unsigned*)((const char*)(gbase) + (voff)[_i]), (LAS unsigned*)(lds + (bufoff) + ldsw + _i * 8192), 16, 0, 0); } while (0)
#define PG8_LDA(dst, b, h) do { _Pragma("unroll") for (int m = 0; m < 4; ++m) _Pragma("unroll") for (int k = 0; k < 2; ++k) dst[m][k] = *(const LAS bf16x8*)(lds + PG8_SA(b, h) + aoff + m * 2048 + k * 1024); } while (0)
#define PG8_LDB(dst, b, h) do { _Pragma("unroll") for (int n = 0; n < 2; ++n) _Pragma("unroll") for (int k = 0; k < 2; ++k) dst[n][k] = *(const LAS bf16x8*)(lds + PG8_SB(b, h) + boff + n * 2048 + k * 1024); } while (0)
#define PG8_MMA(ai, bj, At, Bt) do { __builtin_amdgcn_s_setprio(1); _Pragma("unroll") for (int m = 0; m < 4; ++m) _Pragma("unroll") for (int n = 0; n < 2; ++n) _Pragma("unroll") for (int k = 0; k < 2; ++k) \
        acc[ai][bj][m][n] = __builtin_amdgcn_mfma_f32_16x16x32_bf16(Bt[n][k], At[m][k], acc[ai][bj][m][n], 0, 0, 0); __builtin_amdgcn_s_setprio(0); } while (0)
#define PG8_WAIT_V(n) asm volatile("s_waitcnt vmcnt(" #n ")" ::: "memory")
#define PG8_WAIT_L(n) asm volatile("s_waitcnt lgkmcnt(" #n ")" ::: "memory")
#define PG8_BAR __builtin_amdgcn_s_barrier()
#define PG8_SCHED __builtin_amdgcn_sched_barrier(0)
    Unit cur, nxt; int ui = 0;
    if (!S.next(0, cur)) return;
    f32x4 acc[2][2][4][2];
#pragma unroll
    for (int a = 0; a < 2; ++a)
#pragma unroll
        for (int b = 0; b < 2; ++b)
#pragma unroll
            for (int m = 0; m < 4; ++m)
#pragma unroll
                for (int n = 0; n < 2; ++n) acc[a][b][m][n] = (f32x4){0.f, 0.f, 0.f, 0.f};
    bf16x8 At[4][2], B0[2][2], B1[2][2];
    const char* cA = (const char*)g.A + (size_t)cur.pm * tstep; const char* cB = (const char*)g.Bt + (size_t)cur.pn * tstep;
    S.a_ready(cur);
    if constexpr (SP2) {
        PG8_STAGE(PG8_SB(0, 0), cB, voffB); PG8_STAGE(PG8_SB(0, 1), cB + hstep, voffB); PG8_STAGE(PG8_SA(0, 0), cA, voffA); PG8_STAGE(PG8_SA(0, 1), cA + hstep, voffA);
        if (wr == 1) PG8_BAR;
        PG8_WAIT_V(2); PG8_BAR;
        PG8_STAGE(PG8_SB(1, 0), cB + kstep, voffB); PG8_STAGE(PG8_SA(1, 0), cA + kstep, voffA); PG8_STAGE(PG8_SB(1, 1), cB + hstep + kstep, voffB);
        PG8_WAIT_V(6); PG8_BAR;
    } else {
        PG8_STAGE(PG8_SB(0, 0), cB, voffB); PG8_STAGE(PG8_SA(0, 0), cA, voffA); PG8_STAGE(PG8_SB(0, 1), cB + hstep, voffB); PG8_STAGE(PG8_SA(0, 1), cA + hstep, voffA);
        if (wr == 1) PG8_BAR;
        PG8_WAIT_V(4); PG8_BAR;
        PG8_STAGE(PG8_SB(1, 0), cB + kstep, voffB); PG8_STAGE(PG8_SA(1, 0), cA + kstep, voffA); PG8_STAGE(PG8_SB(1, 1), cB + hstep + kstep, voffB);
        PG8_WAIT_V(6); PG8_BAR;
    }
    for (;;) {
        const bool has_next = S.next(ui + 1, nxt);
        const char* nA = has_next ? (const char*)g.A + (size_t)nxt.pm * tstep : cA; const char* nB = has_next ? (const char*)g.Bt + (size_t)nxt.pn * tstep : cB;
        for (int t = 0; t < nt; t += 2) {
            const bool last = (t == nt - 2);
            const char* a1 = cA + (size_t)(t + 1) * kstep;
            const char* a2 = last ? nA : cA + (size_t)(t + 2) * kstep; const char* b2 = last ? nB : cB + (size_t)(t + 2) * kstep;
            const char* a3 = a2 + kstep; const char* b3 = b2 + kstep;
            if (last && has_next) S.a_ready(nxt);
            if constexpr (SP2) {
            PG8_LDB(B0, 0, 0); PG8_LDB(B1, 0, 1); PG8_SCHED; PG8_LDA(At, 0, 0); PG8_STAGE(PG8_SA(1, 1), a1 + hstep, voffA);
            PG8_WAIT_V(8); PG8_WAIT_L(0); PG8_BAR; PG8_MMA(0, 0, At, B0); PG8_MMA(0, 1, At, B1); PG8_BAR; PG8_SCHED;
            PG8_LDA(At, 0, 1); PG8_STAGE(PG8_SB(0, 0), b2, voffB); PG8_STAGE(PG8_SB(0, 1), b2 + hstep, voffB); PG8_STAGE(PG8_SA(0, 0), a2, voffA);
            PG8_WAIT_V(8); PG8_WAIT_L(0); PG8_BAR; PG8_MMA(1, 0, At, B0); PG8_MMA(1, 1, At, B1); PG8_BAR; PG8_SCHED;
            PG8_LDB(B0, 1, 0); PG8_LDB(B1, 1, 1); PG8_SCHED; PG8_LDA(At, 1, 0); PG8_STAGE(PG8_SA(0, 1), a2 + hstep, voffA);
            PG8_WAIT_V(8); PG8_WAIT_L(0); PG8_BAR; PG8_MMA(0, 0, At, B0); PG8_MMA(0, 1, At, B1); PG8_BAR; PG8_SCHED;
            PG8_LDA(At, 1, 1); PG8_STAGE(PG8_SB(1, 0), b3, voffB); PG8_STAGE(PG8_SB(1, 1), b3 + hstep, voffB); PG8_STAGE(PG8_SA(1, 0), a3, voffA);
            PG8_WAIT_V(8); PG8_WAIT_L(0); PG8_BAR; PG8_MMA(1, 0, At, B0); PG8_MMA(1, 1, At, B1); PG8_BAR; PG8_SCHED;
            } else {
            PG8_LDB(B0, 0, 0); PG8_SCHED; PG8_LDA(At, 0, 0); PG8_STAGE(PG8_SA(1, 1), a1 + hstep, voffA);
            PG8_WAIT_L(8); PG8_BAR; PG8_WAIT_L(0); PG8_MMA(0, 0, At, B0); PG8_BAR; PG8_SCHED;
            PG8_LDB(B1, 0, 1); PG8_STAGE(PG8_SB(0, 0), b2, voffB);
            PG8_BAR; PG8_WAIT_L(0); PG8_MMA(0, 1, At, B1); PG8_BAR;
            PG8_LDA(At, 0, 1); PG8_STAGE(PG8_SA(0, 0), a2, voffA);
            PG8_BAR; PG8_WAIT_L(0); PG8_MMA(1, 0, At, B0); PG8_BAR; PG8_SCHED;
            PG8_STAGE(PG8_SB(0, 1), b2 + hstep, voffB);
            PG8_WAIT_V(6); PG8_BAR; PG8_MMA(1, 1, At, B1); PG8_BAR;
            PG8_LDB(B0, 1, 0); PG8_SCHED; PG8_LDA(At, 1, 0); PG8_STAGE(PG8_SA(0, 1), a2 + hstep, voffA);
            PG8_WAIT_L(8); PG8_BAR; PG8_WAIT_L(0); PG8_MMA(0, 0, At, B0); PG8_BAR; PG8_SCHED;
            PG8_LDB(B1, 1, 1); PG8_STAGE(PG8_SB(1, 0), b3, voffB);
            PG8_BAR; PG8_WAIT_L(0); PG8_MMA(0, 1, At, B1); PG8_BAR;
            PG8_LDA(At, 1, 1); PG8_STAGE(PG8_SA(1, 0), a3, voffA);
            PG8_BAR; PG8_WAIT_L(0); PG8_MMA(1, 0, At, B0); PG8_BAR; PG8_SCHED;
            PG8_STAGE(PG8_SB(1, 1), b3 + hstep, voffB);
            PG8_WAIT_V(6); PG8_BAR; PG8_MMA(1, 1, At, B1); PG8_BAR;
            }
        }
        if constexpr (ALIGN_EPI) { if (wr == 0) PG8_BAR; }
        if constexpr (!Epi::AFTER_DRAIN) { E(acc, cur, wr, wc, fr, fq); S.done(cur); }
        if (!has_next) break;
#pragma unroll
        for (int a = 0; a < 2; ++a)
#pragma unroll
            for (int b = 0; b < 2; ++b)
#pragma unroll
                for (int m = 0; m < 4; ++m)
#pragma unroll
                    for (int n = 0; n < 2; ++n) acc[a][b][m][n] = (f32x4){0.f, 0.f, 0.f, 0.f};
        cur = nxt; cA = nA; cB = nB; ++ui;
        if constexpr (ALIGN_EPI) { if (wr == 1) PG8_BAR; }
    }
    PG8_WAIT_V(0);
    if constexpr (!ALIGN_EPI) { if (wr == 0) PG8_BAR; }
    PG8_BAR;
#undef PG8_SA
#undef PG8_SB
#undef PG8_STAGE
#undef PG8_LDA
#undef PG8_LDB
#undef PG8_MMA
#undef PG8_WAIT_V
#undef PG8_WAIT_L
#undef PG8_BAR
#undef PG8_SCHED
}
}

#define XB_TMO      128
#define XB_XCNT(j)  (256  + 64 * (j))
#define XB_XSUB(j)  (1280 + 64 * (j))
#define XB_XGEN(j)  (2304 + 64 * (j))
#define XB_TOP      3328
#define XB_TOPGEN   3392
#define XCD_BAR_WORDS 3456
#define XB_SPIN_CAP (1u << 18)
__device__ __forceinline__ unsigned xb_ld(unsigned* p)              { return __hip_atomic_load(p, __ATOMIC_RELAXED, __HIP_MEMORY_SCOPE_AGENT); }
__device__ __forceinline__ unsigned xb_add(unsigned* p, unsigned v) { return __hip_atomic_fetch_add(p, v, __ATOMIC_RELAXED, __HIP_MEMORY_SCOPE_AGENT); }
__device__ __forceinline__ unsigned xb_xcc_id() { return (unsigned)__builtin_amdgcn_s_getreg((3 << 11) | 20) & 0xFu; }
#define XB_SPIN(cond, bar) do { unsigned _sp = 0; while (cond) { __builtin_amdgcn_s_sleep(1); \
    if ((++_sp & 255u) == 0u) { if (xb_ld(&(bar)[XB_TMO])) break; if (_sp > XB_SPIN_CAP) { atomicAdd(&(bar)[XB_TMO], 1u); break; } } } } while (0)
struct XcdBarrier { unsigned* bar; unsigned x; volatile LAS unsigned* st; };
__device__ __forceinline__ XcdBarrier xcd_barrier_post(unsigned* bar, volatile LAS unsigned* st) {
    XcdBarrier b; b.bar = bar; b.x = xb_xcc_id(); b.st = st;
    if (threadIdx.x == 0) (void)xb_add(&bar[XB_XCNT(b.x)], 1u);
    return b;
}
__device__ __forceinline__ void xcd_barrier_complete(unsigned* bar, unsigned x, unsigned& nloc, unsigned& nx) {
    const unsigned G = gridDim.x * gridDim.y * gridDim.z;
    unsigned sum, cnt, mine, sp = 0u;
    for (;;) {
        sum = 0u; cnt = 0u; mine = 0u;
#pragma unroll
        for (unsigned j = 0; j < 16; ++j) { const unsigned c = xb_ld(&bar[XB_XCNT(j)]); sum += c; cnt += (c > 0u) ? 1u : 0u; mine = (j == x) ? c : mine; }
        if (sum == G) break;
        __builtin_amdgcn_s_sleep(1);
        if ((++sp & 255u) == 0u) { if (xb_ld(&bar[XB_TMO])) break; if (sp > XB_SPIN_CAP) { atomicAdd(&bar[XB_TMO], 1u); break; } }
    }
    nloc = mine > 0u ? mine : 1u; nx = cnt > 0u ? cnt : 1u;
}
__device__ __forceinline__ void xcd_barrier(const XcdBarrier& b) {
    asm volatile("s_waitcnt vmcnt(0)" ::: "memory");
    __syncthreads();
    if (threadIdx.x == 0) {
        unsigned* bar = b.bar;
        __builtin_amdgcn_s_waitcnt(0);
        unsigned nloc = b.st[0], nx = b.st[1];
        if (nloc == 0u) { xcd_barrier_complete(bar, b.x, nloc, nx); b.st[0] = nloc; b.st[1] = nx; }
        const unsigned old = xb_add(&bar[XB_XSUB(b.x)], 1u);
        const unsigned gen = old / nloc;
        if (old + 1u == (gen + 1u) * nloc) {
            __builtin_amdgcn_fence(__ATOMIC_RELEASE, "agent");
            asm volatile("s_waitcnt vmcnt(0)" ::: "memory");
            const unsigned og = xb_add(&bar[XB_TOP], 1u);
            const unsigned tg = og / nx;
            if (og + 1u == (tg + 1u) * nx) xb_add(&bar[XB_TOPGEN], 1u);
            else XB_SPIN(xb_ld(&bar[XB_TOPGEN]) == tg, bar);
            __builtin_amdgcn_fence(__ATOMIC_ACQUIRE, "agent");
            xb_add(&bar[XB_XGEN(b.x)], 1u);
            asm volatile("s_waitcnt vmcnt(0)" ::: "memory");
        } else {
            XB_SPIN(xb_ld(&bar[XB_XGEN(b.x)]) == gen, bar);
            __builtin_amdgcn_fence(__ATOMIC_ACQUIRE, "agent");
            asm volatile("s_waitcnt vmcnt(0)" ::: "memory");
        }
    }
    __syncthreads();
}

template <int MAP>
DI int colmap(int v, int Nsrc) {
    if (MAP == 0) return v < Nsrc ? v : -1;
    const int g8 = v >> 3, e = v & 7, j = 4 * g8 + (e & 3); return (e < 4) ? j : FF + j;
}
template <int MAP>
DI void p0_transpose_item(const float* W, int K, int Nsrc, const float* gain, bf16_t* WT, LAS float* scr, int kb, int nb, int lane) {
    const int k0 = 64 * kb, n0 = 32 * nb;
    const int sc = colmap<MAP>(n0 + (lane & 31), Nsrc);
#pragma unroll 8
    for (int i = 0; i < 32; ++i) { const int kk = 2 * i + (lane >> 5); float w = 0.f; if (sc >= 0) w = W[(size_t)(k0 + kk) * Nsrc + sc]; if (gain) w *= gain[k0 + kk]; scr[kk * 33 + (lane & 31)] = w; }
    WSYNC();
    const int c = lane & 7;
#pragma unroll
    for (int j = 0; j < 4; ++j) { const int n = (lane >> 3) + 8 * j; const LAS float* s = scr + (8 * c) * 33 + n;
        u32x4 o; o.x = pk2(s[0 * 33], s[1 * 33]); o.y = pk2(s[2 * 33], s[3 * 33]); o.z = pk2(s[4 * 33], s[5 * 33]); o.w = pk2(s[6 * 33], s[7 * 33]);
        *(u32x4*)(WT + (size_t)(n0 + n) * K + k0 + 8 * c) = o; }
    WSYNC();
}


typedef float f32x16 __attribute__((ext_vector_type(16)));
typedef float f32x2v __attribute__((ext_vector_type(2)));
typedef __bf16 bf16x2_t __attribute__((ext_vector_type(2)));
constexpr int KSTR = 208, VSTR = 136;
constexpr int AL_K0 = 0, AL_K1 = 64 * KSTR, AL_V0 = 2 * 64 * KSTR, AL_V1 = AL_V0 + 64 * VSTR, AL_IMP = 45056, AL_SELM = AL_IMP + 32768, AL_OACC = AL_SELM + 1024;
constexpr float NEGB = -1e30f, LOG2E = 1.4426950408889634f;
DI unsigned cvtpk(float lo, float hi) { f32x2v v = {lo, hi}; bf16x2_t b = __builtin_convertvector(v, bf16x2_t); return __builtin_bit_cast(unsigned, b); }
DI f32x16 mfma32(bf16x8 a, bf16x8 b, f32x16 c) { return __builtin_amdgcn_mfma_f32_32x32x16_bf16(a, b, c, 0, 0, 0); }
DI float xhalf_max(float v) { auto rr = __builtin_amdgcn_permlane32_swap(__float_as_uint(v), __float_as_uint(v), false, false); return fmaxf(__uint_as_float(rr[0]), __uint_as_float(rr[1])); }
DI float xhalf_sum(float v) { auto rr = __builtin_amdgcn_permlane32_swap(__float_as_uint(v), __float_as_uint(v), false, false); return __uint_as_float(rr[0]) + __uint_as_float(rr[1]); }
DI float ex2(float x) { return __builtin_amdgcn_exp2f(x); }
template <int KSTEPS>
DI void qk_tile(const LAS unsigned char* Kt, const bf16x8 (&qf)[KSTEPS], int r32, int hi, f32x16& s0, f32x16& s1) {
    const LAS unsigned char* p0 = Kt + r32 * KSTR + hi * 16;
#pragma unroll
    for (int i = 0; i < 16; ++i) { s0[i] = 0.f; s1[i] = 0.f; }
#pragma unroll
    for (int ks = 0; ks < KSTEPS; ++ks) {
        const bf16x8 a0 = *(const LAS bf16x8*)(p0 + ks * 32), a1 = *(const LAS bf16x8*)(p0 + 32 * KSTR + ks * 32);
        s0 = mfma32(a0, qf[ks], s0); s1 = mfma32(a1, qf[ks], s1);
    }
}
DI void mask_tile(f32x16& s0, f32x16& s1, int klo, int khi, int hi) {
    const int lo_ = klo - 4 * hi, hi_ = khi - 4 * hi;
#pragma unroll
    for (int i = 0; i < 16; ++i) { const int kb = (i & 3) + 8 * (i >> 2); if (kb < lo_ || kb > hi_) s0[i] = NEGB; if (kb + 32 < lo_ || kb + 32 > hi_) s1[i] = NEGB; }
}
DI float tile_max(const f32x16& s0, const f32x16& s1) {
    float mx = fmaxf(s0[0], s1[0]);
#pragma unroll
    for (int i = 1; i < 16; ++i) mx = fmaxf(mx, fmaxf(s0[i], s1[i]));
    return xhalf_max(mx);
}
template <int BASE> DI bf16x8 pack8(const f32x16& s) { u32x4 p; p.x = cvtpk(s[BASE], s[BASE + 1]); p.y = cvtpk(s[BASE + 2], s[BASE + 3]); p.z = cvtpk(s[BASE + 4], s[BASE + 5]); p.w = cvtpk(s[BASE + 6], s[BASE + 7]); return __builtin_bit_cast(bf16x8, p); }
DI bf16x8 ld8x2(const bf16_t* p) { const u32x2 a = *(const u32x2*)p, b = *(const u32x2*)(p + 4); u32x4 w; w.x = a.x; w.y = a.y; w.z = b.x; w.w = b.y; return __builtin_bit_cast(bf16x8, w); }
DI bf16x8 vfrag(const LAS unsigned char* p) { const u32x2 a = *(const LAS u32x2*)p, b = *(const LAS u32x2*)(p + 16); u32x4 w; w.x = a.x; w.y = a.y; w.z = b.x; w.w = b.y; return __builtin_bit_cast(bf16x8, w); }
DI void pv_tile(const f32x16& s0, const f32x16& s1, const LAS unsigned char* Vt, f32x16 (&o)[2], int r32, int hi) {
    const bf16x8 p00 = pack8<0>(s0), p01 = pack8<8>(s0), p10 = pack8<0>(s1), p11 = pack8<8>(s1);
#pragma unroll
    for (int dt = 0; dt < 2; ++dt) { const LAS unsigned char* vp = Vt + (32 * dt + r32) * VSTR + 8 * hi;
        o[dt] = mfma32(vfrag(vp), p00, o[dt]); o[dt] = mfma32(vfrag(vp + 32), p01, o[dt]); o[dt] = mfma32(vfrag(vp + 64), p10, o[dt]); o[dt] = mfma32(vfrag(vp + 96), p11, o[dt]); }
}
DI void softmax_pv(f32x16& s0, f32x16& s1, const LAS unsigned char* Vt, f32x16 (&o)[2], float& m, float& l, int r32, int hi) {
    const float mx = tile_max(s0, s1), mn = fmaxf(m, mx), ms = mn < -1e29f ? 0.f : mn, alpha = ex2(m - ms);
    m = mn; float psum = 0.f;
#pragma unroll
    for (int i = 0; i < 16; ++i) { s0[i] = ex2(s0[i] - ms); s1[i] = ex2(s1[i] - ms); psum += s0[i] + s1[i]; }
    l = l * alpha + psum;
#pragma unroll
    for (int i = 0; i < 16; ++i) { o[0][i] *= alpha; o[1][i] *= alpha; }
    pv_tile(s0, s1, Vt, o, r32, hi);
}
template <class LoadF, class StoreF, class StepF>
DI void attn_pipeline(int jbeg, int jend, LoadF ld, StoreF st, StepF step) {
    if (jbeg > jend) return;
    ld(jbeg); st(0); __syncthreads();
    for (int j = jbeg; j <= jend; ++j) { const int cb = (j - jbeg) & 1;
        if (j < jend) ld(j + 1);
        step(j, cb);
        if (j < jend) st(cb ^ 1);
        __syncthreads(); }
}

DI const float* inp(const Args& a, int k) { asm volatile("" : "+s"(k)); return a.in[k]; }
__global__ void __launch_bounds__(NTHR, 2) fwd(Args args) {
    extern __shared__ __attribute__((aligned(16))) unsigned char lds_raw[];
    LAS unsigned char* lds = (LAS unsigned char*)lds_raw;
    LAS float* ldsf = (LAS float*)lds;
    volatile LAS unsigned* LCTL = (volatile LAS unsigned*)(lds + LDS_CTL);
    const int tid0 = threadIdx.x, wave = __builtin_amdgcn_readfirstlane(tid0 >> 6);
    const int G = gridDim.x, bid = blockIdx.x;
#define LAUNDER_TID() int tid = tid0; asm volatile("" : "+v"(tid)); const int lane = tid & 63; (void)lane
    unsigned char* ws = args.ws;
    unsigned* ctl = (unsigned*)(ws + WS_CTL);
    float* acc_base = (float*)(ws + WS_ACC);
    float* ssq0 = (float*)(ws + WS_SSQ0);
    float* hb = (float*)(ws + WS_HB);
    bf16_t* XB = (bf16_t*)(ws + WS_XB); bf16_t* Y = (bf16_t*)(ws + WS_Y); bf16_t* PB = (bf16_t*)(ws + WS_PB); bf16_t* ACT = (bf16_t*)(ws + WS_ACT);
    const float2* cs64 = (const float2*)(ws + WS_CS64); const float2* cs32 = (const float2*)(ws + WS_CS32);
    float* LA = (float*)(ws + WS_LA); float* LH = (float*)(ws + WS_LH); float* CIN = (float*)(ws + WS_CIN);
    float* KVC = (float*)(ws + WS_KVC); float* DEC = (float*)(ws + WS_DEC); float* SST = (float*)(ws + WS_SST);
    bf16_t* MQ = (bf16_t*)(ws + WS_MQ); bf16_t* MKN = (bf16_t*)(ws + WS_MKN); bf16_t* MVT = (bf16_t*)(ws + WS_MV); bf16_t* MKR = (bf16_t*)(ws + WS_MKR);
    bf16_t* VST = (bf16_t*)(ws + WS_VST); bf16_t* VWT = (bf16_t*)(ws + WS_VWT); bf16_t* KCMPB = (bf16_t*)(ws + WS_KCMPB); bf16_t* VCMPT = (bf16_t*)(ws + WS_VCMPT);
    const int* positions = (const int*)inp(args, 1);

    { LAUNDER_TID(); if (tid < 16) LCTL[tid] = 0u; }
    __syncthreads();
    const int lo = args.ph_lo, hi = args.ph_hi;
    XcdBarrier bar; bar.bar = ctl + CW_BAR; bar.x = 0; bar.st = LCTL;
    if (hi - lo > 1) bar = xcd_barrier_post(ctl + CW_BAR, LCTL);
#define IN(k) (lo <= (k) && (k) < hi)
#define SEAM(k) do { if (IN(k) && IN((k) + 1)) xcd_barrier(bar); } while (0)

    if (IN(0)) {
      _Pragma("unroll 1") for (int rep = 0; rep < REP_P0; ++rep) {
        LAUNDER_TID();
        const int gw = bid * 8 + wave, NGW = G * 8;
        LAS float* scr = ldsf + wave * 4096;
        constexpr int I_IN = 16 * 72, I_OUT = 16 * 32, I_GU = 16 * 176, I_DN = 44 * 32, I_L = I_IN + I_OUT + I_GU + I_DN;
        for (int it = gw; it < 2 * I_L; it += NGW) {
            const int l = it / I_L; int r = it % I_L;
            if (r < I_IN) { p0_transpose_item<0>(inp(args, 3) + (size_t)l * DM * NINS, DM, NINS, inp(args, 2) + l * DM, (bf16_t*)(ws + WS_WIN) + (size_t)l * NIN * DM, scr, r / 72, r % 72, lane); continue; } r -= I_IN;
            if (r < I_OUT) { p0_transpose_item<0>(inp(args, 23) + (size_t)l * DM * DM, DM, DM, inp(args, 22) + l * DM, (bf16_t*)(ws + WS_WOUT) + (size_t)l * DM * DM, scr, r / 32, r % 32, lane); continue; } r -= I_OUT;
            if (r < I_GU) { p0_transpose_item<1>(inp(args, 25) + (size_t)l * DM * NGU, DM, NGU, inp(args, 24) + l * DM, (bf16_t*)(ws + WS_WGU) + (size_t)l * NGU * DM, scr, r / 176, r % 176, lane); continue; } r -= I_GU;
            p0_transpose_item<0>(inp(args, 26) + (size_t)l * FF * DM, FF, DM, nullptr, (bf16_t*)(ws + WS_WDN) + (size_t)l * DM * FF, scr, r / 32, r % 32, lane);
        }
        { constexpr int I_UQ = 3 * 12, I_UKV = 2 * 16, I_W1 = 32 * 8, I_W2 = 4 * 2, I_S = 2 * I_UQ + 2 * I_UKV + 4 * I_W1 + 4 * I_W2;
          for (int it = gw; it < I_S; it += NGW) { int r = it;
              if (r < 2 * I_UQ) { const int l = r / I_UQ; r %= I_UQ; p0_transpose_item<0>(inp(args, 20) + (size_t)l * 192 * 384, 192, 384, inp(args, 18) + l * 192, (bf16_t*)(ws + WS_WUQT) + (size_t)l * 384 * 192, scr, r / 12, r % 12, lane); continue; } r -= 2 * I_UQ;
              if (r < 2 * I_UKV) { const int l = r / I_UKV; r %= I_UKV; p0_transpose_item<0>(inp(args, 21) + (size_t)l * 128 * 512, 128, 512, inp(args, 19) + l * 128, (bf16_t*)(ws + WS_WUKVT) + (size_t)l * 512 * 128, scr, r / 16, r % 16, lane); continue; } r -= 2 * I_UKV;
              if (r < 4 * I_W1) { const int lj = r / I_W1; r %= I_W1; p0_transpose_item<0>(inp(args, 12) + (size_t)lj * 2048 * 256, 2048, 256, nullptr, (bf16_t*)(ws + WS_W1T) + (size_t)lj * 256 * 2048, scr, r / 8, r % 8, lane); continue; } r -= 4 * I_W1;
              { const int lj = r / I_W2; r %= I_W2; p0_transpose_item<0>(inp(args, 14) + (size_t)lj * 256 * 64, 256, 64, nullptr, (bf16_t*)(ws + WS_W2T) + (size_t)lj * 64 * 256, scr, r / 2, r % 2, lane); } } }
        for (int m = gw; m < M; m += NGW) {
            const f32x4* xr = (const f32x4*)(inp(args, 0) + (size_t)m * DM) + lane;
            f32x4 v[4]; float s = 0.f;
#pragma unroll
            for (int j = 0; j < 4; ++j) { v[j] = xr[64 * j]; s += v[j][0] * v[j][0] + v[j][1] * v[j][1] + v[j][2] * v[j][2] + v[j][3] * v[j][3]; }
            s = wave_sum(s);
            u32x2* o8 = (u32x2*)(XB + (size_t)m * DM) + lane;
#pragma unroll
            for (int j = 0; j < 4; ++j) { u32x2 w; w.x = pk2(v[j][0], v[j][1]); w.y = pk2(v[j][2], v[j][3]); o8[64 * j] = w; }
            if (lane == 0) ssq0[m] = s;
        }
        for (int e = bid * NTHR + tid; e < M * 32; e += G * NTHR) {
            const int m = e >> 5, i = e & 31; const float pos = (float)positions[m];
            const float invf = powf(10000.f, -(float)(2 * i) / 64.f); float sn, cs; sincosf(pos * invf, &sn, &cs);
            ((float2*)(ws + WS_CS64))[e] = make_float2(cs, sn);
            if (i < 16) { const float invf2 = powf(10000.f, -(float)(2 * i) / 32.f); sincosf(pos * invf2, &sn, &cs); ((float2*)(ws + WS_CS32))[m * 16 + i] = make_float2(cs, sn); }
        }
        for (int e = bid * NTHR + tid; e < 2 * 2 * 256; e += G * NTHR) {
            const int lj = e >> 8, c = e & 255; float a = inp(args, 13)[e];
            const float* pp = inp(args, 11) + (size_t)lj * 2048; const float* w1 = inp(args, 12) + (size_t)lj * 2048 * 256 + c;
            for (int i = 0; i < 2048; ++i) a += pp[i] * w1[(size_t)i * 256];
            hb[e] = a;
        }
      }
    }
    SEAM(0);

    for (int l = 0; l < 2; ++l) {
        const int pb = 1 + 7 * l;
        const float* ssq_mix = (l == 0) ? ssq0 : acc_base + 2 * M;
        float* ssq_out = acc_base + (size_t)l * M;
        float* ssq_down = acc_base + (size_t)(2 + l) * M;
        float* ssq_d = acc_base + (size_t)(4 + l) * M;
        if (IN(pb)) {
            pg8::Gemm g{XB, (const bf16_t*)(ws + WS_WIN) + (size_t)l * NIN * DM, M, NIN, DM}; pg8::StaticOrder S; S.init(M, NIN, G, bid);
            pg8::EpiInProj E{PB, NIN, ssq_mix};
            _Pragma("unroll 1") for (int rep = 0; rep < REP_G16; ++rep) pg8::gemm_phase<pg8::EpiInProj, pg8::StaticOrder, true, true>(lds, g, S, E);
        }
        SEAM(pb);
        if (IN(pb + 1)) {
        LAUNDER_TID();
            constexpr int N_J1 = 1024, N_J2 = 512, N_J3 = 512, N_J4 = 512, N_J4B = 128;
            _Pragma("unroll 1") for (int rep = 0; rep < REP_P2; ++rep) {
            for (int r = bid; r < N_J4B; r += G) {
                    const int j = r & 1, g32 = (r >> 1) & 15, b = r >> 5; const int colb = j == 0 ? C_KC : C_VC; const int r32 = lane & 31, hi = lane >> 5;
                    LAS unsigned char* Tl = lds;
                    LAS unsigned char* Hl = lds + 69632;
                    for (int e = tid; e < 528 * 8; e += NTHR) { const int rr = e >> 3, c8 = e & 7, t = 512 * g32 + rr; u32x4 w = {0u, 0u, 0u, 0u};
                        if (t < SEQ) { const bf16_t* pr = PB + ((size_t)b * SEQ + t) * NIN + colb;
                            if (j == 0) { const u32x4 a = *(const u32x4*)(pr + 8 * (c8 & 3)), c = *(const u32x4*)(pr + 32 + 8 * (c8 & 3)); const float2* cs = cs64 + ((size_t)b * SEQ + t) * 32 + 8 * (c8 & 3);
                                const unsigned au[4] = {a.x, a.y, a.z, a.w}, cu[4] = {c.x, c.y, c.z, c.w}; unsigned ou[4];
#pragma unroll
                                for (int q = 0; q < 4; ++q) { const float2 s0 = cs[2 * q], s1 = cs[2 * q + 1]; const float x1a = bflo(au[q]), x1b = bfhi(au[q]), x2a = bflo(cu[q]), x2b = bfhi(cu[q]);
                                    ou[q] = c8 < 4 ? pk2(x1a * s0.x - x2a * s0.y, x1b * s1.x - x2b * s1.y) : pk2(x2a * s0.x + x1a * s0.y, x2b * s1.x + x1b * s1.y); }
                                w.x = ou[0]; w.y = ou[1]; w.z = ou[2]; w.w = ou[3]; }
                            else w = *(const u32x4*)(pr + 8 * c8); }
                        *(LAS u32x4*)(Tl + rr * 128 + (rr >> 4) * 16 + c8 * 16) = w; }
                    __syncthreads();
                    { const bf16_t* w1t = (const bf16_t*)(ws + WS_W1T) + ((size_t)(l * 2 + j) * 256 + 32 * wave + r32) * 2048 + 8 * hi;
                      f32x16 acc;
#pragma unroll
                      for (int i = 0; i < 16; ++i) acc[i] = 0.f;
#pragma unroll 8
                      for (int kk = 0; kk < 128; ++kk) { const int rowt = 16 * r32 + (kk >> 2);
                          const bf16x8 a = *(const LAS bf16x8*)(Tl + rowt * 128 + (rowt >> 4) * 16 + 32 * (kk & 3) + 16 * hi);
                          const bf16x8 bw = *(const bf16x8*)(w1t + 16 * kk);
                          acc = mfma32(a, bw, acc); }
                      const float hbv = hb[(l * 2 + j) * 256 + 32 * wave + r32];
#pragma unroll
                      for (int i = 0; i < 16; ++i) { const int n = (i & 3) + 8 * (i >> 2) + 4 * hi; *(LAS bf16_t*)(Hl + n * 528 + (32 * wave + r32) * 2) = f2bf(gelu_tanh(acc[i] + hbv)); } }
                    __syncthreads();
                    if (wave < 2) { const bf16_t* w2t = (const bf16_t*)(ws + WS_W2T) + ((size_t)(l * 2 + j) * 64 + 32 * wave + r32) * 256 + 8 * hi;
                      f32x16 acc;
#pragma unroll
                      for (int i = 0; i < 16; ++i) acc[i] = 0.f;
#pragma unroll
                      for (int kk = 0; kk < 16; ++kk) { const bf16x8 a = *(const LAS bf16x8*)(Hl + r32 * 528 + 32 * kk + 16 * hi); const bf16x8 bw = *(const bf16x8*)(w2t + 16 * kk); acc = mfma32(a, bw, acc); }
                      const int dd = 32 * wave + r32;
#pragma unroll
                      for (int g = 0; g < 4; ++g) { const int n0 = 32 * g32 + 8 * g + 4 * hi; float v[4];
#pragma unroll
                          for (int q = 0; q < 4; ++q) v[q] = (n0 + q < 511) ? acc[4 * g + q] : 0.f;
                          if (j == 0) {
#pragma unroll
                              for (int q = 0; q < 4; ++q) KCMPB[((size_t)b * 512 + n0 + q) * 64 + dd] = f2bf(v[q]); }
                          else { u32x2 w; w.x = pk2(v[0], v[1]); w.y = pk2(v[2], v[3]); *(u32x2*)(VCMPT + ((size_t)b * 64 + dd) * 512 + n0) = w; } } }
                    __syncthreads();
            }
            if (bid < N_J3) {
                const int fr = lane & 15, kq = lane >> 4, hh = wave >> 1, odd = wave & 1;
                {
                    bf16x8 bq[3][6];
                    { const bf16_t* wq = (const bf16_t*)(ws + WS_WUQT) + (size_t)l * 384 * 192;
#pragma unroll
                      for (int nt = 0; nt < 3; ++nt)
#pragma unroll
                          for (int ks = 0; ks < 6; ++ks) bq[nt][ks] = *(const bf16x8*)(wq + (size_t)(48 * wave + 16 * nt + fr) * 192 + 32 * ks + 8 * kq); }
                    for (int r = bid; r < N_J3; r += G) {
                        const size_t row0 = (size_t)r * 64;
#pragma unroll 1
                        for (int mt = 0; mt < 4; ++mt) {
                            const bf16_t* pa = PB + (row0 + mt * 16 + fr) * NIN;
                            bf16x8 aq[6]; float ssq_ = 0.f;
#pragma unroll
                            for (int ks = 0; ks < 6; ++ks) { aq[ks] = ld8x2(pa + C_DCQ + 32 * ks + 8 * kq);
#pragma unroll
                                for (int e = 0; e < 8; ++e) { const float v = bf2f((bf16_t)aq[ks][e]); ssq_ += v * v; } }
                            ssq_ += __shfl_xor(ssq_, 16); ssq_ += __shfl_xor(ssq_, 32);
                            const float rq_ = rsqrtf(ssq_ * (1.f / 192.f) + EPS);
                            f32x4 cq[3];
#pragma unroll
                            for (int nt = 0; nt < 3; ++nt) { cq[nt] = (f32x4){0.f, 0.f, 0.f, 0.f};
#pragma unroll
                                for (int ks = 0; ks < 6; ++ks) cq[nt] = __builtin_amdgcn_mfma_f32_16x16x32_bf16(aq[ks], bq[nt][ks], cq[nt], 0, 0, 0); }
                            const float SCQ = 0.10206207261596575f * LOG2E;
#pragma unroll
                            for (int i = 0; i < 4; ++i) {
                                const size_t row = row0 + mt * 16 + 4 * kq + i; const float rqi = __shfl(rq_, 4 * kq + i) * SCQ;
                                float q0 = cq[0][i] * rqi, q1 = cq[1][i] * rqi, q2 = cq[2][i] * rqi;
                                if (odd) { const float2 cs = cs32[row * 16 + fr]; const float x1 = q1, x2 = q2; q1 = x1 * cs.x - x2 * cs.y; q2 = x2 * cs.x + x1 * cs.y; }
                                bf16_t* mq = MQ + row * 384 + hh * 96 + 48 * odd + fr; mq[0] = f2bf(q0); mq[16] = f2bf(q1); mq[32] = f2bf(q2);
                            }
                            if (wave == mt) {
#pragma unroll
                                for (int q = 0; q < 4; ++q) { const int p = lane * 4 + q, tok = p >> 4, i = p & 15; const size_t row = row0 + mt * 16 + tok; const bf16_t* pr = PB + row * NIN + C_DKR;
                                    const float x1 = bf2f(pr[i]), x2 = bf2f(pr[16 + i]); const float2 cs = cs32[row * 16 + i];
                                    MKR[row * 32 + i] = f2bf(x1 * cs.x - x2 * cs.y); MKR[row * 32 + 16 + i] = f2bf(x2 * cs.x + x1 * cs.y); } }
                        }
                    }
                }
                {
                    bf16x8 bkv[4][4];
                    { const bf16_t* wkv = (const bf16_t*)(ws + WS_WUKVT) + (size_t)l * 512 * 128;
#pragma unroll
                      for (int nt = 0; nt < 4; ++nt)
#pragma unroll
                          for (int ks = 0; ks < 4; ++ks) bkv[nt][ks] = *(const bf16x8*)(wkv + (size_t)(64 * wave + 16 * nt + fr) * 128 + 32 * ks + 8 * kq); }
                    for (int r = bid; r < N_J3; r += G) {
                        const size_t row0 = (size_t)r * 64; const size_t bb = row0 / SEQ, t0 = row0 % SEQ;
#pragma unroll 1
                        for (int mt = 0; mt < 4; ++mt) {
                            const bf16_t* pa = PB + (row0 + mt * 16 + fr) * NIN;
                            bf16x8 akv[4]; float sskv_ = 0.f;
#pragma unroll
                            for (int ks = 0; ks < 4; ++ks) { akv[ks] = ld8x2(pa + C_DCKV + 32 * ks + 8 * kq);
#pragma unroll
                                for (int e = 0; e < 8; ++e) { const float v = bf2f((bf16_t)akv[ks][e]); sskv_ += v * v; } }
                            sskv_ += __shfl_xor(sskv_, 16); sskv_ += __shfl_xor(sskv_, 32);
                            const float rk_ = rsqrtf(sskv_ * (1.f / 128.f) + EPS);
                            f32x4 ckv[4];
#pragma unroll
                            for (int nt = 0; nt < 4; ++nt) { ckv[nt] = (f32x4){0.f, 0.f, 0.f, 0.f};
#pragma unroll
                                for (int ks = 0; ks < 4; ++ks) ckv[nt] = __builtin_amdgcn_mfma_f32_16x16x32_bf16(akv[ks], bkv[nt][ks], ckv[nt], 0, 0, 0); }
                            float rki[4];
#pragma unroll
                            for (int i = 0; i < 4; ++i) rki[i] = __shfl(rk_, 4 * kq + i);
                            if (!odd) {
#pragma unroll
                                for (int i = 0; i < 4; ++i) { bf16_t* mk = MKN + (row0 + mt * 16 + 4 * kq + i) * 256 + hh * 64 + fr;
                                    mk[0] = f2bf(ckv[0][i] * rki[i]); mk[16] = f2bf(ckv[1][i] * rki[i]); mk[32] = f2bf(ckv[2][i] * rki[i]); mk[48] = f2bf(ckv[3][i] * rki[i]); } }
                            else {
#pragma unroll
                                for (int nt = 0; nt < 4; ++nt) { u32x2 w; w.x = pk2(ckv[nt][0] * rki[0], ckv[nt][1] * rki[1]); w.y = pk2(ckv[nt][2] * rki[2], ckv[nt][3] * rki[3]);
                                    *(u32x2*)(MVT + ((bb * 4 + hh) * 64 + 16 * nt + fr) * SEQ + t0 + mt * 16 + 4 * kq) = w; } }
                        }
                    }
                }
            }
            for (int r = bid; r < N_J1; r += G) {
                    const int b = r >> 8, tb = r & 255, t0 = tb * 32, ch = tid & 255, half = tid >> 8;
                    LAS float* xa = ldsf; LAS float* xc = ldsf + 35 * 256;
                    for (int e = tid; e < 35 * 256; e += NTHR) { const int rr = e >> 8, c = e & 255, t = t0 - 3 + rr; float v = 0.f; if (t >= 0) v = bf2f(PB[(size_t)(b * SEQ + t) * NIN + C_AX + c]); xa[e] = v; }
                    __syncthreads();
                    { const float cw0 = inp(args, 4)[(l * 4 + 0) * 256 + ch], cw1 = inp(args, 4)[(l * 4 + 1) * 256 + ch], cw2 = inp(args, 4)[(l * 4 + 2) * 256 + ch], cw3 = inp(args, 4)[(l * 4 + 3) * 256 + ch], cb = inp(args, 5)[l * 256 + ch];
                      for (int tt = 0; tt < 16; ++tt) { const int rr = half * 16 + tt; xc[rr * 256 + ch] = cb + cw0 * xa[rr * 256 + ch] + cw1 * xa[(rr + 1) * 256 + ch] + cw2 * xa[(rr + 2) * 256 + ch] + cw3 * xa[(rr + 3) * 256 + ch]; } }
                    __syncthreads();
                    const int h = ch >> 6, cc = ch & 63;
                    LAS float* gR = ldsf + 67 * 256; LAS float* gI = gR + 32 * 256;
#pragma unroll 1
                    for (int pass = 0; pass < 2; ++pass) {
                        float wv[64]; const float* wsrc = (pass == 0 ? inp(args, 6) : inp(args, 8)) + ((size_t)(l * 4 + h) * 64) * 64 + cc; const float bias = (pass == 0 ? inp(args, 7) : inp(args, 9))[l * 256 + ch];
#pragma unroll
                        for (int i = 0; i < 64; ++i) wv[i] = wsrc[i * 64];
#pragma unroll 1
                        for (int tt = 0; tt < 16; ++tt) { const LAS f32x4* xr = (const LAS f32x4*)(xc + (half * 16 + tt) * 256 + h * 64); float a = bias;
#pragma unroll
                            for (int i4 = 0; i4 < 16; ++i4) { const f32x4 x = xr[i4]; a += x[0] * wv[4 * i4] + x[1] * wv[4 * i4 + 1] + x[2] * wv[4 * i4 + 2] + x[3] * wv[4 * i4 + 3]; }
                            (pass == 0 ? gR : gI)[(half * 16 + tt) * 256 + ch] = sigmoidf_(a); }
                    }
                    const float sp = log1pf(expf(-inp(args, 10)[l * 256 + ch]));
                    float hst = 0.f, Ac = 1.f;
#pragma unroll 1
                    for (int tt = 0; tt < 16; ++tt) {
                        const int rr = half * 16 + tt;
                        const float rg = gR[rr * 256 + ch], ig = gI[rr * 256 + ch], la = -8.f * rg * sp, av = expf(la), mult = sqrtf(-expm1f(2.f * la));
                        const float u = mult * (ig * xc[rr * 256 + ch]);
                        hst = av * hst + u; Ac *= av;
                    }
                    const size_t so = ((size_t)(b * 512 + tb * 2 + half)) * 256 + ch;
                    LA[so] = Ac; LH[so] = hst;
                    __syncthreads();
            }
            for (int r = bid; r < N_J2; r += G) {
                    const int b = r >> 7, c = r & 127; const size_t row0 = (size_t)b * SEQ + 64 * c;
                    LAS float* glr = ldsf; LAS float* bb = ldsf + 1024; LAS float* kt = bb + 8192; LAS float* vv = kt + 8192;
                    for (int e = tid; e < 1024; e += NTHR) glr[e] = bf2f(PB[(row0 + (e >> 4)) * NIN + C_GLR + (e & 15)]);
                    __syncthreads();
                    for (int e = tid; e < 8192; e += NTHR) { const int t = e >> 7, kk = e & 127; float z = inp(args, 16)[l * 128 + kk];
#pragma unroll
                        for (int q = 0; q < 16; ++q) z += glr[t * 16 + q] * inp(args, 15)[(l * 16 + q) * 128 + kk];
                        bb[e] = (fminf(z, 0.f) - log1pf(expf(-fabsf(z)))) * (1.f / 16.f); }
                    __syncthreads();
                    if (tid < 128) { float run = 0.f; for (int t = 0; t < 64; ++t) { run += bb[t * 128 + tid]; bb[t * 128 + tid] = run; } }
                    __syncthreads();
                    for (int e = tid; e < 8192; e += NTHR) { const int t = e >> 7, kk = e & 127; kt[e] = bf2f(PB[(row0 + t) * NIN + C_CK + kk]) * expf(bb[63 * 128 + kk] - bb[e]); }
                    for (int e = tid; e < 16384; e += NTHR) vv[e] = bf2f(PB[(row0 + (e >> 8)) * NIN + C_CV + (e & 255)]);
                    __syncthreads();
                    { const int h = tid >> 7, k = (tid >> 2) & 31, v0 = (tid & 3) * 16; float a16[16];
#pragma unroll
                      for (int i = 0; i < 16; ++i) a16[i] = 0.f;
                      for (int t = 0; t < 64; ++t) { const float kv = kt[t * 128 + h * 32 + k]; const LAS f32x4* vp = (const LAS f32x4*)(vv + t * 256 + h * 64 + v0);
#pragma unroll
                          for (int i = 0; i < 4; ++i) { const f32x4 x = vp[i]; a16[4 * i] += kv * x[0]; a16[4 * i + 1] += kv * x[1]; a16[4 * i + 2] += kv * x[2]; a16[4 * i + 3] += kv * x[3]; } }
                      float* o = KVC + ((size_t)(b * 128 + c) * 4 + h) * 2048 + k * 64 + v0;
#pragma unroll
                      for (int i = 0; i < 16; ++i) o[i] = a16[i];
                      if (tid < 128) DEC[(size_t)(b * 128 + c) * 128 + tid] = expf(bb[63 * 128 + tid]); }
                    __syncthreads();
            }
            if (rep == 0) for (int r = bid; r < N_J4; r += G) {
                    const size_t row0 = (size_t)r * 64;
                    for (int e = tid; e < 64 * 192; e += NTHR) { const int tok = e / 192, p = e % 192, i = p & 31; const int base = p < 128 ? C_BQ + (p >> 5) * 64 : (p < 160 ? C_KS : C_KW); const float sc = p < 128 ? 0.125f * LOG2E : 1.f;
                        bf16_t* pr = PB + (row0 + tok) * NIN + base; const float x1 = bf2f(pr[i]), x2 = bf2f(pr[32 + i]); const float2 cs = cs64[(row0 + tok) * 32 + i];
                        pr[i] = f2bf((x1 * cs.x - x2 * cs.y) * sc); pr[32 + i] = f2bf((x2 * cs.x + x1 * cs.y) * sc); }
                    { LAS bf16_t* tl = (LAS bf16_t*)lds; const size_t bb = row0 / SEQ, t0 = row0 % SEQ;
                      for (int mtx = 0; mtx < 2; ++mtx) { const int tok = tid >> 3, c = tid & 7; const u32x4 w = *(const u32x4*)(PB + (row0 + tok) * NIN + (mtx ? C_VW : C_VS) + c * 8);
                          LAS bf16_t* dst = tl + mtx * 64 * 72 + tok * 72 + c * 8; dst[0] = (bf16_t)w.x; dst[1] = (bf16_t)(w.x >> 16); dst[2] = (bf16_t)w.y; dst[3] = (bf16_t)(w.y >> 16); dst[4] = (bf16_t)w.z; dst[5] = (bf16_t)(w.z >> 16); dst[6] = (bf16_t)w.w; dst[7] = (bf16_t)(w.w >> 16); }
                      __syncthreads();
                      for (int mtx = 0; mtx < 2; ++mtx) { const int d = tid >> 3, c8 = tid & 7; const LAS bf16_t* s = tl + mtx * 64 * 72 + (c8 * 8) * 72 + d;
                          u32x4 w; w.x = (unsigned)s[0] | ((unsigned)s[72] << 16); w.y = (unsigned)s[2 * 72] | ((unsigned)s[3 * 72] << 16); w.z = (unsigned)s[4 * 72] | ((unsigned)s[5 * 72] << 16); w.w = (unsigned)s[6 * 72] | ((unsigned)s[7 * 72] << 16);
                          *(u32x4*)((mtx ? VWT : VST) + (bb * 64 + d) * SEQ + t0 + c8 * 8) = w; }
                      __syncthreads(); }
            }
            }
        }
        SEAM(pb + 1);
        if (IN(pb + 2)) {
        LAUNDER_TID();
            constexpr int Q_J5 = 2, Q_J6 = 64, Q_ATT = 1024, Q_TOT = Q_J5 + Q_J6 + Q_ATT;
            for (;;) {
                if (tid == 0) LCTL[2] = __hip_atomic_fetch_add(ctl + CW_QUEUE + 64 * l, 1u, __ATOMIC_RELAXED, __HIP_MEMORY_SCOPE_AGENT);
                __syncthreads();
                int r = __builtin_amdgcn_readfirstlane((int)LCTL[2]);
                __syncthreads();
                if (r >= Q_TOT) break;
                if (r < Q_J5) {
                    const int e = r * NTHR + tid, b = e >> 8, ch = e & 255; float carry = 0.f;
                    for (int c0 = 0; c0 < 512; c0 += 8) { float av[8], hv[8];
#pragma unroll
                        for (int q = 0; q < 8; ++q) { const size_t so = ((size_t)(b * 512 + c0 + q)) * 256 + ch; av[q] = LA[so]; hv[q] = LH[so]; }
#pragma unroll
                        for (int q = 0; q < 8; ++q) { CIN[((size_t)(b * 512 + c0 + q)) * 256 + ch] = carry; carry = av[q] * carry + hv[q]; } }
                    continue;
                }
                r -= Q_J5;
                if (r < Q_J6) {
                    const int e = r * NTHR + tid, b = e >> 13, rem = e & 8191; float Sv = 0.f;
                    for (int c0 = 0; c0 < 128; c0 += 8) { float kv[8], dv[8];
#pragma unroll
                        for (int q = 0; q < 8; ++q) { kv[q] = KVC[(size_t)(b * 128 + c0 + q) * 8192 + rem]; dv[q] = DEC[(size_t)(b * 128 + c0 + q) * 128 + (rem >> 6)]; }
#pragma unroll
                        for (int q = 0; q < 8; ++q) { SST[(size_t)(b * 128 + c0 + q) * 8192 + rem] = Sv; Sv = dv[q] * Sv + kv[q]; } }
                    continue;
                }
                r -= Q_J6;
                const int r32 = lane & 31, hi = lane >> 5;
                const int grp = r >> 5, within = r & 31;
              _Pragma("unroll 1") for (int rep = 0; rep < REP_ATT; ++rep) {
                if (within >= 16) {
                    const int idx = within - 16, b = idx & 3, tb = 127 - (4 * grp + (idx >> 2));
                    const int tl = 8 * wave + (r32 >> 2), head = r32 & 3, T = 64 * tb + tl; const size_t row = (size_t)b * SEQ + T; const bf16_t* prow = PB + row * NIN;
                    bf16x8 qf[4];
#pragma unroll
                    for (int ks = 0; ks < 4; ++ks) qf[ks] = *(const bf16x8*)(prow + C_BQ + head * 64 + 16 * ks + 8 * hi);
                    const float g0 = sigmoidf_(bf2f(prow[C_BG + head * 3])), g1 = sigmoidf_(bf2f(prow[C_BG + head * 3 + 1])), g2 = sigmoidf_(bf2f(prow[C_BG + head * 3 + 2]));
                    LAS float* impb = (LAS float*)(lds + AL_IMP) + wave * 1024; LAS unsigned* selm = (LAS unsigned*)(lds + AL_SELM) + wave * 32;
                    u32x4 rk, rv;
                    const int skey = tid >> 3, sch = tid & 7;
                    auto stK = [&](int buf) { *(LAS u32x4*)(lds + (buf ? AL_K1 : AL_K0) + skey * KSTR + sch * 16) = rk; };
                    auto stKV = [&](int buf) { *(LAS u32x4*)(lds + (buf ? AL_K1 : AL_K0) + skey * KSTR + sch * 16) = rk;
                        LAS unsigned char* vd = lds + (buf ? AL_V1 : AL_V0) + skey * VSTR + sch * 16; u32x2 a, c; a.x = rv.x; a.y = rv.y; c.x = rv.z; c.y = rv.w; *(LAS u32x2*)vd = a; *(LAS u32x2*)(vd + 8) = c; };
                    f32x16 oacc[2], ob[2];
                    const int nv = T >= 31 ? ((T - 31) >> 4) + 1 : 0, ntc = (4 * tb + 3 + 63) >> 6;
                    float mC = NEGB, lC = 0.f;
                    { const bf16_t* kb_ = KCMPB + (size_t)b * 512 * 64;
                      attn_pipeline(0, ntc - 1, [&](int j) { rk = *(const u32x4*)(kb_ + (size_t)(64 * j + skey) * 64 + sch * 8); }, stK,
                        [&](int j, int cb) { f32x16 s0, s1; qk_tile<4>(lds + (cb ? AL_K1 : AL_K0), qf, r32, hi, s0, s1); mask_tile(s0, s1, 0, nv - 1 - 64 * j, hi);
                            const float mx = tile_max(s0, s1), mn = fmaxf(mC, mx), ms = mn < -1e29f ? 0.f : mn, alpha = ex2(mC - ms); mC = mn; float ps = 0.f;
#pragma unroll
                            for (int i = 0; i < 16; ++i) ps += ex2(s0[i] - ms) + ex2(s1[i] - ms);
                            lC = lC * alpha + ps; }); }
                    { const float invC = 1.f / fmaxf(xhalf_sum(lC), 1e-30f), msC = mC < -1e29f ? 0.f : mC; float carry = 0.f;
#pragma unroll
                      for (int i = 0; i < 16; ++i) { ob[0][i] = 0.f; ob[1][i] = 0.f; }
                      const bf16_t* kb_ = KCMPB + (size_t)b * 512 * 64; const bf16_t* vb_ = VCMPT + (size_t)b * 64 * 512;
                      attn_pipeline(0, ntc - 1, [&](int j) { rk = *(const u32x4*)(kb_ + (size_t)(64 * j + skey) * 64 + sch * 8); rv = *(const u32x4*)(vb_ + (size_t)skey * 512 + 64 * j + sch * 8); }, stKV,
                        [&](int j, int cb) { f32x16 s0, s1; qk_tile<4>(lds + (cb ? AL_K1 : AL_K0), qf, r32, hi, s0, s1); mask_tile(s0, s1, 0, nv - 1 - 64 * j, hi);
#pragma unroll
                            for (int i = 0; i < 16; ++i) { s0[i] = ex2(s0[i] - msC) * invC; s1[i] = ex2(s1[i] - msC) * invC; }
                            float gs[8], pl[8];
#pragma unroll
                            for (int q = 0; q < 4; ++q) { gs[q] = (s0[4 * q] + s0[4 * q + 1]) + (s0[4 * q + 2] + s0[4 * q + 3]); gs[4 + q] = (s1[4 * q] + s1[4 * q + 1]) + (s1[4 * q + 2] + s1[4 * q + 3]);
                                pl[q] = __shfl_xor(s0[4 * q + 3], 32); pl[4 + q] = __shfl_xor(s1[4 * q + 3], 32); }
#pragma unroll
                            for (int q = 0; q < 8; ++q) { const float prev = hi ? pl[q] : (q > 0 ? pl[q > 0 ? q - 1 : 0] : carry); float x = gs[q] + prev; x += __shfl_xor(x, 1); x += __shfl_xor(x, 2);
                                if ((r32 & 3) == 0) impb[(r32 >> 2) * 128 + 16 * j + 2 * q + hi] = x; }
                            carry = pl[7];
                            pv_tile(s0, s1, lds + (cb ? AL_V1 : AL_V0), ob, r32, hi); }); }
                    LAS float* oav = (LAS float*)(lds + AL_OACC) + tid;
#pragma unroll
                    for (int i = 0; i < 16; ++i) { oav[i * 512] = g0 * ob[0][i]; oav[(16 + i) * 512] = g0 * ob[1][i]; }
                    WSYNC();
                    for (int tk = 0; tk < 8; ++tk) {
                        const int cur = tb, j0 = lane, j1 = lane + 64; LAS float* sb = impb + tk * 128; const float im0 = sb[j0], im1 = sb[j1];
                        const float s0 = (j0 == 0 || j0 == cur || j0 == cur - 1) ? 1e9f : (j0 <= cur ? im0 : -1e30f);
                        const float s1 = (j1 == cur || j1 == cur - 1) ? 1e9f : (j1 <= cur ? im1 : -1e30f);
                        WSYNC(); sb[j0] = s0; sb[j1] = s1; WSYNC();
                        int rk0 = 0, rk1 = 0;
#pragma unroll 4
                        for (int c4 = 0; c4 < 32; ++c4) { const f32x4 v = ((const LAS f32x4*)sb)[c4];
#pragma unroll
                            for (int q = 0; q < 4; ++q) { const int jj = 4 * c4 + q; const float x = v[q];
                                rk0 += (x > s0 || (x == s0 && jj < j0)) ? 1 : 0; rk1 += (x > s1 || (x == s1 && jj < j1)) ? 1 : 0; } }
                        const unsigned long long m0 = __ballot(rk0 < 16), m1 = __ballot(rk1 < 16);
                        if (lane == 0) { selm[tk * 4] = (unsigned)m0; selm[tk * 4 + 1] = (unsigned)(m0 >> 32); selm[tk * 4 + 2] = (unsigned)m1; selm[tk * 4 + 3] = (unsigned)(m1 >> 32); }
                    }
                    WSYNC();
                    const unsigned sm0 = selm[(r32 >> 2) * 4], sm1 = selm[(r32 >> 2) * 4 + 1], sm2 = selm[(r32 >> 2) * 4 + 2], sm3 = selm[(r32 >> 2) * 4 + 3];
                    { float mB = NEGB, lB = 0.f;
#pragma unroll
                      for (int i = 0; i < 16; ++i) { ob[0][i] = 0.f; ob[1][i] = 0.f; }
                      const bf16_t* kb_ = PB + (size_t)b * SEQ * NIN + C_KS; const bf16_t* vb_ = VST + (size_t)b * 64 * SEQ;
                      attn_pipeline(0, tb, [&](int j) { rk = *(const u32x4*)(kb_ + (size_t)(64 * j + skey) * NIN + sch * 8); rv = *(const u32x4*)(vb_ + (size_t)skey * SEQ + 64 * j + sch * 8); }, stKV,
                        [&](int j, int cb) { const unsigned wsel = j < 32 ? sm0 : (j < 64 ? sm1 : (j < 96 ? sm2 : sm3)); const bool bit = (wsel >> (j & 31)) & 1u;
                            if (__any(bit)) { f32x16 s0, s1; qk_tile<4>(lds + (cb ? AL_K1 : AL_K0), qf, r32, hi, s0, s1);
                                if (j == tb || !__all(bit)) mask_tile(s0, s1, bit ? 0 : 64, j == tb ? tl : 63, hi);
                                softmax_pv(s0, s1, lds + (cb ? AL_V1 : AL_V0), ob, mB, lB, r32, hi); } });
                      const float sc = g1 / fmaxf(xhalf_sum(lB), 1e-30f);
#pragma unroll
                      for (int i = 0; i < 16; ++i) { oav[i * 512] += sc * ob[0][i]; oav[(16 + i) * 512] += sc * ob[1][i]; } }
                    { float mB = NEGB, lB = 0.f;
#pragma unroll
                      for (int i = 0; i < 16; ++i) { ob[0][i] = 0.f; ob[1][i] = 0.f; }
                      const bf16_t* kb_ = PB + (size_t)b * SEQ * NIN + C_KW; const bf16_t* vb_ = VWT + (size_t)b * 64 * SEQ;
                      attn_pipeline(tb >= 8 ? tb - 8 : 0, tb, [&](int j) { rk = *(const u32x4*)(kb_ + (size_t)(64 * j + skey) * NIN + sch * 8); rv = *(const u32x4*)(vb_ + (size_t)skey * SEQ + 64 * j + sch * 8); }, stKV,
                        [&](int j, int cb) { f32x16 s0, s1; qk_tile<4>(lds + (cb ? AL_K1 : AL_K0), qf, r32, hi, s0, s1);
                            if (j == tb || j == tb - 8) mask_tile(s0, s1, j == tb - 8 ? tl + 1 : 0, j == tb ? tl : 63, hi);
                            softmax_pv(s0, s1, lds + (cb ? AL_V1 : AL_V0), ob, mB, lB, r32, hi); });
                      const float sc = g2 / fmaxf(xhalf_sum(lB), 1e-30f);
#pragma unroll
                      for (int i = 0; i < 16; ++i) { oacc[0][i] = oav[i * 512] + sc * ob[0][i]; oacc[1][i] = oav[(16 + i) * 512] + sc * ob[1][i]; } }
                    { float ss = 0.f;
#pragma unroll
                      for (int i = 0; i < 16; ++i) ss += oacc[0][i] * oacc[0][i] + oacc[1][i] * oacc[1][i];
                      ss = xhalf_sum(ss); ss += __shfl_xor(ss, 1); ss += __shfl_xor(ss, 2);
                      const float rinv = rsqrtf(ss * (1.f / 256.f) + EPS);
#pragma unroll
                      for (int dt = 0; dt < 2; ++dt)
#pragma unroll
                          for (int g = 0; g < 4; ++g) { u32x2 w; w.x = cvtpk(oacc[dt][4 * g] * rinv, oacc[dt][4 * g + 1] * rinv); w.y = cvtpk(oacc[dt][4 * g + 2] * rinv, oacc[dt][4 * g + 3] * rinv);
                              *(u32x2*)(Y + row * DM + 256 + head * 64 + 32 * dt + 8 * g + 4 * hi) = w; } }
                    __syncthreads();
                    continue;
                }
                {
                    const int qb = 31 - grp, b = within >> 2, h = within & 3;
                    const int T = 256 * qb + 32 * wave + r32; const size_t row = (size_t)b * SEQ + T;
                    bf16x8 qf[6];
#pragma unroll
                    for (int ks = 0; ks < 6; ++ks) qf[ks] = *(const bf16x8*)(MQ + row * 384 + h * 96 + 16 * ks + 8 * hi);
                    f32x16 o[2];
#pragma unroll
                    for (int i = 0; i < 16; ++i) { o[0][i] = 0.f; o[1][i] = 0.f; }
                    float m = NEGB, l = 0.f;
                    const int jd = 4 * qb + (wave >> 1), jend = 4 * qb + 3;
                    const bf16_t* kn = MKN + (size_t)b * SEQ * 256 + h * 64; const bf16_t* kr = MKR + (size_t)b * SEQ * 32; const bf16_t* vt = MVT + (size_t)(b * 4 + h) * 64 * SEQ;
                    const int key0 = tid / 12, ch0 = tid % 12, key1 = (512 + tid) / 12, ch1 = (512 + tid) % 12, vd_ = tid >> 3, vc8 = tid & 7;
                    u32x4 r0, r1, rv;
                    attn_pipeline(0, jend,
                        [&](int j) { r0 = ch0 < 8 ? *(const u32x4*)(kn + (size_t)(64 * j + key0) * 256 + ch0 * 8) : *(const u32x4*)(kr + (size_t)(64 * j + key0) * 32 + (ch0 - 8) * 8);
                            if (tid < 256) r1 = ch1 < 8 ? *(const u32x4*)(kn + (size_t)(64 * j + key1) * 256 + ch1 * 8) : *(const u32x4*)(kr + (size_t)(64 * j + key1) * 32 + (ch1 - 8) * 8);
                            rv = *(const u32x4*)(vt + (size_t)vd_ * SEQ + 64 * j + vc8 * 8); },
                        [&](int buf) { *(LAS u32x4*)(lds + (buf ? AL_K1 : AL_K0) + key0 * KSTR + ch0 * 16) = r0;
                            if (tid < 256) *(LAS u32x4*)(lds + (buf ? AL_K1 : AL_K0) + key1 * KSTR + ch1 * 16) = r1;
                            LAS unsigned char* vd = lds + (buf ? AL_V1 : AL_V0) + vd_ * VSTR + vc8 * 16; u32x2 a, c; a.x = rv.x; a.y = rv.y; c.x = rv.z; c.y = rv.w; *(LAS u32x2*)vd = a; *(LAS u32x2*)(vd + 8) = c; },
                        [&](int j, int cb) { if (j <= jd) { f32x16 s0, s1; qk_tile<6>(lds + (cb ? AL_K1 : AL_K0), qf, r32, hi, s0, s1);
                                if (j == jd) mask_tile(s0, s1, 0, 32 * (wave & 1) + r32, hi);
                                softmax_pv(s0, s1, lds + (cb ? AL_V1 : AL_V0), o, m, l, r32, hi); } });
                    { const float inv = 1.f / fmaxf(xhalf_sum(l), 1e-30f); float ss = 0.f;
#pragma unroll
                      for (int dt = 0; dt < 2; ++dt)
#pragma unroll
                          for (int g = 0; g < 4; ++g) { const float v0 = o[dt][4 * g] * inv, v1 = o[dt][4 * g + 1] * inv, v2 = o[dt][4 * g + 2] * inv, v3 = o[dt][4 * g + 3] * inv; ss += v0 * v0 + v1 * v1 + v2 * v2 + v3 * v3;
                              u32x2 w; w.x = cvtpk(v0, v1); w.y = cvtpk(v2, v3); *(u32x2*)(Y + row * DM + 768 + h * 64 + 32 * dt + 8 * g + 4 * hi) = w; }
                      ss = xhalf_sum(ss); if (hi == 0 && rep == 0) atomicAdd(ssq_d + row, ss); }
                    __syncthreads();
                }
              }
            }
        }
        SEAM(pb + 2);
        if (IN(pb + 3)) {
        LAUNDER_TID();
            constexpr int N_J9 = 1024, N_J10 = 512, N_J11 = 256, N_P4 = N_J9 + N_J10 + N_J11;
            _Pragma("unroll 1") for (int rep = 0; rep < REP_P4; ++rep)
            for (int it = bid; it < N_P4; it += G) {
                int r = it;
                if (rep > 0 && r >= N_J9 + N_J10) continue;
                if (r < N_J9) {
                    const int b = r >> 8, tb = r & 255, t0 = tb * 32, ch = tid & 255, half = tid >> 8;
                    LAS float* xa = ldsf; LAS float* xc = ldsf + 35 * 256;
                    for (int e = tid; e < 35 * 256; e += NTHR) { const int rr = e >> 8, c = e & 255, t = t0 - 3 + rr; float v = 0.f; if (t >= 0) v = bf2f(PB[(size_t)(b * SEQ + t) * NIN + C_AX + c]); xa[e] = v; }
                    __syncthreads();
                    { const float cw0 = inp(args, 4)[(l * 4 + 0) * 256 + ch], cw1 = inp(args, 4)[(l * 4 + 1) * 256 + ch], cw2 = inp(args, 4)[(l * 4 + 2) * 256 + ch], cw3 = inp(args, 4)[(l * 4 + 3) * 256 + ch], cb = inp(args, 5)[l * 256 + ch];
                      for (int tt = 0; tt < 16; ++tt) { const int rr = half * 16 + tt; xc[rr * 256 + ch] = cb + cw0 * xa[rr * 256 + ch] + cw1 * xa[(rr + 1) * 256 + ch] + cw2 * xa[(rr + 2) * 256 + ch] + cw3 * xa[(rr + 3) * 256 + ch]; } }
                    __syncthreads();
                    const int h = ch >> 6, cc = ch & 63;
                    LAS float* gR = ldsf + 67 * 256; LAS float* gI = gR + 32 * 256;
#pragma unroll 1
                    for (int pass = 0; pass < 2; ++pass) {
                        float wv[64]; const float* wsrc = (pass == 0 ? inp(args, 6) : inp(args, 8)) + ((size_t)(l * 4 + h) * 64) * 64 + cc; const float bias = (pass == 0 ? inp(args, 7) : inp(args, 9))[l * 256 + ch];
#pragma unroll
                        for (int i = 0; i < 64; ++i) wv[i] = wsrc[i * 64];
#pragma unroll 1
                        for (int tt = 0; tt < 16; ++tt) { const LAS f32x4* xr = (const LAS f32x4*)(xc + (half * 16 + tt) * 256 + h * 64); float a = bias;
#pragma unroll
                            for (int i4 = 0; i4 < 16; ++i4) { const f32x4 x = xr[i4]; a += x[0] * wv[4 * i4] + x[1] * wv[4 * i4 + 1] + x[2] * wv[4 * i4 + 2] + x[3] * wv[4 * i4 + 3]; }
                            (pass == 0 ? gR : gI)[(half * 16 + tt) * 256 + ch] = sigmoidf_(a); }
                    }
                    const float sp = log1pf(expf(-inp(args, 10)[l * 256 + ch]));
                    float hst = CIN[((size_t)(b * 512 + tb * 2 + half)) * 256 + ch];
#pragma unroll 1
                    for (int tt = 0; tt < 16; ++tt) {
                        const int rr = half * 16 + tt;
                        const float rg = gR[rr * 256 + ch], ig = gI[rr * 256 + ch], la = -8.f * rg * sp, av = expf(la), mult = sqrtf(-expm1f(2.f * la));
                        const float u = mult * (ig * xc[rr * 256 + ch]);
                        hst = av * hst + u;
                        const float gate = bf2f(PB[((size_t)b * SEQ + t0 + rr) * NIN + C_AG + ch]);
                        xa[rr * 256 + ch] = hst * gelu_tanh(gate);
                    }
                    __syncthreads();
                    for (int q = 0; q < 4; ++q) { const int rr = wave * 4 + q; const f32x4 v = ((const LAS f32x4*)(xa + rr * 256))[lane];
                        const float rinv = rsqrtf(wave_sum(v[0] * v[0] + v[1] * v[1] + v[2] * v[2] + v[3] * v[3]) * (1.f / 256.f) + EPS);
                        u32x2 w; w.x = pk2(v[0] * rinv, v[1] * rinv); w.y = pk2(v[2] * rinv, v[3] * rinv);
                        *(u32x2*)(Y + ((size_t)b * SEQ + t0 + rr) * DM + 4 * lane) = w; }
                    __syncthreads();
                    continue;
                }
                r -= N_J9;
                if (r < N_J10) {
                    const int b = r >> 7, c = r & 127; const size_t row0 = (size_t)b * SEQ + 64 * c;
                    LAS float* glr = ldsf; LAS float* bh = ldsf + 1024; LAS float* qh = bh + 2048; LAS float* kh = qh + 2048; LAS float* vh = kh + 2048; LAS float* Ah = vh + 4096; LAS float* Sh = Ah + 4096; LAS float* oall = Sh + 2048;
                    for (int e = tid; e < 1024; e += NTHR) glr[e] = bf2f(PB[(row0 + (e >> 4)) * NIN + C_GLR + (e & 15)]);
                    __syncthreads();
                    for (int h = 0; h < 4; ++h) {
                        for (int e = tid; e < 2048; e += NTHR) { const int t = e >> 5, k = e & 31, kk = h * 32 + k; float z = inp(args, 16)[l * 128 + kk];
#pragma unroll
                            for (int q = 0; q < 16; ++q) z += glr[t * 16 + q] * inp(args, 15)[(l * 16 + q) * 128 + kk];
                            bh[e] = (fminf(z, 0.f) - log1pf(expf(-fabsf(z)))) * (1.f / 16.f);
                            qh[e] = bf2f(PB[(row0 + t) * NIN + C_CQ + kk]) * 0.17677669529663687f; kh[e] = bf2f(PB[(row0 + t) * NIN + C_CK + kk]); }
                        for (int e = tid; e < 4096; e += NTHR) vh[e] = bf2f(PB[(row0 + (e >> 6)) * NIN + C_CV + h * 64 + (e & 63)]);
                        for (int e = tid; e < 2048; e += NTHR) Sh[e] = SST[((size_t)(b * 128 + c) * 4 + h) * 2048 + e];
                        __syncthreads();
                        if (tid < 32) { float run = 0.f; for (int t = 0; t < 64; ++t) { run += bh[t * 32 + tid]; bh[t * 32 + tid] = run; } }
                        __syncthreads();
                        for (int e = tid; e < 4096; e += NTHR) { const int i = e >> 6, j = e & 63; float a = 0.f;
                            if (j <= i) {
#pragma unroll 8
                                for (int k = 0; k < 32; ++k) a += qh[i * 32 + k] * kh[j * 32 + k] * __expf(bh[i * 32 + k] - bh[j * 32 + k]); }
                            Ah[e] = a; }
                        __syncthreads();
                        for (int e = tid; e < 2048; e += NTHR) qh[e] *= __expf(bh[e]);
                        __syncthreads();
                        { const int i = tid >> 3, v0 = (tid & 7) * 8; float a8[8] = {0.f, 0.f, 0.f, 0.f, 0.f, 0.f, 0.f, 0.f};
                          for (int k = 0; k < 32; ++k) { const float qe = qh[i * 32 + k]; const LAS f32x4* sp4 = (const LAS f32x4*)(Sh + k * 64 + v0); const f32x4 s0 = sp4[0], s1 = sp4[1];
                              a8[0] += qe * s0[0]; a8[1] += qe * s0[1]; a8[2] += qe * s0[2]; a8[3] += qe * s0[3]; a8[4] += qe * s1[0]; a8[5] += qe * s1[1]; a8[6] += qe * s1[2]; a8[7] += qe * s1[3]; }
                          for (int j = 0; j <= i; ++j) { const float aa = Ah[i * 64 + j]; const LAS f32x4* vp4 = (const LAS f32x4*)(vh + j * 64 + v0); const f32x4 s0 = vp4[0], s1 = vp4[1];
                              a8[0] += aa * s0[0]; a8[1] += aa * s0[1]; a8[2] += aa * s0[2]; a8[3] += aa * s0[3]; a8[4] += aa * s1[0]; a8[5] += aa * s1[1]; a8[6] += aa * s1[2]; a8[7] += aa * s1[3]; }
#pragma unroll
                          for (int q = 0; q < 8; ++q) oall[i * 256 + h * 64 + v0 + q] = a8[q]; }
                        __syncthreads();
                    }
                    for (int q = 0; q < 8; ++q) { const int t = wave * 8 + q; const f32x4 v = ((const LAS f32x4*)(oall + t * 256))[lane];
                        float ssh = v[0] * v[0] + v[1] * v[1] + v[2] * v[2] + v[3] * v[3];
                        ssh += __shfl_xor(ssh, 1); ssh += __shfl_xor(ssh, 2); ssh += __shfl_xor(ssh, 4); ssh += __shfl_xor(ssh, 8);
                        const float rh = rsqrtf(ssh * (1.f / 64.f) + EPS); float y[4]; float ss = 0.f;
                        const bf16_t* og = PB + (row0 + t) * NIN + C_OG + 4 * lane;
#pragma unroll
                        for (int i = 0; i < 4; ++i) { const float g = bf2f(og[i]); y[i] = v[i] * rh * inp(args, 17)[l * 64 + ((4 * lane + i) & 63)] * (g / (1.f + __expf(-g))); ss += y[i] * y[i]; }
                        const float rinv = rsqrtf(wave_sum(ss) * (1.f / 256.f) + EPS);
                        u32x2 w; w.x = pk2(y[0] * rinv, y[1] * rinv); w.y = pk2(y[2] * rinv, y[3] * rinv);
                        *(u32x2*)(Y + (row0 + t) * DM + 512 + 4 * lane) = w; }
                    __syncthreads();
                    continue;
                }
                r -= N_J10;
                {
                    for (int e = tid; e < 128 * 32; e += NTHR) { const size_t row = (size_t)r * 128 + (e >> 5); const int c8 = e & 31;
                        const float rinv = rsqrtf(ssq_d[row] * (1.f / 256.f) + EPS);
                        u32x4* p = (u32x4*)(Y + row * DM + 768 + 8 * c8); u32x4 w = *p;
                        w.x = pk2(bflo(w.x) * rinv, bfhi(w.x) * rinv); w.y = pk2(bflo(w.y) * rinv, bfhi(w.y) * rinv); w.z = pk2(bflo(w.z) * rinv, bfhi(w.z) * rinv); w.w = pk2(bflo(w.w) * rinv, bfhi(w.w) * rinv);
                        *p = w; }
                }
            }
        }
        SEAM(pb + 3);
        if (IN(pb + 4)) {
            pg8::Gemm g{Y, (const bf16_t*)(ws + WS_WOUT) + (size_t)l * DM * DM, M, DM, DM}; pg8::StaticOrder S; S.init(M, DM, G, bid);
            pg8::EpiResid E{l == 0 ? inp(args, 0) : (const float*)args.out, args.out, XB, ssq_out};
            pg8::gemm_phase<pg8::EpiResid, pg8::StaticOrder, true, true>(lds, g, S, E);
        }
        SEAM(pb + 4);
        if (IN(pb + 5)) {
            pg8::Gemm g{XB, (const bf16_t*)(ws + WS_WGU) + (size_t)l * NGU * DM, M, NGU, DM}; pg8::StaticOrder S; S.init(M, NGU, G, bid);
            pg8::EpiSwiglu E{ACT, ssq_out};
            _Pragma("unroll 1") for (int rep = 0; rep < REP_G16; ++rep) pg8::gemm_phase<pg8::EpiSwiglu, pg8::StaticOrder, true, true>(lds, g, S, E);
        }
        SEAM(pb + 5);
        if (IN(pb + 6)) {
            pg8::Gemm g{ACT, (const bf16_t*)(ws + WS_WDN) + (size_t)l * DM * FF, M, DM, FF}; pg8::StaticOrder S; S.init(M, DM, G, bid);
            pg8::EpiResid E{(const float*)args.out, args.out, XB, ssq_down};
            pg8::gemm_phase<pg8::EpiResid, pg8::StaticOrder, true, true>(lds, g, S, E);
        }
        SEAM(pb + 6);
    }
    if (IN(15)) {
        LAUNDER_TID();
        const float* ssqf = acc_base + 3 * (size_t)M; const int gw = bid * 8 + wave, NGW = G * 8;
        for (int m = gw; m < M; m += NGW) {
            const float rinv = rsqrtf(ssqf[m] * (1.f / DM) + EPS);
            f32x4* xr = (f32x4*)(args.out + (size_t)m * DM) + lane; const f32x4* gn = (const f32x4*)inp(args, 27) + lane;
#pragma unroll
            for (int j = 0; j < 4; ++j) { f32x4 v = xr[64 * j]; const f32x4 g = gn[64 * j]; v = v * rinv * g; xr[64 * j] = v; }
        }
    }
#undef IN
#undef SEAM
}

extern "C" void kernel_launch(void* const* d_in, const int* in_sizes, int n_in, void* d_out, int out_size, void* d_ws, size_t ws_size, hipStream_t stream) {
    static int grid = 0;
    if (grid == 0) {
        if (n_in != 28 || in_sizes[0] != M * DM || out_size != M * DM || ws_size < WS_END) { fprintf(stderr, "kernel_launch: unexpected shapes (n_in %d, ws %zu)\n", n_in, ws_size); grid = -1; return; }
        int dev = 0, cus = 0;
        if (hipGetDevice(&dev) != hipSuccess || hipDeviceGetAttribute(&cus, hipDeviceAttributeMultiprocessorCount, dev) != hipSuccess) { grid = -1; return; }
        if (hipFuncSetAttribute((const void*)fwd, hipFuncAttributeMaxDynamicSharedMemorySize, LDS_BYTES) != hipSuccess) { fprintf(stderr, "kernel_launch: hipFuncSetAttribute failed\n"); grid = -1; return; }
        int per_cu = 0;
        if (hipOccupancyMaxActiveBlocksPerMultiprocessor(&per_cu, (const void*)fwd, NTHR, LDS_BYTES) != hipSuccess || per_cu < 1) fprintf(stderr, "kernel_launch: occupancy query says %d\n", per_cu);
        (void)hipGetLastError();
        grid = cus;
    }
    if (grid < 0) return;
    (void)hipMemsetAsync((char*)d_ws + WS_CTL, 0, CTL_ZERO_BYTES, stream);
    Args a{};
    for (int i = 0; i < 28; ++i) a.in[i] = (const float*)d_in[i];
    a.out = (float*)d_out; a.ws = (unsigned char*)d_ws;
    if (MK_N_LAUNCHES == 1) { a.ph_lo = 0; a.ph_hi = 16; hipLaunchKernelGGL(fwd, dim3(grid), dim3(NTHR), LDS_BYTES, stream, a); }
    else for (int p = 0; p < 16; ++p) { a.ph_lo = p; a.ph_hi = p + 1; hipLaunchKernelGGL(fwd, dim3(grid), dim3(NTHR), LDS_BYTES, stream, a); }
}
```

```cpp
#include <hip/hip_runtime.h>
#include <cstdio>
#include <cstdint>

#ifndef MK_N_LAUNCHES
#define MK_N_LAUNCHES 1
#endif

#define REP_P0 1
#define REP_G16 1
#define REP_P2 1
#define REP_ATT 1
#define REP_P4 1
#define LAS __attribute__((address_space(3)))
#define DI __device__ __forceinline__
typedef unsigned short bf16_t;
typedef short bf16x8 __attribute__((ext_vector_type(8)));
typedef float f32x4 __attribute__((ext_vector_type(4)));
typedef unsigned u32x4 __attribute__((ext_vector_type(4)));
typedef unsigned u32x2 __attribute__((ext_vector_type(2)));

constexpr int NB = 4, SEQ = 8192, M = NB * SEQ, DM = 1024, NIN = 2304, NINS = 2300, FF = 2816, NGU = 2 * FF;
constexpr float EPS = 1e-6f;
constexpr int C_AX = 0, C_AG = 256, C_BQ = 512, C_KC = 768, C_VC = 832, C_KS = 896, C_VS = 960, C_KW = 1024, C_VW = 1088, C_BG = 1152,
              C_CQ = 1164, C_CK = 1292, C_CV = 1420, C_GLR = 1676, C_OG = 1692, C_DCQ = 1948, C_DCKV = 2140, C_DKR = 2268;
constexpr size_t MiB = 1u << 20;
constexpr size_t WS_CTL = 0, CTL_ZERO_BYTES = 1 * MiB;
constexpr size_t WS_ACC = 64 * 1024;
constexpr size_t WS_SSQ0 = 1 * MiB;
constexpr size_t WS_HB = 1 * MiB + 256 * 1024;
constexpr size_t WS_WIN = 2 * MiB, WS_WOUT = 11 * MiB, WS_WGU = 15 * MiB, WS_WDN = 37 * MiB;
constexpr size_t WS_WUQT = 48 * MiB, WS_WUKVT = 48 * MiB + 512 * 1024, WS_W2T = 49 * MiB, WS_W1T = 50 * MiB;
constexpr size_t WS_CS64 = 64 * MiB, WS_CS32 = 72 * MiB;
constexpr size_t WS_XB = 80 * MiB, WS_Y = 144 * MiB, WS_PB = 208 * MiB, WS_ACT = 208 * MiB;
constexpr size_t WS_LA = 384 * MiB, WS_LH = 386 * MiB, WS_CIN = 388 * MiB;
constexpr size_t WS_KVC = 392 * MiB, WS_DEC = 408 * MiB, WS_SST = 410 * MiB;
constexpr size_t WS_MQ = 428 * MiB, WS_MKN = 452 * MiB, WS_MV = 468 * MiB, WS_MKR = 484 * MiB;
constexpr size_t WS_VST = 490 * MiB, WS_VWT = 494 * MiB, WS_KCMPB = 498 * MiB, WS_VCMPT = 499 * MiB, WS_END = 500 * MiB;
constexpr int CW_QUEUE = 64;
constexpr int CW_BAR = 4096;
constexpr int LDS_BYTES = 163840 - 256;
constexpr int LDS_CTL = LDS_BYTES - 64;
constexpr int NTHR = 512;

struct Args { const float* in[28]; float* out; unsigned char* ws; int ph_lo, ph_hi; };

DI float bf2f(bf16_t h) { return __uint_as_float(((unsigned)h) << 16); }
DI float bflo(unsigned u) { return __uint_as_float(u << 16); }
DI float bfhi(unsigned u) { return __uint_as_float(u & 0xffff0000u); }
DI bf16_t f2bf(float f) { unsigned u = __float_as_uint(f); return (bf16_t)((u + 0x7fffu + ((u >> 16) & 1u)) >> 16); }
DI unsigned pk2(float lo, float hi) { return (unsigned)f2bf(lo) | ((unsigned)f2bf(hi) << 16); }
DI float wave_sum(float v) {
#pragma unroll
    for (int o = 1; o < 64; o <<= 1) v += __shfl_xor(v, o);
    return v;
}
DI float wave_max(float v) {
#pragma unroll
    for (int o = 1; o < 64; o <<= 1) v = fmaxf(v, __shfl_xor(v, o));
    return v;
}
DI int wave_min_i(int v) {
#pragma unroll
    for (int o = 1; o < 64; o <<= 1) { int w = __shfl_xor(v, o); v = w < v ? w : v; }
    return v;
}
DI float sigmoidf_(float x) { return 1.f / (1.f + __expf(-x)); }
DI float gelu_tanh(float x) { const float u = 0.7978845608028654f * (x + 0.044715f * x * x * x); return 0.5f * x * (1.f + tanhf(u)); }
#define WSYNC() do { asm volatile("s_waitcnt lgkmcnt(0)" ::: "memory"); __builtin_amdgcn_wave_barrier(); } while (0)

namespace pg8 {
constexpr int BM = 256, BK = 64, HALF = 128, HTB = HALF * BK * 2, NXCD = 8, WGM = 8;
__host__ __device__ __forceinline__ int lds_byte(int r, int c) { const int st = (r >> 4) * 2 + (c >> 5), rr = r & 15, cc = c & 31, ob = rr * 64 + cc * 2; return st * 1024 + (ob ^ (((ob >> 9) & 1) << 5)); }
__host__ __device__ __forceinline__ void stage_rc(int b, int& R, int& C) { const int st = b / 1024, sb = b % 1024, swz = sb ^ (((sb >> 9) & 1) << 5); R = (st >> 1) * 16 + swz / 64; C = (st & 1) * 32 + (swz % 64) / 2; }
__host__ __device__ __forceinline__ int perm32(int rho) { const int n = rho >> 4, i = rho & 15; return 8 * (i >> 2) + 4 * n + (i & 3); }
struct Unit { int pm, pn; };
struct Gemm { const bf16_t* A; const bf16_t* Bt; int M, N, K; };
struct StaticOrder {
    int nM, nN, nwg, G, c;
    __host__ __device__ void init(int M_, int N_, int G_, int c_) { nM = M_ / BM; nN = N_ / BM; nwg = nM * nN; G = G_; c = c_; }
    __host__ __device__ bool next(int i, Unit& u) const {
        const long L = (long)i * G + c; if (L >= nwg) return false;
        int wgid = (int)L; { const int q = nwg / NXCD, r = nwg % NXCD, xcd = wgid % NXCD, off = wgid / NXCD; wgid = (xcd < r ? xcd * (q + 1) : r * (q + 1) + (xcd - r) * q) + off; }
        const int nig = WGM * nN, gid = wgid / nig, fm = gid * WGM, gsz = (nM - fm) < WGM ? (nM - fm) : WGM;
        u.pm = fm + ((wgid % nig) % gsz); u.pn = (wgid % nig) / gsz; return true;
    }
    __device__ __forceinline__ void a_ready(const Unit&) const {}
    __device__ __forceinline__ void done(const Unit&) const {}
};
DI unsigned cvt_pk_bf16(float lo, float hi) { unsigned r; asm volatile("v_cvt_pk_bf16_f32 %0, %1, %2" : "=v"(r) : "v"(lo), "v"(hi)); return r; }

struct EpiInProj {
    static constexpr bool PERM = true, AFTER_DRAIN = false;
    bf16_t* O; int ldc; const float* ssq;
    DI void operator()(const f32x4 (&acc)[2][2][4][2], const Unit& u, int wr, int wc, int fr, int fq) const {
        const int row0 = u.pm * BM + wr * 64 + fr, col0 = u.pn * BM + wc * 32 + 8 * fq;
#pragma unroll
        for (int ai = 0; ai < 2; ++ai)
#pragma unroll
            for (int m = 0; m < 4; ++m) {
                const int row = row0 + ai * HALF + m * 16;
                const float rinv = rsqrtf(ssq[row] * (1.f / DM) + EPS);
                bf16_t* rowp = O + (size_t)row * ldc + col0;
#pragma unroll
                for (int bj = 0; bj < 2; ++bj) {
                    f32x4 v0 = acc[ai][bj][m][0] * rinv, v1 = acc[ai][bj][m][1] * rinv;
                    u32x4 w; w.x = cvt_pk_bf16(v0[0], v0[1]); w.y = cvt_pk_bf16(v0[2], v0[3]); w.z = cvt_pk_bf16(v1[0], v1[1]); w.w = cvt_pk_bf16(v1[2], v1[3]);
                    *(u32x4*)(rowp + bj * HALF) = w;
                }
            }
    }
};
struct EpiResid {
    static constexpr bool PERM = true, AFTER_DRAIN = false;
    const float* xin; float* xout; bf16_t* xb; float* ssq_out;
    DI void operator()(const f32x4 (&acc)[2][2][4][2], const Unit& u, int wr, int wc, int fr, int fq) const {
        const int row0 = u.pm * BM + wr * 64 + fr, col0 = u.pn * BM + wc * 32 + 8 * fq;
#pragma unroll
        for (int ai = 0; ai < 2; ++ai)
#pragma unroll
            for (int m = 0; m < 4; ++m) {
                const int row = row0 + ai * HALF + m * 16;
                float part = 0.f;
#pragma unroll
                for (int bj = 0; bj < 2; ++bj) {
                    const size_t off = (size_t)row * DM + col0 + bj * HALF;
                    const f32x4 r0 = *(const f32x4*)(xin + off), r1 = *(const f32x4*)(xin + off + 4);
                    const f32x4 v0 = acc[ai][bj][m][0] + r0, v1 = acc[ai][bj][m][1] + r1;
                    *(f32x4*)(xout + off) = v0; *(f32x4*)(xout + off + 4) = v1;
                    u32x4 w; w.x = cvt_pk_bf16(v0[0], v0[1]); w.y = cvt_pk_bf16(v0[2], v0[3]); w.z = cvt_pk_bf16(v1[0], v1[1]); w.w = cvt_pk_bf16(v1[2], v1[3]);
                    *(u32x4*)(xb + off) = w;
                    part += v0[0] * v0[0] + v0[1] * v0[1] + v0[2] * v0[2] + v0[3] * v0[3] + v1[0] * v1[0] + v1[1] * v1[1] + v1[2] * v1[2] + v1[3] * v1[3];
                }
                part += __shfl_xor(part, 16); part += __shfl_xor(part, 32);
                if (fq == 0) atomicAdd(ssq_out + row, part);
            }
    }
};
struct EpiSwiglu {
    static constexpr bool PERM = true, AFTER_DRAIN = false;
    bf16_t* act; const float* ssq;
    DI void operator()(const f32x4 (&acc)[2][2][4][2], const Unit& u, int wr, int wc, int fr, int fq) const {
        const int row0 = u.pm * BM + wr * 64 + fr, j0 = u.pn * 128 + wc * 16 + 4 * fq;
#pragma unroll
        for (int ai = 0; ai < 2; ++ai)
#pragma unroll
            for (int m = 0; m < 4; ++m) {
                const int row = row0 + ai * HALF + m * 16;
                const float rinv = rsqrtf(ssq[row] * (1.f / DM) + EPS);
#pragma unroll
                for (int bj = 0; bj < 2; ++bj) {
                    const f32x4 g = acc[ai][bj][m][0] * rinv, up = acc[ai][bj][m][1] * rinv;
                    float a[4];
#pragma unroll
                    for (int i = 0; i < 4; ++i) a[i] = g[i] / (1.f + __expf(-g[i])) * up[i];
                    u32x2 w; w.x = cvt_pk_bf16(a[0], a[1]); w.y = cvt_pk_bf16(a[2], a[3]);
                    *(u32x2*)(act + (size_t)row * FF + j0 + bj * 64) = w;
                }
            }
    }
};

template <class Epi, class Sched, bool ALIGN_EPI = false, bool SP2 = false>
DI void gemm_phase(LAS unsigned char* lds, const Gemm g, const Sched& S, const Epi& E) {
    int tid_ = threadIdx.x; asm volatile("" : "+v"(tid_));
    const int tid = tid_, wid = __builtin_amdgcn_readfirstlane(tid >> 6), lane = tid & 63, wr = wid >> 2, wc = wid & 3, fr = lane & 15, fq = lane >> 4;
    const int K = g.K, nt = K / BK;
    unsigned voffA[2], voffB[2];
#pragma unroll
    for (int i = 0; i < 2; ++i) { int R, C; stage_rc(tid * 16 + i * 8192, R, C); const int Rb = Epi::PERM ? ((R & ~31) + perm32(R & 31)) : R;
        voffA[i] = (unsigned)(R * K + C) * 2u; voffB[i] = (unsigned)(Rb * K + C) * 2u; }
    const size_t kstep = (size_t)(BK * 2);
    const size_t hstep = (size_t)HALF * K * 2;
    const size_t tstep = 2 * hstep;
    const unsigned ldsw = (unsigned)wid * 1024u;
    const int aoff = lds_byte(wr * 64 + fr, fq * 8), boff = lds_byte(wc * 32 + fr, fq * 8);
#define PG8_SA(b, h) (((b) * 2 + (h)) * HTB)
#define PG8_SB(b, h) ((4 + (b) * 2 + (h)) * HTB)
#define PG8_STAGE(bufoff, gbase, voff) do { _Pragma("unroll") for (int _i = 0; _i < 2; ++_i) \
        __builtin_amdgcn_global_load_lds((const unsigned*)((const char*)(gbase) + (voff)[_i]), (LAS unsigned*)(lds + (bufoff) + ldsw + _i * 8192), 16, 0, 0); } while (0)
#define PG8_LDA(dst, b, h) do { _Pragma("unroll") for (int m = 0; m < 4; ++m) _Pragma("unroll") for (int k = 0; k < 2; ++k) dst[m][k] = *(const LAS bf16x8*)(lds + PG8_SA(b, h) + aoff + m * 2048 + k * 1024); } while (0)
#define PG8_LDB(dst, b, h) do { _Pragma("unroll") for (int n = 0; n < 2; ++n) _Pragma("unroll") for (int k = 0; k < 2; ++k) dst[n][k] = *(const LAS bf16x8*)(lds + PG8_SB(b, h) + boff + n * 2048 + k * 1024); } while (0)
#define PG8_MMA(ai, bj, At, Bt) do { __builtin_amdgcn_s_setprio(1); _Pragma("unroll") for (int m = 0; m < 4; ++m) _Pragma("unroll") for (int n = 0; n < 2; ++n) _Pragma("unroll") for (int k = 0; k < 2; ++k) \
        acc[ai][bj][m][n] = __builtin_amdgcn_mfma_f32_16x16x32_bf16(Bt[n][k], At[m][k], acc[ai][bj][m][n], 0, 0, 0); __builtin_amdgcn_s_setprio(0); } while (0)
#define PG8_WAIT_V(n) asm volatile("s_waitcnt vmcnt(" #n ")" ::: "memory")
#define PG8_WAIT_L(n) asm volatile("s_waitcnt lgkmcnt(" #n ")" ::: "memory")
#define PG8_BAR __builtin_amdgcn_s_barrier()
#define PG8_SCHED __builtin_amdgcn_sched_barrier(0)
    Unit cur, nxt; int ui = 0;
    if (!S.next(0, cur)) return;
    f32x4 acc[2][2][4][2];
#pragma unroll
    for (int a = 0; a < 2; ++a)
#pragma unroll
        for (int b = 0; b < 2; ++b)
#pragma unroll
            for (int m = 0; m < 4; ++m)
#pragma unroll
                for (int n = 0; n < 2; ++n) acc[a][b][m][n] = (f32x4){0.f, 0.f, 0.f, 0.f};
    bf16x8 At[4][2], B0[2][2], B1[2][2];
    const char* cA = (const char*)g.A + (size_t)cur.pm * tstep; const char* cB = (const char*)g.Bt + (size_t)cur.pn * tstep;
    S.a_ready(cur);
    if constexpr (SP2) {
        PG8_STAGE(PG8_SB(0, 0), cB, voffB); PG8_STAGE(PG8_SB(0, 1), cB + hstep, voffB); PG8_STAGE(PG8_SA(0, 0), cA, voffA); PG8_STAGE(PG8_SA(0, 1), cA + hstep, voffA);
        if (wr == 1) PG8_BAR;
        PG8_WAIT_V(2); PG8_BAR;
        PG8_STAGE(PG8_SB(1, 0), cB + kstep, voffB); PG8_STAGE(PG8_SA(1, 0), cA + kstep, voffA); PG8_STAGE(PG8_SB(1, 1), cB + hstep + kstep, voffB);
        PG8_WAIT_V(6); PG8_BAR;
    } else {
        PG8_STAGE(PG8_SB(0, 0), cB, voffB); PG8_STAGE(PG8_SA(0, 0), cA, voffA); PG8_STAGE(PG8_SB(0, 1), cB + hstep, voffB); PG8_STAGE(PG8_SA(0, 1), cA + hstep, voffA);
        if (wr == 1) PG8_BAR;
        PG8_WAIT_V(4); PG8_BAR;
        PG8_STAGE(PG8_SB(1, 0), cB + kstep, voffB); PG8_STAGE(PG8_SA(1, 0), cA + kstep, voffA); PG8_STAGE(PG8_SB(1, 1), cB + hstep + kstep, voffB);
        PG8_WAIT_V(6); PG8_BAR;
    }
    for (;;) {
        const bool has_next = S.next(ui + 1, nxt);
        const char* nA = has_next ? (const char*)g.A + (size_t)nxt.pm * tstep : cA; const char* nB = has_next ? (const char*)g.Bt + (size_t)nxt.pn * tstep : cB;
        for (int t = 0; t < nt; t += 2) {
            const bool last = (t == nt - 2);
            const char* a1 = cA + (size_t)(t + 1) * kstep;
            const char* a2 = last ? nA : cA + (size_t)(t + 2) * kstep; const char* b2 = last ? nB : cB + (size_t)(t + 2) * kstep;
            const char* a3 = a2 + kstep; const char* b3 = b2 + kstep;
            if (last && has_next) S.a_ready(nxt);
            if constexpr (SP2) {
            PG8_LDB(B0, 0, 0); PG8_LDB(B1, 0, 1); PG8_SCHED; PG8_LDA(At, 0, 0); PG8_STAGE(PG8_SA(1, 1), a1 + hstep, voffA);
            PG8_WAIT_V(8); PG8_WAIT_L(0); PG8_BAR; PG8_MMA(0, 0, At, B0); PG8_MMA(0, 1, At, B1); PG8_BAR; PG8_SCHED;
            PG8_LDA(At, 0, 1); PG8_STAGE(PG8_SB(0, 0), b2, voffB); PG8_STAGE(PG8_SB(0, 1), b2 + hstep, voffB); PG8_STAGE(PG8_SA(0, 0), a2, voffA);
            PG8_WAIT_V(8); PG8_WAIT_L(0); PG8_BAR; PG8_MMA(1, 0, At, B0); PG8_MMA(1, 1, At, B1); PG8_BAR; PG8_SCHED;
            PG8_LDB(B0, 1, 0); PG8_LDB(B1, 1, 1); PG8_SCHED; PG8_LDA(At, 1, 0); PG8_STAGE(PG8_SA(0, 1), a2 + hstep, voffA);
            PG8_WAIT_V(8); PG8_WAIT_L(0); PG8_BAR; PG8_MMA(0, 0, At, B0); PG8_MMA(0, 1, At, B1); PG8_BAR; PG8_SCHED;
            PG8_LDA(At, 1, 1); PG8_STAGE(PG8_SB(1, 0), b3, voffB); PG8_STAGE(PG8_SB(1, 1), b3 + hstep, voffB); PG8_STAGE(PG8_SA(1, 0), a3, voffA);
            PG8_WAIT_V(8); PG8_WAIT_L(0); PG8_BAR; PG8_MMA(1, 0, At, B0); PG8_MMA(1, 1, At, B1); PG8_BAR; PG8_SCHED;
            } else {
            PG8_LDB(B0, 0, 0); PG8_SCHED; PG8_LDA(At, 0, 0); PG8_STAGE(PG8_SA(1, 1), a1 + hstep, voffA);
            PG8_WAIT_L(8); PG8_BAR; PG8_WAIT_L(0); PG8_MMA(0, 0, At, B0); PG8_BAR; PG8_SCHED;
            PG8_LDB(B1, 0, 1); PG8_STAGE(PG8_SB(0, 0), b2, voffB);
            PG8_BAR; PG8_WAIT_L(0); PG8_MMA(0, 1, At, B1); PG8_BAR;
            PG8_LDA(At, 0, 1); PG8_STAGE(PG8_SA(0, 0), a2, voffA);
            PG8_BAR; PG8_WAIT_L(0); PG8_MMA(1, 0, At, B0); PG8_BAR; PG8_SCHED;
            PG8_STAGE(PG8_SB(0, 1), b2 + hstep, voffB);
            PG8_WAIT_V(6); PG8_BAR; PG8_MMA(1, 1, At, B1); PG8_BAR;
            PG8_LDB(B0, 1, 0); PG8_SCHED; PG8_LDA(At, 1, 0); PG8_STAGE(PG8_SA(0, 1), a2 + hstep, voffA);
            PG8_WAIT_L(8); PG8_BAR; PG8_WAIT_L(0); PG8_MMA(0, 0, At, B0); PG8_BAR; PG8_SCHED;
            PG8_LDB(B1, 1, 1); PG8_STAGE(PG8_SB(1, 0), b3, voffB);
            PG8_BAR; PG8_WAIT_L(0); PG8_MMA(0, 1, At, B1); PG8_BAR;
            PG8_LDA(At, 1, 1); PG8_STAGE(PG8_SA(1, 0), a3, voffA);
            PG8_BAR; PG8_WAIT_L(0); PG8_MMA(1, 0, At, B0); PG8_BAR; PG8_SCHED;
            PG8_STAGE(PG8_SB(1, 1), b3 + hstep, voffB);
            PG8_WAIT_V(6); PG8_BAR; PG8_MMA(1, 1, At, B1); PG8_BAR;
            }
        }
        if constexpr (ALIGN_EPI) { if (wr == 0) PG8_BAR; }
        if constexpr (!Epi::AFTER_DRAIN) { E(acc, cur, wr, wc, fr, fq); S.done(cur); }
        if (!has_next) break;
#pragma unroll
        for (int a = 0; a < 2; ++a)
#pragma unroll
            for (int b = 0; b < 2; ++b)
#pragma unroll
                for (int m = 0; m < 4; ++m)
#pragma unroll
                    for (int n = 0; n < 2; ++n) acc[a][b][m][n] = (f32x4){0.f, 0.f, 0.f, 0.f};
        cur = nxt; cA = nA; cB = nB; ++ui;
        if constexpr (ALIGN_EPI) { if (wr == 1) PG8_BAR; }
    }
    PG8_WAIT_V(0);
    if constexpr (!ALIGN_EPI) { if (wr == 0) PG8_BAR; }
    PG8_BAR;
#undef PG8_SA
#undef PG8_SB
#undef PG8_STAGE
#undef PG8_LDA
#undef PG8_LDB
#undef PG8_MMA
#undef PG8_WAIT_V
#undef PG8_WAIT_L
#undef PG8_BAR
#undef PG8_SCHED
}
}

#define XB_TMO      128
#define XB_XCNT(j)  (256  + 64 * (j))
#define XB_XSUB(j)  (1280 + 64 * (j))
#define XB_XGEN(j)  (2304 + 64 * (j))
#define XB_TOP      3328
#define XB_TOPGEN   3392
#define XCD_BAR_WORDS 3456
#define XB_SPIN_CAP (1u << 18)
__device__ __forceinline__ unsigned xb_ld(unsigned* p)              { return __hip_atomic_load(p, __ATOMIC_RELAXED, __HIP_MEMORY_SCOPE_AGENT); }
__device__ __forceinline__ unsigned xb_add(unsigned* p, unsigned v) { return __hip_atomic_fetch_add(p, v, __ATOMIC_RELAXED, __HIP_MEMORY_SCOPE_AGENT); }
__device__ __forceinline__ unsigned xb_xcc_id() { return (unsigned)__builtin_amdgcn_s_getreg((3 << 11) | 20) & 0xFu; }
#define XB_SPIN(cond, bar) do { unsigned _sp = 0; while (cond) { __builtin_amdgcn_s_sleep(1); \
    if ((++_sp & 255u) == 0u) { if (xb_ld(&(bar)[XB_TMO])) break; if (_sp > XB_SPIN_CAP) { atomicAdd(&(bar)[XB_TMO], 1u); break; } } } } while (0)
struct XcdBarrier { unsigned* bar; unsigned x; volatile LAS unsigned* st; };
__device__ __forceinline__ XcdBarrier xcd_barrier_post(unsigned* bar, volatile LAS unsigned* st) {
    XcdBarrier b; b.bar = bar; b.x = xb_xcc_id(); b.st = st;
    if (threadIdx.x == 0) (void)xb_add(&bar[XB_XCNT(b.x)], 1u);
    return b;
}
__device__ __forceinline__ void xcd_barrier_complete(unsigned* bar, unsigned x, unsigned& nloc, unsigned& nx) {
    const unsigned G = gridDim.x * gridDim.y * gridDim.z;
    unsigned sum, cnt, mine, sp = 0u;
    for (;;) {
        sum = 0u; cnt = 0u; mine = 0u;
#pragma unroll
        for (unsigned j = 0; j < 16; ++j) { const unsigned c = xb_ld(&bar[XB_XCNT(j)]); sum += c; cnt += (c > 0u) ? 1u : 0u; mine = (j == x) ? c : mine; }
        if (sum == G) break;
        __builtin_amdgcn_s_sleep(1);
        if ((++sp & 255u) == 0u) { if (xb_ld(&bar[XB_TMO])) break; if (sp > XB_SPIN_CAP) { atomicAdd(&bar[XB_TMO], 1u); break; } }
    }
    nloc = mine > 0u ? mine : 1u; nx = cnt > 0u ? cnt : 1u;
}
__device__ __forceinline__ void xcd_barrier(const XcdBarrier& b) {
    asm volatile("s_waitcnt vmcnt(0)" ::: "memory");
    __syncthreads();
    if (threadIdx.x == 0) {
        unsigned* bar = b.bar;
        __builtin_amdgcn_s_waitcnt(0);
        unsigned nloc = b.st[0], nx = b.st[1];
        if (nloc == 0u) { xcd_barrier_complete(bar, b.x, nloc, nx); b.st[0] = nloc; b.st[1] = nx; }
        const unsigned old = xb_add(&bar[XB_XSUB(b.x)], 1u);
        const unsigned gen = old / nloc;
        if (old + 1u == (gen + 1u) * nloc) {
            __builtin_amdgcn_fence(__ATOMIC_RELEASE, "agent");
            asm volatile("s_waitcnt vmcnt(0)" ::: "memory");
            const unsigned og = xb_add(&bar[XB_TOP], 1u);
            const unsigned tg = og / nx;
            if (og + 1u == (tg + 1u) * nx) xb_add(&bar[XB_TOPGEN], 1u);
            else XB_SPIN(xb_ld(&bar[XB_TOPGEN]) == tg, bar);
            __builtin_amdgcn_fence(__ATOMIC_ACQUIRE, "agent");
            xb_add(&bar[XB_XGEN(b.x)], 1u);
            asm volatile("s_waitcnt vmcnt(0)" ::: "memory");
        } else {
            XB_SPIN(xb_ld(&bar[XB_XGEN(b.x)]) == gen, bar);
            __builtin_amdgcn_fence(__ATOMIC_ACQUIRE, "agent");
            asm volatile("s_waitcnt vmcnt(0)" ::: "memory");
        }
    }
    __syncthreads();
}

template <int MAP>
DI int colmap(int v, int Nsrc) {
    if (MAP == 0) return v < Nsrc ? v : -1;
    const int g8 = v >> 3, e = v & 7, j = 4 * g8 + (e & 3); return (e < 4) ? j : FF + j;
}
template <int MAP>
DI void p0_transpose_item(const float* W, int K, int Nsrc, const float* gain, bf16_t* WT, LAS float* scr, int kb, int nb, int lane) {
    const int k0 = 64 * kb, n0 = 32 * nb;
    const int sc = colmap<MAP>(n0 + (lane & 31), Nsrc);
#pragma unroll 8
    for (int i = 0; i < 32; ++i) { const int kk = 2 * i + (lane >> 5); float w = 0.f; if (sc >= 0) w = W[(size_t)(k0 + kk) * Nsrc + sc]; if (gain) w *= gain[k0 + kk]; scr[kk * 33 + (lane & 31)] = w; }
    WSYNC();
    const int c = lane & 7;
#pragma unroll
    for (int j = 0; j < 4; ++j) { const int n = (lane >> 3) + 8 * j; const LAS float* s = scr + (8 * c) * 33 + n;
        u32x4 o; o.x = pk2(s[0 * 33], s[1 * 33]); o.y = pk2(s[2 * 33], s[3 * 33]); o.z = pk2(s[4 * 33], s[5 * 33]); o.w = pk2(s[6 * 33], s[7 * 33]);
        *(u32x4*)(WT + (size_t)(n0 + n) * K + k0 + 8 * c) = o; }
    WSYNC();
}


typedef float f32x16 __attribute__((ext_vector_type(16)));
typedef float f32x2v __attribute__((ext_vector_type(2)));
typedef __bf16 bf16x2_t __attribute__((ext_vector_type(2)));
constexpr int KSTR = 208, VSTR = 136;
constexpr int AL_K0 = 0, AL_K1 = 64 * KSTR, AL_V0 = 2 * 64 * KSTR, AL_V1 = AL_V0 + 64 * VSTR, AL_IMP = 45056, AL_SELM = AL_IMP + 32768, AL_OACC = AL_SELM + 1024;
constexpr float NEGB = -1e30f, LOG2E = 1.4426950408889634f;
DI unsigned cvtpk(float lo, float hi) { f32x2v v = {lo, hi}; bf16x2_t b = __builtin_convertvector(v, bf16x2_t); return __builtin_bit_cast(unsigned, b); }
DI f32x16 mfma32(bf16x8 a, bf16x8 b, f32x16 c) { return __builtin_amdgcn_mfma_f32_32x32x16_bf16(a, b, c, 0, 0, 0); }
DI float xhalf_max(float v) { auto rr = __builtin_amdgcn_permlane32_swap(__float_as_uint(v), __float_as_uint(v), false, false); return fmaxf(__uint_as_float(rr[0]), __uint_as_float(rr[1])); }
DI float xhalf_sum(float v) { auto rr = __builtin_amdgcn_permlane32_swap(__float_as_uint(v), __float_as_uint(v), false, false); return __uint_as_float(rr[0]) + __uint_as_float(rr[1]); }
DI float ex2(float x) { return __builtin_amdgcn_exp2f(x); }
template <int KSTEPS>
DI void qk_tile(const LAS unsigned char* Kt, const bf16x8 (&qf)[KSTEPS], int r32, int hi, f32x16& s0, f32x16& s1) {
    const LAS unsigned char* p0 = Kt + r32 * KSTR + hi * 16;
#pragma unroll
    for (int i = 0; i < 16; ++i) { s0[i] = 0.f; s1[i] = 0.f; }
#pragma unroll
    for (int ks = 0; ks < KSTEPS; ++ks) {
        const bf16x8 a0 = *(const LAS bf16x8*)(p0 + ks * 32), a1 = *(const LAS bf16x8*)(p0 + 32 * KSTR + ks * 32);
        s0 = mfma32(a0, qf[ks], s0); s1 = mfma32(a1, qf[ks], s1);
    }
}
DI void mask_tile(f32x16& s0, f32x16& s1, int klo, int khi, int hi) {
    const int lo_ = klo - 4 * hi, hi_ = khi - 4 * hi;
#pragma unroll
    for (int i = 0; i < 16; ++i) { const int kb = (i & 3) + 8 * (i >> 2); if (kb < lo_ || kb > hi_) s0[i] = NEGB; if (kb + 32 < lo_ || kb + 32 > hi_) s1[i] = NEGB; }
}
DI float tile_max(const f32x16& s0, const f32x16& s1) {
    float mx = fmaxf(s0[0], s1[0]);
#pragma unroll
    for (int i = 1; i < 16; ++i) mx = fmaxf(mx, fmaxf(s0[i], s1[i]));
    return xhalf_max(mx);
}
template <int BASE> DI bf16x8 pack8(const f32x16& s) { u32x4 p; p.x = cvtpk(s[BASE], s[BASE + 1]); p.y = cvtpk(s[BASE + 2], s[BASE + 3]); p.z = cvtpk(s[BASE + 4], s[BASE + 5]); p.w = cvtpk(s[BASE + 6], s[BASE + 7]); return __builtin_bit_cast(bf16x8, p); }
DI bf16x8 ld8x2(const bf16_t* p) { const u32x2 a = *(const u32x2*)p, b = *(const u32x2*)(p + 4); u32x4 w; w.x = a.x; w.y = a.y; w.z = b.x; w.w = b.y; return __builtin_bit_cast(bf16x8, w); }
DI bf16x8 vfrag(const LAS unsigned char* p) { const u32x2 a = *(const LAS u32x2*)p, b = *(const LAS u32x2*)(p + 16); u32x4 w; w.x = a.x; w.y = a.y; w.z = b.x; w.w = b.y; return __builtin_bit_cast(bf16x8, w); }
DI void pv_tile(const f32x16& s0, const f32x16& s1, const LAS unsigned char* Vt, f32x16 (&o)[2], int r32, int hi) {
    const bf16x8 p00 = pack8<0>(s0), p01 = pack8<8>(s0), p10 = pack8<0>(s1), p11 = pack8<8>(s1);
#pragma unroll
    for (int dt = 0; dt < 2; ++dt) { const LAS unsigned char* vp = Vt + (32 * dt + r32) * VSTR + 8 * hi;
        o[dt] = mfma32(vfrag(vp), p00, o[dt]); o[dt] = mfma32(vfrag(vp + 32), p01, o[dt]); o[dt] = mfma32(vfrag(vp + 64), p10, o[dt]); o[dt] = mfma32(vfrag(vp + 96), p11, o[dt]); }
}
DI void softmax_pv(f32x16& s0, f32x16& s1, const LAS unsigned char* Vt, f32x16 (&o)[2], float& m, float& l, int r32, int hi) {
    const float mx = tile_max(s0, s1), mn = fmaxf(m, mx), ms = mn < -1e29f ? 0.f : mn, alpha = ex2(m - ms);
    m = mn; float psum = 0.f;
#pragma unroll
    for (int i = 0; i < 16; ++i) { s0[i] = ex2(s0[i] - ms); s1[i] = ex2(s1[i] - ms); psum += s0[i] + s1[i]; }
    l = l * alpha + psum;
#pragma unroll
    for (int i = 0; i < 16; ++i) { o[0][i] *= alpha; o[1][i] *= alpha; }
    pv_tile(s0, s1, Vt, o, r32, hi);
}
template <class LoadF, class StoreF, class StepF>
DI void attn_pipeline(int jbeg, int jend, LoadF ld, StoreF st, StepF step) {
    if (jbeg > jend) return;
    ld(jbeg); st(0); __syncthreads();
    for (int j = jbeg; j <= jend; ++j) { const int cb = (j - jbeg) & 1;
        if (j < jend) ld(j + 1);
        step(j, cb);
        if (j < jend) st(cb ^ 1);
        __syncthreads(); }
}

DI const float* inp(const Args& a, int k) { asm volatile("" : "+s"(k)); return a.in[k]; }
__global__ void __launch_bounds__(NTHR, 2) fwd(Args args) {
    extern __shared__ __attribute__((aligned(16))) unsigned char lds_raw[];
    LAS unsigned char* lds = (LAS unsigned char*)lds_raw;
    LAS float* ldsf = (LAS float*)lds;
    volatile LAS unsigned* LCTL = (volatile LAS unsigned*)(lds + LDS_CTL);
    const int tid0 = threadIdx.x, wave = __builtin_amdgcn_readfirstlane(tid0 >> 6);
    const int G = gridDim.x, bid = blockIdx.x;
#define LAUNDER_TID() int tid = tid0; asm volatile("" : "+v"(tid)); const int lane = tid & 63; (void)lane
    unsigned char* ws = args.ws;
    unsigned* ctl = (unsigned*)(ws + WS_CTL);
    float* acc_base = (float*)(ws + WS_ACC);
    float* ssq0 = (float*)(ws + WS_SSQ0);
    float* hb = (float*)(ws + WS_HB);
    bf16_t* XB = (bf16_t*)(ws + WS_XB); bf16_t* Y = (bf16_t*)(ws + WS_Y); bf16_t* PB = (bf16_t*)(ws + WS_PB); bf16_t* ACT = (bf16_t*)(ws + WS_ACT);
    const float2* cs64 = (const float2*)(ws + WS_CS64); const float2* cs32 = (const float2*)(ws + WS_CS32);
    float* LRA = (float*)(ws + WS_XB); float* LRU_ = (float*)(ws + WS_XB + 32 * MiB);
    float* LA = (float*)(ws + WS_LA); float* LH = (float*)(ws + WS_LH); float* CIN = (float*)(ws + WS_CIN);
    float* KVC = (float*)(ws + WS_KVC); float* DEC = (float*)(ws + WS_DEC); float* SST = (float*)(ws + WS_SST);
    bf16_t* MQ = (bf16_t*)(ws + WS_MQ); bf16_t* MKN = (bf16_t*)(ws + WS_MKN); bf16_t* MVT = (bf16_t*)(ws + WS_MV); bf16_t* MKR = (bf16_t*)(ws + WS_MKR);
    bf16_t* VST = (bf16_t*)(ws + WS_VST); bf16_t* VWT = (bf16_t*)(ws + WS_VWT); bf16_t* KCMPB = (bf16_t*)(ws + WS_KCMPB); bf16_t* VCMPT = (bf16_t*)(ws + WS_VCMPT);
    const int* positions = (const int*)inp(args, 1);

    { LAUNDER_TID(); if (tid < 16) LCTL[tid] = 0u; }
    __syncthreads();
    const int lo = args.ph_lo, hi = args.ph_hi;
    XcdBarrier bar; bar.bar = ctl + CW_BAR; bar.x = 0; bar.st = LCTL;
    if (hi - lo > 1) bar = xcd_barrier_post(ctl + CW_BAR, LCTL);
#define IN(k) (lo <= (k) && (k) < hi)
#define SEAM(k) do { if (IN(k) && IN((k) + 1)) xcd_barrier(bar); } while (0)

    if (IN(0)) {
      _Pragma("unroll 1") for (int rep = 0; rep < REP_P0; ++rep) {
        LAUNDER_TID();
        const int gw = bid * 8 + wave, NGW = G * 8;
        LAS float* scr = ldsf + wave * 4096;
        constexpr int I_IN = 16 * 72, I_OUT = 16 * 32, I_GU = 16 * 176, I_DN = 44 * 32, I_L = I_IN + I_OUT + I_GU + I_DN;
        for (int it = gw; it < 2 * I_L; it += NGW) {
            const int l = it / I_L; int r = it % I_L;
            if (r < I_IN) { p0_transpose_item<0>(inp(args, 3) + (size_t)l * DM * NINS, DM, NINS, inp(args, 2) + l * DM, (bf16_t*)(ws + WS_WIN) + (size_t)l * NIN * DM, scr, r / 72, r % 72, lane); continue; } r -= I_IN;
            if (r < I_OUT) { p0_transpose_item<0>(inp(args, 23) + (size_t)l * DM * DM, DM, DM, inp(args, 22) + l * DM, (bf16_t*)(ws + WS_WOUT) + (size_t)l * DM * DM, scr, r / 32, r % 32, lane); continue; } r -= I_OUT;
            if (r < I_GU) { p0_transpose_item<1>(inp(args, 25) + (size_t)l * DM * NGU, DM, NGU, inp(args, 24) + l * DM, (bf16_t*)(ws + WS_WGU) + (size_t)l * NGU * DM, scr, r / 176, r % 176, lane); continue; } r -= I_GU;
            p0_transpose_item<0>(inp(args, 26) + (size_t)l * FF * DM, FF, DM, nullptr, (bf16_t*)(ws + WS_WDN) + (size_t)l * DM * FF, scr, r / 32, r % 32, lane);
        }
        { constexpr int I_UQ = 3 * 12, I_UKV = 2 * 16, I_W1 = 32 * 8, I_W2 = 4 * 2, I_S = 2 * I_UQ + 2 * I_UKV + 4 * I_W1 + 4 * I_W2;
          for (int it = gw; it < I_S; it += NGW) { int r = it;
              if (r < 2 * I_UQ) { const int l = r / I_UQ; r %= I_UQ; p0_transpose_item<0>(inp(args, 20) + (size_t)l * 192 * 384, 192, 384, inp(args, 18) + l * 192, (bf16_t*)(ws + WS_WUQT) + (size_t)l * 384 * 192, scr, r / 12, r % 12, lane); continue; } r -= 2 * I_UQ;
              if (r < 2 * I_UKV) { const int l = r / I_UKV; r %= I_UKV; p0_transpose_item<0>(inp(args, 21) + (size_t)l * 128 * 512, 128, 512, inp(args, 19) + l * 128, (bf16_t*)(ws + WS_WUKVT) + (size_t)l * 512 * 128, scr, r / 16, r % 16, lane); continue; } r -= 2 * I_UKV;
              if (r < 4 * I_W1) { const int lj = r / I_W1; r %= I_W1; p0_transpose_item<0>(inp(args, 12) + (size_t)lj * 2048 * 256, 2048, 256, nullptr, (bf16_t*)(ws + WS_W1T) + (size_t)lj * 256 * 2048, scr, r / 8, r % 8, lane); continue; } r -= 4 * I_W1;
              { const int lj = r / I_W2; r %= I_W2; p0_transpose_item<0>(inp(args, 14) + (size_t)lj * 256 * 64, 256, 64, nullptr, (bf16_t*)(ws + WS_W2T) + (size_t)lj * 64 * 256, scr, r / 2, r % 2, lane); } } }
        for (int m = gw; m < M; m += NGW) {
            const f32x4* xr = (const f32x4*)(inp(args, 0) + (size_t)m * DM) + lane;
            f32x4 v[4]; float s = 0.f;
#pragma unroll
            for (int j = 0; j < 4; ++j) { v[j] = xr[64 * j]; s += v[j][0] * v[j][0] + v[j][1] * v[j][1] + v[j][2] * v[j][2] + v[j][3] * v[j][3]; }
            s = wave_sum(s);
            u32x2* o8 = (u32x2*)(XB + (size_t)m * DM) + lane;
#pragma unroll
            for (int j = 0; j < 4; ++j) { u32x2 w; w.x = pk2(v[j][0], v[j][1]); w.y = pk2(v[j][2], v[j][3]); o8[64 * j] = w; }
            if (lane == 0) ssq0[m] = s;
        }
        for (int e = bid * NTHR + tid; e < M * 32; e += G * NTHR) {
            const int m = e >> 5, i = e & 31; const float pos = (float)positions[m];
            const float invf = powf(10000.f, -(float)(2 * i) / 64.f); float sn, cs; sincosf(pos * invf, &sn, &cs);
            ((float2*)(ws + WS_CS64))[e] = make_float2(cs, sn);
            if (i < 16) { const float invf2 = powf(10000.f, -(float)(2 * i) / 32.f); sincosf(pos * invf2, &sn, &cs); ((float2*)(ws + WS_CS32))[m * 16 + i] = make_float2(cs, sn); }
        }
        for (int e = bid * NTHR + tid; e < 2 * 2 * 256; e += G * NTHR) {
            const int lj = e >> 8, c = e & 255; float a = inp(args, 13)[e];
            const float* pp = inp(args, 11) + (size_t)lj * 2048; const float* w1 = inp(args, 12) + (size_t)lj * 2048 * 256 + c;
            for (int i = 0; i < 2048; ++i) a += pp[i] * w1[(size_t)i * 256];
            hb[e] = a;
        }
      }
    }
    SEAM(0);

    for (int l = 0; l < 2; ++l) {
        const int pb = 1 + 7 * l;
        const float* ssq_mix = (l == 0) ? ssq0 : acc_base + 2 * M;
        float* ssq_out = acc_base + (size_t)l * M;
        float* ssq_down = acc_base + (size_t)(2 + l) * M;
        float* ssq_d = acc_base + (size_t)(4 + l) * M;
        if (IN(pb)) {
            pg8::Gemm g{XB, (const bf16_t*)(ws + WS_WIN) + (size_t)l * NIN * DM, M, NIN, DM}; pg8::StaticOrder S; S.init(M, NIN, G, bid);
            pg8::EpiInProj E{PB, NIN, ssq_mix};
            _Pragma("unroll 1") for (int rep = 0; rep < REP_G16; ++rep) pg8::gemm_phase<pg8::EpiInProj, pg8::StaticOrder, true, true>(lds, g, S, E);
        }
        SEAM(pb);
        if (IN(pb + 1)) {
        LAUNDER_TID();
            constexpr int N_J1 = 1024, N_J2 = 512, N_J3 = 512, N_J4 = 512, N_J4B = 128;
            {
            for (int r_ = bid; r_ < N_J4B * REP_P2; r_ += G) { const int r = r_ % N_J4B;
                    const int j = r & 1, g32 = (r >> 1) & 15, b = r >> 5; const int colb = j == 0 ? C_KC : C_VC; const int r32 = lane & 31, hi = lane >> 5;
                    LAS unsigned char* Tl = lds;
                    LAS unsigned char* Hl = lds + 69632;
                    for (int e = tid; e < 528 * 8; e += NTHR) { const int rr = e >> 3, c8 = e & 7, t = 512 * g32 + rr; u32x4 w = {0u, 0u, 0u, 0u};
                        if (t < SEQ) { const bf16_t* pr = PB + ((size_t)b * SEQ + t) * NIN + colb;
                            if (j == 0) { const u32x4 a = *(const u32x4*)(pr + 8 * (c8 & 3)), c = *(const u32x4*)(pr + 32 + 8 * (c8 & 3)); const float2* cs = cs64 + ((size_t)b * SEQ + t) * 32 + 8 * (c8 & 3);
                                const unsigned au[4] = {a.x, a.y, a.z, a.w}, cu[4] = {c.x, c.y, c.z, c.w}; unsigned ou[4];
#pragma unroll
                                for (int q = 0; q < 4; ++q) { const float2 s0 = cs[2 * q], s1 = cs[2 * q + 1]; const float x1a = bflo(au[q]), x1b = bfhi(au[q]), x2a = bflo(cu[q]), x2b = bfhi(cu[q]);
                                    ou[q] = c8 < 4 ? pk2(x1a * s0.x - x2a * s0.y, x1b * s1.x - x2b * s1.y) : pk2(x2a * s0.x + x1a * s0.y, x2b * s1.x + x1b * s1.y); }
                                w.x = ou[0]; w.y = ou[1]; w.z = ou[2]; w.w = ou[3]; }
                            else w = *(const u32x4*)(pr + 8 * c8); }
                        *(LAS u32x4*)(Tl + rr * 128 + (rr >> 4) * 16 + c8 * 16) = w; }
                    __syncthreads();
                    { const bf16_t* w1t = (const bf16_t*)(ws + WS_W1T) + ((size_t)(l * 2 + j) * 256 + 32 * wave + r32) * 2048 + 8 * hi;
                      f32x16 acc;
#pragma unroll
                      for (int i = 0; i < 16; ++i) acc[i] = 0.f;
#pragma unroll 8
                      for (int kk = 0; kk < 128; ++kk) { const int rowt = 16 * r32 + (kk >> 2);
                          const bf16x8 a = *(const LAS bf16x8*)(Tl + rowt * 128 + (rowt >> 4) * 16 + 32 * (kk & 3) + 16 * hi);
                          const bf16x8 bw = *(const bf16x8*)(w1t + 16 * kk);
                          acc = mfma32(a, bw, acc); }
                      const float hbv = hb[(l * 2 + j) * 256 + 32 * wave + r32];
#pragma unroll
                      for (int i = 0; i < 16; ++i) { const int n = (i & 3) + 8 * (i >> 2) + 4 * hi; *(LAS bf16_t*)(Hl + n * 528 + (32 * wave + r32) * 2) = f2bf(gelu_tanh(acc[i] + hbv)); } }
                    __syncthreads();
                    if (wave < 2) { const bf16_t* w2t = (const bf16_t*)(ws + WS_W2T) + ((size_t)(l * 2 + j) * 64 + 32 * wave + r32) * 256 + 8 * hi;
                      f32x16 acc;
#pragma unroll
                      for (int i = 0; i < 16; ++i) acc[i] = 0.f;
#pragma unroll
                      for (int kk = 0; kk < 16; ++kk) { const bf16x8 a = *(const LAS bf16x8*)(Hl + r32 * 528 + 32 * kk + 16 * hi); const bf16x8 bw = *(const bf16x8*)(w2t + 16 * kk); acc = mfma32(a, bw, acc); }
                      const int dd = 32 * wave + r32;
#pragma unroll
                      for (int g = 0; g < 4; ++g) { const int n0 = 32 * g32 + 8 * g + 4 * hi; float v[4];
#pragma unroll
                          for (int q = 0; q < 4; ++q) v[q] = (n0 + q < 511) ? acc[4 * g + q] : 0.f;
                          if (j == 0) {
#pragma unroll
                              for (int q = 0; q < 4; ++q) KCMPB[((size_t)b * 512 + n0 + q) * 64 + dd] = f2bf(v[q]); }
                          else { u32x2 w; w.x = pk2(v[0], v[1]); w.y = pk2(v[2], v[3]); *(u32x2*)(VCMPT + ((size_t)b * 64 + dd) * 512 + n0) = w; } } }
                    __syncthreads();
            }
            if (bid < N_J3) {
                const int fr = lane & 15, kq = lane >> 4, hh = wave >> 1, odd = wave & 1;
                {
                    bf16x8 bq[3][6];
                    { const bf16_t* wq = (const bf16_t*)(ws + WS_WUQT) + (size_t)l * 384 * 192;
#pragma unroll
                      for (int nt = 0; nt < 3; ++nt)
#pragma unroll
                          for (int ks = 0; ks < 6; ++ks) bq[nt][ks] = *(const bf16x8*)(wq + (size_t)(48 * wave + 16 * nt + fr) * 192 + 32 * ks + 8 * kq); }
                    for (int r_ = bid; r_ < N_J3 * REP_P2; r_ += G) { const int r = r_ % N_J3;
                        const size_t row0 = (size_t)r * 64;
#pragma unroll 1
                        for (int mt = 0; mt < 4; ++mt) {
                            const bf16_t* pa = PB + (row0 + mt * 16 + fr) * NIN;
                            bf16x8 aq[6]; float ssq_ = 0.f;
#pragma unroll
                            for (int ks = 0; ks < 6; ++ks) { aq[ks] = ld8x2(pa + C_DCQ + 32 * ks + 8 * kq);
#pragma unroll
                                for (int e = 0; e < 8; ++e) { const float v = bf2f((bf16_t)aq[ks][e]); ssq_ += v * v; } }
                            ssq_ += __shfl_xor(ssq_, 16); ssq_ += __shfl_xor(ssq_, 32);
                            const float rq_ = rsqrtf(ssq_ * (1.f / 192.f) + EPS);
                            f32x4 cq[3];
#pragma unroll
                            for (int nt = 0; nt < 3; ++nt) { cq[nt] = (f32x4){0.f, 0.f, 0.f, 0.f};
#pragma unroll
                                for (int ks = 0; ks < 6; ++ks) cq[nt] = __builtin_amdgcn_mfma_f32_16x16x32_bf16(aq[ks], bq[nt][ks], cq[nt], 0, 0, 0); }
                            const float SCQ = 0.10206207261596575f * LOG2E;
#pragma unroll
                            for (int i = 0; i < 4; ++i) {
                                const size_t row = row0 + mt * 16 + 4 * kq + i; const float rqi = __shfl(rq_, 4 * kq + i) * SCQ;
                                float q0 = cq[0][i] * rqi, q1 = cq[1][i] * rqi, q2 = cq[2][i] * rqi;
                                if (odd) { const float2 cs = cs32[row * 16 + fr]; const float x1 = q1, x2 = q2; q1 = x1 * cs.x - x2 * cs.y; q2 = x2 * cs.x + x1 * cs.y; }
                                bf16_t* mq = MQ + row * 384 + hh * 96 + 48 * odd + fr; mq[0] = f2bf(q0); mq[16] = f2bf(q1); mq[32] = f2bf(q2);
                            }
                            if (wave == mt) {
#pragma unroll
                                for (int q = 0; q < 4; ++q) { const int p = lane * 4 + q, tok = p >> 4, i = p & 15; const size_t row = row0 + mt * 16 + tok; const bf16_t* pr = PB + row * NIN + C_DKR;
                                    const float x1 = bf2f(pr[i]), x2 = bf2f(pr[16 + i]); const float2 cs = cs32[row * 16 + i];
                                    MKR[row * 32 + i] = f2bf(x1 * cs.x - x2 * cs.y); MKR[row * 32 + 16 + i] = f2bf(x2 * cs.x + x1 * cs.y); } }
                        }
                    }
                }
                {
                    bf16x8 bkv[4][4];
                    { const bf16_t* wkv = (const bf16_t*)(ws + WS_WUKVT) + (size_t)l * 512 * 128;
#pragma unroll
                      for (int nt = 0; nt < 4; ++nt)
#pragma unroll
                          for (int ks = 0; ks < 4; ++ks) bkv[nt][ks] = *(const bf16x8*)(wkv + (size_t)(64 * wave + 16 * nt + fr) * 128 + 32 * ks + 8 * kq); }
                    for (int r_ = bid; r_ < N_J3 * REP_P2; r_ += G) { const int r = r_ % N_J3;
                        const size_t row0 = (size_t)r * 64; const size_t bb = row0 / SEQ, t0 = row0 % SEQ;
#pragma unroll 1
                        for (int mt = 0; mt < 4; ++mt) {
                            const bf16_t* pa = PB + (row0 + mt * 16 + fr) * NIN;
                            bf16x8 akv[4]; float sskv_ = 0.f;
#pragma unroll
                            for (int ks = 0; ks < 4; ++ks) { akv[ks] = ld8x2(pa + C_DCKV + 32 * ks + 8 * kq);
#pragma unroll
                                for (int e = 0; e < 8; ++e) { const float v = bf2f((bf16_t)akv[ks][e]); sskv_ += v * v; } }
                            sskv_ += __shfl_xor(sskv_, 16); sskv_ += __shfl_xor(sskv_, 32);
                            const float rk_ = rsqrtf(sskv_ * (1.f / 128.f) + EPS);
                            f32x4 ckv[4];
#pragma unroll
                            for (int nt = 0; nt < 4; ++nt) { ckv[nt] = (f32x4){0.f, 0.f, 0.f, 0.f};
#pragma unroll
                                for (int ks = 0; ks < 4; ++ks) ckv[nt] = __builtin_amdgcn_mfma_f32_16x16x32_bf16(akv[ks], bkv[nt][ks], ckv[nt], 0, 0, 0); }
                            float rki[4];
#pragma unroll
                            for (int i = 0; i < 4; ++i) rki[i] = __shfl(rk_, 4 * kq + i);
                            if (!odd) {
#pragma unroll
                                for (int i = 0; i < 4; ++i) { bf16_t* mk = MKN + (row0 + mt * 16 + 4 * kq + i) * 256 + hh * 64 + fr;
                                    mk[0] = f2bf(ckv[0][i] * rki[i]); mk[16] = f2bf(ckv[1][i] * rki[i]); mk[32] = f2bf(ckv[2][i] * rki[i]); mk[48] = f2bf(ckv[3][i] * rki[i]); } }
                            else {
#pragma unroll
                                for (int nt = 0; nt < 4; ++nt) { u32x2 w; w.x = pk2(ckv[nt][0] * rki[0], ckv[nt][1] * rki[1]); w.y = pk2(ckv[nt][2] * rki[2], ckv[nt][3] * rki[3]);
                                    *(u32x2*)(MVT + ((bb * 4 + hh) * 64 + 16 * nt + fr) * SEQ + t0 + mt * 16 + 4 * kq) = w; } }
                        }
                    }
                }
            }
            for (int r_ = bid; r_ < N_J1 * REP_P2; r_ += G) { const int r = r_ % N_J1;
                    const int b = r >> 8, tb = r & 255, t0 = tb * 32, ch = tid & 255, half = tid >> 8;
                    LAS float* xa = ldsf; LAS float* xc = ldsf + 35 * 256;
                    for (int e = tid; e < 35 * 256; e += NTHR) { const int rr = e >> 8, c = e & 255, t = t0 - 3 + rr; float v = 0.f; if (t >= 0) v = bf2f(PB[(size_t)(b * SEQ + t) * NIN + C_AX + c]); xa[e] = v; }
                    __syncthreads();
                    { const float cw0 = inp(args, 4)[(l * 4 + 0) * 256 + ch], cw1 = inp(args, 4)[(l * 4 + 1) * 256 + ch], cw2 = inp(args, 4)[(l * 4 + 2) * 256 + ch], cw3 = inp(args, 4)[(l * 4 + 3) * 256 + ch], cb = inp(args, 5)[l * 256 + ch];
                      for (int tt = 0; tt < 16; ++tt) { const int rr = half * 16 + tt; xc[rr * 256 + ch] = cb + cw0 * xa[rr * 256 + ch] + cw1 * xa[(rr + 1) * 256 + ch] + cw2 * xa[(rr + 2) * 256 + ch] + cw3 * xa[(rr + 3) * 256 + ch]; } }
                    __syncthreads();
                    const int h = ch >> 6, cc = ch & 63;
                    LAS float* gR = ldsf + 67 * 256; LAS float* gI = gR + 32 * 256;
#pragma unroll 1
                    for (int pass = 0; pass < 2; ++pass) {
                        float wv[64]; const float* wsrc = (pass == 0 ? inp(args, 6) : inp(args, 8)) + ((size_t)(l * 4 + h) * 64) * 64 + cc; const float bias = (pass == 0 ? inp(args, 7) : inp(args, 9))[l * 256 + ch];
#pragma unroll
                        for (int i = 0; i < 64; ++i) wv[i] = wsrc[i * 64];
#pragma unroll 1
                        for (int tt = 0; tt < 16; ++tt) { const LAS f32x4* xr = (const LAS f32x4*)(xc + (half * 16 + tt) * 256 + h * 64); float a = bias;
#pragma unroll
                            for (int i4 = 0; i4 < 16; ++i4) { const f32x4 x = xr[i4]; a += x[0] * wv[4 * i4] + x[1] * wv[4 * i4 + 1] + x[2] * wv[4 * i4 + 2] + x[3] * wv[4 * i4 + 3]; }
                            (pass == 0 ? gR : gI)[(half * 16 + tt) * 256 + ch] = sigmoidf_(a); }
                    }
                    const float sp = log1pf(expf(-inp(args, 10)[l * 256 + ch]));
                    float hst = 0.f, Ac = 1.f;
#pragma unroll 1
                    for (int tt = 0; tt < 16; ++tt) {
                        const int rr = half * 16 + tt;
                        const float rg = gR[rr * 256 + ch], ig = gI[rr * 256 + ch], la = -8.f * rg * sp, av = expf(la), mult = sqrtf(-expm1f(2.f * la));
                        const float u = mult * (ig * xc[rr * 256 + ch]);
                        hst = av * hst + u; Ac *= av;
                        { const size_t ao = ((size_t)b * SEQ + t0 + rr) * 256 + ch; LRA[ao] = av; LRU_[ao] = u; }
                    }
                    const size_t so = ((size_t)(b * 512 + tb * 2 + half)) * 256 + ch;
                    LA[so] = Ac; LH[so] = hst;
                    __syncthreads();
            }
            for (int r_ = bid; r_ < N_J2 * REP_P2; r_ += G) { const int r = r_ % N_J2;
                    const int b = r >> 7, c = r & 127; const size_t row0 = (size_t)b * SEQ + 64 * c;
                    LAS float* glr = ldsf; LAS float* bb = ldsf + 1024; LAS float* kt = bb + 8192; LAS float* vv = kt + 8192;
                    for (int e = tid; e < 1024; e += NTHR) glr[e] = bf2f(PB[(row0 + (e >> 4)) * NIN + C_GLR + (e & 15)]);
                    __syncthreads();
                    for (int e = tid; e < 8192; e += NTHR) { const int t = e >> 7, kk = e & 127; float z = inp(args, 16)[l * 128 + kk];
#pragma unroll
                        for (int q = 0; q < 16; ++q) z += glr[t * 16 + q] * inp(args, 15)[(l * 16 + q) * 128 + kk];
                        bb[e] = (fminf(z, 0.f) - log1pf(expf(-fabsf(z)))) * (1.f / 16.f); }
                    __syncthreads();
                    if (tid < 128) { float run = 0.f; for (int t = 0; t < 64; ++t) { run += bb[t * 128 + tid]; bb[t * 128 + tid] = run; } }
                    __syncthreads();
                    for (int e = tid; e < 8192; e += NTHR) { const int t = e >> 7, kk = e & 127; kt[e] = bf2f(PB[(row0 + t) * NIN + C_CK + kk]) * expf(bb[63 * 128 + kk] - bb[e]); }
                    for (int e = tid; e < 16384; e += NTHR) vv[e] = bf2f(PB[(row0 + (e >> 8)) * NIN + C_CV + (e & 255)]);
                    __syncthreads();
                    { const int h = tid >> 7, k = (tid >> 2) & 31, v0 = (tid & 3) * 16; float a16[16];
#pragma unroll
                      for (int i = 0; i < 16; ++i) a16[i] = 0.f;
                      for (int t = 0; t < 64; ++t) { const float kv = kt[t * 128 + h * 32 + k]; const LAS f32x4* vp = (const LAS f32x4*)(vv + t * 256 + h * 64 + v0);
#pragma unroll
                          for (int i = 0; i < 4; ++i) { const f32x4 x = vp[i]; a16[4 * i] += kv * x[0]; a16[4 * i + 1] += kv * x[1]; a16[4 * i + 2] += kv * x[2]; a16[4 * i + 3] += kv * x[3]; } }
                      float* o = KVC + ((size_t)(b * 128 + c) * 4 + h) * 2048 + k * 64 + v0;
#pragma unroll
                      for (int i = 0; i < 16; ++i) o[i] = a16[i];
                      if (tid < 128) DEC[(size_t)(b * 128 + c) * 128 + tid] = expf(bb[63 * 128 + tid]); }
                    __syncthreads();
            }
            for (int r = bid; r < N_J4; r += G) {
                    const size_t row0 = (size_t)r * 64;
                    for (int e = tid; e < 64 * 192; e += NTHR) { const int tok = e / 192, p = e % 192, i = p & 31; const int base = p < 128 ? C_BQ + (p >> 5) * 64 : (p < 160 ? C_KS : C_KW); const float sc = p < 128 ? 0.125f * LOG2E : 1.f;
                        bf16_t* pr = PB + (row0 + tok) * NIN + base; const float x1 = bf2f(pr[i]), x2 = bf2f(pr[32 + i]); const float2 cs = cs64[(row0 + tok) * 32 + i];
                        pr[i] = f2bf((x1 * cs.x - x2 * cs.y) * sc); pr[32 + i] = f2bf((x2 * cs.x + x1 * cs.y) * sc); }
                    { LAS bf16_t* tl = (LAS bf16_t*)lds; const size_t bb = row0 / SEQ, t0 = row0 % SEQ;
                      for (int mtx = 0; mtx < 2; ++mtx) { const int tok = tid >> 3, c = tid & 7; const u32x4 w = *(const u32x4*)(PB + (row0 + tok) * NIN + (mtx ? C_VW : C_VS) + c * 8);
                          LAS bf16_t* dst = tl + mtx * 64 * 72 + tok * 72 + c * 8; dst[0] = (bf16_t)w.x; dst[1] = (bf16_t)(w.x >> 16); dst[2] = (bf16_t)w.y; dst[3] = (bf16_t)(w.y >> 16); dst[4] = (bf16_t)w.z; dst[5] = (bf16_t)(w.z >> 16); dst[6] = (bf16_t)w.w; dst[7] = (bf16_t)(w.w >> 16); }
                      __syncthreads();
                      for (int mtx = 0; mtx < 2; ++mtx) { const int d = tid >> 3, c8 = tid & 7; const LAS bf16_t* s = tl + mtx * 64 * 72 + (c8 * 8) * 72 + d;
                          u32x4 w; w.x = (unsigned)s[0] | ((unsigned)s[72] << 16); w.y = (unsigned)s[2 * 72] | ((unsigned)s[3 * 72] << 16); w.z = (unsigned)s[4 * 72] | ((unsigned)s[5 * 72] << 16); w.w = (unsigned)s[6 * 72] | ((unsigned)s[7 * 72] << 16);
                          *(u32x4*)((mtx ? VWT : VST) + (bb * 64 + d) * SEQ + t0 + c8 * 8) = w; }
                      __syncthreads(); }
            }
            }
        }
        SEAM(pb + 1);
        if (IN(pb + 2)) {
        LAUNDER_TID();
            constexpr int Q_J5 = 2, Q_J6 = 64, Q_ATT = 1024 * REP_ATT, Q_TOT = Q_J5 + Q_J6 + Q_ATT;
            for (;;) {
                if (tid == 0) LCTL[2] = __hip_atomic_fetch_add(ctl + CW_QUEUE + 64 * l, 1u, __ATOMIC_RELAXED, __HIP_MEMORY_SCOPE_AGENT);
                __syncthreads();
                int r = __builtin_amdgcn_readfirstlane((int)LCTL[2]);
                __syncthreads();
                if (r >= Q_TOT) break;
                if (r < Q_J5) {
                    const int e = r * NTHR + tid, b = e >> 8, ch = e & 255; float carry = 0.f;
                    for (int c0 = 0; c0 < 512; c0 += 8) { float av[8], hv[8];
#pragma unroll
                        for (int q = 0; q < 8; ++q) { const size_t so = ((size_t)(b * 512 + c0 + q)) * 256 + ch; av[q] = LA[so]; hv[q] = LH[so]; }
#pragma unroll
                        for (int q = 0; q < 8; ++q) { CIN[((size_t)(b * 512 + c0 + q)) * 256 + ch] = carry; carry = av[q] * carry + hv[q]; } }
                    continue;
                }
                r -= Q_J5;
                if (r < Q_J6) {
                    const int e = r * NTHR + tid, b = e >> 13, rem = e & 8191; float Sv = 0.f;
                    for (int c0 = 0; c0 < 128; c0 += 8) { float kv[8], dv[8];
#pragma unroll
                        for (int q = 0; q < 8; ++q) { kv[q] = KVC[(size_t)(b * 128 + c0 + q) * 8192 + rem]; dv[q] = DEC[(size_t)(b * 128 + c0 + q) * 128 + (rem >> 6)]; }
#pragma unroll
                        for (int q = 0; q < 8; ++q) { SST[(size_t)(b * 128 + c0 + q) * 8192 + rem] = Sv; Sv = dv[q] * Sv + kv[q]; } }
                    continue;
                }
                r -= Q_J6;
                const int r32 = lane & 31, hi = lane >> 5;
                const int rep = r >> 10; r &= 1023;
                const int grp = r >> 5, within = r & 31;
              {
                if (within >= 16) {
                    const int idx = within - 16, b = idx & 3, tb = 127 - (4 * grp + (idx >> 2));
                    const int tl = 8 * wave + (r32 >> 2), head = r32 & 3, T = 64 * tb + tl; const size_t row = (size_t)b * SEQ + T; const bf16_t* prow = PB + row * NIN;
                    bf16x8 qf[4];
#pragma unroll
                    for (int ks = 0; ks < 4; ++ks) qf[ks] = *(const bf16x8*)(prow + C_BQ + head * 64 + 16 * ks + 8 * hi);
                    const float g0 = sigmoidf_(bf2f(prow[C_BG + head * 3])), g1 = sigmoidf_(bf2f(prow[C_BG + head * 3 + 1])), g2 = sigmoidf_(bf2f(prow[C_BG + head * 3 + 2]));
                    LAS float* impb = (LAS float*)(lds + AL_IMP) + wave * 1024; LAS unsigned* selm = (LAS unsigned*)(lds + AL_SELM) + wave * 32;
                    u32x4 rk, rv;
                    const int skey = tid >> 3, sch = tid & 7;
                    auto stK = [&](int buf) { *(LAS u32x4*)(lds + (buf ? AL_K1 : AL_K0) + skey * KSTR + sch * 16) = rk; };
                    auto stKV = [&](int buf) { *(LAS u32x4*)(lds + (buf ? AL_K1 : AL_K0) + skey * KSTR + sch * 16) = rk;
                        LAS unsigned char* vd = lds + (buf ? AL_V1 : AL_V0) + skey * VSTR + sch * 16; u32x2 a, c; a.x = rv.x; a.y = rv.y; c.x = rv.z; c.y = rv.w; *(LAS u32x2*)vd = a; *(LAS u32x2*)(vd + 8) = c; };
                    f32x16 oacc[2], ob[2];
                    const int nv = T >= 31 ? ((T - 31) >> 4) + 1 : 0, ntc = (4 * tb + 3 + 63) >> 6;
                    float mC = NEGB, lC = 0.f;
                    { const bf16_t* kb_ = KCMPB + (size_t)b * 512 * 64;
                      attn_pipeline(0, ntc - 1, [&](int j) { rk = *(const u32x4*)(kb_ + (size_t)(64 * j + skey) * 64 + sch * 8); }, stK,
                        [&](int j, int cb) { f32x16 s0, s1; qk_tile<4>(lds + (cb ? AL_K1 : AL_K0), qf, r32, hi, s0, s1); mask_tile(s0, s1, 0, nv - 1 - 64 * j, hi);
                            const float mx = tile_max(s0, s1), mn = fmaxf(mC, mx), ms = mn < -1e29f ? 0.f : mn, alpha = ex2(mC - ms); mC = mn; float ps = 0.f;
#pragma unroll
                            for (int i = 0; i < 16; ++i) ps += ex2(s0[i] - ms) + ex2(s1[i] - ms);
                            lC = lC * alpha + ps; }); }
                    { const float invC = 1.f / fmaxf(xhalf_sum(lC), 1e-30f), msC = mC < -1e29f ? 0.f : mC; float carry = 0.f;
#pragma unroll
                      for (int i = 0; i < 16; ++i) { ob[0][i] = 0.f; ob[1][i] = 0.f; }
                      const bf16_t* kb_ = KCMPB + (size_t)b * 512 * 64; const bf16_t* vb_ = VCMPT + (size_t)b * 64 * 512;
                      attn_pipeline(0, ntc - 1, [&](int j) { rk = *(const u32x4*)(kb_ + (size_t)(64 * j + skey) * 64 + sch * 8); rv = *(const u32x4*)(vb_ + (size_t)skey * 512 + 64 * j + sch * 8); }, stKV,
                        [&](int j, int cb) { f32x16 s0, s1; qk_tile<4>(lds + (cb ? AL_K1 : AL_K0), qf, r32, hi, s0, s1); mask_tile(s0, s1, 0, nv - 1 - 64 * j, hi);
#pragma unroll
                            for (int i = 0; i < 16; ++i) { s0[i] = ex2(s0[i] - msC) * invC; s1[i] = ex2(s1[i] - msC) * invC; }
                            float gs[8], pl[8];
#pragma unroll
                            for (int q = 0; q < 4; ++q) { gs[q] = (s0[4 * q] + s0[4 * q + 1]) + (s0[4 * q + 2] + s0[4 * q + 3]); gs[4 + q] = (s1[4 * q] + s1[4 * q + 1]) + (s1[4 * q + 2] + s1[4 * q + 3]);
                                pl[q] = __shfl_xor(s0[4 * q + 3], 32); pl[4 + q] = __shfl_xor(s1[4 * q + 3], 32); }
#pragma unroll
                            for (int q = 0; q < 8; ++q) { const float prev = hi ? pl[q] : (q > 0 ? pl[q > 0 ? q - 1 : 0] : carry); float x = gs[q] + prev; x += __shfl_xor(x, 1); x += __shfl_xor(x, 2);
                                if ((r32 & 3) == 0) impb[(r32 >> 2) * 128 + 16 * j + 2 * q + hi] = x; }
                            carry = pl[7];
                            pv_tile(s0, s1, lds + (cb ? AL_V1 : AL_V0), ob, r32, hi); }); }
                    LAS float* oav = (LAS float*)(lds + AL_OACC) + tid;
#pragma unroll
                    for (int i = 0; i < 16; ++i) { oav[i * 512] = g0 * ob[0][i]; oav[(16 + i) * 512] = g0 * ob[1][i]; }
                    WSYNC();
                    for (int tk = 0; tk < 8; ++tk) {
                        const int cur = tb, j0 = lane, j1 = lane + 64; LAS float* sb = impb + tk * 128; const float im0 = sb[j0], im1 = sb[j1];
                        const float s0 = (j0 == 0 || j0 == cur || j0 == cur - 1) ? 1e9f : (j0 <= cur ? im0 : -1e30f);
                        const float s1 = (j1 == cur || j1 == cur - 1) ? 1e9f : (j1 <= cur ? im1 : -1e30f);
                        WSYNC(); sb[j0] = s0; sb[j1] = s1; WSYNC();
                        int rk0 = 0, rk1 = 0;
#pragma unroll 4
                        for (int c4 = 0; c4 < 32; ++c4) { const f32x4 v = ((const LAS f32x4*)sb)[c4];
#pragma unroll
                            for (int q = 0; q < 4; ++q) { const int jj = 4 * c4 + q; const float x = v[q];
                                rk0 += (x > s0 || (x == s0 && jj < j0)) ? 1 : 0; rk1 += (x > s1 || (x == s1 && jj < j1)) ? 1 : 0; } }
                        const unsigned long long m0 = __ballot(rk0 < 16), m1 = __ballot(rk1 < 16);
                        if (lane == 0) { selm[tk * 4] = (unsigned)m0; selm[tk * 4 + 1] = (unsigned)(m0 >> 32); selm[tk * 4 + 2] = (unsigned)m1; selm[tk * 4 + 3] = (unsigned)(m1 >> 32); }
                    }
                    WSYNC();
                    const unsigned sm0 = selm[(r32 >> 2) * 4], sm1 = selm[(r32 >> 2) * 4 + 1], sm2 = selm[(r32 >> 2) * 4 + 2], sm3 = selm[(r32 >> 2) * 4 + 3];
                    { float mB = NEGB, lB = 0.f;
#pragma unroll
                      for (int i = 0; i < 16; ++i) { ob[0][i] = 0.f; ob[1][i] = 0.f; }
                      const bf16_t* kb_ = PB + (size_t)b * SEQ * NIN + C_KS; const bf16_t* vb_ = VST + (size_t)b * 64 * SEQ;
                      attn_pipeline(0, tb, [&](int j) { rk = *(const u32x4*)(kb_ + (size_t)(64 * j + skey) * NIN + sch * 8); rv = *(const u32x4*)(vb_ + (size_t)skey * SEQ + 64 * j + sch * 8); }, stKV,
                        [&](int j, int cb) { const unsigned wsel = j < 32 ? sm0 : (j < 64 ? sm1 : (j < 96 ? sm2 : sm3)); const bool bit = (wsel >> (j & 31)) & 1u;
                            if (__any(bit)) { f32x16 s0, s1; qk_tile<4>(lds + (cb ? AL_K1 : AL_K0), qf, r32, hi, s0, s1);
                                if (j == tb || !__all(bit)) mask_tile(s0, s1, bit ? 0 : 64, j == tb ? tl : 63, hi);
                                softmax_pv(s0, s1, lds + (cb ? AL_V1 : AL_V0), ob, mB, lB, r32, hi); } });
                      const float sc = g1 / fmaxf(xhalf_sum(lB), 1e-30f);
#pragma unroll
                      for (int i = 0; i < 16; ++i) { oav[i * 512] += sc * ob[0][i]; oav[(16 + i) * 512] += sc * ob[1][i]; } }
                    { float mB = NEGB, lB = 0.f;
#pragma unroll
                      for (int i = 0; i < 16; ++i) { ob[0][i] = 0.f; ob[1][i] = 0.f; }
                      const bf16_t* kb_ = PB + (size_t)b * SEQ * NIN + C_KW; const bf16_t* vb_ = VWT + (size_t)b * 64 * SEQ;
                      attn_pipeline(tb >= 8 ? tb - 8 : 0, tb, [&](int j) { rk = *(const u32x4*)(kb_ + (size_t)(64 * j + skey) * NIN + sch * 8); rv = *(const u32x4*)(vb_ + (size_t)skey * SEQ + 64 * j + sch * 8); }, stKV,
                        [&](int j, int cb) { f32x16 s0, s1; qk_tile<4>(lds + (cb ? AL_K1 : AL_K0), qf, r32, hi, s0, s1);
                            if (j == tb || j == tb - 8) mask_tile(s0, s1, j == tb - 8 ? tl + 1 : 0, j == tb ? tl : 63, hi);
                            softmax_pv(s0, s1, lds + (cb ? AL_V1 : AL_V0), ob, mB, lB, r32, hi); });
                      const float sc = g2 / fmaxf(xhalf_sum(lB), 1e-30f);
#pragma unroll
                      for (int i = 0; i < 16; ++i) { oacc[0][i] = oav[i * 512] + sc * ob[0][i]; oacc[1][i] = oav[(16 + i) * 512] + sc * ob[1][i]; } }
                    { float ss = 0.f;
#pragma unroll
                      for (int i = 0; i < 16; ++i) ss += oacc[0][i] * oacc[0][i] + oacc[1][i] * oacc[1][i];
                      ss = xhalf_sum(ss); ss += __shfl_xor(ss, 1); ss += __shfl_xor(ss, 2);
                      const float rinv = rsqrtf(ss * (1.f / 256.f) + EPS);
#pragma unroll
                      for (int dt = 0; dt < 2; ++dt)
#pragma unroll
                          for (int g = 0; g < 4; ++g) { u32x2 w; w.x = cvtpk(oacc[dt][4 * g] * rinv, oacc[dt][4 * g + 1] * rinv); w.y = cvtpk(oacc[dt][4 * g + 2] * rinv, oacc[dt][4 * g + 3] * rinv);
                              *(u32x2*)(Y + row * DM + 256 + head * 64 + 32 * dt + 8 * g + 4 * hi) = w; } }
                    __syncthreads();
                    continue;
                }
                {
                    const int qb = 31 - grp, b = within >> 2, h = within & 3;
                    const int T = 256 * qb + 32 * wave + r32; const size_t row = (size_t)b * SEQ + T;
                    bf16x8 qf[6];
#pragma unroll
                    for (int ks = 0; ks < 6; ++ks) qf[ks] = *(const bf16x8*)(MQ + row * 384 + h * 96 + 16 * ks + 8 * hi);
                    f32x16 o[2];
#pragma unroll
                    for (int i = 0; i < 16; ++i) { o[0][i] = 0.f; o[1][i] = 0.f; }
                    float m = NEGB, l = 0.f;
                    const int jd = 4 * qb + (wave >> 1), jend = 4 * qb + 3;
                    const bf16_t* kn = MKN + (size_t)b * SEQ * 256 + h * 64; const bf16_t* kr = MKR + (size_t)b * SEQ * 32; const bf16_t* vt = MVT + (size_t)(b * 4 + h) * 64 * SEQ;
                    const int key0 = tid / 12, ch0 = tid % 12, key1 = (512 + tid) / 12, ch1 = (512 + tid) % 12, vd_ = tid >> 3, vc8 = tid & 7;
                    u32x4 r0, r1, rv;
                    attn_pipeline(0, jend,
                        [&](int j) { r0 = ch0 < 8 ? *(const u32x4*)(kn + (size_t)(64 * j + key0) * 256 + ch0 * 8) : *(const u32x4*)(kr + (size_t)(64 * j + key0) * 32 + (ch0 - 8) * 8);
                            if (tid < 256) r1 = ch1 < 8 ? *(const u32x4*)(kn + (size_t)(64 * j + key1) * 256 + ch1 * 8) : *(const u32x4*)(kr + (size_t)(64 * j + key1) * 32 + (ch1 - 8) * 8);
                            rv = *(const u32x4*)(vt + (size_t)vd_ * SEQ + 64 * j + vc8 * 8); },
                        [&](int buf) { *(LAS u32x4*)(lds + (buf ? AL_K1 : AL_K0) + key0 * KSTR + ch0 * 16) = r0;
                            if (tid < 256) *(LAS u32x4*)(lds + (buf ? AL_K1 : AL_K0) + key1 * KSTR + ch1 * 16) = r1;
                            LAS unsigned char* vd = lds + (buf ? AL_V1 : AL_V0) + vd_ * VSTR + vc8 * 16; u32x2 a, c; a.x = rv.x; a.y = rv.y; c.x = rv.z; c.y = rv.w; *(LAS u32x2*)vd = a; *(LAS u32x2*)(vd + 8) = c; },
                        [&](int j, int cb) { if (j <= jd) { f32x16 s0, s1; qk_tile<6>(lds + (cb ? AL_K1 : AL_K0), qf, r32, hi, s0, s1);
                                if (j == jd) mask_tile(s0, s1, 0, 32 * (wave & 1) + r32, hi);
                                softmax_pv(s0, s1, lds + (cb ? AL_V1 : AL_V0), o, m, l, r32, hi); } });
                    { const float inv = 1.f / fmaxf(xhalf_sum(l), 1e-30f); float ss = 0.f;
#pragma unroll
                      for (int dt = 0; dt < 2; ++dt)
#pragma unroll
                          for (int g = 0; g < 4; ++g) { const float v0 = o[dt][4 * g] * inv, v1 = o[dt][4 * g + 1] * inv, v2 = o[dt][4 * g + 2] * inv, v3 = o[dt][4 * g + 3] * inv; ss += v0 * v0 + v1 * v1 + v2 * v2 + v3 * v3;
                              u32x2 w; w.x = cvtpk(v0, v1); w.y = cvtpk(v2, v3); *(u32x2*)(Y + row * DM + 768 + h * 64 + 32 * dt + 8 * g + 4 * hi) = w; }
                      ss = xhalf_sum(ss); if (hi == 0 && rep == 0) atomicAdd(ssq_d + row, ss); }
                    __syncthreads();
                }
              }
            }
        }
        SEAM(pb + 2);
        if (IN(pb + 3)) {
        LAUNDER_TID();
            constexpr int N_J9 = 1024, N_J10 = 512, N_J11 = 256, N_P4 = N_J9 + N_J10 + N_J11;
            _Pragma("unroll 1") for (int rep = 0; rep < REP_P4; ++rep)
            for (int it = bid; it < N_P4; it += G) {
                int r = it;
                if (rep > 0 && r >= N_J9 + N_J10) continue;
                if (r < N_J9) {
                    const int b = r >> 8, tb = r & 255, t0 = tb * 32, ch = tid & 255, half = tid >> 8;
                    LAS float* xa = ldsf;
                    float hst = CIN[((size_t)(b * 512 + tb * 2 + half)) * 256 + ch];
                    { float av[16], uv[16], gv[16];
#pragma unroll
                      for (int tt = 0; tt < 16; ++tt) { const size_t ro = (size_t)b * SEQ + t0 + half * 16 + tt; av[tt] = LRA[ro * 256 + ch]; uv[tt] = LRU_[ro * 256 + ch]; gv[tt] = bf2f(PB[ro * NIN + C_AG + ch]); }
#pragma unroll
                      for (int tt = 0; tt < 16; ++tt) { hst = av[tt] * hst + uv[tt]; xa[(half * 16 + tt) * 256 + ch] = hst * gelu_tanh(gv[tt]); } }
                    __syncthreads();
                    for (int q = 0; q < 4; ++q) { const int rr = wave * 4 + q; const f32x4 v = ((const LAS f32x4*)(xa + rr * 256))[lane];
                        const float rinv = rsqrtf(wave_sum(v[0] * v[0] + v[1] * v[1] + v[2] * v[2] + v[3] * v[3]) * (1.f / 256.f) + EPS);
                        u32x2 w; w.x = pk2(v[0] * rinv, v[1] * rinv); w.y = pk2(v[2] * rinv, v[3] * rinv);
                        *(u32x2*)(Y + ((size_t)b * SEQ + t0 + rr) * DM + 4 * lane) = w; }
                    __syncthreads();
                    continue;
                }
                r -= N_J9;
                if (r < N_J10) {
                    const int b = r >> 7, c = r & 127; const size_t row0 = (size_t)b * SEQ + 64 * c;
                    LAS float* bL = ldsf; LAS float* glr = ldsf + 8192; LAS unsigned char* VTl = lds + 36864; LAS unsigned char* STl = lds + 71680; LAS float* SSX = (LAS float*)(lds + 92160);
                    for (int e = tid; e < 1024; e += NTHR) glr[e] = bf2f(PB[(row0 + (e >> 4)) * NIN + C_GLR + (e & 15)]);
                    for (int e = tid; e < 2048; e += NTHR) { const int jj = e >> 5, hc = e & 31, h = hc >> 3, c8 = hc & 7; const bf16_t* vsrc = PB + (row0 + jj) * NIN + C_CV + h * 64 + 8 * c8; const u32x2 wA = *(const u32x2*)vsrc, wB = *(const u32x2*)(vsrc + 4); u32x4 w; w.x = wA.x; w.y = wA.y; w.z = wB.x; w.w = wB.y;
                        LAS bf16_t* d = (LAS bf16_t*)(VTl + h * 8704 + (8 * c8) * VSTR) + jj;
                        d[0] = (bf16_t)w.x; d[VSTR / 2] = (bf16_t)(w.x >> 16); d[2 * (VSTR / 2)] = (bf16_t)w.y; d[3 * (VSTR / 2)] = (bf16_t)(w.y >> 16); d[4 * (VSTR / 2)] = (bf16_t)w.z; d[5 * (VSTR / 2)] = (bf16_t)(w.z >> 16); d[6 * (VSTR / 2)] = (bf16_t)w.w; d[7 * (VSTR / 2)] = (bf16_t)(w.w >> 16); }
                    for (int e = tid; e < 8192; e += NTHR) { const int h = e >> 11, k = (e >> 6) & 31, v = e & 63; *(LAS bf16_t*)(STl + h * 5120 + v * 80 + k * 2) = f2bf(SST[(size_t)(b * 128 + c) * 8192 + e]); }
                    __syncthreads();
                    for (int e = tid; e < 8192; e += NTHR) { const int t = e >> 7, kk = e & 127; float z = inp(args, 16)[l * 128 + kk];
#pragma unroll
                        for (int q = 0; q < 16; ++q) z += glr[t * 16 + q] * inp(args, 15)[(l * 16 + q) * 128 + kk];
                        bL[e] = (fminf(z, 0.f) - log1pf(expf(-fabsf(z)))) * (1.f / 16.f); }
                    __syncthreads();
                    if (tid < 128) { float run = 0.f; for (int t = 0; t < 64; ++t) { run += bL[t * 128 + tid]; bL[t * 128 + tid] = run; } }
                    __syncthreads();
                    { const int r32 = lane & 31, hi = lane >> 5, h = wave >> 1, ih = wave & 1, i = 32 * ih + r32; const float SCG = 0.17677669529663687f;
                      bf16x8 qrel[2], qabs[2], kt[2][2];
#pragma unroll
                      for (int ks = 0; ks < 2; ++ks) { const int k0 = h * 32 + 16 * ks + 8 * hi; const bf16x8 qv = ld8x2(PB + (row0 + i) * NIN + C_CQ + k0); u32x4 wr_, wa_; unsigned* pr_ = (unsigned*)&wr_; unsigned* pa_ = (unsigned*)&wa_;
#pragma unroll
                          for (int e2 = 0; e2 < 4; ++e2) { const float b0 = bL[i * 128 + k0 + 2 * e2], b1 = bL[i * 128 + k0 + 2 * e2 + 1], f0 = bL[31 * 128 + k0 + 2 * e2], f1 = bL[31 * 128 + k0 + 2 * e2 + 1];
                              const float q0 = bf2f((bf16_t)qv[2 * e2]) * SCG, q1 = bf2f((bf16_t)qv[2 * e2 + 1]) * SCG;
                              pr_[e2] = cvtpk(q0 * __expf(b0 - f0), q1 * __expf(b1 - f1)); pa_[e2] = cvtpk(q0 * __expf(b0), q1 * __expf(b1)); }
                          qrel[ks] = __builtin_bit_cast(bf16x8, wr_); qabs[ks] = __builtin_bit_cast(bf16x8, wa_); }
#pragma unroll
                      for (int jt = 0; jt < 2; ++jt)
#pragma unroll
                          for (int ks = 0; ks < 2; ++ks) { const int jr = 32 * jt + r32, k0 = h * 32 + 16 * ks + 8 * hi; const bf16x8 kv = ld8x2(PB + (row0 + jr) * NIN + C_CK + k0); u32x4 wk_; unsigned* pk_ = (unsigned*)&wk_;
#pragma unroll
                              for (int e2 = 0; e2 < 4; ++e2) { const float b0 = bL[jr * 128 + k0 + 2 * e2], b1 = bL[jr * 128 + k0 + 2 * e2 + 1], f0 = bL[31 * 128 + k0 + 2 * e2], f1 = bL[31 * 128 + k0 + 2 * e2 + 1];
                                  pk_[e2] = cvtpk(bf2f((bf16_t)kv[2 * e2]) * __expf(f0 - b0), bf2f((bf16_t)kv[2 * e2 + 1]) * __expf(f1 - b1)); }
                              kt[jt][ks] = __builtin_bit_cast(bf16x8, wk_); }
                      f32x16 o[2], s[2];
#pragma unroll
                      for (int q = 0; q < 16; ++q) { o[0][q] = 0.f; o[1][q] = 0.f; s[0][q] = 0.f; s[1][q] = 0.f; }
#pragma unroll
                      for (int ks = 0; ks < 2; ++ks) s[0] = mfma32(kt[0][ks], qrel[ks], s[0]);
                      if (ih) {
#pragma unroll
                          for (int ks = 0; ks < 2; ++ks) s[1] = mfma32(kt[1][ks], qrel[ks], s[1]); }
#pragma unroll
                      for (int q = 0; q < 16; ++q) { const int jr = (q & 3) + 8 * (q >> 2) + 4 * hi; if (jr > r32) { if (ih) s[1][q] = 0.f; else s[0][q] = 0.f; } }
                      const LAS unsigned char* VTh = VTl + h * 8704; const LAS unsigned char* STh = STl + h * 5120;
#pragma unroll
                      for (int dt = 0; dt < 2; ++dt) { const LAS unsigned char* vp = VTh + (32 * dt + r32) * VSTR + 8 * hi;
                          o[dt] = mfma32(vfrag(vp), pack8<0>(s[0]), o[dt]); o[dt] = mfma32(vfrag(vp + 32), pack8<8>(s[0]), o[dt]);
                          if (ih) { o[dt] = mfma32(vfrag(vp + 64), pack8<0>(s[1]), o[dt]); o[dt] = mfma32(vfrag(vp + 96), pack8<8>(s[1]), o[dt]); }
#pragma unroll
                          for (int ks = 0; ks < 2; ++ks) o[dt] = mfma32(*(const LAS bf16x8*)(STh + (32 * dt + r32) * 80 + 32 * ks + 16 * hi), qabs[ks], o[dt]); }
                      float ssh = 0.f;
#pragma unroll
                      for (int q = 0; q < 16; ++q) ssh += o[0][q] * o[0][q] + o[1][q] * o[1][q];
                      const float rh = rsqrtf(xhalf_sum(ssh) * (1.f / 64.f) + EPS); float ssg = 0.f;
#pragma unroll
                      for (int dt = 0; dt < 2; ++dt)
#pragma unroll
                          for (int g = 0; g < 4; ++g) { const int v0 = 32 * dt + 8 * g + 4 * hi; const u32x2 ogw = *(const u32x2*)(PB + (row0 + i) * NIN + C_OG + h * 64 + v0); const f32x4 gn = *(const f32x4*)(inp(args, 17) + l * 64 + v0);
                              const float og4[4] = {bflo(ogw.x), bfhi(ogw.x), bflo(ogw.y), bfhi(ogw.y)};
#pragma unroll
                              for (int q = 0; q < 4; ++q) { const float y = o[dt][4 * g + q] * rh * gn[q] * (og4[q] / (1.f + __expf(-og4[q]))); o[dt][4 * g + q] = y; ssg += y * y; } }
                      ssg = xhalf_sum(ssg); if (hi == 0) SSX[i * 4 + h] = ssg;
                      __syncthreads();
                      const f32x4 s4 = *(const LAS f32x4*)(SSX + i * 4); const float rinv = rsqrtf((s4[0] + s4[1] + s4[2] + s4[3]) * (1.f / 256.f) + EPS);
#pragma unroll
                      for (int dt = 0; dt < 2; ++dt)
#pragma unroll
                          for (int g = 0; g < 4; ++g) { u32x2 w; w.x = cvtpk(o[dt][4 * g] * rinv, o[dt][4 * g + 1] * rinv); w.y = cvtpk(o[dt][4 * g + 2] * rinv, o[dt][4 * g + 3] * rinv);
                              *(u32x2*)(Y + (row0 + i) * DM + 512 + h * 64 + 32 * dt + 8 * g + 4 * hi) = w; } }
                    __syncthreads();
                    continue;
                }
                r -= N_J10;
                {
                    for (int e = tid; e < 128 * 32; e += NTHR) { const size_t row = (size_t)r * 128 + (e >> 5); const int c8 = e & 31;
                        const float rinv = rsqrtf(ssq_d[row] * (1.f / 256.f) + EPS);
                        u32x4* p = (u32x4*)(Y + row * DM + 768 + 8 * c8); u32x4 w = *p;
                        w.x = pk2(bflo(w.x) * rinv, bfhi(w.x) * rinv); w.y = pk2(bflo(w.y) * rinv, bfhi(w.y) * rinv); w.z = pk2(bflo(w.z) * rinv, bfhi(w.z) * rinv); w.w = pk2(bflo(w.w) * rinv, bfhi(w.w) * rinv);
                        *p = w; }
                }
            }
        }
        SEAM(pb + 3);
        if (IN(pb + 4)) {
            pg8::Gemm g{Y, (const bf16_t*)(ws + WS_WOUT) + (size_t)l * DM * DM, M, DM, DM}; pg8::StaticOrder S; S.init(M, DM, G, bid);
            pg8::EpiResid E{l == 0 ? inp(args, 0) : (const float*)args.out, args.out, XB, ssq_out};
            pg8::gemm_phase<pg8::EpiResid, pg8::StaticOrder, true, true>(lds, g, S, E);
        }
        SEAM(pb + 4);
        if (IN(pb + 5)) {
            pg8::Gemm g{XB, (const bf16_t*)(ws + WS_WGU) + (size_t)l * NGU * DM, M, NGU, DM}; pg8::StaticOrder S; S.init(M, NGU, G, bid);
            pg8::EpiSwiglu E{ACT, ssq_out};
            _Pragma("unroll 1") for (int rep = 0; rep < REP_G16; ++rep) pg8::gemm_phase<pg8::EpiSwiglu, pg8::StaticOrder, true, true>(lds, g, S, E);
        }
        SEAM(pb + 5);
        if (IN(pb + 6)) {
            pg8::Gemm g{ACT, (const bf16_t*)(ws + WS_WDN) + (size_t)l * DM * FF, M, DM, FF}; pg8::StaticOrder S; S.init(M, DM, G, bid);
            pg8::EpiResid E{(const float*)args.out, args.out, XB, ssq_down};
            pg8::gemm_phase<pg8::EpiResid, pg8::StaticOrder, true, true>(lds, g, S, E);
        }
        SEAM(pb + 6);
    }
    if (IN(15)) {
        LAUNDER_TID();
        const float* ssqf = acc_base + 3 * (size_t)M; const int gw = bid * 8 + wave, NGW = G * 8;
        for (int m = gw; m < M; m += NGW) {
            const float rinv = rsqrtf(ssqf[m] * (1.f / DM) + EPS);
            f32x4* xr = (f32x4*)(args.out + (size_t)m * DM) + lane; const f32x4* gn = (const f32x4*)inp(args, 27) + lane;
#pragma unroll
            for (int j = 0; j < 4; ++j) { f32x4 v = xr[64 * j]; const f32x4 g = gn[64 * j]; v = v * rinv * g; xr[64 * j] = v; }
        }
    }
#undef IN
#undef SEAM
}

extern "C" void kernel_launch(void* const* d_in, const int* in_sizes, int n_in, void* d_out, int out_size, void* d_ws, size_t ws_size, hipStream_t stream) {
    static int grid = 0;
    if (grid == 0) {
        if (n_in != 28 || in_sizes[0] != M * DM || out_size != M * DM || ws_size < WS_END) { fprintf(stderr, "kernel_launch: unexpected shapes (n_in %d, ws %zu)\n", n_in, ws_size); grid = -1; return; }
        int dev = 0, cus = 0;
        if (hipGetDevice(&dev) != hipSuccess || hipDeviceGetAttribute(&cus, hipDeviceAttributeMultiprocessorCount, dev) != hipSuccess) { grid = -1; return; }
        if (hipFuncSetAttribute((const void*)fwd, hipFuncAttributeMaxDynamicSharedMemorySize, LDS_BYTES) != hipSuccess) { fprintf(stderr, "kernel_launch: hipFuncSetAttribute failed\n"); grid = -1; return; }
        int per_cu = 0;
        if (hipOccupancyMaxActiveBlocksPerMultiprocessor(&per_cu, (const void*)fwd, NTHR, LDS_BYTES) != hipSuccess || per_cu < 1) fprintf(stderr, "kernel_launch: occupancy query says %d\n", per_cu);
        (void)hipGetLastError();
        grid = cus;
    }
    if (grid < 0) return;
    (void)hipMemsetAsync((char*)d_ws + WS_CTL, 0, CTL_ZERO_BYTES, stream);
    Args a{};
    for (int i = 0; i < 28; ++i) a.in[i] = (const float*)d_in[i];
    a.out = (float*)d_out; a.ws = (unsigned char*)d_ws;
    if (MK_N_LAUNCHES == 1) { a.ph_lo = 0; a.ph_hi = 16; hipLaunchKernelGGL(fwd, dim3(grid), dim3(NTHR), LDS_BYTES, stream, a); }
    else for (int p = 0; p < 16; ++p) { a.ph_lo = p; a.ph_hi = p + 1; hipLaunchKernelGGL(fwd, dim3(grid), dim3(NTHR), LDS_BYTES, stream, a); }
}
```

```cpp
#include <hip/hip_runtime.h>
#include <cstdio>
#include <cstdint>

#ifndef MK_N_LAUNCHES
#define MK_N_LAUNCHES 1
#endif

#define REP_P0 1
#define REP_G16 1
#define REP_ATT 1
#define LAS __attribute__((address_space(3)))
#define DI __device__ __forceinline__
typedef unsigned short bf16_t;
typedef short bf16x8 __attribute__((ext_vector_type(8)));
typedef float f32x4 __attribute__((ext_vector_type(4)));
typedef unsigned u32x4 __attribute__((ext_vector_type(4)));
typedef unsigned u32x2 __attribute__((ext_vector_type(2)));

constexpr int NB = 4, SEQ = 8192, M = NB * SEQ, DM = 1024, NIN = 2304, NINS = 2300, FF = 2816, NGU = 2 * FF;
constexpr float EPS = 1e-6f;
constexpr int C_AX = 0, C_AG = 256, C_BQ = 512, C_KC = 768, C_VC = 832, C_KS = 896, C_VS = 960, C_KW = 1024, C_VW = 1088, C_BG = 1152,
              C_CQ = 1164, C_CK = 1292, C_CV = 1420, C_GLR = 1676, C_OG = 1692, C_DCQ = 1948, C_DCKV = 2140, C_DKR = 2268;
constexpr size_t MiB = 1u << 20;
constexpr size_t WS_CTL = 0, CTL_ZERO_BYTES = 1 * MiB;
constexpr size_t WS_ACC = 64 * 1024;
constexpr size_t WS_SSQ0 = 1 * MiB;
constexpr size_t WS_HB = 1 * MiB + 256 * 1024;
constexpr size_t WS_WIN = 2 * MiB, WS_WOUT = 11 * MiB, WS_WGU = 15 * MiB, WS_WDN = 37 * MiB;
constexpr size_t WS_WUQT = 48 * MiB, WS_WUKVT = 48 * MiB + 512 * 1024, WS_W2T = 49 * MiB, WS_W1T = 50 * MiB;
constexpr size_t WS_CS64 = 64 * MiB, WS_CS32 = 72 * MiB;
constexpr size_t WS_XB = 80 * MiB, WS_Y = 144 * MiB, WS_PB = 208 * MiB, WS_ACT = 208 * MiB;
constexpr size_t WS_LA = 384 * MiB, WS_LH = 386 * MiB, WS_CIN = 388 * MiB;
constexpr size_t WS_KVC = 392 * MiB, WS_DEC = 408 * MiB, WS_SST = 410 * MiB;
constexpr size_t WS_MQ = 428 * MiB, WS_MKN = 452 * MiB, WS_MV = 468 * MiB, WS_MKR = 484 * MiB;
constexpr size_t WS_SSP = 500 * MiB;
constexpr size_t WS_VST = 490 * MiB, WS_VWT = 494 * MiB, WS_KCMPB = 498 * MiB, WS_VCMPT = 499 * MiB, WS_END = 504 * MiB;
constexpr int CW_QUEUE = 64;
constexpr int CW_FLAG = 1024;
constexpr int CW_BAR = 4096;
constexpr int LDS_BYTES = 163840 - 256;
constexpr int LDS_CTL = LDS_BYTES - 64;
constexpr int NTHR = 512;

struct Args { const float* in[28]; float* out; unsigned char* ws; int ph_lo, ph_hi; };

DI float bf2f(bf16_t h) { return __uint_as_float(((unsigned)h) << 16); }
DI float bflo(unsigned u) { return __uint_as_float(u << 16); }
DI float bfhi(unsigned u) { return __uint_as_float(u & 0xffff0000u); }
DI bf16_t f2bf(float f) { unsigned u = __float_as_uint(f); return (bf16_t)((u + 0x7fffu + ((u >> 16) & 1u)) >> 16); }
DI unsigned pk2(float lo, float hi) { return (unsigned)f2bf(lo) | ((unsigned)f2bf(hi) << 16); }
DI float sum4p(const float* p, size_t row) { return (p[row] + p[(size_t)M + row]) + (p[2 * (size_t)M + row] + p[3 * (size_t)M + row]); }
DI float wave_sum(float v) {
#pragma unroll
    for (int o = 1; o < 64; o <<= 1) v += __shfl_xor(v, o);
    return v;
}
DI float wave_max(float v) {
#pragma unroll
    for (int o = 1; o < 64; o <<= 1) v = fmaxf(v, __shfl_xor(v, o));
    return v;
}
DI int wave_min_i(int v) {
#pragma unroll
    for (int o = 1; o < 64; o <<= 1) { int w = __shfl_xor(v, o); v = w < v ? w : v; }
    return v;
}
DI float sigmoidf_(float x) { return 1.f / (1.f + __expf(-x)); }
DI float gelu_tanh(float x) { const float u = 0.7978845608028654f * (x + 0.044715f * x * x * x); return 0.5f * x * (1.f + tanhf(u)); }
#define WSYNC() do { asm volatile("s_waitcnt lgkmcnt(0)" ::: "memory"); __builtin_amdgcn_wave_barrier(); } while (0)

namespace pg8 {
constexpr int BM = 256, BK = 64, HALF = 128, HTB = HALF * BK * 2, NXCD = 8, WGM = 8;
__host__ __device__ __forceinline__ int lds_byte(int r, int c) { const int st = (r >> 4) * 2 + (c >> 5), rr = r & 15, cc = c & 31, ob = rr * 64 + cc * 2; return st * 1024 + (ob ^ (((ob >> 9) & 1) << 5)); }
__host__ __device__ __forceinline__ void stage_rc(int b, int& R, int& C) { const int st = b / 1024, sb = b % 1024, swz = sb ^ (((sb >> 9) & 1) << 5); R = (st >> 1) * 16 + swz / 64; C = (st & 1) * 32 + (swz % 64) / 2; }
__host__ __device__ __forceinline__ int perm32(int rho) { const int n = rho >> 4, i = rho & 15; return 8 * (i >> 2) + 4 * n + (i & 3); }
struct Unit { int pm, pn; };
struct Gemm { const bf16_t* A; const bf16_t* Bt; int M, N, K; };
struct StaticOrder {
    int nM, nN, nwg, G, c;
    __host__ __device__ void init(int M_, int N_, int G_, int c_) { nM = M_ / BM; nN = N_ / BM; nwg = nM * nN; G = G_; c = c_; }
    __host__ __device__ bool next(int i, Unit& u) const {
        const long L = (long)i * G + c; if (L >= nwg) return false;
        int wgid = (int)L; { const int q = nwg / NXCD, r = nwg % NXCD, xcd = wgid % NXCD, off = wgid / NXCD; wgid = (xcd < r ? xcd * (q + 1) : r * (q + 1) + (xcd - r) * q) + off; }
        const int nig = WGM * nN, gid = wgid / nig, fm = gid * WGM, gsz = (nM - fm) < WGM ? (nM - fm) : WGM;
        u.pm = fm + ((wgid % nig) % gsz); u.pn = (wgid % nig) / gsz; return true;
    }
    __device__ __forceinline__ void a_ready(const Unit&) const {}
    __device__ __forceinline__ void done(const Unit&) const {}
};
DI unsigned cvt_pk_bf16(float lo, float hi) { unsigned r; asm volatile("v_cvt_pk_bf16_f32 %0, %1, %2" : "=v"(r) : "v"(lo), "v"(hi)); return r; }

struct EpiInProj {
    static constexpr bool PERM = true, AFTER_DRAIN = false, MIDSCALE = false;
    bf16_t* O; int ldc; const float* ssq;
    DI void operator()(const f32x4 (&acc)[2][2][4][2], const Unit& u, int wr, int wc, int fr, int fq) const {
        int row0 = u.pm * BM + wr * 64 + fr; asm volatile("" : "+v"(row0)); const int col0 = u.pn * BM + wc * 32 + 8 * fq;
#pragma unroll
        for (int ai = 0; ai < 2; ++ai)
#pragma unroll
            for (int m = 0; m < 4; ++m) {
                const int row = row0 + ai * HALF + m * 16;
                const float rinv = rsqrtf(sum4p(ssq, row) * (1.f / DM) + EPS);
                bf16_t* rowp = O + (size_t)row * ldc + col0;
#pragma unroll
                for (int bj = 0; bj < 2; ++bj) {
                    f32x4 v0 = acc[ai][bj][m][0] * rinv, v1 = acc[ai][bj][m][1] * rinv;
                    u32x4 w; w.x = cvt_pk_bf16(v0[0], v0[1]); w.y = cvt_pk_bf16(v0[2], v0[3]); w.z = cvt_pk_bf16(v1[0], v1[1]); w.w = cvt_pk_bf16(v1[2], v1[3]);
                    *(u32x4*)(rowp + bj * HALF) = w;
                }
            }
    }
};
template <bool MS> struct EpiResid {
    static constexpr bool PERM = true, AFTER_DRAIN = false, MIDSCALE = MS;
    bf16_t* xb; float* ssq_part; const float* ssq_mid; LAS float* ssl;
    DI void midscale(f32x4 (&acc)[2][2][4][2], const Unit& u, int wr, int fr) const {
        int row0 = u.pm * BM + wr * 64 + fr; asm volatile("" : "+v"(row0));
#pragma unroll
        for (int ai = 0; ai < 2; ++ai)
#pragma unroll
            for (int m = 0; m < 4; ++m) { const float s = rsqrtf(sum4p(ssq_mid, row0 + ai * HALF + m * 16) * (1.f / 256.f) + EPS);
#pragma unroll
                for (int bj = 0; bj < 2; ++bj) { acc[ai][bj][m][0] *= s; acc[ai][bj][m][1] *= s; } }
    }
    DI void operator()(const f32x4 (&acc)[2][2][4][2], const Unit& u, int wr, int wc, int fr, int fq) const {
        int rl0 = wr * 64 + fr; asm volatile("" : "+v"(rl0));
        const int col0 = u.pn * BM + wc * 32 + 8 * fq;
#pragma unroll
        for (int ai = 0; ai < 2; ++ai)
#pragma unroll
            for (int m = 0; m < 4; ++m) {
                const int rl = rl0 + ai * HALF + m * 16; const size_t row = (size_t)u.pm * BM + rl;
                float part = 0.f;
#pragma unroll
                for (int bj = 0; bj < 2; ++bj) {
                    u32x4* px = (u32x4*)(xb + row * DM + col0 + bj * HALF); const u32x4 xo = *px;
                    const f32x4 a0 = acc[ai][bj][m][0], a1 = acc[ai][bj][m][1];
                    const float v0 = a0[0] + bflo(xo.x), v1 = a0[1] + bfhi(xo.x), v2 = a0[2] + bflo(xo.y), v3 = a0[3] + bfhi(xo.y), v4 = a1[0] + bflo(xo.z), v5 = a1[1] + bfhi(xo.z), v6 = a1[2] + bflo(xo.w), v7 = a1[3] + bfhi(xo.w);
                    u32x4 w; w.x = cvt_pk_bf16(v0, v1); w.y = cvt_pk_bf16(v2, v3); w.z = cvt_pk_bf16(v4, v5); w.w = cvt_pk_bf16(v6, v7);
                    *px = w;
                    part += (v0 * v0 + v1 * v1) + (v2 * v2 + v3 * v3) + (v4 * v4 + v5 * v5) + (v6 * v6 + v7 * v7);
                }
                part += __shfl_xor(part, 16); part += __shfl_xor(part, 32);
                if (fq == 0) ssl[rl * 4 + wc] = part;
            }
        asm volatile("s_waitcnt lgkmcnt(0)" ::: "memory"); __builtin_amdgcn_s_barrier();
        int tq = threadIdx.x; asm volatile("" : "+v"(tq));
        if (tq < 256) { const f32x4 p = *(const LAS f32x4*)(ssl + tq * 4); ssq_part[(size_t)u.pn * M + (size_t)u.pm * BM + tq] = (p[0] + p[1]) + (p[2] + p[3]); }
    }
};
struct EpiSwiglu {
    static constexpr bool PERM = true, AFTER_DRAIN = false, MIDSCALE = false;
    bf16_t* act; const float* ssq;
    DI void operator()(const f32x4 (&acc)[2][2][4][2], const Unit& u, int wr, int wc, int fr, int fq) const {
        int row0 = u.pm * BM + wr * 64 + fr; asm volatile("" : "+v"(row0)); const int j0 = u.pn * 128 + wc * 16 + 4 * fq;
#pragma unroll
        for (int ai = 0; ai < 2; ++ai)
#pragma unroll
            for (int m = 0; m < 4; ++m) {
                const int row = row0 + ai * HALF + m * 16;
                const float rinv = rsqrtf(sum4p(ssq, row) * (1.f / DM) + EPS);
#pragma unroll
                for (int bj = 0; bj < 2; ++bj) {
                    const f32x4 g = acc[ai][bj][m][0] * rinv, up = acc[ai][bj][m][1] * rinv;
                    float a[4];
#pragma unroll
                    for (int i = 0; i < 4; ++i) a[i] = g[i] / (1.f + __expf(-g[i])) * up[i];
                    u32x2 w; w.x = cvt_pk_bf16(a[0], a[1]); w.y = cvt_pk_bf16(a[2], a[3]);
                    *(u32x2*)(act + (size_t)row * FF + j0 + bj * 64) = w;
                }
            }
    }
};

template <class Epi, class Sched, bool ALIGN_EPI = false, bool SP2 = false>
DI void gemm_phase(LAS unsigned char* lds, const Gemm g, const Sched& S, const Epi& E) {
    int tid_ = threadIdx.x; asm volatile("" : "+v"(tid_));
    const int tid = tid_, wid = __builtin_amdgcn_readfirstlane(tid >> 6), lane = tid & 63, wr = wid >> 2, wc = wid & 3, fr = lane & 15, fq = lane >> 4;
    const int K = g.K, nt = K / BK;
    unsigned voffA[2], voffB[2];
#pragma unroll
    for (int i = 0; i < 2; ++i) { int R, C; stage_rc(tid * 16 + i * 8192, R, C); const int Rb = Epi::PERM ? ((R & ~31) + perm32(R & 31)) : R;
        voffA[i] = (unsigned)(R * K + C) * 2u; voffB[i] = (unsigned)(Rb * K + C) * 2u; }
    const size_t kstep = (size_t)(BK * 2);
    const size_t hstep = (size_t)HALF * K * 2;
    const size_t tstep = 2 * hstep;
    const unsigned ldsw = (unsigned)wid * 1024u;
    const int aoff = lds_byte(wr * 64 + fr, fq * 8), boff = lds_byte(wc * 32 + fr, fq * 8);
#define PG8_SA(b, h) (((b) * 2 + (h)) * HTB)
#define PG8_SB(b, h) ((4 + (b) * 2 + (h)) * HTB)
#define PG8_STAGE(bufoff, gbase, voff) do { _Pragma("unroll") for (int _i = 0; _i < 2; ++_i) \
        __builtin_amdgcn_global_load_lds((const unsigned*)((const char*)(gbase) + (voff)[_i]), (LAS unsigned*)(lds + (bufoff) + ldsw + _i * 8192), 16, 0, 0); } while (0)
#define PG8_LDA(dst, b, h) do { _Pragma("unroll") for (int m = 0; m < 4; ++m) _Pragma("unroll") for (int k = 0; k < 2; ++k) dst[m][k] = *(const LAS bf16x8*)(lds + PG8_SA(b, h) + aoff + m * 2048 + k * 1024); } while (0)
#define PG8_LDB(dst, b, h) do { _Pragma("unroll") for (int n = 0; n < 2; ++n) _Pragma("unroll") for (int k = 0; k < 2; ++k) dst[n][k] = *(const LAS bf16x8*)(lds + PG8_SB(b, h) + boff + n * 2048 + k * 1024); } while (0)
#define PG8_MMA(ai, bj, At, Bt) do { __builtin_amdgcn_s_setprio(1); _Pragma("unroll") for (int m = 0; m < 4; ++m) _Pragma("unroll") for (int n = 0; n < 2; ++n) _Pragma("unroll") for (int k = 0; k < 2; ++k) \
        acc[ai][bj][m][n] = __builtin_amdgcn_mfma_f32_16x16x32_bf16(Bt[n][k], At[m][k], acc[ai][bj][m][n], 0, 0, 0); __builtin_amdgcn_s_setprio(0); } while (0)
#define PG8_WAIT_V(n) asm volatile("s_waitcnt vmcnt(" #n ")" ::: "memory")
#define PG8_WAIT_L(n) asm volatile("s_waitcnt lgkmcnt(" #n ")" ::: "memory")
#define PG8_BAR __builtin_amdgcn_s_barrier()
#define PG8_SCHED __builtin_amdgcn_sched_barrier(0)
    Unit cur, nxt; int ui = 0;
    if (!S.next(0, cur)) return;
    f32x4 acc[2][2][4][2];
#pragma unroll
    for (int a = 0; a < 2; ++a)
#pragma unroll
        for (int b = 0; b < 2; ++b)
#pragma unroll
            for (int m = 0; m < 4; ++m)
#pragma unroll
                for (int n = 0; n < 2; ++n) acc[a][b][m][n] = (f32x4){0.f, 0.f, 0.f, 0.f};
    bf16x8 At[4][2], B0[2][2], B1[2][2];
    const char* cA = (const char*)g.A + (size_t)cur.pm * tstep; const char* cB = (const char*)g.Bt + (size_t)cur.pn * tstep;
    S.a_ready(cur);
    if constexpr (SP2) {
        PG8_STAGE(PG8_SB(0, 0), cB, voffB); PG8_STAGE(PG8_SB(0, 1), cB + hstep, voffB); PG8_STAGE(PG8_SA(0, 0), cA, voffA); PG8_STAGE(PG8_SA(0, 1), cA + hstep, voffA);
        if (wr == 1) PG8_BAR;
        PG8_WAIT_V(2); PG8_BAR;
        PG8_STAGE(PG8_SB(1, 0), cB + kstep, voffB); PG8_STAGE(PG8_SA(1, 0), cA + kstep, voffA); PG8_STAGE(PG8_SB(1, 1), cB + hstep + kstep, voffB);
        PG8_WAIT_V(6); PG8_BAR;
    } else {
        PG8_STAGE(PG8_SB(0, 0), cB, voffB); PG8_STAGE(PG8_SA(0, 0), cA, voffA); PG8_STAGE(PG8_SB(0, 1), cB + hstep, voffB); PG8_STAGE(PG8_SA(0, 1), cA + hstep, voffA);
        if (wr == 1) PG8_BAR;
        PG8_WAIT_V(4); PG8_BAR;
        PG8_STAGE(PG8_SB(1, 0), cB + kstep, voffB); PG8_STAGE(PG8_SA(1, 0), cA + kstep, voffA); PG8_STAGE(PG8_SB(1, 1), cB + hstep + kstep, voffB);
        PG8_WAIT_V(6); PG8_BAR;
    }
    for (;;) {
        const bool has_next = S.next(ui + 1, nxt);
        const char* nA = has_next ? (const char*)g.A + (size_t)nxt.pm * tstep : cA; const char* nB = has_next ? (const char*)g.Bt + (size_t)nxt.pn * tstep : cB;
        for (int t = 0; t < nt; t += 2) {
            const bool last = (t == nt - 2);
            const char* a1 = cA + (size_t)(t + 1) * kstep;
            const char* a2 = last ? nA : cA + (size_t)(t + 2) * kstep; const char* b2 = last ? nB : cB + (size_t)(t + 2) * kstep;
            const char* a3 = a2 + kstep; const char* b3 = b2 + kstep;
            if (last && has_next) S.a_ready(nxt);
            if constexpr (SP2) {
            PG8_LDB(B0, 0, 0); PG8_LDB(B1, 0, 1); PG8_SCHED; PG8_LDA(At, 0, 0); PG8_STAGE(PG8_SA(1, 1), a1 + hstep, voffA);
            PG8_WAIT_V(8); PG8_WAIT_L(0); PG8_BAR; PG8_MMA(0, 0, At, B0); PG8_MMA(0, 1, At, B1); PG8_BAR; PG8_SCHED;
            PG8_LDA(At, 0, 1); PG8_STAGE(PG8_SB(0, 0), b2, voffB); PG8_STAGE(PG8_SB(0, 1), b2 + hstep, voffB); PG8_STAGE(PG8_SA(0, 0), a2, voffA);
            PG8_WAIT_V(8); PG8_WAIT_L(0); PG8_BAR; PG8_MMA(1, 0, At, B0); PG8_MMA(1, 1, At, B1); PG8_BAR; PG8_SCHED;
            PG8_LDB(B0, 1, 0); PG8_LDB(B1, 1, 1); PG8_SCHED; PG8_LDA(At, 1, 0); PG8_STAGE(PG8_SA(0, 1), a2 + hstep, voffA);
            PG8_WAIT_V(8); PG8_WAIT_L(0); PG8_BAR; PG8_MMA(0, 0, At, B0); PG8_MMA(0, 1, At, B1); PG8_BAR; PG8_SCHED;
            PG8_LDA(At, 1, 1); PG8_STAGE(PG8_SB(1, 0), b3, voffB); PG8_STAGE(PG8_SB(1, 1), b3 + hstep, voffB); PG8_STAGE(PG8_SA(1, 0), a3, voffA);
            PG8_WAIT_V(8); PG8_WAIT_L(0); PG8_BAR; PG8_MMA(1, 0, At, B0); PG8_MMA(1, 1, At, B1); PG8_BAR; PG8_SCHED;
            if constexpr (Epi::MIDSCALE) { if (t == 2) E.midscale(acc, cur, wr, fr); }
            } else {
            PG8_LDB(B0, 0, 0); PG8_SCHED; PG8_LDA(At, 0, 0); PG8_STAGE(PG8_SA(1, 1), a1 + hstep, voffA);
            PG8_WAIT_L(8); PG8_BAR; PG8_WAIT_L(0); PG8_MMA(0, 0, At, B0); PG8_BAR; PG8_SCHED;
            PG8_LDB(B1, 0, 1); PG8_STAGE(PG8_SB(0, 0), b2, voffB);
            PG8_BAR; PG8_WAIT_L(0); PG8_MMA(0, 1, At, B1); PG8_BAR;
            PG8_LDA(At, 0, 1); PG8_STAGE(PG8_SA(0, 0), a2, voffA);
            PG8_BAR; PG8_WAIT_L(0); PG8_MMA(1, 0, At, B0); PG8_BAR; PG8_SCHED;
            PG8_STAGE(PG8_SB(0, 1), b2 + hstep, voffB);
            PG8_WAIT_V(6); PG8_BAR; PG8_MMA(1, 1, At, B1); PG8_BAR;
            PG8_LDB(B0, 1, 0); PG8_SCHED; PG8_LDA(At, 1, 0); PG8_STAGE(PG8_SA(0, 1), a2 + hstep, voffA);
            PG8_WAIT_L(8); PG8_BAR; PG8_WAIT_L(0); PG8_MMA(0, 0, At, B0); PG8_BAR; PG8_SCHED;
            PG8_LDB(B1, 1, 1); PG8_STAGE(PG8_SB(1, 0), b3, voffB);
            PG8_BAR; PG8_WAIT_L(0); PG8_MMA(0, 1, At, B1); PG8_BAR;
            PG8_LDA(At, 1, 1); PG8_STAGE(PG8_SA(1, 0), a3, voffA);
            PG8_BAR; PG8_WAIT_L(0); PG8_MMA(1, 0, At, B0); PG8_BAR; PG8_SCHED;
            PG8_STAGE(PG8_SB(1, 1), b3 + hstep, voffB);
            PG8_WAIT_V(6); PG8_BAR; PG8_MMA(1, 1, At, B1); PG8_BAR;
            }
        }
        if constexpr (ALIGN_EPI) { if (wr == 0) PG8_BAR; }
        if constexpr (!Epi::AFTER_DRAIN) { E(acc, cur, wr, wc, fr, fq); S.done(cur); }
        if (!has_next) break;
#pragma unroll
        for (int a = 0; a < 2; ++a)
#pragma unroll
            for (int b = 0; b < 2; ++b)
#pragma unroll
                for (int m = 0; m < 4; ++m)
#pragma unroll
                    for (int n = 0; n < 2; ++n) acc[a][b][m][n] = (f32x4){0.f, 0.f, 0.f, 0.f};
        cur = nxt; cA = nA; cB = nB; ++ui;
        if constexpr (ALIGN_EPI) { if (wr == 1) PG8_BAR; }
    }
    PG8_WAIT_V(0);
    if constexpr (!ALIGN_EPI) { if (wr == 0) PG8_BAR; }
    PG8_BAR;
#undef PG8_SA
#undef PG8_SB
#undef PG8_STAGE
#undef PG8_LDA
#undef PG8_LDB
#undef PG8_MMA
#undef PG8_WAIT_V
#undef PG8_WAIT_L
#undef PG8_BAR
#undef PG8_SCHED
}
}

#define XB_TMO      128
#define XB_XCNT(j)  (256  + 64 * (j))
#define XB_XSUB(j)  (1280 + 64 * (j))
#define XB_XGEN(j)  (2304 + 64 * (j))
#define XB_TOP      3328
#define XB_TOPGEN   3392
#define XCD_BAR_WORDS 3456
#define XB_SPIN_CAP (1u << 18)
__device__ __forceinline__ unsigned xb_ld(unsigned* p)              { return __hip_atomic_load(p, __ATOMIC_RELAXED, __HIP_MEMORY_SCOPE_AGENT); }
__device__ __forceinline__ unsigned xb_add(unsigned* p, unsigned v) { return __hip_atomic_fetch_add(p, v, __ATOMIC_RELAXED, __HIP_MEMORY_SCOPE_AGENT); }
__device__ __forceinline__ unsigned xb_xcc_id() { return (unsigned)__builtin_amdgcn_s_getreg((3 << 11) | 20) & 0xFu; }
#define XB_SPIN(cond, bar) do { unsigned _sp = 0; while (cond) { __builtin_amdgcn_s_sleep(1); \
    if ((++_sp & 255u) == 0u) { if (xb_ld(&(bar)[XB_TMO])) break; if (_sp > XB_SPIN_CAP) { atomicAdd(&(bar)[XB_TMO], 1u); break; } } } } while (0)
struct XcdBarrier { unsigned* bar; unsigned x; volatile LAS unsigned* st; };
__device__ __forceinline__ XcdBarrier xcd_barrier_post(unsigned* bar, volatile LAS unsigned* st) {
    XcdBarrier b; b.bar = bar; b.x = xb_xcc_id(); b.st = st;
    if (threadIdx.x == 0) (void)xb_add(&bar[XB_XCNT(b.x)], 1u);
    return b;
}
__device__ __forceinline__ void xcd_barrier_complete(unsigned* bar, unsigned x, unsigned& nloc, unsigned& nx) {
    const unsigned G = gridDim.x * gridDim.y * gridDim.z;
    unsigned sum, cnt, mine, sp = 0u;
    for (;;) {
        sum = 0u; cnt = 0u; mine = 0u;
#pragma unroll
        for (unsigned j = 0; j < 16; ++j) { const unsigned c = xb_ld(&bar[XB_XCNT(j)]); sum += c; cnt += (c > 0u) ? 1u : 0u; mine = (j == x) ? c : mine; }
        if (sum == G) break;
        __builtin_amdgcn_s_sleep(1);
        if ((++sp & 255u) == 0u) { if (xb_ld(&bar[XB_TMO])) break; if (sp > XB_SPIN_CAP) { atomicAdd(&bar[XB_TMO], 1u); break; } }
    }
    nloc = mine > 0u ? mine : 1u; nx = cnt > 0u ? cnt : 1u;
}
__device__ __forceinline__ void xcd_barrier(const XcdBarrier& b) {
    asm volatile("s_waitcnt vmcnt(0)" ::: "memory");
    __syncthreads();
    if (threadIdx.x == 0) {
        unsigned* bar = b.bar;
        __builtin_amdgcn_s_waitcnt(0);
        unsigned nloc = b.st[0], nx = b.st[1];
        if (nloc == 0u) { xcd_barrier_complete(bar, b.x, nloc, nx); b.st[0] = nloc; b.st[1] = nx; }
        const unsigned old = xb_add(&bar[XB_XSUB(b.x)], 1u);
        const unsigned gen = old / nloc;
        if (old + 1u == (gen + 1u) * nloc) {
            __builtin_amdgcn_fence(__ATOMIC_RELEASE, "agent");
            asm volatile("s_waitcnt vmcnt(0)" ::: "memory");
            const unsigned og = xb_add(&bar[XB_TOP], 1u);
            const unsigned tg = og / nx;
            if (og + 1u == (tg + 1u) * nx) xb_add(&bar[XB_TOPGEN], 1u);
            else XB_SPIN(xb_ld(&bar[XB_TOPGEN]) == tg, bar);
            __builtin_amdgcn_fence(__ATOMIC_ACQUIRE, "agent");
            xb_add(&bar[XB_XGEN(b.x)], 1u);
            asm volatile("s_waitcnt vmcnt(0)" ::: "memory");
        } else {
            XB_SPIN(xb_ld(&bar[XB_XGEN(b.x)]) == gen, bar);
            __builtin_amdgcn_fence(__ATOMIC_ACQUIRE, "agent");
            asm volatile("s_waitcnt vmcnt(0)" ::: "memory");
        }
    }
    __syncthreads();
}

template <int MAP>
DI int colmap(int v, int Nsrc) {
    if (MAP == 0) return v < Nsrc ? v : -1;
    const int g8 = v >> 3, e = v & 7, j = 4 * g8 + (e & 3); return (e < 4) ? j : FF + j;
}
template <int MAP, int KROT = 0>
DI void p0_transpose_item(const float* W, int K, int Nsrc, const float* gain, bf16_t* WT, LAS float* scr, int kb, int nb, int lane) {
    const int k0 = 64 * kb, n0 = 32 * nb;
    const int sc = colmap<MAP>(n0 + (lane & 31), Nsrc);
#pragma unroll 8
    for (int i = 0; i < 32; ++i) { const int kk = 2 * i + (lane >> 5); int ksrc = k0 + kk + KROT; if (KROT && ksrc >= K) ksrc -= K; float w = 0.f; if (sc >= 0) w = W[(size_t)ksrc * Nsrc + sc]; if (gain) w *= gain[ksrc]; scr[kk * 33 + (lane & 31)] = w; }
    WSYNC();
    const int c = lane & 7;
#pragma unroll
    for (int j = 0; j < 4; ++j) { const int n = (lane >> 3) + 8 * j; const LAS float* s = scr + (8 * c) * 33 + n;
        u32x4 o; o.x = pk2(s[0 * 33], s[1 * 33]); o.y = pk2(s[2 * 33], s[3 * 33]); o.z = pk2(s[4 * 33], s[5 * 33]); o.w = pk2(s[6 * 33], s[7 * 33]);
        *(u32x4*)(WT + (size_t)(n0 + n) * K + k0 + 8 * c) = o; }
    WSYNC();
}


typedef float f32x16 __attribute__((ext_vector_type(16)));
typedef float f32x2v __attribute__((ext_vector_type(2)));
typedef __bf16 bf16x2_t __attribute__((ext_vector_type(2)));
constexpr int KSTR = 208, VSTR = 136;
constexpr int AL_K0 = 0, AL_K1 = 64 * KSTR, AL_V0 = 2 * 64 * KSTR, AL_V1 = AL_V0 + 64 * VSTR, AL_IMP = 45056, AL_SELM = AL_IMP + 32768, AL_OACC = AL_SELM + 1024;
constexpr float NEGB = -1e30f, LOG2E = 1.4426950408889634f;
DI unsigned cvtpk(float lo, float hi) { f32x2v v = {lo, hi}; bf16x2_t b = __builtin_convertvector(v, bf16x2_t); return __builtin_bit_cast(unsigned, b); }
DI f32x16 mfma32(bf16x8 a, bf16x8 b, f32x16 c) { return __builtin_amdgcn_mfma_f32_32x32x16_bf16(a, b, c, 0, 0, 0); }
DI float xhalf_max(float v) { auto rr = __builtin_amdgcn_permlane32_swap(__float_as_uint(v), __float_as_uint(v), false, false); return fmaxf(__uint_as_float(rr[0]), __uint_as_float(rr[1])); }
DI float xhalf_sum(float v) { auto rr = __builtin_amdgcn_permlane32_swap(__float_as_uint(v), __float_as_uint(v), false, false); return __uint_as_float(rr[0]) + __uint_as_float(rr[1]); }
DI float ex2(float x) { return __builtin_amdgcn_exp2f(x); }
template <int KSTEPS>
DI void qk_tile(const LAS unsigned char* Kt, const bf16x8 (&qf)[KSTEPS], int r32, int hi, f32x16& s0, f32x16& s1) {
    const LAS unsigned char* p0 = Kt + r32 * KSTR + hi * 16;
#pragma unroll
    for (int i = 0; i < 16; ++i) { s0[i] = 0.f; s1[i] = 0.f; }
#pragma unroll
    for (int ks = 0; ks < KSTEPS; ++ks) {
        const bf16x8 a0 = *(const LAS bf16x8*)(p0 + ks * 32), a1 = *(const LAS bf16x8*)(p0 + 32 * KSTR + ks * 32);
        s0 = mfma32(a0, qf[ks], s0); s1 = mfma32(a1, qf[ks], s1);
    }
}
DI void mask_tile(f32x16& s0, f32x16& s1, int klo, int khi, int hi) {
    const int lo_ = klo - 4 * hi, hi_ = khi - 4 * hi;
#pragma unroll
    for (int i = 0; i < 16; ++i) { const int kb = (i & 3) + 8 * (i >> 2); if (kb < lo_ || kb > hi_) s0[i] = NEGB; if (kb + 32 < lo_ || kb + 32 > hi_) s1[i] = NEGB; }
}
DI float tile_max(const f32x16& s0, const f32x16& s1) {
    float mx = fmaxf(s0[0], s1[0]);
#pragma unroll
    for (int i = 1; i < 16; ++i) mx = fmaxf(mx, fmaxf(s0[i], s1[i]));
    return xhalf_max(mx);
}
template <int BASE> DI bf16x8 pack8(const f32x16& s) { u32x4 p; p.x = cvtpk(s[BASE], s[BASE + 1]); p.y = cvtpk(s[BASE + 2], s[BASE + 3]); p.z = cvtpk(s[BASE + 4], s[BASE + 5]); p.w = cvtpk(s[BASE + 6], s[BASE + 7]); return __builtin_bit_cast(bf16x8, p); }
DI bf16x8 ld8x2(const bf16_t* p) { const u32x2 a = *(const u32x2*)p, b = *(const u32x2*)(p + 4); u32x4 w; w.x = a.x; w.y = a.y; w.z = b.x; w.w = b.y; return __builtin_bit_cast(bf16x8, w); }
DI bf16x8 vfrag(const LAS unsigned char* p) { const u32x2 a = *(const LAS u32x2*)p, b = *(const LAS u32x2*)(p + 16); u32x4 w; w.x = a.x; w.y = a.y; w.z = b.x; w.w = b.y; return __builtin_bit_cast(bf16x8, w); }
DI void pv_tile(const f32x16& s0, const f32x16& s1, const LAS unsigned char* Vt, f32x16 (&o)[2], int r32, int hi) {
    const bf16x8 p00 = pack8<0>(s0), p01 = pack8<8>(s0), p10 = pack8<0>(s1), p11 = pack8<8>(s1);
#pragma unroll
    for (int dt = 0; dt < 2; ++dt) { const LAS unsigned char* vp = Vt + (32 * dt + r32) * VSTR + 8 * hi;
        o[dt] = mfma32(vfrag(vp), p00, o[dt]); o[dt] = mfma32(vfrag(vp + 32), p01, o[dt]); o[dt] = mfma32(vfrag(vp + 64), p10, o[dt]); o[dt] = mfma32(vfrag(vp + 96), p11, o[dt]); }
}
DI void softmax_pv(f32x16& s0, f32x16& s1, const LAS unsigned char* Vt, f32x16 (&o)[2], float& m, float& l, int r32, int hi) {
    const float mx = tile_max(s0, s1), mn = fmaxf(m, mx), ms = mn < -1e29f ? 0.f : mn, alpha = ex2(m - ms);
    m = mn; float psum = 0.f;
#pragma unroll
    for (int i = 0; i < 16; ++i) { s0[i] = ex2(s0[i] - ms); s1[i] = ex2(s1[i] - ms); psum += s0[i] + s1[i]; }
    l = l * alpha + psum;
    if (!__all(alpha == 1.f)) {
#pragma unroll
        for (int i = 0; i < 16; ++i) { o[0][i] *= alpha; o[1][i] *= alpha; } }
    pv_tile(s0, s1, Vt, o, r32, hi);
}
struct StageRegs { u32x4 a, b, c; };
template <class LoadF, class StoreF, class StepF>
DI void attn_pipeline(int jbeg, int jend, LoadF ld, StoreF st, StepF step) {
    if (jbeg > jend) return;
    StageRegs RA, RB;
    ld(jbeg, RA); if (jbeg + 1 <= jend) ld(jbeg + 1, RB);
    st(0, RA); __syncthreads();
    for (int j = jbeg; j <= jend; j += 2) {
        if (j + 2 <= jend) ld(j + 2, RA);
        step(j, 0);
        if (j + 1 <= jend) st(1, RB);
        __syncthreads();
        if (j + 1 > jend) break;
        if (j + 3 <= jend) ld(j + 3, RB);
        step(j + 1, 1);
        if (j + 2 <= jend) st(0, RA);
        __syncthreads();
    }
}
DI const float* inp(const Args& a, int k) { asm volatile("" : "+s"(k)); return a.in[k]; }
__global__ void __launch_bounds__(NTHR, 2) fwd(Args args) {
    extern __shared__ __attribute__((aligned(16))) unsigned char lds_raw[];
    LAS unsigned char* lds = (LAS unsigned char*)lds_raw;
    LAS float* ldsf = (LAS float*)lds;
    volatile LAS unsigned* LCTL = (volatile LAS unsigned*)(lds + LDS_CTL);
    const int tid0 = threadIdx.x, wave = __builtin_amdgcn_readfirstlane(tid0 >> 6);
    const int G = gridDim.x, bid = blockIdx.x;
#define LAUNDER_TID() int tid = tid0; asm volatile("" : "+v"(tid)); const int lane = tid & 63; (void)lane
    unsigned char* ws = args.ws;
    unsigned* ctl = (unsigned*)(ws + WS_CTL);
    float* ssp_base = (float*)(ws + WS_SSP);
    float* hb = (float*)(ws + WS_HB);
    bf16_t* XB = (bf16_t*)(ws + WS_XB); bf16_t* Y = (bf16_t*)(ws + WS_Y); bf16_t* PB = (bf16_t*)(ws + WS_PB); bf16_t* ACT = (bf16_t*)(ws + WS_ACT);
    const float2* cs64 = (const float2*)(ws + WS_CS64); const float2* cs32 = (const float2*)(ws + WS_CS32);
    float* LRA = args.out; float* LRU_ = args.out + (size_t)M * 256;
    float* LA = (float*)(ws + WS_LA); float* LH = (float*)(ws + WS_LH); float* CIN = (float*)(ws + WS_CIN);
    float* KVC = (float*)(ws + WS_KVC); float* DEC = (float*)(ws + WS_DEC); float* SST = (float*)(ws + WS_SST);
    bf16_t* MQ = (bf16_t*)(ws + WS_MQ); bf16_t* MKN = (bf16_t*)(ws + WS_MKN); bf16_t* MVT = (bf16_t*)(ws + WS_MV); bf16_t* MKR = (bf16_t*)(ws + WS_MKR);
    bf16_t* VST = (bf16_t*)(ws + WS_VST); bf16_t* VWT = (bf16_t*)(ws + WS_VWT); bf16_t* KCMPB = (bf16_t*)(ws + WS_KCMPB); bf16_t* VCMPT = (bf16_t*)(ws + WS_VCMPT);
    const int* positions = (const int*)inp(args, 1);

    { LAUNDER_TID(); if (tid < 16) LCTL[tid] = 0u; }
    __syncthreads();
    const int lo = args.ph_lo, hi = args.ph_hi;
    XcdBarrier bar; bar.bar = ctl + CW_BAR; bar.x = 0; bar.st = LCTL;
    if (hi - lo > 1) bar = xcd_barrier_post(ctl + CW_BAR, LCTL);
#define IN(k) (lo <= (k) && (k) < hi)
#define SEAM(k) do { if (IN(k) && IN((k) + 1)) xcd_barrier(bar); } while (0)

    if (IN(0)) {
      _Pragma("unroll 1") for (int rep = 0; rep < REP_P0; ++rep) {
        LAUNDER_TID();
        const int gw = bid * 8 + wave, NGW = G * 8;
        LAS float* scr = ldsf + wave * 4096;
        constexpr int I_IN = 16 * 72, I_OUT = 16 * 32, I_GU = 16 * 176, I_DN = 44 * 32, I_L = I_IN + I_OUT + I_GU + I_DN;
        for (int it = gw; it < 2 * I_L; it += NGW) {
            const int l = it / I_L; int r = it % I_L;
            if (r < I_IN) { p0_transpose_item<0>(inp(args, 3) + (size_t)l * DM * NINS, DM, NINS, inp(args, 2) + l * DM, (bf16_t*)(ws + WS_WIN) + (size_t)l * NIN * DM, scr, r / 72, r % 72, lane); continue; } r -= I_IN;
            if (r < I_OUT) { p0_transpose_item<0, 768>(inp(args, 23) + (size_t)l * DM * DM, DM, DM, inp(args, 22) + l * DM, (bf16_t*)(ws + WS_WOUT) + (size_t)l * DM * DM, scr, r / 32, r % 32, lane); continue; } r -= I_OUT;
            if (r < I_GU) { p0_transpose_item<1>(inp(args, 25) + (size_t)l * DM * NGU, DM, NGU, inp(args, 24) + l * DM, (bf16_t*)(ws + WS_WGU) + (size_t)l * NGU * DM, scr, r / 176, r % 176, lane); continue; } r -= I_GU;
            p0_transpose_item<0>(inp(args, 26) + (size_t)l * FF * DM, FF, DM, nullptr, (bf16_t*)(ws + WS_WDN) + (size_t)l * DM * FF, scr, r / 32, r % 32, lane);
        }
        { constexpr int I_UQ = 3 * 12, I_UKV = 2 * 16, I_W1 = 32 * 8, I_W2 = 4 * 2, I_S = 2 * I_UQ + 2 * I_UKV + 4 * I_W1 + 4 * I_W2;
          for (int it = gw; it < I_S; it += NGW) { int r = it;
              if (r < 2 * I_UQ) { const int l = r / I_UQ; r %= I_UQ; p0_transpose_item<0>(inp(args, 20) + (size_t)l * 192 * 384, 192, 384, inp(args, 18) + l * 192, (bf16_t*)(ws + WS_WUQT) + (size_t)l * 384 * 192, scr, r / 12, r % 12, lane); continue; } r -= 2 * I_UQ;
              if (r < 2 * I_UKV) { const int l = r / I_UKV; r %= I_UKV; p0_transpose_item<0>(inp(args, 21) + (size_t)l * 128 * 512, 128, 512, inp(args, 19) + l * 128, (bf16_t*)(ws + WS_WUKVT) + (size_t)l * 512 * 128, scr, r / 16, r % 16, lane); continue; } r -= 2 * I_UKV;
              if (r < 4 * I_W1) { const int lj = r / I_W1; r %= I_W1; p0_transpose_item<0>(inp(args, 12) + (size_t)lj * 2048 * 256, 2048, 256, nullptr, (bf16_t*)(ws + WS_W1T) + (size_t)lj * 256 * 2048, scr, r / 8, r % 8, lane); continue; } r -= 4 * I_W1;
              { const int lj = r / I_W2; r %= I_W2; p0_transpose_item<0>(inp(args, 14) + (size_t)lj * 256 * 64, 256, 64, nullptr, (bf16_t*)(ws + WS_W2T) + (size_t)lj * 64 * 256, scr, r / 2, r % 2, lane); } } }
        for (int m = gw; m < M; m += NGW) {
            const f32x4* xr = (const f32x4*)(inp(args, 0) + (size_t)m * DM) + lane;
            f32x4 v[4]; float s = 0.f;
#pragma unroll
            for (int j = 0; j < 4; ++j) { v[j] = xr[64 * j]; s += v[j][0] * v[j][0] + v[j][1] * v[j][1] + v[j][2] * v[j][2] + v[j][3] * v[j][3]; }
            s = wave_sum(s);
            u32x2* o8 = (u32x2*)(XB + (size_t)m * DM) + lane;
#pragma unroll
            for (int j = 0; j < 4; ++j) { u32x2 w; w.x = pk2(v[j][0], v[j][1]); w.y = pk2(v[j][2], v[j][3]); o8[64 * j] = w; }
            if (lane < 4) ssp_base[(size_t)lane * M + m] = lane == 0 ? s : 0.f;
        }
        for (int e = bid * NTHR + tid; e < M * 32; e += G * NTHR) {
            const int m = e >> 5, i = e & 31; const float pos = (float)positions[m];
            const float invf = powf(10000.f, -(float)(2 * i) / 64.f); float sn, cs; sincosf(pos * invf, &sn, &cs);
            ((float2*)(ws + WS_CS64))[e] = make_float2(cs, sn);
            if (i < 16) { const float invf2 = powf(10000.f, -(float)(2 * i) / 32.f); sincosf(pos * invf2, &sn, &cs); ((float2*)(ws + WS_CS32))[m * 16 + i] = make_float2(cs, sn); }
        }
        for (int e = bid * NTHR + tid; e < 2 * 2 * 256; e += G * NTHR) {
            const int lj = e >> 8, c = e & 255; float a = inp(args, 13)[e];
            const float* pp = inp(args, 11) + (size_t)lj * 2048; const float* w1 = inp(args, 12) + (size_t)lj * 2048 * 256 + c;
            for (int i = 0; i < 2048; ++i) a += pp[i] * w1[(size_t)i * 256];
            hb[e] = a;
        }
      }
    }
    SEAM(0);

    for (int l = 0; l < 2; ++l) {
        const int pb = 1 + 6 * l;
        const float* ssq_mix = ssp_base + (size_t)(l == 0 ? 0 : 2) * 4 * M;
        float* ssq_out = ssp_base + (size_t)(1 + 3 * l) * 4 * M;
        float* ssq_down = ssp_base + (size_t)(2 + 3 * l) * 4 * M;
        float* ssq_d = ssp_base + (size_t)(3 + 3 * l) * 4 * M;
        if (IN(pb)) {
            pg8::Gemm g{XB, (const bf16_t*)(ws + WS_WIN) + (size_t)l * NIN * DM, M, NIN, DM}; pg8::StaticOrder S; S.init(M, NIN, G, bid);
            pg8::EpiInProj E{PB, NIN, ssq_mix};
            _Pragma("unroll 1") for (int rep = 0; rep < REP_G16; ++rep) pg8::gemm_phase<pg8::EpiInProj, pg8::StaticOrder, true, true>(lds, g, S, E);
        }
        SEAM(pb);
        if (IN(pb + 1)) {
        LAUNDER_TID();
            constexpr int N_J1 = 1024, N_J2 = 512, N_J3 = 512, N_J4 = 512, N_J4B = 128;
            {
            for (int r_ = bid; r_ < N_J4B; r_ += G) { const int r = r_ % N_J4B;
                    const int j = r & 1, g32 = (r >> 1) & 15, b = r >> 5; const int colb = j == 0 ? C_KC : C_VC; const int r32 = lane & 31, hi = lane >> 5;
                    LAS unsigned char* Tl = lds;
                    LAS unsigned char* Hl = lds + 69632;
                    for (int e = tid; e < 528 * 8; e += NTHR) { const int rr = e >> 3, c8 = e & 7, t = 512 * g32 + rr; u32x4 w = {0u, 0u, 0u, 0u};
                        if (t < SEQ) { const bf16_t* pr = PB + ((size_t)b * SEQ + t) * NIN + colb;
                            if (j == 0) { const u32x4 a = *(const u32x4*)(pr + 8 * (c8 & 3)), c = *(const u32x4*)(pr + 32 + 8 * (c8 & 3)); const float2* cs = cs64 + ((size_t)b * SEQ + t) * 32 + 8 * (c8 & 3);
                                const unsigned au[4] = {a.x, a.y, a.z, a.w}, cu[4] = {c.x, c.y, c.z, c.w}; unsigned ou[4];
#pragma unroll
                                for (int q = 0; q < 4; ++q) { const float2 s0 = cs[2 * q], s1 = cs[2 * q + 1]; const float x1a = bflo(au[q]), x1b = bfhi(au[q]), x2a = bflo(cu[q]), x2b = bfhi(cu[q]);
                                    ou[q] = c8 < 4 ? pk2(x1a * s0.x - x2a * s0.y, x1b * s1.x - x2b * s1.y) : pk2(x2a * s0.x + x1a * s0.y, x2b * s1.x + x1b * s1.y); }
                                w.x = ou[0]; w.y = ou[1]; w.z = ou[2]; w.w = ou[3]; }
                            else w = *(const u32x4*)(pr + 8 * c8); }
                        *(LAS u32x4*)(Tl + rr * 128 + (rr >> 4) * 16 + c8 * 16) = w; }
                    __syncthreads();
                    { const bf16_t* w1t = (const bf16_t*)(ws + WS_W1T) + ((size_t)(l * 2 + j) * 256 + 32 * wave + r32) * 2048 + 8 * hi;
                      f32x16 acc;
#pragma unroll
                      for (int i = 0; i < 16; ++i) acc[i] = 0.f;
#pragma unroll 8
                      for (int kk = 0; kk < 128; ++kk) { const int rowt = 16 * r32 + (kk >> 2);
                          const bf16x8 a = *(const LAS bf16x8*)(Tl + rowt * 128 + (rowt >> 4) * 16 + 32 * (kk & 3) + 16 * hi);
                          const bf16x8 bw = *(const bf16x8*)(w1t + 16 * kk);
                          acc = mfma32(a, bw, acc); }
                      const float hbv = hb[(l * 2 + j) * 256 + 32 * wave + r32];
#pragma unroll
                      for (int i = 0; i < 16; ++i) { const int n = (i & 3) + 8 * (i >> 2) + 4 * hi; *(LAS bf16_t*)(Hl + n * 528 + (32 * wave + r32) * 2) = f2bf(gelu_tanh(acc[i] + hbv)); } }
                    __syncthreads();
                    if (wave < 2) { const bf16_t* w2t = (const bf16_t*)(ws + WS_W2T) + ((size_t)(l * 2 + j) * 64 + 32 * wave + r32) * 256 + 8 * hi;
                      f32x16 acc;
#pragma unroll
                      for (int i = 0; i < 16; ++i) acc[i] = 0.f;
#pragma unroll
                      for (int kk = 0; kk < 16; ++kk) { const bf16x8 a = *(const LAS bf16x8*)(Hl + r32 * 528 + 32 * kk + 16 * hi); const bf16x8 bw = *(const bf16x8*)(w2t + 16 * kk); acc = mfma32(a, bw, acc); }
                      const int dd = 32 * wave + r32;
#pragma unroll
                      for (int g = 0; g < 4; ++g) { const int n0 = 32 * g32 + 8 * g + 4 * hi; float v[4];
#pragma unroll
                          for (int q = 0; q < 4; ++q) v[q] = (n0 + q < 511) ? acc[4 * g + q] : 0.f;
                          if (j == 0) {
#pragma unroll
                              for (int q = 0; q < 4; ++q) KCMPB[((size_t)b * 512 + n0 + q) * 64 + dd] = f2bf(v[q]); }
                          else { u32x2 w; w.x = pk2(v[0], v[1]); w.y = pk2(v[2], v[3]); *(u32x2*)(VCMPT + ((size_t)b * 64 + dd) * 512 + n0) = w; } } }
                    __syncthreads();
            }
            if (bid < N_J3) {
                const int fr = lane & 15, kq = lane >> 4, hh = wave >> 1, odd = wave & 1;
                {
                    bf16x8 bq[3][6];
                    { const bf16_t* wq = (const bf16_t*)(ws + WS_WUQT) + (size_t)l * 384 * 192;
#pragma unroll
                      for (int nt = 0; nt < 3; ++nt)
#pragma unroll
                          for (int ks = 0; ks < 6; ++ks) bq[nt][ks] = *(const bf16x8*)(wq + (size_t)(48 * wave + 16 * nt + fr) * 192 + 32 * ks + 8 * kq); }
                    for (int r_ = bid; r_ < N_J3; r_ += G) { const int r = r_ % N_J3;
                        const size_t row0 = (size_t)r * 64;
#pragma unroll 1
                        for (int mt = 0; mt < 4; ++mt) {
                            const bf16_t* pa = PB + (row0 + mt * 16 + fr) * NIN;
                            bf16x8 aq[6]; float ssq_ = 0.f;
#pragma unroll
                            for (int ks = 0; ks < 6; ++ks) { aq[ks] = ld8x2(pa + C_DCQ + 32 * ks + 8 * kq);
#pragma unroll
                                for (int e = 0; e < 8; ++e) { const float v = bf2f((bf16_t)aq[ks][e]); ssq_ += v * v; } }
                            ssq_ += __shfl_xor(ssq_, 16); ssq_ += __shfl_xor(ssq_, 32);
                            const float rq_ = rsqrtf(ssq_ * (1.f / 192.f) + EPS);
                            f32x4 cq[3];
#pragma unroll
                            for (int nt = 0; nt < 3; ++nt) { cq[nt] = (f32x4){0.f, 0.f, 0.f, 0.f};
#pragma unroll
                                for (int ks = 0; ks < 6; ++ks) cq[nt] = __builtin_amdgcn_mfma_f32_16x16x32_bf16(aq[ks], bq[nt][ks], cq[nt], 0, 0, 0); }
                            const float SCQ = 0.10206207261596575f * LOG2E;
#pragma unroll
                            for (int i = 0; i < 4; ++i) {
                                const size_t row = row0 + mt * 16 + 4 * kq + i; const float rqi = __shfl(rq_, 4 * kq + i) * SCQ;
                                float q0 = cq[0][i] * rqi, q1 = cq[1][i] * rqi, q2 = cq[2][i] * rqi;
                                if (odd) { const float2 cs = cs32[row * 16 + fr]; const float x1 = q1, x2 = q2; q1 = x1 * cs.x - x2 * cs.y; q2 = x2 * cs.x + x1 * cs.y; }
                                bf16_t* mq = MQ + row * 384 + hh * 96 + 48 * odd + fr; mq[0] = f2bf(q0); mq[16] = f2bf(q1); mq[32] = f2bf(q2);
                            }
                            if (wave == mt) {
#pragma unroll
                                for (int q = 0; q < 4; ++q) { const int p = lane * 4 + q, tok = p >> 4, i = p & 15; const size_t row = row0 + mt * 16 + tok; const bf16_t* pr = PB + row * NIN + C_DKR;
                                    const float x1 = bf2f(pr[i]), x2 = bf2f(pr[16 + i]); const float2 cs = cs32[row * 16 + i];
                                    MKR[row * 32 + i] = f2bf(x1 * cs.x - x2 * cs.y); MKR[row * 32 + 16 + i] = f2bf(x2 * cs.x + x1 * cs.y); } }
                        }
                    }
                }
                {
                    bf16x8 bkv[4][4];
                    { const bf16_t* wkv = (const bf16_t*)(ws + WS_WUKVT) + (size_t)l * 512 * 128;
#pragma unroll
                      for (int nt = 0; nt < 4; ++nt)
#pragma unroll
                          for (int ks = 0; ks < 4; ++ks) bkv[nt][ks] = *(const bf16x8*)(wkv + (size_t)(64 * wave + 16 * nt + fr) * 128 + 32 * ks + 8 * kq); }
                    for (int r_ = bid; r_ < N_J3; r_ += G) { const int r = r_ % N_J3;
                        const size_t row0 = (size_t)r * 64; const size_t bb = row0 / SEQ, t0 = row0 % SEQ;
#pragma unroll 1
                        for (int mt = 0; mt < 4; ++mt) {
                            const bf16_t* pa = PB + (row0 + mt * 16 + fr) * NIN;
                            bf16x8 akv[4]; float sskv_ = 0.f;
#pragma unroll
                            for (int ks = 0; ks < 4; ++ks) { akv[ks] = ld8x2(pa + C_DCKV + 32 * ks + 8 * kq);
#pragma unroll
                                for (int e = 0; e < 8; ++e) { const float v = bf2f((bf16_t)akv[ks][e]); sskv_ += v * v; } }
                            sskv_ += __shfl_xor(sskv_, 16); sskv_ += __shfl_xor(sskv_, 32);
                            const float rk_ = rsqrtf(sskv_ * (1.f / 128.f) + EPS);
                            f32x4 ckv[4];
#pragma unroll
                            for (int nt = 0; nt < 4; ++nt) { ckv[nt] = (f32x4){0.f, 0.f, 0.f, 0.f};
#pragma unroll
                                for (int ks = 0; ks < 4; ++ks) ckv[nt] = __builtin_amdgcn_mfma_f32_16x16x32_bf16(akv[ks], bkv[nt][ks], ckv[nt], 0, 0, 0); }
                            float rki[4];
#pragma unroll
                            for (int i = 0; i < 4; ++i) rki[i] = __shfl(rk_, 4 * kq + i);
                            if (!odd) {
#pragma unroll
                                for (int i = 0; i < 4; ++i) { bf16_t* mk = MKN + (row0 + mt * 16 + 4 * kq + i) * 256 + hh * 64 + fr;
                                    mk[0] = f2bf(ckv[0][i] * rki[i]); mk[16] = f2bf(ckv[1][i] * rki[i]); mk[32] = f2bf(ckv[2][i] * rki[i]); mk[48] = f2bf(ckv[3][i] * rki[i]); } }
                            else {
#pragma unroll
                                for (int nt = 0; nt < 4; ++nt) { u32x2 w; w.x = pk2(ckv[nt][0] * rki[0], ckv[nt][1] * rki[1]); w.y = pk2(ckv[nt][2] * rki[2], ckv[nt][3] * rki[3]);
                                    *(u32x2*)(MVT + ((bb * 4 + hh) * 64 + 16 * nt + fr) * SEQ + t0 + mt * 16 + 4 * kq) = w; } }
                        }
                    }
                }
            }
            for (int r_ = bid; r_ < N_J1; r_ += G) { const int r = r_ % N_J1;
                    const int b = r >> 8, tb = r & 255, t0 = tb * 32, ch = tid & 255, half = tid >> 8;
                    LAS float* xa = ldsf; LAS float* xc = ldsf + 35 * 256;
                    for (int e = tid; e < 35 * 256; e += NTHR) { const int rr = e >> 8, c = e & 255, t = t0 - 3 + rr; float v = 0.f; if (t >= 0) v = bf2f(PB[(size_t)(b * SEQ + t) * NIN + C_AX + c]); xa[e] = v; }
                    __syncthreads();
                    { const float cw0 = inp(args, 4)[(l * 4 + 0) * 256 + ch], cw1 = inp(args, 4)[(l * 4 + 1) * 256 + ch], cw2 = inp(args, 4)[(l * 4 + 2) * 256 + ch], cw3 = inp(args, 4)[(l * 4 + 3) * 256 + ch], cb = inp(args, 5)[l * 256 + ch];
                      for (int tt = 0; tt < 16; ++tt) { const int rr = half * 16 + tt; xc[rr * 256 + ch] = cb + cw0 * xa[rr * 256 + ch] + cw1 * xa[(rr + 1) * 256 + ch] + cw2 * xa[(rr + 2) * 256 + ch] + cw3 * xa[(rr + 3) * 256 + ch]; } }
                    __syncthreads();
                    const int h = ch >> 6, cc = ch & 63;
                    LAS float* gR = ldsf + 67 * 256; LAS float* gI = gR + 32 * 256;
#pragma unroll 1
                    for (int pass = 0; pass < 2; ++pass) {
                        float wv[64]; const float* wsrc = (pass == 0 ? inp(args, 6) : inp(args, 8)) + ((size_t)(l * 4 + h) * 64) * 64 + cc; const float bias = (pass == 0 ? inp(args, 7) : inp(args, 9))[l * 256 + ch];
#pragma unroll
                        for (int i = 0; i < 64; ++i) wv[i] = wsrc[i * 64];
#pragma unroll 1
                        for (int tt = 0; tt < 16; ++tt) { const LAS f32x4* xr = (const LAS f32x4*)(xc + (half * 16 + tt) * 256 + h * 64); float a = bias;
#pragma unroll
                            for (int i4 = 0; i4 < 16; ++i4) { const f32x4 x = xr[i4]; a += x[0] * wv[4 * i4] + x[1] * wv[4 * i4 + 1] + x[2] * wv[4 * i4 + 2] + x[3] * wv[4 * i4 + 3]; }
                            (pass == 0 ? gR : gI)[(half * 16 + tt) * 256 + ch] = sigmoidf_(a); }
                    }
                    const float sp = log1pf(expf(-inp(args, 10)[l * 256 + ch]));
                    float hst = 0.f, Ac = 1.f;
#pragma unroll 1
                    for (int tt = 0; tt < 16; ++tt) {
                        const int rr = half * 16 + tt;
                        const float rg = gR[rr * 256 + ch], ig = gI[rr * 256 + ch], la = -8.f * rg * sp, av = expf(la), mult = sqrtf(-expm1f(2.f * la));
                        const float u = mult * (ig * xc[rr * 256 + ch]);
                        hst = av * hst + u; Ac *= av;
                        { const size_t ao = ((size_t)b * SEQ + t0 + rr) * 256 + ch; LRA[ao] = av; LRU_[ao] = u; }
                    }
                    const size_t so = ((size_t)(b * 512 + tb * 2 + half)) * 256 + ch;
                    LA[so] = Ac; LH[so] = hst;
                    __syncthreads();
            }
            for (int r_ = bid; r_ < N_J2; r_ += G) { const int r = r_ % N_J2;
                    const int b = r >> 7, c = r & 127; const size_t row0 = (size_t)b * SEQ + 64 * c;
                    LAS float* glr = ldsf; LAS float* bb = ldsf + 1024; LAS float* kt = bb + 8192; LAS float* vv = kt + 8192;
                    for (int e = tid; e < 1024; e += NTHR) glr[e] = bf2f(PB[(row0 + (e >> 4)) * NIN + C_GLR + (e & 15)]);
                    __syncthreads();
                    for (int e = tid; e < 8192; e += NTHR) { const int t = e >> 7, kk = e & 127; float z = inp(args, 16)[l * 128 + kk];
#pragma unroll
                        for (int q = 0; q < 16; ++q) z += glr[t * 16 + q] * inp(args, 15)[(l * 16 + q) * 128 + kk];
                        bb[e] = (fminf(z, 0.f) - log1pf(expf(-fabsf(z)))) * (1.f / 16.f); }
                    __syncthreads();
                    if (tid < 128) { float run = 0.f; for (int t = 0; t < 64; ++t) { run += bb[t * 128 + tid]; bb[t * 128 + tid] = run; } }
                    __syncthreads();
                    for (int e = tid; e < 8192; e += NTHR) { const int t = e >> 7, kk = e & 127; kt[e] = bf2f(PB[(row0 + t) * NIN + C_CK + kk]) * expf(bb[63 * 128 + kk] - bb[e]); }
                    for (int e = tid; e < 16384; e += NTHR) vv[e] = bf2f(PB[(row0 + (e >> 8)) * NIN + C_CV + (e & 255)]);
                    __syncthreads();
                    { const int h = tid >> 7, k = (tid >> 2) & 31, v0 = (tid & 3) * 16; float a16[16];
#pragma unroll
                      for (int i = 0; i < 16; ++i) a16[i] = 0.f;
                      for (int t = 0; t < 64; ++t) { const float kv = kt[t * 128 + h * 32 + k]; const LAS f32x4* vp = (const LAS f32x4*)(vv + t * 256 + h * 64 + v0);
#pragma unroll
                          for (int i = 0; i < 4; ++i) { const f32x4 x = vp[i]; a16[4 * i] += kv * x[0]; a16[4 * i + 1] += kv * x[1]; a16[4 * i + 2] += kv * x[2]; a16[4 * i + 3] += kv * x[3]; } }
                      float* o = KVC + ((size_t)(b * 128 + c) * 4 + h) * 2048 + k * 64 + v0;
#pragma unroll
                      for (int i = 0; i < 16; ++i) o[i] = a16[i];
                      if (tid < 128) DEC[(size_t)(b * 128 + c) * 128 + tid] = expf(bb[63 * 128 + tid]); }
                    __syncthreads();
            }
            for (int r = bid; r < N_J4; r += G) {
                    const size_t row0 = (size_t)r * 64;
                    for (int e = tid; e < 64 * 192; e += NTHR) { const int tok = e / 192, p = e % 192, i = p & 31; const int base = p < 128 ? C_BQ + (p >> 5) * 64 : (p < 160 ? C_KS : C_KW); const float sc = p < 128 ? 0.125f * LOG2E : 1.f;
                        bf16_t* pr = PB + (row0 + tok) * NIN + base; const float x1 = bf2f(pr[i]), x2 = bf2f(pr[32 + i]); const float2 cs = cs64[(row0 + tok) * 32 + i];
                        pr[i] = f2bf((x1 * cs.x - x2 * cs.y) * sc); pr[32 + i] = f2bf((x2 * cs.x + x1 * cs.y) * sc); }
                    { LAS bf16_t* tl = (LAS bf16_t*)lds; const size_t bb = row0 / SEQ, t0 = row0 % SEQ;
                      for (int mtx = 0; mtx < 2; ++mtx) { const int tok = tid >> 3, c = tid & 7; const u32x4 w = *(const u32x4*)(PB + (row0 + tok) * NIN + (mtx ? C_VW : C_VS) + c * 8);
                          LAS bf16_t* dst = tl + mtx * 64 * 72 + tok * 72 + c * 8; dst[0] = (bf16_t)w.x; dst[1] = (bf16_t)(w.x >> 16); dst[2] = (bf16_t)w.y; dst[3] = (bf16_t)(w.y >> 16); dst[4] = (bf16_t)w.z; dst[5] = (bf16_t)(w.z >> 16); dst[6] = (bf16_t)w.w; dst[7] = (bf16_t)(w.w >> 16); }
                      __syncthreads();
                      for (int mtx = 0; mtx < 2; ++mtx) { const int d = tid >> 3, c8 = tid & 7; const LAS bf16_t* s = tl + mtx * 64 * 72 + (c8 * 8) * 72 + d;
                          u32x4 w; w.x = (unsigned)s[0] | ((unsigned)s[72] << 16); w.y = (unsigned)s[2 * 72] | ((unsigned)s[3 * 72] << 16); w.z = (unsigned)s[4 * 72] | ((unsigned)s[5 * 72] << 16); w.w = (unsigned)s[6 * 72] | ((unsigned)s[7 * 72] << 16);
                          *(u32x4*)((mtx ? VWT : VST) + (bb * 64 + d) * SEQ + t0 + c8 * 8) = w; }
                      __syncthreads(); }
            }
            }
        }
        SEAM(pb + 1);
        if (IN(pb + 2)) {
        LAUNDER_TID();
            constexpr int Q_J5 = 2, Q_J6 = 64, Q_ATT = 1024 * REP_ATT, Q_J9 = 1024, Q_J10 = 512, Q_TOT = Q_J5 + Q_J6 + Q_ATT + Q_J9 + Q_J10;
            if (tid == 0) { LCTL[4] = 0u; LCTL[5] = 0u; }
            __syncthreads();
            const int tid_o = tid;
            for (;;) {
                int tid = tid_o; asm volatile("" : "+v"(tid)); const int lane = tid & 63;
                if (tid == 0) LCTL[2] = __hip_atomic_fetch_add(ctl + CW_QUEUE + 64 * l, 1u, __ATOMIC_RELAXED, __HIP_MEMORY_SCOPE_AGENT);
                __syncthreads();
                int r = __builtin_amdgcn_readfirstlane((int)LCTL[2]); const unsigned seen5 = LCTL[4], seen6 = LCTL[5];
                __syncthreads();
                if (r >= Q_TOT) break;
                if (r < Q_J5) {
                    const int e = r * NTHR + tid, b = e >> 8, ch = e & 255; float carry = 0.f;
                    for (int c0 = 0; c0 < 512; c0 += 8) { float av[8], hv[8];
#pragma unroll
                        for (int q = 0; q < 8; ++q) { const size_t so = ((size_t)(b * 512 + c0 + q)) * 256 + ch; av[q] = LA[so]; hv[q] = LH[so]; }
#pragma unroll
                        for (int q = 0; q < 8; ++q) { CIN[((size_t)(b * 512 + c0 + q)) * 256 + ch] = carry; carry = av[q] * carry + hv[q]; } }
                    asm volatile("s_waitcnt vmcnt(0)" ::: "memory"); __syncthreads();
                    if (tid == 0) { __builtin_amdgcn_fence(__ATOMIC_RELEASE, "agent"); asm volatile("s_waitcnt vmcnt(0)" ::: "memory"); (void)xb_add(ctl + CW_FLAG + 64 * (2 * l + 0), 1u); }
                    continue;
                }
                r -= Q_J5;
                if (r < Q_J6) {
                    const int e = r * NTHR + tid, b = e >> 13, rem = e & 8191; float Sv = 0.f;
                    for (int c0 = 0; c0 < 128; c0 += 8) { float kv[8], dv[8];
#pragma unroll
                        for (int q = 0; q < 8; ++q) { kv[q] = KVC[(size_t)(b * 128 + c0 + q) * 8192 + rem]; dv[q] = DEC[(size_t)(b * 128 + c0 + q) * 128 + (rem >> 6)]; }
#pragma unroll
                        for (int q = 0; q < 8; ++q) { SST[(size_t)(b * 128 + c0 + q) * 8192 + rem] = Sv; Sv = dv[q] * Sv + kv[q]; } }
                    asm volatile("s_waitcnt vmcnt(0)" ::: "memory"); __syncthreads();
                    if (tid == 0) { __builtin_amdgcn_fence(__ATOMIC_RELEASE, "agent"); asm volatile("s_waitcnt vmcnt(0)" ::: "memory"); (void)xb_add(ctl + CW_FLAG + 64 * (2 * l + 1), 1u); }
                    continue;
                }
                r -= Q_J6;
                if (r >= Q_ATT) {
                    r -= Q_ATT; const bool is9 = r < Q_J9;
                    if (!(is9 ? seen5 : seen6)) {
                        if (tid == 0) { unsigned* f = ctl + CW_FLAG + 64 * (2 * l + (is9 ? 0 : 1)); const unsigned target = is9 ? (unsigned)Q_J5 : (unsigned)Q_J6;
                            XB_SPIN(xb_ld(f) < target, ctl + CW_BAR); __builtin_amdgcn_fence(__ATOMIC_ACQUIRE, "agent"); asm volatile("s_waitcnt vmcnt(0)" ::: "memory"); LCTL[is9 ? 4 : 5] = 1u; }
                        __syncthreads(); }
                    if (is9) {
                    const int b = r >> 8, tb = r & 255, t0 = tb * 32, ch = tid & 255, half = tid >> 8;
                    LAS float* xa = ldsf;
                    float hst = CIN[((size_t)(b * 512 + tb * 2 + half)) * 256 + ch];
                    { float av[16], uv[16], gv[16];
#pragma unroll
                      for (int tt = 0; tt < 16; ++tt) { const size_t ro = (size_t)b * SEQ + t0 + half * 16 + tt; av[tt] = LRA[ro * 256 + ch]; uv[tt] = LRU_[ro * 256 + ch]; gv[tt] = bf2f(PB[ro * NIN + C_AG + ch]); }
#pragma unroll
                      for (int tt = 0; tt < 16; ++tt) { hst = av[tt] * hst + uv[tt]; xa[(half * 16 + tt) * 256 + ch] = hst * gelu_tanh(gv[tt]); } }
                    __syncthreads();
                    for (int q = 0; q < 4; ++q) { const int rr = wave * 4 + q; const f32x4 v = ((const LAS f32x4*)(xa + rr * 256))[lane];
                        const float rinv = rsqrtf(wave_sum(v[0] * v[0] + v[1] * v[1] + v[2] * v[2] + v[3] * v[3]) * (1.f / 256.f) + EPS);
                        u32x2 w; w.x = pk2(v[0] * rinv, v[1] * rinv); w.y = pk2(v[2] * rinv, v[3] * rinv);
                        *(u32x2*)(Y + ((size_t)b * SEQ + t0 + rr) * DM + 256 + 4 * lane) = w; }
                    __syncthreads();
                    } else { r -= Q_J9;
                    const int b = r >> 7, c = r & 127; const size_t row0 = (size_t)b * SEQ + 64 * c;
                    LAS float* bL = ldsf; LAS float* glr = ldsf + 8192; LAS unsigned char* VTl = lds + 36864; LAS unsigned char* STl = lds + 71680; LAS float* SSX = (LAS float*)(lds + 92160);
                    for (int e = tid; e < 1024; e += NTHR) glr[e] = bf2f(PB[(row0 + (e >> 4)) * NIN + C_GLR + (e & 15)]);
                    for (int e = tid; e < 2048; e += NTHR) { const int jj = e >> 5, hc = e & 31, h = hc >> 3, c8 = hc & 7; const bf16_t* vsrc = PB + (row0 + jj) * NIN + C_CV + h * 64 + 8 * c8; const u32x2 wA = *(const u32x2*)vsrc, wB = *(const u32x2*)(vsrc + 4); u32x4 w; w.x = wA.x; w.y = wA.y; w.z = wB.x; w.w = wB.y;
                        LAS bf16_t* d = (LAS bf16_t*)(VTl + h * 8704 + (8 * c8) * VSTR) + jj;
                        d[0] = (bf16_t)w.x; d[VSTR / 2] = (bf16_t)(w.x >> 16); d[2 * (VSTR / 2)] = (bf16_t)w.y; d[3 * (VSTR / 2)] = (bf16_t)(w.y >> 16); d[4 * (VSTR / 2)] = (bf16_t)w.z; d[5 * (VSTR / 2)] = (bf16_t)(w.z >> 16); d[6 * (VSTR / 2)] = (bf16_t)w.w; d[7 * (VSTR / 2)] = (bf16_t)(w.w >> 16); }
                    for (int e = tid; e < 8192; e += NTHR) { const int h = e >> 11, k = (e >> 6) & 31, v = e & 63; *(LAS bf16_t*)(STl + h * 5120 + v * 80 + k * 2) = f2bf(SST[(size_t)(b * 128 + c) * 8192 + e]); }
                    __syncthreads();
                    for (int e = tid; e < 8192; e += NTHR) { const int t = e >> 7, kk = e & 127; float z = inp(args, 16)[l * 128 + kk];
#pragma unroll
                        for (int q = 0; q < 16; ++q) z += glr[t * 16 + q] * inp(args, 15)[(l * 16 + q) * 128 + kk];
                        bL[e] = (fminf(z, 0.f) - log1pf(expf(-fabsf(z)))) * (1.f / 16.f); }
                    __syncthreads();
                    if (tid < 128) { float run = 0.f; for (int t = 0; t < 64; ++t) { run += bL[t * 128 + tid]; bL[t * 128 + tid] = run; } }
                    __syncthreads();
                    { const int r32 = lane & 31, hi = lane >> 5, h = wave >> 1, ih = wave & 1, i = 32 * ih + r32; const float SCG = 0.17677669529663687f;
                      bf16x8 qrel[2], qabs[2], kt[2][2];
#pragma unroll
                      for (int ks = 0; ks < 2; ++ks) { const int k0 = h * 32 + 16 * ks + 8 * hi; const bf16x8 qv = ld8x2(PB + (row0 + i) * NIN + C_CQ + k0); u32x4 wr_, wa_; unsigned* pr_ = (unsigned*)&wr_; unsigned* pa_ = (unsigned*)&wa_;
#pragma unroll
                          for (int e2 = 0; e2 < 4; ++e2) { const float b0 = bL[i * 128 + k0 + 2 * e2], b1 = bL[i * 128 + k0 + 2 * e2 + 1], f0 = bL[31 * 128 + k0 + 2 * e2], f1 = bL[31 * 128 + k0 + 2 * e2 + 1];
                              const float q0 = bf2f((bf16_t)qv[2 * e2]) * SCG, q1 = bf2f((bf16_t)qv[2 * e2 + 1]) * SCG;
                              pr_[e2] = cvtpk(q0 * __expf(b0 - f0), q1 * __expf(b1 - f1)); pa_[e2] = cvtpk(q0 * __expf(b0), q1 * __expf(b1)); }
                          qrel[ks] = __builtin_bit_cast(bf16x8, wr_); qabs[ks] = __builtin_bit_cast(bf16x8, wa_); }
#pragma unroll
                      for (int jt = 0; jt < 2; ++jt)
#pragma unroll
                          for (int ks = 0; ks < 2; ++ks) { const int jr = 32 * jt + r32, k0 = h * 32 + 16 * ks + 8 * hi; const bf16x8 kv = ld8x2(PB + (row0 + jr) * NIN + C_CK + k0); u32x4 wk_; unsigned* pk_ = (unsigned*)&wk_;
#pragma unroll
                              for (int e2 = 0; e2 < 4; ++e2) { const float b0 = bL[jr * 128 + k0 + 2 * e2], b1 = bL[jr * 128 + k0 + 2 * e2 + 1], f0 = bL[31 * 128 + k0 + 2 * e2], f1 = bL[31 * 128 + k0 + 2 * e2 + 1];
                                  pk_[e2] = cvtpk(bf2f((bf16_t)kv[2 * e2]) * __expf(f0 - b0), bf2f((bf16_t)kv[2 * e2 + 1]) * __expf(f1 - b1)); }
                              kt[jt][ks] = __builtin_bit_cast(bf16x8, wk_); }
                      f32x16 o[2], s[2];
#pragma unroll
                      for (int q = 0; q < 16; ++q) { o[0][q] = 0.f; o[1][q] = 0.f; s[0][q] = 0.f; s[1][q] = 0.f; }
#pragma unroll
                      for (int ks = 0; ks < 2; ++ks) s[0] = mfma32(kt[0][ks], qrel[ks], s[0]);
                      if (ih) {
#pragma unroll
                          for (int ks = 0; ks < 2; ++ks) s[1] = mfma32(kt[1][ks], qrel[ks], s[1]); }
#pragma unroll
                      for (int q = 0; q < 16; ++q) { const int jr = (q & 3) + 8 * (q >> 2) + 4 * hi; if (jr > r32) { if (ih) s[1][q] = 0.f; else s[0][q] = 0.f; } }
                      const LAS unsigned char* VTh = VTl + h * 8704; const LAS unsigned char* STh = STl + h * 5120;
#pragma unroll
                      for (int dt = 0; dt < 2; ++dt) { const LAS unsigned char* vp = VTh + (32 * dt + r32) * VSTR + 8 * hi;
                          o[dt] = mfma32(vfrag(vp), pack8<0>(s[0]), o[dt]); o[dt] = mfma32(vfrag(vp + 32), pack8<8>(s[0]), o[dt]);
                          if (ih) { o[dt] = mfma32(vfrag(vp + 64), pack8<0>(s[1]), o[dt]); o[dt] = mfma32(vfrag(vp + 96), pack8<8>(s[1]), o[dt]); }
#pragma unroll
                          for (int ks = 0; ks < 2; ++ks) o[dt] = mfma32(*(const LAS bf16x8*)(STh + (32 * dt + r32) * 80 + 32 * ks + 16 * hi), qabs[ks], o[dt]); }
                      float ssh = 0.f;
#pragma unroll
                      for (int q = 0; q < 16; ++q) ssh += o[0][q] * o[0][q] + o[1][q] * o[1][q];
                      const float rh = rsqrtf(xhalf_sum(ssh) * (1.f / 64.f) + EPS); float ssg = 0.f;
#pragma unroll
                      for (int dt = 0; dt < 2; ++dt)
#pragma unroll
                          for (int g = 0; g < 4; ++g) { const int v0 = 32 * dt + 8 * g + 4 * hi; const u32x2 ogw = *(const u32x2*)(PB + (row0 + i) * NIN + C_OG + h * 64 + v0); const f32x4 gn = *(const f32x4*)(inp(args, 17) + l * 64 + v0);
                              const float og4[4] = {bflo(ogw.x), bfhi(ogw.x), bflo(ogw.y), bfhi(ogw.y)};
#pragma unroll
                              for (int q = 0; q < 4; ++q) { const float y = o[dt][4 * g + q] * rh * gn[q] * (og4[q] / (1.f + __expf(-og4[q]))); o[dt][4 * g + q] = y; ssg += y * y; } }
                      ssg = xhalf_sum(ssg); if (hi == 0) SSX[i * 4 + h] = ssg;
                      __syncthreads();
                      const f32x4 s4 = *(const LAS f32x4*)(SSX + i * 4); const float rinv = rsqrtf((s4[0] + s4[1] + s4[2] + s4[3]) * (1.f / 256.f) + EPS);
#pragma unroll
                      for (int dt = 0; dt < 2; ++dt)
#pragma unroll
                          for (int g = 0; g < 4; ++g) { u32x2 w; w.x = cvtpk(o[dt][4 * g] * rinv, o[dt][4 * g + 1] * rinv); w.y = cvtpk(o[dt][4 * g + 2] * rinv, o[dt][4 * g + 3] * rinv);
                              *(u32x2*)(Y + (row0 + i) * DM + 768 + h * 64 + 32 * dt + 8 * g + 4 * hi) = w; } }
                    __syncthreads();
                    }
                    continue;
                }
                const int r32 = lane & 31, hi = lane >> 5;
                const int rep = r >> 10; r &= 1023;
                const int grp = r >> 5, within = r & 31;
              {
                if (within >= 16) {
                    const int idx = within - 16, b = idx & 3, tb = 127 - (4 * grp + (idx >> 2));
                    const int tl = 8 * wave + (r32 >> 2), head = r32 & 3, T = 64 * tb + tl; const size_t row = (size_t)b * SEQ + T; const bf16_t* prow = PB + row * NIN;
                    bf16x8 qf[4];
#pragma unroll
                    for (int ks = 0; ks < 4; ++ks) qf[ks] = *(const bf16x8*)(prow + C_BQ + head * 64 + 16 * ks + 8 * hi);
                    const float g0 = sigmoidf_(bf2f(prow[C_BG + head * 3])), g1 = sigmoidf_(bf2f(prow[C_BG + head * 3 + 1])), g2 = sigmoidf_(bf2f(prow[C_BG + head * 3 + 2]));
                    LAS float* impb = (LAS float*)(lds + AL_IMP) + wave * 1024; LAS unsigned* selm = (LAS unsigned*)(lds + AL_SELM) + wave * 32;
                    const int skey = tid >> 3, sch = tid & 7;
                    auto stK = [&](int buf, const StageRegs& R) { *(LAS u32x4*)(lds + (buf ? AL_K1 : AL_K0) + skey * KSTR + sch * 16) = R.a; };
                    auto stKV = [&](int buf, const StageRegs& R) { *(LAS u32x4*)(lds + (buf ? AL_K1 : AL_K0) + skey * KSTR + sch * 16) = R.a;
                        LAS unsigned char* vd = lds + (buf ? AL_V1 : AL_V0) + skey * VSTR + sch * 16; u32x2 a, c; a.x = R.b.x; a.y = R.b.y; c.x = R.b.z; c.y = R.b.w; *(LAS u32x2*)vd = a; *(LAS u32x2*)(vd + 8) = c; };
                    f32x16 oacc[2], ob[2];
                    const int nv = T >= 31 ? ((T - 31) >> 4) + 1 : 0, ntc = (4 * tb + 3 + 63) >> 6;
                    float mC = NEGB, lC = 0.f;
                    { const bf16_t* kb_ = KCMPB + (size_t)b * 512 * 64;
                      attn_pipeline(0, ntc - 1, [&](int j, StageRegs& R) { R.a = *(const u32x4*)(kb_ + (size_t)(64 * j + skey) * 64 + sch * 8); }, stK,
                        [&](int j, int cb) { f32x16 s0, s1; qk_tile<4>(lds + (cb ? AL_K1 : AL_K0), qf, r32, hi, s0, s1); mask_tile(s0, s1, 0, nv - 1 - 64 * j, hi);
                            const float mx = tile_max(s0, s1), mn = fmaxf(mC, mx), ms = mn < -1e29f ? 0.f : mn, alpha = ex2(mC - ms); mC = mn; float ps = 0.f;
#pragma unroll
                            for (int i = 0; i < 16; ++i) ps += ex2(s0[i] - ms) + ex2(s1[i] - ms);
                            lC = lC * alpha + ps; }); }
                    { const float invC = 1.f / fmaxf(xhalf_sum(lC), 1e-30f), msC = mC < -1e29f ? 0.f : mC; float carry = 0.f;
#pragma unroll
                      for (int i = 0; i < 16; ++i) { ob[0][i] = 0.f; ob[1][i] = 0.f; }
                      const bf16_t* kb_ = KCMPB + (size_t)b * 512 * 64; const bf16_t* vb_ = VCMPT + (size_t)b * 64 * 512;
                      attn_pipeline(0, ntc - 1, [&](int j, StageRegs& R) { R.a = *(const u32x4*)(kb_ + (size_t)(64 * j + skey) * 64 + sch * 8); R.b = *(const u32x4*)(vb_ + (size_t)skey * 512 + 64 * j + sch * 8); }, stKV,
                        [&](int j, int cb) { f32x16 s0, s1; qk_tile<4>(lds + (cb ? AL_K1 : AL_K0), qf, r32, hi, s0, s1); mask_tile(s0, s1, 0, nv - 1 - 64 * j, hi);
#pragma unroll
                            for (int i = 0; i < 16; ++i) { s0[i] = ex2(s0[i] - msC) * invC; s1[i] = ex2(s1[i] - msC) * invC; }
                            float gs[8], pl[8];
#pragma unroll
                            for (int q = 0; q < 4; ++q) { gs[q] = (s0[4 * q] + s0[4 * q + 1]) + (s0[4 * q + 2] + s0[4 * q + 3]); gs[4 + q] = (s1[4 * q] + s1[4 * q + 1]) + (s1[4 * q + 2] + s1[4 * q + 3]);
                                pl[q] = __shfl_xor(s0[4 * q + 3], 32); pl[4 + q] = __shfl_xor(s1[4 * q + 3], 32); }
#pragma unroll
                            for (int q = 0; q < 8; ++q) { const float prev = hi ? pl[q] : (q > 0 ? pl[q > 0 ? q - 1 : 0] : carry); float x = gs[q] + prev; x += __shfl_xor(x, 1); x += __shfl_xor(x, 2);
                                if ((r32 & 3) == 0) impb[(r32 >> 2) * 128 + 16 * j + 2 * q + hi] = x; }
                            carry = pl[7];
                            pv_tile(s0, s1, lds + (cb ? AL_V1 : AL_V0), ob, r32, hi); }); }
                    LAS float* oav = (LAS float*)(lds + AL_OACC) + tid;
#pragma unroll
                    for (int i = 0; i < 16; ++i) { oav[i * 512] = g0 * ob[0][i]; oav[(16 + i) * 512] = g0 * ob[1][i]; }
                    WSYNC();
                    for (int tk = 0; tk < 8; ++tk) {
                        const int cur = tb, j0 = lane, j1 = lane + 64; LAS float* sb = impb + tk * 128; const float im0 = sb[j0], im1 = sb[j1];
                        const float s0 = (j0 == 0 || j0 == cur || j0 == cur - 1) ? 1e9f : (j0 <= cur ? im0 : -1e30f);
                        const float s1 = (j1 == cur || j1 == cur - 1) ? 1e9f : (j1 <= cur ? im1 : -1e30f);
                        WSYNC(); sb[j0] = s0; sb[j1] = s1; WSYNC();
                        int rk0 = 0, rk1 = 0;
#pragma unroll 4
                        for (int c4 = 0; c4 < 32; ++c4) { const f32x4 v = ((const LAS f32x4*)sb)[c4];
#pragma unroll
                            for (int q = 0; q < 4; ++q) { const int jj = 4 * c4 + q; const float x = v[q];
                                rk0 += (x > s0 || (x == s0 && jj < j0)) ? 1 : 0; rk1 += (x > s1 || (x == s1 && jj < j1)) ? 1 : 0; } }
                        const unsigned long long m0 = __ballot(rk0 < 16), m1 = __ballot(rk1 < 16);
                        if (lane == 0) { selm[tk * 4] = (unsigned)m0; selm[tk * 4 + 1] = (unsigned)(m0 >> 32); selm[tk * 4 + 2] = (unsigned)m1; selm[tk * 4 + 3] = (unsigned)(m1 >> 32); }
                    }
                    WSYNC();
                    const unsigned sm0 = selm[(r32 >> 2) * 4], sm1 = selm[(r32 >> 2) * 4 + 1], sm2 = selm[(r32 >> 2) * 4 + 2], sm3 = selm[(r32 >> 2) * 4 + 3];
                    { float mB = NEGB, lB = 0.f;
#pragma unroll
                      for (int i = 0; i < 16; ++i) { ob[0][i] = 0.f; ob[1][i] = 0.f; }
                      const bf16_t* kb_ = PB + (size_t)b * SEQ * NIN + C_KS; const bf16_t* vb_ = VST + (size_t)b * 64 * SEQ;
                      attn_pipeline(0, tb, [&](int j, StageRegs& R) { R.a = *(const u32x4*)(kb_ + (size_t)(64 * j + skey) * NIN + sch * 8); R.b = *(const u32x4*)(vb_ + (size_t)skey * SEQ + 64 * j + sch * 8); }, stKV,
                        [&](int j, int cb) { const unsigned wsel = j < 32 ? sm0 : (j < 64 ? sm1 : (j < 96 ? sm2 : sm3)); const bool bit = (wsel >> (j & 31)) & 1u;
                            if (__any(bit)) { f32x16 s0, s1; qk_tile<4>(lds + (cb ? AL_K1 : AL_K0), qf, r32, hi, s0, s1);
                                if (j == tb || !__all(bit)) mask_tile(s0, s1, bit ? 0 : 64, j == tb ? tl : 63, hi);
                                softmax_pv(s0, s1, lds + (cb ? AL_V1 : AL_V0), ob, mB, lB, r32, hi); } });
                      const float sc = g1 / fmaxf(xhalf_sum(lB), 1e-30f);
#pragma unroll
                      for (int i = 0; i < 16; ++i) { oav[i * 512] += sc * ob[0][i]; oav[(16 + i) * 512] += sc * ob[1][i]; } }
                    { float mB = NEGB, lB = 0.f;
#pragma unroll
                      for (int i = 0; i < 16; ++i) { ob[0][i] = 0.f; ob[1][i] = 0.f; }
                      const bf16_t* kb_ = PB + (size_t)b * SEQ * NIN + C_KW; const bf16_t* vb_ = VWT + (size_t)b * 64 * SEQ;
                      attn_pipeline(tb >= 8 ? tb - 8 : 0, tb, [&](int j, StageRegs& R) { R.a = *(const u32x4*)(kb_ + (size_t)(64 * j + skey) * NIN + sch * 8); R.b = *(const u32x4*)(vb_ + (size_t)skey * SEQ + 64 * j + sch * 8); }, stKV,
                        [&](int j, int cb) { f32x16 s0, s1; qk_tile<4>(lds + (cb ? AL_K1 : AL_K0), qf, r32, hi, s0, s1);
                            if (j == tb || j == tb - 8) mask_tile(s0, s1, j == tb - 8 ? tl + 1 : 0, j == tb ? tl : 63, hi);
                            softmax_pv(s0, s1, lds + (cb ? AL_V1 : AL_V0), ob, mB, lB, r32, hi); });
                      const float sc = g2 / fmaxf(xhalf_sum(lB), 1e-30f);
#pragma unroll
                      for (int i = 0; i < 16; ++i) { oacc[0][i] = oav[i * 512] + sc * ob[0][i]; oacc[1][i] = oav[(16 + i) * 512] + sc * ob[1][i]; } }
                    { float ss = 0.f;
#pragma unroll
                      for (int i = 0; i < 16; ++i) ss += oacc[0][i] * oacc[0][i] + oacc[1][i] * oacc[1][i];
                      ss = xhalf_sum(ss); ss += __shfl_xor(ss, 1); ss += __shfl_xor(ss, 2);
                      const float rinv = rsqrtf(ss * (1.f / 256.f) + EPS);
#pragma unroll
                      for (int dt = 0; dt < 2; ++dt)
#pragma unroll
                          for (int g = 0; g < 4; ++g) { u32x2 w; w.x = cvtpk(oacc[dt][4 * g] * rinv, oacc[dt][4 * g + 1] * rinv); w.y = cvtpk(oacc[dt][4 * g + 2] * rinv, oacc[dt][4 * g + 3] * rinv);
                              *(u32x2*)(Y + row * DM + 512 + head * 64 + 32 * dt + 8 * g + 4 * hi) = w; } }
                    __syncthreads();
                    continue;
                }
                {
                    const int qb = 31 - grp, b = within >> 2, h = within & 3;
                    const int T = 256 * qb + 32 * wave + r32; const size_t row = (size_t)b * SEQ + T;
                    bf16x8 qf[6];
#pragma unroll
                    for (int ks = 0; ks < 6; ++ks) qf[ks] = *(const bf16x8*)(MQ + row * 384 + h * 96 + 16 * ks + 8 * hi);
                    f32x16 o[2];
#pragma unroll
                    for (int i = 0; i < 16; ++i) { o[0][i] = 0.f; o[1][i] = 0.f; }
                    float m = NEGB, l = 0.f;
                    const int jd = 4 * qb + (wave >> 1), jend = 4 * qb + 3;
                    const bf16_t* kn = MKN + (size_t)b * SEQ * 256 + h * 64; const bf16_t* kr = MKR + (size_t)b * SEQ * 32; const bf16_t* vt = MVT + (size_t)(b * 4 + h) * 64 * SEQ;
                    const int key0 = tid / 12, ch0 = tid % 12, key1 = (512 + tid) / 12, ch1 = (512 + tid) % 12, vd_ = tid >> 3, vc8 = tid & 7;
                    attn_pipeline(0, jend,
                        [&](int j, StageRegs& R) { R.a = ch0 < 8 ? *(const u32x4*)(kn + (size_t)(64 * j + key0) * 256 + ch0 * 8) : *(const u32x4*)(kr + (size_t)(64 * j + key0) * 32 + (ch0 - 8) * 8);
                            if (tid < 256) R.b = ch1 < 8 ? *(const u32x4*)(kn + (size_t)(64 * j + key1) * 256 + ch1 * 8) : *(const u32x4*)(kr + (size_t)(64 * j + key1) * 32 + (ch1 - 8) * 8);
                            R.c = *(const u32x4*)(vt + (size_t)vd_ * SEQ + 64 * j + vc8 * 8); },
                        [&](int buf, const StageRegs& R) { *(LAS u32x4*)(lds + (buf ? AL_K1 : AL_K0) + key0 * KSTR + ch0 * 16) = R.a;
                            if (tid < 256) *(LAS u32x4*)(lds + (buf ? AL_K1 : AL_K0) + key1 * KSTR + ch1 * 16) = R.b;
                            LAS unsigned char* vd = lds + (buf ? AL_V1 : AL_V0) + vd_ * VSTR + vc8 * 16; u32x2 a, c; a.x = R.c.x; a.y = R.c.y; c.x = R.c.z; c.y = R.c.w; *(LAS u32x2*)vd = a; *(LAS u32x2*)(vd + 8) = c; },
                        [&](int j, int cb) { if (j <= jd) { f32x16 s0, s1; qk_tile<6>(lds + (cb ? AL_K1 : AL_K0), qf, r32, hi, s0, s1);
                                if (j == jd) mask_tile(s0, s1, 0, 32 * (wave & 1) + r32, hi);
                                softmax_pv(s0, s1, lds + (cb ? AL_V1 : AL_V0), o, m, l, r32, hi); } });
                    { const float inv = 1.f / fmaxf(xhalf_sum(l), 1e-30f); float ss = 0.f;
#pragma unroll
                      for (int dt = 0; dt < 2; ++dt)
#pragma unroll
                          for (int g = 0; g < 4; ++g) { const float v0 = o[dt][4 * g] * inv, v1 = o[dt][4 * g + 1] * inv, v2 = o[dt][4 * g + 2] * inv, v3 = o[dt][4 * g + 3] * inv; ss += v0 * v0 + v1 * v1 + v2 * v2 + v3 * v3;
                              u32x2 w; w.x = cvtpk(v0, v1); w.y = cvtpk(v2, v3); *(u32x2*)(Y + row * DM + h * 64 + 32 * dt + 8 * g + 4 * hi) = w; }
                      ss = xhalf_sum(ss); if (hi == 0) ssq_d[(size_t)h * M + row] = ss; }
                    __syncthreads();
                }
              }
            }
        }
        SEAM(pb + 2);
        if (IN(pb + 3)) {
            pg8::Gemm g{Y, (const bf16_t*)(ws + WS_WOUT) + (size_t)l * DM * DM, M, DM, DM}; pg8::StaticOrder S; S.init(M, DM, G, bid);
            pg8::EpiResid<true> E{XB, ssq_out, ssq_d, (LAS float*)(lds + 131072)};
            pg8::gemm_phase<pg8::EpiResid<true>, pg8::StaticOrder, true, true>(lds, g, S, E);
        }
        SEAM(pb + 3);
        if (IN(pb + 4)) {
            pg8::Gemm g{XB, (const bf16_t*)(ws + WS_WGU) + (size_t)l * NGU * DM, M, NGU, DM}; pg8::StaticOrder S; S.init(M, NGU, G, bid);
            pg8::EpiSwiglu E{ACT, ssq_out};
            _Pragma("unroll 1") for (int rep = 0; rep < REP_G16; ++rep) pg8::gemm_phase<pg8::EpiSwiglu, pg8::StaticOrder, true, true>(lds, g, S, E);
        }
        SEAM(pb + 4);
        if (IN(pb + 5)) {
            pg8::Gemm g{ACT, (const bf16_t*)(ws + WS_WDN) + (size_t)l * DM * FF, M, DM, FF}; pg8::StaticOrder S; S.init(M, DM, G, bid);
            pg8::EpiResid<false> E{XB, ssq_down, nullptr, (LAS float*)(lds + 131072)};
            pg8::gemm_phase<pg8::EpiResid<false>, pg8::StaticOrder, true, true>(lds, g, S, E);
        }
        SEAM(pb + 5);
    }
    if (IN(13)) {
        LAUNDER_TID();
        const float* ssqf = ssp_base + (size_t)5 * 4 * M; const int gw = bid * 8 + wave, NGW = G * 8;
        for (int m = gw; m < M; m += NGW) {
            const float rinv = rsqrtf(sum4p(ssqf, m) * (1.f / DM) + EPS);
            const u32x2* xr = (const u32x2*)(XB + (size_t)m * DM) + lane; f32x4* orow = (f32x4*)(args.out + (size_t)m * DM) + lane; const f32x4* gn = (const f32x4*)inp(args, 27) + lane;
#pragma unroll
            for (int j = 0; j < 4; ++j) { const u32x2 w = xr[64 * j]; const f32x4 g = gn[64 * j]; f32x4 v; v[0] = bflo(w.x) * rinv * g[0]; v[1] = bfhi(w.x) * rinv * g[1]; v[2] = bflo(w.y) * rinv * g[2]; v[3] = bfhi(w.y) * rinv * g[3]; orow[64 * j] = v; }
        }
    }
#undef IN
#undef SEAM
}

extern "C" void kernel_launch(void* const* d_in, const int* in_sizes, int n_in, void* d_out, int out_size, void* d_ws, size_t ws_size, hipStream_t stream) {
    static int grid = 0;
    if (grid == 0) {
        if (n_in != 28 || in_sizes[0] != M * DM || out_size != M * DM || ws_size < WS_END) { fprintf(stderr, "kernel_launch: unexpected shapes (n_in %d, ws %zu)\n", n_in, ws_size); grid = -1; return; }
        int dev = 0, cus = 0;
        if (hipGetDevice(&dev) != hipSuccess || hipDeviceGetAttribute(&cus, hipDeviceAttributeMultiprocessorCount, dev) != hipSuccess) { grid = -1; return; }
        if (hipFuncSetAttribute((const void*)fwd, hipFuncAttributeMaxDynamicSharedMemorySize, LDS_BYTES) != hipSuccess) { fprintf(stderr, "kernel_launch: hipFuncSetAttribute failed\n"); grid = -1; return; }
        int per_cu = 0;
        if (hipOccupancyMaxActiveBlocksPerMultiprocessor(&per_cu, (const void*)fwd, NTHR, LDS_BYTES) != hipSuccess || per_cu < 1) fprintf(stderr, "kernel_launch: occupancy query says %d\n", per_cu);
        (void)hipGetLastError();
        grid = cus;
    }
    if (grid < 0) return;
    (void)hipMemsetAsync((char*)d_ws + WS_CTL, 0, CTL_ZERO_BYTES, stream);
    Args a{};
    for (int i = 0; i < 28; ++i) a.in[i] = (const float*)d_in[i];
    a.out = (float*)d_out; a.ws = (unsigned char*)d_ws;
    if (MK_N_LAUNCHES == 1) { a.ph_lo = 0; a.ph_hi = 14; hipLaunchKernelGGL(fwd, dim3(grid), dim3(NTHR), LDS_BYTES, stream, a); }
    else for (int p = 0; p < 14; ++p) { a.ph_lo = p; a.ph_hi = p + 1; hipLaunchKernelGGL(fwd, dim3(grid), dim3(NTHR), LDS_BYTES, stream, a); }
}
```

```cpp
#include <hip/hip_runtime.h>
#include <cstdio>
#include <cstdint>

#ifndef MK_N_LAUNCHES
#define MK_N_LAUNCHES 1
#endif

#define REP_P0 1
#define REP_G16 1
#define REP_G57 0
#define REP_ATT 1
#define REP_J4B 1
#define REP_J3 1
#define REP_J1 1
#define REP_J2 1
#define REP_P3 1
#define REP_ONLY 0
#define LAS __attribute__((address_space(3)))
#define DI __device__ __forceinline__
typedef unsigned short bf16_t;
typedef short bf16x8 __attribute__((ext_vector_type(8)));
typedef float f32x4 __attribute__((ext_vector_type(4)));
typedef unsigned u32x4 __attribute__((ext_vector_type(4)));
typedef unsigned u32x2 __attribute__((ext_vector_type(2)));

constexpr int NB = 4, SEQ = 8192, M = NB * SEQ, DM = 1024, NIN = 2304, NINS = 2300, FF = 2816, NGU = 2 * FF;
constexpr float EPS = 1e-6f;
constexpr int C_AX = 0, C_AG = 256, C_BQ = 512, C_KC = 768, C_VC = 832, C_KS = 896, C_VS = 960, C_KW = 1024, C_VW = 1088, C_BG = 1152,
              C_CQ = 1164, C_CK = 1292, C_CV = 1420, C_GLR = 1676, C_OG = 1692, C_DCQ = 1948, C_DCKV = 2140, C_DKR = 2268;
constexpr size_t MiB = 1u << 20;
constexpr size_t WS_CTL = 0, CTL_ZERO_BYTES = 1 * MiB;
constexpr size_t WS_ACC = 64 * 1024;
constexpr size_t WS_SSQ0 = 1 * MiB;
constexpr size_t WS_HB = 1 * MiB + 256 * 1024;
constexpr size_t WS_WIN = 2 * MiB, WS_WOUT = 11 * MiB, WS_WGU = 15 * MiB, WS_WDN = 37 * MiB;
constexpr size_t WS_WUQT = 48 * MiB, WS_WUKVT = 48 * MiB + 512 * 1024, WS_W2T = 49 * MiB, WS_W1T = 50 * MiB;
constexpr size_t WS_WGT = 49 * MiB + 512 * 1024, WS_SP = 49 * MiB + 768 * 1024;
constexpr size_t WS_BCS = 352 * MiB;
constexpr size_t WS_CS64 = 64 * MiB, WS_CS32 = 72 * MiB;
constexpr size_t WS_XB = 80 * MiB, WS_Y = 144 * MiB, WS_PB = 208 * MiB, WS_ACT = 208 * MiB;
constexpr size_t WS_LA = 384 * MiB, WS_LH = 386 * MiB, WS_CIN = 388 * MiB;
constexpr size_t WS_KVC = 392 * MiB, WS_DEC = 408 * MiB, WS_SST = 410 * MiB;
constexpr size_t WS_MQ = 428 * MiB, WS_MKN = 452 * MiB, WS_MV = 468 * MiB, WS_MKR = 484 * MiB;
constexpr size_t WS_SSP = 500 * MiB;
constexpr size_t WS_VST = 490 * MiB, WS_VWT = 494 * MiB, WS_KCMPB = 498 * MiB, WS_VCMPT = 499 * MiB, WS_END = 504 * MiB;
constexpr int CW_QUEUE = 64;
constexpr int CW_FLAG = 1024;
constexpr int CW_BAR = 4096;
constexpr int LDS_BYTES = 163840 - 256;
constexpr int LDS_CTL = LDS_BYTES - 64;
constexpr int NTHR = 512;

struct Args { const float* in[28]; float* out; unsigned char* ws; int ph_lo, ph_hi; };

DI float bf2f(bf16_t h) { return __uint_as_float(((unsigned)h) << 16); }
DI float bflo(unsigned u) { return __uint_as_float(u << 16); }
DI float bfhi(unsigned u) { return __uint_as_float(u & 0xffff0000u); }
DI bf16_t f2bf(float f) { unsigned u = __float_as_uint(f); return (bf16_t)((u + 0x7fffu + ((u >> 16) & 1u)) >> 16); }
DI unsigned pk2(float lo, float hi) { return (unsigned)f2bf(lo) | ((unsigned)f2bf(hi) << 16); }
DI float sum4p(const float* p, size_t row) { return (p[row] + p[(size_t)M + row]) + (p[2 * (size_t)M + row] + p[3 * (size_t)M + row]); }
DI float wave_sum(float v) {
#pragma unroll
    for (int o = 1; o < 64; o <<= 1) v += __shfl_xor(v, o);
    return v;
}
DI float wave_max(float v) {
#pragma unroll
    for (int o = 1; o < 64; o <<= 1) v = fmaxf(v, __shfl_xor(v, o));
    return v;
}
DI int wave_min_i(int v) {
#pragma unroll
    for (int o = 1; o < 64; o <<= 1) { int w = __shfl_xor(v, o); v = w < v ? w : v; }
    return v;
}
DI float sigmoidf_(float x) { return 1.f / (1.f + __expf(-x)); }
DI float gelu_tanh(float x) { const float u = 0.7978845608028654f * (x + 0.044715f * x * x * x); return 0.5f * x * (1.f + tanhf(u)); }
#define WSYNC() do { asm volatile("s_waitcnt lgkmcnt(0)" ::: "memory"); __builtin_amdgcn_wave_barrier(); } while (0)

namespace pg8 {
constexpr int BM = 256, BK = 64, HALF = 128, HTB = HALF * BK * 2, NXCD = 8, WGM = 8;
__host__ __device__ __forceinline__ int lds_byte(int r, int c) { const int st = (r >> 4) * 2 + (c >> 5), rr = r & 15, cc = c & 31, ob = rr * 64 + cc * 2; return st * 1024 + (ob ^ (((ob >> 9) & 1) << 5)); }
__host__ __device__ __forceinline__ void stage_rc(int b, int& R, int& C) { const int st = b / 1024, sb = b % 1024, swz = sb ^ (((sb >> 9) & 1) << 5); R = (st >> 1) * 16 + swz / 64; C = (st & 1) * 32 + (swz % 64) / 2; }
__host__ __device__ __forceinline__ int perm32(int rho) { const int n = rho >> 4, i = rho & 15; return 8 * (i >> 2) + 4 * n + (i & 3); }
struct Unit { int pm, pn; };
struct Gemm { const bf16_t* A; const bf16_t* Bt; int M, N, K; };
struct StaticOrder {
    int nM, nN, nwg, G, c;
    __host__ __device__ void init(int M_, int N_, int G_, int c_) { nM = M_ / BM; nN = N_ / BM; nwg = nM * nN; G = G_; c = c_; }
    __host__ __device__ bool next(int i, Unit& u) const {
        const long L = (long)i * G + c; if (L >= nwg) return false;
        int wgid = (int)L; { const int q = nwg / NXCD, r = nwg % NXCD, xcd = wgid % NXCD, off = wgid / NXCD; wgid = (xcd < r ? xcd * (q + 1) : r * (q + 1) + (xcd - r) * q) + off; }
        const int nig = WGM * nN, gid = wgid / nig, fm = gid * WGM, gsz = (nM - fm) < WGM ? (nM - fm) : WGM;
        u.pm = fm + ((wgid % nig) % gsz); u.pn = (wgid % nig) / gsz; return true;
    }
    __device__ __forceinline__ void a_ready(const Unit&) const {}
    __device__ __forceinline__ void done(const Unit&) const {}
};
DI unsigned cvt_pk_bf16(float lo, float hi) { unsigned r; asm volatile("v_cvt_pk_bf16_f32 %0, %1, %2" : "=v"(r) : "v"(lo), "v"(hi)); return r; }

struct EpiInProj {
    static constexpr bool PERM = true, AFTER_DRAIN = false, MIDSCALE = false;
    bf16_t* O; int ldc; const float* ssq;
    DI void operator()(const f32x4 (&acc)[2][2][4][2], const Unit& u, int wr, int wc, int fr, int fq) const {
        int row0 = u.pm * BM + wr * 64 + fr; asm volatile("" : "+v"(row0)); const int col0 = u.pn * BM + wc * 32 + 8 * fq;
#pragma unroll
        for (int ai = 0; ai < 2; ++ai)
#pragma unroll
            for (int m = 0; m < 4; ++m) {
                const int row = row0 + ai * HALF + m * 16;
                const float rinv = rsqrtf(sum4p(ssq, row) * (1.f / DM) + EPS);
                bf16_t* rowp = O + (size_t)row * ldc + col0;
#pragma unroll
                for (int bj = 0; bj < 2; ++bj) {
                    f32x4 v0 = acc[ai][bj][m][0] * rinv, v1 = acc[ai][bj][m][1] * rinv;
                    u32x4 w; w.x = cvt_pk_bf16(v0[0], v0[1]); w.y = cvt_pk_bf16(v0[2], v0[3]); w.z = cvt_pk_bf16(v1[0], v1[1]); w.w = cvt_pk_bf16(v1[2], v1[3]);
                    *(u32x4*)(rowp + bj * HALF) = w;
                }
            }
    }
};
template <bool MS> struct EpiResid {
    static constexpr bool PERM = true, AFTER_DRAIN = false, MIDSCALE = MS;
    bf16_t* xb; float* ssq_part; const float* ssq_mid; LAS float* ssl;
    DI void midscale(f32x4 (&acc)[2][2][4][2], const Unit& u, int wr, int fr) const {
        int row0 = u.pm * BM + wr * 64 + fr; asm volatile("" : "+v"(row0));
#pragma unroll
        for (int ai = 0; ai < 2; ++ai)
#pragma unroll
            for (int m = 0; m < 4; ++m) { const float s = rsqrtf(sum4p(ssq_mid, row0 + ai * HALF + m * 16) * (1.f / 256.f) + EPS);
#pragma unroll
                for (int bj = 0; bj < 2; ++bj) { acc[ai][bj][m][0] *= s; acc[ai][bj][m][1] *= s; } }
    }
    DI void operator()(const f32x4 (&acc)[2][2][4][2], const Unit& u, int wr, int wc, int fr, int fq) const {
        int rl0 = wr * 64 + fr; asm volatile("" : "+v"(rl0));
        const int col0 = u.pn * BM + wc * 32 + 8 * fq;
#pragma unroll
        for (int ai = 0; ai < 2; ++ai)
#pragma unroll
            for (int m = 0; m < 4; ++m) {
                const int rl = rl0 + ai * HALF + m * 16; const size_t row = (size_t)u.pm * BM + rl;
                float part = 0.f;
#pragma unroll
                for (int bj = 0; bj < 2; ++bj) {
                    u32x4* px = (u32x4*)(xb + row * DM + col0 + bj * HALF); const u32x4 xo = *px;
                    const f32x4 a0 = acc[ai][bj][m][0], a1 = acc[ai][bj][m][1];
                    const float v0 = a0[0] + bflo(xo.x), v1 = a0[1] + bfhi(xo.x), v2 = a0[2] + bflo(xo.y), v3 = a0[3] + bfhi(xo.y), v4 = a1[0] + bflo(xo.z), v5 = a1[1] + bfhi(xo.z), v6 = a1[2] + bflo(xo.w), v7 = a1[3] + bfhi(xo.w);
                    u32x4 w; w.x = cvt_pk_bf16(v0, v1); w.y = cvt_pk_bf16(v2, v3); w.z = cvt_pk_bf16(v4, v5); w.w = cvt_pk_bf16(v6, v7);
                    *px = w;
                    part += (v0 * v0 + v1 * v1) + (v2 * v2 + v3 * v3) + (v4 * v4 + v5 * v5) + (v6 * v6 + v7 * v7);
                }
                part += __shfl_xor(part, 16); part += __shfl_xor(part, 32);
                if (fq == 0) ssl[rl * 4 + wc] = part;
            }
        asm volatile("s_waitcnt lgkmcnt(0)" ::: "memory"); __builtin_amdgcn_s_barrier();
        int tq = threadIdx.x; asm volatile("" : "+v"(tq));
        if (tq < 256) { const f32x4 p = *(const LAS f32x4*)(ssl + tq * 4); ssq_part[(size_t)u.pn * M + (size_t)u.pm * BM + tq] = (p[0] + p[1]) + (p[2] + p[3]); }
    }
};
struct EpiSwiglu {
    static constexpr bool PERM = true, AFTER_DRAIN = false, MIDSCALE = false;
    bf16_t* act; const float* ssq;
    DI void operator()(const f32x4 (&acc)[2][2][4][2], const Unit& u, int wr, int wc, int fr, int fq) const {
        int row0 = u.pm * BM + wr * 64 + fr; asm volatile("" : "+v"(row0)); const int j0 = u.pn * 128 + wc * 16 + 4 * fq;
#pragma unroll
        for (int ai = 0; ai < 2; ++ai)
#pragma unroll
            for (int m = 0; m < 4; ++m) {
                const int row = row0 + ai * HALF + m * 16;
                const float rinv = rsqrtf(sum4p(ssq, row) * (1.f / DM) + EPS);
#pragma unroll
                for (int bj = 0; bj < 2; ++bj) {
                    const f32x4 g = acc[ai][bj][m][0] * rinv, up = acc[ai][bj][m][1] * rinv;
                    float a[4];
#pragma unroll
                    for (int i = 0; i < 4; ++i) a[i] = g[i] / (1.f + __expf(-g[i])) * up[i];
                    u32x2 w; w.x = cvt_pk_bf16(a[0], a[1]); w.y = cvt_pk_bf16(a[2], a[3]);
                    *(u32x2*)(act + (size_t)row * FF + j0 + bj * 64) = w;
                }
            }
    }
};

template <class Epi, class Sched, bool ALIGN_EPI = false, bool SP2 = false>
DI void gemm_phase(LAS unsigned char* lds, const Gemm g, const Sched& S, const Epi& E) {
    int tid_ = threadIdx.x; asm volatile("" : "+v"(tid_));
    const int tid = tid_, wid = __builtin_amdgcn_readfirstlane(tid >> 6), lane = tid & 63, wr = wid >> 2, wc = wid & 3, fr = lane & 15, fq = lane >> 4;
    const int K = g.K, nt = K / BK;
    unsigned voffA[2], voffB[2];
#pragma unroll
    for (int i = 0; i < 2; ++i) { int R, C; stage_rc(tid * 16 + i * 8192, R, C); const int Rb = Epi::PERM ? ((R & ~31) + perm32(R & 31)) : R;
        voffA[i] = (unsigned)(R * K + C) * 2u; voffB[i] = (unsigned)(Rb * K + C) * 2u; }
    const size_t kstep = (size_t)(BK * 2);
    const size_t hstep = (size_t)HALF * K * 2;
    const size_t tstep = 2 * hstep;
    const unsigned ldsw = (unsigned)wid * 1024u;
    const int aoff = lds_byte(wr * 64 + fr, fq * 8), boff = lds_byte(wc * 32 + fr, fq * 8);
#define PG8_SA(b, h) (((b) * 2 + (h)) * HTB)
#define PG8_SB(b, h) ((4 + (b) * 2 + (h)) * HTB)
#define PG8_STAGE(bufoff, gbase, voff) do { _Pragma("unroll") for (int _i = 0; _i < 2; ++_i) \
        __builtin_amdgcn_global_load_lds((const unsigned*)((const char*)(gbase) + (voff)[_i]), (LAS unsigned*)(lds + (bufoff) + ldsw + _i * 8192), 16, 0, 0); } while (0)
#define PG8_LDA(dst, b, h) do { _Pragma("unroll") for (int m = 0; m < 4; ++m) _Pragma("unroll") for (int k = 0; k < 2; ++k) dst[m][k] = *(const LAS bf16x8*)(lds + PG8_SA(b, h) + aoff + m * 2048 + k * 1024); } while (0)
#define PG8_LDB(dst, b, h) do { _Pragma("unroll") for (int n = 0; n < 2; ++n) _Pragma("unroll") for (int k = 0; k < 2; ++k) dst[n][k] = *(const LAS bf16x8*)(lds + PG8_SB(b, h) + boff + n * 2048 + k * 1024); } while (0)
#define PG8_MMA(ai, bj, At, Bt) do { __builtin_amdgcn_s_setprio(1); _Pragma("unroll") for (int m = 0; m < 4; ++m) _Pragma("unroll") for (int n = 0; n < 2; ++n) _Pragma("unroll") for (int k = 0; k < 2; ++k) \
        acc[ai][bj][m][n] = __builtin_amdgcn_mfma_f32_16x16x32_bf16(Bt[n][k], At[m][k], acc[ai][bj][m][n], 0, 0, 0); __builtin_amdgcn_s_setprio(0); } while (0)
#define PG8_WAIT_V(n) asm volatile("s_waitcnt vmcnt(" #n ")" ::: "memory")
#define PG8_WAIT_L(n) asm volatile("s_waitcnt lgkmcnt(" #n ")" ::: "memory")
#define PG8_BAR __builtin_amdgcn_s_barrier()
#define PG8_SCHED __builtin_amdgcn_sched_barrier(0)
    Unit cur, nxt; int ui = 0;
    if (!S.next(0, cur)) return;
    f32x4 acc[2][2][4][2];
#pragma unroll
    for (int a = 0; a < 2; ++a)
#pragma unroll
        for (int b = 0; b < 2; ++b)
#pragma unroll
            for (int m = 0; m < 4; ++m)
#pragma unroll
                for (int n = 0; n < 2; ++n) acc[a][b][m][n] = (f32x4){0.f, 0.f, 0.f, 0.f};
    bf16x8 At[4][2], B0[2][2], B1[2][2];
    const char* cA = (const char*)g.A + (size_t)cur.pm * tstep; const char* cB = (const char*)g.Bt + (size_t)cur.pn * tstep;
    S.a_ready(cur);
    if constexpr (SP2) {
        PG8_STAGE(PG8_SB(0, 0), cB, voffB); PG8_STAGE(PG8_SB(0, 1), cB + hstep, voffB); PG8_STAGE(PG8_SA(0, 0), cA, voffA); PG8_STAGE(PG8_SA(0, 1), cA + hstep, voffA);
        if (wr == 1) PG8_BAR;
        PG8_WAIT_V(2); PG8_BAR;
        PG8_STAGE(PG8_SB(1, 0), cB + kstep, voffB); PG8_STAGE(PG8_SA(1, 0), cA + kstep, voffA); PG8_STAGE(PG8_SB(1, 1), cB + hstep + kstep, voffB);
        PG8_WAIT_V(6); PG8_BAR;
    } else {
        PG8_STAGE(PG8_SB(0, 0), cB, voffB); PG8_STAGE(PG8_SA(0, 0), cA, voffA); PG8_STAGE(PG8_SB(0, 1), cB + hstep, voffB); PG8_STAGE(PG8_SA(0, 1), cA + hstep, voffA);
        if (wr == 1) PG8_BAR;
        PG8_WAIT_V(4); PG8_BAR;
        PG8_STAGE(PG8_SB(1, 0), cB + kstep, voffB); PG8_STAGE(PG8_SA(1, 0), cA + kstep, voffA); PG8_STAGE(PG8_SB(1, 1), cB + hstep + kstep, voffB);
        PG8_WAIT_V(6); PG8_BAR;
    }
    for (;;) {
        const bool has_next = S.next(ui + 1, nxt);
        const char* nA = has_next ? (const char*)g.A + (size_t)nxt.pm * tstep : cA; const char* nB = has_next ? (const char*)g.Bt + (size_t)nxt.pn * tstep : cB;
        for (int t = 0; t < nt; t += 2) {
            const bool last = (t == nt - 2);
            const char* a1 = cA + (size_t)(t + 1) * kstep;
            const char* a2 = last ? nA : cA + (size_t)(t + 2) * kstep; const char* b2 = last ? nB : cB + (size_t)(t + 2) * kstep;
            const char* a3 = a2 + kstep; const char* b3 = b2 + kstep;
            if (last && has_next) S.a_ready(nxt);
            if constexpr (SP2) {
            PG8_LDB(B0, 0, 0); PG8_LDB(B1, 0, 1); PG8_SCHED; PG8_LDA(At, 0, 0); PG8_STAGE(PG8_SA(1, 1), a1 + hstep, voffA);
            PG8_WAIT_V(8); PG8_WAIT_L(0); PG8_BAR; PG8_MMA(0, 0, At, B0); PG8_MMA(0, 1, At, B1); PG8_BAR; PG8_SCHED;
            PG8_LDA(At, 0, 1); PG8_STAGE(PG8_SB(0, 0), b2, voffB); PG8_STAGE(PG8_SB(0, 1), b2 + hstep, voffB); PG8_STAGE(PG8_SA(0, 0), a2, voffA);
            PG8_WAIT_V(8); PG8_WAIT_L(0); PG8_BAR; PG8_MMA(1, 0, At, B0); PG8_MMA(1, 1, At, B1); PG8_BAR; PG8_SCHED;
            PG8_LDB(B0, 1, 0); PG8_LDB(B1, 1, 1); PG8_SCHED; PG8_LDA(At, 1, 0); PG8_STAGE(PG8_SA(0, 1), a2 + hstep, voffA);
            PG8_WAIT_V(8); PG8_WAIT_L(0); PG8_BAR; PG8_MMA(0, 0, At, B0); PG8_MMA(0, 1, At, B1); PG8_BAR; PG8_SCHED;
            PG8_LDA(At, 1, 1); PG8_STAGE(PG8_SB(1, 0), b3, voffB); PG8_STAGE(PG8_SB(1, 1), b3 + hstep, voffB); PG8_STAGE(PG8_SA(1, 0), a3, voffA);
            PG8_WAIT_V(8); PG8_WAIT_L(0); PG8_BAR; PG8_MMA(1, 0, At, B0); PG8_MMA(1, 1, At, B1); PG8_BAR; PG8_SCHED;
            if constexpr (Epi::MIDSCALE) { if (t == 2) E.midscale(acc, cur, wr, fr); }
            } else {
            PG8_LDB(B0, 0, 0); PG8_SCHED; PG8_LDA(At, 0, 0); PG8_STAGE(PG8_SA(1, 1), a1 + hstep, voffA);
            PG8_WAIT_L(8); PG8_BAR; PG8_WAIT_L(0); PG8_MMA(0, 0, At, B0); PG8_BAR; PG8_SCHED;
            PG8_LDB(B1, 0, 1); PG8_STAGE(PG8_SB(0, 0), b2, voffB);
            PG8_BAR; PG8_WAIT_L(0); PG8_MMA(0, 1, At, B1); PG8_BAR;
            PG8_LDA(At, 0, 1); PG8_STAGE(PG8_SA(0, 0), a2, voffA);
            PG8_BAR; PG8_WAIT_L(0); PG8_MMA(1, 0, At, B0); PG8_BAR; PG8_SCHED;
            PG8_STAGE(PG8_SB(0, 1), b2 + hstep, voffB);
            PG8_WAIT_V(6); PG8_BAR; PG8_MMA(1, 1, At, B1); PG8_BAR;
            PG8_LDB(B0, 1, 0); PG8_SCHED; PG8_LDA(At, 1, 0); PG8_STAGE(PG8_SA(0, 1), a2 + hstep, voffA);
            PG8_WAIT_L(8); PG8_BAR; PG8_WAIT_L(0); PG8_MMA(0, 0, At, B0); PG8_BAR; PG8_SCHED;
            PG8_LDB(B1, 1, 1); PG8_STAGE(PG8_SB(1, 0), b3, voffB);
            PG8_BAR; PG8_WAIT_L(0); PG8_MMA(0, 1, At, B1); PG8_BAR;
            PG8_LDA(At, 1, 1); PG8_STAGE(PG8_SA(1, 0), a3, voffA);
            PG8_BAR; PG8_WAIT_L(0); PG8_MMA(1, 0, At, B0); PG8_BAR; PG8_SCHED;
            PG8_STAGE(PG8_SB(1, 1), b3 + hstep, voffB);
            PG8_WAIT_V(6); PG8_BAR; PG8_MMA(1, 1, At, B1); PG8_BAR;
            }
        }
        if constexpr (ALIGN_EPI) { if (wr == 0) PG8_BAR; }
        if constexpr (!Epi::AFTER_DRAIN) { E(acc, cur, wr, wc, fr, fq); S.done(cur); }
        if (!has_next) break;
#pragma unroll
        for (int a = 0; a < 2; ++a)
#pragma unroll
            for (int b = 0; b < 2; ++b)
#pragma unroll
                for (int m = 0; m < 4; ++m)
#pragma unroll
                    for (int n = 0; n < 2; ++n) acc[a][b][m][n] = (f32x4){0.f, 0.f, 0.f, 0.f};
        cur = nxt; cA = nA; cB = nB; ++ui;
        if constexpr (ALIGN_EPI) { if (wr == 1) PG8_BAR; }
    }
    PG8_WAIT_V(0);
    if constexpr (!ALIGN_EPI) { if (wr == 0) PG8_BAR; }
    PG8_BAR;
#undef PG8_SA
#undef PG8_SB
#undef PG8_STAGE
#undef PG8_LDA
#undef PG8_LDB
#undef PG8_MMA
#undef PG8_WAIT_V
#undef PG8_WAIT_L
#undef PG8_BAR
#undef PG8_SCHED
}
}

#define XB_TMO      128
#define XB_XCNT(j)  (256  + 64 * (j))
#define XB_XSUB(j)  (1280 + 64 * (j))
#define XB_XGEN(j)  (2304 + 64 * (j))
#define XB_TOP      3328
#define XB_TOPGEN   3392
#define XCD_BAR_WORDS 3456
#define XB_SPIN_CAP (1u << 18)
__device__ __forceinline__ unsigned xb_ld(unsigned* p)              { return __hip_atomic_load(p, __ATOMIC_RELAXED, __HIP_MEMORY_SCOPE_AGENT); }
__device__ __forceinline__ unsigned xb_add(unsigned* p, unsigned v) { return __hip_atomic_fetch_add(p, v, __ATOMIC_RELAXED, __HIP_MEMORY_SCOPE_AGENT); }
__device__ __forceinline__ unsigned xb_xcc_id() { return (unsigned)__builtin_amdgcn_s_getreg((3 << 11) | 20) & 0xFu; }
#define XB_SPIN(cond, bar) do { unsigned _sp = 0; while (cond) { __builtin_amdgcn_s_sleep(1); \
    if ((++_sp & 255u) == 0u) { if (xb_ld(&(bar)[XB_TMO])) break; if (_sp > XB_SPIN_CAP) { atomicAdd(&(bar)[XB_TMO], 1u); break; } } } } while (0)
struct XcdBarrier { unsigned* bar; unsigned x; volatile LAS unsigned* st; };
__device__ __forceinline__ XcdBarrier xcd_barrier_post(unsigned* bar, volatile LAS unsigned* st) {
    XcdBarrier b; b.bar = bar; b.x = xb_xcc_id(); b.st = st;
    if (threadIdx.x == 0) (void)xb_add(&bar[XB_XCNT(b.x)], 1u);
    return b;
}
__device__ __forceinline__ void xcd_barrier_complete(unsigned* bar, unsigned x, unsigned& nloc, unsigned& nx) {
    const unsigned G = gridDim.x * gridDim.y * gridDim.z;
    unsigned sum, cnt, mine, sp = 0u;
    for (;;) {
        sum = 0u; cnt = 0u; mine = 0u;
#pragma unroll
        for (unsigned j = 0; j < 16; ++j) { const unsigned c = xb_ld(&bar[XB_XCNT(j)]); sum += c; cnt += (c > 0u) ? 1u : 0u; mine = (j == x) ? c : mine; }
        if (sum == G) break;
        __builtin_amdgcn_s_sleep(1);
        if ((++sp & 255u) == 0u) { if (xb_ld(&bar[XB_TMO])) break; if (sp > XB_SPIN_CAP) { atomicAdd(&bar[XB_TMO], 1u); break; } }
    }
    nloc = mine > 0u ? mine : 1u; nx = cnt > 0u ? cnt : 1u;
}
__device__ __forceinline__ void xcd_barrier(const XcdBarrier& b) {
    asm volatile("s_waitcnt vmcnt(0)" ::: "memory");
    __syncthreads();
    if (threadIdx.x == 0) {
        unsigned* bar = b.bar;
        __builtin_amdgcn_s_waitcnt(0);
        unsigned nloc = b.st[0], nx = b.st[1];
        if (nloc == 0u) { xcd_barrier_complete(bar, b.x, nloc, nx); b.st[0] = nloc; b.st[1] = nx; }
        const unsigned old = xb_add(&bar[XB_XSUB(b.x)], 1u);
        const unsigned gen = old / nloc;
        if (old + 1u == (gen + 1u) * nloc) {
            __builtin_amdgcn_fence(__ATOMIC_RELEASE, "agent");
            asm volatile("s_waitcnt vmcnt(0)" ::: "memory");
            const unsigned og = xb_add(&bar[XB_TOP], 1u);
            const unsigned tg = og / nx;
            if (og + 1u == (tg + 1u) * nx) xb_add(&bar[XB_TOPGEN], 1u);
            else XB_SPIN(xb_ld(&bar[XB_TOPGEN]) == tg, bar);
            __builtin_amdgcn_fence(__ATOMIC_ACQUIRE, "agent");
            xb_add(&bar[XB_XGEN(b.x)], 1u);
            asm volatile("s_waitcnt vmcnt(0)" ::: "memory");
        } else {
            XB_SPIN(xb_ld(&bar[XB_XGEN(b.x)]) == gen, bar);
            __builtin_amdgcn_fence(__ATOMIC_ACQUIRE, "agent");
            asm volatile("s_waitcnt vmcnt(0)" ::: "memory");
        }
    }
    __syncthreads();
}

template <int MAP>
DI int colmap(int v, int Nsrc) {
    if (MAP == 0) return v < Nsrc ? v : -1;
    const int g8 = v >> 3, e = v & 7, j = 4 * g8 + (e & 3); return (e < 4) ? j : FF + j;
}
template <int MAP, int KROT = 0>
DI void p0_transpose_item(const float* W, int K, int Nsrc, const float* gain, bf16_t* WT, LAS float* scr, int kb, int nb, int lane) {
    const int k0 = 64 * kb, n0 = 32 * nb;
    const int sc = colmap<MAP>(n0 + (lane & 31), Nsrc);
#pragma unroll 8
    for (int i = 0; i < 32; ++i) { const int kk = 2 * i + (lane >> 5); int ksrc = k0 + kk + KROT; if (KROT && ksrc >= K) ksrc -= K; float w = 0.f; if (sc >= 0) w = W[(size_t)ksrc * Nsrc + sc]; if (gain) w *= gain[ksrc]; scr[kk * 33 + (lane & 31)] = w; }
    WSYNC();
    const int c = lane & 7;
#pragma unroll
    for (int j = 0; j < 4; ++j) { const int n = (lane >> 3) + 8 * j; const LAS float* s = scr + (8 * c) * 33 + n;
        u32x4 o; o.x = pk2(s[0 * 33], s[1 * 33]); o.y = pk2(s[2 * 33], s[3 * 33]); o.z = pk2(s[4 * 33], s[5 * 33]); o.w = pk2(s[6 * 33], s[7 * 33]);
        *(u32x4*)(WT + (size_t)(n0 + n) * K + k0 + 8 * c) = o; }
    WSYNC();
}


typedef float f32x16 __attribute__((ext_vector_type(16)));
typedef float f32x2v __attribute__((ext_vector_type(2)));
typedef __bf16 bf16x2_t __attribute__((ext_vector_type(2)));
constexpr int KSTR = 208, VSTR = 136;
constexpr int AL_K0 = 0, AL_K1 = 64 * KSTR, AL_V0 = 2 * 64 * KSTR, AL_V1 = AL_V0 + 64 * VSTR, AL_IMP = 45056, AL_SELM = AL_IMP + 32768, AL_OACC = AL_SELM + 1024;
constexpr float NEGB = -1e30f, LOG2E = 1.4426950408889634f;
DI unsigned cvtpk(float lo, float hi) { f32x2v v = {lo, hi}; bf16x2_t b = __builtin_convertvector(v, bf16x2_t); return __builtin_bit_cast(unsigned, b); }
DI f32x16 mfma32(bf16x8 a, bf16x8 b, f32x16 c) { return __builtin_amdgcn_mfma_f32_32x32x16_bf16(a, b, c, 0, 0, 0); }
DI float xhalf_max(float v) { auto rr = __builtin_amdgcn_permlane32_swap(__float_as_uint(v), __float_as_uint(v), false, false); return fmaxf(__uint_as_float(rr[0]), __uint_as_float(rr[1])); }
DI float xhalf_sum(float v) { auto rr = __builtin_amdgcn_permlane32_swap(__float_as_uint(v), __float_as_uint(v), false, false); return __uint_as_float(rr[0]) + __uint_as_float(rr[1]); }
DI float ex2(float x) { return __builtin_amdgcn_exp2f(x); }
template <int KSTEPS>
DI void qk_tile(const LAS unsigned char* Kt, const bf16x8 (&qf)[KSTEPS], int r32, int hi, f32x16& s0, f32x16& s1) {
    const LAS unsigned char* p0 = Kt + r32 * KSTR + hi * 16;
#pragma unroll
    for (int i = 0; i < 16; ++i) { s0[i] = 0.f; s1[i] = 0.f; }
#pragma unroll
    for (int ks = 0; ks < KSTEPS; ++ks) {
        const bf16x8 a0 = *(const LAS bf16x8*)(p0 + ks * 32), a1 = *(const LAS bf16x8*)(p0 + 32 * KSTR + ks * 32);
        s0 = mfma32(a0, qf[ks], s0); s1 = mfma32(a1, qf[ks], s1);
    }
}
DI void mask_tile(f32x16& s0, f32x16& s1, int klo, int khi, int hi) {
    const int lo_ = klo - 4 * hi, hi_ = khi - 4 * hi;
#pragma unroll
    for (int i = 0; i < 16; ++i) { const int kb = (i & 3) + 8 * (i >> 2); if (kb < lo_ || kb > hi_) s0[i] = NEGB; if (kb + 32 < lo_ || kb + 32 > hi_) s1[i] = NEGB; }
}
DI float tile_max(const f32x16& s0, const f32x16& s1) {
    float mx = fmaxf(s0[0], s1[0]);
#pragma unroll
    for (int i = 1; i < 16; ++i) mx = fmaxf(mx, fmaxf(s0[i], s1[i]));
    return xhalf_max(mx);
}
template <int BASE> DI bf16x8 pack8(const f32x16& s) { u32x4 p; p.x = cvtpk(s[BASE], s[BASE + 1]); p.y = cvtpk(s[BASE + 2], s[BASE + 3]); p.z = cvtpk(s[BASE + 4], s[BASE + 5]); p.w = cvtpk(s[BASE + 6], s[BASE + 7]); return __builtin_bit_cast(bf16x8, p); }
DI bf16x8 ld8x2(const bf16_t* p) { const u32x2 a = *(const u32x2*)p, b = *(const u32x2*)(p + 4); u32x4 w; w.x = a.x; w.y = a.y; w.z = b.x; w.w = b.y; return __builtin_bit_cast(bf16x8, w); }
DI bf16x8 vfrag(const LAS unsigned char* p) { const u32x2 a = *(const LAS u32x2*)p, b = *(const LAS u32x2*)(p + 16); u32x4 w; w.x = a.x; w.y = a.y; w.z = b.x; w.w = b.y; return __builtin_bit_cast(bf16x8, w); }
DI void pv_tile(const f32x16& s0, const f32x16& s1, const LAS unsigned char* Vt, f32x16 (&o)[2], int r32, int hi) {
    const bf16x8 p00 = pack8<0>(s0), p01 = pack8<8>(s0), p10 = pack8<0>(s1), p11 = pack8<8>(s1);
#pragma unroll
    for (int dt = 0; dt < 2; ++dt) { const LAS unsigned char* vp = Vt + (32 * dt + r32) * VSTR + 8 * hi;
        o[dt] = mfma32(vfrag(vp), p00, o[dt]); o[dt] = mfma32(vfrag(vp + 32), p01, o[dt]); o[dt] = mfma32(vfrag(vp + 64), p10, o[dt]); o[dt] = mfma32(vfrag(vp + 96), p11, o[dt]); }
}
DI void softmax_pv(f32x16& s0, f32x16& s1, const LAS unsigned char* Vt, f32x16 (&o)[2], float& m, float& l, int r32, int hi) {
    const float mx = tile_max(s0, s1), mn = fmaxf(m, mx), ms = mn < -1e29f ? 0.f : mn, alpha = ex2(m - ms);
    m = mn; float psum = 0.f;
#pragma unroll
    for (int i = 0; i < 16; ++i) { s0[i] = ex2(s0[i] - ms); s1[i] = ex2(s1[i] - ms); psum += s0[i] + s1[i]; }
    l = l * alpha + psum;
    if (!__all(alpha == 1.f)) {
#pragma unroll
        for (int i = 0; i < 16; ++i) { o[0][i] *= alpha; o[1][i] *= alpha; } }
    pv_tile(s0, s1, Vt, o, r32, hi);
}
struct SoftState { float m, l; f32x16 negm; };
constexpr float SM_THR = 8.f;
DI void soft_init(SoftState& S, f32x16 (&o)[2]) { S.m = 0.f; S.l = 0.f;
#pragma unroll
    for (int i = 0; i < 16; ++i) { S.negm[i] = 0.f; o[0][i] = 0.f; o[1][i] = 0.f; } }
DI float max3f(float a, float b, float c) { float r; asm("v_max3_f32 %0, %1, %2, %3" : "=v"(r) : "v"(a), "v"(b), "v"(c)); return r; }
template <int KSTEPS>
DI void attn_step(const LAS unsigned char* Kt, const LAS unsigned char* Vt, const bf16x8 (&qf)[KSTEPS], SoftState& S, f32x16 (&o)[2], bool masked, int klo, int khi, bool first, int r32, int hi) {
    f32x16 s0 = S.negm, s1 = S.negm;
    { const LAS unsigned char* p0 = Kt + r32 * KSTR + hi * 16;
#pragma unroll
      for (int ks = 0; ks < KSTEPS; ++ks) { const bf16x8 a0 = *(const LAS bf16x8*)(p0 + ks * 32), a1 = *(const LAS bf16x8*)(p0 + 32 * KSTR + ks * 32);
          s0 = mfma32(a0, qf[ks], s0); s1 = mfma32(a1, qf[ks], s1); } }
    if (__builtin_expect(masked, 0)) { asm volatile("; boundary tile mask" ::: "memory"); mask_tile(s0, s1, klo, khi, hi); }
    asm volatile("s_nop 15\n\ts_nop 7" : "+v"(s0), "+v"(s1));
    float rm;
    { float a = max3f(s0[0], s0[1], s0[2]), b = max3f(s1[0], s1[1], s1[2]);
#pragma unroll
      for (int i = 3; i < 15; i += 2) { a = max3f(a, s0[i], s0[i + 1]); b = max3f(b, s1[i], s1[i + 1]); }
      rm = xhalf_max(fmaxf(max3f(a, b, s0[15]), s1[15])); }
    if (first) {
        const float dl = rm < -1e29f ? 0.f : rm; S.m = dl;
#pragma unroll
        for (int i = 0; i < 16; ++i) { s0[i] -= dl; s1[i] -= dl; S.negm[i] = -dl; }
    } else if (__any(rm > SM_THR)) {
        const float dl = fmaxf(rm, 0.f), alpha = ex2(-dl); S.m += dl; S.l *= alpha;
#pragma unroll
        for (int i = 0; i < 16; ++i) { s0[i] -= dl; s1[i] -= dl; S.negm[i] = -S.m; o[0][i] *= alpha; o[1][i] *= alpha; }
    }
    float p0 = 0.f, p1 = 0.f, p2 = 0.f, p3 = 0.f;
#pragma unroll
    for (int i = 0; i < 16; i += 2) { s0[i] = ex2(s0[i]); s0[i + 1] = ex2(s0[i + 1]); s1[i] = ex2(s1[i]); s1[i + 1] = ex2(s1[i + 1]); p0 += s0[i]; p1 += s0[i + 1]; p2 += s1[i]; p3 += s1[i + 1]; }
    S.l += (p0 + p1) + (p2 + p3);
    pv_tile(s0, s1, Vt, o, r32, hi);
}
struct StageRegs { u32x4 a, b, c; };
template <class LoadF, class StoreF, class StepF>
DI void attn_pipeline(int jbeg, int jend, LoadF ld, StoreF st, StepF step) {
    if (jbeg > jend) return;
    StageRegs RA;
    ld(jbeg, RA); st(0, RA); __syncthreads();
    for (int j = jbeg; j <= jend; j += 2) {
        if (j + 1 <= jend) ld(j + 1, RA);
        step(j, 0);
        if (j + 1 <= jend) st(1, RA);
        __syncthreads();
        if (j + 1 > jend) break;
        if (j + 2 <= jend) ld(j + 2, RA);
        step(j + 1, 1);
        if (j + 2 <= jend) st(0, RA);
        __syncthreads();
    }
}
DI const float* inp(const Args& a, int k) { asm volatile("" : "+s"(k)); return a.in[k]; }
__global__ void __launch_bounds__(NTHR, 2) fwd(Args args) {
    extern __shared__ __attribute__((aligned(16))) unsigned char lds_raw[];
    LAS unsigned char* lds = (LAS unsigned char*)lds_raw;
    LAS float* ldsf = (LAS float*)lds;
    volatile LAS unsigned* LCTL = (volatile LAS unsigned*)(lds + LDS_CTL);
    const int tid0 = threadIdx.x, wave = __builtin_amdgcn_readfirstlane(tid0 >> 6);
    const int G = gridDim.x, bid = blockIdx.x;
#define LAUNDER_TID() int tid = tid0; asm volatile("" : "+v"(tid)); const int lane = tid & 63; (void)lane
#define WS_PTRS() unsigned char* ws = args.ws; asm volatile("" : "+s"(ws)); \
    unsigned* ctl = (unsigned*)(ws + WS_CTL); float* ssp_base = (float*)(ws + WS_SSP); float* hb = (float*)(ws + WS_HB); \
    bf16_t* XB = (bf16_t*)(ws + WS_XB); bf16_t* Y = (bf16_t*)(ws + WS_Y); bf16_t* PB = (bf16_t*)(ws + WS_PB); bf16_t* ACT = (bf16_t*)(ws + WS_ACT); \
    const float2* cs64 = (const float2*)(ws + WS_CS64); const float2* cs32 = (const float2*)(ws + WS_CS32); \
    float* LRA = args.out; float* LRU_ = args.out + (size_t)M * 256; \
    float* LA = (float*)(ws + WS_LA); float* LH = (float*)(ws + WS_LH); float* CIN = (float*)(ws + WS_CIN); \
    float* KVC = (float*)(ws + WS_KVC); float* DEC = (float*)(ws + WS_DEC); float* SST = (float*)(ws + WS_SST); \
    bf16_t* MQ = (bf16_t*)(ws + WS_MQ); bf16_t* MKN = (bf16_t*)(ws + WS_MKN); bf16_t* MVT = (bf16_t*)(ws + WS_MV); bf16_t* MKR = (bf16_t*)(ws + WS_MKR); \
    bf16_t* VST = (bf16_t*)(ws + WS_VST); bf16_t* VWT = (bf16_t*)(ws + WS_VWT); bf16_t* KCMPB = (bf16_t*)(ws + WS_KCMPB); bf16_t* VCMPT = (bf16_t*)(ws + WS_VCMPT); \
    const float* ssq_mix = ssp_base + (size_t)(l_ == 0 ? 0 : 2) * 4 * M; float* ssq_out = ssp_base + (size_t)(1 + 3 * l_) * 4 * M; float* ssq_down = ssp_base + (size_t)(2 + 3 * l_) * 4 * M; float* ssq_d = ssp_base + (size_t)(3 + 3 * l_) * 4 * M; \
    (void)ctl; (void)hb; (void)XB; (void)Y; (void)PB; (void)ACT; (void)cs64; (void)cs32; (void)LRA; (void)LRU_; (void)LA; (void)LH; (void)CIN; (void)KVC; (void)DEC; (void)SST; (void)MQ; (void)MKN; (void)MVT; (void)MKR; (void)VST; (void)VWT; (void)KCMPB; (void)VCMPT; (void)ssq_mix; (void)ssq_out; (void)ssq_down; (void)ssq_d
    unsigned* ctl0 = (unsigned*)(args.ws + WS_CTL);
    { LAUNDER_TID(); if (tid < 16) LCTL[tid] = 0u; }
    __syncthreads();
    const int lo = args.ph_lo, hi = args.ph_hi;
    XcdBarrier bar; bar.bar = ctl0 + CW_BAR; bar.x = 0; bar.st = LCTL;
    if (hi - lo > 1) bar = xcd_barrier_post(ctl0 + CW_BAR, LCTL);
#define IN(k) (lo <= (k) && (k) < hi)
#define SEAM(k) do { if (IN(k) && IN((k) + 1)) xcd_barrier(bar); } while (0)

    if (IN(0)) {
        const int l_ = 0; WS_PTRS();
      _Pragma("unroll 1") for (int rep = 0; rep < REP_P0; ++rep) {
        LAUNDER_TID();
        const int gw = bid * 8 + wave, NGW = G * 8;
        LAS float* scr = ldsf + wave * 4096;
        constexpr int I_IN = 16 * 72, I_OUT = 16 * 32, I_GU = 16 * 176, I_DN = 44 * 32, I_L = I_IN + I_OUT + I_GU + I_DN;
        for (int it = gw; it < 2 * I_L; it += NGW) {
            const int l = it / I_L; int r = it % I_L;
            if (r < I_IN) { p0_transpose_item<0>(inp(args, 3) + (size_t)l * DM * NINS, DM, NINS, inp(args, 2) + l * DM, (bf16_t*)(ws + WS_WIN) + (size_t)l * NIN * DM, scr, r / 72, r % 72, lane); continue; } r -= I_IN;
            if (r < I_OUT) { p0_transpose_item<0, 768>(inp(args, 23) + (size_t)l * DM * DM, DM, DM, inp(args, 22) + l * DM, (bf16_t*)(ws + WS_WOUT) + (size_t)l * DM * DM, scr, r / 32, r % 32, lane); continue; } r -= I_OUT;
            if (r < I_GU) { p0_transpose_item<1>(inp(args, 25) + (size_t)l * DM * NGU, DM, NGU, inp(args, 24) + l * DM, (bf16_t*)(ws + WS_WGU) + (size_t)l * NGU * DM, scr, r / 176, r % 176, lane); continue; } r -= I_GU;
            p0_transpose_item<0>(inp(args, 26) + (size_t)l * FF * DM, FF, DM, nullptr, (bf16_t*)(ws + WS_WDN) + (size_t)l * DM * FF, scr, r / 32, r % 32, lane);
        }
        { constexpr int I_UQ = 3 * 12, I_UKV = 2 * 16, I_W1 = 32 * 8, I_W2 = 4 * 2, I_S = 2 * I_UQ + 2 * I_UKV + 4 * I_W1 + 4 * I_W2;
          for (int it = gw; it < I_S; it += NGW) { int r = it;
              if (r < 2 * I_UQ) { const int l = r / I_UQ; r %= I_UQ; p0_transpose_item<0>(inp(args, 20) + (size_t)l * 192 * 384, 192, 384, inp(args, 18) + l * 192, (bf16_t*)(ws + WS_WUQT) + (size_t)l * 384 * 192, scr, r / 12, r % 12, lane); continue; } r -= 2 * I_UQ;
              if (r < 2 * I_UKV) { const int l = r / I_UKV; r %= I_UKV; p0_transpose_item<0>(inp(args, 21) + (size_t)l * 128 * 512, 128, 512, inp(args, 19) + l * 128, (bf16_t*)(ws + WS_WUKVT) + (size_t)l * 512 * 128, scr, r / 16, r % 16, lane); continue; } r -= 2 * I_UKV;
              if (r < 4 * I_W1) { const int lj = r / I_W1; r %= I_W1; p0_transpose_item<0>(inp(args, 12) + (size_t)lj * 2048 * 256, 2048, 256, nullptr, (bf16_t*)(ws + WS_W1T) + (size_t)lj * 256 * 2048, scr, r / 8, r % 8, lane); continue; } r -= 4 * I_W1;
              { const int lj = r / I_W2; r %= I_W2; p0_transpose_item<0>(inp(args, 14) + (size_t)lj * 256 * 64, 256, 64, nullptr, (bf16_t*)(ws + WS_W2T) + (size_t)lj * 64 * 256, scr, r / 2, r % 2, lane); } } }
        for (int e = bid * NTHR + tid; e < 2 * 2 * 4 * 64 * 64; e += G * NTHR) {
            const int k = e & 63, n = (e >> 6) & 63, h = (e >> 12) & 3, g = (e >> 14) & 1, l = e >> 15;
            ((bf16_t*)(ws + WS_WGT))[e] = f2bf((g == 0 ? inp(args, 6) : inp(args, 8))[(((size_t)l * 4 + h) * 64 + k) * 64 + n]); }
        for (int e = bid * NTHR + tid; e < 512; e += G * NTHR) ((float*)(ws + WS_SP))[e] = log1pf(expf(-inp(args, 10)[e]));
        for (int m = gw; m < M; m += NGW) {
            const f32x4* xr = (const f32x4*)(inp(args, 0) + (size_t)m * DM) + lane;
            f32x4 v[4]; float s = 0.f;
#pragma unroll
            for (int j = 0; j < 4; ++j) { v[j] = xr[64 * j]; s += v[j][0] * v[j][0] + v[j][1] * v[j][1] + v[j][2] * v[j][2] + v[j][3] * v[j][3]; }
            s = wave_sum(s);
            u32x2* o8 = (u32x2*)(XB + (size_t)m * DM) + lane;
#pragma unroll
            for (int j = 0; j < 4; ++j) { u32x2 w; w.x = pk2(v[j][0], v[j][1]); w.y = pk2(v[j][2], v[j][3]); o8[64 * j] = w; }
            if (lane < 4) ssp_base[(size_t)lane * M + m] = lane == 0 ? s : 0.f;
        }
        for (int e = bid * NTHR + tid; e < M * 32; e += G * NTHR) {
            const int m = e >> 5, i = e & 31; const float pos = (float)((const int*)inp(args, 1))[m];
            const float invf = powf(10000.f, -(float)(2 * i) / 64.f); float sn, cs; sincosf(pos * invf, &sn, &cs);
            ((float2*)(ws + WS_CS64))[e] = make_float2(cs, sn);
            if (i < 16) { const float invf2 = powf(10000.f, -(float)(2 * i) / 32.f); sincosf(pos * invf2, &sn, &cs); ((float2*)(ws + WS_CS32))[m * 16 + i] = make_float2(cs, sn); }
        }
        for (int e = bid * NTHR + tid; e < 2 * 2 * 256; e += G * NTHR) {
            const int lj = e >> 8, c = e & 255; float a = inp(args, 13)[e];
            const float* pp = inp(args, 11) + (size_t)lj * 2048; const float* w1 = inp(args, 12) + (size_t)lj * 2048 * 256 + c;
            for (int i = 0; i < 2048; ++i) a += pp[i] * w1[(size_t)i * 256];
            hb[e] = a;
        }
      }
    }
    SEAM(0);

    for (int l = 0; l < 2; ++l) {
        const int pb = 1 + 6 * l;
        if (IN(pb)) {
        const int l_ = l; WS_PTRS();
            pg8::Gemm g{XB, (const bf16_t*)(ws + WS_WIN) + (size_t)l * NIN * DM, M, NIN, DM}; pg8::StaticOrder S; S.init(M, NIN, G, bid);
            pg8::EpiInProj E{PB, NIN, ssq_mix};
            _Pragma("unroll 1") for (int rep = 0; rep < REP_G16; ++rep) pg8::gemm_phase<pg8::EpiInProj, pg8::StaticOrder, true, true>(lds, g, S, E);
        }
        SEAM(pb);
        if (IN(pb + 1)) {
        const int l_ = l; WS_PTRS();
        LAUNDER_TID();
            constexpr int N_J1 = 1024, N_J2 = 512, N_J3 = 512, N_J4 = 512, N_J4B = 128;
            {
            for (int r_ = bid; r_ < N_J4B * REP_J4B; r_ += G) { const int r = r_ % N_J4B;
                    const int j = r & 1, g32 = (r >> 1) & 15, b = r >> 5; const int colb = j == 0 ? C_KC : C_VC; const int r32 = lane & 31, hi = lane >> 5;
                    LAS unsigned char* Tl = lds;
                    LAS unsigned char* Hl = lds + 69632;
                    for (int e = tid; e < 528 * 8; e += NTHR) { const int rr = e >> 3, c8 = e & 7, t = 512 * g32 + rr; u32x4 w = {0u, 0u, 0u, 0u};
                        if (t < SEQ) { const bf16_t* pr = PB + ((size_t)b * SEQ + t) * NIN + colb;
                            if (j == 0) { const u32x4 a = *(const u32x4*)(pr + 8 * (c8 & 3)), c = *(const u32x4*)(pr + 32 + 8 * (c8 & 3)); const float2* cs = cs64 + ((size_t)b * SEQ + t) * 32 + 8 * (c8 & 3);
                                const unsigned au[4] = {a.x, a.y, a.z, a.w}, cu[4] = {c.x, c.y, c.z, c.w}; unsigned ou[4];
#pragma unroll
                                for (int q = 0; q < 4; ++q) { const float2 s0 = cs[2 * q], s1 = cs[2 * q + 1]; const float x1a = bflo(au[q]), x1b = bfhi(au[q]), x2a = bflo(cu[q]), x2b = bfhi(cu[q]);
                                    ou[q] = c8 < 4 ? pk2(x1a * s0.x - x2a * s0.y, x1b * s1.x - x2b * s1.y) : pk2(x2a * s0.x + x1a * s0.y, x2b * s1.x + x1b * s1.y); }
                                w.x = ou[0]; w.y = ou[1]; w.z = ou[2]; w.w = ou[3]; }
                            else w = *(const u32x4*)(pr + 8 * c8); }
                        *(LAS u32x4*)(Tl + rr * 128 + (rr >> 4) * 16 + c8 * 16) = w; }
                    __syncthreads();
                    { const bf16_t* w1t = (const bf16_t*)(ws + WS_W1T) + ((size_t)(l * 2 + j) * 256 + 32 * wave + r32) * 2048 + 8 * hi;
                      f32x16 acc;
#pragma unroll
                      for (int i = 0; i < 16; ++i) acc[i] = 0.f;
#pragma unroll 8
                      for (int kk = 0; kk < 128; ++kk) { const int rowt = 16 * r32 + (kk >> 2);
                          const bf16x8 a = *(const LAS bf16x8*)(Tl + rowt * 128 + (rowt >> 4) * 16 + 32 * (kk & 3) + 16 * hi);
                          const bf16x8 bw = *(const bf16x8*)(w1t + 16 * kk);
                          acc = mfma32(a, bw, acc); }
                      const float hbv = hb[(l * 2 + j) * 256 + 32 * wave + r32];
#pragma unroll
                      for (int i = 0; i < 16; ++i) { const int n = (i & 3) + 8 * (i >> 2) + 4 * hi; *(LAS bf16_t*)(Hl + n * 528 + (32 * wave + r32) * 2) = f2bf(gelu_tanh(acc[i] + hbv)); } }
                    __syncthreads();
                    if (wave < 2) { const bf16_t* w2t = (const bf16_t*)(ws + WS_W2T) + ((size_t)(l * 2 + j) * 64 + 32 * wave + r32) * 256 + 8 * hi;
                      f32x16 acc;
#pragma unroll
                      for (int i = 0; i < 16; ++i) acc[i] = 0.f;
#pragma unroll
                      for (int kk = 0; kk < 16; ++kk) { const bf16x8 a = *(const LAS bf16x8*)(Hl + r32 * 528 + 32 * kk + 16 * hi); const bf16x8 bw = *(const bf16x8*)(w2t + 16 * kk); acc = mfma32(a, bw, acc); }
                      const int dd = 32 * wave + r32;
#pragma unroll
                      for (int g = 0; g < 4; ++g) { const int n0 = 32 * g32 + 8 * g + 4 * hi; float v[4];
#pragma unroll
                          for (int q = 0; q < 4; ++q) v[q] = (n0 + q < 511) ? acc[4 * g + q] : 0.f;
                          if (j == 0) {
#pragma unroll
                              for (int q = 0; q < 4; ++q) KCMPB[((size_t)b * 512 + n0 + q) * 64 + dd] = f2bf(v[q]); }
                          else { u32x2 w; w.x = pk2(v[0], v[1]); w.y = pk2(v[2], v[3]); *(u32x2*)(VCMPT + ((size_t)b * 64 + dd) * 512 + n0) = w; } } }
                    __syncthreads();
            }
            if (bid < N_J3) {
                const int fr = lane & 15, kq = lane >> 4, hh = wave >> 1, odd = wave & 1;
                {
                    bf16x8 bq[3][6];
                    { const bf16_t* wq = (const bf16_t*)(ws + WS_WUQT) + (size_t)l * 384 * 192;
#pragma unroll
                      for (int nt = 0; nt < 3; ++nt)
#pragma unroll
                          for (int ks = 0; ks < 6; ++ks) bq[nt][ks] = *(const bf16x8*)(wq + (size_t)(48 * wave + 16 * nt + fr) * 192 + 32 * ks + 8 * kq); }
                    for (int r_ = bid; r_ < N_J3 * REP_J3; r_ += G) { const int r = r_ % N_J3;
                        const size_t row0 = (size_t)r * 64;
#pragma unroll 1
                        for (int mt = 0; mt < 4; ++mt) {
                            const bf16_t* pa = PB + (row0 + mt * 16 + fr) * NIN;
                            bf16x8 aq[6]; float ssq_ = 0.f;
#pragma unroll
                            for (int ks = 0; ks < 6; ++ks) { aq[ks] = ld8x2(pa + C_DCQ + 32 * ks + 8 * kq);
#pragma unroll
                                for (int e = 0; e < 8; ++e) { const float v = bf2f((bf16_t)aq[ks][e]); ssq_ += v * v; } }
                            ssq_ += __shfl_xor(ssq_, 16); ssq_ += __shfl_xor(ssq_, 32);
                            const float rq_ = rsqrtf(ssq_ * (1.f / 192.f) + EPS);
                            f32x4 cq[3];
#pragma unroll
                            for (int nt = 0; nt < 3; ++nt) { cq[nt] = (f32x4){0.f, 0.f, 0.f, 0.f};
#pragma unroll
                                for (int ks = 0; ks < 6; ++ks) cq[nt] = __builtin_amdgcn_mfma_f32_16x16x32_bf16(aq[ks], bq[nt][ks], cq[nt], 0, 0, 0); }
                            const float SCQ = 0.10206207261596575f * LOG2E;
#pragma unroll
                            for (int i = 0; i < 4; ++i) {
                                const size_t row = row0 + mt * 16 + 4 * kq + i; const float rqi = __shfl(rq_, 4 * kq + i) * SCQ;
                                float q0 = cq[0][i] * rqi, q1 = cq[1][i] * rqi, q2 = cq[2][i] * rqi;
                                if (odd) { const float2 cs = cs32[row * 16 + fr]; const float x1 = q1, x2 = q2; q1 = x1 * cs.x - x2 * cs.y; q2 = x2 * cs.x + x1 * cs.y; }
                                bf16_t* mq = MQ + row * 384 + hh * 96 + 48 * odd + fr; mq[0] = f2bf(q0); mq[16] = f2bf(q1); mq[32] = f2bf(q2);
                            }
                            if (wave == mt) {
#pragma unroll
                                for (int q = 0; q < 4; ++q) { const int p = lane * 4 + q, tok = p >> 4, i = p & 15; const size_t row = row0 + mt * 16 + tok; const bf16_t* pr = PB + row * NIN + C_DKR;
                                    const float x1 = bf2f(pr[i]), x2 = bf2f(pr[16 + i]); const float2 cs = cs32[row * 16 + i];
                                    MKR[row * 32 + i] = f2bf(x1 * cs.x - x2 * cs.y); MKR[row * 32 + 16 + i] = f2bf(x2 * cs.x + x1 * cs.y); } }
                        }
                    }
                }
                {
                    bf16x8 bkv[4][4];
                    { const bf16_t* wkv = (const bf16_t*)(ws + WS_WUKVT) + (size_t)l * 512 * 128;
#pragma unroll
                      for (int nt = 0; nt < 4; ++nt)
#pragma unroll
                          for (int ks = 0; ks < 4; ++ks) bkv[nt][ks] = *(const bf16x8*)(wkv + (size_t)(64 * wave + 16 * nt + fr) * 128 + 32 * ks + 8 * kq); }
                    for (int r_ = bid; r_ < N_J3 * REP_J3; r_ += G) { const int r = r_ % N_J3;
                        const size_t row0 = (size_t)r * 64; const size_t bb = row0 / SEQ, t0 = row0 % SEQ;
#pragma unroll 1
                        for (int mt = 0; mt < 4; ++mt) {
                            const bf16_t* pa = PB + (row0 + mt * 16 + fr) * NIN;
                            bf16x8 akv[4]; float sskv_ = 0.f;
#pragma unroll
                            for (int ks = 0; ks < 4; ++ks) { akv[ks] = ld8x2(pa + C_DCKV + 32 * ks + 8 * kq);
#pragma unroll
                                for (int e = 0; e < 8; ++e) { const float v = bf2f((bf16_t)akv[ks][e]); sskv_ += v * v; } }
                            sskv_ += __shfl_xor(sskv_, 16); sskv_ += __shfl_xor(sskv_, 32);
                            const float rk_ = rsqrtf(sskv_ * (1.f / 128.f) + EPS);
                            f32x4 ckv[4];
#pragma unroll
                            for (int nt = 0; nt < 4; ++nt) { ckv[nt] = (f32x4){0.f, 0.f, 0.f, 0.f};
#pragma unroll
                                for (int ks = 0; ks < 4; ++ks) ckv[nt] = __builtin_amdgcn_mfma_f32_16x16x32_bf16(akv[ks], bkv[nt][ks], ckv[nt], 0, 0, 0); }
                            float rki[4];
#pragma unroll
                            for (int i = 0; i < 4; ++i) rki[i] = __shfl(rk_, 4 * kq + i);
                            if (!odd) {
#pragma unroll
                                for (int i = 0; i < 4; ++i) { bf16_t* mk = MKN + (row0 + mt * 16 + 4 * kq + i) * 256 + hh * 64 + fr;
                                    mk[0] = f2bf(ckv[0][i] * rki[i]); mk[16] = f2bf(ckv[1][i] * rki[i]); mk[32] = f2bf(ckv[2][i] * rki[i]); mk[48] = f2bf(ckv[3][i] * rki[i]); } }
                            else {
#pragma unroll
                                for (int nt = 0; nt < 4; ++nt) { u32x2 w; w.x = pk2(ckv[nt][0] * rki[0], ckv[nt][1] * rki[1]); w.y = pk2(ckv[nt][2] * rki[2], ckv[nt][3] * rki[3]);
                                    *(u32x2*)(MVT + ((bb * 4 + hh) * 64 + 16 * nt + fr) * SEQ + t0 + mt * 16 + 4 * kq) = w; } }
                        }
                    }
                }
            }
            {
                const int r32 = lane & 31, hi = lane >> 5, gh = wave >> 1, gg = wave & 1, ch = tid & 255, half = tid >> 8;
                bf16x8 bW[2][4];
                { const bf16_t* wt = (const bf16_t*)(ws + WS_WGT) + (size_t)(((l * 2 + gg) * 4 + gh) * 64) * 64;
#pragma unroll
                  for (int nt = 0; nt < 2; ++nt)
#pragma unroll
                      for (int ks = 0; ks < 4; ++ks) bW[nt][ks] = *(const bf16x8*)(wt + (size_t)(32 * nt + r32) * 64 + 16 * ks + 8 * hi); }
                const float gbias0 = (gg == 0 ? inp(args, 7) : inp(args, 9))[l * 256 + gh * 64 + r32], gbias1 = (gg == 0 ? inp(args, 7) : inp(args, 9))[l * 256 + gh * 64 + 32 + r32];
                const float cw0 = inp(args, 4)[(l * 4 + 0) * 256 + ch], cw1 = inp(args, 4)[(l * 4 + 1) * 256 + ch], cw2 = inp(args, 4)[(l * 4 + 2) * 256 + ch], cw3 = inp(args, 4)[(l * 4 + 3) * 256 + ch], cb = inp(args, 5)[l * 256 + ch];
                const float sp = ((const float*)(ws + WS_SP))[l * 256 + ch];
                LAS float* xa = ldsf; LAS float* xc = ldsf + 35 * 256; LAS unsigned char* xcb = lds + 67 * 1024; LAS float* gR = (LAS float*)(lds + 67 * 1024 + 32 * 528); LAS float* gI = gR + 32 * 256;
            for (int r_ = bid; r_ < N_J1 * REP_J1; r_ += G) { const int r = r_ % N_J1;
                    const int b = r >> 8, tb = r & 255, t0 = tb * 32;
                    for (int c = tid; c < 35 * 32; c += NTHR) { const int rr = c >> 5, c8 = c & 31, t = t0 - 3 + rr; u32x4 w = {0u, 0u, 0u, 0u}; if (t >= 0) w = *(const u32x4*)(PB + ((size_t)b * SEQ + t) * NIN + C_AX + 8 * c8);
                        LAS f32x4* d = (LAS f32x4*)(xa + rr * 256 + 8 * c8); d[0] = (f32x4){bflo(w.x), bfhi(w.x), bflo(w.y), bfhi(w.y)}; d[1] = (f32x4){bflo(w.z), bfhi(w.z), bflo(w.w), bfhi(w.w)}; }
                    __syncthreads();
#pragma unroll 4
                    for (int tt = 0; tt < 16; ++tt) { const int rr = half * 16 + tt; const float v = cb + cw0 * xa[rr * 256 + ch] + cw1 * xa[(rr + 1) * 256 + ch] + cw2 * xa[(rr + 2) * 256 + ch] + cw3 * xa[(rr + 3) * 256 + ch];
                        xc[rr * 256 + ch] = v; *(LAS bf16_t*)(xcb + rr * 528 + ch * 2) = f2bf(v); }
                    __syncthreads();
                    { f32x16 acc[2];
#pragma unroll
                      for (int i = 0; i < 16; ++i) { acc[0][i] = 0.f; acc[1][i] = 0.f; }
#pragma unroll
                      for (int ks = 0; ks < 4; ++ks) { const bf16x8 a = *(const LAS bf16x8*)(xcb + r32 * 528 + (gh * 64 + 16 * ks + 8 * hi) * 2); acc[0] = mfma32(a, bW[0][ks], acc[0]); acc[1] = mfma32(a, bW[1][ks], acc[1]); }
                      LAS float* gd = gg == 0 ? gR : gI;
#pragma unroll
                      for (int i = 0; i < 16; ++i) { const int tok = (i & 3) + 8 * (i >> 2) + 4 * hi; gd[tok * 256 + gh * 64 + r32] = sigmoidf_(acc[0][i] + gbias0); gd[tok * 256 + gh * 64 + 32 + r32] = sigmoidf_(acc[1][i] + gbias1); } }
                    __syncthreads();
                    float hst = 0.f, Ac = 1.f;
#pragma unroll 4
                    for (int tt = 0; tt < 16; ++tt) {
                        const int rr = half * 16 + tt;
                        const float la = -8.f * gR[rr * 256 + ch] * sp, x2 = 2.f * la;
                        const float av = la > -0.25f ? 1.f + la * (1.f + la * (0.5f + la * (0.16666667f + la * (0.041666667f + la * 0.0083333333f)))) : __expf(la);
                        const float om = x2 > -0.5f ? -x2 * (1.f + x2 * (0.5f + x2 * (0.16666667f + x2 * (0.041666667f + x2 * (0.0083333333f + x2 * 0.0013888889f))))) : 1.f - __expf(x2);
                        const float u = __builtin_amdgcn_sqrtf(om) * (gI[rr * 256 + ch] * xc[rr * 256 + ch]);
                        hst = av * hst + u; Ac *= av;
                        { const size_t ao = ((size_t)b * SEQ + t0 + rr) * 256 + ch; LRA[ao] = av; LRU_[ao] = u; }
                    }
                    const size_t so = ((size_t)(b * 512 + tb * 2 + half)) * 256 + ch;
                    LA[so] = Ac; LH[so] = hst;
                    __syncthreads();
            }
            }
            {
                const int kk = tid & 127, tq = tid >> 7, r32 = lane & 31, hi = lane >> 5;
                float wg[16]; const float bg = inp(args, 16)[l * 128 + kk];
#pragma unroll
                for (int q = 0; q < 16; ++q) wg[q] = inp(args, 15)[(l * 16 + q) * 128 + kk];
                LAS float* glr = ldsf; LAS float* tot = ldsf + 1024; LAS unsigned char* KTl = lds + 8192; LAS unsigned char* VTl = lds + 8192 + 128 * VSTR;
                float* BCS = (float*)(ws + WS_BCS);
            for (int r_ = bid; r_ < N_J2 * REP_J2; r_ += G) { const int r = r_ % N_J2;
                    const int b = r >> 7, c = r & 127; const size_t row0 = (size_t)b * SEQ + 64 * c;
                    for (int e = tid; e < 1024; e += NTHR) glr[e] = bf2f(PB[(row0 + (e >> 4)) * NIN + C_GLR + (e & 15)]);
                    for (int e = tid; e < 2048; e += NTHR) { const int jj = e >> 5, hc = e & 31; const bf16_t* vsrc = PB + (row0 + jj) * NIN + C_CV + 8 * hc; const u32x2 wA = *(const u32x2*)vsrc, wB = *(const u32x2*)(vsrc + 4);
                        LAS bf16_t* d = (LAS bf16_t*)(VTl + (8 * hc) * VSTR) + jj;
                        d[0] = (bf16_t)wA.x; d[VSTR / 2] = (bf16_t)(wA.x >> 16); d[2 * (VSTR / 2)] = (bf16_t)wA.y; d[3 * (VSTR / 2)] = (bf16_t)(wA.y >> 16); d[4 * (VSTR / 2)] = (bf16_t)wB.x; d[5 * (VSTR / 2)] = (bf16_t)(wB.x >> 16); d[6 * (VSTR / 2)] = (bf16_t)wB.y; d[7 * (VSTR / 2)] = (bf16_t)(wB.y >> 16); }
                    __syncthreads();
                    float bv[16]; float run = 0.f;
#pragma unroll
                    for (int tt = 0; tt < 16; ++tt) { const LAS f32x4* g4 = (const LAS f32x4*)(glr + (16 * tq + tt) * 16); float z = bg;
#pragma unroll
                        for (int q = 0; q < 4; ++q) { const f32x4 g = g4[q]; z += g[0] * wg[4 * q] + g[1] * wg[4 * q + 1] + g[2] * wg[4 * q + 2] + g[3] * wg[4 * q + 3]; }
                        run += (fminf(z, 0.f) - __logf(1.f + __expf(-fabsf(z)))) * (1.f / 16.f); bv[tt] = run; }
                    tot[tq * 128 + kk] = run;
                    __syncthreads();
                    { const float t0_ = tot[kk], t1_ = tot[128 + kk], t2_ = tot[256 + kk], t3_ = tot[384 + kk]; const float off = tq == 0 ? 0.f : (tq == 1 ? t0_ : (tq == 2 ? t0_ + t1_ : (t0_ + t1_) + t2_)), blast = ((t0_ + t1_) + t2_) + t3_;
#pragma unroll
                      for (int tt = 0; tt < 16; ++tt) { const int t = 16 * tq + tt; const float bt = bv[tt] + off; BCS[(row0 + t) * 128 + kk] = bt;
                          *((LAS bf16_t*)(KTl + kk * VSTR) + t) = f2bf(bf2f(PB[(row0 + t) * NIN + C_CK + kk]) * __expf(blast - bt)); }
                      if (tq == 0) DEC[(size_t)(b * 128 + c) * 128 + kk] = __expf(blast); }
                    __syncthreads();
                    { const int h = wave >> 1, nt = wave & 1; f32x16 acc;
#pragma unroll
                      for (int i = 0; i < 16; ++i) acc[i] = 0.f;
                      const LAS unsigned char* ap = KTl + (h * 32 + r32) * VSTR + 16 * hi; const LAS unsigned char* bp = VTl + (h * 64 + 32 * nt + r32) * VSTR + 16 * hi;
#pragma unroll
                      for (int s = 0; s < 4; ++s) { const u32x2 a0 = *(const LAS u32x2*)(ap + 32 * s), a1 = *(const LAS u32x2*)(ap + 32 * s + 8), b0 = *(const LAS u32x2*)(bp + 32 * s), b1 = *(const LAS u32x2*)(bp + 32 * s + 8);
                          u32x4 aw, bw; aw.x = a0.x; aw.y = a0.y; aw.z = a1.x; aw.w = a1.y; bw.x = b0.x; bw.y = b0.y; bw.z = b1.x; bw.w = b1.y;
                          acc = mfma32(__builtin_bit_cast(bf16x8, aw), __builtin_bit_cast(bf16x8, bw), acc); }
                      float* o = KVC + ((size_t)(b * 128 + c) * 4 + h) * 2048 + 32 * nt + r32;
#pragma unroll
                      for (int i = 0; i < 16; ++i) o[((i & 3) + 8 * (i >> 2) + 4 * hi) * 64] = acc[i]; }
                    __syncthreads();
            }
            }
            for (int r = bid; r < N_J4; r += G) {
                    const size_t row0 = (size_t)r * 64;
                    for (int e = tid; e < 64 * 192; e += NTHR) { const int tok = e / 192, p = e % 192, i = p & 31; const int base = p < 128 ? C_BQ + (p >> 5) * 64 : (p < 160 ? C_KS : C_KW); const float sc = p < 128 ? 0.125f * LOG2E : 1.f;
                        bf16_t* pr = PB + (row0 + tok) * NIN + base; const float x1 = bf2f(pr[i]), x2 = bf2f(pr[32 + i]); const float2 cs = cs64[(row0 + tok) * 32 + i];
                        pr[i] = f2bf((x1 * cs.x - x2 * cs.y) * sc); pr[32 + i] = f2bf((x2 * cs.x + x1 * cs.y) * sc); }
                    { LAS bf16_t* tl = (LAS bf16_t*)lds; const size_t bb = row0 / SEQ, t0 = row0 % SEQ;
                      for (int mtx = 0; mtx < 2; ++mtx) { const int tok = tid >> 3, c = tid & 7; const u32x4 w = *(const u32x4*)(PB + (row0 + tok) * NIN + (mtx ? C_VW : C_VS) + c * 8);
                          LAS bf16_t* dst = tl + mtx * 64 * 72 + tok * 72 + c * 8; dst[0] = (bf16_t)w.x; dst[1] = (bf16_t)(w.x >> 16); dst[2] = (bf16_t)w.y; dst[3] = (bf16_t)(w.y >> 16); dst[4] = (bf16_t)w.z; dst[5] = (bf16_t)(w.z >> 16); dst[6] = (bf16_t)w.w; dst[7] = (bf16_t)(w.w >> 16); }
                      __syncthreads();
                      for (int mtx = 0; mtx < 2; ++mtx) { const int d = tid >> 3, c8 = tid & 7; const LAS bf16_t* s = tl + mtx * 64 * 72 + (c8 * 8) * 72 + d;
                          u32x4 w; w.x = (unsigned)s[0] | ((unsigned)s[72] << 16); w.y = (unsigned)s[2 * 72] | ((unsigned)s[3 * 72] << 16); w.z = (unsigned)s[4 * 72] | ((unsigned)s[5 * 72] << 16); w.w = (unsigned)s[6 * 72] | ((unsigned)s[7 * 72] << 16);
                          *(u32x4*)((mtx ? VWT : VST) + (bb * 64 + d) * SEQ + t0 + c8 * 8) = w; }
                      __syncthreads(); }
            }
            }
        }
        SEAM(pb + 1);
        if (IN(pb + 2)) {
        const int l_ = l; WS_PTRS();
        LAUNDER_TID();
            constexpr int Q_J5 = 2, Q_J6 = 64, Q_ATT = 1024 * REP_ATT, Q_J9 = 1024, Q_J10 = 512, Q_TOT = Q_J5 + Q_J6 + Q_ATT + Q_J9 + Q_J10;
            if (tid == 0) { LCTL[4] = 0u; LCTL[5] = 0u; }
            __syncthreads();
            const int tid_o = tid;
            for (;;) {
                int tid = tid_o; asm volatile("" : "+v"(tid)); const int lane = tid & 63;
                if (tid == 0) LCTL[2] = __hip_atomic_fetch_add(ctl + CW_QUEUE + 64 * l, 1u, __ATOMIC_RELAXED, __HIP_MEMORY_SCOPE_AGENT);
                __syncthreads();
                int r = __builtin_amdgcn_readfirstlane((int)LCTL[2]); const unsigned seen5 = LCTL[4], seen6 = LCTL[5];
                __syncthreads();
                if (r >= Q_TOT * REP_P3) break;
                if (REP_P3 > 1 && r >= Q_TOT) r -= Q_TOT;
                if (r < Q_J5) {
                    const int e = r * NTHR + tid, b = e >> 8, ch = e & 255; float carry = 0.f;
                    for (int c0 = 0; c0 < 512; c0 += 8) { float av[8], hv[8];
#pragma unroll
                        for (int q = 0; q < 8; ++q) { const size_t so = ((size_t)(b * 512 + c0 + q)) * 256 + ch; av[q] = LA[so]; hv[q] = LH[so]; }
#pragma unroll
                        for (int q = 0; q < 8; ++q) { CIN[((size_t)(b * 512 + c0 + q)) * 256 + ch] = carry; carry = av[q] * carry + hv[q]; } }
                    asm volatile("s_waitcnt vmcnt(0)" ::: "memory"); __syncthreads();
                    if (tid == 0) { __builtin_amdgcn_fence(__ATOMIC_RELEASE, "agent"); asm volatile("s_waitcnt vmcnt(0)" ::: "memory"); (void)xb_add(ctl + CW_FLAG + 64 * (2 * l + 0), 1u); }
                    continue;
                }
                r -= Q_J5;
                if (r < Q_J6) {
                    const int e = r * NTHR + tid, b = e >> 13, rem = e & 8191; float Sv = 0.f;
                    for (int c0 = 0; c0 < 128; c0 += 8) { float kv[8], dv[8];
#pragma unroll
                        for (int q = 0; q < 8; ++q) { kv[q] = KVC[(size_t)(b * 128 + c0 + q) * 8192 + rem]; dv[q] = DEC[(size_t)(b * 128 + c0 + q) * 128 + (rem >> 6)]; }
#pragma unroll
                        for (int q = 0; q < 8; ++q) { SST[(size_t)(b * 128 + c0 + q) * 8192 + rem] = Sv; Sv = dv[q] * Sv + kv[q]; } }
                    asm volatile("s_waitcnt vmcnt(0)" ::: "memory"); __syncthreads();
                    if (tid == 0) { __builtin_amdgcn_fence(__ATOMIC_RELEASE, "agent"); asm volatile("s_waitcnt vmcnt(0)" ::: "memory"); (void)xb_add(ctl + CW_FLAG + 64 * (2 * l + 1), 1u); }
                    continue;
                }
                r -= Q_J6;
                if (r >= Q_ATT) {
                    r -= Q_ATT; const bool is9 = r < Q_J9;
                    if (!(is9 ? seen5 : seen6)) {
                        if (tid == 0) { unsigned* f = ctl + CW_FLAG + 64 * (2 * l + (is9 ? 0 : 1)); const unsigned target = is9 ? (unsigned)Q_J5 : (unsigned)Q_J6;
                            XB_SPIN(xb_ld(f) < target, ctl + CW_BAR); __builtin_amdgcn_fence(__ATOMIC_ACQUIRE, "agent"); asm volatile("s_waitcnt vmcnt(0)" ::: "memory"); LCTL[is9 ? 4 : 5] = 1u; }
                        __syncthreads(); }
                    if (is9) {
                    const int b = r >> 8, tb = r & 255, t0 = tb * 32, ch = tid & 255, half = tid >> 8;
                    LAS float* xa = ldsf;
                    float hst = CIN[((size_t)(b * 512 + tb * 2 + half)) * 256 + ch];
                    { float av[16], uv[16], gv[16];
#pragma unroll
                      for (int tt = 0; tt < 16; ++tt) { const size_t ro = (size_t)b * SEQ + t0 + half * 16 + tt; av[tt] = LRA[ro * 256 + ch]; uv[tt] = LRU_[ro * 256 + ch]; gv[tt] = bf2f(PB[ro * NIN + C_AG + ch]); }
#pragma unroll
                      for (int tt = 0; tt < 16; ++tt) { hst = av[tt] * hst + uv[tt]; xa[(half * 16 + tt) * 256 + ch] = hst * gelu_tanh(gv[tt]); } }
                    __syncthreads();
                    for (int q = 0; q < 4; ++q) { const int rr = wave * 4 + q; const f32x4 v = ((const LAS f32x4*)(xa + rr * 256))[lane];
                        const float rinv = rsqrtf(wave_sum(v[0] * v[0] + v[1] * v[1] + v[2] * v[2] + v[3] * v[3]) * (1.f / 256.f) + EPS);
                        u32x2 w; w.x = pk2(v[0] * rinv, v[1] * rinv); w.y = pk2(v[2] * rinv, v[3] * rinv);
                        *(u32x2*)(Y + ((size_t)b * SEQ + t0 + rr) * DM + 256 + 4 * lane) = w; }
                    __syncthreads();
                    } else { r -= Q_J9;
                    const int b = r >> 7, c = r & 127; const size_t row0 = (size_t)b * SEQ + 64 * c;
                    LAS float* bL = ldsf; LAS float* glr = ldsf + 8192; LAS unsigned char* VTl = lds + 36864; LAS unsigned char* STl = lds + 71680; LAS float* SSX = (LAS float*)(lds + 92160);
                    for (int e = tid; e < 2048; e += NTHR) ((LAS f32x4*)bL)[e] = ((const f32x4*)((const float*)(ws + WS_BCS) + row0 * 128))[e];
                    for (int e = tid; e < 2048; e += NTHR) { const int jj = e >> 5, hc = e & 31, h = hc >> 3, c8 = hc & 7; const bf16_t* vsrc = PB + (row0 + jj) * NIN + C_CV + h * 64 + 8 * c8; const u32x2 wA = *(const u32x2*)vsrc, wB = *(const u32x2*)(vsrc + 4); u32x4 w; w.x = wA.x; w.y = wA.y; w.z = wB.x; w.w = wB.y;
                        LAS bf16_t* d = (LAS bf16_t*)(VTl + h * 8704 + (8 * c8) * VSTR) + jj;
                        d[0] = (bf16_t)w.x; d[VSTR / 2] = (bf16_t)(w.x >> 16); d[2 * (VSTR / 2)] = (bf16_t)w.y; d[3 * (VSTR / 2)] = (bf16_t)(w.y >> 16); d[4 * (VSTR / 2)] = (bf16_t)w.z; d[5 * (VSTR / 2)] = (bf16_t)(w.z >> 16); d[6 * (VSTR / 2)] = (bf16_t)w.w; d[7 * (VSTR / 2)] = (bf16_t)(w.w >> 16); }
                    for (int e = tid; e < 8192; e += NTHR) { const int h = e >> 11, k = (e >> 6) & 31, v = e & 63; *(LAS bf16_t*)(STl + h * 5120 + v * 80 + k * 2) = f2bf(SST[(size_t)(b * 128 + c) * 8192 + e]); }
                    __syncthreads();
                    { const int r32 = lane & 31, hi = lane >> 5, h = wave >> 1, ih = wave & 1, i = 32 * ih + r32; const float SCG = 0.17677669529663687f;
                      bf16x8 qrel[2], qabs[2], kt[2][2];
#pragma unroll
                      for (int ks = 0; ks < 2; ++ks) { const int k0 = h * 32 + 16 * ks + 8 * hi; const bf16x8 qv = ld8x2(PB + (row0 + i) * NIN + C_CQ + k0); u32x4 wr_, wa_; unsigned* pr_ = (unsigned*)&wr_; unsigned* pa_ = (unsigned*)&wa_;
#pragma unroll
                          for (int e2 = 0; e2 < 4; ++e2) { const float b0 = bL[i * 128 + k0 + 2 * e2], b1 = bL[i * 128 + k0 + 2 * e2 + 1], f0 = bL[31 * 128 + k0 + 2 * e2], f1 = bL[31 * 128 + k0 + 2 * e2 + 1];
                              const float q0 = bf2f((bf16_t)qv[2 * e2]) * SCG, q1 = bf2f((bf16_t)qv[2 * e2 + 1]) * SCG;
                              pr_[e2] = cvtpk(q0 * __expf(b0 - f0), q1 * __expf(b1 - f1)); pa_[e2] = cvtpk(q0 * __expf(b0), q1 * __expf(b1)); }
                          qrel[ks] = __builtin_bit_cast(bf16x8, wr_); qabs[ks] = __builtin_bit_cast(bf16x8, wa_); }
#pragma unroll
                      for (int jt = 0; jt < 2; ++jt)
#pragma unroll
                          for (int ks = 0; ks < 2; ++ks) { const int jr = 32 * jt + r32, k0 = h * 32 + 16 * ks + 8 * hi; const bf16x8 kv = ld8x2(PB + (row0 + jr) * NIN + C_CK + k0); u32x4 wk_; unsigned* pk_ = (unsigned*)&wk_;
#pragma unroll
                              for (int e2 = 0; e2 < 4; ++e2) { const float b0 = bL[jr * 128 + k0 + 2 * e2], b1 = bL[jr * 128 + k0 + 2 * e2 + 1], f0 = bL[31 * 128 + k0 + 2 * e2], f1 = bL[31 * 128 + k0 + 2 * e2 + 1];
                                  pk_[e2] = cvtpk(bf2f((bf16_t)kv[2 * e2]) * __expf(f0 - b0), bf2f((bf16_t)kv[2 * e2 + 1]) * __expf(f1 - b1)); }
                              kt[jt][ks] = __builtin_bit_cast(bf16x8, wk_); }
                      f32x16 o[2], s[2];
#pragma unroll
                      for (int q = 0; q < 16; ++q) { o[0][q] = 0.f; o[1][q] = 0.f; s[0][q] = 0.f; s[1][q] = 0.f; }
#pragma unroll
                      for (int ks = 0; ks < 2; ++ks) s[0] = mfma32(kt[0][ks], qrel[ks], s[0]);
                      if (ih) {
#pragma unroll
                          for (int ks = 0; ks < 2; ++ks) s[1] = mfma32(kt[1][ks], qrel[ks], s[1]); }
#pragma unroll
                      for (int q = 0; q < 16; ++q) { const int jr = (q & 3) + 8 * (q >> 2) + 4 * hi; if (jr > r32) { if (ih) s[1][q] = 0.f; else s[0][q] = 0.f; } }
                      const LAS unsigned char* VTh = VTl + h * 8704; const LAS unsigned char* STh = STl + h * 5120;
#pragma unroll
                      for (int dt = 0; dt < 2; ++dt) { const LAS unsigned char* vp = VTh + (32 * dt + r32) * VSTR + 8 * hi;
                          o[dt] = mfma32(vfrag(vp), pack8<0>(s[0]), o[dt]); o[dt] = mfma32(vfrag(vp + 32), pack8<8>(s[0]), o[dt]);
                          if (ih) { o[dt] = mfma32(vfrag(vp + 64), pack8<0>(s[1]), o[dt]); o[dt] = mfma32(vfrag(vp + 96), pack8<8>(s[1]), o[dt]); }
#pragma unroll
                          for (int ks = 0; ks < 2; ++ks) o[dt] = mfma32(*(const LAS bf16x8*)(STh + (32 * dt + r32) * 80 + 32 * ks + 16 * hi), qabs[ks], o[dt]); }
                      float ssh = 0.f;
#pragma unroll
                      for (int q = 0; q < 16; ++q) ssh += o[0][q] * o[0][q] + o[1][q] * o[1][q];
                      const float rh = rsqrtf(xhalf_sum(ssh) * (1.f / 64.f) + EPS); float ssg = 0.f;
#pragma unroll
                      for (int dt = 0; dt < 2; ++dt)
#pragma unroll
                          for (int g = 0; g < 4; ++g) { const int v0 = 32 * dt + 8 * g + 4 * hi; const u32x2 ogw = *(const u32x2*)(PB + (row0 + i) * NIN + C_OG + h * 64 + v0); const f32x4 gn = *(const f32x4*)(inp(args, 17) + l * 64 + v0);
                              const float og4[4] = {bflo(ogw.x), bfhi(ogw.x), bflo(ogw.y), bfhi(ogw.y)};
#pragma unroll
                              for (int q = 0; q < 4; ++q) { const float y = o[dt][4 * g + q] * rh * gn[q] * (og4[q] / (1.f + __expf(-og4[q]))); o[dt][4 * g + q] = y; ssg += y * y; } }
                      ssg = xhalf_sum(ssg); if (hi == 0) SSX[i * 4 + h] = ssg;
                      __syncthreads();
                      const f32x4 s4 = *(const LAS f32x4*)(SSX + i * 4); const float rinv = rsqrtf((s4[0] + s4[1] + s4[2] + s4[3]) * (1.f / 256.f) + EPS);
#pragma unroll
                      for (int dt = 0; dt < 2; ++dt)
#pragma unroll
                          for (int g = 0; g < 4; ++g) { u32x2 w; w.x = cvtpk(o[dt][4 * g] * rinv, o[dt][4 * g + 1] * rinv); w.y = cvtpk(o[dt][4 * g + 2] * rinv, o[dt][4 * g + 3] * rinv);
                              *(u32x2*)(Y + (row0 + i) * DM + 768 + h * 64 + 32 * dt + 8 * g + 4 * hi) = w; } }
                    __syncthreads();
                    }
                    continue;
                }
                const int r32 = lane & 31, hi = lane >> 5;
                const int rep = r >> 10; r &= 1023;
                const int grp = r >> 5, within = r & 31;
                if (rep && ((REP_ONLY == 1 && within >= 16) || (REP_ONLY == 2 && within < 16))) continue;
              {
                if (within >= 16) {
                    const int idx = within - 16, b = idx & 3, tb = 127 - (4 * grp + (idx >> 2));
                    const int tl = 8 * wave + (r32 >> 2), head = r32 & 3, T = 64 * tb + tl; const size_t row = (size_t)b * SEQ + T; const bf16_t* prow = PB + row * NIN;
                    bf16x8 qf[4];
#pragma unroll
                    for (int ks = 0; ks < 4; ++ks) qf[ks] = *(const bf16x8*)(prow + C_BQ + head * 64 + 16 * ks + 8 * hi);
                    LAS float* impb = (LAS float*)(lds + AL_IMP) + wave * 1024; LAS unsigned* selm = (LAS unsigned*)(lds + AL_SELM) + wave * 32;
                    const int skey = tid >> 3, sch = tid & 7;
                    const unsigned koffP = (unsigned)(skey * NIN + sch * 8), voffS = (unsigned)(skey * SEQ + sch * 8), koffC = (unsigned)(skey * 64 + sch * 8), voffC = (unsigned)(skey * 512 + sch * 8);
                    auto stK = [&](int buf, const StageRegs& R) { *(LAS u32x4*)(lds + (buf ? AL_K1 : AL_K0) + skey * KSTR + sch * 16) = R.a; };
                    auto stKV = [&](int buf, const StageRegs& R) { *(LAS u32x4*)(lds + (buf ? AL_K1 : AL_K0) + skey * KSTR + sch * 16) = R.a;
                        LAS unsigned char* vd = lds + (buf ? AL_V1 : AL_V0) + skey * VSTR + sch * 16; u32x2 a, c; a.x = R.b.x; a.y = R.b.y; c.x = R.b.z; c.y = R.b.w; *(LAS u32x2*)vd = a; *(LAS u32x2*)(vd + 8) = c; };
                    f32x16 oacc[2], ob[2];
                    const int nv = T >= 31 ? ((T - 31) >> 4) + 1 : 0, ntc = (4 * tb + 3 + 63) >> 6;
                    float mC = NEGB, lC = 0.f;
                    { const bf16_t* kb_ = KCMPB + (size_t)b * 512 * 64;
                      attn_pipeline(0, ntc - 1, [&](int j, StageRegs& R) { R.a = *(const u32x4*)((kb_ + (size_t)j * 64 * 64) + koffC); }, stK,
                        [&](int j, int cb) { f32x16 s0, s1; qk_tile<4>(lds + (cb ? AL_K1 : AL_K0), qf, r32, hi, s0, s1); mask_tile(s0, s1, 0, nv - 1 - 64 * j, hi);
                            const float mx = tile_max(s0, s1), mn = fmaxf(mC, mx), ms = mn < -1e29f ? 0.f : mn, alpha = ex2(mC - ms); mC = mn; float ps = 0.f;
#pragma unroll
                            for (int i = 0; i < 16; ++i) ps += ex2(s0[i] - ms) + ex2(s1[i] - ms);
                            lC = lC * alpha + ps; }); }
                    { const float invC = 1.f / fmaxf(xhalf_sum(lC), 1e-30f), msC = mC < -1e29f ? 0.f : mC; float carry = 0.f;
#pragma unroll
                      for (int i = 0; i < 16; ++i) { ob[0][i] = 0.f; ob[1][i] = 0.f; }
                      const bf16_t* kb_ = KCMPB + (size_t)b * 512 * 64; const bf16_t* vb_ = VCMPT + (size_t)b * 64 * 512;
                      attn_pipeline(0, ntc - 1, [&](int j, StageRegs& R) { R.a = *(const u32x4*)((kb_ + (size_t)j * 64 * 64) + koffC); R.b = *(const u32x4*)((vb_ + j * 64) + voffC); }, stKV,
                        [&](int j, int cb) { f32x16 s0, s1; qk_tile<4>(lds + (cb ? AL_K1 : AL_K0), qf, r32, hi, s0, s1); mask_tile(s0, s1, 0, nv - 1 - 64 * j, hi);
#pragma unroll
                            for (int i = 0; i < 16; ++i) { s0[i] = ex2(s0[i] - msC) * invC; s1[i] = ex2(s1[i] - msC) * invC; }
                            float gs[8], pl[8];
#pragma unroll
                            for (int q = 0; q < 4; ++q) { gs[q] = (s0[4 * q] + s0[4 * q + 1]) + (s0[4 * q + 2] + s0[4 * q + 3]); gs[4 + q] = (s1[4 * q] + s1[4 * q + 1]) + (s1[4 * q + 2] + s1[4 * q + 3]);
                                pl[q] = __shfl_xor(s0[4 * q + 3], 32); pl[4 + q] = __shfl_xor(s1[4 * q + 3], 32); }
#pragma unroll
                            for (int q = 0; q < 8; ++q) { const float prev = hi ? pl[q] : (q > 0 ? pl[q > 0 ? q - 1 : 0] : carry); float x = gs[q] + prev; x += __shfl_xor(x, 1); x += __shfl_xor(x, 2);
                                if ((r32 & 3) == 0) impb[(r32 >> 2) * 128 + 16 * j + 2 * q + hi] = x; }
                            carry = pl[7];
                            pv_tile(s0, s1, lds + (cb ? AL_V1 : AL_V0), ob, r32, hi); }); }
                    LAS float* oav = (LAS float*)(lds + AL_OACC) + tid; const float g0 = sigmoidf_(bf2f(prow[C_BG + head * 3]));
#pragma unroll
                    for (int i = 0; i < 16; ++i) { oav[i * 512] = g0 * ob[0][i]; oav[(16 + i) * 512] = g0 * ob[1][i]; }
                    WSYNC();
                    for (int tk = 0; tk < 8; ++tk) {
                        const int cur = tb, j0 = lane, j1 = lane + 64; LAS float* sb = impb + tk * 128; const float im0 = sb[j0], im1 = sb[j1];
                        const float s0 = (j0 == 0 || j0 == cur || j0 == cur - 1) ? 1e9f : (j0 <= cur ? im0 : -1e30f);
                        const float s1 = (j1 == cur || j1 == cur - 1) ? 1e9f : (j1 <= cur ? im1 : -1e30f);
                        WSYNC(); sb[j0] = s0; sb[j1] = s1; WSYNC();
                        int rk0 = 0, rk1 = 0;
#pragma unroll 4
                        for (int c4 = 0; c4 < 32; ++c4) { const f32x4 v = ((const LAS f32x4*)sb)[c4];
#pragma unroll
                            for (int q = 0; q < 4; ++q) { const int jj = 4 * c4 + q; const float x = v[q];
                                rk0 += (x > s0 || (x == s0 && jj < j0)) ? 1 : 0; rk1 += (x > s1 || (x == s1 && jj < j1)) ? 1 : 0; } }
                        const unsigned long long m0 = __ballot(rk0 < 16), m1 = __ballot(rk1 < 16);
                        if (lane == 0) { selm[tk * 4] = (unsigned)m0; selm[tk * 4 + 1] = (unsigned)(m0 >> 32); selm[tk * 4 + 2] = (unsigned)m1; selm[tk * 4 + 3] = (unsigned)(m1 >> 32); }
                    }
                    WSYNC();
                    const unsigned sm0 = selm[(r32 >> 2) * 4], sm1 = selm[(r32 >> 2) * 4 + 1], sm2 = selm[(r32 >> 2) * 4 + 2], sm3 = selm[(r32 >> 2) * 4 + 3];
                    { SoftState SB; soft_init(SB, ob);
                      const bf16_t* kb_ = PB + (size_t)b * SEQ * NIN + C_KS; const bf16_t* vb_ = VST + (size_t)b * 64 * SEQ;
                      attn_pipeline(0, tb, [&](int j, StageRegs& R) { R.a = *(const u32x4*)((kb_ + (size_t)j * 64 * NIN) + koffP); R.b = *(const u32x4*)((vb_ + j * 64) + voffS); }, stKV,
                        [&](int j, int cb) { const unsigned wsel = j < 32 ? sm0 : (j < 64 ? sm1 : (j < 96 ? sm2 : sm3)); const bool bit = (wsel >> (j & 31)) & 1u;
                            if (__any(bit)) attn_step<4>(lds + (cb ? AL_K1 : AL_K0), lds + (cb ? AL_V1 : AL_V0), qf, SB, ob, j == tb || !__all(bit), bit ? 0 : 64, j == tb ? tl : 63, j == 0, r32, hi); });
                      const float sc = sigmoidf_(bf2f(prow[C_BG + head * 3 + 1])) / fmaxf(xhalf_sum(SB.l), 1e-30f);
#pragma unroll
                      for (int i = 0; i < 16; ++i) { oav[i * 512] += sc * ob[0][i]; oav[(16 + i) * 512] += sc * ob[1][i]; } }
                    { SoftState SB; soft_init(SB, ob); const int jb0 = tb >= 8 ? tb - 8 : 0;
                      const bf16_t* kb_ = PB + (size_t)b * SEQ * NIN + C_KW; const bf16_t* vb_ = VWT + (size_t)b * 64 * SEQ;
                      attn_pipeline(tb >= 8 ? tb - 8 : 0, tb, [&](int j, StageRegs& R) { R.a = *(const u32x4*)((kb_ + (size_t)j * 64 * NIN) + koffP); R.b = *(const u32x4*)((vb_ + j * 64) + voffS); }, stKV,
                        [&](int j, int cb) { attn_step<4>(lds + (cb ? AL_K1 : AL_K0), lds + (cb ? AL_V1 : AL_V0), qf, SB, ob, j == tb || j == tb - 8, j == tb - 8 ? tl + 1 : 0, j == tb ? tl : 63, j == jb0, r32, hi); });
                      const float sc = sigmoidf_(bf2f(prow[C_BG + head * 3 + 2])) / fmaxf(xhalf_sum(SB.l), 1e-30f);
#pragma unroll
                      for (int i = 0; i < 16; ++i) { oacc[0][i] = oav[i * 512] + sc * ob[0][i]; oacc[1][i] = oav[(16 + i) * 512] + sc * ob[1][i]; } }
                    { float ss = 0.f;
#pragma unroll
                      for (int i = 0; i < 16; ++i) ss += oacc[0][i] * oacc[0][i] + oacc[1][i] * oacc[1][i];
                      ss = xhalf_sum(ss); ss += __shfl_xor(ss, 1); ss += __shfl_xor(ss, 2);
                      const float rinv = rsqrtf(ss * (1.f / 256.f) + EPS);
#pragma unroll
                      for (int dt = 0; dt < 2; ++dt)
#pragma unroll
                          for (int g = 0; g < 4; ++g) { u32x2 w; w.x = cvtpk(oacc[dt][4 * g] * rinv, oacc[dt][4 * g + 1] * rinv); w.y = cvtpk(oacc[dt][4 * g + 2] * rinv, oacc[dt][4 * g + 3] * rinv);
                              *(u32x2*)(Y + row * DM + 512 + head * 64 + 32 * dt + 8 * g + 4 * hi) = w; } }
                    __syncthreads();
                    continue;
                }
                {
                    const int qb = 31 - grp, b = within >> 2, h = within & 3;
                    const int T = 256 * qb + 32 * wave + r32; const size_t row = (size_t)b * SEQ + T;
                    bf16x8 qf[6];
#pragma unroll
                    for (int ks = 0; ks < 6; ++ks) qf[ks] = *(const bf16x8*)(MQ + row * 384 + h * 96 + 16 * ks + 8 * hi);
                    f32x16 o[2]; SoftState SM; soft_init(SM, o);
                    const int jd = 4 * qb + (wave >> 1), jend = 4 * qb + 3;
                    const bf16_t* kn = MKN + (size_t)b * SEQ * 256 + h * 64; const bf16_t* kr = MKR + (size_t)b * SEQ * 32; const bf16_t* vt = MVT + (size_t)(b * 4 + h) * 64 * SEQ;
                    const int vd_ = tid >> 3, vc8 = tid & 7, rkey = tid >> 2, rch = tid & 3;
                    const unsigned ko0 = (unsigned)(vd_ * 256 + vc8 * 8), ko1 = (unsigned)(rkey * 32 + rch * 8), vo_ = (unsigned)(vd_ * SEQ + vc8 * 8);
                    attn_pipeline(0, jend,
                        [&](int j, StageRegs& R) { R.a = *(const u32x4*)((kn + (size_t)j * 64 * 256) + ko0);
                            if (tid < 256) R.b = *(const u32x4*)((kr + (size_t)j * 64 * 32) + ko1);
                            R.c = *(const u32x4*)((vt + j * 64) + vo_); },
                        [&](int buf, const StageRegs& R) { *(LAS u32x4*)(lds + (buf ? AL_K1 : AL_K0) + vd_ * KSTR + vc8 * 16) = R.a;
                            if (tid < 256) *(LAS u32x4*)(lds + (buf ? AL_K1 : AL_K0) + rkey * KSTR + 128 + rch * 16) = R.b;
                            LAS unsigned char* vd = lds + (buf ? AL_V1 : AL_V0) + vd_ * VSTR + vc8 * 16; u32x2 a, c; a.x = R.c.x; a.y = R.c.y; c.x = R.c.z; c.y = R.c.w; *(LAS u32x2*)vd = a; *(LAS u32x2*)(vd + 8) = c; },
                        [&](int j, int cb) { if (j <= jd) attn_step<6>(lds + (cb ? AL_K1 : AL_K0), lds + (cb ? AL_V1 : AL_V0), qf, SM, o, j == jd, 0, 32 * (wave & 1) + r32, j == 0, r32, hi); });
                    { const float inv = 1.f / fmaxf(xhalf_sum(SM.l), 1e-30f); float ss = 0.f;
#pragma unroll
                      for (int dt = 0; dt < 2; ++dt)
#pragma unroll
                          for (int g = 0; g < 4; ++g) { const float v0 = o[dt][4 * g] * inv, v1 = o[dt][4 * g + 1] * inv, v2 = o[dt][4 * g + 2] * inv, v3 = o[dt][4 * g + 3] * inv; ss += v0 * v0 + v1 * v1 + v2 * v2 + v3 * v3;
                              u32x2 w; w.x = cvtpk(v0, v1); w.y = cvtpk(v2, v3); *(u32x2*)(Y + row * DM + h * 64 + 32 * dt + 8 * g + 4 * hi) = w; }
                      ss = xhalf_sum(ss); if (hi == 0) ssq_d[(size_t)h * M + row] = ss; }
                    __syncthreads();
                }
              }
            }
        }
        SEAM(pb + 2);
        if (IN(pb + 3)) {
        const int l_ = l; WS_PTRS();
            pg8::Gemm g{Y, (const bf16_t*)(ws + WS_WOUT) + (size_t)l * DM * DM, M, DM, DM}; pg8::StaticOrder S; S.init(M, DM, G, bid);
            pg8::EpiResid<true> E{XB, ssq_out, ssq_d, (LAS float*)(lds + 131072)};
            pg8::gemm_phase<pg8::EpiResid<true>, pg8::StaticOrder, true, true>(lds, g, S, E);
            if (REP_G57) { pg8::EpiInProj E2{PB, DM, ssq_mix}; pg8::gemm_phase<pg8::EpiInProj, pg8::StaticOrder, true, true>(lds, g, S, E2); }
        }
        SEAM(pb + 3);
        if (IN(pb + 4)) {
        const int l_ = l; WS_PTRS();
            pg8::Gemm g{XB, (const bf16_t*)(ws + WS_WGU) + (size_t)l * NGU * DM, M, NGU, DM}; pg8::StaticOrder S; S.init(M, NGU, G, bid);
            pg8::EpiSwiglu E{ACT, ssq_out};
            _Pragma("unroll 1") for (int rep = 0; rep < REP_G16; ++rep) pg8::gemm_phase<pg8::EpiSwiglu, pg8::StaticOrder, true, true>(lds, g, S, E);
        }
        SEAM(pb + 4);
        if (IN(pb + 5)) {
        const int l_ = l; WS_PTRS();
            pg8::Gemm g{ACT, (const bf16_t*)(ws + WS_WDN) + (size_t)l * DM * FF, M, DM, FF}; pg8::StaticOrder S; S.init(M, DM, G, bid);
            pg8::EpiResid<false> E{XB, ssq_down, nullptr, (LAS float*)(lds + 131072)};
            pg8::gemm_phase<pg8::EpiResid<false>, pg8::StaticOrder, true, true>(lds, g, S, E);
            if (REP_G57) { pg8::EpiInProj E2{Y, DM, ssq_mix}; pg8::gemm_phase<pg8::EpiInProj, pg8::StaticOrder, true, true>(lds, g, S, E2); }
        }
        SEAM(pb + 5);
    }
    if (IN(13)) {
        const int l_ = 1; WS_PTRS();
        LAUNDER_TID();
        const float* ssqf = ssp_base + (size_t)5 * 4 * M; const int gw = bid * 8 + wave, NGW = G * 8;
        for (int m = gw; m < M; m += NGW) {
            const float rinv = rsqrtf(sum4p(ssqf, m) * (1.f / DM) + EPS);
            const u32x2* xr = (const u32x2*)(XB + (size_t)m * DM) + lane; f32x4* orow = (f32x4*)(args.out + (size_t)m * DM) + lane; const f32x4* gn = (const f32x4*)inp(args, 27) + lane;
#pragma unroll
            for (int j = 0; j < 4; ++j) { const u32x2 w = xr[64 * j]; const f32x4 g = gn[64 * j]; f32x4 v; v[0] = bflo(w.x) * rinv * g[0]; v[1] = bfhi(w.x) * rinv * g[1]; v[2] = bflo(w.y) * rinv * g[2]; v[3] = bfhi(w.y) * rinv * g[3]; orow[64 * j] = v; }
        }
    }
#undef IN
#undef SEAM
}

extern "C" void kernel_launch(void* const* d_in, const int* in_sizes, int n_in, void* d_out, int out_size, void* d_ws, size_t ws_size, hipStream_t stream) {
    static int grid = 0;
    if (grid == 0) {
        if (n_in != 28 || in_sizes[0] != M * DM || out_size != M * DM || ws_size < WS_END) { fprintf(stderr, "kernel_launch: unexpected shapes (n_in %d, ws %zu)\n", n_in, ws_size); grid = -1; return; }
        int dev = 0, cus = 0;
        if (hipGetDevice(&dev) != hipSuccess || hipDeviceGetAttribute(&cus, hipDeviceAttributeMultiprocessorCount, dev) != hipSuccess) { grid = -1; return; }
        if (hipFuncSetAttribute((const void*)fwd, hipFuncAttributeMaxDynamicSharedMemorySize, LDS_BYTES) != hipSuccess) { fprintf(stderr, "kernel_launch: hipFuncSetAttribute failed\n"); grid = -1; return; }
        int per_cu = 0;
        if (hipOccupancyMaxActiveBlocksPerMultiprocessor(&per_cu, (const void*)fwd, NTHR, LDS_BYTES) != hipSuccess || per_cu < 1) fprintf(stderr, "kernel_launch: occupancy query says %d\n", per_cu);
        (void)hipGetLastError();
        grid = cus;
    }
    if (grid < 0) return;
    (void)hipMemsetAsync((char*)d_ws + WS_CTL, 0, CTL_ZERO_BYTES, stream);
    Args a{};
    for (int i = 0; i < 28; ++i) a.in[i] = (const float*)d_in[i];
    a.out = (float*)d_out; a.ws = (unsigned char*)d_ws;
    if (MK_N_LAUNCHES == 1) { a.ph_lo = 0; a.ph_hi = 14; hipLaunchKernelGGL(fwd, dim3(grid), dim3(NTHR), LDS_BYTES, stream, a); }
    else for (int p = 0; p < 14; ++p) { a.ph_lo = p; a.ph_hi = p + 1; hipLaunchKernelGGL(fwd, dim3(grid), dim3(NTHR), LDS_BYTES, stream, a); }
}
```

```cpp
#include <hip/hip_runtime.h>
#include <cstdio>
#include <cstdint>

#ifndef MK_N_LAUNCHES
#define MK_N_LAUNCHES 1
#endif

#define REP_P0 1
#define REP_G16 1
#define REP_G57 0
#define REP_ATT 1
#define REP_J4B 1
#define REP_J3 1
#define REP_J1 1
#define REP_J2 1
#define REP_P3 1
#define REP_ONLY 0
#define LAS __attribute__((address_space(3)))
#define DI __device__ __forceinline__
typedef unsigned short bf16_t;
typedef short bf16x8 __attribute__((ext_vector_type(8)));
typedef float f32x4 __attribute__((ext_vector_type(4)));
typedef unsigned u32x4 __attribute__((ext_vector_type(4)));
typedef unsigned u32x2 __attribute__((ext_vector_type(2)));

constexpr int NB = 4, SEQ = 8192, M = NB * SEQ, DM = 1024, NIN = 2304, NINS = 2300, FF = 2816, NGU = 2 * FF;
constexpr float EPS = 1e-6f;
constexpr int C_AX = 0, C_AG = 256, C_BQ = 512, C_KC = 768, C_VC = 832, C_KS = 896, C_VS = 960, C_KW = 1024, C_VW = 1088, C_BG = 1152,
              C_CQ = 1164, C_CK = 1292, C_CV = 1420, C_GLR = 1676, C_OG = 1692, C_DCQ = 1948, C_DCKV = 2140, C_DKR = 2268;
constexpr size_t MiB = 1u << 20;
constexpr size_t WS_CTL = 0, CTL_ZERO_BYTES = 1 * MiB;
constexpr size_t WS_ACC = 64 * 1024;
constexpr size_t WS_SSQ0 = 1 * MiB;
constexpr size_t WS_HB = 1 * MiB + 256 * 1024;
constexpr size_t WS_WIN = 2 * MiB, WS_WOUT = 11 * MiB, WS_WGU = 15 * MiB, WS_WDN = 37 * MiB;
constexpr size_t WS_WUQT = 48 * MiB, WS_WUKVT = 48 * MiB + 512 * 1024, WS_W2T = 49 * MiB, WS_W1T = 50 * MiB;
constexpr size_t WS_WGT = 49 * MiB + 512 * 1024, WS_SP = 49 * MiB + 768 * 1024;
constexpr size_t WS_BCS = 352 * MiB;
constexpr size_t WS_CS64 = 64 * MiB, WS_CS32 = 72 * MiB;
constexpr size_t WS_XB = 80 * MiB, WS_Y = 144 * MiB, WS_PB = 208 * MiB, WS_ACT = 208 * MiB;
constexpr size_t WS_LA = 384 * MiB, WS_LH = 386 * MiB, WS_CIN = 388 * MiB;
constexpr size_t WS_KVC = 392 * MiB, WS_DEC = 408 * MiB, WS_SST = 410 * MiB;
constexpr size_t WS_MQ = 428 * MiB, WS_MKN = 452 * MiB, WS_MV = 468 * MiB, WS_MKR = 484 * MiB;
constexpr size_t WS_SSP = 500 * MiB;
constexpr size_t WS_KSF = 504 * MiB;
constexpr size_t WS_VST = 490 * MiB, WS_VWT = 494 * MiB, WS_KCMPB = 498 * MiB, WS_VCMPT = 499 * MiB, WS_END = 508 * MiB;
constexpr int CW_QUEUE = 64;
constexpr int CW_FLAG = 1024;
constexpr int CW_BAR = 4096;
constexpr int LDS_BYTES = 163840 - 256;
constexpr int LDS_CTL = LDS_BYTES - 64;
constexpr int NTHR = 512;

struct Args { const float* in[28]; float* out; unsigned char* ws; int ph_lo, ph_hi; };

DI float bf2f(bf16_t h) { return __uint_as_float(((unsigned)h) << 16); }
DI float bflo(unsigned u) { return __uint_as_float(u << 16); }
DI float bfhi(unsigned u) { return __uint_as_float(u & 0xffff0000u); }
DI bf16_t f2bf(float f) { unsigned u = __float_as_uint(f); return (bf16_t)((u + 0x7fffu + ((u >> 16) & 1u)) >> 16); }
DI unsigned pk2(float lo, float hi) { return (unsigned)f2bf(lo) | ((unsigned)f2bf(hi) << 16); }
DI float sum4p(const float* p, size_t row) { return (p[row] + p[(size_t)M + row]) + (p[2 * (size_t)M + row] + p[3 * (size_t)M + row]); }
DI float wave_sum(float v) {
#pragma unroll
    for (int o = 1; o < 64; o <<= 1) v += __shfl_xor(v, o);
    return v;
}
DI float wave_max(float v) {
#pragma unroll
    for (int o = 1; o < 64; o <<= 1) v = fmaxf(v, __shfl_xor(v, o));
    return v;
}
DI int wave_min_i(int v) {
#pragma unroll
    for (int o = 1; o < 64; o <<= 1) { int w = __shfl_xor(v, o); v = w < v ? w : v; }
    return v;
}
DI float sigmoidf_(float x) { return 1.f / (1.f + __expf(-x)); }
DI float gelu_tanh(float x) { const float u = 0.7978845608028654f * (x + 0.044715f * x * x * x); return 0.5f * x * (1.f + tanhf(u)); }
#define WSYNC() do { asm volatile("s_waitcnt lgkmcnt(0)" ::: "memory"); __builtin_amdgcn_wave_barrier(); } while (0)

namespace pg8 {
constexpr int BM = 256, BK = 64, HALF = 128, HTB = HALF * BK * 2, NXCD = 8, WGM = 8;
__host__ __device__ __forceinline__ int lds_byte(int r, int c) { const int st = (r >> 4) * 2 + (c >> 5), rr = r & 15, cc = c & 31, ob = rr * 64 + cc * 2; return st * 1024 + (ob ^ (((ob >> 9) & 1) << 5)); }
__host__ __device__ __forceinline__ void stage_rc(int b, int& R, int& C) { const int st = b / 1024, sb = b % 1024, swz = sb ^ (((sb >> 9) & 1) << 5); R = (st >> 1) * 16 + swz / 64; C = (st & 1) * 32 + (swz % 64) / 2; }
__host__ __device__ __forceinline__ int perm32(int rho) { const int n = rho >> 4, i = rho & 15; return 8 * (i >> 2) + 4 * n + (i & 3); }
struct Unit { int pm, pn; };
struct Gemm { const bf16_t* A; const bf16_t* Bt; int M, N, K; };
struct StaticOrder {
    int nM, nN, nwg, G, c;
    __host__ __device__ void init(int M_, int N_, int G_, int c_) { nM = M_ / BM; nN = N_ / BM; nwg = nM * nN; G = G_; c = c_; }
    __host__ __device__ bool next(int i, Unit& u) const {
        const long L = (long)i * G + c; if (L >= nwg) return false;
        int wgid = (int)L; { const int q = nwg / NXCD, r = nwg % NXCD, xcd = wgid % NXCD, off = wgid / NXCD; wgid = (xcd < r ? xcd * (q + 1) : r * (q + 1) + (xcd - r) * q) + off; }
        const int nig = WGM * nN, gid = wgid / nig, fm = gid * WGM, gsz = (nM - fm) < WGM ? (nM - fm) : WGM;
        u.pm = fm + ((wgid % nig) % gsz); u.pn = (wgid % nig) / gsz; return true;
    }
    __device__ __forceinline__ void a_ready(const Unit&) const {}
    __device__ __forceinline__ void done(const Unit&) const {}
};
DI unsigned cvt_pk_bf16(float lo, float hi) { unsigned r; asm volatile("v_cvt_pk_bf16_f32 %0, %1, %2" : "=v"(r) : "v"(lo), "v"(hi)); return r; }

struct EpiInProj {
    static constexpr bool PERM = true, AFTER_DRAIN = false, MIDSCALE = false;
    bf16_t* O; int ldc; const float* ssq;
    DI void operator()(const f32x4 (&acc)[2][2][4][2], const Unit& u, int wr, int wc, int fr, int fq) const {
        int row0 = u.pm * BM + wr * 64 + fr; asm volatile("" : "+v"(row0)); const int col0 = u.pn * BM + wc * 32 + 8 * fq;
#pragma unroll
        for (int ai = 0; ai < 2; ++ai)
#pragma unroll
            for (int m = 0; m < 4; ++m) {
                const int row = row0 + ai * HALF + m * 16;
                const float rinv = rsqrtf(sum4p(ssq, row) * (1.f / DM) + EPS);
                bf16_t* rowp = O + (size_t)row * ldc + col0;
#pragma unroll
                for (int bj = 0; bj < 2; ++bj) {
                    f32x4 v0 = acc[ai][bj][m][0] * rinv, v1 = acc[ai][bj][m][1] * rinv;
                    u32x4 w; w.x = cvt_pk_bf16(v0[0], v0[1]); w.y = cvt_pk_bf16(v0[2], v0[3]); w.z = cvt_pk_bf16(v1[0], v1[1]); w.w = cvt_pk_bf16(v1[2], v1[3]);
                    *(u32x4*)(rowp + bj * HALF) = w;
                }
            }
    }
};
template <bool MS> struct EpiResid {
    static constexpr bool PERM = true, AFTER_DRAIN = false, MIDSCALE = MS;
    bf16_t* xb; float* ssq_part; const float* ssq_mid; LAS float* ssl;
    DI void midscale(f32x4 (&acc)[2][2][4][2], const Unit& u, int wr, int fr) const {
        int row0 = u.pm * BM + wr * 64 + fr; asm volatile("" : "+v"(row0));
#pragma unroll
        for (int ai = 0; ai < 2; ++ai)
#pragma unroll
            for (int m = 0; m < 4; ++m) { const float s = rsqrtf(sum4p(ssq_mid, row0 + ai * HALF + m * 16) * (1.f / 256.f) + EPS);
#pragma unroll
                for (int bj = 0; bj < 2; ++bj) { acc[ai][bj][m][0] *= s; acc[ai][bj][m][1] *= s; } }
    }
    DI void operator()(const f32x4 (&acc)[2][2][4][2], const Unit& u, int wr, int wc, int fr, int fq) const {
        int rl0 = wr * 64 + fr; asm volatile("" : "+v"(rl0));
        const int col0 = u.pn * BM + wc * 32 + 8 * fq;
#pragma unroll
        for (int ai = 0; ai < 2; ++ai)
#pragma unroll
            for (int m = 0; m < 4; ++m) {
                const int rl = rl0 + ai * HALF + m * 16; const size_t row = (size_t)u.pm * BM + rl;
                float part = 0.f;
#pragma unroll
                for (int bj = 0; bj < 2; ++bj) {
                    u32x4* px = (u32x4*)(xb + row * DM + col0 + bj * HALF); const u32x4 xo = *px;
                    const f32x4 a0 = acc[ai][bj][m][0], a1 = acc[ai][bj][m][1];
                    const float v0 = a0[0] + bflo(xo.x), v1 = a0[1] + bfhi(xo.x), v2 = a0[2] + bflo(xo.y), v3 = a0[3] + bfhi(xo.y), v4 = a1[0] + bflo(xo.z), v5 = a1[1] + bfhi(xo.z), v6 = a1[2] + bflo(xo.w), v7 = a1[3] + bfhi(xo.w);
                    u32x4 w; w.x = cvt_pk_bf16(v0, v1); w.y = cvt_pk_bf16(v2, v3); w.z = cvt_pk_bf16(v4, v5); w.w = cvt_pk_bf16(v6, v7);
                    *px = w;
                    part += (v0 * v0 + v1 * v1) + (v2 * v2 + v3 * v3) + (v4 * v4 + v5 * v5) + (v6 * v6 + v7 * v7);
                }
                part += __shfl_xor(part, 16); part += __shfl_xor(part, 32);
                if (fq == 0) ssl[rl * 4 + wc] = part;
            }
        asm volatile("s_waitcnt lgkmcnt(0)" ::: "memory"); __builtin_amdgcn_s_barrier();
        int tq = threadIdx.x; asm volatile("" : "+v"(tq));
        if (tq < 256) { const f32x4 p = *(const LAS f32x4*)(ssl + tq * 4); ssq_part[(size_t)u.pn * M + (size_t)u.pm * BM + tq] = (p[0] + p[1]) + (p[2] + p[3]); }
    }
};
struct EpiSwiglu {
    static constexpr bool PERM = true, AFTER_DRAIN = false, MIDSCALE = false;
    bf16_t* act; const float* ssq;
    DI void operator()(const f32x4 (&acc)[2][2][4][2], const Unit& u, int wr, int wc, int fr, int fq) const {
        int row0 = u.pm * BM + wr * 64 + fr; asm volatile("" : "+v"(row0)); const int j0 = u.pn * 128 + wc * 16 + 4 * fq;
#pragma unroll
        for (int ai = 0; ai < 2; ++ai)
#pragma unroll
            for (int m = 0; m < 4; ++m) {
                const int row = row0 + ai * HALF + m * 16;
                const float rinv = rsqrtf(sum4p(ssq, row) * (1.f / DM) + EPS);
#pragma unroll
                for (int bj = 0; bj < 2; ++bj) {
                    const f32x4 g = acc[ai][bj][m][0] * rinv, up = acc[ai][bj][m][1] * rinv;
                    float a[4];
#pragma unroll
                    for (int i = 0; i < 4; ++i) a[i] = g[i] / (1.f + __expf(-g[i])) * up[i];
                    u32x2 w; w.x = cvt_pk_bf16(a[0], a[1]); w.y = cvt_pk_bf16(a[2], a[3]);
                    *(u32x2*)(act + (size_t)row * FF + j0 + bj * 64) = w;
                }
            }
    }
};

template <class Epi, class Sched, bool ALIGN_EPI = false, bool SP2 = false>
DI void gemm_phase(LAS unsigned char* lds, const Gemm g, const Sched& S, const Epi& E) {
    int tid_ = threadIdx.x; asm volatile("" : "+v"(tid_));
    const int tid = tid_, wid = __builtin_amdgcn_readfirstlane(tid >> 6), lane = tid & 63, wr = wid >> 2, wc = wid & 3, fr = lane & 15, fq = lane >> 4;
    const int K = g.K, nt = K / BK;
    unsigned voffA[2], voffB[2];
#pragma unroll
    for (int i = 0; i < 2; ++i) { int R, C; stage_rc(tid * 16 + i * 8192, R, C); const int Rb = Epi::PERM ? ((R & ~31) + perm32(R & 31)) : R;
        voffA[i] = (unsigned)(R * K + C) * 2u; voffB[i] = (unsigned)(Rb * K + C) * 2u; }
    const size_t kstep = (size_t)(BK * 2);
    const size_t hstep = (size_t)HALF * K * 2;
    const size_t tstep = 2 * hstep;
    const unsigned ldsw = (unsigned)wid * 1024u;
    const int aoff = lds_byte(wr * 64 + fr, fq * 8), boff = lds_byte(wc * 32 + fr, fq * 8);
#define PG8_SA(b, h) (((b) * 2 + (h)) * HTB)
#define PG8_SB(b, h) ((4 + (b) * 2 + (h)) * HTB)
#define PG8_STAGE(bufoff, gbase, voff) do { _Pragma("unroll") for (int _i = 0; _i < 2; ++_i) \
        __builtin_amdgcn_global_load_lds((const unsigned*)((const char*)(gbase) + (voff)[_i]), (LAS unsigned*)(lds + (bufoff) + ldsw + _i * 8192), 16, 0, 0); } while (0)
#define PG8_LDA(dst, b, h) do { _Pragma("unroll") for (int m = 0; m < 4; ++m) _Pragma("unroll") for (int k = 0; k < 2; ++k) dst[m][k] = *(const LAS bf16x8*)(lds + PG8_SA(b, h) + aoff + m * 2048 + k * 1024); } while (0)
#define PG8_LDB(dst, b, h) do { _Pragma("unroll") for (int n = 0; n < 2; ++n) _Pragma("unroll") for (int k = 0; k < 2; ++k) dst[n][k] = *(const LAS bf16x8*)(lds + PG8_SB(b, h) + boff + n * 2048 + k * 1024); } while (0)
#define PG8_MMA(ai, bj, At, Bt) do { __builtin_amdgcn_s_setprio(1); _Pragma("unroll") for (int m = 0; m < 4; ++m) _Pragma("unroll") for (int n = 0; n < 2; ++n) _Pragma("unroll") for (int k = 0; k < 2; ++k) \
        acc[ai][bj][m][n] = __builtin_amdgcn_mfma_f32_16x16x32_bf16(Bt[n][k], At[m][k], acc[ai][bj][m][n], 0, 0, 0); __builtin_amdgcn_s_setprio(0); } while (0)
#define PG8_WAIT_V(n) asm volatile("s_waitcnt vmcnt(" #n ")" ::: "memory")
#define PG8_WAIT_L(n) asm volatile("s_waitcnt lgkmcnt(" #n ")" ::: "memory")
#define PG8_BAR __builtin_amdgcn_s_barrier()
#define PG8_SCHED __builtin_amdgcn_sched_barrier(0)
    Unit cur, nxt; int ui = 0;
    if (!S.next(0, cur)) return;
    f32x4 acc[2][2][4][2];
#pragma unroll
    for (int a = 0; a < 2; ++a)
#pragma unroll
        for (int b = 0; b < 2; ++b)
#pragma unroll
            for (int m = 0; m < 4; ++m)
#pragma unroll
                for (int n = 0; n < 2; ++n) acc[a][b][m][n] = (f32x4){0.f, 0.f, 0.f, 0.f};
    bf16x8 At[4][2], B0[2][2], B1[2][2];
    const char* cA = (const char*)g.A + (size_t)cur.pm * tstep; const char* cB = (const char*)g.Bt + (size_t)cur.pn * tstep;
    S.a_ready(cur);
    if constexpr (SP2) {
        PG8_STAGE(PG8_SB(0, 0), cB, voffB); PG8_STAGE(PG8_SB(0, 1), cB + hstep, voffB); PG8_STAGE(PG8_SA(0, 0), cA, voffA); PG8_STAGE(PG8_SA(0, 1), cA + hstep, voffA);
        if (wr == 1) PG8_BAR;
        PG8_WAIT_V(2); PG8_BAR;
        PG8_STAGE(PG8_SB(1, 0), cB + kstep, voffB); PG8_STAGE(PG8_SA(1, 0), cA + kstep, voffA); PG8_STAGE(PG8_SB(1, 1), cB + hstep + kstep, voffB);
        PG8_WAIT_V(6); PG8_BAR;
    } else {
        PG8_STAGE(PG8_SB(0, 0), cB, voffB); PG8_STAGE(PG8_SA(0, 0), cA, voffA); PG8_STAGE(PG8_SB(0, 1), cB + hstep, voffB); PG8_STAGE(PG8_SA(0, 1), cA + hstep, voffA);
        if (wr == 1) PG8_BAR;
        PG8_WAIT_V(4); PG8_BAR;
        PG8_STAGE(PG8_SB(1, 0), cB + kstep, voffB); PG8_STAGE(PG8_SA(1, 0), cA + kstep, voffA); PG8_STAGE(PG8_SB(1, 1), cB + hstep + kstep, voffB);
        PG8_WAIT_V(6); PG8_BAR;
    }
    for (;;) {
        const bool has_next = S.next(ui + 1, nxt);
        const char* nA = has_next ? (const char*)g.A + (size_t)nxt.pm * tstep : cA; const char* nB = has_next ? (const char*)g.Bt + (size_t)nxt.pn * tstep : cB;
        for (int t = 0; t < nt; t += 2) {
            const bool last = (t == nt - 2);
            const char* a1 = cA + (size_t)(t + 1) * kstep;
            const char* a2 = last ? nA : cA + (size_t)(t + 2) * kstep; const char* b2 = last ? nB : cB + (size_t)(t + 2) * kstep;
            const char* a3 = a2 + kstep; const char* b3 = b2 + kstep;
            if (last && has_next) S.a_ready(nxt);
            if constexpr (SP2) {
            PG8_LDB(B0, 0, 0); PG8_LDB(B1, 0, 1); PG8_SCHED; PG8_LDA(At, 0, 0); PG8_STAGE(PG8_SA(1, 1), a1 + hstep, voffA);
            PG8_WAIT_V(8); PG8_WAIT_L(0); PG8_BAR; PG8_MMA(0, 0, At, B0); PG8_MMA(0, 1, At, B1); PG8_BAR; PG8_SCHED;
            PG8_LDA(At, 0, 1); PG8_STAGE(PG8_SB(0, 0), b2, voffB); PG8_STAGE(PG8_SB(0, 1), b2 + hstep, voffB); PG8_STAGE(PG8_SA(0, 0), a2, voffA);
            PG8_WAIT_V(8); PG8_WAIT_L(0); PG8_BAR; PG8_MMA(1, 0, At, B0); PG8_MMA(1, 1, At, B1); PG8_BAR; PG8_SCHED;
            PG8_LDB(B0, 1, 0); PG8_LDB(B1, 1, 1); PG8_SCHED; PG8_LDA(At, 1, 0); PG8_STAGE(PG8_SA(0, 1), a2 + hstep, voffA);
            PG8_WAIT_V(8); PG8_WAIT_L(0); PG8_BAR; PG8_MMA(0, 0, At, B0); PG8_MMA(0, 1, At, B1); PG8_BAR; PG8_SCHED;
            PG8_LDA(At, 1, 1); PG8_STAGE(PG8_SB(1, 0), b3, voffB); PG8_STAGE(PG8_SB(1, 1), b3 + hstep, voffB); PG8_STAGE(PG8_SA(1, 0), a3, voffA);
            PG8_WAIT_V(8); PG8_WAIT_L(0); PG8_BAR; PG8_MMA(1, 0, At, B0); PG8_MMA(1, 1, At, B1); PG8_BAR; PG8_SCHED;
            if constexpr (Epi::MIDSCALE) { if (t == 2) E.midscale(acc, cur, wr, fr); }
            } else {
            PG8_LDB(B0, 0, 0); PG8_SCHED; PG8_LDA(At, 0, 0); PG8_STAGE(PG8_SA(1, 1), a1 + hstep, voffA);
            PG8_WAIT_L(8); PG8_BAR; PG8_WAIT_L(0); PG8_MMA(0, 0, At, B0); PG8_BAR; PG8_SCHED;
            PG8_LDB(B1, 0, 1); PG8_STAGE(PG8_SB(0, 0), b2, voffB);
            PG8_BAR; PG8_WAIT_L(0); PG8_MMA(0, 1, At, B1); PG8_BAR;
            PG8_LDA(At, 0, 1); PG8_STAGE(PG8_SA(0, 0), a2, voffA);
            PG8_BAR; PG8_WAIT_L(0); PG8_MMA(1, 0, At, B0); PG8_BAR; PG8_SCHED;
            PG8_STAGE(PG8_SB(0, 1), b2 + hstep, voffB);
            PG8_WAIT_V(6); PG8_BAR; PG8_MMA(1, 1, At, B1); PG8_BAR;
            PG8_LDB(B0, 1, 0); PG8_SCHED; PG8_LDA(At, 1, 0); PG8_STAGE(PG8_SA(0, 1), a2 + hstep, voffA);
            PG8_WAIT_L(8); PG8_BAR; PG8_WAIT_L(0); PG8_MMA(0, 0, At, B0); PG8_BAR; PG8_SCHED;
            PG8_LDB(B1, 1, 1); PG8_STAGE(PG8_SB(1, 0), b3, voffB);
            PG8_BAR; PG8_WAIT_L(0); PG8_MMA(0, 1, At, B1); PG8_BAR;
            PG8_LDA(At, 1, 1); PG8_STAGE(PG8_SA(1, 0), a3, voffA);
            PG8_BAR; PG8_WAIT_L(0); PG8_MMA(1, 0, At, B0); PG8_BAR; PG8_SCHED;
            PG8_STAGE(PG8_SB(1, 1), b3 + hstep, voffB);
            PG8_WAIT_V(6); PG8_BAR; PG8_MMA(1, 1, At, B1); PG8_BAR;
            }
        }
        if constexpr (ALIGN_EPI) { if (wr == 0) PG8_BAR; }
        if constexpr (!Epi::AFTER_DRAIN) { E(acc, cur, wr, wc, fr, fq); S.done(cur); }
        if (!has_next) break;
#pragma unroll
        for (int a = 0; a < 2; ++a)
#pragma unroll
            for (int b = 0; b < 2; ++b)
#pragma unroll
                for (int m = 0; m < 4; ++m)
#pragma unroll
                    for (int n = 0; n < 2; ++n) acc[a][b][m][n] = (f32x4){0.f, 0.f, 0.f, 0.f};
        cur = nxt; cA = nA; cB = nB; ++ui;
        if constexpr (ALIGN_EPI) { if (wr == 1) PG8_BAR; }
    }
    PG8_WAIT_V(0);
    if constexpr (!ALIGN_EPI) { if (wr == 0) PG8_BAR; }
    PG8_BAR;
#undef PG8_SA
#undef PG8_SB
#undef PG8_STAGE
#undef PG8_LDA
#undef PG8_LDB
#undef PG8_MMA
#undef PG8_WAIT_V
#undef PG8_WAIT_L
#undef PG8_BAR
#undef PG8_SCHED
}
}

#define XB_TMO      128
#define XB_XCNT(j)  (256  + 64 * (j))
#define XB_XSUB(j)  (1280 + 64 * (j))
#define XB_XGEN(j)  (2304 + 64 * (j))
#define XB_TOP      3328
#define XB_TOPGEN   3392
#define XCD_BAR_WORDS 3456
#define XB_SPIN_CAP (1u << 18)
__device__ __forceinline__ unsigned xb_ld(unsigned* p)              { return __hip_atomic_load(p, __ATOMIC_RELAXED, __HIP_MEMORY_SCOPE_AGENT); }
__device__ __forceinline__ unsigned xb_add(unsigned* p, unsigned v) { return __hip_atomic_fetch_add(p, v, __ATOMIC_RELAXED, __HIP_MEMORY_SCOPE_AGENT); }
__device__ __forceinline__ unsigned xb_xcc_id() { return (unsigned)__builtin_amdgcn_s_getreg((3 << 11) | 20) & 0xFu; }
#define XB_SPIN(cond, bar) do { unsigned _sp = 0; while (cond) { __builtin_amdgcn_s_sleep(1); \
    if ((++_sp & 255u) == 0u) { if (xb_ld(&(bar)[XB_TMO])) break; if (_sp > XB_SPIN_CAP) { atomicAdd(&(bar)[XB_TMO], 1u); break; } } } } while (0)
struct XcdBarrier { unsigned* bar; unsigned x; volatile LAS unsigned* st; };
__device__ __forceinline__ XcdBarrier xcd_barrier_post(unsigned* bar, volatile LAS unsigned* st) {
    XcdBarrier b; b.bar = bar; b.x = xb_xcc_id(); b.st = st;
    if (threadIdx.x == 0) (void)xb_add(&bar[XB_XCNT(b.x)], 1u);
    return b;
}
__device__ __forceinline__ void xcd_barrier_complete(unsigned* bar, unsigned x, unsigned& nloc, unsigned& nx) {
    const unsigned G = gridDim.x * gridDim.y * gridDim.z;
    unsigned sum, cnt, mine, sp = 0u;
    for (;;) {
        sum = 0u; cnt = 0u; mine = 0u;
#pragma unroll
        for (unsigned j = 0; j < 16; ++j) { const unsigned c = xb_ld(&bar[XB_XCNT(j)]); sum += c; cnt += (c > 0u) ? 1u : 0u; mine = (j == x) ? c : mine; }
        if (sum == G) break;
        __builtin_amdgcn_s_sleep(1);
        if ((++sp & 255u) == 0u) { if (xb_ld(&bar[XB_TMO])) break; if (sp > XB_SPIN_CAP) { atomicAdd(&bar[XB_TMO], 1u); break; } }
    }
    nloc = mine > 0u ? mine : 1u; nx = cnt > 0u ? cnt : 1u;
}
__device__ __forceinline__ void xcd_barrier(const XcdBarrier& b) {
    asm volatile("s_waitcnt vmcnt(0)" ::: "memory");
    __syncthreads();
    if (threadIdx.x == 0) {
        unsigned* bar = b.bar;
        __builtin_amdgcn_s_waitcnt(0);
        unsigned nloc = b.st[0], nx = b.st[1];
        if (nloc == 0u) { xcd_barrier_complete(bar, b.x, nloc, nx); b.st[0] = nloc; b.st[1] = nx; }
        const unsigned old = xb_add(&bar[XB_XSUB(b.x)], 1u);
        const unsigned gen = old / nloc;
        if (old + 1u == (gen + 1u) * nloc) {
            __builtin_amdgcn_fence(__ATOMIC_RELEASE, "agent");
            asm volatile("s_waitcnt vmcnt(0)" ::: "memory");
            const unsigned og = xb_add(&bar[XB_TOP], 1u);
            const unsigned tg = og / nx;
            if (og + 1u == (tg + 1u) * nx) xb_add(&bar[XB_TOPGEN], 1u);
            else XB_SPIN(xb_ld(&bar[XB_TOPGEN]) == tg, bar);
            __builtin_amdgcn_fence(__ATOMIC_ACQUIRE, "agent");
            xb_add(&bar[XB_XGEN(b.x)], 1u);
            asm volatile("s_waitcnt vmcnt(0)" ::: "memory");
        } else {
            XB_SPIN(xb_ld(&bar[XB_XGEN(b.x)]) == gen, bar);
            __builtin_amdgcn_fence(__ATOMIC_ACQUIRE, "agent");
            asm volatile("s_waitcnt vmcnt(0)" ::: "memory");
        }
    }
    __syncthreads();
}

template <int MAP>
DI int colmap(int v, int Nsrc) {
    if (MAP == 0) return v < Nsrc ? v : -1;
    const int g8 = v >> 3, e = v & 7, j = 4 * g8 + (e & 3); return (e < 4) ? j : FF + j;
}
template <int MAP, int KROT = 0>
DI void p0_transpose_item(const float* W, int K, int Nsrc, const float* gain, bf16_t* WT, LAS float* scr, int kb, int nb, int lane) {
    const int k0 = 64 * kb, n0 = 32 * nb;
    const int sc = colmap<MAP>(n0 + (lane & 31), Nsrc);
#pragma unroll 8
    for (int i = 0; i < 32; ++i) { const int kk = 2 * i + (lane >> 5); int ksrc = k0 + kk + KROT; if (KROT && ksrc >= K) ksrc -= K; float w = 0.f; if (sc >= 0) w = W[(size_t)ksrc * Nsrc + sc]; if (gain) w *= gain[ksrc]; scr[kk * 33 + (lane & 31)] = w; }
    WSYNC();
    const int c = lane & 7;
#pragma unroll
    for (int j = 0; j < 4; ++j) { const int n = (lane >> 3) + 8 * j; const LAS float* s = scr + (8 * c) * 33 + n;
        u32x4 o; o.x = pk2(s[0 * 33], s[1 * 33]); o.y = pk2(s[2 * 33], s[3 * 33]); o.z = pk2(s[4 * 33], s[5 * 33]); o.w = pk2(s[6 * 33], s[7 * 33]);
        *(u32x4*)(WT + (size_t)(n0 + n) * K + k0 + 8 * c) = o; }
    WSYNC();
}


typedef float f32x16 __attribute__((ext_vector_type(16)));
typedef float f32x2v __attribute__((ext_vector_type(2)));
typedef __bf16 bf16x2_t __attribute__((ext_vector_type(2)));
constexpr int KSTR = 208, VSTR = 136;
constexpr int AL_K0 = 0, AL_K1 = 64 * KSTR, AL_V0 = 2 * 64 * KSTR, AL_V1 = AL_V0 + 64 * VSTR, AL_IMP = 45056, AL_SELM = AL_IMP + 32768, AL_OACC = AL_SELM + 1024;
constexpr float NEGB = -1e30f, LOG2E = 1.4426950408889634f;
DI unsigned cvtpk(float lo, float hi) { f32x2v v = {lo, hi}; bf16x2_t b = __builtin_convertvector(v, bf16x2_t); return __builtin_bit_cast(unsigned, b); }
DI f32x16 mfma32(bf16x8 a, bf16x8 b, f32x16 c) { return __builtin_amdgcn_mfma_f32_32x32x16_bf16(a, b, c, 0, 0, 0); }
DI float xhalf_max(float v) { auto rr = __builtin_amdgcn_permlane32_swap(__float_as_uint(v), __float_as_uint(v), false, false); return fmaxf(__uint_as_float(rr[0]), __uint_as_float(rr[1])); }
DI float xhalf_sum(float v) { auto rr = __builtin_amdgcn_permlane32_swap(__float_as_uint(v), __float_as_uint(v), false, false); return __uint_as_float(rr[0]) + __uint_as_float(rr[1]); }
DI float ex2(float x) { return __builtin_amdgcn_exp2f(x); }
template <int KSTEPS>
DI void qk_tile(const LAS unsigned char* Kt, const bf16x8 (&qf)[KSTEPS], int r32, int hi, f32x16& s0, f32x16& s1) {
    const LAS unsigned char* p0 = Kt + r32 * KSTR + hi * 16;
#pragma unroll
    for (int i = 0; i < 16; ++i) { s0[i] = 0.f; s1[i] = 0.f; }
#pragma unroll
    for (int ks = 0; ks < KSTEPS; ++ks) {
        const bf16x8 a0 = *(const LAS bf16x8*)(p0 + ks * 32), a1 = *(const LAS bf16x8*)(p0 + 32 * KSTR + ks * 32);
        s0 = mfma32(a0, qf[ks], s0); s1 = mfma32(a1, qf[ks], s1);
    }
}
DI void mask_tile(f32x16& s0, f32x16& s1, int klo, int khi, int hi) {
    const int lo_ = klo - 4 * hi, hi_ = khi - 4 * hi;
#pragma unroll
    for (int i = 0; i < 16; ++i) { const int kb = (i & 3) + 8 * (i >> 2); if (kb < lo_ || kb > hi_) s0[i] = NEGB; if (kb + 32 < lo_ || kb + 32 > hi_) s1[i] = NEGB; }
}
DI float tile_max(const f32x16& s0, const f32x16& s1) {
    float mx = fmaxf(s0[0], s1[0]);
#pragma unroll
    for (int i = 1; i < 16; ++i) mx = fmaxf(mx, fmaxf(s0[i], s1[i]));
    return xhalf_max(mx);
}
template <int BASE> DI bf16x8 pack8(const f32x16& s) { u32x4 p; p.x = cvtpk(s[BASE], s[BASE + 1]); p.y = cvtpk(s[BASE + 2], s[BASE + 3]); p.z = cvtpk(s[BASE + 4], s[BASE + 5]); p.w = cvtpk(s[BASE + 6], s[BASE + 7]); return __builtin_bit_cast(bf16x8, p); }
DI bf16x8 ld8x2(const bf16_t* p) { const u32x2 a = *(const u32x2*)p, b = *(const u32x2*)(p + 4); u32x4 w; w.x = a.x; w.y = a.y; w.z = b.x; w.w = b.y; return __builtin_bit_cast(bf16x8, w); }
DI bf16x8 vfrag(const LAS unsigned char* p) { const u32x2 a = *(const LAS u32x2*)p, b = *(const LAS u32x2*)(p + 16); u32x4 w; w.x = a.x; w.y = a.y; w.z = b.x; w.w = b.y; return __builtin_bit_cast(bf16x8, w); }
DI void pv_tile(const f32x16& s0, const f32x16& s1, const LAS unsigned char* Vt, f32x16 (&o)[2], int r32, int hi) {
    const bf16x8 p00 = pack8<0>(s0), p01 = pack8<8>(s0), p10 = pack8<0>(s1), p11 = pack8<8>(s1);
#pragma unroll
    for (int dt = 0; dt < 2; ++dt) { const LAS unsigned char* vp = Vt + (32 * dt + r32) * VSTR + 8 * hi;
        o[dt] = mfma32(vfrag(vp), p00, o[dt]); o[dt] = mfma32(vfrag(vp + 32), p01, o[dt]); o[dt] = mfma32(vfrag(vp + 64), p10, o[dt]); o[dt] = mfma32(vfrag(vp + 96), p11, o[dt]); }
}
DI void softmax_pv(f32x16& s0, f32x16& s1, const LAS unsigned char* Vt, f32x16 (&o)[2], float& m, float& l, int r32, int hi) {
    const float mx = tile_max(s0, s1), mn = fmaxf(m, mx), ms = mn < -1e29f ? 0.f : mn, alpha = ex2(m - ms);
    m = mn; float psum = 0.f;
#pragma unroll
    for (int i = 0; i < 16; ++i) { s0[i] = ex2(s0[i] - ms); s1[i] = ex2(s1[i] - ms); psum += s0[i] + s1[i]; }
    l = l * alpha + psum;
    if (!__all(alpha == 1.f)) {
#pragma unroll
        for (int i = 0; i < 16; ++i) { o[0][i] *= alpha; o[1][i] *= alpha; } }
    pv_tile(s0, s1, Vt, o, r32, hi);
}
struct SoftState { float m, l; };
constexpr float SM_THR = 8.f;
DI void soft_init(SoftState& S, f32x16 (&o)[2]) { S.m = 0.f; S.l = 0.f;
#pragma unroll
    for (int i = 0; i < 16; ++i) { o[0][i] = 0.f; o[1][i] = 0.f; } }
DI f32x16 bcast16(float v) { f32x16 c;
#pragma unroll
    for (int i = 0; i < 16; ++i) c[i] = v;
    return c; }
DI float max3f(float a, float b, float c) { float r; asm("v_max3_f32 %0, %1, %2, %3" : "=v"(r) : "v"(a), "v"(b), "v"(c)); return r; }
DI void soft_update(f32x16& s0, f32x16& s1, SoftState& S, f32x16 (&o)[2], bool masked, int klo, int khi, bool first, int hi) {
    if (__builtin_expect(masked, 0)) { asm volatile("; boundary tile mask" ::: "memory"); mask_tile(s0, s1, klo, khi, hi); }
    asm volatile("s_nop 15\n\ts_nop 7" : "+v"(s0), "+v"(s1));
    float rm;
    { float a = max3f(s0[0], s0[1], s0[2]), b = max3f(s1[0], s1[1], s1[2]);
#pragma unroll
      for (int i = 3; i < 15; i += 2) { a = max3f(a, s0[i], s0[i + 1]); b = max3f(b, s1[i], s1[i + 1]); }
      rm = xhalf_max(fmaxf(max3f(a, b, s0[15]), s1[15])); }
    if (first) {
        const float dl = rm < -1e29f ? 0.f : rm; S.m = dl;
#pragma unroll
        for (int i = 0; i < 16; ++i) { s0[i] -= dl; s1[i] -= dl; }
    } else if (__any(rm > SM_THR)) {
        const float dl = fmaxf(rm, 0.f), alpha = ex2(-dl); S.m += dl; S.l *= alpha;
#pragma unroll
        for (int i = 0; i < 16; ++i) { s0[i] -= dl; s1[i] -= dl; o[0][i] *= alpha; o[1][i] *= alpha; }
    }
    float p0 = 0.f, p1 = 0.f, p2 = 0.f, p3 = 0.f;
#pragma unroll
    for (int i = 0; i < 16; i += 2) { s0[i] = ex2(s0[i]); s0[i + 1] = ex2(s0[i + 1]); s1[i] = ex2(s1[i]); s1[i + 1] = ex2(s1[i + 1]); p0 += s0[i]; p1 += s0[i + 1]; p2 += s1[i]; p3 += s1[i + 1]; }
    S.l += (p0 + p1) + (p2 + p3);
}
template <int KSTEPS>
DI void attn_step(const LAS unsigned char* Kt, const LAS unsigned char* Vt, const bf16x8 (&qf)[KSTEPS], SoftState& S, f32x16 (&o)[2], bool masked, int klo, int khi, bool first, int r32, int hi) {
    const f32x16 cinit = bcast16(-S.m); f32x16 s0 = cinit, s1 = cinit;
    { const LAS unsigned char* p0 = Kt + r32 * KSTR + hi * 16;
#pragma unroll
      for (int ks = 0; ks < KSTEPS; ++ks) { const bf16x8 a0 = *(const LAS bf16x8*)(p0 + ks * 32), a1 = *(const LAS bf16x8*)(p0 + 32 * KSTR + ks * 32);
          s0 = mfma32(a0, qf[ks], s0); s1 = mfma32(a1, qf[ks], s1); } }
    soft_update(s0, s1, S, o, masked, klo, khi, first, hi);
    pv_tile(s0, s1, Vt, o, r32, hi);
}
struct StageRegs { u32x4 a, b, c; };
template <class LoadF, class StoreF, class StepF>
DI void attn_pipeline(int jbeg, int jend, LoadF ld, StoreF st, StepF step) {
    if (jbeg > jend) return;
    StageRegs RA;
    ld(jbeg, RA); st(0, RA); __syncthreads();
    for (int j = jbeg; j <= jend; j += 2) {
        if (j + 1 <= jend) ld(j + 1, RA);
        step(j, 0);
        if (j + 1 <= jend) st(1, RA);
        __syncthreads();
        if (j + 1 > jend) break;
        if (j + 2 <= jend) ld(j + 2, RA);
        step(j + 1, 1);
        if (j + 2 <= jend) st(0, RA);
        __syncthreads();
    }
}
DI const float* inp(const Args& a, int k) { asm volatile("" : "+s"(k)); return a.in[k]; }
__global__ void __launch_bounds__(NTHR, 2) fwd(Args args) {
    extern __shared__ __attribute__((aligned(16))) unsigned char lds_raw[];
    LAS unsigned char* lds = (LAS unsigned char*)lds_raw;
    LAS float* ldsf = (LAS float*)lds;
    volatile LAS unsigned* LCTL = (volatile LAS unsigned*)(lds + LDS_CTL);
    const int tid0 = threadIdx.x, wave = __builtin_amdgcn_readfirstlane(tid0 >> 6);
    const int G = gridDim.x, bid = blockIdx.x;
#define LAUNDER_TID() int tid = tid0; asm volatile("" : "+v"(tid)); const int lane = tid & 63; (void)lane
#define WS_PTRS() unsigned char* ws = args.ws; asm volatile("" : "+s"(ws)); \
    unsigned* ctl = (unsigned*)(ws + WS_CTL); float* ssp_base = (float*)(ws + WS_SSP); float* hb = (float*)(ws + WS_HB); \
    bf16_t* XB = (bf16_t*)(ws + WS_XB); bf16_t* Y = (bf16_t*)(ws + WS_Y); bf16_t* PB = (bf16_t*)(ws + WS_PB); bf16_t* ACT = (bf16_t*)(ws + WS_ACT); \
    const float2* cs64 = (const float2*)(ws + WS_CS64); const float2* cs32 = (const float2*)(ws + WS_CS32); \
    float* LRA = args.out; float* LRU_ = args.out + (size_t)M * 256; \
    float* LA = (float*)(ws + WS_LA); float* LH = (float*)(ws + WS_LH); float* CIN = (float*)(ws + WS_CIN); \
    float* KVC = (float*)(ws + WS_KVC); float* DEC = (float*)(ws + WS_DEC); float* SST = (float*)(ws + WS_SST); \
    bf16_t* MQ = (bf16_t*)(ws + WS_MQ); bf16_t* MKN = (bf16_t*)(ws + WS_MKN); bf16_t* MVT = (bf16_t*)(ws + WS_MV); bf16_t* MKR = (bf16_t*)(ws + WS_MKR); \
    bf16_t* VST = (bf16_t*)(ws + WS_VST); bf16_t* KSF = (bf16_t*)(ws + WS_KSF); (void)KSF; bf16_t* VWT = (bf16_t*)(ws + WS_VWT); bf16_t* KCMPB = (bf16_t*)(ws + WS_KCMPB); bf16_t* VCMPT = (bf16_t*)(ws + WS_VCMPT); \
    const float* ssq_mix = ssp_base + (size_t)(l_ == 0 ? 0 : 2) * 4 * M; float* ssq_out = ssp_base + (size_t)(1 + 3 * l_) * 4 * M; float* ssq_down = ssp_base + (size_t)(2 + 3 * l_) * 4 * M; float* ssq_d = ssp_base + (size_t)(3 + 3 * l_) * 4 * M; \
    (void)ctl; (void)hb; (void)XB; (void)Y; (void)PB; (void)ACT; (void)cs64; (void)cs32; (void)LRA; (void)LRU_; (void)LA; (void)LH; (void)CIN; (void)KVC; (void)DEC; (void)SST; (void)MQ; (void)MKN; (void)MVT; (void)MKR; (void)VST; (void)VWT; (void)KCMPB; (void)VCMPT; (void)ssq_mix; (void)ssq_out; (void)ssq_down; (void)ssq_d
    unsigned* ctl0 = (unsigned*)(args.ws + WS_CTL);
    { LAUNDER_TID(); if (tid < 16) LCTL[tid] = 0u; }
    __syncthreads();
    const int lo = args.ph_lo, hi = args.ph_hi;
    XcdBarrier bar; bar.bar = ctl0 + CW_BAR; bar.x = 0; bar.st = LCTL;
    if (hi - lo > 1) bar = xcd_barrier_post(ctl0 + CW_BAR, LCTL);
#define IN(k) (lo <= (k) && (k) < hi)
#define SEAM(k) do { if (IN(k) && IN((k) + 1)) xcd_barrier(bar); } while (0)

    if (IN(0)) {
        const int l_ = 0; WS_PTRS();
      _Pragma("unroll 1") for (int rep = 0; rep < REP_P0; ++rep) {
        LAUNDER_TID();
        const int gw = bid * 8 + wave, NGW = G * 8;
        LAS float* scr = ldsf + wave * 4096;
        constexpr int I_IN = 16 * 72, I_OUT = 16 * 32, I_GU = 16 * 176, I_DN = 44 * 32, I_L = I_IN + I_OUT + I_GU + I_DN;
        for (int it = gw; it < 2 * I_L; it += NGW) {
            const int l = it / I_L; int r = it % I_L;
            if (r < I_IN) { p0_transpose_item<0>(inp(args, 3) + (size_t)l * DM * NINS, DM, NINS, inp(args, 2) + l * DM, (bf16_t*)(ws + WS_WIN) + (size_t)l * NIN * DM, scr, r / 72, r % 72, lane); continue; } r -= I_IN;
            if (r < I_OUT) { p0_transpose_item<0, 768>(inp(args, 23) + (size_t)l * DM * DM, DM, DM, inp(args, 22) + l * DM, (bf16_t*)(ws + WS_WOUT) + (size_t)l * DM * DM, scr, r / 32, r % 32, lane); continue; } r -= I_OUT;
            if (r < I_GU) { p0_transpose_item<1>(inp(args, 25) + (size_t)l * DM * NGU, DM, NGU, inp(args, 24) + l * DM, (bf16_t*)(ws + WS_WGU) + (size_t)l * NGU * DM, scr, r / 176, r % 176, lane); continue; } r -= I_GU;
            p0_transpose_item<0>(inp(args, 26) + (size_t)l * FF * DM, FF, DM, nullptr, (bf16_t*)(ws + WS_WDN) + (size_t)l * DM * FF, scr, r / 32, r % 32, lane);
        }
        { constexpr int I_UQ = 3 * 12, I_UKV = 2 * 16, I_W1 = 32 * 8, I_W2 = 4 * 2, I_S = 2 * I_UQ + 2 * I_UKV + 4 * I_W1 + 4 * I_W2;
          for (int it = gw; it < I_S; it += NGW) { int r = it;
              if (r < 2 * I_UQ) { const int l = r / I_UQ; r %= I_UQ; p0_transpose_item<0>(inp(args, 20) + (size_t)l * 192 * 384, 192, 384, inp(args, 18) + l * 192, (bf16_t*)(ws + WS_WUQT) + (size_t)l * 384 * 192, scr, r / 12, r % 12, lane); continue; } r -= 2 * I_UQ;
              if (r < 2 * I_UKV) { const int l = r / I_UKV; r %= I_UKV; p0_transpose_item<0>(inp(args, 21) + (size_t)l * 128 * 512, 128, 512, inp(args, 19) + l * 128, (bf16_t*)(ws + WS_WUKVT) + (size_t)l * 512 * 128, scr, r / 16, r % 16, lane); continue; } r -= 2 * I_UKV;
              if (r < 4 * I_W1) { const int lj = r / I_W1; r %= I_W1; p0_transpose_item<0>(inp(args, 12) + (size_t)lj * 2048 * 256, 2048, 256, nullptr, (bf16_t*)(ws + WS_W1T) + (size_t)lj * 256 * 2048, scr, r / 8, r % 8, lane); continue; } r -= 4 * I_W1;
              { const int lj = r / I_W2; r %= I_W2; p0_transpose_item<0>(inp(args, 14) + (size_t)lj * 256 * 64, 256, 64, nullptr, (bf16_t*)(ws + WS_W2T) + (size_t)lj * 64 * 256, scr, r / 2, r % 2, lane); } } }
        for (int e = bid * NTHR + tid; e < 2 * 2 * 4 * 64 * 64; e += G * NTHR) {
            const int k = e & 63, n = (e >> 6) & 63, h = (e >> 12) & 3, g = (e >> 14) & 1, l = e >> 15;
            ((bf16_t*)(ws + WS_WGT))[e] = f2bf((g == 0 ? inp(args, 6) : inp(args, 8))[(((size_t)l * 4 + h) * 64 + k) * 64 + n]); }
        for (int e = bid * NTHR + tid; e < 512; e += G * NTHR) ((float*)(ws + WS_SP))[e] = log1pf(expf(-inp(args, 10)[e]));
        for (int m = gw; m < M; m += NGW) {
            const f32x4* xr = (const f32x4*)(inp(args, 0) + (size_t)m * DM) + lane;
            f32x4 v[4]; float s = 0.f;
#pragma unroll
            for (int j = 0; j < 4; ++j) { v[j] = xr[64 * j]; s += v[j][0] * v[j][0] + v[j][1] * v[j][1] + v[j][2] * v[j][2] + v[j][3] * v[j][3]; }
            s = wave_sum(s);
            u32x2* o8 = (u32x2*)(XB + (size_t)m * DM) + lane;
#pragma unroll
            for (int j = 0; j < 4; ++j) { u32x2 w; w.x = pk2(v[j][0], v[j][1]); w.y = pk2(v[j][2], v[j][3]); o8[64 * j] = w; }
            if (lane < 4) ssp_base[(size_t)lane * M + m] = lane == 0 ? s : 0.f;
        }
        for (int e = bid * NTHR + tid; e < M * 32; e += G * NTHR) {
            const int m = e >> 5, i = e & 31; const float pos = (float)((const int*)inp(args, 1))[m];
            const float invf = powf(10000.f, -(float)(2 * i) / 64.f); float sn, cs; sincosf(pos * invf, &sn, &cs);
            ((float2*)(ws + WS_CS64))[e] = make_float2(cs, sn);
            if (i < 16) { const float invf2 = powf(10000.f, -(float)(2 * i) / 32.f); sincosf(pos * invf2, &sn, &cs); ((float2*)(ws + WS_CS32))[m * 16 + i] = make_float2(cs, sn); }
        }
        for (int e = bid * NTHR + tid; e < 2 * 2 * 256; e += G * NTHR) {
            const int lj = e >> 8, c = e & 255; float a = inp(args, 13)[e];
            const float* pp = inp(args, 11) + (size_t)lj * 2048; const float* w1 = inp(args, 12) + (size_t)lj * 2048 * 256 + c;
            for (int i = 0; i < 2048; ++i) a += pp[i] * w1[(size_t)i * 256];
            hb[e] = a;
        }
      }
    }
    SEAM(0);

    for (int l = 0; l < 2; ++l) {
        const int pb = 1 + 6 * l;
        if (IN(pb)) {
        const int l_ = l; WS_PTRS();
            pg8::Gemm g{XB, (const bf16_t*)(ws + WS_WIN) + (size_t)l * NIN * DM, M, NIN, DM}; pg8::StaticOrder S; S.init(M, NIN, G, bid);
            pg8::EpiInProj E{PB, NIN, ssq_mix};
            _Pragma("unroll 1") for (int rep = 0; rep < REP_G16; ++rep) pg8::gemm_phase<pg8::EpiInProj, pg8::StaticOrder, true, true>(lds, g, S, E);
        }
        SEAM(pb);
        if (IN(pb + 1)) {
        const int l_ = l; WS_PTRS();
        LAUNDER_TID();
            constexpr int N_J1 = 1024, N_J2 = 512, N_J3 = 512, N_J4 = 512, N_J4B = 128;
            {
            for (int r_ = bid; r_ < N_J4B * REP_J4B; r_ += G) { const int r = r_ % N_J4B;
                    const int j = r & 1, g32 = (r >> 1) & 15, b = r >> 5; const int colb = j == 0 ? C_KC : C_VC; const int r32 = lane & 31, hi = lane >> 5;
                    LAS unsigned char* Tl = lds;
                    LAS unsigned char* Hl = lds + 69632;
                    for (int e = tid; e < 528 * 8; e += NTHR) { const int rr = e >> 3, c8 = e & 7, t = 512 * g32 + rr; u32x4 w = {0u, 0u, 0u, 0u};
                        if (t < SEQ) { const bf16_t* pr = PB + ((size_t)b * SEQ + t) * NIN + colb;
                            if (j == 0) { const u32x4 a = *(const u32x4*)(pr + 8 * (c8 & 3)), c = *(const u32x4*)(pr + 32 + 8 * (c8 & 3)); const float2* cs = cs64 + ((size_t)b * SEQ + t) * 32 + 8 * (c8 & 3);
                                const unsigned au[4] = {a.x, a.y, a.z, a.w}, cu[4] = {c.x, c.y, c.z, c.w}; unsigned ou[4];
#pragma unroll
                                for (int q = 0; q < 4; ++q) { const float2 s0 = cs[2 * q], s1 = cs[2 * q + 1]; const float x1a = bflo(au[q]), x1b = bfhi(au[q]), x2a = bflo(cu[q]), x2b = bfhi(cu[q]);
                                    ou[q] = c8 < 4 ? pk2(x1a * s0.x - x2a * s0.y, x1b * s1.x - x2b * s1.y) : pk2(x2a * s0.x + x1a * s0.y, x2b * s1.x + x1b * s1.y); }
                                w.x = ou[0]; w.y = ou[1]; w.z = ou[2]; w.w = ou[3]; }
                            else w = *(const u32x4*)(pr + 8 * c8); }
                        *(LAS u32x4*)(Tl + rr * 128 + (rr >> 4) * 16 + c8 * 16) = w; }
                    __syncthreads();
                    { const bf16_t* w1t = (const bf16_t*)(ws + WS_W1T) + ((size_t)(l * 2 + j) * 256 + 32 * wave + r32) * 2048 + 8 * hi;
                      f32x16 acc;
#pragma unroll
                      for (int i = 0; i < 16; ++i) acc[i] = 0.f;
#pragma unroll 8
                      for (int kk = 0; kk < 128; ++kk) { const int rowt = 16 * r32 + (kk >> 2);
                          const bf16x8 a = *(const LAS bf16x8*)(Tl + rowt * 128 + (rowt >> 4) * 16 + 32 * (kk & 3) + 16 * hi);
                          const bf16x8 bw = *(const bf16x8*)(w1t + 16 * kk);
                          acc = mfma32(a, bw, acc); }
                      const float hbv = hb[(l * 2 + j) * 256 + 32 * wave + r32];
#pragma unroll
                      for (int i = 0; i < 16; ++i) { const int n = (i & 3) + 8 * (i >> 2) + 4 * hi; *(LAS bf16_t*)(Hl + n * 528 + (32 * wave + r32) * 2) = f2bf(gelu_tanh(acc[i] + hbv)); } }
                    __syncthreads();
                    if (wave < 2) { const bf16_t* w2t = (const bf16_t*)(ws + WS_W2T) + ((size_t)(l * 2 + j) * 64 + 32 * wave + r32) * 256 + 8 * hi;
                      f32x16 acc;
#pragma unroll
                      for (int i = 0; i < 16; ++i) acc[i] = 0.f;
#pragma unroll
                      for (int kk = 0; kk < 16; ++kk) { const bf16x8 a = *(const LAS bf16x8*)(Hl + r32 * 528 + 32 * kk + 16 * hi); const bf16x8 bw = *(const bf16x8*)(w2t + 16 * kk); acc = mfma32(a, bw, acc); }
                      const int dd = 32 * wave + r32;
#pragma unroll
                      for (int g = 0; g < 4; ++g) { const int n0 = 32 * g32 + 8 * g + 4 * hi; float v[4];
#pragma unroll
                          for (int q = 0; q < 4; ++q) v[q] = (n0 + q < 511) ? acc[4 * g + q] : 0.f;
                          if (j == 0) {
#pragma unroll
                              for (int q = 0; q < 4; ++q) KCMPB[((size_t)b * 512 + n0 + q) * 64 + dd] = f2bf(v[q]); }
                          else { u32x2 w; w.x = pk2(v[0], v[1]); w.y = pk2(v[2], v[3]); *(u32x2*)(VCMPT + ((size_t)b * 64 + dd) * 512 + n0) = w; } } }
                    __syncthreads();
            }
            if (bid < N_J3) {
                const int fr = lane & 15, kq = lane >> 4, hh = wave >> 1, odd = wave & 1;
                {
                    bf16x8 bq[3][6];
                    { const bf16_t* wq = (const bf16_t*)(ws + WS_WUQT) + (size_t)l * 384 * 192;
#pragma unroll
                      for (int nt = 0; nt < 3; ++nt)
#pragma unroll
                          for (int ks = 0; ks < 6; ++ks) bq[nt][ks] = *(const bf16x8*)(wq + (size_t)(48 * wave + 16 * nt + fr) * 192 + 32 * ks + 8 * kq); }
                    for (int r_ = bid; r_ < N_J3 * REP_J3; r_ += G) { const int r = r_ % N_J3;
                        const size_t row0 = (size_t)r * 64;
#pragma unroll 1
                        for (int mt = 0; mt < 4; ++mt) {
                            const bf16_t* pa = PB + (row0 + mt * 16 + fr) * NIN;
                            bf16x8 aq[6]; float ssq_ = 0.f;
#pragma unroll
                            for (int ks = 0; ks < 6; ++ks) { aq[ks] = ld8x2(pa + C_DCQ + 32 * ks + 8 * kq);
#pragma unroll
                                for (int e = 0; e < 8; ++e) { const float v = bf2f((bf16_t)aq[ks][e]); ssq_ += v * v; } }
                            ssq_ += __shfl_xor(ssq_, 16); ssq_ += __shfl_xor(ssq_, 32);
                            const float rq_ = rsqrtf(ssq_ * (1.f / 192.f) + EPS);
                            f32x4 cq[3];
#pragma unroll
                            for (int nt = 0; nt < 3; ++nt) { cq[nt] = (f32x4){0.f, 0.f, 0.f, 0.f};
#pragma unroll
                                for (int ks = 0; ks < 6; ++ks) cq[nt] = __builtin_amdgcn_mfma_f32_16x16x32_bf16(aq[ks], bq[nt][ks], cq[nt], 0, 0, 0); }
                            const float SCQ = 0.10206207261596575f * LOG2E;
#pragma unroll
                            for (int i = 0; i < 4; ++i) {
                                const size_t row = row0 + mt * 16 + 4 * kq + i; const float rqi = __shfl(rq_, 4 * kq + i) * SCQ;
                                float q0 = cq[0][i] * rqi, q1 = cq[1][i] * rqi, q2 = cq[2][i] * rqi;
                                if (odd) { const float2 cs = cs32[row * 16 + fr]; const float x1 = q1, x2 = q2; q1 = x1 * cs.x - x2 * cs.y; q2 = x2 * cs.x + x1 * cs.y; }
                                bf16_t* mq = MQ + row * 384 + hh * 96 + 48 * odd + fr; mq[0] = f2bf(q0); mq[16] = f2bf(q1); mq[32] = f2bf(q2);
                            }
                            if (wave == mt) {
#pragma unroll
                                for (int q = 0; q < 4; ++q) { const int p = lane * 4 + q, tok = p >> 4, i = p & 15; const size_t row = row0 + mt * 16 + tok; const bf16_t* pr = PB + row * NIN + C_DKR;
                                    const float x1 = bf2f(pr[i]), x2 = bf2f(pr[16 + i]); const float2 cs = cs32[row * 16 + i];
                                    MKR[row * 32 + i] = f2bf(x1 * cs.x - x2 * cs.y); MKR[row * 32 + 16 + i] = f2bf(x2 * cs.x + x1 * cs.y); } }
                        }
                    }
                }
                {
                    bf16x8 bkv[4][4];
                    { const bf16_t* wkv = (const bf16_t*)(ws + WS_WUKVT) + (size_t)l * 512 * 128;
#pragma unroll
                      for (int nt = 0; nt < 4; ++nt)
#pragma unroll
                          for (int ks = 0; ks < 4; ++ks) bkv[nt][ks] = *(const bf16x8*)(wkv + (size_t)(64 * wave + 16 * nt + fr) * 128 + 32 * ks + 8 * kq); }
                    for (int r_ = bid; r_ < N_J3 * REP_J3; r_ += G) { const int r = r_ % N_J3;
                        const size_t row0 = (size_t)r * 64; const size_t bb = row0 / SEQ, t0 = row0 % SEQ;
#pragma unroll 1
                        for (int mt = 0; mt < 4; ++mt) {
                            const bf16_t* pa = PB + (row0 + mt * 16 + fr) * NIN;
                            bf16x8 akv[4]; float sskv_ = 0.f;
#pragma unroll
                            for (int ks = 0; ks < 4; ++ks) { akv[ks] = ld8x2(pa + C_DCKV + 32 * ks + 8 * kq);
#pragma unroll
                                for (int e = 0; e < 8; ++e) { const float v = bf2f((bf16_t)akv[ks][e]); sskv_ += v * v; } }
                            sskv_ += __shfl_xor(sskv_, 16); sskv_ += __shfl_xor(sskv_, 32);
                            const float rk_ = rsqrtf(sskv_ * (1.f / 128.f) + EPS);
                            f32x4 ckv[4];
#pragma unroll
                            for (int nt = 0; nt < 4; ++nt) { ckv[nt] = (f32x4){0.f, 0.f, 0.f, 0.f};
#pragma unroll
                                for (int ks = 0; ks < 4; ++ks) ckv[nt] = __builtin_amdgcn_mfma_f32_16x16x32_bf16(akv[ks], bkv[nt][ks], ckv[nt], 0, 0, 0); }
                            float rki[4];
#pragma unroll
                            for (int i = 0; i < 4; ++i) rki[i] = __shfl(rk_, 4 * kq + i);
                            if (!odd) {
#pragma unroll
                                for (int i = 0; i < 4; ++i) { bf16_t* mk = MKN + (row0 + mt * 16 + 4 * kq + i) * 256 + hh * 64 + fr;
                                    mk[0] = f2bf(ckv[0][i] * rki[i]); mk[16] = f2bf(ckv[1][i] * rki[i]); mk[32] = f2bf(ckv[2][i] * rki[i]); mk[48] = f2bf(ckv[3][i] * rki[i]); } }
                            else {
#pragma unroll
                                for (int nt = 0; nt < 4; ++nt) { u32x2 w; w.x = pk2(ckv[nt][0] * rki[0], ckv[nt][1] * rki[1]); w.y = pk2(ckv[nt][2] * rki[2], ckv[nt][3] * rki[3]);
                                    *(u32x2*)(MVT + ((bb * 4 + hh) * 64 + 16 * nt + fr) * SEQ + t0 + mt * 16 + 4 * kq) = w; } }
                        }
                    }
                }
            }
            {
                const int r32 = lane & 31, hi = lane >> 5, gh = wave >> 1, gg = wave & 1, ch = tid & 255, half = tid >> 8;
                bf16x8 bW[2][4];
                { const bf16_t* wt = (const bf16_t*)(ws + WS_WGT) + (size_t)(((l * 2 + gg) * 4 + gh) * 64) * 64;
#pragma unroll
                  for (int nt = 0; nt < 2; ++nt)
#pragma unroll
                      for (int ks = 0; ks < 4; ++ks) bW[nt][ks] = *(const bf16x8*)(wt + (size_t)(32 * nt + r32) * 64 + 16 * ks + 8 * hi); }
                const float gbias0 = (gg == 0 ? inp(args, 7) : inp(args, 9))[l * 256 + gh * 64 + r32], gbias1 = (gg == 0 ? inp(args, 7) : inp(args, 9))[l * 256 + gh * 64 + 32 + r32];
                const float cw0 = inp(args, 4)[(l * 4 + 0) * 256 + ch], cw1 = inp(args, 4)[(l * 4 + 1) * 256 + ch], cw2 = inp(args, 4)[(l * 4 + 2) * 256 + ch], cw3 = inp(args, 4)[(l * 4 + 3) * 256 + ch], cb = inp(args, 5)[l * 256 + ch];
                const float sp = ((const float*)(ws + WS_SP))[l * 256 + ch];
                LAS float* xa = ldsf; LAS float* xc = ldsf + 35 * 256; LAS unsigned char* xcb = lds + 67 * 1024; LAS float* gR = (LAS float*)(lds + 67 * 1024 + 32 * 528); LAS float* gI = gR + 32 * 256;
            for (int r_ = bid; r_ < N_J1 * REP_J1; r_ += G) { const int r = r_ % N_J1;
                    const int b = r >> 8, tb = r & 255, t0 = tb * 32;
                    for (int c = tid; c < 35 * 32; c += NTHR) { const int rr = c >> 5, c8 = c & 31, t = t0 - 3 + rr; u32x4 w = {0u, 0u, 0u, 0u}; if (t >= 0) w = *(const u32x4*)(PB + ((size_t)b * SEQ + t) * NIN + C_AX + 8 * c8);
                        LAS f32x4* d = (LAS f32x4*)(xa + rr * 256 + 8 * c8); d[0] = (f32x4){bflo(w.x), bfhi(w.x), bflo(w.y), bfhi(w.y)}; d[1] = (f32x4){bflo(w.z), bfhi(w.z), bflo(w.w), bfhi(w.w)}; }
                    __syncthreads();
#pragma unroll 4
                    for (int tt = 0; tt < 16; ++tt) { const int rr = half * 16 + tt; const float v = cb + cw0 * xa[rr * 256 + ch] + cw1 * xa[(rr + 1) * 256 + ch] + cw2 * xa[(rr + 2) * 256 + ch] + cw3 * xa[(rr + 3) * 256 + ch];
                        xc[rr * 256 + ch] = v; *(LAS bf16_t*)(xcb + rr * 528 + ch * 2) = f2bf(v); }
                    __syncthreads();
                    { f32x16 acc[2];
#pragma unroll
                      for (int i = 0; i < 16; ++i) { acc[0][i] = 0.f; acc[1][i] = 0.f; }
#pragma unroll
                      for (int ks = 0; ks < 4; ++ks) { const bf16x8 a = *(const LAS bf16x8*)(xcb + r32 * 528 + (gh * 64 + 16 * ks + 8 * hi) * 2); acc[0] = mfma32(a, bW[0][ks], acc[0]); acc[1] = mfma32(a, bW[1][ks], acc[1]); }
                      LAS float* gd = gg == 0 ? gR : gI;
#pragma unroll
                      for (int i = 0; i < 16; ++i) { const int tok = (i & 3) + 8 * (i >> 2) + 4 * hi; gd[tok * 256 + gh * 64 + r32] = sigmoidf_(acc[0][i] + gbias0); gd[tok * 256 + gh * 64 + 32 + r32] = sigmoidf_(acc[1][i] + gbias1); } }
                    __syncthreads();
                    float hst = 0.f, Ac = 1.f;
#pragma unroll 4
                    for (int tt = 0; tt < 16; ++tt) {
                        const int rr = half * 16 + tt;
                        const float la = -8.f * gR[rr * 256 + ch] * sp, x2 = 2.f * la;
                        const float av = la > -0.25f ? 1.f + la * (1.f + la * (0.5f + la * (0.16666667f + la * (0.041666667f + la * 0.0083333333f)))) : __expf(la);
                        const float om = x2 > -0.5f ? -x2 * (1.f + x2 * (0.5f + x2 * (0.16666667f + x2 * (0.041666667f + x2 * (0.0083333333f + x2 * 0.0013888889f))))) : 1.f - __expf(x2);
                        const float u = __builtin_amdgcn_sqrtf(om) * (gI[rr * 256 + ch] * xc[rr * 256 + ch]);
                        hst = av * hst + u; Ac *= av;
                        { const size_t ao = ((size_t)b * SEQ + t0 + rr) * 256 + ch; LRA[ao] = av; LRU_[ao] = u; }
                    }
                    const size_t so = ((size_t)(b * 512 + tb * 2 + half)) * 256 + ch;
                    LA[so] = Ac; LH[so] = hst;
                    __syncthreads();
            }
            }
            {
                const int kk = tid & 127, tq = tid >> 7, r32 = lane & 31, hi = lane >> 5;
                float wg[16]; const float bg = inp(args, 16)[l * 128 + kk];
#pragma unroll
                for (int q = 0; q < 16; ++q) wg[q] = inp(args, 15)[(l * 16 + q) * 128 + kk];
                LAS float* glr = ldsf; LAS float* tot = ldsf + 1024; LAS unsigned char* KTl = lds + 8192; LAS unsigned char* VTl = lds + 8192 + 128 * VSTR;
                float* BCS = (float*)(ws + WS_BCS);
            for (int r_ = bid; r_ < N_J2 * REP_J2; r_ += G) { const int r = r_ % N_J2;
                    const int b = r >> 7, c = r & 127; const size_t row0 = (size_t)b * SEQ + 64 * c;
                    for (int e = tid; e < 1024; e += NTHR) glr[e] = bf2f(PB[(row0 + (e >> 4)) * NIN + C_GLR + (e & 15)]);
                    for (int e = tid; e < 2048; e += NTHR) { const int jj = e >> 5, hc = e & 31; const bf16_t* vsrc = PB + (row0 + jj) * NIN + C_CV + 8 * hc; const u32x2 wA = *(const u32x2*)vsrc, wB = *(const u32x2*)(vsrc + 4);
                        LAS bf16_t* d = (LAS bf16_t*)(VTl + (8 * hc) * VSTR) + jj;
                        d[0] = (bf16_t)wA.x; d[VSTR / 2] = (bf16_t)(wA.x >> 16); d[2 * (VSTR / 2)] = (bf16_t)wA.y; d[3 * (VSTR / 2)] = (bf16_t)(wA.y >> 16); d[4 * (VSTR / 2)] = (bf16_t)wB.x; d[5 * (VSTR / 2)] = (bf16_t)(wB.x >> 16); d[6 * (VSTR / 2)] = (bf16_t)wB.y; d[7 * (VSTR / 2)] = (bf16_t)(wB.y >> 16); }
                    __syncthreads();
                    float bv[16]; float run = 0.f;
#pragma unroll
                    for (int tt = 0; tt < 16; ++tt) { const LAS f32x4* g4 = (const LAS f32x4*)(glr + (16 * tq + tt) * 16); float z = bg;
#pragma unroll
                        for (int q = 0; q < 4; ++q) { const f32x4 g = g4[q]; z += g[0] * wg[4 * q] + g[1] * wg[4 * q + 1] + g[2] * wg[4 * q + 2] + g[3] * wg[4 * q + 3]; }
                        run += (fminf(z, 0.f) - __logf(1.f + __expf(-fabsf(z)))) * (1.f / 16.f); bv[tt] = run; }
                    tot[tq * 128 + kk] = run;
                    __syncthreads();
                    { const float t0_ = tot[kk], t1_ = tot[128 + kk], t2_ = tot[256 + kk], t3_ = tot[384 + kk]; const float off = tq == 0 ? 0.f : (tq == 1 ? t0_ : (tq == 2 ? t0_ + t1_ : (t0_ + t1_) + t2_)), blast = ((t0_ + t1_) + t2_) + t3_;
#pragma unroll
                      for (int tt = 0; tt < 16; ++tt) { const int t = 16 * tq + tt; const float bt = bv[tt] + off; BCS[(row0 + t) * 128 + kk] = bt;
                          *((LAS bf16_t*)(KTl + kk * VSTR) + t) = f2bf(bf2f(PB[(row0 + t) * NIN + C_CK + kk]) * __expf(blast - bt)); }
                      if (tq == 0) DEC[(size_t)(b * 128 + c) * 128 + kk] = __expf(blast); }
                    __syncthreads();
                    { const int h = wave >> 1, nt = wave & 1; f32x16 acc;
#pragma unroll
                      for (int i = 0; i < 16; ++i) acc[i] = 0.f;
                      const LAS unsigned char* ap = KTl + (h * 32 + r32) * VSTR + 16 * hi; const LAS unsigned char* bp = VTl + (h * 64 + 32 * nt + r32) * VSTR + 16 * hi;
#pragma unroll
                      for (int s = 0; s < 4; ++s) { const u32x2 a0 = *(const LAS u32x2*)(ap + 32 * s), a1 = *(const LAS u32x2*)(ap + 32 * s + 8), b0 = *(const LAS u32x2*)(bp + 32 * s), b1 = *(const LAS u32x2*)(bp + 32 * s + 8);
                          u32x4 aw, bw; aw.x = a0.x; aw.y = a0.y; aw.z = a1.x; aw.w = a1.y; bw.x = b0.x; bw.y = b0.y; bw.z = b1.x; bw.w = b1.y;
                          acc = mfma32(__builtin_bit_cast(bf16x8, aw), __builtin_bit_cast(bf16x8, bw), acc); }
                      float* o = KVC + ((size_t)(b * 128 + c) * 4 + h) * 2048 + 32 * nt + r32;
#pragma unroll
                      for (int i = 0; i < 16; ++i) o[((i & 3) + 8 * (i >> 2) + 4 * hi) * 64] = acc[i]; }
                    __syncthreads();
            }
            }
            for (int r = bid; r < N_J4; r += G) {
                    const size_t row0 = (size_t)r * 64;
#pragma unroll
                    for (int it3 = 0; it3 < 3; ++it3) {
                        const int e = tid + it3 * NTHR, tok = e / 24, p = e % 24, hd = p >> 2, c8 = p & 3; const int base = hd < 4 ? C_BQ + hd * 64 : (hd == 4 ? C_KS : C_KW); const float sc = hd < 4 ? 0.125f * LOG2E : 1.f;
                        bf16_t* pr = PB + (row0 + tok) * NIN + base + 8 * c8; const u32x4 a = *(const u32x4*)pr, c = *(const u32x4*)(pr + 32); const float2* cs = cs64 + (row0 + tok) * 32 + 8 * c8;
                        const unsigned au[4] = {a.x, a.y, a.z, a.w}, cu[4] = {c.x, c.y, c.z, c.w}; unsigned o1[4], o2[4];
#pragma unroll
                        for (int q = 0; q < 4; ++q) { const float2 s0 = cs[2 * q], s1 = cs[2 * q + 1]; const float x1a = bflo(au[q]), x1b = bfhi(au[q]), x2a = bflo(cu[q]), x2b = bfhi(cu[q]);
                            o1[q] = pk2((x1a * s0.x - x2a * s0.y) * sc, (x1b * s1.x - x2b * s1.y) * sc); o2[q] = pk2((x2a * s0.x + x1a * s0.y) * sc, (x2b * s1.x + x1b * s1.y) * sc); }
                        u32x4 w1, w2; w1.x = o1[0]; w1.y = o1[1]; w1.z = o1[2]; w1.w = o1[3]; w2.x = o2[0]; w2.y = o2[1]; w2.z = o2[2]; w2.w = o2[3];
                        *(u32x4*)pr = w1; *(u32x4*)(pr + 32) = w2;
                        if (hd == 4) {
                            bf16_t* kf_ = KSF + (row0 / 64) * 4096 + (size_t)((((tok >> 5) * 4 + (c8 >> 1)) * 64 + (c8 & 1) * 32 + (tok & 31)) * 8); *(u32x4*)kf_ = w1; *(u32x4*)(kf_ + 2 * 64 * 8) = w2; } }
                    { LAS bf16_t* tl = (LAS bf16_t*)lds; const size_t bb = row0 / SEQ, t0 = row0 % SEQ;
                      for (int mtx = 0; mtx < 2; ++mtx) { const int tok = tid >> 3, c = tid & 7; const u32x4 w = *(const u32x4*)(PB + (row0 + tok) * NIN + (mtx ? C_VW : C_VS) + c * 8);
                          LAS bf16_t* dst = tl + mtx * 64 * 72 + tok * 72 + c * 8; dst[0] = (bf16_t)w.x; dst[1] = (bf16_t)(w.x >> 16); dst[2] = (bf16_t)w.y; dst[3] = (bf16_t)(w.y >> 16); dst[4] = (bf16_t)w.z; dst[5] = (bf16_t)(w.z >> 16); dst[6] = (bf16_t)w.w; dst[7] = (bf16_t)(w.w >> 16); }
                      __syncthreads();
                      for (int mtx = 0; mtx < 2; ++mtx) { const int d = tid >> 3, c8 = tid & 7; const LAS bf16_t* s = tl + mtx * 64 * 72 + (c8 * 8) * 72 + d;
                          u32x4 w; w.x = (unsigned)s[0] | ((unsigned)s[72] << 16); w.y = (unsigned)s[2 * 72] | ((unsigned)s[3 * 72] << 16); w.z = (unsigned)s[4 * 72] | ((unsigned)s[5 * 72] << 16); w.w = (unsigned)s[6 * 72] | ((unsigned)s[7 * 72] << 16);
                          if (mtx) *(u32x4*)(VWT + (bb * 64 + d) * SEQ + t0 + c8 * 8) = w;
                          else { const int s_ = c8 >> 1, h_ = c8 & 1; const LAS bf16_t* q = tl + (16 * s_ + 4 * h_) * 72 + d;
                              u32x4 f; f.x = (unsigned)q[0] | ((unsigned)q[72] << 16); f.y = (unsigned)q[2 * 72] | ((unsigned)q[3 * 72] << 16); f.z = (unsigned)q[8 * 72] | ((unsigned)q[9 * 72] << 16); f.w = (unsigned)q[10 * 72] | ((unsigned)q[11 * 72] << 16);
                              *(u32x4*)(VST + (row0 / 64) * 4096 + (size_t)((((d >> 5) * 4 + s_) * 64 + h_ * 32 + (d & 31)) * 8)) = f; } }
                      __syncthreads(); }
            }
            }
        }
        SEAM(pb + 1);
        if (IN(pb + 2)) {
        const int l_ = l; WS_PTRS();
        LAUNDER_TID();
            constexpr int Q_J5 = 2, Q_J6 = 64, Q_ATT = 1024 * REP_ATT, Q_J9 = 1024, Q_J10 = 512, Q_TOT = Q_J5 + Q_J6 + Q_ATT + Q_J9 + Q_J10;
            if (tid == 0) { LCTL[4] = 0u; LCTL[5] = 0u; }
            __syncthreads();
            const int tid_o = tid;
            for (;;) {
                int tid = tid_o; asm volatile("" : "+v"(tid)); const int lane = tid & 63;
                if (tid == 0) LCTL[2] = __hip_atomic_fetch_add(ctl + CW_QUEUE + 64 * l, 1u, __ATOMIC_RELAXED, __HIP_MEMORY_SCOPE_AGENT);
                __syncthreads();
                int r = __builtin_amdgcn_readfirstlane((int)LCTL[2]); const unsigned seen5 = LCTL[4], seen6 = LCTL[5];
                __syncthreads();
                if (r >= Q_TOT * REP_P3) break;
                if (REP_P3 > 1 && r >= Q_TOT) r -= Q_TOT;
                if (r < Q_J5) {
                    const int e = r * NTHR + tid, b = e >> 8, ch = e & 255; float carry = 0.f;
                    for (int c0 = 0; c0 < 512; c0 += 8) { float av[8], hv[8];
#pragma unroll
                        for (int q = 0; q < 8; ++q) { const size_t so = ((size_t)(b * 512 + c0 + q)) * 256 + ch; av[q] = LA[so]; hv[q] = LH[so]; }
#pragma unroll
                        for (int q = 0; q < 8; ++q) { CIN[((size_t)(b * 512 + c0 + q)) * 256 + ch] = carry; carry = av[q] * carry + hv[q]; } }
                    asm volatile("s_waitcnt vmcnt(0)" ::: "memory"); __syncthreads();
                    if (tid == 0) { __builtin_amdgcn_fence(__ATOMIC_RELEASE, "agent"); asm volatile("s_waitcnt vmcnt(0)" ::: "memory"); (void)xb_add(ctl + CW_FLAG + 64 * (2 * l + 0), 1u); }
                    continue;
                }
                r -= Q_J5;
                if (r < Q_J6) {
                    const int e = r * NTHR + tid, b = e >> 13, rem = e & 8191; float Sv = 0.f;
                    for (int c0 = 0; c0 < 128; c0 += 8) { float kv[8], dv[8];
#pragma unroll
                        for (int q = 0; q < 8; ++q) { kv[q] = KVC[(size_t)(b * 128 + c0 + q) * 8192 + rem]; dv[q] = DEC[(size_t)(b * 128 + c0 + q) * 128 + (rem >> 6)]; }
#pragma unroll
                        for (int q = 0; q < 8; ++q) { SST[(size_t)(b * 128 + c0 + q) * 8192 + rem] = Sv; Sv = dv[q] * Sv + kv[q]; } }
                    asm volatile("s_waitcnt vmcnt(0)" ::: "memory"); __syncthreads();
                    if (tid == 0) { __builtin_amdgcn_fence(__ATOMIC_RELEASE, "agent"); asm volatile("s_waitcnt vmcnt(0)" ::: "memory"); (void)xb_add(ctl + CW_FLAG + 64 * (2 * l + 1), 1u); }
                    continue;
                }
                r -= Q_J6;
                if (r >= Q_ATT) {
                    r -= Q_ATT; const bool is9 = r < Q_J9;
                    if (!(is9 ? seen5 : seen6)) {
                        if (tid == 0) { unsigned* f = ctl + CW_FLAG + 64 * (2 * l + (is9 ? 0 : 1)); const unsigned target = is9 ? (unsigned)Q_J5 : (unsigned)Q_J6;
                            XB_SPIN(xb_ld(f) < target, ctl + CW_BAR); __builtin_amdgcn_fence(__ATOMIC_ACQUIRE, "agent"); asm volatile("s_waitcnt vmcnt(0)" ::: "memory"); LCTL[is9 ? 4 : 5] = 1u; }
                        __syncthreads(); }
                    if (is9) {
                    const int b = r >> 8, tb = r & 255, t0 = tb * 32, ch = tid & 255, half = tid >> 8;
                    LAS float* xa = ldsf;
                    float hst = CIN[((size_t)(b * 512 + tb * 2 + half)) * 256 + ch];
                    { float av[16], uv[16], gv[16];
#pragma unroll
                      for (int tt = 0; tt < 16; ++tt) { const size_t ro = (size_t)b * SEQ + t0 + half * 16 + tt; av[tt] = LRA[ro * 256 + ch]; uv[tt] = LRU_[ro * 256 + ch]; gv[tt] = bf2f(PB[ro * NIN + C_AG + ch]); }
#pragma unroll
                      for (int tt = 0; tt < 16; ++tt) { hst = av[tt] * hst + uv[tt]; xa[(half * 16 + tt) * 256 + ch] = hst * gelu_tanh(gv[tt]); } }
                    __syncthreads();
                    for (int q = 0; q < 4; ++q) { const int rr = wave * 4 + q; const f32x4 v = ((const LAS f32x4*)(xa + rr * 256))[lane];
                        const float rinv = rsqrtf(wave_sum(v[0] * v[0] + v[1] * v[1] + v[2] * v[2] + v[3] * v[3]) * (1.f / 256.f) + EPS);
                        u32x2 w; w.x = pk2(v[0] * rinv, v[1] * rinv); w.y = pk2(v[2] * rinv, v[3] * rinv);
                        *(u32x2*)(Y + ((size_t)b * SEQ + t0 + rr) * DM + 256 + 4 * lane) = w; }
                    __syncthreads();
                    } else { r -= Q_J9;
                    const int b = r >> 7, c = r & 127; const size_t row0 = (size_t)b * SEQ + 64 * c;
                    LAS float* bL = ldsf; LAS float* glr = ldsf + 8192; LAS unsigned char* VTl = lds + 36864; LAS unsigned char* STl = lds + 71680; LAS float* SSX = (LAS float*)(lds + 92160);
                    for (int e = tid; e < 2048; e += NTHR) ((LAS f32x4*)bL)[e] = ((const f32x4*)((const float*)(ws + WS_BCS) + row0 * 128))[e];
                    for (int e = tid; e < 2048; e += NTHR) { const int jj = e >> 5, hc = e & 31, h = hc >> 3, c8 = hc & 7; const bf16_t* vsrc = PB + (row0 + jj) * NIN + C_CV + h * 64 + 8 * c8; const u32x2 wA = *(const u32x2*)vsrc, wB = *(const u32x2*)(vsrc + 4); u32x4 w; w.x = wA.x; w.y = wA.y; w.z = wB.x; w.w = wB.y;
                        LAS bf16_t* d = (LAS bf16_t*)(VTl + h * 8704 + (8 * c8) * VSTR) + jj;
                        d[0] = (bf16_t)w.x; d[VSTR / 2] = (bf16_t)(w.x >> 16); d[2 * (VSTR / 2)] = (bf16_t)w.y; d[3 * (VSTR / 2)] = (bf16_t)(w.y >> 16); d[4 * (VSTR / 2)] = (bf16_t)w.z; d[5 * (VSTR / 2)] = (bf16_t)(w.z >> 16); d[6 * (VSTR / 2)] = (bf16_t)w.w; d[7 * (VSTR / 2)] = (bf16_t)(w.w >> 16); }
                    for (int e = tid; e < 8192; e += NTHR) { const int h = e >> 11, k = (e >> 6) & 31, v = e & 63; *(LAS bf16_t*)(STl + h * 5120 + v * 80 + k * 2) = f2bf(SST[(size_t)(b * 128 + c) * 8192 + e]); }
                    __syncthreads();
                    { const int r32 = lane & 31, hi = lane >> 5, h = wave >> 1, ih = wave & 1, i = 32 * ih + r32; const float SCG = 0.17677669529663687f;
                      bf16x8 qrel[2], qabs[2], kt[2][2];
#pragma unroll
                      for (int ks = 0; ks < 2; ++ks) { const int k0 = h * 32 + 16 * ks + 8 * hi; const bf16x8 qv = ld8x2(PB + (row0 + i) * NIN + C_CQ + k0); u32x4 wr_, wa_; unsigned* pr_ = (unsigned*)&wr_; unsigned* pa_ = (unsigned*)&wa_;
#pragma unroll
                          for (int e2 = 0; e2 < 4; ++e2) { const float b0 = bL[i * 128 + k0 + 2 * e2], b1 = bL[i * 128 + k0 + 2 * e2 + 1], f0 = bL[31 * 128 + k0 + 2 * e2], f1 = bL[31 * 128 + k0 + 2 * e2 + 1];
                              const float q0 = bf2f((bf16_t)qv[2 * e2]) * SCG, q1 = bf2f((bf16_t)qv[2 * e2 + 1]) * SCG;
                              pr_[e2] = cvtpk(q0 * __expf(b0 - f0), q1 * __expf(b1 - f1)); pa_[e2] = cvtpk(q0 * __expf(b0), q1 * __expf(b1)); }
                          qrel[ks] = __builtin_bit_cast(bf16x8, wr_); qabs[ks] = __builtin_bit_cast(bf16x8, wa_); }
#pragma unroll
                      for (int jt = 0; jt < 2; ++jt)
#pragma unroll
                          for (int ks = 0; ks < 2; ++ks) { const int jr = 32 * jt + r32, k0 = h * 32 + 16 * ks + 8 * hi; const bf16x8 kv = ld8x2(PB + (row0 + jr) * NIN + C_CK + k0); u32x4 wk_; unsigned* pk_ = (unsigned*)&wk_;
#pragma unroll
                              for (int e2 = 0; e2 < 4; ++e2) { const float b0 = bL[jr * 128 + k0 + 2 * e2], b1 = bL[jr * 128 + k0 + 2 * e2 + 1], f0 = bL[31 * 128 + k0 + 2 * e2], f1 = bL[31 * 128 + k0 + 2 * e2 + 1];
                                  pk_[e2] = cvtpk(bf2f((bf16_t)kv[2 * e2]) * __expf(f0 - b0), bf2f((bf16_t)kv[2 * e2 + 1]) * __expf(f1 - b1)); }
                              kt[jt][ks] = __builtin_bit_cast(bf16x8, wk_); }
                      f32x16 o[2], s[2];
#pragma unroll
                      for (int q = 0; q < 16; ++q) { o[0][q] = 0.f; o[1][q] = 0.f; s[0][q] = 0.f; s[1][q] = 0.f; }
#pragma unroll
                      for (int ks = 0; ks < 2; ++ks) s[0] = mfma32(kt[0][ks], qrel[ks], s[0]);
                      if (ih) {
#pragma unroll
                          for (int ks = 0; ks < 2; ++ks) s[1] = mfma32(kt[1][ks], qrel[ks], s[1]); }
#pragma unroll
                      for (int q = 0; q < 16; ++q) { const int jr = (q & 3) + 8 * (q >> 2) + 4 * hi; if (jr > r32) { if (ih) s[1][q] = 0.f; else s[0][q] = 0.f; } }
                      const LAS unsigned char* VTh = VTl + h * 8704; const LAS unsigned char* STh = STl + h * 5120;
#pragma unroll
                      for (int dt = 0; dt < 2; ++dt) { const LAS unsigned char* vp = VTh + (32 * dt + r32) * VSTR + 8 * hi;
                          o[dt] = mfma32(vfrag(vp), pack8<0>(s[0]), o[dt]); o[dt] = mfma32(vfrag(vp + 32), pack8<8>(s[0]), o[dt]);
                          if (ih) { o[dt] = mfma32(vfrag(vp + 64), pack8<0>(s[1]), o[dt]); o[dt] = mfma32(vfrag(vp + 96), pack8<8>(s[1]), o[dt]); }
#pragma unroll
                          for (int ks = 0; ks < 2; ++ks) o[dt] = mfma32(*(const LAS bf16x8*)(STh + (32 * dt + r32) * 80 + 32 * ks + 16 * hi), qabs[ks], o[dt]); }
                      float ssh = 0.f;
#pragma unroll
                      for (int q = 0; q < 16; ++q) ssh += o[0][q] * o[0][q] + o[1][q] * o[1][q];
                      const float rh = rsqrtf(xhalf_sum(ssh) * (1.f / 64.f) + EPS); float ssg = 0.f;
#pragma unroll
                      for (int dt = 0; dt < 2; ++dt)
#pragma unroll
                          for (int g = 0; g < 4; ++g) { const int v0 = 32 * dt + 8 * g + 4 * hi; const u32x2 ogw = *(const u32x2*)(PB + (row0 + i) * NIN + C_OG + h * 64 + v0); const f32x4 gn = *(const f32x4*)(inp(args, 17) + l * 64 + v0);
                              const float og4[4] = {bflo(ogw.x), bfhi(ogw.x), bflo(ogw.y), bfhi(ogw.y)};
#pragma unroll
                              for (int q = 0; q < 4; ++q) { const float y = o[dt][4 * g + q] * rh * gn[q] * (og4[q] / (1.f + __expf(-og4[q]))); o[dt][4 * g + q] = y; ssg += y * y; } }
                      ssg = xhalf_sum(ssg); if (hi == 0) SSX[i * 4 + h] = ssg;
                      __syncthreads();
                      const f32x4 s4 = *(const LAS f32x4*)(SSX + i * 4); const float rinv = rsqrtf((s4[0] + s4[1] + s4[2] + s4[3]) * (1.f / 256.f) + EPS);
#pragma unroll
                      for (int dt = 0; dt < 2; ++dt)
#pragma unroll
                          for (int g = 0; g < 4; ++g) { u32x2 w; w.x = cvtpk(o[dt][4 * g] * rinv, o[dt][4 * g + 1] * rinv); w.y = cvtpk(o[dt][4 * g + 2] * rinv, o[dt][4 * g + 3] * rinv);
                              *(u32x2*)(Y + (row0 + i) * DM + 768 + h * 64 + 32 * dt + 8 * g + 4 * hi) = w; } }
                    __syncthreads();
                    }
                    continue;
                }
                const int r32 = lane & 31, hi = lane >> 5;
                const int rep = r >> 10; r &= 1023;
                const int grp = r >> 5, within = r & 31;
                if (rep && ((REP_ONLY == 1 && within >= 16) || (REP_ONLY == 2 && within < 16))) continue;
              {
                if (within >= 16) {
                    const int idx = within - 16, b = idx & 3, tb = 127 - (4 * grp + (idx >> 2));
                    const int tl = 8 * wave + (r32 >> 2), head = r32 & 3, T = 64 * tb + tl; const size_t row = (size_t)b * SEQ + T; const bf16_t* prow = PB + row * NIN;
                    bf16x8 qf[4];
#pragma unroll
                    for (int ks = 0; ks < 4; ++ks) qf[ks] = *(const bf16x8*)(prow + C_BQ + head * 64 + 16 * ks + 8 * hi);
                    LAS float* impb = (LAS float*)(lds + AL_IMP) + wave * 1024; LAS unsigned* selm = (LAS unsigned*)(lds + AL_SELM) + wave * 32;
                    const int skey = tid >> 3, sch = tid & 7;
                    const unsigned koffP = (unsigned)(skey * NIN + sch * 8), voffS = (unsigned)(skey * SEQ + sch * 8), koffC = (unsigned)(skey * 64 + sch * 8), voffC = (unsigned)(skey * 512 + sch * 8);
                    auto stK = [&](int buf, const StageRegs& R) __attribute__((always_inline)) { *(LAS u32x4*)(lds + (buf ? AL_K1 : AL_K0) + skey * KSTR + sch * 16) = R.a; };
                    auto stKV = [&](int buf, const StageRegs& R) __attribute__((always_inline)) { *(LAS u32x4*)(lds + (buf ? AL_K1 : AL_K0) + skey * KSTR + sch * 16) = R.a;
                        LAS unsigned char* vd = lds + (buf ? AL_V1 : AL_V0) + skey * VSTR + sch * 16; u32x2 a, c; a.x = R.b.x; a.y = R.b.y; c.x = R.b.z; c.y = R.b.w; *(LAS u32x2*)vd = a; *(LAS u32x2*)(vd + 8) = c; };
                    f32x16 oacc[2], ob[2];
                    const int nv = T >= 31 ? ((T - 31) >> 4) + 1 : 0, ntc = (4 * tb + 3 + 63) >> 6;
                    float mC = NEGB, lC = 0.f;
                    { const bf16_t* kb_ = KCMPB + (size_t)b * 512 * 64;
                      attn_pipeline(0, ntc - 1, [&](int j, StageRegs& R) __attribute__((always_inline)) { R.a = *(const u32x4*)((kb_ + (size_t)j * 64 * 64) + koffC); }, stK,
                        [&](int j, int cb) __attribute__((always_inline)) { f32x16 s0, s1; qk_tile<4>(lds + (cb ? AL_K1 : AL_K0), qf, r32, hi, s0, s1); mask_tile(s0, s1, 0, nv - 1 - 64 * j, hi);
                            const float mx = tile_max(s0, s1), mn = fmaxf(mC, mx), ms = mn < -1e29f ? 0.f : mn, alpha = ex2(mC - ms); mC = mn; float ps = 0.f;
#pragma unroll
                            for (int i = 0; i < 16; ++i) ps += ex2(s0[i] - ms) + ex2(s1[i] - ms);
                            lC = lC * alpha + ps; }); }
                    { const float invC = 1.f / fmaxf(xhalf_sum(lC), 1e-30f), msC = mC < -1e29f ? 0.f : mC; float carry = 0.f;
#pragma unroll
                      for (int i = 0; i < 16; ++i) { ob[0][i] = 0.f; ob[1][i] = 0.f; }
                      const bf16_t* kb_ = KCMPB + (size_t)b * 512 * 64; const bf16_t* vb_ = VCMPT + (size_t)b * 64 * 512;
                      attn_pipeline(0, ntc - 1, [&](int j, StageRegs& R) __attribute__((always_inline)) { R.a = *(const u32x4*)((kb_ + (size_t)j * 64 * 64) + koffC); R.b = *(const u32x4*)((vb_ + j * 64) + voffC); }, stKV,
                        [&](int j, int cb) __attribute__((always_inline)) { f32x16 s0, s1; qk_tile<4>(lds + (cb ? AL_K1 : AL_K0), qf, r32, hi, s0, s1); mask_tile(s0, s1, 0, nv - 1 - 64 * j, hi);
#pragma unroll
                            for (int i = 0; i < 16; ++i) { s0[i] = ex2(s0[i] - msC) * invC; s1[i] = ex2(s1[i] - msC) * invC; }
                            float gs[8], pl[8];
#pragma unroll
                            for (int q = 0; q < 4; ++q) { gs[q] = (s0[4 * q] + s0[4 * q + 1]) + (s0[4 * q + 2] + s0[4 * q + 3]); gs[4 + q] = (s1[4 * q] + s1[4 * q + 1]) + (s1[4 * q + 2] + s1[4 * q + 3]);
                                pl[q] = __shfl_xor(s0[4 * q + 3], 32); pl[4 + q] = __shfl_xor(s1[4 * q + 3], 32); }
#pragma unroll
                            for (int q = 0; q < 8; ++q) { const float prev = hi ? pl[q] : (q > 0 ? pl[q > 0 ? q - 1 : 0] : carry); float x = gs[q] + prev; x += __shfl_xor(x, 1); x += __shfl_xor(x, 2);
                                if ((r32 & 3) == 0) impb[(r32 >> 2) * 128 + 16 * j + 2 * q + hi] = x; }
                            carry = pl[7];
                            pv_tile(s0, s1, lds + (cb ? AL_V1 : AL_V0), ob, r32, hi); }); }
                    LAS float* oav = (LAS float*)(lds + AL_OACC) + tid; const float g0 = sigmoidf_(bf2f(prow[C_BG + head * 3]));
#pragma unroll
                    for (int i = 0; i < 16; ++i) { oav[i * 512] = g0 * ob[0][i]; oav[(16 + i) * 512] = g0 * ob[1][i]; }
                    WSYNC();
                    for (int tk = 0; tk < 8; ++tk) {
                        const int cur = tb, j0 = lane, j1 = lane + 64; const float im0 = impb[tk * 128 + j0], im1 = impb[tk * 128 + j1];
                        const unsigned k0 = ((j0 == 0 || j0 == cur || j0 == cur - 1) ? 0xFF000000u : (j0 <= cur ? (__float_as_uint(im0) & ~127u) : 0u)) | (unsigned)(127 - j0);
                        const unsigned k1 = ((j1 == cur || j1 == cur - 1) ? 0xFF000000u : (j1 <= cur ? (__float_as_uint(im1) & ~127u) : 0u)) | (unsigned)(127 - j1);
                        unsigned T = 0u;
#pragma unroll 4
                        for (int bb = 31; bb >= 0; --bb) { const unsigned cand = T | (1u << bb); const int cnt = __popcll(__ballot(k0 >= cand)) + __popcll(__ballot(k1 >= cand)); if (cnt >= 16) T = cand; }
                        const unsigned long long m0 = __ballot(k0 >= T), m1 = __ballot(k1 >= T);
                        if (lane == 0) { selm[tk * 4] = (unsigned)m0; selm[tk * 4 + 1] = (unsigned)(m0 >> 32); selm[tk * 4 + 2] = (unsigned)m1; selm[tk * 4 + 3] = (unsigned)(m1 >> 32); }
                    }
                    WSYNC();
                    const unsigned sm0 = selm[(r32 >> 2) * 4], sm1 = selm[(r32 >> 2) * 4 + 1], sm2 = selm[(r32 >> 2) * 4 + 2], sm3 = selm[(r32 >> 2) * 4 + 3];
                    { SoftState SB; soft_init(SB, ob);
                      unsigned u0 = sm0, u1 = sm1, u2 = sm2, u3 = sm3;
#pragma unroll
                      for (int o_ = 1; o_ < 64; o_ <<= 1) { u0 |= (unsigned)__shfl_xor((int)u0, o_); u1 |= (unsigned)__shfl_xor((int)u1, o_); u2 |= (unsigned)__shfl_xor((int)u2, o_); u3 |= (unsigned)__shfl_xor((int)u3, o_); }
                      unsigned long long Ulo = ((unsigned long long)(unsigned)__builtin_amdgcn_readfirstlane((int)u1) << 32) | (unsigned)__builtin_amdgcn_readfirstlane((int)u0), Uhi = ((unsigned long long)(unsigned)__builtin_amdgcn_readfirstlane((int)u3) << 32) | (unsigned)__builtin_amdgcn_readfirstlane((int)u2);
                      if (tb < 64) { if (tb < 63) Ulo &= (2ull << tb) - 1ull; Uhi = 0ull; } else if (tb < 127) Uhi &= (2ull << (tb - 64)) - 1ull;
                      const bf16_t* ksf = KSF + (size_t)b * 128 * 4096; const bf16_t* vsf = VST + (size_t)b * 128 * 4096; const unsigned lo8 = (unsigned)lane * 8u;
                      bf16x8 kf[2][4], vf[2][4];
                      int j = 0; Ulo &= ~1ull;
#pragma unroll
                      for (int f = 0; f < 8; ++f) kf[f >> 2][f & 3] = *(const bf16x8*)((ksf + f * 512) + lo8);
                      bool first = true;
                      for (;;) {
#pragma unroll
                          for (int f = 0; f < 8; ++f) vf[f >> 2][f & 3] = *(const bf16x8*)((vsf + (size_t)j * 4096 + f * 512) + lo8);
                          const f32x16 cinit = bcast16(-SB.m); f32x16 s0 = cinit, s1 = cinit;
#pragma unroll
                          for (int ks = 0; ks < 4; ++ks) { s0 = mfma32(kf[0][ks], qf[ks], s0); s1 = mfma32(kf[1][ks], qf[ks], s1); }
                          __builtin_amdgcn_sched_barrier(0);
                          const int jn = Ulo ? (int)__builtin_ctzll(Ulo) : (Uhi ? 64 + (int)__builtin_ctzll(Uhi) : -1);
                          if (Ulo) Ulo &= Ulo - 1ull; else Uhi &= Uhi - 1ull;
                          if (jn >= 0) {
#pragma unroll
                              for (int f = 0; f < 8; ++f) kf[f >> 2][f & 3] = *(const bf16x8*)((ksf + (size_t)jn * 4096 + f * 512) + lo8); }
                          const unsigned wsel = j < 32 ? sm0 : (j < 64 ? sm1 : (j < 96 ? sm2 : sm3)); const bool bit = (wsel >> (j & 31)) & 1u;
                          soft_update(s0, s1, SB, ob, j == tb || !__all(bit), bit ? 0 : 64, j == tb ? tl : 63, first, hi);
                          { const bf16x8 p00 = pack8<0>(s0), p01 = pack8<8>(s0), p10 = pack8<0>(s1), p11 = pack8<8>(s1);
#pragma unroll
                            for (int dt = 0; dt < 2; ++dt) { ob[dt] = mfma32(vf[dt][0], p00, ob[dt]); ob[dt] = mfma32(vf[dt][1], p01, ob[dt]); ob[dt] = mfma32(vf[dt][2], p10, ob[dt]); ob[dt] = mfma32(vf[dt][3], p11, ob[dt]); } }
                          if (jn < 0) break;
                          j = jn; first = false;
                      }
                      const float sc = sigmoidf_(bf2f(prow[C_BG + head * 3 + 1])) / fmaxf(xhalf_sum(SB.l), 1e-30f);
#pragma unroll
                      for (int i = 0; i < 16; ++i) { oav[i * 512] += sc * ob[0][i]; oav[(16 + i) * 512] += sc * ob[1][i]; } }
                    __syncthreads();
                    { SoftState SB; soft_init(SB, ob); const int jb0 = tb >= 8 ? tb - 8 : 0;
                      const bf16_t* kb_ = PB + (size_t)b * SEQ * NIN + C_KW; const bf16_t* vb_ = VWT + (size_t)b * 64 * SEQ;
                      attn_pipeline(tb >= 8 ? tb - 8 : 0, tb, [&](int j, StageRegs& R) __attribute__((always_inline)) { R.a = *(const u32x4*)((kb_ + (size_t)j * 64 * NIN) + koffP); R.b = *(const u32x4*)((vb_ + j * 64) + voffS); }, stKV,
                        [&](int j, int cb) __attribute__((always_inline)) { attn_step<4>(lds + (cb ? AL_K1 : AL_K0), lds + (cb ? AL_V1 : AL_V0), qf, SB, ob, j == tb || j == tb - 8, j == tb - 8 ? tl + 1 : 0, j == tb ? tl : 63, j == jb0, r32, hi); });
                      const float sc = sigmoidf_(bf2f(prow[C_BG + head * 3 + 2])) / fmaxf(xhalf_sum(SB.l), 1e-30f);
#pragma unroll
                      for (int i = 0; i < 16; ++i) { oacc[0][i] = oav[i * 512] + sc * ob[0][i]; oacc[1][i] = oav[(16 + i) * 512] + sc * ob[1][i]; } }
                    { float ss = 0.f;
#pragma unroll
                      for (int i = 0; i < 16; ++i) ss += oacc[0][i] * oacc[0][i] + oacc[1][i] * oacc[1][i];
                      ss = xhalf_sum(ss); ss += __shfl_xor(ss, 1); ss += __shfl_xor(ss, 2);
                      const float rinv = rsqrtf(ss * (1.f / 256.f) + EPS);
#pragma unroll
                      for (int dt = 0; dt < 2; ++dt)
#pragma unroll
                          for (int g = 0; g < 4; ++g) { u32x2 w; w.x = cvtpk(oacc[dt][4 * g] * rinv, oacc[dt][4 * g + 1] * rinv); w.y = cvtpk(oacc[dt][4 * g + 2] * rinv, oacc[dt][4 * g + 3] * rinv);
                              *(u32x2*)(Y + row * DM + 512 + head * 64 + 32 * dt + 8 * g + 4 * hi) = w; } }
                    __syncthreads();
                    continue;
                }
                {
                    const int qb = 31 - grp, b = within >> 2, h = within & 3;
                    const int T = 256 * qb + 32 * wave + r32; const size_t row = (size_t)b * SEQ + T;
                    bf16x8 qf[6];
#pragma unroll
                    for (int ks = 0; ks < 6; ++ks) qf[ks] = *(const bf16x8*)(MQ + row * 384 + h * 96 + 16 * ks + 8 * hi);
                    f32x16 o[2]; SoftState SM; soft_init(SM, o);
                    const int jd = 4 * qb + (wave >> 1), jend = 4 * qb + 3;
                    const bf16_t* kn = MKN + (size_t)b * SEQ * 256 + h * 64; const bf16_t* kr = MKR + (size_t)b * SEQ * 32; const bf16_t* vt = MVT + (size_t)(b * 4 + h) * 64 * SEQ;
                    const int vd_ = tid >> 3, vc8 = tid & 7, rkey = tid >> 2, rch = tid & 3;
                    const unsigned ko0 = (unsigned)(vd_ * 256 + vc8 * 8), ko1 = (unsigned)(rkey * 32 + rch * 8), vo_ = (unsigned)(vd_ * SEQ + vc8 * 8);
                    attn_pipeline(0, jend,
                        [&](int j, StageRegs& R) __attribute__((always_inline)) { R.a = *(const u32x4*)((kn + (size_t)j * 64 * 256) + ko0);
                            if (tid < 256) R.b = *(const u32x4*)((kr + (size_t)j * 64 * 32) + ko1);
                            R.c = *(const u32x4*)((vt + j * 64) + vo_); },
                        [&](int buf, const StageRegs& R) __attribute__((always_inline)) { *(LAS u32x4*)(lds + (buf ? AL_K1 : AL_K0) + vd_ * KSTR + vc8 * 16) = R.a;
                            if (tid < 256) *(LAS u32x4*)(lds + (buf ? AL_K1 : AL_K0) + rkey * KSTR + 128 + rch * 16) = R.b;
                            LAS unsigned char* vd = lds + (buf ? AL_V1 : AL_V0) + vd_ * VSTR + vc8 * 16; u32x2 a, c; a.x = R.c.x; a.y = R.c.y; c.x = R.c.z; c.y = R.c.w; *(LAS u32x2*)vd = a; *(LAS u32x2*)(vd + 8) = c; },
                        [&](int j, int cb) __attribute__((always_inline)) { if (j <= jd) attn_step<6>(lds + (cb ? AL_K1 : AL_K0), lds + (cb ? AL_V1 : AL_V0), qf, SM, o, j == jd, 0, 32 * (wave & 1) + r32, j == 0, r32, hi); });
                    { const float inv = 1.f / fmaxf(xhalf_sum(SM.l), 1e-30f); float ss = 0.f;
#pragma unroll
                      for (int dt = 0; dt < 2; ++dt)
#pragma unroll
                          for (int g = 0; g < 4; ++g) { const float v0 = o[dt][4 * g] * inv, v1 = o[dt][4 * g + 1] * inv, v2 = o[dt][4 * g + 2] * inv, v3 = o[dt][4 * g + 3] * inv; ss += v0 * v0 + v1 * v1 + v2 * v2 + v3 * v3;
                              u32x2 w; w.x = cvtpk(v0, v1); w.y = cvtpk(v2, v3); *(u32x2*)(Y + row * DM + h * 64 + 32 * dt + 8 * g + 4 * hi) = w; }
                      ss = xhalf_sum(ss); if (hi == 0) ssq_d[(size_t)h * M + row] = ss; }
                    __syncthreads();
                }
              }
            }
        }
        SEAM(pb + 2);
        if (IN(pb + 3)) {
        const int l_ = l; WS_PTRS();
            pg8::Gemm g{Y, (const bf16_t*)(ws + WS_WOUT) + (size_t)l * DM * DM, M, DM, DM}; pg8::StaticOrder S; S.init(M, DM, G, bid);
            pg8::EpiResid<true> E{XB, ssq_out, ssq_d, (LAS float*)(lds + 131072)};
            pg8::gemm_phase<pg8::EpiResid<true>, pg8::StaticOrder, true, true>(lds, g, S, E);
            if (REP_G57) { pg8::EpiInProj E2{PB, DM, ssq_mix}; pg8::gemm_phase<pg8::EpiInProj, pg8::StaticOrder, true, true>(lds, g, S, E2); }
        }
        SEAM(pb + 3);
        if (IN(pb + 4)) {
        const int l_ = l; WS_PTRS();
            pg8::Gemm g{XB, (const bf16_t*)(ws + WS_WGU) + (size_t)l * NGU * DM, M, NGU, DM}; pg8::StaticOrder S; S.init(M, NGU, G, bid);
            pg8::EpiSwiglu E{ACT, ssq_out};
            _Pragma("unroll 1") for (int rep = 0; rep < REP_G16; ++rep) pg8::gemm_phase<pg8::EpiSwiglu, pg8::StaticOrder, true, true>(lds, g, S, E);
        }
        SEAM(pb + 4);
        if (IN(pb + 5)) {
        const int l_ = l; WS_PTRS();
            pg8::Gemm g{ACT, (const bf16_t*)(ws + WS_WDN) + (size_t)l * DM * FF, M, DM, FF}; pg8::StaticOrder S; S.init(M, DM, G, bid);
            pg8::EpiResid<false> E{XB, ssq_down, nullptr, (LAS float*)(lds + 131072)};
            pg8::gemm_phase<pg8::EpiResid<false>, pg8::StaticOrder, true, true>(lds, g, S, E);
            if (REP_G57) { pg8::EpiInProj E2{Y, DM, ssq_mix}; pg8::gemm_phase<pg8::EpiInProj, pg8::StaticOrder, true, true>(lds, g, S, E2); }
        }
        SEAM(pb + 5);
    }
    if (IN(13)) {
        const int l_ = 1; WS_PTRS();
        LAUNDER_TID();
        const float* ssqf = ssp_base + (size_t)5 * 4 * M; const int gw = bid * 8 + wave, NGW = G * 8;
        for (int m = gw; m < M; m += NGW) {
            const float rinv = rsqrtf(sum4p(ssqf, m) * (1.f / DM) + EPS);
            const u32x2* xr = (const u32x2*)(XB + (size_t)m * DM) + lane; f32x4* orow = (f32x4*)(args.out + (size_t)m * DM) + lane; const f32x4* gn = (const f32x4*)inp(args, 27) + lane;
#pragma unroll
            for (int j = 0; j < 4; ++j) { const u32x2 w = xr[64 * j]; const f32x4 g = gn[64 * j]; f32x4 v; v[0] = bflo(w.x) * rinv * g[0]; v[1] = bfhi(w.x) * rinv * g[1]; v[2] = bflo(w.y) * rinv * g[2]; v[3] = bfhi(w.y) * rinv * g[3]; orow[64 * j] = v; }
        }
    }
#undef IN
#undef SEAM
}

extern "C" void kernel_launch(void* const* d_in, const int* in_sizes, int n_in, void* d_out, int out_size, void* d_ws, size_t ws_size, hipStream_t stream) {
    static int grid = 0;
    if (grid == 0) {
        if (n_in != 28 || in_sizes[0] != M * DM || out_size != M * DM || ws_size < WS_END) { fprintf(stderr, "kernel_launch: unexpected shapes (n_in %d, ws %zu)\n", n_in, ws_size); grid = -1; return; }
        int dev = 0, cus = 0;
        if (hipGetDevice(&dev) != hipSuccess || hipDeviceGetAttribute(&cus, hipDeviceAttributeMultiprocessorCount, dev) != hipSuccess) { grid = -1; return; }
        if (hipFuncSetAttribute((const void*)fwd, hipFuncAttributeMaxDynamicSharedMemorySize, LDS_BYTES) != hipSuccess) { fprintf(stderr, "kernel_launch: hipFuncSetAttribute failed\n"); grid = -1; return; }
        int per_cu = 0;
        if (hipOccupancyMaxActiveBlocksPerMultiprocessor(&per_cu, (const void*)fwd, NTHR, LDS_BYTES) != hipSuccess || per_cu < 1) fprintf(stderr, "kernel_launch: occupancy query says %d\n", per_cu);
        (void)hipGetLastError();
        grid = cus;
    }
    if (grid < 0) return;
    (void)hipMemsetAsync((char*)d_ws + WS_CTL, 0, CTL_ZERO_BYTES, stream);
    Args a{};
    for (int i = 0; i < 28; ++i) a.in[i] = (const float*)d_in[i];
    a.out = (float*)d_out; a.ws = (unsigned char*)d_ws;
    if (MK_N_LAUNCHES == 1) { a.ph_lo = 0; a.ph_hi = 14; hipLaunchKernelGGL(fwd, dim3(grid), dim3(NTHR), LDS_BYTES, stream, a); }
    else for (int p = 0; p < 14; ++p) { a.ph_lo = p; a.ph_hi = p + 1; hipLaunchKernelGGL(fwd, dim3(grid), dim3(NTHR), LDS_BYTES, stream, a); }
}
```

```cpp
#include <hip/hip_runtime.h>
#include <cstdio>
#include <cstdint>

#ifndef MK_N_LAUNCHES
#define MK_N_LAUNCHES 1
#endif

#define REP_P0 1
#define REP_G16 1
#define REP_G57 0
#define REP_ATT 1
#define REP_J4B 1
#define REP_J3 1
#define REP_J1 1
#define REP_J2 1
#define REP_P3 1
#define REP_ONLY 0
#define LAS __attribute__((address_space(3)))
#define DI __device__ __forceinline__
typedef unsigned short bf16_t;
typedef short bf16x8 __attribute__((ext_vector_type(8)));
typedef float f32x4 __attribute__((ext_vector_type(4)));
typedef unsigned u32x4 __attribute__((ext_vector_type(4)));
typedef unsigned u32x2 __attribute__((ext_vector_type(2)));

constexpr int NB = 4, SEQ = 8192, M = NB * SEQ, DM = 1024, NIN = 2304, NINS = 2300, FF = 2816, NGU = 2 * FF;
constexpr float EPS = 1e-6f;
constexpr int C_AX = 0, C_AG = 256, C_BQ = 512, C_KC = 768, C_VC = 832, C_KS = 896, C_VS = 960, C_KW = 1024, C_VW = 1088, C_BG = 1152,
              C_CQ = 1164, C_CK = 1292, C_CV = 1420, C_GLR = 1676, C_OG = 1692, C_DCQ = 1948, C_DCKV = 2140, C_DKR = 2268;
constexpr size_t MiB = 1u << 20;
constexpr size_t WS_CTL = 0, CTL_ZERO_BYTES = 1 * MiB;
constexpr size_t WS_ACC = 64 * 1024;
constexpr size_t WS_SSQ0 = 1 * MiB;
constexpr size_t WS_HB = 1 * MiB + 256 * 1024;
constexpr size_t WS_WIN = 2 * MiB, WS_WOUT = 11 * MiB, WS_WGU = 15 * MiB, WS_WDN = 37 * MiB;
constexpr size_t WS_WUQT = 48 * MiB, WS_WUKVT = 48 * MiB + 512 * 1024, WS_W2T = 49 * MiB, WS_W1T = 50 * MiB;
constexpr size_t WS_WGT = 49 * MiB + 512 * 1024, WS_SP = 49 * MiB + 768 * 1024;
constexpr size_t WS_BCS = 352 * MiB;
constexpr size_t WS_CS64 = 64 * MiB, WS_CS32 = 72 * MiB;
constexpr size_t WS_XB = 80 * MiB, WS_Y = 144 * MiB, WS_PB = 208 * MiB, WS_ACT = 208 * MiB;
constexpr size_t WS_LA = 384 * MiB, WS_LH = 386 * MiB, WS_CIN = 388 * MiB;
constexpr size_t WS_KVC = 392 * MiB, WS_DEC = 408 * MiB, WS_SST = 410 * MiB;
constexpr size_t WS_MQ = 428 * MiB, WS_MKN = 452 * MiB, WS_MV = 468 * MiB, WS_MKR = 484 * MiB;
constexpr size_t WS_SSP = 500 * MiB;
constexpr size_t WS_KSF = 504 * MiB;
constexpr size_t WS_VST = 490 * MiB, WS_VWT = 494 * MiB, WS_KCMPB = 498 * MiB, WS_VCMPT = 499 * MiB, WS_END = 508 * MiB;
constexpr int CW_QUEUE = 64;
constexpr int CW_FLAG = 1024;
constexpr int CW_BAR = 4096;
constexpr int LDS_BYTES = 163840 - 256;
constexpr int LDS_CTL = LDS_BYTES - 64;
constexpr int NTHR = 512;

struct Args { const float* in[28]; float* out; unsigned char* ws; int ph_lo, ph_hi; };

DI float bf2f(bf16_t h) { return __uint_as_float(((unsigned)h) << 16); }
DI float bflo(unsigned u) { return __uint_as_float(u << 16); }
DI float bfhi(unsigned u) { return __uint_as_float(u & 0xffff0000u); }
DI bf16_t f2bf(float f) { unsigned u = __float_as_uint(f); return (bf16_t)((u + 0x7fffu + ((u >> 16) & 1u)) >> 16); }
DI unsigned pk2(float lo, float hi) { return (unsigned)f2bf(lo) | ((unsigned)f2bf(hi) << 16); }
DI float sum4p(const float* p, size_t row) { return (p[row] + p[(size_t)M + row]) + (p[2 * (size_t)M + row] + p[3 * (size_t)M + row]); }
DI float wave_sum(float v) {
#pragma unroll
    for (int o = 1; o < 64; o <<= 1) v += __shfl_xor(v, o);
    return v;
}
DI float wave_max(float v) {
#pragma unroll
    for (int o = 1; o < 64; o <<= 1) v = fmaxf(v, __shfl_xor(v, o));
    return v;
}
DI int wave_min_i(int v) {
#pragma unroll
    for (int o = 1; o < 64; o <<= 1) { int w = __shfl_xor(v, o); v = w < v ? w : v; }
    return v;
}
DI float sigmoidf_(float x) { return 1.f / (1.f + __expf(-x)); }
DI float gelu_tanh(float x) { const float u = 0.7978845608028654f * (x + 0.044715f * x * x * x); return 0.5f * x * (1.f + tanhf(u)); }
#define WSYNC() do { asm volatile("s_waitcnt lgkmcnt(0)" ::: "memory"); __builtin_amdgcn_wave_barrier(); } while (0)

namespace pg8 {
constexpr int BM = 256, BK = 64, HALF = 128, HTB = HALF * BK * 2, NXCD = 8, WGM = 8;
__host__ __device__ __forceinline__ int lds_byte(int r, int c) { const int st = (r >> 4) * 2 + (c >> 5), rr = r & 15, cc = c & 31, ob = rr * 64 + cc * 2; return st * 1024 + (ob ^ (((ob >> 9) & 1) << 5)); }
__host__ __device__ __forceinline__ void stage_rc(int b, int& R, int& C) { const int st = b / 1024, sb = b % 1024, swz = sb ^ (((sb >> 9) & 1) << 5); R = (st >> 1) * 16 + swz / 64; C = (st & 1) * 32 + (swz % 64) / 2; }
__host__ __device__ __forceinline__ int perm32(int rho) { const int n = rho >> 4, i = rho & 15; return 8 * (i >> 2) + 4 * n + (i & 3); }
struct Unit { int pm, pn; };
struct Gemm { const bf16_t* A; const bf16_t* Bt; int M, N, K; };
struct StaticOrder {
    int nM, nN, nwg, G, c;
    __host__ __device__ void init(int M_, int N_, int G_, int c_) { nM = M_ / BM; nN = N_ / BM; nwg = nM * nN; G = G_; c = c_; }
    __host__ __device__ bool next(int i, Unit& u) const {
        const long L = (long)i * G + c; if (L >= nwg) return false;
        int wgid = (int)L; { const int q = nwg / NXCD, r = nwg % NXCD, xcd = wgid % NXCD, off = wgid / NXCD; wgid = (xcd < r ? xcd * (q + 1) : r * (q + 1) + (xcd - r) * q) + off; }
        const int nig = WGM * nN, gid = wgid / nig, fm = gid * WGM, gsz = (nM - fm) < WGM ? (nM - fm) : WGM;
        u.pm = fm + ((wgid % nig) % gsz); u.pn = (wgid % nig) / gsz; return true;
    }
    __device__ __forceinline__ void a_ready(const Unit&) const {}
    __device__ __forceinline__ void done(const Unit&) const {}
};
DI unsigned cvt_pk_bf16(float lo, float hi) { unsigned r; asm volatile("v_cvt_pk_bf16_f32 %0, %1, %2" : "=v"(r) : "v"(lo), "v"(hi)); return r; }

struct EpiInProj {
    static constexpr bool PERM = true, AFTER_DRAIN = false, MIDSCALE = false;
    bf16_t* O; int ldc; const float* ssq;
    DI void operator()(const f32x4 (&acc)[2][2][4][2], const Unit& u, int wr, int wc, int fr, int fq) const {
        int row0 = u.pm * BM + wr * 64 + fr; asm volatile("" : "+v"(row0)); const int col0 = u.pn * BM + wc * 32 + 8 * fq;
#pragma unroll
        for (int ai = 0; ai < 2; ++ai)
#pragma unroll
            for (int m = 0; m < 4; ++m) {
                const int row = row0 + ai * HALF + m * 16;
                const float rinv = rsqrtf(sum4p(ssq, row) * (1.f / DM) + EPS);
                bf16_t* rowp = O + (size_t)row * ldc + col0;
#pragma unroll
                for (int bj = 0; bj < 2; ++bj) {
                    f32x4 v0 = acc[ai][bj][m][0] * rinv, v1 = acc[ai][bj][m][1] * rinv;
                    u32x4 w; w.x = cvt_pk_bf16(v0[0], v0[1]); w.y = cvt_pk_bf16(v0[2], v0[3]); w.z = cvt_pk_bf16(v1[0], v1[1]); w.w = cvt_pk_bf16(v1[2], v1[3]);
                    *(u32x4*)(rowp + bj * HALF) = w;
                }
            }
    }
};
template <bool MS> struct EpiResid {
    static constexpr bool PERM = true, AFTER_DRAIN = false, MIDSCALE = MS;
    bf16_t* xb; float* ssq_part; const float* ssq_mid; LAS float* ssl;
    DI void midscale(f32x4 (&acc)[2][2][4][2], const Unit& u, int wr, int fr) const {
        int row0 = u.pm * BM + wr * 64 + fr; asm volatile("" : "+v"(row0));
#pragma unroll
        for (int ai = 0; ai < 2; ++ai)
#pragma unroll
            for (int m = 0; m < 4; ++m) { const float s = rsqrtf(sum4p(ssq_mid, row0 + ai * HALF + m * 16) * (1.f / 256.f) + EPS);
#pragma unroll
                for (int bj = 0; bj < 2; ++bj) { acc[ai][bj][m][0] *= s; acc[ai][bj][m][1] *= s; } }
    }
    DI void operator()(const f32x4 (&acc)[2][2][4][2], const Unit& u, int wr, int wc, int fr, int fq) const {
        int rl0 = wr * 64 + fr; asm volatile("" : "+v"(rl0));
        const int col0 = u.pn * BM + wc * 32 + 8 * fq;
#pragma unroll
        for (int ai = 0; ai < 2; ++ai)
#pragma unroll
            for (int m = 0; m < 4; ++m) {
                const int rl = rl0 + ai * HALF + m * 16; const size_t row = (size_t)u.pm * BM + rl;
                float part = 0.f;
#pragma unroll
                for (int bj = 0; bj < 2; ++bj) {
                    u32x4* px = (u32x4*)(xb + row * DM + col0 + bj * HALF); const u32x4 xo = *px;
                    const f32x4 a0 = acc[ai][bj][m][0], a1 = acc[ai][bj][m][1];
                    const float v0 = a0[0] + bflo(xo.x), v1 = a0[1] + bfhi(xo.x), v2 = a0[2] + bflo(xo.y), v3 = a0[3] + bfhi(xo.y), v4 = a1[0] + bflo(xo.z), v5 = a1[1] + bfhi(xo.z), v6 = a1[2] + bflo(xo.w), v7 = a1[3] + bfhi(xo.w);
                    u32x4 w; w.x = cvt_pk_bf16(v0, v1); w.y = cvt_pk_bf16(v2, v3); w.z = cvt_pk_bf16(v4, v5); w.w = cvt_pk_bf16(v6, v7);
                    *px = w;
                    part += (v0 * v0 + v1 * v1) + (v2 * v2 + v3 * v3) + (v4 * v4 + v5 * v5) + (v6 * v6 + v7 * v7);
                }
                part += __shfl_xor(part, 16); part += __shfl_xor(part, 32);
                if (fq == 0) ssl[rl * 4 + wc] = part;
            }
        asm volatile("s_waitcnt lgkmcnt(0)" ::: "memory"); __builtin_amdgcn_s_barrier();
        int tq = threadIdx.x; asm volatile("" : "+v"(tq));
        if (tq < 256) { const f32x4 p = *(const LAS f32x4*)(ssl + tq * 4); ssq_part[(size_t)u.pn * M + (size_t)u.pm * BM + tq] = (p[0] + p[1]) + (p[2] + p[3]); }
    }
};
struct EpiSwiglu {
    static constexpr bool PERM = true, AFTER_DRAIN = false, MIDSCALE = false;
    bf16_t* act; const float* ssq;
    DI void operator()(const f32x4 (&acc)[2][2][4][2], const Unit& u, int wr, int wc, int fr, int fq) const {
        int row0 = u.pm * BM + wr * 64 + fr; asm volatile("" : "+v"(row0)); const int j0 = u.pn * 128 + wc * 16 + 4 * fq;
#pragma unroll
        for (int ai = 0; ai < 2; ++ai)
#pragma unroll
            for (int m = 0; m < 4; ++m) {
                const int row = row0 + ai * HALF + m * 16;
                const float rinv = rsqrtf(sum4p(ssq, row) * (1.f / DM) + EPS);
#pragma unroll
                for (int bj = 0; bj < 2; ++bj) {
                    const f32x4 g = acc[ai][bj][m][0] * rinv, up = acc[ai][bj][m][1] * rinv;
                    float a[4];
#pragma unroll
                    for (int i = 0; i < 4; ++i) a[i] = g[i] / (1.f + __expf(-g[i])) * up[i];
                    u32x2 w; w.x = cvt_pk_bf16(a[0], a[1]); w.y = cvt_pk_bf16(a[2], a[3]);
                    *(u32x2*)(act + (size_t)row * FF + j0 + bj * 64) = w;
                }
            }
    }
};

template <class Epi, class Sched, bool ALIGN_EPI = false, bool SP2 = false>
DI void gemm_phase(LAS unsigned char* lds, const Gemm g, const Sched& S, const Epi& E) {
    int tid_ = threadIdx.x; asm volatile("" : "+v"(tid_));
    const int tid = tid_, wid = __builtin_amdgcn_readfirstlane(tid >> 6), lane = tid & 63, wr = wid >> 2, wc = wid & 3, fr = lane & 15, fq = lane >> 4;
    const int K = g.K, nt = K / BK;
    unsigned voffA[2], voffB[2];
#pragma unroll
    for (int i = 0; i < 2; ++i) { int R, C; stage_rc(tid * 16 + i * 8192, R, C); const int Rb = Epi::PERM ? ((R & ~31) + perm32(R & 31)) : R;
        voffA[i] = (unsigned)(R * K + C) * 2u; voffB[i] = (unsigned)(Rb * K + C) * 2u; }
    const size_t kstep = (size_t)(BK * 2);
    const size_t hstep = (size_t)HALF * K * 2;
    const size_t tstep = 2 * hstep;
    const unsigned ldsw = (unsigned)wid * 1024u;
    const int aoff = lds_byte(wr * 64 + fr, fq * 8), boff = lds_byte(wc * 32 + fr, fq * 8);
#define PG8_SA(b, h) (((b) * 2 + (h)) * HTB)
#define PG8_SB(b, h) ((4 + (b) * 2 + (h)) * HTB)
#define PG8_STAGE(bufoff, gbase, voff) do { _Pragma("unroll") for (int _i = 0; _i < 2; ++_i) \
        __builtin_amdgcn_global_load_lds((const unsigned*)((const char*)(gbase) + (voff)[_i]), (LAS unsigned*)(lds + (bufoff) + ldsw + _i * 8192), 16, 0, 0); } while (0)
#define PG8_LDA(dst, b, h) do { _Pragma("unroll") for (int m = 0; m < 4; ++m) _Pragma("unroll") for (int k = 0; k < 2; ++k) dst[m][k] = *(const LAS bf16x8*)(lds + PG8_SA(b, h) + aoff + m * 2048 + k * 1024); } while (0)
#define PG8_LDB(dst, b, h) do { _Pragma("unroll") for (int n = 0; n < 2; ++n) _Pragma("unroll") for (int k = 0; k < 2; ++k) dst[n][k] = *(const LAS bf16x8*)(lds + PG8_SB(b, h) + boff + n * 2048 + k * 1024); } while (0)
#define PG8_MMA(ai, bj, At, Bt) do { __builtin_amdgcn_s_setprio(1); _Pragma("unroll") for (int m = 0; m < 4; ++m) _Pragma("unroll") for (int n = 0; n < 2; ++n) _Pragma("unroll") for (int k = 0; k < 2; ++k) \
        acc[ai][bj][m][n] = __builtin_amdgcn_mfma_f32_16x16x32_bf16(Bt[n][k], At[m][k], acc[ai][bj][m][n], 0, 0, 0); __builtin_amdgcn_s_setprio(0); } while (0)
#define PG8_WAIT_V(n) asm volatile("s_waitcnt vmcnt(" #n ")" ::: "memory")
#define PG8_WAIT_L(n) asm volatile("s_waitcnt lgkmcnt(" #n ")" ::: "memory")
#define PG8_BAR __builtin_amdgcn_s_barrier()
#define PG8_SCHED __builtin_amdgcn_sched_barrier(0)
    Unit cur, nxt; int ui = 0;
    if (!S.next(0, cur)) return;
    f32x4 acc[2][2][4][2];
#pragma unroll
    for (int a = 0; a < 2; ++a)
#pragma unroll
        for (int b = 0; b < 2; ++b)
#pragma unroll
            for (int m = 0; m < 4; ++m)
#pragma unroll
                for (int n = 0; n < 2; ++n) acc[a][b][m][n] = (f32x4){0.f, 0.f, 0.f, 0.f};
    bf16x8 At[4][2], B0[2][2], B1[2][2];
    const char* cA = (const char*)g.A + (size_t)cur.pm * tstep; const char* cB = (const char*)g.Bt + (size_t)cur.pn * tstep;
    S.a_ready(cur);
    if constexpr (SP2) {
        PG8_STAGE(PG8_SB(0, 0), cB, voffB); PG8_STAGE(PG8_SB(0, 1), cB + hstep, voffB); PG8_STAGE(PG8_SA(0, 0), cA, voffA); PG8_STAGE(PG8_SA(0, 1), cA + hstep, voffA);
        if (wr == 1) PG8_BAR;
        PG8_WAIT_V(2); PG8_BAR;
        PG8_STAGE(PG8_SB(1, 0), cB + kstep, voffB); PG8_STAGE(PG8_SA(1, 0), cA + kstep, voffA); PG8_STAGE(PG8_SB(1, 1), cB + hstep + kstep, voffB);
        PG8_WAIT_V(6); PG8_BAR;
    } else {
        PG8_STAGE(PG8_SB(0, 0), cB, voffB); PG8_STAGE(PG8_SA(0, 0), cA, voffA); PG8_STAGE(PG8_SB(0, 1), cB + hstep, voffB); PG8_STAGE(PG8_SA(0, 1), cA + hstep, voffA);
        if (wr == 1) PG8_BAR;
        PG8_WAIT_V(4); PG8_BAR;
        PG8_STAGE(PG8_SB(1, 0), cB + kstep, voffB); PG8_STAGE(PG8_SA(1, 0), cA + kstep, voffA); PG8_STAGE(PG8_SB(1, 1), cB + hstep + kstep, voffB);
        PG8_WAIT_V(6); PG8_BAR;
    }
    for (;;) {
        const bool has_next = S.next(ui + 1, nxt);
        const char* nA = has_next ? (const char*)g.A + (size_t)nxt.pm * tstep : cA; const char* nB = has_next ? (const char*)g.Bt + (size_t)nxt.pn * tstep : cB;
        for (int t = 0; t < nt; t += 2) {
            const bool last = (t == nt - 2);
            const char* a1 = cA + (size_t)(t + 1) * kstep;
            const char* a2 = last ? nA : cA + (size_t)(t + 2) * kstep; const char* b2 = last ? nB : cB + (size_t)(t + 2) * kstep;
            const char* a3 = a2 + kstep; const char* b3 = b2 + kstep;
            if (last && has_next) S.a_ready(nxt);
            if constexpr (SP2) {
            PG8_LDB(B0, 0, 0); PG8_LDB(B1, 0, 1); PG8_SCHED; PG8_LDA(At, 0, 0); PG8_STAGE(PG8_SA(1, 1), a1 + hstep, voffA);
            PG8_WAIT_V(8); PG8_WAIT_L(0); PG8_BAR; PG8_MMA(0, 0, At, B0); PG8_MMA(0, 1, At, B1); PG8_BAR; PG8_SCHED;
            PG8_LDA(At, 0, 1); PG8_STAGE(PG8_SB(0, 0), b2, voffB); PG8_STAGE(PG8_SB(0, 1), b2 + hstep, voffB); PG8_STAGE(PG8_SA(0, 0), a2, voffA);
            PG8_WAIT_V(8); PG8_WAIT_L(0); PG8_BAR; PG8_MMA(1, 0, At, B0); PG8_MMA(1, 1, At, B1); PG8_BAR; PG8_SCHED;
            PG8_LDB(B0, 1, 0); PG8_LDB(B1, 1, 1); PG8_SCHED; PG8_LDA(At, 1, 0); PG8_STAGE(PG8_SA(0, 1), a2 + hstep, voffA);
            PG8_WAIT_V(8); PG8_WAIT_L(0); PG8_BAR; PG8_MMA(0, 0, At, B0); PG8_MMA(0, 1, At, B1); PG8_BAR; PG8_SCHED;
            PG8_LDA(At, 1, 1); PG8_STAGE(PG8_SB(1, 0), b3, voffB); PG8_STAGE(PG8_SB(1, 1), b3 + hstep, voffB); PG8_STAGE(PG8_SA(1, 0), a3, voffA);
            PG8_WAIT_V(8); PG8_WAIT_L(0); PG8_BAR; PG8_MMA(1, 0, At, B0); PG8_MMA(1, 1, At, B1); PG8_BAR; PG8_SCHED;
            if constexpr (Epi::MIDSCALE) { if (t == 2) E.midscale(acc, cur, wr, fr); }
            } else {
            PG8_LDB(B0, 0, 0); PG8_SCHED; PG8_LDA(At, 0, 0); PG8_STAGE(PG8_SA(1, 1), a1 + hstep, voffA);
            PG8_WAIT_L(8); PG8_BAR; PG8_WAIT_L(0); PG8_MMA(0, 0, At, B0); PG8_BAR; PG8_SCHED;
            PG8_LDB(B1, 0, 1); PG8_STAGE(PG8_SB(0, 0), b2, voffB);
            PG8_BAR; PG8_WAIT_L(0); PG8_MMA(0, 1, At, B1); PG8_BAR;
            PG8_LDA(At, 0, 1); PG8_STAGE(PG8_SA(0, 0), a2, voffA);
            PG8_BAR; PG8_WAIT_L(0); PG8_MMA(1, 0, At, B0); PG8_BAR; PG8_SCHED;
            PG8_STAGE(PG8_SB(0, 1), b2 + hstep, voffB);
            PG8_WAIT_V(6); PG8_BAR; PG8_MMA(1, 1, At, B1); PG8_BAR;
            PG8_LDB(B0, 1, 0); PG8_SCHED; PG8_LDA(At, 1, 0); PG8_STAGE(PG8_SA(0, 1), a2 + hstep, voffA);
            PG8_WAIT_L(8); PG8_BAR; PG8_WAIT_L(0); PG8_MMA(0, 0, At, B0); PG8_BAR; PG8_SCHED;
            PG8_LDB(B1, 1, 1); PG8_STAGE(PG8_SB(1, 0), b3, voffB);
            PG8_BAR; PG8_WAIT_L(0); PG8_MMA(0, 1, At, B1); PG8_BAR;
            PG8_LDA(At, 1, 1); PG8_STAGE(PG8_SA(1, 0), a3, voffA);
            PG8_BAR; PG8_WAIT_L(0); PG8_MMA(1, 0, At, B0); PG8_BAR; PG8_SCHED;
            PG8_STAGE(PG8_SB(1, 1), b3 + hstep, voffB);
            PG8_WAIT_V(6); PG8_BAR; PG8_MMA(1, 1, At, B1); PG8_BAR;
            }
        }
        if constexpr (ALIGN_EPI) { if (wr == 0) PG8_BAR; }
        if constexpr (!Epi::AFTER_DRAIN) { E(acc, cur, wr, wc, fr, fq); S.done(cur); }
        if (!has_next) break;
#pragma unroll
        for (int a = 0; a < 2; ++a)
#pragma unroll
            for (int b = 0; b < 2; ++b)
#pragma unroll
                for (int m = 0; m < 4; ++m)
#pragma unroll
                    for (int n = 0; n < 2; ++n) acc[a][b][m][n] = (f32x4){0.f, 0.f, 0.f, 0.f};
        cur = nxt; cA = nA; cB = nB; ++ui;
        if constexpr (ALIGN_EPI) { if (wr == 1) PG8_BAR; }
    }
    PG8_WAIT_V(0);
    if constexpr (!ALIGN_EPI) { if (wr == 0) PG8_BAR; }
    PG8_BAR;
#undef PG8_SA
#undef PG8_SB
#undef PG8_STAGE
#undef PG8_LDA
#undef PG8_LDB
#undef PG8_MMA
#undef PG8_WAIT_V
#undef PG8_WAIT_L
#undef PG8_BAR
#undef PG8_SCHED
}
}

#define XB_TMO      128
#define XB_XCNT(j)  (256  + 64 * (j))
#define XB_XSUB(j)  (1280 + 64 * (j))
#define XB_XGEN(j)  (2304 + 64 * (j))
#define XB_TOP      3328
#define XB_TOPGEN   3392
#define XCD_BAR_WORDS 3456
#define XB_SPIN_CAP (1u << 18)
__device__ __forceinline__ unsigned xb_ld(unsigned* p)              { return __hip_atomic_load(p, __ATOMIC_RELAXED, __HIP_MEMORY_SCOPE_AGENT); }
__device__ __forceinline__ unsigned xb_add(unsigned* p, unsigned v) { return __hip_atomic_fetch_add(p, v, __ATOMIC_RELAXED, __HIP_MEMORY_SCOPE_AGENT); }
__device__ __forceinline__ unsigned xb_xcc_id() { return (unsigned)__builtin_amdgcn_s_getreg((3 << 11) | 20) & 0xFu; }
#define XB_SPIN(cond, bar) do { unsigned _sp = 0; while (cond) { __builtin_amdgcn_s_sleep(1); \
    if ((++_sp & 255u) == 0u) { if (xb_ld(&(bar)[XB_TMO])) break; if (_sp > XB_SPIN_CAP) { atomicAdd(&(bar)[XB_TMO], 1u); break; } } } } while (0)
struct XcdBarrier { unsigned* bar; unsigned x; volatile LAS unsigned* st; };
__device__ __forceinline__ XcdBarrier xcd_barrier_post(unsigned* bar, volatile LAS unsigned* st) {
    XcdBarrier b; b.bar = bar; b.x = xb_xcc_id(); b.st = st;
    if (threadIdx.x == 0) (void)xb_add(&bar[XB_XCNT(b.x)], 1u);
    return b;
}
__device__ __forceinline__ void xcd_barrier_complete(unsigned* bar, unsigned x, unsigned& nloc, unsigned& nx) {
    const unsigned G = gridDim.x * gridDim.y * gridDim.z;
    unsigned sum, cnt, mine, sp = 0u;
    for (;;) {
        sum = 0u; cnt = 0u; mine = 0u;
#pragma unroll
        for (unsigned j = 0; j < 16; ++j) { const unsigned c = xb_ld(&bar[XB_XCNT(j)]); sum += c; cnt += (c > 0u) ? 1u : 0u; mine = (j == x) ? c : mine; }
        if (sum == G) break;
        __builtin_amdgcn_s_sleep(1);
        if ((++sp & 255u) == 0u) { if (xb_ld(&bar[XB_TMO])) break; if (sp > XB_SPIN_CAP) { atomicAdd(&bar[XB_TMO], 1u); break; } }
    }
    nloc = mine > 0u ? mine : 1u; nx = cnt > 0u ? cnt : 1u;
}
__device__ __forceinline__ void xcd_barrier(const XcdBarrier& b) {
    asm volatile("s_waitcnt vmcnt(0)" ::: "memory");
    __syncthreads();
    if (threadIdx.x == 0) {
        unsigned* bar = b.bar;
        __builtin_amdgcn_s_waitcnt(0);
        unsigned nloc = b.st[0], nx = b.st[1];
        if (nloc == 0u) { xcd_barrier_complete(bar, b.x, nloc, nx); b.st[0] = nloc; b.st[1] = nx; }
        const unsigned old = xb_add(&bar[XB_XSUB(b.x)], 1u);
        const unsigned gen = old / nloc;
        if (old + 1u == (gen + 1u) * nloc) {
            __builtin_amdgcn_fence(__ATOMIC_RELEASE, "agent");
            asm volatile("s_waitcnt vmcnt(0)" ::: "memory");
            const unsigned og = xb_add(&bar[XB_TOP], 1u);
            const unsigned tg = og / nx;
            if (og + 1u == (tg + 1u) * nx) xb_add(&bar[XB_TOPGEN], 1u);
            else XB_SPIN(xb_ld(&bar[XB_TOPGEN]) == tg, bar);
            __builtin_amdgcn_fence(__ATOMIC_ACQUIRE, "agent");
            xb_add(&bar[XB_XGEN(b.x)], 1u);
            asm volatile("s_waitcnt vmcnt(0)" ::: "memory");
        } else {
            XB_SPIN(xb_ld(&bar[XB_XGEN(b.x)]) == gen, bar);
            __builtin_amdgcn_fence(__ATOMIC_ACQUIRE, "agent");
            asm volatile("s_waitcnt vmcnt(0)" ::: "memory");
        }
    }
    __syncthreads();
}

template <int MAP>
DI int colmap(int v, int Nsrc) {
    if (MAP == 0) return v < Nsrc ? v : -1;
    const int g8 = v >> 3, e = v & 7, j = 4 * g8 + (e & 3); return (e < 4) ? j : FF + j;
}
template <int MAP, int KROT = 0>
DI void p0_transpose_item64(const float* W, int K, int Nsrc, const float* gain, bf16_t* WT, LAS float* scr, int kb, int nb, int lane) {
    const int k0 = 64 * kb, n0 = 64 * nb, v = n0 + 4 * (lane & 15);
    const int sc = MAP == 0 ? (v < Nsrc ? v : -1) : ((v >> 3) * 4 + ((v >> 2) & 1) * FF);
#pragma unroll 4
    for (int i = 0; i < 16; ++i) { const int kk = 4 * i + (lane >> 4); int ksrc = k0 + kk + KROT; if (KROT && ksrc >= K) ksrc -= K; f32x4 w = {0.f, 0.f, 0.f, 0.f}; if (sc >= 0) w = *(const f32x4*)(W + (size_t)ksrc * Nsrc + sc); if (gain) w = w * gain[ksrc];
        LAS float* d = scr + kk * 65 + 4 * (lane & 15); d[0] = w[0]; d[1] = w[1]; d[2] = w[2]; d[3] = w[3]; }
    WSYNC();
    const int c = lane & 7;
#pragma unroll
    for (int j = 0; j < 8; ++j) { const int n = (lane >> 3) + 8 * j; const LAS float* s = scr + (8 * c) * 65 + n;
        u32x4 o; o.x = pk2(s[0 * 65], s[1 * 65]); o.y = pk2(s[2 * 65], s[3 * 65]); o.z = pk2(s[4 * 65], s[5 * 65]); o.w = pk2(s[6 * 65], s[7 * 65]);
        *(u32x4*)(WT + (size_t)(n0 + n) * K + k0 + 8 * c) = o; }
    WSYNC();
}
template <int MAP, int KROT = 0>
DI void p0_transpose_item(const float* W, int K, int Nsrc, const float* gain, bf16_t* WT, LAS float* scr, int kb, int nb, int lane) {
    const int k0 = 64 * kb, n0 = 32 * nb;
    const int sc = colmap<MAP>(n0 + (lane & 31), Nsrc);
#pragma unroll 8
    for (int i = 0; i < 32; ++i) { const int kk = 2 * i + (lane >> 5); int ksrc = k0 + kk + KROT; if (KROT && ksrc >= K) ksrc -= K; float w = 0.f; if (sc >= 0) w = W[(size_t)ksrc * Nsrc + sc]; if (gain) w *= gain[ksrc]; scr[kk * 33 + (lane & 31)] = w; }
    WSYNC();
    const int c = lane & 7;
#pragma unroll
    for (int j = 0; j < 4; ++j) { const int n = (lane >> 3) + 8 * j; const LAS float* s = scr + (8 * c) * 33 + n;
        u32x4 o; o.x = pk2(s[0 * 33], s[1 * 33]); o.y = pk2(s[2 * 33], s[3 * 33]); o.z = pk2(s[4 * 33], s[5 * 33]); o.w = pk2(s[6 * 33], s[7 * 33]);
        *(u32x4*)(WT + (size_t)(n0 + n) * K + k0 + 8 * c) = o; }
    WSYNC();
}


typedef float f32x16 __attribute__((ext_vector_type(16)));
typedef float f32x2v __attribute__((ext_vector_type(2)));
typedef __bf16 bf16x2_t __attribute__((ext_vector_type(2)));
constexpr int KSTR = 208, VSTR = 136;
constexpr int AL_K0 = 0, AL_K1 = 64 * KSTR, AL_V0 = 2 * 64 * KSTR, AL_V1 = AL_V0 + 64 * VSTR, AL_IMP = 45056, AL_SELM = AL_IMP + 32768, AL_OACC = AL_SELM + 1024;
constexpr float NEGB = -1e30f, LOG2E = 1.4426950408889634f;
DI unsigned cvtpk(float lo, float hi) { f32x2v v = {lo, hi}; bf16x2_t b = __builtin_convertvector(v, bf16x2_t); return __builtin_bit_cast(unsigned, b); }
DI f32x16 mfma32(bf16x8 a, bf16x8 b, f32x16 c) { return __builtin_amdgcn_mfma_f32_32x32x16_bf16(a, b, c, 0, 0, 0); }
DI float xhalf_max(float v) { auto rr = __builtin_amdgcn_permlane32_swap(__float_as_uint(v), __float_as_uint(v), false, false); return fmaxf(__uint_as_float(rr[0]), __uint_as_float(rr[1])); }
DI float xhalf_sum(float v) { auto rr = __builtin_amdgcn_permlane32_swap(__float_as_uint(v), __float_as_uint(v), false, false); return __uint_as_float(rr[0]) + __uint_as_float(rr[1]); }
DI float ex2(float x) { return __builtin_amdgcn_exp2f(x); }
template <int KSTEPS>
DI void qk_tile(const LAS unsigned char* Kt, const bf16x8 (&qf)[KSTEPS], int r32, int hi, f32x16& s0, f32x16& s1) {
    const LAS unsigned char* p0 = Kt + r32 * KSTR + hi * 16;
#pragma unroll
    for (int i = 0; i < 16; ++i) { s0[i] = 0.f; s1[i] = 0.f; }
#pragma unroll
    for (int ks = 0; ks < KSTEPS; ++ks) {
        const bf16x8 a0 = *(const LAS bf16x8*)(p0 + ks * 32), a1 = *(const LAS bf16x8*)(p0 + 32 * KSTR + ks * 32);
        s0 = mfma32(a0, qf[ks], s0); s1 = mfma32(a1, qf[ks], s1);
    }
}
DI void mask_tile(f32x16& s0, f32x16& s1, int klo, int khi, int hi) {
    const int lo_ = klo - 4 * hi, hi_ = khi - 4 * hi;
#pragma unroll
    for (int i = 0; i < 16; ++i) { const int kb = (i & 3) + 8 * (i >> 2); if (kb < lo_ || kb > hi_) s0[i] = NEGB; if (kb + 32 < lo_ || kb + 32 > hi_) s1[i] = NEGB; }
}
DI float tile_max(const f32x16& s0, const f32x16& s1) {
    float mx = fmaxf(s0[0], s1[0]);
#pragma unroll
    for (int i = 1; i < 16; ++i) mx = fmaxf(mx, fmaxf(s0[i], s1[i]));
    return xhalf_max(mx);
}
template <int BASE> DI bf16x8 pack8(const f32x16& s) { u32x4 p; p.x = cvtpk(s[BASE], s[BASE + 1]); p.y = cvtpk(s[BASE + 2], s[BASE + 3]); p.z = cvtpk(s[BASE + 4], s[BASE + 5]); p.w = cvtpk(s[BASE + 6], s[BASE + 7]); return __builtin_bit_cast(bf16x8, p); }
DI bf16x8 ld8x2(const bf16_t* p) { const u32x2 a = *(const u32x2*)p, b = *(const u32x2*)(p + 4); u32x4 w; w.x = a.x; w.y = a.y; w.z = b.x; w.w = b.y; return __builtin_bit_cast(bf16x8, w); }
DI bf16x8 vfrag(const LAS unsigned char* p) { const u32x2 a = *(const LAS u32x2*)p, b = *(const LAS u32x2*)(p + 16); u32x4 w; w.x = a.x; w.y = a.y; w.z = b.x; w.w = b.y; return __builtin_bit_cast(bf16x8, w); }
template <int VS = VSTR>
DI void pv_tile(const f32x16& s0, const f32x16& s1, const LAS unsigned char* Vt, f32x16 (&o)[2], int r32, int hi) {
    const bf16x8 p00 = pack8<0>(s0), p01 = pack8<8>(s0), p10 = pack8<0>(s1), p11 = pack8<8>(s1);
#pragma unroll
    for (int dt = 0; dt < 2; ++dt) { const LAS unsigned char* vp = Vt + (32 * dt + r32) * VS + 8 * hi;
        o[dt] = mfma32(vfrag(vp), p00, o[dt]); o[dt] = mfma32(vfrag(vp + 32), p01, o[dt]); o[dt] = mfma32(vfrag(vp + 64), p10, o[dt]); o[dt] = mfma32(vfrag(vp + 96), p11, o[dt]); }
}
DI void softmax_pv(f32x16& s0, f32x16& s1, const LAS unsigned char* Vt, f32x16 (&o)[2], float& m, float& l, int r32, int hi) {
    const float mx = tile_max(s0, s1), mn = fmaxf(m, mx), ms = mn < -1e29f ? 0.f : mn, alpha = ex2(m - ms);
    m = mn; float psum = 0.f;
#pragma unroll
    for (int i = 0; i < 16; ++i) { s0[i] = ex2(s0[i] - ms); s1[i] = ex2(s1[i] - ms); psum += s0[i] + s1[i]; }
    l = l * alpha + psum;
    if (!__all(alpha == 1.f)) {
#pragma unroll
        for (int i = 0; i < 16; ++i) { o[0][i] *= alpha; o[1][i] *= alpha; } }
    pv_tile(s0, s1, Vt, o, r32, hi);
}
struct SoftState { float m, l; };
constexpr float SM_THR = 8.f;
DI void soft_init(SoftState& S, f32x16 (&o)[2]) { S.m = 0.f; S.l = 0.f;
#pragma unroll
    for (int i = 0; i < 16; ++i) { o[0][i] = 0.f; o[1][i] = 0.f; } }
DI f32x16 bcast16(float v) { f32x16 c;
#pragma unroll
    for (int i = 0; i < 16; ++i) c[i] = v;
    return c; }
DI float max3f(float a, float b, float c) { float r; asm("v_max3_f32 %0, %1, %2, %3" : "=v"(r) : "v"(a), "v"(b), "v"(c)); return r; }
DI float soft_update(f32x16& s0, f32x16& s1, SoftState& S, f32x16 (&o)[2], bool masked, int klo, int khi, bool first, int hi, float adj = 0.f) {
    if (__any(adj != 0.f)) {
#pragma unroll
        for (int i = 0; i < 16; ++i) { s0[i] -= adj; s1[i] -= adj; } }
    float dl_ret = 0.f;
    if (__builtin_expect(masked, 0)) { asm volatile("; boundary tile mask" ::: "memory"); mask_tile(s0, s1, klo, khi, hi); }
    asm volatile("s_nop 15\n\ts_nop 7" : "+v"(s0), "+v"(s1));
    float rm;
    { float a = max3f(s0[0], s0[1], s0[2]), b = max3f(s1[0], s1[1], s1[2]);
#pragma unroll
      for (int i = 3; i < 15; i += 2) { a = max3f(a, s0[i], s0[i + 1]); b = max3f(b, s1[i], s1[i + 1]); }
      rm = xhalf_max(fmaxf(max3f(a, b, s0[15]), s1[15])); }
    if (first) {
        const float dl = rm < -1e29f ? 0.f : rm; S.m = dl; dl_ret = dl;
#pragma unroll
        for (int i = 0; i < 16; ++i) { s0[i] -= dl; s1[i] -= dl; }
    } else if (__any(rm > SM_THR)) {
        const float dl = fmaxf(rm, 0.f), alpha = ex2(-dl); S.m += dl; S.l *= alpha; dl_ret = dl;
#pragma unroll
        for (int i = 0; i < 16; ++i) { s0[i] -= dl; s1[i] -= dl; o[0][i] *= alpha; o[1][i] *= alpha; }
    }
    float p0 = 0.f, p1 = 0.f, p2 = 0.f, p3 = 0.f;
#pragma unroll
    for (int i = 0; i < 16; i += 2) { s0[i] = ex2(s0[i]); s0[i + 1] = ex2(s0[i + 1]); s1[i] = ex2(s1[i]); s1[i + 1] = ex2(s1[i + 1]); p0 += s0[i]; p1 += s0[i + 1]; p2 += s1[i]; p3 += s1[i + 1]; }
    S.l += (p0 + p1) + (p2 + p3);
    return dl_ret;
}
template <int KSTEPS, int VS = VSTR>
DI void attn_step(const LAS unsigned char* Kt, const LAS unsigned char* Vt, const bf16x8 (&qf)[KSTEPS], SoftState& S, f32x16 (&o)[2], bool masked, int klo, int khi, bool first, int r32, int hi) {
    const f32x16 cinit = bcast16(-S.m); f32x16 s0 = cinit, s1 = cinit;
    { const LAS unsigned char* p0 = Kt + r32 * KSTR + hi * 16;
#pragma unroll
      for (int ks = 0; ks < KSTEPS; ++ks) { const bf16x8 a0 = *(const LAS bf16x8*)(p0 + ks * 32), a1 = *(const LAS bf16x8*)(p0 + 32 * KSTR + ks * 32);
          s0 = mfma32(a0, qf[ks], s0); s1 = mfma32(a1, qf[ks], s1); } }
    soft_update(s0, s1, S, o, masked, klo, khi, first, hi);
    pv_tile<VS>(s0, s1, Vt, o, r32, hi);
}
template <int KSTEPS, int VS>
DI void attn_step2(const LAS unsigned char* Kt, const LAS unsigned char* Vt, const bf16x8 (&qf)[KSTEPS], SoftState& S, f32x16 (&o)[2], bool masked0, int khi0, bool masked1, int khi1, bool first, int r32, int hi) {
    const f32x16 cinit = bcast16(-S.m); f32x16 a0 = cinit, a1 = cinit, b0 = cinit, b1 = cinit;
    { const LAS unsigned char* p0 = Kt + r32 * KSTR + hi * 16;
#pragma unroll
      for (int ks = 0; ks < KSTEPS; ++ks) { const bf16x8 k0 = *(const LAS bf16x8*)(p0 + ks * 32), k1 = *(const LAS bf16x8*)(p0 + 32 * KSTR + ks * 32);
          a0 = mfma32(k0, qf[ks], a0); a1 = mfma32(k1, qf[ks], a1); }
#pragma unroll
      for (int ks = 0; ks < KSTEPS; ++ks) { const bf16x8 k0 = *(const LAS bf16x8*)(p0 + 64 * KSTR + ks * 32), k1 = *(const LAS bf16x8*)(p0 + 96 * KSTR + ks * 32);
          b0 = mfma32(k0, qf[ks], b0); b1 = mfma32(k1, qf[ks], b1); } }
    const float dl0 = soft_update(a0, a1, S, o, masked0, 0, khi0, first, hi);
    pv_tile<VS>(a0, a1, Vt, o, r32, hi);
    (void)soft_update(b0, b1, S, o, masked1, 0, khi1, false, hi, dl0);
    pv_tile<VS>(b0, b1, Vt + 128, o, r32, hi);
}
struct StageRegs { u32x4 a, b, c, d, e; };
template <class LoadF, class StoreF, class StepF>
DI void attn_pipeline(int jbeg, int jend, LoadF ld, StoreF st, StepF step) {
    if (jbeg > jend) return;
    StageRegs RA;
    ld(jbeg, RA); st(0, RA); __syncthreads();
    for (int j = jbeg; j <= jend; j += 2) {
        if (j + 1 <= jend) ld(j + 1, RA);
        step(j, 0);
        if (j + 1 <= jend) st(1, RA);
        __syncthreads();
        if (j + 1 > jend) break;
        if (j + 2 <= jend) ld(j + 2, RA);
        step(j + 1, 1);
        if (j + 2 <= jend) st(0, RA);
        __syncthreads();
    }
}
DI const float* inp(const Args& a, int k) { asm volatile("" : "+s"(k)); return a.in[k]; }
__global__ void __launch_bounds__(NTHR, 2) fwd(Args args) {
    extern __shared__ __attribute__((aligned(16))) unsigned char lds_raw[];
    LAS unsigned char* lds = (LAS unsigned char*)lds_raw;
    LAS float* ldsf = (LAS float*)lds;
    volatile LAS unsigned* LCTL = (volatile LAS unsigned*)(lds + LDS_CTL);
    const int tid0 = threadIdx.x, wave = __builtin_amdgcn_readfirstlane(tid0 >> 6);
    const int G = gridDim.x, bid = blockIdx.x;
#define LAUNDER_TID() int tid = tid0; asm volatile("" : "+v"(tid)); const int lane = tid & 63; (void)lane
#define WS_PTRS() unsigned char* ws = args.ws; asm volatile("" : "+s"(ws)); \
    unsigned* ctl = (unsigned*)(ws + WS_CTL); float* ssp_base = (float*)(ws + WS_SSP); float* hb = (float*)(ws + WS_HB); \
    bf16_t* XB = (bf16_t*)(ws + WS_XB); bf16_t* Y = (bf16_t*)(ws + WS_Y); bf16_t* PB = (bf16_t*)(ws + WS_PB); bf16_t* ACT = (bf16_t*)(ws + WS_ACT); \
    const float2* cs64 = (const float2*)(ws + WS_CS64); const float2* cs32 = (const float2*)(ws + WS_CS32); \
    float* LRA = args.out; float* LRU_ = args.out + (size_t)M * 256; \
    float* LA = (float*)(ws + WS_LA); float* LH = (float*)(ws + WS_LH); float* CIN = (float*)(ws + WS_CIN); \
    float* KVC = (float*)(ws + WS_KVC); float* DEC = (float*)(ws + WS_DEC); float* SST = (float*)(ws + WS_SST); \
    bf16_t* MQ = (bf16_t*)(ws + WS_MQ); bf16_t* MKN = (bf16_t*)(ws + WS_MKN); bf16_t* MVT = (bf16_t*)(ws + WS_MV); bf16_t* MKR = (bf16_t*)(ws + WS_MKR); \
    bf16_t* VST = (bf16_t*)(ws + WS_VST); bf16_t* KSF = (bf16_t*)(ws + WS_KSF); (void)KSF; bf16_t* VWT = (bf16_t*)(ws + WS_VWT); bf16_t* KCMPB = (bf16_t*)(ws + WS_KCMPB); bf16_t* VCMPT = (bf16_t*)(ws + WS_VCMPT); \
    const float* ssq_mix = ssp_base + (size_t)(l_ == 0 ? 0 : 2) * 4 * M; float* ssq_out = ssp_base + (size_t)(1 + 3 * l_) * 4 * M; float* ssq_down = ssp_base + (size_t)(2 + 3 * l_) * 4 * M; float* ssq_d = ssp_base + (size_t)(3 + 3 * l_) * 4 * M; \
    (void)ctl; (void)hb; (void)XB; (void)Y; (void)PB; (void)ACT; (void)cs64; (void)cs32; (void)LRA; (void)LRU_; (void)LA; (void)LH; (void)CIN; (void)KVC; (void)DEC; (void)SST; (void)MQ; (void)MKN; (void)MVT; (void)MKR; (void)VST; (void)VWT; (void)KCMPB; (void)VCMPT; (void)ssq_mix; (void)ssq_out; (void)ssq_down; (void)ssq_d
    unsigned* ctl0 = (unsigned*)(args.ws + WS_CTL);
    { LAUNDER_TID(); if (tid < 16) LCTL[tid] = 0u; }
    __syncthreads();
    const int lo = args.ph_lo, hi = args.ph_hi;
    XcdBarrier bar; bar.bar = ctl0 + CW_BAR; bar.x = 0; bar.st = LCTL;
    if (hi - lo > 1) bar = xcd_barrier_post(ctl0 + CW_BAR, LCTL);
#define IN(k) (lo <= (k) && (k) < hi)
#define SEAM(k) do { if (IN(k) && IN((k) + 1)) xcd_barrier(bar); } while (0)

    if (IN(0)) {
        const int l_ = 0; WS_PTRS();
      _Pragma("unroll 1") for (int rep = 0; rep < REP_P0; ++rep) {
        LAUNDER_TID();
        const int gw = bid * 8 + wave, NGW = G * 8;
        LAS float* scr = ldsf + wave * 4224; LAS float* scr64 = scr;
        constexpr int I_IN = 16 * 36, I_OUT = 16 * 16, I_GU = 16 * 88, I_DN = 44 * 16, I_L = I_IN + I_OUT + I_GU + I_DN;
        for (int it = gw; it < 2 * I_L; it += NGW) {
            const int l = it / I_L; int r = it % I_L;
            if (r < I_IN) { p0_transpose_item64<0>(inp(args, 3) + (size_t)l * DM * NINS, DM, NINS, inp(args, 2) + l * DM, (bf16_t*)(ws + WS_WIN) + (size_t)l * NIN * DM, scr64, r / 36, r % 36, lane); continue; } r -= I_IN;
            if (r < I_OUT) { p0_transpose_item64<0, 768>(inp(args, 23) + (size_t)l * DM * DM, DM, DM, inp(args, 22) + l * DM, (bf16_t*)(ws + WS_WOUT) + (size_t)l * DM * DM, scr64, r / 16, r % 16, lane); continue; } r -= I_OUT;
            if (r < I_GU) { p0_transpose_item64<1>(inp(args, 25) + (size_t)l * DM * NGU, DM, NGU, inp(args, 24) + l * DM, (bf16_t*)(ws + WS_WGU) + (size_t)l * NGU * DM, scr64, r / 88, r % 88, lane); continue; } r -= I_GU;
            p0_transpose_item64<0>(inp(args, 26) + (size_t)l * FF * DM, FF, DM, nullptr, (bf16_t*)(ws + WS_WDN) + (size_t)l * DM * FF, scr64, r / 16, r % 16, lane);
        }
        { constexpr int I_UQ = 3 * 12, I_UKV = 2 * 16, I_W1 = 32 * 8, I_W2 = 4 * 2, I_S = 2 * I_UQ + 2 * I_UKV + 4 * I_W1 + 4 * I_W2;
          for (int it = gw; it < I_S; it += NGW) { int r = it;
              if (r < 2 * I_UQ) { const int l = r / I_UQ; r %= I_UQ; p0_transpose_item<0>(inp(args, 20) + (size_t)l * 192 * 384, 192, 384, inp(args, 18) + l * 192, (bf16_t*)(ws + WS_WUQT) + (size_t)l * 384 * 192, scr, r / 12, r % 12, lane); continue; } r -= 2 * I_UQ;
              if (r < 2 * I_UKV) { const int l = r / I_UKV; r %= I_UKV; p0_transpose_item<0>(inp(args, 21) + (size_t)l * 128 * 512, 128, 512, inp(args, 19) + l * 128, (bf16_t*)(ws + WS_WUKVT) + (size_t)l * 512 * 128, scr, r / 16, r % 16, lane); continue; } r -= 2 * I_UKV;
              if (r < 4 * I_W1) { const int lj = r / I_W1; r %= I_W1; p0_transpose_item<0>(inp(args, 12) + (size_t)lj * 2048 * 256, 2048, 256, nullptr, (bf16_t*)(ws + WS_W1T) + (size_t)lj * 256 * 2048, scr, r / 8, r % 8, lane); continue; } r -= 4 * I_W1;
              { const int lj = r / I_W2; r %= I_W2; p0_transpose_item<0>(inp(args, 14) + (size_t)lj * 256 * 64, 256, 64, nullptr, (bf16_t*)(ws + WS_W2T) + (size_t)lj * 64 * 256, scr, r / 2, r % 2, lane); } } }
        for (int e = bid * NTHR + tid; e < 2 * 2 * 4 * 64 * 64; e += G * NTHR) {
            const int k = e & 63, n = (e >> 6) & 63, h = (e >> 12) & 3, g = (e >> 14) & 1, l = e >> 15;
            ((bf16_t*)(ws + WS_WGT))[e] = f2bf((g == 0 ? inp(args, 6) : inp(args, 8))[(((size_t)l * 4 + h) * 64 + k) * 64 + n]); }
        for (int e = bid * NTHR + tid; e < 512; e += G * NTHR) ((float*)(ws + WS_SP))[e] = log1pf(expf(-inp(args, 10)[e]));
        for (int m = gw; m < M; m += NGW) {
            const f32x4* xr = (const f32x4*)(inp(args, 0) + (size_t)m * DM) + lane;
            f32x4 v[4]; float s = 0.f;
#pragma unroll
            for (int j = 0; j < 4; ++j) { v[j] = xr[64 * j]; s += v[j][0] * v[j][0] + v[j][1] * v[j][1] + v[j][2] * v[j][2] + v[j][3] * v[j][3]; }
            s = wave_sum(s);
            u32x2* o8 = (u32x2*)(XB + (size_t)m * DM) + lane;
#pragma unroll
            for (int j = 0; j < 4; ++j) { u32x2 w; w.x = pk2(v[j][0], v[j][1]); w.y = pk2(v[j][2], v[j][3]); o8[64 * j] = w; }
            if (lane < 4) ssp_base[(size_t)lane * M + m] = lane == 0 ? s : 0.f;
        }
        for (int e = bid * NTHR + tid; e < M * 32; e += G * NTHR) {
            const int m = e >> 5, i = e & 31; const float pos = (float)((const int*)inp(args, 1))[m];
            const float invf = powf(10000.f, -(float)(2 * i) / 64.f); float sn, cs; sincosf(pos * invf, &sn, &cs);
            ((float2*)(ws + WS_CS64))[e] = make_float2(cs, sn);
            if (i < 16) { const float invf2 = powf(10000.f, -(float)(2 * i) / 32.f); sincosf(pos * invf2, &sn, &cs); ((float2*)(ws + WS_CS32))[m * 16 + i] = make_float2(cs, sn); }
        }
        for (int e = bid * NTHR + tid; e < 2 * 2 * 256; e += G * NTHR) {
            const int lj = e >> 8, c = e & 255; float a = inp(args, 13)[e];
            const float* pp = inp(args, 11) + (size_t)lj * 2048; const float* w1 = inp(args, 12) + (size_t)lj * 2048 * 256 + c;
            for (int i = 0; i < 2048; ++i) a += pp[i] * w1[(size_t)i * 256];
            hb[e] = a;
        }
      }
    }
    SEAM(0);

    for (int l = 0; l < 2; ++l) {
        const int pb = 1 + 6 * l;
        if (IN(pb)) {
        const int l_ = l; WS_PTRS();
            pg8::Gemm g{XB, (const bf16_t*)(ws + WS_WIN) + (size_t)l * NIN * DM, M, NIN, DM}; pg8::StaticOrder S; S.init(M, NIN, G, bid);
            pg8::EpiInProj E{PB, NIN, ssq_mix};
            _Pragma("unroll 1") for (int rep = 0; rep < REP_G16; ++rep) pg8::gemm_phase<pg8::EpiInProj, pg8::StaticOrder, true, true>(lds, g, S, E);
        }
        SEAM(pb);
        if (IN(pb + 1)) {
        const int l_ = l; WS_PTRS();
        LAUNDER_TID();
            constexpr int N_J1 = 1024, N_J2 = 512, N_J3 = 512, N_J4 = 512, N_J4B = 128;
            {
            for (int r_ = bid; r_ < N_J4B * REP_J4B; r_ += G) { const int r = r_ % N_J4B;
                    const int j = r & 1, g32 = (r >> 1) & 15, b = r >> 5; const int colb = j == 0 ? C_KC : C_VC; const int r32 = lane & 31, hi = lane >> 5;
                    LAS unsigned char* Tl = lds;
                    LAS unsigned char* Hl = lds + 69632;
                    for (int e = tid; e < 528 * 8; e += NTHR) { const int rr = e >> 3, c8 = e & 7, t = 512 * g32 + rr; u32x4 w = {0u, 0u, 0u, 0u};
                        if (t < SEQ) { const bf16_t* pr = PB + ((size_t)b * SEQ + t) * NIN + colb;
                            if (j == 0) { const u32x4 a = *(const u32x4*)(pr + 8 * (c8 & 3)), c = *(const u32x4*)(pr + 32 + 8 * (c8 & 3)); const float2* cs = cs64 + ((size_t)b * SEQ + t) * 32 + 8 * (c8 & 3);
                                const unsigned au[4] = {a.x, a.y, a.z, a.w}, cu[4] = {c.x, c.y, c.z, c.w}; unsigned ou[4];
#pragma unroll
                                for (int q = 0; q < 4; ++q) { const float2 s0 = cs[2 * q], s1 = cs[2 * q + 1]; const float x1a = bflo(au[q]), x1b = bfhi(au[q]), x2a = bflo(cu[q]), x2b = bfhi(cu[q]);
                                    ou[q] = c8 < 4 ? pk2(x1a * s0.x - x2a * s0.y, x1b * s1.x - x2b * s1.y) : pk2(x2a * s0.x + x1a * s0.y, x2b * s1.x + x1b * s1.y); }
                                w.x = ou[0]; w.y = ou[1]; w.z = ou[2]; w.w = ou[3]; }
                            else w = *(const u32x4*)(pr + 8 * c8); }
                        *(LAS u32x4*)(Tl + rr * 128 + (rr >> 4) * 16 + c8 * 16) = w; }
                    __syncthreads();
                    { const bf16_t* w1t = (const bf16_t*)(ws + WS_W1T) + ((size_t)(l * 2 + j) * 256 + 32 * wave + r32) * 2048 + 8 * hi;
                      f32x16 acc;
#pragma unroll
                      for (int i = 0; i < 16; ++i) acc[i] = 0.f;
#pragma unroll 8
                      for (int kk = 0; kk < 128; ++kk) { const int rowt = 16 * r32 + (kk >> 2);
                          const bf16x8 a = *(const LAS bf16x8*)(Tl + rowt * 128 + (rowt >> 4) * 16 + 32 * (kk & 3) + 16 * hi);
                          const bf16x8 bw = *(const bf16x8*)(w1t + 16 * kk);
                          acc = mfma32(a, bw, acc); }
                      const float hbv = hb[(l * 2 + j) * 256 + 32 * wave + r32];
#pragma unroll
                      for (int i = 0; i < 16; ++i) { const int n = (i & 3) + 8 * (i >> 2) + 4 * hi; *(LAS bf16_t*)(Hl + n * 528 + (32 * wave + r32) * 2) = f2bf(gelu_tanh(acc[i] + hbv)); } }
                    __syncthreads();
                    if (wave < 2) { const bf16_t* w2t = (const bf16_t*)(ws + WS_W2T) + ((size_t)(l * 2 + j) * 64 + 32 * wave + r32) * 256 + 8 * hi;
                      f32x16 acc;
#pragma unroll
                      for (int i = 0; i < 16; ++i) acc[i] = 0.f;
#pragma unroll
                      for (int kk = 0; kk < 16; ++kk) { const bf16x8 a = *(const LAS bf16x8*)(Hl + r32 * 528 + 32 * kk + 16 * hi); const bf16x8 bw = *(const bf16x8*)(w2t + 16 * kk); acc = mfma32(a, bw, acc); }
                      const int dd = 32 * wave + r32;
#pragma unroll
                      for (int g = 0; g < 4; ++g) { const int n0 = 32 * g32 + 8 * g + 4 * hi; float v[4];
#pragma unroll
                          for (int q = 0; q < 4; ++q) v[q] = (n0 + q < 511) ? acc[4 * g + q] : 0.f;
                          if (j == 0) {
#pragma unroll
                              for (int q = 0; q < 4; ++q) KCMPB[((size_t)b * 512 + n0 + q) * 64 + dd] = f2bf(v[q]); }
                          else { u32x2 w; w.x = pk2(v[0], v[1]); w.y = pk2(v[2], v[3]); *(u32x2*)(VCMPT + ((size_t)b * 64 + dd) * 512 + n0) = w; } } }
                    __syncthreads();
            }
            if (bid < N_J3) {
                const int fr = lane & 15, kq = lane >> 4, hh = wave >> 1, odd = wave & 1;
                {
                    bf16x8 bq[3][6];
                    { const bf16_t* wq = (const bf16_t*)(ws + WS_WUQT) + (size_t)l * 384 * 192;
#pragma unroll
                      for (int nt = 0; nt < 3; ++nt)
#pragma unroll
                          for (int ks = 0; ks < 6; ++ks) bq[nt][ks] = *(const bf16x8*)(wq + (size_t)(48 * wave + 16 * nt + fr) * 192 + 32 * ks + 8 * kq); }
                    for (int r_ = bid; r_ < N_J3 * REP_J3; r_ += G) { const int r = r_ % N_J3;
                        const size_t row0 = (size_t)r * 64;
#pragma unroll 1
                        for (int mt = 0; mt < 4; ++mt) {
                            const bf16_t* pa = PB + (row0 + mt * 16 + fr) * NIN;
                            bf16x8 aq[6]; float ssq_ = 0.f;
#pragma unroll
                            for (int ks = 0; ks < 6; ++ks) { aq[ks] = ld8x2(pa + C_DCQ + 32 * ks + 8 * kq);
#pragma unroll
                                for (int e = 0; e < 8; ++e) { const float v = bf2f((bf16_t)aq[ks][e]); ssq_ += v * v; } }
                            ssq_ += __shfl_xor(ssq_, 16); ssq_ += __shfl_xor(ssq_, 32);
                            const float rq_ = rsqrtf(ssq_ * (1.f / 192.f) + EPS);
                            f32x4 cq[3];
#pragma unroll
                            for (int nt = 0; nt < 3; ++nt) { cq[nt] = (f32x4){0.f, 0.f, 0.f, 0.f};
#pragma unroll
                                for (int ks = 0; ks < 6; ++ks) cq[nt] = __builtin_amdgcn_mfma_f32_16x16x32_bf16(aq[ks], bq[nt][ks], cq[nt], 0, 0, 0); }
                            const float SCQ = 0.10206207261596575f * LOG2E;
#pragma unroll
                            for (int i = 0; i < 4; ++i) {
                                const size_t row = row0 + mt * 16 + 4 * kq + i; const float rqi = __shfl(rq_, 4 * kq + i) * SCQ;
                                float q0 = cq[0][i] * rqi, q1 = cq[1][i] * rqi, q2 = cq[2][i] * rqi;
                                if (odd) { const float2 cs = cs32[row * 16 + fr]; const float x1 = q1, x2 = q2; q1 = x1 * cs.x - x2 * cs.y; q2 = x2 * cs.x + x1 * cs.y; }
                                bf16_t* mq = MQ + row * 384 + hh * 96 + 48 * odd + fr; mq[0] = f2bf(q0); mq[16] = f2bf(q1); mq[32] = f2bf(q2);
                            }
                            if (wave == mt) {
#pragma unroll
                                for (int q = 0; q < 4; ++q) { const int p = lane * 4 + q, tok = p >> 4, i = p & 15; const size_t row = row0 + mt * 16 + tok; const bf16_t* pr = PB + row * NIN + C_DKR;
                                    const float x1 = bf2f(pr[i]), x2 = bf2f(pr[16 + i]); const float2 cs = cs32[row * 16 + i];
                                    MKR[row * 32 + i] = f2bf(x1 * cs.x - x2 * cs.y); MKR[row * 32 + 16 + i] = f2bf(x2 * cs.x + x1 * cs.y); } }
                        }
                    }
                }
                {
                    bf16x8 bkv[4][4];
                    { const bf16_t* wkv = (const bf16_t*)(ws + WS_WUKVT) + (size_t)l * 512 * 128;
#pragma unroll
                      for (int nt = 0; nt < 4; ++nt)
#pragma unroll
                          for (int ks = 0; ks < 4; ++ks) bkv[nt][ks] = *(const bf16x8*)(wkv + (size_t)(64 * wave + 16 * nt + fr) * 128 + 32 * ks + 8 * kq); }
                    for (int r_ = bid; r_ < N_J3 * REP_J3; r_ += G) { const int r = r_ % N_J3;
                        const size_t row0 = (size_t)r * 64; const size_t bb = row0 / SEQ, t0 = row0 % SEQ;
#pragma unroll 1
                        for (int mt = 0; mt < 4; ++mt) {
                            const bf16_t* pa = PB + (row0 + mt * 16 + fr) * NIN;
                            bf16x8 akv[4]; float sskv_ = 0.f;
#pragma unroll
                            for (int ks = 0; ks < 4; ++ks) { akv[ks] = ld8x2(pa + C_DCKV + 32 * ks + 8 * kq);
#pragma unroll
                                for (int e = 0; e < 8; ++e) { const float v = bf2f((bf16_t)akv[ks][e]); sskv_ += v * v; } }
                            sskv_ += __shfl_xor(sskv_, 16); sskv_ += __shfl_xor(sskv_, 32);
                            const float rk_ = rsqrtf(sskv_ * (1.f / 128.f) + EPS);
                            f32x4 ckv[4];
#pragma unroll
                            for (int nt = 0; nt < 4; ++nt) { ckv[nt] = (f32x4){0.f, 0.f, 0.f, 0.f};
#pragma unroll
                                for (int ks = 0; ks < 4; ++ks) ckv[nt] = __builtin_amdgcn_mfma_f32_16x16x32_bf16(akv[ks], bkv[nt][ks], ckv[nt], 0, 0, 0); }
                            float rki[4];
#pragma unroll
                            for (int i = 0; i < 4; ++i) rki[i] = __shfl(rk_, 4 * kq + i);
                            if (!odd) {
#pragma unroll
                                for (int i = 0; i < 4; ++i) { bf16_t* mk = MKN + (row0 + mt * 16 + 4 * kq + i) * 256 + hh * 64 + fr;
                                    mk[0] = f2bf(ckv[0][i] * rki[i]); mk[16] = f2bf(ckv[1][i] * rki[i]); mk[32] = f2bf(ckv[2][i] * rki[i]); mk[48] = f2bf(ckv[3][i] * rki[i]); } }
                            else {
#pragma unroll
                                for (int nt = 0; nt < 4; ++nt) { u32x2 w; w.x = pk2(ckv[nt][0] * rki[0], ckv[nt][1] * rki[1]); w.y = pk2(ckv[nt][2] * rki[2], ckv[nt][3] * rki[3]);
                                    *(u32x2*)(MVT + ((bb * 4 + hh) * 64 + 16 * nt + fr) * SEQ + t0 + mt * 16 + 4 * kq) = w; } }
                        }
                    }
                }
            }
            {
                const int r32 = lane & 31, hi = lane >> 5, gh = wave >> 1, gg = wave & 1, ch = tid & 255, half = tid >> 8;
                bf16x8 bW[2][4];
                { const bf16_t* wt = (const bf16_t*)(ws + WS_WGT) + (size_t)(((l * 2 + gg) * 4 + gh) * 64) * 64;
#pragma unroll
                  for (int nt = 0; nt < 2; ++nt)
#pragma unroll
                      for (int ks = 0; ks < 4; ++ks) bW[nt][ks] = *(const bf16x8*)(wt + (size_t)(32 * nt + r32) * 64 + 16 * ks + 8 * hi); }
                const float gbias0 = (gg == 0 ? inp(args, 7) : inp(args, 9))[l * 256 + gh * 64 + r32], gbias1 = (gg == 0 ? inp(args, 7) : inp(args, 9))[l * 256 + gh * 64 + 32 + r32];
                const float cw0 = inp(args, 4)[(l * 4 + 0) * 256 + ch], cw1 = inp(args, 4)[(l * 4 + 1) * 256 + ch], cw2 = inp(args, 4)[(l * 4 + 2) * 256 + ch], cw3 = inp(args, 4)[(l * 4 + 3) * 256 + ch], cb = inp(args, 5)[l * 256 + ch];
                const float sp = ((const float*)(ws + WS_SP))[l * 256 + ch];
                LAS float* xa = ldsf; LAS float* xc = ldsf + 35 * 256; LAS unsigned char* xcb = lds + 67 * 1024; LAS float* gR = (LAS float*)(lds + 67 * 1024 + 32 * 528); LAS float* gI = gR + 32 * 256;
            for (int r_ = bid; r_ < N_J1 * REP_J1; r_ += G) { const int r = r_ % N_J1;
                    const int b = r >> 8, tb = r & 255, t0 = tb * 32;
                    for (int c = tid; c < 35 * 32; c += NTHR) { const int rr = c >> 5, c8 = c & 31, t = t0 - 3 + rr; u32x4 w = {0u, 0u, 0u, 0u}; if (t >= 0) w = *(const u32x4*)(PB + ((size_t)b * SEQ + t) * NIN + C_AX + 8 * c8);
                        LAS f32x4* d = (LAS f32x4*)(xa + rr * 256 + 8 * c8); d[0] = (f32x4){bflo(w.x), bfhi(w.x), bflo(w.y), bfhi(w.y)}; d[1] = (f32x4){bflo(w.z), bfhi(w.z), bflo(w.w), bfhi(w.w)}; }
                    __syncthreads();
#pragma unroll 4
                    for (int tt = 0; tt < 16; ++tt) { const int rr = half * 16 + tt; const float v = cb + cw0 * xa[rr * 256 + ch] + cw1 * xa[(rr + 1) * 256 + ch] + cw2 * xa[(rr + 2) * 256 + ch] + cw3 * xa[(rr + 3) * 256 + ch];
                        xc[rr * 256 + ch] = v; *(LAS bf16_t*)(xcb + rr * 528 + ch * 2) = f2bf(v); }
                    __syncthreads();
                    { f32x16 acc[2];
#pragma unroll
                      for (int i = 0; i < 16; ++i) { acc[0][i] = 0.f; acc[1][i] = 0.f; }
#pragma unroll
                      for (int ks = 0; ks < 4; ++ks) { const bf16x8 a = *(const LAS bf16x8*)(xcb + r32 * 528 + (gh * 64 + 16 * ks + 8 * hi) * 2); acc[0] = mfma32(a, bW[0][ks], acc[0]); acc[1] = mfma32(a, bW[1][ks], acc[1]); }
                      LAS float* gd = gg == 0 ? gR : gI;
#pragma unroll
                      for (int i = 0; i < 16; ++i) { const int tok = (i & 3) + 8 * (i >> 2) + 4 * hi; gd[tok * 256 + gh * 64 + r32] = sigmoidf_(acc[0][i] + gbias0); gd[tok * 256 + gh * 64 + 32 + r32] = sigmoidf_(acc[1][i] + gbias1); } }
                    __syncthreads();
                    float hst = 0.f, Ac = 1.f;
#pragma unroll 4
                    for (int tt = 0; tt < 16; ++tt) {
                        const int rr = half * 16 + tt;
                        const float la = -8.f * gR[rr * 256 + ch] * sp, x2 = 2.f * la;
                        const float av = la > -0.25f ? 1.f + la * (1.f + la * (0.5f + la * (0.16666667f + la * (0.041666667f + la * 0.0083333333f)))) : __expf(la);
                        const float om = x2 > -0.5f ? -x2 * (1.f + x2 * (0.5f + x2 * (0.16666667f + x2 * (0.041666667f + x2 * (0.0083333333f + x2 * 0.0013888889f))))) : 1.f - __expf(x2);
                        const float u = __builtin_amdgcn_sqrtf(om) * (gI[rr * 256 + ch] * xc[rr * 256 + ch]);
                        hst = av * hst + u; Ac *= av;
                        { const size_t ao = ((size_t)b * SEQ + t0 + rr) * 256 + ch; LRA[ao] = av; LRU_[ao] = u; }
                    }
                    const size_t so = ((size_t)(b * 512 + tb * 2 + half)) * 256 + ch;
                    LA[so] = Ac; LH[so] = hst;
                    __syncthreads();
            }
            }
            {
                const int kk = tid & 127, tq = tid >> 7, r32 = lane & 31, hi = lane >> 5;
                float wg[16]; const float bg = inp(args, 16)[l * 128 + kk];
#pragma unroll
                for (int q = 0; q < 16; ++q) wg[q] = inp(args, 15)[(l * 16 + q) * 128 + kk];
                LAS float* glr = ldsf; LAS float* tot = ldsf + 1024; LAS unsigned char* KTl = lds + 8192; LAS unsigned char* VTl = lds + 8192 + 128 * VSTR;
                float* BCS = (float*)(ws + WS_BCS);
            for (int r_ = bid; r_ < N_J2 * REP_J2; r_ += G) { const int r = r_ % N_J2;
                    const int b = r >> 7, c = r & 127; const size_t row0 = (size_t)b * SEQ + 64 * c;
                    for (int e = tid; e < 1024; e += NTHR) glr[e] = bf2f(PB[(row0 + (e >> 4)) * NIN + C_GLR + (e & 15)]);
                    for (int e = tid; e < 2048; e += NTHR) { const int jj = e >> 5, hc = e & 31; const bf16_t* vsrc = PB + (row0 + jj) * NIN + C_CV + 8 * hc; const u32x2 wA = *(const u32x2*)vsrc, wB = *(const u32x2*)(vsrc + 4);
                        LAS bf16_t* d = (LAS bf16_t*)(VTl + (8 * hc) * VSTR) + jj;
                        d[0] = (bf16_t)wA.x; d[VSTR / 2] = (bf16_t)(wA.x >> 16); d[2 * (VSTR / 2)] = (bf16_t)wA.y; d[3 * (VSTR / 2)] = (bf16_t)(wA.y >> 16); d[4 * (VSTR / 2)] = (bf16_t)wB.x; d[5 * (VSTR / 2)] = (bf16_t)(wB.x >> 16); d[6 * (VSTR / 2)] = (bf16_t)wB.y; d[7 * (VSTR / 2)] = (bf16_t)(wB.y >> 16); }
                    __syncthreads();
                    float bv[16]; float run = 0.f;
#pragma unroll
                    for (int tt = 0; tt < 16; ++tt) { const LAS f32x4* g4 = (const LAS f32x4*)(glr + (16 * tq + tt) * 16); float z = bg;
#pragma unroll
                        for (int q = 0; q < 4; ++q) { const f32x4 g = g4[q]; z += g[0] * wg[4 * q] + g[1] * wg[4 * q + 1] + g[2] * wg[4 * q + 2] + g[3] * wg[4 * q + 3]; }
                        run += (fminf(z, 0.f) - __logf(1.f + __expf(-fabsf(z)))) * (1.f / 16.f); bv[tt] = run; }
                    tot[tq * 128 + kk] = run;
                    __syncthreads();
                    { const float t0_ = tot[kk], t1_ = tot[128 + kk], t2_ = tot[256 + kk], t3_ = tot[384 + kk]; const float off = tq == 0 ? 0.f : (tq == 1 ? t0_ : (tq == 2 ? t0_ + t1_ : (t0_ + t1_) + t2_)), blast = ((t0_ + t1_) + t2_) + t3_;
#pragma unroll
                      for (int tt = 0; tt < 16; ++tt) { const int t = 16 * tq + tt; const float bt = bv[tt] + off; BCS[(row0 + t) * 128 + kk] = bt;
                          *((LAS bf16_t*)(KTl + kk * VSTR) + t) = f2bf(bf2f(PB[(row0 + t) * NIN + C_CK + kk]) * __expf(blast - bt)); }
                      if (tq == 0) DEC[(size_t)(b * 128 + c) * 128 + kk] = __expf(blast); }
                    __syncthreads();
                    { const int h = wave >> 1, nt = wave & 1; f32x16 acc;
#pragma unroll
                      for (int i = 0; i < 16; ++i) acc[i] = 0.f;
                      const LAS unsigned char* ap = KTl + (h * 32 + r32) * VSTR + 16 * hi; const LAS unsigned char* bp = VTl + (h * 64 + 32 * nt + r32) * VSTR + 16 * hi;
#pragma unroll
                      for (int s = 0; s < 4; ++s) { const u32x2 a0 = *(const LAS u32x2*)(ap + 32 * s), a1 = *(const LAS u32x2*)(ap + 32 * s + 8), b0 = *(const LAS u32x2*)(bp + 32 * s), b1 = *(const LAS u32x2*)(bp + 32 * s + 8);
                          u32x4 aw, bw; aw.x = a0.x; aw.y = a0.y; aw.z = a1.x; aw.w = a1.y; bw.x = b0.x; bw.y = b0.y; bw.z = b1.x; bw.w = b1.y;
                          acc = mfma32(__builtin_bit_cast(bf16x8, aw), __builtin_bit_cast(bf16x8, bw), acc); }
                      float* o = KVC + ((size_t)(b * 128 + c) * 4 + h) * 2048 + 32 * nt + r32;
#pragma unroll
                      for (int i = 0; i < 16; ++i) o[((i & 3) + 8 * (i >> 2) + 4 * hi) * 64] = acc[i]; }
                    __syncthreads();
            }
            }
            for (int r = bid; r < N_J4; r += G) {
                    const size_t row0 = (size_t)r * 64;
#pragma unroll
                    for (int it3 = 0; it3 < 3; ++it3) {
                        const int e = tid + it3 * NTHR, tok = e / 24, p = e % 24, hd = p >> 2, c8 = p & 3; const int base = hd < 4 ? C_BQ + hd * 64 : (hd == 4 ? C_KS : C_KW); const float sc = hd < 4 ? 0.125f * LOG2E : 1.f;
                        bf16_t* pr = PB + (row0 + tok) * NIN + base + 8 * c8; const u32x4 a = *(const u32x4*)pr, c = *(const u32x4*)(pr + 32); const float2* cs = cs64 + (row0 + tok) * 32 + 8 * c8;
                        const unsigned au[4] = {a.x, a.y, a.z, a.w}, cu[4] = {c.x, c.y, c.z, c.w}; unsigned o1[4], o2[4];
#pragma unroll
                        for (int q = 0; q < 4; ++q) { const float2 s0 = cs[2 * q], s1 = cs[2 * q + 1]; const float x1a = bflo(au[q]), x1b = bfhi(au[q]), x2a = bflo(cu[q]), x2b = bfhi(cu[q]);
                            o1[q] = pk2((x1a * s0.x - x2a * s0.y) * sc, (x1b * s1.x - x2b * s1.y) * sc); o2[q] = pk2((x2a * s0.x + x1a * s0.y) * sc, (x2b * s1.x + x1b * s1.y) * sc); }
                        u32x4 w1, w2; w1.x = o1[0]; w1.y = o1[1]; w1.z = o1[2]; w1.w = o1[3]; w2.x = o2[0]; w2.y = o2[1]; w2.z = o2[2]; w2.w = o2[3];
                        *(u32x4*)pr = w1; *(u32x4*)(pr + 32) = w2;
                        if (hd == 4) {
                            bf16_t* kf_ = KSF + (row0 / 64) * 4096 + (size_t)((((tok >> 5) * 4 + (c8 >> 1)) * 64 + (c8 & 1) * 32 + (tok & 31)) * 8); *(u32x4*)kf_ = w1; *(u32x4*)(kf_ + 2 * 64 * 8) = w2; } }
                    { LAS bf16_t* tl = (LAS bf16_t*)lds; const size_t bb = row0 / SEQ, t0 = row0 % SEQ;
                      for (int mtx = 0; mtx < 2; ++mtx) { const int tok = tid >> 3, c = tid & 7; const u32x4 w = *(const u32x4*)(PB + (row0 + tok) * NIN + (mtx ? C_VW : C_VS) + c * 8);
                          LAS bf16_t* dst = tl + mtx * 64 * 72 + tok * 72 + c * 8; dst[0] = (bf16_t)w.x; dst[1] = (bf16_t)(w.x >> 16); dst[2] = (bf16_t)w.y; dst[3] = (bf16_t)(w.y >> 16); dst[4] = (bf16_t)w.z; dst[5] = (bf16_t)(w.z >> 16); dst[6] = (bf16_t)w.w; dst[7] = (bf16_t)(w.w >> 16); }
                      __syncthreads();
                      for (int mtx = 0; mtx < 2; ++mtx) { const int d = tid >> 3, c8 = tid & 7; const LAS bf16_t* s = tl + mtx * 64 * 72 + (c8 * 8) * 72 + d;
                          u32x4 w; w.x = (unsigned)s[0] | ((unsigned)s[72] << 16); w.y = (unsigned)s[2 * 72] | ((unsigned)s[3 * 72] << 16); w.z = (unsigned)s[4 * 72] | ((unsigned)s[5 * 72] << 16); w.w = (unsigned)s[6 * 72] | ((unsigned)s[7 * 72] << 16);
                          if (mtx) *(u32x4*)(VWT + (bb * 64 + d) * SEQ + t0 + c8 * 8) = w;
                          else { const int s_ = c8 >> 1, h_ = c8 & 1; const LAS bf16_t* q = tl + (16 * s_ + 4 * h_) * 72 + d;
                              u32x4 f; f.x = (unsigned)q[0] | ((unsigned)q[72] << 16); f.y = (unsigned)q[2 * 72] | ((unsigned)q[3 * 72] << 16); f.z = (unsigned)q[8 * 72] | ((unsigned)q[9 * 72] << 16); f.w = (unsigned)q[10 * 72] | ((unsigned)q[11 * 72] << 16);
                              *(u32x4*)(VST + (row0 / 64) * 4096 + (size_t)((((d >> 5) * 4 + s_) * 64 + h_ * 32 + (d & 31)) * 8)) = f; } }
                      __syncthreads(); }
            }
            }
        }
        SEAM(pb + 1);
        if (IN(pb + 2)) {
        const int l_ = l; WS_PTRS();
        LAUNDER_TID();
            constexpr int Q_J5 = 2, Q_J6 = 64, Q_ATT = 1024 * REP_ATT, Q_J9 = 1024, Q_J10 = 512, Q_TOT = Q_J5 + Q_J6 + Q_ATT + Q_J9 + Q_J10;
            if (tid == 0) { LCTL[4] = 0u; LCTL[5] = 0u; }
            __syncthreads();
            const int tid_o = tid;
            for (;;) {
                int tid = tid_o; asm volatile("" : "+v"(tid)); const int lane = tid & 63;
                if (tid == 0) LCTL[2] = __hip_atomic_fetch_add(ctl + CW_QUEUE + 64 * l, 1u, __ATOMIC_RELAXED, __HIP_MEMORY_SCOPE_AGENT);
                __syncthreads();
                int r = __builtin_amdgcn_readfirstlane((int)LCTL[2]); const unsigned seen5 = LCTL[4], seen6 = LCTL[5];
                __syncthreads();
                if (r >= Q_TOT * REP_P3) break;
                if (REP_P3 > 1 && r >= Q_TOT) r -= Q_TOT;
                if (r < Q_J5) {
                    const int e = r * NTHR + tid, b = e >> 8, ch = e & 255; float carry = 0.f;
                    for (int c0 = 0; c0 < 512; c0 += 8) { float av[8], hv[8];
#pragma unroll
                        for (int q = 0; q < 8; ++q) { const size_t so = ((size_t)(b * 512 + c0 + q)) * 256 + ch; av[q] = LA[so]; hv[q] = LH[so]; }
#pragma unroll
                        for (int q = 0; q < 8; ++q) { CIN[((size_t)(b * 512 + c0 + q)) * 256 + ch] = carry; carry = av[q] * carry + hv[q]; } }
                    asm volatile("s_waitcnt vmcnt(0)" ::: "memory"); __syncthreads();
                    if (tid == 0) { __builtin_amdgcn_fence(__ATOMIC_RELEASE, "agent"); asm volatile("s_waitcnt vmcnt(0)" ::: "memory"); (void)xb_add(ctl + CW_FLAG + 64 * (2 * l + 0), 1u); }
                    continue;
                }
                r -= Q_J5;
                if (r < Q_J6) {
                    const int e = r * NTHR + tid, b = e >> 13, rem = e & 8191; float Sv = 0.f;
                    for (int c0 = 0; c0 < 128; c0 += 8) { float kv[8], dv[8];
#pragma unroll
                        for (int q = 0; q < 8; ++q) { kv[q] = KVC[(size_t)(b * 128 + c0 + q) * 8192 + rem]; dv[q] = DEC[(size_t)(b * 128 + c0 + q) * 128 + (rem >> 6)]; }
#pragma unroll
                        for (int q = 0; q < 8; ++q) { SST[(size_t)(b * 128 + c0 + q) * 8192 + rem] = Sv; Sv = dv[q] * Sv + kv[q]; } }
                    asm volatile("s_waitcnt vmcnt(0)" ::: "memory"); __syncthreads();
                    if (tid == 0) { __builtin_amdgcn_fence(__ATOMIC_RELEASE, "agent"); asm volatile("s_waitcnt vmcnt(0)" ::: "memory"); (void)xb_add(ctl + CW_FLAG + 64 * (2 * l + 1), 1u); }
                    continue;
                }
                r -= Q_J6;
                if (r >= Q_ATT) {
                    r -= Q_ATT; const bool is9 = r < Q_J9;
                    if (!(is9 ? seen5 : seen6)) {
                        if (tid == 0) { unsigned* f = ctl + CW_FLAG + 64 * (2 * l + (is9 ? 0 : 1)); const unsigned target = is9 ? (unsigned)Q_J5 : (unsigned)Q_J6;
                            XB_SPIN(xb_ld(f) < target, ctl + CW_BAR); __builtin_amdgcn_fence(__ATOMIC_ACQUIRE, "agent"); asm volatile("s_waitcnt vmcnt(0)" ::: "memory"); LCTL[is9 ? 4 : 5] = 1u; }
                        __syncthreads(); }
                    if (is9) {
                    const int b = r >> 8, tb = r & 255, t0 = tb * 32, ch = tid & 255, half = tid >> 8;
                    LAS float* xa = ldsf;
                    float hst = CIN[((size_t)(b * 512 + tb * 2 + half)) * 256 + ch];
                    { float av[16], uv[16], gv[16];
#pragma unroll
                      for (int tt = 0; tt < 16; ++tt) { const size_t ro = (size_t)b * SEQ + t0 + half * 16 + tt; av[tt] = LRA[ro * 256 + ch]; uv[tt] = LRU_[ro * 256 + ch]; gv[tt] = bf2f(PB[ro * NIN + C_AG + ch]); }
#pragma unroll
                      for (int tt = 0; tt < 16; ++tt) { hst = av[tt] * hst + uv[tt]; xa[(half * 16 + tt) * 256 + ch] = hst * gelu_tanh(gv[tt]); } }
                    __syncthreads();
                    for (int q = 0; q < 4; ++q) { const int rr = wave * 4 + q; const f32x4 v = ((const LAS f32x4*)(xa + rr * 256))[lane];
                        const float rinv = rsqrtf(wave_sum(v[0] * v[0] + v[1] * v[1] + v[2] * v[2] + v[3] * v[3]) * (1.f / 256.f) + EPS);
                        u32x2 w; w.x = pk2(v[0] * rinv, v[1] * rinv); w.y = pk2(v[2] * rinv, v[3] * rinv);
                        *(u32x2*)(Y + ((size_t)b * SEQ + t0 + rr) * DM + 256 + 4 * lane) = w; }
                    __syncthreads();
                    } else { r -= Q_J9;
                    const int b = r >> 7, c = r & 127; const size_t row0 = (size_t)b * SEQ + 64 * c;
                    LAS float* bL = ldsf; LAS float* glr = ldsf + 8192; LAS unsigned char* VTl = lds + 36864; LAS unsigned char* STl = lds + 71680; LAS float* SSX = (LAS float*)(lds + 92160);
                    for (int e = tid; e < 2048; e += NTHR) ((LAS f32x4*)bL)[e] = ((const f32x4*)((const float*)(ws + WS_BCS) + row0 * 128))[e];
                    for (int e = tid; e < 2048; e += NTHR) { const int jj = e >> 5, hc = e & 31, h = hc >> 3, c8 = hc & 7; const bf16_t* vsrc = PB + (row0 + jj) * NIN + C_CV + h * 64 + 8 * c8; const u32x2 wA = *(const u32x2*)vsrc, wB = *(const u32x2*)(vsrc + 4); u32x4 w; w.x = wA.x; w.y = wA.y; w.z = wB.x; w.w = wB.y;
                        LAS bf16_t* d = (LAS bf16_t*)(VTl + h * 8704 + (8 * c8) * VSTR) + jj;
                        d[0] = (bf16_t)w.x; d[VSTR / 2] = (bf16_t)(w.x >> 16); d[2 * (VSTR / 2)] = (bf16_t)w.y; d[3 * (VSTR / 2)] = (bf16_t)(w.y >> 16); d[4 * (VSTR / 2)] = (bf16_t)w.z; d[5 * (VSTR / 2)] = (bf16_t)(w.z >> 16); d[6 * (VSTR / 2)] = (bf16_t)w.w; d[7 * (VSTR / 2)] = (bf16_t)(w.w >> 16); }
                    for (int e = tid; e < 8192; e += NTHR) { const int h = e >> 11, k = (e >> 6) & 31, v = e & 63; *(LAS bf16_t*)(STl + h * 5120 + v * 80 + k * 2) = f2bf(SST[(size_t)(b * 128 + c) * 8192 + e]); }
                    __syncthreads();
                    { const int r32 = lane & 31, hi = lane >> 5, h = wave >> 1, ih = wave & 1, i = 32 * ih + r32; const float SCG = 0.17677669529663687f;
                      bf16x8 qrel[2], qabs[2], kt[2][2];
#pragma unroll
                      for (int ks = 0; ks < 2; ++ks) { const int k0 = h * 32 + 16 * ks + 8 * hi; const bf16x8 qv = ld8x2(PB + (row0 + i) * NIN + C_CQ + k0); u32x4 wr_, wa_; unsigned* pr_ = (unsigned*)&wr_; unsigned* pa_ = (unsigned*)&wa_;
#pragma unroll
                          for (int e2 = 0; e2 < 4; ++e2) { const float b0 = bL[i * 128 + k0 + 2 * e2], b1 = bL[i * 128 + k0 + 2 * e2 + 1], f0 = bL[31 * 128 + k0 + 2 * e2], f1 = bL[31 * 128 + k0 + 2 * e2 + 1];
                              const float q0 = bf2f((bf16_t)qv[2 * e2]) * SCG, q1 = bf2f((bf16_t)qv[2 * e2 + 1]) * SCG;
                              pr_[e2] = cvtpk(q0 * __expf(b0 - f0), q1 * __expf(b1 - f1)); pa_[e2] = cvtpk(q0 * __expf(b0), q1 * __expf(b1)); }
                          qrel[ks] = __builtin_bit_cast(bf16x8, wr_); qabs[ks] = __builtin_bit_cast(bf16x8, wa_); }
#pragma unroll
                      for (int jt = 0; jt < 2; ++jt)
#pragma unroll
                          for (int ks = 0; ks < 2; ++ks) { const int jr = 32 * jt + r32, k0 = h * 32 + 16 * ks + 8 * hi; const bf16x8 kv = ld8x2(PB + (row0 + jr) * NIN + C_CK + k0); u32x4 wk_; unsigned* pk_ = (unsigned*)&wk_;
#pragma unroll
                              for (int e2 = 0; e2 < 4; ++e2) { const float b0 = bL[jr * 128 + k0 + 2 * e2], b1 = bL[jr * 128 + k0 + 2 * e2 + 1], f0 = bL[31 * 128 + k0 + 2 * e2], f1 = bL[31 * 128 + k0 + 2 * e2 + 1];
                                  pk_[e2] = cvtpk(bf2f((bf16_t)kv[2 * e2]) * __expf(f0 - b0), bf2f((bf16_t)kv[2 * e2 + 1]) * __expf(f1 - b1)); }
                              kt[jt][ks] = __builtin_bit_cast(bf16x8, wk_); }
                      f32x16 o[2], s[2];
#pragma unroll
                      for (int q = 0; q < 16; ++q) { o[0][q] = 0.f; o[1][q] = 0.f; s[0][q] = 0.f; s[1][q] = 0.f; }
#pragma unroll
                      for (int ks = 0; ks < 2; ++ks) s[0] = mfma32(kt[0][ks], qrel[ks], s[0]);
                      if (ih) {
#pragma unroll
                          for (int ks = 0; ks < 2; ++ks) s[1] = mfma32(kt[1][ks], qrel[ks], s[1]); }
#pragma unroll
                      for (int q = 0; q < 16; ++q) { const int jr = (q & 3) + 8 * (q >> 2) + 4 * hi; if (jr > r32) { if (ih) s[1][q] = 0.f; else s[0][q] = 0.f; } }
                      const LAS unsigned char* VTh = VTl + h * 8704; const LAS unsigned char* STh = STl + h * 5120;
#pragma unroll
                      for (int dt = 0; dt < 2; ++dt) { const LAS unsigned char* vp = VTh + (32 * dt + r32) * VSTR + 8 * hi;
                          o[dt] = mfma32(vfrag(vp), pack8<0>(s[0]), o[dt]); o[dt] = mfma32(vfrag(vp + 32), pack8<8>(s[0]), o[dt]);
                          if (ih) { o[dt] = mfma32(vfrag(vp + 64), pack8<0>(s[1]), o[dt]); o[dt] = mfma32(vfrag(vp + 96), pack8<8>(s[1]), o[dt]); }
#pragma unroll
                          for (int ks = 0; ks < 2; ++ks) o[dt] = mfma32(*(const LAS bf16x8*)(STh + (32 * dt + r32) * 80 + 32 * ks + 16 * hi), qabs[ks], o[dt]); }
                      float ssh = 0.f;
#pragma unroll
                      for (int q = 0; q < 16; ++q) ssh += o[0][q] * o[0][q] + o[1][q] * o[1][q];
                      const float rh = rsqrtf(xhalf_sum(ssh) * (1.f / 64.f) + EPS); float ssg = 0.f;
#pragma unroll
                      for (int dt = 0; dt < 2; ++dt)
#pragma unroll
                          for (int g = 0; g < 4; ++g) { const int v0 = 32 * dt + 8 * g + 4 * hi; const u32x2 ogw = *(const u32x2*)(PB + (row0 + i) * NIN + C_OG + h * 64 + v0); const f32x4 gn = *(const f32x4*)(inp(args, 17) + l * 64 + v0);
                              const float og4[4] = {bflo(ogw.x), bfhi(ogw.x), bflo(ogw.y), bfhi(ogw.y)};
#pragma unroll
                              for (int q = 0; q < 4; ++q) { const float y = o[dt][4 * g + q] * rh * gn[q] * (og4[q] / (1.f + __expf(-og4[q]))); o[dt][4 * g + q] = y; ssg += y * y; } }
                      ssg = xhalf_sum(ssg); if (hi == 0) SSX[i * 4 + h] = ssg;
                      __syncthreads();
                      const f32x4 s4 = *(const LAS f32x4*)(SSX + i * 4); const float rinv = rsqrtf((s4[0] + s4[1] + s4[2] + s4[3]) * (1.f / 256.f) + EPS);
#pragma unroll
                      for (int dt = 0; dt < 2; ++dt)
#pragma unroll
                          for (int g = 0; g < 4; ++g) { u32x2 w; w.x = cvtpk(o[dt][4 * g] * rinv, o[dt][4 * g + 1] * rinv); w.y = cvtpk(o[dt][4 * g + 2] * rinv, o[dt][4 * g + 3] * rinv);
                              *(u32x2*)(Y + (row0 + i) * DM + 768 + h * 64 + 32 * dt + 8 * g + 4 * hi) = w; } }
                    __syncthreads();
                    }
                    continue;
                }
                const int r32 = lane & 31, hi = lane >> 5;
                const int rep = r >> 10; r &= 1023;
                const int grp = r >> 5, within = r & 31;
                if (rep && ((REP_ONLY == 1 && within >= 16) || (REP_ONLY == 2 && within < 16))) continue;
              {
                if (within >= 16) {
                    const int idx = within - 16, b = idx & 3, tb = 127 - (4 * grp + (idx >> 2));
                    const int tl = 8 * wave + (r32 >> 2), head = r32 & 3, T = 64 * tb + tl; const size_t row = (size_t)b * SEQ + T; const bf16_t* prow = PB + row * NIN;
                    bf16x8 qf[4];
#pragma unroll
                    for (int ks = 0; ks < 4; ++ks) qf[ks] = *(const bf16x8*)(prow + C_BQ + head * 64 + 16 * ks + 8 * hi);
                    LAS float* impb = (LAS float*)(lds + AL_IMP) + wave * 1024; LAS unsigned* selm = (LAS unsigned*)(lds + AL_SELM) + wave * 32;
                    const int skey = tid >> 3, sch = tid & 7;
                    const unsigned koffP = (unsigned)(skey * NIN + sch * 8), voffS = (unsigned)(skey * SEQ + sch * 8), koffC = (unsigned)(skey * 64 + sch * 8), voffC = (unsigned)(skey * 512 + sch * 8);
                    auto stK = [&](int buf, const StageRegs& R) __attribute__((always_inline)) { *(LAS u32x4*)(lds + (buf ? AL_K1 : AL_K0) + skey * KSTR + sch * 16) = R.a; };
                    auto stKV = [&](int buf, const StageRegs& R) __attribute__((always_inline)) { *(LAS u32x4*)(lds + (buf ? AL_K1 : AL_K0) + skey * KSTR + sch * 16) = R.a;
                        LAS unsigned char* vd = lds + (buf ? AL_V1 : AL_V0) + skey * VSTR + sch * 16; u32x2 a, c; a.x = R.b.x; a.y = R.b.y; c.x = R.b.z; c.y = R.b.w; *(LAS u32x2*)vd = a; *(LAS u32x2*)(vd + 8) = c; };
                    f32x16 oacc[2], ob[2];
                    const int nv = T >= 31 ? ((T - 31) >> 4) + 1 : 0, ntc = (4 * tb + 3 + 63) >> 6;
                    float mC = NEGB, lC = 0.f;
                    { const bf16_t* kb_ = KCMPB + (size_t)b * 512 * 64;
                      attn_pipeline(0, ntc - 1, [&](int j, StageRegs& R) __attribute__((always_inline)) { R.a = *(const u32x4*)((kb_ + (size_t)j * 64 * 64) + koffC); }, stK,
                        [&](int j, int cb) __attribute__((always_inline)) { f32x16 s0, s1; qk_tile<4>(lds + (cb ? AL_K1 : AL_K0), qf, r32, hi, s0, s1); mask_tile(s0, s1, 0, nv - 1 - 64 * j, hi);
                            const float mx = tile_max(s0, s1), mn = fmaxf(mC, mx), ms = mn < -1e29f ? 0.f : mn, alpha = ex2(mC - ms); mC = mn; float ps = 0.f;
#pragma unroll
                            for (int i = 0; i < 16; ++i) ps += ex2(s0[i] - ms) + ex2(s1[i] - ms);
                            lC = lC * alpha + ps; }); }
                    { const float invC = 1.f / fmaxf(xhalf_sum(lC), 1e-30f), msC = mC < -1e29f ? 0.f : mC; float carry = 0.f;
#pragma unroll
                      for (int i = 0; i < 16; ++i) { ob[0][i] = 0.f; ob[1][i] = 0.f; }
                      const bf16_t* kb_ = KCMPB + (size_t)b * 512 * 64; const bf16_t* vb_ = VCMPT + (size_t)b * 64 * 512;
                      attn_pipeline(0, ntc - 1, [&](int j, StageRegs& R) __attribute__((always_inline)) { R.a = *(const u32x4*)((kb_ + (size_t)j * 64 * 64) + koffC); R.b = *(const u32x4*)((vb_ + j * 64) + voffC); }, stKV,
                        [&](int j, int cb) __attribute__((always_inline)) { f32x16 s0, s1; qk_tile<4>(lds + (cb ? AL_K1 : AL_K0), qf, r32, hi, s0, s1); mask_tile(s0, s1, 0, nv - 1 - 64 * j, hi);
#pragma unroll
                            for (int i = 0; i < 16; ++i) { s0[i] = ex2(s0[i] - msC) * invC; s1[i] = ex2(s1[i] - msC) * invC; }
                            float gs[8], pl[8];
#pragma unroll
                            for (int q = 0; q < 4; ++q) { gs[q] = (s0[4 * q] + s0[4 * q + 1]) + (s0[4 * q + 2] + s0[4 * q + 3]); gs[4 + q] = (s1[4 * q] + s1[4 * q + 1]) + (s1[4 * q + 2] + s1[4 * q + 3]);
                                pl[q] = __shfl_xor(s0[4 * q + 3], 32); pl[4 + q] = __shfl_xor(s1[4 * q + 3], 32); }
#pragma unroll
                            for (int q = 0; q < 8; ++q) { const float prev = hi ? pl[q] : (q > 0 ? pl[q > 0 ? q - 1 : 0] : carry); float x = gs[q] + prev; x += __shfl_xor(x, 1); x += __shfl_xor(x, 2);
                                if ((r32 & 3) == 0) impb[(r32 >> 2) * 128 + 16 * j + 2 * q + hi] = x; }
                            carry = pl[7];
                            pv_tile(s0, s1, lds + (cb ? AL_V1 : AL_V0), ob, r32, hi); }); }
                    LAS float* oav = (LAS float*)(lds + AL_OACC) + tid; const float g0 = sigmoidf_(bf2f(prow[C_BG + head * 3]));
#pragma unroll
                    for (int i = 0; i < 16; ++i) { oav[i * 512] = g0 * ob[0][i]; oav[(16 + i) * 512] = g0 * ob[1][i]; }
                    WSYNC();
                    for (int tk = 0; tk < 8; ++tk) {
                        const int cur = tb, j0 = lane, j1 = lane + 64; const float im0 = impb[tk * 128 + j0], im1 = impb[tk * 128 + j1];
                        const unsigned k0 = ((j0 == 0 || j0 == cur || j0 == cur - 1) ? 0xFF000000u : (j0 <= cur ? (__float_as_uint(im0) & ~127u) : 0u)) | (unsigned)(127 - j0);
                        const unsigned k1 = ((j1 == cur || j1 == cur - 1) ? 0xFF000000u : (j1 <= cur ? (__float_as_uint(im1) & ~127u) : 0u)) | (unsigned)(127 - j1);
                        unsigned T = 0u;
#pragma unroll 4
                        for (int bb = 31; bb >= 0; --bb) { const unsigned cand = T | (1u << bb); const int cnt = __popcll(__ballot(k0 >= cand)) + __popcll(__ballot(k1 >= cand)); if (cnt >= 16) T = cand; }
                        const unsigned long long m0 = __ballot(k0 >= T), m1 = __ballot(k1 >= T);
                        if (lane == 0) { selm[tk * 4] = (unsigned)m0; selm[tk * 4 + 1] = (unsigned)(m0 >> 32); selm[tk * 4 + 2] = (unsigned)m1; selm[tk * 4 + 3] = (unsigned)(m1 >> 32); }
                    }
                    WSYNC();
                    const unsigned sm0 = selm[(r32 >> 2) * 4], sm1 = selm[(r32 >> 2) * 4 + 1], sm2 = selm[(r32 >> 2) * 4 + 2], sm3 = selm[(r32 >> 2) * 4 + 3];
                    { SoftState SB; soft_init(SB, ob);
                      unsigned u0 = sm0, u1 = sm1, u2 = sm2, u3 = sm3;
#pragma unroll
                      for (int o_ = 1; o_ < 64; o_ <<= 1) { u0 |= (unsigned)__shfl_xor((int)u0, o_); u1 |= (unsigned)__shfl_xor((int)u1, o_); u2 |= (unsigned)__shfl_xor((int)u2, o_); u3 |= (unsigned)__shfl_xor((int)u3, o_); }
                      unsigned long long Ulo = ((unsigned long long)(unsigned)__builtin_amdgcn_readfirstlane((int)u1) << 32) | (unsigned)__builtin_amdgcn_readfirstlane((int)u0), Uhi = ((unsigned long long)(unsigned)__builtin_amdgcn_readfirstlane((int)u3) << 32) | (unsigned)__builtin_amdgcn_readfirstlane((int)u2);
                      if (tb < 64) { if (tb < 63) Ulo &= (2ull << tb) - 1ull; Uhi = 0ull; } else if (tb < 127) Uhi &= (2ull << (tb - 64)) - 1ull;
                      const bf16_t* ksf = KSF + (size_t)b * 128 * 4096; const bf16_t* vsf = VST + (size_t)b * 128 * 4096; const unsigned lo8 = (unsigned)lane * 8u;
                      bf16x8 kf[2][4], vf[2][4];
                      int j = 0; Ulo &= ~1ull;
#pragma unroll
                      for (int f = 0; f < 8; ++f) kf[f >> 2][f & 3] = *(const bf16x8*)((ksf + f * 512) + lo8);
                      bool first = true;
                      for (;;) {
#pragma unroll
                          for (int f = 0; f < 8; ++f) vf[f >> 2][f & 3] = *(const bf16x8*)((vsf + (size_t)j * 4096 + f * 512) + lo8);
                          const f32x16 cinit = bcast16(-SB.m); f32x16 s0 = cinit, s1 = cinit;
#pragma unroll
                          for (int ks = 0; ks < 4; ++ks) { s0 = mfma32(kf[0][ks], qf[ks], s0); s1 = mfma32(kf[1][ks], qf[ks], s1); }
                          __builtin_amdgcn_sched_barrier(0);
                          const int jn = Ulo ? (int)__builtin_ctzll(Ulo) : (Uhi ? 64 + (int)__builtin_ctzll(Uhi) : -1);
                          if (Ulo) Ulo &= Ulo - 1ull; else Uhi &= Uhi - 1ull;
                          if (jn >= 0) {
#pragma unroll
                              for (int f = 0; f < 8; ++f) kf[f >> 2][f & 3] = *(const bf16x8*)((ksf + (size_t)jn * 4096 + f * 512) + lo8); }
                          const unsigned wsel = j < 32 ? sm0 : (j < 64 ? sm1 : (j < 96 ? sm2 : sm3)); const bool bit = (wsel >> (j & 31)) & 1u;
                          soft_update(s0, s1, SB, ob, j == tb || !__all(bit), bit ? 0 : 64, j == tb ? tl : 63, first, hi);
                          { const bf16x8 p00 = pack8<0>(s0), p01 = pack8<8>(s0), p10 = pack8<0>(s1), p11 = pack8<8>(s1);
#pragma unroll
                            for (int dt = 0; dt < 2; ++dt) { ob[dt] = mfma32(vf[dt][0], p00, ob[dt]); ob[dt] = mfma32(vf[dt][1], p01, ob[dt]); ob[dt] = mfma32(vf[dt][2], p10, ob[dt]); ob[dt] = mfma32(vf[dt][3], p11, ob[dt]); } }
                          if (jn < 0) break;
                          j = jn; first = false;
                      }
                      const float sc = sigmoidf_(bf2f(prow[C_BG + head * 3 + 1])) / fmaxf(xhalf_sum(SB.l), 1e-30f);
#pragma unroll
                      for (int i = 0; i < 16; ++i) { oav[i * 512] += sc * ob[0][i]; oav[(16 + i) * 512] += sc * ob[1][i]; } }
                    __syncthreads();
                    { SoftState SB; soft_init(SB, ob); const int jb0 = tb >= 8 ? tb - 8 : 0;
                      const bf16_t* kb_ = PB + (size_t)b * SEQ * NIN + C_KW; const bf16_t* vb_ = VWT + (size_t)b * 64 * SEQ;
                      attn_pipeline(tb >= 8 ? tb - 8 : 0, tb, [&](int j, StageRegs& R) __attribute__((always_inline)) { R.a = *(const u32x4*)((kb_ + (size_t)j * 64 * NIN) + koffP); R.b = *(const u32x4*)((vb_ + j * 64) + voffS); }, stKV,
                        [&](int j, int cb) __attribute__((always_inline)) { attn_step<4>(lds + (cb ? AL_K1 : AL_K0), lds + (cb ? AL_V1 : AL_V0), qf, SB, ob, j == tb || j == tb - 8, j == tb - 8 ? tl + 1 : 0, j == tb ? tl : 63, j == jb0, r32, hi); });
                      const float sc = sigmoidf_(bf2f(prow[C_BG + head * 3 + 2])) / fmaxf(xhalf_sum(SB.l), 1e-30f);
#pragma unroll
                      for (int i = 0; i < 16; ++i) { oacc[0][i] = oav[i * 512] + sc * ob[0][i]; oacc[1][i] = oav[(16 + i) * 512] + sc * ob[1][i]; } }
                    { float ss = 0.f;
#pragma unroll
                      for (int i = 0; i < 16; ++i) ss += oacc[0][i] * oacc[0][i] + oacc[1][i] * oacc[1][i];
                      ss = xhalf_sum(ss); ss += __shfl_xor(ss, 1); ss += __shfl_xor(ss, 2);
                      const float rinv = rsqrtf(ss * (1.f / 256.f) + EPS);
#pragma unroll
                      for (int dt = 0; dt < 2; ++dt)
#pragma unroll
                          for (int g = 0; g < 4; ++g) { u32x2 w; w.x = cvtpk(oacc[dt][4 * g] * rinv, oacc[dt][4 * g + 1] * rinv); w.y = cvtpk(oacc[dt][4 * g + 2] * rinv, oacc[dt][4 * g + 3] * rinv);
                              *(u32x2*)(Y + row * DM + 512 + head * 64 + 32 * dt + 8 * g + 4 * hi) = w; } }
                    __syncthreads();
                    continue;
                }
                {
                    const int qb = 31 - grp, b = within >> 2, h = within & 3;
                    const int T = 256 * qb + 32 * wave + r32; const size_t row = (size_t)b * SEQ + T;
                    bf16x8 qf[6];
#pragma unroll
                    for (int ks = 0; ks < 6; ++ks) qf[ks] = *(const bf16x8*)(MQ + row * 384 + h * 96 + 16 * ks + 8 * hi);
                    f32x16 o[2]; SoftState SM; soft_init(SM, o);
                    const int jd = 4 * qb + (wave >> 1);
                    const bf16_t* kn = MKN + (size_t)b * SEQ * 256 + h * 64; const bf16_t* kr = MKR + (size_t)b * SEQ * 32; const bf16_t* vt = MVT + (size_t)(b * 4 + h) * 64 * SEQ;
                    constexpr int VS2 = 264, AM_K0 = 0, AM_K1 = 128 * KSTR, AM_V0 = 2 * 128 * KSTR, AM_V1 = AM_V0 + 64 * VS2;
                    const int nk = tid >> 3, nc = tid & 7, rkey = tid >> 2, rch = tid & 3, vr = tid >> 4, vc = tid & 15;
                    const unsigned ko0 = (unsigned)(nk * 256 + nc * 8), ko1 = (unsigned)(rkey * 32 + rch * 8), vo_ = (unsigned)(vr * SEQ + vc * 8);
                    attn_pipeline(0, 2 * qb + 1,
                        [&](int jj, StageRegs& R) __attribute__((always_inline)) { const bf16_t* knj = kn + (size_t)jj * 128 * 256; const bf16_t* vtj = vt + jj * 128;
                            R.a = *(const u32x4*)(knj + ko0); R.b = *(const u32x4*)((knj + 64 * 256) + ko0); R.c = *(const u32x4*)((kr + (size_t)jj * 128 * 32) + ko1);
                            R.d = *(const u32x4*)(vtj + vo_); R.e = *(const u32x4*)((vtj + 32 * SEQ) + vo_); },
                        [&](int buf, const StageRegs& R) __attribute__((always_inline)) { LAS unsigned char* kb_ = lds + (buf ? AM_K1 : AM_K0); LAS unsigned char* vb_ = lds + (buf ? AM_V1 : AM_V0) + vr * VS2 + vc * 16;
                            *(LAS u32x4*)(kb_ + nk * KSTR + nc * 16) = R.a; *(LAS u32x4*)(kb_ + (64 + nk) * KSTR + nc * 16) = R.b; *(LAS u32x4*)(kb_ + rkey * KSTR + 128 + rch * 16) = R.c;
                            u32x2 p, q; p.x = R.d.x; p.y = R.d.y; q.x = R.d.z; q.y = R.d.w; *(LAS u32x2*)vb_ = p; *(LAS u32x2*)(vb_ + 8) = q;
                            p.x = R.e.x; p.y = R.e.y; q.x = R.e.z; q.y = R.e.w; *(LAS u32x2*)(vb_ + 32 * VS2) = p; *(LAS u32x2*)(vb_ + 32 * VS2 + 8) = q; },
                        [&](int jj, int cb) __attribute__((always_inline)) {
                            const int j0 = 2 * jj, kd = 32 * (wave & 1) + r32;
                            if (j0 + 1 <= jd) attn_step2<6, VS2>(lds + (cb ? AM_K1 : AM_K0), lds + (cb ? AM_V1 : AM_V0), qf, SM, o, false, 63, j0 + 1 == jd, j0 + 1 == jd ? kd : 63, j0 == 0, r32, hi);
                            else if (j0 <= jd) attn_step<6, VS2>(lds + (cb ? AM_K1 : AM_K0), lds + (cb ? AM_V1 : AM_V0), qf, SM, o, j0 == jd, 0, kd, j0 == 0, r32, hi); });
                    { const float inv = 1.f / fmaxf(xhalf_sum(SM.l), 1e-30f); float ss = 0.f;
#pragma unroll
                      for (int dt = 0; dt < 2; ++dt)
#pragma unroll
                          for (int g = 0; g < 4; ++g) { const float v0 = o[dt][4 * g] * inv, v1 = o[dt][4 * g + 1] * inv, v2 = o[dt][4 * g + 2] * inv, v3 = o[dt][4 * g + 3] * inv; ss += v0 * v0 + v1 * v1 + v2 * v2 + v3 * v3;
                              u32x2 w; w.x = cvtpk(v0, v1); w.y = cvtpk(v2, v3); *(u32x2*)(Y + row * DM + h * 64 + 32 * dt + 8 * g + 4 * hi) = w; }
                      ss = xhalf_sum(ss); if (hi == 0) ssq_d[(size_t)h * M + row] = ss; }
                    __syncthreads();
                }
              }
            }
        }
        SEAM(pb + 2);
        if (IN(pb + 3)) {
        const int l_ = l; WS_PTRS();
            pg8::Gemm g{Y, (const bf16_t*)(ws + WS_WOUT) + (size_t)l * DM * DM, M, DM, DM}; pg8::StaticOrder S; S.init(M, DM, G, bid);
            pg8::EpiResid<true> E{XB, ssq_out, ssq_d, (LAS float*)(lds + 131072)};
            pg8::gemm_phase<pg8::EpiResid<true>, pg8::StaticOrder, true, true>(lds, g, S, E);
            if (REP_G57) { pg8::EpiInProj E2{PB, DM, ssq_mix}; pg8::gemm_phase<pg8::EpiInProj, pg8::StaticOrder, true, true>(lds, g, S, E2); }
        }
        SEAM(pb + 3);
        if (IN(pb + 4)) {
        const int l_ = l; WS_PTRS();
            pg8::Gemm g{XB, (const bf16_t*)(ws + WS_WGU) + (size_t)l * NGU * DM, M, NGU, DM}; pg8::StaticOrder S; S.init(M, NGU, G, bid);
            pg8::EpiSwiglu E{ACT, ssq_out};
            _Pragma("unroll 1") for (int rep = 0; rep < REP_G16; ++rep) pg8::gemm_phase<pg8::EpiSwiglu, pg8::StaticOrder, true, true>(lds, g, S, E);
        }
        SEAM(pb + 4);
        if (IN(pb + 5)) {
        const int l_ = l; WS_PTRS();
            pg8::Gemm g{ACT, (const bf16_t*)(ws + WS_WDN) + (size_t)l * DM * FF, M, DM, FF}; pg8::StaticOrder S; S.init(M, DM, G, bid);
            pg8::EpiResid<false> E{XB, ssq_down, nullptr, (LAS float*)(lds + 131072)};
            pg8::gemm_phase<pg8::EpiResid<false>, pg8::StaticOrder, true, true>(lds, g, S, E);
            if (REP_G57) { pg8::EpiInProj E2{Y, DM, ssq_mix}; pg8::gemm_phase<pg8::EpiInProj, pg8::StaticOrder, true, true>(lds, g, S, E2); }
        }
        SEAM(pb + 5);
    }
    if (IN(13)) {
        const int l_ = 1; WS_PTRS();
        LAUNDER_TID();
        const float* ssqf = ssp_base + (size_t)5 * 4 * M; const int gw = bid * 8 + wave, NGW = G * 8;
        for (int m = gw; m < M; m += NGW) {
            const float rinv = rsqrtf(sum4p(ssqf, m) * (1.f / DM) + EPS);
            const u32x2* xr = (const u32x2*)(XB + (size_t)m * DM) + lane; f32x4* orow = (f32x4*)(args.out + (size_t)m * DM) + lane; const f32x4* gn = (const f32x4*)inp(args, 27) + lane;
#pragma unroll
            for (int j = 0; j < 4; ++j) { const u32x2 w = xr[64 * j]; const f32x4 g = gn[64 * j]; f32x4 v; v[0] = bflo(w.x) * rinv * g[0]; v[1] = bfhi(w.x) * rinv * g[1]; v[2] = bflo(w.y) * rinv * g[2]; v[3] = bfhi(w.y) * rinv * g[3]; orow[64 * j] = v; }
        }
    }
#undef IN
#undef SEAM
}

extern "C" void kernel_launch(void* const* d_in, const int* in_sizes, int n_in, void* d_out, int out_size, void* d_ws, size_t ws_size, hipStream_t stream) {
    static int grid = 0;
    if (grid == 0) {
        if (n_in != 28 || in_sizes[0] != M * DM || out_size != M * DM || ws_size < WS_END) { fprintf(stderr, "kernel_launch: unexpected shapes (n_in %d, ws %zu)\n", n_in, ws_size); grid = -1; return; }
        int dev = 0, cus = 0;
        if (hipGetDevice(&dev) != hipSuccess || hipDeviceGetAttribute(&cus, hipDeviceAttributeMultiprocessorCount, dev) != hipSuccess) { grid = -1; return; }
        if (hipFuncSetAttribute((const void*)fwd, hipFuncAttributeMaxDynamicSharedMemorySize, LDS_BYTES) != hipSuccess) { fprintf(stderr, "kernel_launch: hipFuncSetAttribute failed\n"); grid = -1; return; }
        int per_cu = 0;
        if (hipOccupancyMaxActiveBlocksPerMultiprocessor(&per_cu, (const void*)fwd, NTHR, LDS_BYTES) != hipSuccess || per_cu < 1) fprintf(stderr, "kernel_launch: occupancy query says %d\n", per_cu);
        (void)hipGetLastError();
        grid = cus;
    }
    if (grid < 0) return;
    (void)hipMemsetAsync((char*)d_ws + WS_CTL, 0, CTL_ZERO_BYTES, stream);
    Args a{};
    for (int i = 0; i < 28; ++i) a.in[i] = (const float*)d_in[i];
    a.out = (float*)d_out; a.ws = (unsigned char*)d_ws;
    if (MK_N_LAUNCHES == 1) { a.ph_lo = 0; a.ph_hi = 14; hipLaunchKernelGGL(fwd, dim3(grid), dim3(NTHR), LDS_BYTES, stream, a); }
    else for (int p = 0; p < 14; ++p) { a.ph_lo = p; a.ph_hi = p + 1; hipLaunchKernelGGL(fwd, dim3(grid), dim3(NTHR), LDS_BYTES, stream, a); }
}
```

```cpp
#include <hip/hip_runtime.h>
#include <cstdio>
#include <cstdint>

#ifndef MK_N_LAUNCHES
#define MK_N_LAUNCHES 1
#endif

#define REP_P0 1
#define REP_G16 1
#define REP_G57 0
#define REP_ATT 1
#define STAGGER 6
#define REP_J4B 1
#define REP_J3 1
#define REP_J1 1
#define REP_J2 1
#define REP_P3 1
#define REP_ONLY 0
#define LAS __attribute__((address_space(3)))
#define DI __device__ __forceinline__
typedef unsigned short bf16_t;
typedef short bf16x8 __attribute__((ext_vector_type(8)));
typedef float f32x4 __attribute__((ext_vector_type(4)));
typedef unsigned u32x4 __attribute__((ext_vector_type(4)));
typedef unsigned u32x2 __attribute__((ext_vector_type(2)));

constexpr int NB = 4, SEQ = 8192, M = NB * SEQ, DM = 1024, NIN = 2304, NINS = 2300, FF = 2816, NGU = 2 * FF;
constexpr float EPS = 1e-6f;
constexpr int C_AX = 0, C_AG = 256, C_BQ = 512, C_KC = 768, C_VC = 832, C_KS = 896, C_VS = 960, C_KW = 1024, C_VW = 1088, C_BG = 1152,
              C_CQ = 1164, C_CK = 1292, C_CV = 1420, C_GLR = 1676, C_OG = 1692, C_DCQ = 1948, C_DCKV = 2140, C_DKR = 2268;
constexpr size_t MiB = 1u << 20;
constexpr size_t WS_CTL = 0, CTL_ZERO_BYTES = 1 * MiB;
constexpr size_t WS_ACC = 64 * 1024;
constexpr size_t WS_SSQ0 = 1 * MiB;
constexpr size_t WS_HB = 1 * MiB + 256 * 1024;
constexpr size_t WS_WIN = 2 * MiB, WS_WOUT = 11 * MiB, WS_WGU = 15 * MiB, WS_WDN = 37 * MiB;
constexpr size_t WS_WUQT = 48 * MiB, WS_WUKVT = 48 * MiB + 512 * 1024, WS_W2T = 49 * MiB, WS_W1T = 50 * MiB;
constexpr size_t WS_WGT = 49 * MiB + 512 * 1024, WS_SP = 49 * MiB + 768 * 1024;
constexpr size_t WS_BCS = 352 * MiB;
constexpr size_t WS_CS64 = 64 * MiB, WS_CS32 = 72 * MiB;
constexpr size_t WS_XB = 80 * MiB, WS_Y = 144 * MiB, WS_PB = 208 * MiB, WS_ACT = 208 * MiB;
constexpr size_t WS_LA = 384 * MiB, WS_LH = 386 * MiB, WS_CIN = 388 * MiB;
constexpr size_t WS_KVC = 392 * MiB, WS_DEC = 408 * MiB, WS_SST = 410 * MiB;
constexpr size_t WS_MQ = 428 * MiB, WS_MKN = 452 * MiB, WS_MV = 468 * MiB, WS_MKR = 484 * MiB;
constexpr size_t WS_SSP = 500 * MiB;
constexpr size_t WS_KSF = 504 * MiB;
constexpr size_t WS_VST = 490 * MiB, WS_VWT = 494 * MiB, WS_KCMPB = 498 * MiB, WS_VCMPT = 499 * MiB, WS_END = 508 * MiB;
constexpr int CW_QUEUE = 64;
constexpr int CW_FLAG = 1024;
constexpr int CW_BAR = 4096;
constexpr int LDS_BYTES = 163840 - 256;
constexpr int LDS_CTL = LDS_BYTES - 64;
constexpr int NTHR = 512;

struct Args { const float* in[28]; float* out; unsigned char* ws; int ph_lo, ph_hi; };

DI float bf2f(bf16_t h) { return __uint_as_float(((unsigned)h) << 16); }
DI float bflo(unsigned u) { return __uint_as_float(u << 16); }
DI float bfhi(unsigned u) { return __uint_as_float(u & 0xffff0000u); }
DI bf16_t f2bf(float f) { unsigned u = __float_as_uint(f); return (bf16_t)((u + 0x7fffu + ((u >> 16) & 1u)) >> 16); }
DI unsigned pk2(float lo, float hi) { return (unsigned)f2bf(lo) | ((unsigned)f2bf(hi) << 16); }
DI float sum4p(const float* p, size_t row) { return (p[row] + p[(size_t)M + row]) + (p[2 * (size_t)M + row] + p[3 * (size_t)M + row]); }
DI float wave_sum(float v) {
#pragma unroll
    for (int o = 1; o < 64; o <<= 1) v += __shfl_xor(v, o);
    return v;
}
DI float wave_max(float v) {
#pragma unroll
    for (int o = 1; o < 64; o <<= 1) v = fmaxf(v, __shfl_xor(v, o));
    return v;
}
DI int wave_min_i(int v) {
#pragma unroll
    for (int o = 1; o < 64; o <<= 1) { int w = __shfl_xor(v, o); v = w < v ? w : v; }
    return v;
}
DI float sigmoidf_(float x) { return __builtin_amdgcn_rcpf(1.f + __builtin_amdgcn_exp2f(-1.4426950408889634f * x)); }
DI float gelu_tanh(float x) { const float u = 0.7978845608028654f * (x + 0.044715f * x * x * x); return 0.5f * x * (1.f + tanhf(u)); }
#define WSYNC() do { asm volatile("s_waitcnt lgkmcnt(0)" ::: "memory"); __builtin_amdgcn_wave_barrier(); } while (0)

namespace pg8 {
constexpr int BM = 256, BK = 64, HALF = 128, HTB = HALF * BK * 2, NXCD = 8, WGM = 8;
__host__ __device__ __forceinline__ int lds_byte(int r, int c) { const int st = (r >> 4) * 2 + (c >> 5), rr = r & 15, cc = c & 31, ob = rr * 64 + cc * 2; return st * 1024 + (ob ^ (((ob >> 9) & 1) << 5)); }
__host__ __device__ __forceinline__ void stage_rc(int b, int& R, int& C) { const int st = b / 1024, sb = b % 1024, swz = sb ^ (((sb >> 9) & 1) << 5); R = (st >> 1) * 16 + swz / 64; C = (st & 1) * 32 + (swz % 64) / 2; }
__host__ __device__ __forceinline__ int perm32(int rho) { const int n = rho >> 4, i = rho & 15; return 8 * (i >> 2) + 4 * n + (i & 3); }
struct Unit { int pm, pn; };
struct Gemm { const bf16_t* A; const bf16_t* Bt; int M, N, K; };
struct StaticOrder {
    int nM, nN, nwg, G, c;
    __host__ __device__ void init(int M_, int N_, int G_, int c_) { nM = M_ / BM; nN = N_ / BM; nwg = nM * nN; G = G_; c = c_; }
    __host__ __device__ bool next(int i, Unit& u) const {
        const long L = (long)i * G + c; if (L >= nwg) return false;
        int wgid = (int)L; { const int q = nwg / NXCD, r = nwg % NXCD, xcd = wgid % NXCD, off = wgid / NXCD; wgid = (xcd < r ? xcd * (q + 1) : r * (q + 1) + (xcd - r) * q) + off; }
        const int nig = WGM * nN, gid = wgid / nig, fm = gid * WGM, gsz = (nM - fm) < WGM ? (nM - fm) : WGM;
        u.pm = fm + ((wgid % nig) % gsz); u.pn = (wgid % nig) / gsz; return true;
    }
    __device__ __forceinline__ void a_ready(const Unit&) const {}
    __device__ __forceinline__ void done(const Unit&) const {}
};
DI unsigned cvt_pk_bf16(float lo, float hi) { unsigned r; asm volatile("v_cvt_pk_bf16_f32 %0, %1, %2" : "=v"(r) : "v"(lo), "v"(hi)); return r; }

struct EpiInProj {
    static constexpr bool PERM = true, AFTER_DRAIN = false, MIDSCALE = false;
    bf16_t* O; int ldc; const float* ssq;
    DI void operator()(const f32x4 (&acc)[2][2][4][2], const Unit& u, int wr, int wc, int fr, int fq) const {
        int row0 = u.pm * BM + wr * 64 + fr; asm volatile("" : "+v"(row0)); const int col0 = u.pn * BM + wc * 32 + 8 * fq;
#pragma unroll
        for (int ai = 0; ai < 2; ++ai)
#pragma unroll
            for (int m = 0; m < 4; ++m) {
                const int row = row0 + ai * HALF + m * 16;
                const float rinv = rsqrtf(sum4p(ssq, row) * (1.f / DM) + EPS);
                bf16_t* rowp = O + (size_t)row * ldc + col0;
#pragma unroll
                for (int bj = 0; bj < 2; ++bj) {
                    f32x4 v0 = acc[ai][bj][m][0] * rinv, v1 = acc[ai][bj][m][1] * rinv;
                    u32x4 w; w.x = cvt_pk_bf16(v0[0], v0[1]); w.y = cvt_pk_bf16(v0[2], v0[3]); w.z = cvt_pk_bf16(v1[0], v1[1]); w.w = cvt_pk_bf16(v1[2], v1[3]);
                    *(u32x4*)(rowp + bj * HALF) = w;
                }
            }
    }
};
template <bool MS> struct EpiResid {
    static constexpr bool PERM = true, AFTER_DRAIN = false, MIDSCALE = MS;
    bf16_t* xb; float* ssq_part; const float* ssq_mid; LAS float* ssl;
    DI void midscale(f32x4 (&acc)[2][2][4][2], const Unit& u, int wr, int fr) const {
        int row0 = u.pm * BM + wr * 64 + fr; asm volatile("" : "+v"(row0));
#pragma unroll
        for (int ai = 0; ai < 2; ++ai)
#pragma unroll
            for (int m = 0; m < 4; ++m) { const float s = rsqrtf(sum4p(ssq_mid, row0 + ai * HALF + m * 16) * (1.f / 256.f) + EPS);
#pragma unroll
                for (int bj = 0; bj < 2; ++bj) { acc[ai][bj][m][0] *= s; acc[ai][bj][m][1] *= s; } }
    }
    DI void operator()(const f32x4 (&acc)[2][2][4][2], const Unit& u, int wr, int wc, int fr, int fq) const {
        int rl0 = wr * 64 + fr; asm volatile("" : "+v"(rl0));
        const int col0 = u.pn * BM + wc * 32 + 8 * fq;
#pragma unroll
        for (int ai = 0; ai < 2; ++ai)
#pragma unroll
            for (int m = 0; m < 4; ++m) {
                const int rl = rl0 + ai * HALF + m * 16; const size_t row = (size_t)u.pm * BM + rl;
                float part = 0.f;
#pragma unroll
                for (int bj = 0; bj < 2; ++bj) {
                    u32x4* px = (u32x4*)(xb + row * DM + col0 + bj * HALF); const u32x4 xo = *px;
                    const f32x4 a0 = acc[ai][bj][m][0], a1 = acc[ai][bj][m][1];
                    const float v0 = a0[0] + bflo(xo.x), v1 = a0[1] + bfhi(xo.x), v2 = a0[2] + bflo(xo.y), v3 = a0[3] + bfhi(xo.y), v4 = a1[0] + bflo(xo.z), v5 = a1[1] + bfhi(xo.z), v6 = a1[2] + bflo(xo.w), v7 = a1[3] + bfhi(xo.w);
                    u32x4 w; w.x = cvt_pk_bf16(v0, v1); w.y = cvt_pk_bf16(v2, v3); w.z = cvt_pk_bf16(v4, v5); w.w = cvt_pk_bf16(v6, v7);
                    *px = w;
                    part += (v0 * v0 + v1 * v1) + (v2 * v2 + v3 * v3) + (v4 * v4 + v5 * v5) + (v6 * v6 + v7 * v7);
                }
                part += __shfl_xor(part, 16); part += __shfl_xor(part, 32);
                if (fq == 0) ssl[rl * 4 + wc] = part;
            }
        asm volatile("s_waitcnt lgkmcnt(0)" ::: "memory"); __builtin_amdgcn_s_barrier();
        int tq = threadIdx.x; asm volatile("" : "+v"(tq));
        if (tq < 256) { const f32x4 p = *(const LAS f32x4*)(ssl + tq * 4); ssq_part[(size_t)u.pn * M + (size_t)u.pm * BM + tq] = (p[0] + p[1]) + (p[2] + p[3]); }
    }
};
struct EpiSwiglu {
    static constexpr bool PERM = true, AFTER_DRAIN = false, MIDSCALE = false;
    bf16_t* act; const float* ssq;
    DI void operator()(const f32x4 (&acc)[2][2][4][2], const Unit& u, int wr, int wc, int fr, int fq) const {
        int row0 = u.pm * BM + wr * 64 + fr; asm volatile("" : "+v"(row0)); const int j0 = u.pn * 128 + wc * 16 + 4 * fq;
#pragma unroll
        for (int ai = 0; ai < 2; ++ai)
#pragma unroll
            for (int m = 0; m < 4; ++m) {
                const int row = row0 + ai * HALF + m * 16;
                const float rinv = rsqrtf(sum4p(ssq, row) * (1.f / DM) + EPS);
#pragma unroll
                for (int bj = 0; bj < 2; ++bj) {
                    const f32x4 g = acc[ai][bj][m][0] * rinv, up = acc[ai][bj][m][1] * rinv;
                    float a[4];
#pragma unroll
                    for (int i = 0; i < 4; ++i) a[i] = g[i] * up[i] * __builtin_amdgcn_rcpf(1.f + __builtin_amdgcn_exp2f(-1.4426950408889634f * g[i]));
                    u32x2 w; w.x = cvt_pk_bf16(a[0], a[1]); w.y = cvt_pk_bf16(a[2], a[3]);
                    *(u32x2*)(act + (size_t)row * FF + j0 + bj * 64) = w;
                }
            }
    }
};

template <class Epi, class Sched, bool ALIGN_EPI = false, bool SP2 = false>
DI void gemm_phase(LAS unsigned char* lds, const Gemm g, const Sched& S, const Epi& E) {
    int tid_ = threadIdx.x; asm volatile("" : "+v"(tid_));
    const int tid = tid_, wid = __builtin_amdgcn_readfirstlane(tid >> 6), lane = tid & 63, wr = wid >> 2, wc = wid & 3, fr = lane & 15, fq = lane >> 4;
    const int K = g.K, nt = K / BK;
    unsigned voffA[2], voffB[2];
#pragma unroll
    for (int i = 0; i < 2; ++i) { int R, C; stage_rc(tid * 16 + i * 8192, R, C); const int Rb = Epi::PERM ? ((R & ~31) + perm32(R & 31)) : R;
        voffA[i] = (unsigned)(R * K + C) * 2u; voffB[i] = (unsigned)(Rb * K + C) * 2u; }
    const size_t kstep = (size_t)(BK * 2);
    const size_t hstep = (size_t)HALF * K * 2;
    const size_t tstep = 2 * hstep;
    const unsigned ldsw = (unsigned)wid * 1024u;
    const int aoff = lds_byte(wr * 64 + fr, fq * 8), boff = lds_byte(wc * 32 + fr, fq * 8);
#define PG8_SA(b, h) (((b) * 2 + (h)) * HTB)
#define PG8_SB(b, h) ((4 + (b) * 2 + (h)) * HTB)
#define PG8_STAGE(bufoff, gbase, voff) do { _Pragma("unroll") for (int _i = 0; _i < 2; ++_i) \
        __builtin_amdgcn_global_load_lds((const unsigned*)((const char*)(gbase) + (voff)[_i]), (LAS unsigned*)(lds + (bufoff) + ldsw + _i * 8192), 16, 0, 0); } while (0)
#define PG8_LDA(dst, b, h) do { _Pragma("unroll") for (int m = 0; m < 4; ++m) _Pragma("unroll") for (int k = 0; k < 2; ++k) dst[m][k] = *(const LAS bf16x8*)(lds + PG8_SA(b, h) + aoff + m * 2048 + k * 1024); } while (0)
#define PG8_LDB(dst, b, h) do { _Pragma("unroll") for (int n = 0; n < 2; ++n) _Pragma("unroll") for (int k = 0; k < 2; ++k) dst[n][k] = *(const LAS bf16x8*)(lds + PG8_SB(b, h) + boff + n * 2048 + k * 1024); } while (0)
#define PG8_MMA(ai, bj, At, Bt) do { __builtin_amdgcn_s_setprio(1); _Pragma("unroll") for (int m = 0; m < 4; ++m) _Pragma("unroll") for (int n = 0; n < 2; ++n) _Pragma("unroll") for (int k = 0; k < 2; ++k) \
        acc[ai][bj][m][n] = __builtin_amdgcn_mfma_f32_16x16x32_bf16(Bt[n][k], At[m][k], acc[ai][bj][m][n], 0, 0, 0); __builtin_amdgcn_s_setprio(0); } while (0)
#define PG8_WAIT_V(n) asm volatile("s_waitcnt vmcnt(" #n ")" ::: "memory")
#define PG8_WAIT_L(n) asm volatile("s_waitcnt lgkmcnt(" #n ")" ::: "memory")
#define PG8_BAR __builtin_amdgcn_s_barrier()
#define PG8_SCHED __builtin_amdgcn_sched_barrier(0)
    Unit cur, nxt; int ui = 0;
    if (!S.next(0, cur)) return;
    f32x4 acc[2][2][4][2];
#pragma unroll
    for (int a = 0; a < 2; ++a)
#pragma unroll
        for (int b = 0; b < 2; ++b)
#pragma unroll
            for (int m = 0; m < 4; ++m)
#pragma unroll
                for (int n = 0; n < 2; ++n) acc[a][b][m][n] = (f32x4){0.f, 0.f, 0.f, 0.f};
    bf16x8 At[4][2], B0[2][2], B1[2][2];
    const char* cA = (const char*)g.A + (size_t)cur.pm * tstep; const char* cB = (const char*)g.Bt + (size_t)cur.pn * tstep;
    S.a_ready(cur);
    if constexpr (SP2) {
        PG8_STAGE(PG8_SB(0, 0), cB, voffB); PG8_STAGE(PG8_SB(0, 1), cB + hstep, voffB); PG8_STAGE(PG8_SA(0, 0), cA, voffA); PG8_STAGE(PG8_SA(0, 1), cA + hstep, voffA);
        if (wr == 1) PG8_BAR;
        PG8_WAIT_V(2); PG8_BAR;
        PG8_STAGE(PG8_SB(1, 0), cB + kstep, voffB); PG8_STAGE(PG8_SA(1, 0), cA + kstep, voffA); PG8_STAGE(PG8_SB(1, 1), cB + hstep + kstep, voffB);
        PG8_WAIT_V(6); PG8_BAR;
    } else {
        PG8_STAGE(PG8_SB(0, 0), cB, voffB); PG8_STAGE(PG8_SA(0, 0), cA, voffA); PG8_STAGE(PG8_SB(0, 1), cB + hstep, voffB); PG8_STAGE(PG8_SA(0, 1), cA + hstep, voffA);
        if (wr == 1) PG8_BAR;
        PG8_WAIT_V(4); PG8_BAR;
        PG8_STAGE(PG8_SB(1, 0), cB + kstep, voffB); PG8_STAGE(PG8_SA(1, 0), cA + kstep, voffA); PG8_STAGE(PG8_SB(1, 1), cB + hstep + kstep, voffB);
        PG8_WAIT_V(6); PG8_BAR;
    }
    for (;;) {
        const bool has_next = S.next(ui + 1, nxt);
        const char* nA = has_next ? (const char*)g.A + (size_t)nxt.pm * tstep : cA; const char* nB = has_next ? (const char*)g.Bt + (size_t)nxt.pn * tstep : cB;
        for (int t = 0; t < nt; t += 2) {
            const bool last = (t == nt - 2);
            const char* a1 = cA + (size_t)(t + 1) * kstep;
            const char* a2 = last ? nA : cA + (size_t)(t + 2) * kstep; const char* b2 = last ? nB : cB + (size_t)(t + 2) * kstep;
            const char* a3 = a2 + kstep; const char* b3 = b2 + kstep;
            if (last && has_next) S.a_ready(nxt);
            if constexpr (SP2) {
            PG8_LDB(B0, 0, 0); PG8_LDB(B1, 0, 1); PG8_SCHED; PG8_LDA(At, 0, 0); PG8_STAGE(PG8_SA(1, 1), a1 + hstep, voffA);
            PG8_WAIT_V(8); PG8_WAIT_L(0); PG8_BAR; PG8_MMA(0, 0, At, B0); PG8_MMA(0, 1, At, B1); PG8_BAR; PG8_SCHED;
            PG8_LDA(At, 0, 1); PG8_STAGE(PG8_SB(0, 0), b2, voffB); PG8_STAGE(PG8_SB(0, 1), b2 + hstep, voffB); PG8_STAGE(PG8_SA(0, 0), a2, voffA);
            PG8_WAIT_V(8); PG8_WAIT_L(0); PG8_BAR; PG8_MMA(1, 0, At, B0); PG8_MMA(1, 1, At, B1); PG8_BAR; PG8_SCHED;
            PG8_LDB(B0, 1, 0); PG8_LDB(B1, 1, 1); PG8_SCHED; PG8_LDA(At, 1, 0); PG8_STAGE(PG8_SA(0, 1), a2 + hstep, voffA);
            PG8_WAIT_V(8); PG8_WAIT_L(0); PG8_BAR; PG8_MMA(0, 0, At, B0); PG8_MMA(0, 1, At, B1); PG8_BAR; PG8_SCHED;
            PG8_LDA(At, 1, 1); PG8_STAGE(PG8_SB(1, 0), b3, voffB); PG8_STAGE(PG8_SB(1, 1), b3 + hstep, voffB); PG8_STAGE(PG8_SA(1, 0), a3, voffA);
            PG8_WAIT_V(8); PG8_WAIT_L(0); PG8_BAR; PG8_MMA(1, 0, At, B0); PG8_MMA(1, 1, At, B1); PG8_BAR; PG8_SCHED;
            if constexpr (Epi::MIDSCALE) { if (t == 2) E.midscale(acc, cur, wr, fr); }
            } else {
            PG8_LDB(B0, 0, 0); PG8_SCHED; PG8_LDA(At, 0, 0); PG8_STAGE(PG8_SA(1, 1), a1 + hstep, voffA);
            PG8_WAIT_L(8); PG8_BAR; PG8_WAIT_L(0); PG8_MMA(0, 0, At, B0); PG8_BAR; PG8_SCHED;
            PG8_LDB(B1, 0, 1); PG8_STAGE(PG8_SB(0, 0), b2, voffB);
            PG8_BAR; PG8_WAIT_L(0); PG8_MMA(0, 1, At, B1); PG8_BAR;
            PG8_LDA(At, 0, 1); PG8_STAGE(PG8_SA(0, 0), a2, voffA);
            PG8_BAR; PG8_WAIT_L(0); PG8_MMA(1, 0, At, B0); PG8_BAR; PG8_SCHED;
            PG8_STAGE(PG8_SB(0, 1), b2 + hstep, voffB);
            PG8_WAIT_V(6); PG8_BAR; PG8_MMA(1, 1, At, B1); PG8_BAR;
            PG8_LDB(B0, 1, 0); PG8_SCHED; PG8_LDA(At, 1, 0); PG8_STAGE(PG8_SA(0, 1), a2 + hstep, voffA);
            PG8_WAIT_L(8); PG8_BAR; PG8_WAIT_L(0); PG8_MMA(0, 0, At, B0); PG8_BAR; PG8_SCHED;
            PG8_LDB(B1, 1, 1); PG8_STAGE(PG8_SB(1, 0), b3, voffB);
            PG8_BAR; PG8_WAIT_L(0); PG8_MMA(0, 1, At, B1); PG8_BAR;
            PG8_LDA(At, 1, 1); PG8_STAGE(PG8_SA(1, 0), a3, voffA);
            PG8_BAR; PG8_WAIT_L(0); PG8_MMA(1, 0, At, B0); PG8_BAR; PG8_SCHED;
            PG8_STAGE(PG8_SB(1, 1), b3 + hstep, voffB);
            PG8_WAIT_V(6); PG8_BAR; PG8_MMA(1, 1, At, B1); PG8_BAR;
            }
        }
        if constexpr (ALIGN_EPI) { if (wr == 0) PG8_BAR; }
        if constexpr (!Epi::AFTER_DRAIN) { E(acc, cur, wr, wc, fr, fq); S.done(cur); }
        if (!has_next) break;
#pragma unroll
        for (int a = 0; a < 2; ++a)
#pragma unroll
            for (int b = 0; b < 2; ++b)
#pragma unroll
                for (int m = 0; m < 4; ++m)
#pragma unroll
                    for (int n = 0; n < 2; ++n) acc[a][b][m][n] = (f32x4){0.f, 0.f, 0.f, 0.f};
        cur = nxt; cA = nA; cB = nB; ++ui;
        if constexpr (ALIGN_EPI) { if (wr == 1) PG8_BAR; }
    }
    PG8_WAIT_V(0);
    if constexpr (!ALIGN_EPI) { if (wr == 0) PG8_BAR; }
    PG8_BAR;
#undef PG8_SA
#undef PG8_SB
#undef PG8_STAGE
#undef PG8_LDA
#undef PG8_LDB
#undef PG8_MMA
#undef PG8_WAIT_V
#undef PG8_WAIT_L
#undef PG8_BAR
#undef PG8_SCHED
}
}

#define XB_TMO      128
#define XB_XCNT(j)  (256  + 64 * (j))
#define XB_XSUB(j)  (1280 + 64 * (j))
#define XB_XGEN(j)  (2304 + 64 * (j))
#define XB_TOP      3328
#define XB_TOPGEN   3392
#define XCD_BAR_WORDS 3456
#define XB_SPIN_CAP (1u << 18)
__device__ __forceinline__ unsigned xb_ld(unsigned* p)              { return __hip_atomic_load(p, __ATOMIC_RELAXED, __HIP_MEMORY_SCOPE_AGENT); }
__device__ __forceinline__ unsigned xb_add(unsigned* p, unsigned v) { return __hip_atomic_fetch_add(p, v, __ATOMIC_RELAXED, __HIP_MEMORY_SCOPE_AGENT); }
__device__ __forceinline__ unsigned xb_xcc_id() { return (unsigned)__builtin_amdgcn_s_getreg((3 << 11) | 20) & 0xFu; }
#define XB_SPIN(cond, bar) do { unsigned _sp = 0; while (cond) { __builtin_amdgcn_s_sleep(1); \
    if ((++_sp & 255u) == 0u) { if (xb_ld(&(bar)[XB_TMO])) break; if (_sp > XB_SPIN_CAP) { atomicAdd(&(bar)[XB_TMO], 1u); break; } } } } while (0)
struct XcdBarrier { unsigned* bar; unsigned x; volatile LAS unsigned* st; };
__device__ __forceinline__ XcdBarrier xcd_barrier_post(unsigned* bar, volatile LAS unsigned* st) {
    XcdBarrier b; b.bar = bar; b.x = xb_xcc_id(); b.st = st;
    if (threadIdx.x == 0) (void)xb_add(&bar[XB_XCNT(b.x)], 1u);
    return b;
}
__device__ __forceinline__ void xcd_barrier_complete(unsigned* bar, unsigned x, unsigned& nloc, unsigned& nx) {
    const unsigned G = gridDim.x * gridDim.y * gridDim.z;
    unsigned sum, cnt, mine, sp = 0u;
    for (;;) {
        sum = 0u; cnt = 0u; mine = 0u;
#pragma unroll
        for (unsigned j = 0; j < 16; ++j) { const unsigned c = xb_ld(&bar[XB_XCNT(j)]); sum += c; cnt += (c > 0u) ? 1u : 0u; mine = (j == x) ? c : mine; }
        if (sum == G) break;
        __builtin_amdgcn_s_sleep(1);
        if ((++sp & 255u) == 0u) { if (xb_ld(&bar[XB_TMO])) break; if (sp > XB_SPIN_CAP) { atomicAdd(&bar[XB_TMO], 1u); break; } }
    }
    nloc = mine > 0u ? mine : 1u; nx = cnt > 0u ? cnt : 1u;
}
__device__ __forceinline__ void xcd_barrier(const XcdBarrier& b) {
    asm volatile("s_waitcnt vmcnt(0)" ::: "memory");
    __syncthreads();
    if (threadIdx.x == 0) {
        unsigned* bar = b.bar;
        __builtin_amdgcn_s_waitcnt(0);
        unsigned nloc = b.st[0], nx = b.st[1];
        if (nloc == 0u) { xcd_barrier_complete(bar, b.x, nloc, nx); b.st[0] = nloc; b.st[1] = nx; }
        const unsigned old = xb_add(&bar[XB_XSUB(b.x)], 1u);
        const unsigned gen = old / nloc;
        if (old + 1u == (gen + 1u) * nloc) {
            __builtin_amdgcn_fence(__ATOMIC_RELEASE, "agent");
            asm volatile("s_waitcnt vmcnt(0)" ::: "memory");
            const unsigned og = xb_add(&bar[XB_TOP], 1u);
            const unsigned tg = og / nx;
            if (og + 1u == (tg + 1u) * nx) xb_add(&bar[XB_TOPGEN], 1u);
            else XB_SPIN(xb_ld(&bar[XB_TOPGEN]) == tg, bar);
            __builtin_amdgcn_fence(__ATOMIC_ACQUIRE, "agent");
            xb_add(&bar[XB_XGEN(b.x)], 1u);
            asm volatile("s_waitcnt vmcnt(0)" ::: "memory");
        } else {
            XB_SPIN(xb_ld(&bar[XB_XGEN(b.x)]) == gen, bar);
            __builtin_amdgcn_fence(__ATOMIC_ACQUIRE, "agent");
            asm volatile("s_waitcnt vmcnt(0)" ::: "memory");
        }
    }
    __syncthreads();
}

template <int MAP>
DI int colmap(int v, int Nsrc) {
    if (MAP == 0) return v < Nsrc ? v : -1;
    const int g8 = v >> 3, e = v & 7, j = 4 * g8 + (e & 3); return (e < 4) ? j : FF + j;
}
template <int MAP, int KROT = 0>
DI void p0_transpose_item64(const float* W, int K, int Nsrc, const float* gain, bf16_t* WT, LAS float* scr, int kb, int nb, int lane) {
    const int k0 = 64 * kb, n0 = 64 * nb, v = n0 + 4 * (lane & 15);
    const int sc = MAP == 0 ? (v < Nsrc ? v : -1) : ((v >> 3) * 4 + ((v >> 2) & 1) * FF);
#pragma unroll 4
    for (int i = 0; i < 16; ++i) { const int kk = 4 * i + (lane >> 4); int ksrc = k0 + kk + KROT; if (KROT && ksrc >= K) ksrc -= K; f32x4 w = {0.f, 0.f, 0.f, 0.f}; if (sc >= 0) w = *(const f32x4*)(W + (size_t)ksrc * Nsrc + sc); if (gain) w = w * gain[ksrc];
        LAS float* d = scr + kk * 65 + 4 * (lane & 15); d[0] = w[0]; d[1] = w[1]; d[2] = w[2]; d[3] = w[3]; }
    WSYNC();
    const int c = lane & 7;
#pragma unroll
    for (int j = 0; j < 8; ++j) { const int n = (lane >> 3) + 8 * j; const LAS float* s = scr + (8 * c) * 65 + n;
        u32x4 o; o.x = pk2(s[0 * 65], s[1 * 65]); o.y = pk2(s[2 * 65], s[3 * 65]); o.z = pk2(s[4 * 65], s[5 * 65]); o.w = pk2(s[6 * 65], s[7 * 65]);
        *(u32x4*)(WT + (size_t)(n0 + n) * K + k0 + 8 * c) = o; }
    WSYNC();
}
template <int MAP, int KROT = 0>
DI void p0_transpose_item(const float* W, int K, int Nsrc, const float* gain, bf16_t* WT, LAS float* scr, int kb, int nb, int lane) {
    const int k0 = 64 * kb, n0 = 32 * nb;
    const int sc = colmap<MAP>(n0 + (lane & 31), Nsrc);
#pragma unroll 8
    for (int i = 0; i < 32; ++i) { const int kk = 2 * i + (lane >> 5); int ksrc = k0 + kk + KROT; if (KROT && ksrc >= K) ksrc -= K; float w = 0.f; if (sc >= 0) w = W[(size_t)ksrc * Nsrc + sc]; if (gain) w *= gain[ksrc]; scr[kk * 33 + (lane & 31)] = w; }
    WSYNC();
    const int c = lane & 7;
#pragma unroll
    for (int j = 0; j < 4; ++j) { const int n = (lane >> 3) + 8 * j; const LAS float* s = scr + (8 * c) * 33 + n;
        u32x4 o; o.x = pk2(s[0 * 33], s[1 * 33]); o.y = pk2(s[2 * 33], s[3 * 33]); o.z = pk2(s[4 * 33], s[5 * 33]); o.w = pk2(s[6 * 33], s[7 * 33]);
        *(u32x4*)(WT + (size_t)(n0 + n) * K + k0 + 8 * c) = o; }
    WSYNC();
}


typedef float f32x16 __attribute__((ext_vector_type(16)));
typedef float f32x2v __attribute__((ext_vector_type(2)));
typedef __bf16 bf16x2_t __attribute__((ext_vector_type(2)));
constexpr int KSTR = 208, VSTR = 136;
constexpr int AL_K0 = 0, AL_K1 = 64 * KSTR, AL_V0 = 2 * 64 * KSTR, AL_V1 = AL_V0 + 64 * VSTR, AL_IMP = 45056, AL_SELM = AL_IMP + 32768, AL_OACC = AL_SELM + 1024;
constexpr float NEGB = -1e30f, LOG2E = 1.4426950408889634f;
DI unsigned cvtpk(float lo, float hi) { f32x2v v = {lo, hi}; bf16x2_t b = __builtin_convertvector(v, bf16x2_t); return __builtin_bit_cast(unsigned, b); }
DI f32x16 mfma32(bf16x8 a, bf16x8 b, f32x16 c) { return __builtin_amdgcn_mfma_f32_32x32x16_bf16(a, b, c, 0, 0, 0); }
DI float xhalf_max(float v) { auto rr = __builtin_amdgcn_permlane32_swap(__float_as_uint(v), __float_as_uint(v), false, false); return fmaxf(__uint_as_float(rr[0]), __uint_as_float(rr[1])); }
DI float xhalf_sum(float v) { auto rr = __builtin_amdgcn_permlane32_swap(__float_as_uint(v), __float_as_uint(v), false, false); return __uint_as_float(rr[0]) + __uint_as_float(rr[1]); }
DI float ex2(float x) { return __builtin_amdgcn_exp2f(x); }
template <int KSTEPS>
DI void qk_tile(const LAS unsigned char* Kt, const bf16x8 (&qf)[KSTEPS], int r32, int hi, f32x16& s0, f32x16& s1) {
    const LAS unsigned char* p0 = Kt + r32 * KSTR + hi * 16;
#pragma unroll
    for (int i = 0; i < 16; ++i) { s0[i] = 0.f; s1[i] = 0.f; }
#pragma unroll
    for (int ks = 0; ks < KSTEPS; ++ks) {
        const bf16x8 a0 = *(const LAS bf16x8*)(p0 + ks * 32), a1 = *(const LAS bf16x8*)(p0 + 32 * KSTR + ks * 32);
        s0 = mfma32(a0, qf[ks], s0); s1 = mfma32(a1, qf[ks], s1);
    }
}
DI void mask_tile(f32x16& s0, f32x16& s1, int klo, int khi, int hi) {
    const int lo_ = klo - 4 * hi, hi_ = khi - 4 * hi;
#pragma unroll
    for (int i = 0; i < 16; ++i) { const int kb = (i & 3) + 8 * (i >> 2); if (kb < lo_ || kb > hi_) s0[i] = NEGB; if (kb + 32 < lo_ || kb + 32 > hi_) s1[i] = NEGB; }
}
DI float tile_max(const f32x16& s0, const f32x16& s1) {
    float mx = fmaxf(s0[0], s1[0]);
#pragma unroll
    for (int i = 1; i < 16; ++i) mx = fmaxf(mx, fmaxf(s0[i], s1[i]));
    return xhalf_max(mx);
}
template <int BASE> DI bf16x8 pack8(const f32x16& s) { u32x4 p; p.x = cvtpk(s[BASE], s[BASE + 1]); p.y = cvtpk(s[BASE + 2], s[BASE + 3]); p.z = cvtpk(s[BASE + 4], s[BASE + 5]); p.w = cvtpk(s[BASE + 6], s[BASE + 7]); return __builtin_bit_cast(bf16x8, p); }
DI bf16x8 ld8x2(const bf16_t* p) { const u32x2 a = *(const u32x2*)p, b = *(const u32x2*)(p + 4); u32x4 w; w.x = a.x; w.y = a.y; w.z = b.x; w.w = b.y; return __builtin_bit_cast(bf16x8, w); }
DI bf16x8 vfrag(const LAS unsigned char* p) { const u32x2 a = *(const LAS u32x2*)p, b = *(const LAS u32x2*)(p + 16); u32x4 w; w.x = a.x; w.y = a.y; w.z = b.x; w.w = b.y; return __builtin_bit_cast(bf16x8, w); }
template <int VS = VSTR>
DI void pv_tile(const f32x16& s0, const f32x16& s1, const LAS unsigned char* Vt, f32x16 (&o)[2], int r32, int hi) {
    const bf16x8 p00 = pack8<0>(s0), p01 = pack8<8>(s0), p10 = pack8<0>(s1), p11 = pack8<8>(s1);
#pragma unroll
    for (int dt = 0; dt < 2; ++dt) { const LAS unsigned char* vp = Vt + (32 * dt + r32) * VS + 8 * hi;
        o[dt] = mfma32(vfrag(vp), p00, o[dt]); o[dt] = mfma32(vfrag(vp + 32), p01, o[dt]); o[dt] = mfma32(vfrag(vp + 64), p10, o[dt]); o[dt] = mfma32(vfrag(vp + 96), p11, o[dt]); }
}
DI void softmax_pv(f32x16& s0, f32x16& s1, const LAS unsigned char* Vt, f32x16 (&o)[2], float& m, float& l, int r32, int hi) {
    const float mx = tile_max(s0, s1), mn = fmaxf(m, mx), ms = mn < -1e29f ? 0.f : mn, alpha = ex2(m - ms);
    m = mn; float psum = 0.f;
#pragma unroll
    for (int i = 0; i < 16; ++i) { s0[i] = ex2(s0[i] - ms); s1[i] = ex2(s1[i] - ms); psum += s0[i] + s1[i]; }
    l = l * alpha + psum;
    if (!__all(alpha == 1.f)) {
#pragma unroll
        for (int i = 0; i < 16; ++i) { o[0][i] *= alpha; o[1][i] *= alpha; } }
    pv_tile(s0, s1, Vt, o, r32, hi);
}
struct SoftState { float m, l; };
constexpr float SM_THR = 8.f;
DI void soft_init(SoftState& S, f32x16 (&o)[2]) { S.m = 0.f; S.l = 0.f;
#pragma unroll
    for (int i = 0; i < 16; ++i) { o[0][i] = 0.f; o[1][i] = 0.f; } }
DI f32x16 bcast16(float v) { f32x16 c;
#pragma unroll
    for (int i = 0; i < 16; ++i) c[i] = v;
    return c; }
DI float max3f(float a, float b, float c) { float r; asm("v_max3_f32 %0, %1, %2, %3" : "=v"(r) : "v"(a), "v"(b), "v"(c)); return r; }
DI float soft_update(f32x16& s0, f32x16& s1, SoftState& S, f32x16 (&o)[2], bool masked, int klo, int khi, bool first, int hi, float adj = 0.f) {
    if (__any(adj != 0.f)) {
#pragma unroll
        for (int i = 0; i < 16; ++i) { s0[i] -= adj; s1[i] -= adj; } }
    float dl_ret = 0.f;
    if (__builtin_expect(masked, 0)) { asm volatile("; boundary tile mask" ::: "memory"); mask_tile(s0, s1, klo, khi, hi); }
    asm volatile("s_nop 15\n\ts_nop 7" : "+v"(s0), "+v"(s1));
    float rm;
    { float a = max3f(s0[0], s0[1], s0[2]), b = max3f(s1[0], s1[1], s1[2]);
#pragma unroll
      for (int i = 3; i < 15; i += 2) { a = max3f(a, s0[i], s0[i + 1]); b = max3f(b, s1[i], s1[i + 1]); }
      rm = xhalf_max(fmaxf(max3f(a, b, s0[15]), s1[15])); }
    if (first) {
        const float dl = rm < -1e29f ? 0.f : rm; S.m = dl; dl_ret = dl;
#pragma unroll
        for (int i = 0; i < 16; ++i) { s0[i] -= dl; s1[i] -= dl; }
    } else if (__any(rm > SM_THR)) {
        const float dl = fmaxf(rm, 0.f), alpha = ex2(-dl); S.m += dl; S.l *= alpha; dl_ret = dl;
#pragma unroll
        for (int i = 0; i < 16; ++i) { s0[i] -= dl; s1[i] -= dl; o[0][i] *= alpha; o[1][i] *= alpha; }
    }
    float p0 = 0.f, p1 = 0.f, p2 = 0.f, p3 = 0.f;
#pragma unroll
    for (int i = 0; i < 16; i += 2) { s0[i] = ex2(s0[i]); s0[i + 1] = ex2(s0[i + 1]); s1[i] = ex2(s1[i]); s1[i + 1] = ex2(s1[i + 1]); p0 += s0[i]; p1 += s0[i + 1]; p2 += s1[i]; p3 += s1[i + 1]; }
    S.l += (p0 + p1) + (p2 + p3);
    return dl_ret;
}
template <int KSTEPS, int VS = VSTR>
DI void attn_step(const LAS unsigned char* Kt, const LAS unsigned char* Vt, const bf16x8 (&qf)[KSTEPS], SoftState& S, f32x16 (&o)[2], bool masked, int klo, int khi, bool first, int r32, int hi) {
    const f32x16 cinit = bcast16(-S.m); f32x16 s0 = cinit, s1 = cinit;
    { const LAS unsigned char* p0 = Kt + r32 * KSTR + hi * 16;
#pragma unroll
      for (int ks = 0; ks < KSTEPS; ++ks) { const bf16x8 a0 = *(const LAS bf16x8*)(p0 + ks * 32), a1 = *(const LAS bf16x8*)(p0 + 32 * KSTR + ks * 32);
          s0 = mfma32(a0, qf[ks], s0); s1 = mfma32(a1, qf[ks], s1); } }
    soft_update(s0, s1, S, o, masked, klo, khi, first, hi);
    pv_tile<VS>(s0, s1, Vt, o, r32, hi);
}
template <int KSTEPS, int VS>
DI void attn_step2(const LAS unsigned char* Kt, const LAS unsigned char* Vt, const bf16x8 (&qf)[KSTEPS], SoftState& S, f32x16 (&o)[2], bool masked0, int khi0, bool masked1, int khi1, bool first, int r32, int hi) {
    const f32x16 cinit = bcast16(-S.m); f32x16 a0 = cinit, a1 = cinit, b0 = cinit, b1 = cinit;
    { const LAS unsigned char* p0 = Kt + r32 * KSTR + hi * 16;
#pragma unroll
      for (int ks = 0; ks < KSTEPS; ++ks) { const bf16x8 k0 = *(const LAS bf16x8*)(p0 + ks * 32), k1 = *(const LAS bf16x8*)(p0 + 32 * KSTR + ks * 32);
          a0 = mfma32(k0, qf[ks], a0); a1 = mfma32(k1, qf[ks], a1); }
#pragma unroll
      for (int ks = 0; ks < KSTEPS; ++ks) { const bf16x8 k0 = *(const LAS bf16x8*)(p0 + 64 * KSTR + ks * 32), k1 = *(const LAS bf16x8*)(p0 + 96 * KSTR + ks * 32);
          b0 = mfma32(k0, qf[ks], b0); b1 = mfma32(k1, qf[ks], b1); } }
    const float dl0 = soft_update(a0, a1, S, o, masked0, 0, khi0, first, hi);
    pv_tile<VS>(a0, a1, Vt, o, r32, hi);
    (void)soft_update(b0, b1, S, o, masked1, 0, khi1, false, hi, dl0);
    pv_tile<VS>(b0, b1, Vt + 128, o, r32, hi);
}
struct StageRegs { u32x4 a, b, c, d, e; };
template <class LoadF, class StoreF, class StepF>
DI void attn_pipeline(int jbeg, int jend, LoadF ld, StoreF st, StepF step) {
    if (jbeg > jend) return;
    StageRegs RA;
    ld(jbeg, RA); st(0, RA); __syncthreads();
    for (int j = jbeg; j <= jend; j += 2) {
        if (j + 1 <= jend) ld(j + 1, RA);
        step(j, 0);
        if (j + 1 <= jend) st(1, RA);
        __syncthreads();
        if (STAGGER && __builtin_amdgcn_readfirstlane(threadIdx.x >> 6) >= 4) __builtin_amdgcn_s_sleep(STAGGER);
        if (j + 1 > jend) break;
        if (j + 2 <= jend) ld(j + 2, RA);
        step(j + 1, 1);
        if (j + 2 <= jend) st(0, RA);
        __syncthreads();
        if (STAGGER && __builtin_amdgcn_readfirstlane(threadIdx.x >> 6) >= 4) __builtin_amdgcn_s_sleep(STAGGER);
    }
}
DI const float* inp(const Args& a, int k) { asm volatile("" : "+s"(k)); return a.in[k]; }
__global__ void __launch_bounds__(NTHR, 2) fwd(Args args) {
    extern __shared__ __attribute__((aligned(16))) unsigned char lds_raw[];
    LAS unsigned char* lds = (LAS unsigned char*)lds_raw;
    LAS float* ldsf = (LAS float*)lds;
    volatile LAS unsigned* LCTL = (volatile LAS unsigned*)(lds + LDS_CTL);
    const int tid0 = threadIdx.x, wave = __builtin_amdgcn_readfirstlane(tid0 >> 6);
    const int G = gridDim.x, bid = blockIdx.x;
#define LAUNDER_TID() int tid = tid0; asm volatile("" : "+v"(tid)); const int lane = tid & 63; (void)lane
#define WS_PTRS() unsigned char* ws = args.ws; asm volatile("" : "+s"(ws)); \
    unsigned* ctl = (unsigned*)(ws + WS_CTL); float* ssp_base = (float*)(ws + WS_SSP); float* hb = (float*)(ws + WS_HB); \
    bf16_t* XB = (bf16_t*)(ws + WS_XB); bf16_t* Y = (bf16_t*)(ws + WS_Y); bf16_t* PB = (bf16_t*)(ws + WS_PB); bf16_t* ACT = (bf16_t*)(ws + WS_ACT); \
    const float2* cs64 = (const float2*)(ws + WS_CS64); const float2* cs32 = (const float2*)(ws + WS_CS32); \
    float* LRA = args.out; float* LRU_ = args.out + (size_t)M * 256; \
    float* LA = (float*)(ws + WS_LA); float* LH = (float*)(ws + WS_LH); float* CIN = (float*)(ws + WS_CIN); \
    float* KVC = (float*)(ws + WS_KVC); float* DEC = (float*)(ws + WS_DEC); float* SST = (float*)(ws + WS_SST); \
    bf16_t* MQ = (bf16_t*)(ws + WS_MQ); bf16_t* MKN = (bf16_t*)(ws + WS_MKN); bf16_t* MVT = (bf16_t*)(ws + WS_MV); bf16_t* MKR = (bf16_t*)(ws + WS_MKR); \
    bf16_t* VST = (bf16_t*)(ws + WS_VST); bf16_t* KSF = (bf16_t*)(ws + WS_KSF); (void)KSF; bf16_t* VWT = (bf16_t*)(ws + WS_VWT); bf16_t* KCMPB = (bf16_t*)(ws + WS_KCMPB); bf16_t* VCMPT = (bf16_t*)(ws + WS_VCMPT); \
    const float* ssq_mix = ssp_base + (size_t)(l_ == 0 ? 0 : 2) * 4 * M; float* ssq_out = ssp_base + (size_t)(1 + 3 * l_) * 4 * M; float* ssq_down = ssp_base + (size_t)(2 + 3 * l_) * 4 * M; float* ssq_d = ssp_base + (size_t)(3 + 3 * l_) * 4 * M; \
    (void)ctl; (void)hb; (void)XB; (void)Y; (void)PB; (void)ACT; (void)cs64; (void)cs32; (void)LRA; (void)LRU_; (void)LA; (void)LH; (void)CIN; (void)KVC; (void)DEC; (void)SST; (void)MQ; (void)MKN; (void)MVT; (void)MKR; (void)VST; (void)VWT; (void)KCMPB; (void)VCMPT; (void)ssq_mix; (void)ssq_out; (void)ssq_down; (void)ssq_d
    unsigned* ctl0 = (unsigned*)(args.ws + WS_CTL);
    { LAUNDER_TID(); if (tid < 16) LCTL[tid] = 0u; }
    __syncthreads();
    const int lo = args.ph_lo, hi = args.ph_hi;
    XcdBarrier bar; bar.bar = ctl0 + CW_BAR; bar.x = 0; bar.st = LCTL;
    if (hi - lo > 1) bar = xcd_barrier_post(ctl0 + CW_BAR, LCTL);
#define IN(k) (lo <= (k) && (k) < hi)
#define SEAM(k) do { if (IN(k) && IN((k) + 1)) xcd_barrier(bar); } while (0)

    if (IN(0)) {
        const int l_ = 0; WS_PTRS();
      _Pragma("unroll 1") for (int rep = 0; rep < REP_P0; ++rep) {
        LAUNDER_TID();
        const int gw = bid * 8 + wave, NGW = G * 8;
        LAS float* scr = ldsf + wave * 4224; LAS float* scr64 = scr;
        constexpr int I_IN = 16 * 36, I_OUT = 16 * 16, I_GU = 16 * 88, I_DN = 44 * 16, I_L = I_IN + I_OUT + I_GU + I_DN;
        for (int it = gw; it < 2 * I_L; it += NGW) {
            const int l = it / I_L; int r = it % I_L;
            if (r < I_IN) { p0_transpose_item64<0>(inp(args, 3) + (size_t)l * DM * NINS, DM, NINS, inp(args, 2) + l * DM, (bf16_t*)(ws + WS_WIN) + (size_t)l * NIN * DM, scr64, r / 36, r % 36, lane); continue; } r -= I_IN;
            if (r < I_OUT) { p0_transpose_item64<0, 768>(inp(args, 23) + (size_t)l * DM * DM, DM, DM, inp(args, 22) + l * DM, (bf16_t*)(ws + WS_WOUT) + (size_t)l * DM * DM, scr64, r / 16, r % 16, lane); continue; } r -= I_OUT;
            if (r < I_GU) { p0_transpose_item64<1>(inp(args, 25) + (size_t)l * DM * NGU, DM, NGU, inp(args, 24) + l * DM, (bf16_t*)(ws + WS_WGU) + (size_t)l * NGU * DM, scr64, r / 88, r % 88, lane); continue; } r -= I_GU;
            p0_transpose_item64<0>(inp(args, 26) + (size_t)l * FF * DM, FF, DM, nullptr, (bf16_t*)(ws + WS_WDN) + (size_t)l * DM * FF, scr64, r / 16, r % 16, lane);
        }
        { constexpr int I_UQ = 3 * 12, I_UKV = 2 * 16, I_W1 = 32 * 8, I_W2 = 4 * 2, I_S = 2 * I_UQ + 2 * I_UKV + 4 * I_W1 + 4 * I_W2;
          for (int it = gw; it < I_S; it += NGW) { int r = it;
              if (r < 2 * I_UQ) { const int l = r / I_UQ; r %= I_UQ; p0_transpose_item<0>(inp(args, 20) + (size_t)l * 192 * 384, 192, 384, inp(args, 18) + l * 192, (bf16_t*)(ws + WS_WUQT) + (size_t)l * 384 * 192, scr, r / 12, r % 12, lane); continue; } r -= 2 * I_UQ;
              if (r < 2 * I_UKV) { const int l = r / I_UKV; r %= I_UKV; p0_transpose_item<0>(inp(args, 21) + (size_t)l * 128 * 512, 128, 512, inp(args, 19) + l * 128, (bf16_t*)(ws + WS_WUKVT) + (size_t)l * 512 * 128, scr, r / 16, r % 16, lane); continue; } r -= 2 * I_UKV;
              if (r < 4 * I_W1) { const int lj = r / I_W1; r %= I_W1; p0_transpose_item<0>(inp(args, 12) + (size_t)lj * 2048 * 256, 2048, 256, nullptr, (bf16_t*)(ws + WS_W1T) + (size_t)lj * 256 * 2048, scr, r / 8, r % 8, lane); continue; } r -= 4 * I_W1;
              { const int lj = r / I_W2; r %= I_W2; p0_transpose_item<0>(inp(args, 14) + (size_t)lj * 256 * 64, 256, 64, nullptr, (bf16_t*)(ws + WS_W2T) + (size_t)lj * 64 * 256, scr, r / 2, r % 2, lane); } } }
        for (int e = bid * NTHR + tid; e < 2 * 2 * 4 * 64 * 64; e += G * NTHR) {
            const int k = e & 63, n = (e >> 6) & 63, h = (e >> 12) & 3, g = (e >> 14) & 1, l = e >> 15;
            ((bf16_t*)(ws + WS_WGT))[e] = f2bf((g == 0 ? inp(args, 6) : inp(args, 8))[(((size_t)l * 4 + h) * 64 + k) * 64 + n]); }
        for (int e = bid * NTHR + tid; e < 512; e += G * NTHR) ((float*)(ws + WS_SP))[e] = log1pf(expf(-inp(args, 10)[e]));
        for (int m = gw; m < M; m += NGW) {
            const f32x4* xr = (const f32x4*)(inp(args, 0) + (size_t)m * DM) + lane;
            f32x4 v[4]; float s = 0.f;
#pragma unroll
            for (int j = 0; j < 4; ++j) { v[j] = xr[64 * j]; s += v[j][0] * v[j][0] + v[j][1] * v[j][1] + v[j][2] * v[j][2] + v[j][3] * v[j][3]; }
            s = wave_sum(s);
            u32x2* o8 = (u32x2*)(XB + (size_t)m * DM) + lane;
#pragma unroll
            for (int j = 0; j < 4; ++j) { u32x2 w; w.x = pk2(v[j][0], v[j][1]); w.y = pk2(v[j][2], v[j][3]); o8[64 * j] = w; }
            if (lane < 4) ssp_base[(size_t)lane * M + m] = lane == 0 ? s : 0.f;
        }
        for (int e = bid * NTHR + tid; e < M * 32; e += G * NTHR) {
            const int m = e >> 5, i = e & 31; const float pos = (float)((const int*)inp(args, 1))[m];
            const float invf = __builtin_amdgcn_exp2f(-(float)(2 * i) * (13.287712379549449f / 64.f)); float sn, cs; { float rv = pos * invf * 0.15915494309189535f; rv -= floorf(rv); sn = __builtin_amdgcn_sinf(rv); cs = __builtin_amdgcn_cosf(rv); }
            ((float2*)(ws + WS_CS64))[e] = make_float2(cs, sn);
            if (i < 16) { const float invf2 = __builtin_amdgcn_exp2f(-(float)(2 * i) * (13.287712379549449f / 32.f)); float rv = pos * invf2 * 0.15915494309189535f; rv -= floorf(rv); sn = __builtin_amdgcn_sinf(rv); cs = __builtin_amdgcn_cosf(rv); ((float2*)(ws + WS_CS32))[m * 16 + i] = make_float2(cs, sn); }
        }
        for (int e = bid * NTHR + tid; e < 2 * 2 * 256; e += G * NTHR) {
            const int lj = e >> 8, c = e & 255; float a = inp(args, 13)[e];
            const float* pp = inp(args, 11) + (size_t)lj * 2048; const float* w1 = inp(args, 12) + (size_t)lj * 2048 * 256 + c;
            for (int i = 0; i < 2048; ++i) a += pp[i] * w1[(size_t)i * 256];
            hb[e] = a;
        }
      }
    }
    SEAM(0);

    for (int l = 0; l < 2; ++l) {
        const int pb = 1 + 6 * l;
        if (IN(pb)) {
        const int l_ = l; WS_PTRS();
            pg8::Gemm g{XB, (const bf16_t*)(ws + WS_WIN) + (size_t)l * NIN * DM, M, NIN, DM}; pg8::StaticOrder S; S.init(M, NIN, G, bid);
            pg8::EpiInProj E{PB, NIN, ssq_mix};
            _Pragma("unroll 1") for (int rep = 0; rep < REP_G16; ++rep) pg8::gemm_phase<pg8::EpiInProj, pg8::StaticOrder, true, true>(lds, g, S, E);
        }
        SEAM(pb);
        if (IN(pb + 1)) {
        const int l_ = l; WS_PTRS();
        LAUNDER_TID();
            constexpr int N_J1 = 1024, N_J2 = 512, N_J3 = 512, N_J4 = 512, N_J4B = 128;
            {
            for (int r_ = bid; r_ < N_J4B * REP_J4B; r_ += G) { const int r = r_ % N_J4B;
                    const int j = r & 1, g32 = (r >> 1) & 15, b = r >> 5; const int colb = j == 0 ? C_KC : C_VC; const int r32 = lane & 31, hi = lane >> 5;
                    LAS unsigned char* Tl = lds;
                    LAS unsigned char* Hl = lds + 69632;
                    for (int e = tid; e < 528 * 8; e += NTHR) { const int rr = e >> 3, c8 = e & 7, t = 512 * g32 + rr; u32x4 w = {0u, 0u, 0u, 0u};
                        if (t < SEQ) { const bf16_t* pr = PB + ((size_t)b * SEQ + t) * NIN + colb;
                            if (j == 0) { const u32x4 a = *(const u32x4*)(pr + 8 * (c8 & 3)), c = *(const u32x4*)(pr + 32 + 8 * (c8 & 3)); const float2* cs = cs64 + ((size_t)b * SEQ + t) * 32 + 8 * (c8 & 3);
                                const unsigned au[4] = {a.x, a.y, a.z, a.w}, cu[4] = {c.x, c.y, c.z, c.w}; unsigned ou[4];
#pragma unroll
                                for (int q = 0; q < 4; ++q) { const float2 s0 = cs[2 * q], s1 = cs[2 * q + 1]; const float x1a = bflo(au[q]), x1b = bfhi(au[q]), x2a = bflo(cu[q]), x2b = bfhi(cu[q]);
                                    ou[q] = c8 < 4 ? pk2(x1a * s0.x - x2a * s0.y, x1b * s1.x - x2b * s1.y) : pk2(x2a * s0.x + x1a * s0.y, x2b * s1.x + x1b * s1.y); }
                                w.x = ou[0]; w.y = ou[1]; w.z = ou[2]; w.w = ou[3]; }
                            else w = *(const u32x4*)(pr + 8 * c8); }
                        *(LAS u32x4*)(Tl + rr * 128 + (rr >> 4) * 16 + c8 * 16) = w; }
                    __syncthreads();
                    { const bf16_t* w1t = (const bf16_t*)(ws + WS_W1T) + ((size_t)(l * 2 + j) * 256 + 32 * wave + r32) * 2048 + 8 * hi;
                      f32x16 acc;
#pragma unroll
                      for (int i = 0; i < 16; ++i) acc[i] = 0.f;
#pragma unroll 8
                      for (int kk = 0; kk < 128; ++kk) { const int rowt = 16 * r32 + (kk >> 2);
                          const bf16x8 a = *(const LAS bf16x8*)(Tl + rowt * 128 + (rowt >> 4) * 16 + 32 * (kk & 3) + 16 * hi);
                          const bf16x8 bw = *(const bf16x8*)(w1t + 16 * kk);
                          acc = mfma32(a, bw, acc); }
                      const float hbv = hb[(l * 2 + j) * 256 + 32 * wave + r32];
#pragma unroll
                      for (int i = 0; i < 16; ++i) { const int n = (i & 3) + 8 * (i >> 2) + 4 * hi; *(LAS bf16_t*)(Hl + n * 528 + (32 * wave + r32) * 2) = f2bf(gelu_tanh(acc[i] + hbv)); } }
                    __syncthreads();
                    if (wave < 2) { const bf16_t* w2t = (const bf16_t*)(ws + WS_W2T) + ((size_t)(l * 2 + j) * 64 + 32 * wave + r32) * 256 + 8 * hi;
                      f32x16 acc;
#pragma unroll
                      for (int i = 0; i < 16; ++i) acc[i] = 0.f;
#pragma unroll
                      for (int kk = 0; kk < 16; ++kk) { const bf16x8 a = *(const LAS bf16x8*)(Hl + r32 * 528 + 32 * kk + 16 * hi); const bf16x8 bw = *(const bf16x8*)(w2t + 16 * kk); acc = mfma32(a, bw, acc); }
                      const int dd = 32 * wave + r32;
#pragma unroll
                      for (int g = 0; g < 4; ++g) { const int n0 = 32 * g32 + 8 * g + 4 * hi; float v[4];
#pragma unroll
                          for (int q = 0; q < 4; ++q) v[q] = (n0 + q < 511) ? acc[4 * g + q] : 0.f;
                          if (j == 0) {
#pragma unroll
                              for (int q = 0; q < 4; ++q) KCMPB[((size_t)b * 512 + n0 + q) * 64 + dd] = f2bf(v[q]); }
                          else { u32x2 w; w.x = pk2(v[0], v[1]); w.y = pk2(v[2], v[3]); *(u32x2*)(VCMPT + ((size_t)b * 64 + dd) * 512 + n0) = w; } } }
                    __syncthreads();
            }
            if (bid < N_J3) {
                const int fr = lane & 15, kq = lane >> 4, hh = wave >> 1, odd = wave & 1;
                {
                    bf16x8 bq[3][6];
                    { const bf16_t* wq = (const bf16_t*)(ws + WS_WUQT) + (size_t)l * 384 * 192;
#pragma unroll
                      for (int nt = 0; nt < 3; ++nt)
#pragma unroll
                          for (int ks = 0; ks < 6; ++ks) bq[nt][ks] = *(const bf16x8*)(wq + (size_t)(48 * wave + 16 * nt + fr) * 192 + 32 * ks + 8 * kq); }
                    for (int r_ = bid; r_ < N_J3 * REP_J3; r_ += G) { const int r = r_ % N_J3;
                        const size_t row0 = (size_t)r * 64;
#pragma unroll 1
                        for (int mt = 0; mt < 4; ++mt) {
                            const bf16_t* pa = PB + (row0 + mt * 16 + fr) * NIN;
                            bf16x8 aq[6]; float ssq_ = 0.f;
#pragma unroll
                            for (int ks = 0; ks < 6; ++ks) { aq[ks] = ld8x2(pa + C_DCQ + 32 * ks + 8 * kq);
#pragma unroll
                                for (int e = 0; e < 8; ++e) { const float v = bf2f((bf16_t)aq[ks][e]); ssq_ += v * v; } }
                            ssq_ += __shfl_xor(ssq_, 16); ssq_ += __shfl_xor(ssq_, 32);
                            const float rq_ = rsqrtf(ssq_ * (1.f / 192.f) + EPS);
                            f32x4 cq[3];
#pragma unroll
                            for (int nt = 0; nt < 3; ++nt) { cq[nt] = (f32x4){0.f, 0.f, 0.f, 0.f};
#pragma unroll
                                for (int ks = 0; ks < 6; ++ks) cq[nt] = __builtin_amdgcn_mfma_f32_16x16x32_bf16(aq[ks], bq[nt][ks], cq[nt], 0, 0, 0); }
                            const float SCQ = 0.10206207261596575f * LOG2E;
#pragma unroll
                            for (int i = 0; i < 4; ++i) {
                                const size_t row = row0 + mt * 16 + 4 * kq + i; const float rqi = __shfl(rq_, 4 * kq + i) * SCQ;
                                float q0 = cq[0][i] * rqi, q1 = cq[1][i] * rqi, q2 = cq[2][i] * rqi;
                                if (odd) { const float2 cs = cs32[row * 16 + fr]; const float x1 = q1, x2 = q2; q1 = x1 * cs.x - x2 * cs.y; q2 = x2 * cs.x + x1 * cs.y; }
                                bf16_t* mq = MQ + row * 384 + hh * 96 + 48 * odd + fr; mq[0] = f2bf(q0); mq[16] = f2bf(q1); mq[32] = f2bf(q2);
                            }
                            if (wave == mt) {
#pragma unroll
                                for (int q = 0; q < 4; ++q) { const int p = lane * 4 + q, tok = p >> 4, i = p & 15; const size_t row = row0 + mt * 16 + tok; const bf16_t* pr = PB + row * NIN + C_DKR;
                                    const float x1 = bf2f(pr[i]), x2 = bf2f(pr[16 + i]); const float2 cs = cs32[row * 16 + i];
                                    MKR[row * 32 + i] = f2bf(x1 * cs.x - x2 * cs.y); MKR[row * 32 + 16 + i] = f2bf(x2 * cs.x + x1 * cs.y); } }
                        }
                    }
                }
                {
                    bf16x8 bkv[4][4];
                    { const bf16_t* wkv = (const bf16_t*)(ws + WS_WUKVT) + (size_t)l * 512 * 128;
#pragma unroll
                      for (int nt = 0; nt < 4; ++nt)
#pragma unroll
                          for (int ks = 0; ks < 4; ++ks) bkv[nt][ks] = *(const bf16x8*)(wkv + (size_t)(64 * wave + 16 * nt + fr) * 128 + 32 * ks + 8 * kq); }
                    for (int r_ = bid; r_ < N_J3 * REP_J3; r_ += G) { const int r = r_ % N_J3;
                        const size_t row0 = (size_t)r * 64; const size_t bb = row0 / SEQ, t0 = row0 % SEQ;
#pragma unroll 1
                        for (int mt = 0; mt < 4; ++mt) {
                            const bf16_t* pa = PB + (row0 + mt * 16 + fr) * NIN;
                            bf16x8 akv[4]; float sskv_ = 0.f;
#pragma unroll
                            for (int ks = 0; ks < 4; ++ks) { akv[ks] = ld8x2(pa + C_DCKV + 32 * ks + 8 * kq);
#pragma unroll
                                for (int e = 0; e < 8; ++e) { const float v = bf2f((bf16_t)akv[ks][e]); sskv_ += v * v; } }
                            sskv_ += __shfl_xor(sskv_, 16); sskv_ += __shfl_xor(sskv_, 32);
                            const float rk_ = rsqrtf(sskv_ * (1.f / 128.f) + EPS);
                            f32x4 ckv[4];
#pragma unroll
                            for (int nt = 0; nt < 4; ++nt) { ckv[nt] = (f32x4){0.f, 0.f, 0.f, 0.f};
#pragma unroll
                                for (int ks = 0; ks < 4; ++ks) ckv[nt] = __builtin_amdgcn_mfma_f32_16x16x32_bf16(akv[ks], bkv[nt][ks], ckv[nt], 0, 0, 0); }
                            float rki[4];
#pragma unroll
                            for (int i = 0; i < 4; ++i) rki[i] = __shfl(rk_, 4 * kq + i);
                            if (!odd) {
#pragma unroll
                                for (int i = 0; i < 4; ++i) { bf16_t* mk = MKN + (row0 + mt * 16 + 4 * kq + i) * 256 + hh * 64 + fr;
                                    mk[0] = f2bf(ckv[0][i] * rki[i]); mk[16] = f2bf(ckv[1][i] * rki[i]); mk[32] = f2bf(ckv[2][i] * rki[i]); mk[48] = f2bf(ckv[3][i] * rki[i]); } }
                            else {
#pragma unroll
                                for (int nt = 0; nt < 4; ++nt) { u32x2 w; w.x = pk2(ckv[nt][0] * rki[0], ckv[nt][1] * rki[1]); w.y = pk2(ckv[nt][2] * rki[2], ckv[nt][3] * rki[3]);
                                    *(u32x2*)(MVT + ((bb * 4 + hh) * 64 + 16 * nt + fr) * SEQ + t0 + mt * 16 + 4 * kq) = w; } }
                        }
                    }
                }
            }
            {
                const int r32 = lane & 31, hi = lane >> 5, gh = wave >> 1, gg = wave & 1, ch = tid & 255, half = tid >> 8;
                bf16x8 bW[2][4];
                { const bf16_t* wt = (const bf16_t*)(ws + WS_WGT) + (size_t)(((l * 2 + gg) * 4 + gh) * 64) * 64;
#pragma unroll
                  for (int nt = 0; nt < 2; ++nt)
#pragma unroll
                      for (int ks = 0; ks < 4; ++ks) bW[nt][ks] = *(const bf16x8*)(wt + (size_t)(32 * nt + r32) * 64 + 16 * ks + 8 * hi); }
                const float gbias0 = (gg == 0 ? inp(args, 7) : inp(args, 9))[l * 256 + gh * 64 + r32], gbias1 = (gg == 0 ? inp(args, 7) : inp(args, 9))[l * 256 + gh * 64 + 32 + r32];
                const float cw0 = inp(args, 4)[(l * 4 + 0) * 256 + ch], cw1 = inp(args, 4)[(l * 4 + 1) * 256 + ch], cw2 = inp(args, 4)[(l * 4 + 2) * 256 + ch], cw3 = inp(args, 4)[(l * 4 + 3) * 256 + ch], cb = inp(args, 5)[l * 256 + ch];
                const float sp = ((const float*)(ws + WS_SP))[l * 256 + ch];
                LAS float* xa = ldsf; LAS float* xc = ldsf + 35 * 256; LAS unsigned char* xcb = lds + 67 * 1024; LAS float* gR = (LAS float*)(lds + 67 * 1024 + 32 * 528); LAS float* gI = gR + 32 * 256;
            for (int r_ = bid; r_ < N_J1 * REP_J1; r_ += G) { const int r = r_ % N_J1;
                    const int b = r >> 8, tb = r & 255, t0 = tb * 32;
                    for (int c = tid; c < 35 * 32; c += NTHR) { const int rr = c >> 5, c8 = c & 31, t = t0 - 3 + rr; u32x4 w = {0u, 0u, 0u, 0u}; if (t >= 0) w = *(const u32x4*)(PB + ((size_t)b * SEQ + t) * NIN + C_AX + 8 * c8);
                        LAS f32x4* d = (LAS f32x4*)(xa + rr * 256 + 8 * c8); d[0] = (f32x4){bflo(w.x), bfhi(w.x), bflo(w.y), bfhi(w.y)}; d[1] = (f32x4){bflo(w.z), bfhi(w.z), bflo(w.w), bfhi(w.w)}; }
                    __syncthreads();
#pragma unroll 4
                    for (int tt = 0; tt < 16; ++tt) { const int rr = half * 16 + tt; const float v = cb + cw0 * xa[rr * 256 + ch] + cw1 * xa[(rr + 1) * 256 + ch] + cw2 * xa[(rr + 2) * 256 + ch] + cw3 * xa[(rr + 3) * 256 + ch];
                        xc[rr * 256 + ch] = v; *(LAS bf16_t*)(xcb + rr * 528 + ch * 2) = f2bf(v); }
                    __syncthreads();
                    { f32x16 acc[2];
#pragma unroll
                      for (int i = 0; i < 16; ++i) { acc[0][i] = 0.f; acc[1][i] = 0.f; }
#pragma unroll
                      for (int ks = 0; ks < 4; ++ks) { const bf16x8 a = *(const LAS bf16x8*)(xcb + r32 * 528 + (gh * 64 + 16 * ks + 8 * hi) * 2); acc[0] = mfma32(a, bW[0][ks], acc[0]); acc[1] = mfma32(a, bW[1][ks], acc[1]); }
                      LAS float* gd = gg == 0 ? gR : gI;
#pragma unroll
                      for (int i = 0; i < 16; ++i) { const int tok = (i & 3) + 8 * (i >> 2) + 4 * hi; gd[tok * 256 + gh * 64 + r32] = sigmoidf_(acc[0][i] + gbias0); gd[tok * 256 + gh * 64 + 32 + r32] = sigmoidf_(acc[1][i] + gbias1); } }
                    __syncthreads();
                    float hst = 0.f, Ac = 1.f;
#pragma unroll 4
                    for (int tt = 0; tt < 16; ++tt) {
                        const int rr = half * 16 + tt;
                        const float la = -8.f * gR[rr * 256 + ch] * sp, x2 = 2.f * la;
                        const float av = la > -0.25f ? 1.f + la * (1.f + la * (0.5f + la * (0.16666667f + la * (0.041666667f + la * 0.0083333333f)))) : __expf(la);
                        const float om = x2 > -0.5f ? -x2 * (1.f + x2 * (0.5f + x2 * (0.16666667f + x2 * (0.041666667f + x2 * (0.0083333333f + x2 * 0.0013888889f))))) : 1.f - __expf(x2);
                        const float u = __builtin_amdgcn_sqrtf(om) * (gI[rr * 256 + ch] * xc[rr * 256 + ch]);
                        hst = av * hst + u; Ac *= av;
                        { const size_t ao = ((size_t)b * SEQ + t0 + rr) * 256 + ch; LRA[ao] = av; LRU_[ao] = u; }
                    }
                    const size_t so = ((size_t)(b * 512 + tb * 2 + half)) * 256 + ch;
                    LA[so] = Ac; LH[so] = hst;
                    __syncthreads();
            }
            }
            {
                const int kk = tid & 127, tq = tid >> 7, r32 = lane & 31, hi = lane >> 5;
                float wg[16]; const float bg = inp(args, 16)[l * 128 + kk];
#pragma unroll
                for (int q = 0; q < 16; ++q) wg[q] = inp(args, 15)[(l * 16 + q) * 128 + kk];
                LAS float* glr = ldsf; LAS float* tot = ldsf + 1024; LAS unsigned char* KTl = lds + 8192; LAS unsigned char* VTl = lds + 8192 + 128 * VSTR;
                float* BCS = (float*)(ws + WS_BCS);
            for (int r_ = bid; r_ < N_J2 * REP_J2; r_ += G) { const int r = r_ % N_J2;
                    const int b = r >> 7, c = r & 127; const size_t row0 = (size_t)b * SEQ + 64 * c;
                    for (int e = tid; e < 1024; e += NTHR) glr[e] = bf2f(PB[(row0 + (e >> 4)) * NIN + C_GLR + (e & 15)]);
                    for (int e = tid; e < 2048; e += NTHR) { const int jj = e >> 5, hc = e & 31; const bf16_t* vsrc = PB + (row0 + jj) * NIN + C_CV + 8 * hc; const u32x2 wA = *(const u32x2*)vsrc, wB = *(const u32x2*)(vsrc + 4);
                        LAS bf16_t* d = (LAS bf16_t*)(VTl + (8 * hc) * VSTR) + jj;
                        d[0] = (bf16_t)wA.x; d[VSTR / 2] = (bf16_t)(wA.x >> 16); d[2 * (VSTR / 2)] = (bf16_t)wA.y; d[3 * (VSTR / 2)] = (bf16_t)(wA.y >> 16); d[4 * (VSTR / 2)] = (bf16_t)wB.x; d[5 * (VSTR / 2)] = (bf16_t)(wB.x >> 16); d[6 * (VSTR / 2)] = (bf16_t)wB.y; d[7 * (VSTR / 2)] = (bf16_t)(wB.y >> 16); }
                    __syncthreads();
                    float bv[16]; float run = 0.f;
#pragma unroll
                    for (int tt = 0; tt < 16; ++tt) { const LAS f32x4* g4 = (const LAS f32x4*)(glr + (16 * tq + tt) * 16); float z = bg;
#pragma unroll
                        for (int q = 0; q < 4; ++q) { const f32x4 g = g4[q]; z += g[0] * wg[4 * q] + g[1] * wg[4 * q + 1] + g[2] * wg[4 * q + 2] + g[3] * wg[4 * q + 3]; }
                        run += (fminf(z, 0.f) - __logf(1.f + __expf(-fabsf(z)))) * (1.f / 16.f); bv[tt] = run; }
                    tot[tq * 128 + kk] = run;
                    __syncthreads();
                    { const float t0_ = tot[kk], t1_ = tot[128 + kk], t2_ = tot[256 + kk], t3_ = tot[384 + kk]; const float off = tq == 0 ? 0.f : (tq == 1 ? t0_ : (tq == 2 ? t0_ + t1_ : (t0_ + t1_) + t2_)), blast = ((t0_ + t1_) + t2_) + t3_;
#pragma unroll
                      for (int tt = 0; tt < 16; ++tt) { const int t = 16 * tq + tt; const float bt = bv[tt] + off; BCS[(row0 + t) * 128 + kk] = bt;
                          *((LAS bf16_t*)(KTl + kk * VSTR) + t) = f2bf(bf2f(PB[(row0 + t) * NIN + C_CK + kk]) * __expf(blast - bt)); }
                      if (tq == 0) DEC[(size_t)(b * 128 + c) * 128 + kk] = __expf(blast); }
                    __syncthreads();
                    { const int h = wave >> 1, nt = wave & 1; f32x16 acc;
#pragma unroll
                      for (int i = 0; i < 16; ++i) acc[i] = 0.f;
                      const LAS unsigned char* ap = KTl + (h * 32 + r32) * VSTR + 16 * hi; const LAS unsigned char* bp = VTl + (h * 64 + 32 * nt + r32) * VSTR + 16 * hi;
#pragma unroll
                      for (int s = 0; s < 4; ++s) { const u32x2 a0 = *(const LAS u32x2*)(ap + 32 * s), a1 = *(const LAS u32x2*)(ap + 32 * s + 8), b0 = *(const LAS u32x2*)(bp + 32 * s), b1 = *(const LAS u32x2*)(bp + 32 * s + 8);
                          u32x4 aw, bw; aw.x = a0.x; aw.y = a0.y; aw.z = a1.x; aw.w = a1.y; bw.x = b0.x; bw.y = b0.y; bw.z = b1.x; bw.w = b1.y;
                          acc = mfma32(__builtin_bit_cast(bf16x8, aw), __builtin_bit_cast(bf16x8, bw), acc); }
                      float* o = KVC + ((size_t)(b * 128 + c) * 4 + h) * 2048 + 32 * nt + r32;
#pragma unroll
                      for (int i = 0; i < 16; ++i) o[((i & 3) + 8 * (i >> 2) + 4 * hi) * 64] = acc[i]; }
                    __syncthreads();
            }
            }
            for (int r = bid; r < N_J4; r += G) {
                    const size_t row0 = (size_t)r * 64;
#pragma unroll
                    for (int it3 = 0; it3 < 3; ++it3) {
                        const int e = tid + it3 * NTHR, tok = e / 24, p = e % 24, hd = p >> 2, c8 = p & 3; const int base = hd < 4 ? C_BQ + hd * 64 : (hd == 4 ? C_KS : C_KW); const float sc = hd < 4 ? 0.125f * LOG2E : 1.f;
                        bf16_t* pr = PB + (row0 + tok) * NIN + base + 8 * c8; const u32x4 a = *(const u32x4*)pr, c = *(const u32x4*)(pr + 32); const float2* cs = cs64 + (row0 + tok) * 32 + 8 * c8;
                        const unsigned au[4] = {a.x, a.y, a.z, a.w}, cu[4] = {c.x, c.y, c.z, c.w}; unsigned o1[4], o2[4];
#pragma unroll
                        for (int q = 0; q < 4; ++q) { const float2 s0 = cs[2 * q], s1 = cs[2 * q + 1]; const float x1a = bflo(au[q]), x1b = bfhi(au[q]), x2a = bflo(cu[q]), x2b = bfhi(cu[q]);
                            o1[q] = pk2((x1a * s0.x - x2a * s0.y) * sc, (x1b * s1.x - x2b * s1.y) * sc); o2[q] = pk2((x2a * s0.x + x1a * s0.y) * sc, (x2b * s1.x + x1b * s1.y) * sc); }
                        u32x4 w1, w2; w1.x = o1[0]; w1.y = o1[1]; w1.z = o1[2]; w1.w = o1[3]; w2.x = o2[0]; w2.y = o2[1]; w2.z = o2[2]; w2.w = o2[3];
                        *(u32x4*)pr = w1; *(u32x4*)(pr + 32) = w2;
                        if (hd == 4) {
                            bf16_t* kf_ = KSF + (row0 / 64) * 4096 + (size_t)((((tok >> 5) * 4 + (c8 >> 1)) * 64 + (c8 & 1) * 32 + (tok & 31)) * 8); *(u32x4*)kf_ = w1; *(u32x4*)(kf_ + 2 * 64 * 8) = w2; } }
                    { LAS bf16_t* tl = (LAS bf16_t*)lds; const size_t bb = row0 / SEQ, t0 = row0 % SEQ;
                      for (int mtx = 0; mtx < 2; ++mtx) { const int tok = tid >> 3, c = tid & 7; const u32x4 w = *(const u32x4*)(PB + (row0 + tok) * NIN + (mtx ? C_VW : C_VS) + c * 8);
                          LAS bf16_t* dst = tl + mtx * 64 * 72 + tok * 72 + c * 8; dst[0] = (bf16_t)w.x; dst[1] = (bf16_t)(w.x >> 16); dst[2] = (bf16_t)w.y; dst[3] = (bf16_t)(w.y >> 16); dst[4] = (bf16_t)w.z; dst[5] = (bf16_t)(w.z >> 16); dst[6] = (bf16_t)w.w; dst[7] = (bf16_t)(w.w >> 16); }
                      __syncthreads();
                      for (int mtx = 0; mtx < 2; ++mtx) { const int d = tid >> 3, c8 = tid & 7; const LAS bf16_t* s = tl + mtx * 64 * 72 + (c8 * 8) * 72 + d;
                          u32x4 w; w.x = (unsigned)s[0] | ((unsigned)s[72] << 16); w.y = (unsigned)s[2 * 72] | ((unsigned)s[3 * 72] << 16); w.z = (unsigned)s[4 * 72] | ((unsigned)s[5 * 72] << 16); w.w = (unsigned)s[6 * 72] | ((unsigned)s[7 * 72] << 16);
                          if (mtx) *(u32x4*)(VWT + (bb * 64 + d) * SEQ + t0 + c8 * 8) = w;
                          else { const int s_ = c8 >> 1, h_ = c8 & 1; const LAS bf16_t* q = tl + (16 * s_ + 4 * h_) * 72 + d;
                              u32x4 f; f.x = (unsigned)q[0] | ((unsigned)q[72] << 16); f.y = (unsigned)q[2 * 72] | ((unsigned)q[3 * 72] << 16); f.z = (unsigned)q[8 * 72] | ((unsigned)q[9 * 72] << 16); f.w = (unsigned)q[10 * 72] | ((unsigned)q[11 * 72] << 16);
                              *(u32x4*)(VST + (row0 / 64) * 4096 + (size_t)((((d >> 5) * 4 + s_) * 64 + h_ * 32 + (d & 31)) * 8)) = f; } }
                      __syncthreads(); }
            }
            }
        }
        SEAM(pb + 1);
        if (IN(pb + 2)) {
        const int l_ = l; WS_PTRS();
        LAUNDER_TID();
            constexpr int Q_J5 = 2, Q_J6 = 64, Q_ATT = 1024 * REP_ATT, Q_J9 = 1024, Q_J10 = 512, Q_TOT = Q_J5 + Q_J6 + Q_ATT + Q_J9 + Q_J10;
            if (tid == 0) { LCTL[4] = 0u; LCTL[5] = 0u; }
            __syncthreads();
            const int tid_o = tid;
            for (;;) {
                int tid = tid_o; asm volatile("" : "+v"(tid)); const int lane = tid & 63;
                if (tid == 0) LCTL[2] = __hip_atomic_fetch_add(ctl + CW_QUEUE + 64 * l, 1u, __ATOMIC_RELAXED, __HIP_MEMORY_SCOPE_AGENT);
                __syncthreads();
                int r = __builtin_amdgcn_readfirstlane((int)LCTL[2]); const unsigned seen5 = LCTL[4], seen6 = LCTL[5];
                __syncthreads();
                if (r >= Q_TOT * REP_P3) break;
                if (REP_P3 > 1 && r >= Q_TOT) r -= Q_TOT;
                if (r < Q_J5) {
                    const int e = r * NTHR + tid, b = e >> 8, ch = e & 255; float carry = 0.f;
                    for (int c0 = 0; c0 < 512; c0 += 8) { float av[8], hv[8];
#pragma unroll
                        for (int q = 0; q < 8; ++q) { const size_t so = ((size_t)(b * 512 + c0 + q)) * 256 + ch; av[q] = LA[so]; hv[q] = LH[so]; }
#pragma unroll
                        for (int q = 0; q < 8; ++q) { CIN[((size_t)(b * 512 + c0 + q)) * 256 + ch] = carry; carry = av[q] * carry + hv[q]; } }
                    asm volatile("s_waitcnt vmcnt(0)" ::: "memory"); __syncthreads();
                    if (tid == 0) { __builtin_amdgcn_fence(__ATOMIC_RELEASE, "agent"); asm volatile("s_waitcnt vmcnt(0)" ::: "memory"); (void)xb_add(ctl + CW_FLAG + 64 * (2 * l + 0), 1u); }
                    continue;
                }
                r -= Q_J5;
                if (r < Q_J6) {
                    const int e = r * NTHR + tid, b = e >> 13, rem = e & 8191; float Sv = 0.f;
                    for (int c0 = 0; c0 < 128; c0 += 8) { float kv[8], dv[8];
#pragma unroll
                        for (int q = 0; q < 8; ++q) { kv[q] = KVC[(size_t)(b * 128 + c0 + q) * 8192 + rem]; dv[q] = DEC[(size_t)(b * 128 + c0 + q) * 128 + (rem >> 6)]; }
#pragma unroll
                        for (int q = 0; q < 8; ++q) { SST[(size_t)(b * 128 + c0 + q) * 8192 + rem] = Sv; Sv = dv[q] * Sv + kv[q]; } }
                    asm volatile("s_waitcnt vmcnt(0)" ::: "memory"); __syncthreads();
                    if (tid == 0) { __builtin_amdgcn_fence(__ATOMIC_RELEASE, "agent"); asm volatile("s_waitcnt vmcnt(0)" ::: "memory"); (void)xb_add(ctl + CW_FLAG + 64 * (2 * l + 1), 1u); }
                    continue;
                }
                r -= Q_J6;
                if (r >= Q_ATT) {
                    r -= Q_ATT; const bool is9 = r < Q_J9;
                    if (!(is9 ? seen5 : seen6)) {
                        if (tid == 0) { unsigned* f = ctl + CW_FLAG + 64 * (2 * l + (is9 ? 0 : 1)); const unsigned target = is9 ? (unsigned)Q_J5 : (unsigned)Q_J6;
                            XB_SPIN(xb_ld(f) < target, ctl + CW_BAR); __builtin_amdgcn_fence(__ATOMIC_ACQUIRE, "agent"); asm volatile("s_waitcnt vmcnt(0)" ::: "memory"); LCTL[is9 ? 4 : 5] = 1u; }
                        __syncthreads(); }
                    if (is9) {
                    const int b = r >> 8, tb = r & 255, t0 = tb * 32, ch = tid & 255, half = tid >> 8;
                    LAS float* xa = ldsf;
                    float hst = CIN[((size_t)(b * 512 + tb * 2 + half)) * 256 + ch];
                    { float av[16], uv[16], gv[16];
#pragma unroll
                      for (int tt = 0; tt < 16; ++tt) { const size_t ro = (size_t)b * SEQ + t0 + half * 16 + tt; av[tt] = LRA[ro * 256 + ch]; uv[tt] = LRU_[ro * 256 + ch]; gv[tt] = bf2f(PB[ro * NIN + C_AG + ch]); }
#pragma unroll
                      for (int tt = 0; tt < 16; ++tt) { hst = av[tt] * hst + uv[tt]; xa[(half * 16 + tt) * 256 + ch] = hst * gelu_tanh(gv[tt]); } }
                    __syncthreads();
                    for (int q = 0; q < 4; ++q) { const int rr = wave * 4 + q; const f32x4 v = ((const LAS f32x4*)(xa + rr * 256))[lane];
                        const float rinv = rsqrtf(wave_sum(v[0] * v[0] + v[1] * v[1] + v[2] * v[2] + v[3] * v[3]) * (1.f / 256.f) + EPS);
                        u32x2 w; w.x = pk2(v[0] * rinv, v[1] * rinv); w.y = pk2(v[2] * rinv, v[3] * rinv);
                        *(u32x2*)(Y + ((size_t)b * SEQ + t0 + rr) * DM + 256 + 4 * lane) = w; }
                    __syncthreads();
                    } else { r -= Q_J9;
                    const int b = r >> 7, c = r & 127; const size_t row0 = (size_t)b * SEQ + 64 * c;
                    LAS float* bL = ldsf; LAS float* glr = ldsf + 8192; LAS unsigned char* VTl = lds + 36864; LAS unsigned char* STl = lds + 71680; LAS float* SSX = (LAS float*)(lds + 92160);
                    for (int e = tid; e < 2048; e += NTHR) ((LAS f32x4*)bL)[e] = ((const f32x4*)((const float*)(ws + WS_BCS) + row0 * 128))[e];
                    for (int e = tid; e < 2048; e += NTHR) { const int jj = e >> 5, hc = e & 31, h = hc >> 3, c8 = hc & 7; const bf16_t* vsrc = PB + (row0 + jj) * NIN + C_CV + h * 64 + 8 * c8; const u32x2 wA = *(const u32x2*)vsrc, wB = *(const u32x2*)(vsrc + 4); u32x4 w; w.x = wA.x; w.y = wA.y; w.z = wB.x; w.w = wB.y;
                        LAS bf16_t* d = (LAS bf16_t*)(VTl + h * 8704 + (8 * c8) * VSTR) + jj;
                        d[0] = (bf16_t)w.x; d[VSTR / 2] = (bf16_t)(w.x >> 16); d[2 * (VSTR / 2)] = (bf16_t)w.y; d[3 * (VSTR / 2)] = (bf16_t)(w.y >> 16); d[4 * (VSTR / 2)] = (bf16_t)w.z; d[5 * (VSTR / 2)] = (bf16_t)(w.z >> 16); d[6 * (VSTR / 2)] = (bf16_t)w.w; d[7 * (VSTR / 2)] = (bf16_t)(w.w >> 16); }
                    for (int e = tid; e < 8192; e += NTHR) { const int h = e >> 11, k = (e >> 6) & 31, v = e & 63; *(LAS bf16_t*)(STl + h * 5120 + v * 80 + k * 2) = f2bf(SST[(size_t)(b * 128 + c) * 8192 + e]); }
                    __syncthreads();
                    { const int r32 = lane & 31, hi = lane >> 5, h = wave >> 1, ih = wave & 1, i = 32 * ih + r32; const float SCG = 0.17677669529663687f;
                      bf16x8 qrel[2], qabs[2], kt[2][2];
#pragma unroll
                      for (int ks = 0; ks < 2; ++ks) { const int k0 = h * 32 + 16 * ks + 8 * hi; const bf16x8 qv = ld8x2(PB + (row0 + i) * NIN + C_CQ + k0); u32x4 wr_, wa_; unsigned* pr_ = (unsigned*)&wr_; unsigned* pa_ = (unsigned*)&wa_;
#pragma unroll
                          for (int e2 = 0; e2 < 4; ++e2) { const float b0 = bL[i * 128 + k0 + 2 * e2], b1 = bL[i * 128 + k0 + 2 * e2 + 1], f0 = bL[31 * 128 + k0 + 2 * e2], f1 = bL[31 * 128 + k0 + 2 * e2 + 1];
                              const float q0 = bf2f((bf16_t)qv[2 * e2]) * SCG, q1 = bf2f((bf16_t)qv[2 * e2 + 1]) * SCG;
                              pr_[e2] = cvtpk(q0 * __expf(b0 - f0), q1 * __expf(b1 - f1)); pa_[e2] = cvtpk(q0 * __expf(b0), q1 * __expf(b1)); }
                          qrel[ks] = __builtin_bit_cast(bf16x8, wr_); qabs[ks] = __builtin_bit_cast(bf16x8, wa_); }
#pragma unroll
                      for (int jt = 0; jt < 2; ++jt)
#pragma unroll
                          for (int ks = 0; ks < 2; ++ks) { const int jr = 32 * jt + r32, k0 = h * 32 + 16 * ks + 8 * hi; const bf16x8 kv = ld8x2(PB + (row0 + jr) * NIN + C_CK + k0); u32x4 wk_; unsigned* pk_ = (unsigned*)&wk_;
#pragma unroll
                              for (int e2 = 0; e2 < 4; ++e2) { const float b0 = bL[jr * 128 + k0 + 2 * e2], b1 = bL[jr * 128 + k0 + 2 * e2 + 1], f0 = bL[31 * 128 + k0 + 2 * e2], f1 = bL[31 * 128 + k0 + 2 * e2 + 1];
                                  pk_[e2] = cvtpk(bf2f((bf16_t)kv[2 * e2]) * __expf(f0 - b0), bf2f((bf16_t)kv[2 * e2 + 1]) * __expf(f1 - b1)); }
                              kt[jt][ks] = __builtin_bit_cast(bf16x8, wk_); }
                      f32x16 o[2], s[2];
#pragma unroll
                      for (int q = 0; q < 16; ++q) { o[0][q] = 0.f; o[1][q] = 0.f; s[0][q] = 0.f; s[1][q] = 0.f; }
#pragma unroll
                      for (int ks = 0; ks < 2; ++ks) s[0] = mfma32(kt[0][ks], qrel[ks], s[0]);
                      if (ih) {
#pragma unroll
                          for (int ks = 0; ks < 2; ++ks) s[1] = mfma32(kt[1][ks], qrel[ks], s[1]); }
#pragma unroll
                      for (int q = 0; q < 16; ++q) { const int jr = (q & 3) + 8 * (q >> 2) + 4 * hi; if (jr > r32) { if (ih) s[1][q] = 0.f; else s[0][q] = 0.f; } }
                      const LAS unsigned char* VTh = VTl + h * 8704; const LAS unsigned char* STh = STl + h * 5120;
#pragma unroll
                      for (int dt = 0; dt < 2; ++dt) { const LAS unsigned char* vp = VTh + (32 * dt + r32) * VSTR + 8 * hi;
                          o[dt] = mfma32(vfrag(vp), pack8<0>(s[0]), o[dt]); o[dt] = mfma32(vfrag(vp + 32), pack8<8>(s[0]), o[dt]);
                          if (ih) { o[dt] = mfma32(vfrag(vp + 64), pack8<0>(s[1]), o[dt]); o[dt] = mfma32(vfrag(vp + 96), pack8<8>(s[1]), o[dt]); }
#pragma unroll
                          for (int ks = 0; ks < 2; ++ks) o[dt] = mfma32(*(const LAS bf16x8*)(STh + (32 * dt + r32) * 80 + 32 * ks + 16 * hi), qabs[ks], o[dt]); }
                      float ssh = 0.f;
#pragma unroll
                      for (int q = 0; q < 16; ++q) ssh += o[0][q] * o[0][q] + o[1][q] * o[1][q];
                      const float rh = rsqrtf(xhalf_sum(ssh) * (1.f / 64.f) + EPS); float ssg = 0.f;
#pragma unroll
                      for (int dt = 0; dt < 2; ++dt)
#pragma unroll
                          for (int g = 0; g < 4; ++g) { const int v0 = 32 * dt + 8 * g + 4 * hi; const u32x2 ogw = *(const u32x2*)(PB + (row0 + i) * NIN + C_OG + h * 64 + v0); const f32x4 gn = *(const f32x4*)(inp(args, 17) + l * 64 + v0);
                              const float og4[4] = {bflo(ogw.x), bfhi(ogw.x), bflo(ogw.y), bfhi(ogw.y)};
#pragma unroll
                              for (int q = 0; q < 4; ++q) { const float y = o[dt][4 * g + q] * rh * gn[q] * (og4[q] * sigmoidf_(og4[q])); o[dt][4 * g + q] = y; ssg += y * y; } }
                      ssg = xhalf_sum(ssg); if (hi == 0) SSX[i * 4 + h] = ssg;
                      __syncthreads();
                      const f32x4 s4 = *(const LAS f32x4*)(SSX + i * 4); const float rinv = rsqrtf((s4[0] + s4[1] + s4[2] + s4[3]) * (1.f / 256.f) + EPS);
#pragma unroll
                      for (int dt = 0; dt < 2; ++dt)
#pragma unroll
                          for (int g = 0; g < 4; ++g) { u32x2 w; w.x = cvtpk(o[dt][4 * g] * rinv, o[dt][4 * g + 1] * rinv); w.y = cvtpk(o[dt][4 * g + 2] * rinv, o[dt][4 * g + 3] * rinv);
                              *(u32x2*)(Y + (row0 + i) * DM + 768 + h * 64 + 32 * dt + 8 * g + 4 * hi) = w; } }
                    __syncthreads();
                    }
                    continue;
                }
                const int r32 = lane & 31, hi = lane >> 5;
                const int rep = r >> 10; r &= 1023;
                const int grp = r >> 5, within = r & 31;
                if (rep && ((REP_ONLY == 1 && within >= 16) || (REP_ONLY == 2 && within < 16))) continue;
              {
                if (within >= 16) {
                    const int idx = within - 16, b = idx & 3, tb = 127 - (4 * grp + (idx >> 2));
                    const int tl = 8 * wave + (r32 >> 2), head = r32 & 3, T = 64 * tb + tl; const size_t row = (size_t)b * SEQ + T; const bf16_t* prow = PB + row * NIN;
                    bf16x8 qf[4];
#pragma unroll
                    for (int ks = 0; ks < 4; ++ks) qf[ks] = *(const bf16x8*)(prow + C_BQ + head * 64 + 16 * ks + 8 * hi);
                    LAS float* impb = (LAS float*)(lds + AL_IMP) + wave * 1024; LAS unsigned* selm = (LAS unsigned*)(lds + AL_SELM) + wave * 32;
                    const int skey = tid >> 3, sch = tid & 7;
                    const unsigned koffP = (unsigned)(skey * NIN + sch * 8), voffS = (unsigned)(skey * SEQ + sch * 8), koffC = (unsigned)(skey * 64 + sch * 8), voffC = (unsigned)(skey * 512 + sch * 8);
                    auto stK = [&](int buf, const StageRegs& R) __attribute__((always_inline)) { *(LAS u32x4*)(lds + (buf ? AL_K1 : AL_K0) + skey * KSTR + sch * 16) = R.a; };
                    auto stKV = [&](int buf, const StageRegs& R) __attribute__((always_inline)) { *(LAS u32x4*)(lds + (buf ? AL_K1 : AL_K0) + skey * KSTR + sch * 16) = R.a;
                        LAS unsigned char* vd = lds + (buf ? AL_V1 : AL_V0) + skey * VSTR + sch * 16; u32x2 a, c; a.x = R.b.x; a.y = R.b.y; c.x = R.b.z; c.y = R.b.w; *(LAS u32x2*)vd = a; *(LAS u32x2*)(vd + 8) = c; };
                    f32x16 oacc[2], ob[2];
                    const int nv = T >= 31 ? ((T - 31) >> 4) + 1 : 0, ntc = (4 * tb + 3 + 63) >> 6;
                    float mC = NEGB, lC = 0.f;
                    { const bf16_t* kb_ = KCMPB + (size_t)b * 512 * 64;
                      attn_pipeline(0, ntc - 1, [&](int j, StageRegs& R) __attribute__((always_inline)) { R.a = *(const u32x4*)((kb_ + (size_t)j * 64 * 64) + koffC); }, stK,
                        [&](int j, int cb) __attribute__((always_inline)) { f32x16 s0, s1; qk_tile<4>(lds + (cb ? AL_K1 : AL_K0), qf, r32, hi, s0, s1); mask_tile(s0, s1, 0, nv - 1 - 64 * j, hi);
                            const float mx = tile_max(s0, s1), mn = fmaxf(mC, mx), ms = mn < -1e29f ? 0.f : mn, alpha = ex2(mC - ms); mC = mn; float ps = 0.f;
#pragma unroll
                            for (int i = 0; i < 16; ++i) ps += ex2(s0[i] - ms) + ex2(s1[i] - ms);
                            lC = lC * alpha + ps; }); }
                    { const float invC = 1.f / fmaxf(xhalf_sum(lC), 1e-30f), msC = mC < -1e29f ? 0.f : mC; float carry = 0.f;
#pragma unroll
                      for (int i = 0; i < 16; ++i) { ob[0][i] = 0.f; ob[1][i] = 0.f; }
                      const bf16_t* kb_ = KCMPB + (size_t)b * 512 * 64; const bf16_t* vb_ = VCMPT + (size_t)b * 64 * 512;
                      attn_pipeline(0, ntc - 1, [&](int j, StageRegs& R) __attribute__((always_inline)) { R.a = *(const u32x4*)((kb_ + (size_t)j * 64 * 64) + koffC); R.b = *(const u32x4*)((vb_ + j * 64) + voffC); }, stKV,
                        [&](int j, int cb) __attribute__((always_inline)) { f32x16 s0, s1; qk_tile<4>(lds + (cb ? AL_K1 : AL_K0), qf, r32, hi, s0, s1); mask_tile(s0, s1, 0, nv - 1 - 64 * j, hi);
#pragma unroll
                            for (int i = 0; i < 16; ++i) { s0[i] = ex2(s0[i] - msC) * invC; s1[i] = ex2(s1[i] - msC) * invC; }
                            float gs[8], pl[8];
#pragma unroll
                            for (int q = 0; q < 4; ++q) { gs[q] = (s0[4 * q] + s0[4 * q + 1]) + (s0[4 * q + 2] + s0[4 * q + 3]); gs[4 + q] = (s1[4 * q] + s1[4 * q + 1]) + (s1[4 * q + 2] + s1[4 * q + 3]);
                                pl[q] = __shfl_xor(s0[4 * q + 3], 32); pl[4 + q] = __shfl_xor(s1[4 * q + 3], 32); }
#pragma unroll
                            for (int q = 0; q < 8; ++q) { const float prev = hi ? pl[q] : (q > 0 ? pl[q > 0 ? q - 1 : 0] : carry); float x = gs[q] + prev; x += __shfl_xor(x, 1); x += __shfl_xor(x, 2);
                                if ((r32 & 3) == 0) impb[(r32 >> 2) * 128 + 16 * j + 2 * q + hi] = x; }
                            carry = pl[7];
                            pv_tile(s0, s1, lds + (cb ? AL_V1 : AL_V0), ob, r32, hi); }); }
                    LAS float* oav = (LAS float*)(lds + AL_OACC) + tid; const float g0 = sigmoidf_(bf2f(prow[C_BG + head * 3]));
#pragma unroll
                    for (int i = 0; i < 16; ++i) { oav[i * 512] = g0 * ob[0][i]; oav[(16 + i) * 512] = g0 * ob[1][i]; }
                    WSYNC();
                    for (int tk = 0; tk < 8; ++tk) {
                        const int cur = tb, j0 = lane, j1 = lane + 64; const float im0 = impb[tk * 128 + j0], im1 = impb[tk * 128 + j1];
                        const unsigned k0 = ((j0 == 0 || j0 == cur || j0 == cur - 1) ? 0xFF000000u : (j0 <= cur ? (__float_as_uint(im0) & ~127u) : 0u)) | (unsigned)(127 - j0);
                        const unsigned k1 = ((j1 == cur || j1 == cur - 1) ? 0xFF000000u : (j1 <= cur ? (__float_as_uint(im1) & ~127u) : 0u)) | (unsigned)(127 - j1);
                        unsigned T = 0u;
#pragma unroll 4
                        for (int bb = 31; bb >= 0; --bb) { const unsigned cand = T | (1u << bb); const int cnt = __popcll(__ballot(k0 >= cand)) + __popcll(__ballot(k1 >= cand)); if (cnt >= 16) T = cand; }
                        const unsigned long long m0 = __ballot(k0 >= T), m1 = __ballot(k1 >= T);
                        if (lane == 0) { selm[tk * 4] = (unsigned)m0; selm[tk * 4 + 1] = (unsigned)(m0 >> 32); selm[tk * 4 + 2] = (unsigned)m1; selm[tk * 4 + 3] = (unsigned)(m1 >> 32); }
                    }
                    WSYNC();
                    const unsigned sm0 = selm[(r32 >> 2) * 4], sm1 = selm[(r32 >> 2) * 4 + 1], sm2 = selm[(r32 >> 2) * 4 + 2], sm3 = selm[(r32 >> 2) * 4 + 3];
                    { SoftState SB; soft_init(SB, ob);
                      unsigned u0 = sm0, u1 = sm1, u2 = sm2, u3 = sm3;
#pragma unroll
                      for (int o_ = 1; o_ < 64; o_ <<= 1) { u0 |= (unsigned)__shfl_xor((int)u0, o_); u1 |= (unsigned)__shfl_xor((int)u1, o_); u2 |= (unsigned)__shfl_xor((int)u2, o_); u3 |= (unsigned)__shfl_xor((int)u3, o_); }
                      unsigned long long Ulo = ((unsigned long long)(unsigned)__builtin_amdgcn_readfirstlane((int)u1) << 32) | (unsigned)__builtin_amdgcn_readfirstlane((int)u0), Uhi = ((unsigned long long)(unsigned)__builtin_amdgcn_readfirstlane((int)u3) << 32) | (unsigned)__builtin_amdgcn_readfirstlane((int)u2);
                      if (tb < 64) { if (tb < 63) Ulo &= (2ull << tb) - 1ull; Uhi = 0ull; } else if (tb < 127) Uhi &= (2ull << (tb - 64)) - 1ull;
                      const bf16_t* ksf = KSF + (size_t)b * 128 * 4096; const bf16_t* vsf = VST + (size_t)b * 128 * 4096; const unsigned lo8 = (unsigned)lane * 8u;
                      bf16x8 kf[2][4], vf[2][4];
                      int j = 0; Ulo &= ~1ull;
#pragma unroll
                      for (int f = 0; f < 8; ++f) kf[f >> 2][f & 3] = *(const bf16x8*)((ksf + f * 512) + lo8);
                      bool first = true;
                      for (;;) {
#pragma unroll
                          for (int f = 0; f < 8; ++f) vf[f >> 2][f & 3] = *(const bf16x8*)((vsf + (size_t)j * 4096 + f * 512) + lo8);
                          const f32x16 cinit = bcast16(-SB.m); f32x16 s0 = cinit, s1 = cinit;
#pragma unroll
                          for (int ks = 0; ks < 4; ++ks) { s0 = mfma32(kf[0][ks], qf[ks], s0); s1 = mfma32(kf[1][ks], qf[ks], s1); }
                          __builtin_amdgcn_sched_barrier(0);
                          const int jn = Ulo ? (int)__builtin_ctzll(Ulo) : (Uhi ? 64 + (int)__builtin_ctzll(Uhi) : -1);
                          if (Ulo) Ulo &= Ulo - 1ull; else Uhi &= Uhi - 1ull;
                          if (jn >= 0) {
#pragma unroll
                              for (int f = 0; f < 8; ++f) kf[f >> 2][f & 3] = *(const bf16x8*)((ksf + (size_t)jn * 4096 + f * 512) + lo8); }
                          const unsigned wsel = j < 32 ? sm0 : (j < 64 ? sm1 : (j < 96 ? sm2 : sm3)); const bool bit = (wsel >> (j & 31)) & 1u;
                          soft_update(s0, s1, SB, ob, j == tb || !__all(bit), bit ? 0 : 64, j == tb ? tl : 63, first, hi);
                          { const bf16x8 p00 = pack8<0>(s0), p01 = pack8<8>(s0), p10 = pack8<0>(s1), p11 = pack8<8>(s1);
#pragma unroll
                            for (int dt = 0; dt < 2; ++dt) { ob[dt] = mfma32(vf[dt][0], p00, ob[dt]); ob[dt] = mfma32(vf[dt][1], p01, ob[dt]); ob[dt] = mfma32(vf[dt][2], p10, ob[dt]); ob[dt] = mfma32(vf[dt][3], p11, ob[dt]); } }
                          if (jn < 0) break;
                          j = jn; first = false;
                      }
                      const float sc = sigmoidf_(bf2f(prow[C_BG + head * 3 + 1])) / fmaxf(xhalf_sum(SB.l), 1e-30f);
#pragma unroll
                      for (int i = 0; i < 16; ++i) { oav[i * 512] += sc * ob[0][i]; oav[(16 + i) * 512] += sc * ob[1][i]; } }
                    __syncthreads();
                    { SoftState SB; soft_init(SB, ob); const int jb0 = tb >= 8 ? tb - 8 : 0;
                      const bf16_t* kb_ = PB + (size_t)b * SEQ * NIN + C_KW; const bf16_t* vb_ = VWT + (size_t)b * 64 * SEQ;
                      attn_pipeline(tb >= 8 ? tb - 8 : 0, tb, [&](int j, StageRegs& R) __attribute__((always_inline)) { R.a = *(const u32x4*)((kb_ + (size_t)j * 64 * NIN) + koffP); R.b = *(const u32x4*)((vb_ + j * 64) + voffS); }, stKV,
                        [&](int j, int cb) __attribute__((always_inline)) { attn_step<4>(lds + (cb ? AL_K1 : AL_K0), lds + (cb ? AL_V1 : AL_V0), qf, SB, ob, j == tb || j == tb - 8, j == tb - 8 ? tl + 1 : 0, j == tb ? tl : 63, j == jb0, r32, hi); });
                      const float sc = sigmoidf_(bf2f(prow[C_BG + head * 3 + 2])) / fmaxf(xhalf_sum(SB.l), 1e-30f);
#pragma unroll
                      for (int i = 0; i < 16; ++i) { oacc[0][i] = oav[i * 512] + sc * ob[0][i]; oacc[1][i] = oav[(16 + i) * 512] + sc * ob[1][i]; } }
                    { float ss = 0.f;
#pragma unroll
                      for (int i = 0; i < 16; ++i) ss += oacc[0][i] * oacc[0][i] + oacc[1][i] * oacc[1][i];
                      ss = xhalf_sum(ss); ss += __shfl_xor(ss, 1); ss += __shfl_xor(ss, 2);
                      const float rinv = rsqrtf(ss * (1.f / 256.f) + EPS);
#pragma unroll
                      for (int dt = 0; dt < 2; ++dt)
#pragma unroll
                          for (int g = 0; g < 4; ++g) { u32x2 w; w.x = cvtpk(oacc[dt][4 * g] * rinv, oacc[dt][4 * g + 1] * rinv); w.y = cvtpk(oacc[dt][4 * g + 2] * rinv, oacc[dt][4 * g + 3] * rinv);
                              *(u32x2*)(Y + row * DM + 512 + head * 64 + 32 * dt + 8 * g + 4 * hi) = w; } }
                    __syncthreads();
                    continue;
                }
                {
                    const int qb = 31 - grp, b = within >> 2, h = within & 3;
                    const int T = 256 * qb + 32 * wave + r32; const size_t row = (size_t)b * SEQ + T;
                    bf16x8 qf[6];
#pragma unroll
                    for (int ks = 0; ks < 6; ++ks) qf[ks] = *(const bf16x8*)(MQ + row * 384 + h * 96 + 16 * ks + 8 * hi);
                    f32x16 o[2]; SoftState SM; soft_init(SM, o);
                    const int jd = 4 * qb + (wave >> 1);
                    const bf16_t* kn = MKN + (size_t)b * SEQ * 256 + h * 64; const bf16_t* kr = MKR + (size_t)b * SEQ * 32; const bf16_t* vt = MVT + (size_t)(b * 4 + h) * 64 * SEQ;
                    constexpr int VS2 = 264, AM_K0 = 0, AM_K1 = 128 * KSTR, AM_V0 = 2 * 128 * KSTR, AM_V1 = AM_V0 + 64 * VS2;
                    const int nk = tid >> 3, nc = tid & 7, rkey = tid >> 2, rch = tid & 3, vr = tid >> 4, vc = tid & 15;
                    const unsigned ko0 = (unsigned)(nk * 256 + nc * 8), ko1 = (unsigned)(rkey * 32 + rch * 8), vo_ = (unsigned)(vr * SEQ + vc * 8);
                    attn_pipeline(0, 2 * qb + 1,
                        [&](int jj, StageRegs& R) __attribute__((always_inline)) { const bf16_t* knj = kn + (size_t)jj * 128 * 256; const bf16_t* vtj = vt + jj * 128;
                            R.a = *(const u32x4*)(knj + ko0); R.b = *(const u32x4*)((knj + 64 * 256) + ko0); R.c = *(const u32x4*)((kr + (size_t)jj * 128 * 32) + ko1);
                            R.d = *(const u32x4*)(vtj + vo_); R.e = *(const u32x4*)((vtj + 32 * SEQ) + vo_); },
                        [&](int buf, const StageRegs& R) __attribute__((always_inline)) { LAS unsigned char* kb_ = lds + (buf ? AM_K1 : AM_K0); LAS unsigned char* vb_ = lds + (buf ? AM_V1 : AM_V0) + vr * VS2 + vc * 16;
                            *(LAS u32x4*)(kb_ + nk * KSTR + nc * 16) = R.a; *(LAS u32x4*)(kb_ + (64 + nk) * KSTR + nc * 16) = R.b; *(LAS u32x4*)(kb_ + rkey * KSTR + 128 + rch * 16) = R.c;
                            u32x2 p, q; p.x = R.d.x; p.y = R.d.y; q.x = R.d.z; q.y = R.d.w; *(LAS u32x2*)vb_ = p; *(LAS u32x2*)(vb_ + 8) = q;
                            p.x = R.e.x; p.y = R.e.y; q.x = R.e.z; q.y = R.e.w; *(LAS u32x2*)(vb_ + 32 * VS2) = p; *(LAS u32x2*)(vb_ + 32 * VS2 + 8) = q; },
                        [&](int jj, int cb) __attribute__((always_inline)) {
                            const int j0 = 2 * jj, kd = 32 * (wave & 1) + r32;
                            if (j0 + 1 <= jd) attn_step2<6, VS2>(lds + (cb ? AM_K1 : AM_K0), lds + (cb ? AM_V1 : AM_V0), qf, SM, o, false, 63, j0 + 1 == jd, j0 + 1 == jd ? kd : 63, j0 == 0, r32, hi);
                            else if (j0 <= jd) attn_step<6, VS2>(lds + (cb ? AM_K1 : AM_K0), lds + (cb ? AM_V1 : AM_V0), qf, SM, o, j0 == jd, 0, kd, j0 == 0, r32, hi); });
                    { const float inv = 1.f / fmaxf(xhalf_sum(SM.l), 1e-30f); float ss = 0.f;
#pragma unroll
                      for (int dt = 0; dt < 2; ++dt)
#pragma unroll
                          for (int g = 0; g < 4; ++g) { const float v0 = o[dt][4 * g] * inv, v1 = o[dt][4 * g + 1] * inv, v2 = o[dt][4 * g + 2] * inv, v3 = o[dt][4 * g + 3] * inv; ss += v0 * v0 + v1 * v1 + v2 * v2 + v3 * v3;
                              u32x2 w; w.x = cvtpk(v0, v1); w.y = cvtpk(v2, v3); *(u32x2*)(Y + row * DM + h * 64 + 32 * dt + 8 * g + 4 * hi) = w; }
                      ss = xhalf_sum(ss); if (hi == 0) ssq_d[(size_t)h * M + row] = ss; }
                    __syncthreads();
                }
              }
            }
        }
        SEAM(pb + 2);
        if (IN(pb + 3)) {
        const int l_ = l; WS_PTRS();
            pg8::Gemm g{Y, (const bf16_t*)(ws + WS_WOUT) + (size_t)l * DM * DM, M, DM, DM}; pg8::StaticOrder S; S.init(M, DM, G, bid);
            pg8::EpiResid<true> E{XB, ssq_out, ssq_d, (LAS float*)(lds + 131072)};
            pg8::gemm_phase<pg8::EpiResid<true>, pg8::StaticOrder, true, true>(lds, g, S, E);
            if (REP_G57) { pg8::EpiInProj E2{PB, DM, ssq_mix}; pg8::gemm_phase<pg8::EpiInProj, pg8::StaticOrder, true, true>(lds, g, S, E2); }
        }
        SEAM(pb + 3);
        if (IN(pb + 4)) {
        const int l_ = l; WS_PTRS();
            pg8::Gemm g{XB, (const bf16_t*)(ws + WS_WGU) + (size_t)l * NGU * DM, M, NGU, DM}; pg8::StaticOrder S; S.init(M, NGU, G, bid);
            pg8::EpiSwiglu E{ACT, ssq_out};
            _Pragma("unroll 1") for (int rep = 0; rep < REP_G16; ++rep) pg8::gemm_phase<pg8::EpiSwiglu, pg8::StaticOrder, true, true>(lds, g, S, E);
        }
        SEAM(pb + 4);
        if (IN(pb + 5)) {
        const int l_ = l; WS_PTRS();
            pg8::Gemm g{ACT, (const bf16_t*)(ws + WS_WDN) + (size_t)l * DM * FF, M, DM, FF}; pg8::StaticOrder S; S.init(M, DM, G, bid);
            pg8::EpiResid<false> E{XB, ssq_down, nullptr, (LAS float*)(lds + 131072)};
            pg8::gemm_phase<pg8::EpiResid<false>, pg8::StaticOrder, true, true>(lds, g, S, E);
            if (REP_G57) { pg8::EpiInProj E2{Y, DM, ssq_mix}; pg8::gemm_phase<pg8::EpiInProj, pg8::StaticOrder, true, true>(lds, g, S, E2); }
        }
        SEAM(pb + 5);
    }
    if (IN(13)) {
        const int l_ = 1; WS_PTRS();
        LAUNDER_TID();
        const float* ssqf = ssp_base + (size_t)5 * 4 * M; const int gw = bid * 8 + wave, NGW = G * 8;
        for (int m = gw; m < M; m += NGW) {
            const float rinv = rsqrtf(sum4p(ssqf, m) * (1.f / DM) + EPS);
            const u32x2* xr = (const u32x2*)(XB + (size_t)m * DM) + lane; f32x4* orow = (f32x4*)(args.out + (size_t)m * DM) + lane; const f32x4* gn = (const f32x4*)inp(args, 27) + lane;
#pragma unroll
            for (int j = 0; j < 4; ++j) { const u32x2 w = xr[64 * j]; const f32x4 g = gn[64 * j]; f32x4 v; v[0] = bflo(w.x) * rinv * g[0]; v[1] = bfhi(w.x) * rinv * g[1]; v[2] = bflo(w.y) * rinv * g[2]; v[3] = bfhi(w.y) * rinv * g[3]; orow[64 * j] = v; }
        }
    }
#undef IN
#undef SEAM
}

extern "C" void kernel_launch(void* const* d_in, const int* in_sizes, int n_in, void* d_out, int out_size, void* d_ws, size_t ws_size, hipStream_t stream) {
    static int grid = 0;
    if (grid == 0) {
        if (n_in != 28 || in_sizes[0] != M * DM || out_size != M * DM || ws_size < WS_END) { fprintf(stderr, "kernel_launch: unexpected shapes (n_in %d, ws %zu)\n", n_in, ws_size); grid = -1; return; }
        int dev = 0, cus = 0;
        if (hipGetDevice(&dev) != hipSuccess || hipDeviceGetAttribute(&cus, hipDeviceAttributeMultiprocessorCount, dev) != hipSuccess) { grid = -1; return; }
        if (hipFuncSetAttribute((const void*)fwd, hipFuncAttributeMaxDynamicSharedMemorySize, LDS_BYTES) != hipSuccess) { fprintf(stderr, "kernel_launch: hipFuncSetAttribute failed\n"); grid = -1; return; }
        int per_cu = 0;
        if (hipOccupancyMaxActiveBlocksPerMultiprocessor(&per_cu, (const void*)fwd, NTHR, LDS_BYTES) != hipSuccess || per_cu < 1) fprintf(stderr, "kernel_launch: occupancy query says %d\n", per_cu);
        (void)hipGetLastError();
        grid = cus;
    }
    if (grid < 0) return;
    (void)hipMemsetAsync((char*)d_ws + WS_CTL, 0, CTL_ZERO_BYTES, stream);
    Args a{};
    for (int i = 0; i < 28; ++i) a.in[i] = (const float*)d_in[i];
    a.out = (float*)d_out; a.ws = (unsigned char*)d_ws;
    if (MK_N_LAUNCHES == 1) { a.ph_lo = 0; a.ph_hi = 14; hipLaunchKernelGGL(fwd, dim3(grid), dim3(NTHR), LDS_BYTES, stream, a); }
    else for (int p = 0; p < 14; ++p) { a.ph_lo = p; a.ph_hi = p + 1; hipLaunchKernelGGL(fwd, dim3(grid), dim3(NTHR), LDS_BYTES, stream, a); }
}
```

```cpp
#include <hip/hip_runtime.h>
#include <cstdio>
#include <cstdint>

#ifndef MK_N_LAUNCHES
#define MK_N_LAUNCHES 1
#endif

#define REP_P0 1
#define REP_G16 1
#define REP_G57 0
#define REP_ATT 1
#define STAGGER 6
#define REP_J4B 1
#define REP_J3 1
#define REP_J1 1
#define REP_J2 1
#define REP_P3 1
#define REP_ONLY 0
#define LAS __attribute__((address_space(3)))
#define DI __device__ __forceinline__
typedef unsigned short bf16_t;
typedef short bf16x8 __attribute__((ext_vector_type(8)));
typedef float f32x4 __attribute__((ext_vector_type(4)));
typedef unsigned u32x4 __attribute__((ext_vector_type(4)));
typedef unsigned u32x2 __attribute__((ext_vector_type(2)));

constexpr int NB = 4, SEQ = 8192, M = NB * SEQ, DM = 1024, NIN = 2304, NINS = 2300, FF = 2816, NGU = 2 * FF;
constexpr float EPS = 1e-6f;
constexpr int C_AX = 0, C_AG = 256, C_BQ = 512, C_KC = 768, C_VC = 832, C_KS = 896, C_VS = 960, C_KW = 1024, C_VW = 1088, C_BG = 1152,
              C_CQ = 1164, C_CK = 1292, C_CV = 1420, C_GLR = 1676, C_OG = 1692, C_DCQ = 1948, C_DCKV = 2140, C_DKR = 2268;
constexpr size_t MiB = 1u << 20;
constexpr size_t WS_CTL = 0, CTL_ZERO_BYTES = 1 * MiB;
constexpr size_t WS_ACC = 64 * 1024;
constexpr size_t WS_SSQ0 = 1 * MiB;
constexpr size_t WS_HB = 1 * MiB + 256 * 1024;
constexpr size_t WS_WIN = 2 * MiB, WS_WOUT = 11 * MiB, WS_WGU = 15 * MiB, WS_WDN = 37 * MiB;
constexpr size_t WS_WUQT = 48 * MiB, WS_WUKVT = 48 * MiB + 512 * 1024, WS_W2T = 49 * MiB, WS_W1T = 50 * MiB;
constexpr size_t WS_WGT = 49 * MiB + 512 * 1024, WS_SP = 49 * MiB + 768 * 1024;
constexpr size_t WS_BCS = 352 * MiB;
constexpr size_t WS_CS64 = 64 * MiB, WS_CS32 = 72 * MiB;
constexpr size_t WS_XB = 80 * MiB, WS_Y = 144 * MiB, WS_PB = 208 * MiB, WS_ACT = 208 * MiB;
constexpr size_t WS_LA = 384 * MiB, WS_LH = 386 * MiB, WS_CIN = 388 * MiB;
constexpr size_t WS_KVC = 392 * MiB, WS_DEC = 408 * MiB, WS_SST = 410 * MiB;
constexpr size_t WS_MQ = 428 * MiB, WS_MKN = 452 * MiB, WS_MV = 468 * MiB, WS_MKR = 484 * MiB;
constexpr size_t WS_SSP = 500 * MiB;
constexpr size_t WS_KSF = 504 * MiB;
constexpr size_t WS_VST = 490 * MiB, WS_VWT = 494 * MiB, WS_KCMPB = 498 * MiB, WS_VCMPT = 499 * MiB, WS_END = 508 * MiB;
constexpr int CW_QUEUE = 64;
constexpr int CW_FLAG = 1024;
constexpr int CW_BAR = 4096;
constexpr int LDS_BYTES = 163840 - 256;
constexpr int LDS_CTL = LDS_BYTES - 64;
constexpr int NTHR = 512;

struct Args { const float* in[28]; float* out; unsigned char* ws; int ph_lo, ph_hi; };

DI float bf2f(bf16_t h) { return __uint_as_float(((unsigned)h) << 16); }
DI float bflo(unsigned u) { return __uint_as_float(u << 16); }
DI float bfhi(unsigned u) { return __uint_as_float(u & 0xffff0000u); }
DI bf16_t f2bf(float f) { unsigned u = __float_as_uint(f); return (bf16_t)((u + 0x7fffu + ((u >> 16) & 1u)) >> 16); }
DI unsigned pk2(float lo, float hi) { return (unsigned)f2bf(lo) | ((unsigned)f2bf(hi) << 16); }
DI float sum4p(const float* p, size_t row) { return (p[row] + p[(size_t)M + row]) + (p[2 * (size_t)M + row] + p[3 * (size_t)M + row]); }
DI float wave_sum(float v) {
#pragma unroll
    for (int o = 1; o < 64; o <<= 1) v += __shfl_xor(v, o);
    return v;
}
DI float wave_max(float v) {
#pragma unroll
    for (int o = 1; o < 64; o <<= 1) v = fmaxf(v, __shfl_xor(v, o));
    return v;
}
DI int wave_min_i(int v) {
#pragma unroll
    for (int o = 1; o < 64; o <<= 1) { int w = __shfl_xor(v, o); v = w < v ? w : v; }
    return v;
}
DI float sigmoidf_(float x) { return __builtin_amdgcn_rcpf(1.f + __builtin_amdgcn_exp2f(-1.4426950408889634f * x)); }
DI float gelu_tanh(float x) { const float u = 0.7978845608028654f * (x + 0.044715f * x * x * x); return x * sigmoidf_(2.f * u); }
#define WSYNC() do { asm volatile("s_waitcnt lgkmcnt(0)" ::: "memory"); __builtin_amdgcn_wave_barrier(); } while (0)

namespace pg8 {
constexpr int BM = 256, BK = 64, HALF = 128, HTB = HALF * BK * 2, NXCD = 8, WGM = 8;
__host__ __device__ __forceinline__ int lds_byte(int r, int c) { const int st = (r >> 4) * 2 + (c >> 5), rr = r & 15, cc = c & 31, ob = rr * 64 + cc * 2; return st * 1024 + (ob ^ (((ob >> 9) & 1) << 5)); }
__host__ __device__ __forceinline__ void stage_rc(int b, int& R, int& C) { const int st = b / 1024, sb = b % 1024, swz = sb ^ (((sb >> 9) & 1) << 5); R = (st >> 1) * 16 + swz / 64; C = (st & 1) * 32 + (swz % 64) / 2; }
__host__ __device__ __forceinline__ int perm32(int rho) { const int n = rho >> 4, i = rho & 15; return 8 * (i >> 2) + 4 * n + (i & 3); }
struct Unit { int pm, pn; };
struct Gemm { const bf16_t* A; const bf16_t* Bt; int M, N, K; };
struct StaticOrder {
    int nM, nN, nwg, G, c;
    __host__ __device__ void init(int M_, int N_, int G_, int c_) { nM = M_ / BM; nN = N_ / BM; nwg = nM * nN; G = G_; c = c_; }
    __host__ __device__ bool next(int i, Unit& u) const {
        const long L = (long)i * G + c; if (L >= nwg) return false;
        int wgid = (int)L; { const int q = nwg / NXCD, r = nwg % NXCD, xcd = wgid % NXCD, off = wgid / NXCD; wgid = (xcd < r ? xcd * (q + 1) : r * (q + 1) + (xcd - r) * q) + off; }
        const int nig = WGM * nN, gid = wgid / nig, fm = gid * WGM, gsz = (nM - fm) < WGM ? (nM - fm) : WGM;
        u.pm = fm + ((wgid % nig) % gsz); u.pn = (wgid % nig) / gsz; return true;
    }
    __device__ __forceinline__ void a_ready(const Unit&) const {}
    __device__ __forceinline__ void done(const Unit&) const {}
};
DI unsigned cvt_pk_bf16(float lo, float hi) { unsigned r; asm volatile("v_cvt_pk_bf16_f32 %0, %1, %2" : "=v"(r) : "v"(lo), "v"(hi)); return r; }

struct EpiInProj {
    static constexpr bool PERM = true, AFTER_DRAIN = false, MIDSCALE = false;
    bf16_t* O; int ldc; const float* ssq;
    DI void operator()(const f32x4 (&acc)[2][2][4][2], const Unit& u, int wr, int wc, int fr, int fq) const {
        int row0 = u.pm * BM + wr * 64 + fr; asm volatile("" : "+v"(row0)); const int col0 = u.pn * BM + wc * 32 + 8 * fq;
#pragma unroll
        for (int ai = 0; ai < 2; ++ai)
#pragma unroll
            for (int m = 0; m < 4; ++m) {
                const int row = row0 + ai * HALF + m * 16;
                const float rinv = rsqrtf(sum4p(ssq, row) * (1.f / DM) + EPS);
                bf16_t* rowp = O + (size_t)row * ldc + col0;
#pragma unroll
                for (int bj = 0; bj < 2; ++bj) {
                    f32x4 v0 = acc[ai][bj][m][0] * rinv, v1 = acc[ai][bj][m][1] * rinv;
                    u32x4 w; w.x = cvt_pk_bf16(v0[0], v0[1]); w.y = cvt_pk_bf16(v0[2], v0[3]); w.z = cvt_pk_bf16(v1[0], v1[1]); w.w = cvt_pk_bf16(v1[2], v1[3]);
                    *(u32x4*)(rowp + bj * HALF) = w;
                }
            }
    }
};
template <bool MS> struct EpiResid {
    static constexpr bool PERM = true, AFTER_DRAIN = false, MIDSCALE = MS;
    bf16_t* xb; float* ssq_part; const float* ssq_mid; LAS float* ssl;
    DI void midscale(f32x4 (&acc)[2][2][4][2], const Unit& u, int wr, int fr) const {
        int row0 = u.pm * BM + wr * 64 + fr; asm volatile("" : "+v"(row0));
#pragma unroll
        for (int ai = 0; ai < 2; ++ai)
#pragma unroll
            for (int m = 0; m < 4; ++m) { const float s = rsqrtf(sum4p(ssq_mid, row0 + ai * HALF + m * 16) * (1.f / 256.f) + EPS);
#pragma unroll
                for (int bj = 0; bj < 2; ++bj) { acc[ai][bj][m][0] *= s; acc[ai][bj][m][1] *= s; } }
    }
    DI void operator()(const f32x4 (&acc)[2][2][4][2], const Unit& u, int wr, int wc, int fr, int fq) const {
        int rl0 = wr * 64 + fr; asm volatile("" : "+v"(rl0));
        const int col0 = u.pn * BM + wc * 32 + 8 * fq;
#pragma unroll
        for (int ai = 0; ai < 2; ++ai)
#pragma unroll
            for (int m = 0; m < 4; ++m) {
                const int rl = rl0 + ai * HALF + m * 16; const size_t row = (size_t)u.pm * BM + rl;
                float part = 0.f;
#pragma unroll
                for (int bj = 0; bj < 2; ++bj) {
                    u32x4* px = (u32x4*)(xb + row * DM + col0 + bj * HALF); const u32x4 xo = *px;
                    const f32x4 a0 = acc[ai][bj][m][0], a1 = acc[ai][bj][m][1];
                    const float v0 = a0[0] + bflo(xo.x), v1 = a0[1] + bfhi(xo.x), v2 = a0[2] + bflo(xo.y), v3 = a0[3] + bfhi(xo.y), v4 = a1[0] + bflo(xo.z), v5 = a1[1] + bfhi(xo.z), v6 = a1[2] + bflo(xo.w), v7 = a1[3] + bfhi(xo.w);
                    u32x4 w; w.x = cvt_pk_bf16(v0, v1); w.y = cvt_pk_bf16(v2, v3); w.z = cvt_pk_bf16(v4, v5); w.w = cvt_pk_bf16(v6, v7);
                    *px = w;
                    part += (v0 * v0 + v1 * v1) + (v2 * v2 + v3 * v3) + (v4 * v4 + v5 * v5) + (v6 * v6 + v7 * v7);
                }
                part += __shfl_xor(part, 16); part += __shfl_xor(part, 32);
                if (fq == 0) ssl[rl * 4 + wc] = part;
            }
        asm volatile("s_waitcnt lgkmcnt(0)" ::: "memory"); __builtin_amdgcn_s_barrier();
        int tq = threadIdx.x; asm volatile("" : "+v"(tq));
        if (tq < 256) { const f32x4 p = *(const LAS f32x4*)(ssl + tq * 4); ssq_part[(size_t)u.pn * M + (size_t)u.pm * BM + tq] = (p[0] + p[1]) + (p[2] + p[3]); }
    }
};
struct EpiSwiglu {
    static constexpr bool PERM = true, AFTER_DRAIN = false, MIDSCALE = false;
    bf16_t* act; const float* ssq;
    DI void operator()(const f32x4 (&acc)[2][2][4][2], const Unit& u, int wr, int wc, int fr, int fq) const {
        int row0 = u.pm * BM + wr * 64 + fr; asm volatile("" : "+v"(row0)); const int j0 = u.pn * 128 + wc * 16 + 4 * fq;
#pragma unroll
        for (int ai = 0; ai < 2; ++ai)
#pragma unroll
            for (int m = 0; m < 4; ++m) {
                const int row = row0 + ai * HALF + m * 16;
                const float rinv = rsqrtf(sum4p(ssq, row) * (1.f / DM) + EPS);
#pragma unroll
                for (int bj = 0; bj < 2; ++bj) {
                    const f32x4 g = acc[ai][bj][m][0] * rinv, up = acc[ai][bj][m][1] * rinv;
                    float a[4];
#pragma unroll
                    for (int i = 0; i < 4; ++i) a[i] = g[i] * up[i] * __builtin_amdgcn_rcpf(1.f + __builtin_amdgcn_exp2f(-1.4426950408889634f * g[i]));
                    u32x2 w; w.x = cvt_pk_bf16(a[0], a[1]); w.y = cvt_pk_bf16(a[2], a[3]);
                    *(u32x2*)(act + (size_t)row * FF + j0 + bj * 64) = w;
                }
            }
    }
};

template <class Epi, class Sched, bool ALIGN_EPI = false, bool SP2 = false>
DI void gemm_phase(LAS unsigned char* lds, const Gemm g, const Sched& S, const Epi& E) {
    int tid_ = threadIdx.x; asm volatile("" : "+v"(tid_));
    const int tid = tid_, wid = __builtin_amdgcn_readfirstlane(tid >> 6), lane = tid & 63, wr = wid >> 2, wc = wid & 3, fr = lane & 15, fq = lane >> 4;
    const int K = g.K, nt = K / BK;
    unsigned voffA[2], voffB[2];
#pragma unroll
    for (int i = 0; i < 2; ++i) { int R, C; stage_rc(tid * 16 + i * 8192, R, C); const int Rb = Epi::PERM ? ((R & ~31) + perm32(R & 31)) : R;
        voffA[i] = (unsigned)(R * K + C) * 2u; voffB[i] = (unsigned)(Rb * K + C) * 2u; }
    const size_t kstep = (size_t)(BK * 2);
    const size_t hstep = (size_t)HALF * K * 2;
    const size_t tstep = 2 * hstep;
    const unsigned ldsw = (unsigned)wid * 1024u;
    const int aoff = lds_byte(wr * 64 + fr, fq * 8), boff = lds_byte(wc * 32 + fr, fq * 8);
#define PG8_SA(b, h) (((b) * 2 + (h)) * HTB)
#define PG8_SB(b, h) ((4 + (b) * 2 + (h)) * HTB)
#define PG8_STAGE(bufoff, gbase, voff) do { _Pragma("unroll") for (int _i = 0; _i < 2; ++_i) \
        __builtin_amdgcn_global_load_lds((const unsigned*)((const char*)(gbase) + (voff)[_i]), (LAS unsigned*)(lds + (bufoff) + ldsw + _i * 8192), 16, 0, 0); } while (0)
#define PG8_LDA(dst, b, h) do { _Pragma("unroll") for (int m = 0; m < 4; ++m) _Pragma("unroll") for (int k = 0; k < 2; ++k) dst[m][k] = *(const LAS bf16x8*)(lds + PG8_SA(b, h) + aoff + m * 2048 + k * 1024); } while (0)
#define PG8_LDB(dst, b, h) do { _Pragma("unroll") for (int n = 0; n < 2; ++n) _Pragma("unroll") for (int k = 0; k < 2; ++k) dst[n][k] = *(const LAS bf16x8*)(lds + PG8_SB(b, h) + boff + n * 2048 + k * 1024); } while (0)
#define PG8_MMA(ai, bj, At, Bt) do { __builtin_amdgcn_s_setprio(1); _Pragma("unroll") for (int m = 0; m < 4; ++m) _Pragma("unroll") for (int n = 0; n < 2; ++n) _Pragma("unroll") for (int k = 0; k < 2; ++k) \
        acc[ai][bj][m][n] = __builtin_amdgcn_mfma_f32_16x16x32_bf16(Bt[n][k], At[m][k], acc[ai][bj][m][n], 0, 0, 0); __builtin_amdgcn_s_setprio(0); } while (0)
#define PG8_WAIT_V(n) asm volatile("s_waitcnt vmcnt(" #n ")" ::: "memory")
#define PG8_WAIT_L(n) asm volatile("s_waitcnt lgkmcnt(" #n ")" ::: "memory")
#define PG8_BAR __builtin_amdgcn_s_barrier()
#define PG8_SCHED __builtin_amdgcn_sched_barrier(0)
    Unit cur, nxt; int ui = 0;
    if (!S.next(0, cur)) return;
    f32x4 acc[2][2][4][2];
#pragma unroll
    for (int a = 0; a < 2; ++a)
#pragma unroll
        for (int b = 0; b < 2; ++b)
#pragma unroll
            for (int m = 0; m < 4; ++m)
#pragma unroll
                for (int n = 0; n < 2; ++n) acc[a][b][m][n] = (f32x4){0.f, 0.f, 0.f, 0.f};
    bf16x8 At[4][2], B0[2][2], B1[2][2];
    const char* cA = (const char*)g.A + (size_t)cur.pm * tstep; const char* cB = (const char*)g.Bt + (size_t)cur.pn * tstep;
    S.a_ready(cur);
    if constexpr (SP2) {
        PG8_STAGE(PG8_SB(0, 0), cB, voffB); PG8_STAGE(PG8_SB(0, 1), cB + hstep, voffB); PG8_STAGE(PG8_SA(0, 0), cA, voffA); PG8_STAGE(PG8_SA(0, 1), cA + hstep, voffA);
        if (wr == 1) PG8_BAR;
        PG8_WAIT_V(2); PG8_BAR;
        PG8_STAGE(PG8_SB(1, 0), cB + kstep, voffB); PG8_STAGE(PG8_SA(1, 0), cA + kstep, voffA); PG8_STAGE(PG8_SB(1, 1), cB + hstep + kstep, voffB);
        PG8_WAIT_V(6); PG8_BAR;
    } else {
        PG8_STAGE(PG8_SB(0, 0), cB, voffB); PG8_STAGE(PG8_SA(0, 0), cA, voffA); PG8_STAGE(PG8_SB(0, 1), cB + hstep, voffB); PG8_STAGE(PG8_SA(0, 1), cA + hstep, voffA);
        if (wr == 1) PG8_BAR;
        PG8_WAIT_V(4); PG8_BAR;
        PG8_STAGE(PG8_SB(1, 0), cB + kstep, voffB); PG8_STAGE(PG8_SA(1, 0), cA + kstep, voffA); PG8_STAGE(PG8_SB(1, 1), cB + hstep + kstep, voffB);
        PG8_WAIT_V(6); PG8_BAR;
    }
    for (;;) {
        const bool has_next = S.next(ui + 1, nxt);
        const char* nA = has_next ? (const char*)g.A + (size_t)nxt.pm * tstep : cA; const char* nB = has_next ? (const char*)g.Bt + (size_t)nxt.pn * tstep : cB;
        for (int t = 0; t < nt; t += 2) {
            const bool last = (t == nt - 2);
            const char* a1 = cA + (size_t)(t + 1) * kstep;
            const char* a2 = last ? nA : cA + (size_t)(t + 2) * kstep; const char* b2 = last ? nB : cB + (size_t)(t + 2) * kstep;
            const char* a3 = a2 + kstep; const char* b3 = b2 + kstep;
            if (last && has_next) S.a_ready(nxt);
            if constexpr (SP2) {
            PG8_LDB(B0, 0, 0); PG8_LDB(B1, 0, 1); PG8_SCHED; PG8_LDA(At, 0, 0); PG8_STAGE(PG8_SA(1, 1), a1 + hstep, voffA);
            PG8_WAIT_V(8); PG8_WAIT_L(0); PG8_BAR; PG8_MMA(0, 0, At, B0); PG8_MMA(0, 1, At, B1); PG8_BAR; PG8_SCHED;
            PG8_LDA(At, 0, 1); PG8_STAGE(PG8_SB(0, 0), b2, voffB); PG8_STAGE(PG8_SB(0, 1), b2 + hstep, voffB); PG8_STAGE(PG8_SA(0, 0), a2, voffA);
            PG8_WAIT_V(8); PG8_WAIT_L(0); PG8_BAR; PG8_MMA(1, 0, At, B0); PG8_MMA(1, 1, At, B1); PG8_BAR; PG8_SCHED;
            PG8_LDB(B0, 1, 0); PG8_LDB(B1, 1, 1); PG8_SCHED; PG8_LDA(At, 1, 0); PG8_STAGE(PG8_SA(0, 1), a2 + hstep, voffA);
            PG8_WAIT_V(8); PG8_WAIT_L(0); PG8_BAR; PG8_MMA(0, 0, At, B0); PG8_MMA(0, 1, At, B1); PG8_BAR; PG8_SCHED;
            PG8_LDA(At, 1, 1); PG8_STAGE(PG8_SB(1, 0), b3, voffB); PG8_STAGE(PG8_SB(1, 1), b3 + hstep, voffB); PG8_STAGE(PG8_SA(1, 0), a3, voffA);
            PG8_WAIT_V(8); PG8_WAIT_L(0); PG8_BAR; PG8_MMA(1, 0, At, B0); PG8_MMA(1, 1, At, B1); PG8_BAR; PG8_SCHED;
            if constexpr (Epi::MIDSCALE) { if (t == 2) E.midscale(acc, cur, wr, fr); }
            } else {
            PG8_LDB(B0, 0, 0); PG8_SCHED; PG8_LDA(At, 0, 0); PG8_STAGE(PG8_SA(1, 1), a1 + hstep, voffA);
            PG8_WAIT_L(8); PG8_BAR; PG8_WAIT_L(0); PG8_MMA(0, 0, At, B0); PG8_BAR; PG8_SCHED;
            PG8_LDB(B1, 0, 1); PG8_STAGE(PG8_SB(0, 0), b2, voffB);
            PG8_BAR; PG8_WAIT_L(0); PG8_MMA(0, 1, At, B1); PG8_BAR;
            PG8_LDA(At, 0, 1); PG8_STAGE(PG8_SA(0, 0), a2, voffA);
            PG8_BAR; PG8_WAIT_L(0); PG8_MMA(1, 0, At, B0); PG8_BAR; PG8_SCHED;
            PG8_STAGE(PG8_SB(0, 1), b2 + hstep, voffB);
            PG8_WAIT_V(6); PG8_BAR; PG8_MMA(1, 1, At, B1); PG8_BAR;
            PG8_LDB(B0, 1, 0); PG8_SCHED; PG8_LDA(At, 1, 0); PG8_STAGE(PG8_SA(0, 1), a2 + hstep, voffA);
            PG8_WAIT_L(8); PG8_BAR; PG8_WAIT_L(0); PG8_MMA(0, 0, At, B0); PG8_BAR; PG8_SCHED;
            PG8_LDB(B1, 1, 1); PG8_STAGE(PG8_SB(1, 0), b3, voffB);
            PG8_BAR; PG8_WAIT_L(0); PG8_MMA(0, 1, At, B1); PG8_BAR;
            PG8_LDA(At, 1, 1); PG8_STAGE(PG8_SA(1, 0), a3, voffA);
            PG8_BAR; PG8_WAIT_L(0); PG8_MMA(1, 0, At, B0); PG8_BAR; PG8_SCHED;
            PG8_STAGE(PG8_SB(1, 1), b3 + hstep, voffB);
            PG8_WAIT_V(6); PG8_BAR; PG8_MMA(1, 1, At, B1); PG8_BAR;
            }
        }
        if constexpr (ALIGN_EPI) { if (wr == 0) PG8_BAR; }
        if constexpr (!Epi::AFTER_DRAIN) { E(acc, cur, wr, wc, fr, fq); S.done(cur); }
        if (!has_next) break;
#pragma unroll
        for (int a = 0; a < 2; ++a)
#pragma unroll
            for (int b = 0; b < 2; ++b)
#pragma unroll
                for (int m = 0; m < 4; ++m)
#pragma unroll
                    for (int n = 0; n < 2; ++n) acc[a][b][m][n] = (f32x4){0.f, 0.f, 0.f, 0.f};
        cur = nxt; cA = nA; cB = nB; ++ui;
        if constexpr (ALIGN_EPI) { if (wr == 1) PG8_BAR; }
    }
    PG8_WAIT_V(0);
    if constexpr (!ALIGN_EPI) { if (wr == 0) PG8_BAR; }
    PG8_BAR;
#undef PG8_SA
#undef PG8_SB
#undef PG8_STAGE
#undef PG8_LDA
#undef PG8_LDB
#undef PG8_MMA
#undef PG8_WAIT_V
#undef PG8_WAIT_L
#undef PG8_BAR
#undef PG8_SCHED
}
}

#define XB_TMO      128
#define XB_XCNT(j)  (256  + 64 * (j))
#define XB_XSUB(j)  (1280 + 64 * (j))
#define XB_XGEN(j)  (2304 + 64 * (j))
#define XB_TOP      3328
#define XB_TOPGEN   3392
#define XCD_BAR_WORDS 3456
#define XB_SPIN_CAP (1u << 18)
__device__ __forceinline__ unsigned xb_ld(unsigned* p)              { return __hip_atomic_load(p, __ATOMIC_RELAXED, __HIP_MEMORY_SCOPE_AGENT); }
__device__ __forceinline__ unsigned xb_add(unsigned* p, unsigned v) { return __hip_atomic_fetch_add(p, v, __ATOMIC_RELAXED, __HIP_MEMORY_SCOPE_AGENT); }
__device__ __forceinline__ unsigned xb_xcc_id() { return (unsigned)__builtin_amdgcn_s_getreg((3 << 11) | 20) & 0xFu; }
#define XB_SPIN(cond, bar) do { unsigned _sp = 0; while (cond) { __builtin_amdgcn_s_sleep(1); \
    if ((++_sp & 255u) == 0u) { if (xb_ld(&(bar)[XB_TMO])) break; if (_sp > XB_SPIN_CAP) { atomicAdd(&(bar)[XB_TMO], 1u); break; } } } } while (0)
struct XcdBarrier { unsigned* bar; unsigned x; volatile LAS unsigned* st; };
__device__ __forceinline__ XcdBarrier xcd_barrier_post(unsigned* bar, volatile LAS unsigned* st) {
    XcdBarrier b; b.bar = bar; b.x = xb_xcc_id(); b.st = st;
    if (threadIdx.x == 0) (void)xb_add(&bar[XB_XCNT(b.x)], 1u);
    return b;
}
__device__ __forceinline__ void xcd_barrier_complete(unsigned* bar, unsigned x, unsigned& nloc, unsigned& nx) {
    const unsigned G = gridDim.x * gridDim.y * gridDim.z;
    unsigned sum, cnt, mine, sp = 0u;
    for (;;) {
        sum = 0u; cnt = 0u; mine = 0u;
#pragma unroll
        for (unsigned j = 0; j < 16; ++j) { const unsigned c = xb_ld(&bar[XB_XCNT(j)]); sum += c; cnt += (c > 0u) ? 1u : 0u; mine = (j == x) ? c : mine; }
        if (sum == G) break;
        __builtin_amdgcn_s_sleep(1);
        if ((++sp & 255u) == 0u) { if (xb_ld(&bar[XB_TMO])) break; if (sp > XB_SPIN_CAP) { atomicAdd(&bar[XB_TMO], 1u); break; } }
    }
    nloc = mine > 0u ? mine : 1u; nx = cnt > 0u ? cnt : 1u;
}
__device__ __forceinline__ void xcd_barrier(const XcdBarrier& b) {
    asm volatile("s_waitcnt vmcnt(0)" ::: "memory");
    __syncthreads();
    if (threadIdx.x == 0) {
        unsigned* bar = b.bar;
        __builtin_amdgcn_s_waitcnt(0);
        unsigned nloc = b.st[0], nx = b.st[1];
        if (nloc == 0u) { xcd_barrier_complete(bar, b.x, nloc, nx); b.st[0] = nloc; b.st[1] = nx; }
        const unsigned old = xb_add(&bar[XB_XSUB(b.x)], 1u);
        const unsigned gen = old / nloc;
        if (old + 1u == (gen + 1u) * nloc) {
            __builtin_amdgcn_fence(__ATOMIC_RELEASE, "agent");
            asm volatile("s_waitcnt vmcnt(0)" ::: "memory");
            const unsigned og = xb_add(&bar[XB_TOP], 1u);
            const unsigned tg = og / nx;
            if (og + 1u == (tg + 1u) * nx) xb_add(&bar[XB_TOPGEN], 1u);
            else XB_SPIN(xb_ld(&bar[XB_TOPGEN]) == tg, bar);
            __builtin_amdgcn_fence(__ATOMIC_ACQUIRE, "agent");
            xb_add(&bar[XB_XGEN(b.x)], 1u);
            asm volatile("s_waitcnt vmcnt(0)" ::: "memory");
        } else {
            XB_SPIN(xb_ld(&bar[XB_XGEN(b.x)]) == gen, bar);
            __builtin_amdgcn_fence(__ATOMIC_ACQUIRE, "agent");
            asm volatile("s_waitcnt vmcnt(0)" ::: "memory");
        }
    }
    __syncthreads();
}

template <int MAP>
DI int colmap(int v, int Nsrc) {
    if (MAP == 0) return v < Nsrc ? v : -1;
    const int g8 = v >> 3, e = v & 7, j = 4 * g8 + (e & 3); return (e < 4) ? j : FF + j;
}
template <int MAP, int KROT = 0>
DI void p0_transpose_item64(const float* W, int K, int Nsrc, const float* gain, bf16_t* WT, LAS float* scr, int kb, int nb, int lane) {
    const int k0 = 64 * kb, n0 = 64 * nb, v = n0 + 4 * (lane & 15);
    const int sc = MAP == 0 ? (v < Nsrc ? v : -1) : ((v >> 3) * 4 + ((v >> 2) & 1) * FF);
#pragma unroll 4
    for (int i = 0; i < 16; ++i) { const int kk = 4 * i + (lane >> 4); int ksrc = k0 + kk + KROT; if (KROT && ksrc >= K) ksrc -= K; f32x4 w = {0.f, 0.f, 0.f, 0.f}; if (sc >= 0) w = *(const f32x4*)(W + (size_t)ksrc * Nsrc + sc); if (gain) w = w * gain[ksrc];
        LAS float* d = scr + kk * 65 + 4 * (lane & 15); d[0] = w[0]; d[1] = w[1]; d[2] = w[2]; d[3] = w[3]; }
    WSYNC();
    const int c = lane & 7;
#pragma unroll
    for (int j = 0; j < 8; ++j) { const int n = (lane >> 3) + 8 * j; const LAS float* s = scr + (8 * c) * 65 + n;
        u32x4 o; o.x = pk2(s[0 * 65], s[1 * 65]); o.y = pk2(s[2 * 65], s[3 * 65]); o.z = pk2(s[4 * 65], s[5 * 65]); o.w = pk2(s[6 * 65], s[7 * 65]);
        *(u32x4*)(WT + (size_t)(n0 + n) * K + k0 + 8 * c) = o; }
    WSYNC();
}
template <int MAP, int KROT = 0>
DI void p0_transpose_item(const float* W, int K, int Nsrc, const float* gain, bf16_t* WT, LAS float* scr, int kb, int nb, int lane) {
    const int k0 = 64 * kb, n0 = 32 * nb;
    const int sc = colmap<MAP>(n0 + (lane & 31), Nsrc);
#pragma unroll 8
    for (int i = 0; i < 32; ++i) { const int kk = 2 * i + (lane >> 5); int ksrc = k0 + kk + KROT; if (KROT && ksrc >= K) ksrc -= K; float w = 0.f; if (sc >= 0) w = W[(size_t)ksrc * Nsrc + sc]; if (gain) w *= gain[ksrc]; scr[kk * 33 + (lane & 31)] = w; }
    WSYNC();
    const int c = lane & 7;
#pragma unroll
    for (int j = 0; j < 4; ++j) { const int n = (lane >> 3) + 8 * j; const LAS float* s = scr + (8 * c) * 33 + n;
        u32x4 o; o.x = pk2(s[0 * 33], s[1 * 33]); o.y = pk2(s[2 * 33], s[3 * 33]); o.z = pk2(s[4 * 33], s[5 * 33]); o.w = pk2(s[6 * 33], s[7 * 33]);
        *(u32x4*)(WT + (size_t)(n0 + n) * K + k0 + 8 * c) = o; }
    WSYNC();
}


typedef float f32x16 __attribute__((ext_vector_type(16)));
typedef float f32x2v __attribute__((ext_vector_type(2)));
typedef __bf16 bf16x2_t __attribute__((ext_vector_type(2)));
constexpr int KSTR = 208, VSTR = 136;
constexpr int AL_K0 = 0, AL_K1 = 64 * KSTR, AL_V0 = 2 * 64 * KSTR, AL_V1 = AL_V0 + 64 * VSTR, AL_IMP = 45056, AL_SELM = AL_IMP + 32768, AL_OACC = AL_SELM + 1024;
constexpr float NEGB = -1e30f, LOG2E = 1.4426950408889634f;
DI unsigned cvtpk(float lo, float hi) { f32x2v v = {lo, hi}; bf16x2_t b = __builtin_convertvector(v, bf16x2_t); return __builtin_bit_cast(unsigned, b); }
DI f32x16 mfma32(bf16x8 a, bf16x8 b, f32x16 c) { return __builtin_amdgcn_mfma_f32_32x32x16_bf16(a, b, c, 0, 0, 0); }
DI float xhalf_max(float v) { auto rr = __builtin_amdgcn_permlane32_swap(__float_as_uint(v), __float_as_uint(v), false, false); return fmaxf(__uint_as_float(rr[0]), __uint_as_float(rr[1])); }
DI float xhalf_sum(float v) { auto rr = __builtin_amdgcn_permlane32_swap(__float_as_uint(v), __float_as_uint(v), false, false); return __uint_as_float(rr[0]) + __uint_as_float(rr[1]); }
DI float ex2(float x) { return __builtin_amdgcn_exp2f(x); }
template <int KSTEPS>
DI void qk_tile(const LAS unsigned char* Kt, const bf16x8 (&qf)[KSTEPS], int r32, int hi, f32x16& s0, f32x16& s1) {
    const LAS unsigned char* p0 = Kt + r32 * KSTR + hi * 16;
#pragma unroll
    for (int i = 0; i < 16; ++i) { s0[i] = 0.f; s1[i] = 0.f; }
#pragma unroll
    for (int ks = 0; ks < KSTEPS; ++ks) {
        const bf16x8 a0 = *(const LAS bf16x8*)(p0 + ks * 32), a1 = *(const LAS bf16x8*)(p0 + 32 * KSTR + ks * 32);
        s0 = mfma32(a0, qf[ks], s0); s1 = mfma32(a1, qf[ks], s1);
    }
}
DI void mask_tile(f32x16& s0, f32x16& s1, int klo, int khi, int hi) {
    const int lo_ = klo - 4 * hi, hi_ = khi - 4 * hi;
#pragma unroll
    for (int i = 0; i < 16; ++i) { const int kb = (i & 3) + 8 * (i >> 2); if (kb < lo_ || kb > hi_) s0[i] = NEGB; if (kb + 32 < lo_ || kb + 32 > hi_) s1[i] = NEGB; }
}
DI float tile_max(const f32x16& s0, const f32x16& s1) {
    float mx = fmaxf(s0[0], s1[0]);
#pragma unroll
    for (int i = 1; i < 16; ++i) mx = fmaxf(mx, fmaxf(s0[i], s1[i]));
    return xhalf_max(mx);
}
template <int BASE> DI bf16x8 pack8(const f32x16& s) { u32x4 p; p.x = cvtpk(s[BASE], s[BASE + 1]); p.y = cvtpk(s[BASE + 2], s[BASE + 3]); p.z = cvtpk(s[BASE + 4], s[BASE + 5]); p.w = cvtpk(s[BASE + 6], s[BASE + 7]); return __builtin_bit_cast(bf16x8, p); }
DI bf16x8 ld8x2(const bf16_t* p) { const u32x2 a = *(const u32x2*)p, b = *(const u32x2*)(p + 4); u32x4 w; w.x = a.x; w.y = a.y; w.z = b.x; w.w = b.y; return __builtin_bit_cast(bf16x8, w); }
DI bf16x8 vfrag(const LAS unsigned char* p) { const u32x2 a = *(const LAS u32x2*)p, b = *(const LAS u32x2*)(p + 16); u32x4 w; w.x = a.x; w.y = a.y; w.z = b.x; w.w = b.y; return __builtin_bit_cast(bf16x8, w); }
template <int VS = VSTR>
DI void pv_tile(const f32x16& s0, const f32x16& s1, const LAS unsigned char* Vt, f32x16 (&o)[2], int r32, int hi) {
    const bf16x8 p00 = pack8<0>(s0), p01 = pack8<8>(s0), p10 = pack8<0>(s1), p11 = pack8<8>(s1);
#pragma unroll
    for (int dt = 0; dt < 2; ++dt) { const LAS unsigned char* vp = Vt + (32 * dt + r32) * VS + 8 * hi;
        o[dt] = mfma32(vfrag(vp), p00, o[dt]); o[dt] = mfma32(vfrag(vp + 32), p01, o[dt]); o[dt] = mfma32(vfrag(vp + 64), p10, o[dt]); o[dt] = mfma32(vfrag(vp + 96), p11, o[dt]); }
}
DI void softmax_pv(f32x16& s0, f32x16& s1, const LAS unsigned char* Vt, f32x16 (&o)[2], float& m, float& l, int r32, int hi) {
    const float mx = tile_max(s0, s1), mn = fmaxf(m, mx), ms = mn < -1e29f ? 0.f : mn, alpha = ex2(m - ms);
    m = mn; float psum = 0.f;
#pragma unroll
    for (int i = 0; i < 16; ++i) { s0[i] = ex2(s0[i] - ms); s1[i] = ex2(s1[i] - ms); psum += s0[i] + s1[i]; }
    l = l * alpha + psum;
    if (!__all(alpha == 1.f)) {
#pragma unroll
        for (int i = 0; i < 16; ++i) { o[0][i] *= alpha; o[1][i] *= alpha; } }
    pv_tile(s0, s1, Vt, o, r32, hi);
}
struct SoftState { float m, l; };
constexpr float SM_THR = 8.f;
DI void soft_init(SoftState& S, f32x16 (&o)[2]) { S.m = 0.f; S.l = 0.f;
#pragma unroll
    for (int i = 0; i < 16; ++i) { o[0][i] = 0.f; o[1][i] = 0.f; } }
DI f32x16 bcast16(float v) { f32x16 c;
#pragma unroll
    for (int i = 0; i < 16; ++i) c[i] = v;
    return c; }
DI float max3f(float a, float b, float c) { float r; asm("v_max3_f32 %0, %1, %2, %3" : "=v"(r) : "v"(a), "v"(b), "v"(c)); return r; }
DI float soft_update(f32x16& s0, f32x16& s1, SoftState& S, f32x16 (&o)[2], bool masked, int klo, int khi, bool first, int hi, float adj = 0.f) {
    if (__any(adj != 0.f)) {
#pragma unroll
        for (int i = 0; i < 16; ++i) { s0[i] -= adj; s1[i] -= adj; } }
    float dl_ret = 0.f;
    if (__builtin_expect(masked, 0)) { asm volatile("; boundary tile mask" ::: "memory"); mask_tile(s0, s1, klo, khi, hi); }
    asm volatile("s_nop 15\n\ts_nop 7" : "+v"(s0), "+v"(s1));
    float rm;
    { float a = max3f(s0[0], s0[1], s0[2]), b = max3f(s1[0], s1[1], s1[2]);
#pragma unroll
      for (int i = 3; i < 15; i += 2) { a = max3f(a, s0[i], s0[i + 1]); b = max3f(b, s1[i], s1[i + 1]); }
      rm = xhalf_max(fmaxf(max3f(a, b, s0[15]), s1[15])); }
    if (first) {
        const float dl = rm < -1e29f ? 0.f : rm; S.m = dl; dl_ret = dl;
#pragma unroll
        for (int i = 0; i < 16; ++i) { s0[i] -= dl; s1[i] -= dl; }
    } else if (__any(rm > SM_THR)) {
        const float dl = fmaxf(rm, 0.f), alpha = ex2(-dl); S.m += dl; S.l *= alpha; dl_ret = dl;
#pragma unroll
        for (int i = 0; i < 16; ++i) { s0[i] -= dl; s1[i] -= dl; o[0][i] *= alpha; o[1][i] *= alpha; }
    }
    float p0 = 0.f, p1 = 0.f, p2 = 0.f, p3 = 0.f;
#pragma unroll
    for (int i = 0; i < 16; i += 2) { s0[i] = ex2(s0[i]); s0[i + 1] = ex2(s0[i + 1]); s1[i] = ex2(s1[i]); s1[i + 1] = ex2(s1[i + 1]); p0 += s0[i]; p1 += s0[i + 1]; p2 += s1[i]; p3 += s1[i + 1]; }
    S.l += (p0 + p1) + (p2 + p3);
    return dl_ret;
}
template <int KSTEPS, int VS = VSTR>
DI void attn_step(const LAS unsigned char* Kt, const LAS unsigned char* Vt, const bf16x8 (&qf)[KSTEPS], SoftState& S, f32x16 (&o)[2], bool masked, int klo, int khi, bool first, int r32, int hi) {
    const f32x16 cinit = bcast16(-S.m); f32x16 s0 = cinit, s1 = cinit;
    { const LAS unsigned char* p0 = Kt + r32 * KSTR + hi * 16;
#pragma unroll
      for (int ks = 0; ks < KSTEPS; ++ks) { const bf16x8 a0 = *(const LAS bf16x8*)(p0 + ks * 32), a1 = *(const LAS bf16x8*)(p0 + 32 * KSTR + ks * 32);
          s0 = mfma32(a0, qf[ks], s0); s1 = mfma32(a1, qf[ks], s1); } }
    soft_update(s0, s1, S, o, masked, klo, khi, first, hi);
    pv_tile<VS>(s0, s1, Vt, o, r32, hi);
}
template <int KSTEPS, int VS>
DI void attn_step2(const LAS unsigned char* Kt, const LAS unsigned char* Vt, const bf16x8 (&qf)[KSTEPS], SoftState& S, f32x16 (&o)[2], bool masked0, int khi0, bool masked1, int khi1, bool first, int r32, int hi) {
    const f32x16 cinit = bcast16(-S.m); f32x16 a0 = cinit, a1 = cinit, b0 = cinit, b1 = cinit;
    { const LAS unsigned char* p0 = Kt + r32 * KSTR + hi * 16;
#pragma unroll
      for (int ks = 0; ks < KSTEPS; ++ks) { const bf16x8 k0 = *(const LAS bf16x8*)(p0 + ks * 32), k1 = *(const LAS bf16x8*)(p0 + 32 * KSTR + ks * 32);
          a0 = mfma32(k0, qf[ks], a0); a1 = mfma32(k1, qf[ks], a1); }
#pragma unroll
      for (int ks = 0; ks < KSTEPS; ++ks) { const bf16x8 k0 = *(const LAS bf16x8*)(p0 + 64 * KSTR + ks * 32), k1 = *(const LAS bf16x8*)(p0 + 96 * KSTR + ks * 32);
          b0 = mfma32(k0, qf[ks], b0); b1 = mfma32(k1, qf[ks], b1); } }
    const float dl0 = soft_update(a0, a1, S, o, masked0, 0, khi0, first, hi);
    pv_tile<VS>(a0, a1, Vt, o, r32, hi);
    (void)soft_update(b0, b1, S, o, masked1, 0, khi1, false, hi, dl0);
    pv_tile<VS>(b0, b1, Vt + 128, o, r32, hi);
}
struct StageRegs { u32x4 a, b, c, d, e; };
template <class LoadF, class StoreF, class StepF>
DI void attn_pipeline(int jbeg, int jend, LoadF ld, StoreF st, StepF step) {
    if (jbeg > jend) return;
    StageRegs RA;
    ld(jbeg, RA); st(0, RA); __syncthreads();
    for (int j = jbeg; j <= jend; j += 2) {
        if (j + 1 <= jend) ld(j + 1, RA);
        step(j, 0);
        if (j + 1 <= jend) st(1, RA);
        __syncthreads();
        if (STAGGER && __builtin_amdgcn_readfirstlane(threadIdx.x >> 6) >= 4) __builtin_amdgcn_s_sleep(STAGGER);
        if (j + 1 > jend) break;
        if (j + 2 <= jend) ld(j + 2, RA);
        step(j + 1, 1);
        if (j + 2 <= jend) st(0, RA);
        __syncthreads();
        if (STAGGER && __builtin_amdgcn_readfirstlane(threadIdx.x >> 6) >= 4) __builtin_amdgcn_s_sleep(STAGGER);
    }
}
DI const float* inp(const Args& a, int k) { asm volatile("" : "+s"(k)); return a.in[k]; }
__global__ void __launch_bounds__(NTHR, 2) fwd(Args args) {
    extern __shared__ __attribute__((aligned(16))) unsigned char lds_raw[];
    LAS unsigned char* lds = (LAS unsigned char*)lds_raw;
    LAS float* ldsf = (LAS float*)lds;
    volatile LAS unsigned* LCTL = (volatile LAS unsigned*)(lds + LDS_CTL);
    const int tid0 = threadIdx.x, wave = __builtin_amdgcn_readfirstlane(tid0 >> 6);
    const int G = gridDim.x, bid = blockIdx.x;
#define LAUNDER_TID() int tid = tid0; asm volatile("" : "+v"(tid)); const int lane = tid & 63; (void)lane
#define WS_PTRS() unsigned char* ws = args.ws; asm volatile("" : "+s"(ws)); \
    unsigned* ctl = (unsigned*)(ws + WS_CTL); float* ssp_base = (float*)(ws + WS_SSP); float* hb = (float*)(ws + WS_HB); \
    bf16_t* XB = (bf16_t*)(ws + WS_XB); bf16_t* Y = (bf16_t*)(ws + WS_Y); bf16_t* PB = (bf16_t*)(ws + WS_PB); bf16_t* ACT = (bf16_t*)(ws + WS_ACT); \
    const float2* cs64 = (const float2*)(ws + WS_CS64); const float2* cs32 = (const float2*)(ws + WS_CS32); \
    float* LRA = args.out; float* LRU_ = args.out + (size_t)M * 256; \
    float* LA = (float*)(ws + WS_LA); float* LH = (float*)(ws + WS_LH); float* CIN = (float*)(ws + WS_CIN); \
    float* KVC = (float*)(ws + WS_KVC); float* DEC = (float*)(ws + WS_DEC); float* SST = (float*)(ws + WS_SST); \
    bf16_t* MQ = (bf16_t*)(ws + WS_MQ); bf16_t* MKN = (bf16_t*)(ws + WS_MKN); bf16_t* MVT = (bf16_t*)(ws + WS_MV); bf16_t* MKR = (bf16_t*)(ws + WS_MKR); \
    bf16_t* VST = (bf16_t*)(ws + WS_VST); bf16_t* KSF = (bf16_t*)(ws + WS_KSF); (void)KSF; bf16_t* VWT = (bf16_t*)(ws + WS_VWT); bf16_t* KCMPB = (bf16_t*)(ws + WS_KCMPB); bf16_t* VCMPT = (bf16_t*)(ws + WS_VCMPT); \
    const float* ssq_mix = ssp_base + (size_t)(l_ == 0 ? 0 : 2) * 4 * M; float* ssq_out = ssp_base + (size_t)(1 + 3 * l_) * 4 * M; float* ssq_down = ssp_base + (size_t)(2 + 3 * l_) * 4 * M; float* ssq_d = ssp_base + (size_t)(3 + 3 * l_) * 4 * M; \
    (void)ctl; (void)hb; (void)XB; (void)Y; (void)PB; (void)ACT; (void)cs64; (void)cs32; (void)LRA; (void)LRU_; (void)LA; (void)LH; (void)CIN; (void)KVC; (void)DEC; (void)SST; (void)MQ; (void)MKN; (void)MVT; (void)MKR; (void)VST; (void)VWT; (void)KCMPB; (void)VCMPT; (void)ssq_mix; (void)ssq_out; (void)ssq_down; (void)ssq_d
    unsigned* ctl0 = (unsigned*)(args.ws + WS_CTL);
    { LAUNDER_TID(); if (tid < 16) LCTL[tid] = 0u; }
    __syncthreads();
    const int lo = args.ph_lo, hi = args.ph_hi;
    XcdBarrier bar; bar.bar = ctl0 + CW_BAR; bar.x = 0; bar.st = LCTL;
    if (hi - lo > 1) bar = xcd_barrier_post(ctl0 + CW_BAR, LCTL);
#define IN(k) (lo <= (k) && (k) < hi)
#define SEAM(k) do { if (IN(k) && IN((k) + 1)) xcd_barrier(bar); } while (0)

    if (IN(0)) {
        const int l_ = 0; WS_PTRS();
      _Pragma("unroll 1") for (int rep = 0; rep < REP_P0; ++rep) {
        LAUNDER_TID();
        const int gw = bid * 8 + wave, NGW = G * 8;
        LAS float* scr = ldsf + wave * 4224; LAS float* scr64 = scr;
        constexpr int I_IN = 16 * 36, I_OUT = 16 * 16, I_GU = 16 * 88, I_DN = 44 * 16, I_L = I_IN + I_OUT + I_GU + I_DN;
        for (int it = gw; it < 2 * I_L; it += NGW) {
            const int l = it / I_L; int r = it % I_L;
            if (r < I_IN) { p0_transpose_item64<0>(inp(args, 3) + (size_t)l * DM * NINS, DM, NINS, inp(args, 2) + l * DM, (bf16_t*)(ws + WS_WIN) + (size_t)l * NIN * DM, scr64, r / 36, r % 36, lane); continue; } r -= I_IN;
            if (r < I_OUT) { p0_transpose_item64<0, 768>(inp(args, 23) + (size_t)l * DM * DM, DM, DM, inp(args, 22) + l * DM, (bf16_t*)(ws + WS_WOUT) + (size_t)l * DM * DM, scr64, r / 16, r % 16, lane); continue; } r -= I_OUT;
            if (r < I_GU) { p0_transpose_item64<1>(inp(args, 25) + (size_t)l * DM * NGU, DM, NGU, inp(args, 24) + l * DM, (bf16_t*)(ws + WS_WGU) + (size_t)l * NGU * DM, scr64, r / 88, r % 88, lane); continue; } r -= I_GU;
            p0_transpose_item64<0>(inp(args, 26) + (size_t)l * FF * DM, FF, DM, nullptr, (bf16_t*)(ws + WS_WDN) + (size_t)l * DM * FF, scr64, r / 16, r % 16, lane);
        }
        { constexpr int I_UQ = 3 * 12, I_UKV = 2 * 16, I_W1 = 32 * 8, I_W2 = 4 * 2, I_S = 2 * I_UQ + 2 * I_UKV + 4 * I_W1 + 4 * I_W2;
          for (int it = gw; it < I_S; it += NGW) { int r = it;
              if (r < 2 * I_UQ) { const int l = r / I_UQ; r %= I_UQ; p0_transpose_item<0>(inp(args, 20) + (size_t)l * 192 * 384, 192, 384, inp(args, 18) + l * 192, (bf16_t*)(ws + WS_WUQT) + (size_t)l * 384 * 192, scr, r / 12, r % 12, lane); continue; } r -= 2 * I_UQ;
              if (r < 2 * I_UKV) { const int l = r / I_UKV; r %= I_UKV; p0_transpose_item<0>(inp(args, 21) + (size_t)l * 128 * 512, 128, 512, inp(args, 19) + l * 128, (bf16_t*)(ws + WS_WUKVT) + (size_t)l * 512 * 128, scr, r / 16, r % 16, lane); continue; } r -= 2 * I_UKV;
              if (r < 4 * I_W1) { const int lj = r / I_W1; r %= I_W1; p0_transpose_item<0>(inp(args, 12) + (size_t)lj * 2048 * 256, 2048, 256, nullptr, (bf16_t*)(ws + WS_W1T) + (size_t)lj * 256 * 2048, scr, r / 8, r % 8, lane); continue; } r -= 4 * I_W1;
              { const int lj = r / I_W2; r %= I_W2; p0_transpose_item<0>(inp(args, 14) + (size_t)lj * 256 * 64, 256, 64, nullptr, (bf16_t*)(ws + WS_W2T) + (size_t)lj * 64 * 256, scr, r / 2, r % 2, lane); } } }
        for (int e = bid * NTHR + tid; e < 2 * 2 * 4 * 64 * 64; e += G * NTHR) {
            const int k = e & 63, n = (e >> 6) & 63, h = (e >> 12) & 3, g = (e >> 14) & 1, l = e >> 15;
            ((bf16_t*)(ws + WS_WGT))[e] = f2bf((g == 0 ? inp(args, 6) : inp(args, 8))[(((size_t)l * 4 + h) * 64 + k) * 64 + n]); }
        for (int e = bid * NTHR + tid; e < 512; e += G * NTHR) ((float*)(ws + WS_SP))[e] = log1pf(expf(-inp(args, 10)[e]));
        for (int m = gw; m < M; m += NGW) {
            const f32x4* xr = (const f32x4*)(inp(args, 0) + (size_t)m * DM) + lane;
            f32x4 v[4]; float s = 0.f;
#pragma unroll
            for (int j = 0; j < 4; ++j) { v[j] = xr[64 * j]; s += v[j][0] * v[j][0] + v[j][1] * v[j][1] + v[j][2] * v[j][2] + v[j][3] * v[j][3]; }
            s = wave_sum(s);
            u32x2* o8 = (u32x2*)(XB + (size_t)m * DM) + lane;
#pragma unroll
            for (int j = 0; j < 4; ++j) { u32x2 w; w.x = pk2(v[j][0], v[j][1]); w.y = pk2(v[j][2], v[j][3]); o8[64 * j] = w; }
            if (lane < 4) ssp_base[(size_t)lane * M + m] = lane == 0 ? s : 0.f;
        }
        for (int e = bid * NTHR + tid; e < M * 32; e += G * NTHR) {
            const int m = e >> 5, i = e & 31; const float pos = (float)((const int*)inp(args, 1))[m];
            const float invf = __builtin_amdgcn_exp2f(-(float)(2 * i) * (13.287712379549449f / 64.f)); float sn, cs; { float rv = pos * invf * 0.15915494309189535f; rv -= floorf(rv); sn = __builtin_amdgcn_sinf(rv); cs = __builtin_amdgcn_cosf(rv); }
            ((float2*)(ws + WS_CS64))[e] = make_float2(cs, sn);
            if (i < 16) { const float invf2 = __builtin_amdgcn_exp2f(-(float)(2 * i) * (13.287712379549449f / 32.f)); float rv = pos * invf2 * 0.15915494309189535f; rv -= floorf(rv); sn = __builtin_amdgcn_sinf(rv); cs = __builtin_amdgcn_cosf(rv); ((float2*)(ws + WS_CS32))[m * 16 + i] = make_float2(cs, sn); }
        }
        for (int e = bid * NTHR + tid; e < 2 * 2 * 256; e += G * NTHR) {
            const int lj = e >> 8, c = e & 255; float a = inp(args, 13)[e];
            const float* pp = inp(args, 11) + (size_t)lj * 2048; const float* w1 = inp(args, 12) + (size_t)lj * 2048 * 256 + c;
            for (int i = 0; i < 2048; ++i) a += pp[i] * w1[(size_t)i * 256];
            hb[e] = a;
        }
      }
    }
    SEAM(0);

    for (int l = 0; l < 2; ++l) {
        const int pb = 1 + 6 * l;
        if (IN(pb)) {
        const int l_ = l; WS_PTRS();
            pg8::Gemm g{XB, (const bf16_t*)(ws + WS_WIN) + (size_t)l * NIN * DM, M, NIN, DM}; pg8::StaticOrder S; S.init(M, NIN, G, bid);
            pg8::EpiInProj E{PB, NIN, ssq_mix};
            _Pragma("unroll 1") for (int rep = 0; rep < REP_G16; ++rep) pg8::gemm_phase<pg8::EpiInProj, pg8::StaticOrder, true, true>(lds, g, S, E);
        }
        SEAM(pb);
        if (IN(pb + 1)) {
        const int l_ = l; WS_PTRS();
        LAUNDER_TID();
            constexpr int N_J1 = 1024, N_J2 = 512, N_J3 = 512, N_J4 = 512, N_J4B = 128;
            {
            for (int r_ = bid; r_ < N_J4B * REP_J4B; r_ += G) { const int r = r_ % N_J4B;
                    const int j = r & 1, g32 = (r >> 1) & 15, b = r >> 5; const int colb = j == 0 ? C_KC : C_VC; const int r32 = lane & 31, hi = lane >> 5;
                    LAS unsigned char* Tl = lds;
                    LAS unsigned char* Hl = lds + 69632;
                    for (int e = tid; e < 528 * 8; e += NTHR) { const int rr = e >> 3, c8 = e & 7, t = 512 * g32 + rr; u32x4 w = {0u, 0u, 0u, 0u};
                        if (t < SEQ) { const bf16_t* pr = PB + ((size_t)b * SEQ + t) * NIN + colb;
                            if (j == 0) { const u32x4 a = *(const u32x4*)(pr + 8 * (c8 & 3)), c = *(const u32x4*)(pr + 32 + 8 * (c8 & 3)); const float2* cs = cs64 + ((size_t)b * SEQ + t) * 32 + 8 * (c8 & 3);
                                const unsigned au[4] = {a.x, a.y, a.z, a.w}, cu[4] = {c.x, c.y, c.z, c.w}; unsigned ou[4];
#pragma unroll
                                for (int q = 0; q < 4; ++q) { const float2 s0 = cs[2 * q], s1 = cs[2 * q + 1]; const float x1a = bflo(au[q]), x1b = bfhi(au[q]), x2a = bflo(cu[q]), x2b = bfhi(cu[q]);
                                    ou[q] = c8 < 4 ? pk2(x1a * s0.x - x2a * s0.y, x1b * s1.x - x2b * s1.y) : pk2(x2a * s0.x + x1a * s0.y, x2b * s1.x + x1b * s1.y); }
                                w.x = ou[0]; w.y = ou[1]; w.z = ou[2]; w.w = ou[3]; }
                            else w = *(const u32x4*)(pr + 8 * c8); }
                        *(LAS u32x4*)(Tl + rr * 128 + (rr >> 4) * 16 + c8 * 16) = w; }
                    __syncthreads();
                    { const bf16_t* w1t = (const bf16_t*)(ws + WS_W1T) + ((size_t)(l * 2 + j) * 256 + 32 * wave + r32) * 2048 + 8 * hi;
                      f32x16 acc;
#pragma unroll
                      for (int i = 0; i < 16; ++i) acc[i] = 0.f;
#pragma unroll 8
                      for (int kk = 0; kk < 128; ++kk) { const int rowt = 16 * r32 + (kk >> 2);
                          const bf16x8 a = *(const LAS bf16x8*)(Tl + rowt * 128 + (rowt >> 4) * 16 + 32 * (kk & 3) + 16 * hi);
                          const bf16x8 bw = *(const bf16x8*)(w1t + 16 * kk);
                          acc = mfma32(a, bw, acc); }
                      const float hbv = hb[(l * 2 + j) * 256 + 32 * wave + r32];
#pragma unroll
                      for (int i = 0; i < 16; ++i) { const int n = (i & 3) + 8 * (i >> 2) + 4 * hi; *(LAS bf16_t*)(Hl + n * 528 + (32 * wave + r32) * 2) = f2bf(gelu_tanh(acc[i] + hbv)); } }
                    __syncthreads();
                    if (wave < 2) { const bf16_t* w2t = (const bf16_t*)(ws + WS_W2T) + ((size_t)(l * 2 + j) * 64 + 32 * wave + r32) * 256 + 8 * hi;
                      f32x16 acc;
#pragma unroll
                      for (int i = 0; i < 16; ++i) acc[i] = 0.f;
#pragma unroll
                      for (int kk = 0; kk < 16; ++kk) { const bf16x8 a = *(const LAS bf16x8*)(Hl + r32 * 528 + 32 * kk + 16 * hi); const bf16x8 bw = *(const bf16x8*)(w2t + 16 * kk); acc = mfma32(a, bw, acc); }
                      const int dd = 32 * wave + r32;
#pragma unroll
                      for (int g = 0; g < 4; ++g) { const int n0 = 32 * g32 + 8 * g + 4 * hi; float v[4];
#pragma unroll
                          for (int q = 0; q < 4; ++q) v[q] = (n0 + q < 511) ? acc[4 * g + q] : 0.f;
                          if (j == 0) {
#pragma unroll
                              for (int q = 0; q < 4; ++q) KCMPB[((size_t)b * 512 + n0 + q) * 64 + dd] = f2bf(v[q]); }
                          else { u32x2 w; w.x = pk2(v[0], v[1]); w.y = pk2(v[2], v[3]); *(u32x2*)(VCMPT + ((size_t)b * 64 + dd) * 512 + n0) = w; } } }
                    __syncthreads();
            }
            if (bid < N_J3) {
                const int fr = lane & 15, kq = lane >> 4, hh = wave >> 1, odd = wave & 1;
                {
                    bf16x8 bq[3][6];
                    { const bf16_t* wq = (const bf16_t*)(ws + WS_WUQT) + (size_t)l * 384 * 192;
#pragma unroll
                      for (int nt = 0; nt < 3; ++nt)
#pragma unroll
                          for (int ks = 0; ks < 6; ++ks) bq[nt][ks] = *(const bf16x8*)(wq + (size_t)(48 * wave + 16 * nt + fr) * 192 + 32 * ks + 8 * kq); }
                    for (int r_ = bid; r_ < N_J3 * REP_J3; r_ += G) { const int r = r_ % N_J3;
                        const size_t row0 = (size_t)r * 64;
#pragma unroll 1
                        for (int mt = 0; mt < 4; ++mt) {
                            const bf16_t* pa = PB + (row0 + mt * 16 + fr) * NIN;
                            bf16x8 aq[6]; float ssq_ = 0.f;
#pragma unroll
                            for (int ks = 0; ks < 6; ++ks) { aq[ks] = ld8x2(pa + C_DCQ + 32 * ks + 8 * kq);
#pragma unroll
                                for (int e = 0; e < 8; ++e) { const float v = bf2f((bf16_t)aq[ks][e]); ssq_ += v * v; } }
                            ssq_ += __shfl_xor(ssq_, 16); ssq_ += __shfl_xor(ssq_, 32);
                            const float rq_ = rsqrtf(ssq_ * (1.f / 192.f) + EPS);
                            f32x4 cq[3];
#pragma unroll
                            for (int nt = 0; nt < 3; ++nt) { cq[nt] = (f32x4){0.f, 0.f, 0.f, 0.f};
#pragma unroll
                                for (int ks = 0; ks < 6; ++ks) cq[nt] = __builtin_amdgcn_mfma_f32_16x16x32_bf16(aq[ks], bq[nt][ks], cq[nt], 0, 0, 0); }
                            const float SCQ = 0.10206207261596575f * LOG2E;
#pragma unroll
                            for (int i = 0; i < 4; ++i) {
                                const size_t row = row0 + mt * 16 + 4 * kq + i; const float rqi = __shfl(rq_, 4 * kq + i) * SCQ;
                                float q0 = cq[0][i] * rqi, q1 = cq[1][i] * rqi, q2 = cq[2][i] * rqi;
                                if (odd) { const float2 cs = cs32[row * 16 + fr]; const float x1 = q1, x2 = q2; q1 = x1 * cs.x - x2 * cs.y; q2 = x2 * cs.x + x1 * cs.y; }
                                bf16_t* mq = MQ + row * 384 + hh * 96 + 48 * odd + fr; mq[0] = f2bf(q0); mq[16] = f2bf(q1); mq[32] = f2bf(q2);
                            }
                            if (wave == mt) {
#pragma unroll
                                for (int q = 0; q < 4; ++q) { const int p = lane * 4 + q, tok = p >> 4, i = p & 15; const size_t row = row0 + mt * 16 + tok; const bf16_t* pr = PB + row * NIN + C_DKR;
                                    const float x1 = bf2f(pr[i]), x2 = bf2f(pr[16 + i]); const float2 cs = cs32[row * 16 + i];
                                    MKR[row * 32 + i] = f2bf(x1 * cs.x - x2 * cs.y); MKR[row * 32 + 16 + i] = f2bf(x2 * cs.x + x1 * cs.y); } }
                        }
                    }
                }
                {
                    bf16x8 bkv[4][4];
                    { const bf16_t* wkv = (const bf16_t*)(ws + WS_WUKVT) + (size_t)l * 512 * 128;
#pragma unroll
                      for (int nt = 0; nt < 4; ++nt)
#pragma unroll
                          for (int ks = 0; ks < 4; ++ks) bkv[nt][ks] = *(const bf16x8*)(wkv + (size_t)(64 * wave + 16 * nt + fr) * 128 + 32 * ks + 8 * kq); }
                    for (int r_ = bid; r_ < N_J3 * REP_J3; r_ += G) { const int r = r_ % N_J3;
                        const size_t row0 = (size_t)r * 64; const size_t bb = row0 / SEQ, t0 = row0 % SEQ;
#pragma unroll 1
                        for (int mt = 0; mt < 4; ++mt) {
                            const bf16_t* pa = PB + (row0 + mt * 16 + fr) * NIN;
                            bf16x8 akv[4]; float sskv_ = 0.f;
#pragma unroll
                            for (int ks = 0; ks < 4; ++ks) { akv[ks] = ld8x2(pa + C_DCKV + 32 * ks + 8 * kq);
#pragma unroll
                                for (int e = 0; e < 8; ++e) { const float v = bf2f((bf16_t)akv[ks][e]); sskv_ += v * v; } }
                            sskv_ += __shfl_xor(sskv_, 16); sskv_ += __shfl_xor(sskv_, 32);
                            const float rk_ = rsqrtf(sskv_ * (1.f / 128.f) + EPS);
                            f32x4 ckv[4];
#pragma unroll
                            for (int nt = 0; nt < 4; ++nt) { ckv[nt] = (f32x4){0.f, 0.f, 0.f, 0.f};
#pragma unroll
                                for (int ks = 0; ks < 4; ++ks) ckv[nt] = __builtin_amdgcn_mfma_f32_16x16x32_bf16(akv[ks], bkv[nt][ks], ckv[nt], 0, 0, 0); }
                            float rki[4];
#pragma unroll
                            for (int i = 0; i < 4; ++i) rki[i] = __shfl(rk_, 4 * kq + i);
                            if (!odd) {
#pragma unroll
                                for (int i = 0; i < 4; ++i) { bf16_t* mk = MKN + (row0 + mt * 16 + 4 * kq + i) * 256 + hh * 64 + fr;
                                    mk[0] = f2bf(ckv[0][i] * rki[i]); mk[16] = f2bf(ckv[1][i] * rki[i]); mk[32] = f2bf(ckv[2][i] * rki[i]); mk[48] = f2bf(ckv[3][i] * rki[i]); } }
                            else {
#pragma unroll
                                for (int nt = 0; nt < 4; ++nt) { u32x2 w; w.x = pk2(ckv[nt][0] * rki[0], ckv[nt][1] * rki[1]); w.y = pk2(ckv[nt][2] * rki[2], ckv[nt][3] * rki[3]);
                                    *(u32x2*)(MVT + ((bb * 4 + hh) * 64 + 16 * nt + fr) * SEQ + t0 + mt * 16 + 4 * kq) = w; } }
                        }
                    }
                }
            }
            {
                const int r32 = lane & 31, hi = lane >> 5, gh = wave >> 1, gg = wave & 1, ch = tid & 255, half = tid >> 8;
                bf16x8 bW[2][4];
                { const bf16_t* wt = (const bf16_t*)(ws + WS_WGT) + (size_t)(((l * 2 + gg) * 4 + gh) * 64) * 64;
#pragma unroll
                  for (int nt = 0; nt < 2; ++nt)
#pragma unroll
                      for (int ks = 0; ks < 4; ++ks) bW[nt][ks] = *(const bf16x8*)(wt + (size_t)(32 * nt + r32) * 64 + 16 * ks + 8 * hi); }
                const float gbias0 = (gg == 0 ? inp(args, 7) : inp(args, 9))[l * 256 + gh * 64 + r32], gbias1 = (gg == 0 ? inp(args, 7) : inp(args, 9))[l * 256 + gh * 64 + 32 + r32];
                const float cw0 = inp(args, 4)[(l * 4 + 0) * 256 + ch], cw1 = inp(args, 4)[(l * 4 + 1) * 256 + ch], cw2 = inp(args, 4)[(l * 4 + 2) * 256 + ch], cw3 = inp(args, 4)[(l * 4 + 3) * 256 + ch], cb = inp(args, 5)[l * 256 + ch];
                const float sp = ((const float*)(ws + WS_SP))[l * 256 + ch];
                LAS float* xa = ldsf; LAS float* xc = ldsf + 35 * 256; LAS unsigned char* xcb = lds + 67 * 1024; LAS float* gR = (LAS float*)(lds + 67 * 1024 + 32 * 528); LAS float* gI = gR + 32 * 256;
            for (int r_ = bid; r_ < N_J1 * REP_J1; r_ += G) { const int r = r_ % N_J1;
                    const int b = r >> 8, tb = r & 255, t0 = tb * 32;
                    for (int c = tid; c < 35 * 32; c += NTHR) { const int rr = c >> 5, c8 = c & 31, t = t0 - 3 + rr; u32x4 w = {0u, 0u, 0u, 0u}; if (t >= 0) w = *(const u32x4*)(PB + ((size_t)b * SEQ + t) * NIN + C_AX + 8 * c8);
                        LAS f32x4* d = (LAS f32x4*)(xa + rr * 256 + 8 * c8); d[0] = (f32x4){bflo(w.x), bfhi(w.x), bflo(w.y), bfhi(w.y)}; d[1] = (f32x4){bflo(w.z), bfhi(w.z), bflo(w.w), bfhi(w.w)}; }
                    __syncthreads();
#pragma unroll 4
                    for (int tt = 0; tt < 16; ++tt) { const int rr = half * 16 + tt; const float v = cb + cw0 * xa[rr * 256 + ch] + cw1 * xa[(rr + 1) * 256 + ch] + cw2 * xa[(rr + 2) * 256 + ch] + cw3 * xa[(rr + 3) * 256 + ch];
                        xc[rr * 256 + ch] = v; *(LAS bf16_t*)(xcb + rr * 528 + ch * 2) = f2bf(v); }
                    __syncthreads();
                    { f32x16 acc[2];
#pragma unroll
                      for (int i = 0; i < 16; ++i) { acc[0][i] = 0.f; acc[1][i] = 0.f; }
#pragma unroll
                      for (int ks = 0; ks < 4; ++ks) { const bf16x8 a = *(const LAS bf16x8*)(xcb + r32 * 528 + (gh * 64 + 16 * ks + 8 * hi) * 2); acc[0] = mfma32(a, bW[0][ks], acc[0]); acc[1] = mfma32(a, bW[1][ks], acc[1]); }
                      LAS float* gd = gg == 0 ? gR : gI;
#pragma unroll
                      for (int i = 0; i < 16; ++i) { const int tok = (i & 3) + 8 * (i >> 2) + 4 * hi; gd[tok * 256 + gh * 64 + r32] = sigmoidf_(acc[0][i] + gbias0); gd[tok * 256 + gh * 64 + 32 + r32] = sigmoidf_(acc[1][i] + gbias1); } }
                    __syncthreads();
                    float hst = 0.f, Ac = 1.f;
#pragma unroll 4
                    for (int tt = 0; tt < 16; ++tt) {
                        const int rr = half * 16 + tt;
                        const float la = -8.f * gR[rr * 256 + ch] * sp, x2 = 2.f * la;
                        const float av = la > -0.25f ? 1.f + la * (1.f + la * (0.5f + la * (0.16666667f + la * (0.041666667f + la * 0.0083333333f)))) : __expf(la);
                        const float om = x2 > -0.5f ? -x2 * (1.f + x2 * (0.5f + x2 * (0.16666667f + x2 * (0.041666667f + x2 * (0.0083333333f + x2 * 0.0013888889f))))) : 1.f - __expf(x2);
                        const float u = __builtin_amdgcn_sqrtf(om) * (gI[rr * 256 + ch] * xc[rr * 256 + ch]);
                        hst = av * hst + u; Ac *= av;
                        { const size_t ao = ((size_t)b * SEQ + t0 + rr) * 256 + ch; LRA[ao] = av; LRU_[ao] = u; }
                    }
                    const size_t so = ((size_t)(b * 512 + tb * 2 + half)) * 256 + ch;
                    LA[so] = Ac; LH[so] = hst;
                    __syncthreads();
            }
            }
            {
                const int kk = tid & 127, tq = tid >> 7, r32 = lane & 31, hi = lane >> 5;
                float wg[16]; const float bg = inp(args, 16)[l * 128 + kk];
#pragma unroll
                for (int q = 0; q < 16; ++q) wg[q] = inp(args, 15)[(l * 16 + q) * 128 + kk];
                LAS float* glr = ldsf; LAS float* tot = ldsf + 1024; LAS unsigned char* KTl = lds + 8192; LAS unsigned char* VTl = lds + 8192 + 128 * VSTR;
                float* BCS = (float*)(ws + WS_BCS);
            for (int r_ = bid; r_ < N_J2 * REP_J2; r_ += G) { const int r = r_ % N_J2;
                    const int b = r >> 7, c = r & 127; const size_t row0 = (size_t)b * SEQ + 64 * c;
                    for (int e = tid; e < 1024; e += NTHR) glr[e] = bf2f(PB[(row0 + (e >> 4)) * NIN + C_GLR + (e & 15)]);
                    for (int e = tid; e < 2048; e += NTHR) { const int jj = e >> 5, hc = e & 31; const bf16_t* vsrc = PB + (row0 + jj) * NIN + C_CV + 8 * hc; const u32x2 wA = *(const u32x2*)vsrc, wB = *(const u32x2*)(vsrc + 4);
                        LAS bf16_t* d = (LAS bf16_t*)(VTl + (8 * hc) * VSTR) + jj;
                        d[0] = (bf16_t)wA.x; d[VSTR / 2] = (bf16_t)(wA.x >> 16); d[2 * (VSTR / 2)] = (bf16_t)wA.y; d[3 * (VSTR / 2)] = (bf16_t)(wA.y >> 16); d[4 * (VSTR / 2)] = (bf16_t)wB.x; d[5 * (VSTR / 2)] = (bf16_t)(wB.x >> 16); d[6 * (VSTR / 2)] = (bf16_t)wB.y; d[7 * (VSTR / 2)] = (bf16_t)(wB.y >> 16); }
                    __syncthreads();
                    float bv[16]; float run = 0.f;
#pragma unroll
                    for (int tt = 0; tt < 16; ++tt) { const LAS f32x4* g4 = (const LAS f32x4*)(glr + (16 * tq + tt) * 16); float z = bg;
#pragma unroll
                        for (int q = 0; q < 4; ++q) { const f32x4 g = g4[q]; z += g[0] * wg[4 * q] + g[1] * wg[4 * q + 1] + g[2] * wg[4 * q + 2] + g[3] * wg[4 * q + 3]; }
                        run += (fminf(z, 0.f) - __logf(1.f + __expf(-fabsf(z)))) * (1.f / 16.f); bv[tt] = run; }
                    tot[tq * 128 + kk] = run;
                    __syncthreads();
                    { const float t0_ = tot[kk], t1_ = tot[128 + kk], t2_ = tot[256 + kk], t3_ = tot[384 + kk]; const float off = tq == 0 ? 0.f : (tq == 1 ? t0_ : (tq == 2 ? t0_ + t1_ : (t0_ + t1_) + t2_)), blast = ((t0_ + t1_) + t2_) + t3_;
#pragma unroll
                      for (int tt = 0; tt < 16; ++tt) { const int t = 16 * tq + tt; const float bt = bv[tt] + off; BCS[(row0 + t) * 128 + kk] = bt;
                          *((LAS bf16_t*)(KTl + kk * VSTR) + t) = f2bf(bf2f(PB[(row0 + t) * NIN + C_CK + kk]) * __expf(blast - bt)); }
                      if (tq == 0) DEC[(size_t)(b * 128 + c) * 128 + kk] = __expf(blast); }
                    __syncthreads();
                    { const int h = wave >> 1, nt = wave & 1; f32x16 acc;
#pragma unroll
                      for (int i = 0; i < 16; ++i) acc[i] = 0.f;
                      const LAS unsigned char* ap = KTl + (h * 32 + r32) * VSTR + 16 * hi; const LAS unsigned char* bp = VTl + (h * 64 + 32 * nt + r32) * VSTR + 16 * hi;
#pragma unroll
                      for (int s = 0; s < 4; ++s) { const u32x2 a0 = *(const LAS u32x2*)(ap + 32 * s), a1 = *(const LAS u32x2*)(ap + 32 * s + 8), b0 = *(const LAS u32x2*)(bp + 32 * s), b1 = *(const LAS u32x2*)(bp + 32 * s + 8);
                          u32x4 aw, bw; aw.x = a0.x; aw.y = a0.y; aw.z = a1.x; aw.w = a1.y; bw.x = b0.x; bw.y = b0.y; bw.z = b1.x; bw.w = b1.y;
                          acc = mfma32(__builtin_bit_cast(bf16x8, aw), __builtin_bit_cast(bf16x8, bw), acc); }
                      float* o = KVC + ((size_t)(b * 128 + c) * 4 + h) * 2048 + 32 * nt + r32;
#pragma unroll
                      for (int i = 0; i < 16; ++i) o[((i & 3) + 8 * (i >> 2) + 4 * hi) * 64] = acc[i]; }
                    __syncthreads();
            }
            }
            for (int r = bid; r < N_J4; r += G) {
                    const size_t row0 = (size_t)r * 64;
#pragma unroll
                    for (int it3 = 0; it3 < 3; ++it3) {
                        const int e = tid + it3 * NTHR, tok = e / 24, p = e % 24, hd = p >> 2, c8 = p & 3; const int base = hd < 4 ? C_BQ + hd * 64 : (hd == 4 ? C_KS : C_KW); const float sc = hd < 4 ? 0.125f * LOG2E : 1.f;
                        bf16_t* pr = PB + (row0 + tok) * NIN + base + 8 * c8; const u32x4 a = *(const u32x4*)pr, c = *(const u32x4*)(pr + 32); const float2* cs = cs64 + (row0 + tok) * 32 + 8 * c8;
                        const unsigned au[4] = {a.x, a.y, a.z, a.w}, cu[4] = {c.x, c.y, c.z, c.w}; unsigned o1[4], o2[4];
#pragma unroll
                        for (int q = 0; q < 4; ++q) { const float2 s0 = cs[2 * q], s1 = cs[2 * q + 1]; const float x1a = bflo(au[q]), x1b = bfhi(au[q]), x2a = bflo(cu[q]), x2b = bfhi(cu[q]);
                            o1[q] = pk2((x1a * s0.x - x2a * s0.y) * sc, (x1b * s1.x - x2b * s1.y) * sc); o2[q] = pk2((x2a * s0.x + x1a * s0.y) * sc, (x2b * s1.x + x1b * s1.y) * sc); }
                        u32x4 w1, w2; w1.x = o1[0]; w1.y = o1[1]; w1.z = o1[2]; w1.w = o1[3]; w2.x = o2[0]; w2.y = o2[1]; w2.z = o2[2]; w2.w = o2[3];
                        *(u32x4*)pr = w1; *(u32x4*)(pr + 32) = w2;
                        if (hd == 4) {
                            bf16_t* kf_ = KSF + (row0 / 64) * 4096 + (size_t)((((tok >> 5) * 4 + (c8 >> 1)) * 64 + (c8 & 1) * 32 + (tok & 31)) * 8); *(u32x4*)kf_ = w1; *(u32x4*)(kf_ + 2 * 64 * 8) = w2; } }
                    { LAS bf16_t* tl = (LAS bf16_t*)lds; const size_t bb = row0 / SEQ, t0 = row0 % SEQ;
                      for (int mtx = 0; mtx < 2; ++mtx) { const int tok = tid >> 3, c = tid & 7; const u32x4 w = *(const u32x4*)(PB + (row0 + tok) * NIN + (mtx ? C_VW : C_VS) + c * 8);
                          LAS bf16_t* dst = tl + mtx * 64 * 72 + tok * 72 + c * 8; dst[0] = (bf16_t)w.x; dst[1] = (bf16_t)(w.x >> 16); dst[2] = (bf16_t)w.y; dst[3] = (bf16_t)(w.y >> 16); dst[4] = (bf16_t)w.z; dst[5] = (bf16_t)(w.z >> 16); dst[6] = (bf16_t)w.w; dst[7] = (bf16_t)(w.w >> 16); }
                      __syncthreads();
                      for (int mtx = 0; mtx < 2; ++mtx) { const int d = tid >> 3, c8 = tid & 7; const LAS bf16_t* s = tl + mtx * 64 * 72 + (c8 * 8) * 72 + d;
                          u32x4 w; w.x = (unsigned)s[0] | ((unsigned)s[72] << 16); w.y = (unsigned)s[2 * 72] | ((unsigned)s[3 * 72] << 16); w.z = (unsigned)s[4 * 72] | ((unsigned)s[5 * 72] << 16); w.w = (unsigned)s[6 * 72] | ((unsigned)s[7 * 72] << 16);
                          if (mtx) *(u32x4*)(VWT + (bb * 64 + d) * SEQ + t0 + c8 * 8) = w;
                          else { const int s_ = c8 >> 1, h_ = c8 & 1; const LAS bf16_t* q = tl + (16 * s_ + 4 * h_) * 72 + d;
                              u32x4 f; f.x = (unsigned)q[0] | ((unsigned)q[72] << 16); f.y = (unsigned)q[2 * 72] | ((unsigned)q[3 * 72] << 16); f.z = (unsigned)q[8 * 72] | ((unsigned)q[9 * 72] << 16); f.w = (unsigned)q[10 * 72] | ((unsigned)q[11 * 72] << 16);
                              *(u32x4*)(VST + (row0 / 64) * 4096 + (size_t)((((d >> 5) * 4 + s_) * 64 + h_ * 32 + (d & 31)) * 8)) = f; } }
                      __syncthreads(); }
            }
            }
        }
        SEAM(pb + 1);
        if (IN(pb + 2)) {
        const int l_ = l; WS_PTRS();
        LAUNDER_TID();
            constexpr int Q_J5 = 2, Q_J6 = 64, Q_ATT = 1024 * REP_ATT, Q_J9 = 1024, Q_J10 = 512, Q_TOT = Q_J5 + Q_J6 + Q_ATT + Q_J9 + Q_J10;
            if (tid == 0) { LCTL[4] = 0u; LCTL[5] = 0u; }
            __syncthreads();
            const int tid_o = tid;
            for (;;) {
                int tid = tid_o; asm volatile("" : "+v"(tid)); const int lane = tid & 63;
                if (tid == 0) LCTL[2] = __hip_atomic_fetch_add(ctl + CW_QUEUE + 64 * l, 1u, __ATOMIC_RELAXED, __HIP_MEMORY_SCOPE_AGENT);
                __syncthreads();
                int r = __builtin_amdgcn_readfirstlane((int)LCTL[2]); const unsigned seen5 = LCTL[4], seen6 = LCTL[5];
                __syncthreads();
                if (r >= Q_TOT * REP_P3) break;
                if (REP_P3 > 1 && r >= Q_TOT) r -= Q_TOT;
                if (r < Q_J5) {
                    const int e = r * NTHR + tid, b = e >> 8, ch = e & 255; float carry = 0.f;
                    for (int c0 = 0; c0 < 512; c0 += 8) { float av[8], hv[8];
#pragma unroll
                        for (int q = 0; q < 8; ++q) { const size_t so = ((size_t)(b * 512 + c0 + q)) * 256 + ch; av[q] = LA[so]; hv[q] = LH[so]; }
#pragma unroll
                        for (int q = 0; q < 8; ++q) { CIN[((size_t)(b * 512 + c0 + q)) * 256 + ch] = carry; carry = av[q] * carry + hv[q]; } }
                    asm volatile("s_waitcnt vmcnt(0)" ::: "memory"); __syncthreads();
                    if (tid == 0) { __builtin_amdgcn_fence(__ATOMIC_RELEASE, "agent"); asm volatile("s_waitcnt vmcnt(0)" ::: "memory"); (void)xb_add(ctl + CW_FLAG + 64 * (2 * l + 0), 1u); }
                    continue;
                }
                r -= Q_J5;
                if (r < Q_J6) {
                    const int e = r * NTHR + tid, b = e >> 13, rem = e & 8191; float Sv = 0.f;
                    for (int c0 = 0; c0 < 128; c0 += 8) { float kv[8], dv[8];
#pragma unroll
                        for (int q = 0; q < 8; ++q) { kv[q] = KVC[(size_t)(b * 128 + c0 + q) * 8192 + rem]; dv[q] = DEC[(size_t)(b * 128 + c0 + q) * 128 + (rem >> 6)]; }
#pragma unroll
                        for (int q = 0; q < 8; ++q) { SST[(size_t)(b * 128 + c0 + q) * 8192 + rem] = Sv; Sv = dv[q] * Sv + kv[q]; } }
                    asm volatile("s_waitcnt vmcnt(0)" ::: "memory"); __syncthreads();
                    if (tid == 0) { __builtin_amdgcn_fence(__ATOMIC_RELEASE, "agent"); asm volatile("s_waitcnt vmcnt(0)" ::: "memory"); (void)xb_add(ctl + CW_FLAG + 64 * (2 * l + 1), 1u); }
                    continue;
                }
                r -= Q_J6;
                if (r >= Q_ATT) {
                    r -= Q_ATT; const bool is9 = r < Q_J9;
                    if (!(is9 ? seen5 : seen6)) {
                        if (tid == 0) { unsigned* f = ctl + CW_FLAG + 64 * (2 * l + (is9 ? 0 : 1)); const unsigned target = is9 ? (unsigned)Q_J5 : (unsigned)Q_J6;
                            XB_SPIN(xb_ld(f) < target, ctl + CW_BAR); __builtin_amdgcn_fence(__ATOMIC_ACQUIRE, "agent"); asm volatile("s_waitcnt vmcnt(0)" ::: "memory"); LCTL[is9 ? 4 : 5] = 1u; }
                        __syncthreads(); }
                    if (is9) {
                    const int b = r >> 8, tb = r & 255, t0 = tb * 32, ch = tid & 255, half = tid >> 8;
                    LAS float* xa = ldsf;
                    float hst = CIN[((size_t)(b * 512 + tb * 2 + half)) * 256 + ch];
                    { float av[16], uv[16], gv[16];
#pragma unroll
                      for (int tt = 0; tt < 16; ++tt) { const size_t ro = (size_t)b * SEQ + t0 + half * 16 + tt; av[tt] = LRA[ro * 256 + ch]; uv[tt] = LRU_[ro * 256 + ch]; gv[tt] = bf2f(PB[ro * NIN + C_AG + ch]); }
#pragma unroll
                      for (int tt = 0; tt < 16; ++tt) { hst = av[tt] * hst + uv[tt]; xa[(half * 16 + tt) * 256 + ch] = hst * gelu_tanh(gv[tt]); } }
                    __syncthreads();
                    for (int q = 0; q < 4; ++q) { const int rr = wave * 4 + q; const f32x4 v = ((const LAS f32x4*)(xa + rr * 256))[lane];
                        const float rinv = rsqrtf(wave_sum(v[0] * v[0] + v[1] * v[1] + v[2] * v[2] + v[3] * v[3]) * (1.f / 256.f) + EPS);
                        u32x2 w; w.x = pk2(v[0] * rinv, v[1] * rinv); w.y = pk2(v[2] * rinv, v[3] * rinv);
                        *(u32x2*)(Y + ((size_t)b * SEQ + t0 + rr) * DM + 256 + 4 * lane) = w; }
                    __syncthreads();
                    } else { r -= Q_J9;
                    const int b = r >> 7, c = r & 127; const size_t row0 = (size_t)b * SEQ + 64 * c;
                    LAS float* bL = ldsf; LAS float* glr = ldsf + 8192; LAS unsigned char* VTl = lds + 36864; LAS unsigned char* STl = lds + 71680; LAS float* SSX = (LAS float*)(lds + 92160);
                    for (int e = tid; e < 2048; e += NTHR) ((LAS f32x4*)bL)[e] = ((const f32x4*)((const float*)(ws + WS_BCS) + row0 * 128))[e];
                    for (int e = tid; e < 2048; e += NTHR) { const int jj = e >> 5, hc = e & 31, h = hc >> 3, c8 = hc & 7; const bf16_t* vsrc = PB + (row0 + jj) * NIN + C_CV + h * 64 + 8 * c8; const u32x2 wA = *(const u32x2*)vsrc, wB = *(const u32x2*)(vsrc + 4); u32x4 w; w.x = wA.x; w.y = wA.y; w.z = wB.x; w.w = wB.y;
                        LAS bf16_t* d = (LAS bf16_t*)(VTl + h * 8704 + (8 * c8) * VSTR) + jj;
                        d[0] = (bf16_t)w.x; d[VSTR / 2] = (bf16_t)(w.x >> 16); d[2 * (VSTR / 2)] = (bf16_t)w.y; d[3 * (VSTR / 2)] = (bf16_t)(w.y >> 16); d[4 * (VSTR / 2)] = (bf16_t)w.z; d[5 * (VSTR / 2)] = (bf16_t)(w.z >> 16); d[6 * (VSTR / 2)] = (bf16_t)w.w; d[7 * (VSTR / 2)] = (bf16_t)(w.w >> 16); }
                    for (int e = tid; e < 8192; e += NTHR) { const int h = e >> 11, k = (e >> 6) & 31, v = e & 63; *(LAS bf16_t*)(STl + h * 5120 + v * 80 + k * 2) = f2bf(SST[(size_t)(b * 128 + c) * 8192 + e]); }
                    __syncthreads();
                    { const int r32 = lane & 31, hi = lane >> 5, h = wave >> 1, ih = wave & 1, i = 32 * ih + r32; const float SCG = 0.17677669529663687f;
                      bf16x8 qrel[2], qabs[2], kt[2][2];
#pragma unroll
                      for (int ks = 0; ks < 2; ++ks) { const int k0 = h * 32 + 16 * ks + 8 * hi; const bf16x8 qv = ld8x2(PB + (row0 + i) * NIN + C_CQ + k0); u32x4 wr_, wa_; unsigned* pr_ = (unsigned*)&wr_; unsigned* pa_ = (unsigned*)&wa_;
#pragma unroll
                          for (int e2 = 0; e2 < 4; ++e2) { const float b0 = bL[i * 128 + k0 + 2 * e2], b1 = bL[i * 128 + k0 + 2 * e2 + 1], f0 = bL[31 * 128 + k0 + 2 * e2], f1 = bL[31 * 128 + k0 + 2 * e2 + 1];
                              const float q0 = bf2f((bf16_t)qv[2 * e2]) * SCG, q1 = bf2f((bf16_t)qv[2 * e2 + 1]) * SCG;
                              pr_[e2] = cvtpk(q0 * __expf(b0 - f0), q1 * __expf(b1 - f1)); pa_[e2] = cvtpk(q0 * __expf(b0), q1 * __expf(b1)); }
                          qrel[ks] = __builtin_bit_cast(bf16x8, wr_); qabs[ks] = __builtin_bit_cast(bf16x8, wa_); }
#pragma unroll
                      for (int jt = 0; jt < 2; ++jt)
#pragma unroll
                          for (int ks = 0; ks < 2; ++ks) { const int jr = 32 * jt + r32, k0 = h * 32 + 16 * ks + 8 * hi; const bf16x8 kv = ld8x2(PB + (row0 + jr) * NIN + C_CK + k0); u32x4 wk_; unsigned* pk_ = (unsigned*)&wk_;
#pragma unroll
                              for (int e2 = 0; e2 < 4; ++e2) { const float b0 = bL[jr * 128 + k0 + 2 * e2], b1 = bL[jr * 128 + k0 + 2 * e2 + 1], f0 = bL[31 * 128 + k0 + 2 * e2], f1 = bL[31 * 128 + k0 + 2 * e2 + 1];
                                  pk_[e2] = cvtpk(bf2f((bf16_t)kv[2 * e2]) * __expf(f0 - b0), bf2f((bf16_t)kv[2 * e2 + 1]) * __expf(f1 - b1)); }
                              kt[jt][ks] = __builtin_bit_cast(bf16x8, wk_); }
                      f32x16 o[2], s[2];
#pragma unroll
                      for (int q = 0; q < 16; ++q) { o[0][q] = 0.f; o[1][q] = 0.f; s[0][q] = 0.f; s[1][q] = 0.f; }
#pragma unroll
                      for (int ks = 0; ks < 2; ++ks) s[0] = mfma32(kt[0][ks], qrel[ks], s[0]);
                      if (ih) {
#pragma unroll
                          for (int ks = 0; ks < 2; ++ks) s[1] = mfma32(kt[1][ks], qrel[ks], s[1]); }
#pragma unroll
                      for (int q = 0; q < 16; ++q) { const int jr = (q & 3) + 8 * (q >> 2) + 4 * hi; if (jr > r32) { if (ih) s[1][q] = 0.f; else s[0][q] = 0.f; } }
                      const LAS unsigned char* VTh = VTl + h * 8704; const LAS unsigned char* STh = STl + h * 5120;
#pragma unroll
                      for (int dt = 0; dt < 2; ++dt) { const LAS unsigned char* vp = VTh + (32 * dt + r32) * VSTR + 8 * hi;
                          o[dt] = mfma32(vfrag(vp), pack8<0>(s[0]), o[dt]); o[dt] = mfma32(vfrag(vp + 32), pack8<8>(s[0]), o[dt]);
                          if (ih) { o[dt] = mfma32(vfrag(vp + 64), pack8<0>(s[1]), o[dt]); o[dt] = mfma32(vfrag(vp + 96), pack8<8>(s[1]), o[dt]); }
#pragma unroll
                          for (int ks = 0; ks < 2; ++ks) o[dt] = mfma32(*(const LAS bf16x8*)(STh + (32 * dt + r32) * 80 + 32 * ks + 16 * hi), qabs[ks], o[dt]); }
                      float ssh = 0.f;
#pragma unroll
                      for (int q = 0; q < 16; ++q) ssh += o[0][q] * o[0][q] + o[1][q] * o[1][q];
                      const float rh = rsqrtf(xhalf_sum(ssh) * (1.f / 64.f) + EPS); float ssg = 0.f;
#pragma unroll
                      for (int dt = 0; dt < 2; ++dt)
#pragma unroll
                          for (int g = 0; g < 4; ++g) { const int v0 = 32 * dt + 8 * g + 4 * hi; const u32x2 ogw = *(const u32x2*)(PB + (row0 + i) * NIN + C_OG + h * 64 + v0); const f32x4 gn = *(const f32x4*)(inp(args, 17) + l * 64 + v0);
                              const float og4[4] = {bflo(ogw.x), bfhi(ogw.x), bflo(ogw.y), bfhi(ogw.y)};
#pragma unroll
                              for (int q = 0; q < 4; ++q) { const float y = o[dt][4 * g + q] * rh * gn[q] * (og4[q] * sigmoidf_(og4[q])); o[dt][4 * g + q] = y; ssg += y * y; } }
                      ssg = xhalf_sum(ssg); if (hi == 0) SSX[i * 4 + h] = ssg;
                      __syncthreads();
                      const f32x4 s4 = *(const LAS f32x4*)(SSX + i * 4); const float rinv = rsqrtf((s4[0] + s4[1] + s4[2] + s4[3]) * (1.f / 256.f) + EPS);
#pragma unroll
                      for (int dt = 0; dt < 2; ++dt)
#pragma unroll
                          for (int g = 0; g < 4; ++g) { u32x2 w; w.x = cvtpk(o[dt][4 * g] * rinv, o[dt][4 * g + 1] * rinv); w.y = cvtpk(o[dt][4 * g + 2] * rinv, o[dt][4 * g + 3] * rinv);
                              *(u32x2*)(Y + (row0 + i) * DM + 768 + h * 64 + 32 * dt + 8 * g + 4 * hi) = w; } }
                    __syncthreads();
                    }
                    continue;
                }
                const int r32 = lane & 31, hi = lane >> 5;
                const int rep = r >> 10; r &= 1023;
                const int grp = r >> 5, within = r & 31;
                if (rep && ((REP_ONLY == 1 && within >= 16) || (REP_ONLY == 2 && within < 16))) continue;
              {
                if (within >= 16) {
                    const int idx = within - 16, b = idx & 3, tb = 127 - (4 * grp + (idx >> 2));
                    const int tl = 8 * wave + (r32 >> 2), head = r32 & 3, T = 64 * tb + tl; const size_t row = (size_t)b * SEQ + T; const bf16_t* prow = PB + row * NIN;
                    bf16x8 qf[4];
#pragma unroll
                    for (int ks = 0; ks < 4; ++ks) qf[ks] = *(const bf16x8*)(prow + C_BQ + head * 64 + 16 * ks + 8 * hi);
                    LAS float* impb = (LAS float*)(lds + AL_IMP) + wave * 1024; LAS unsigned* selm = (LAS unsigned*)(lds + AL_SELM) + wave * 32;
                    const int skey = tid >> 3, sch = tid & 7;
                    const unsigned koffP = (unsigned)(skey * NIN + sch * 8), voffS = (unsigned)(skey * SEQ + sch * 8), koffC = (unsigned)(skey * 64 + sch * 8), voffC = (unsigned)(skey * 512 + sch * 8);
                    auto stK = [&](int buf, const StageRegs& R) __attribute__((always_inline)) { *(LAS u32x4*)(lds + (buf ? AL_K1 : AL_K0) + skey * KSTR + sch * 16) = R.a; };
                    auto stKV = [&](int buf, const StageRegs& R) __attribute__((always_inline)) { *(LAS u32x4*)(lds + (buf ? AL_K1 : AL_K0) + skey * KSTR + sch * 16) = R.a;
                        LAS unsigned char* vd = lds + (buf ? AL_V1 : AL_V0) + skey * VSTR + sch * 16; u32x2 a, c; a.x = R.b.x; a.y = R.b.y; c.x = R.b.z; c.y = R.b.w; *(LAS u32x2*)vd = a; *(LAS u32x2*)(vd + 8) = c; };
                    f32x16 oacc[2], ob[2];
                    const int nv = T >= 31 ? ((T - 31) >> 4) + 1 : 0, ntc = (4 * tb + 3 + 63) >> 6;
                    float mC = NEGB, lC = 0.f;
                    { const bf16_t* kb_ = KCMPB + (size_t)b * 512 * 64;
                      attn_pipeline(0, ntc - 1, [&](int j, StageRegs& R) __attribute__((always_inline)) { R.a = *(const u32x4*)((kb_ + (size_t)j * 64 * 64) + koffC); }, stK,
                        [&](int j, int cb) __attribute__((always_inline)) { f32x16 s0, s1; qk_tile<4>(lds + (cb ? AL_K1 : AL_K0), qf, r32, hi, s0, s1); if (!__all(nv - 1 - 64 * j >= 63)) mask_tile(s0, s1, 0, nv - 1 - 64 * j, hi);
                            const float mx = tile_max(s0, s1), mn = fmaxf(mC, mx), ms = mn < -1e29f ? 0.f : mn, alpha = ex2(mC - ms); mC = mn; float ps = 0.f;
#pragma unroll
                            for (int i = 0; i < 16; ++i) ps += ex2(s0[i] - ms) + ex2(s1[i] - ms);
                            lC = lC * alpha + ps; }); }
                    { const float invC = 1.f / fmaxf(xhalf_sum(lC), 1e-30f), msC = mC < -1e29f ? 0.f : mC; float carry = 0.f;
#pragma unroll
                      for (int i = 0; i < 16; ++i) { ob[0][i] = 0.f; ob[1][i] = 0.f; }
                      const bf16_t* kb_ = KCMPB + (size_t)b * 512 * 64; const bf16_t* vb_ = VCMPT + (size_t)b * 64 * 512;
                      attn_pipeline(0, ntc - 1, [&](int j, StageRegs& R) __attribute__((always_inline)) { R.a = *(const u32x4*)((kb_ + (size_t)j * 64 * 64) + koffC); R.b = *(const u32x4*)((vb_ + j * 64) + voffC); }, stKV,
                        [&](int j, int cb) __attribute__((always_inline)) { f32x16 s0, s1; qk_tile<4>(lds + (cb ? AL_K1 : AL_K0), qf, r32, hi, s0, s1); if (!__all(nv - 1 - 64 * j >= 63)) mask_tile(s0, s1, 0, nv - 1 - 64 * j, hi);
#pragma unroll
                            for (int i = 0; i < 16; ++i) { s0[i] = ex2(s0[i] - msC) * invC; s1[i] = ex2(s1[i] - msC) * invC; }
                            float gs[8], pl[8];
#pragma unroll
                            for (int q = 0; q < 4; ++q) { gs[q] = (s0[4 * q] + s0[4 * q + 1]) + (s0[4 * q + 2] + s0[4 * q + 3]); gs[4 + q] = (s1[4 * q] + s1[4 * q + 1]) + (s1[4 * q + 2] + s1[4 * q + 3]);
                                pl[q] = __shfl_xor(s0[4 * q + 3], 32); pl[4 + q] = __shfl_xor(s1[4 * q + 3], 32); }
#pragma unroll
                            for (int q = 0; q < 8; ++q) { const float prev = hi ? pl[q] : (q > 0 ? pl[q > 0 ? q - 1 : 0] : carry); float x = gs[q] + prev; x += __shfl_xor(x, 1); x += __shfl_xor(x, 2);
                                if ((r32 & 3) == 0) impb[(r32 >> 2) * 128 + 16 * j + 2 * q + hi] = x; }
                            carry = pl[7];
                            pv_tile(s0, s1, lds + (cb ? AL_V1 : AL_V0), ob, r32, hi); }); }
                    LAS float* oav = (LAS float*)(lds + AL_OACC) + tid; const float g0 = sigmoidf_(bf2f(prow[C_BG + head * 3]));
#pragma unroll
                    for (int i = 0; i < 16; ++i) { oav[i * 512] = g0 * ob[0][i]; oav[(16 + i) * 512] = g0 * ob[1][i]; }
                    WSYNC();
                    for (int tk = 0; tk < 8; ++tk) {
                        const int cur = tb, j0 = lane, j1 = lane + 64; const float im0 = impb[tk * 128 + j0], im1 = impb[tk * 128 + j1];
                        const unsigned k0 = ((j0 == 0 || j0 == cur || j0 == cur - 1) ? 0xFF000000u : (j0 <= cur ? (__float_as_uint(im0) & ~127u) : 0u)) | (unsigned)(127 - j0);
                        const unsigned k1 = ((j1 == cur || j1 == cur - 1) ? 0xFF000000u : (j1 <= cur ? (__float_as_uint(im1) & ~127u) : 0u)) | (unsigned)(127 - j1);
                        unsigned T = 0u;
#pragma unroll 4
                        for (int bb = 31; bb >= 0; --bb) { const unsigned cand = T | (1u << bb); const int cnt = __popcll(__ballot(k0 >= cand)) + __popcll(__ballot(k1 >= cand)); if (cnt >= 16) T = cand; }
                        const unsigned long long m0 = __ballot(k0 >= T), m1 = __ballot(k1 >= T);
                        if (lane == 0) { selm[tk * 4] = (unsigned)m0; selm[tk * 4 + 1] = (unsigned)(m0 >> 32); selm[tk * 4 + 2] = (unsigned)m1; selm[tk * 4 + 3] = (unsigned)(m1 >> 32); }
                    }
                    WSYNC();
                    const unsigned sm0 = selm[(r32 >> 2) * 4], sm1 = selm[(r32 >> 2) * 4 + 1], sm2 = selm[(r32 >> 2) * 4 + 2], sm3 = selm[(r32 >> 2) * 4 + 3];
                    { SoftState SB; soft_init(SB, ob);
                      unsigned u0 = sm0, u1 = sm1, u2 = sm2, u3 = sm3;
#pragma unroll
                      for (int o_ = 1; o_ < 64; o_ <<= 1) { u0 |= (unsigned)__shfl_xor((int)u0, o_); u1 |= (unsigned)__shfl_xor((int)u1, o_); u2 |= (unsigned)__shfl_xor((int)u2, o_); u3 |= (unsigned)__shfl_xor((int)u3, o_); }
                      unsigned long long Ulo = ((unsigned long long)(unsigned)__builtin_amdgcn_readfirstlane((int)u1) << 32) | (unsigned)__builtin_amdgcn_readfirstlane((int)u0), Uhi = ((unsigned long long)(unsigned)__builtin_amdgcn_readfirstlane((int)u3) << 32) | (unsigned)__builtin_amdgcn_readfirstlane((int)u2);
                      if (tb < 64) { if (tb < 63) Ulo &= (2ull << tb) - 1ull; Uhi = 0ull; } else if (tb < 127) Uhi &= (2ull << (tb - 64)) - 1ull;
                      const bf16_t* ksf = KSF + (size_t)b * 128 * 4096; const bf16_t* vsf = VST + (size_t)b * 128 * 4096; const unsigned lo8 = (unsigned)lane * 8u;
                      bf16x8 kf[2][4], vf[2][4];
                      int j = 0; Ulo &= ~1ull;
#pragma unroll
                      for (int f = 0; f < 8; ++f) kf[f >> 2][f & 3] = *(const bf16x8*)((ksf + f * 512) + lo8);
                      bool first = true;
                      for (;;) {
#pragma unroll
                          for (int f = 0; f < 8; ++f) vf[f >> 2][f & 3] = *(const bf16x8*)((vsf + (size_t)j * 4096 + f * 512) + lo8);
                          const unsigned wsel = j < 32 ? sm0 : (j < 64 ? sm1 : (j < 96 ? sm2 : sm3)); const bool bit = (wsel >> (j & 31)) & 1u;
                          const f32x16 cinit = bcast16(bit ? -SB.m : NEGB); f32x16 s0 = cinit, s1 = cinit;
#pragma unroll
                          for (int ks = 0; ks < 4; ++ks) { s0 = mfma32(kf[0][ks], qf[ks], s0); s1 = mfma32(kf[1][ks], qf[ks], s1); }
                          __builtin_amdgcn_sched_barrier(0);
                          const int jn = Ulo ? (int)__builtin_ctzll(Ulo) : (Uhi ? 64 + (int)__builtin_ctzll(Uhi) : -1);
                          if (Ulo) Ulo &= Ulo - 1ull; else Uhi &= Uhi - 1ull;
                          if (jn >= 0) {
#pragma unroll
                              for (int f = 0; f < 8; ++f) kf[f >> 2][f & 3] = *(const bf16x8*)((ksf + (size_t)jn * 4096 + f * 512) + lo8); }
                          soft_update(s0, s1, SB, ob, j == tb, 0, tl, first, hi);
                          { const bf16x8 p00 = pack8<0>(s0), p01 = pack8<8>(s0), p10 = pack8<0>(s1), p11 = pack8<8>(s1);
#pragma unroll
                            for (int dt = 0; dt < 2; ++dt) { ob[dt] = mfma32(vf[dt][0], p00, ob[dt]); ob[dt] = mfma32(vf[dt][1], p01, ob[dt]); ob[dt] = mfma32(vf[dt][2], p10, ob[dt]); ob[dt] = mfma32(vf[dt][3], p11, ob[dt]); } }
                          if (jn < 0) break;
                          j = jn; first = false;
                      }
                      const float sc = sigmoidf_(bf2f(prow[C_BG + head * 3 + 1])) / fmaxf(xhalf_sum(SB.l), 1e-30f);
#pragma unroll
                      for (int i = 0; i < 16; ++i) { oav[i * 512] += sc * ob[0][i]; oav[(16 + i) * 512] += sc * ob[1][i]; } }
                    __syncthreads();
                    { SoftState SB; soft_init(SB, ob); const int jb0 = tb >= 8 ? tb - 8 : 0;
                      const bf16_t* kb_ = PB + (size_t)b * SEQ * NIN + C_KW; const bf16_t* vb_ = VWT + (size_t)b * 64 * SEQ;
                      attn_pipeline(tb >= 8 ? tb - 8 : 0, tb, [&](int j, StageRegs& R) __attribute__((always_inline)) { R.a = *(const u32x4*)((kb_ + (size_t)j * 64 * NIN) + koffP); R.b = *(const u32x4*)((vb_ + j * 64) + voffS); }, stKV,
                        [&](int j, int cb) __attribute__((always_inline)) { attn_step<4>(lds + (cb ? AL_K1 : AL_K0), lds + (cb ? AL_V1 : AL_V0), qf, SB, ob, j == tb || j == tb - 8, j == tb - 8 ? tl + 1 : 0, j == tb ? tl : 63, j == jb0, r32, hi); });
                      const float sc = sigmoidf_(bf2f(prow[C_BG + head * 3 + 2])) / fmaxf(xhalf_sum(SB.l), 1e-30f);
#pragma unroll
                      for (int i = 0; i < 16; ++i) { oacc[0][i] = oav[i * 512] + sc * ob[0][i]; oacc[1][i] = oav[(16 + i) * 512] + sc * ob[1][i]; } }
                    { float ss = 0.f;
#pragma unroll
                      for (int i = 0; i < 16; ++i) ss += oacc[0][i] * oacc[0][i] + oacc[1][i] * oacc[1][i];
                      ss = xhalf_sum(ss); ss += __shfl_xor(ss, 1); ss += __shfl_xor(ss, 2);
                      const float rinv = rsqrtf(ss * (1.f / 256.f) + EPS);
#pragma unroll
                      for (int dt = 0; dt < 2; ++dt)
#pragma unroll
                          for (int g = 0; g < 4; ++g) { u32x2 w; w.x = cvtpk(oacc[dt][4 * g] * rinv, oacc[dt][4 * g + 1] * rinv); w.y = cvtpk(oacc[dt][4 * g + 2] * rinv, oacc[dt][4 * g + 3] * rinv);
                              *(u32x2*)(Y + row * DM + 512 + head * 64 + 32 * dt + 8 * g + 4 * hi) = w; } }
                    __syncthreads();
                    continue;
                }
                {
                    const int qb = 31 - grp, b = within >> 2, h = within & 3;
                    const int T = 256 * qb + 32 * wave + r32; const size_t row = (size_t)b * SEQ + T;
                    bf16x8 qf[6];
#pragma unroll
                    for (int ks = 0; ks < 6; ++ks) qf[ks] = *(const bf16x8*)(MQ + row * 384 + h * 96 + 16 * ks + 8 * hi);
                    f32x16 o[2]; SoftState SM; soft_init(SM, o);
                    const int jd = 4 * qb + (wave >> 1);
                    const bf16_t* kn = MKN + (size_t)b * SEQ * 256 + h * 64; const bf16_t* kr = MKR + (size_t)b * SEQ * 32; const bf16_t* vt = MVT + (size_t)(b * 4 + h) * 64 * SEQ;
                    constexpr int VS2 = 264, AM_K0 = 0, AM_K1 = 128 * KSTR, AM_V0 = 2 * 128 * KSTR, AM_V1 = AM_V0 + 64 * VS2;
                    const int nk = tid >> 3, nc = tid & 7, rkey = tid >> 2, rch = tid & 3, vr = tid >> 4, vc = tid & 15;
                    const unsigned ko0 = (unsigned)(nk * 256 + nc * 8), ko1 = (unsigned)(rkey * 32 + rch * 8), vo_ = (unsigned)(vr * SEQ + vc * 8);
                    attn_pipeline(0, 2 * qb + 1,
                        [&](int jj, StageRegs& R) __attribute__((always_inline)) { const bf16_t* knj = kn + (size_t)jj * 128 * 256; const bf16_t* vtj = vt + jj * 128;
                            R.a = *(const u32x4*)(knj + ko0); R.b = *(const u32x4*)((knj + 64 * 256) + ko0); R.c = *(const u32x4*)((kr + (size_t)jj * 128 * 32) + ko1);
                            R.d = *(const u32x4*)(vtj + vo_); R.e = *(const u32x4*)((vtj + 32 * SEQ) + vo_); },
                        [&](int buf, const StageRegs& R) __attribute__((always_inline)) { LAS unsigned char* kb_ = lds + (buf ? AM_K1 : AM_K0); LAS unsigned char* vb_ = lds + (buf ? AM_V1 : AM_V0) + vr * VS2 + vc * 16;
                            *(LAS u32x4*)(kb_ + nk * KSTR + nc * 16) = R.a; *(LAS u32x4*)(kb_ + (64 + nk) * KSTR + nc * 16) = R.b; *(LAS u32x4*)(kb_ + rkey * KSTR + 128 + rch * 16) = R.c;
                            u32x2 p, q; p.x = R.d.x; p.y = R.d.y; q.x = R.d.z; q.y = R.d.w; *(LAS u32x2*)vb_ = p; *(LAS u32x2*)(vb_ + 8) = q;
                            p.x = R.e.x; p.y = R.e.y; q.x = R.e.z; q.y = R.e.w; *(LAS u32x2*)(vb_ + 32 * VS2) = p; *(LAS u32x2*)(vb_ + 32 * VS2 + 8) = q; },
                        [&](int jj, int cb) __attribute__((always_inline)) {
                            const int j0 = 2 * jj, kd = 32 * (wave & 1) + r32;
                            if (j0 + 1 <= jd) attn_step2<6, VS2>(lds + (cb ? AM_K1 : AM_K0), lds + (cb ? AM_V1 : AM_V0), qf, SM, o, false, 63, j0 + 1 == jd, j0 + 1 == jd ? kd : 63, j0 == 0, r32, hi);
                            else if (j0 <= jd) attn_step<6, VS2>(lds + (cb ? AM_K1 : AM_K0), lds + (cb ? AM_V1 : AM_V0), qf, SM, o, j0 == jd, 0, kd, j0 == 0, r32, hi); });
                    { const float inv = 1.f / fmaxf(xhalf_sum(SM.l), 1e-30f); float ss = 0.f;
#pragma unroll
                      for (int dt = 0; dt < 2; ++dt)
#pragma unroll
                          for (int g = 0; g < 4; ++g) { const float v0 = o[dt][4 * g] * inv, v1 = o[dt][4 * g + 1] * inv, v2 = o[dt][4 * g + 2] * inv, v3 = o[dt][4 * g + 3] * inv; ss += v0 * v0 + v1 * v1 + v2 * v2 + v3 * v3;
                              u32x2 w; w.x = cvtpk(v0, v1); w.y = cvtpk(v2, v3); *(u32x2*)(Y + row * DM + h * 64 + 32 * dt + 8 * g + 4 * hi) = w; }
                      ss = xhalf_sum(ss); if (hi == 0) ssq_d[(size_t)h * M + row] = ss; }
                    __syncthreads();
                }
              }
            }
        }
        SEAM(pb + 2);
        if (IN(pb + 3)) {
        const int l_ = l; WS_PTRS();
            pg8::Gemm g{Y, (const bf16_t*)(ws + WS_WOUT) + (size_t)l * DM * DM, M, DM, DM}; pg8::StaticOrder S; S.init(M, DM, G, bid);
            pg8::EpiResid<true> E{XB, ssq_out, ssq_d, (LAS float*)(lds + 131072)};
            pg8::gemm_phase<pg8::EpiResid<true>, pg8::StaticOrder, true, true>(lds, g, S, E);
            if (REP_G57) { pg8::EpiInProj E2{PB, DM, ssq_mix}; pg8::gemm_phase<pg8::EpiInProj, pg8::StaticOrder, true, true>(lds, g, S, E2); }
        }
        SEAM(pb + 3);
        if (IN(pb + 4)) {
        const int l_ = l; WS_PTRS();
            pg8::Gemm g{XB, (const bf16_t*)(ws + WS_WGU) + (size_t)l * NGU * DM, M, NGU, DM}; pg8::StaticOrder S; S.init(M, NGU, G, bid);
            pg8::EpiSwiglu E{ACT, ssq_out};
            _Pragma("unroll 1") for (int rep = 0; rep < REP_G16; ++rep) pg8::gemm_phase<pg8::EpiSwiglu, pg8::StaticOrder, true, true>(lds, g, S, E);
        }
        SEAM(pb + 4);
        if (IN(pb + 5)) {
        const int l_ = l; WS_PTRS();
            pg8::Gemm g{ACT, (const bf16_t*)(ws + WS_WDN) + (size_t)l * DM * FF, M, DM, FF}; pg8::StaticOrder S; S.init(M, DM, G, bid);
            pg8::EpiResid<false> E{XB, ssq_down, nullptr, (LAS float*)(lds + 131072)};
            pg8::gemm_phase<pg8::EpiResid<false>, pg8::StaticOrder, true, true>(lds, g, S, E);
            if (REP_G57) { pg8::EpiInProj E2{Y, DM, ssq_mix}; pg8::gemm_phase<pg8::EpiInProj, pg8::StaticOrder, true, true>(lds, g, S, E2); }
        }
        SEAM(pb + 5);
    }
    if (IN(13)) {
        const int l_ = 1; WS_PTRS();
        LAUNDER_TID();
        const float* ssqf = ssp_base + (size_t)5 * 4 * M; const int gw = bid * 8 + wave, NGW = G * 8;
        for (int m = gw; m < M; m += NGW) {
            const float rinv = rsqrtf(sum4p(ssqf, m) * (1.f / DM) + EPS);
            const u32x2* xr = (const u32x2*)(XB + (size_t)m * DM) + lane; f32x4* orow = (f32x4*)(args.out + (size_t)m * DM) + lane; const f32x4* gn = (const f32x4*)inp(args, 27) + lane;
#pragma unroll
            for (int j = 0; j < 4; ++j) { const u32x2 w = xr[64 * j]; const f32x4 g = gn[64 * j]; f32x4 v; v[0] = bflo(w.x) * rinv * g[0]; v[1] = bfhi(w.x) * rinv * g[1]; v[2] = bflo(w.y) * rinv * g[2]; v[3] = bfhi(w.y) * rinv * g[3]; orow[64 * j] = v; }
        }
    }
#undef IN
#undef SEAM
}

extern "C" void kernel_launch(void* const* d_in, const int* in_sizes, int n_in, void* d_out, int out_size, void* d_ws, size_t ws_size, hipStream_t stream) {
    static int grid = 0;
    if (grid == 0) {
        if (n_in != 28 || in_sizes[0] != M * DM || out_size != M * DM || ws_size < WS_END) { fprintf(stderr, "kernel_launch: unexpected shapes (n_in %d, ws %zu)\n", n_in, ws_size); grid = -1; return; }
        int dev = 0, cus = 0;
        if (hipGetDevice(&dev) != hipSuccess || hipDeviceGetAttribute(&cus, hipDeviceAttributeMultiprocessorCount, dev) != hipSuccess) { grid = -1; return; }
        if (hipFuncSetAttribute((const void*)fwd, hipFuncAttributeMaxDynamicSharedMemorySize, LDS_BYTES) != hipSuccess) { fprintf(stderr, "kernel_launch: hipFuncSetAttribute failed\n"); grid = -1; return; }
        int per_cu = 0;
        if (hipOccupancyMaxActiveBlocksPerMultiprocessor(&per_cu, (const void*)fwd, NTHR, LDS_BYTES) != hipSuccess || per_cu < 1) fprintf(stderr, "kernel_launch: occupancy query says %d\n", per_cu);
        (void)hipGetLastError();
        grid = cus;
    }
    if (grid < 0) return;
    (void)hipMemsetAsync((char*)d_ws + WS_CTL, 0, CTL_ZERO_BYTES, stream);
    Args a{};
    for (int i = 0; i < 28; ++i) a.in[i] = (const float*)d_in[i];
    a.out = (float*)d_out; a.ws = (unsigned char*)d_ws;
    if (MK_N_LAUNCHES == 1) { a.ph_lo = 0; a.ph_hi = 14; hipLaunchKernelGGL(fwd, dim3(grid), dim3(NTHR), LDS_BYTES, stream, a); }
    else for (int p = 0; p < 14; ++p) { a.ph_lo = p; a.ph_hi = p + 1; hipLaunchKernelGGL(fwd, dim3(grid), dim3(NTHR), LDS_BYTES, stream, a); }
}
```

```cpp
#include <hip/hip_runtime.h>
#include <cstdio>
#include <cstdint>

#ifndef MK_N_LAUNCHES
#define MK_N_LAUNCHES 1
#endif

#define REP_P0 1
#define REP_G16 1
#define REP_G57 0
#define REP_ATT 1
#define STAGGER 6
#define REP_J4B 1
#define REP_J3 1
#define REP_J1 1
#define REP_J2 1
#define REP_P3 1
#define REP_ONLY 0
#define LAS __attribute__((address_space(3)))
#define DI __device__ __forceinline__
typedef unsigned short bf16_t;
typedef short bf16x8 __attribute__((ext_vector_type(8)));
typedef float f32x4 __attribute__((ext_vector_type(4)));
typedef unsigned u32x4 __attribute__((ext_vector_type(4)));
typedef unsigned u32x2 __attribute__((ext_vector_type(2)));

constexpr int NB = 4, SEQ = 8192, M = NB * SEQ, DM = 1024, NIN = 2304, NINS = 2300, FF = 2816, NGU = 2 * FF;
constexpr float EPS = 1e-6f;
constexpr int C_AX = 0, C_AG = 256, C_BQ = 512, C_KC = 768, C_VC = 832, C_KS = 896, C_VS = 960, C_KW = 1024, C_VW = 1088, C_BG = 1152,
              C_CQ = 1164, C_CK = 1292, C_CV = 1420, C_GLR = 1676, C_OG = 1692, C_DCQ = 1948, C_DCKV = 2140, C_DKR = 2268;
constexpr size_t MiB = 1u << 20;
constexpr size_t WS_CTL = 0, CTL_ZERO_BYTES = 1 * MiB;
constexpr size_t WS_ACC = 64 * 1024;
constexpr size_t WS_SSQ0 = 1 * MiB;
constexpr size_t WS_HB = 1 * MiB + 256 * 1024;
constexpr size_t WS_WIN = 2 * MiB, WS_WOUT = 11 * MiB, WS_WGU = 15 * MiB, WS_WDN = 37 * MiB;
constexpr size_t WS_WUQT = 48 * MiB, WS_WUKVT = 48 * MiB + 512 * 1024, WS_W2T = 49 * MiB, WS_W1T = 50 * MiB;
constexpr size_t WS_WGT = 49 * MiB + 512 * 1024, WS_SP = 49 * MiB + 768 * 1024;
constexpr size_t WS_BCS = 352 * MiB;
constexpr size_t WS_CS64 = 64 * MiB, WS_CS32 = 72 * MiB;
constexpr size_t WS_XB = 80 * MiB, WS_Y = 144 * MiB, WS_PB = 208 * MiB, WS_ACT = 208 * MiB;
constexpr size_t WS_LA = 384 * MiB, WS_LH = 386 * MiB, WS_CIN = 388 * MiB;
constexpr size_t WS_KVC = 392 * MiB, WS_DEC = 408 * MiB, WS_SST = 410 * MiB;
constexpr size_t WS_MQ = 428 * MiB, WS_MKN = 452 * MiB, WS_MV = 468 * MiB, WS_MKR = 484 * MiB;
constexpr size_t WS_SSP = 500 * MiB;
constexpr size_t WS_KSF = 504 * MiB;
constexpr size_t WS_VST = 490 * MiB, WS_VWT = 494 * MiB, WS_KCMPB = 498 * MiB, WS_VCMPT = 499 * MiB, WS_END = 508 * MiB;
constexpr int CW_QUEUE = 64;
constexpr int CW_FLAG = 1024;
constexpr int CW_BAR = 4096;
constexpr int LDS_BYTES = 163840 - 256;
constexpr int LDS_CTL = LDS_BYTES - 64;
constexpr int NTHR = 512;

struct Args { const float* in[28]; float* out; unsigned char* ws; int ph_lo, ph_hi; };

DI float bf2f(bf16_t h) { return __uint_as_float(((unsigned)h) << 16); }
DI float bflo(unsigned u) { return __uint_as_float(u << 16); }
DI float bfhi(unsigned u) { return __uint_as_float(u & 0xffff0000u); }
DI bf16_t f2bf(float f) { unsigned u = __float_as_uint(f); return (bf16_t)((u + 0x7fffu + ((u >> 16) & 1u)) >> 16); }
DI unsigned pk2(float lo, float hi) { return (unsigned)f2bf(lo) | ((unsigned)f2bf(hi) << 16); }
DI float sum4p(const float* p, size_t row) { return (p[row] + p[(size_t)M + row]) + (p[2 * (size_t)M + row] + p[3 * (size_t)M + row]); }
DI float wave_sum(float v) {
#pragma unroll
    for (int o = 1; o < 64; o <<= 1) v += __shfl_xor(v, o);
    return v;
}
DI float wave_max(float v) {
#pragma unroll
    for (int o = 1; o < 64; o <<= 1) v = fmaxf(v, __shfl_xor(v, o));
    return v;
}
DI int wave_min_i(int v) {
#pragma unroll
    for (int o = 1; o < 64; o <<= 1) { int w = __shfl_xor(v, o); v = w < v ? w : v; }
    return v;
}
DI float sigmoidf_(float x) { return __builtin_amdgcn_rcpf(1.f + __builtin_amdgcn_exp2f(-1.4426950408889634f * x)); }
DI float gelu_tanh(float x) { const float u = 0.7978845608028654f * (x + 0.044715f * x * x * x); return x * sigmoidf_(2.f * u); }
#define WSYNC() do { asm volatile("s_waitcnt lgkmcnt(0)" ::: "memory"); __builtin_amdgcn_wave_barrier(); } while (0)

namespace pg8 {
constexpr int BM = 256, BK = 64, HALF = 128, HTB = HALF * BK * 2, NXCD = 8, WGM = 8;
__host__ __device__ __forceinline__ int lds_byte(int r, int c) { const int st = (r >> 4) * 2 + (c >> 5), rr = r & 15, cc = c & 31, ob = rr * 64 + cc * 2; return st * 1024 + (ob ^ (((ob >> 9) & 1) << 5)); }
__host__ __device__ __forceinline__ void stage_rc(int b, int& R, int& C) { const int st = b / 1024, sb = b % 1024, swz = sb ^ (((sb >> 9) & 1) << 5); R = (st >> 1) * 16 + swz / 64; C = (st & 1) * 32 + (swz % 64) / 2; }
__host__ __device__ __forceinline__ int perm32(int rho) { const int n = rho >> 4, i = rho & 15; return 8 * (i >> 2) + 4 * n + (i & 3); }
struct Unit { int pm, pn; };
struct Gemm { const bf16_t* A; const bf16_t* Bt; int M, N, K; };
struct StaticOrder {
    int nM, nN, nwg, G, c;
    __host__ __device__ void init(int M_, int N_, int G_, int c_) { nM = M_ / BM; nN = N_ / BM; nwg = nM * nN; G = G_; c = c_; }
    __host__ __device__ bool next(int i, Unit& u) const {
        const long L = (long)i * G + c; if (L >= nwg) return false;
        int wgid = (int)L; { const int q = nwg / NXCD, r = nwg % NXCD, xcd = wgid % NXCD, off = wgid / NXCD; wgid = (xcd < r ? xcd * (q + 1) : r * (q + 1) + (xcd - r) * q) + off; }
        const int nig = WGM * nN, gid = wgid / nig, fm = gid * WGM, gsz = (nM - fm) < WGM ? (nM - fm) : WGM;
        u.pm = fm + ((wgid % nig) % gsz); u.pn = (wgid % nig) / gsz; return true;
    }
    __device__ __forceinline__ void a_ready(const Unit&) const {}
    __device__ __forceinline__ void done(const Unit&) const {}
};
DI unsigned cvt_pk_bf16(float lo, float hi) { unsigned r; asm volatile("v_cvt_pk_bf16_f32 %0, %1, %2" : "=v"(r) : "v"(lo), "v"(hi)); return r; }

struct EpiInProj {
    static constexpr bool PERM = true, AFTER_DRAIN = false, MIDSCALE = false;
    bf16_t* O; int ldc; const float* ssq;
    DI void operator()(const f32x4 (&acc)[2][2][4][2], const Unit& u, int wr, int wc, int fr, int fq) const {
        int row0 = u.pm * BM + wr * 64 + fr; asm volatile("" : "+v"(row0)); const int col0 = u.pn * BM + wc * 32 + 8 * fq;
#pragma unroll
        for (int ai = 0; ai < 2; ++ai)
#pragma unroll
            for (int m = 0; m < 4; ++m) {
                const int row = row0 + ai * HALF + m * 16;
                const float rinv = rsqrtf(sum4p(ssq, row) * (1.f / DM) + EPS);
                bf16_t* rowp = O + (size_t)row * ldc + col0;
#pragma unroll
                for (int bj = 0; bj < 2; ++bj) {
                    f32x4 v0 = acc[ai][bj][m][0] * rinv, v1 = acc[ai][bj][m][1] * rinv;
                    u32x4 w; w.x = cvt_pk_bf16(v0[0], v0[1]); w.y = cvt_pk_bf16(v0[2], v0[3]); w.z = cvt_pk_bf16(v1[0], v1[1]); w.w = cvt_pk_bf16(v1[2], v1[3]);
                    *(u32x4*)(rowp + bj * HALF) = w;
                }
            }
    }
};
template <bool MS> struct EpiResid {
    static constexpr bool PERM = true, AFTER_DRAIN = false, MIDSCALE = MS;
    bf16_t* xb; float* ssq_part; const float* ssq_mid; LAS float* ssl;
    DI void midscale(f32x4 (&acc)[2][2][4][2], const Unit& u, int wr, int fr) const {
        int row0 = u.pm * BM + wr * 64 + fr; asm volatile("" : "+v"(row0));
#pragma unroll
        for (int ai = 0; ai < 2; ++ai)
#pragma unroll
            for (int m = 0; m < 4; ++m) { const float s = rsqrtf(sum4p(ssq_mid, row0 + ai * HALF + m * 16) * (1.f / 256.f) + EPS);
#pragma unroll
                for (int bj = 0; bj < 2; ++bj) { acc[ai][bj][m][0] *= s; acc[ai][bj][m][1] *= s; } }
    }
    DI void operator()(const f32x4 (&acc)[2][2][4][2], const Unit& u, int wr, int wc, int fr, int fq) const {
        int rl0 = wr * 64 + fr; asm volatile("" : "+v"(rl0));
        const int col0 = u.pn * BM + wc * 32 + 8 * fq;
#pragma unroll
        for (int ai = 0; ai < 2; ++ai)
#pragma unroll
            for (int m = 0; m < 4; ++m) {
                const int rl = rl0 + ai * HALF + m * 16; const size_t row = (size_t)u.pm * BM + rl;
                float part = 0.f;
#pragma unroll
                for (int bj = 0; bj < 2; ++bj) {
                    u32x4* px = (u32x4*)(xb + row * DM + col0 + bj * HALF); const u32x4 xo = *px;
                    const f32x4 a0 = acc[ai][bj][m][0], a1 = acc[ai][bj][m][1];
                    const float v0 = a0[0] + bflo(xo.x), v1 = a0[1] + bfhi(xo.x), v2 = a0[2] + bflo(xo.y), v3 = a0[3] + bfhi(xo.y), v4 = a1[0] + bflo(xo.z), v5 = a1[1] + bfhi(xo.z), v6 = a1[2] + bflo(xo.w), v7 = a1[3] + bfhi(xo.w);
                    u32x4 w; w.x = cvt_pk_bf16(v0, v1); w.y = cvt_pk_bf16(v2, v3); w.z = cvt_pk_bf16(v4, v5); w.w = cvt_pk_bf16(v6, v7);
                    *px = w;
                    part += (v0 * v0 + v1 * v1) + (v2 * v2 + v3 * v3) + (v4 * v4 + v5 * v5) + (v6 * v6 + v7 * v7);
                }
                part += __shfl_xor(part, 16); part += __shfl_xor(part, 32);
                if (fq == 0) ssl[rl * 4 + wc] = part;
            }
        asm volatile("s_waitcnt lgkmcnt(0)" ::: "memory"); __builtin_amdgcn_s_barrier();
        int tq = threadIdx.x; asm volatile("" : "+v"(tq));
        if (tq < 256) { const f32x4 p = *(const LAS f32x4*)(ssl + tq * 4); ssq_part[(size_t)u.pn * M + (size_t)u.pm * BM + tq] = (p[0] + p[1]) + (p[2] + p[3]); }
    }
};
struct EpiSwiglu {
    static constexpr bool PERM = true, AFTER_DRAIN = false, MIDSCALE = false;
    bf16_t* act; const float* ssq;
    DI void operator()(const f32x4 (&acc)[2][2][4][2], const Unit& u, int wr, int wc, int fr, int fq) const {
        int row0 = u.pm * BM + wr * 64 + fr; asm volatile("" : "+v"(row0)); const int j0 = u.pn * 128 + wc * 16 + 4 * fq;
#pragma unroll
        for (int ai = 0; ai < 2; ++ai)
#pragma unroll
            for (int m = 0; m < 4; ++m) {
                const int row = row0 + ai * HALF + m * 16;
                const float rinv = rsqrtf(sum4p(ssq, row) * (1.f / DM) + EPS);
#pragma unroll
                for (int bj = 0; bj < 2; ++bj) {
                    const f32x4 g = acc[ai][bj][m][0] * rinv, up = acc[ai][bj][m][1] * rinv;
                    float a[4];
#pragma unroll
                    for (int i = 0; i < 4; ++i) a[i] = g[i] * up[i] * __builtin_amdgcn_rcpf(1.f + __builtin_amdgcn_exp2f(-1.4426950408889634f * g[i]));
                    u32x2 w; w.x = cvt_pk_bf16(a[0], a[1]); w.y = cvt_pk_bf16(a[2], a[3]);
                    *(u32x2*)(act + (size_t)row * FF + j0 + bj * 64) = w;
                }
            }
    }
};

template <class Epi, class Sched, bool ALIGN_EPI = false, bool SP2 = false>
DI void gemm_phase(LAS unsigned char* lds, const Gemm g, const Sched& S, const Epi& E) {
    int tid_ = threadIdx.x; asm volatile("" : "+v"(tid_));
    const int tid = tid_, wid = __builtin_amdgcn_readfirstlane(tid >> 6), lane = tid & 63, wr = wid >> 2, wc = wid & 3, fr = lane & 15, fq = lane >> 4;
    const int K = g.K, nt = K / BK;
    unsigned voffA[2], voffB[2];
#pragma unroll
    for (int i = 0; i < 2; ++i) { int R, C; stage_rc(tid * 16 + i * 8192, R, C); const int Rb = Epi::PERM ? ((R & ~31) + perm32(R & 31)) : R;
        voffA[i] = (unsigned)(R * K + C) * 2u; voffB[i] = (unsigned)(Rb * K + C) * 2u; }
    const size_t kstep = (size_t)(BK * 2);
    const size_t hstep = (size_t)HALF * K * 2;
    const size_t tstep = 2 * hstep;
    const unsigned ldsw = (unsigned)wid * 1024u;
    const int aoff = lds_byte(wr * 64 + fr, fq * 8), boff = lds_byte(wc * 32 + fr, fq * 8);
#define PG8_SA(b, h) (((b) * 2 + (h)) * HTB)
#define PG8_SB(b, h) ((4 + (b) * 2 + (h)) * HTB)
#define PG8_STAGE(bufoff, gbase, voff) do { _Pragma("unroll") for (int _i = 0; _i < 2; ++_i) \
        __builtin_amdgcn_global_load_lds((const unsigned*)((const char*)(gbase) + (voff)[_i]), (LAS unsigned*)(lds + (bufoff) + ldsw + _i * 8192), 16, 0, 0); } while (0)
#define PG8_LDA(dst, b, h) do { _Pragma("unroll") for (int m = 0; m < 4; ++m) _Pragma("unroll") for (int k = 0; k < 2; ++k) dst[m][k] = *(const LAS bf16x8*)(lds + PG8_SA(b, h) + aoff + m * 2048 + k * 1024); } while (0)
#define PG8_LDB(dst, b, h) do { _Pragma("unroll") for (int n = 0; n < 2; ++n) _Pragma("unroll") for (int k = 0; k < 2; ++k) dst[n][k] = *(const LAS bf16x8*)(lds + PG8_SB(b, h) + boff + n * 2048 + k * 1024); } while (0)
#define PG8_MMA(ai, bj, At, Bt) do { __builtin_amdgcn_s_setprio(1); _Pragma("unroll") for (int m = 0; m < 4; ++m) _Pragma("unroll") for (int n = 0; n < 2; ++n) _Pragma("unroll") for (int k = 0; k < 2; ++k) \
        acc[ai][bj][m][n] = __builtin_amdgcn_mfma_f32_16x16x32_bf16(Bt[n][k], At[m][k], acc[ai][bj][m][n], 0, 0, 0); __builtin_amdgcn_s_setprio(0); } while (0)
#define PG8_WAIT_V(n) asm volatile("s_waitcnt vmcnt(" #n ")" ::: "memory")
#define PG8_WAIT_L(n) asm volatile("s_waitcnt lgkmcnt(" #n ")" ::: "memory")
#define PG8_BAR __builtin_amdgcn_s_barrier()
#define PG8_SCHED __builtin_amdgcn_sched_barrier(0)
    Unit cur, nxt; int ui = 0;
    if (!S.next(0, cur)) return;
    f32x4 acc[2][2][4][2];
#pragma unroll
    for (int a = 0; a < 2; ++a)
#pragma unroll
        for (int b = 0; b < 2; ++b)
#pragma unroll
            for (int m = 0; m < 4; ++m)
#pragma unroll
                for (int n = 0; n < 2; ++n) acc[a][b][m][n] = (f32x4){0.f, 0.f, 0.f, 0.f};
    bf16x8 At[4][2], B0[2][2], B1[2][2];
    const char* cA = (const char*)g.A + (size_t)cur.pm * tstep; const char* cB = (const char*)g.Bt + (size_t)cur.pn * tstep;
    S.a_ready(cur);
    if constexpr (SP2) {
        PG8_STAGE(PG8_SB(0, 0), cB, voffB); PG8_STAGE(PG8_SB(0, 1), cB + hstep, voffB); PG8_STAGE(PG8_SA(0, 0), cA, voffA); PG8_STAGE(PG8_SA(0, 1), cA + hstep, voffA);
        if (wr == 1) PG8_BAR;
        PG8_WAIT_V(2); PG8_BAR;
        PG8_STAGE(PG8_SB(1, 0), cB + kstep, voffB); PG8_STAGE(PG8_SA(1, 0), cA + kstep, voffA); PG8_STAGE(PG8_SB(1, 1), cB + hstep + kstep, voffB);
        PG8_WAIT_V(6); PG8_BAR;
    } else {
        PG8_STAGE(PG8_SB(0, 0), cB, voffB); PG8_STAGE(PG8_SA(0, 0), cA, voffA); PG8_STAGE(PG8_SB(0, 1), cB + hstep, voffB); PG8_STAGE(PG8_SA(0, 1), cA + hstep, voffA);
        if (wr == 1) PG8_BAR;
        PG8_WAIT_V(4); PG8_BAR;
        PG8_STAGE(PG8_SB(1, 0), cB + kstep, voffB); PG8_STAGE(PG8_SA(1, 0), cA + kstep, voffA); PG8_STAGE(PG8_SB(1, 1), cB + hstep + kstep, voffB);
        PG8_WAIT_V(6); PG8_BAR;
    }
    for (;;) {
        const bool has_next = S.next(ui + 1, nxt);
        const char* nA = has_next ? (const char*)g.A + (size_t)nxt.pm * tstep : cA; const char* nB = has_next ? (const char*)g.Bt + (size_t)nxt.pn * tstep : cB;
        for (int t = 0; t < nt; t += 2) {
            const bool last = (t == nt - 2);
            const char* a1 = cA + (size_t)(t + 1) * kstep;
            const char* a2 = last ? nA : cA + (size_t)(t + 2) * kstep; const char* b2 = last ? nB : cB + (size_t)(t + 2) * kstep;
            const char* a3 = a2 + kstep; const char* b3 = b2 + kstep;
            if (last && has_next) S.a_ready(nxt);
            if constexpr (SP2) {
            PG8_LDB(B0, 0, 0); PG8_LDB(B1, 0, 1); PG8_SCHED; PG8_LDA(At, 0, 0); PG8_STAGE(PG8_SA(1, 1), a1 + hstep, voffA);
            PG8_WAIT_V(8); PG8_WAIT_L(0); PG8_BAR; PG8_MMA(0, 0, At, B0); PG8_MMA(0, 1, At, B1); PG8_BAR; PG8_SCHED;
            PG8_LDA(At, 0, 1); PG8_STAGE(PG8_SB(0, 0), b2, voffB); PG8_STAGE(PG8_SB(0, 1), b2 + hstep, voffB); PG8_STAGE(PG8_SA(0, 0), a2, voffA);
            PG8_WAIT_V(8); PG8_WAIT_L(0); PG8_BAR; PG8_MMA(1, 0, At, B0); PG8_MMA(1, 1, At, B1); PG8_BAR; PG8_SCHED;
            PG8_LDB(B0, 1, 0); PG8_LDB(B1, 1, 1); PG8_SCHED; PG8_LDA(At, 1, 0); PG8_STAGE(PG8_SA(0, 1), a2 + hstep, voffA);
            PG8_WAIT_V(8); PG8_WAIT_L(0); PG8_BAR; PG8_MMA(0, 0, At, B0); PG8_MMA(0, 1, At, B1); PG8_BAR; PG8_SCHED;
            PG8_LDA(At, 1, 1); PG8_STAGE(PG8_SB(1, 0), b3, voffB); PG8_STAGE(PG8_SB(1, 1), b3 + hstep, voffB); PG8_STAGE(PG8_SA(1, 0), a3, voffA);
            PG8_WAIT_V(8); PG8_WAIT_L(0); PG8_BAR; PG8_MMA(1, 0, At, B0); PG8_MMA(1, 1, At, B1); PG8_BAR; PG8_SCHED;
            if constexpr (Epi::MIDSCALE) { if (t == 2) E.midscale(acc, cur, wr, fr); }
            } else {
            PG8_LDB(B0, 0, 0); PG8_SCHED; PG8_LDA(At, 0, 0); PG8_STAGE(PG8_SA(1, 1), a1 + hstep, voffA);
            PG8_WAIT_L(8); PG8_BAR; PG8_WAIT_L(0); PG8_MMA(0, 0, At, B0); PG8_BAR; PG8_SCHED;
            PG8_LDB(B1, 0, 1); PG8_STAGE(PG8_SB(0, 0), b2, voffB);
            PG8_BAR; PG8_WAIT_L(0); PG8_MMA(0, 1, At, B1); PG8_BAR;
            PG8_LDA(At, 0, 1); PG8_STAGE(PG8_SA(0, 0), a2, voffA);
            PG8_BAR; PG8_WAIT_L(0); PG8_MMA(1, 0, At, B0); PG8_BAR; PG8_SCHED;
            PG8_STAGE(PG8_SB(0, 1), b2 + hstep, voffB);
            PG8_WAIT_V(6); PG8_BAR; PG8_MMA(1, 1, At, B1); PG8_BAR;
            PG8_LDB(B0, 1, 0); PG8_SCHED; PG8_LDA(At, 1, 0); PG8_STAGE(PG8_SA(0, 1), a2 + hstep, voffA);
            PG8_WAIT_L(8); PG8_BAR; PG8_WAIT_L(0); PG8_MMA(0, 0, At, B0); PG8_BAR; PG8_SCHED;
            PG8_LDB(B1, 1, 1); PG8_STAGE(PG8_SB(1, 0), b3, voffB);
            PG8_BAR; PG8_WAIT_L(0); PG8_MMA(0, 1, At, B1); PG8_BAR;
            PG8_LDA(At, 1, 1); PG8_STAGE(PG8_SA(1, 0), a3, voffA);
            PG8_BAR; PG8_WAIT_L(0); PG8_MMA(1, 0, At, B0); PG8_BAR; PG8_SCHED;
            PG8_STAGE(PG8_SB(1, 1), b3 + hstep, voffB);
            PG8_WAIT_V(6); PG8_BAR; PG8_MMA(1, 1, At, B1); PG8_BAR;
            }
        }
        if constexpr (ALIGN_EPI) { if (wr == 0) PG8_BAR; }
        if constexpr (!Epi::AFTER_DRAIN) { E(acc, cur, wr, wc, fr, fq); S.done(cur); }
        if (!has_next) break;
#pragma unroll
        for (int a = 0; a < 2; ++a)
#pragma unroll
            for (int b = 0; b < 2; ++b)
#pragma unroll
                for (int m = 0; m < 4; ++m)
#pragma unroll
                    for (int n = 0; n < 2; ++n) acc[a][b][m][n] = (f32x4){0.f, 0.f, 0.f, 0.f};
        cur = nxt; cA = nA; cB = nB; ++ui;
        if constexpr (ALIGN_EPI) { if (wr == 1) PG8_BAR; }
    }
    PG8_WAIT_V(0);
    if constexpr (!ALIGN_EPI) { if (wr == 0) PG8_BAR; }
    PG8_BAR;
#undef PG8_SA
#undef PG8_SB
#undef PG8_STAGE
#undef PG8_LDA
#undef PG8_LDB
#undef PG8_MMA
#undef PG8_WAIT_V
#undef PG8_WAIT_L
#undef PG8_BAR
#undef PG8_SCHED
}
}

#define XB_TMO      128
#define XB_XCNT(j)  (256  + 64 * (j))
#define XB_XSUB(j)  (1280 + 64 * (j))
#define XB_XGEN(j)  (2304 + 64 * (j))
#define XB_TOP      3328
#define XB_TOPGEN   3392
#define XCD_BAR_WORDS 3456
#define XB_SPIN_CAP (1u << 18)
__device__ __forceinline__ unsigned xb_ld(unsigned* p)              { return __hip_atomic_load(p, __ATOMIC_RELAXED, __HIP_MEMORY_SCOPE_AGENT); }
__device__ __forceinline__ unsigned xb_add(unsigned* p, unsigned v) { return __hip_atomic_fetch_add(p, v, __ATOMIC_RELAXED, __HIP_MEMORY_SCOPE_AGENT); }
__device__ __forceinline__ unsigned xb_xcc_id() { return (unsigned)__builtin_amdgcn_s_getreg((3 << 11) | 20) & 0xFu; }
#define XB_SPIN(cond, bar) do { unsigned _sp = 0; while (cond) { __builtin_amdgcn_s_sleep(1); \
    if ((++_sp & 255u) == 0u) { if (xb_ld(&(bar)[XB_TMO])) break; if (_sp > XB_SPIN_CAP) { atomicAdd(&(bar)[XB_TMO], 1u); break; } } } } while (0)
struct XcdBarrier { unsigned* bar; unsigned x; volatile LAS unsigned* st; };
__device__ __forceinline__ XcdBarrier xcd_barrier_post(unsigned* bar, volatile LAS unsigned* st) {
    XcdBarrier b; b.bar = bar; b.x = xb_xcc_id(); b.st = st;
    if (threadIdx.x == 0) (void)xb_add(&bar[XB_XCNT(b.x)], 1u);
    return b;
}
__device__ __forceinline__ void xcd_barrier_complete(unsigned* bar, unsigned x, unsigned& nloc, unsigned& nx) {
    const unsigned G = gridDim.x * gridDim.y * gridDim.z;
    unsigned sum, cnt, mine, sp = 0u;
    for (;;) {
        sum = 0u; cnt = 0u; mine = 0u;
#pragma unroll
        for (unsigned j = 0; j < 16; ++j) { const unsigned c = xb_ld(&bar[XB_XCNT(j)]); sum += c; cnt += (c > 0u) ? 1u : 0u; mine = (j == x) ? c : mine; }
        if (sum == G) break;
        __builtin_amdgcn_s_sleep(1);
        if ((++sp & 255u) == 0u) { if (xb_ld(&bar[XB_TMO])) break; if (sp > XB_SPIN_CAP) { atomicAdd(&bar[XB_TMO], 1u); break; } }
    }
    nloc = mine > 0u ? mine : 1u; nx = cnt > 0u ? cnt : 1u;
}
__device__ __forceinline__ void xcd_barrier(const XcdBarrier& b) {
    asm volatile("s_waitcnt vmcnt(0)" ::: "memory");
    __syncthreads();
    if (threadIdx.x == 0) {
        unsigned* bar = b.bar;
        __builtin_amdgcn_s_waitcnt(0);
        unsigned nloc = b.st[0], nx = b.st[1];
        if (nloc == 0u) { xcd_barrier_complete(bar, b.x, nloc, nx); b.st[0] = nloc; b.st[1] = nx; }
        const unsigned old = xb_add(&bar[XB_XSUB(b.x)], 1u);
        const unsigned gen = old / nloc;
        if (old + 1u == (gen + 1u) * nloc) {
            __builtin_amdgcn_fence(__ATOMIC_RELEASE, "agent");
            asm volatile("s_waitcnt vmcnt(0)" ::: "memory");
            const unsigned og = xb_add(&bar[XB_TOP], 1u);
            const unsigned tg = og / nx;
            if (og + 1u == (tg + 1u) * nx) xb_add(&bar[XB_TOPGEN], 1u);
            else XB_SPIN(xb_ld(&bar[XB_TOPGEN]) == tg, bar);
            __builtin_amdgcn_fence(__ATOMIC_ACQUIRE, "agent");
            xb_add(&bar[XB_XGEN(b.x)], 1u);
            asm volatile("s_waitcnt vmcnt(0)" ::: "memory");
        } else {
            XB_SPIN(xb_ld(&bar[XB_XGEN(b.x)]) == gen, bar);
            __builtin_amdgcn_fence(__ATOMIC_ACQUIRE, "agent");
            asm volatile("s_waitcnt vmcnt(0)" ::: "memory");
        }
    }
    __syncthreads();
}

template <int MAP>
DI int colmap(int v, int Nsrc) {
    if (MAP == 0) return v < Nsrc ? v : -1;
    const int g8 = v >> 3, e = v & 7, j = 4 * g8 + (e & 3); return (e < 4) ? j : FF + j;
}
template <int MAP, int KROT = 0>
DI void p0_transpose_item64(const float* W, int K, int Nsrc, const float* gain, bf16_t* WT, LAS float* scr, int kb, int nb, int lane) {
    const int k0 = 64 * kb, n0 = 64 * nb, v = n0 + 4 * (lane & 15);
    const int sc = MAP == 0 ? (v < Nsrc ? v : -1) : ((v >> 3) * 4 + ((v >> 2) & 1) * FF);
#pragma unroll 4
    for (int i = 0; i < 16; ++i) { const int kk = 4 * i + (lane >> 4); int ksrc = k0 + kk + KROT; if (KROT && ksrc >= K) ksrc -= K; f32x4 w = {0.f, 0.f, 0.f, 0.f}; if (sc >= 0) w = *(const f32x4*)(W + (size_t)ksrc * Nsrc + sc); if (gain) w = w * gain[ksrc];
        LAS float* d = scr + kk * 65 + 4 * (lane & 15); d[0] = w[0]; d[1] = w[1]; d[2] = w[2]; d[3] = w[3]; }
    WSYNC();
    const int c = lane & 7;
#pragma unroll
    for (int j = 0; j < 8; ++j) { const int n = (lane >> 3) + 8 * j; const LAS float* s = scr + (8 * c) * 65 + n;
        u32x4 o; o.x = pk2(s[0 * 65], s[1 * 65]); o.y = pk2(s[2 * 65], s[3 * 65]); o.z = pk2(s[4 * 65], s[5 * 65]); o.w = pk2(s[6 * 65], s[7 * 65]);
        *(u32x4*)(WT + (size_t)(n0 + n) * K + k0 + 8 * c) = o; }
    WSYNC();
}
template <int MAP, int KROT = 0>
DI void p0_transpose_item(const float* W, int K, int Nsrc, const float* gain, bf16_t* WT, LAS float* scr, int kb, int nb, int lane) {
    const int k0 = 64 * kb, n0 = 32 * nb;
    const int sc = colmap<MAP>(n0 + (lane & 31), Nsrc);
#pragma unroll 8
    for (int i = 0; i < 32; ++i) { const int kk = 2 * i + (lane >> 5); int ksrc = k0 + kk + KROT; if (KROT && ksrc >= K) ksrc -= K; float w = 0.f; if (sc >= 0) w = W[(size_t)ksrc * Nsrc + sc]; if (gain) w *= gain[ksrc]; scr[kk * 33 + (lane & 31)] = w; }
    WSYNC();
    const int c = lane & 7;
#pragma unroll
    for (int j = 0; j < 4; ++j) { const int n = (lane >> 3) + 8 * j; const LAS float* s = scr + (8 * c) * 33 + n;
        u32x4 o; o.x = pk2(s[0 * 33], s[1 * 33]); o.y = pk2(s[2 * 33], s[3 * 33]); o.z = pk2(s[4 * 33], s[5 * 33]); o.w = pk2(s[6 * 33], s[7 * 33]);
        *(u32x4*)(WT + (size_t)(n0 + n) * K + k0 + 8 * c) = o; }
    WSYNC();
}


typedef float f32x16 __attribute__((ext_vector_type(16)));
typedef float f32x2v __attribute__((ext_vector_type(2)));
typedef __bf16 bf16x2_t __attribute__((ext_vector_type(2)));
constexpr int KSTR = 208, VSTR = 136;
constexpr int VSTP = 144;
constexpr int AL_K0 = 0, AL_K1 = 64 * KSTR, AL_V0 = 2 * 64 * KSTR, AL_V1 = AL_V0 + 64 * VSTP, AL_IMP = 45056, AL_SELM = AL_IMP + 32768, AL_OACC = AL_SELM + 1024;
constexpr float NEGB = -1e30f, LOG2E = 1.4426950408889634f;
DI unsigned cvtpk(float lo, float hi) { f32x2v v = {lo, hi}; bf16x2_t b = __builtin_convertvector(v, bf16x2_t); return __builtin_bit_cast(unsigned, b); }
DI f32x16 mfma32(bf16x8 a, bf16x8 b, f32x16 c) { return __builtin_amdgcn_mfma_f32_32x32x16_bf16(a, b, c, 0, 0, 0); }
DI float xhalf_max(float v) { auto rr = __builtin_amdgcn_permlane32_swap(__float_as_uint(v), __float_as_uint(v), false, false); return fmaxf(__uint_as_float(rr[0]), __uint_as_float(rr[1])); }
DI float xhalf_sum(float v) { auto rr = __builtin_amdgcn_permlane32_swap(__float_as_uint(v), __float_as_uint(v), false, false); return __uint_as_float(rr[0]) + __uint_as_float(rr[1]); }
DI float ex2(float x) { return __builtin_amdgcn_exp2f(x); }
template <int KSTEPS>
DI void qk_tile(const LAS unsigned char* Kt, const bf16x8 (&qf)[KSTEPS], int r32, int hi, f32x16& s0, f32x16& s1) {
    const LAS unsigned char* p0 = Kt + r32 * KSTR + hi * 16;
#pragma unroll
    for (int i = 0; i < 16; ++i) { s0[i] = 0.f; s1[i] = 0.f; }
#pragma unroll
    for (int ks = 0; ks < KSTEPS; ++ks) {
        const bf16x8 a0 = *(const LAS bf16x8*)(p0 + ks * 32), a1 = *(const LAS bf16x8*)(p0 + 32 * KSTR + ks * 32);
        s0 = mfma32(a0, qf[ks], s0); s1 = mfma32(a1, qf[ks], s1);
    }
}
DI void mask_tile(f32x16& s0, f32x16& s1, int klo, int khi, int hi) {
    const int lo_ = klo - 4 * hi, hi_ = khi - 4 * hi;
#pragma unroll
    for (int i = 0; i < 16; ++i) { const int kb = (i & 3) + 8 * (i >> 2); if (kb < lo_ || kb > hi_) s0[i] = NEGB; if (kb + 32 < lo_ || kb + 32 > hi_) s1[i] = NEGB; }
}
DI float tile_max(const f32x16& s0, const f32x16& s1) {
    float mx = fmaxf(s0[0], s1[0]);
#pragma unroll
    for (int i = 1; i < 16; ++i) mx = fmaxf(mx, fmaxf(s0[i], s1[i]));
    return xhalf_max(mx);
}
template <int BASE> DI bf16x8 pack8(const f32x16& s) { u32x4 p; p.x = cvtpk(s[BASE], s[BASE + 1]); p.y = cvtpk(s[BASE + 2], s[BASE + 3]); p.z = cvtpk(s[BASE + 4], s[BASE + 5]); p.w = cvtpk(s[BASE + 6], s[BASE + 7]); return __builtin_bit_cast(bf16x8, p); }
DI bf16x8 ld8x2(const bf16_t* p) { const u32x2 a = *(const u32x2*)p, b = *(const u32x2*)(p + 4); u32x4 w; w.x = a.x; w.y = a.y; w.z = b.x; w.w = b.y; return __builtin_bit_cast(bf16x8, w); }
DI bf16x8 vfrag(const LAS unsigned char* p) { const u32x2 a = *(const LAS u32x2*)p, b = *(const LAS u32x2*)(p + 16); u32x4 w; w.x = a.x; w.y = a.y; w.z = b.x; w.w = b.y; return __builtin_bit_cast(bf16x8, w); }
template <int VS = VSTP>
DI void pv_tile(const f32x16& s0, const f32x16& s1, const LAS unsigned char* Vt, f32x16 (&o)[2], int r32, int hi) {
    const bf16x8 p00 = pack8<0>(s0), p01 = pack8<8>(s0), p10 = pack8<0>(s1), p11 = pack8<8>(s1);
#pragma unroll
    for (int dt = 0; dt < 2; ++dt) { const LAS unsigned char* vp = Vt + (32 * dt + r32) * VS + 16 * hi;
        o[dt] = mfma32(*(const LAS bf16x8*)vp, p00, o[dt]); o[dt] = mfma32(*(const LAS bf16x8*)(vp + 32), p01, o[dt]); o[dt] = mfma32(*(const LAS bf16x8*)(vp + 64), p10, o[dt]); o[dt] = mfma32(*(const LAS bf16x8*)(vp + 96), p11, o[dt]); }
}
DI void softmax_pv(f32x16& s0, f32x16& s1, const LAS unsigned char* Vt, f32x16 (&o)[2], float& m, float& l, int r32, int hi) {
    const float mx = tile_max(s0, s1), mn = fmaxf(m, mx), ms = mn < -1e29f ? 0.f : mn, alpha = ex2(m - ms);
    m = mn; float psum = 0.f;
#pragma unroll
    for (int i = 0; i < 16; ++i) { s0[i] = ex2(s0[i] - ms); s1[i] = ex2(s1[i] - ms); psum += s0[i] + s1[i]; }
    l = l * alpha + psum;
    if (!__all(alpha == 1.f)) {
#pragma unroll
        for (int i = 0; i < 16; ++i) { o[0][i] *= alpha; o[1][i] *= alpha; } }
    pv_tile(s0, s1, Vt, o, r32, hi);
}
struct SoftState { float m, l; };
constexpr float SM_THR = 8.f;
DI void soft_init(SoftState& S, f32x16 (&o)[2]) { S.m = 0.f; S.l = 0.f;
#pragma unroll
    for (int i = 0; i < 16; ++i) { o[0][i] = 0.f; o[1][i] = 0.f; } }
DI f32x16 bcast16(float v) { f32x16 c;
#pragma unroll
    for (int i = 0; i < 16; ++i) c[i] = v;
    return c; }
DI float max3f(float a, float b, float c) { float r; asm("v_max3_f32 %0, %1, %2, %3" : "=v"(r) : "v"(a), "v"(b), "v"(c)); return r; }
DI float soft_update(f32x16& s0, f32x16& s1, SoftState& S, f32x16 (&o)[2], bool masked, int klo, int khi, bool first, int hi, float adj = 0.f) {
    if (__any(adj != 0.f)) {
#pragma unroll
        for (int i = 0; i < 16; ++i) { s0[i] -= adj; s1[i] -= adj; } }
    float dl_ret = 0.f;
    if (__builtin_expect(masked, 0)) { asm volatile("; boundary tile mask" ::: "memory"); mask_tile(s0, s1, klo, khi, hi); }
    asm volatile("s_nop 15\n\ts_nop 7" : "+v"(s0), "+v"(s1));
    float rm;
    { float a = max3f(s0[0], s0[1], s0[2]), b = max3f(s1[0], s1[1], s1[2]);
#pragma unroll
      for (int i = 3; i < 15; i += 2) { a = max3f(a, s0[i], s0[i + 1]); b = max3f(b, s1[i], s1[i + 1]); }
      rm = xhalf_max(fmaxf(max3f(a, b, s0[15]), s1[15])); }
    if (first) {
        const float dl = rm < -1e29f ? 0.f : rm; S.m = dl; dl_ret = dl;
#pragma unroll
        for (int i = 0; i < 16; ++i) { s0[i] -= dl; s1[i] -= dl; }
    } else if (__any(rm > SM_THR)) {
        const float dl = fmaxf(rm, 0.f), alpha = ex2(-dl); S.m += dl; S.l *= alpha; dl_ret = dl;
#pragma unroll
        for (int i = 0; i < 16; ++i) { s0[i] -= dl; s1[i] -= dl; o[0][i] *= alpha; o[1][i] *= alpha; }
    }
    float p0 = 0.f, p1 = 0.f, p2 = 0.f, p3 = 0.f;
#pragma unroll
    for (int i = 0; i < 16; i += 2) { s0[i] = ex2(s0[i]); s0[i + 1] = ex2(s0[i + 1]); s1[i] = ex2(s1[i]); s1[i + 1] = ex2(s1[i + 1]); p0 += s0[i]; p1 += s0[i + 1]; p2 += s1[i]; p3 += s1[i + 1]; }
    S.l += (p0 + p1) + (p2 + p3);
    return dl_ret;
}
template <int KSTEPS, int VS = VSTP>
DI void attn_step(const LAS unsigned char* Kt, const LAS unsigned char* Vt, const bf16x8 (&qf)[KSTEPS], SoftState& S, f32x16 (&o)[2], bool masked, int klo, int khi, bool first, int r32, int hi) {
    const f32x16 cinit = bcast16(-S.m); f32x16 s0 = cinit, s1 = cinit;
    { const LAS unsigned char* p0 = Kt + r32 * KSTR + hi * 16;
#pragma unroll
      for (int ks = 0; ks < KSTEPS; ++ks) { const bf16x8 a0 = *(const LAS bf16x8*)(p0 + ks * 32), a1 = *(const LAS bf16x8*)(p0 + 32 * KSTR + ks * 32);
          s0 = mfma32(a0, qf[ks], s0); s1 = mfma32(a1, qf[ks], s1); } }
    soft_update(s0, s1, S, o, masked, klo, khi, first, hi);
    pv_tile<VS>(s0, s1, Vt, o, r32, hi);
}
template <int KSTEPS, int VS>
DI void attn_step2(const LAS unsigned char* Kt, const LAS unsigned char* Vt, const bf16x8 (&qf)[KSTEPS], SoftState& S, f32x16 (&o)[2], bool masked0, int khi0, bool masked1, int khi1, bool first, int r32, int hi) {
    const f32x16 cinit = bcast16(-S.m); f32x16 a0 = cinit, a1 = cinit, b0 = cinit, b1 = cinit;
    { const LAS unsigned char* p0 = Kt + r32 * KSTR + hi * 16;
#pragma unroll
      for (int ks = 0; ks < KSTEPS; ++ks) { const bf16x8 k0 = *(const LAS bf16x8*)(p0 + ks * 32), k1 = *(const LAS bf16x8*)(p0 + 32 * KSTR + ks * 32);
          a0 = mfma32(k0, qf[ks], a0); a1 = mfma32(k1, qf[ks], a1); }
#pragma unroll
      for (int ks = 0; ks < KSTEPS; ++ks) { const bf16x8 k0 = *(const LAS bf16x8*)(p0 + 64 * KSTR + ks * 32), k1 = *(const LAS bf16x8*)(p0 + 96 * KSTR + ks * 32);
          b0 = mfma32(k0, qf[ks], b0); b1 = mfma32(k1, qf[ks], b1); } }
    const float dl0 = soft_update(a0, a1, S, o, masked0, 0, khi0, first, hi);
    pv_tile<VS>(a0, a1, Vt, o, r32, hi);
    (void)soft_update(b0, b1, S, o, masked1, 0, khi1, false, hi, dl0);
    pv_tile<VS>(b0, b1, Vt + 128, o, r32, hi);
}
struct StageRegs { u32x4 a, b, c, d, e; };
template <class LoadF, class StoreF, class StepF>
DI void attn_pipeline(int jbeg, int jend, LoadF ld, StoreF st, StepF step) {
    if (jbeg > jend) return;
    StageRegs RA;
    ld(jbeg, RA); st(0, RA); __syncthreads();
    for (int j = jbeg; j <= jend; j += 2) {
        if (j + 1 <= jend) ld(j + 1, RA);
        step(j, 0);
        if (j + 1 <= jend) st(1, RA);
        __syncthreads();
        if (STAGGER && __builtin_amdgcn_readfirstlane(threadIdx.x >> 6) >= 4) __builtin_amdgcn_s_sleep(STAGGER);
        if (j + 1 > jend) break;
        if (j + 2 <= jend) ld(j + 2, RA);
        step(j + 1, 1);
        if (j + 2 <= jend) st(0, RA);
        __syncthreads();
        if (STAGGER && __builtin_amdgcn_readfirstlane(threadIdx.x >> 6) >= 4) __builtin_amdgcn_s_sleep(STAGGER);
    }
}
DI const float* inp(const Args& a, int k) { asm volatile("" : "+s"(k)); return a.in[k]; }
__global__ void __launch_bounds__(NTHR, 2) fwd(Args args) {
    extern __shared__ __attribute__((aligned(16))) unsigned char lds_raw[];
    LAS unsigned char* lds = (LAS unsigned char*)lds_raw;
    LAS float* ldsf = (LAS float*)lds;
    volatile LAS unsigned* LCTL = (volatile LAS unsigned*)(lds + LDS_CTL);
    const int tid0 = threadIdx.x, wave = __builtin_amdgcn_readfirstlane(tid0 >> 6);
    const int G = gridDim.x, bid = blockIdx.x;
#define LAUNDER_TID() int tid = tid0; asm volatile("" : "+v"(tid)); const int lane = tid & 63; (void)lane
#define WS_PTRS() unsigned char* ws = args.ws; asm volatile("" : "+s"(ws)); \
    unsigned* ctl = (unsigned*)(ws + WS_CTL); float* ssp_base = (float*)(ws + WS_SSP); float* hb = (float*)(ws + WS_HB); \
    bf16_t* XB = (bf16_t*)(ws + WS_XB); bf16_t* Y = (bf16_t*)(ws + WS_Y); bf16_t* PB = (bf16_t*)(ws + WS_PB); bf16_t* ACT = (bf16_t*)(ws + WS_ACT); \
    const float2* cs64 = (const float2*)(ws + WS_CS64); const float2* cs32 = (const float2*)(ws + WS_CS32); \
    float* LRA = args.out; float* LRU_ = args.out + (size_t)M * 256; \
    float* LA = (float*)(ws + WS_LA); float* LH = (float*)(ws + WS_LH); float* CIN = (float*)(ws + WS_CIN); \
    float* KVC = (float*)(ws + WS_KVC); float* DEC = (float*)(ws + WS_DEC); float* SST = (float*)(ws + WS_SST); \
    bf16_t* MQ = (bf16_t*)(ws + WS_MQ); bf16_t* MKN = (bf16_t*)(ws + WS_MKN); bf16_t* MVT = (bf16_t*)(ws + WS_MV); bf16_t* MKR = (bf16_t*)(ws + WS_MKR); \
    bf16_t* VST = (bf16_t*)(ws + WS_VST); bf16_t* KSF = (bf16_t*)(ws + WS_KSF); (void)KSF; bf16_t* VWT = (bf16_t*)(ws + WS_VWT); bf16_t* KCMPB = (bf16_t*)(ws + WS_KCMPB); bf16_t* VCMPT = (bf16_t*)(ws + WS_VCMPT); \
    const float* ssq_mix = ssp_base + (size_t)(l_ == 0 ? 0 : 2) * 4 * M; float* ssq_out = ssp_base + (size_t)(1 + 3 * l_) * 4 * M; float* ssq_down = ssp_base + (size_t)(2 + 3 * l_) * 4 * M; float* ssq_d = ssp_base + (size_t)(3 + 3 * l_) * 4 * M; \
    (void)ctl; (void)hb; (void)XB; (void)Y; (void)PB; (void)ACT; (void)cs64; (void)cs32; (void)LRA; (void)LRU_; (void)LA; (void)LH; (void)CIN; (void)KVC; (void)DEC; (void)SST; (void)MQ; (void)MKN; (void)MVT; (void)MKR; (void)VST; (void)VWT; (void)KCMPB; (void)VCMPT; (void)ssq_mix; (void)ssq_out; (void)ssq_down; (void)ssq_d
    unsigned* ctl0 = (unsigned*)(args.ws + WS_CTL);
    { LAUNDER_TID(); if (tid < 16) LCTL[tid] = 0u; }
    __syncthreads();
    const int lo = args.ph_lo, hi = args.ph_hi;
    XcdBarrier bar; bar.bar = ctl0 + CW_BAR; bar.x = 0; bar.st = LCTL;
    if (hi - lo > 1) bar = xcd_barrier_post(ctl0 + CW_BAR, LCTL);
#define IN(k) (lo <= (k) && (k) < hi)
#define SEAM(k) do { if (IN(k) && IN((k) + 1)) xcd_barrier(bar); } while (0)

    if (IN(0)) {
        const int l_ = 0; WS_PTRS();
      _Pragma("unroll 1") for (int rep = 0; rep < REP_P0; ++rep) {
        LAUNDER_TID();
        const int gw = bid * 8 + wave, NGW = G * 8;
        LAS float* scr = ldsf + wave * 4224; LAS float* scr64 = scr;
        constexpr int I_IN = 16 * 36, I_OUT = 16 * 16, I_GU = 16 * 88, I_DN = 44 * 16, I_L = I_IN + I_OUT + I_GU + I_DN;
        for (int it = gw; it < 2 * I_L; it += NGW) {
            const int l = it / I_L; int r = it % I_L;
            if (r < I_IN) { p0_transpose_item64<0>(inp(args, 3) + (size_t)l * DM * NINS, DM, NINS, inp(args, 2) + l * DM, (bf16_t*)(ws + WS_WIN) + (size_t)l * NIN * DM, scr64, r / 36, r % 36, lane); continue; } r -= I_IN;
            if (r < I_OUT) { p0_transpose_item64<0, 768>(inp(args, 23) + (size_t)l * DM * DM, DM, DM, inp(args, 22) + l * DM, (bf16_t*)(ws + WS_WOUT) + (size_t)l * DM * DM, scr64, r / 16, r % 16, lane); continue; } r -= I_OUT;
            if (r < I_GU) { p0_transpose_item64<1>(inp(args, 25) + (size_t)l * DM * NGU, DM, NGU, inp(args, 24) + l * DM, (bf16_t*)(ws + WS_WGU) + (size_t)l * NGU * DM, scr64, r / 88, r % 88, lane); continue; } r -= I_GU;
            p0_transpose_item64<0>(inp(args, 26) + (size_t)l * FF * DM, FF, DM, nullptr, (bf16_t*)(ws + WS_WDN) + (size_t)l * DM * FF, scr64, r / 16, r % 16, lane);
        }
        { constexpr int I_UQ = 3 * 12, I_UKV = 2 * 16, I_W1 = 32 * 8, I_W2 = 4 * 2, I_S = 2 * I_UQ + 2 * I_UKV + 4 * I_W1 + 4 * I_W2;
          for (int it = gw; it < I_S; it += NGW) { int r = it;
              if (r < 2 * I_UQ) { const int l = r / I_UQ; r %= I_UQ; p0_transpose_item<0>(inp(args, 20) + (size_t)l * 192 * 384, 192, 384, inp(args, 18) + l * 192, (bf16_t*)(ws + WS_WUQT) + (size_t)l * 384 * 192, scr, r / 12, r % 12, lane); continue; } r -= 2 * I_UQ;
              if (r < 2 * I_UKV) { const int l = r / I_UKV; r %= I_UKV; p0_transpose_item<0>(inp(args, 21) + (size_t)l * 128 * 512, 128, 512, inp(args, 19) + l * 128, (bf16_t*)(ws + WS_WUKVT) + (size_t)l * 512 * 128, scr, r / 16, r % 16, lane); continue; } r -= 2 * I_UKV;
              if (r < 4 * I_W1) { const int lj = r / I_W1; r %= I_W1; p0_transpose_item<0>(inp(args, 12) + (size_t)lj * 2048 * 256, 2048, 256, nullptr, (bf16_t*)(ws + WS_W1T) + (size_t)lj * 256 * 2048, scr, r / 8, r % 8, lane); continue; } r -= 4 * I_W1;
              { const int lj = r / I_W2; r %= I_W2; p0_transpose_item<0>(inp(args, 14) + (size_t)lj * 256 * 64, 256, 64, nullptr, (bf16_t*)(ws + WS_W2T) + (size_t)lj * 64 * 256, scr, r / 2, r % 2, lane); } } }
        for (int e = bid * NTHR + tid; e < 2 * 2 * 4 * 64 * 64; e += G * NTHR) {
            const int k = e & 63, n = (e >> 6) & 63, h = (e >> 12) & 3, g = (e >> 14) & 1, l = e >> 15;
            ((bf16_t*)(ws + WS_WGT))[e] = f2bf((g == 0 ? inp(args, 6) : inp(args, 8))[(((size_t)l * 4 + h) * 64 + k) * 64 + n]); }
        for (int e = bid * NTHR + tid; e < 512; e += G * NTHR) ((float*)(ws + WS_SP))[e] = log1pf(expf(-inp(args, 10)[e]));
        for (int m = gw; m < M; m += NGW) {
            const f32x4* xr = (const f32x4*)(inp(args, 0) + (size_t)m * DM) + lane;
            f32x4 v[4]; float s = 0.f;
#pragma unroll
            for (int j = 0; j < 4; ++j) { v[j] = xr[64 * j]; s += v[j][0] * v[j][0] + v[j][1] * v[j][1] + v[j][2] * v[j][2] + v[j][3] * v[j][3]; }
            s = wave_sum(s);
            u32x2* o8 = (u32x2*)(XB + (size_t)m * DM) + lane;
#pragma unroll
            for (int j = 0; j < 4; ++j) { u32x2 w; w.x = pk2(v[j][0], v[j][1]); w.y = pk2(v[j][2], v[j][3]); o8[64 * j] = w; }
            if (lane < 4) ssp_base[(size_t)lane * M + m] = lane == 0 ? s : 0.f;
        }
        for (int e = bid * NTHR + tid; e < M * 32; e += G * NTHR) {
            const int m = e >> 5, i = e & 31; const float pos = (float)((const int*)inp(args, 1))[m];
            const float invf = __builtin_amdgcn_exp2f(-(float)(2 * i) * (13.287712379549449f / 64.f)); float sn, cs; { float rv = pos * invf * 0.15915494309189535f; rv -= floorf(rv); sn = __builtin_amdgcn_sinf(rv); cs = __builtin_amdgcn_cosf(rv); }
            ((float2*)(ws + WS_CS64))[e] = make_float2(cs, sn);
            if (i < 16) { const float invf2 = __builtin_amdgcn_exp2f(-(float)(2 * i) * (13.287712379549449f / 32.f)); float rv = pos * invf2 * 0.15915494309189535f; rv -= floorf(rv); sn = __builtin_amdgcn_sinf(rv); cs = __builtin_amdgcn_cosf(rv); ((float2*)(ws + WS_CS32))[m * 16 + i] = make_float2(cs, sn); }
        }
        for (int e = bid * NTHR + tid; e < 2 * 2 * 256; e += G * NTHR) {
            const int lj = e >> 8, c = e & 255; float a = inp(args, 13)[e];
            const float* pp = inp(args, 11) + (size_t)lj * 2048; const float* w1 = inp(args, 12) + (size_t)lj * 2048 * 256 + c;
            for (int i = 0; i < 2048; ++i) a += pp[i] * w1[(size_t)i * 256];
            hb[e] = a;
        }
      }
    }
    SEAM(0);

    for (int l = 0; l < 2; ++l) {
        const int pb = 1 + 6 * l;
        if (IN(pb)) {
        const int l_ = l; WS_PTRS();
            pg8::Gemm g{XB, (const bf16_t*)(ws + WS_WIN) + (size_t)l * NIN * DM, M, NIN, DM}; pg8::StaticOrder S; S.init(M, NIN, G, bid);
            pg8::EpiInProj E{PB, NIN, ssq_mix};
            _Pragma("unroll 1") for (int rep = 0; rep < REP_G16; ++rep) pg8::gemm_phase<pg8::EpiInProj, pg8::StaticOrder, true, true>(lds, g, S, E);
        }
        SEAM(pb);
        if (IN(pb + 1)) {
        const int l_ = l; WS_PTRS();
        LAUNDER_TID();
            constexpr int N_J1 = 1024, N_J2 = 512, N_J3 = 512, N_J4 = 512, N_J4B = 128;
            {
            for (int r_ = bid; r_ < N_J4B * REP_J4B; r_ += G) { const int r = r_ % N_J4B;
                    const int j = r & 1, g32 = (r >> 1) & 15, b = r >> 5; const int colb = j == 0 ? C_KC : C_VC; const int r32 = lane & 31, hi = lane >> 5;
                    LAS unsigned char* Tl = lds;
                    LAS unsigned char* Hl = lds + 69632;
                    for (int e = tid; e < 528 * 8; e += NTHR) { const int rr = e >> 3, c8 = e & 7, t = 512 * g32 + rr; u32x4 w = {0u, 0u, 0u, 0u};
                        if (t < SEQ) { const bf16_t* pr = PB + ((size_t)b * SEQ + t) * NIN + colb;
                            if (j == 0) { const u32x4 a = *(const u32x4*)(pr + 8 * (c8 & 3)), c = *(const u32x4*)(pr + 32 + 8 * (c8 & 3)); const float2* cs = cs64 + ((size_t)b * SEQ + t) * 32 + 8 * (c8 & 3);
                                const unsigned au[4] = {a.x, a.y, a.z, a.w}, cu[4] = {c.x, c.y, c.z, c.w}; unsigned ou[4];
#pragma unroll
                                for (int q = 0; q < 4; ++q) { const float2 s0 = cs[2 * q], s1 = cs[2 * q + 1]; const float x1a = bflo(au[q]), x1b = bfhi(au[q]), x2a = bflo(cu[q]), x2b = bfhi(cu[q]);
                                    ou[q] = c8 < 4 ? pk2(x1a * s0.x - x2a * s0.y, x1b * s1.x - x2b * s1.y) : pk2(x2a * s0.x + x1a * s0.y, x2b * s1.x + x1b * s1.y); }
                                w.x = ou[0]; w.y = ou[1]; w.z = ou[2]; w.w = ou[3]; }
                            else w = *(const u32x4*)(pr + 8 * c8); }
                        *(LAS u32x4*)(Tl + rr * 128 + (rr >> 4) * 16 + c8 * 16) = w; }
                    __syncthreads();
                    { const bf16_t* w1t = (const bf16_t*)(ws + WS_W1T) + ((size_t)(l * 2 + j) * 256 + 32 * wave + r32) * 2048 + 8 * hi;
                      f32x16 acc;
#pragma unroll
                      for (int i = 0; i < 16; ++i) acc[i] = 0.f;
#pragma unroll 16
                      for (int kk = 0; kk < 128; ++kk) { const int rowt = 16 * r32 + (kk >> 2);
                          const bf16x8 a = *(const LAS bf16x8*)(Tl + rowt * 128 + (rowt >> 4) * 16 + 32 * (kk & 3) + 16 * hi);
                          const bf16x8 bw = *(const bf16x8*)(w1t + 16 * kk);
                          acc = mfma32(a, bw, acc); }
                      const float hbv = hb[(l * 2 + j) * 256 + 32 * wave + r32];
#pragma unroll
                      for (int i = 0; i < 16; ++i) { const int n = (i & 3) + 8 * (i >> 2) + 4 * hi; *(LAS bf16_t*)(Hl + n * 528 + (32 * wave + r32) * 2) = f2bf(gelu_tanh(acc[i] + hbv)); } }
                    __syncthreads();
                    if (wave < 2) { const bf16_t* w2t = (const bf16_t*)(ws + WS_W2T) + ((size_t)(l * 2 + j) * 64 + 32 * wave + r32) * 256 + 8 * hi;
                      f32x16 acc;
#pragma unroll
                      for (int i = 0; i < 16; ++i) acc[i] = 0.f;
#pragma unroll
                      for (int kk = 0; kk < 16; ++kk) { const bf16x8 a = *(const LAS bf16x8*)(Hl + r32 * 528 + 32 * kk + 16 * hi); const bf16x8 bw = *(const bf16x8*)(w2t + 16 * kk); acc = mfma32(a, bw, acc); }
                      const int dd = 32 * wave + r32;
#pragma unroll
                      for (int g = 0; g < 4; ++g) { const int n0 = 32 * g32 + 8 * g + 4 * hi; float v[4];
#pragma unroll
                          for (int q = 0; q < 4; ++q) v[q] = (n0 + q < 511) ? acc[4 * g + q] : 0.f;
                          if (j == 0) {
#pragma unroll
                              for (int q = 0; q < 4; ++q) KCMPB[((size_t)b * 512 + n0 + q) * 64 + dd] = f2bf(v[q]); }
                          else { u32x2 w; w.x = pk2(v[0], v[1]); w.y = pk2(v[2], v[3]); *(u32x2*)(VCMPT + ((size_t)b * 64 + dd) * 512 + n0) = w; } } }
                    __syncthreads();
            }
            if (bid < N_J3) {
                const int fr = lane & 15, kq = lane >> 4, hh = wave >> 1, odd = wave & 1;
                {
                    bf16x8 bq[3][6];
                    { const bf16_t* wq = (const bf16_t*)(ws + WS_WUQT) + (size_t)l * 384 * 192;
#pragma unroll
                      for (int nt = 0; nt < 3; ++nt)
#pragma unroll
                          for (int ks = 0; ks < 6; ++ks) bq[nt][ks] = *(const bf16x8*)(wq + (size_t)(48 * wave + 16 * nt + fr) * 192 + 32 * ks + 8 * kq); }
                    for (int r_ = bid; r_ < N_J3 * REP_J3; r_ += G) { const int r = r_ % N_J3;
                        const size_t row0 = (size_t)r * 64;
#pragma unroll 1
                        for (int mt = 0; mt < 4; ++mt) {
                            const bf16_t* pa = PB + (row0 + mt * 16 + fr) * NIN;
                            bf16x8 aq[6]; float ssq_ = 0.f;
#pragma unroll
                            for (int ks = 0; ks < 6; ++ks) { aq[ks] = ld8x2(pa + C_DCQ + 32 * ks + 8 * kq);
#pragma unroll
                                for (int e = 0; e < 8; ++e) { const float v = bf2f((bf16_t)aq[ks][e]); ssq_ += v * v; } }
                            ssq_ += __shfl_xor(ssq_, 16); ssq_ += __shfl_xor(ssq_, 32);
                            const float rq_ = rsqrtf(ssq_ * (1.f / 192.f) + EPS);
                            f32x4 cq[3];
#pragma unroll
                            for (int nt = 0; nt < 3; ++nt) { cq[nt] = (f32x4){0.f, 0.f, 0.f, 0.f};
#pragma unroll
                                for (int ks = 0; ks < 6; ++ks) cq[nt] = __builtin_amdgcn_mfma_f32_16x16x32_bf16(aq[ks], bq[nt][ks], cq[nt], 0, 0, 0); }
                            const float SCQ = 0.10206207261596575f * LOG2E;
#pragma unroll
                            for (int i = 0; i < 4; ++i) {
                                const size_t row = row0 + mt * 16 + 4 * kq + i; const float rqi = __shfl(rq_, 4 * kq + i) * SCQ;
                                float q0 = cq[0][i] * rqi, q1 = cq[1][i] * rqi, q2 = cq[2][i] * rqi;
                                if (odd) { const float2 cs = cs32[row * 16 + fr]; const float x1 = q1, x2 = q2; q1 = x1 * cs.x - x2 * cs.y; q2 = x2 * cs.x + x1 * cs.y; }
                                bf16_t* mq = MQ + row * 384 + hh * 96 + 48 * odd + fr; mq[0] = f2bf(q0); mq[16] = f2bf(q1); mq[32] = f2bf(q2);
                            }
                            if (wave == mt) {
#pragma unroll
                                for (int q = 0; q < 4; ++q) { const int p = lane * 4 + q, tok = p >> 4, i = p & 15; const size_t row = row0 + mt * 16 + tok; const bf16_t* pr = PB + row * NIN + C_DKR;
                                    const float x1 = bf2f(pr[i]), x2 = bf2f(pr[16 + i]); const float2 cs = cs32[row * 16 + i];
                                    MKR[row * 32 + i] = f2bf(x1 * cs.x - x2 * cs.y); MKR[row * 32 + 16 + i] = f2bf(x2 * cs.x + x1 * cs.y); } }
                        }
                    }
                }
                {
                    bf16x8 bkv[4][4];
                    { const bf16_t* wkv = (const bf16_t*)(ws + WS_WUKVT) + (size_t)l * 512 * 128;
#pragma unroll
                      for (int nt = 0; nt < 4; ++nt)
#pragma unroll
                          for (int ks = 0; ks < 4; ++ks) bkv[nt][ks] = *(const bf16x8*)(wkv + (size_t)(64 * wave + 16 * nt + fr) * 128 + 32 * ks + 8 * kq); }
                    for (int r_ = bid; r_ < N_J3 * REP_J3; r_ += G) { const int r = r_ % N_J3;
                        const size_t row0 = (size_t)r * 64; const size_t bb = row0 / SEQ, t0 = row0 % SEQ;
#pragma unroll 1
                        for (int mt = 0; mt < 4; ++mt) {
                            const bf16_t* pa = PB + (row0 + mt * 16 + fr) * NIN;
                            bf16x8 akv[4]; float sskv_ = 0.f;
#pragma unroll
                            for (int ks = 0; ks < 4; ++ks) { akv[ks] = ld8x2(pa + C_DCKV + 32 * ks + 8 * kq);
#pragma unroll
                                for (int e = 0; e < 8; ++e) { const float v = bf2f((bf16_t)akv[ks][e]); sskv_ += v * v; } }
                            sskv_ += __shfl_xor(sskv_, 16); sskv_ += __shfl_xor(sskv_, 32);
                            const float rk_ = rsqrtf(sskv_ * (1.f / 128.f) + EPS);
                            f32x4 ckv[4];
#pragma unroll
                            for (int nt = 0; nt < 4; ++nt) { ckv[nt] = (f32x4){0.f, 0.f, 0.f, 0.f};
#pragma unroll
                                for (int ks = 0; ks < 4; ++ks) ckv[nt] = __builtin_amdgcn_mfma_f32_16x16x32_bf16(akv[ks], bkv[nt][ks], ckv[nt], 0, 0, 0); }
                            float rki[4];
#pragma unroll
                            for (int i = 0; i < 4; ++i) rki[i] = __shfl(rk_, 4 * kq + i);
                            if (!odd) {
#pragma unroll
                                for (int i = 0; i < 4; ++i) { bf16_t* mk = MKN + (row0 + mt * 16 + 4 * kq + i) * 256 + hh * 64 + fr;
                                    mk[0] = f2bf(ckv[0][i] * rki[i]); mk[16] = f2bf(ckv[1][i] * rki[i]); mk[32] = f2bf(ckv[2][i] * rki[i]); mk[48] = f2bf(ckv[3][i] * rki[i]); } }
                            else {
#pragma unroll
                                for (int nt = 0; nt < 4; ++nt) { u32x2 w; w.x = pk2(ckv[nt][0] * rki[0], ckv[nt][1] * rki[1]); w.y = pk2(ckv[nt][2] * rki[2], ckv[nt][3] * rki[3]);
                                    *(u32x2*)(MVT + ((bb * 4 + hh) * 64 + 16 * nt + fr) * SEQ + t0 + mt * 16 + 4 * kq) = w; } }
                        }
                    }
                }
            }
            {
                const int r32 = lane & 31, hi = lane >> 5, gh = wave >> 1, gg = wave & 1, ch = tid & 255, half = tid >> 8;
                bf16x8 bW[2][4];
                { const bf16_t* wt = (const bf16_t*)(ws + WS_WGT) + (size_t)(((l * 2 + gg) * 4 + gh) * 64) * 64;
#pragma unroll
                  for (int nt = 0; nt < 2; ++nt)
#pragma unroll
                      for (int ks = 0; ks < 4; ++ks) bW[nt][ks] = *(const bf16x8*)(wt + (size_t)(32 * nt + r32) * 64 + 16 * ks + 8 * hi); }
                const float gbias0 = (gg == 0 ? inp(args, 7) : inp(args, 9))[l * 256 + gh * 64 + r32], gbias1 = (gg == 0 ? inp(args, 7) : inp(args, 9))[l * 256 + gh * 64 + 32 + r32];
                const float cw0 = inp(args, 4)[(l * 4 + 0) * 256 + ch], cw1 = inp(args, 4)[(l * 4 + 1) * 256 + ch], cw2 = inp(args, 4)[(l * 4 + 2) * 256 + ch], cw3 = inp(args, 4)[(l * 4 + 3) * 256 + ch], cb = inp(args, 5)[l * 256 + ch];
                const float sp = ((const float*)(ws + WS_SP))[l * 256 + ch];
                LAS float* xa = ldsf; LAS float* xc = ldsf + 35 * 256; LAS unsigned char* xcb = lds + 67 * 1024; LAS float* gR = (LAS float*)(lds + 67 * 1024 + 32 * 528); LAS float* gI = gR + 32 * 256;
            const bool j1bal = (G == 256 && REP_J1 == 1);
            for (int r_ = bid, k_ = 0; j1bal ? (k_ < (bid < 128 ? 3 : 5)) : (r_ < N_J1 * REP_J1); r_ += G, ++k_) { const int r = j1bal ? (bid < 128 ? bid + 128 * k_ : 384 + (bid - 128) + 128 * k_) : r_ % N_J1;
                    const int b = r >> 8, tb = r & 255, t0 = tb * 32;
                    for (int c = tid; c < 35 * 32; c += NTHR) { const int rr = c >> 5, c8 = c & 31, t = t0 - 3 + rr; u32x4 w = {0u, 0u, 0u, 0u}; if (t >= 0) w = *(const u32x4*)(PB + ((size_t)b * SEQ + t) * NIN + C_AX + 8 * c8);
                        LAS f32x4* d = (LAS f32x4*)(xa + rr * 256 + 8 * c8); d[0] = (f32x4){bflo(w.x), bfhi(w.x), bflo(w.y), bfhi(w.y)}; d[1] = (f32x4){bflo(w.z), bfhi(w.z), bflo(w.w), bfhi(w.w)}; }
                    __syncthreads();
#pragma unroll 4
                    for (int tt = 0; tt < 16; ++tt) { const int rr = half * 16 + tt; const float v = cb + cw0 * xa[rr * 256 + ch] + cw1 * xa[(rr + 1) * 256 + ch] + cw2 * xa[(rr + 2) * 256 + ch] + cw3 * xa[(rr + 3) * 256 + ch];
                        xc[rr * 256 + ch] = v; *(LAS bf16_t*)(xcb + rr * 528 + ch * 2) = f2bf(v); }
                    __syncthreads();
                    { f32x16 acc[2];
#pragma unroll
                      for (int i = 0; i < 16; ++i) { acc[0][i] = 0.f; acc[1][i] = 0.f; }
#pragma unroll
                      for (int ks = 0; ks < 4; ++ks) { const bf16x8 a = *(const LAS bf16x8*)(xcb + r32 * 528 + (gh * 64 + 16 * ks + 8 * hi) * 2); acc[0] = mfma32(a, bW[0][ks], acc[0]); acc[1] = mfma32(a, bW[1][ks], acc[1]); }
                      LAS float* gd = gg == 0 ? gR : gI;
#pragma unroll
                      for (int i = 0; i < 16; ++i) { const int tok = (i & 3) + 8 * (i >> 2) + 4 * hi; gd[tok * 256 + gh * 64 + r32] = sigmoidf_(acc[0][i] + gbias0); gd[tok * 256 + gh * 64 + 32 + r32] = sigmoidf_(acc[1][i] + gbias1); } }
                    __syncthreads();
                    float hst = 0.f, Ac = 1.f;
#pragma unroll 4
                    for (int tt = 0; tt < 16; ++tt) {
                        const int rr = half * 16 + tt;
                        const float la = -8.f * gR[rr * 256 + ch] * sp, x2 = 2.f * la;
                        const float av = la > -0.25f ? 1.f + la * (1.f + la * (0.5f + la * (0.16666667f + la * (0.041666667f + la * 0.0083333333f)))) : __expf(la);
                        const float om = x2 > -0.5f ? -x2 * (1.f + x2 * (0.5f + x2 * (0.16666667f + x2 * (0.041666667f + x2 * (0.0083333333f + x2 * 0.0013888889f))))) : 1.f - __expf(x2);
                        const float u = __builtin_amdgcn_sqrtf(om) * (gI[rr * 256 + ch] * xc[rr * 256 + ch]);
                        hst = av * hst + u; Ac *= av;
                        { const size_t ao = ((size_t)b * SEQ + t0 + rr) * 256 + ch; LRA[ao] = av; LRU_[ao] = u; }
                    }
                    const size_t so = ((size_t)(b * 512 + tb * 2 + half)) * 256 + ch;
                    LA[so] = Ac; LH[so] = hst;
                    __syncthreads();
            }
            }
            {
                const int kk = tid & 127, tq = tid >> 7, r32 = lane & 31, hi = lane >> 5;
                float wg[16]; const float bg = inp(args, 16)[l * 128 + kk];
#pragma unroll
                for (int q = 0; q < 16; ++q) wg[q] = inp(args, 15)[(l * 16 + q) * 128 + kk];
                LAS float* glr = ldsf; LAS float* tot = ldsf + 1024; LAS unsigned char* KTl = lds + 8192; LAS unsigned char* VTl = lds + 8192 + 128 * VSTR;
                float* BCS = (float*)(ws + WS_BCS);
            for (int r_ = bid; r_ < N_J2 * REP_J2; r_ += G) { const int r = r_ % N_J2;
                    const int b = r >> 7, c = r & 127; const size_t row0 = (size_t)b * SEQ + 64 * c;
                    for (int e = tid; e < 1024; e += NTHR) glr[e] = bf2f(PB[(row0 + (e >> 4)) * NIN + C_GLR + (e & 15)]);
                    for (int e = tid; e < 2048; e += NTHR) { const int jj = e >> 5, hc = e & 31; const bf16_t* vsrc = PB + (row0 + jj) * NIN + C_CV + 8 * hc; const u32x2 wA = *(const u32x2*)vsrc, wB = *(const u32x2*)(vsrc + 4);
                        LAS bf16_t* d = (LAS bf16_t*)(VTl + (8 * hc) * VSTR) + jj;
                        d[0] = (bf16_t)wA.x; d[VSTR / 2] = (bf16_t)(wA.x >> 16); d[2 * (VSTR / 2)] = (bf16_t)wA.y; d[3 * (VSTR / 2)] = (bf16_t)(wA.y >> 16); d[4 * (VSTR / 2)] = (bf16_t)wB.x; d[5 * (VSTR / 2)] = (bf16_t)(wB.x >> 16); d[6 * (VSTR / 2)] = (bf16_t)wB.y; d[7 * (VSTR / 2)] = (bf16_t)(wB.y >> 16); }
                    __syncthreads();
                    float bv[16]; float run = 0.f;
#pragma unroll
                    for (int tt = 0; tt < 16; ++tt) { const LAS f32x4* g4 = (const LAS f32x4*)(glr + (16 * tq + tt) * 16); float z = bg;
#pragma unroll
                        for (int q = 0; q < 4; ++q) { const f32x4 g = g4[q]; z += g[0] * wg[4 * q] + g[1] * wg[4 * q + 1] + g[2] * wg[4 * q + 2] + g[3] * wg[4 * q + 3]; }
                        run += (fminf(z, 0.f) - __logf(1.f + __expf(-fabsf(z)))) * (1.f / 16.f); bv[tt] = run; }
                    tot[tq * 128 + kk] = run;
                    __syncthreads();
                    { const float t0_ = tot[kk], t1_ = tot[128 + kk], t2_ = tot[256 + kk], t3_ = tot[384 + kk]; const float off = tq == 0 ? 0.f : (tq == 1 ? t0_ : (tq == 2 ? t0_ + t1_ : (t0_ + t1_) + t2_)), blast = ((t0_ + t1_) + t2_) + t3_;
#pragma unroll
                      for (int tt = 0; tt < 16; ++tt) { const int t = 16 * tq + tt; const float bt = bv[tt] + off; BCS[(row0 + t) * 128 + kk] = bt;
                          *((LAS bf16_t*)(KTl + kk * VSTR) + t) = f2bf(bf2f(PB[(row0 + t) * NIN + C_CK + kk]) * __expf(blast - bt)); }
                      if (tq == 0) DEC[(size_t)(b * 128 + c) * 128 + kk] = __expf(blast); }
                    __syncthreads();
                    { const int h = wave >> 1, nt = wave & 1; f32x16 acc;
#pragma unroll
                      for (int i = 0; i < 16; ++i) acc[i] = 0.f;
                      const LAS unsigned char* ap = KTl + (h * 32 + r32) * VSTR + 16 * hi; const LAS unsigned char* bp = VTl + (h * 64 + 32 * nt + r32) * VSTR + 16 * hi;
#pragma unroll
                      for (int s = 0; s < 4; ++s) { const u32x2 a0 = *(const LAS u32x2*)(ap + 32 * s), a1 = *(const LAS u32x2*)(ap + 32 * s + 8), b0 = *(const LAS u32x2*)(bp + 32 * s), b1 = *(const LAS u32x2*)(bp + 32 * s + 8);
                          u32x4 aw, bw; aw.x = a0.x; aw.y = a0.y; aw.z = a1.x; aw.w = a1.y; bw.x = b0.x; bw.y = b0.y; bw.z = b1.x; bw.w = b1.y;
                          acc = mfma32(__builtin_bit_cast(bf16x8, aw), __builtin_bit_cast(bf16x8, bw), acc); }
                      float* o = KVC + ((size_t)(b * 128 + c) * 4 + h) * 2048 + 32 * nt + r32;
#pragma unroll
                      for (int i = 0; i < 16; ++i) o[((i & 3) + 8 * (i >> 2) + 4 * hi) * 64] = acc[i]; }
                    __syncthreads();
            }
            }
            for (int r = bid; r < N_J4; r += G) {
                    const size_t row0 = (size_t)r * 64;
#pragma unroll
                    for (int it3 = 0; it3 < 3; ++it3) {
                        const int e = tid + it3 * NTHR, tok = e / 24, p = e % 24, hd = p >> 2, c8 = p & 3; const int base = hd < 4 ? C_BQ + hd * 64 : (hd == 4 ? C_KS : C_KW); const float sc = hd < 4 ? 0.125f * LOG2E : 1.f;
                        bf16_t* pr = PB + (row0 + tok) * NIN + base + 8 * c8; const u32x4 a = *(const u32x4*)pr, c = *(const u32x4*)(pr + 32); const float2* cs = cs64 + (row0 + tok) * 32 + 8 * c8;
                        const unsigned au[4] = {a.x, a.y, a.z, a.w}, cu[4] = {c.x, c.y, c.z, c.w}; unsigned o1[4], o2[4];
#pragma unroll
                        for (int q = 0; q < 4; ++q) { const float2 s0 = cs[2 * q], s1 = cs[2 * q + 1]; const float x1a = bflo(au[q]), x1b = bfhi(au[q]), x2a = bflo(cu[q]), x2b = bfhi(cu[q]);
                            o1[q] = pk2((x1a * s0.x - x2a * s0.y) * sc, (x1b * s1.x - x2b * s1.y) * sc); o2[q] = pk2((x2a * s0.x + x1a * s0.y) * sc, (x2b * s1.x + x1b * s1.y) * sc); }
                        u32x4 w1, w2; w1.x = o1[0]; w1.y = o1[1]; w1.z = o1[2]; w1.w = o1[3]; w2.x = o2[0]; w2.y = o2[1]; w2.z = o2[2]; w2.w = o2[3];
                        *(u32x4*)pr = w1; *(u32x4*)(pr + 32) = w2;
                        if (hd == 4) {
                            bf16_t* kf_ = KSF + (row0 / 64) * 4096 + (size_t)((((tok >> 5) * 4 + (c8 >> 1)) * 64 + (c8 & 1) * 32 + (tok & 31)) * 8); *(u32x4*)kf_ = w1; *(u32x4*)(kf_ + 2 * 64 * 8) = w2; } }
                    { LAS bf16_t* tl = (LAS bf16_t*)lds; const size_t bb = row0 / SEQ, t0 = row0 % SEQ;
                      for (int mtx = 0; mtx < 2; ++mtx) { const int tok = tid >> 3, c = tid & 7; const u32x4 w = *(const u32x4*)(PB + (row0 + tok) * NIN + (mtx ? C_VW : C_VS) + c * 8);
                          LAS bf16_t* dst = tl + mtx * 64 * 72 + tok * 72 + c * 8; dst[0] = (bf16_t)w.x; dst[1] = (bf16_t)(w.x >> 16); dst[2] = (bf16_t)w.y; dst[3] = (bf16_t)(w.y >> 16); dst[4] = (bf16_t)w.z; dst[5] = (bf16_t)(w.z >> 16); dst[6] = (bf16_t)w.w; dst[7] = (bf16_t)(w.w >> 16); }
                      __syncthreads();
                      for (int mtx = 0; mtx < 2; ++mtx) { const int d = tid >> 3, c8 = tid & 7; const LAS bf16_t* s = tl + mtx * 64 * 72 + (c8 * 8) * 72 + d;
                          u32x4 w; w.x = (unsigned)s[0] | ((unsigned)s[72] << 16); w.y = (unsigned)s[2 * 72] | ((unsigned)s[3 * 72] << 16); w.z = (unsigned)s[4 * 72] | ((unsigned)s[5 * 72] << 16); w.w = (unsigned)s[6 * 72] | ((unsigned)s[7 * 72] << 16);
                          if (mtx) *(u32x4*)(VWT + (bb * 64 + d) * SEQ + t0 + c8 * 8) = w;
                          else { const int s_ = c8 >> 1, h_ = c8 & 1; const LAS bf16_t* q = tl + (16 * s_ + 4 * h_) * 72 + d;
                              u32x4 f; f.x = (unsigned)q[0] | ((unsigned)q[72] << 16); f.y = (unsigned)q[2 * 72] | ((unsigned)q[3 * 72] << 16); f.z = (unsigned)q[8 * 72] | ((unsigned)q[9 * 72] << 16); f.w = (unsigned)q[10 * 72] | ((unsigned)q[11 * 72] << 16);
                              *(u32x4*)(VST + (row0 / 64) * 4096 + (size_t)((((d >> 5) * 4 + s_) * 64 + h_ * 32 + (d & 31)) * 8)) = f; } }
                      __syncthreads(); }
            }
            }
        }
        SEAM(pb + 1);
        if (IN(pb + 2)) {
        const int l_ = l; WS_PTRS();
        LAUNDER_TID();
            constexpr int Q_J5 = 2, Q_J6 = 64, Q_ATT = 1024 * REP_ATT, Q_J9 = 1024, Q_J10 = 512, Q_TOT = Q_J5 + Q_J6 + Q_ATT + Q_J9 + Q_J10;
            if (tid == 0) { LCTL[4] = 0u; LCTL[5] = 0u; }
            __syncthreads();
            const int tid_o = tid;
            for (;;) {
                int tid = tid_o; asm volatile("" : "+v"(tid)); const int lane = tid & 63;
                if (tid == 0) LCTL[2] = __hip_atomic_fetch_add(ctl + CW_QUEUE + 64 * l, 1u, __ATOMIC_RELAXED, __HIP_MEMORY_SCOPE_AGENT);
                __syncthreads();
                int r = __builtin_amdgcn_readfirstlane((int)LCTL[2]); const unsigned seen5 = LCTL[4], seen6 = LCTL[5];
                __syncthreads();
                if (r >= Q_TOT * REP_P3) break;
                if (REP_P3 > 1 && r >= Q_TOT) r -= Q_TOT;
                if (r < Q_J5) {
                    const int e = r * NTHR + tid, b = e >> 8, ch = e & 255; float carry = 0.f;
                    for (int c0 = 0; c0 < 512; c0 += 8) { float av[8], hv[8];
#pragma unroll
                        for (int q = 0; q < 8; ++q) { const size_t so = ((size_t)(b * 512 + c0 + q)) * 256 + ch; av[q] = LA[so]; hv[q] = LH[so]; }
#pragma unroll
                        for (int q = 0; q < 8; ++q) { CIN[((size_t)(b * 512 + c0 + q)) * 256 + ch] = carry; carry = av[q] * carry + hv[q]; } }
                    asm volatile("s_waitcnt vmcnt(0)" ::: "memory"); __syncthreads();
                    if (tid == 0) { __builtin_amdgcn_fence(__ATOMIC_RELEASE, "agent"); asm volatile("s_waitcnt vmcnt(0)" ::: "memory"); (void)xb_add(ctl + CW_FLAG + 64 * (2 * l + 0), 1u); }
                    continue;
                }
                r -= Q_J5;
                if (r < Q_J6) {
                    const int e = r * NTHR + tid, b = e >> 13, rem = e & 8191; float Sv = 0.f;
                    for (int c0 = 0; c0 < 128; c0 += 8) { float kv[8], dv[8];
#pragma unroll
                        for (int q = 0; q < 8; ++q) { kv[q] = KVC[(size_t)(b * 128 + c0 + q) * 8192 + rem]; dv[q] = DEC[(size_t)(b * 128 + c0 + q) * 128 + (rem >> 6)]; }
#pragma unroll
                        for (int q = 0; q < 8; ++q) { SST[(size_t)(b * 128 + c0 + q) * 8192 + rem] = Sv; Sv = dv[q] * Sv + kv[q]; } }
                    asm volatile("s_waitcnt vmcnt(0)" ::: "memory"); __syncthreads();
                    if (tid == 0) { __builtin_amdgcn_fence(__ATOMIC_RELEASE, "agent"); asm volatile("s_waitcnt vmcnt(0)" ::: "memory"); (void)xb_add(ctl + CW_FLAG + 64 * (2 * l + 1), 1u); }
                    continue;
                }
                r -= Q_J6;
                if (r >= Q_ATT) {
                    r -= Q_ATT; const bool is9 = r < Q_J9;
                    if (!(is9 ? seen5 : seen6)) {
                        if (tid == 0) { unsigned* f = ctl + CW_FLAG + 64 * (2 * l + (is9 ? 0 : 1)); const unsigned target = is9 ? (unsigned)Q_J5 : (unsigned)Q_J6;
                            XB_SPIN(xb_ld(f) < target, ctl + CW_BAR); __builtin_amdgcn_fence(__ATOMIC_ACQUIRE, "agent"); asm volatile("s_waitcnt vmcnt(0)" ::: "memory"); LCTL[is9 ? 4 : 5] = 1u; }
                        __syncthreads(); }
                    if (is9) {
                    const int b = r >> 8, tb = r & 255, t0 = tb * 32, ch = tid & 255, half = tid >> 8;
                    LAS float* xa = ldsf;
                    float hst = CIN[((size_t)(b * 512 + tb * 2 + half)) * 256 + ch];
                    { float av[16], uv[16], gv[16];
#pragma unroll
                      for (int tt = 0; tt < 16; ++tt) { const size_t ro = (size_t)b * SEQ + t0 + half * 16 + tt; av[tt] = LRA[ro * 256 + ch]; uv[tt] = LRU_[ro * 256 + ch]; gv[tt] = bf2f(PB[ro * NIN + C_AG + ch]); }
#pragma unroll
                      for (int tt = 0; tt < 16; ++tt) { hst = av[tt] * hst + uv[tt]; xa[(half * 16 + tt) * 256 + ch] = hst * gelu_tanh(gv[tt]); } }
                    __syncthreads();
                    for (int q = 0; q < 4; ++q) { const int rr = wave * 4 + q; const f32x4 v = ((const LAS f32x4*)(xa + rr * 256))[lane];
                        const float rinv = rsqrtf(wave_sum(v[0] * v[0] + v[1] * v[1] + v[2] * v[2] + v[3] * v[3]) * (1.f / 256.f) + EPS);
                        u32x2 w; w.x = pk2(v[0] * rinv, v[1] * rinv); w.y = pk2(v[2] * rinv, v[3] * rinv);
                        *(u32x2*)(Y + ((size_t)b * SEQ + t0 + rr) * DM + 256 + 4 * lane) = w; }
                    __syncthreads();
                    } else { r -= Q_J9;
                    const int b = r >> 7, c = r & 127; const size_t row0 = (size_t)b * SEQ + 64 * c;
                    LAS float* bL = ldsf; LAS float* glr = ldsf + 8192; LAS unsigned char* VTl = lds + 36864; LAS unsigned char* STl = lds + 71680; LAS float* SSX = (LAS float*)(lds + 92160);
                    for (int e = tid; e < 2048; e += NTHR) ((LAS f32x4*)bL)[e] = ((const f32x4*)((const float*)(ws + WS_BCS) + row0 * 128))[e];
                    for (int e = tid; e < 2048; e += NTHR) { const int jj = e >> 5, hc = e & 31, h = hc >> 3, c8 = hc & 7; const bf16_t* vsrc = PB + (row0 + jj) * NIN + C_CV + h * 64 + 8 * c8; const u32x2 wA = *(const u32x2*)vsrc, wB = *(const u32x2*)(vsrc + 4); u32x4 w; w.x = wA.x; w.y = wA.y; w.z = wB.x; w.w = wB.y;
                        LAS bf16_t* d = (LAS bf16_t*)(VTl + h * 8704 + (8 * c8) * VSTR) + jj;
                        d[0] = (bf16_t)w.x; d[VSTR / 2] = (bf16_t)(w.x >> 16); d[2 * (VSTR / 2)] = (bf16_t)w.y; d[3 * (VSTR / 2)] = (bf16_t)(w.y >> 16); d[4 * (VSTR / 2)] = (bf16_t)w.z; d[5 * (VSTR / 2)] = (bf16_t)(w.z >> 16); d[6 * (VSTR / 2)] = (bf16_t)w.w; d[7 * (VSTR / 2)] = (bf16_t)(w.w >> 16); }
                    for (int e = tid; e < 8192; e += NTHR) { const int h = e >> 11, k = (e >> 6) & 31, v = e & 63; *(LAS bf16_t*)(STl + h * 5120 + v * 80 + k * 2) = f2bf(SST[(size_t)(b * 128 + c) * 8192 + e]); }
                    __syncthreads();
                    { const int r32 = lane & 31, hi = lane >> 5, h = wave >> 1, ih = wave & 1, i = 32 * ih + r32; const float SCG = 0.17677669529663687f;
                      bf16x8 qrel[2], qabs[2], kt[2][2];
#pragma unroll
                      for (int ks = 0; ks < 2; ++ks) { const int k0 = h * 32 + 16 * ks + 8 * hi; const bf16x8 qv = ld8x2(PB + (row0 + i) * NIN + C_CQ + k0); u32x4 wr_, wa_; unsigned* pr_ = (unsigned*)&wr_; unsigned* pa_ = (unsigned*)&wa_;
#pragma unroll
                          for (int e2 = 0; e2 < 4; ++e2) { const float b0 = bL[i * 128 + k0 + 2 * e2], b1 = bL[i * 128 + k0 + 2 * e2 + 1], f0 = bL[31 * 128 + k0 + 2 * e2], f1 = bL[31 * 128 + k0 + 2 * e2 + 1];
                              const float q0 = bf2f((bf16_t)qv[2 * e2]) * SCG, q1 = bf2f((bf16_t)qv[2 * e2 + 1]) * SCG;
                              pr_[e2] = cvtpk(q0 * __expf(b0 - f0), q1 * __expf(b1 - f1)); pa_[e2] = cvtpk(q0 * __expf(b0), q1 * __expf(b1)); }
                          qrel[ks] = __builtin_bit_cast(bf16x8, wr_); qabs[ks] = __builtin_bit_cast(bf16x8, wa_); }
#pragma unroll
                      for (int jt = 0; jt < 2; ++jt)
#pragma unroll
                          for (int ks = 0; ks < 2; ++ks) { const int jr = 32 * jt + r32, k0 = h * 32 + 16 * ks + 8 * hi; const bf16x8 kv = ld8x2(PB + (row0 + jr) * NIN + C_CK + k0); u32x4 wk_; unsigned* pk_ = (unsigned*)&wk_;
#pragma unroll
                              for (int e2 = 0; e2 < 4; ++e2) { const float b0 = bL[jr * 128 + k0 + 2 * e2], b1 = bL[jr * 128 + k0 + 2 * e2 + 1], f0 = bL[31 * 128 + k0 + 2 * e2], f1 = bL[31 * 128 + k0 + 2 * e2 + 1];
                                  pk_[e2] = cvtpk(bf2f((bf16_t)kv[2 * e2]) * __expf(f0 - b0), bf2f((bf16_t)kv[2 * e2 + 1]) * __expf(f1 - b1)); }
                              kt[jt][ks] = __builtin_bit_cast(bf16x8, wk_); }
                      f32x16 o[2], s[2];
#pragma unroll
                      for (int q = 0; q < 16; ++q) { o[0][q] = 0.f; o[1][q] = 0.f; s[0][q] = 0.f; s[1][q] = 0.f; }
#pragma unroll
                      for (int ks = 0; ks < 2; ++ks) s[0] = mfma32(kt[0][ks], qrel[ks], s[0]);
                      if (ih) {
#pragma unroll
                          for (int ks = 0; ks < 2; ++ks) s[1] = mfma32(kt[1][ks], qrel[ks], s[1]); }
#pragma unroll
                      for (int q = 0; q < 16; ++q) { const int jr = (q & 3) + 8 * (q >> 2) + 4 * hi; if (jr > r32) { if (ih) s[1][q] = 0.f; else s[0][q] = 0.f; } }
                      const LAS unsigned char* VTh = VTl + h * 8704; const LAS unsigned char* STh = STl + h * 5120;
#pragma unroll
                      for (int dt = 0; dt < 2; ++dt) { const LAS unsigned char* vp = VTh + (32 * dt + r32) * VSTR + 8 * hi;
                          o[dt] = mfma32(vfrag(vp), pack8<0>(s[0]), o[dt]); o[dt] = mfma32(vfrag(vp + 32), pack8<8>(s[0]), o[dt]);
                          if (ih) { o[dt] = mfma32(vfrag(vp + 64), pack8<0>(s[1]), o[dt]); o[dt] = mfma32(vfrag(vp + 96), pack8<8>(s[1]), o[dt]); }
#pragma unroll
                          for (int ks = 0; ks < 2; ++ks) o[dt] = mfma32(*(const LAS bf16x8*)(STh + (32 * dt + r32) * 80 + 32 * ks + 16 * hi), qabs[ks], o[dt]); }
                      float ssh = 0.f;
#pragma unroll
                      for (int q = 0; q < 16; ++q) ssh += o[0][q] * o[0][q] + o[1][q] * o[1][q];
                      const float rh = rsqrtf(xhalf_sum(ssh) * (1.f / 64.f) + EPS); float ssg = 0.f;
#pragma unroll
                      for (int dt = 0; dt < 2; ++dt)
#pragma unroll
                          for (int g = 0; g < 4; ++g) { const int v0 = 32 * dt + 8 * g + 4 * hi; const u32x2 ogw = *(const u32x2*)(PB + (row0 + i) * NIN + C_OG + h * 64 + v0); const f32x4 gn = *(const f32x4*)(inp(args, 17) + l * 64 + v0);
                              const float og4[4] = {bflo(ogw.x), bfhi(ogw.x), bflo(ogw.y), bfhi(ogw.y)};
#pragma unroll
                              for (int q = 0; q < 4; ++q) { const float y = o[dt][4 * g + q] * rh * gn[q] * (og4[q] * sigmoidf_(og4[q])); o[dt][4 * g + q] = y; ssg += y * y; } }
                      ssg = xhalf_sum(ssg); if (hi == 0) SSX[i * 4 + h] = ssg;
                      __syncthreads();
                      const f32x4 s4 = *(const LAS f32x4*)(SSX + i * 4); const float rinv = rsqrtf((s4[0] + s4[1] + s4[2] + s4[3]) * (1.f / 256.f) + EPS);
#pragma unroll
                      for (int dt = 0; dt < 2; ++dt)
#pragma unroll
                          for (int g = 0; g < 4; ++g) { u32x2 w; w.x = cvtpk(o[dt][4 * g] * rinv, o[dt][4 * g + 1] * rinv); w.y = cvtpk(o[dt][4 * g + 2] * rinv, o[dt][4 * g + 3] * rinv);
                              *(u32x2*)(Y + (row0 + i) * DM + 768 + h * 64 + 32 * dt + 8 * g + 4 * hi) = w; } }
                    __syncthreads();
                    }
                    continue;
                }
                const int r32 = lane & 31, hi = lane >> 5;
                const int rep = r >> 10; r &= 1023;
                const int grp = r >> 5, within = r & 31;
                if (rep && ((REP_ONLY == 1 && within >= 16) || (REP_ONLY == 2 && within < 16))) continue;
              {
                if (within >= 16) {
                    const int idx = within - 16, b = idx & 3, tb = 127 - (4 * grp + (idx >> 2));
                    const int tl = 8 * wave + (r32 >> 2), head = r32 & 3, T = 64 * tb + tl; const size_t row = (size_t)b * SEQ + T; const bf16_t* prow = PB + row * NIN;
                    bf16x8 qf[4];
#pragma unroll
                    for (int ks = 0; ks < 4; ++ks) qf[ks] = *(const bf16x8*)(prow + C_BQ + head * 64 + 16 * ks + 8 * hi);
                    LAS float* impb = (LAS float*)(lds + AL_IMP) + wave * 1024; LAS unsigned* selm = (LAS unsigned*)(lds + AL_SELM) + wave * 32;
                    const int skey = tid >> 3, sch = tid & 7;
                    const unsigned koffP = (unsigned)(skey * NIN + sch * 8), voffS = (unsigned)(skey * SEQ + sch * 8), koffC = (unsigned)(skey * 64 + sch * 8), voffC = (unsigned)(skey * 512 + sch * 8);
                    auto stK = [&](int buf, const StageRegs& R) __attribute__((always_inline)) { *(LAS u32x4*)(lds + (buf ? AL_K1 : AL_K0) + skey * KSTR + sch * 16) = R.a; };
                    auto stKV = [&](int buf, const StageRegs& R) __attribute__((always_inline)) { *(LAS u32x4*)(lds + (buf ? AL_K1 : AL_K0) + skey * KSTR + sch * 16) = R.a;
                        LAS unsigned char* vd = lds + (buf ? AL_V1 : AL_V0) + skey * VSTP + (sch >> 1) * 32 + (sch & 1) * 8; u32x2 a, c; a.x = R.b.x; a.y = R.b.y; c.x = R.b.z; c.y = R.b.w; *(LAS u32x2*)vd = a; *(LAS u32x2*)(vd + 16) = c; };
                    f32x16 oacc[2], ob[2];
                    const int nv = T >= 31 ? ((T - 31) >> 4) + 1 : 0, ntc = (4 * tb + 3 + 63) >> 6;
                    float mC = NEGB, lC = 0.f;
                    { const bf16_t* kb_ = KCMPB + (size_t)b * 512 * 64;
                      attn_pipeline(0, ntc - 1, [&](int j, StageRegs& R) __attribute__((always_inline)) { R.a = *(const u32x4*)((kb_ + (size_t)j * 64 * 64) + koffC); }, stK,
                        [&](int j, int cb) __attribute__((always_inline)) { f32x16 s0, s1; qk_tile<4>(lds + (cb ? AL_K1 : AL_K0), qf, r32, hi, s0, s1); if (!__all(nv - 1 - 64 * j >= 63)) mask_tile(s0, s1, 0, nv - 1 - 64 * j, hi);
                            const float mx = tile_max(s0, s1), mn = fmaxf(mC, mx), ms = mn < -1e29f ? 0.f : mn, alpha = ex2(mC - ms); mC = mn; float ps = 0.f;
#pragma unroll
                            for (int i = 0; i < 16; ++i) ps += ex2(s0[i] - ms) + ex2(s1[i] - ms);
                            lC = lC * alpha + ps; }); }
                    { const float invC = 1.f / fmaxf(xhalf_sum(lC), 1e-30f), msC = mC < -1e29f ? 0.f : mC; float carry = 0.f;
#pragma unroll
                      for (int i = 0; i < 16; ++i) { ob[0][i] = 0.f; ob[1][i] = 0.f; }
                      const bf16_t* kb_ = KCMPB + (size_t)b * 512 * 64; const bf16_t* vb_ = VCMPT + (size_t)b * 64 * 512;
                      attn_pipeline(0, ntc - 1, [&](int j, StageRegs& R) __attribute__((always_inline)) { R.a = *(const u32x4*)((kb_ + (size_t)j * 64 * 64) + koffC); R.b = *(const u32x4*)((vb_ + j * 64) + voffC); }, stKV,
                        [&](int j, int cb) __attribute__((always_inline)) { f32x16 s0, s1; qk_tile<4>(lds + (cb ? AL_K1 : AL_K0), qf, r32, hi, s0, s1); if (!__all(nv - 1 - 64 * j >= 63)) mask_tile(s0, s1, 0, nv - 1 - 64 * j, hi);
#pragma unroll
                            for (int i = 0; i < 16; ++i) { s0[i] = ex2(s0[i] - msC) * invC; s1[i] = ex2(s1[i] - msC) * invC; }
                            float gs[8], pl[8];
#pragma unroll
                            for (int q = 0; q < 4; ++q) { gs[q] = (s0[4 * q] + s0[4 * q + 1]) + (s0[4 * q + 2] + s0[4 * q + 3]); gs[4 + q] = (s1[4 * q] + s1[4 * q + 1]) + (s1[4 * q + 2] + s1[4 * q + 3]);
                                pl[q] = __shfl_xor(s0[4 * q + 3], 32); pl[4 + q] = __shfl_xor(s1[4 * q + 3], 32); }
#pragma unroll
                            for (int q = 0; q < 8; ++q) { const float prev = hi ? pl[q] : (q > 0 ? pl[q > 0 ? q - 1 : 0] : carry); float x = gs[q] + prev; x += __shfl_xor(x, 1); x += __shfl_xor(x, 2);
                                if ((r32 & 3) == 0) impb[(r32 >> 2) * 128 + 16 * j + 2 * q + hi] = x; }
                            carry = pl[7];
                            pv_tile(s0, s1, lds + (cb ? AL_V1 : AL_V0), ob, r32, hi); }); }
                    LAS float* oav = (LAS float*)(lds + AL_OACC) + tid; const float g0 = sigmoidf_(bf2f(prow[C_BG + head * 3]));
#pragma unroll
                    for (int i = 0; i < 16; ++i) { oav[i * 512] = g0 * ob[0][i]; oav[(16 + i) * 512] = g0 * ob[1][i]; }
                    WSYNC();
                    for (int tk = 0; tk < 8; ++tk) {
                        const int cur = tb, j0 = lane, j1 = lane + 64; const float im0 = impb[tk * 128 + j0], im1 = impb[tk * 128 + j1];
                        const unsigned k0 = ((j0 == 0 || j0 == cur || j0 == cur - 1) ? 0xFF000000u : (j0 <= cur ? (__float_as_uint(im0) & ~127u) : 0u)) | (unsigned)(127 - j0);
                        const unsigned k1 = ((j1 == cur || j1 == cur - 1) ? 0xFF000000u : (j1 <= cur ? (__float_as_uint(im1) & ~127u) : 0u)) | (unsigned)(127 - j1);
                        unsigned T = 0u;
#pragma unroll 4
                        for (int bb = 31; bb >= 0; --bb) { const unsigned cand = T | (1u << bb); const int cnt = __popcll(__ballot(k0 >= cand)) + __popcll(__ballot(k1 >= cand)); if (cnt >= 16) T = cand; }
                        const unsigned long long m0 = __ballot(k0 >= T), m1 = __ballot(k1 >= T);
                        if (lane == 0) { selm[tk * 4] = (unsigned)m0; selm[tk * 4 + 1] = (unsigned)(m0 >> 32); selm[tk * 4 + 2] = (unsigned)m1; selm[tk * 4 + 3] = (unsigned)(m1 >> 32); }
                    }
                    WSYNC();
                    const unsigned sm0 = selm[(r32 >> 2) * 4], sm1 = selm[(r32 >> 2) * 4 + 1], sm2 = selm[(r32 >> 2) * 4 + 2], sm3 = selm[(r32 >> 2) * 4 + 3];
                    { SoftState SB; soft_init(SB, ob);
                      unsigned u0 = sm0, u1 = sm1, u2 = sm2, u3 = sm3;
#pragma unroll
                      for (int o_ = 1; o_ < 64; o_ <<= 1) { u0 |= (unsigned)__shfl_xor((int)u0, o_); u1 |= (unsigned)__shfl_xor((int)u1, o_); u2 |= (unsigned)__shfl_xor((int)u2, o_); u3 |= (unsigned)__shfl_xor((int)u3, o_); }
                      unsigned long long Ulo = ((unsigned long long)(unsigned)__builtin_amdgcn_readfirstlane((int)u1) << 32) | (unsigned)__builtin_amdgcn_readfirstlane((int)u0), Uhi = ((unsigned long long)(unsigned)__builtin_amdgcn_readfirstlane((int)u3) << 32) | (unsigned)__builtin_amdgcn_readfirstlane((int)u2);
                      if (tb < 64) { if (tb < 63) Ulo &= (2ull << tb) - 1ull; Uhi = 0ull; } else if (tb < 127) Uhi &= (2ull << (tb - 64)) - 1ull;
                      const bf16_t* ksf = KSF + (size_t)b * 128 * 4096; const bf16_t* vsf = VST + (size_t)b * 128 * 4096; const unsigned lo8 = (unsigned)lane * 8u;
                      bf16x8 kf[2][4], vf[2][4];
                      int j = 0; Ulo &= ~1ull;
#pragma unroll
                      for (int f = 0; f < 8; ++f) kf[f >> 2][f & 3] = *(const bf16x8*)((ksf + f * 512) + lo8);
                      bool first = true;
                      for (;;) {
#pragma unroll
                          for (int f = 0; f < 8; ++f) vf[f >> 2][f & 3] = *(const bf16x8*)((vsf + (size_t)j * 4096 + f * 512) + lo8);
                          const unsigned wsel = j < 32 ? sm0 : (j < 64 ? sm1 : (j < 96 ? sm2 : sm3)); const bool bit = (wsel >> (j & 31)) & 1u;
                          const f32x16 cinit = bcast16(bit ? -SB.m : NEGB); f32x16 s0 = cinit, s1 = cinit;
#pragma unroll
                          for (int ks = 0; ks < 4; ++ks) { s0 = mfma32(kf[0][ks], qf[ks], s0); s1 = mfma32(kf[1][ks], qf[ks], s1); }
                          __builtin_amdgcn_sched_barrier(0);
                          const int jn = Ulo ? (int)__builtin_ctzll(Ulo) : (Uhi ? 64 + (int)__builtin_ctzll(Uhi) : -1);
                          if (Ulo) Ulo &= Ulo - 1ull; else Uhi &= Uhi - 1ull;
                          if (jn >= 0) {
#pragma unroll
                              for (int f = 0; f < 8; ++f) kf[f >> 2][f & 3] = *(const bf16x8*)((ksf + (size_t)jn * 4096 + f * 512) + lo8); }
                          soft_update(s0, s1, SB, ob, j == tb, 0, tl, first, hi);
                          { const bf16x8 p00 = pack8<0>(s0), p01 = pack8<8>(s0), p10 = pack8<0>(s1), p11 = pack8<8>(s1);
#pragma unroll
                            for (int dt = 0; dt < 2; ++dt) { ob[dt] = mfma32(vf[dt][0], p00, ob[dt]); ob[dt] = mfma32(vf[dt][1], p01, ob[dt]); ob[dt] = mfma32(vf[dt][2], p10, ob[dt]); ob[dt] = mfma32(vf[dt][3], p11, ob[dt]); } }
                          if (jn < 0) break;
                          j = jn; first = false;
                      }
                      const float sc = sigmoidf_(bf2f(prow[C_BG + head * 3 + 1])) / fmaxf(xhalf_sum(SB.l), 1e-30f);
#pragma unroll
                      for (int i = 0; i < 16; ++i) { oav[i * 512] += sc * ob[0][i]; oav[(16 + i) * 512] += sc * ob[1][i]; } }
                    __syncthreads();
                    { SoftState SB; soft_init(SB, ob); const int jb0 = tb >= 8 ? tb - 8 : 0;
                      const bf16_t* kb_ = PB + (size_t)b * SEQ * NIN + C_KW; const bf16_t* vb_ = VWT + (size_t)b * 64 * SEQ;
                      attn_pipeline(tb >= 8 ? tb - 8 : 0, tb, [&](int j, StageRegs& R) __attribute__((always_inline)) { R.a = *(const u32x4*)((kb_ + (size_t)j * 64 * NIN) + koffP); R.b = *(const u32x4*)((vb_ + j * 64) + voffS); }, stKV,
                        [&](int j, int cb) __attribute__((always_inline)) { attn_step<4>(lds + (cb ? AL_K1 : AL_K0), lds + (cb ? AL_V1 : AL_V0), qf, SB, ob, j == tb || j == tb - 8, j == tb - 8 ? tl + 1 : 0, j == tb ? tl : 63, j == jb0, r32, hi); });
                      const float sc = sigmoidf_(bf2f(prow[C_BG + head * 3 + 2])) / fmaxf(xhalf_sum(SB.l), 1e-30f);
#pragma unroll
                      for (int i = 0; i < 16; ++i) { oacc[0][i] = oav[i * 512] + sc * ob[0][i]; oacc[1][i] = oav[(16 + i) * 512] + sc * ob[1][i]; } }
                    { float ss = 0.f;
#pragma unroll
                      for (int i = 0; i < 16; ++i) ss += oacc[0][i] * oacc[0][i] + oacc[1][i] * oacc[1][i];
                      ss = xhalf_sum(ss); ss += __shfl_xor(ss, 1); ss += __shfl_xor(ss, 2);
                      const float rinv = rsqrtf(ss * (1.f / 256.f) + EPS);
#pragma unroll
                      for (int dt = 0; dt < 2; ++dt)
#pragma unroll
                          for (int g = 0; g < 4; ++g) { u32x2 w; w.x = cvtpk(oacc[dt][4 * g] * rinv, oacc[dt][4 * g + 1] * rinv); w.y = cvtpk(oacc[dt][4 * g + 2] * rinv, oacc[dt][4 * g + 3] * rinv);
                              *(u32x2*)(Y + row * DM + 512 + head * 64 + 32 * dt + 8 * g + 4 * hi) = w; } }
                    __syncthreads();
                    continue;
                }
                {
                    const int qb = 31 - grp, b = within >> 2, h = within & 3;
                    const int T = 256 * qb + 32 * wave + r32; const size_t row = (size_t)b * SEQ + T;
                    bf16x8 qf[6];
#pragma unroll
                    for (int ks = 0; ks < 6; ++ks) qf[ks] = *(const bf16x8*)(MQ + row * 384 + h * 96 + 16 * ks + 8 * hi);
                    f32x16 o[2]; SoftState SM; soft_init(SM, o);
                    const int jd = 4 * qb + (wave >> 1);
                    const bf16_t* kn = MKN + (size_t)b * SEQ * 256 + h * 64; const bf16_t* kr = MKR + (size_t)b * SEQ * 32; const bf16_t* vt = MVT + (size_t)(b * 4 + h) * 64 * SEQ;
                    constexpr int VS2 = 272, AM_K0 = 0, AM_K1 = 128 * KSTR, AM_V0 = 2 * 128 * KSTR, AM_V1 = AM_V0 + 64 * VS2;
                    const int nk = tid >> 3, nc = tid & 7, rkey = tid >> 2, rch = tid & 3, vr = tid >> 4, vc = tid & 15;
                    const unsigned ko0 = (unsigned)(nk * 256 + nc * 8), ko1 = (unsigned)(rkey * 32 + rch * 8), vo_ = (unsigned)(vr * SEQ + vc * 8);
                    attn_pipeline(0, 2 * qb + 1,
                        [&](int jj, StageRegs& R) __attribute__((always_inline)) { const bf16_t* knj = kn + (size_t)jj * 128 * 256; const bf16_t* vtj = vt + jj * 128;
                            R.a = *(const u32x4*)(knj + ko0); R.b = *(const u32x4*)((knj + 64 * 256) + ko0); R.c = *(const u32x4*)((kr + (size_t)jj * 128 * 32) + ko1);
                            R.d = *(const u32x4*)(vtj + vo_); R.e = *(const u32x4*)((vtj + 32 * SEQ) + vo_); },
                        [&](int buf, const StageRegs& R) __attribute__((always_inline)) { LAS unsigned char* kb_ = lds + (buf ? AM_K1 : AM_K0); LAS unsigned char* vb_ = lds + (buf ? AM_V1 : AM_V0) + vr * VS2 + (vc >> 1) * 32 + (vc & 1) * 8;
                            *(LAS u32x4*)(kb_ + nk * KSTR + nc * 16) = R.a; *(LAS u32x4*)(kb_ + (64 + nk) * KSTR + nc * 16) = R.b; *(LAS u32x4*)(kb_ + rkey * KSTR + 128 + rch * 16) = R.c;
                            u32x2 p, q; p.x = R.d.x; p.y = R.d.y; q.x = R.d.z; q.y = R.d.w; *(LAS u32x2*)vb_ = p; *(LAS u32x2*)(vb_ + 16) = q;
                            p.x = R.e.x; p.y = R.e.y; q.x = R.e.z; q.y = R.e.w; *(LAS u32x2*)(vb_ + 32 * VS2) = p; *(LAS u32x2*)(vb_ + 32 * VS2 + 16) = q; },
                        [&](int jj, int cb) __attribute__((always_inline)) {
                            const int j0 = 2 * jj, kd = 32 * (wave & 1) + r32;
                            if (j0 + 1 <= jd) attn_step2<6, VS2>(lds + (cb ? AM_K1 : AM_K0), lds + (cb ? AM_V1 : AM_V0), qf, SM, o, false, 63, j0 + 1 == jd, j0 + 1 == jd ? kd : 63, j0 == 0, r32, hi);
                            else if (j0 <= jd) attn_step<6, VS2>(lds + (cb ? AM_K1 : AM_K0), lds + (cb ? AM_V1 : AM_V0), qf, SM, o, j0 == jd, 0, kd, j0 == 0, r32, hi); });
                    { const float inv = 1.f / fmaxf(xhalf_sum(SM.l), 1e-30f); float ss = 0.f;
#pragma unroll
                      for (int dt = 0; dt < 2; ++dt)
#pragma unroll
                          for (int g = 0; g < 4; ++g) { const float v0 = o[dt][4 * g] * inv, v1 = o[dt][4 * g + 1] * inv, v2 = o[dt][4 * g + 2] * inv, v3 = o[dt][4 * g + 3] * inv; ss += v0 * v0 + v1 * v1 + v2 * v2 + v3 * v3;
                              u32x2 w; w.x = cvtpk(v0, v1); w.y = cvtpk(v2, v3); *(u32x2*)(Y + row * DM + h * 64 + 32 * dt + 8 * g + 4 * hi) = w; }
                      ss = xhalf_sum(ss); if (hi == 0) ssq_d[(size_t)h * M + row] = ss; }
                    __syncthreads();
                }
              }
            }
        }
        SEAM(pb + 2);
        if (IN(pb + 3)) {
        const int l_ = l; WS_PTRS();
            pg8::Gemm g{Y, (const bf16_t*)(ws + WS_WOUT) + (size_t)l * DM * DM, M, DM, DM}; pg8::StaticOrder S; S.init(M, DM, G, bid);
            pg8::EpiResid<true> E{XB, ssq_out, ssq_d, (LAS float*)(lds + 131072)};
            pg8::gemm_phase<pg8::EpiResid<true>, pg8::StaticOrder, true, true>(lds, g, S, E);
            if (REP_G57) { pg8::EpiInProj E2{PB, DM, ssq_mix}; pg8::gemm_phase<pg8::EpiInProj, pg8::StaticOrder, true, true>(lds, g, S, E2); }
        }
        SEAM(pb + 3);
        if (IN(pb + 4)) {
        const int l_ = l; WS_PTRS();
            pg8::Gemm g{XB, (const bf16_t*)(ws + WS_WGU) + (size_t)l * NGU * DM, M, NGU, DM}; pg8::StaticOrder S; S.init(M, NGU, G, bid);
            pg8::EpiSwiglu E{ACT, ssq_out};
            _Pragma("unroll 1") for (int rep = 0; rep < REP_G16; ++rep) pg8::gemm_phase<pg8::EpiSwiglu, pg8::StaticOrder, true, true>(lds, g, S, E);
        }
        SEAM(pb + 4);
        if (IN(pb + 5)) {
        const int l_ = l; WS_PTRS();
            pg8::Gemm g{ACT, (const bf16_t*)(ws + WS_WDN) + (size_t)l * DM * FF, M, DM, FF}; pg8::StaticOrder S; S.init(M, DM, G, bid);
            pg8::EpiResid<false> E{XB, ssq_down, nullptr, (LAS float*)(lds + 131072)};
            pg8::gemm_phase<pg8::EpiResid<false>, pg8::StaticOrder, true, true>(lds, g, S, E);
            if (REP_G57) { pg8::EpiInProj E2{Y, DM, ssq_mix}; pg8::gemm_phase<pg8::EpiInProj, pg8::StaticOrder, true, true>(lds, g, S, E2); }
        }
        SEAM(pb + 5);
    }
    if (IN(13)) {
        const int l_ = 1; WS_PTRS();
        LAUNDER_TID();
        const float* ssqf = ssp_base + (size_t)5 * 4 * M; const int gw = bid * 8 + wave, NGW = G * 8;
        for (int m = gw; m < M; m += NGW) {
            const float rinv = rsqrtf(sum4p(ssqf, m) * (1.f / DM) + EPS);
            const u32x2* xr = (const u32x2*)(XB + (size_t)m * DM) + lane; f32x4* orow = (f32x4*)(args.out + (size_t)m * DM) + lane; const f32x4* gn = (const f32x4*)inp(args, 27) + lane;
#pragma unroll
            for (int j = 0; j < 4; ++j) { const u32x2 w = xr[64 * j]; const f32x4 g = gn[64 * j]; f32x4 v; v[0] = bflo(w.x) * rinv * g[0]; v[1] = bfhi(w.x) * rinv * g[1]; v[2] = bflo(w.y) * rinv * g[2]; v[3] = bfhi(w.y) * rinv * g[3]; orow[64 * j] = v; }
        }
    }
#undef IN
#undef SEAM
}

extern "C" void kernel_launch(void* const* d_in, const int* in_sizes, int n_in, void* d_out, int out_size, void* d_ws, size_t ws_size, hipStream_t stream) {
    static int grid = 0;
    if (grid == 0) {
        if (n_in != 28 || in_sizes[0] != M * DM || out_size != M * DM || ws_size < WS_END) { fprintf(stderr, "kernel_launch: unexpected shapes (n_in %d, ws %zu)\n", n_in, ws_size); grid = -1; return; }
        int dev = 0, cus = 0;
        if (hipGetDevice(&dev) != hipSuccess || hipDeviceGetAttribute(&cus, hipDeviceAttributeMultiprocessorCount, dev) != hipSuccess) { grid = -1; return; }
        if (hipFuncSetAttribute((const void*)fwd, hipFuncAttributeMaxDynamicSharedMemorySize, LDS_BYTES) != hipSuccess) { fprintf(stderr, "kernel_launch: hipFuncSetAttribute failed\n"); grid = -1; return; }
        int per_cu = 0;
        if (hipOccupancyMaxActiveBlocksPerMultiprocessor(&per_cu, (const void*)fwd, NTHR, LDS_BYTES) != hipSuccess || per_cu < 1) fprintf(stderr, "kernel_launch: occupancy query says %d\n", per_cu);
        (void)hipGetLastError();
        grid = cus;
    }
    if (grid < 0) return;
    (void)hipMemsetAsync((char*)d_ws + WS_CTL, 0, CTL_ZERO_BYTES, stream);
    Args a{};
    for (int i = 0; i < 28; ++i) a.in[i] = (const float*)d_in[i];
    a.out = (float*)d_out; a.ws = (unsigned char*)d_ws;
    if (MK_N_LAUNCHES == 1) { a.ph_lo = 0; a.ph_hi = 14; hipLaunchKernelGGL(fwd, dim3(grid), dim3(NTHR), LDS_BYTES, stream, a); }
    else for (int p = 0; p < 14; ++p) { a.ph_lo = p; a.ph_hi = p + 1; hipLaunchKernelGGL(fwd, dim3(grid), dim3(NTHR), LDS_BYTES, stream, a); }
}
```

```cpp
#include <hip/hip_runtime.h>
#include <cstdio>
#include <cstdint>

#ifndef MK_N_LAUNCHES
#define MK_N_LAUNCHES 1
#endif

#define REP_P0 1
#define REP_G16 1
#define REP_G57 0
#define REP_ATT 1
#define STAGGER 6
#define REP_J4B 1
#define REP_J3 1
#define REP_J1 1
#define REP_J2 1
#define REP_P3 1
#define REP_ONLY 0
#define LAS __attribute__((address_space(3)))
#define DI __device__ __forceinline__
typedef unsigned short bf16_t;
typedef short bf16x8 __attribute__((ext_vector_type(8)));
typedef float f32x4 __attribute__((ext_vector_type(4)));
typedef unsigned u32x4 __attribute__((ext_vector_type(4)));
typedef unsigned u32x2 __attribute__((ext_vector_type(2)));

constexpr int NB = 4, SEQ = 8192, M = NB * SEQ, DM = 1024, NIN = 2304, NINS = 2300, FF = 2816, NGU = 2 * FF;
constexpr float EPS = 1e-6f;
constexpr int C_AX = 0, C_AG = 256, C_BQ = 512, C_KC = 768, C_VC = 832, C_KS = 896, C_VS = 960, C_KW = 1024, C_VW = 1088, C_BG = 1152,
              C_CQ = 1164, C_CK = 1292, C_CV = 1420, C_GLR = 1676, C_OG = 1692, C_DCQ = 1948, C_DCKV = 2140, C_DKR = 2268;
constexpr size_t MiB = 1u << 20;
constexpr size_t WS_CTL = 0, CTL_ZERO_BYTES = 1 * MiB;
constexpr size_t WS_ACC = 64 * 1024;
constexpr size_t WS_SSQ0 = 1 * MiB;
constexpr size_t WS_HB = 1 * MiB + 256 * 1024;
constexpr size_t WS_WIN = 2 * MiB, WS_WOUT = 11 * MiB, WS_WGU = 15 * MiB, WS_WDN = 37 * MiB;
constexpr size_t WS_WUQT = 48 * MiB, WS_WUKVT = 48 * MiB + 512 * 1024, WS_W2T = 49 * MiB, WS_W1T = 50 * MiB;
constexpr size_t WS_WGT = 49 * MiB + 512 * 1024, WS_SP = 49 * MiB + 768 * 1024;
constexpr size_t WS_BCS = 352 * MiB;
constexpr size_t WS_CS64 = 64 * MiB, WS_CS32 = 72 * MiB;
constexpr size_t WS_XB = 80 * MiB, WS_Y = 144 * MiB, WS_PB = 208 * MiB, WS_ACT = 208 * MiB;
constexpr size_t WS_LA = 384 * MiB, WS_LH = 386 * MiB, WS_CIN = 388 * MiB;
constexpr size_t WS_KVC = 392 * MiB, WS_DEC = 408 * MiB, WS_SST = 410 * MiB;
constexpr size_t WS_MQ = 428 * MiB, WS_MKN = 452 * MiB, WS_MV = 468 * MiB, WS_MKR = 484 * MiB;
constexpr size_t WS_SSP = 500 * MiB;
constexpr size_t WS_KSF = 504 * MiB;
constexpr size_t WS_VST = 490 * MiB, WS_VWT = 494 * MiB, WS_KCMPB = 498 * MiB, WS_VCMPT = 499 * MiB, WS_END = 508 * MiB;
constexpr int CW_QUEUE = 64;
constexpr int CW_FLAG = 1024;
constexpr int CW_BAR = 4096;
constexpr int LDS_BYTES = 163840 - 256;
constexpr int LDS_CTL = LDS_BYTES - 64;
constexpr int NTHR = 512;

struct Args { const float* in[28]; float* out; unsigned char* ws; int ph_lo, ph_hi; };

DI float bf2f(bf16_t h) { return __uint_as_float(((unsigned)h) << 16); }
DI float bflo(unsigned u) { return __uint_as_float(u << 16); }
DI float bfhi(unsigned u) { return __uint_as_float(u & 0xffff0000u); }
DI bf16_t f2bf(float f) { unsigned u = __float_as_uint(f); return (bf16_t)((u + 0x7fffu + ((u >> 16) & 1u)) >> 16); }
DI unsigned pk2(float lo, float hi) { return (unsigned)f2bf(lo) | ((unsigned)f2bf(hi) << 16); }
DI float sum4p(const float* p, size_t row) { return (p[row] + p[(size_t)M + row]) + (p[2 * (size_t)M + row] + p[3 * (size_t)M + row]); }
DI float wave_sum(float v) {
#pragma unroll
    for (int o = 1; o < 64; o <<= 1) v += __shfl_xor(v, o);
    return v;
}
DI float wave_max(float v) {
#pragma unroll
    for (int o = 1; o < 64; o <<= 1) v = fmaxf(v, __shfl_xor(v, o));
    return v;
}
DI int wave_min_i(int v) {
#pragma unroll
    for (int o = 1; o < 64; o <<= 1) { int w = __shfl_xor(v, o); v = w < v ? w : v; }
    return v;
}
DI float sigmoidf_(float x) { return __builtin_amdgcn_rcpf(1.f + __builtin_amdgcn_exp2f(-1.4426950408889634f * x)); }
DI float gelu_tanh(float x) { const float u = 0.7978845608028654f * (x + 0.044715f * x * x * x); return x * sigmoidf_(2.f * u); }
#define WSYNC() do { asm volatile("s_waitcnt lgkmcnt(0)" ::: "memory"); __builtin_amdgcn_wave_barrier(); } while (0)

namespace pg8 {
constexpr int BM = 256, BK = 64, HALF = 128, HTB = HALF * BK * 2, NXCD = 8, WGM = 8;
__host__ __device__ __forceinline__ int lds_byte(int r, int c) { const int st = (r >> 4) * 2 + (c >> 5), rr = r & 15, cc = c & 31, ob = rr * 64 + cc * 2; return st * 1024 + (ob ^ (((ob >> 9) & 1) << 5)); }
__host__ __device__ __forceinline__ void stage_rc(int b, int& R, int& C) { const int st = b / 1024, sb = b % 1024, swz = sb ^ (((sb >> 9) & 1) << 5); R = (st >> 1) * 16 + swz / 64; C = (st & 1) * 32 + (swz % 64) / 2; }
__host__ __device__ __forceinline__ int perm32(int rho) { const int n = rho >> 4, i = rho & 15; return 8 * (i >> 2) + 4 * n + (i & 3); }
struct Unit { int pm, pn; };
struct Gemm { const bf16_t* A; const bf16_t* Bt; int M, N, K; };
struct StaticOrder {
    int nM, nN, nwg, G, c;
    __host__ __device__ void init(int M_, int N_, int G_, int c_) { nM = M_ / BM; nN = N_ / BM; nwg = nM * nN; G = G_; c = c_; }
    __host__ __device__ bool next(int i, Unit& u) const {
        const long L = (long)i * G + c; if (L >= nwg) return false;
        int wgid = (int)L; { const int q = nwg / NXCD, r = nwg % NXCD, xcd = wgid % NXCD, off = wgid / NXCD; wgid = (xcd < r ? xcd * (q + 1) : r * (q + 1) + (xcd - r) * q) + off; }
        const int nig = WGM * nN, gid = wgid / nig, fm = gid * WGM, gsz = (nM - fm) < WGM ? (nM - fm) : WGM;
        u.pm = fm + ((wgid % nig) % gsz); u.pn = (wgid % nig) / gsz; return true;
    }
    __device__ __forceinline__ void a_ready(const Unit&) const {}
    __device__ __forceinline__ void done(const Unit&) const {}
};
DI unsigned cvt_pk_bf16(float lo, float hi) { unsigned r; asm volatile("v_cvt_pk_bf16_f32 %0, %1, %2" : "=v"(r) : "v"(lo), "v"(hi)); return r; }

struct EpiInProj {
    static constexpr bool PERM = true, AFTER_DRAIN = false, MIDSCALE = false;
    bf16_t* O; int ldc; const float* ssq;
    DI void operator()(const f32x4 (&acc)[2][2][4][2], const Unit& u, int wr, int wc, int fr, int fq) const {
        int row0 = u.pm * BM + wr * 64 + fr; asm volatile("" : "+v"(row0)); const int col0 = u.pn * BM + wc * 32 + 8 * fq;
#pragma unroll
        for (int ai = 0; ai < 2; ++ai)
#pragma unroll
            for (int m = 0; m < 4; ++m) {
                const int row = row0 + ai * HALF + m * 16;
                const float rinv = rsqrtf(sum4p(ssq, row) * (1.f / DM) + EPS);
                bf16_t* rowp = O + (size_t)row * ldc + col0;
#pragma unroll
                for (int bj = 0; bj < 2; ++bj) {
                    f32x4 v0 = acc[ai][bj][m][0] * rinv, v1 = acc[ai][bj][m][1] * rinv;
                    u32x4 w; w.x = cvt_pk_bf16(v0[0], v0[1]); w.y = cvt_pk_bf16(v0[2], v0[3]); w.z = cvt_pk_bf16(v1[0], v1[1]); w.w = cvt_pk_bf16(v1[2], v1[3]);
                    *(u32x4*)(rowp + bj * HALF) = w;
                }
            }
    }
};
template <bool MS> struct EpiResid {
    static constexpr bool PERM = true, AFTER_DRAIN = false, MIDSCALE = MS;
    bf16_t* xb; float* ssq_part; const float* ssq_mid; LAS float* ssl;
    DI void midscale(f32x4 (&acc)[2][2][4][2], const Unit& u, int wr, int fr) const {
        int row0 = u.pm * BM + wr * 64 + fr; asm volatile("" : "+v"(row0));
#pragma unroll
        for (int ai = 0; ai < 2; ++ai)
#pragma unroll
            for (int m = 0; m < 4; ++m) { const float s = rsqrtf(sum4p(ssq_mid, row0 + ai * HALF + m * 16) * (1.f / 256.f) + EPS);
#pragma unroll
                for (int bj = 0; bj < 2; ++bj) { acc[ai][bj][m][0] *= s; acc[ai][bj][m][1] *= s; } }
    }
    DI void operator()(const f32x4 (&acc)[2][2][4][2], const Unit& u, int wr, int wc, int fr, int fq) const {
        int rl0 = wr * 64 + fr; asm volatile("" : "+v"(rl0));
        const int col0 = u.pn * BM + wc * 32 + 8 * fq;
#pragma unroll
        for (int ai = 0; ai < 2; ++ai)
#pragma unroll
            for (int m = 0; m < 4; ++m) {
                const int rl = rl0 + ai * HALF + m * 16; const size_t row = (size_t)u.pm * BM + rl;
                float part = 0.f;
#pragma unroll
                for (int bj = 0; bj < 2; ++bj) {
                    u32x4* px = (u32x4*)(xb + row * DM + col0 + bj * HALF); const u32x4 xo = *px;
                    const f32x4 a0 = acc[ai][bj][m][0], a1 = acc[ai][bj][m][1];
                    const float v0 = a0[0] + bflo(xo.x), v1 = a0[1] + bfhi(xo.x), v2 = a0[2] + bflo(xo.y), v3 = a0[3] + bfhi(xo.y), v4 = a1[0] + bflo(xo.z), v5 = a1[1] + bfhi(xo.z), v6 = a1[2] + bflo(xo.w), v7 = a1[3] + bfhi(xo.w);
                    u32x4 w; w.x = cvt_pk_bf16(v0, v1); w.y = cvt_pk_bf16(v2, v3); w.z = cvt_pk_bf16(v4, v5); w.w = cvt_pk_bf16(v6, v7);
                    *px = w;
                    part += (v0 * v0 + v1 * v1) + (v2 * v2 + v3 * v3) + (v4 * v4 + v5 * v5) + (v6 * v6 + v7 * v7);
                }
                part += __shfl_xor(part, 16); part += __shfl_xor(part, 32);
                if (fq == 0) ssl[rl * 4 + wc] = part;
            }
        asm volatile("s_waitcnt lgkmcnt(0)" ::: "memory"); __builtin_amdgcn_s_barrier();
        int tq = threadIdx.x; asm volatile("" : "+v"(tq));
        if (tq < 256) { const f32x4 p = *(const LAS f32x4*)(ssl + tq * 4); ssq_part[(size_t)u.pn * M + (size_t)u.pm * BM + tq] = (p[0] + p[1]) + (p[2] + p[3]); }
    }
};
struct EpiSwiglu {
    static constexpr bool PERM = true, AFTER_DRAIN = false, MIDSCALE = false;
    bf16_t* act; const float* ssq;
    DI void operator()(const f32x4 (&acc)[2][2][4][2], const Unit& u, int wr, int wc, int fr, int fq) const {
        int row0 = u.pm * BM + wr * 64 + fr; asm volatile("" : "+v"(row0)); const int jst = u.pn * 128 + wc * 16 + 4 * (fq & 2) + (fq & 1) * 64;
#pragma unroll
        for (int ai = 0; ai < 2; ++ai)
#pragma unroll
            for (int m = 0; m < 4; ++m) {
                const int row = row0 + ai * HALF + m * 16;
                const float rinv = rsqrtf(sum4p(ssq, row) * (1.f / DM) + EPS);
                u32x2 w[2];
#pragma unroll
                for (int bj = 0; bj < 2; ++bj) {
                    const f32x4 g = acc[ai][bj][m][0] * rinv, up = acc[ai][bj][m][1] * rinv;
                    float a[4];
#pragma unroll
                    for (int i = 0; i < 4; ++i) a[i] = g[i] * up[i] * __builtin_amdgcn_rcpf(1.f + __builtin_amdgcn_exp2f(-1.4426950408889634f * g[i]));
                    w[bj].x = cvt_pk_bf16(a[0], a[1]); w[bj].y = cvt_pk_bf16(a[2], a[3]);
                }
                const auto rx = __builtin_amdgcn_permlane16_swap(w[0].x, w[1].x, false, false), ry = __builtin_amdgcn_permlane16_swap(w[0].y, w[1].y, false, false);
                u32x4 o; o.x = rx[0]; o.y = ry[0]; o.z = rx[1]; o.w = ry[1];
                *(u32x4*)(act + (size_t)row * FF + jst) = o;
            }
    }
};

template <class Epi, class Sched, bool ALIGN_EPI = false, bool SP2 = false>
DI void gemm_phase(LAS unsigned char* lds, const Gemm g, const Sched& S, const Epi& E) {
    int tid_ = threadIdx.x; asm volatile("" : "+v"(tid_));
    const int tid = tid_, wid = __builtin_amdgcn_readfirstlane(tid >> 6), lane = tid & 63, wr = wid >> 2, wc = wid & 3, fr = lane & 15, fq = lane >> 4;
    const int K = g.K, nt = K / BK;
    unsigned voffA[2], voffB[2];
#pragma unroll
    for (int i = 0; i < 2; ++i) { int R, C; stage_rc(tid * 16 + i * 8192, R, C); const int Rb = Epi::PERM ? ((R & ~31) + perm32(R & 31)) : R;
        voffA[i] = (unsigned)(R * K + C) * 2u; voffB[i] = (unsigned)(Rb * K + C) * 2u; }
    const size_t kstep = (size_t)(BK * 2);
    const size_t hstep = (size_t)HALF * K * 2;
    const size_t tstep = 2 * hstep;
    const unsigned ldsw = (unsigned)wid * 1024u;
    const int aoff = lds_byte(wr * 64 + fr, fq * 8), boff = lds_byte(wc * 32 + fr, fq * 8);
#define PG8_SA(b, h) (((b) * 2 + (h)) * HTB)
#define PG8_SB(b, h) ((4 + (b) * 2 + (h)) * HTB)
#define PG8_STAGE(bufoff, gbase, voff) do { _Pragma("unroll") for (int _i = 0; _i < 2; ++_i) \
        __builtin_amdgcn_global_load_lds((const unsigned*)((const char*)(gbase) + (voff)[_i]), (LAS unsigned*)(lds + (bufoff) + ldsw + _i * 8192), 16, 0, 0); } while (0)
#define PG8_LDA(dst, b, h) do { _Pragma("unroll") for (int m = 0; m < 4; ++m) _Pragma("unroll") for (int k = 0; k < 2; ++k) dst[m][k] = *(const LAS bf16x8*)(lds + PG8_SA(b, h) + aoff + m * 2048 + k * 1024); } while (0)
#define PG8_LDB(dst, b, h) do { _Pragma("unroll") for (int n = 0; n < 2; ++n) _Pragma("unroll") for (int k = 0; k < 2; ++k) dst[n][k] = *(const LAS bf16x8*)(lds + PG8_SB(b, h) + boff + n * 2048 + k * 1024); } while (0)
#define PG8_MMA(ai, bj, At, Bt) do { __builtin_amdgcn_s_setprio(1); _Pragma("unroll") for (int m = 0; m < 4; ++m) _Pragma("unroll") for (int n = 0; n < 2; ++n) _Pragma("unroll") for (int k = 0; k < 2; ++k) \
        acc[ai][bj][m][n] = __builtin_amdgcn_mfma_f32_16x16x32_bf16(Bt[n][k], At[m][k], acc[ai][bj][m][n], 0, 0, 0); __builtin_amdgcn_s_setprio(0); } while (0)
#define PG8_WAIT_V(n) asm volatile("s_waitcnt vmcnt(" #n ")" ::: "memory")
#define PG8_WAIT_L(n) asm volatile("s_waitcnt lgkmcnt(" #n ")" ::: "memory")
#define PG8_BAR __builtin_amdgcn_s_barrier()
#define PG8_SCHED __builtin_amdgcn_sched_barrier(0)
    Unit cur, nxt; int ui = 0;
    if (!S.next(0, cur)) return;
    f32x4 acc[2][2][4][2];
#pragma unroll
    for (int a = 0; a < 2; ++a)
#pragma unroll
        for (int b = 0; b < 2; ++b)
#pragma unroll
            for (int m = 0; m < 4; ++m)
#pragma unroll
                for (int n = 0; n < 2; ++n) acc[a][b][m][n] = (f32x4){0.f, 0.f, 0.f, 0.f};
    bf16x8 At[4][2], B0[2][2], B1[2][2];
    const char* cA = (const char*)g.A + (size_t)cur.pm * tstep; const char* cB = (const char*)g.Bt + (size_t)cur.pn * tstep;
    S.a_ready(cur);
    if constexpr (SP2) {
        PG8_STAGE(PG8_SB(0, 0), cB, voffB); PG8_STAGE(PG8_SB(0, 1), cB + hstep, voffB); PG8_STAGE(PG8_SA(0, 0), cA, voffA); PG8_STAGE(PG8_SA(0, 1), cA + hstep, voffA);
        if (wr == 1) PG8_BAR;
        PG8_WAIT_V(2); PG8_BAR;
        PG8_STAGE(PG8_SB(1, 0), cB + kstep, voffB); PG8_STAGE(PG8_SA(1, 0), cA + kstep, voffA); PG8_STAGE(PG8_SB(1, 1), cB + hstep + kstep, voffB);
        PG8_WAIT_V(6); PG8_BAR;
    } else {
        PG8_STAGE(PG8_SB(0, 0), cB, voffB); PG8_STAGE(PG8_SA(0, 0), cA, voffA); PG8_STAGE(PG8_SB(0, 1), cB + hstep, voffB); PG8_STAGE(PG8_SA(0, 1), cA + hstep, voffA);
        if (wr == 1) PG8_BAR;
        PG8_WAIT_V(4); PG8_BAR;
        PG8_STAGE(PG8_SB(1, 0), cB + kstep, voffB); PG8_STAGE(PG8_SA(1, 0), cA + kstep, voffA); PG8_STAGE(PG8_SB(1, 1), cB + hstep + kstep, voffB);
        PG8_WAIT_V(6); PG8_BAR;
    }
    for (;;) {
        const bool has_next = S.next(ui + 1, nxt);
        const char* nA = has_next ? (const char*)g.A + (size_t)nxt.pm * tstep : cA; const char* nB = has_next ? (const char*)g.Bt + (size_t)nxt.pn * tstep : cB;
        for (int t = 0; t < nt; t += 2) {
            const bool last = (t == nt - 2);
            const char* a1 = cA + (size_t)(t + 1) * kstep;
            const char* a2 = last ? nA : cA + (size_t)(t + 2) * kstep; const char* b2 = last ? nB : cB + (size_t)(t + 2) * kstep;
            const char* a3 = a2 + kstep; const char* b3 = b2 + kstep;
            if (last && has_next) S.a_ready(nxt);
            if constexpr (SP2) {
            PG8_LDB(B0, 0, 0); PG8_LDB(B1, 0, 1); PG8_SCHED; PG8_LDA(At, 0, 0); PG8_STAGE(PG8_SA(1, 1), a1 + hstep, voffA);
            PG8_WAIT_V(8); PG8_WAIT_L(0); PG8_BAR; PG8_MMA(0, 0, At, B0); PG8_MMA(0, 1, At, B1); PG8_BAR; PG8_SCHED;
            PG8_LDA(At, 0, 1); PG8_STAGE(PG8_SB(0, 0), b2, voffB); PG8_STAGE(PG8_SB(0, 1), b2 + hstep, voffB); PG8_STAGE(PG8_SA(0, 0), a2, voffA);
            PG8_WAIT_V(8); PG8_WAIT_L(0); PG8_BAR; PG8_MMA(1, 0, At, B0); PG8_MMA(1, 1, At, B1); PG8_BAR; PG8_SCHED;
            PG8_LDB(B0, 1, 0); PG8_LDB(B1, 1, 1); PG8_SCHED; PG8_LDA(At, 1, 0); PG8_STAGE(PG8_SA(0, 1), a2 + hstep, voffA);
            PG8_WAIT_V(8); PG8_WAIT_L(0); PG8_BAR; PG8_MMA(0, 0, At, B0); PG8_MMA(0, 1, At, B1); PG8_BAR; PG8_SCHED;
            PG8_LDA(At, 1, 1); PG8_STAGE(PG8_SB(1, 0), b3, voffB); PG8_STAGE(PG8_SB(1, 1), b3 + hstep, voffB); PG8_STAGE(PG8_SA(1, 0), a3, voffA);
            PG8_WAIT_V(8); PG8_WAIT_L(0); PG8_BAR; PG8_MMA(1, 0, At, B0); PG8_MMA(1, 1, At, B1); PG8_BAR; PG8_SCHED;
            if constexpr (Epi::MIDSCALE) { if (t == 2) E.midscale(acc, cur, wr, fr); }
            } else {
            PG8_LDB(B0, 0, 0); PG8_SCHED; PG8_LDA(At, 0, 0); PG8_STAGE(PG8_SA(1, 1), a1 + hstep, voffA);
            PG8_WAIT_L(8); PG8_BAR; PG8_WAIT_L(0); PG8_MMA(0, 0, At, B0); PG8_BAR; PG8_SCHED;
            PG8_LDB(B1, 0, 1); PG8_STAGE(PG8_SB(0, 0), b2, voffB);
            PG8_BAR; PG8_WAIT_L(0); PG8_MMA(0, 1, At, B1); PG8_BAR;
            PG8_LDA(At, 0, 1); PG8_STAGE(PG8_SA(0, 0), a2, voffA);
            PG8_BAR; PG8_WAIT_L(0); PG8_MMA(1, 0, At, B0); PG8_BAR; PG8_SCHED;
            PG8_STAGE(PG8_SB(0, 1), b2 + hstep, voffB);
            PG8_WAIT_V(6); PG8_BAR; PG8_MMA(1, 1, At, B1); PG8_BAR;
            PG8_LDB(B0, 1, 0); PG8_SCHED; PG8_LDA(At, 1, 0); PG8_STAGE(PG8_SA(0, 1), a2 + hstep, voffA);
            PG8_WAIT_L(8); PG8_BAR; PG8_WAIT_L(0); PG8_MMA(0, 0, At, B0); PG8_BAR; PG8_SCHED;
            PG8_LDB(B1, 1, 1); PG8_STAGE(PG8_SB(1, 0), b3, voffB);
            PG8_BAR; PG8_WAIT_L(0); PG8_MMA(0, 1, At, B1); PG8_BAR;
            PG8_LDA(At, 1, 1); PG8_STAGE(PG8_SA(1, 0), a3, voffA);
            PG8_BAR; PG8_WAIT_L(0); PG8_MMA(1, 0, At, B0); PG8_BAR; PG8_SCHED;
            PG8_STAGE(PG8_SB(1, 1), b3 + hstep, voffB);
            PG8_WAIT_V(6); PG8_BAR; PG8_MMA(1, 1, At, B1); PG8_BAR;
            }
        }
        if constexpr (ALIGN_EPI) { if (wr == 0) PG8_BAR; }
        if constexpr (!Epi::AFTER_DRAIN) { E(acc, cur, wr, wc, fr, fq); S.done(cur); }
        if (!has_next) break;
#pragma unroll
        for (int a = 0; a < 2; ++a)
#pragma unroll
            for (int b = 0; b < 2; ++b)
#pragma unroll
                for (int m = 0; m < 4; ++m)
#pragma unroll
                    for (int n = 0; n < 2; ++n) acc[a][b][m][n] = (f32x4){0.f, 0.f, 0.f, 0.f};
        cur = nxt; cA = nA; cB = nB; ++ui;
        if constexpr (ALIGN_EPI) { if (wr == 1) PG8_BAR; }
    }
    PG8_WAIT_V(0);
    if constexpr (!ALIGN_EPI) { if (wr == 0) PG8_BAR; }
    PG8_BAR;
#undef PG8_SA
#undef PG8_SB
#undef PG8_STAGE
#undef PG8_LDA
#undef PG8_LDB
#undef PG8_MMA
#undef PG8_WAIT_V
#undef PG8_WAIT_L
#undef PG8_BAR
#undef PG8_SCHED
}
}

#define XB_TMO      128
#define XB_XCNT(j)  (256  + 64 * (j))
#define XB_XSUB(j)  (1280 + 64 * (j))
#define XB_XGEN(j)  (2304 + 64 * (j))
#define XB_TOP      3328
#define XB_TOPGEN   3392
#define XCD_BAR_WORDS 3456
#define XB_SPIN_CAP (1u << 18)
__device__ __forceinline__ unsigned xb_ld(unsigned* p)              { return __hip_atomic_load(p, __ATOMIC_RELAXED, __HIP_MEMORY_SCOPE_AGENT); }
__device__ __forceinline__ unsigned xb_add(unsigned* p, unsigned v) { return __hip_atomic_fetch_add(p, v, __ATOMIC_RELAXED, __HIP_MEMORY_SCOPE_AGENT); }
__device__ __forceinline__ unsigned xb_xcc_id() { return (unsigned)__builtin_amdgcn_s_getreg((3 << 11) | 20) & 0xFu; }
#define XB_SPIN(cond, bar) do { unsigned _sp = 0; while (cond) { __builtin_amdgcn_s_sleep(1); \
    if ((++_sp & 255u) == 0u) { if (xb_ld(&(bar)[XB_TMO])) break; if (_sp > XB_SPIN_CAP) { atomicAdd(&(bar)[XB_TMO], 1u); break; } } } } while (0)
struct XcdBarrier { unsigned* bar; unsigned x; volatile LAS unsigned* st; };
__device__ __forceinline__ XcdBarrier xcd_barrier_post(unsigned* bar, volatile LAS unsigned* st) {
    XcdBarrier b; b.bar = bar; b.x = xb_xcc_id(); b.st = st;
    if (threadIdx.x == 0) (void)xb_add(&bar[XB_XCNT(b.x)], 1u);
    return b;
}
__device__ __forceinline__ void xcd_barrier_complete(unsigned* bar, unsigned x, unsigned& nloc, unsigned& nx) {
    const unsigned G = gridDim.x * gridDim.y * gridDim.z;
    unsigned sum, cnt, mine, sp = 0u;
    for (;;) {
        sum = 0u; cnt = 0u; mine = 0u;
#pragma unroll
        for (unsigned j = 0; j < 16; ++j) { const unsigned c = xb_ld(&bar[XB_XCNT(j)]); sum += c; cnt += (c > 0u) ? 1u : 0u; mine = (j == x) ? c : mine; }
        if (sum == G) break;
        __builtin_amdgcn_s_sleep(1);
        if ((++sp & 255u) == 0u) { if (xb_ld(&bar[XB_TMO])) break; if (sp > XB_SPIN_CAP) { atomicAdd(&bar[XB_TMO], 1u); break; } }
    }
    nloc = mine > 0u ? mine : 1u; nx = cnt > 0u ? cnt : 1u;
}
__device__ __forceinline__ void xcd_barrier(const XcdBarrier& b) {
    asm volatile("s_waitcnt vmcnt(0)" ::: "memory");
    __syncthreads();
    if (threadIdx.x == 0) {
        unsigned* bar = b.bar;
        __builtin_amdgcn_s_waitcnt(0);
        unsigned nloc = b.st[0], nx = b.st[1];
        if (nloc == 0u) { xcd_barrier_complete(bar, b.x, nloc, nx); b.st[0] = nloc; b.st[1] = nx; }
        const unsigned old = xb_add(&bar[XB_XSUB(b.x)], 1u);
        const unsigned gen = old / nloc;
        if (old + 1u == (gen + 1u) * nloc) {
            __builtin_amdgcn_fence(__ATOMIC_RELEASE, "agent");
            asm volatile("s_waitcnt vmcnt(0)" ::: "memory");
            const unsigned og = xb_add(&bar[XB_TOP], 1u);
            const unsigned tg = og / nx;
            if (og + 1u == (tg + 1u) * nx) xb_add(&bar[XB_TOPGEN], 1u);
            else XB_SPIN(xb_ld(&bar[XB_TOPGEN]) == tg, bar);
            __builtin_amdgcn_fence(__ATOMIC_ACQUIRE, "agent");
            xb_add(&bar[XB_XGEN(b.x)], 1u);
            asm volatile("s_waitcnt vmcnt(0)" ::: "memory");
        } else {
            XB_SPIN(xb_ld(&bar[XB_XGEN(b.x)]) == gen, bar);
            __builtin_amdgcn_fence(__ATOMIC_ACQUIRE, "agent");
            asm volatile("s_waitcnt vmcnt(0)" ::: "memory");
        }
    }
    __syncthreads();
}

template <int MAP>
DI int colmap(int v, int Nsrc) {
    if (MAP == 0) return v < Nsrc ? v : -1;
    const int g8 = v >> 3, e = v & 7, j = 4 * g8 + (e & 3); return (e < 4) ? j : FF + j;
}
template <int MAP, int KROT = 0>
DI void p0_transpose_item64(const float* W, int K, int Nsrc, const float* gain, bf16_t* WT, LAS float* scr, int kb, int nb, int lane) {
    const int k0 = 64 * kb, n0 = 64 * nb, v = n0 + 4 * (lane & 15);
    const int sc = MAP == 0 ? (v < Nsrc ? v : -1) : ((v >> 3) * 4 + ((v >> 2) & 1) * FF);
#pragma unroll 4
    for (int i = 0; i < 16; ++i) { const int kk = 4 * i + (lane >> 4); int ksrc = k0 + kk + KROT; if (KROT && ksrc >= K) ksrc -= K; f32x4 w = {0.f, 0.f, 0.f, 0.f}; if (sc >= 0) w = *(const f32x4*)(W + (size_t)ksrc * Nsrc + sc); if (gain) w = w * gain[ksrc];
        LAS float* d = scr + kk * 65 + 4 * (lane & 15); d[0] = w[0]; d[1] = w[1]; d[2] = w[2]; d[3] = w[3]; }
    WSYNC();
    const int c = lane & 7;
#pragma unroll
    for (int j = 0; j < 8; ++j) { const int n = (lane >> 3) + 8 * j; const LAS float* s = scr + (8 * c) * 65 + n;
        u32x4 o; o.x = pk2(s[0 * 65], s[1 * 65]); o.y = pk2(s[2 * 65], s[3 * 65]); o.z = pk2(s[4 * 65], s[5 * 65]); o.w = pk2(s[6 * 65], s[7 * 65]);
        *(u32x4*)(WT + (size_t)(n0 + n) * K + k0 + 8 * c) = o; }
    WSYNC();
}
template <int MAP, int KROT = 0>
DI void p0_transpose_item(const float* W, int K, int Nsrc, const float* gain, bf16_t* WT, LAS float* scr, int kb, int nb, int lane) {
    const int k0 = 64 * kb, n0 = 32 * nb;
    const int sc = colmap<MAP>(n0 + (lane & 31), Nsrc);
#pragma unroll 8
    for (int i = 0; i < 32; ++i) { const int kk = 2 * i + (lane >> 5); int ksrc = k0 + kk + KROT; if (KROT && ksrc >= K) ksrc -= K; float w = 0.f; if (sc >= 0) w = W[(size_t)ksrc * Nsrc + sc]; if (gain) w *= gain[ksrc]; scr[kk * 33 + (lane & 31)] = w; }
    WSYNC();
    const int c = lane & 7;
#pragma unroll
    for (int j = 0; j < 4; ++j) { const int n = (lane >> 3) + 8 * j; const LAS float* s = scr + (8 * c) * 33 + n;
        u32x4 o; o.x = pk2(s[0 * 33], s[1 * 33]); o.y = pk2(s[2 * 33], s[3 * 33]); o.z = pk2(s[4 * 33], s[5 * 33]); o.w = pk2(s[6 * 33], s[7 * 33]);
        *(u32x4*)(WT + (size_t)(n0 + n) * K + k0 + 8 * c) = o; }
    WSYNC();
}


typedef float f32x16 __attribute__((ext_vector_type(16)));
typedef float f32x2v __attribute__((ext_vector_type(2)));
typedef __bf16 bf16x2_t __attribute__((ext_vector_type(2)));
constexpr int KSTR = 208, VSTR = 136;
constexpr int VSTP = 144;
constexpr int AL_K0 = 0, AL_K1 = 64 * KSTR, AL_V0 = 2 * 64 * KSTR, AL_V1 = AL_V0 + 64 * VSTP, AL_IMP = 45056, AL_SELM = AL_IMP + 32768, AL_OACC = AL_SELM + 1024;
constexpr float NEGB = -1e30f, LOG2E = 1.4426950408889634f;
DI unsigned cvtpk(float lo, float hi) { f32x2v v = {lo, hi}; bf16x2_t b = __builtin_convertvector(v, bf16x2_t); return __builtin_bit_cast(unsigned, b); }
DI f32x16 mfma32(bf16x8 a, bf16x8 b, f32x16 c) { return __builtin_amdgcn_mfma_f32_32x32x16_bf16(a, b, c, 0, 0, 0); }
DI float xhalf_max(float v) { auto rr = __builtin_amdgcn_permlane32_swap(__float_as_uint(v), __float_as_uint(v), false, false); return fmaxf(__uint_as_float(rr[0]), __uint_as_float(rr[1])); }
DI float xhalf_sum(float v) { auto rr = __builtin_amdgcn_permlane32_swap(__float_as_uint(v), __float_as_uint(v), false, false); return __uint_as_float(rr[0]) + __uint_as_float(rr[1]); }
DI float ex2(float x) { return __builtin_amdgcn_exp2f(x); }
template <int KSTEPS>
DI void qk_tile(const LAS unsigned char* Kt, const bf16x8 (&qf)[KSTEPS], int r32, int hi, f32x16& s0, f32x16& s1) {
    const LAS unsigned char* p0 = Kt + r32 * KSTR + hi * 16;
#pragma unroll
    for (int i = 0; i < 16; ++i) { s0[i] = 0.f; s1[i] = 0.f; }
#pragma unroll
    for (int ks = 0; ks < KSTEPS; ++ks) {
        const bf16x8 a0 = *(const LAS bf16x8*)(p0 + ks * 32), a1 = *(const LAS bf16x8*)(p0 + 32 * KSTR + ks * 32);
        s0 = mfma32(a0, qf[ks], s0); s1 = mfma32(a1, qf[ks], s1);
    }
}
DI void mask_tile(f32x16& s0, f32x16& s1, int klo, int khi, int hi) {
    const int lo_ = klo - 4 * hi, hi_ = khi - 4 * hi;
#pragma unroll
    for (int i = 0; i < 16; ++i) { const int kb = (i & 3) + 8 * (i >> 2); if (kb < lo_ || kb > hi_) s0[i] = NEGB; if (kb + 32 < lo_ || kb + 32 > hi_) s1[i] = NEGB; }
}
DI float tile_max(const f32x16& s0, const f32x16& s1) {
    float mx = fmaxf(s0[0], s1[0]);
#pragma unroll
    for (int i = 1; i < 16; ++i) mx = fmaxf(mx, fmaxf(s0[i], s1[i]));
    return xhalf_max(mx);
}
template <int BASE> DI bf16x8 pack8(const f32x16& s) { u32x4 p; p.x = cvtpk(s[BASE], s[BASE + 1]); p.y = cvtpk(s[BASE + 2], s[BASE + 3]); p.z = cvtpk(s[BASE + 4], s[BASE + 5]); p.w = cvtpk(s[BASE + 6], s[BASE + 7]); return __builtin_bit_cast(bf16x8, p); }
DI bf16x8 ld8x2(const bf16_t* p) { const u32x2 a = *(const u32x2*)p, b = *(const u32x2*)(p + 4); u32x4 w; w.x = a.x; w.y = a.y; w.z = b.x; w.w = b.y; return __builtin_bit_cast(bf16x8, w); }
DI bf16x8 vfrag(const LAS unsigned char* p) { const u32x2 a = *(const LAS u32x2*)p, b = *(const LAS u32x2*)(p + 16); u32x4 w; w.x = a.x; w.y = a.y; w.z = b.x; w.w = b.y; return __builtin_bit_cast(bf16x8, w); }
template <int VS = VSTP>
DI void pv_tile(const f32x16& s0, const f32x16& s1, const LAS unsigned char* Vt, f32x16 (&o)[2], int r32, int hi) {
    const bf16x8 p00 = pack8<0>(s0), p01 = pack8<8>(s0), p10 = pack8<0>(s1), p11 = pack8<8>(s1);
#pragma unroll
    for (int dt = 0; dt < 2; ++dt) { const LAS unsigned char* vp = Vt + (32 * dt + r32) * VS + 16 * hi;
        o[dt] = mfma32(*(const LAS bf16x8*)vp, p00, o[dt]); o[dt] = mfma32(*(const LAS bf16x8*)(vp + 32), p01, o[dt]); o[dt] = mfma32(*(const LAS bf16x8*)(vp + 64), p10, o[dt]); o[dt] = mfma32(*(const LAS bf16x8*)(vp + 96), p11, o[dt]); }
}
DI void softmax_pv(f32x16& s0, f32x16& s1, const LAS unsigned char* Vt, f32x16 (&o)[2], float& m, float& l, int r32, int hi) {
    const float mx = tile_max(s0, s1), mn = fmaxf(m, mx), ms = mn < -1e29f ? 0.f : mn, alpha = ex2(m - ms);
    m = mn; float psum = 0.f;
#pragma unroll
    for (int i = 0; i < 16; ++i) { s0[i] = ex2(s0[i] - ms); s1[i] = ex2(s1[i] - ms); psum += s0[i] + s1[i]; }
    l = l * alpha + psum;
    if (!__all(alpha == 1.f)) {
#pragma unroll
        for (int i = 0; i < 16; ++i) { o[0][i] *= alpha; o[1][i] *= alpha; } }
    pv_tile(s0, s1, Vt, o, r32, hi);
}
struct SoftState { float m, l; };
constexpr float SM_THR = 8.f;
DI void soft_init(SoftState& S, f32x16 (&o)[2]) { S.m = 0.f; S.l = 0.f;
#pragma unroll
    for (int i = 0; i < 16; ++i) { o[0][i] = 0.f; o[1][i] = 0.f; } }
DI f32x16 bcast16(float v) { f32x16 c;
#pragma unroll
    for (int i = 0; i < 16; ++i) c[i] = v;
    return c; }
DI float max3f(float a, float b, float c) { float r; asm("v_max3_f32 %0, %1, %2, %3" : "=v"(r) : "v"(a), "v"(b), "v"(c)); return r; }
template <int VS>
DI void load_vfrags(const LAS unsigned char* Vt, bf16x8 (&vfr)[2][4], int r32, int hi) {
#pragma unroll
    for (int dt = 0; dt < 2; ++dt) { const LAS unsigned char* vp = Vt + (32 * dt + r32) * VS + 16 * hi;
#pragma unroll
        for (int s = 0; s < 4; ++s) vfr[dt][s] = *(const LAS bf16x8*)(vp + 32 * s); }
}
DI void pv_regs(const f32x16& s0, const f32x16& s1, const bf16x8 (&vfr)[2][4], f32x16 (&o)[2]) {
    const bf16x8 p00 = pack8<0>(s0), p01 = pack8<8>(s0), p10 = pack8<0>(s1), p11 = pack8<8>(s1);
#pragma unroll
    for (int dt = 0; dt < 2; ++dt) { o[dt] = mfma32(vfr[dt][0], p00, o[dt]); o[dt] = mfma32(vfr[dt][1], p01, o[dt]); o[dt] = mfma32(vfr[dt][2], p10, o[dt]); o[dt] = mfma32(vfr[dt][3], p11, o[dt]); }
}
DI float soft_update(f32x16& s0, f32x16& s1, SoftState& S, f32x16 (&o)[2], bool masked, int klo, int khi, bool first, int hi, float adj = 0.f) {
    if (__any(adj != 0.f)) {
#pragma unroll
        for (int i = 0; i < 16; ++i) { s0[i] -= adj; s1[i] -= adj; } }
    float dl_ret = 0.f;
    if (__builtin_expect(masked, 0)) { asm volatile("; boundary tile mask" ::: "memory"); mask_tile(s0, s1, klo, khi, hi); }
    asm volatile("s_nop 15\n\ts_nop 7" : "+v"(s0), "+v"(s1));
    float rm;
    { float a = max3f(s0[0], s0[1], s0[2]), b = max3f(s1[0], s1[1], s1[2]);
#pragma unroll
      for (int i = 3; i < 15; i += 2) { a = max3f(a, s0[i], s0[i + 1]); b = max3f(b, s1[i], s1[i + 1]); }
      rm = xhalf_max(fmaxf(max3f(a, b, s0[15]), s1[15])); }
    if (first) {
        const float dl = rm < -1e29f ? 0.f : rm; S.m = dl; dl_ret = dl;
#pragma unroll
        for (int i = 0; i < 16; ++i) { s0[i] -= dl; s1[i] -= dl; }
    } else if (__any(rm > SM_THR)) {
        const float dl = fmaxf(rm, 0.f), alpha = ex2(-dl); S.m += dl; S.l *= alpha; dl_ret = dl;
#pragma unroll
        for (int i = 0; i < 16; ++i) { s0[i] -= dl; s1[i] -= dl; o[0][i] *= alpha; o[1][i] *= alpha; }
    }
    float p0 = 0.f, p1 = 0.f, p2 = 0.f, p3 = 0.f;
#pragma unroll
    for (int i = 0; i < 16; i += 2) { s0[i] = ex2(s0[i]); s0[i + 1] = ex2(s0[i + 1]); s1[i] = ex2(s1[i]); s1[i + 1] = ex2(s1[i + 1]); p0 += s0[i]; p1 += s0[i + 1]; p2 += s1[i]; p3 += s1[i + 1]; }
    S.l += (p0 + p1) + (p2 + p3);
    return dl_ret;
}
template <int KSTEPS, int VS = VSTP, bool VPREF = false>
DI void attn_step(const LAS unsigned char* Kt, const LAS unsigned char* Vt, const bf16x8 (&qf)[KSTEPS], SoftState& S, f32x16 (&o)[2], bool masked, int klo, int khi, bool first, int r32, int hi) {
    const f32x16 cinit = bcast16(-S.m); f32x16 s0 = cinit, s1 = cinit;
    { const LAS unsigned char* p0 = Kt + r32 * KSTR + hi * 16;
#pragma unroll
      for (int ks = 0; ks < KSTEPS; ++ks) { const bf16x8 a0 = *(const LAS bf16x8*)(p0 + ks * 32), a1 = *(const LAS bf16x8*)(p0 + 32 * KSTR + ks * 32);
          s0 = mfma32(a0, qf[ks], s0); s1 = mfma32(a1, qf[ks], s1); } }
    if constexpr (VPREF) { bf16x8 vfr[2][4]; load_vfrags<VS>(Vt, vfr, r32, hi); __builtin_amdgcn_sched_barrier(0);
        soft_update(s0, s1, S, o, masked, klo, khi, first, hi);
        __builtin_amdgcn_sched_barrier(0);
        pv_regs(s0, s1, vfr, o); }
    else { soft_update(s0, s1, S, o, masked, klo, khi, first, hi); pv_tile<VS>(s0, s1, Vt, o, r32, hi); }
}
template <int KSTEPS, int VS>
DI void attn_step2(const LAS unsigned char* Kt, const LAS unsigned char* Vt, const bf16x8 (&qf)[KSTEPS], SoftState& S, f32x16 (&o)[2], bool masked0, int khi0, bool masked1, int khi1, bool first, int r32, int hi) {
    const f32x16 cinit = bcast16(-S.m); f32x16 a0 = cinit, a1 = cinit, b0 = cinit, b1 = cinit;
    { const LAS unsigned char* p0 = Kt + r32 * KSTR + hi * 16;
#pragma unroll
      for (int ks = 0; ks < KSTEPS; ++ks) { const bf16x8 k0 = *(const LAS bf16x8*)(p0 + ks * 32), k1 = *(const LAS bf16x8*)(p0 + 32 * KSTR + ks * 32);
          a0 = mfma32(k0, qf[ks], a0); a1 = mfma32(k1, qf[ks], a1); }
#pragma unroll
      for (int ks = 0; ks < KSTEPS; ++ks) { const bf16x8 k0 = *(const LAS bf16x8*)(p0 + 64 * KSTR + ks * 32), k1 = *(const LAS bf16x8*)(p0 + 96 * KSTR + ks * 32);
          b0 = mfma32(k0, qf[ks], b0); b1 = mfma32(k1, qf[ks], b1); } }
    bf16x8 vfr[2][4]; load_vfrags<VS>(Vt, vfr, r32, hi); __builtin_amdgcn_sched_barrier(0);
    const float dl0 = soft_update(a0, a1, S, o, masked0, 0, khi0, first, hi);
    __builtin_amdgcn_sched_barrier(0);
    pv_regs(a0, a1, vfr, o);
    __builtin_amdgcn_sched_barrier(0);
    load_vfrags<VS>(Vt + 128, vfr, r32, hi); __builtin_amdgcn_sched_barrier(0);
    (void)soft_update(b0, b1, S, o, masked1, 0, khi1, false, hi, dl0);
    __builtin_amdgcn_sched_barrier(0);
    pv_regs(b0, b1, vfr, o);
}
struct StageRegs { u32x4 a, b, c, d, e; };
template <class LoadF, class StoreF, class StepF>
DI void attn_pipeline(int jbeg, int jend, LoadF ld, StoreF st, StepF step) {
    if (jbeg > jend) return;
    StageRegs RA;
    ld(jbeg, RA); st(0, RA); __syncthreads();
    for (int j = jbeg; j <= jend; j += 2) {
        if (j + 1 <= jend) ld(j + 1, RA);
        step(j, 0);
        if (j + 1 <= jend) st(1, RA);
        __syncthreads();
        if (STAGGER && __builtin_amdgcn_readfirstlane(threadIdx.x >> 6) >= 4) __builtin_amdgcn_s_sleep(STAGGER);
        if (j + 1 > jend) break;
        if (j + 2 <= jend) ld(j + 2, RA);
        step(j + 1, 1);
        if (j + 2 <= jend) st(0, RA);
        __syncthreads();
        if (STAGGER && __builtin_amdgcn_readfirstlane(threadIdx.x >> 6) >= 4) __builtin_amdgcn_s_sleep(STAGGER);
    }
}
DI const float* inp(const Args& a, int k) { asm volatile("" : "+s"(k)); return a.in[k]; }
__global__ void __launch_bounds__(NTHR, 2) fwd(Args args) {
    extern __shared__ __attribute__((aligned(16))) unsigned char lds_raw[];
    LAS unsigned char* lds = (LAS unsigned char*)lds_raw;
    LAS float* ldsf = (LAS float*)lds;
    volatile LAS unsigned* LCTL = (volatile LAS unsigned*)(lds + LDS_CTL);
    const int tid0 = threadIdx.x, wave = __builtin_amdgcn_readfirstlane(tid0 >> 6);
    const int G = gridDim.x, bid = blockIdx.x;
#define LAUNDER_TID() int tid = tid0; asm volatile("" : "+v"(tid)); const int lane = tid & 63; (void)lane
#define WS_PTRS() unsigned char* ws = args.ws; asm volatile("" : "+s"(ws)); \
    unsigned* ctl = (unsigned*)(ws + WS_CTL); float* ssp_base = (float*)(ws + WS_SSP); float* hb = (float*)(ws + WS_HB); \
    bf16_t* XB = (bf16_t*)(ws + WS_XB); bf16_t* Y = (bf16_t*)(ws + WS_Y); bf16_t* PB = (bf16_t*)(ws + WS_PB); bf16_t* ACT = (bf16_t*)(ws + WS_ACT); \
    const float2* cs64 = (const float2*)(ws + WS_CS64); const float2* cs32 = (const float2*)(ws + WS_CS32); \
    float* LRA = args.out; float* LRU_ = args.out + (size_t)M * 256; \
    float* LA = (float*)(ws + WS_LA); float* LH = (float*)(ws + WS_LH); float* CIN = (float*)(ws + WS_CIN); \
    float* KVC = (float*)(ws + WS_KVC); float* DEC = (float*)(ws + WS_DEC); float* SST = (float*)(ws + WS_SST); \
    bf16_t* MQ = (bf16_t*)(ws + WS_MQ); bf16_t* MKN = (bf16_t*)(ws + WS_MKN); bf16_t* MVT = (bf16_t*)(ws + WS_MV); bf16_t* MKR = (bf16_t*)(ws + WS_MKR); \
    bf16_t* VST = (bf16_t*)(ws + WS_VST); bf16_t* KSF = (bf16_t*)(ws + WS_KSF); (void)KSF; bf16_t* VWT = (bf16_t*)(ws + WS_VWT); bf16_t* KCMPB = (bf16_t*)(ws + WS_KCMPB); bf16_t* VCMPT = (bf16_t*)(ws + WS_VCMPT); \
    const float* ssq_mix = ssp_base + (size_t)(l_ == 0 ? 0 : 2) * 4 * M; float* ssq_out = ssp_base + (size_t)(1 + 3 * l_) * 4 * M; float* ssq_down = ssp_base + (size_t)(2 + 3 * l_) * 4 * M; float* ssq_d = ssp_base + (size_t)(3 + 3 * l_) * 4 * M; \
    (void)ctl; (void)hb; (void)XB; (void)Y; (void)PB; (void)ACT; (void)cs64; (void)cs32; (void)LRA; (void)LRU_; (void)LA; (void)LH; (void)CIN; (void)KVC; (void)DEC; (void)SST; (void)MQ; (void)MKN; (void)MVT; (void)MKR; (void)VST; (void)VWT; (void)KCMPB; (void)VCMPT; (void)ssq_mix; (void)ssq_out; (void)ssq_down; (void)ssq_d
    unsigned* ctl0 = (unsigned*)(args.ws + WS_CTL);
    { LAUNDER_TID(); if (tid < 16) LCTL[tid] = 0u; }
    __syncthreads();
    const int lo = args.ph_lo, hi = args.ph_hi;
    XcdBarrier bar; bar.bar = ctl0 + CW_BAR; bar.x = 0; bar.st = LCTL;
    if (hi - lo > 1) bar = xcd_barrier_post(ctl0 + CW_BAR, LCTL);
#define IN(k) (lo <= (k) && (k) < hi)
#define SEAM(k) do { if (IN(k) && IN((k) + 1)) xcd_barrier(bar); } while (0)

    if (IN(0)) {
        const int l_ = 0; WS_PTRS();
      _Pragma("unroll 1") for (int rep = 0; rep < REP_P0; ++rep) {
        LAUNDER_TID();
        const int gw = bid * 8 + wave, NGW = G * 8;
        LAS float* scr = ldsf + wave * 4224; LAS float* scr64 = scr;
        constexpr int I_IN = 16 * 36, I_OUT = 16 * 16, I_GU = 16 * 88, I_DN = 44 * 16, I_L = I_IN + I_OUT + I_GU + I_DN;
        for (int it = gw; it < 2 * I_L; it += NGW) {
            const int l = it / I_L; int r = it % I_L;
            if (r < I_IN) { p0_transpose_item64<0>(inp(args, 3) + (size_t)l * DM * NINS, DM, NINS, inp(args, 2) + l * DM, (bf16_t*)(ws + WS_WIN) + (size_t)l * NIN * DM, scr64, r / 36, r % 36, lane); continue; } r -= I_IN;
            if (r < I_OUT) { p0_transpose_item64<0, 768>(inp(args, 23) + (size_t)l * DM * DM, DM, DM, inp(args, 22) + l * DM, (bf16_t*)(ws + WS_WOUT) + (size_t)l * DM * DM, scr64, r / 16, r % 16, lane); continue; } r -= I_OUT;
            if (r < I_GU) { p0_transpose_item64<1>(inp(args, 25) + (size_t)l * DM * NGU, DM, NGU, inp(args, 24) + l * DM, (bf16_t*)(ws + WS_WGU) + (size_t)l * NGU * DM, scr64, r / 88, r % 88, lane); continue; } r -= I_GU;
            p0_transpose_item64<0>(inp(args, 26) + (size_t)l * FF * DM, FF, DM, nullptr, (bf16_t*)(ws + WS_WDN) + (size_t)l * DM * FF, scr64, r / 16, r % 16, lane);
        }
        { constexpr int I_UQ = 3 * 12, I_UKV = 2 * 16, I_W1 = 32 * 8, I_W2 = 4 * 2, I_S = 2 * I_UQ + 2 * I_UKV + 4 * I_W1 + 4 * I_W2;
          for (int it = gw; it < I_S; it += NGW) { int r = it;
              if (r < 2 * I_UQ) { const int l = r / I_UQ; r %= I_UQ; p0_transpose_item<0>(inp(args, 20) + (size_t)l * 192 * 384, 192, 384, inp(args, 18) + l * 192, (bf16_t*)(ws + WS_WUQT) + (size_t)l * 384 * 192, scr, r / 12, r % 12, lane); continue; } r -= 2 * I_UQ;
              if (r < 2 * I_UKV) { const int l = r / I_UKV; r %= I_UKV; p0_transpose_item<0>(inp(args, 21) + (size_t)l * 128 * 512, 128, 512, inp(args, 19) + l * 128, (bf16_t*)(ws + WS_WUKVT) + (size_t)l * 512 * 128, scr, r / 16, r % 16, lane); continue; } r -= 2 * I_UKV;
              if (r < 4 * I_W1) { const int lj = r / I_W1; r %= I_W1; p0_transpose_item<0>(inp(args, 12) + (size_t)lj * 2048 * 256, 2048, 256, nullptr, (bf16_t*)(ws + WS_W1T) + (size_t)lj * 256 * 2048, scr, r / 8, r % 8, lane); continue; } r -= 4 * I_W1;
              { const int lj = r / I_W2; r %= I_W2; p0_transpose_item<0>(inp(args, 14) + (size_t)lj * 256 * 64, 256, 64, nullptr, (bf16_t*)(ws + WS_W2T) + (size_t)lj * 64 * 256, scr, r / 2, r % 2, lane); } } }
        for (int e = bid * NTHR + tid; e < 2 * 2 * 4 * 64 * 64; e += G * NTHR) {
            const int k = e & 63, n = (e >> 6) & 63, h = (e >> 12) & 3, g = (e >> 14) & 1, l = e >> 15;
            ((bf16_t*)(ws + WS_WGT))[e] = f2bf((g == 0 ? inp(args, 6) : inp(args, 8))[(((size_t)l * 4 + h) * 64 + k) * 64 + n]); }
        for (int e = bid * NTHR + tid; e < 512; e += G * NTHR) ((float*)(ws + WS_SP))[e] = log1pf(expf(-inp(args, 10)[e]));
        for (int m = gw; m < M; m += NGW) {
            const f32x4* xr = (const f32x4*)(inp(args, 0) + (size_t)m * DM) + lane;
            f32x4 v[4]; float s = 0.f;
#pragma unroll
            for (int j = 0; j < 4; ++j) { v[j] = xr[64 * j]; s += v[j][0] * v[j][0] + v[j][1] * v[j][1] + v[j][2] * v[j][2] + v[j][3] * v[j][3]; }
            s = wave_sum(s);
            u32x2* o8 = (u32x2*)(XB + (size_t)m * DM) + lane;
#pragma unroll
            for (int j = 0; j < 4; ++j) { u32x2 w; w.x = pk2(v[j][0], v[j][1]); w.y = pk2(v[j][2], v[j][3]); o8[64 * j] = w; }
            if (lane < 4) ssp_base[(size_t)lane * M + m] = lane == 0 ? s : 0.f;
        }
        for (int e = bid * NTHR + tid; e < M * 32; e += G * NTHR) {
            const int m = e >> 5, i = e & 31; const float pos = (float)((const int*)inp(args, 1))[m];
            const float invf = __builtin_amdgcn_exp2f(-(float)(2 * i) * (13.287712379549449f / 64.f)); float sn, cs; { float rv = pos * invf * 0.15915494309189535f; rv -= floorf(rv); sn = __builtin_amdgcn_sinf(rv); cs = __builtin_amdgcn_cosf(rv); }
            ((float2*)(ws + WS_CS64))[e] = make_float2(cs, sn);
            if (i < 16) { const float invf2 = __builtin_amdgcn_exp2f(-(float)(2 * i) * (13.287712379549449f / 32.f)); float rv = pos * invf2 * 0.15915494309189535f; rv -= floorf(rv); sn = __builtin_amdgcn_sinf(rv); cs = __builtin_amdgcn_cosf(rv); ((float2*)(ws + WS_CS32))[m * 16 + i] = make_float2(cs, sn); }
        }
        for (int e = bid * NTHR + tid; e < 2 * 2 * 256; e += G * NTHR) {
            const int lj = e >> 8, c = e & 255; float a = inp(args, 13)[e];
            const float* pp = inp(args, 11) + (size_t)lj * 2048; const float* w1 = inp(args, 12) + (size_t)lj * 2048 * 256 + c;
            for (int i = 0; i < 2048; ++i) a += pp[i] * w1[(size_t)i * 256];
            hb[e] = a;
        }
      }
    }
    SEAM(0);

    for (int l = 0; l < 2; ++l) {
        const int pb = 1 + 6 * l;
        if (IN(pb)) {
        const int l_ = l; WS_PTRS();
            pg8::Gemm g{XB, (const bf16_t*)(ws + WS_WIN) + (size_t)l * NIN * DM, M, NIN, DM}; pg8::StaticOrder S; S.init(M, NIN, G, bid);
            pg8::EpiInProj E{PB, NIN, ssq_mix};
            _Pragma("unroll 1") for (int rep = 0; rep < REP_G16; ++rep) pg8::gemm_phase<pg8::EpiInProj, pg8::StaticOrder, true, true>(lds, g, S, E);
        }
        SEAM(pb);
        if (IN(pb + 1)) {
        const int l_ = l; WS_PTRS();
        LAUNDER_TID();
            constexpr int N_J1 = 1024, N_J2 = 512, N_J3 = 512, N_J4 = 512, N_J4B = 128;
            {
            for (int r_ = bid; r_ < N_J4B * REP_J4B; r_ += G) { const int r = r_ % N_J4B;
                    const int j = r & 1, g32 = (r >> 1) & 15, b = r >> 5; const int colb = j == 0 ? C_KC : C_VC; const int r32 = lane & 31, hi = lane >> 5;
                    LAS unsigned char* Tl = lds;
                    LAS unsigned char* Hl = lds + 69632;
                    for (int e = tid; e < 528 * 8; e += NTHR) { const int rr = e >> 3, c8 = e & 7, t = 512 * g32 + rr; u32x4 w = {0u, 0u, 0u, 0u};
                        if (t < SEQ) { const bf16_t* pr = PB + ((size_t)b * SEQ + t) * NIN + colb;
                            if (j == 0) { const u32x4 a = *(const u32x4*)(pr + 8 * (c8 & 3)), c = *(const u32x4*)(pr + 32 + 8 * (c8 & 3)); const float2* cs = cs64 + ((size_t)b * SEQ + t) * 32 + 8 * (c8 & 3);
                                const unsigned au[4] = {a.x, a.y, a.z, a.w}, cu[4] = {c.x, c.y, c.z, c.w}; unsigned ou[4];
#pragma unroll
                                for (int q = 0; q < 4; ++q) { const float2 s0 = cs[2 * q], s1 = cs[2 * q + 1]; const float x1a = bflo(au[q]), x1b = bfhi(au[q]), x2a = bflo(cu[q]), x2b = bfhi(cu[q]);
                                    ou[q] = c8 < 4 ? pk2(x1a * s0.x - x2a * s0.y, x1b * s1.x - x2b * s1.y) : pk2(x2a * s0.x + x1a * s0.y, x2b * s1.x + x1b * s1.y); }
                                w.x = ou[0]; w.y = ou[1]; w.z = ou[2]; w.w = ou[3]; }
                            else w = *(const u32x4*)(pr + 8 * c8); }
                        *(LAS u32x4*)(Tl + rr * 128 + (rr >> 4) * 16 + c8 * 16) = w; }
                    __syncthreads();
                    { const bf16_t* w1t = (const bf16_t*)(ws + WS_W1T) + ((size_t)(l * 2 + j) * 256 + 32 * wave + r32) * 2048 + 8 * hi;
                      f32x16 acc;
#pragma unroll
                      for (int i = 0; i < 16; ++i) acc[i] = 0.f;
#pragma unroll 16
                      for (int kk = 0; kk < 128; ++kk) { const int rowt = 16 * r32 + (kk >> 2);
                          const bf16x8 a = *(const LAS bf16x8*)(Tl + rowt * 128 + (rowt >> 4) * 16 + 32 * (kk & 3) + 16 * hi);
                          const bf16x8 bw = *(const bf16x8*)(w1t + 16 * kk);
                          acc = mfma32(a, bw, acc); }
                      const float hbv = hb[(l * 2 + j) * 256 + 32 * wave + r32];
#pragma unroll
                      for (int i = 0; i < 16; ++i) { const int n = (i & 3) + 8 * (i >> 2) + 4 * hi; *(LAS bf16_t*)(Hl + n * 528 + (32 * wave + r32) * 2) = f2bf(gelu_tanh(acc[i] + hbv)); } }
                    __syncthreads();
                    if (wave < 2) { const bf16_t* w2t = (const bf16_t*)(ws + WS_W2T) + ((size_t)(l * 2 + j) * 64 + 32 * wave + r32) * 256 + 8 * hi;
                      f32x16 acc;
#pragma unroll
                      for (int i = 0; i < 16; ++i) acc[i] = 0.f;
#pragma unroll
                      for (int kk = 0; kk < 16; ++kk) { const bf16x8 a = *(const LAS bf16x8*)(Hl + r32 * 528 + 32 * kk + 16 * hi); const bf16x8 bw = *(const bf16x8*)(w2t + 16 * kk); acc = mfma32(a, bw, acc); }
                      const int dd = 32 * wave + r32;
#pragma unroll
                      for (int g = 0; g < 4; ++g) { const int n0 = 32 * g32 + 8 * g + 4 * hi; float v[4];
#pragma unroll
                          for (int q = 0; q < 4; ++q) v[q] = (n0 + q < 511) ? acc[4 * g + q] : 0.f;
                          if (j == 0) {
#pragma unroll
                              for (int q = 0; q < 4; ++q) KCMPB[((size_t)b * 512 + n0 + q) * 64 + dd] = f2bf(v[q]); }
                          else { u32x2 w; w.x = pk2(v[0], v[1]); w.y = pk2(v[2], v[3]); *(u32x2*)(VCMPT + ((size_t)b * 64 + dd) * 512 + n0) = w; } } }
                    __syncthreads();
            }
            if (bid < N_J3) {
                const int fr = lane & 15, kq = lane >> 4, hh = wave >> 1, odd = wave & 1;
                {
                    bf16x8 bq[3][6];
                    { const bf16_t* wq = (const bf16_t*)(ws + WS_WUQT) + (size_t)l * 384 * 192;
#pragma unroll
                      for (int nt = 0; nt < 3; ++nt)
#pragma unroll
                          for (int ks = 0; ks < 6; ++ks) bq[nt][ks] = *(const bf16x8*)(wq + (size_t)(48 * wave + 16 * nt + fr) * 192 + 32 * ks + 8 * kq); }
                    for (int r_ = bid; r_ < N_J3 * REP_J3; r_ += G) { const int r = r_ % N_J3;
                        const size_t row0 = (size_t)r * 64;
#pragma unroll 1
                        for (int mt = 0; mt < 4; ++mt) {
                            const bf16_t* pa = PB + (row0 + mt * 16 + fr) * NIN;
                            bf16x8 aq[6]; float ssq_ = 0.f;
#pragma unroll
                            for (int ks = 0; ks < 6; ++ks) { aq[ks] = ld8x2(pa + C_DCQ + 32 * ks + 8 * kq);
#pragma unroll
                                for (int e = 0; e < 8; ++e) { const float v = bf2f((bf16_t)aq[ks][e]); ssq_ += v * v; } }
                            ssq_ += __shfl_xor(ssq_, 16); ssq_ += __shfl_xor(ssq_, 32);
                            const float rq_ = rsqrtf(ssq_ * (1.f / 192.f) + EPS);
                            f32x4 cq[3];
#pragma unroll
                            for (int nt = 0; nt < 3; ++nt) { cq[nt] = (f32x4){0.f, 0.f, 0.f, 0.f};
#pragma unroll
                                for (int ks = 0; ks < 6; ++ks) cq[nt] = __builtin_amdgcn_mfma_f32_16x16x32_bf16(aq[ks], bq[nt][ks], cq[nt], 0, 0, 0); }
                            const float SCQ = 0.10206207261596575f * LOG2E;
#pragma unroll
                            for (int i = 0; i < 4; ++i) {
                                const size_t row = row0 + mt * 16 + 4 * kq + i; const float rqi = __shfl(rq_, 4 * kq + i) * SCQ;
                                float q0 = cq[0][i] * rqi, q1 = cq[1][i] * rqi, q2 = cq[2][i] * rqi;
                                if (odd) { const float2 cs = cs32[row * 16 + fr]; const float x1 = q1, x2 = q2; q1 = x1 * cs.x - x2 * cs.y; q2 = x2 * cs.x + x1 * cs.y; }
                                bf16_t* mq = MQ + row * 384 + hh * 96 + 48 * odd + fr; mq[0] = f2bf(q0); mq[16] = f2bf(q1); mq[32] = f2bf(q2);
                            }
                            if (wave == mt) {
#pragma unroll
                                for (int q = 0; q < 4; ++q) { const int p = lane * 4 + q, tok = p >> 4, i = p & 15; const size_t row = row0 + mt * 16 + tok; const bf16_t* pr = PB + row * NIN + C_DKR;
                                    const float x1 = bf2f(pr[i]), x2 = bf2f(pr[16 + i]); const float2 cs = cs32[row * 16 + i];
                                    MKR[row * 32 + i] = f2bf(x1 * cs.x - x2 * cs.y); MKR[row * 32 + 16 + i] = f2bf(x2 * cs.x + x1 * cs.y); } }
                        }
                    }
                }
                {
                    bf16x8 bkv[4][4];
                    { const bf16_t* wkv = (const bf16_t*)(ws + WS_WUKVT) + (size_t)l * 512 * 128;
#pragma unroll
                      for (int nt = 0; nt < 4; ++nt)
#pragma unroll
                          for (int ks = 0; ks < 4; ++ks) bkv[nt][ks] = *(const bf16x8*)(wkv + (size_t)(64 * wave + 16 * nt + fr) * 128 + 32 * ks + 8 * kq); }
                    for (int r_ = bid; r_ < N_J3 * REP_J3; r_ += G) { const int r = r_ % N_J3;
                        const size_t row0 = (size_t)r * 64; const size_t bb = row0 / SEQ, t0 = row0 % SEQ;
#pragma unroll 1
                        for (int mt = 0; mt < 4; ++mt) {
                            const bf16_t* pa = PB + (row0 + mt * 16 + fr) * NIN;
                            bf16x8 akv[4]; float sskv_ = 0.f;
#pragma unroll
                            for (int ks = 0; ks < 4; ++ks) { akv[ks] = ld8x2(pa + C_DCKV + 32 * ks + 8 * kq);
#pragma unroll
                                for (int e = 0; e < 8; ++e) { const float v = bf2f((bf16_t)akv[ks][e]); sskv_ += v * v; } }
                            sskv_ += __shfl_xor(sskv_, 16); sskv_ += __shfl_xor(sskv_, 32);
                            const float rk_ = rsqrtf(sskv_ * (1.f / 128.f) + EPS);
                            f32x4 ckv[4];
#pragma unroll
                            for (int nt = 0; nt < 4; ++nt) { ckv[nt] = (f32x4){0.f, 0.f, 0.f, 0.f};
#pragma unroll
                                for (int ks = 0; ks < 4; ++ks) ckv[nt] = __builtin_amdgcn_mfma_f32_16x16x32_bf16(akv[ks], bkv[nt][ks], ckv[nt], 0, 0, 0); }
                            float rki[4];
#pragma unroll
                            for (int i = 0; i < 4; ++i) rki[i] = __shfl(rk_, 4 * kq + i);
                            if (!odd) {
#pragma unroll
                                for (int i = 0; i < 4; ++i) { bf16_t* mk = MKN + (row0 + mt * 16 + 4 * kq + i) * 256 + hh * 64 + fr;
                                    mk[0] = f2bf(ckv[0][i] * rki[i]); mk[16] = f2bf(ckv[1][i] * rki[i]); mk[32] = f2bf(ckv[2][i] * rki[i]); mk[48] = f2bf(ckv[3][i] * rki[i]); } }
                            else {
#pragma unroll
                                for (int nt = 0; nt < 4; ++nt) { u32x2 w; w.x = pk2(ckv[nt][0] * rki[0], ckv[nt][1] * rki[1]); w.y = pk2(ckv[nt][2] * rki[2], ckv[nt][3] * rki[3]);
                                    *(u32x2*)(MVT + ((bb * 4 + hh) * 64 + 16 * nt + fr) * SEQ + t0 + mt * 16 + 4 * kq) = w; } }
                        }
                    }
                }
            }
            {
                const int r32 = lane & 31, hi = lane >> 5, gh = wave >> 1, gg = wave & 1, ch = tid & 255, half = tid >> 8;
                bf16x8 bW[2][4];
                { const bf16_t* wt = (const bf16_t*)(ws + WS_WGT) + (size_t)(((l * 2 + gg) * 4 + gh) * 64) * 64;
#pragma unroll
                  for (int nt = 0; nt < 2; ++nt)
#pragma unroll
                      for (int ks = 0; ks < 4; ++ks) bW[nt][ks] = *(const bf16x8*)(wt + (size_t)(32 * nt + r32) * 64 + 16 * ks + 8 * hi); }
                const float gbias0 = (gg == 0 ? inp(args, 7) : inp(args, 9))[l * 256 + gh * 64 + r32], gbias1 = (gg == 0 ? inp(args, 7) : inp(args, 9))[l * 256 + gh * 64 + 32 + r32];
                const float cw0 = inp(args, 4)[(l * 4 + 0) * 256 + ch], cw1 = inp(args, 4)[(l * 4 + 1) * 256 + ch], cw2 = inp(args, 4)[(l * 4 + 2) * 256 + ch], cw3 = inp(args, 4)[(l * 4 + 3) * 256 + ch], cb = inp(args, 5)[l * 256 + ch];
                const float sp = ((const float*)(ws + WS_SP))[l * 256 + ch];
                LAS float* xa = ldsf; LAS float* xc = ldsf + 35 * 256; LAS unsigned char* xcb = lds + 67 * 1024; LAS float* gR = (LAS float*)(lds + 67 * 1024 + 32 * 528); LAS float* gI = gR + 32 * 256;
            const bool j1bal = (G == 256 && REP_J1 == 1);
            for (int r_ = bid, k_ = 0; j1bal ? (k_ < (bid < 128 ? 3 : 5)) : (r_ < N_J1 * REP_J1); r_ += G, ++k_) { const int r = j1bal ? (bid < 128 ? bid + 128 * k_ : 384 + (bid - 128) + 128 * k_) : r_ % N_J1;
                    const int b = r >> 8, tb = r & 255, t0 = tb * 32;
                    for (int c = tid; c < 35 * 32; c += NTHR) { const int rr = c >> 5, c8 = c & 31, t = t0 - 3 + rr; u32x4 w = {0u, 0u, 0u, 0u}; if (t >= 0) w = *(const u32x4*)(PB + ((size_t)b * SEQ + t) * NIN + C_AX + 8 * c8);
                        LAS f32x4* d = (LAS f32x4*)(xa + rr * 256 + 8 * c8); d[0] = (f32x4){bflo(w.x), bfhi(w.x), bflo(w.y), bfhi(w.y)}; d[1] = (f32x4){bflo(w.z), bfhi(w.z), bflo(w.w), bfhi(w.w)}; }
                    __syncthreads();
#pragma unroll 4
                    for (int tt = 0; tt < 16; ++tt) { const int rr = half * 16 + tt; const float v = cb + cw0 * xa[rr * 256 + ch] + cw1 * xa[(rr + 1) * 256 + ch] + cw2 * xa[(rr + 2) * 256 + ch] + cw3 * xa[(rr + 3) * 256 + ch];
                        xc[rr * 256 + ch] = v; *(LAS bf16_t*)(xcb + rr * 528 + ch * 2) = f2bf(v); }
                    __syncthreads();
                    { f32x16 acc[2];
#pragma unroll
                      for (int i = 0; i < 16; ++i) { acc[0][i] = 0.f; acc[1][i] = 0.f; }
#pragma unroll
                      for (int ks = 0; ks < 4; ++ks) { const bf16x8 a = *(const LAS bf16x8*)(xcb + r32 * 528 + (gh * 64 + 16 * ks + 8 * hi) * 2); acc[0] = mfma32(a, bW[0][ks], acc[0]); acc[1] = mfma32(a, bW[1][ks], acc[1]); }
                      LAS float* gd = gg == 0 ? gR : gI;
#pragma unroll
                      for (int i = 0; i < 16; ++i) { const int tok = (i & 3) + 8 * (i >> 2) + 4 * hi; gd[tok * 256 + gh * 64 + r32] = sigmoidf_(acc[0][i] + gbias0); gd[tok * 256 + gh * 64 + 32 + r32] = sigmoidf_(acc[1][i] + gbias1); } }
                    __syncthreads();
                    float hst = 0.f, Ac = 1.f;
#pragma unroll 4
                    for (int tt = 0; tt < 16; ++tt) {
                        const int rr = half * 16 + tt;
                        const float la = -8.f * gR[rr * 256 + ch] * sp, x2 = 2.f * la;
                        const float av = la > -0.25f ? 1.f + la * (1.f + la * (0.5f + la * (0.16666667f + la * (0.041666667f + la * 0.0083333333f)))) : __expf(la);
                        const float om = x2 > -0.5f ? -x2 * (1.f + x2 * (0.5f + x2 * (0.16666667f + x2 * (0.041666667f + x2 * (0.0083333333f + x2 * 0.0013888889f))))) : 1.f - __expf(x2);
                        const float u = __builtin_amdgcn_sqrtf(om) * (gI[rr * 256 + ch] * xc[rr * 256 + ch]);
                        hst = av * hst + u; Ac *= av;
                        { const size_t ao = ((size_t)b * SEQ + t0 + rr) * 256 + ch; LRA[ao] = av; LRU_[ao] = u; }
                    }
                    const size_t so = ((size_t)(b * 512 + tb * 2 + half)) * 256 + ch;
                    LA[so] = Ac; LH[so] = hst;
                    __syncthreads();
            }
            }
            {
                const int kk = tid & 127, tq = tid >> 7, r32 = lane & 31, hi = lane >> 5;
                float wg[16]; const float bg = inp(args, 16)[l * 128 + kk];
#pragma unroll
                for (int q = 0; q < 16; ++q) wg[q] = inp(args, 15)[(l * 16 + q) * 128 + kk];
                LAS float* glr = ldsf; LAS float* tot = ldsf + 1024; LAS unsigned char* KTl = lds + 8192; LAS unsigned char* VTl = lds + 8192 + 128 * VSTR;
                float* BCS = (float*)(ws + WS_BCS);
            for (int r_ = bid; r_ < N_J2 * REP_J2; r_ += G) { const int r = r_ % N_J2;
                    const int b = r >> 7, c = r & 127; const size_t row0 = (size_t)b * SEQ + 64 * c;
                    for (int e = tid; e < 1024; e += NTHR) glr[e] = bf2f(PB[(row0 + (e >> 4)) * NIN + C_GLR + (e & 15)]);
                    for (int e = tid; e < 2048; e += NTHR) { const int jj = e >> 5, hc = e & 31; const bf16_t* vsrc = PB + (row0 + jj) * NIN + C_CV + 8 * hc; const u32x2 wA = *(const u32x2*)vsrc, wB = *(const u32x2*)(vsrc + 4);
                        LAS bf16_t* d = (LAS bf16_t*)(VTl + (8 * hc) * VSTR) + jj;
                        d[0] = (bf16_t)wA.x; d[VSTR / 2] = (bf16_t)(wA.x >> 16); d[2 * (VSTR / 2)] = (bf16_t)wA.y; d[3 * (VSTR / 2)] = (bf16_t)(wA.y >> 16); d[4 * (VSTR / 2)] = (bf16_t)wB.x; d[5 * (VSTR / 2)] = (bf16_t)(wB.x >> 16); d[6 * (VSTR / 2)] = (bf16_t)wB.y; d[7 * (VSTR / 2)] = (bf16_t)(wB.y >> 16); }
                    __syncthreads();
                    float bv[16]; float run = 0.f;
#pragma unroll
                    for (int tt = 0; tt < 16; ++tt) { const LAS f32x4* g4 = (const LAS f32x4*)(glr + (16 * tq + tt) * 16); float z = bg;
#pragma unroll
                        for (int q = 0; q < 4; ++q) { const f32x4 g = g4[q]; z += g[0] * wg[4 * q] + g[1] * wg[4 * q + 1] + g[2] * wg[4 * q + 2] + g[3] * wg[4 * q + 3]; }
                        run += (fminf(z, 0.f) - __logf(1.f + __expf(-fabsf(z)))) * (1.f / 16.f); bv[tt] = run; }
                    tot[tq * 128 + kk] = run;
                    __syncthreads();
                    { const float t0_ = tot[kk], t1_ = tot[128 + kk], t2_ = tot[256 + kk], t3_ = tot[384 + kk]; const float off = tq == 0 ? 0.f : (tq == 1 ? t0_ : (tq == 2 ? t0_ + t1_ : (t0_ + t1_) + t2_)), blast = ((t0_ + t1_) + t2_) + t3_;
#pragma unroll
                      for (int tt = 0; tt < 16; ++tt) { const int t = 16 * tq + tt; const float bt = bv[tt] + off; BCS[(row0 + t) * 128 + kk] = bt;
                          *((LAS bf16_t*)(KTl + kk * VSTR) + t) = f2bf(bf2f(PB[(row0 + t) * NIN + C_CK + kk]) * __expf(blast - bt)); }
                      if (tq == 0) DEC[(size_t)(b * 128 + c) * 128 + kk] = __expf(blast); }
                    __syncthreads();
                    { const int h = wave >> 1, nt = wave & 1; f32x16 acc;
#pragma unroll
                      for (int i = 0; i < 16; ++i) acc[i] = 0.f;
                      const LAS unsigned char* ap = KTl + (h * 32 + r32) * VSTR + 16 * hi; const LAS unsigned char* bp = VTl + (h * 64 + 32 * nt + r32) * VSTR + 16 * hi;
#pragma unroll
                      for (int s = 0; s < 4; ++s) { const u32x2 a0 = *(const LAS u32x2*)(ap + 32 * s), a1 = *(const LAS u32x2*)(ap + 32 * s + 8), b0 = *(const LAS u32x2*)(bp + 32 * s), b1 = *(const LAS u32x2*)(bp + 32 * s + 8);
                          u32x4 aw, bw; aw.x = a0.x; aw.y = a0.y; aw.z = a1.x; aw.w = a1.y; bw.x = b0.x; bw.y = b0.y; bw.z = b1.x; bw.w = b1.y;
                          acc = mfma32(__builtin_bit_cast(bf16x8, aw), __builtin_bit_cast(bf16x8, bw), acc); }
                      float* o = KVC + ((size_t)(b * 128 + c) * 4 + h) * 2048 + 32 * nt + r32;
#pragma unroll
                      for (int i = 0; i < 16; ++i) o[((i & 3) + 8 * (i >> 2) + 4 * hi) * 64] = acc[i]; }
                    __syncthreads();
            }
            }
            for (int r = bid; r < N_J4; r += G) {
                    const size_t row0 = (size_t)r * 64;
#pragma unroll
                    for (int it3 = 0; it3 < 3; ++it3) {
                        const int e = tid + it3 * NTHR, tok = e / 24, p = e % 24, hd = p >> 2, c8 = p & 3; const int base = hd < 4 ? C_BQ + hd * 64 : (hd == 4 ? C_KS : C_KW); const float sc = hd < 4 ? 0.125f * LOG2E : 1.f;
                        bf16_t* pr = PB + (row0 + tok) * NIN + base + 8 * c8; const u32x4 a = *(const u32x4*)pr, c = *(const u32x4*)(pr + 32); const float2* cs = cs64 + (row0 + tok) * 32 + 8 * c8;
                        const unsigned au[4] = {a.x, a.y, a.z, a.w}, cu[4] = {c.x, c.y, c.z, c.w}; unsigned o1[4], o2[4];
#pragma unroll
                        for (int q = 0; q < 4; ++q) { const float2 s0 = cs[2 * q], s1 = cs[2 * q + 1]; const float x1a = bflo(au[q]), x1b = bfhi(au[q]), x2a = bflo(cu[q]), x2b = bfhi(cu[q]);
                            o1[q] = pk2((x1a * s0.x - x2a * s0.y) * sc, (x1b * s1.x - x2b * s1.y) * sc); o2[q] = pk2((x2a * s0.x + x1a * s0.y) * sc, (x2b * s1.x + x1b * s1.y) * sc); }
                        u32x4 w1, w2; w1.x = o1[0]; w1.y = o1[1]; w1.z = o1[2]; w1.w = o1[3]; w2.x = o2[0]; w2.y = o2[1]; w2.z = o2[2]; w2.w = o2[3];
                        *(u32x4*)pr = w1; *(u32x4*)(pr + 32) = w2;
                        if (hd == 4) {
                            bf16_t* kf_ = KSF + (row0 / 64) * 4096 + (size_t)((((tok >> 5) * 4 + (c8 >> 1)) * 64 + (c8 & 1) * 32 + (tok & 31)) * 8); *(u32x4*)kf_ = w1; *(u32x4*)(kf_ + 2 * 64 * 8) = w2; } }
                    { LAS bf16_t* tl = (LAS bf16_t*)lds; const size_t bb = row0 / SEQ, t0 = row0 % SEQ;
                      for (int mtx = 0; mtx < 2; ++mtx) { const int tok = tid >> 3, c = tid & 7; const u32x4 w = *(const u32x4*)(PB + (row0 + tok) * NIN + (mtx ? C_VW : C_VS) + c * 8);
                          LAS bf16_t* dst = tl + mtx * 64 * 72 + tok * 72 + c * 8; dst[0] = (bf16_t)w.x; dst[1] = (bf16_t)(w.x >> 16); dst[2] = (bf16_t)w.y; dst[3] = (bf16_t)(w.y >> 16); dst[4] = (bf16_t)w.z; dst[5] = (bf16_t)(w.z >> 16); dst[6] = (bf16_t)w.w; dst[7] = (bf16_t)(w.w >> 16); }
                      __syncthreads();
                      for (int mtx = 0; mtx < 2; ++mtx) { const int d = tid >> 3, c8 = tid & 7; const LAS bf16_t* s = tl + mtx * 64 * 72 + (c8 * 8) * 72 + d;
                          u32x4 w; w.x = (unsigned)s[0] | ((unsigned)s[72] << 16); w.y = (unsigned)s[2 * 72] | ((unsigned)s[3 * 72] << 16); w.z = (unsigned)s[4 * 72] | ((unsigned)s[5 * 72] << 16); w.w = (unsigned)s[6 * 72] | ((unsigned)s[7 * 72] << 16);
                          if (mtx) *(u32x4*)(VWT + (bb * 64 + d) * SEQ + t0 + c8 * 8) = w;
                          else { const int s_ = c8 >> 1, h_ = c8 & 1; const LAS bf16_t* q = tl + (16 * s_ + 4 * h_) * 72 + d;
                              u32x4 f; f.x = (unsigned)q[0] | ((unsigned)q[72] << 16); f.y = (unsigned)q[2 * 72] | ((unsigned)q[3 * 72] << 16); f.z = (unsigned)q[8 * 72] | ((unsigned)q[9 * 72] << 16); f.w = (unsigned)q[10 * 72] | ((unsigned)q[11 * 72] << 16);
                              *(u32x4*)(VST + (row0 / 64) * 4096 + (size_t)((((d >> 5) * 4 + s_) * 64 + h_ * 32 + (d & 31)) * 8)) = f; } }
                      __syncthreads(); }
            }
            }
        }
        SEAM(pb + 1);
        if (IN(pb + 2)) {
        const int l_ = l; WS_PTRS();
        LAUNDER_TID();
            constexpr int Q_J5 = 2, Q_J6 = 64, Q_ATT = 1024 * REP_ATT, Q_J9 = 1024, Q_J10 = 512, Q_TOT = Q_J5 + Q_J6 + Q_ATT + Q_J9 + Q_J10;
            if (tid == 0) { LCTL[4] = 0u; LCTL[5] = 0u; }
            __syncthreads();
            const int tid_o = tid;
            for (;;) {
                int tid = tid_o; asm volatile("" : "+v"(tid)); const int lane = tid & 63;
                if (tid == 0) LCTL[2] = __hip_atomic_fetch_add(ctl + CW_QUEUE + 64 * l, 1u, __ATOMIC_RELAXED, __HIP_MEMORY_SCOPE_AGENT);
                __syncthreads();
                int r = __builtin_amdgcn_readfirstlane((int)LCTL[2]); const unsigned seen5 = LCTL[4], seen6 = LCTL[5];
                __syncthreads();
                if (r >= Q_TOT * REP_P3) break;
                if (REP_P3 > 1 && r >= Q_TOT) r -= Q_TOT;
                if (r < Q_J5) {
                    const int e = r * NTHR + tid, b = e >> 8, ch = e & 255; float carry = 0.f;
                    for (int c0 = 0; c0 < 512; c0 += 8) { float av[8], hv[8];
#pragma unroll
                        for (int q = 0; q < 8; ++q) { const size_t so = ((size_t)(b * 512 + c0 + q)) * 256 + ch; av[q] = LA[so]; hv[q] = LH[so]; }
#pragma unroll
                        for (int q = 0; q < 8; ++q) { CIN[((size_t)(b * 512 + c0 + q)) * 256 + ch] = carry; carry = av[q] * carry + hv[q]; } }
                    asm volatile("s_waitcnt vmcnt(0)" ::: "memory"); __syncthreads();
                    if (tid == 0) { __builtin_amdgcn_fence(__ATOMIC_RELEASE, "agent"); asm volatile("s_waitcnt vmcnt(0)" ::: "memory"); (void)xb_add(ctl + CW_FLAG + 64 * (2 * l + 0), 1u); }
                    continue;
                }
                r -= Q_J5;
                if (r < Q_J6) {
                    const int e = r * NTHR + tid, b = e >> 13, rem = e & 8191; float Sv = 0.f;
                    for (int c0 = 0; c0 < 128; c0 += 8) { float kv[8], dv[8];
#pragma unroll
                        for (int q = 0; q < 8; ++q) { kv[q] = KVC[(size_t)(b * 128 + c0 + q) * 8192 + rem]; dv[q] = DEC[(size_t)(b * 128 + c0 + q) * 128 + (rem >> 6)]; }
#pragma unroll
                        for (int q = 0; q < 8; ++q) { SST[(size_t)(b * 128 + c0 + q) * 8192 + rem] = Sv; Sv = dv[q] * Sv + kv[q]; } }
                    asm volatile("s_waitcnt vmcnt(0)" ::: "memory"); __syncthreads();
                    if (tid == 0) { __builtin_amdgcn_fence(__ATOMIC_RELEASE, "agent"); asm volatile("s_waitcnt vmcnt(0)" ::: "memory"); (void)xb_add(ctl + CW_FLAG + 64 * (2 * l + 1), 1u); }
                    continue;
                }
                r -= Q_J6;
                if (r >= Q_ATT) {
                    r -= Q_ATT; const bool is9 = r < Q_J9;
                    if (!(is9 ? seen5 : seen6)) {
                        if (tid == 0) { unsigned* f = ctl + CW_FLAG + 64 * (2 * l + (is9 ? 0 : 1)); const unsigned target = is9 ? (unsigned)Q_J5 : (unsigned)Q_J6;
                            XB_SPIN(xb_ld(f) < target, ctl + CW_BAR); __builtin_amdgcn_fence(__ATOMIC_ACQUIRE, "agent"); asm volatile("s_waitcnt vmcnt(0)" ::: "memory"); LCTL[is9 ? 4 : 5] = 1u; }
                        __syncthreads(); }
                    if (is9) {
                    const int b = r >> 8, tb = r & 255, t0 = tb * 32, ch = tid & 255, half = tid >> 8;
                    LAS float* xa = ldsf;
                    float hst = CIN[((size_t)(b * 512 + tb * 2 + half)) * 256 + ch];
                    { float av[16], uv[16], gv[16];
#pragma unroll
                      for (int tt = 0; tt < 16; ++tt) { const size_t ro = (size_t)b * SEQ + t0 + half * 16 + tt; av[tt] = LRA[ro * 256 + ch]; uv[tt] = LRU_[ro * 256 + ch]; gv[tt] = bf2f(PB[ro * NIN + C_AG + ch]); }
#pragma unroll
                      for (int tt = 0; tt < 16; ++tt) { hst = av[tt] * hst + uv[tt]; xa[(half * 16 + tt) * 256 + ch] = hst * gelu_tanh(gv[tt]); } }
                    __syncthreads();
                    for (int q = 0; q < 4; ++q) { const int rr = wave * 4 + q; const f32x4 v = ((const LAS f32x4*)(xa + rr * 256))[lane];
                        const float rinv = rsqrtf(wave_sum(v[0] * v[0] + v[1] * v[1] + v[2] * v[2] + v[3] * v[3]) * (1.f / 256.f) + EPS);
                        u32x2 w; w.x = pk2(v[0] * rinv, v[1] * rinv); w.y = pk2(v[2] * rinv, v[3] * rinv);
                        *(u32x2*)(Y + ((size_t)b * SEQ + t0 + rr) * DM + 256 + 4 * lane) = w; }
                    __syncthreads();
                    } else { r -= Q_J9;
                    const int b = r >> 7, c = r & 127; const size_t row0 = (size_t)b * SEQ + 64 * c;
                    LAS float* bL = ldsf; LAS float* glr = ldsf + 8192; LAS unsigned char* VTl = lds + 36864; LAS unsigned char* STl = lds + 71680; LAS float* SSX = (LAS float*)(lds + 92160);
                    for (int e = tid; e < 2048; e += NTHR) ((LAS f32x4*)bL)[e] = ((const f32x4*)((const float*)(ws + WS_BCS) + row0 * 128))[e];
                    for (int e = tid; e < 2048; e += NTHR) { const int jj = e >> 5, hc = e & 31, h = hc >> 3, c8 = hc & 7; const bf16_t* vsrc = PB + (row0 + jj) * NIN + C_CV + h * 64 + 8 * c8; const u32x2 wA = *(const u32x2*)vsrc, wB = *(const u32x2*)(vsrc + 4); u32x4 w; w.x = wA.x; w.y = wA.y; w.z = wB.x; w.w = wB.y;
                        LAS bf16_t* d = (LAS bf16_t*)(VTl + h * 8704 + (8 * c8) * VSTR) + jj;
                        d[0] = (bf16_t)w.x; d[VSTR / 2] = (bf16_t)(w.x >> 16); d[2 * (VSTR / 2)] = (bf16_t)w.y; d[3 * (VSTR / 2)] = (bf16_t)(w.y >> 16); d[4 * (VSTR / 2)] = (bf16_t)w.z; d[5 * (VSTR / 2)] = (bf16_t)(w.z >> 16); d[6 * (VSTR / 2)] = (bf16_t)w.w; d[7 * (VSTR / 2)] = (bf16_t)(w.w >> 16); }
                    for (int e = tid; e < 8192; e += NTHR) { const int h = e >> 11, k = (e >> 6) & 31, v = e & 63; *(LAS bf16_t*)(STl + h * 5120 + v * 80 + k * 2) = f2bf(SST[(size_t)(b * 128 + c) * 8192 + e]); }
                    __syncthreads();
                    { const int r32 = lane & 31, hi = lane >> 5, h = wave >> 1, ih = wave & 1, i = 32 * ih + r32; const float SCG = 0.17677669529663687f;
                      bf16x8 qrel[2], qabs[2], kt[2][2];
#pragma unroll
                      for (int ks = 0; ks < 2; ++ks) { const int k0 = h * 32 + 16 * ks + 8 * hi; const bf16x8 qv = ld8x2(PB + (row0 + i) * NIN + C_CQ + k0); u32x4 wr_, wa_; unsigned* pr_ = (unsigned*)&wr_; unsigned* pa_ = (unsigned*)&wa_;
#pragma unroll
                          for (int e2 = 0; e2 < 4; ++e2) { const float b0 = bL[i * 128 + k0 + 2 * e2], b1 = bL[i * 128 + k0 + 2 * e2 + 1], f0 = bL[31 * 128 + k0 + 2 * e2], f1 = bL[31 * 128 + k0 + 2 * e2 + 1];
                              const float q0 = bf2f((bf16_t)qv[2 * e2]) * SCG, q1 = bf2f((bf16_t)qv[2 * e2 + 1]) * SCG;
                              pr_[e2] = cvtpk(q0 * __expf(b0 - f0), q1 * __expf(b1 - f1)); pa_[e2] = cvtpk(q0 * __expf(b0), q1 * __expf(b1)); }
                          qrel[ks] = __builtin_bit_cast(bf16x8, wr_); qabs[ks] = __builtin_bit_cast(bf16x8, wa_); }
#pragma unroll
                      for (int jt = 0; jt < 2; ++jt)
#pragma unroll
                          for (int ks = 0; ks < 2; ++ks) { const int jr = 32 * jt + r32, k0 = h * 32 + 16 * ks + 8 * hi; const bf16x8 kv = ld8x2(PB + (row0 + jr) * NIN + C_CK + k0); u32x4 wk_; unsigned* pk_ = (unsigned*)&wk_;
#pragma unroll
                              for (int e2 = 0; e2 < 4; ++e2) { const float b0 = bL[jr * 128 + k0 + 2 * e2], b1 = bL[jr * 128 + k0 + 2 * e2 + 1], f0 = bL[31 * 128 + k0 + 2 * e2], f1 = bL[31 * 128 + k0 + 2 * e2 + 1];
                                  pk_[e2] = cvtpk(bf2f((bf16_t)kv[2 * e2]) * __expf(f0 - b0), bf2f((bf16_t)kv[2 * e2 + 1]) * __expf(f1 - b1)); }
                              kt[jt][ks] = __builtin_bit_cast(bf16x8, wk_); }
                      f32x16 o[2], s[2];
#pragma unroll
                      for (int q = 0; q < 16; ++q) { o[0][q] = 0.f; o[1][q] = 0.f; s[0][q] = 0.f; s[1][q] = 0.f; }
#pragma unroll
                      for (int ks = 0; ks < 2; ++ks) s[0] = mfma32(kt[0][ks], qrel[ks], s[0]);
                      if (ih) {
#pragma unroll
                          for (int ks = 0; ks < 2; ++ks) s[1] = mfma32(kt[1][ks], qrel[ks], s[1]); }
#pragma unroll
                      for (int q = 0; q < 16; ++q) { const int jr = (q & 3) + 8 * (q >> 2) + 4 * hi; if (jr > r32) { if (ih) s[1][q] = 0.f; else s[0][q] = 0.f; } }
                      const LAS unsigned char* VTh = VTl + h * 8704; const LAS unsigned char* STh = STl + h * 5120;
#pragma unroll
                      for (int dt = 0; dt < 2; ++dt) { const LAS unsigned char* vp = VTh + (32 * dt + r32) * VSTR + 8 * hi;
                          o[dt] = mfma32(vfrag(vp), pack8<0>(s[0]), o[dt]); o[dt] = mfma32(vfrag(vp + 32), pack8<8>(s[0]), o[dt]);
                          if (ih) { o[dt] = mfma32(vfrag(vp + 64), pack8<0>(s[1]), o[dt]); o[dt] = mfma32(vfrag(vp + 96), pack8<8>(s[1]), o[dt]); }
#pragma unroll
                          for (int ks = 0; ks < 2; ++ks) o[dt] = mfma32(*(const LAS bf16x8*)(STh + (32 * dt + r32) * 80 + 32 * ks + 16 * hi), qabs[ks], o[dt]); }
                      float ssh = 0.f;
#pragma unroll
                      for (int q = 0; q < 16; ++q) ssh += o[0][q] * o[0][q] + o[1][q] * o[1][q];
                      const float rh = rsqrtf(xhalf_sum(ssh) * (1.f / 64.f) + EPS); float ssg = 0.f;
#pragma unroll
                      for (int dt = 0; dt < 2; ++dt)
#pragma unroll
                          for (int g = 0; g < 4; ++g) { const int v0 = 32 * dt + 8 * g + 4 * hi; const u32x2 ogw = *(const u32x2*)(PB + (row0 + i) * NIN + C_OG + h * 64 + v0); const f32x4 gn = *(const f32x4*)(inp(args, 17) + l * 64 + v0);
                              const float og4[4] = {bflo(ogw.x), bfhi(ogw.x), bflo(ogw.y), bfhi(ogw.y)};
#pragma unroll
                              for (int q = 0; q < 4; ++q) { const float y = o[dt][4 * g + q] * rh * gn[q] * (og4[q] * sigmoidf_(og4[q])); o[dt][4 * g + q] = y; ssg += y * y; } }
                      ssg = xhalf_sum(ssg); if (hi == 0) SSX[i * 4 + h] = ssg;
                      __syncthreads();
                      const f32x4 s4 = *(const LAS f32x4*)(SSX + i * 4); const float rinv = rsqrtf((s4[0] + s4[1] + s4[2] + s4[3]) * (1.f / 256.f) + EPS);
#pragma unroll
                      for (int dt = 0; dt < 2; ++dt)
#pragma unroll
                          for (int g = 0; g < 4; ++g) { u32x2 w; w.x = cvtpk(o[dt][4 * g] * rinv, o[dt][4 * g + 1] * rinv); w.y = cvtpk(o[dt][4 * g + 2] * rinv, o[dt][4 * g + 3] * rinv);
                              *(u32x2*)(Y + (row0 + i) * DM + 768 + h * 64 + 32 * dt + 8 * g + 4 * hi) = w; } }
                    __syncthreads();
                    }
                    continue;
                }
                const int r32 = lane & 31, hi = lane >> 5;
                const int rep = r >> 10; r &= 1023;
                const int grp = r >> 5, within = r & 31;
                if (rep && ((REP_ONLY == 1 && within >= 16) || (REP_ONLY == 2 && within < 16))) continue;
              {
                if (within >= 16) {
                    const int idx = within - 16, b = idx & 3, tb = 127 - (4 * grp + (idx >> 2));
                    const int tl = 8 * wave + (r32 >> 2), head = r32 & 3, T = 64 * tb + tl; const size_t row = (size_t)b * SEQ + T; const bf16_t* prow = PB + row * NIN;
                    bf16x8 qf[4];
#pragma unroll
                    for (int ks = 0; ks < 4; ++ks) qf[ks] = *(const bf16x8*)(prow + C_BQ + head * 64 + 16 * ks + 8 * hi);
                    LAS float* impb = (LAS float*)(lds + AL_IMP) + wave * 1024; LAS unsigned* selm = (LAS unsigned*)(lds + AL_SELM) + wave * 32;
                    const int skey = tid >> 3, sch = tid & 7;
                    const unsigned koffP = (unsigned)(skey * NIN + sch * 8), voffS = (unsigned)(skey * SEQ + sch * 8), koffC = (unsigned)(skey * 64 + sch * 8), voffC = (unsigned)(skey * 512 + sch * 8);
                    auto stK = [&](int buf, const StageRegs& R) __attribute__((always_inline)) { *(LAS u32x4*)(lds + (buf ? AL_K1 : AL_K0) + skey * KSTR + sch * 16) = R.a; };
                    auto stKV = [&](int buf, const StageRegs& R) __attribute__((always_inline)) { *(LAS u32x4*)(lds + (buf ? AL_K1 : AL_K0) + skey * KSTR + sch * 16) = R.a;
                        LAS unsigned char* vd = lds + (buf ? AL_V1 : AL_V0) + skey * VSTP + (sch >> 1) * 32 + (sch & 1) * 8; u32x2 a, c; a.x = R.b.x; a.y = R.b.y; c.x = R.b.z; c.y = R.b.w; *(LAS u32x2*)vd = a; *(LAS u32x2*)(vd + 16) = c; };
                    f32x16 oacc[2], ob[2];
                    const int nv = T >= 31 ? ((T - 31) >> 4) + 1 : 0, ntc = (4 * tb + 3 + 63) >> 6;
                    float mC = NEGB, lC = 0.f;
                    { const bf16_t* kb_ = KCMPB + (size_t)b * 512 * 64;
                      attn_pipeline(0, ntc - 1, [&](int j, StageRegs& R) __attribute__((always_inline)) { R.a = *(const u32x4*)((kb_ + (size_t)j * 64 * 64) + koffC); }, stK,
                        [&](int j, int cb) __attribute__((always_inline)) { f32x16 s0, s1; qk_tile<4>(lds + (cb ? AL_K1 : AL_K0), qf, r32, hi, s0, s1); if (!__all(nv - 1 - 64 * j >= 63)) mask_tile(s0, s1, 0, nv - 1 - 64 * j, hi);
                            const float mx = tile_max(s0, s1), mn = fmaxf(mC, mx), ms = mn < -1e29f ? 0.f : mn, alpha = ex2(mC - ms); mC = mn; float ps = 0.f;
#pragma unroll
                            for (int i = 0; i < 16; ++i) ps += ex2(s0[i] - ms) + ex2(s1[i] - ms);
                            lC = lC * alpha + ps; }); }
                    { const float invC = 1.f / fmaxf(xhalf_sum(lC), 1e-30f), msC = mC < -1e29f ? 0.f : mC; float carry = 0.f;
#pragma unroll
                      for (int i = 0; i < 16; ++i) { ob[0][i] = 0.f; ob[1][i] = 0.f; }
                      const bf16_t* kb_ = KCMPB + (size_t)b * 512 * 64; const bf16_t* vb_ = VCMPT + (size_t)b * 64 * 512;
                      attn_pipeline(0, ntc - 1, [&](int j, StageRegs& R) __attribute__((always_inline)) { R.a = *(const u32x4*)((kb_ + (size_t)j * 64 * 64) + koffC); R.b = *(const u32x4*)((vb_ + j * 64) + voffC); }, stKV,
                        [&](int j, int cb) __attribute__((always_inline)) { f32x16 s0, s1; qk_tile<4>(lds + (cb ? AL_K1 : AL_K0), qf, r32, hi, s0, s1); if (!__all(nv - 1 - 64 * j >= 63)) mask_tile(s0, s1, 0, nv - 1 - 64 * j, hi);
#pragma unroll
                            for (int i = 0; i < 16; ++i) { s0[i] = ex2(s0[i] - msC) * invC; s1[i] = ex2(s1[i] - msC) * invC; }
                            float gs[8], pl[8];
#pragma unroll
                            for (int q = 0; q < 4; ++q) { gs[q] = (s0[4 * q] + s0[4 * q + 1]) + (s0[4 * q + 2] + s0[4 * q + 3]); gs[4 + q] = (s1[4 * q] + s1[4 * q + 1]) + (s1[4 * q + 2] + s1[4 * q + 3]);
                                pl[q] = __shfl_xor(s0[4 * q + 3], 32); pl[4 + q] = __shfl_xor(s1[4 * q + 3], 32); }
#pragma unroll
                            for (int q = 0; q < 8; ++q) { const float prev = hi ? pl[q] : (q > 0 ? pl[q > 0 ? q - 1 : 0] : carry); float x = gs[q] + prev; x += __shfl_xor(x, 1); x += __shfl_xor(x, 2);
                                if ((r32 & 3) == 0) impb[(r32 >> 2) * 128 + 16 * j + 2 * q + hi] = x; }
                            carry = pl[7];
                            pv_tile(s0, s1, lds + (cb ? AL_V1 : AL_V0), ob, r32, hi); }); }
                    LAS float* oav = (LAS float*)(lds + AL_OACC) + tid; const float g0 = sigmoidf_(bf2f(prow[C_BG + head * 3]));
#pragma unroll
                    for (int i = 0; i < 16; ++i) { oav[i * 512] = g0 * ob[0][i]; oav[(16 + i) * 512] = g0 * ob[1][i]; }
                    WSYNC();
                    for (int tk = 0; tk < 8; ++tk) {
                        const int cur = tb, j0 = lane, j1 = lane + 64; const float im0 = impb[tk * 128 + j0], im1 = impb[tk * 128 + j1];
                        const unsigned k0 = ((j0 == 0 || j0 == cur || j0 == cur - 1) ? 0xFF000000u : (j0 <= cur ? (__float_as_uint(im0) & ~127u) : 0u)) | (unsigned)(127 - j0);
                        const unsigned k1 = ((j1 == cur || j1 == cur - 1) ? 0xFF000000u : (j1 <= cur ? (__float_as_uint(im1) & ~127u) : 0u)) | (unsigned)(127 - j1);
                        unsigned T = 0u;
#pragma unroll 4
                        for (int bb = 31; bb >= 0; --bb) { const unsigned cand = T | (1u << bb); const int cnt = __popcll(__ballot(k0 >= cand)) + __popcll(__ballot(k1 >= cand)); if (cnt >= 16) T = cand; }
                        const unsigned long long m0 = __ballot(k0 >= T), m1 = __ballot(k1 >= T);
                        if (lane == 0) { selm[tk * 4] = (unsigned)m0; selm[tk * 4 + 1] = (unsigned)(m0 >> 32); selm[tk * 4 + 2] = (unsigned)m1; selm[tk * 4 + 3] = (unsigned)(m1 >> 32); }
                    }
                    WSYNC();
                    const unsigned sm0 = selm[(r32 >> 2) * 4], sm1 = selm[(r32 >> 2) * 4 + 1], sm2 = selm[(r32 >> 2) * 4 + 2], sm3 = selm[(r32 >> 2) * 4 + 3];
                    { SoftState SB; soft_init(SB, ob);
                      unsigned u0 = sm0, u1 = sm1, u2 = sm2, u3 = sm3;
#pragma unroll
                      for (int o_ = 1; o_ < 64; o_ <<= 1) { u0 |= (unsigned)__shfl_xor((int)u0, o_); u1 |= (unsigned)__shfl_xor((int)u1, o_); u2 |= (unsigned)__shfl_xor((int)u2, o_); u3 |= (unsigned)__shfl_xor((int)u3, o_); }
                      unsigned long long Ulo = ((unsigned long long)(unsigned)__builtin_amdgcn_readfirstlane((int)u1) << 32) | (unsigned)__builtin_amdgcn_readfirstlane((int)u0), Uhi = ((unsigned long long)(unsigned)__builtin_amdgcn_readfirstlane((int)u3) << 32) | (unsigned)__builtin_amdgcn_readfirstlane((int)u2);
                      if (tb < 64) { if (tb < 63) Ulo &= (2ull << tb) - 1ull; Uhi = 0ull; } else if (tb < 127) Uhi &= (2ull << (tb - 64)) - 1ull;
                      const bf16_t* ksf = KSF + (size_t)b * 128 * 4096; const bf16_t* vsf = VST + (size_t)b * 128 * 4096; const unsigned lo8 = (unsigned)lane * 8u;
                      bf16x8 kf[2][4], vf[2][4];
                      int j = 0; Ulo &= ~1ull;
#pragma unroll
                      for (int f = 0; f < 8; ++f) kf[f >> 2][f & 3] = *(const bf16x8*)((ksf + f * 512) + lo8);
                      bool first = true;
                      for (;;) {
#pragma unroll
                          for (int f = 0; f < 8; ++f) vf[f >> 2][f & 3] = *(const bf16x8*)((vsf + (size_t)j * 4096 + f * 512) + lo8);
                          const unsigned wsel = j < 32 ? sm0 : (j < 64 ? sm1 : (j < 96 ? sm2 : sm3)); const bool bit = (wsel >> (j & 31)) & 1u;
                          const f32x16 cinit = bcast16(bit ? -SB.m : NEGB); f32x16 s0 = cinit, s1 = cinit;
#pragma unroll
                          for (int ks = 0; ks < 4; ++ks) { s0 = mfma32(kf[0][ks], qf[ks], s0); s1 = mfma32(kf[1][ks], qf[ks], s1); }
                          __builtin_amdgcn_sched_barrier(0);
                          const int jn = Ulo ? (int)__builtin_ctzll(Ulo) : (Uhi ? 64 + (int)__builtin_ctzll(Uhi) : -1);
                          if (Ulo) Ulo &= Ulo - 1ull; else Uhi &= Uhi - 1ull;
                          if (jn >= 0) {
#pragma unroll
                              for (int f = 0; f < 8; ++f) kf[f >> 2][f & 3] = *(const bf16x8*)((ksf + (size_t)jn * 4096 + f * 512) + lo8); }
                          soft_update(s0, s1, SB, ob, j == tb, 0, tl, first, hi);
                          { const bf16x8 p00 = pack8<0>(s0), p01 = pack8<8>(s0), p10 = pack8<0>(s1), p11 = pack8<8>(s1);
#pragma unroll
                            for (int dt = 0; dt < 2; ++dt) { ob[dt] = mfma32(vf[dt][0], p00, ob[dt]); ob[dt] = mfma32(vf[dt][1], p01, ob[dt]); ob[dt] = mfma32(vf[dt][2], p10, ob[dt]); ob[dt] = mfma32(vf[dt][3], p11, ob[dt]); } }
                          if (jn < 0) break;
                          j = jn; first = false;
                      }
                      const float sc = sigmoidf_(bf2f(prow[C_BG + head * 3 + 1])) / fmaxf(xhalf_sum(SB.l), 1e-30f);
#pragma unroll
                      for (int i = 0; i < 16; ++i) { oav[i * 512] += sc * ob[0][i]; oav[(16 + i) * 512] += sc * ob[1][i]; } }
                    __syncthreads();
                    { SoftState SB; soft_init(SB, ob); const int jb0 = tb >= 8 ? tb - 8 : 0;
                      const bf16_t* kb_ = PB + (size_t)b * SEQ * NIN + C_KW; const bf16_t* vb_ = VWT + (size_t)b * 64 * SEQ;
                      attn_pipeline(tb >= 8 ? tb - 8 : 0, tb, [&](int j, StageRegs& R) __attribute__((always_inline)) { R.a = *(const u32x4*)((kb_ + (size_t)j * 64 * NIN) + koffP); R.b = *(const u32x4*)((vb_ + j * 64) + voffS); }, stKV,
                        [&](int j, int cb) __attribute__((always_inline)) { attn_step<4>(lds + (cb ? AL_K1 : AL_K0), lds + (cb ? AL_V1 : AL_V0), qf, SB, ob, j == tb || j == tb - 8, j == tb - 8 ? tl + 1 : 0, j == tb ? tl : 63, j == jb0, r32, hi); });
                      const float sc = sigmoidf_(bf2f(prow[C_BG + head * 3 + 2])) / fmaxf(xhalf_sum(SB.l), 1e-30f);
#pragma unroll
                      for (int i = 0; i < 16; ++i) { oacc[0][i] = oav[i * 512] + sc * ob[0][i]; oacc[1][i] = oav[(16 + i) * 512] + sc * ob[1][i]; } }
                    { float ss = 0.f;
#pragma unroll
                      for (int i = 0; i < 16; ++i) ss += oacc[0][i] * oacc[0][i] + oacc[1][i] * oacc[1][i];
                      ss = xhalf_sum(ss); ss += __shfl_xor(ss, 1); ss += __shfl_xor(ss, 2);
                      const float rinv = rsqrtf(ss * (1.f / 256.f) + EPS);
#pragma unroll
                      for (int dt = 0; dt < 2; ++dt)
#pragma unroll
                          for (int g = 0; g < 4; ++g) { u32x2 w; w.x = cvtpk(oacc[dt][4 * g] * rinv, oacc[dt][4 * g + 1] * rinv); w.y = cvtpk(oacc[dt][4 * g + 2] * rinv, oacc[dt][4 * g + 3] * rinv);
                              *(u32x2*)(Y + row * DM + 512 + head * 64 + 32 * dt + 8 * g + 4 * hi) = w; } }
                    __syncthreads();
                    continue;
                }
                {
                    const int qb = 31 - grp, b = within >> 2, h = within & 3;
                    const int T = 256 * qb + 32 * wave + r32; const size_t row = (size_t)b * SEQ + T;
                    bf16x8 qf[6];
#pragma unroll
                    for (int ks = 0; ks < 6; ++ks) qf[ks] = *(const bf16x8*)(MQ + row * 384 + h * 96 + 16 * ks + 8 * hi);
                    f32x16 o[2]; SoftState SM; soft_init(SM, o);
                    const int jd = 4 * qb + (wave >> 1);
                    const bf16_t* kn = MKN + (size_t)b * SEQ * 256 + h * 64; const bf16_t* kr = MKR + (size_t)b * SEQ * 32; const bf16_t* vt = MVT + (size_t)(b * 4 + h) * 64 * SEQ;
                    constexpr int VS2 = 272, AM_K0 = 0, AM_K1 = 128 * KSTR, AM_V0 = 2 * 128 * KSTR, AM_V1 = AM_V0 + 64 * VS2;
                    const int nk = tid >> 3, nc = tid & 7, rkey = tid >> 2, rch = tid & 3, vr = tid >> 4, vc = tid & 15;
                    const unsigned ko0 = (unsigned)(nk * 256 + nc * 8), ko1 = (unsigned)(rkey * 32 + rch * 8), vo_ = (unsigned)(vr * SEQ + vc * 8);
                    attn_pipeline(0, 2 * qb + 1,
                        [&](int jj, StageRegs& R) __attribute__((always_inline)) { const bf16_t* knj = kn + (size_t)jj * 128 * 256; const bf16_t* vtj = vt + jj * 128;
                            R.a = *(const u32x4*)(knj + ko0); R.b = *(const u32x4*)((knj + 64 * 256) + ko0); R.c = *(const u32x4*)((kr + (size_t)jj * 128 * 32) + ko1);
                            R.d = *(const u32x4*)(vtj + vo_); R.e = *(const u32x4*)((vtj + 32 * SEQ) + vo_); },
                        [&](int buf, const StageRegs& R) __attribute__((always_inline)) { LAS unsigned char* kb_ = lds + (buf ? AM_K1 : AM_K0); LAS unsigned char* vb_ = lds + (buf ? AM_V1 : AM_V0) + vr * VS2 + (vc >> 1) * 32 + (vc & 1) * 8;
                            *(LAS u32x4*)(kb_ + nk * KSTR + nc * 16) = R.a; *(LAS u32x4*)(kb_ + (64 + nk) * KSTR + nc * 16) = R.b; *(LAS u32x4*)(kb_ + rkey * KSTR + 128 + rch * 16) = R.c;
                            u32x2 p, q; p.x = R.d.x; p.y = R.d.y; q.x = R.d.z; q.y = R.d.w; *(LAS u32x2*)vb_ = p; *(LAS u32x2*)(vb_ + 16) = q;
                            p.x = R.e.x; p.y = R.e.y; q.x = R.e.z; q.y = R.e.w; *(LAS u32x2*)(vb_ + 32 * VS2) = p; *(LAS u32x2*)(vb_ + 32 * VS2 + 16) = q; },
                        [&](int jj, int cb) __attribute__((always_inline)) {
                            const int kd = 32 * (wave & 1) + r32;
#pragma unroll
                            for (int hh = 0; hh < 2; ++hh) { const int j = 2 * jj + hh;
                                if (j <= jd) attn_step<6, VS2, true>(lds + (cb ? AM_K1 : AM_K0) + hh * 64 * KSTR, lds + (cb ? AM_V1 : AM_V0) + hh * 128, qf, SM, o, j == jd, 0, kd, j == 0, r32, hi); } });
                    { const float inv = 1.f / fmaxf(xhalf_sum(SM.l), 1e-30f); float ss = 0.f;
#pragma unroll
                      for (int dt = 0; dt < 2; ++dt)
#pragma unroll
                          for (int g = 0; g < 4; ++g) { const float v0 = o[dt][4 * g] * inv, v1 = o[dt][4 * g + 1] * inv, v2 = o[dt][4 * g + 2] * inv, v3 = o[dt][4 * g + 3] * inv; ss += v0 * v0 + v1 * v1 + v2 * v2 + v3 * v3;
                              u32x2 w; w.x = cvtpk(v0, v1); w.y = cvtpk(v2, v3); *(u32x2*)(Y + row * DM + h * 64 + 32 * dt + 8 * g + 4 * hi) = w; }
                      ss = xhalf_sum(ss); if (hi == 0) ssq_d[(size_t)h * M + row] = ss; }
                    __syncthreads();
                }
              }
            }
        }
        SEAM(pb + 2);
        if (IN(pb + 3)) {
        const int l_ = l; WS_PTRS();
            pg8::Gemm g{Y, (const bf16_t*)(ws + WS_WOUT) + (size_t)l * DM * DM, M, DM, DM}; pg8::StaticOrder S; S.init(M, DM, G, bid);
            pg8::EpiResid<true> E{XB, ssq_out, ssq_d, (LAS float*)(lds + 131072)};
            pg8::gemm_phase<pg8::EpiResid<true>, pg8::StaticOrder, true, true>(lds, g, S, E);
            if (REP_G57) { pg8::EpiInProj E2{PB, DM, ssq_mix}; pg8::gemm_phase<pg8::EpiInProj, pg8::StaticOrder, true, true>(lds, g, S, E2); }
        }
        SEAM(pb + 3);
        if (IN(pb + 4)) {
        const int l_ = l; WS_PTRS();
            pg8::Gemm g{XB, (const bf16_t*)(ws + WS_WGU) + (size_t)l * NGU * DM, M, NGU, DM}; pg8::StaticOrder S; S.init(M, NGU, G, bid);
            pg8::EpiSwiglu E{ACT, ssq_out};
            _Pragma("unroll 1") for (int rep = 0; rep < REP_G16; ++rep) pg8::gemm_phase<pg8::EpiSwiglu, pg8::StaticOrder, true, true>(lds, g, S, E);
        }
        SEAM(pb + 4);
        if (IN(pb + 5)) {
        const int l_ = l; WS_PTRS();
            pg8::Gemm g{ACT, (const bf16_t*)(ws + WS_WDN) + (size_t)l * DM * FF, M, DM, FF}; pg8::StaticOrder S; S.init(M, DM, G, bid);
            pg8::EpiResid<false> E{XB, ssq_down, nullptr, (LAS float*)(lds + 131072)};
            pg8::gemm_phase<pg8::EpiResid<false>, pg8::StaticOrder, true, true>(lds, g, S, E);
            if (REP_G57) { pg8::EpiInProj E2{Y, DM, ssq_mix}; pg8::gemm_phase<pg8::EpiInProj, pg8::StaticOrder, true, true>(lds, g, S, E2); }
        }
        SEAM(pb + 5);
    }
    if (IN(13)) {
        const int l_ = 1; WS_PTRS();
        LAUNDER_TID();
        const float* ssqf = ssp_base + (size_t)5 * 4 * M; const int gw = bid * 8 + wave, NGW = G * 8;
        for (int m = gw; m < M; m += NGW) {
            const float rinv = rsqrtf(sum4p(ssqf, m) * (1.f / DM) + EPS);
            const u32x2* xr = (const u32x2*)(XB + (size_t)m * DM) + lane; f32x4* orow = (f32x4*)(args.out + (size_t)m * DM) + lane; const f32x4* gn = (const f32x4*)inp(args, 27) + lane;
#pragma unroll
            for (int j = 0; j < 4; ++j) { const u32x2 w = xr[64 * j]; const f32x4 g = gn[64 * j]; f32x4 v; v[0] = bflo(w.x) * rinv * g[0]; v[1] = bfhi(w.x) * rinv * g[1]; v[2] = bflo(w.y) * rinv * g[2]; v[3] = bfhi(w.y) * rinv * g[3]; orow[64 * j] = v; }
        }
    }
#undef IN
#undef SEAM
}

extern "C" void kernel_launch(void* const* d_in, const int* in_sizes, int n_in, void* d_out, int out_size, void* d_ws, size_t ws_size, hipStream_t stream) {
    static int grid = 0;
    if (grid == 0) {
        if (n_in != 28 || in_sizes[0] != M * DM || out_size != M * DM || ws_size < WS_END) { fprintf(stderr, "kernel_launch: unexpected shapes (n_in %d, ws %zu)\n", n_in, ws_size); grid = -1; return; }
        int dev = 0, cus = 0;
        if (hipGetDevice(&dev) != hipSuccess || hipDeviceGetAttribute(&cus, hipDeviceAttributeMultiprocessorCount, dev) != hipSuccess) { grid = -1; return; }
        if (hipFuncSetAttribute((const void*)fwd, hipFuncAttributeMaxDynamicSharedMemorySize, LDS_BYTES) != hipSuccess) { fprintf(stderr, "kernel_launch: hipFuncSetAttribute failed\n"); grid = -1; return; }
        int per_cu = 0;
        if (hipOccupancyMaxActiveBlocksPerMultiprocessor(&per_cu, (const void*)fwd, NTHR, LDS_BYTES) != hipSuccess || per_cu < 1) fprintf(stderr, "kernel_launch: occupancy query says %d\n", per_cu);
        (void)hipGetLastError();
        grid = cus;
    }
    if (grid < 0) return;
    (void)hipMemsetAsync((char*)d_ws + WS_CTL, 0, CTL_ZERO_BYTES, stream);
    Args a{};
    for (int i = 0; i < 28; ++i) a.in[i] = (const float*)d_in[i];
    a.out = (float*)d_out; a.ws = (unsigned char*)d_ws;
    if (MK_N_LAUNCHES == 1) { a.ph_lo = 0; a.ph_hi = 14; hipLaunchKernelGGL(fwd, dim3(grid), dim3(NTHR), LDS_BYTES, stream, a); }
    else for (int p = 0; p < 14; ++p) { a.ph_lo = p; a.ph_hi = p + 1; hipLaunchKernelGGL(fwd, dim3(grid), dim3(NTHR), LDS_BYTES, stream, a); }
}
```

```cpp
#include <hip/hip_runtime.h>
#include <cstdio>
#include <cstdint>

#ifndef MK_N_LAUNCHES
#define MK_N_LAUNCHES 1
#endif

#define REP_P0 1
#define REP_G16 1
#define REP_G57 0
#define REP_ATT 1
#define STAGGER 6
#define REP_J4B 1
#define REP_J3 1
#define REP_J1 1
#define REP_J2 1
#define REP_P3 1
#define REP_ONLY 0
#define LAS __attribute__((address_space(3)))
#define DI __device__ __forceinline__
typedef unsigned short bf16_t;
typedef short bf16x8 __attribute__((ext_vector_type(8)));
typedef float f32x4 __attribute__((ext_vector_type(4)));
typedef unsigned u32x4 __attribute__((ext_vector_type(4)));
typedef unsigned u32x2 __attribute__((ext_vector_type(2)));

constexpr int NB = 4, SEQ = 8192, M = NB * SEQ, DM = 1024, NIN = 2304, NINS = 2300, FF = 2816, NGU = 2 * FF;
constexpr float EPS = 1e-6f;
constexpr int C_AX = 0, C_AG = 256, C_BQ = 512, C_KC = 768, C_VC = 832, C_KS = 896, C_VS = 960, C_KW = 1024, C_VW = 1088, C_BG = 1152,
              C_CQ = 1164, C_CK = 1292, C_CV = 1420, C_GLR = 1676, C_OG = 1692, C_DCQ = 1948, C_DCKV = 2140, C_DKR = 2268;
constexpr size_t MiB = 1u << 20;
constexpr size_t WS_CTL = 0, CTL_ZERO_BYTES = 1 * MiB;
constexpr size_t WS_ACC = 64 * 1024;
constexpr size_t WS_SSQ0 = 1 * MiB;
constexpr size_t WS_HB = 1 * MiB + 256 * 1024;
constexpr size_t WS_WIN = 2 * MiB, WS_WOUT = 11 * MiB, WS_WGU = 15 * MiB, WS_WDN = 37 * MiB;
constexpr size_t WS_WUQT = 48 * MiB, WS_WUKVT = 48 * MiB + 512 * 1024, WS_W2T = 49 * MiB, WS_W1T = 50 * MiB;
constexpr size_t WS_WGT = 49 * MiB + 512 * 1024, WS_SP = 49 * MiB + 768 * 1024;
constexpr size_t WS_BCS = 352 * MiB;
constexpr size_t WS_CS64 = 64 * MiB, WS_CS32 = 72 * MiB;
constexpr size_t WS_XB = 80 * MiB, WS_Y = 144 * MiB, WS_PB = 208 * MiB, WS_ACT = 208 * MiB;
constexpr size_t WS_LA = 384 * MiB, WS_LH = 386 * MiB, WS_CIN = 388 * MiB;
constexpr size_t WS_KVC = 392 * MiB, WS_DEC = 408 * MiB, WS_SST = 410 * MiB;
constexpr size_t WS_MQ = 428 * MiB, WS_MKN = 452 * MiB, WS_MV = 468 * MiB, WS_MKR = 484 * MiB;
constexpr size_t WS_SSP = 500 * MiB;
constexpr size_t WS_KSF = 504 * MiB;
constexpr size_t WS_VST = 490 * MiB, WS_VWT = 494 * MiB, WS_KCMPB = 498 * MiB, WS_VCMPT = 499 * MiB, WS_END = 508 * MiB;
constexpr int CW_QUEUE = 64;
constexpr int CW_FLAG = 1024;
constexpr int CW_BAR = 4096;
constexpr int LDS_BYTES = 163840 - 256;
constexpr int LDS_CTL = LDS_BYTES - 64;
constexpr int NTHR = 512;

struct Args { const float* in[28]; float* out; unsigned char* ws; int ph_lo, ph_hi; };

DI float bf2f(bf16_t h) { return __uint_as_float(((unsigned)h) << 16); }
DI float bflo(unsigned u) { return __uint_as_float(u << 16); }
DI float bfhi(unsigned u) { return __uint_as_float(u & 0xffff0000u); }
DI bf16_t f2bf(float f) { unsigned u = __float_as_uint(f); return (bf16_t)((u + 0x7fffu + ((u >> 16) & 1u)) >> 16); }
DI unsigned pk2(float lo, float hi) { return (unsigned)f2bf(lo) | ((unsigned)f2bf(hi) << 16); }
DI float sum4p(const float* p, size_t row) { return (p[row] + p[(size_t)M + row]) + (p[2 * (size_t)M + row] + p[3 * (size_t)M + row]); }
DI float wave_sum(float v) {
#pragma unroll
    for (int o = 1; o < 64; o <<= 1) v += __shfl_xor(v, o);
    return v;
}
DI float wave_max(float v) {
#pragma unroll
    for (int o = 1; o < 64; o <<= 1) v = fmaxf(v, __shfl_xor(v, o));
    return v;
}
DI int wave_min_i(int v) {
#pragma unroll
    for (int o = 1; o < 64; o <<= 1) { int w = __shfl_xor(v, o); v = w < v ? w : v; }
    return v;
}
DI float sigmoidf_(float x) { return __builtin_amdgcn_rcpf(1.f + __builtin_amdgcn_exp2f(-1.4426950408889634f * x)); }
DI float gelu_tanh(float x) { const float u = 0.7978845608028654f * (x + 0.044715f * x * x * x); return x * sigmoidf_(2.f * u); }
#define WSYNC() do { asm volatile("s_waitcnt lgkmcnt(0)" ::: "memory"); __builtin_amdgcn_wave_barrier(); } while (0)

namespace pg8 {
constexpr int BM = 256, BK = 64, HALF = 128, HTB = HALF * BK * 2, NXCD = 8, WGM = 8;
__host__ __device__ __forceinline__ int lds_byte(int r, int c) { const int st = (r >> 4) * 2 + (c >> 5), rr = r & 15, cc = c & 31, ob = rr * 64 + cc * 2; return st * 1024 + (ob ^ (((ob >> 9) & 1) << 5)); }
__host__ __device__ __forceinline__ void stage_rc(int b, int& R, int& C) { const int st = b / 1024, sb = b % 1024, swz = sb ^ (((sb >> 9) & 1) << 5); R = (st >> 1) * 16 + swz / 64; C = (st & 1) * 32 + (swz % 64) / 2; }
__host__ __device__ __forceinline__ int perm32(int rho) { const int n = rho >> 4, i = rho & 15; return 8 * (i >> 2) + 4 * n + (i & 3); }
struct Unit { int pm, pn; };
struct Gemm { const bf16_t* A; const bf16_t* Bt; int M, N, K; };
struct StaticOrder {
    int nM, nN, nwg, G, c;
    __host__ __device__ void init(int M_, int N_, int G_, int c_) { nM = M_ / BM; nN = N_ / BM; nwg = nM * nN; G = G_; c = c_; }
    __host__ __device__ bool next(int i, Unit& u) const {
        const long L = (long)i * G + c; if (L >= nwg) return false;
        int wgid = (int)L; { const int q = nwg / NXCD, r = nwg % NXCD, xcd = wgid % NXCD, off = wgid / NXCD; wgid = (xcd < r ? xcd * (q + 1) : r * (q + 1) + (xcd - r) * q) + off; }
        const int nig = WGM * nN, gid = wgid / nig, fm = gid * WGM, gsz = (nM - fm) < WGM ? (nM - fm) : WGM;
        u.pm = fm + ((wgid % nig) % gsz); u.pn = (wgid % nig) / gsz; return true;
    }
    __device__ __forceinline__ void a_ready(const Unit&) const {}
    __device__ __forceinline__ void done(const Unit&) const {}
};
DI unsigned cvt_pk_bf16(float lo, float hi) { unsigned r; asm volatile("v_cvt_pk_bf16_f32 %0, %1, %2" : "=v"(r) : "v"(lo), "v"(hi)); return r; }

struct EpiInProj {
    static constexpr bool PERM = true, AFTER_DRAIN = false, MIDSCALE = false;
    bf16_t* O; int ldc; const float* ssq;
    DI void operator()(const f32x4 (&acc)[2][2][4][2], const Unit& u, int wr, int wc, int fr, int fq) const {
        int row0 = u.pm * BM + wr * 64 + fr; asm volatile("" : "+v"(row0)); const int col0 = u.pn * BM + wc * 32 + 8 * fq;
        float rinvs[2][4];
#pragma unroll
        for (int ai = 0; ai < 2; ++ai)
#pragma unroll
            for (int m = 0; m < 4; ++m) rinvs[ai][m] = sum4p(ssq, row0 + ai * HALF + m * 16);
#pragma unroll
        for (int ai = 0; ai < 2; ++ai)
#pragma unroll
            for (int m = 0; m < 4; ++m) {
                const int row = row0 + ai * HALF + m * 16;
                const float rinv = rsqrtf(rinvs[ai][m] * (1.f / DM) + EPS);
                bf16_t* rowp = O + (size_t)row * ldc + col0;
#pragma unroll
                for (int bj = 0; bj < 2; ++bj) {
                    f32x4 v0 = acc[ai][bj][m][0] * rinv, v1 = acc[ai][bj][m][1] * rinv;
                    u32x4 w; w.x = cvt_pk_bf16(v0[0], v0[1]); w.y = cvt_pk_bf16(v0[2], v0[3]); w.z = cvt_pk_bf16(v1[0], v1[1]); w.w = cvt_pk_bf16(v1[2], v1[3]);
                    *(u32x4*)(rowp + bj * HALF) = w;
                }
            }
    }
};
template <bool MS> struct EpiResid {
    static constexpr bool PERM = true, AFTER_DRAIN = false, MIDSCALE = MS;
    bf16_t* xb; float* ssq_part; const float* ssq_mid; LAS float* ssl;
    DI void midscale(f32x4 (&acc)[2][2][4][2], const Unit& u, int wr, int fr) const {
        int row0 = u.pm * BM + wr * 64 + fr; asm volatile("" : "+v"(row0)); float sm_[2][4];
#pragma unroll
        for (int ai = 0; ai < 2; ++ai)
#pragma unroll
            for (int m = 0; m < 4; ++m) sm_[ai][m] = sum4p(ssq_mid, row0 + ai * HALF + m * 16);
#pragma unroll
        for (int ai = 0; ai < 2; ++ai)
#pragma unroll
            for (int m = 0; m < 4; ++m) { const float s = rsqrtf(sm_[ai][m] * (1.f / 256.f) + EPS);
#pragma unroll
                for (int bj = 0; bj < 2; ++bj) { acc[ai][bj][m][0] *= s; acc[ai][bj][m][1] *= s; } }
    }
    DI void operator()(const f32x4 (&acc)[2][2][4][2], const Unit& u, int wr, int wc, int fr, int fq) const {
        int rl0 = wr * 64 + fr; asm volatile("" : "+v"(rl0));
        const int col0 = u.pn * BM + wc * 32 + 8 * fq;
        u32x4 xin[2][4][2];
#pragma unroll
        for (int ai = 0; ai < 2; ++ai)
#pragma unroll
            for (int m = 0; m < 4; ++m)
#pragma unroll
                for (int bj = 0; bj < 2; ++bj) xin[ai][m][bj] = *(const u32x4*)(xb + ((size_t)u.pm * BM + rl0 + ai * HALF + m * 16) * DM + col0 + bj * HALF);
#pragma unroll
        for (int ai = 0; ai < 2; ++ai)
#pragma unroll
            for (int m = 0; m < 4; ++m) {
                const int rl = rl0 + ai * HALF + m * 16; const size_t row = (size_t)u.pm * BM + rl;
                float part = 0.f;
#pragma unroll
                for (int bj = 0; bj < 2; ++bj) {
                    u32x4* px = (u32x4*)(xb + row * DM + col0 + bj * HALF); const u32x4 xo = xin[ai][m][bj];
                    const f32x4 a0 = acc[ai][bj][m][0], a1 = acc[ai][bj][m][1];
                    const float v0 = a0[0] + bflo(xo.x), v1 = a0[1] + bfhi(xo.x), v2 = a0[2] + bflo(xo.y), v3 = a0[3] + bfhi(xo.y), v4 = a1[0] + bflo(xo.z), v5 = a1[1] + bfhi(xo.z), v6 = a1[2] + bflo(xo.w), v7 = a1[3] + bfhi(xo.w);
                    u32x4 w; w.x = cvt_pk_bf16(v0, v1); w.y = cvt_pk_bf16(v2, v3); w.z = cvt_pk_bf16(v4, v5); w.w = cvt_pk_bf16(v6, v7);
                    *px = w;
                    part += (v0 * v0 + v1 * v1) + (v2 * v2 + v3 * v3) + (v4 * v4 + v5 * v5) + (v6 * v6 + v7 * v7);
                }
                part += __shfl_xor(part, 16); part += __shfl_xor(part, 32);
                if (fq == 0) ssl[rl * 4 + wc] = part;
            }
        asm volatile("s_waitcnt lgkmcnt(0)" ::: "memory"); __builtin_amdgcn_s_barrier();
        int tq = threadIdx.x; asm volatile("" : "+v"(tq));
        if (tq < 256) { const f32x4 p = *(const LAS f32x4*)(ssl + tq * 4); ssq_part[(size_t)u.pn * M + (size_t)u.pm * BM + tq] = (p[0] + p[1]) + (p[2] + p[3]); }
    }
};
struct EpiSwiglu {
    static constexpr bool PERM = true, AFTER_DRAIN = false, MIDSCALE = false;
    bf16_t* act; const float* ssq;
    DI void operator()(const f32x4 (&acc)[2][2][4][2], const Unit& u, int wr, int wc, int fr, int fq) const {
        int row0 = u.pm * BM + wr * 64 + fr; asm volatile("" : "+v"(row0)); const int jst = u.pn * 128 + wc * 16 + 4 * (fq & 2) + (fq & 1) * 64;
        float rinvs[2][4];
#pragma unroll
        for (int ai = 0; ai < 2; ++ai)
#pragma unroll
            for (int m = 0; m < 4; ++m) rinvs[ai][m] = sum4p(ssq, row0 + ai * HALF + m * 16);
#pragma unroll
        for (int ai = 0; ai < 2; ++ai)
#pragma unroll
            for (int m = 0; m < 4; ++m) {
                const int row = row0 + ai * HALF + m * 16;
                const float rinv = rsqrtf(rinvs[ai][m] * (1.f / DM) + EPS);
                u32x2 w[2];
#pragma unroll
                for (int bj = 0; bj < 2; ++bj) {
                    const f32x4 g = acc[ai][bj][m][0] * rinv, up = acc[ai][bj][m][1] * rinv;
                    float a[4];
#pragma unroll
                    for (int i = 0; i < 4; ++i) a[i] = g[i] * up[i] * __builtin_amdgcn_rcpf(1.f + __builtin_amdgcn_exp2f(-1.4426950408889634f * g[i]));
                    w[bj].x = cvt_pk_bf16(a[0], a[1]); w[bj].y = cvt_pk_bf16(a[2], a[3]);
                }
                const auto rx = __builtin_amdgcn_permlane16_swap(w[0].x, w[1].x, false, false), ry = __builtin_amdgcn_permlane16_swap(w[0].y, w[1].y, false, false);
                u32x4 o; o.x = rx[0]; o.y = ry[0]; o.z = rx[1]; o.w = ry[1];
                *(u32x4*)(act + (size_t)row * FF + jst) = o;
            }
    }
};

template <class Epi, class Sched, bool ALIGN_EPI = false, bool SP2 = false>
DI void gemm_phase(LAS unsigned char* lds, const Gemm g, const Sched& S, const Epi& E) {
    int tid_ = threadIdx.x; asm volatile("" : "+v"(tid_));
    const int tid = tid_, wid = __builtin_amdgcn_readfirstlane(tid >> 6), lane = tid & 63, wr = wid >> 2, wc = wid & 3, fr = lane & 15, fq = lane >> 4;
    const int K = g.K, nt = K / BK;
    unsigned voffA[2], voffB[2];
#pragma unroll
    for (int i = 0; i < 2; ++i) { int R, C; stage_rc(tid * 16 + i * 8192, R, C); const int Rb = Epi::PERM ? ((R & ~31) + perm32(R & 31)) : R;
        voffA[i] = (unsigned)(R * K + C) * 2u; voffB[i] = (unsigned)(Rb * K + C) * 2u; }
    const size_t kstep = (size_t)(BK * 2);
    const size_t hstep = (size_t)HALF * K * 2;
    const size_t tstep = 2 * hstep;
    const unsigned ldsw = (unsigned)wid * 1024u;
    const int aoff = lds_byte(wr * 64 + fr, fq * 8), boff = lds_byte(wc * 32 + fr, fq * 8);
#define PG8_SA(b, h) (((b) * 2 + (h)) * HTB)
#define PG8_SB(b, h) ((4 + (b) * 2 + (h)) * HTB)
#define PG8_STAGE(bufoff, gbase, voff) do { _Pragma("unroll") for (int _i = 0; _i < 2; ++_i) \
        __builtin_amdgcn_global_load_lds((const unsigned*)((const char*)(gbase) + (voff)[_i]), (LAS unsigned*)(lds + (bufoff) + ldsw + _i * 8192), 16, 0, 0); } while (0)
#define PG8_LDA(dst, b, h) do { _Pragma("unroll") for (int m = 0; m < 4; ++m) _Pragma("unroll") for (int k = 0; k < 2; ++k) dst[m][k] = *(const LAS bf16x8*)(lds + PG8_SA(b, h) + aoff + m * 2048 + k * 1024); } while (0)
#define PG8_LDB(dst, b, h) do { _Pragma("unroll") for (int n = 0; n < 2; ++n) _Pragma("unroll") for (int k = 0; k < 2; ++k) dst[n][k] = *(const LAS bf16x8*)(lds + PG8_SB(b, h) + boff + n * 2048 + k * 1024); } while (0)
#define PG8_MMA(ai, bj, At, Bt) do { __builtin_amdgcn_s_setprio(1); _Pragma("unroll") for (int m = 0; m < 4; ++m) _Pragma("unroll") for (int n = 0; n < 2; ++n) _Pragma("unroll") for (int k = 0; k < 2; ++k) \
        acc[ai][bj][m][n] = __builtin_amdgcn_mfma_f32_16x16x32_bf16(Bt[n][k], At[m][k], acc[ai][bj][m][n], 0, 0, 0); __builtin_amdgcn_s_setprio(0); } while (0)
#define PG8_WAIT_V(n) asm volatile("s_waitcnt vmcnt(" #n ")" ::: "memory")
#define PG8_WAIT_L(n) asm volatile("s_waitcnt lgkmcnt(" #n ")" ::: "memory")
#define PG8_BAR __builtin_amdgcn_s_barrier()
#define PG8_SCHED __builtin_amdgcn_sched_barrier(0)
    Unit cur, nxt; int ui = 0;
    if (!S.next(0, cur)) return;
    f32x4 acc[2][2][4][2];
#pragma unroll
    for (int a = 0; a < 2; ++a)
#pragma unroll
        for (int b = 0; b < 2; ++b)
#pragma unroll
            for (int m = 0; m < 4; ++m)
#pragma unroll
                for (int n = 0; n < 2; ++n) acc[a][b][m][n] = (f32x4){0.f, 0.f, 0.f, 0.f};
    bf16x8 At[4][2], B0[2][2], B1[2][2];
    const char* cA = (const char*)g.A + (size_t)cur.pm * tstep; const char* cB = (const char*)g.Bt + (size_t)cur.pn * tstep;
    S.a_ready(cur);
    if constexpr (SP2) {
        PG8_STAGE(PG8_SB(0, 0), cB, voffB); PG8_STAGE(PG8_SB(0, 1), cB + hstep, voffB); PG8_STAGE(PG8_SA(0, 0), cA, voffA); PG8_STAGE(PG8_SA(0, 1), cA + hstep, voffA);
        if (wr == 1) PG8_BAR;
        PG8_WAIT_V(2); PG8_BAR;
        PG8_STAGE(PG8_SB(1, 0), cB + kstep, voffB); PG8_STAGE(PG8_SA(1, 0), cA + kstep, voffA); PG8_STAGE(PG8_SB(1, 1), cB + hstep + kstep, voffB);
        PG8_WAIT_V(6); PG8_BAR;
    } else {
        PG8_STAGE(PG8_SB(0, 0), cB, voffB); PG8_STAGE(PG8_SA(0, 0), cA, voffA); PG8_STAGE(PG8_SB(0, 1), cB + hstep, voffB); PG8_STAGE(PG8_SA(0, 1), cA + hstep, voffA);
        if (wr == 1) PG8_BAR;
        PG8_WAIT_V(4); PG8_BAR;
        PG8_STAGE(PG8_SB(1, 0), cB + kstep, voffB); PG8_STAGE(PG8_SA(1, 0), cA + kstep, voffA); PG8_STAGE(PG8_SB(1, 1), cB + hstep + kstep, voffB);
        PG8_WAIT_V(6); PG8_BAR;
    }
    for (;;) {
        const bool has_next = S.next(ui + 1, nxt);
        const char* nA = has_next ? (const char*)g.A + (size_t)nxt.pm * tstep : cA; const char* nB = has_next ? (const char*)g.Bt + (size_t)nxt.pn * tstep : cB;
        for (int t = 0; t < nt; t += 2) {
            const bool last = (t == nt - 2);
            const char* a1 = cA + (size_t)(t + 1) * kstep;
            const char* a2 = last ? nA : cA + (size_t)(t + 2) * kstep; const char* b2 = last ? nB : cB + (size_t)(t + 2) * kstep;
            const char* a3 = a2 + kstep; const char* b3 = b2 + kstep;
            if (last && has_next) S.a_ready(nxt);
            if constexpr (SP2) {
            PG8_LDB(B0, 0, 0); PG8_LDB(B1, 0, 1); PG8_SCHED; PG8_LDA(At, 0, 0); PG8_STAGE(PG8_SA(1, 1), a1 + hstep, voffA);
            PG8_WAIT_V(8); PG8_WAIT_L(0); PG8_BAR; PG8_MMA(0, 0, At, B0); PG8_MMA(0, 1, At, B1); PG8_BAR; PG8_SCHED;
            PG8_LDA(At, 0, 1); PG8_STAGE(PG8_SB(0, 0), b2, voffB); PG8_STAGE(PG8_SB(0, 1), b2 + hstep, voffB); PG8_STAGE(PG8_SA(0, 0), a2, voffA);
            PG8_WAIT_V(8); PG8_WAIT_L(0); PG8_BAR; PG8_MMA(1, 0, At, B0); PG8_MMA(1, 1, At, B1); PG8_BAR; PG8_SCHED;
            PG8_LDB(B0, 1, 0); PG8_LDB(B1, 1, 1); PG8_SCHED; PG8_LDA(At, 1, 0); PG8_STAGE(PG8_SA(0, 1), a2 + hstep, voffA);
            PG8_WAIT_V(8); PG8_WAIT_L(0); PG8_BAR; PG8_MMA(0, 0, At, B0); PG8_MMA(0, 1, At, B1); PG8_BAR; PG8_SCHED;
            PG8_LDA(At, 1, 1); PG8_STAGE(PG8_SB(1, 0), b3, voffB); PG8_STAGE(PG8_SB(1, 1), b3 + hstep, voffB); PG8_STAGE(PG8_SA(1, 0), a3, voffA);
            PG8_WAIT_V(8); PG8_WAIT_L(0); PG8_BAR; PG8_MMA(1, 0, At, B0); PG8_MMA(1, 1, At, B1); PG8_BAR; PG8_SCHED;
            if constexpr (Epi::MIDSCALE) { if (t == 2) E.midscale(acc, cur, wr, fr); }
            } else {
            PG8_LDB(B0, 0, 0); PG8_SCHED; PG8_LDA(At, 0, 0); PG8_STAGE(PG8_SA(1, 1), a1 + hstep, voffA);
            PG8_WAIT_L(8); PG8_BAR; PG8_WAIT_L(0); PG8_MMA(0, 0, At, B0); PG8_BAR; PG8_SCHED;
            PG8_LDB(B1, 0, 1); PG8_STAGE(PG8_SB(0, 0), b2, voffB);
            PG8_BAR; PG8_WAIT_L(0); PG8_MMA(0, 1, At, B1); PG8_BAR;
            PG8_LDA(At, 0, 1); PG8_STAGE(PG8_SA(0, 0), a2, voffA);
            PG8_BAR; PG8_WAIT_L(0); PG8_MMA(1, 0, At, B0); PG8_BAR; PG8_SCHED;
            PG8_STAGE(PG8_SB(0, 1), b2 + hstep, voffB);
            PG8_WAIT_V(6); PG8_BAR; PG8_MMA(1, 1, At, B1); PG8_BAR;
            PG8_LDB(B0, 1, 0); PG8_SCHED; PG8_LDA(At, 1, 0); PG8_STAGE(PG8_SA(0, 1), a2 + hstep, voffA);
            PG8_WAIT_L(8); PG8_BAR; PG8_WAIT_L(0); PG8_MMA(0, 0, At, B0); PG8_BAR; PG8_SCHED;
            PG8_LDB(B1, 1, 1); PG8_STAGE(PG8_SB(1, 0), b3, voffB);
            PG8_BAR; PG8_WAIT_L(0); PG8_MMA(0, 1, At, B1); PG8_BAR;
            PG8_LDA(At, 1, 1); PG8_STAGE(PG8_SA(1, 0), a3, voffA);
            PG8_BAR; PG8_WAIT_L(0); PG8_MMA(1, 0, At, B0); PG8_BAR; PG8_SCHED;
            PG8_STAGE(PG8_SB(1, 1), b3 + hstep, voffB);
            PG8_WAIT_V(6); PG8_BAR; PG8_MMA(1, 1, At, B1); PG8_BAR;
            }
        }
        if constexpr (ALIGN_EPI) { if (wr == 0) PG8_BAR; }
        if constexpr (!Epi::AFTER_DRAIN) { E(acc, cur, wr, wc, fr, fq); S.done(cur); }
        if (!has_next) break;
#pragma unroll
        for (int a = 0; a < 2; ++a)
#pragma unroll
            for (int b = 0; b < 2; ++b)
#pragma unroll
                for (int m = 0; m < 4; ++m)
#pragma unroll
                    for (int n = 0; n < 2; ++n) acc[a][b][m][n] = (f32x4){0.f, 0.f, 0.f, 0.f};
        cur = nxt; cA = nA; cB = nB; ++ui;
        if constexpr (ALIGN_EPI) { if (wr == 1) PG8_BAR; }
    }
    PG8_WAIT_V(0);
    if constexpr (!ALIGN_EPI) { if (wr == 0) PG8_BAR; }
    PG8_BAR;
#undef PG8_SA
#undef PG8_SB
#undef PG8_STAGE
#undef PG8_LDA
#undef PG8_LDB
#undef PG8_MMA
#undef PG8_WAIT_V
#undef PG8_WAIT_L
#undef PG8_BAR
#undef PG8_SCHED
}
}

#define XB_TMO      128
#define XB_XCNT(j)  (256  + 64 * (j))
#define XB_XSUB(j)  (1280 + 64 * (j))
#define XB_XGEN(j)  (2304 + 64 * (j))
#define XB_TOP      3328
#define XB_TOPGEN   3392
#define XCD_BAR_WORDS 3456
#define XB_SPIN_CAP (1u << 18)
__device__ __forceinline__ unsigned xb_ld(unsigned* p)              { return __hip_atomic_load(p, __ATOMIC_RELAXED, __HIP_MEMORY_SCOPE_AGENT); }
__device__ __forceinline__ unsigned xb_add(unsigned* p, unsigned v) { return __hip_atomic_fetch_add(p, v, __ATOMIC_RELAXED, __HIP_MEMORY_SCOPE_AGENT); }
__device__ __forceinline__ unsigned xb_xcc_id() { return (unsigned)__builtin_amdgcn_s_getreg((3 << 11) | 20) & 0xFu; }
#define XB_SPIN(cond, bar) do { unsigned _sp = 0; while (cond) { __builtin_amdgcn_s_sleep(1); \
    if ((++_sp & 255u) == 0u) { if (xb_ld(&(bar)[XB_TMO])) break; if (_sp > XB_SPIN_CAP) { atomicAdd(&(bar)[XB_TMO], 1u); break; } } } } while (0)
struct XcdBarrier { unsigned* bar; unsigned x; volatile LAS unsigned* st; };
__device__ __forceinline__ XcdBarrier xcd_barrier_post(unsigned* bar, volatile LAS unsigned* st) {
    XcdBarrier b; b.bar = bar; b.x = xb_xcc_id(); b.st = st;
    if (threadIdx.x == 0) (void)xb_add(&bar[XB_XCNT(b.x)], 1u);
    return b;
}
__device__ __forceinline__ void xcd_barrier_complete(unsigned* bar, unsigned x, unsigned& nloc, unsigned& nx) {
    const unsigned G = gridDim.x * gridDim.y * gridDim.z;
    unsigned sum, cnt, mine, sp = 0u;
    for (;;) {
        sum = 0u; cnt = 0u; mine = 0u;
#pragma unroll
        for (unsigned j = 0; j < 16; ++j) { const unsigned c = xb_ld(&bar[XB_XCNT(j)]); sum += c; cnt += (c > 0u) ? 1u : 0u; mine = (j == x) ? c : mine; }
        if (sum == G) break;
        __builtin_amdgcn_s_sleep(1);
        if ((++sp & 255u) == 0u) { if (xb_ld(&bar[XB_TMO])) break; if (sp > XB_SPIN_CAP) { atomicAdd(&bar[XB_TMO], 1u); break; } }
    }
    nloc = mine > 0u ? mine : 1u; nx = cnt > 0u ? cnt : 1u;
}
__device__ __forceinline__ void xcd_barrier(const XcdBarrier& b) {
    asm volatile("s_waitcnt vmcnt(0)" ::: "memory");
    __syncthreads();
    if (threadIdx.x == 0) {
        unsigned* bar = b.bar;
        __builtin_amdgcn_s_waitcnt(0);
        unsigned nloc = b.st[0], nx = b.st[1];
        if (nloc == 0u) { xcd_barrier_complete(bar, b.x, nloc, nx); b.st[0] = nloc; b.st[1] = nx; }
        const unsigned old = xb_add(&bar[XB_XSUB(b.x)], 1u);
        const unsigned gen = old / nloc;
        if (old + 1u == (gen + 1u) * nloc) {
            __builtin_amdgcn_fence(__ATOMIC_RELEASE, "agent");
            asm volatile("s_waitcnt vmcnt(0)" ::: "memory");
            const unsigned og = xb_add(&bar[XB_TOP], 1u);
            const unsigned tg = og / nx;
            if (og + 1u == (tg + 1u) * nx) xb_add(&bar[XB_TOPGEN], 1u);
            else XB_SPIN(xb_ld(&bar[XB_TOPGEN]) == tg, bar);
            __builtin_amdgcn_fence(__ATOMIC_ACQUIRE, "agent");
            xb_add(&bar[XB_XGEN(b.x)], 1u);
            asm volatile("s_waitcnt vmcnt(0)" ::: "memory");
        } else {
            XB_SPIN(xb_ld(&bar[XB_XGEN(b.x)]) == gen, bar);
            __builtin_amdgcn_fence(__ATOMIC_ACQUIRE, "agent");
            asm volatile("s_waitcnt vmcnt(0)" ::: "memory");
        }
    }
    __syncthreads();
}

template <int MAP>
DI int colmap(int v, int Nsrc) {
    if (MAP == 0) return v < Nsrc ? v : -1;
    const int g8 = v >> 3, e = v & 7, j = 4 * g8 + (e & 3); return (e < 4) ? j : FF + j;
}
template <int MAP, int KROT = 0>
DI void p0_transpose_item64(const float* W, int K, int Nsrc, const float* gain, bf16_t* WT, LAS float* scr, int kb, int nb, int lane) {
    const int k0 = 64 * kb, n0 = 64 * nb, v = n0 + 4 * (lane & 15);
    const int sc = MAP == 0 ? (v < Nsrc ? v : -1) : ((v >> 3) * 4 + ((v >> 2) & 1) * FF);
#pragma unroll 4
    for (int i = 0; i < 16; ++i) { const int kk = 4 * i + (lane >> 4); int ksrc = k0 + kk + KROT; if (KROT && ksrc >= K) ksrc -= K; f32x4 w = {0.f, 0.f, 0.f, 0.f}; if (sc >= 0) w = *(const f32x4*)(W + (size_t)ksrc * Nsrc + sc); if (gain) w = w * gain[ksrc];
        LAS float* d = scr + kk * 65 + 4 * (lane & 15); d[0] = w[0]; d[1] = w[1]; d[2] = w[2]; d[3] = w[3]; }
    WSYNC();
    const int c = lane & 7;
#pragma unroll
    for (int j = 0; j < 8; ++j) { const int n = (lane >> 3) + 8 * j; const LAS float* s = scr + (8 * c) * 65 + n;
        u32x4 o; o.x = pk2(s[0 * 65], s[1 * 65]); o.y = pk2(s[2 * 65], s[3 * 65]); o.z = pk2(s[4 * 65], s[5 * 65]); o.w = pk2(s[6 * 65], s[7 * 65]);
        *(u32x4*)(WT + (size_t)(n0 + n) * K + k0 + 8 * c) = o; }
    WSYNC();
}
template <int MAP, int KROT = 0>
DI void p0_transpose_item(const float* W, int K, int Nsrc, const float* gain, bf16_t* WT, LAS float* scr, int kb, int nb, int lane) {
    const int k0 = 64 * kb, n0 = 32 * nb;
    const int sc = colmap<MAP>(n0 + (lane & 31), Nsrc);
#pragma unroll 8
    for (int i = 0; i < 32; ++i) { const int kk = 2 * i + (lane >> 5); int ksrc = k0 + kk + KROT; if (KROT && ksrc >= K) ksrc -= K; float w = 0.f; if (sc >= 0) w = W[(size_t)ksrc * Nsrc + sc]; if (gain) w *= gain[ksrc]; scr[kk * 33 + (lane & 31)] = w; }
    WSYNC();
    const int c = lane & 7;
#pragma unroll
    for (int j = 0; j < 4; ++j) { const int n = (lane >> 3) + 8 * j; const LAS float* s = scr + (8 * c) * 33 + n;
        u32x4 o; o.x = pk2(s[0 * 33], s[1 * 33]); o.y = pk2(s[2 * 33], s[3 * 33]); o.z = pk2(s[4 * 33], s[5 * 33]); o.w = pk2(s[6 * 33], s[7 * 33]);
        *(u32x4*)(WT + (size_t)(n0 + n) * K + k0 + 8 * c) = o; }
    WSYNC();
}


typedef float f32x16 __attribute__((ext_vector_type(16)));
typedef float f32x2v __attribute__((ext_vector_type(2)));
typedef __bf16 bf16x2_t __attribute__((ext_vector_type(2)));
constexpr int KSTR = 208, VSTR = 136;
constexpr int VSTP = 144;
constexpr int AL_K0 = 0, AL_K1 = 64 * KSTR, AL_V0 = 2 * 64 * KSTR, AL_V1 = AL_V0 + 64 * VSTP, AL_IMP = 45056, AL_SELM = AL_IMP + 32768, AL_OACC = AL_SELM + 1024;
constexpr float NEGB = -1e30f, LOG2E = 1.4426950408889634f;
DI unsigned cvtpk(float lo, float hi) { f32x2v v = {lo, hi}; bf16x2_t b = __builtin_convertvector(v, bf16x2_t); return __builtin_bit_cast(unsigned, b); }
DI f32x16 mfma32(bf16x8 a, bf16x8 b, f32x16 c) { return __builtin_amdgcn_mfma_f32_32x32x16_bf16(a, b, c, 0, 0, 0); }
DI float xhalf_max(float v) { auto rr = __builtin_amdgcn_permlane32_swap(__float_as_uint(v), __float_as_uint(v), false, false); return fmaxf(__uint_as_float(rr[0]), __uint_as_float(rr[1])); }
DI float xhalf_sum(float v) { auto rr = __builtin_amdgcn_permlane32_swap(__float_as_uint(v), __float_as_uint(v), false, false); return __uint_as_float(rr[0]) + __uint_as_float(rr[1]); }
DI float ex2(float x) { return __builtin_amdgcn_exp2f(x); }
template <int KSTEPS>
DI void qk_tile(const LAS unsigned char* Kt, const bf16x8 (&qf)[KSTEPS], int r32, int hi, f32x16& s0, f32x16& s1) {
    const LAS unsigned char* p0 = Kt + r32 * KSTR + hi * 16;
#pragma unroll
    for (int i = 0; i < 16; ++i) { s0[i] = 0.f; s1[i] = 0.f; }
#pragma unroll
    for (int ks = 0; ks < KSTEPS; ++ks) {
        const bf16x8 a0 = *(const LAS bf16x8*)(p0 + ks * 32), a1 = *(const LAS bf16x8*)(p0 + 32 * KSTR + ks * 32);
        s0 = mfma32(a0, qf[ks], s0); s1 = mfma32(a1, qf[ks], s1);
    }
}
DI void mask_tile(f32x16& s0, f32x16& s1, int klo, int khi, int hi) {
    const int lo_ = klo - 4 * hi, hi_ = khi - 4 * hi;
#pragma unroll
    for (int i = 0; i < 16; ++i) { const int kb = (i & 3) + 8 * (i >> 2); if (kb < lo_ || kb > hi_) s0[i] = NEGB; if (kb + 32 < lo_ || kb + 32 > hi_) s1[i] = NEGB; }
}
DI float tile_max(const f32x16& s0, const f32x16& s1) {
    float mx = fmaxf(s0[0], s1[0]);
#pragma unroll
    for (int i = 1; i < 16; ++i) mx = fmaxf(mx, fmaxf(s0[i], s1[i]));
    return xhalf_max(mx);
}
template <int BASE> DI bf16x8 pack8(const f32x16& s) { u32x4 p; p.x = cvtpk(s[BASE], s[BASE + 1]); p.y = cvtpk(s[BASE + 2], s[BASE + 3]); p.z = cvtpk(s[BASE + 4], s[BASE + 5]); p.w = cvtpk(s[BASE + 6], s[BASE + 7]); return __builtin_bit_cast(bf16x8, p); }
DI bf16x8 ld8x2(const bf16_t* p) { const u32x2 a = *(const u32x2*)p, b = *(const u32x2*)(p + 4); u32x4 w; w.x = a.x; w.y = a.y; w.z = b.x; w.w = b.y; return __builtin_bit_cast(bf16x8, w); }
DI bf16x8 vfrag(const LAS unsigned char* p) { const u32x2 a = *(const LAS u32x2*)p, b = *(const LAS u32x2*)(p + 16); u32x4 w; w.x = a.x; w.y = a.y; w.z = b.x; w.w = b.y; return __builtin_bit_cast(bf16x8, w); }
template <int VS = VSTP>
DI void pv_tile(const f32x16& s0, const f32x16& s1, const LAS unsigned char* Vt, f32x16 (&o)[2], int r32, int hi) {
    const bf16x8 p00 = pack8<0>(s0), p01 = pack8<8>(s0), p10 = pack8<0>(s1), p11 = pack8<8>(s1);
#pragma unroll
    for (int dt = 0; dt < 2; ++dt) { const LAS unsigned char* vp = Vt + (32 * dt + r32) * VS + 16 * hi;
        o[dt] = mfma32(*(const LAS bf16x8*)vp, p00, o[dt]); o[dt] = mfma32(*(const LAS bf16x8*)(vp + 32), p01, o[dt]); o[dt] = mfma32(*(const LAS bf16x8*)(vp + 64), p10, o[dt]); o[dt] = mfma32(*(const LAS bf16x8*)(vp + 96), p11, o[dt]); }
}
DI void softmax_pv(f32x16& s0, f32x16& s1, const LAS unsigned char* Vt, f32x16 (&o)[2], float& m, float& l, int r32, int hi) {
    const float mx = tile_max(s0, s1), mn = fmaxf(m, mx), ms = mn < -1e29f ? 0.f : mn, alpha = ex2(m - ms);
    m = mn; float psum = 0.f;
#pragma unroll
    for (int i = 0; i < 16; ++i) { s0[i] = ex2(s0[i] - ms); s1[i] = ex2(s1[i] - ms); psum += s0[i] + s1[i]; }
    l = l * alpha + psum;
    if (!__all(alpha == 1.f)) {
#pragma unroll
        for (int i = 0; i < 16; ++i) { o[0][i] *= alpha; o[1][i] *= alpha; } }
    pv_tile(s0, s1, Vt, o, r32, hi);
}
struct SoftState { float m, l; };
constexpr float SM_THR = 8.f;
DI void soft_init(SoftState& S, f32x16 (&o)[2]) { S.m = 0.f; S.l = 0.f;
#pragma unroll
    for (int i = 0; i < 16; ++i) { o[0][i] = 0.f; o[1][i] = 0.f; } }
DI f32x16 bcast16(float v) { f32x16 c;
#pragma unroll
    for (int i = 0; i < 16; ++i) c[i] = v;
    return c; }
DI float max3f(float a, float b, float c) { float r; asm("v_max3_f32 %0, %1, %2, %3" : "=v"(r) : "v"(a), "v"(b), "v"(c)); return r; }
template <int VS>
DI void load_vfrags(const LAS unsigned char* Vt, bf16x8 (&vfr)[2][4], int r32, int hi) {
#pragma unroll
    for (int dt = 0; dt < 2; ++dt) { const LAS unsigned char* vp = Vt + (32 * dt + r32) * VS + 16 * hi;
#pragma unroll
        for (int s = 0; s < 4; ++s) vfr[dt][s] = *(const LAS bf16x8*)(vp + 32 * s); }
}
DI void pv_regs(const f32x16& s0, const f32x16& s1, const bf16x8 (&vfr)[2][4], f32x16 (&o)[2]) {
    const bf16x8 p00 = pack8<0>(s0), p01 = pack8<8>(s0), p10 = pack8<0>(s1), p11 = pack8<8>(s1);
#pragma unroll
    for (int dt = 0; dt < 2; ++dt) { o[dt] = mfma32(vfr[dt][0], p00, o[dt]); o[dt] = mfma32(vfr[dt][1], p01, o[dt]); o[dt] = mfma32(vfr[dt][2], p10, o[dt]); o[dt] = mfma32(vfr[dt][3], p11, o[dt]); }
}
DI float soft_update(f32x16& s0, f32x16& s1, SoftState& S, f32x16 (&o)[2], bool masked, int klo, int khi, bool first, int hi, float adj = 0.f) {
    if (__any(adj != 0.f)) {
#pragma unroll
        for (int i = 0; i < 16; ++i) { s0[i] -= adj; s1[i] -= adj; } }
    float dl_ret = 0.f;
    if (__builtin_expect(masked, 0)) { asm volatile("; boundary tile mask" ::: "memory"); mask_tile(s0, s1, klo, khi, hi); }
    asm volatile("s_nop 15\n\ts_nop 7" : "+v"(s0), "+v"(s1));
    float rm;
    { float a = max3f(s0[0], s0[1], s0[2]), b = max3f(s1[0], s1[1], s1[2]);
#pragma unroll
      for (int i = 3; i < 15; i += 2) { a = max3f(a, s0[i], s0[i + 1]); b = max3f(b, s1[i], s1[i + 1]); }
      rm = xhalf_max(fmaxf(max3f(a, b, s0[15]), s1[15])); }
    if (first) {
        const float dl = rm < -1e29f ? 0.f : rm; S.m = dl; dl_ret = dl;
#pragma unroll
        for (int i = 0; i < 16; ++i) { s0[i] -= dl; s1[i] -= dl; }
    } else if (__any(rm > SM_THR)) {
        const float dl = fmaxf(rm, 0.f), alpha = ex2(-dl); S.m += dl; S.l *= alpha; dl_ret = dl;
#pragma unroll
        for (int i = 0; i < 16; ++i) { s0[i] -= dl; s1[i] -= dl; o[0][i] *= alpha; o[1][i] *= alpha; }
    }
    float p0 = 0.f, p1 = 0.f, p2 = 0.f, p3 = 0.f;
#pragma unroll
    for (int i = 0; i < 16; i += 2) { s0[i] = ex2(s0[i]); s0[i + 1] = ex2(s0[i + 1]); s1[i] = ex2(s1[i]); s1[i + 1] = ex2(s1[i + 1]); p0 += s0[i]; p1 += s0[i + 1]; p2 += s1[i]; p3 += s1[i + 1]; }
    S.l += (p0 + p1) + (p2 + p3);
    return dl_ret;
}
template <int KSTEPS, int VS = VSTP, bool VPREF = false>
DI void attn_step(const LAS unsigned char* Kt, const LAS unsigned char* Vt, const bf16x8 (&qf)[KSTEPS], SoftState& S, f32x16 (&o)[2], bool masked, int klo, int khi, bool first, int r32, int hi) {
    const f32x16 cinit = bcast16(-S.m); f32x16 s0 = cinit, s1 = cinit;
    { const LAS unsigned char* p0 = Kt + r32 * KSTR + hi * 16;
#pragma unroll
      for (int ks = 0; ks < KSTEPS; ++ks) { const bf16x8 a0 = *(const LAS bf16x8*)(p0 + ks * 32), a1 = *(const LAS bf16x8*)(p0 + 32 * KSTR + ks * 32);
          s0 = mfma32(a0, qf[ks], s0); s1 = mfma32(a1, qf[ks], s1); } }
    if constexpr (VPREF) { bf16x8 vfr[2][4]; load_vfrags<VS>(Vt, vfr, r32, hi); __builtin_amdgcn_sched_barrier(0);
        soft_update(s0, s1, S, o, masked, klo, khi, first, hi);
        __builtin_amdgcn_sched_barrier(0);
        pv_regs(s0, s1, vfr, o); }
    else { soft_update(s0, s1, S, o, masked, klo, khi, first, hi); pv_tile<VS>(s0, s1, Vt, o, r32, hi); }
}
template <int KSTEPS, int VS>
DI void attn_step2(const LAS unsigned char* Kt, const LAS unsigned char* Vt, const bf16x8 (&qf)[KSTEPS], SoftState& S, f32x16 (&o)[2], bool masked0, int khi0, bool masked1, int khi1, bool first, int r32, int hi) {
    const f32x16 cinit = bcast16(-S.m); f32x16 a0 = cinit, a1 = cinit, b0 = cinit, b1 = cinit;
    { const LAS unsigned char* p0 = Kt + r32 * KSTR + hi * 16;
#pragma unroll
      for (int ks = 0; ks < KSTEPS; ++ks) { const bf16x8 k0 = *(const LAS bf16x8*)(p0 + ks * 32), k1 = *(const LAS bf16x8*)(p0 + 32 * KSTR + ks * 32);
          a0 = mfma32(k0, qf[ks], a0); a1 = mfma32(k1, qf[ks], a1); }
#pragma unroll
      for (int ks = 0; ks < KSTEPS; ++ks) { const bf16x8 k0 = *(const LAS bf16x8*)(p0 + 64 * KSTR + ks * 32), k1 = *(const LAS bf16x8*)(p0 + 96 * KSTR + ks * 32);
          b0 = mfma32(k0, qf[ks], b0); b1 = mfma32(k1, qf[ks], b1); } }
    bf16x8 vfr[2][4]; load_vfrags<VS>(Vt, vfr, r32, hi); __builtin_amdgcn_sched_barrier(0);
    const float dl0 = soft_update(a0, a1, S, o, masked0, 0, khi0, first, hi);
    __builtin_amdgcn_sched_barrier(0);
    pv_regs(a0, a1, vfr, o);
    __builtin_amdgcn_sched_barrier(0);
    load_vfrags<VS>(Vt + 128, vfr, r32, hi); __builtin_amdgcn_sched_barrier(0);
    (void)soft_update(b0, b1, S, o, masked1, 0, khi1, false, hi, dl0);
    __builtin_amdgcn_sched_barrier(0);
    pv_regs(b0, b1, vfr, o);
}
struct StageRegs { u32x4 a, b, c, d, e; };
template <class LoadF, class StoreF, class StepF>
DI void attn_pipeline(int jbeg, int jend, LoadF ld, StoreF st, StepF step) {
    if (jbeg > jend) return;
    StageRegs RA;
    ld(jbeg, RA); st(0, RA); __syncthreads();
    for (int j = jbeg; j <= jend; j += 2) {
        if (j + 1 <= jend) ld(j + 1, RA);
        step(j, 0);
        if (j + 1 <= jend) st(1, RA);
        __syncthreads();
        if (STAGGER && __builtin_amdgcn_readfirstlane(threadIdx.x >> 6) >= 4) __builtin_amdgcn_s_sleep(STAGGER);
        if (j + 1 > jend) break;
        if (j + 2 <= jend) ld(j + 2, RA);
        step(j + 1, 1);
        if (j + 2 <= jend) st(0, RA);
        __syncthreads();
        if (STAGGER && __builtin_amdgcn_readfirstlane(threadIdx.x >> 6) >= 4) __builtin_amdgcn_s_sleep(STAGGER);
    }
}
DI const float* inp(const Args& a, int k) { asm volatile("" : "+s"(k)); return a.in[k]; }
__global__ void __launch_bounds__(NTHR, 2) fwd(Args args) {
    extern __shared__ __attribute__((aligned(16))) unsigned char lds_raw[];
    LAS unsigned char* lds = (LAS unsigned char*)lds_raw;
    LAS float* ldsf = (LAS float*)lds;
    volatile LAS unsigned* LCTL = (volatile LAS unsigned*)(lds + LDS_CTL);
    const int tid0 = threadIdx.x, wave = __builtin_amdgcn_readfirstlane(tid0 >> 6);
    const int G = gridDim.x, bid = blockIdx.x;
#define LAUNDER_TID() int tid = tid0; asm volatile("" : "+v"(tid)); const int lane = tid & 63; (void)lane
#define WS_PTRS() unsigned char* ws = args.ws; asm volatile("" : "+s"(ws)); \
    unsigned* ctl = (unsigned*)(ws + WS_CTL); float* ssp_base = (float*)(ws + WS_SSP); float* hb = (float*)(ws + WS_HB); \
    bf16_t* XB = (bf16_t*)(ws + WS_XB); bf16_t* Y = (bf16_t*)(ws + WS_Y); bf16_t* PB = (bf16_t*)(ws + WS_PB); bf16_t* ACT = (bf16_t*)(ws + WS_ACT); \
    const float2* cs64 = (const float2*)(ws + WS_CS64); const float2* cs32 = (const float2*)(ws + WS_CS32); \
    float* LRA = args.out; float* LRU_ = args.out + (size_t)M * 256; \
    float* LA = (float*)(ws + WS_LA); float* LH = (float*)(ws + WS_LH); float* CIN = (float*)(ws + WS_CIN); \
    float* KVC = (float*)(ws + WS_KVC); float* DEC = (float*)(ws + WS_DEC); float* SST = (float*)(ws + WS_SST); \
    bf16_t* MQ = (bf16_t*)(ws + WS_MQ); bf16_t* MKN = (bf16_t*)(ws + WS_MKN); bf16_t* MVT = (bf16_t*)(ws + WS_MV); bf16_t* MKR = (bf16_t*)(ws + WS_MKR); \
    bf16_t* VST = (bf16_t*)(ws + WS_VST); bf16_t* KSF = (bf16_t*)(ws + WS_KSF); (void)KSF; bf16_t* VWT = (bf16_t*)(ws + WS_VWT); bf16_t* KCMPB = (bf16_t*)(ws + WS_KCMPB); bf16_t* VCMPT = (bf16_t*)(ws + WS_VCMPT); \
    const float* ssq_mix = ssp_base + (size_t)(l_ == 0 ? 0 : 2) * 4 * M; float* ssq_out = ssp_base + (size_t)(1 + 3 * l_) * 4 * M; float* ssq_down = ssp_base + (size_t)(2 + 3 * l_) * 4 * M; float* ssq_d = ssp_base + (size_t)(3 + 3 * l_) * 4 * M; \
    (void)ctl; (void)hb; (void)XB; (void)Y; (void)PB; (void)ACT; (void)cs64; (void)cs32; (void)LRA; (void)LRU_; (void)LA; (void)LH; (void)CIN; (void)KVC; (void)DEC; (void)SST; (void)MQ; (void)MKN; (void)MVT; (void)MKR; (void)VST; (void)VWT; (void)KCMPB; (void)VCMPT; (void)ssq_mix; (void)ssq_out; (void)ssq_down; (void)ssq_d
    unsigned* ctl0 = (unsigned*)(args.ws + WS_CTL);
    { LAUNDER_TID(); if (tid < 16) LCTL[tid] = 0u; }
    __syncthreads();
    const int lo = args.ph_lo, hi = args.ph_hi;
    XcdBarrier bar; bar.bar = ctl0 + CW_BAR; bar.x = 0; bar.st = LCTL;
    if (hi - lo > 1) bar = xcd_barrier_post(ctl0 + CW_BAR, LCTL);
#define IN(k) (lo <= (k) && (k) < hi)
#define SEAM(k) do { if (IN(k) && IN((k) + 1)) xcd_barrier(bar); } while (0)

    if (IN(0)) {
        const int l_ = 0; WS_PTRS();
      _Pragma("unroll 1") for (int rep = 0; rep < REP_P0; ++rep) {
        LAUNDER_TID();
        const int gw = bid * 8 + wave, NGW = G * 8;
        LAS float* scr = ldsf + wave * 4224; LAS float* scr64 = scr;
        constexpr int I_IN = 16 * 36, I_OUT = 16 * 16, I_GU = 16 * 88, I_DN = 44 * 16, I_L = I_IN + I_OUT + I_GU + I_DN;
        for (int it = gw; it < 2 * I_L; it += NGW) {
            const int l = it / I_L; int r = it % I_L;
            if (r < I_IN) { p0_transpose_item64<0>(inp(args, 3) + (size_t)l * DM * NINS, DM, NINS, inp(args, 2) + l * DM, (bf16_t*)(ws + WS_WIN) + (size_t)l * NIN * DM, scr64, r / 36, r % 36, lane); continue; } r -= I_IN;
            if (r < I_OUT) { p0_transpose_item64<0, 768>(inp(args, 23) + (size_t)l * DM * DM, DM, DM, inp(args, 22) + l * DM, (bf16_t*)(ws + WS_WOUT) + (size_t)l * DM * DM, scr64, r / 16, r % 16, lane); continue; } r -= I_OUT;
            if (r < I_GU) { p0_transpose_item64<1>(inp(args, 25) + (size_t)l * DM * NGU, DM, NGU, inp(args, 24) + l * DM, (bf16_t*)(ws + WS_WGU) + (size_t)l * NGU * DM, scr64, r / 88, r % 88, lane); continue; } r -= I_GU;
            p0_transpose_item64<0>(inp(args, 26) + (size_t)l * FF * DM, FF, DM, nullptr, (bf16_t*)(ws + WS_WDN) + (size_t)l * DM * FF, scr64, r / 16, r % 16, lane);
        }
        { constexpr int I_UQ = 3 * 12, I_UKV = 2 * 16, I_W1 = 32 * 8, I_W2 = 4 * 2, I_S = 2 * I_UQ + 2 * I_UKV + 4 * I_W1 + 4 * I_W2;
          for (int it = gw; it < I_S; it += NGW) { int r = it;
              if (r < 2 * I_UQ) { const int l = r / I_UQ; r %= I_UQ; p0_transpose_item<0>(inp(args, 20) + (size_t)l * 192 * 384, 192, 384, inp(args, 18) + l * 192, (bf16_t*)(ws + WS_WUQT) + (size_t)l * 384 * 192, scr, r / 12, r % 12, lane); continue; } r -= 2 * I_UQ;
              if (r < 2 * I_UKV) { const int l = r / I_UKV; r %= I_UKV; p0_transpose_item<0>(inp(args, 21) + (size_t)l * 128 * 512, 128, 512, inp(args, 19) + l * 128, (bf16_t*)(ws + WS_WUKVT) + (size_t)l * 512 * 128, scr, r / 16, r % 16, lane); continue; } r -= 2 * I_UKV;
              if (r < 4 * I_W1) { const int lj = r / I_W1; r %= I_W1; p0_transpose_item<0>(inp(args, 12) + (size_t)lj * 2048 * 256, 2048, 256, nullptr, (bf16_t*)(ws + WS_W1T) + (size_t)lj * 256 * 2048, scr, r / 8, r % 8, lane); continue; } r -= 4 * I_W1;
              { const int lj = r / I_W2; r %= I_W2; p0_transpose_item<0>(inp(args, 14) + (size_t)lj * 256 * 64, 256, 64, nullptr, (bf16_t*)(ws + WS_W2T) + (size_t)lj * 64 * 256, scr, r / 2, r % 2, lane); } } }
        for (int e = bid * NTHR + tid; e < 2 * 2 * 4 * 64 * 64; e += G * NTHR) {
            const int k = e & 63, n = (e >> 6) & 63, h = (e >> 12) & 3, g = (e >> 14) & 1, l = e >> 15;
            ((bf16_t*)(ws + WS_WGT))[e] = f2bf((g == 0 ? inp(args, 6) : inp(args, 8))[(((size_t)l * 4 + h) * 64 + k) * 64 + n]); }
        for (int e = bid * NTHR + tid; e < 512; e += G * NTHR) ((float*)(ws + WS_SP))[e] = log1pf(expf(-inp(args, 10)[e]));
        for (int m = gw; m < M; m += NGW) {
            const f32x4* xr = (const f32x4*)(inp(args, 0) + (size_t)m * DM) + lane;
            f32x4 v[4]; float s = 0.f;
#pragma unroll
            for (int j = 0; j < 4; ++j) { v[j] = xr[64 * j]; s += v[j][0] * v[j][0] + v[j][1] * v[j][1] + v[j][2] * v[j][2] + v[j][3] * v[j][3]; }
            s = wave_sum(s);
            u32x2* o8 = (u32x2*)(XB + (size_t)m * DM) + lane;
#pragma unroll
            for (int j = 0; j < 4; ++j) { u32x2 w; w.x = pk2(v[j][0], v[j][1]); w.y = pk2(v[j][2], v[j][3]); o8[64 * j] = w; }
            if (lane < 4) ssp_base[(size_t)lane * M + m] = lane == 0 ? s : 0.f;
        }
        for (int e = bid * NTHR + tid; e < M * 32; e += G * NTHR) {
            const int m = e >> 5, i = e & 31; const float pos = (float)((const int*)inp(args, 1))[m];
            const float invf = __builtin_amdgcn_exp2f(-(float)(2 * i) * (13.287712379549449f / 64.f)); float sn, cs; { float rv = pos * invf * 0.15915494309189535f; rv -= floorf(rv); sn = __builtin_amdgcn_sinf(rv); cs = __builtin_amdgcn_cosf(rv); }
            ((float2*)(ws + WS_CS64))[e] = make_float2(cs, sn);
            if (i < 16) { const float invf2 = __builtin_amdgcn_exp2f(-(float)(2 * i) * (13.287712379549449f / 32.f)); float rv = pos * invf2 * 0.15915494309189535f; rv -= floorf(rv); sn = __builtin_amdgcn_sinf(rv); cs = __builtin_amdgcn_cosf(rv); ((float2*)(ws + WS_CS32))[m * 16 + i] = make_float2(cs, sn); }
        }
        for (int e = bid * NTHR + tid; e < 2 * 2 * 256; e += G * NTHR) {
            const int lj = e >> 8, c = e & 255; float a = inp(args, 13)[e];
            const float* pp = inp(args, 11) + (size_t)lj * 2048; const float* w1 = inp(args, 12) + (size_t)lj * 2048 * 256 + c;
            for (int i = 0; i < 2048; ++i) a += pp[i] * w1[(size_t)i * 256];
            hb[e] = a;
        }
      }
    }
    SEAM(0);

    for (int l = 0; l < 2; ++l) {
        const int pb = 1 + 6 * l;
        if (IN(pb)) {
        const int l_ = l; WS_PTRS();
            pg8::Gemm g{XB, (const bf16_t*)(ws + WS_WIN) + (size_t)l * NIN * DM, M, NIN, DM}; pg8::StaticOrder S; S.init(M, NIN, G, bid);
            pg8::EpiInProj E{PB, NIN, ssq_mix};
            _Pragma("unroll 1") for (int rep = 0; rep < REP_G16; ++rep) pg8::gemm_phase<pg8::EpiInProj, pg8::StaticOrder, true, true>(lds, g, S, E);
        }
        SEAM(pb);
        if (IN(pb + 1)) {
        const int l_ = l; WS_PTRS();
        LAUNDER_TID();
            constexpr int N_J1 = 1024, N_J2 = 512, N_J3 = 512, N_J4 = 512, N_J4B = 128;
            {
            for (int r_ = bid; r_ < N_J4B * REP_J4B; r_ += G) { const int r = r_ % N_J4B;
                    const int j = r & 1, g32 = (r >> 1) & 15, b = r >> 5; const int colb = j == 0 ? C_KC : C_VC; const int r32 = lane & 31, hi = lane >> 5;
                    LAS unsigned char* Tl = lds;
                    LAS unsigned char* Hl = lds + 69632;
                    for (int e = tid; e < 528 * 8; e += NTHR) { const int rr = e >> 3, c8 = e & 7, t = 512 * g32 + rr; u32x4 w = {0u, 0u, 0u, 0u};
                        if (t < SEQ) { const bf16_t* pr = PB + ((size_t)b * SEQ + t) * NIN + colb;
                            if (j == 0) { const u32x4 a = *(const u32x4*)(pr + 8 * (c8 & 3)), c = *(const u32x4*)(pr + 32 + 8 * (c8 & 3)); const float2* cs = cs64 + ((size_t)b * SEQ + t) * 32 + 8 * (c8 & 3);
                                const unsigned au[4] = {a.x, a.y, a.z, a.w}, cu[4] = {c.x, c.y, c.z, c.w}; unsigned ou[4];
#pragma unroll
                                for (int q = 0; q < 4; ++q) { const float2 s0 = cs[2 * q], s1 = cs[2 * q + 1]; const float x1a = bflo(au[q]), x1b = bfhi(au[q]), x2a = bflo(cu[q]), x2b = bfhi(cu[q]);
                                    ou[q] = c8 < 4 ? pk2(x1a * s0.x - x2a * s0.y, x1b * s1.x - x2b * s1.y) : pk2(x2a * s0.x + x1a * s0.y, x2b * s1.x + x1b * s1.y); }
                                w.x = ou[0]; w.y = ou[1]; w.z = ou[2]; w.w = ou[3]; }
                            else w = *(const u32x4*)(pr + 8 * c8); }
                        *(LAS u32x4*)(Tl + rr * 128 + (rr >> 4) * 16 + c8 * 16) = w; }
                    __syncthreads();
                    { const bf16_t* w1t = (const bf16_t*)(ws + WS_W1T) + ((size_t)(l * 2 + j) * 256 + 32 * wave + r32) * 2048 + 8 * hi;
                      f32x16 acc;
#pragma unroll
                      for (int i = 0; i < 16; ++i) acc[i] = 0.f;
#pragma unroll 16
                      for (int kk = 0; kk < 128; ++kk) { const int rowt = 16 * r32 + (kk >> 2);
                          const bf16x8 a = *(const LAS bf16x8*)(Tl + rowt * 128 + (rowt >> 4) * 16 + 32 * (kk & 3) + 16 * hi);
                          const bf16x8 bw = *(const bf16x8*)(w1t + 16 * kk);
                          acc = mfma32(a, bw, acc); }
                      const float hbv = hb[(l * 2 + j) * 256 + 32 * wave + r32];
#pragma unroll
                      for (int i = 0; i < 16; ++i) { const int n = (i & 3) + 8 * (i >> 2) + 4 * hi; *(LAS bf16_t*)(Hl + n * 528 + (32 * wave + r32) * 2) = f2bf(gelu_tanh(acc[i] + hbv)); } }
                    __syncthreads();
                    if (wave < 2) { const bf16_t* w2t = (const bf16_t*)(ws + WS_W2T) + ((size_t)(l * 2 + j) * 64 + 32 * wave + r32) * 256 + 8 * hi;
                      f32x16 acc;
#pragma unroll
                      for (int i = 0; i < 16; ++i) acc[i] = 0.f;
#pragma unroll
                      for (int kk = 0; kk < 16; ++kk) { const bf16x8 a = *(const LAS bf16x8*)(Hl + r32 * 528 + 32 * kk + 16 * hi); const bf16x8 bw = *(const bf16x8*)(w2t + 16 * kk); acc = mfma32(a, bw, acc); }
                      const int dd = 32 * wave + r32;
#pragma unroll
                      for (int g = 0; g < 4; ++g) { const int n0 = 32 * g32 + 8 * g + 4 * hi; float v[4];
#pragma unroll
                          for (int q = 0; q < 4; ++q) v[q] = (n0 + q < 511) ? acc[4 * g + q] : 0.f;
                          if (j == 0) {
#pragma unroll
                              for (int q = 0; q < 4; ++q) KCMPB[((size_t)b * 512 + n0 + q) * 64 + dd] = f2bf(v[q]); }
                          else { u32x2 w; w.x = pk2(v[0], v[1]); w.y = pk2(v[2], v[3]); *(u32x2*)(VCMPT + ((size_t)b * 64 + dd) * 512 + n0) = w; } } }
                    __syncthreads();
            }
            if (bid < N_J3) {
                const int fr = lane & 15, kq = lane >> 4, hh = wave >> 1, odd = wave & 1;
                {
                    bf16x8 bq[3][6];
                    { const bf16_t* wq = (const bf16_t*)(ws + WS_WUQT) + (size_t)l * 384 * 192;
#pragma unroll
                      for (int nt = 0; nt < 3; ++nt)
#pragma unroll
                          for (int ks = 0; ks < 6; ++ks) bq[nt][ks] = *(const bf16x8*)(wq + (size_t)(48 * wave + 16 * nt + fr) * 192 + 32 * ks + 8 * kq); }
                    for (int r_ = bid; r_ < N_J3 * REP_J3; r_ += G) { const int r = r_ % N_J3;
                        const size_t row0 = (size_t)r * 64;
#pragma unroll 1
                        for (int mt = 0; mt < 4; ++mt) {
                            const bf16_t* pa = PB + (row0 + mt * 16 + fr) * NIN;
                            bf16x8 aq[6]; float ssq_ = 0.f;
#pragma unroll
                            for (int ks = 0; ks < 6; ++ks) { aq[ks] = ld8x2(pa + C_DCQ + 32 * ks + 8 * kq);
#pragma unroll
                                for (int e = 0; e < 8; ++e) { const float v = bf2f((bf16_t)aq[ks][e]); ssq_ += v * v; } }
                            ssq_ += __shfl_xor(ssq_, 16); ssq_ += __shfl_xor(ssq_, 32);
                            const float rq_ = rsqrtf(ssq_ * (1.f / 192.f) + EPS);
                            f32x4 cq[3];
#pragma unroll
                            for (int nt = 0; nt < 3; ++nt) { cq[nt] = (f32x4){0.f, 0.f, 0.f, 0.f};
#pragma unroll
                                for (int ks = 0; ks < 6; ++ks) cq[nt] = __builtin_amdgcn_mfma_f32_16x16x32_bf16(aq[ks], bq[nt][ks], cq[nt], 0, 0, 0); }
                            const float SCQ = 0.10206207261596575f * LOG2E;
#pragma unroll
                            for (int i = 0; i < 4; ++i) {
                                const size_t row = row0 + mt * 16 + 4 * kq + i; const float rqi = __shfl(rq_, 4 * kq + i) * SCQ;
                                float q0 = cq[0][i] * rqi, q1 = cq[1][i] * rqi, q2 = cq[2][i] * rqi;
                                if (odd) { const float2 cs = cs32[row * 16 + fr]; const float x1 = q1, x2 = q2; q1 = x1 * cs.x - x2 * cs.y; q2 = x2 * cs.x + x1 * cs.y; }
                                bf16_t* mq = MQ + row * 384 + hh * 96 + 48 * odd + fr; mq[0] = f2bf(q0); mq[16] = f2bf(q1); mq[32] = f2bf(q2);
                            }
                            if (wave == mt) {
#pragma unroll
                                for (int q = 0; q < 4; ++q) { const int p = lane * 4 + q, tok = p >> 4, i = p & 15; const size_t row = row0 + mt * 16 + tok; const bf16_t* pr = PB + row * NIN + C_DKR;
                                    const float x1 = bf2f(pr[i]), x2 = bf2f(pr[16 + i]); const float2 cs = cs32[row * 16 + i];
                                    MKR[row * 32 + i] = f2bf(x1 * cs.x - x2 * cs.y); MKR[row * 32 + 16 + i] = f2bf(x2 * cs.x + x1 * cs.y); } }
                        }
                    }
                }
                {
                    bf16x8 bkv[4][4];
                    { const bf16_t* wkv = (const bf16_t*)(ws + WS_WUKVT) + (size_t)l * 512 * 128;
#pragma unroll
                      for (int nt = 0; nt < 4; ++nt)
#pragma unroll
                          for (int ks = 0; ks < 4; ++ks) bkv[nt][ks] = *(const bf16x8*)(wkv + (size_t)(64 * wave + 16 * nt + fr) * 128 + 32 * ks + 8 * kq); }
                    for (int r_ = bid; r_ < N_J3 * REP_J3; r_ += G) { const int r = r_ % N_J3;
                        const size_t row0 = (size_t)r * 64; const size_t bb = row0 / SEQ, t0 = row0 % SEQ;
#pragma unroll 1
                        for (int mt = 0; mt < 4; ++mt) {
                            const bf16_t* pa = PB + (row0 + mt * 16 + fr) * NIN;
                            bf16x8 akv[4]; float sskv_ = 0.f;
#pragma unroll
                            for (int ks = 0; ks < 4; ++ks) { akv[ks] = ld8x2(pa + C_DCKV + 32 * ks + 8 * kq);
#pragma unroll
                                for (int e = 0; e < 8; ++e) { const float v = bf2f((bf16_t)akv[ks][e]); sskv_ += v * v; } }
                            sskv_ += __shfl_xor(sskv_, 16); sskv_ += __shfl_xor(sskv_, 32);
                            const float rk_ = rsqrtf(sskv_ * (1.f / 128.f) + EPS);
                            f32x4 ckv[4];
#pragma unroll
                            for (int nt = 0; nt < 4; ++nt) { ckv[nt] = (f32x4){0.f, 0.f, 0.f, 0.f};
#pragma unroll
                                for (int ks = 0; ks < 4; ++ks) ckv[nt] = __builtin_amdgcn_mfma_f32_16x16x32_bf16(akv[ks], bkv[nt][ks], ckv[nt], 0, 0, 0); }
                            float rki[4];
#pragma unroll
                            for (int i = 0; i < 4; ++i) rki[i] = __shfl(rk_, 4 * kq + i);
                            if (!odd) {
#pragma unroll
                                for (int i = 0; i < 4; ++i) { bf16_t* mk = MKN + (row0 + mt * 16 + 4 * kq + i) * 256 + hh * 64 + fr;
                                    mk[0] = f2bf(ckv[0][i] * rki[i]); mk[16] = f2bf(ckv[1][i] * rki[i]); mk[32] = f2bf(ckv[2][i] * rki[i]); mk[48] = f2bf(ckv[3][i] * rki[i]); } }
                            else {
#pragma unroll
                                for (int nt = 0; nt < 4; ++nt) { u32x2 w; w.x = pk2(ckv[nt][0] * rki[0], ckv[nt][1] * rki[1]); w.y = pk2(ckv[nt][2] * rki[2], ckv[nt][3] * rki[3]);
                                    *(u32x2*)(MVT + ((bb * 4 + hh) * 64 + 16 * nt + fr) * SEQ + t0 + mt * 16 + 4 * kq) = w; } }
                        }
                    }
                }
            }
            {
                const int r32 = lane & 31, hi = lane >> 5, gh = wave >> 1, gg = wave & 1, ch = tid & 255, half = tid >> 8;
                bf16x8 bW[2][4];
                { const bf16_t* wt = (const bf16_t*)(ws + WS_WGT) + (size_t)(((l * 2 + gg) * 4 + gh) * 64) * 64;
#pragma unroll
                  for (int nt = 0; nt < 2; ++nt)
#pragma unroll
                      for (int ks = 0; ks < 4; ++ks) bW[nt][ks] = *(const bf16x8*)(wt + (size_t)(32 * nt + r32) * 64 + 16 * ks + 8 * hi); }
                const float gbias0 = (gg == 0 ? inp(args, 7) : inp(args, 9))[l * 256 + gh * 64 + r32], gbias1 = (gg == 0 ? inp(args, 7) : inp(args, 9))[l * 256 + gh * 64 + 32 + r32];
                const float cw0 = inp(args, 4)[(l * 4 + 0) * 256 + ch], cw1 = inp(args, 4)[(l * 4 + 1) * 256 + ch], cw2 = inp(args, 4)[(l * 4 + 2) * 256 + ch], cw3 = inp(args, 4)[(l * 4 + 3) * 256 + ch], cb = inp(args, 5)[l * 256 + ch];
                const float sp = ((const float*)(ws + WS_SP))[l * 256 + ch];
                LAS float* xa = ldsf; LAS float* xc = ldsf + 35 * 256; LAS unsigned char* xcb = lds + 67 * 1024; LAS float* gR = (LAS float*)(lds + 67 * 1024 + 32 * 528); LAS float* gI = gR + 32 * 256;
            const bool j1bal = (G == 256 && REP_J1 == 1);
            for (int r_ = bid, k_ = 0; j1bal ? (k_ < (bid < 128 ? 3 : 5)) : (r_ < N_J1 * REP_J1); r_ += G, ++k_) { const int r = j1bal ? (bid < 128 ? bid + 128 * k_ : 384 + (bid - 128) + 128 * k_) : r_ % N_J1;
                    const int b = r >> 8, tb = r & 255, t0 = tb * 32;
                    for (int c = tid; c < 35 * 32; c += NTHR) { const int rr = c >> 5, c8 = c & 31, t = t0 - 3 + rr; u32x4 w = {0u, 0u, 0u, 0u}; if (t >= 0) w = *(const u32x4*)(PB + ((size_t)b * SEQ + t) * NIN + C_AX + 8 * c8);
                        LAS f32x4* d = (LAS f32x4*)(xa + rr * 256 + 8 * c8); d[0] = (f32x4){bflo(w.x), bfhi(w.x), bflo(w.y), bfhi(w.y)}; d[1] = (f32x4){bflo(w.z), bfhi(w.z), bflo(w.w), bfhi(w.w)}; }
                    __syncthreads();
#pragma unroll 4
                    for (int tt = 0; tt < 16; ++tt) { const int rr = half * 16 + tt; const float v = cb + cw0 * xa[rr * 256 + ch] + cw1 * xa[(rr + 1) * 256 + ch] + cw2 * xa[(rr + 2) * 256 + ch] + cw3 * xa[(rr + 3) * 256 + ch];
                        xc[rr * 256 + ch] = v; *(LAS bf16_t*)(xcb + rr * 528 + ch * 2) = f2bf(v); }
                    __syncthreads();
                    { f32x16 acc[2];
#pragma unroll
                      for (int i = 0; i < 16; ++i) { acc[0][i] = 0.f; acc[1][i] = 0.f; }
#pragma unroll
                      for (int ks = 0; ks < 4; ++ks) { const bf16x8 a = *(const LAS bf16x8*)(xcb + r32 * 528 + (gh * 64 + 16 * ks + 8 * hi) * 2); acc[0] = mfma32(a, bW[0][ks], acc[0]); acc[1] = mfma32(a, bW[1][ks], acc[1]); }
                      LAS float* gd = gg == 0 ? gR : gI;
#pragma unroll
                      for (int i = 0; i < 16; ++i) { const int tok = (i & 3) + 8 * (i >> 2) + 4 * hi; gd[tok * 256 + gh * 64 + r32] = sigmoidf_(acc[0][i] + gbias0); gd[tok * 256 + gh * 64 + 32 + r32] = sigmoidf_(acc[1][i] + gbias1); } }
                    __syncthreads();
                    float hst = 0.f, Ac = 1.f;
#pragma unroll 4
                    for (int tt = 0; tt < 16; ++tt) {
                        const int rr = half * 16 + tt;
                        const float la = -8.f * gR[rr * 256 + ch] * sp, x2 = 2.f * la;
                        const float av = la > -0.25f ? 1.f + la * (1.f + la * (0.5f + la * (0.16666667f + la * (0.041666667f + la * 0.0083333333f)))) : __expf(la);
                        const float om = x2 > -0.5f ? -x2 * (1.f + x2 * (0.5f + x2 * (0.16666667f + x2 * (0.041666667f + x2 * (0.0083333333f + x2 * 0.0013888889f))))) : 1.f - __expf(x2);
                        const float u = __builtin_amdgcn_sqrtf(om) * (gI[rr * 256 + ch] * xc[rr * 256 + ch]);
                        hst = av * hst + u; Ac *= av;
                        { const size_t ao = ((size_t)b * SEQ + t0 + rr) * 256 + ch; LRA[ao] = av; LRU_[ao] = u; }
                    }
                    const size_t so = ((size_t)(b * 512 + tb * 2 + half)) * 256 + ch;
                    LA[so] = Ac; LH[so] = hst;
                    __syncthreads();
            }
            }
            {
                const int kk = tid & 127, tq = tid >> 7, r32 = lane & 31, hi = lane >> 5;
                float wg[16]; const float bg = inp(args, 16)[l * 128 + kk];
#pragma unroll
                for (int q = 0; q < 16; ++q) wg[q] = inp(args, 15)[(l * 16 + q) * 128 + kk];
                LAS float* glr = ldsf; LAS float* tot = ldsf + 1024; LAS unsigned char* KTl = lds + 8192; LAS unsigned char* VTl = lds + 8192 + 128 * VSTR;
                float* BCS = (float*)(ws + WS_BCS);
            for (int r_ = bid; r_ < N_J2 * REP_J2; r_ += G) { const int r = r_ % N_J2;
                    const int b = r >> 7, c = r & 127; const size_t row0 = (size_t)b * SEQ + 64 * c;
                    for (int e = tid; e < 1024; e += NTHR) glr[e] = bf2f(PB[(row0 + (e >> 4)) * NIN + C_GLR + (e & 15)]);
                    for (int e = tid; e < 2048; e += NTHR) { const int jj = e >> 5, hc = e & 31; const bf16_t* vsrc = PB + (row0 + jj) * NIN + C_CV + 8 * hc; const u32x2 wA = *(const u32x2*)vsrc, wB = *(const u32x2*)(vsrc + 4);
                        LAS bf16_t* d = (LAS bf16_t*)(VTl + (8 * hc) * VSTR) + jj;
                        d[0] = (bf16_t)wA.x; d[VSTR / 2] = (bf16_t)(wA.x >> 16); d[2 * (VSTR / 2)] = (bf16_t)wA.y; d[3 * (VSTR / 2)] = (bf16_t)(wA.y >> 16); d[4 * (VSTR / 2)] = (bf16_t)wB.x; d[5 * (VSTR / 2)] = (bf16_t)(wB.x >> 16); d[6 * (VSTR / 2)] = (bf16_t)wB.y; d[7 * (VSTR / 2)] = (bf16_t)(wB.y >> 16); }
                    __syncthreads();
                    float bv[16]; float run = 0.f;
#pragma unroll
                    for (int tt = 0; tt < 16; ++tt) { const LAS f32x4* g4 = (const LAS f32x4*)(glr + (16 * tq + tt) * 16); float z = bg;
#pragma unroll
                        for (int q = 0; q < 4; ++q) { const f32x4 g = g4[q]; z += g[0] * wg[4 * q] + g[1] * wg[4 * q + 1] + g[2] * wg[4 * q + 2] + g[3] * wg[4 * q + 3]; }
                        run += (fminf(z, 0.f) - __logf(1.f + __expf(-fabsf(z)))) * (1.f / 16.f); bv[tt] = run; }
                    tot[tq * 128 + kk] = run;
                    __syncthreads();
                    { const float t0_ = tot[kk], t1_ = tot[128 + kk], t2_ = tot[256 + kk], t3_ = tot[384 + kk]; const float off = tq == 0 ? 0.f : (tq == 1 ? t0_ : (tq == 2 ? t0_ + t1_ : (t0_ + t1_) + t2_)), blast = ((t0_ + t1_) + t2_) + t3_;
#pragma unroll
                      for (int tt = 0; tt < 16; ++tt) { const int t = 16 * tq + tt; const float bt = bv[tt] + off; BCS[(row0 + t) * 128 + kk] = bt;
                          *((LAS bf16_t*)(KTl + kk * VSTR) + t) = f2bf(bf2f(PB[(row0 + t) * NIN + C_CK + kk]) * __expf(blast - bt)); }
                      if (tq == 0) DEC[(size_t)(b * 128 + c) * 128 + kk] = __expf(blast); }
                    __syncthreads();
                    { const int h = wave >> 1, nt = wave & 1; f32x16 acc;
#pragma unroll
                      for (int i = 0; i < 16; ++i) acc[i] = 0.f;
                      const LAS unsigned char* ap = KTl + (h * 32 + r32) * VSTR + 16 * hi; const LAS unsigned char* bp = VTl + (h * 64 + 32 * nt + r32) * VSTR + 16 * hi;
#pragma unroll
                      for (int s = 0; s < 4; ++s) { const u32x2 a0 = *(const LAS u32x2*)(ap + 32 * s), a1 = *(const LAS u32x2*)(ap + 32 * s + 8), b0 = *(const LAS u32x2*)(bp + 32 * s), b1 = *(const LAS u32x2*)(bp + 32 * s + 8);
                          u32x4 aw, bw; aw.x = a0.x; aw.y = a0.y; aw.z = a1.x; aw.w = a1.y; bw.x = b0.x; bw.y = b0.y; bw.z = b1.x; bw.w = b1.y;
                          acc = mfma32(__builtin_bit_cast(bf16x8, aw), __builtin_bit_cast(bf16x8, bw), acc); }
                      float* o = KVC + ((size_t)(b * 128 + c) * 4 + h) * 2048 + 32 * nt + r32;
#pragma unroll
                      for (int i = 0; i < 16; ++i) o[((i & 3) + 8 * (i >> 2) + 4 * hi) * 64] = acc[i]; }
                    __syncthreads();
            }
            }
            for (int r = bid; r < N_J4; r += G) {
                    const size_t row0 = (size_t)r * 64;
#pragma unroll
                    for (int it3 = 0; it3 < 3; ++it3) {
                        const int e = tid + it3 * NTHR, tok = e / 24, p = e % 24, hd = p >> 2, c8 = p & 3; const int base = hd < 4 ? C_BQ + hd * 64 : (hd == 4 ? C_KS : C_KW); const float sc = hd < 4 ? 0.125f * LOG2E : 1.f;
                        bf16_t* pr = PB + (row0 + tok) * NIN + base + 8 * c8; const u32x4 a = *(const u32x4*)pr, c = *(const u32x4*)(pr + 32); const float2* cs = cs64 + (row0 + tok) * 32 + 8 * c8;
                        const unsigned au[4] = {a.x, a.y, a.z, a.w}, cu[4] = {c.x, c.y, c.z, c.w}; unsigned o1[4], o2[4];
#pragma unroll
                        for (int q = 0; q < 4; ++q) { const float2 s0 = cs[2 * q], s1 = cs[2 * q + 1]; const float x1a = bflo(au[q]), x1b = bfhi(au[q]), x2a = bflo(cu[q]), x2b = bfhi(cu[q]);
                            o1[q] = pk2((x1a * s0.x - x2a * s0.y) * sc, (x1b * s1.x - x2b * s1.y) * sc); o2[q] = pk2((x2a * s0.x + x1a * s0.y) * sc, (x2b * s1.x + x1b * s1.y) * sc); }
                        u32x4 w1, w2; w1.x = o1[0]; w1.y = o1[1]; w1.z = o1[2]; w1.w = o1[3]; w2.x = o2[0]; w2.y = o2[1]; w2.z = o2[2]; w2.w = o2[3];
                        *(u32x4*)pr = w1; *(u32x4*)(pr + 32) = w2;
                        if (hd == 4) {
                            bf16_t* kf_ = KSF + (row0 / 64) * 4096 + (size_t)((((tok >> 5) * 4 + (c8 >> 1)) * 64 + (c8 & 1) * 32 + (tok & 31)) * 8); *(u32x4*)kf_ = w1; *(u32x4*)(kf_ + 2 * 64 * 8) = w2; } }
                    { LAS bf16_t* tl = (LAS bf16_t*)lds; const size_t bb = row0 / SEQ, t0 = row0 % SEQ;
                      for (int mtx = 0; mtx < 2; ++mtx) { const int tok = tid >> 3, c = tid & 7; const u32x4 w = *(const u32x4*)(PB + (row0 + tok) * NIN + (mtx ? C_VW : C_VS) + c * 8);
                          LAS bf16_t* dst = tl + mtx * 64 * 72 + tok * 72 + c * 8; dst[0] = (bf16_t)w.x; dst[1] = (bf16_t)(w.x >> 16); dst[2] = (bf16_t)w.y; dst[3] = (bf16_t)(w.y >> 16); dst[4] = (bf16_t)w.z; dst[5] = (bf16_t)(w.z >> 16); dst[6] = (bf16_t)w.w; dst[7] = (bf16_t)(w.w >> 16); }
                      __syncthreads();
                      for (int mtx = 0; mtx < 2; ++mtx) { const int d = tid >> 3, c8 = tid & 7; const LAS bf16_t* s = tl + mtx * 64 * 72 + (c8 * 8) * 72 + d;
                          u32x4 w; w.x = (unsigned)s[0] | ((unsigned)s[72] << 16); w.y = (unsigned)s[2 * 72] | ((unsigned)s[3 * 72] << 16); w.z = (unsigned)s[4 * 72] | ((unsigned)s[5 * 72] << 16); w.w = (unsigned)s[6 * 72] | ((unsigned)s[7 * 72] << 16);
                          if (mtx) *(u32x4*)(VWT + (bb * 64 + d) * SEQ + t0 + c8 * 8) = w;
                          else { const int s_ = c8 >> 1, h_ = c8 & 1; const LAS bf16_t* q = tl + (16 * s_ + 4 * h_) * 72 + d;
                              u32x4 f; f.x = (unsigned)q[0] | ((unsigned)q[72] << 16); f.y = (unsigned)q[2 * 72] | ((unsigned)q[3 * 72] << 16); f.z = (unsigned)q[8 * 72] | ((unsigned)q[9 * 72] << 16); f.w = (unsigned)q[10 * 72] | ((unsigned)q[11 * 72] << 16);
                              *(u32x4*)(VST + (row0 / 64) * 4096 + (size_t)((((d >> 5) * 4 + s_) * 64 + h_ * 32 + (d & 31)) * 8)) = f; } }
                      __syncthreads(); }
            }
            }
        }
        SEAM(pb + 1);
        if (IN(pb + 2)) {
        const int l_ = l; WS_PTRS();
        LAUNDER_TID();
            constexpr int Q_J5 = 2, Q_J6 = 64, Q_ATT = 1024 * REP_ATT, Q_J9 = 1024, Q_J10 = 512, Q_TOT = Q_J5 + Q_J6 + Q_ATT + Q_J9 + Q_J10;
            if (tid == 0) { LCTL[4] = 0u; LCTL[5] = 0u; }
            __syncthreads();
            const int tid_o = tid;
            for (;;) {
                int tid = tid_o; asm volatile("" : "+v"(tid)); const int lane = tid & 63;
                if (tid == 0) LCTL[2] = __hip_atomic_fetch_add(ctl + CW_QUEUE + 64 * l, 1u, __ATOMIC_RELAXED, __HIP_MEMORY_SCOPE_AGENT);
                __syncthreads();
                int r = __builtin_amdgcn_readfirstlane((int)LCTL[2]); const unsigned seen5 = LCTL[4], seen6 = LCTL[5];
                __syncthreads();
                if (r >= Q_TOT * REP_P3) break;
                if (REP_P3 > 1 && r >= Q_TOT) r -= Q_TOT;
                if (r < Q_J5) {
                    const int e = r * NTHR + tid, b = e >> 8, ch = e & 255; float carry = 0.f;
                    for (int c0 = 0; c0 < 512; c0 += 8) { float av[8], hv[8];
#pragma unroll
                        for (int q = 0; q < 8; ++q) { const size_t so = ((size_t)(b * 512 + c0 + q)) * 256 + ch; av[q] = LA[so]; hv[q] = LH[so]; }
#pragma unroll
                        for (int q = 0; q < 8; ++q) { CIN[((size_t)(b * 512 + c0 + q)) * 256 + ch] = carry; carry = av[q] * carry + hv[q]; } }
                    asm volatile("s_waitcnt vmcnt(0)" ::: "memory"); __syncthreads();
                    if (tid == 0) { __builtin_amdgcn_fence(__ATOMIC_RELEASE, "agent"); asm volatile("s_waitcnt vmcnt(0)" ::: "memory"); (void)xb_add(ctl + CW_FLAG + 64 * (2 * l + 0), 1u); }
                    continue;
                }
                r -= Q_J5;
                if (r < Q_J6) {
                    const int e = r * NTHR + tid, b = e >> 13, rem = e & 8191; float Sv = 0.f;
                    for (int c0 = 0; c0 < 128; c0 += 8) { float kv[8], dv[8];
#pragma unroll
                        for (int q = 0; q < 8; ++q) { kv[q] = KVC[(size_t)(b * 128 + c0 + q) * 8192 + rem]; dv[q] = DEC[(size_t)(b * 128 + c0 + q) * 128 + (rem >> 6)]; }
#pragma unroll
                        for (int q = 0; q < 8; ++q) { SST[(size_t)(b * 128 + c0 + q) * 8192 + rem] = Sv; Sv = dv[q] * Sv + kv[q]; } }
                    asm volatile("s_waitcnt vmcnt(0)" ::: "memory"); __syncthreads();
                    if (tid == 0) { __builtin_amdgcn_fence(__ATOMIC_RELEASE, "agent"); asm volatile("s_waitcnt vmcnt(0)" ::: "memory"); (void)xb_add(ctl + CW_FLAG + 64 * (2 * l + 1), 1u); }
                    continue;
                }
                r -= Q_J6;
                if (r >= Q_ATT) {
                    r -= Q_ATT; const bool is9 = r < Q_J9;
                    if (!(is9 ? seen5 : seen6)) {
                        if (tid == 0) { unsigned* f = ctl + CW_FLAG + 64 * (2 * l + (is9 ? 0 : 1)); const unsigned target = is9 ? (unsigned)Q_J5 : (unsigned)Q_J6;
                            XB_SPIN(xb_ld(f) < target, ctl + CW_BAR); __builtin_amdgcn_fence(__ATOMIC_ACQUIRE, "agent"); asm volatile("s_waitcnt vmcnt(0)" ::: "memory"); LCTL[is9 ? 4 : 5] = 1u; }
                        __syncthreads(); }
                    if (is9) {
                    const int b = r >> 8, tb = r & 255, t0 = tb * 32, ch = tid & 255, half = tid >> 8;
                    LAS float* xa = ldsf;
                    float hst = CIN[((size_t)(b * 512 + tb * 2 + half)) * 256 + ch];
                    { float av[16], uv[16], gv[16];
#pragma unroll
                      for (int tt = 0; tt < 16; ++tt) { const size_t ro = (size_t)b * SEQ + t0 + half * 16 + tt; av[tt] = LRA[ro * 256 + ch]; uv[tt] = LRU_[ro * 256 + ch]; gv[tt] = bf2f(PB[ro * NIN + C_AG + ch]); }
#pragma unroll
                      for (int tt = 0; tt < 16; ++tt) { hst = av[tt] * hst + uv[tt]; xa[(half * 16 + tt) * 256 + ch] = hst * gelu_tanh(gv[tt]); } }
                    __syncthreads();
                    for (int q = 0; q < 4; ++q) { const int rr = wave * 4 + q; const f32x4 v = ((const LAS f32x4*)(xa + rr * 256))[lane];
                        const float rinv = rsqrtf(wave_sum(v[0] * v[0] + v[1] * v[1] + v[2] * v[2] + v[3] * v[3]) * (1.f / 256.f) + EPS);
                        u32x2 w; w.x = pk2(v[0] * rinv, v[1] * rinv); w.y = pk2(v[2] * rinv, v[3] * rinv);
                        *(u32x2*)(Y + ((size_t)b * SEQ + t0 + rr) * DM + 256 + 4 * lane) = w; }
                    __syncthreads();
                    } else { r -= Q_J9;
                    const int b = r >> 7, c = r & 127; const size_t row0 = (size_t)b * SEQ + 64 * c;
                    LAS float* bL = ldsf; LAS float* glr = ldsf + 8192; LAS unsigned char* VTl = lds + 36864; LAS unsigned char* STl = lds + 71680; LAS float* SSX = (LAS float*)(lds + 92160);
                    for (int e = tid; e < 2048; e += NTHR) ((LAS f32x4*)bL)[e] = ((const f32x4*)((const float*)(ws + WS_BCS) + row0 * 128))[e];
                    for (int e = tid; e < 2048; e += NTHR) { const int jj = e >> 5, hc = e & 31, h = hc >> 3, c8 = hc & 7; const bf16_t* vsrc = PB + (row0 + jj) * NIN + C_CV + h * 64 + 8 * c8; const u32x2 wA = *(const u32x2*)vsrc, wB = *(const u32x2*)(vsrc + 4); u32x4 w; w.x = wA.x; w.y = wA.y; w.z = wB.x; w.w = wB.y;
                        LAS bf16_t* d = (LAS bf16_t*)(VTl + h * 8704 + (8 * c8) * VSTR) + jj;
                        d[0] = (bf16_t)w.x; d[VSTR / 2] = (bf16_t)(w.x >> 16); d[2 * (VSTR / 2)] = (bf16_t)w.y; d[3 * (VSTR / 2)] = (bf16_t)(w.y >> 16); d[4 * (VSTR / 2)] = (bf16_t)w.z; d[5 * (VSTR / 2)] = (bf16_t)(w.z >> 16); d[6 * (VSTR / 2)] = (bf16_t)w.w; d[7 * (VSTR / 2)] = (bf16_t)(w.w >> 16); }
                    for (int e = tid; e < 8192; e += NTHR) { const int h = e >> 11, k = (e >> 6) & 31, v = e & 63; *(LAS bf16_t*)(STl + h * 5120 + v * 80 + k * 2) = f2bf(SST[(size_t)(b * 128 + c) * 8192 + e]); }
                    __syncthreads();
                    { const int r32 = lane & 31, hi = lane >> 5, h = wave >> 1, ih = wave & 1, i = 32 * ih + r32; const float SCG = 0.17677669529663687f;
                      bf16x8 qrel[2], qabs[2], kt[2][2];
#pragma unroll
                      for (int ks = 0; ks < 2; ++ks) { const int k0 = h * 32 + 16 * ks + 8 * hi; const bf16x8 qv = ld8x2(PB + (row0 + i) * NIN + C_CQ + k0); u32x4 wr_, wa_; unsigned* pr_ = (unsigned*)&wr_; unsigned* pa_ = (unsigned*)&wa_;
#pragma unroll
                          for (int e2 = 0; e2 < 4; ++e2) { const float b0 = bL[i * 128 + k0 + 2 * e2], b1 = bL[i * 128 + k0 + 2 * e2 + 1], f0 = bL[31 * 128 + k0 + 2 * e2], f1 = bL[31 * 128 + k0 + 2 * e2 + 1];
                              const float q0 = bf2f((bf16_t)qv[2 * e2]) * SCG, q1 = bf2f((bf16_t)qv[2 * e2 + 1]) * SCG;
                              pr_[e2] = cvtpk(q0 * __expf(b0 - f0), q1 * __expf(b1 - f1)); pa_[e2] = cvtpk(q0 * __expf(b0), q1 * __expf(b1)); }
                          qrel[ks] = __builtin_bit_cast(bf16x8, wr_); qabs[ks] = __builtin_bit_cast(bf16x8, wa_); }
#pragma unroll
                      for (int jt = 0; jt < 2; ++jt)
#pragma unroll
                          for (int ks = 0; ks < 2; ++ks) { const int jr = 32 * jt + r32, k0 = h * 32 + 16 * ks + 8 * hi; const bf16x8 kv = ld8x2(PB + (row0 + jr) * NIN + C_CK + k0); u32x4 wk_; unsigned* pk_ = (unsigned*)&wk_;
#pragma unroll
                              for (int e2 = 0; e2 < 4; ++e2) { const float b0 = bL[jr * 128 + k0 + 2 * e2], b1 = bL[jr * 128 + k0 + 2 * e2 + 1], f0 = bL[31 * 128 + k0 + 2 * e2], f1 = bL[31 * 128 + k0 + 2 * e2 + 1];
                                  pk_[e2] = cvtpk(bf2f((bf16_t)kv[2 * e2]) * __expf(f0 - b0), bf2f((bf16_t)kv[2 * e2 + 1]) * __expf(f1 - b1)); }
                              kt[jt][ks] = __builtin_bit_cast(bf16x8, wk_); }
                      f32x16 o[2], s[2];
#pragma unroll
                      for (int q = 0; q < 16; ++q) { o[0][q] = 0.f; o[1][q] = 0.f; s[0][q] = 0.f; s[1][q] = 0.f; }
#pragma unroll
                      for (int ks = 0; ks < 2; ++ks) s[0] = mfma32(kt[0][ks], qrel[ks], s[0]);
                      if (ih) {
#pragma unroll
                          for (int ks = 0; ks < 2; ++ks) s[1] = mfma32(kt[1][ks], qrel[ks], s[1]); }
#pragma unroll
                      for (int q = 0; q < 16; ++q) { const int jr = (q & 3) + 8 * (q >> 2) + 4 * hi; if (jr > r32) { if (ih) s[1][q] = 0.f; else s[0][q] = 0.f; } }
                      const LAS unsigned char* VTh = VTl + h * 8704; const LAS unsigned char* STh = STl + h * 5120;
#pragma unroll
                      for (int dt = 0; dt < 2; ++dt) { const LAS unsigned char* vp = VTh + (32 * dt + r32) * VSTR + 8 * hi;
                          o[dt] = mfma32(vfrag(vp), pack8<0>(s[0]), o[dt]); o[dt] = mfma32(vfrag(vp + 32), pack8<8>(s[0]), o[dt]);
                          if (ih) { o[dt] = mfma32(vfrag(vp + 64), pack8<0>(s[1]), o[dt]); o[dt] = mfma32(vfrag(vp + 96), pack8<8>(s[1]), o[dt]); }
#pragma unroll
                          for (int ks = 0; ks < 2; ++ks) o[dt] = mfma32(*(const LAS bf16x8*)(STh + (32 * dt + r32) * 80 + 32 * ks + 16 * hi), qabs[ks], o[dt]); }
                      float ssh = 0.f;
#pragma unroll
                      for (int q = 0; q < 16; ++q) ssh += o[0][q] * o[0][q] + o[1][q] * o[1][q];
                      const float rh = rsqrtf(xhalf_sum(ssh) * (1.f / 64.f) + EPS); float ssg = 0.f;
#pragma unroll
                      for (int dt = 0; dt < 2; ++dt)
#pragma unroll
                          for (int g = 0; g < 4; ++g) { const int v0 = 32 * dt + 8 * g + 4 * hi; const u32x2 ogw = *(const u32x2*)(PB + (row0 + i) * NIN + C_OG + h * 64 + v0); const f32x4 gn = *(const f32x4*)(inp(args, 17) + l * 64 + v0);
                              const float og4[4] = {bflo(ogw.x), bfhi(ogw.x), bflo(ogw.y), bfhi(ogw.y)};
#pragma unroll
                              for (int q = 0; q < 4; ++q) { const float y = o[dt][4 * g + q] * rh * gn[q] * (og4[q] * sigmoidf_(og4[q])); o[dt][4 * g + q] = y; ssg += y * y; } }
                      ssg = xhalf_sum(ssg); if (hi == 0) SSX[i * 4 + h] = ssg;
                      __syncthreads();
                      const f32x4 s4 = *(const LAS f32x4*)(SSX + i * 4); const float rinv = rsqrtf((s4[0] + s4[1] + s4[2] + s4[3]) * (1.f / 256.f) + EPS);
#pragma unroll
                      for (int dt = 0; dt < 2; ++dt)
#pragma unroll
                          for (int g = 0; g < 4; ++g) { u32x2 w; w.x = cvtpk(o[dt][4 * g] * rinv, o[dt][4 * g + 1] * rinv); w.y = cvtpk(o[dt][4 * g + 2] * rinv, o[dt][4 * g + 3] * rinv);
                              *(u32x2*)(Y + (row0 + i) * DM + 768 + h * 64 + 32 * dt + 8 * g + 4 * hi) = w; } }
                    __syncthreads();
                    }
                    continue;
                }
                const int r32 = lane & 31, hi = lane >> 5;
                const int rep = r >> 10; r &= 1023;
                const int grp = r >> 5, within = r & 31;
                if (rep && ((REP_ONLY == 1 && within >= 16) || (REP_ONLY == 2 && within < 16))) continue;
              {
                if (within >= 16) {
                    const int idx = within - 16, b = idx & 3, tb = 127 - (4 * grp + (idx >> 2));
                    const int tl = 8 * wave + (r32 >> 2), head = r32 & 3, T = 64 * tb + tl; const size_t row = (size_t)b * SEQ + T; const bf16_t* prow = PB + row * NIN;
                    bf16x8 qf[4];
#pragma unroll
                    for (int ks = 0; ks < 4; ++ks) qf[ks] = *(const bf16x8*)(prow + C_BQ + head * 64 + 16 * ks + 8 * hi);
                    LAS float* impb = (LAS float*)(lds + AL_IMP) + wave * 1024; LAS unsigned* selm = (LAS unsigned*)(lds + AL_SELM) + wave * 32;
                    const int skey = tid >> 3, sch = tid & 7;
                    const unsigned koffP = (unsigned)(skey * NIN + sch * 8), voffS = (unsigned)(skey * SEQ + sch * 8), koffC = (unsigned)(skey * 64 + sch * 8), voffC = (unsigned)(skey * 512 + sch * 8);
                    auto stK = [&](int buf, const StageRegs& R) __attribute__((always_inline)) { *(LAS u32x4*)(lds + (buf ? AL_K1 : AL_K0) + skey * KSTR + sch * 16) = R.a; };
                    auto stKV = [&](int buf, const StageRegs& R) __attribute__((always_inline)) { *(LAS u32x4*)(lds + (buf ? AL_K1 : AL_K0) + skey * KSTR + sch * 16) = R.a;
                        LAS unsigned char* vd = lds + (buf ? AL_V1 : AL_V0) + skey * VSTP + (sch >> 1) * 32 + (sch & 1) * 8; u32x2 a, c; a.x = R.b.x; a.y = R.b.y; c.x = R.b.z; c.y = R.b.w; *(LAS u32x2*)vd = a; *(LAS u32x2*)(vd + 16) = c; };
                    f32x16 oacc[2], ob[2];
                    const int nv = T >= 31 ? ((T - 31) >> 4) + 1 : 0, ntc = (4 * tb + 3 + 63) >> 6;
                    float mC = NEGB, lC = 0.f;
                    { const bf16_t* kb_ = KCMPB + (size_t)b * 512 * 64;
                      attn_pipeline(0, ntc - 1, [&](int j, StageRegs& R) __attribute__((always_inline)) { R.a = *(const u32x4*)((kb_ + (size_t)j * 64 * 64) + koffC); }, stK,
                        [&](int j, int cb) __attribute__((always_inline)) { f32x16 s0, s1; qk_tile<4>(lds + (cb ? AL_K1 : AL_K0), qf, r32, hi, s0, s1); if (!__all(nv - 1 - 64 * j >= 63)) mask_tile(s0, s1, 0, nv - 1 - 64 * j, hi);
                            const float mx = tile_max(s0, s1), mn = fmaxf(mC, mx), ms = mn < -1e29f ? 0.f : mn, alpha = ex2(mC - ms); mC = mn; float ps = 0.f;
#pragma unroll
                            for (int i = 0; i < 16; ++i) ps += ex2(s0[i] - ms) + ex2(s1[i] - ms);
                            lC = lC * alpha + ps; }); }
                    { const float invC = 1.f / fmaxf(xhalf_sum(lC), 1e-30f), msC = mC < -1e29f ? 0.f : mC; float carry = 0.f;
#pragma unroll
                      for (int i = 0; i < 16; ++i) { ob[0][i] = 0.f; ob[1][i] = 0.f; }
                      const bf16_t* kb_ = KCMPB + (size_t)b * 512 * 64; const bf16_t* vb_ = VCMPT + (size_t)b * 64 * 512;
                      attn_pipeline(0, ntc - 1, [&](int j, StageRegs& R) __attribute__((always_inline)) { R.a = *(const u32x4*)((kb_ + (size_t)j * 64 * 64) + koffC); R.b = *(const u32x4*)((vb_ + j * 64) + voffC); }, stKV,
                        [&](int j, int cb) __attribute__((always_inline)) { f32x16 s0, s1; qk_tile<4>(lds + (cb ? AL_K1 : AL_K0), qf, r32, hi, s0, s1); if (!__all(nv - 1 - 64 * j >= 63)) mask_tile(s0, s1, 0, nv - 1 - 64 * j, hi);
#pragma unroll
                            for (int i = 0; i < 16; ++i) { s0[i] = ex2(s0[i] - msC) * invC; s1[i] = ex2(s1[i] - msC) * invC; }
                            float gs[8], pl[8];
#pragma unroll
                            for (int q = 0; q < 4; ++q) { gs[q] = (s0[4 * q] + s0[4 * q + 1]) + (s0[4 * q + 2] + s0[4 * q + 3]); gs[4 + q] = (s1[4 * q] + s1[4 * q + 1]) + (s1[4 * q + 2] + s1[4 * q + 3]);
                                pl[q] = __shfl_xor(s0[4 * q + 3], 32); pl[4 + q] = __shfl_xor(s1[4 * q + 3], 32); }
#pragma unroll
                            for (int q = 0; q < 8; ++q) { const float prev = hi ? pl[q] : (q > 0 ? pl[q > 0 ? q - 1 : 0] : carry); float x = gs[q] + prev; x += __shfl_xor(x, 1); x += __shfl_xor(x, 2);
                                if ((r32 & 3) == 0) impb[(r32 >> 2) * 128 + 16 * j + 2 * q + hi] = x; }
                            carry = pl[7];
                            pv_tile(s0, s1, lds + (cb ? AL_V1 : AL_V0), ob, r32, hi); }); }
                    LAS float* oav = (LAS float*)(lds + AL_OACC) + tid; const float g0 = sigmoidf_(bf2f(prow[C_BG + head * 3]));
#pragma unroll
                    for (int i = 0; i < 16; ++i) { oav[i * 512] = g0 * ob[0][i]; oav[(16 + i) * 512] = g0 * ob[1][i]; }
                    WSYNC();
                    for (int tk = 0; tk < 8; ++tk) {
                        const int cur = tb, j0 = lane, j1 = lane + 64; const float im0 = impb[tk * 128 + j0], im1 = impb[tk * 128 + j1];
                        const unsigned k0 = ((j0 == 0 || j0 == cur || j0 == cur - 1) ? 0xFF000000u : (j0 <= cur ? (__float_as_uint(im0) & ~127u) : 0u)) | (unsigned)(127 - j0);
                        const unsigned k1 = ((j1 == cur || j1 == cur - 1) ? 0xFF000000u : (j1 <= cur ? (__float_as_uint(im1) & ~127u) : 0u)) | (unsigned)(127 - j1);
                        unsigned T = 0u;
#pragma unroll 4
                        for (int bb = 31; bb >= 0; --bb) { const unsigned cand = T | (1u << bb); const int cnt = __popcll(__ballot(k0 >= cand)) + __popcll(__ballot(k1 >= cand)); if (cnt >= 16) T = cand; }
                        const unsigned long long m0 = __ballot(k0 >= T), m1 = __ballot(k1 >= T);
                        if (lane == 0) { selm[tk * 4] = (unsigned)m0; selm[tk * 4 + 1] = (unsigned)(m0 >> 32); selm[tk * 4 + 2] = (unsigned)m1; selm[tk * 4 + 3] = (unsigned)(m1 >> 32); }
                    }
                    WSYNC();
                    const unsigned sm0 = selm[(r32 >> 2) * 4], sm1 = selm[(r32 >> 2) * 4 + 1], sm2 = selm[(r32 >> 2) * 4 + 2], sm3 = selm[(r32 >> 2) * 4 + 3];
                    { SoftState SB; soft_init(SB, ob);
                      unsigned u0 = sm0, u1 = sm1, u2 = sm2, u3 = sm3;
#pragma unroll
                      for (int o_ = 1; o_ < 64; o_ <<= 1) { u0 |= (unsigned)__shfl_xor((int)u0, o_); u1 |= (unsigned)__shfl_xor((int)u1, o_); u2 |= (unsigned)__shfl_xor((int)u2, o_); u3 |= (unsigned)__shfl_xor((int)u3, o_); }
                      unsigned long long Ulo = ((unsigned long long)(unsigned)__builtin_amdgcn_readfirstlane((int)u1) << 32) | (unsigned)__builtin_amdgcn_readfirstlane((int)u0), Uhi = ((unsigned long long)(unsigned)__builtin_amdgcn_readfirstlane((int)u3) << 32) | (unsigned)__builtin_amdgcn_readfirstlane((int)u2);
                      if (tb < 64) { if (tb < 63) Ulo &= (2ull << tb) - 1ull; Uhi = 0ull; } else if (tb < 127) Uhi &= (2ull << (tb - 64)) - 1ull;
                      const bf16_t* ksf = KSF + (size_t)b * 128 * 4096; const bf16_t* vsf = VST + (size_t)b * 128 * 4096; const unsigned lo8 = (unsigned)lane * 8u;
                      bf16x8 kf[2][4], vf[2][4];
                      int j = 0; Ulo &= ~1ull;
#pragma unroll
                      for (int f = 0; f < 8; ++f) kf[f >> 2][f & 3] = *(const bf16x8*)((ksf + f * 512) + lo8);
                      bool first = true;
                      for (;;) {
#pragma unroll
                          for (int f = 0; f < 8; ++f) vf[f >> 2][f & 3] = *(const bf16x8*)((vsf + (size_t)j * 4096 + f * 512) + lo8);
                          const unsigned wsel = j < 32 ? sm0 : (j < 64 ? sm1 : (j < 96 ? sm2 : sm3)); const bool bit = (wsel >> (j & 31)) & 1u;
                          const f32x16 cinit = bcast16(bit ? -SB.m : NEGB); f32x16 s0 = cinit, s1 = cinit;
#pragma unroll
                          for (int ks = 0; ks < 4; ++ks) { s0 = mfma32(kf[0][ks], qf[ks], s0); s1 = mfma32(kf[1][ks], qf[ks], s1); }
                          __builtin_amdgcn_sched_barrier(0);
                          const int jn = Ulo ? (int)__builtin_ctzll(Ulo) : (Uhi ? 64 + (int)__builtin_ctzll(Uhi) : -1);
                          if (Ulo) Ulo &= Ulo - 1ull; else Uhi &= Uhi - 1ull;
                          if (jn >= 0) {
#pragma unroll
                              for (int f = 0; f < 8; ++f) kf[f >> 2][f & 3] = *(const bf16x8*)((ksf + (size_t)jn * 4096 + f * 512) + lo8); }
                          soft_update(s0, s1, SB, ob, j == tb, 0, tl, first, hi);
                          { const bf16x8 p00 = pack8<0>(s0), p01 = pack8<8>(s0), p10 = pack8<0>(s1), p11 = pack8<8>(s1);
#pragma unroll
                            for (int dt = 0; dt < 2; ++dt) { ob[dt] = mfma32(vf[dt][0], p00, ob[dt]); ob[dt] = mfma32(vf[dt][1], p01, ob[dt]); ob[dt] = mfma32(vf[dt][2], p10, ob[dt]); ob[dt] = mfma32(vf[dt][3], p11, ob[dt]); } }
                          if (jn < 0) break;
                          j = jn; first = false;
                      }
                      const float sc = sigmoidf_(bf2f(prow[C_BG + head * 3 + 1])) / fmaxf(xhalf_sum(SB.l), 1e-30f);
#pragma unroll
                      for (int i = 0; i < 16; ++i) { oav[i * 512] += sc * ob[0][i]; oav[(16 + i) * 512] += sc * ob[1][i]; } }
                    __syncthreads();
                    { SoftState SB; soft_init(SB, ob); const int jb0 = tb >= 8 ? tb - 8 : 0;
                      const bf16_t* kb_ = PB + (size_t)b * SEQ * NIN + C_KW; const bf16_t* vb_ = VWT + (size_t)b * 64 * SEQ;
                      attn_pipeline(tb >= 8 ? tb - 8 : 0, tb, [&](int j, StageRegs& R) __attribute__((always_inline)) { R.a = *(const u32x4*)((kb_ + (size_t)j * 64 * NIN) + koffP); R.b = *(const u32x4*)((vb_ + j * 64) + voffS); }, stKV,
                        [&](int j, int cb) __attribute__((always_inline)) { attn_step<4>(lds + (cb ? AL_K1 : AL_K0), lds + (cb ? AL_V1 : AL_V0), qf, SB, ob, j == tb || j == tb - 8, j == tb - 8 ? tl + 1 : 0, j == tb ? tl : 63, j == jb0, r32, hi); });
                      const float sc = sigmoidf_(bf2f(prow[C_BG + head * 3 + 2])) / fmaxf(xhalf_sum(SB.l), 1e-30f);
#pragma unroll
                      for (int i = 0; i < 16; ++i) { oacc[0][i] = oav[i * 512] + sc * ob[0][i]; oacc[1][i] = oav[(16 + i) * 512] + sc * ob[1][i]; } }
                    { float ss = 0.f;
#pragma unroll
                      for (int i = 0; i < 16; ++i) ss += oacc[0][i] * oacc[0][i] + oacc[1][i] * oacc[1][i];
                      ss = xhalf_sum(ss); ss += __shfl_xor(ss, 1); ss += __shfl_xor(ss, 2);
                      const float rinv = rsqrtf(ss * (1.f / 256.f) + EPS);
#pragma unroll
                      for (int dt = 0; dt < 2; ++dt)
#pragma unroll
                          for (int g = 0; g < 4; ++g) { u32x2 w; w.x = cvtpk(oacc[dt][4 * g] * rinv, oacc[dt][4 * g + 1] * rinv); w.y = cvtpk(oacc[dt][4 * g + 2] * rinv, oacc[dt][4 * g + 3] * rinv);
                              *(u32x2*)(Y + row * DM + 512 + head * 64 + 32 * dt + 8 * g + 4 * hi) = w; } }
                    __syncthreads();
                    continue;
                }
                {
                    const int qb = 31 - grp, b = within >> 2, h = within & 3;
                    const int T = 256 * qb + 32 * wave + r32; const size_t row = (size_t)b * SEQ + T;
                    bf16x8 qf[6];
#pragma unroll
                    for (int ks = 0; ks < 6; ++ks) qf[ks] = *(const bf16x8*)(MQ + row * 384 + h * 96 + 16 * ks + 8 * hi);
                    f32x16 o[2]; SoftState SM; soft_init(SM, o);
                    const int jd = 4 * qb + (wave >> 1);
                    const bf16_t* kn = MKN + (size_t)b * SEQ * 256 + h * 64; const bf16_t* kr = MKR + (size_t)b * SEQ * 32; const bf16_t* vt = MVT + (size_t)(b * 4 + h) * 64 * SEQ;
                    constexpr int VS2 = 272, AM_K0 = 0, AM_K1 = 128 * KSTR, AM_V0 = 2 * 128 * KSTR, AM_V1 = AM_V0 + 64 * VS2;
                    const int nk = tid >> 3, nc = tid & 7, rkey = tid >> 2, rch = tid & 3, vr = tid >> 4, vc = tid & 15;
                    const unsigned ko0 = (unsigned)(nk * 256 + nc * 8), ko1 = (unsigned)(rkey * 32 + rch * 8), vo_ = (unsigned)(vr * SEQ + vc * 8);
                    attn_pipeline(0, 2 * qb + 1,
                        [&](int jj, StageRegs& R) __attribute__((always_inline)) { const bf16_t* knj = kn + (size_t)jj * 128 * 256; const bf16_t* vtj = vt + jj * 128;
                            R.a = *(const u32x4*)(knj + ko0); R.b = *(const u32x4*)((knj + 64 * 256) + ko0); R.c = *(const u32x4*)((kr + (size_t)jj * 128 * 32) + ko1);
                            R.d = *(const u32x4*)(vtj + vo_); R.e = *(const u32x4*)((vtj + 32 * SEQ) + vo_); },
                        [&](int buf, const StageRegs& R) __attribute__((always_inline)) { LAS unsigned char* kb_ = lds + (buf ? AM_K1 : AM_K0); LAS unsigned char* vb_ = lds + (buf ? AM_V1 : AM_V0) + vr * VS2 + (vc >> 1) * 32 + (vc & 1) * 8;
                            *(LAS u32x4*)(kb_ + nk * KSTR + nc * 16) = R.a; *(LAS u32x4*)(kb_ + (64 + nk) * KSTR + nc * 16) = R.b; *(LAS u32x4*)(kb_ + rkey * KSTR + 128 + rch * 16) = R.c;
                            u32x2 p, q; p.x = R.d.x; p.y = R.d.y; q.x = R.d.z; q.y = R.d.w; *(LAS u32x2*)vb_ = p; *(LAS u32x2*)(vb_ + 16) = q;
                            p.x = R.e.x; p.y = R.e.y; q.x = R.e.z; q.y = R.e.w; *(LAS u32x2*)(vb_ + 32 * VS2) = p; *(LAS u32x2*)(vb_ + 32 * VS2 + 16) = q; },
                        [&](int jj, int cb) __attribute__((always_inline)) {
                            const int kd = 32 * (wave & 1) + r32;
#pragma unroll
                            for (int hh = 0; hh < 2; ++hh) { const int j = 2 * jj + hh;
                                if (j <= jd) attn_step<6, VS2, true>(lds + (cb ? AM_K1 : AM_K0) + hh * 64 * KSTR, lds + (cb ? AM_V1 : AM_V0) + hh * 128, qf, SM, o, j == jd, 0, kd, j == 0, r32, hi); } });
                    { const float inv = 1.f / fmaxf(xhalf_sum(SM.l), 1e-30f); float ss = 0.f;
#pragma unroll
                      for (int dt = 0; dt < 2; ++dt)
#pragma unroll
                          for (int g = 0; g < 4; ++g) { const float v0 = o[dt][4 * g] * inv, v1 = o[dt][4 * g + 1] * inv, v2 = o[dt][4 * g + 2] * inv, v3 = o[dt][4 * g + 3] * inv; ss += v0 * v0 + v1 * v1 + v2 * v2 + v3 * v3;
                              u32x2 w; w.x = cvtpk(v0, v1); w.y = cvtpk(v2, v3); *(u32x2*)(Y + row * DM + h * 64 + 32 * dt + 8 * g + 4 * hi) = w; }
                      ss = xhalf_sum(ss); if (hi == 0) ssq_d[(size_t)h * M + row] = ss; }
                    __syncthreads();
                }
              }
            }
        }
        SEAM(pb + 2);
        if (IN(pb + 3)) {
        const int l_ = l; WS_PTRS();
            pg8::Gemm g{Y, (const bf16_t*)(ws + WS_WOUT) + (size_t)l * DM * DM, M, DM, DM}; pg8::StaticOrder S; S.init(M, DM, G, bid);
            pg8::EpiResid<true> E{XB, ssq_out, ssq_d, (LAS float*)(lds + 131072)};
            pg8::gemm_phase<pg8::EpiResid<true>, pg8::StaticOrder, true, true>(lds, g, S, E);
            if (REP_G57) { pg8::EpiInProj E2{PB, DM, ssq_mix}; pg8::gemm_phase<pg8::EpiInProj, pg8::StaticOrder, true, true>(lds, g, S, E2); }
        }
        SEAM(pb + 3);
        if (IN(pb + 4)) {
        const int l_ = l; WS_PTRS();
            pg8::Gemm g{XB, (const bf16_t*)(ws + WS_WGU) + (size_t)l * NGU * DM, M, NGU, DM}; pg8::StaticOrder S; S.init(M, NGU, G, bid);
            pg8::EpiSwiglu E{ACT, ssq_out};
            _Pragma("unroll 1") for (int rep = 0; rep < REP_G16; ++rep) pg8::gemm_phase<pg8::EpiSwiglu, pg8::StaticOrder, true, true>(lds, g, S, E);
        }
        SEAM(pb + 4);
        if (IN(pb + 5)) {
        const int l_ = l; WS_PTRS();
            pg8::Gemm g{ACT, (const bf16_t*)(ws + WS_WDN) + (size_t)l * DM * FF, M, DM, FF}; pg8::StaticOrder S; S.init(M, DM, G, bid);
            pg8::EpiResid<false> E{XB, ssq_down, nullptr, (LAS float*)(lds + 131072)};
            pg8::gemm_phase<pg8::EpiResid<false>, pg8::StaticOrder, true, true>(lds, g, S, E);
            if (REP_G57) { pg8::EpiInProj E2{Y, DM, ssq_mix}; pg8::gemm_phase<pg8::EpiInProj, pg8::StaticOrder, true, true>(lds, g, S, E2); }
        }
        SEAM(pb + 5);
    }
    if (IN(13)) {
        const int l_ = 1; WS_PTRS();
        LAUNDER_TID();
        const float* ssqf = ssp_base + (size_t)5 * 4 * M; const int gw = bid * 8 + wave, NGW = G * 8;
        for (int m = gw; m < M; m += NGW) {
            const float rinv = rsqrtf(sum4p(ssqf, m) * (1.f / DM) + EPS);
            const u32x2* xr = (const u32x2*)(XB + (size_t)m * DM) + lane; f32x4* orow = (f32x4*)(args.out + (size_t)m * DM) + lane; const f32x4* gn = (const f32x4*)inp(args, 27) + lane;
#pragma unroll
            for (int j = 0; j < 4; ++j) { const u32x2 w = xr[64 * j]; const f32x4 g = gn[64 * j]; f32x4 v; v[0] = bflo(w.x) * rinv * g[0]; v[1] = bfhi(w.x) * rinv * g[1]; v[2] = bflo(w.y) * rinv * g[2]; v[3] = bfhi(w.y) * rinv * g[3]; orow[64 * j] = v; }
        }
    }
#undef IN
#undef SEAM
}

extern "C" void kernel_launch(void* const* d_in, const int* in_sizes, int n_in, void* d_out, int out_size, void* d_ws, size_t ws_size, hipStream_t stream) {
    static int grid = 0;
    if (grid == 0) {
        if (n_in != 28 || in_sizes[0] != M * DM || out_size != M * DM || ws_size < WS_END) { fprintf(stderr, "kernel_launch: unexpected shapes (n_in %d, ws %zu)\n", n_in, ws_size); grid = -1; return; }
        int dev = 0, cus = 0;
        if (hipGetDevice(&dev) != hipSuccess || hipDeviceGetAttribute(&cus, hipDeviceAttributeMultiprocessorCount, dev) != hipSuccess) { grid = -1; return; }
        if (hipFuncSetAttribute((const void*)fwd, hipFuncAttributeMaxDynamicSharedMemorySize, LDS_BYTES) != hipSuccess) { fprintf(stderr, "kernel_launch: hipFuncSetAttribute failed\n"); grid = -1; return; }
        int per_cu = 0;
        if (hipOccupancyMaxActiveBlocksPerMultiprocessor(&per_cu, (const void*)fwd, NTHR, LDS_BYTES) != hipSuccess || per_cu < 1) fprintf(stderr, "kernel_launch: occupancy query says %d\n", per_cu);
        (void)hipGetLastError();
        grid = cus;
    }
    if (grid < 0) return;
    (void)hipMemsetAsync((char*)d_ws + WS_CTL, 0, CTL_ZERO_BYTES, stream);
    Args a{};
    for (int i = 0; i < 28; ++i) a.in[i] = (const float*)d_in[i];
    a.out = (float*)d_out; a.ws = (unsigned char*)d_ws;
    if (MK_N_LAUNCHES == 1) { a.ph_lo = 0; a.ph_hi = 14; hipLaunchKernelGGL(fwd, dim3(grid), dim3(NTHR), LDS_BYTES, stream, a); }
    else for (int p = 0; p < 14; ++p) { a.ph_lo = p; a.ph_hi = p + 1; hipLaunchKernelGGL(fwd, dim3(grid), dim3(NTHR), LDS_BYTES, stream, a); }
}
```

```cpp
#include <hip/hip_runtime.h>
#include <cstdio>
#include <cstdint>

#ifndef MK_N_LAUNCHES
#define MK_N_LAUNCHES 1
#endif

#define REP_P0 1
#define REP_G16 1
#define REP_G57 0
#define REP_ATT 1
#define STAGGER 6
#define REP_J4B 1
#define REP_J3 1
#define REP_J1 1
#define REP_J2 1
#define REP_P3 1
#define REP_ONLY 0
#define LAS __attribute__((address_space(3)))
#define DI __device__ __forceinline__
typedef unsigned short bf16_t;
typedef short bf16x8 __attribute__((ext_vector_type(8)));
typedef float f32x4 __attribute__((ext_vector_type(4)));
typedef unsigned u32x4 __attribute__((ext_vector_type(4)));
typedef unsigned u32x2 __attribute__((ext_vector_type(2)));

constexpr int NB = 4, SEQ = 8192, M = NB * SEQ, DM = 1024, NIN = 2304, NINS = 2300, FF = 2816, NGU = 2 * FF;
constexpr float EPS = 1e-6f;
constexpr int C_AX = 0, C_AG = 256, C_BQ = 512, C_KC = 768, C_VC = 832, C_KS = 896, C_VS = 960, C_KW = 1024, C_VW = 1088, C_BG = 1152,
              C_CQ = 1164, C_CK = 1292, C_CV = 1420, C_GLR = 1676, C_OG = 1692, C_DCQ = 1948, C_DCKV = 2140, C_DKR = 2268;
constexpr size_t MiB = 1u << 20;
constexpr size_t WS_CTL = 0, CTL_ZERO_BYTES = 1 * MiB;
constexpr size_t WS_ACC = 64 * 1024;
constexpr size_t WS_SSQ0 = 1 * MiB;
constexpr size_t WS_HB = 1 * MiB + 256 * 1024;
constexpr size_t WS_WIN = 2 * MiB, WS_WOUT = 11 * MiB, WS_WGU = 15 * MiB, WS_WDN = 37 * MiB;
constexpr size_t WS_WUQT = 48 * MiB, WS_WUKVT = 48 * MiB + 512 * 1024, WS_W2T = 49 * MiB, WS_W1T = 50 * MiB;
constexpr size_t WS_WGT = 49 * MiB + 512 * 1024, WS_SP = 49 * MiB + 768 * 1024;
constexpr size_t WS_BCS = 352 * MiB;
constexpr size_t WS_CS64 = 64 * MiB, WS_CS32 = 72 * MiB;
constexpr size_t WS_XB = 80 * MiB, WS_Y = 144 * MiB, WS_PB = 208 * MiB, WS_ACT = 208 * MiB;
constexpr size_t WS_LA = 384 * MiB, WS_LH = 386 * MiB, WS_CIN = 388 * MiB;
constexpr size_t WS_KVC = 392 * MiB, WS_DEC = 408 * MiB, WS_SST = 410 * MiB;
constexpr size_t WS_MQ = 428 * MiB, WS_MKN = 452 * MiB, WS_MV = 468 * MiB, WS_MKR = 484 * MiB;
constexpr size_t WS_SSP = 500 * MiB;
constexpr size_t WS_KSF = 504 * MiB;
constexpr size_t WS_VST = 490 * MiB, WS_VWT = 494 * MiB, WS_KCMPB = 498 * MiB, WS_VCMPT = 499 * MiB, WS_END = 508 * MiB;
constexpr int CW_QUEUE = 64;
constexpr int CW_FLAG = 1024;
constexpr int CW_BAR = 4096;
constexpr int LDS_BYTES = 163840 - 256;
constexpr int LDS_CTL = LDS_BYTES - 64;
constexpr int NTHR = 512;

struct Args { const float* in[28]; float* out; unsigned char* ws; int ph_lo, ph_hi; };

DI float bf2f(bf16_t h) { return __uint_as_float(((unsigned)h) << 16); }
DI float bflo(unsigned u) { return __uint_as_float(u << 16); }
DI float bfhi(unsigned u) { return __uint_as_float(u & 0xffff0000u); }
DI bf16_t f2bf(float f) { unsigned u = __float_as_uint(f); return (bf16_t)((u + 0x7fffu + ((u >> 16) & 1u)) >> 16); }
DI unsigned pk2(float lo, float hi) { return (unsigned)f2bf(lo) | ((unsigned)f2bf(hi) << 16); }
DI float sum4p(const float* p, size_t row) { return (p[row] + p[(size_t)M + row]) + (p[2 * (size_t)M + row] + p[3 * (size_t)M + row]); }
DI int lane_id() { int l; asm volatile("v_mbcnt_lo_u32_b32 %0, -1, 0\n\tv_mbcnt_hi_u32_b32 %0, -1, %0" : "=v"(l)); return l; }
DI int tid_of(int wave) { return (wave << 6) + lane_id(); }
DI int shx(int v, int m) { return __builtin_amdgcn_ds_bpermute((lane_id() ^ m) << 2, v); }
DI unsigned shx(unsigned v, int m) { return (unsigned)__builtin_amdgcn_ds_bpermute((lane_id() ^ m) << 2, (int)v); }
DI float shx(float v, int m) { return __int_as_float(__builtin_amdgcn_ds_bpermute((lane_id() ^ m) << 2, __float_as_int(v))); }
DI float shf(float v, int src) { return __int_as_float(__builtin_amdgcn_ds_bpermute(src << 2, __float_as_int(v))); }
DI float wave_sum(float v) {
#pragma unroll
    for (int o = 1; o < 64; o <<= 1) v += shx(v, o);
    return v;
}
DI float wave_max(float v) {
#pragma unroll
    for (int o = 1; o < 64; o <<= 1) v = fmaxf(v, shx(v, o));
    return v;
}
DI int wave_min_i(int v) {
#pragma unroll
    for (int o = 1; o < 64; o <<= 1) { int w = shx(v, o); v = w < v ? w : v; }
    return v;
}
DI float sigmoidf_(float x) { return __builtin_amdgcn_rcpf(1.f + __builtin_amdgcn_exp2f(-1.4426950408889634f * x)); }
DI float gelu_tanh(float x) { const float u = 0.7978845608028654f * (x + 0.044715f * x * x * x); return x * sigmoidf_(2.f * u); }
#define WSYNC() do { asm volatile("s_waitcnt lgkmcnt(0)" ::: "memory"); __builtin_amdgcn_wave_barrier(); } while (0)

namespace pg8 {
constexpr int BM = 256, BK = 64, HALF = 128, HTB = HALF * BK * 2, NXCD = 8, WGM = 8;
__host__ __device__ __forceinline__ int lds_byte(int r, int c) { const int st = (r >> 4) * 2 + (c >> 5), rr = r & 15, cc = c & 31, ob = rr * 64 + cc * 2; return st * 1024 + (ob ^ (((ob >> 9) & 1) << 5)); }
__host__ __device__ __forceinline__ void stage_rc(int b, int& R, int& C) { const int st = b / 1024, sb = b % 1024, swz = sb ^ (((sb >> 9) & 1) << 5); R = (st >> 1) * 16 + swz / 64; C = (st & 1) * 32 + (swz % 64) / 2; }
__host__ __device__ __forceinline__ int perm32(int rho) { const int n = rho >> 4, i = rho & 15; return 8 * (i >> 2) + 4 * n + (i & 3); }
struct Unit { int pm, pn; };
struct Gemm { const bf16_t* A; const bf16_t* Bt; int M, N, K; };
struct StaticOrder {
    int nM, nN, nwg, G, c;
    __host__ __device__ void init(int M_, int N_, int G_, int c_) { nM = M_ / BM; nN = N_ / BM; nwg = nM * nN; G = G_; c = c_; }
    __host__ __device__ bool next(int i, Unit& u) const {
        const long L = (long)i * G + c; if (L >= nwg) return false;
        int wgid = (int)L; { const int q = nwg / NXCD, r = nwg % NXCD, xcd = wgid % NXCD, off = wgid / NXCD; wgid = (xcd < r ? xcd * (q + 1) : r * (q + 1) + (xcd - r) * q) + off; }
        const int nig = WGM * nN, gid = wgid / nig, fm = gid * WGM, gsz = (nM - fm) < WGM ? (nM - fm) : WGM;
        u.pm = fm + ((wgid % nig) % gsz); u.pn = (wgid % nig) / gsz; return true;
    }
    __device__ __forceinline__ void a_ready(const Unit&) const {}
    __device__ __forceinline__ void done(const Unit&) const {}
};
DI unsigned cvt_pk_bf16(float lo, float hi) { unsigned r; asm volatile("v_cvt_pk_bf16_f32 %0, %1, %2" : "=v"(r) : "v"(lo), "v"(hi)); return r; }
DI void row_stats8(float (&out)[2][4], const float* p, int row0, int fq) {
    const unsigned voff = (unsigned)(fq * M + row0) * 4u;
    float v0, v1, v2, v3, v4, v5, v6, v7;
    asm volatile("global_load_dword %0, %8, %9\n\tglobal_load_dword %1, %8, %9 offset:64\n\tglobal_load_dword %2, %8, %9 offset:128\n\tglobal_load_dword %3, %8, %9 offset:192\n\t"
                 "global_load_dword %4, %8, %9 offset:512\n\tglobal_load_dword %5, %8, %9 offset:576\n\tglobal_load_dword %6, %8, %9 offset:640\n\tglobal_load_dword %7, %8, %9 offset:704\n\ts_waitcnt vmcnt(0)"
                 : "=&v"(v0), "=&v"(v1), "=&v"(v2), "=&v"(v3), "=&v"(v4), "=&v"(v5), "=&v"(v6), "=&v"(v7) : "v"(voff), "s"(p) : "memory");
    const int l4 = lane_id() << 2;
    const float v[8] = {v0, v1, v2, v3, v4, v5, v6, v7};
#pragma unroll
    for (int i = 0; i < 8; ++i) {
        float t = v[i];
        t += __int_as_float(__builtin_amdgcn_ds_bpermute(l4 ^ 64, __float_as_int(t)));
        t += __int_as_float(__builtin_amdgcn_ds_bpermute(l4 ^ 128, __float_as_int(t)));
        out[i >> 2][i & 3] = t;
    }
}

struct EpiInProj {
    static constexpr bool PERM = true, AFTER_DRAIN = false, MIDSCALE = false; static constexpr int NST = 16;
    bf16_t* O; int ldc; const float* ssq;
    DI void operator()(const f32x4 (&acc)[2][2][4][2], const Unit& u, int wr, int wc, int fr, int fq) const {
        int row0 = u.pm * BM + wr * 64 + fr; asm volatile("" : "+v"(row0)); const int col0 = u.pn * BM + wc * 32 + 8 * fq;
        float rinvs[2][4]; row_stats8(rinvs, ssq, row0, fq);
#pragma unroll
        for (int ai = 0; ai < 2; ++ai)
#pragma unroll
            for (int m = 0; m < 4; ++m) {
                const int row = row0 + ai * HALF + m * 16;
                const float rinv = rsqrtf(rinvs[ai][m] * (1.f / DM) + EPS);
                bf16_t* rowp = O + (size_t)row * ldc + col0;
#pragma unroll
                for (int bj = 0; bj < 2; ++bj) {
                    f32x4 v0 = acc[ai][bj][m][0] * rinv, v1 = acc[ai][bj][m][1] * rinv;
                    u32x4 w; w.x = cvt_pk_bf16(v0[0], v0[1]); w.y = cvt_pk_bf16(v0[2], v0[3]); w.z = cvt_pk_bf16(v1[0], v1[1]); w.w = cvt_pk_bf16(v1[2], v1[3]);
                    *(u32x4*)(rowp + bj * HALF) = w;
                }
            }
    }
};
template <bool MS> struct EpiResid {
    static constexpr bool PERM = true, AFTER_DRAIN = false, MIDSCALE = MS; static constexpr int NST = 16;
    bf16_t* xb; float* ssq_part; const float* ssq_mid; LAS float* ssl;
    DI void midscale(f32x4 (&acc)[2][2][4][2], const Unit& u, int wr, int fr) const {
        int row0 = u.pm * BM + wr * 64 + (fr & 15); asm volatile("" : "+v"(row0)); float sm_[2][4]; row_stats8(sm_, ssq_mid, row0, fr >> 4);
#pragma unroll
        for (int ai = 0; ai < 2; ++ai)
#pragma unroll
            for (int m = 0; m < 4; ++m) { const float s = rsqrtf(sm_[ai][m] * (1.f / 256.f) + EPS);
#pragma unroll
                for (int bj = 0; bj < 2; ++bj) { acc[ai][bj][m][0] *= s; acc[ai][bj][m][1] *= s; } }
    }
    DI void operator()(const f32x4 (&acc)[2][2][4][2], const Unit& u, int wr, int wc, int fr, int fq) const {
        int rl0 = wr * 64 + fr; asm volatile("" : "+v"(rl0));
        const int col0 = u.pn * BM + wc * 32 + 8 * fq;
        u32x4 xin[2][4][2];
#pragma unroll
        for (int ai = 0; ai < 2; ++ai)
#pragma unroll
            for (int m = 0; m < 4; ++m)
#pragma unroll
                for (int bj = 0; bj < 2; ++bj) xin[ai][m][bj] = *(const u32x4*)(xb + ((size_t)u.pm * BM + rl0 + ai * HALF + m * 16) * DM + col0 + bj * HALF);
#pragma unroll
        for (int ai = 0; ai < 2; ++ai)
#pragma unroll
            for (int m = 0; m < 4; ++m) {
                const int rl = rl0 + ai * HALF + m * 16; const size_t row = (size_t)u.pm * BM + rl;
                float part = 0.f;
#pragma unroll
                for (int bj = 0; bj < 2; ++bj) {
                    u32x4* px = (u32x4*)(xb + row * DM + col0 + bj * HALF); const u32x4 xo = xin[ai][m][bj];
                    const f32x4 a0 = acc[ai][bj][m][0], a1 = acc[ai][bj][m][1];
                    const float v0 = a0[0] + bflo(xo.x), v1 = a0[1] + bfhi(xo.x), v2 = a0[2] + bflo(xo.y), v3 = a0[3] + bfhi(xo.y), v4 = a1[0] + bflo(xo.z), v5 = a1[1] + bfhi(xo.z), v6 = a1[2] + bflo(xo.w), v7 = a1[3] + bfhi(xo.w);
                    u32x4 w; w.x = cvt_pk_bf16(v0, v1); w.y = cvt_pk_bf16(v2, v3); w.z = cvt_pk_bf16(v4, v5); w.w = cvt_pk_bf16(v6, v7);
                    *px = w;
                    part += (v0 * v0 + v1 * v1) + (v2 * v2 + v3 * v3) + (v4 * v4 + v5 * v5) + (v6 * v6 + v7 * v7);
                }
                part += shx(part, 16); part += shx(part, 32);
                if (fq == 0) ssl[rl * 4 + wc] = part;
            }
        asm volatile("s_waitcnt lgkmcnt(0)" ::: "memory"); __builtin_amdgcn_s_barrier();
        int tq = tid_of(wr * 4 + wc); asm volatile("" : "+v"(tq));
        if (tq < 256) { const f32x4 p = *(const LAS f32x4*)(ssl + tq * 4); ssq_part[(size_t)u.pn * M + (size_t)u.pm * BM + tq] = (p[0] + p[1]) + (p[2] + p[3]); }
    }
};
struct EpiSwiglu {
    static constexpr bool PERM = true, AFTER_DRAIN = false, MIDSCALE = false; static constexpr int NST = 8;
    bf16_t* act; const float* ssq;
    DI void operator()(const f32x4 (&acc)[2][2][4][2], const Unit& u, int wr, int wc, int fr, int fq) const {
        int row0 = u.pm * BM + wr * 64 + fr; asm volatile("" : "+v"(row0)); const int jst = u.pn * 128 + wc * 16 + 4 * (fq & 2) + (fq & 1) * 64;
        float rinvs[2][4]; row_stats8(rinvs, ssq, row0, fq);
#pragma unroll
        for (int ai = 0; ai < 2; ++ai)
#pragma unroll
            for (int m = 0; m < 4; ++m) {
                const int row = row0 + ai * HALF + m * 16;
                const float rinv = rsqrtf(rinvs[ai][m] * (1.f / DM) + EPS);
                u32x2 w[2];
#pragma unroll
                for (int bj = 0; bj < 2; ++bj) {
                    const f32x4 g = acc[ai][bj][m][0] * rinv, up = acc[ai][bj][m][1] * rinv;
                    float a[4];
#pragma unroll
                    for (int i = 0; i < 4; ++i) a[i] = g[i] * up[i] * __builtin_amdgcn_rcpf(1.f + __builtin_amdgcn_exp2f(-1.4426950408889634f * g[i]));
                    w[bj].x = cvt_pk_bf16(a[0], a[1]); w[bj].y = cvt_pk_bf16(a[2], a[3]);
                }
                const auto rx = __builtin_amdgcn_permlane16_swap(w[0].x, w[1].x, false, false), ry = __builtin_amdgcn_permlane16_swap(w[0].y, w[1].y, false, false);
                u32x4 o; o.x = rx[0]; o.y = ry[0]; o.z = rx[1]; o.w = ry[1];
                *(u32x4*)(act + (size_t)row * FF + jst) = o;
            }
    }
};

DI void glds_sv(unsigned voff, const void* sbase, unsigned lds_dst) {
    unsigned keep;
    asm volatile("s_mov_b32 %0, m0\n\ts_mov_b32 m0, %3\n\ts_nop 0\n\tglobal_load_lds_dwordx4 %1, %2\n\ts_mov_b32 m0, %0" : "=&s"(keep) : "v"(voff), "s"(sbase), "s"(lds_dst) : "memory");
}
template <class Epi, class Sched, bool ALIGN_EPI = false, bool SP2 = false>
DI void gemm_phase(LAS unsigned char* lds, const Gemm g, const Sched& S, const Epi& E, const int wave_) {
    int wv_ = wave_; asm volatile("" : "+s"(wv_));
    int tid_ = tid_of(wv_); asm volatile("" : "+v"(tid_));
    const int tid = tid_, wid = wv_, lane = tid & 63, wr = wid >> 2, wc = wid & 3, fr = lane & 15, fq = lane >> 4;
    const int K = g.K, nt = K / BK;
    unsigned voffA[2], voffB[2];
#pragma unroll
    for (int i = 0; i < 2; ++i) { int R, C; stage_rc(tid * 16 + i * 8192, R, C); const int Rb = Epi::PERM ? ((R & ~31) + perm32(R & 31)) : R;
        voffA[i] = (unsigned)(R * K + C) * 2u; voffB[i] = (unsigned)(Rb * K + C) * 2u; }
    const size_t kstep = (size_t)(BK * 2);
    const size_t hstep = (size_t)HALF * K * 2;
    const size_t tstep = 2 * hstep;
    const unsigned ldsw = (unsigned)wid * 1024u;
    const unsigned ldsb = (unsigned)(size_t)lds + ldsw;
    const int aoff = lds_byte(wr * 64 + fr, fq * 8), boff = lds_byte(wc * 32 + fr, fq * 8);
#define PG8_SA(b, h) (((b) * 2 + (h)) * HTB)
#define PG8_SB(b, h) ((4 + (b) * 2 + (h)) * HTB)
#define PG8_STAGE(bufoff, gbase, voff) do { _Pragma("unroll") for (int _i = 0; _i < 2; ++_i) \
        glds_sv((voff)[_i], (const void*)(gbase), ldsb + (unsigned)((bufoff) + _i * 8192)); } while (0)
#define PG8_LDA(dst, b, h) do { _Pragma("unroll") for (int m = 0; m < 4; ++m) _Pragma("unroll") for (int k = 0; k < 2; ++k) dst[m][k] = *(const LAS bf16x8*)(lds + PG8_SA(b, h) + aoff + m * 2048 + k * 1024); } while (0)
#define PG8_LDB(dst, b, h) do { _Pragma("unroll") for (int n = 0; n < 2; ++n) _Pragma("unroll") for (int k = 0; k < 2; ++k) dst[n][k] = *(const LAS bf16x8*)(lds + PG8_SB(b, h) + boff + n * 2048 + k * 1024); } while (0)
#define PG8_MMA(ai, bj, At, Bt) do { __builtin_amdgcn_s_setprio(1); _Pragma("unroll") for (int m = 0; m < 4; ++m) _Pragma("unroll") for (int n = 0; n < 2; ++n) _Pragma("unroll") for (int k = 0; k < 2; ++k) \
        acc[ai][bj][m][n] = __builtin_amdgcn_mfma_f32_16x16x32_bf16(Bt[n][k], At[m][k], acc[ai][bj][m][n], 0, 0, 0); __builtin_amdgcn_s_setprio(0); } while (0)
#define PG8_WAIT_V(n) asm volatile("s_waitcnt vmcnt(" #n ")" ::: "memory")
#define PG8_WAIT_L(n) asm volatile("s_waitcnt lgkmcnt(" #n ")" ::: "memory")
#define PG8_WAIT_VF do { if constexpr (Epi::NST == 16) PG8_WAIT_V(24); else PG8_WAIT_V(16); } while (0)
#define PG8_BAR __builtin_amdgcn_s_barrier()
#define PG8_SCHED __builtin_amdgcn_sched_barrier(0)
    Unit cur, nxt; int ui = 0;
    if (!S.next(0, cur)) return;
    f32x4 acc[2][2][4][2];
#pragma unroll
    for (int a = 0; a < 2; ++a)
#pragma unroll
        for (int b = 0; b < 2; ++b)
#pragma unroll
            for (int m = 0; m < 4; ++m)
#pragma unroll
                for (int n = 0; n < 2; ++n) acc[a][b][m][n] = (f32x4){0.f, 0.f, 0.f, 0.f};
    bf16x8 At[4][2], B0[2][2], B1[2][2];
    const char* cA = (const char*)g.A + (size_t)cur.pm * tstep; const char* cB = (const char*)g.Bt + (size_t)cur.pn * tstep;
    S.a_ready(cur);
    if constexpr (SP2) {
        PG8_STAGE(PG8_SB(0, 0), cB, voffB); PG8_STAGE(PG8_SB(0, 1), cB + hstep, voffB); PG8_STAGE(PG8_SA(0, 0), cA, voffA); PG8_STAGE(PG8_SA(0, 1), cA + hstep, voffA);
        if (wr == 1) PG8_BAR;
        PG8_WAIT_V(2); PG8_BAR;
        PG8_STAGE(PG8_SB(1, 0), cB + kstep, voffB); PG8_STAGE(PG8_SA(1, 0), cA + kstep, voffA); PG8_STAGE(PG8_SB(1, 1), cB + hstep + kstep, voffB);
        PG8_WAIT_V(6); PG8_BAR;
        PG8_STAGE(PG8_SA(1, 1), cA + hstep + kstep, voffA);
#pragma unroll
        for (int i = 0; i < Epi::NST / 2; ++i) PG8_STAGE(PG8_SA(1, 1), cA + hstep + kstep, voffA);
    } else {
        PG8_STAGE(PG8_SB(0, 0), cB, voffB); PG8_STAGE(PG8_SA(0, 0), cA, voffA); PG8_STAGE(PG8_SB(0, 1), cB + hstep, voffB); PG8_STAGE(PG8_SA(0, 1), cA + hstep, voffA);
        if (wr == 1) PG8_BAR;
        PG8_WAIT_V(4); PG8_BAR;
        PG8_STAGE(PG8_SB(1, 0), cB + kstep, voffB); PG8_STAGE(PG8_SA(1, 0), cA + kstep, voffA); PG8_STAGE(PG8_SB(1, 1), cB + hstep + kstep, voffB);
        PG8_WAIT_V(6); PG8_BAR;
    }
    for (;;) {
        const bool has_next = S.next(ui + 1, nxt);
        const char* nA = has_next ? (const char*)g.A + (size_t)nxt.pm * tstep : cA; const char* nB = has_next ? (const char*)g.Bt + (size_t)nxt.pn * tstep : cB;
        static_assert(SP2, "only the SP2 schedule is kept");
#define PG8_TRIP(t, WV) do { \
            const bool last = ((t) == nt - 2); \
            const char* a2 = last ? nA : cA + (size_t)((t) + 2) * kstep; const char* b2 = last ? nB : cB + (size_t)((t) + 2) * kstep; \
            const char* a3 = a2 + kstep; const char* b3 = b2 + kstep; \
            if (last && has_next) S.a_ready(nxt); \
            PG8_LDB(B0, 0, 0); PG8_LDB(B1, 0, 1); PG8_SCHED; PG8_LDA(At, 0, 0); \
            WV; PG8_WAIT_L(0); PG8_BAR; PG8_MMA(0, 0, At, B0); PG8_MMA(0, 1, At, B1); PG8_BAR; PG8_SCHED; \
            PG8_LDA(At, 0, 1); PG8_STAGE(PG8_SB(0, 0), b2, voffB); PG8_STAGE(PG8_SB(0, 1), b2 + hstep, voffB); PG8_STAGE(PG8_SA(0, 0), a2, voffA); \
            WV; PG8_WAIT_L(0); PG8_BAR; PG8_MMA(1, 0, At, B0); PG8_MMA(1, 1, At, B1); PG8_BAR; PG8_SCHED; \
            PG8_LDB(B0, 1, 0); PG8_LDB(B1, 1, 1); PG8_SCHED; PG8_LDA(At, 1, 0); PG8_STAGE(PG8_SA(0, 1), a2 + hstep, voffA); \
            WV; PG8_WAIT_L(0); PG8_BAR; PG8_MMA(0, 0, At, B0); PG8_MMA(0, 1, At, B1); PG8_BAR; PG8_SCHED; \
            PG8_LDA(At, 1, 1); PG8_STAGE(PG8_SB(1, 0), b3, voffB); PG8_STAGE(PG8_SB(1, 1), b3 + hstep, voffB); PG8_STAGE(PG8_SA(1, 0), a3, voffA); \
            PG8_WAIT_V(8); PG8_WAIT_L(0); PG8_BAR; PG8_MMA(1, 0, At, B0); PG8_MMA(1, 1, At, B1); PG8_BAR; PG8_SCHED; \
            PG8_STAGE(PG8_SA(1, 1), a3 + hstep, voffA); } while (0)
        PG8_TRIP(0, PG8_WAIT_VF);
        for (int t = 2; t < nt; t += 2) {
            PG8_TRIP(t, PG8_WAIT_V(8));
            if constexpr (Epi::MIDSCALE) { if (t == 2) { int te = lane_id(); asm volatile("" : "+v"(te)); E.midscale(acc, cur, wr, te); } }
        }
#undef PG8_TRIP
        if constexpr (ALIGN_EPI) { if (wr == 0) PG8_BAR; }
        if constexpr (!Epi::AFTER_DRAIN) { int te = lane_id(); asm volatile("" : "+v"(te)); E(acc, cur, wr, wc, te & 15, te >> 4); S.done(cur); }
        if (!has_next) break;
#pragma unroll
        for (int a = 0; a < 2; ++a)
#pragma unroll
            for (int b = 0; b < 2; ++b)
#pragma unroll
                for (int m = 0; m < 4; ++m)
#pragma unroll
                    for (int n = 0; n < 2; ++n) acc[a][b][m][n] = (f32x4){0.f, 0.f, 0.f, 0.f};
        cur = nxt; cA = nA; cB = nB; ++ui;
        if constexpr (ALIGN_EPI) { if (wr == 1) PG8_BAR; }
    }
    PG8_WAIT_V(0);
    if constexpr (!ALIGN_EPI) { if (wr == 0) PG8_BAR; }
    PG8_BAR;
#undef PG8_SA
#undef PG8_SB
#undef PG8_STAGE
#undef PG8_LDA
#undef PG8_LDB
#undef PG8_MMA
#undef PG8_WAIT_V
#undef PG8_WAIT_L
#undef PG8_WAIT_VF
#undef PG8_BAR
#undef PG8_SCHED
}
}

#define XB_TMO      128
#define XB_XCNT(j)  (256  + 64 * (j))
#define XB_XSUB(j)  (1280 + 64 * (j))
#define XB_XGEN(j)  (2304 + 64 * (j))
#define XB_TOP      3328
#define XB_TOPGEN   3392
#define XCD_BAR_WORDS 3456
#define XB_SPIN_CAP (1u << 18)
__device__ __forceinline__ unsigned xb_ld(unsigned* p)              { return __hip_atomic_load(p, __ATOMIC_RELAXED, __HIP_MEMORY_SCOPE_AGENT); }
__device__ __forceinline__ unsigned xb_add(unsigned* p, unsigned v) { return __hip_atomic_fetch_add(p, v, __ATOMIC_RELAXED, __HIP_MEMORY_SCOPE_AGENT); }
__device__ __forceinline__ unsigned xb_xcc_id() { return (unsigned)__builtin_amdgcn_s_getreg((3 << 11) | 20) & 0xFu; }
#define XB_SPIN(cond, bar) do { unsigned _sp = 0; while (cond) { __builtin_amdgcn_s_sleep(1); \
    if ((++_sp & 255u) == 0u) { if (xb_ld(&(bar)[XB_TMO])) break; if (_sp > XB_SPIN_CAP) { atomicAdd(&(bar)[XB_TMO], 1u); break; } } } } while (0)
struct XcdBarrier { unsigned* bar; unsigned x; volatile LAS unsigned* st; };
__device__ __forceinline__ XcdBarrier xcd_barrier_post(unsigned* bar, volatile LAS unsigned* st, const int tidx) {
    XcdBarrier b; b.bar = bar; b.x = xb_xcc_id(); b.st = st;
    if (tidx == 0) (void)xb_add(&bar[XB_XCNT(b.x)], 1u);
    return b;
}
__device__ __forceinline__ void xcd_barrier_complete(unsigned* bar, unsigned x, unsigned& nloc, unsigned& nx) {
    const unsigned G = gridDim.x * gridDim.y * gridDim.z;
    unsigned sum, cnt, mine, sp = 0u;
    for (;;) {
        sum = 0u; cnt = 0u; mine = 0u;
#pragma unroll
        for (unsigned j = 0; j < 16; ++j) { const unsigned c = xb_ld(&bar[XB_XCNT(j)]); sum += c; cnt += (c > 0u) ? 1u : 0u; mine = (j == x) ? c : mine; }
        if (sum == G) break;
        __builtin_amdgcn_s_sleep(1);
        if ((++sp & 255u) == 0u) { if (xb_ld(&bar[XB_TMO])) break; if (sp > XB_SPIN_CAP) { atomicAdd(&bar[XB_TMO], 1u); break; } }
    }
    nloc = mine > 0u ? mine : 1u; nx = cnt > 0u ? cnt : 1u;
}
__device__ __forceinline__ void xcd_barrier(const XcdBarrier& b, const int tidx) {
    asm volatile("s_waitcnt vmcnt(0)" ::: "memory");
    __syncthreads();
    if (tidx == 0) {
        unsigned* bar = b.bar;
        __builtin_amdgcn_s_waitcnt(0);
        unsigned nloc = b.st[0], nx = b.st[1];
        if (nloc == 0u) { xcd_barrier_complete(bar, b.x, nloc, nx); b.st[0] = nloc; b.st[1] = nx; }
        const unsigned old = xb_add(&bar[XB_XSUB(b.x)], 1u);
        const unsigned gen = old / nloc;
        if (old + 1u == (gen + 1u) * nloc) {
            __builtin_amdgcn_fence(__ATOMIC_RELEASE, "agent");
            asm volatile("s_waitcnt vmcnt(0)" ::: "memory");
            const unsigned og = xb_add(&bar[XB_TOP], 1u);
            const unsigned tg = og / nx;
            if (og + 1u == (tg + 1u) * nx) xb_add(&bar[XB_TOPGEN], 1u);
            else XB_SPIN(xb_ld(&bar[XB_TOPGEN]) == tg, bar);
            __builtin_amdgcn_fence(__ATOMIC_ACQUIRE, "agent");
            xb_add(&bar[XB_XGEN(b.x)], 1u);
            asm volatile("s_waitcnt vmcnt(0)" ::: "memory");
        } else {
            XB_SPIN(xb_ld(&bar[XB_XGEN(b.x)]) == gen, bar);
            __builtin_amdgcn_fence(__ATOMIC_ACQUIRE, "agent");
            asm volatile("s_waitcnt vmcnt(0)" ::: "memory");
        }
    }
    __syncthreads();
}

template <int MAP>
DI int colmap(int v, int Nsrc) {
    if (MAP == 0) return v < Nsrc ? v : -1;
    const int g8 = v >> 3, e = v & 7, j = 4 * g8 + (e & 3); return (e < 4) ? j : FF + j;
}
template <int MAP, int KROT = 0>
DI void p0_transpose_item64(const float* W, int K, int Nsrc, const float* gain, bf16_t* WT, LAS float* scr, int kb, int nb, int lane) {
    const int k0 = 64 * kb, n0 = 64 * nb, v = n0 + 4 * (lane & 15);
    const int sc = MAP == 0 ? (v < Nsrc ? v : -1) : ((v >> 3) * 4 + ((v >> 2) & 1) * FF);
#pragma unroll 4
    for (int i = 0; i < 16; ++i) { const int kk = 4 * i + (lane >> 4); int ksrc = k0 + kk + KROT; if (KROT && ksrc >= K) ksrc -= K; f32x4 w = {0.f, 0.f, 0.f, 0.f}; if (sc >= 0) w = *(const f32x4*)(W + (size_t)ksrc * Nsrc + sc); if (gain) w = w * gain[ksrc];
        LAS float* d = scr + kk * 65 + 4 * (lane & 15); d[0] = w[0]; d[1] = w[1]; d[2] = w[2]; d[3] = w[3]; }
    WSYNC();
    const int c = lane & 7;
#pragma unroll
    for (int j = 0; j < 8; ++j) { const int n = (lane >> 3) + 8 * j; const LAS float* s = scr + (8 * c) * 65 + n;
        u32x4 o; o.x = pk2(s[0 * 65], s[1 * 65]); o.y = pk2(s[2 * 65], s[3 * 65]); o.z = pk2(s[4 * 65], s[5 * 65]); o.w = pk2(s[6 * 65], s[7 * 65]);
        *(u32x4*)(WT + (size_t)(n0 + n) * K + k0 + 8 * c) = o; }
    WSYNC();
}
template <int MAP, int KROT = 0>
DI void p0_transpose_item(const float* W, int K, int Nsrc, const float* gain, bf16_t* WT, LAS float* scr, int kb, int nb, int lane) {
    const int k0 = 64 * kb, n0 = 32 * nb;
    const int sc = colmap<MAP>(n0 + (lane & 31), Nsrc);
#pragma unroll 8
    for (int i = 0; i < 32; ++i) { const int kk = 2 * i + (lane >> 5); int ksrc = k0 + kk + KROT; if (KROT && ksrc >= K) ksrc -= K; float w = 0.f; if (sc >= 0) w = W[(size_t)ksrc * Nsrc + sc]; if (gain) w *= gain[ksrc]; scr[kk * 33 + (lane & 31)] = w; }
    WSYNC();
    const int c = lane & 7;
#pragma unroll
    for (int j = 0; j < 4; ++j) { const int n = (lane >> 3) + 8 * j; const LAS float* s = scr + (8 * c) * 33 + n;
        u32x4 o; o.x = pk2(s[0 * 33], s[1 * 33]); o.y = pk2(s[2 * 33], s[3 * 33]); o.z = pk2(s[4 * 33], s[5 * 33]); o.w = pk2(s[6 * 33], s[7 * 33]);
        *(u32x4*)(WT + (size_t)(n0 + n) * K + k0 + 8 * c) = o; }
    WSYNC();
}


typedef float f32x16 __attribute__((ext_vector_type(16)));
typedef float f32x2v __attribute__((ext_vector_type(2)));
typedef __bf16 bf16x2_t __attribute__((ext_vector_type(2)));
constexpr int KSTR = 208, VSTR = 136;
constexpr int VSTP = 144;
constexpr int AL_K0 = 0, AL_K1 = 64 * KSTR, AL_V0 = 2 * 64 * KSTR, AL_V1 = AL_V0 + 64 * VSTP, AL_IMP = 45056, AL_SELM = AL_IMP + 32768, AL_OACC = AL_SELM + 1024;
constexpr float NEGB = -1e30f, LOG2E = 1.4426950408889634f;
DI unsigned cvtpk(float lo, float hi) { f32x2v v = {lo, hi}; bf16x2_t b = __builtin_convertvector(v, bf16x2_t); return __builtin_bit_cast(unsigned, b); }
DI f32x16 mfma32(bf16x8 a, bf16x8 b, f32x16 c) { return __builtin_amdgcn_mfma_f32_32x32x16_bf16(a, b, c, 0, 0, 0); }
DI float xhalf_max(float v) { auto rr = __builtin_amdgcn_permlane32_swap(__float_as_uint(v), __float_as_uint(v), false, false); return fmaxf(__uint_as_float(rr[0]), __uint_as_float(rr[1])); }
DI float xhalf_sum(float v) { auto rr = __builtin_amdgcn_permlane32_swap(__float_as_uint(v), __float_as_uint(v), false, false); return __uint_as_float(rr[0]) + __uint_as_float(rr[1]); }
DI float ex2(float x) { return __builtin_amdgcn_exp2f(x); }
template <int KSTEPS>
DI void qk_tile(const LAS unsigned char* Kt, const bf16x8 (&qf)[KSTEPS], int r32, int hi, f32x16& s0, f32x16& s1) {
    const LAS unsigned char* p0 = Kt + r32 * KSTR + hi * 16;
#pragma unroll
    for (int i = 0; i < 16; ++i) { s0[i] = 0.f; s1[i] = 0.f; }
#pragma unroll
    for (int ks = 0; ks < KSTEPS; ++ks) {
        const bf16x8 a0 = *(const LAS bf16x8*)(p0 + ks * 32), a1 = *(const LAS bf16x8*)(p0 + 32 * KSTR + ks * 32);
        s0 = mfma32(a0, qf[ks], s0); s1 = mfma32(a1, qf[ks], s1);
    }
}
DI void mask_tile(f32x16& s0, f32x16& s1, int klo, int khi, int hi) {
    const int lo_ = klo - 4 * hi, hi_ = khi - 4 * hi;
#pragma unroll
    for (int i = 0; i < 16; ++i) { const int kb = (i & 3) + 8 * (i >> 2); if (kb < lo_ || kb > hi_) s0[i] = NEGB; if (kb + 32 < lo_ || kb + 32 > hi_) s1[i] = NEGB; }
}
DI float tile_max(const f32x16& s0, const f32x16& s1) {
    float mx = fmaxf(s0[0], s1[0]);
#pragma unroll
    for (int i = 1; i < 16; ++i) mx = fmaxf(mx, fmaxf(s0[i], s1[i]));
    return xhalf_max(mx);
}
template <int BASE> DI bf16x8 pack8(const f32x16& s) { u32x4 p; p.x = cvtpk(s[BASE], s[BASE + 1]); p.y = cvtpk(s[BASE + 2], s[BASE + 3]); p.z = cvtpk(s[BASE + 4], s[BASE + 5]); p.w = cvtpk(s[BASE + 6], s[BASE + 7]); return __builtin_bit_cast(bf16x8, p); }
DI bf16x8 ld8x2(const bf16_t* p) { const u32x2 a = *(const u32x2*)p, b = *(const u32x2*)(p + 4); u32x4 w; w.x = a.x; w.y = a.y; w.z = b.x; w.w = b.y; return __builtin_bit_cast(bf16x8, w); }
DI bf16x8 vfrag(const LAS unsigned char* p) { const u32x2 a = *(const LAS u32x2*)p, b = *(const LAS u32x2*)(p + 16); u32x4 w; w.x = a.x; w.y = a.y; w.z = b.x; w.w = b.y; return __builtin_bit_cast(bf16x8, w); }
template <int VS = VSTP>
DI void pv_tile(const f32x16& s0, const f32x16& s1, const LAS unsigned char* Vt, f32x16 (&o)[2], int r32, int hi) {
    const bf16x8 p00 = pack8<0>(s0), p01 = pack8<8>(s0), p10 = pack8<0>(s1), p11 = pack8<8>(s1);
#pragma unroll
    for (int dt = 0; dt < 2; ++dt) { const LAS unsigned char* vp = Vt + (32 * dt + r32) * VS + 16 * hi;
        o[dt] = mfma32(*(const LAS bf16x8*)vp, p00, o[dt]); o[dt] = mfma32(*(const LAS bf16x8*)(vp + 32), p01, o[dt]); o[dt] = mfma32(*(const LAS bf16x8*)(vp + 64), p10, o[dt]); o[dt] = mfma32(*(const LAS bf16x8*)(vp + 96), p11, o[dt]); }
}
DI void softmax_pv(f32x16& s0, f32x16& s1, const LAS unsigned char* Vt, f32x16 (&o)[2], float& m, float& l, int r32, int hi) {
    const float mx = tile_max(s0, s1), mn = fmaxf(m, mx), ms = mn < -1e29f ? 0.f : mn, alpha = ex2(m - ms);
    m = mn; float psum = 0.f;
#pragma unroll
    for (int i = 0; i < 16; ++i) { s0[i] = ex2(s0[i] - ms); s1[i] = ex2(s1[i] - ms); psum += s0[i] + s1[i]; }
    l = l * alpha + psum;
    if (!__all(alpha == 1.f)) {
#pragma unroll
        for (int i = 0; i < 16; ++i) { o[0][i] *= alpha; o[1][i] *= alpha; } }
    pv_tile(s0, s1, Vt, o, r32, hi);
}
struct SoftState { float m, l; };
constexpr float SM_THR = 8.f;
DI void soft_init(SoftState& S, f32x16 (&o)[2]) { S.m = 0.f; S.l = 0.f;
#pragma unroll
    for (int i = 0; i < 16; ++i) { o[0][i] = 0.f; o[1][i] = 0.f; } }
DI f32x16 bcast16(float v) { f32x16 c;
#pragma unroll
    for (int i = 0; i < 16; ++i) c[i] = v;
    return c; }
DI float max3f(float a, float b, float c) { float r; asm("v_max3_f32 %0, %1, %2, %3" : "=v"(r) : "v"(a), "v"(b), "v"(c)); return r; }
template <int VS>
DI void load_vfrags(const LAS unsigned char* Vt, bf16x8 (&vfr)[2][4], int r32, int hi) {
#pragma unroll
    for (int dt = 0; dt < 2; ++dt) { const LAS unsigned char* vp = Vt + (32 * dt + r32) * VS + 16 * hi;
#pragma unroll
        for (int s = 0; s < 4; ++s) vfr[dt][s] = *(const LAS bf16x8*)(vp + 32 * s); }
}
DI void pv_regs(const f32x16& s0, const f32x16& s1, const bf16x8 (&vfr)[2][4], f32x16 (&o)[2]) {
    const bf16x8 p00 = pack8<0>(s0), p01 = pack8<8>(s0), p10 = pack8<0>(s1), p11 = pack8<8>(s1);
#pragma unroll
    for (int dt = 0; dt < 2; ++dt) { o[dt] = mfma32(vfr[dt][0], p00, o[dt]); o[dt] = mfma32(vfr[dt][1], p01, o[dt]); o[dt] = mfma32(vfr[dt][2], p10, o[dt]); o[dt] = mfma32(vfr[dt][3], p11, o[dt]); }
}
DI float soft_update(f32x16& s0, f32x16& s1, SoftState& S, f32x16 (&o)[2], bool masked, int klo, int khi, bool first, int hi, float adj = 0.f) {
    if (__any(adj != 0.f)) {
#pragma unroll
        for (int i = 0; i < 16; ++i) { s0[i] -= adj; s1[i] -= adj; } }
    float dl_ret = 0.f;
    if (__builtin_expect(masked, 0)) { asm volatile("; boundary tile mask" ::: "memory"); mask_tile(s0, s1, klo, khi, hi); }
    asm volatile("s_nop 15\n\ts_nop 7" : "+v"(s0), "+v"(s1));
    float rm;
    { float a = max3f(s0[0], s0[1], s0[2]), b = max3f(s1[0], s1[1], s1[2]);
#pragma unroll
      for (int i = 3; i < 15; i += 2) { a = max3f(a, s0[i], s0[i + 1]); b = max3f(b, s1[i], s1[i + 1]); }
      rm = xhalf_max(fmaxf(max3f(a, b, s0[15]), s1[15])); }
    if (first) {
        const float dl = rm < -1e29f ? 0.f : rm; S.m = dl; dl_ret = dl;
#pragma unroll
        for (int i = 0; i < 16; ++i) { s0[i] -= dl; s1[i] -= dl; }
    } else if (__any(rm > SM_THR)) {
        const float dl = fmaxf(rm, 0.f), alpha = ex2(-dl); S.m += dl; S.l *= alpha; dl_ret = dl;
#pragma unroll
        for (int i = 0; i < 16; ++i) { s0[i] -= dl; s1[i] -= dl; o[0][i] *= alpha; o[1][i] *= alpha; }
    }
    float p0 = 0.f, p1 = 0.f, p2 = 0.f, p3 = 0.f;
#pragma unroll
    for (int i = 0; i < 16; i += 2) { s0[i] = ex2(s0[i]); s0[i + 1] = ex2(s0[i + 1]); s1[i] = ex2(s1[i]); s1[i + 1] = ex2(s1[i + 1]); p0 += s0[i]; p1 += s0[i + 1]; p2 += s1[i]; p3 += s1[i + 1]; }
    S.l += (p0 + p1) + (p2 + p3);
    return dl_ret;
}
template <int KSTEPS, int VS = VSTP, bool VPREF = false>
DI void attn_step(const LAS unsigned char* Kt, const LAS unsigned char* Vt, const bf16x8 (&qf)[KSTEPS], SoftState& S, f32x16 (&o)[2], bool masked, int klo, int khi, bool first, int r32, int hi) {
    const f32x16 cinit = bcast16(-S.m); f32x16 s0 = cinit, s1 = cinit;
    { const LAS unsigned char* p0 = Kt + r32 * KSTR + hi * 16;
#pragma unroll
      for (int ks = 0; ks < KSTEPS; ++ks) { const bf16x8 a0 = *(const LAS bf16x8*)(p0 + ks * 32), a1 = *(const LAS bf16x8*)(p0 + 32 * KSTR + ks * 32);
          s0 = mfma32(a0, qf[ks], s0); s1 = mfma32(a1, qf[ks], s1); } }
    if constexpr (VPREF) { bf16x8 vfr[2][4]; load_vfrags<VS>(Vt, vfr, r32, hi); __builtin_amdgcn_sched_barrier(0);
        soft_update(s0, s1, S, o, masked, klo, khi, first, hi);
        __builtin_amdgcn_sched_barrier(0);
        pv_regs(s0, s1, vfr, o); }
    else { soft_update(s0, s1, S, o, masked, klo, khi, first, hi); pv_tile<VS>(s0, s1, Vt, o, r32, hi); }
}
template <int KSTEPS, int VS>
DI void attn_step2(const LAS unsigned char* Kt, const LAS unsigned char* Vt, const bf16x8 (&qf)[KSTEPS], SoftState& S, f32x16 (&o)[2], bool masked0, int khi0, bool masked1, int khi1, bool first, int r32, int hi) {
    const f32x16 cinit = bcast16(-S.m); f32x16 a0 = cinit, a1 = cinit, b0 = cinit, b1 = cinit;
    { const LAS unsigned char* p0 = Kt + r32 * KSTR + hi * 16;
#pragma unroll
      for (int ks = 0; ks < KSTEPS; ++ks) { const bf16x8 k0 = *(const LAS bf16x8*)(p0 + ks * 32), k1 = *(const LAS bf16x8*)(p0 + 32 * KSTR + ks * 32);
          a0 = mfma32(k0, qf[ks], a0); a1 = mfma32(k1, qf[ks], a1); }
#pragma unroll
      for (int ks = 0; ks < KSTEPS; ++ks) { const bf16x8 k0 = *(const LAS bf16x8*)(p0 + 64 * KSTR + ks * 32), k1 = *(const LAS bf16x8*)(p0 + 96 * KSTR + ks * 32);
          b0 = mfma32(k0, qf[ks], b0); b1 = mfma32(k1, qf[ks], b1); } }
    bf16x8 vfr[2][4]; load_vfrags<VS>(Vt, vfr, r32, hi); __builtin_amdgcn_sched_barrier(0);
    const float dl0 = soft_update(a0, a1, S, o, masked0, 0, khi0, first, hi);
    __builtin_amdgcn_sched_barrier(0);
    pv_regs(a0, a1, vfr, o);
    __builtin_amdgcn_sched_barrier(0);
    load_vfrags<VS>(Vt + 128, vfr, r32, hi); __builtin_amdgcn_sched_barrier(0);
    (void)soft_update(b0, b1, S, o, masked1, 0, khi1, false, hi, dl0);
    __builtin_amdgcn_sched_barrier(0);
    pv_regs(b0, b1, vfr, o);
}
struct StageRegs { u32x4 a, b, c, d, e; };
template <class LoadF, class StoreF, class StepF>
DI void attn_pipeline(const int wave_, int jbeg, int jend, LoadF ld, StoreF st, StepF step) {
    if (jbeg > jend) return;
    StageRegs RA;
    ld(jbeg, RA); st(0, RA); __syncthreads();
    for (int j = jbeg; j <= jend; j += 2) {
        if (j + 1 <= jend) ld(j + 1, RA);
        step(j, 0);
        if (j + 1 <= jend) st(1, RA);
        __syncthreads();
        if (STAGGER && wave_ >= 4) __builtin_amdgcn_s_sleep(STAGGER);
        if (j + 1 > jend) break;
        if (j + 2 <= jend) ld(j + 2, RA);
        step(j + 1, 1);
        if (j + 2 <= jend) st(0, RA);
        __syncthreads();
        if (STAGGER && wave_ >= 4) __builtin_amdgcn_s_sleep(STAGGER);
    }
}
#define AS_GLOBAL(T, p) ((T*)(__attribute__((address_space(1))) T*)(p))
DI const float* inp(const Args& a, int k) { asm volatile("" : "+s"(k)); return AS_GLOBAL(const float, a.in[k]); }
__global__ void __launch_bounds__(NTHR, 2) fwd(Args args) {
    extern __shared__ __attribute__((aligned(16))) unsigned char lds_raw[];
    LAS unsigned char* lds = (LAS unsigned char*)lds_raw;
    LAS float* ldsf = (LAS float*)lds;
    volatile LAS unsigned* LCTL = (volatile LAS unsigned*)(lds + LDS_CTL);
    const int wave = __builtin_amdgcn_readfirstlane((int)threadIdx.x >> 6);
    const int G = gridDim.x, bid = blockIdx.x;
#define LAUNDER_TID() int tid = tid_of(wave); asm volatile("" : "+v"(tid)); const int lane = tid & 63; (void)lane
#define WS_PTRS() __attribute__((address_space(1))) unsigned char* wsg_ = (__attribute__((address_space(1))) unsigned char*)args.ws; asm volatile("" : "+s"(wsg_)); unsigned char* ws = (unsigned char*)wsg_; float* const out_ = AS_GLOBAL(float, args.out); \
    unsigned* ctl = (unsigned*)(ws + WS_CTL); float* ssp_base = (float*)(ws + WS_SSP); float* hb = (float*)(ws + WS_HB); \
    bf16_t* XB = (bf16_t*)(ws + WS_XB); bf16_t* Y = (bf16_t*)(ws + WS_Y); bf16_t* PB = (bf16_t*)(ws + WS_PB); bf16_t* ACT = (bf16_t*)(ws + WS_ACT); \
    const float2* cs64 = (const float2*)(ws + WS_CS64); const float2* cs32 = (const float2*)(ws + WS_CS32); \
    float* LRA = out_; float* LRU_ = out_ + (size_t)M * 256; \
    float* LA = (float*)(ws + WS_LA); float* LH = (float*)(ws + WS_LH); float* CIN = (float*)(ws + WS_CIN); \
    float* KVC = (float*)(ws + WS_KVC); float* DEC = (float*)(ws + WS_DEC); float* SST = (float*)(ws + WS_SST); \
    bf16_t* MQ = (bf16_t*)(ws + WS_MQ); bf16_t* MKN = (bf16_t*)(ws + WS_MKN); bf16_t* MVT = (bf16_t*)(ws + WS_MV); bf16_t* MKR = (bf16_t*)(ws + WS_MKR); \
    bf16_t* VST = (bf16_t*)(ws + WS_VST); bf16_t* KSF = (bf16_t*)(ws + WS_KSF); (void)KSF; bf16_t* VWT = (bf16_t*)(ws + WS_VWT); bf16_t* KCMPB = (bf16_t*)(ws + WS_KCMPB); bf16_t* VCMPT = (bf16_t*)(ws + WS_VCMPT); \
    const float* ssq_mix = ssp_base + (size_t)(l_ == 0 ? 0 : 2) * 4 * M; float* ssq_out = ssp_base + (size_t)(1 + 3 * l_) * 4 * M; float* ssq_down = ssp_base + (size_t)(2 + 3 * l_) * 4 * M; float* ssq_d = ssp_base + (size_t)(3 + 3 * l_) * 4 * M; \
    (void)ctl; (void)hb; (void)XB; (void)Y; (void)PB; (void)ACT; (void)cs64; (void)cs32; (void)LRA; (void)LRU_; (void)LA; (void)LH; (void)CIN; (void)KVC; (void)DEC; (void)SST; (void)MQ; (void)MKN; (void)MVT; (void)MKR; (void)VST; (void)VWT; (void)KCMPB; (void)VCMPT; (void)ssq_mix; (void)ssq_out; (void)ssq_down; (void)ssq_d
    unsigned* ctl0 = (unsigned*)(AS_GLOBAL(unsigned char, args.ws) + WS_CTL);
    { LAUNDER_TID(); if (tid < 16) LCTL[tid] = 0u; }
    __syncthreads();
    const int lo = args.ph_lo, hi = args.ph_hi;
    XcdBarrier bar; bar.bar = ctl0 + CW_BAR; bar.x = 0; bar.st = LCTL;
    if (hi - lo > 1) bar = xcd_barrier_post(ctl0 + CW_BAR, LCTL, tid_of(wave));
#define IN(k) (lo <= (k) && (k) < hi)
#define SEAM(k) do { if (IN(k) && IN((k) + 1)) { XcdBarrier b_ = bar; asm volatile("" : "+s"(b_.bar), "+s"(b_.x)); xcd_barrier(b_, tid_of(wave)); } } while (0)

    if (IN(0)) {
        const int l_ = 0; WS_PTRS();
      _Pragma("unroll 1") for (int rep = 0; rep < REP_P0; ++rep) {
        LAUNDER_TID();
        const int gw = bid * 8 + wave, NGW = G * 8;
        LAS float* scr = ldsf + wave * 4224; LAS float* scr64 = scr;
        constexpr int I_IN = 16 * 36, I_OUT = 16 * 16, I_GU = 16 * 88, I_DN = 44 * 16, I_L = I_IN + I_OUT + I_GU + I_DN;
        for (int it = gw; it < 2 * I_L; it += NGW) {
            const int l = it / I_L; int r = it % I_L;
            if (r < I_IN) { p0_transpose_item64<0>(inp(args, 3) + (size_t)l * DM * NINS, DM, NINS, inp(args, 2) + l * DM, (bf16_t*)(ws + WS_WIN) + (size_t)l * NIN * DM, scr64, r / 36, r % 36, lane); continue; } r -= I_IN;
            if (r < I_OUT) { p0_transpose_item64<0, 768>(inp(args, 23) + (size_t)l * DM * DM, DM, DM, inp(args, 22) + l * DM, (bf16_t*)(ws + WS_WOUT) + (size_t)l * DM * DM, scr64, r / 16, r % 16, lane); continue; } r -= I_OUT;
            if (r < I_GU) { p0_transpose_item64<1>(inp(args, 25) + (size_t)l * DM * NGU, DM, NGU, inp(args, 24) + l * DM, (bf16_t*)(ws + WS_WGU) + (size_t)l * NGU * DM, scr64, r / 88, r % 88, lane); continue; } r -= I_GU;
            p0_transpose_item64<0>(inp(args, 26) + (size_t)l * FF * DM, FF, DM, nullptr, (bf16_t*)(ws + WS_WDN) + (size_t)l * DM * FF, scr64, r / 16, r % 16, lane);
        }
        { constexpr int I_UQ = 3 * 12, I_UKV = 2 * 16, I_W1 = 32 * 8, I_W2 = 4 * 2, I_S = 2 * I_UQ + 2 * I_UKV + 4 * I_W1 + 4 * I_W2;
          for (int it = gw; it < I_S; it += NGW) { int r = it;
              if (r < 2 * I_UQ) { const int l = r / I_UQ; r %= I_UQ; p0_transpose_item<0>(inp(args, 20) + (size_t)l * 192 * 384, 192, 384, inp(args, 18) + l * 192, (bf16_t*)(ws + WS_WUQT) + (size_t)l * 384 * 192, scr, r / 12, r % 12, lane); continue; } r -= 2 * I_UQ;
              if (r < 2 * I_UKV) { const int l = r / I_UKV; r %= I_UKV; p0_transpose_item<0>(inp(args, 21) + (size_t)l * 128 * 512, 128, 512, inp(args, 19) + l * 128, (bf16_t*)(ws + WS_WUKVT) + (size_t)l * 512 * 128, scr, r / 16, r % 16, lane); continue; } r -= 2 * I_UKV;
              if (r < 4 * I_W1) { const int lj = r / I_W1; r %= I_W1; p0_transpose_item<0>(inp(args, 12) + (size_t)lj * 2048 * 256, 2048, 256, nullptr, (bf16_t*)(ws + WS_W1T) + (size_t)lj * 256 * 2048, scr, r / 8, r % 8, lane); continue; } r -= 4 * I_W1;
              { const int lj = r / I_W2; r %= I_W2; p0_transpose_item<0>(inp(args, 14) + (size_t)lj * 256 * 64, 256, 64, nullptr, (bf16_t*)(ws + WS_W2T) + (size_t)lj * 64 * 256, scr, r / 2, r % 2, lane); } } }
        for (int e = bid * NTHR + tid; e < 2 * 2 * 4 * 64 * 64; e += G * NTHR) {
            const int k = e & 63, n = (e >> 6) & 63, h = (e >> 12) & 3, g = (e >> 14) & 1, l = e >> 15;
            ((bf16_t*)(ws + WS_WGT))[e] = f2bf((g == 0 ? inp(args, 6) : inp(args, 8))[(((size_t)l * 4 + h) * 64 + k) * 64 + n]); }
        for (int e = bid * NTHR + tid; e < 512; e += G * NTHR) ((float*)(ws + WS_SP))[e] = log1pf(expf(-inp(args, 10)[e]));
        for (int m = gw; m < M; m += NGW) {
            const f32x4* xr = (const f32x4*)(inp(args, 0) + (size_t)m * DM) + lane;
            f32x4 v[4]; float s = 0.f;
#pragma unroll
            for (int j = 0; j < 4; ++j) { v[j] = xr[64 * j]; s += v[j][0] * v[j][0] + v[j][1] * v[j][1] + v[j][2] * v[j][2] + v[j][3] * v[j][3]; }
            s = wave_sum(s);
            u32x2* o8 = (u32x2*)(XB + (size_t)m * DM) + lane;
#pragma unroll
            for (int j = 0; j < 4; ++j) { u32x2 w; w.x = pk2(v[j][0], v[j][1]); w.y = pk2(v[j][2], v[j][3]); o8[64 * j] = w; }
            if (lane < 4) ssp_base[(size_t)lane * M + m] = lane == 0 ? s : 0.f;
        }
        for (int e = bid * NTHR + tid; e < M * 32; e += G * NTHR) {
            const int m = e >> 5, i = e & 31; const float pos = (float)((const int*)inp(args, 1))[m];
            const float invf = __builtin_amdgcn_exp2f(-(float)(2 * i) * (13.287712379549449f / 64.f)); float sn, cs; { float rv = pos * invf * 0.15915494309189535f; rv -= floorf(rv); sn = __builtin_amdgcn_sinf(rv); cs = __builtin_amdgcn_cosf(rv); }
            ((float2*)(ws + WS_CS64))[e] = make_float2(cs, sn);
            if (i < 16) { const float invf2 = __builtin_amdgcn_exp2f(-(float)(2 * i) * (13.287712379549449f / 32.f)); float rv = pos * invf2 * 0.15915494309189535f; rv -= floorf(rv); sn = __builtin_amdgcn_sinf(rv); cs = __builtin_amdgcn_cosf(rv); ((float2*)(ws + WS_CS32))[m * 16 + i] = make_float2(cs, sn); }
        }
        for (int e = bid * NTHR + tid; e < 2 * 2 * 256; e += G * NTHR) {
            const int lj = e >> 8, c = e & 255; float a = inp(args, 13)[e];
            const float* pp = inp(args, 11) + (size_t)lj * 2048; const float* w1 = inp(args, 12) + (size_t)lj * 2048 * 256 + c;
            for (int i = 0; i < 2048; ++i) a += pp[i] * w1[(size_t)i * 256];
            hb[e] = a;
        }
      }
    }
    SEAM(0);

    for (int l = 0; l < 2; ++l) {
        const int pb = 1 + 6 * l;
        if (IN(pb)) {
        const int l_ = l; WS_PTRS();
            pg8::Gemm g{XB, (const bf16_t*)(ws + WS_WIN) + (size_t)l * NIN * DM, M, NIN, DM}; pg8::StaticOrder S; S.init(M, NIN, G, bid);
            pg8::EpiInProj E{PB, NIN, ssq_mix};
            _Pragma("unroll 1") for (int rep = 0; rep < REP_G16; ++rep) pg8::gemm_phase<pg8::EpiInProj, pg8::StaticOrder, true, true>(lds, g, S, E, wave);
        }
        SEAM(pb);
        if (IN(pb + 1)) {
        const int l_ = l; WS_PTRS();
        LAUNDER_TID();
            constexpr int N_J1 = 1024, N_J2 = 512, N_J3 = 512, N_J4 = 512, N_J4B = 128;
            {
            for (int r_ = bid; r_ < N_J4B * REP_J4B; r_ += G) { const int r = r_ % N_J4B;
                    const int j = r & 1, g32 = (r >> 1) & 15, b = r >> 5; const int colb = j == 0 ? C_KC : C_VC; const int r32 = lane & 31, hi = lane >> 5;
                    LAS unsigned char* Tl = lds;
                    LAS unsigned char* Hl = lds + 69632;
                    for (int e = tid; e < 528 * 8; e += NTHR) { const int rr = e >> 3, c8 = e & 7, t = 512 * g32 + rr; u32x4 w = {0u, 0u, 0u, 0u};
                        if (t < SEQ) { const bf16_t* pr = PB + ((size_t)b * SEQ + t) * NIN + colb;
                            if (j == 0) { const u32x4 a = *(const u32x4*)(pr + 8 * (c8 & 3)), c = *(const u32x4*)(pr + 32 + 8 * (c8 & 3)); const float2* cs = cs64 + ((size_t)b * SEQ + t) * 32 + 8 * (c8 & 3);
                                const unsigned au[4] = {a.x, a.y, a.z, a.w}, cu[4] = {c.x, c.y, c.z, c.w}; unsigned ou[4];
#pragma unroll
                                for (int q = 0; q < 4; ++q) { const float2 s0 = cs[2 * q], s1 = cs[2 * q + 1]; const float x1a = bflo(au[q]), x1b = bfhi(au[q]), x2a = bflo(cu[q]), x2b = bfhi(cu[q]);
                                    ou[q] = c8 < 4 ? pk2(x1a * s0.x - x2a * s0.y, x1b * s1.x - x2b * s1.y) : pk2(x2a * s0.x + x1a * s0.y, x2b * s1.x + x1b * s1.y); }
                                w.x = ou[0]; w.y = ou[1]; w.z = ou[2]; w.w = ou[3]; }
                            else w = *(const u32x4*)(pr + 8 * c8); }
                        *(LAS u32x4*)(Tl + rr * 128 + (rr >> 4) * 16 + c8 * 16) = w; }
                    __syncthreads();
                    { const bf16_t* w1t = (const bf16_t*)(ws + WS_W1T) + ((size_t)(l * 2 + j) * 256 + 32 * wave + r32) * 2048 + 8 * hi;
                      f32x16 acc;
#pragma unroll
                      for (int i = 0; i < 16; ++i) acc[i] = 0.f;
#pragma unroll 16
                      for (int kk = 0; kk < 128; ++kk) { const int rowt = 16 * r32 + (kk >> 2);
                          const bf16x8 a = *(const LAS bf16x8*)(Tl + rowt * 128 + (rowt >> 4) * 16 + 32 * (kk & 3) + 16 * hi);
                          const bf16x8 bw = *(const bf16x8*)(w1t + 16 * kk);
                          acc = mfma32(a, bw, acc); }
                      const float hbv = hb[(l * 2 + j) * 256 + 32 * wave + r32];
#pragma unroll
                      for (int i = 0; i < 16; ++i) { const int n = (i & 3) + 8 * (i >> 2) + 4 * hi; *(LAS bf16_t*)(Hl + n * 528 + (32 * wave + r32) * 2) = f2bf(gelu_tanh(acc[i] + hbv)); } }
                    __syncthreads();
                    if (wave < 2) { const bf16_t* w2t = (const bf16_t*)(ws + WS_W2T) + ((size_t)(l * 2 + j) * 64 + 32 * wave + r32) * 256 + 8 * hi;
                      f32x16 acc;
#pragma unroll
                      for (int i = 0; i < 16; ++i) acc[i] = 0.f;
#pragma unroll
                      for (int kk = 0; kk < 16; ++kk) { const bf16x8 a = *(const LAS bf16x8*)(Hl + r32 * 528 + 32 * kk + 16 * hi); const bf16x8 bw = *(const bf16x8*)(w2t + 16 * kk); acc = mfma32(a, bw, acc); }
                      const int dd = 32 * wave + r32;
#pragma unroll
                      for (int g = 0; g < 4; ++g) { const int n0 = 32 * g32 + 8 * g + 4 * hi; float v[4];
#pragma unroll
                          for (int q = 0; q < 4; ++q) v[q] = (n0 + q < 511) ? acc[4 * g + q] : 0.f;
                          if (j == 0) {
#pragma unroll
                              for (int q = 0; q < 4; ++q) KCMPB[((size_t)b * 512 + n0 + q) * 64 + dd] = f2bf(v[q]); }
                          else { u32x2 w; w.x = pk2(v[0], v[1]); w.y = pk2(v[2], v[3]); *(u32x2*)(VCMPT + ((size_t)b * 64 + dd) * 512 + n0) = w; } } }
                    __syncthreads();
            }
            if (bid < N_J3) {
                const int fr = lane & 15, kq = lane >> 4, hh = wave >> 1, odd = wave & 1;
                {
                    bf16x8 bq[3][6];
                    { const bf16_t* wq = (const bf16_t*)(ws + WS_WUQT) + (size_t)l * 384 * 192;
#pragma unroll
                      for (int nt = 0; nt < 3; ++nt)
#pragma unroll
                          for (int ks = 0; ks < 6; ++ks) bq[nt][ks] = *(const bf16x8*)(wq + (size_t)(48 * wave + 16 * nt + fr) * 192 + 32 * ks + 8 * kq); }
                    for (int r_ = bid; r_ < N_J3 * REP_J3; r_ += G) { const int r = r_ % N_J3;
                        const size_t row0 = (size_t)r * 64;
#pragma unroll 1
                        for (int mt = 0; mt < 4; ++mt) {
                            const bf16_t* pa = PB + (row0 + mt * 16 + fr) * NIN;
                            bf16x8 aq[6]; float ssq_ = 0.f;
#pragma unroll
                            for (int ks = 0; ks < 6; ++ks) { aq[ks] = ld8x2(pa + C_DCQ + 32 * ks + 8 * kq);
#pragma unroll
                                for (int e = 0; e < 8; ++e) { const float v = bf2f((bf16_t)aq[ks][e]); ssq_ += v * v; } }
                            ssq_ += shx(ssq_, 16); ssq_ += shx(ssq_, 32);
                            const float rq_ = rsqrtf(ssq_ * (1.f / 192.f) + EPS);
                            f32x4 cq[3];
#pragma unroll
                            for (int nt = 0; nt < 3; ++nt) { cq[nt] = (f32x4){0.f, 0.f, 0.f, 0.f};
#pragma unroll
                                for (int ks = 0; ks < 6; ++ks) cq[nt] = __builtin_amdgcn_mfma_f32_16x16x32_bf16(aq[ks], bq[nt][ks], cq[nt], 0, 0, 0); }
                            const float SCQ = 0.10206207261596575f * LOG2E;
#pragma unroll
                            for (int i = 0; i < 4; ++i) {
                                const size_t row = row0 + mt * 16 + 4 * kq + i; const float rqi = shf(rq_, 4 * kq + i) * SCQ;
                                float q0 = cq[0][i] * rqi, q1 = cq[1][i] * rqi, q2 = cq[2][i] * rqi;
                                if (odd) { const float2 cs = cs32[row * 16 + fr]; const float x1 = q1, x2 = q2; q1 = x1 * cs.x - x2 * cs.y; q2 = x2 * cs.x + x1 * cs.y; }
                                bf16_t* mq = MQ + row * 384 + hh * 96 + 48 * odd + fr; mq[0] = f2bf(q0); mq[16] = f2bf(q1); mq[32] = f2bf(q2);
                            }
                            if (wave == mt) {
#pragma unroll
                                for (int q = 0; q < 4; ++q) { const int p = lane * 4 + q, tok = p >> 4, i = p & 15; const size_t row = row0 + mt * 16 + tok; const bf16_t* pr = PB + row * NIN + C_DKR;
                                    const float x1 = bf2f(pr[i]), x2 = bf2f(pr[16 + i]); const float2 cs = cs32[row * 16 + i];
                                    MKR[row * 32 + i] = f2bf(x1 * cs.x - x2 * cs.y); MKR[row * 32 + 16 + i] = f2bf(x2 * cs.x + x1 * cs.y); } }
                        }
                    }
                }
                {
                    bf16x8 bkv[4][4];
                    { const bf16_t* wkv = (const bf16_t*)(ws + WS_WUKVT) + (size_t)l * 512 * 128;
#pragma unroll
                      for (int nt = 0; nt < 4; ++nt)
#pragma unroll
                          for (int ks = 0; ks < 4; ++ks) bkv[nt][ks] = *(const bf16x8*)(wkv + (size_t)(64 * wave + 16 * nt + fr) * 128 + 32 * ks + 8 * kq); }
                    for (int r_ = bid; r_ < N_J3 * REP_J3; r_ += G) { const int r = r_ % N_J3;
                        const size_t row0 = (size_t)r * 64; const size_t bb = row0 / SEQ, t0 = row0 % SEQ;
#pragma unroll 1
                        for (int mt = 0; mt < 4; ++mt) {
                            const bf16_t* pa = PB + (row0 + mt * 16 + fr) * NIN;
                            bf16x8 akv[4]; float sskv_ = 0.f;
#pragma unroll
                            for (int ks = 0; ks < 4; ++ks) { akv[ks] = ld8x2(pa + C_DCKV + 32 * ks + 8 * kq);
#pragma unroll
                                for (int e = 0; e < 8; ++e) { const float v = bf2f((bf16_t)akv[ks][e]); sskv_ += v * v; } }
                            sskv_ += shx(sskv_, 16); sskv_ += shx(sskv_, 32);
                            const float rk_ = rsqrtf(sskv_ * (1.f / 128.f) + EPS);
                            f32x4 ckv[4];
#pragma unroll
                            for (int nt = 0; nt < 4; ++nt) { ckv[nt] = (f32x4){0.f, 0.f, 0.f, 0.f};
#pragma unroll
                                for (int ks = 0; ks < 4; ++ks) ckv[nt] = __builtin_amdgcn_mfma_f32_16x16x32_bf16(akv[ks], bkv[nt][ks], ckv[nt], 0, 0, 0); }
                            float rki[4];
#pragma unroll
                            for (int i = 0; i < 4; ++i) rki[i] = shf(rk_, 4 * kq + i);
                            if (!odd) {
#pragma unroll
                                for (int i = 0; i < 4; ++i) { bf16_t* mk = MKN + (row0 + mt * 16 + 4 * kq + i) * 256 + hh * 64 + fr;
                                    mk[0] = f2bf(ckv[0][i] * rki[i]); mk[16] = f2bf(ckv[1][i] * rki[i]); mk[32] = f2bf(ckv[2][i] * rki[i]); mk[48] = f2bf(ckv[3][i] * rki[i]); } }
                            else {
#pragma unroll
                                for (int nt = 0; nt < 4; ++nt) { u32x2 w; w.x = pk2(ckv[nt][0] * rki[0], ckv[nt][1] * rki[1]); w.y = pk2(ckv[nt][2] * rki[2], ckv[nt][3] * rki[3]);
                                    *(u32x2*)(MVT + ((bb * 4 + hh) * 64 + 16 * nt + fr) * SEQ + t0 + mt * 16 + 4 * kq) = w; } }
                        }
                    }
                }
            }
            {
                const int r32 = lane & 31, hi = lane >> 5, gh = wave >> 1, gg = wave & 1, ch = tid & 255, half = tid >> 8;
                bf16x8 bW[2][4];
                { const bf16_t* wt = (const bf16_t*)(ws + WS_WGT) + (size_t)(((l * 2 + gg) * 4 + gh) * 64) * 64;
#pragma unroll
                  for (int nt = 0; nt < 2; ++nt)
#pragma unroll
                      for (int ks = 0; ks < 4; ++ks) bW[nt][ks] = *(const bf16x8*)(wt + (size_t)(32 * nt + r32) * 64 + 16 * ks + 8 * hi); }
                const float gbias0 = (gg == 0 ? inp(args, 7) : inp(args, 9))[l * 256 + gh * 64 + r32], gbias1 = (gg == 0 ? inp(args, 7) : inp(args, 9))[l * 256 + gh * 64 + 32 + r32];
                const float cw0 = inp(args, 4)[(l * 4 + 0) * 256 + ch], cw1 = inp(args, 4)[(l * 4 + 1) * 256 + ch], cw2 = inp(args, 4)[(l * 4 + 2) * 256 + ch], cw3 = inp(args, 4)[(l * 4 + 3) * 256 + ch], cb = inp(args, 5)[l * 256 + ch];
                const float sp = ((const float*)(ws + WS_SP))[l * 256 + ch];
                LAS float* xa = ldsf; LAS float* xc = ldsf + 35 * 256; LAS unsigned char* xcb = lds + 67 * 1024; LAS float* gR = (LAS float*)(lds + 67 * 1024 + 32 * 528); LAS float* gI = gR + 32 * 256;
            const bool j1bal = (G == 256 && REP_J1 == 1);
            for (int r_ = bid, k_ = 0; j1bal ? (k_ < (bid < 128 ? 3 : 5)) : (r_ < N_J1 * REP_J1); r_ += G, ++k_) { const int r = j1bal ? (bid < 128 ? bid + 128 * k_ : 384 + (bid - 128) + 128 * k_) : r_ % N_J1;
                    const int b = r >> 8, tb = r & 255, t0 = tb * 32;
                    for (int c = tid; c < 35 * 32; c += NTHR) { const int rr = c >> 5, c8 = c & 31, t = t0 - 3 + rr; u32x4 w = {0u, 0u, 0u, 0u}; if (t >= 0) w = *(const u32x4*)(PB + ((size_t)b * SEQ + t) * NIN + C_AX + 8 * c8);
                        LAS f32x4* d = (LAS f32x4*)(xa + rr * 256 + 8 * c8); d[0] = (f32x4){bflo(w.x), bfhi(w.x), bflo(w.y), bfhi(w.y)}; d[1] = (f32x4){bflo(w.z), bfhi(w.z), bflo(w.w), bfhi(w.w)}; }
                    __syncthreads();
#pragma unroll 4
                    for (int tt = 0; tt < 16; ++tt) { const int rr = half * 16 + tt; const float v = cb + cw0 * xa[rr * 256 + ch] + cw1 * xa[(rr + 1) * 256 + ch] + cw2 * xa[(rr + 2) * 256 + ch] + cw3 * xa[(rr + 3) * 256 + ch];
                        xc[rr * 256 + ch] = v; *(LAS bf16_t*)(xcb + rr * 528 + ch * 2) = f2bf(v); }
                    __syncthreads();
                    { f32x16 acc[2];
#pragma unroll
                      for (int i = 0; i < 16; ++i) { acc[0][i] = 0.f; acc[1][i] = 0.f; }
#pragma unroll
                      for (int ks = 0; ks < 4; ++ks) { const bf16x8 a = *(const LAS bf16x8*)(xcb + r32 * 528 + (gh * 64 + 16 * ks + 8 * hi) * 2); acc[0] = mfma32(a, bW[0][ks], acc[0]); acc[1] = mfma32(a, bW[1][ks], acc[1]); }
                      LAS float* gd = gg == 0 ? gR : gI;
#pragma unroll
                      for (int i = 0; i < 16; ++i) { const int tok = (i & 3) + 8 * (i >> 2) + 4 * hi; gd[tok * 256 + gh * 64 + r32] = sigmoidf_(acc[0][i] + gbias0); gd[tok * 256 + gh * 64 + 32 + r32] = sigmoidf_(acc[1][i] + gbias1); } }
                    __syncthreads();
                    float hst = 0.f, Ac = 1.f;
#pragma unroll 4
                    for (int tt = 0; tt < 16; ++tt) {
                        const int rr = half * 16 + tt;
                        const float la = -8.f * gR[rr * 256 + ch] * sp, x2 = 2.f * la;
                        const float av = la > -0.25f ? 1.f + la * (1.f + la * (0.5f + la * (0.16666667f + la * (0.041666667f + la * 0.0083333333f)))) : __expf(la);
                        const float om = x2 > -0.5f ? -x2 * (1.f + x2 * (0.5f + x2 * (0.16666667f + x2 * (0.041666667f + x2 * (0.0083333333f + x2 * 0.0013888889f))))) : 1.f - __expf(x2);
                        const float u = __builtin_amdgcn_sqrtf(om) * (gI[rr * 256 + ch] * xc[rr * 256 + ch]);
                        hst = av * hst + u; Ac *= av;
                        { const size_t ao = ((size_t)b * SEQ + t0 + rr) * 256 + ch; LRA[ao] = av; LRU_[ao] = u; }
                    }
                    const size_t so = ((size_t)(b * 512 + tb * 2 + half)) * 256 + ch;
                    LA[so] = Ac; LH[so] = hst;
                    __syncthreads();
            }
            }
            {
                const int kk = tid & 127, tq = tid >> 7, r32 = lane & 31, hi = lane >> 5;
                float wg[16]; const float bg = inp(args, 16)[l * 128 + kk];
#pragma unroll
                for (int q = 0; q < 16; ++q) wg[q] = inp(args, 15)[(l * 16 + q) * 128 + kk];
                LAS float* glr = ldsf; LAS float* tot = ldsf + 1024; LAS unsigned char* KTl = lds + 8192; LAS unsigned char* VTl = lds + 8192 + 128 * VSTR;
                float* BCS = (float*)(ws + WS_BCS);
            for (int r_ = bid; r_ < N_J2 * REP_J2; r_ += G) { const int r = r_ % N_J2;
                    const int b = r >> 7, c = r & 127; const size_t row0 = (size_t)b * SEQ + 64 * c;
                    for (int e = tid; e < 1024; e += NTHR) glr[e] = bf2f(PB[(row0 + (e >> 4)) * NIN + C_GLR + (e & 15)]);
                    for (int e = tid; e < 2048; e += NTHR) { const int jj = e >> 5, hc = e & 31; const bf16_t* vsrc = PB + (row0 + jj) * NIN + C_CV + 8 * hc; const u32x2 wA = *(const u32x2*)vsrc, wB = *(const u32x2*)(vsrc + 4);
                        LAS bf16_t* d = (LAS bf16_t*)(VTl + (8 * hc) * VSTR) + jj;
                        d[0] = (bf16_t)wA.x; d[VSTR / 2] = (bf16_t)(wA.x >> 16); d[2 * (VSTR / 2)] = (bf16_t)wA.y; d[3 * (VSTR / 2)] = (bf16_t)(wA.y >> 16); d[4 * (VSTR / 2)] = (bf16_t)wB.x; d[5 * (VSTR / 2)] = (bf16_t)(wB.x >> 16); d[6 * (VSTR / 2)] = (bf16_t)wB.y; d[7 * (VSTR / 2)] = (bf16_t)(wB.y >> 16); }
                    __syncthreads();
                    float bv[16]; float run = 0.f;
#pragma unroll
                    for (int tt = 0; tt < 16; ++tt) { const LAS f32x4* g4 = (const LAS f32x4*)(glr + (16 * tq + tt) * 16); float z = bg;
#pragma unroll
                        for (int q = 0; q < 4; ++q) { const f32x4 g = g4[q]; z += g[0] * wg[4 * q] + g[1] * wg[4 * q + 1] + g[2] * wg[4 * q + 2] + g[3] * wg[4 * q + 3]; }
                        run += (fminf(z, 0.f) - __logf(1.f + __expf(-fabsf(z)))) * (1.f / 16.f); bv[tt] = run; }
                    tot[tq * 128 + kk] = run;
                    __syncthreads();
                    { const float t0_ = tot[kk], t1_ = tot[128 + kk], t2_ = tot[256 + kk], t3_ = tot[384 + kk]; const float off = tq == 0 ? 0.f : (tq == 1 ? t0_ : (tq == 2 ? t0_ + t1_ : (t0_ + t1_) + t2_)), blast = ((t0_ + t1_) + t2_) + t3_;
#pragma unroll
                      for (int tt = 0; tt < 16; ++tt) { const int t = 16 * tq + tt; const float bt = bv[tt] + off; BCS[(row0 + t) * 128 + kk] = bt;
                          *((LAS bf16_t*)(KTl + kk * VSTR) + t) = f2bf(bf2f(PB[(row0 + t) * NIN + C_CK + kk]) * __expf(blast - bt)); }
                      if (tq == 0) DEC[(size_t)(b * 128 + c) * 128 + kk] = __expf(blast); }
                    __syncthreads();
                    { const int h = wave >> 1, nt = wave & 1; f32x16 acc;
#pragma unroll
                      for (int i = 0; i < 16; ++i) acc[i] = 0.f;
                      const LAS unsigned char* ap = KTl + (h * 32 + r32) * VSTR + 16 * hi; const LAS unsigned char* bp = VTl + (h * 64 + 32 * nt + r32) * VSTR + 16 * hi;
#pragma unroll
                      for (int s = 0; s < 4; ++s) { const u32x2 a0 = *(const LAS u32x2*)(ap + 32 * s), a1 = *(const LAS u32x2*)(ap + 32 * s + 8), b0 = *(const LAS u32x2*)(bp + 32 * s), b1 = *(const LAS u32x2*)(bp + 32 * s + 8);
                          u32x4 aw, bw; aw.x = a0.x; aw.y = a0.y; aw.z = a1.x; aw.w = a1.y; bw.x = b0.x; bw.y = b0.y; bw.z = b1.x; bw.w = b1.y;
                          acc = mfma32(__builtin_bit_cast(bf16x8, aw), __builtin_bit_cast(bf16x8, bw), acc); }
                      float* o = KVC + ((size_t)(b * 128 + c) * 4 + h) * 2048 + 32 * nt + r32;
#pragma unroll
                      for (int i = 0; i < 16; ++i) o[((i & 3) + 8 * (i >> 2) + 4 * hi) * 64] = acc[i]; }
                    __syncthreads();
            }
            }
            for (int r = bid; r < N_J4; r += G) {
                    const size_t row0 = (size_t)r * 64;
#pragma unroll
                    for (int it3 = 0; it3 < 3; ++it3) {
                        const int e = tid + it3 * NTHR, tok = e / 24, p = e % 24, hd = p >> 2, c8 = p & 3; const int base = hd < 4 ? C_BQ + hd * 64 : (hd == 4 ? C_KS : C_KW); const float sc = hd < 4 ? 0.125f * LOG2E : 1.f;
                        bf16_t* pr = PB + (row0 + tok) * NIN + base + 8 * c8; const u32x4 a = *(const u32x4*)pr, c = *(const u32x4*)(pr + 32); const float2* cs = cs64 + (row0 + tok) * 32 + 8 * c8;
                        const unsigned au[4] = {a.x, a.y, a.z, a.w}, cu[4] = {c.x, c.y, c.z, c.w}; unsigned o1[4], o2[4];
#pragma unroll
                        for (int q = 0; q < 4; ++q) { const float2 s0 = cs[2 * q], s1 = cs[2 * q + 1]; const float x1a = bflo(au[q]), x1b = bfhi(au[q]), x2a = bflo(cu[q]), x2b = bfhi(cu[q]);
                            o1[q] = pk2((x1a * s0.x - x2a * s0.y) * sc, (x1b * s1.x - x2b * s1.y) * sc); o2[q] = pk2((x2a * s0.x + x1a * s0.y) * sc, (x2b * s1.x + x1b * s1.y) * sc); }
                        u32x4 w1, w2; w1.x = o1[0]; w1.y = o1[1]; w1.z = o1[2]; w1.w = o1[3]; w2.x = o2[0]; w2.y = o2[1]; w2.z = o2[2]; w2.w = o2[3];
                        *(u32x4*)pr = w1; *(u32x4*)(pr + 32) = w2;
                        if (hd == 4) {
                            bf16_t* kf_ = KSF + (row0 / 64) * 4096 + (size_t)((((tok >> 5) * 4 + (c8 >> 1)) * 64 + (c8 & 1) * 32 + (tok & 31)) * 8); *(u32x4*)kf_ = w1; *(u32x4*)(kf_ + 2 * 64 * 8) = w2; } }
                    { LAS bf16_t* tl = (LAS bf16_t*)lds; const size_t bb = row0 / SEQ, t0 = row0 % SEQ;
                      for (int mtx = 0; mtx < 2; ++mtx) { const int tok = tid >> 3, c = tid & 7; const u32x4 w = *(const u32x4*)(PB + (row0 + tok) * NIN + (mtx ? C_VW : C_VS) + c * 8);
                          LAS bf16_t* dst = tl + mtx * 64 * 72 + tok * 72 + c * 8; dst[0] = (bf16_t)w.x; dst[1] = (bf16_t)(w.x >> 16); dst[2] = (bf16_t)w.y; dst[3] = (bf16_t)(w.y >> 16); dst[4] = (bf16_t)w.z; dst[5] = (bf16_t)(w.z >> 16); dst[6] = (bf16_t)w.w; dst[7] = (bf16_t)(w.w >> 16); }
                      __syncthreads();
                      for (int mtx = 0; mtx < 2; ++mtx) { const int d = tid >> 3, c8 = tid & 7; const LAS bf16_t* s = tl + mtx * 64 * 72 + (c8 * 8) * 72 + d;
                          u32x4 w; w.x = (unsigned)s[0] | ((unsigned)s[72] << 16); w.y = (unsigned)s[2 * 72] | ((unsigned)s[3 * 72] << 16); w.z = (unsigned)s[4 * 72] | ((unsigned)s[5 * 72] << 16); w.w = (unsigned)s[6 * 72] | ((unsigned)s[7 * 72] << 16);
                          if (mtx) *(u32x4*)(VWT + (bb * 64 + d) * SEQ + t0 + c8 * 8) = w;
                          else { const int s_ = c8 >> 1, h_ = c8 & 1; const LAS bf16_t* q = tl + (16 * s_ + 4 * h_) * 72 + d;
                              u32x4 f; f.x = (unsigned)q[0] | ((unsigned)q[72] << 16); f.y = (unsigned)q[2 * 72] | ((unsigned)q[3 * 72] << 16); f.z = (unsigned)q[8 * 72] | ((unsigned)q[9 * 72] << 16); f.w = (unsigned)q[10 * 72] | ((unsigned)q[11 * 72] << 16);
                              *(u32x4*)(VST + (row0 / 64) * 4096 + (size_t)((((d >> 5) * 4 + s_) * 64 + h_ * 32 + (d & 31)) * 8)) = f; } }
                      __syncthreads(); }
            }
            }
        }
        SEAM(pb + 1);
        if (IN(pb + 2)) {
        const int l_ = l; WS_PTRS();
        LAUNDER_TID();
            constexpr int Q_J5 = 2, Q_J6 = 64, Q_ATT = 1024 * REP_ATT, Q_J9 = 1024, Q_J10 = 512, Q_TOT = Q_J5 + Q_J6 + Q_ATT + Q_J9 + Q_J10;
            if (tid == 0) { LCTL[4] = 0u; LCTL[5] = 0u; }
            __syncthreads();
            const int tid_o = tid;
            for (;;) {
                int tid = tid_o; asm volatile("" : "+v"(tid)); const int lane = tid & 63;
                if (tid == 0) LCTL[2] = __hip_atomic_fetch_add(ctl + CW_QUEUE + 64 * l, 1u, __ATOMIC_RELAXED, __HIP_MEMORY_SCOPE_AGENT);
                __syncthreads();
                int r = __builtin_amdgcn_readfirstlane((int)LCTL[2]); const unsigned seen5 = LCTL[4], seen6 = LCTL[5];
                __syncthreads();
                if (r >= Q_TOT * REP_P3) break;
                if (REP_P3 > 1 && r >= Q_TOT) r -= Q_TOT;
                if (r < Q_J5) {
                    const int e = r * NTHR + tid, b = e >> 8, ch = e & 255; float carry = 0.f;
                    for (int c0 = 0; c0 < 512; c0 += 8) { float av[8], hv[8];
#pragma unroll
                        for (int q = 0; q < 8; ++q) { const size_t so = ((size_t)(b * 512 + c0 + q)) * 256 + ch; av[q] = LA[so]; hv[q] = LH[so]; }
#pragma unroll
                        for (int q = 0; q < 8; ++q) { CIN[((size_t)(b * 512 + c0 + q)) * 256 + ch] = carry; carry = av[q] * carry + hv[q]; } }
                    asm volatile("s_waitcnt vmcnt(0)" ::: "memory"); __syncthreads();
                    if (tid == 0) { __builtin_amdgcn_fence(__ATOMIC_RELEASE, "agent"); asm volatile("s_waitcnt vmcnt(0)" ::: "memory"); (void)xb_add(ctl + CW_FLAG + 64 * (2 * l + 0), 1u); }
                    continue;
                }
                r -= Q_J5;
                if (r < Q_J6) {
                    const int e = r * NTHR + tid, b = e >> 13, rem = e & 8191; float Sv = 0.f;
                    for (int c0 = 0; c0 < 128; c0 += 8) { float kv[8], dv[8];
#pragma unroll
                        for (int q = 0; q < 8; ++q) { kv[q] = KVC[(size_t)(b * 128 + c0 + q) * 8192 + rem]; dv[q] = DEC[(size_t)(b * 128 + c0 + q) * 128 + (rem >> 6)]; }
#pragma unroll
                        for (int q = 0; q < 8; ++q) { SST[(size_t)(b * 128 + c0 + q) * 8192 + rem] = Sv; Sv = dv[q] * Sv + kv[q]; } }
                    asm volatile("s_waitcnt vmcnt(0)" ::: "memory"); __syncthreads();
                    if (tid == 0) { __builtin_amdgcn_fence(__ATOMIC_RELEASE, "agent"); asm volatile("s_waitcnt vmcnt(0)" ::: "memory"); (void)xb_add(ctl + CW_FLAG + 64 * (2 * l + 1), 1u); }
                    continue;
                }
                r -= Q_J6;
                if (r >= Q_ATT) {
                    r -= Q_ATT; const bool is9 = r < Q_J9;
                    if (!(is9 ? seen5 : seen6)) {
                        if (tid == 0) { unsigned* f = ctl + CW_FLAG + 64 * (2 * l + (is9 ? 0 : 1)); const unsigned target = is9 ? (unsigned)Q_J5 : (unsigned)Q_J6;
                            XB_SPIN(xb_ld(f) < target, ctl + CW_BAR); __builtin_amdgcn_fence(__ATOMIC_ACQUIRE, "agent"); asm volatile("s_waitcnt vmcnt(0)" ::: "memory"); LCTL[is9 ? 4 : 5] = 1u; }
                        __syncthreads(); }
                    if (is9) {
                    const int b = r >> 8, tb = r & 255, t0 = tb * 32, ch = tid & 255, half = tid >> 8;
                    LAS float* xa = ldsf;
                    float hst = CIN[((size_t)(b * 512 + tb * 2 + half)) * 256 + ch];
                    { float av[16], uv[16], gv[16];
#pragma unroll
                      for (int tt = 0; tt < 16; ++tt) { const size_t ro = (size_t)b * SEQ + t0 + half * 16 + tt; av[tt] = LRA[ro * 256 + ch]; uv[tt] = LRU_[ro * 256 + ch]; gv[tt] = bf2f(PB[ro * NIN + C_AG + ch]); }
#pragma unroll
                      for (int tt = 0; tt < 16; ++tt) { hst = av[tt] * hst + uv[tt]; xa[(half * 16 + tt) * 256 + ch] = hst * gelu_tanh(gv[tt]); } }
                    __syncthreads();
                    for (int q = 0; q < 4; ++q) { const int rr = wave * 4 + q; const f32x4 v = ((const LAS f32x4*)(xa + rr * 256))[lane];
                        const float rinv = rsqrtf(wave_sum(v[0] * v[0] + v[1] * v[1] + v[2] * v[2] + v[3] * v[3]) * (1.f / 256.f) + EPS);
                        u32x2 w; w.x = pk2(v[0] * rinv, v[1] * rinv); w.y = pk2(v[2] * rinv, v[3] * rinv);
                        *(u32x2*)(Y + ((size_t)b * SEQ + t0 + rr) * DM + 256 + 4 * lane) = w; }
                    __syncthreads();
                    } else { r -= Q_J9;
                    const int b = r >> 7, c = r & 127; const size_t row0 = (size_t)b * SEQ + 64 * c;
                    LAS float* bL = ldsf; LAS float* glr = ldsf + 8192; LAS unsigned char* VTl = lds + 36864; LAS unsigned char* STl = lds + 71680; LAS float* SSX = (LAS float*)(lds + 92160);
                    for (int e = tid; e < 2048; e += NTHR) ((LAS f32x4*)bL)[e] = ((const f32x4*)((const float*)(ws + WS_BCS) + row0 * 128))[e];
                    for (int e = tid; e < 2048; e += NTHR) { const int jj = e >> 5, hc = e & 31, h = hc >> 3, c8 = hc & 7; const bf16_t* vsrc = PB + (row0 + jj) * NIN + C_CV + h * 64 + 8 * c8; const u32x2 wA = *(const u32x2*)vsrc, wB = *(const u32x2*)(vsrc + 4); u32x4 w; w.x = wA.x; w.y = wA.y; w.z = wB.x; w.w = wB.y;
                        LAS bf16_t* d = (LAS bf16_t*)(VTl + h * 8704 + (8 * c8) * VSTR) + jj;
                        d[0] = (bf16_t)w.x; d[VSTR / 2] = (bf16_t)(w.x >> 16); d[2 * (VSTR / 2)] = (bf16_t)w.y; d[3 * (VSTR / 2)] = (bf16_t)(w.y >> 16); d[4 * (VSTR / 2)] = (bf16_t)w.z; d[5 * (VSTR / 2)] = (bf16_t)(w.z >> 16); d[6 * (VSTR / 2)] = (bf16_t)w.w; d[7 * (VSTR / 2)] = (bf16_t)(w.w >> 16); }
                    for (int e = tid; e < 8192; e += NTHR) { const int h = e >> 11, k = (e >> 6) & 31, v = e & 63; *(LAS bf16_t*)(STl + h * 5120 + v * 80 + k * 2) = f2bf(SST[(size_t)(b * 128 + c) * 8192 + e]); }
                    __syncthreads();
                    { const int r32 = lane & 31, hi = lane >> 5, h = wave >> 1, ih = wave & 1, i = 32 * ih + r32; const float SCG = 0.17677669529663687f;
                      bf16x8 qrel[2], qabs[2], kt[2][2];
#pragma unroll
                      for (int ks = 0; ks < 2; ++ks) { const int k0 = h * 32 + 16 * ks + 8 * hi; const bf16x8 qv = ld8x2(PB + (row0 + i) * NIN + C_CQ + k0); u32x4 wr_, wa_; unsigned* pr_ = (unsigned*)&wr_; unsigned* pa_ = (unsigned*)&wa_;
#pragma unroll
                          for (int e2 = 0; e2 < 4; ++e2) { const float b0 = bL[i * 128 + k0 + 2 * e2], b1 = bL[i * 128 + k0 + 2 * e2 + 1], f0 = bL[31 * 128 + k0 + 2 * e2], f1 = bL[31 * 128 + k0 + 2 * e2 + 1];
                              const float q0 = bf2f((bf16_t)qv[2 * e2]) * SCG, q1 = bf2f((bf16_t)qv[2 * e2 + 1]) * SCG;
                              pr_[e2] = cvtpk(q0 * __expf(b0 - f0), q1 * __expf(b1 - f1)); pa_[e2] = cvtpk(q0 * __expf(b0), q1 * __expf(b1)); }
                          qrel[ks] = __builtin_bit_cast(bf16x8, wr_); qabs[ks] = __builtin_bit_cast(bf16x8, wa_); }
#pragma unroll
                      for (int jt = 0; jt < 2; ++jt)
#pragma unroll
                          for (int ks = 0; ks < 2; ++ks) { const int jr = 32 * jt + r32, k0 = h * 32 + 16 * ks + 8 * hi; const bf16x8 kv = ld8x2(PB + (row0 + jr) * NIN + C_CK + k0); u32x4 wk_; unsigned* pk_ = (unsigned*)&wk_;
#pragma unroll
                              for (int e2 = 0; e2 < 4; ++e2) { const float b0 = bL[jr * 128 + k0 + 2 * e2], b1 = bL[jr * 128 + k0 + 2 * e2 + 1], f0 = bL[31 * 128 + k0 + 2 * e2], f1 = bL[31 * 128 + k0 + 2 * e2 + 1];
                                  pk_[e2] = cvtpk(bf2f((bf16_t)kv[2 * e2]) * __expf(f0 - b0), bf2f((bf16_t)kv[2 * e2 + 1]) * __expf(f1 - b1)); }
                              kt[jt][ks] = __builtin_bit_cast(bf16x8, wk_); }
                      f32x16 o[2], s[2];
#pragma unroll
                      for (int q = 0; q < 16; ++q) { o[0][q] = 0.f; o[1][q] = 0.f; s[0][q] = 0.f; s[1][q] = 0.f; }
#pragma unroll
                      for (int ks = 0; ks < 2; ++ks) s[0] = mfma32(kt[0][ks], qrel[ks], s[0]);
                      if (ih) {
#pragma unroll
                          for (int ks = 0; ks < 2; ++ks) s[1] = mfma32(kt[1][ks], qrel[ks], s[1]); }
#pragma unroll
                      for (int q = 0; q < 16; ++q) { const int jr = (q & 3) + 8 * (q >> 2) + 4 * hi; if (jr > r32) { if (ih) s[1][q] = 0.f; else s[0][q] = 0.f; } }
                      const LAS unsigned char* VTh = VTl + h * 8704; const LAS unsigned char* STh = STl + h * 5120;
#pragma unroll
                      for (int dt = 0; dt < 2; ++dt) { const LAS unsigned char* vp = VTh + (32 * dt + r32) * VSTR + 8 * hi;
                          o[dt] = mfma32(vfrag(vp), pack8<0>(s[0]), o[dt]); o[dt] = mfma32(vfrag(vp + 32), pack8<8>(s[0]), o[dt]);
                          if (ih) { o[dt] = mfma32(vfrag(vp + 64), pack8<0>(s[1]), o[dt]); o[dt] = mfma32(vfrag(vp + 96), pack8<8>(s[1]), o[dt]); }
#pragma unroll
                          for (int ks = 0; ks < 2; ++ks) o[dt] = mfma32(*(const LAS bf16x8*)(STh + (32 * dt + r32) * 80 + 32 * ks + 16 * hi), qabs[ks], o[dt]); }
                      float ssh = 0.f;
#pragma unroll
                      for (int q = 0; q < 16; ++q) ssh += o[0][q] * o[0][q] + o[1][q] * o[1][q];
                      const float rh = rsqrtf(xhalf_sum(ssh) * (1.f / 64.f) + EPS); float ssg = 0.f;
#pragma unroll
                      for (int dt = 0; dt < 2; ++dt)
#pragma unroll
                          for (int g = 0; g < 4; ++g) { const int v0 = 32 * dt + 8 * g + 4 * hi; const u32x2 ogw = *(const u32x2*)(PB + (row0 + i) * NIN + C_OG + h * 64 + v0); const f32x4 gn = *(const f32x4*)(inp(args, 17) + l * 64 + v0);
                              const float og4[4] = {bflo(ogw.x), bfhi(ogw.x), bflo(ogw.y), bfhi(ogw.y)};
#pragma unroll
                              for (int q = 0; q < 4; ++q) { const float y = o[dt][4 * g + q] * rh * gn[q] * (og4[q] * sigmoidf_(og4[q])); o[dt][4 * g + q] = y; ssg += y * y; } }
                      ssg = xhalf_sum(ssg); if (hi == 0) SSX[i * 4 + h] = ssg;
                      __syncthreads();
                      const f32x4 s4 = *(const LAS f32x4*)(SSX + i * 4); const float rinv = rsqrtf((s4[0] + s4[1] + s4[2] + s4[3]) * (1.f / 256.f) + EPS);
#pragma unroll
                      for (int dt = 0; dt < 2; ++dt)
#pragma unroll
                          for (int g = 0; g < 4; ++g) { u32x2 w; w.x = cvtpk(o[dt][4 * g] * rinv, o[dt][4 * g + 1] * rinv); w.y = cvtpk(o[dt][4 * g + 2] * rinv, o[dt][4 * g + 3] * rinv);
                              *(u32x2*)(Y + (row0 + i) * DM + 768 + h * 64 + 32 * dt + 8 * g + 4 * hi) = w; } }
                    __syncthreads();
                    }
                    continue;
                }
                const int r32 = lane & 31, hi = lane >> 5;
                const int rep = r >> 10; r &= 1023;
                const int grp = r >> 5, within = r & 31;
                if (rep && ((REP_ONLY == 1 && within >= 16) || (REP_ONLY == 2 && within < 16))) continue;
              {
                if (within >= 16) {
                    const int idx = within - 16, b = idx & 3, tb = 127 - (4 * grp + (idx >> 2));
                    const int tl = 8 * wave + (r32 >> 2), head = r32 & 3, T = 64 * tb + tl; const size_t row = (size_t)b * SEQ + T; const bf16_t* prow = PB + row * NIN;
                    bf16x8 qf[4];
#pragma unroll
                    for (int ks = 0; ks < 4; ++ks) qf[ks] = *(const bf16x8*)(prow + C_BQ + head * 64 + 16 * ks + 8 * hi);
                    LAS float* impb = (LAS float*)(lds + AL_IMP) + wave * 1024; LAS unsigned* selm = (LAS unsigned*)(lds + AL_SELM) + wave * 32;
                    const int skey = tid >> 3, sch = tid & 7;
                    const unsigned koffP = (unsigned)(skey * NIN + sch * 8), voffS = (unsigned)(skey * SEQ + sch * 8), koffC = (unsigned)(skey * 64 + sch * 8), voffC = (unsigned)(skey * 512 + sch * 8);
                    auto stK = [&](int buf, const StageRegs& R) __attribute__((always_inline)) { *(LAS u32x4*)(lds + (buf ? AL_K1 : AL_K0) + skey * KSTR + sch * 16) = R.a; };
                    auto stKV = [&](int buf, const StageRegs& R) __attribute__((always_inline)) { *(LAS u32x4*)(lds + (buf ? AL_K1 : AL_K0) + skey * KSTR + sch * 16) = R.a;
                        LAS unsigned char* vd = lds + (buf ? AL_V1 : AL_V0) + skey * VSTP + (sch >> 1) * 32 + (sch & 1) * 8; u32x2 a, c; a.x = R.b.x; a.y = R.b.y; c.x = R.b.z; c.y = R.b.w; *(LAS u32x2*)vd = a; *(LAS u32x2*)(vd + 16) = c; };
                    f32x16 oacc[2], ob[2];
                    const int nv = T >= 31 ? ((T - 31) >> 4) + 1 : 0, ntc = (4 * tb + 3 + 63) >> 6;
                    float mC = NEGB, lC = 0.f;
                    { const bf16_t* kb_ = KCMPB + (size_t)b * 512 * 64;
                      attn_pipeline(wave, 0, ntc - 1, [&](int j, StageRegs& R) __attribute__((always_inline)) { R.a = *(const u32x4*)((kb_ + (size_t)j * 64 * 64) + koffC); }, stK,
                        [&](int j, int cb) __attribute__((always_inline)) { f32x16 s0, s1; qk_tile<4>(lds + (cb ? AL_K1 : AL_K0), qf, r32, hi, s0, s1); if (!__all(nv - 1 - 64 * j >= 63)) mask_tile(s0, s1, 0, nv - 1 - 64 * j, hi);
                            const float mx = tile_max(s0, s1), mn = fmaxf(mC, mx), ms = mn < -1e29f ? 0.f : mn, alpha = ex2(mC - ms); mC = mn; float ps = 0.f;
#pragma unroll
                            for (int i = 0; i < 16; ++i) ps += ex2(s0[i] - ms) + ex2(s1[i] - ms);
                            lC = lC * alpha + ps; }); }
                    { const float invC = 1.f / fmaxf(xhalf_sum(lC), 1e-30f), msC = mC < -1e29f ? 0.f : mC; float carry = 0.f;
#pragma unroll
                      for (int i = 0; i < 16; ++i) { ob[0][i] = 0.f; ob[1][i] = 0.f; }
                      const bf16_t* kb_ = KCMPB + (size_t)b * 512 * 64; const bf16_t* vb_ = VCMPT + (size_t)b * 64 * 512;
                      attn_pipeline(wave, 0, ntc - 1, [&](int j, StageRegs& R) __attribute__((always_inline)) { R.a = *(const u32x4*)((kb_ + (size_t)j * 64 * 64) + koffC); R.b = *(const u32x4*)((vb_ + j * 64) + voffC); }, stKV,
                        [&](int j, int cb) __attribute__((always_inline)) { f32x16 s0, s1; qk_tile<4>(lds + (cb ? AL_K1 : AL_K0), qf, r32, hi, s0, s1); if (!__all(nv - 1 - 64 * j >= 63)) mask_tile(s0, s1, 0, nv - 1 - 64 * j, hi);
#pragma unroll
                            for (int i = 0; i < 16; ++i) { s0[i] = ex2(s0[i] - msC) * invC; s1[i] = ex2(s1[i] - msC) * invC; }
                            float gs[8], pl[8];
#pragma unroll
                            for (int q = 0; q < 4; ++q) { gs[q] = (s0[4 * q] + s0[4 * q + 1]) + (s0[4 * q + 2] + s0[4 * q + 3]); gs[4 + q] = (s1[4 * q] + s1[4 * q + 1]) + (s1[4 * q + 2] + s1[4 * q + 3]);
                                pl[q] = shx(s0[4 * q + 3], 32); pl[4 + q] = shx(s1[4 * q + 3], 32); }
#pragma unroll
                            for (int q = 0; q < 8; ++q) { const float prev = hi ? pl[q] : (q > 0 ? pl[q > 0 ? q - 1 : 0] : carry); float x = gs[q] + prev; x += shx(x, 1); x += shx(x, 2);
                                if ((r32 & 3) == 0) impb[(r32 >> 2) * 128 + 16 * j + 2 * q + hi] = x; }
                            carry = pl[7];
                            pv_tile(s0, s1, lds + (cb ? AL_V1 : AL_V0), ob, r32, hi); }); }
                    LAS float* oav = (LAS float*)(lds + AL_OACC) + tid; const float g0 = sigmoidf_(bf2f(prow[C_BG + head * 3]));
#pragma unroll
                    for (int i = 0; i < 16; ++i) { oav[i * 512] = g0 * ob[0][i]; oav[(16 + i) * 512] = g0 * ob[1][i]; }
                    WSYNC();
                    for (int tk = 0; tk < 8; ++tk) {
                        const int cur = tb, j0 = lane, j1 = lane + 64; const float im0 = impb[tk * 128 + j0], im1 = impb[tk * 128 + j1];
                        const unsigned k0 = ((j0 == 0 || j0 == cur || j0 == cur - 1) ? 0xFF000000u : (j0 <= cur ? (__float_as_uint(im0) & ~127u) : 0u)) | (unsigned)(127 - j0);
                        const unsigned k1 = ((j1 == cur || j1 == cur - 1) ? 0xFF000000u : (j1 <= cur ? (__float_as_uint(im1) & ~127u) : 0u)) | (unsigned)(127 - j1);
                        unsigned T = 0u;
#pragma unroll 4
                        for (int bb = 31; bb >= 0; --bb) { const unsigned cand = T | (1u << bb); const int cnt = __popcll(__ballot(k0 >= cand)) + __popcll(__ballot(k1 >= cand)); if (cnt >= 16) T = cand; }
                        const unsigned long long m0 = __ballot(k0 >= T), m1 = __ballot(k1 >= T);
                        if (lane == 0) { selm[tk * 4] = (unsigned)m0; selm[tk * 4 + 1] = (unsigned)(m0 >> 32); selm[tk * 4 + 2] = (unsigned)m1; selm[tk * 4 + 3] = (unsigned)(m1 >> 32); }
                    }
                    WSYNC();
                    const unsigned sm0 = selm[(r32 >> 2) * 4], sm1 = selm[(r32 >> 2) * 4 + 1], sm2 = selm[(r32 >> 2) * 4 + 2], sm3 = selm[(r32 >> 2) * 4 + 3];
                    { SoftState SB; soft_init(SB, ob);
                      unsigned u0 = sm0, u1 = sm1, u2 = sm2, u3 = sm3;
#pragma unroll
                      for (int o_ = 1; o_ < 64; o_ <<= 1) { u0 |= shx(u0, o_); u1 |= shx(u1, o_); u2 |= shx(u2, o_); u3 |= shx(u3, o_); }
                      unsigned long long Ulo = ((unsigned long long)(unsigned)__builtin_amdgcn_readfirstlane((int)u1) << 32) | (unsigned)__builtin_amdgcn_readfirstlane((int)u0), Uhi = ((unsigned long long)(unsigned)__builtin_amdgcn_readfirstlane((int)u3) << 32) | (unsigned)__builtin_amdgcn_readfirstlane((int)u2);
                      if (tb < 64) { if (tb < 63) Ulo &= (2ull << tb) - 1ull; Uhi = 0ull; } else if (tb < 127) Uhi &= (2ull << (tb - 64)) - 1ull;
                      const bf16_t* ksf = KSF + (size_t)b * 128 * 4096; const bf16_t* vsf = VST + (size_t)b * 128 * 4096; const unsigned lo8 = (unsigned)lane * 8u;
                      bf16x8 kf[2][4], vf[2][4];
                      int j = 0; Ulo &= ~1ull;
#pragma unroll
                      for (int f = 0; f < 8; ++f) kf[f >> 2][f & 3] = *(const bf16x8*)((ksf + f * 512) + lo8);
                      bool first = true;
                      for (;;) {
#pragma unroll
                          for (int f = 0; f < 8; ++f) vf[f >> 2][f & 3] = *(const bf16x8*)((vsf + (size_t)j * 4096 + f * 512) + lo8);
                          const unsigned wsel = j < 32 ? sm0 : (j < 64 ? sm1 : (j < 96 ? sm2 : sm3)); const bool bit = (wsel >> (j & 31)) & 1u;
                          const f32x16 cinit = bcast16(bit ? -SB.m : NEGB); f32x16 s0 = cinit, s1 = cinit;
#pragma unroll
                          for (int ks = 0; ks < 4; ++ks) { s0 = mfma32(kf[0][ks], qf[ks], s0); s1 = mfma32(kf[1][ks], qf[ks], s1); }
                          __builtin_amdgcn_sched_barrier(0);
                          const int jn = Ulo ? (int)__builtin_ctzll(Ulo) : (Uhi ? 64 + (int)__builtin_ctzll(Uhi) : -1);
                          if (Ulo) Ulo &= Ulo - 1ull; else Uhi &= Uhi - 1ull;
                          if (jn >= 0) {
#pragma unroll
                              for (int f = 0; f < 8; ++f) kf[f >> 2][f & 3] = *(const bf16x8*)((ksf + (size_t)jn * 4096 + f * 512) + lo8); }
                          soft_update(s0, s1, SB, ob, j == tb, 0, tl, first, hi);
                          { const bf16x8 p00 = pack8<0>(s0), p01 = pack8<8>(s0), p10 = pack8<0>(s1), p11 = pack8<8>(s1);
#pragma unroll
                            for (int dt = 0; dt < 2; ++dt) { ob[dt] = mfma32(vf[dt][0], p00, ob[dt]); ob[dt] = mfma32(vf[dt][1], p01, ob[dt]); ob[dt] = mfma32(vf[dt][2], p10, ob[dt]); ob[dt] = mfma32(vf[dt][3], p11, ob[dt]); } }
                          if (jn < 0) break;
                          j = jn; first = false;
                      }
                      const float sc = sigmoidf_(bf2f(prow[C_BG + head * 3 + 1])) / fmaxf(xhalf_sum(SB.l), 1e-30f);
#pragma unroll
                      for (int i = 0; i < 16; ++i) { oav[i * 512] += sc * ob[0][i]; oav[(16 + i) * 512] += sc * ob[1][i]; } }
                    __syncthreads();
                    { SoftState SB; soft_init(SB, ob); const int jb0 = tb >= 8 ? tb - 8 : 0;
                      const bf16_t* kb_ = PB + (size_t)b * SEQ * NIN + C_KW; const bf16_t* vb_ = VWT + (size_t)b * 64 * SEQ;
                      attn_pipeline(wave, tb >= 8 ? tb - 8 : 0, tb, [&](int j, StageRegs& R) __attribute__((always_inline)) { R.a = *(const u32x4*)((kb_ + (size_t)j * 64 * NIN) + koffP); R.b = *(const u32x4*)((vb_ + j * 64) + voffS); }, stKV,
                        [&](int j, int cb) __attribute__((always_inline)) { attn_step<4>(lds + (cb ? AL_K1 : AL_K0), lds + (cb ? AL_V1 : AL_V0), qf, SB, ob, j == tb || j == tb - 8, j == tb - 8 ? tl + 1 : 0, j == tb ? tl : 63, j == jb0, r32, hi); });
                      const float sc = sigmoidf_(bf2f(prow[C_BG + head * 3 + 2])) / fmaxf(xhalf_sum(SB.l), 1e-30f);
#pragma unroll
                      for (int i = 0; i < 16; ++i) { oacc[0][i] = oav[i * 512] + sc * ob[0][i]; oacc[1][i] = oav[(16 + i) * 512] + sc * ob[1][i]; } }
                    { float ss = 0.f;
#pragma unroll
                      for (int i = 0; i < 16; ++i) ss += oacc[0][i] * oacc[0][i] + oacc[1][i] * oacc[1][i];
                      ss = xhalf_sum(ss); ss += shx(ss, 1); ss += shx(ss, 2);
                      const float rinv = rsqrtf(ss * (1.f / 256.f) + EPS);
#pragma unroll
                      for (int dt = 0; dt < 2; ++dt)
#pragma unroll
                          for (int g = 0; g < 4; ++g) { u32x2 w; w.x = cvtpk(oacc[dt][4 * g] * rinv, oacc[dt][4 * g + 1] * rinv); w.y = cvtpk(oacc[dt][4 * g + 2] * rinv, oacc[dt][4 * g + 3] * rinv);
                              *(u32x2*)(Y + row * DM + 512 + head * 64 + 32 * dt + 8 * g + 4 * hi) = w; } }
                    __syncthreads();
                    continue;
                }
                {
                    const int qb = 31 - grp, b = within >> 2, h = within & 3;
                    const int T = 256 * qb + 32 * wave + r32; const size_t row = (size_t)b * SEQ + T;
                    bf16x8 qf[6];
#pragma unroll
                    for (int ks = 0; ks < 6; ++ks) qf[ks] = *(const bf16x8*)(MQ + row * 384 + h * 96 + 16 * ks + 8 * hi);
                    f32x16 o[2]; SoftState SM; soft_init(SM, o);
                    const int jd = 4 * qb + (wave >> 1);
                    const bf16_t* kn = MKN + (size_t)b * SEQ * 256 + h * 64; const bf16_t* kr = MKR + (size_t)b * SEQ * 32; const bf16_t* vt = MVT + (size_t)(b * 4 + h) * 64 * SEQ;
                    constexpr int VS2 = 272, AM_K0 = 0, AM_K1 = 128 * KSTR, AM_V0 = 2 * 128 * KSTR, AM_V1 = AM_V0 + 64 * VS2;
                    const int nk = tid >> 3, nc = tid & 7, rkey = tid >> 2, rch = tid & 3, vr = tid >> 4, vc = tid & 15;
                    const unsigned ko0 = (unsigned)(nk * 256 + nc * 8), ko1 = (unsigned)(rkey * 32 + rch * 8), vo_ = (unsigned)(vr * SEQ + vc * 8);
                    attn_pipeline(wave, 0, 2 * qb + 1,
                        [&](int jj, StageRegs& R) __attribute__((always_inline)) { const bf16_t* knj = kn + (size_t)jj * 128 * 256; const bf16_t* vtj = vt + jj * 128;
                            R.a = *(const u32x4*)(knj + ko0); R.b = *(const u32x4*)((knj + 64 * 256) + ko0); R.c = *(const u32x4*)((kr + (size_t)jj * 128 * 32) + ko1);
                            R.d = *(const u32x4*)(vtj + vo_); R.e = *(const u32x4*)((vtj + 32 * SEQ) + vo_); },
                        [&](int buf, const StageRegs& R) __attribute__((always_inline)) { LAS unsigned char* kb_ = lds + (buf ? AM_K1 : AM_K0); LAS unsigned char* vb_ = lds + (buf ? AM_V1 : AM_V0) + vr * VS2 + (vc >> 1) * 32 + (vc & 1) * 8;
                            *(LAS u32x4*)(kb_ + nk * KSTR + nc * 16) = R.a; *(LAS u32x4*)(kb_ + (64 + nk) * KSTR + nc * 16) = R.b; *(LAS u32x4*)(kb_ + rkey * KSTR + 128 + rch * 16) = R.c;
                            u32x2 p, q; p.x = R.d.x; p.y = R.d.y; q.x = R.d.z; q.y = R.d.w; *(LAS u32x2*)vb_ = p; *(LAS u32x2*)(vb_ + 16) = q;
                            p.x = R.e.x; p.y = R.e.y; q.x = R.e.z; q.y = R.e.w; *(LAS u32x2*)(vb_ + 32 * VS2) = p; *(LAS u32x2*)(vb_ + 32 * VS2 + 16) = q; },
                        [&](int jj, int cb) __attribute__((always_inline)) {
                            const int kd = 32 * (wave & 1) + r32;
#pragma unroll
                            for (int hh = 0; hh < 2; ++hh) { const int j = 2 * jj + hh;
                                if (j <= jd) attn_step<6, VS2, true>(lds + (cb ? AM_K1 : AM_K0) + hh * 64 * KSTR, lds + (cb ? AM_V1 : AM_V0) + hh * 128, qf, SM, o, j == jd, 0, kd, j == 0, r32, hi); } });
                    { const float inv = 1.f / fmaxf(xhalf_sum(SM.l), 1e-30f); float ss = 0.f;
#pragma unroll
                      for (int dt = 0; dt < 2; ++dt)
#pragma unroll
                          for (int g = 0; g < 4; ++g) { const float v0 = o[dt][4 * g] * inv, v1 = o[dt][4 * g + 1] * inv, v2 = o[dt][4 * g + 2] * inv, v3 = o[dt][4 * g + 3] * inv; ss += v0 * v0 + v1 * v1 + v2 * v2 + v3 * v3;
                              u32x2 w; w.x = cvtpk(v0, v1); w.y = cvtpk(v2, v3); *(u32x2*)(Y + row * DM + h * 64 + 32 * dt + 8 * g + 4 * hi) = w; }
                      ss = xhalf_sum(ss); if (hi == 0) ssq_d[(size_t)h * M + row] = ss; }
                    __syncthreads();
                }
              }
            }
        }
        SEAM(pb + 2);
        if (IN(pb + 3)) {
        const int l_ = l; WS_PTRS();
            pg8::Gemm g{Y, (const bf16_t*)(ws + WS_WOUT) + (size_t)l * DM * DM, M, DM, DM}; pg8::StaticOrder S; S.init(M, DM, G, bid);
            pg8::EpiResid<true> E{XB, ssq_out, ssq_d, (LAS float*)(lds + 131072)};
            pg8::gemm_phase<pg8::EpiResid<true>, pg8::StaticOrder, true, true>(lds, g, S, E, wave);
            if (REP_G57) { pg8::EpiInProj E2{PB, DM, ssq_mix}; pg8::gemm_phase<pg8::EpiInProj, pg8::StaticOrder, true, true>(lds, g, S, E2, wave); }
        }
        SEAM(pb + 3);
        if (IN(pb + 4)) {
        const int l_ = l; WS_PTRS();
            pg8::Gemm g{XB, (const bf16_t*)(ws + WS_WGU) + (size_t)l * NGU * DM, M, NGU, DM}; pg8::StaticOrder S; S.init(M, NGU, G, bid);
            pg8::EpiSwiglu E{ACT, ssq_out};
            _Pragma("unroll 1") for (int rep = 0; rep < REP_G16; ++rep) pg8::gemm_phase<pg8::EpiSwiglu, pg8::StaticOrder, true, true>(lds, g, S, E, wave);
        }
        SEAM(pb + 4);
        if (IN(pb + 5)) {
        const int l_ = l; WS_PTRS();
            pg8::Gemm g{ACT, (const bf16_t*)(ws + WS_WDN) + (size_t)l * DM * FF, M, DM, FF}; pg8::StaticOrder S; S.init(M, DM, G, bid);
            pg8::EpiResid<false> E{XB, ssq_down, nullptr, (LAS float*)(lds + 131072)};
            pg8::gemm_phase<pg8::EpiResid<false>, pg8::StaticOrder, true, true>(lds, g, S, E, wave);
            if (REP_G57) { pg8::EpiInProj E2{Y, DM, ssq_mix}; pg8::gemm_phase<pg8::EpiInProj, pg8::StaticOrder, true, true>(lds, g, S, E2, wave); }
        }
        SEAM(pb + 5);
    }
    if (IN(13)) {
        const int l_ = 1; WS_PTRS();
        LAUNDER_TID();
        const float* ssqf = ssp_base + (size_t)5 * 4 * M; const int gw = bid * 8 + wave, NGW = G * 8;
        for (int m = gw; m < M; m += NGW) {
            const float rinv = rsqrtf(sum4p(ssqf, m) * (1.f / DM) + EPS);
            const u32x2* xr = (const u32x2*)(XB + (size_t)m * DM) + lane; f32x4* orow = (f32x4*)(out_ + (size_t)m * DM) + lane; const f32x4* gn = (const f32x4*)inp(args, 27) + lane;
#pragma unroll
            for (int j = 0; j < 4; ++j) { const u32x2 w = xr[64 * j]; const f32x4 g = gn[64 * j]; f32x4 v; v[0] = bflo(w.x) * rinv * g[0]; v[1] = bfhi(w.x) * rinv * g[1]; v[2] = bflo(w.y) * rinv * g[2]; v[3] = bfhi(w.y) * rinv * g[3]; orow[64 * j] = v; }
        }
    }
#undef IN
#undef SEAM
}

extern "C" void kernel_launch(void* const* d_in, const int* in_sizes, int n_in, void* d_out, int out_size, void* d_ws, size_t ws_size, hipStream_t stream) {
    static int grid = 0;
    if (grid == 0) {
        if (n_in != 28 || in_sizes[0] != M * DM || out_size != M * DM || ws_size < WS_END) { fprintf(stderr, "kernel_launch: unexpected shapes (n_in %d, ws %zu)\n", n_in, ws_size); grid = -1; return; }
        int dev = 0, cus = 0;
        if (hipGetDevice(&dev) != hipSuccess || hipDeviceGetAttribute(&cus, hipDeviceAttributeMultiprocessorCount, dev) != hipSuccess) { grid = -1; return; }
        if (hipFuncSetAttribute((const void*)fwd, hipFuncAttributeMaxDynamicSharedMemorySize, LDS_BYTES) != hipSuccess) { fprintf(stderr, "kernel_launch: hipFuncSetAttribute failed\n"); grid = -1; return; }
        int per_cu = 0;
        if (hipOccupancyMaxActiveBlocksPerMultiprocessor(&per_cu, (const void*)fwd, NTHR, LDS_BYTES) != hipSuccess || per_cu < 1) fprintf(stderr, "kernel_launch: occupancy query says %d\n", per_cu);
        (void)hipGetLastError();
        grid = cus;
    }
    if (grid < 0) return;
    (void)hipMemsetAsync((char*)d_ws + WS_CTL, 0, CTL_ZERO_BYTES, stream);
    Args a{};
    for (int i = 0; i < 28; ++i) a.in[i] = (const float*)d_in[i];
    a.out = (float*)d_out; a.ws = (unsigned char*)d_ws;
    if (MK_N_LAUNCHES == 1) { a.ph_lo = 0; a.ph_hi = 14; hipLaunchKernelGGL(fwd, dim3(grid), dim3(NTHR), LDS_BYTES, stream, a); }
    else for (int p = 0; p < 14; ++p) { a.ph_lo = p; a.ph_hi = p + 1; hipLaunchKernelGGL(fwd, dim3(grid), dim3(NTHR), LDS_BYTES, stream, a); }
}
```

```cpp
#include <hip/hip_runtime.h>
#include <cstdio>
#include <cstdint>

#ifndef MK_N_LAUNCHES
#define MK_N_LAUNCHES 1
#endif

#define REP_P0 1
#define REP_G16 1
#define REP_G57 0
#define REP_ATT 1
#define STAGGER 6
#define REP_J4B 1
#define REP_J3 1
#define REP_J1 1
#define REP_J2 1
#define REP_P3 1
#define REP_ONLY 0
#define LAS __attribute__((address_space(3)))
#define DI __device__ __forceinline__
typedef unsigned short bf16_t;
typedef short bf16x8 __attribute__((ext_vector_type(8)));
typedef float f32x4 __attribute__((ext_vector_type(4)));
typedef unsigned u32x4 __attribute__((ext_vector_type(4)));
typedef unsigned u32x2 __attribute__((ext_vector_type(2)));

constexpr int NB = 4, SEQ = 8192, M = NB * SEQ, DM = 1024, NIN = 2304, NINS = 2300, FF = 2816, NGU = 2 * FF;
constexpr float EPS = 1e-6f;
constexpr int C_AX = 0, C_AG = 256, C_BQ = 512, C_KC = 768, C_VC = 832, C_KS = 896, C_VS = 960, C_KW = 1024, C_VW = 1088, C_BG = 1152,
              C_CQ = 1164, C_CK = 1292, C_CV = 1420, C_GLR = 1676, C_OG = 1692, C_DCQ = 1948, C_DCKV = 2140, C_DKR = 2268;
constexpr size_t MiB = 1u << 20;
constexpr size_t WS_CTL = 0, CTL_ZERO_BYTES = 1 * MiB;
constexpr size_t WS_ACC = 64 * 1024;
constexpr size_t WS_SSQ0 = 1 * MiB;
constexpr size_t WS_HB = 1 * MiB + 256 * 1024;
constexpr size_t WS_WIN = 2 * MiB, WS_WOUT = 11 * MiB, WS_WGU = 15 * MiB, WS_WDN = 37 * MiB;
constexpr size_t WS_WUQT = 48 * MiB, WS_WUKVT = 48 * MiB + 512 * 1024, WS_W2T = 49 * MiB, WS_W1T = 50 * MiB;
constexpr size_t WS_WGT = 49 * MiB + 512 * 1024, WS_SP = 49 * MiB + 768 * 1024;
constexpr size_t WS_BCS = 352 * MiB;
constexpr size_t WS_CS64 = 64 * MiB, WS_CS32 = 72 * MiB;
constexpr size_t WS_XB = 80 * MiB, WS_Y = 144 * MiB, WS_PB = 208 * MiB, WS_ACT = 208 * MiB;
constexpr size_t WS_LA = 384 * MiB, WS_LH = 386 * MiB, WS_CIN = 388 * MiB;
constexpr size_t WS_KVC = 392 * MiB, WS_DEC = 408 * MiB, WS_SST = 410 * MiB;
constexpr size_t WS_MQ = 428 * MiB, WS_MKN = 452 * MiB, WS_MV = 468 * MiB, WS_MKR = 484 * MiB;
constexpr size_t WS_SSP = 500 * MiB;
constexpr size_t WS_KSF = 504 * MiB;
constexpr size_t WS_VST = 490 * MiB, WS_VWT = 494 * MiB, WS_KCMPB = 498 * MiB, WS_VCMPT = 499 * MiB, WS_END = 508 * MiB;
constexpr int CW_QUEUE = 64;
constexpr int CW_FLAG = 1024;
constexpr int CW_BAR = 4096;
constexpr int LDS_BYTES = 163840 - 256;
constexpr int LDS_CTL = LDS_BYTES - 64;
constexpr int NTHR = 512;

struct Args { const float* in[28]; float* out; unsigned char* ws; int ph_lo, ph_hi; };

DI float bf2f(bf16_t h) { return __uint_as_float(((unsigned)h) << 16); }
DI float bflo(unsigned u) { return __uint_as_float(u << 16); }
DI float bfhi(unsigned u) { return __uint_as_float(u & 0xffff0000u); }
DI bf16_t f2bf(float f) { unsigned u = __float_as_uint(f); return (bf16_t)((u + 0x7fffu + ((u >> 16) & 1u)) >> 16); }
DI unsigned pk2(float lo, float hi) { return (unsigned)f2bf(lo) | ((unsigned)f2bf(hi) << 16); }
DI float sum4p(const float* p, size_t row) { return (p[row] + p[(size_t)M + row]) + (p[2 * (size_t)M + row] + p[3 * (size_t)M + row]); }
DI int lane_id() { int l; asm volatile("v_mbcnt_lo_u32_b32 %0, -1, 0\n\tv_mbcnt_hi_u32_b32 %0, -1, %0" : "=v"(l)); return l; }
DI int tid_of(int wave) { return (wave << 6) + lane_id(); }
DI int shx(int v, int m) { return __builtin_amdgcn_ds_bpermute((lane_id() ^ m) << 2, v); }
DI unsigned shx(unsigned v, int m) { return (unsigned)__builtin_amdgcn_ds_bpermute((lane_id() ^ m) << 2, (int)v); }
DI float shx(float v, int m) { return __int_as_float(__builtin_amdgcn_ds_bpermute((lane_id() ^ m) << 2, __float_as_int(v))); }
DI float shf(float v, int src) { return __int_as_float(__builtin_amdgcn_ds_bpermute(src << 2, __float_as_int(v))); }
template <int CTRL> DI float dppf(float v) { return __int_as_float(__builtin_amdgcn_mov_dpp(__float_as_int(v), CTRL, 0xF, 0xF, true)); }
template <int CTRL> DI int dppi(int v) { return __builtin_amdgcn_mov_dpp(v, CTRL, 0xF, 0xF, true); }
DI float x16f_sum(float v) { auto rr = __builtin_amdgcn_permlane16_swap(__float_as_uint(v), __float_as_uint(v), false, false); return __uint_as_float(rr[0]) + __uint_as_float(rr[1]); }
DI float x32f_sum(float v) { auto rr = __builtin_amdgcn_permlane32_swap(__float_as_uint(v), __float_as_uint(v), false, false); return __uint_as_float(rr[0]) + __uint_as_float(rr[1]); }
DI float x32f_other(float v) { const unsigned u = __float_as_uint(v); auto rr = __builtin_amdgcn_permlane32_swap(u, u, false, false); return __uint_as_float(rr[0] ^ rr[1] ^ u); }
DI float quad_sum(float v) { v += dppf<0xB1>(v); v += dppf<0x4E>(v); return v; }
DI float wave_sum(float v) { v = quad_sum(v); v += dppf<0x141>(v); v += dppf<0x140>(v); v = x16f_sum(v); return x32f_sum(v); }
DI float wave_max(float v) {
    v = fmaxf(v, dppf<0xB1>(v)); v = fmaxf(v, dppf<0x4E>(v)); v = fmaxf(v, dppf<0x141>(v)); v = fmaxf(v, dppf<0x140>(v));
    { auto rr = __builtin_amdgcn_permlane16_swap(__float_as_uint(v), __float_as_uint(v), false, false); v = fmaxf(__uint_as_float(rr[0]), __uint_as_float(rr[1])); }
    { auto rr = __builtin_amdgcn_permlane32_swap(__float_as_uint(v), __float_as_uint(v), false, false); v = fmaxf(__uint_as_float(rr[0]), __uint_as_float(rr[1])); }
    return v;
}
DI int wave_min_i(int v) {
    { int w = dppi<0xB1>(v); v = w < v ? w : v; } { int w = dppi<0x4E>(v); v = w < v ? w : v; } { int w = dppi<0x141>(v); v = w < v ? w : v; } { int w = dppi<0x140>(v); v = w < v ? w : v; }
    { auto rr = __builtin_amdgcn_permlane16_swap((unsigned)v, (unsigned)v, false, false); const int a_ = (int)rr[0], b_ = (int)rr[1]; v = a_ < b_ ? a_ : b_; }
    { auto rr = __builtin_amdgcn_permlane32_swap((unsigned)v, (unsigned)v, false, false); const int a_ = (int)rr[0], b_ = (int)rr[1]; v = a_ < b_ ? a_ : b_; }
    return v;
}
DI unsigned wave_or(unsigned v) {
    v |= (unsigned)dppi<0xB1>((int)v); v |= (unsigned)dppi<0x4E>((int)v); v |= (unsigned)dppi<0x141>((int)v); v |= (unsigned)dppi<0x140>((int)v);
    { auto rr = __builtin_amdgcn_permlane16_swap(v, v, false, false); v = rr[0] | rr[1]; }
    { auto rr = __builtin_amdgcn_permlane32_swap(v, v, false, false); v = rr[0] | rr[1]; }
    return v;
}
DI float sigmoidf_(float x) { return __builtin_amdgcn_rcpf(1.f + __builtin_amdgcn_exp2f(-1.4426950408889634f * x)); }
DI float gelu_tanh(float x) { const float u = 0.7978845608028654f * (x + 0.044715f * x * x * x); return x * sigmoidf_(2.f * u); }
#define WSYNC() do { asm volatile("s_waitcnt lgkmcnt(0)" ::: "memory"); __builtin_amdgcn_wave_barrier(); } while (0)

namespace pg8 {
constexpr int BM = 256, BK = 64, HALF = 128, HTB = HALF * BK * 2, NXCD = 8, WGM = 8;
__host__ __device__ __forceinline__ int lds_byte(int r, int c) { const int st = (r >> 4) * 2 + (c >> 5), rr = r & 15, cc = c & 31, ob = rr * 64 + cc * 2; return st * 1024 + (ob ^ (((ob >> 9) & 1) << 5)); }
__host__ __device__ __forceinline__ void stage_rc(int b, int& R, int& C) { const int st = b / 1024, sb = b % 1024, swz = sb ^ (((sb >> 9) & 1) << 5); R = (st >> 1) * 16 + swz / 64; C = (st & 1) * 32 + (swz % 64) / 2; }
__host__ __device__ __forceinline__ int perm32(int rho) { const int n = rho >> 4, i = rho & 15; return 8 * (i >> 2) + 4 * n + (i & 3); }
struct Unit { int pm, pn; };
struct Gemm { const bf16_t* A; const bf16_t* Bt; int M, N, K; };
struct StaticOrder {
    int nM, nN, nwg, G, c;
    __host__ __device__ void init(int M_, int N_, int G_, int c_) { nM = M_ / BM; nN = N_ / BM; nwg = nM * nN; G = G_; c = c_; }
    __host__ __device__ bool next(int i, Unit& u) const {
        const long L = (long)i * G + c; if (L >= nwg) return false;
        int wgid = (int)L; { const int q = nwg / NXCD, r = nwg % NXCD, xcd = wgid % NXCD, off = wgid / NXCD; wgid = (xcd < r ? xcd * (q + 1) : r * (q + 1) + (xcd - r) * q) + off; }
        const int nig = WGM * nN, gid = wgid / nig, fm = gid * WGM, gsz = (nM - fm) < WGM ? (nM - fm) : WGM;
        u.pm = fm + ((wgid % nig) % gsz); u.pn = (wgid % nig) / gsz; return true;
    }
    __device__ __forceinline__ void a_ready(const Unit&) const {}
    __device__ __forceinline__ void done(const Unit&) const {}
};
DI unsigned cvt_pk_bf16(float lo, float hi) { unsigned r; asm volatile("v_cvt_pk_bf16_f32 %0, %1, %2" : "=v"(r) : "v"(lo), "v"(hi)); return r; }
DI void row_stats8(float (&out)[2][4], const float* p, int row0, int fq) {
    const unsigned voff = (unsigned)(fq * M + row0) * 4u;
    float v0, v1, v2, v3, v4, v5, v6, v7;
    asm volatile("global_load_dword %0, %8, %9\n\tglobal_load_dword %1, %8, %9 offset:64\n\tglobal_load_dword %2, %8, %9 offset:128\n\tglobal_load_dword %3, %8, %9 offset:192\n\t"
                 "global_load_dword %4, %8, %9 offset:512\n\tglobal_load_dword %5, %8, %9 offset:576\n\tglobal_load_dword %6, %8, %9 offset:640\n\tglobal_load_dword %7, %8, %9 offset:704\n\ts_waitcnt vmcnt(0)"
                 : "=&v"(v0), "=&v"(v1), "=&v"(v2), "=&v"(v3), "=&v"(v4), "=&v"(v5), "=&v"(v6), "=&v"(v7) : "v"(voff), "s"(p) : "memory");
    const int l4 = lane_id() << 2;
    const float v[8] = {v0, v1, v2, v3, v4, v5, v6, v7};
#pragma unroll
    for (int i = 0; i < 8; ++i) {
        float t = v[i];
        t += __int_as_float(__builtin_amdgcn_ds_bpermute(l4 ^ 64, __float_as_int(t)));
        t += __int_as_float(__builtin_amdgcn_ds_bpermute(l4 ^ 128, __float_as_int(t)));
        out[i >> 2][i & 3] = t;
    }
}
DI void row_stats_lds(float (&out)[2][4], const LAS float* sb, int rl0) {
#pragma unroll
    for (int ai = 0; ai < 2; ++ai)
#pragma unroll
        for (int m = 0; m < 4; ++m) { const LAS float* q = sb + rl0 + ai * HALF + m * 16; out[ai][m] = (q[0] + q[256]) + (q[512] + q[768]); }
}

struct EpiInProj {
    static constexpr bool PERM = true, AFTER_DRAIN = false, MIDSCALE = false; static constexpr int NST = 16;
    bf16_t* O; int ldc; const float* ssq;
    static constexpr bool STAT = true; DI const float* stat() const { return ssq; }
    DI void operator()(const f32x4 (&acc)[2][2][4][2], const Unit& u, int wr, int wc, int fr, int fq, const LAS float* sb) const {
        int row0 = u.pm * BM + wr * 64 + fr; asm volatile("" : "+v"(row0)); const int col0 = u.pn * BM + wc * 32 + 8 * fq;
        float rinvs[2][4]; row_stats_lds(rinvs, sb, wr * 64 + fr);
#pragma unroll
        for (int ai = 0; ai < 2; ++ai)
#pragma unroll
            for (int m = 0; m < 4; ++m) {
                const int row = row0 + ai * HALF + m * 16;
                const float rinv = rsqrtf(rinvs[ai][m] * (1.f / DM) + EPS);
                bf16_t* rowp = O + (size_t)row * ldc + col0;
#pragma unroll
                for (int bj = 0; bj < 2; ++bj) {
                    f32x4 v0 = acc[ai][bj][m][0] * rinv, v1 = acc[ai][bj][m][1] * rinv;
                    u32x4 w; w.x = cvt_pk_bf16(v0[0], v0[1]); w.y = cvt_pk_bf16(v0[2], v0[3]); w.z = cvt_pk_bf16(v1[0], v1[1]); w.w = cvt_pk_bf16(v1[2], v1[3]);
                    *(u32x4*)(rowp + bj * HALF) = w;
                }
            }
    }
};
template <bool MS> struct EpiResid {
    static constexpr bool PERM = true, AFTER_DRAIN = false, MIDSCALE = MS; static constexpr int NST = 16;
    bf16_t* xb; float* ssq_part; const float* ssq_mid; LAS float* ssl;
    static constexpr bool STAT = MS; DI const float* stat() const { return ssq_mid; }
    DI void midscale(f32x4 (&acc)[2][2][4][2], const Unit& u, int wr, int fr, const LAS float* sb) const {
        float sm_[2][4]; row_stats_lds(sm_, sb, wr * 64 + (fr & 15));
#pragma unroll
        for (int ai = 0; ai < 2; ++ai)
#pragma unroll
            for (int m = 0; m < 4; ++m) { const float s = rsqrtf(sm_[ai][m] * (1.f / 256.f) + EPS);
#pragma unroll
                for (int bj = 0; bj < 2; ++bj) { acc[ai][bj][m][0] *= s; acc[ai][bj][m][1] *= s; } }
    }
    DI void operator()(const f32x4 (&acc)[2][2][4][2], const Unit& u, int wr, int wc, int fr, int fq, const LAS float*) const {
        int rl0 = wr * 64 + fr; asm volatile("" : "+v"(rl0));
        const int col0 = u.pn * BM + wc * 32 + 8 * fq;
        u32x4 xin[2][4][2];
#pragma unroll
        for (int ai = 0; ai < 2; ++ai)
#pragma unroll
            for (int m = 0; m < 4; ++m)
#pragma unroll
                for (int bj = 0; bj < 2; ++bj) xin[ai][m][bj] = *(const u32x4*)(xb + ((size_t)u.pm * BM + rl0 + ai * HALF + m * 16) * DM + col0 + bj * HALF);
        __builtin_amdgcn_sched_barrier(0);
#pragma unroll
        for (int ai = 0; ai < 2; ++ai)
#pragma unroll
            for (int m = 0; m < 4; ++m) {
                const int rl = rl0 + ai * HALF + m * 16; const size_t row = (size_t)u.pm * BM + rl;
                float part = 0.f;
#pragma unroll
                for (int bj = 0; bj < 2; ++bj) {
                    u32x4* px = (u32x4*)(xb + row * DM + col0 + bj * HALF); const u32x4 xo = xin[ai][m][bj];
                    const f32x4 a0 = acc[ai][bj][m][0], a1 = acc[ai][bj][m][1];
                    const float v0 = a0[0] + bflo(xo.x), v1 = a0[1] + bfhi(xo.x), v2 = a0[2] + bflo(xo.y), v3 = a0[3] + bfhi(xo.y), v4 = a1[0] + bflo(xo.z), v5 = a1[1] + bfhi(xo.z), v6 = a1[2] + bflo(xo.w), v7 = a1[3] + bfhi(xo.w);
                    u32x4 w; w.x = cvt_pk_bf16(v0, v1); w.y = cvt_pk_bf16(v2, v3); w.z = cvt_pk_bf16(v4, v5); w.w = cvt_pk_bf16(v6, v7);
                    *px = w;
                    part += (v0 * v0 + v1 * v1) + (v2 * v2 + v3 * v3) + (v4 * v4 + v5 * v5) + (v6 * v6 + v7 * v7);
                }
                part = x32f_sum(x16f_sum(part));
                if (fq == 0) ssl[rl * 4 + wc] = part;
            }
        asm volatile("s_waitcnt lgkmcnt(0)" ::: "memory"); __builtin_amdgcn_s_barrier();
        int tq = tid_of(wr * 4 + wc); asm volatile("" : "+v"(tq));
        if (tq < 256) { const f32x4 p = *(const LAS f32x4*)(ssl + tq * 4); ssq_part[(size_t)u.pn * M + (size_t)u.pm * BM + tq] = (p[0] + p[1]) + (p[2] + p[3]); }
    }
};
struct EpiSwiglu {
    static constexpr bool PERM = true, AFTER_DRAIN = false, MIDSCALE = false; static constexpr int NST = 8;
    bf16_t* act; const float* ssq;
    static constexpr bool STAT = true; DI const float* stat() const { return ssq; }
    DI void operator()(const f32x4 (&acc)[2][2][4][2], const Unit& u, int wr, int wc, int fr, int fq, const LAS float* sb) const {
        int row0 = u.pm * BM + wr * 64 + fr; asm volatile("" : "+v"(row0)); const int jst = u.pn * 128 + wc * 16 + 4 * (fq & 2) + (fq & 1) * 64;
        float rinvs[2][4]; row_stats_lds(rinvs, sb, wr * 64 + fr);
#pragma unroll
        for (int ai = 0; ai < 2; ++ai)
#pragma unroll
            for (int m = 0; m < 4; ++m) {
                const int row = row0 + ai * HALF + m * 16;
                const float rinv = rsqrtf(rinvs[ai][m] * (1.f / DM) + EPS);
                u32x2 w[2];
#pragma unroll
                for (int bj = 0; bj < 2; ++bj) {
                    const f32x4 g = acc[ai][bj][m][0] * rinv, up = acc[ai][bj][m][1] * rinv;
                    float a[4];
#pragma unroll
                    for (int i = 0; i < 4; ++i) a[i] = g[i] * up[i] * __builtin_amdgcn_rcpf(1.f + __builtin_amdgcn_exp2f(-1.4426950408889634f * g[i]));
                    w[bj].x = cvt_pk_bf16(a[0], a[1]); w[bj].y = cvt_pk_bf16(a[2], a[3]);
                }
                const auto rx = __builtin_amdgcn_permlane16_swap(w[0].x, w[1].x, false, false), ry = __builtin_amdgcn_permlane16_swap(w[0].y, w[1].y, false, false);
                u32x4 o; o.x = rx[0]; o.y = ry[0]; o.z = rx[1]; o.w = ry[1];
                *(u32x4*)(act + (size_t)row * FF + jst) = o;
            }
    }
};

DI void glds_sv(unsigned voff, const void* sbase, unsigned lds_dst) {
    unsigned keep;
    asm volatile("s_mov_b32 %0, m0\n\ts_mov_b32 m0, %3\n\ts_nop 0\n\tglobal_load_lds_dwordx4 %1, %2\n\ts_mov_b32 m0, %0" : "=&s"(keep) : "v"(voff), "s"(sbase), "s"(lds_dst) : "memory");
}
DI void glds_sv4(unsigned voff, const void* sbase, unsigned lds_dst) {
    unsigned keep;
    asm volatile("s_mov_b32 %0, m0\n\ts_mov_b32 m0, %3\n\ts_nop 0\n\tglobal_load_lds_dword %1, %2\n\ts_mov_b32 m0, %0" : "=&s"(keep) : "v"(voff), "s"(sbase), "s"(lds_dst) : "memory");
}
template <class Epi, class Sched, bool ALIGN_EPI = false, bool SP2 = false>
DI void gemm_phase(LAS unsigned char* lds, const Gemm g, const Sched& S, const Epi& E, const int wave_) {
    int wv_ = wave_; asm volatile("" : "+s"(wv_));
    int tid_ = tid_of(wv_); asm volatile("" : "+v"(tid_));
    const int tid = tid_, wid = wv_, lane = tid & 63, wr = wid >> 2, wc = wid & 3, fr = lane & 15, fq = lane >> 4;
    const int K = g.K, nt = K / BK;
    unsigned voffA[2], voffB[2];
#pragma unroll
    for (int i = 0; i < 2; ++i) { int R, C; stage_rc(tid * 16 + i * 8192, R, C); const int Rb = Epi::PERM ? ((R & ~31) + perm32(R & 31)) : R;
        voffA[i] = (unsigned)(R * K + C) * 2u; voffB[i] = (unsigned)(Rb * K + C) * 2u; }
    const size_t kstep = (size_t)(BK * 2);
    const size_t hstep = (size_t)HALF * K * 2;
    const size_t tstep = 2 * hstep;
    const unsigned ldsw = (unsigned)wid * 1024u;
    const unsigned statb = (unsigned)(size_t)lds + 131072u + 4096u; const LAS float* sbuf = (const LAS float*)(lds + 131072 + 4096);
    const unsigned ldsb = (unsigned)(size_t)lds + ldsw;
    const int aoff = lds_byte(wr * 64 + fr, fq * 8), boff = lds_byte(wc * 32 + fr, fq * 8);
#define PG8_SA(b, h) (((b) * 2 + (h)) * HTB)
#define PG8_SB(b, h) ((4 + (b) * 2 + (h)) * HTB)
#define PG8_STAGE(bufoff, gbase, voff) do { _Pragma("unroll") for (int _i = 0; _i < 2; ++_i) \
        glds_sv((voff)[_i], (const void*)(gbase), ldsb + (unsigned)((bufoff) + _i * 8192)); } while (0)
#define PG8_LDA(dst, b, h) do { _Pragma("unroll") for (int m = 0; m < 4; ++m) _Pragma("unroll") for (int k = 0; k < 2; ++k) dst[m][k] = *(const LAS bf16x8*)(lds + PG8_SA(b, h) + aoff + m * 2048 + k * 1024); } while (0)
#define PG8_LDB(dst, b, h) do { _Pragma("unroll") for (int n = 0; n < 2; ++n) _Pragma("unroll") for (int k = 0; k < 2; ++k) dst[n][k] = *(const LAS bf16x8*)(lds + PG8_SB(b, h) + boff + n * 2048 + k * 1024); } while (0)
#define PG8_MMA(ai, bj, At, Bt) do { __builtin_amdgcn_s_setprio(1); _Pragma("unroll") for (int m = 0; m < 4; ++m) _Pragma("unroll") for (int n = 0; n < 2; ++n) _Pragma("unroll") for (int k = 0; k < 2; ++k) \
        acc[ai][bj][m][n] = __builtin_amdgcn_mfma_f32_16x16x32_bf16(Bt[n][k], At[m][k], acc[ai][bj][m][n], 0, 0, 0); __builtin_amdgcn_s_setprio(0); } while (0)
#define PG8_WAIT_V(n) asm volatile("s_waitcnt vmcnt(" #n ")" ::: "memory")
#define PG8_WAIT_L(n) asm volatile("s_waitcnt lgkmcnt(" #n ")" ::: "memory")
#define PG8_WAIT_VF do { if constexpr (Epi::NST == 16) PG8_WAIT_V(24); else PG8_WAIT_V(16); } while (0)
#define PG8_BAR __builtin_amdgcn_s_barrier()
#define PG8_SCHED __builtin_amdgcn_sched_barrier(0)
    Unit cur, nxt; int ui = 0;
    if (!S.next(0, cur)) return;
    f32x4 acc[2][2][4][2];
#pragma unroll
    for (int a = 0; a < 2; ++a)
#pragma unroll
        for (int b = 0; b < 2; ++b)
#pragma unroll
            for (int m = 0; m < 4; ++m)
#pragma unroll
                for (int n = 0; n < 2; ++n) acc[a][b][m][n] = (f32x4){0.f, 0.f, 0.f, 0.f};
    bf16x8 At[4][2], B0[2][2], B1[2][2];
    const char* cA = (const char*)g.A + (size_t)cur.pm * tstep; const char* cB = (const char*)g.Bt + (size_t)cur.pn * tstep;
    S.a_ready(cur);
    if constexpr (SP2) {
        PG8_STAGE(PG8_SB(0, 0), cB, voffB); PG8_STAGE(PG8_SB(0, 1), cB + hstep, voffB); PG8_STAGE(PG8_SA(0, 0), cA, voffA); PG8_STAGE(PG8_SA(0, 1), cA + hstep, voffA);
        if (wr == 1) PG8_BAR;
        PG8_WAIT_V(2); PG8_BAR;
        PG8_STAGE(PG8_SB(1, 0), cB + kstep, voffB); PG8_STAGE(PG8_SA(1, 0), cA + kstep, voffA); PG8_STAGE(PG8_SB(1, 1), cB + hstep + kstep, voffB);
        PG8_WAIT_V(6); PG8_BAR;
        PG8_STAGE(PG8_SA(1, 1), cA + hstep + kstep, voffA);
#pragma unroll
        for (int i = 0; i < Epi::NST / 2; ++i) PG8_STAGE(PG8_SA(1, 1), cA + hstep + kstep, voffA);
    } else {
        PG8_STAGE(PG8_SB(0, 0), cB, voffB); PG8_STAGE(PG8_SA(0, 0), cA, voffA); PG8_STAGE(PG8_SB(0, 1), cB + hstep, voffB); PG8_STAGE(PG8_SA(0, 1), cA + hstep, voffA);
        if (wr == 1) PG8_BAR;
        PG8_WAIT_V(4); PG8_BAR;
        PG8_STAGE(PG8_SB(1, 0), cB + kstep, voffB); PG8_STAGE(PG8_SA(1, 0), cA + kstep, voffA); PG8_STAGE(PG8_SB(1, 1), cB + hstep + kstep, voffB);
        PG8_WAIT_V(6); PG8_BAR;
    }
    for (;;) {
        const bool has_next = S.next(ui + 1, nxt);
        const char* nA = has_next ? (const char*)g.A + (size_t)nxt.pm * tstep : cA; const char* nB = has_next ? (const char*)g.Bt + (size_t)nxt.pn * tstep : cB;
        static_assert(SP2, "only the SP2 schedule is kept");
#define PG8_STATDMA do { if constexpr (Epi::STAT) { const float* sp_ = E.stat() + (size_t)cur.pm * BM; int l4_ = lane_id() << 2; \
            _Pragma("unroll") for (int i_ = 0; i_ < 2; ++i_) { const int ix_ = wid * 2 + i_; glds_sv4((unsigned)l4_, sp_ + (size_t)(ix_ >> 2) * M + (ix_ & 3) * 64, statb + (unsigned)(ix_ * 256)); } } } while (0)
#define PG8_TRIP(t, WV, PRE2) do { \
            const bool last = ((t) == nt - 2); \
            const char* a2 = last ? nA : cA + (size_t)((t) + 2) * kstep; const char* b2 = last ? nB : cB + (size_t)((t) + 2) * kstep; \
            const char* a3 = a2 + kstep; const char* b3 = b2 + kstep; \
            if (last && has_next) S.a_ready(nxt); \
            PG8_LDB(B0, 0, 0); PG8_LDB(B1, 0, 1); PG8_SCHED; PG8_LDA(At, 0, 0); \
            WV; PG8_WAIT_L(0); PG8_BAR; PG8_MMA(0, 0, At, B0); PG8_MMA(0, 1, At, B1); PG8_BAR; PG8_SCHED; \
            PG8_LDA(At, 0, 1); PRE2; PG8_STAGE(PG8_SB(0, 0), b2, voffB); PG8_STAGE(PG8_SB(0, 1), b2 + hstep, voffB); PG8_STAGE(PG8_SA(0, 0), a2, voffA); \
            WV; PG8_WAIT_L(0); PG8_BAR; PG8_MMA(1, 0, At, B0); PG8_MMA(1, 1, At, B1); PG8_BAR; PG8_SCHED; \
            PG8_LDB(B0, 1, 0); PG8_LDB(B1, 1, 1); PG8_SCHED; PG8_LDA(At, 1, 0); PG8_STAGE(PG8_SA(0, 1), a2 + hstep, voffA); \
            WV; PG8_WAIT_L(0); PG8_BAR; PG8_MMA(0, 0, At, B0); PG8_MMA(0, 1, At, B1); PG8_BAR; PG8_SCHED; \
            PG8_LDA(At, 1, 1); PG8_STAGE(PG8_SB(1, 0), b3, voffB); PG8_STAGE(PG8_SB(1, 1), b3 + hstep, voffB); PG8_STAGE(PG8_SA(1, 0), a3, voffA); \
            PG8_WAIT_V(8); PG8_WAIT_L(0); PG8_BAR; PG8_MMA(1, 0, At, B0); PG8_MMA(1, 1, At, B1); PG8_BAR; PG8_SCHED; \
            PG8_STAGE(PG8_SA(1, 1), a3 + hstep, voffA); } while (0)
        PG8_TRIP(0, PG8_WAIT_VF, PG8_STATDMA);
        for (int t = 2; t < nt; t += 2) {
            PG8_TRIP(t, PG8_WAIT_V(8), (void)0);
            if constexpr (Epi::MIDSCALE) { if (t == 2) { int te = lane_id(); asm volatile("" : "+v"(te)); E.midscale(acc, cur, wr, te, sbuf); } }
        }
#undef PG8_TRIP
#undef PG8_STATDMA
        if constexpr (ALIGN_EPI) { if (wr == 0) PG8_BAR; }
        if constexpr (!Epi::AFTER_DRAIN) { int te = lane_id(); asm volatile("" : "+v"(te)); E(acc, cur, wr, wc, te & 15, te >> 4, sbuf); S.done(cur); }
        if (!has_next) break;
#pragma unroll
        for (int a = 0; a < 2; ++a)
#pragma unroll
            for (int b = 0; b < 2; ++b)
#pragma unroll
                for (int m = 0; m < 4; ++m)
#pragma unroll
                    for (int n = 0; n < 2; ++n) acc[a][b][m][n] = (f32x4){0.f, 0.f, 0.f, 0.f};
        cur = nxt; cA = nA; cB = nB; ++ui;
        if constexpr (ALIGN_EPI) { if (wr == 1) PG8_BAR; }
    }
    PG8_WAIT_V(0);
    if constexpr (!ALIGN_EPI) { if (wr == 0) PG8_BAR; }
    PG8_BAR;
#undef PG8_SA
#undef PG8_SB
#undef PG8_STAGE
#undef PG8_LDA
#undef PG8_LDB
#undef PG8_MMA
#undef PG8_WAIT_V
#undef PG8_WAIT_L
#undef PG8_WAIT_VF
#undef PG8_BAR
#undef PG8_SCHED
}
}

#define XB_TMO      128
#define XB_XCNT(j)  (256  + 64 * (j))
#define XB_XSUB(j)  (1280 + 64 * (j))
#define XB_XGEN(j)  (2304 + 64 * (j))
#define XB_TOP      3328
#define XB_TOPGEN   3392
#define XCD_BAR_WORDS 3456
#define XB_SPIN_CAP (1u << 18)
__device__ __forceinline__ unsigned xb_ld(unsigned* p)              { return __hip_atomic_load(p, __ATOMIC_RELAXED, __HIP_MEMORY_SCOPE_AGENT); }
__device__ __forceinline__ unsigned xb_add(unsigned* p, unsigned v) { return __hip_atomic_fetch_add(p, v, __ATOMIC_RELAXED, __HIP_MEMORY_SCOPE_AGENT); }
__device__ __forceinline__ unsigned xb_xcc_id() { return (unsigned)__builtin_amdgcn_s_getreg((3 << 11) | 20) & 0xFu; }
#define XB_SPIN(cond, bar) do { unsigned _sp = 0; while (cond) { __builtin_amdgcn_s_sleep(1); \
    if ((++_sp & 255u) == 0u) { if (xb_ld(&(bar)[XB_TMO])) break; if (_sp > XB_SPIN_CAP) { atomicAdd(&(bar)[XB_TMO], 1u); break; } } } } while (0)
struct XcdBarrier { unsigned* bar; unsigned x; volatile LAS unsigned* st; };
__device__ __forceinline__ XcdBarrier xcd_barrier_post(unsigned* bar, volatile LAS unsigned* st, const int tidx) {
    XcdBarrier b; b.bar = bar; b.x = xb_xcc_id(); b.st = st;
    if (tidx == 0) (void)xb_add(&bar[XB_XCNT(b.x)], 1u);
    return b;
}
__device__ __forceinline__ void xcd_barrier_complete(unsigned* bar, unsigned x, unsigned& nloc, unsigned& nx) {
    const unsigned G = gridDim.x * gridDim.y * gridDim.z;
    unsigned sum, cnt, mine, sp = 0u;
    for (;;) {
        sum = 0u; cnt = 0u; mine = 0u;
#pragma unroll
        for (unsigned j = 0; j < 16; ++j) { const unsigned c = xb_ld(&bar[XB_XCNT(j)]); sum += c; cnt += (c > 0u) ? 1u : 0u; mine = (j == x) ? c : mine; }
        if (sum == G) break;
        __builtin_amdgcn_s_sleep(1);
        if ((++sp & 255u) == 0u) { if (xb_ld(&bar[XB_TMO])) break; if (sp > XB_SPIN_CAP) { atomicAdd(&bar[XB_TMO], 1u); break; } }
    }
    nloc = mine > 0u ? mine : 1u; nx = cnt > 0u ? cnt : 1u;
}
__device__ __forceinline__ void xcd_barrier(const XcdBarrier& b, const int tidx) {
    asm volatile("s_waitcnt vmcnt(0)" ::: "memory");
    __syncthreads();
    if (tidx == 0) {
        unsigned* bar = b.bar;
        __builtin_amdgcn_s_waitcnt(0);
        unsigned nloc = b.st[0], nx = b.st[1];
        if (nloc == 0u) { xcd_barrier_complete(bar, b.x, nloc, nx); b.st[0] = nloc; b.st[1] = nx; }
        const unsigned old = xb_add(&bar[XB_XSUB(b.x)], 1u);
        const unsigned gen = old / nloc;
        if (old + 1u == (gen + 1u) * nloc) {
            __builtin_amdgcn_fence(__ATOMIC_RELEASE, "agent");
            asm volatile("s_waitcnt vmcnt(0)" ::: "memory");
            const unsigned og = xb_add(&bar[XB_TOP], 1u);
            const unsigned tg = og / nx;
            if (og + 1u == (tg + 1u) * nx) xb_add(&bar[XB_TOPGEN], 1u);
            else XB_SPIN(xb_ld(&bar[XB_TOPGEN]) == tg, bar);
            __builtin_amdgcn_fence(__ATOMIC_ACQUIRE, "agent");
            xb_add(&bar[XB_XGEN(b.x)], 1u);
            asm volatile("s_waitcnt vmcnt(0)" ::: "memory");
        } else {
            XB_SPIN(xb_ld(&bar[XB_XGEN(b.x)]) == gen, bar);
            __builtin_amdgcn_fence(__ATOMIC_ACQUIRE, "agent");
            asm volatile("s_waitcnt vmcnt(0)" ::: "memory");
        }
    }
    __syncthreads();
}

template <int MAP>
DI int colmap(int v, int Nsrc) {
    if (MAP == 0) return v < Nsrc ? v : -1;
    const int g8 = v >> 3, e = v & 7, j = 4 * g8 + (e & 3); return (e < 4) ? j : FF + j;
}
template <int MAP, int KROT = 0>
DI void p0_transpose_item64(const float* W, int K, int Nsrc, const float* gain, bf16_t* WT, LAS float* scr, int kb, int nb, int lane) {
    const int k0 = 64 * kb, n0 = 64 * nb, v = n0 + 4 * (lane & 15);
    const int sc = MAP == 0 ? (v < Nsrc ? v : -1) : ((v >> 3) * 4 + ((v >> 2) & 1) * FF);
    const int scc = sc >= 0 ? sc : 0; const float* gp = gain ? gain : W; f32x4 wv[16]; float gv[16];
#pragma unroll
    for (int i = 0; i < 16; ++i) { const int kk = 4 * i + (lane >> 4); int ksrc = k0 + kk + KROT; if (KROT && ksrc >= K) ksrc -= K; wv[i] = *(const f32x4*)(W + (size_t)ksrc * Nsrc + scc); gv[i] = gp[ksrc]; }
    __builtin_amdgcn_sched_barrier(0);
#pragma unroll
    for (int i = 0; i < 16; ++i) { const int kk = 4 * i + (lane >> 4); const float gm = sc >= 0 ? (gain ? gv[i] : 1.f) : 0.f; const f32x4 w = wv[i] * gm;
        LAS float* d = scr + kk * 65 + 4 * (lane & 15); d[0] = w[0]; d[1] = w[1]; d[2] = w[2]; d[3] = w[3]; }
    WSYNC();
    const int c = lane & 7;
#pragma unroll
    for (int j = 0; j < 8; ++j) { const int n = (lane >> 3) + 8 * j; const LAS float* s = scr + (8 * c) * 65 + n;
        u32x4 o; o.x = pk2(s[0 * 65], s[1 * 65]); o.y = pk2(s[2 * 65], s[3 * 65]); o.z = pk2(s[4 * 65], s[5 * 65]); o.w = pk2(s[6 * 65], s[7 * 65]);
        *(u32x4*)(WT + (size_t)(n0 + n) * K + k0 + 8 * c) = o; }
    WSYNC();
}
template <int MAP, int KROT = 0>
DI void p0_transpose_item(const float* W, int K, int Nsrc, const float* gain, bf16_t* WT, LAS float* scr, int kb, int nb, int lane) {
    const int k0 = 64 * kb, n0 = 32 * nb;
    const int sc = colmap<MAP>(n0 + (lane & 31), Nsrc);
    const int scc = sc >= 0 ? sc : 0; const float* gp = gain ? gain : W; float wv[32], gv[32];
#pragma unroll
    for (int i = 0; i < 32; ++i) { const int kk = 2 * i + (lane >> 5); int ksrc = k0 + kk + KROT; if (KROT && ksrc >= K) ksrc -= K; wv[i] = W[(size_t)ksrc * Nsrc + scc]; gv[i] = gp[ksrc]; }
    __builtin_amdgcn_sched_barrier(0);
#pragma unroll
    for (int i = 0; i < 32; ++i) { const int kk = 2 * i + (lane >> 5); const float gm = sc >= 0 ? (gain ? gv[i] : 1.f) : 0.f; scr[kk * 33 + (lane & 31)] = wv[i] * gm; }
    WSYNC();
    const int c = lane & 7;
#pragma unroll
    for (int j = 0; j < 4; ++j) { const int n = (lane >> 3) + 8 * j; const LAS float* s = scr + (8 * c) * 33 + n;
        u32x4 o; o.x = pk2(s[0 * 33], s[1 * 33]); o.y = pk2(s[2 * 33], s[3 * 33]); o.z = pk2(s[4 * 33], s[5 * 33]); o.w = pk2(s[6 * 33], s[7 * 33]);
        *(u32x4*)(WT + (size_t)(n0 + n) * K + k0 + 8 * c) = o; }
    WSYNC();
}


typedef float f32x16 __attribute__((ext_vector_type(16)));
typedef float f32x2v __attribute__((ext_vector_type(2)));
typedef __bf16 bf16x2_t __attribute__((ext_vector_type(2)));
constexpr int KSTR = 208, VSTR = 136;
constexpr int VSTP = 144;
constexpr int AL_K0 = 0, AL_K1 = 64 * KSTR, AL_V0 = 2 * 64 * KSTR, AL_V1 = AL_V0 + 64 * VSTP, AL_IMP = 45056, AL_SELM = AL_IMP + 32768, AL_OACC = AL_SELM + 1024;
constexpr float NEGB = -1e30f, LOG2E = 1.4426950408889634f;
DI unsigned cvtpk(float lo, float hi) { f32x2v v = {lo, hi}; bf16x2_t b = __builtin_convertvector(v, bf16x2_t); return __builtin_bit_cast(unsigned, b); }
DI f32x16 mfma32(bf16x8 a, bf16x8 b, f32x16 c) { return __builtin_amdgcn_mfma_f32_32x32x16_bf16(a, b, c, 0, 0, 0); }
DI float xhalf_max(float v) { auto rr = __builtin_amdgcn_permlane32_swap(__float_as_uint(v), __float_as_uint(v), false, false); return fmaxf(__uint_as_float(rr[0]), __uint_as_float(rr[1])); }
DI float xhalf_sum(float v) { auto rr = __builtin_amdgcn_permlane32_swap(__float_as_uint(v), __float_as_uint(v), false, false); return __uint_as_float(rr[0]) + __uint_as_float(rr[1]); }
DI float ex2(float x) { return __builtin_amdgcn_exp2f(x); }
template <int KSTEPS>
DI void qk_tile(const LAS unsigned char* Kt, const bf16x8 (&qf)[KSTEPS], int r32, int hi, f32x16& s0, f32x16& s1) {
    const LAS unsigned char* p0 = Kt + r32 * KSTR + hi * 16;
#pragma unroll
    for (int i = 0; i < 16; ++i) { s0[i] = 0.f; s1[i] = 0.f; }
#pragma unroll
    for (int ks = 0; ks < KSTEPS; ++ks) {
        const bf16x8 a0 = *(const LAS bf16x8*)(p0 + ks * 32), a1 = *(const LAS bf16x8*)(p0 + 32 * KSTR + ks * 32);
        s0 = mfma32(a0, qf[ks], s0); s1 = mfma32(a1, qf[ks], s1);
    }
}
DI void mask_tile(f32x16& s0, f32x16& s1, int klo, int khi, int hi) {
    const int lo_ = klo - 4 * hi, hi_ = khi - 4 * hi;
#pragma unroll
    for (int i = 0; i < 16; ++i) { const int kb = (i & 3) + 8 * (i >> 2); if (kb < lo_ || kb > hi_) s0[i] = NEGB; if (kb + 32 < lo_ || kb + 32 > hi_) s1[i] = NEGB; }
}
DI float tile_max(const f32x16& s0, const f32x16& s1) {
    float mx = fmaxf(s0[0], s1[0]);
#pragma unroll
    for (int i = 1; i < 16; ++i) mx = fmaxf(mx, fmaxf(s0[i], s1[i]));
    return xhalf_max(mx);
}
template <int BASE> DI bf16x8 pack8(const f32x16& s) { u32x4 p; p.x = cvtpk(s[BASE], s[BASE + 1]); p.y = cvtpk(s[BASE + 2], s[BASE + 3]); p.z = cvtpk(s[BASE + 4], s[BASE + 5]); p.w = cvtpk(s[BASE + 6], s[BASE + 7]); return __builtin_bit_cast(bf16x8, p); }
DI bf16x8 ld8x2(const bf16_t* p) { const u32x2 a = *(const u32x2*)p, b = *(const u32x2*)(p + 4); u32x4 w; w.x = a.x; w.y = a.y; w.z = b.x; w.w = b.y; return __builtin_bit_cast(bf16x8, w); }
DI bf16x8 vfrag(const LAS unsigned char* p) { const u32x2 a = *(const LAS u32x2*)p, b = *(const LAS u32x2*)(p + 16); u32x4 w; w.x = a.x; w.y = a.y; w.z = b.x; w.w = b.y; return __builtin_bit_cast(bf16x8, w); }
template <int VS = VSTP>
DI void pv_tile(const f32x16& s0, const f32x16& s1, const LAS unsigned char* Vt, f32x16 (&o)[2], int r32, int hi) {
    const bf16x8 p00 = pack8<0>(s0), p01 = pack8<8>(s0), p10 = pack8<0>(s1), p11 = pack8<8>(s1);
#pragma unroll
    for (int dt = 0; dt < 2; ++dt) { const LAS unsigned char* vp = Vt + (32 * dt + r32) * VS + 16 * hi;
        o[dt] = mfma32(*(const LAS bf16x8*)vp, p00, o[dt]); o[dt] = mfma32(*(const LAS bf16x8*)(vp + 32), p01, o[dt]); o[dt] = mfma32(*(const LAS bf16x8*)(vp + 64), p10, o[dt]); o[dt] = mfma32(*(const LAS bf16x8*)(vp + 96), p11, o[dt]); }
}
DI void softmax_pv(f32x16& s0, f32x16& s1, const LAS unsigned char* Vt, f32x16 (&o)[2], float& m, float& l, int r32, int hi) {
    const float mx = tile_max(s0, s1), mn = fmaxf(m, mx), ms = mn < -1e29f ? 0.f : mn, alpha = ex2(m - ms);
    m = mn; float psum = 0.f;
#pragma unroll
    for (int i = 0; i < 16; ++i) { s0[i] = ex2(s0[i] - ms); s1[i] = ex2(s1[i] - ms); psum += s0[i] + s1[i]; }
    l = l * alpha + psum;
    if (!__all(alpha == 1.f)) {
#pragma unroll
        for (int i = 0; i < 16; ++i) { o[0][i] *= alpha; o[1][i] *= alpha; } }
    pv_tile(s0, s1, Vt, o, r32, hi);
}
struct SoftState { float m, l; };
constexpr float SM_THR = 8.f;
DI void soft_init(SoftState& S, f32x16 (&o)[2]) { S.m = 0.f; S.l = 0.f;
#pragma unroll
    for (int i = 0; i < 16; ++i) { o[0][i] = 0.f; o[1][i] = 0.f; } }
DI f32x16 bcast16(float v) { f32x16 c;
#pragma unroll
    for (int i = 0; i < 16; ++i) c[i] = v;
    return c; }
DI float max3f(float a, float b, float c) { float r; asm("v_max3_f32 %0, %1, %2, %3" : "=v"(r) : "v"(a), "v"(b), "v"(c)); return r; }
template <int VS>
DI void load_vfrags(const LAS unsigned char* Vt, bf16x8 (&vfr)[2][4], int r32, int hi) {
#pragma unroll
    for (int dt = 0; dt < 2; ++dt) { const LAS unsigned char* vp = Vt + (32 * dt + r32) * VS + 16 * hi;
#pragma unroll
        for (int s = 0; s < 4; ++s) vfr[dt][s] = *(const LAS bf16x8*)(vp + 32 * s); }
}
DI void pv_regs(const f32x16& s0, const f32x16& s1, const bf16x8 (&vfr)[2][4], f32x16 (&o)[2]) {
    const bf16x8 p00 = pack8<0>(s0), p01 = pack8<8>(s0), p10 = pack8<0>(s1), p11 = pack8<8>(s1);
#pragma unroll
    for (int dt = 0; dt < 2; ++dt) { o[dt] = mfma32(vfr[dt][0], p00, o[dt]); o[dt] = mfma32(vfr[dt][1], p01, o[dt]); o[dt] = mfma32(vfr[dt][2], p10, o[dt]); o[dt] = mfma32(vfr[dt][3], p11, o[dt]); }
}
DI float soft_update(f32x16& s0, f32x16& s1, SoftState& S, f32x16 (&o)[2], bool masked, int klo, int khi, bool first, int hi, float adj = 0.f) {
    if (__any(adj != 0.f)) {
#pragma unroll
        for (int i = 0; i < 16; ++i) { s0[i] -= adj; s1[i] -= adj; } }
    float dl_ret = 0.f;
    if (__builtin_expect(masked, 0)) { asm volatile("; boundary tile mask" ::: "memory"); mask_tile(s0, s1, klo, khi, hi); }
    asm volatile("s_nop 15\n\ts_nop 7" : "+v"(s0), "+v"(s1));
    float rm;
    { float a = max3f(s0[0], s0[1], s0[2]), b = max3f(s1[0], s1[1], s1[2]);
#pragma unroll
      for (int i = 3; i < 15; i += 2) { a = max3f(a, s0[i], s0[i + 1]); b = max3f(b, s1[i], s1[i + 1]); }
      rm = xhalf_max(fmaxf(max3f(a, b, s0[15]), s1[15])); }
    if (first) {
        const float dl = rm < -1e29f ? 0.f : rm; S.m = dl; dl_ret = dl;
#pragma unroll
        for (int i = 0; i < 16; ++i) { s0[i] -= dl; s1[i] -= dl; }
    } else if (__any(rm > SM_THR)) {
        const float dl = fmaxf(rm, 0.f), alpha = ex2(-dl); S.m += dl; S.l *= alpha; dl_ret = dl;
#pragma unroll
        for (int i = 0; i < 16; ++i) { s0[i] -= dl; s1[i] -= dl; o[0][i] *= alpha; o[1][i] *= alpha; }
    }
    float p0 = 0.f, p1 = 0.f, p2 = 0.f, p3 = 0.f;
#pragma unroll
    for (int i = 0; i < 16; i += 2) { s0[i] = ex2(s0[i]); s0[i + 1] = ex2(s0[i + 1]); s1[i] = ex2(s1[i]); s1[i + 1] = ex2(s1[i + 1]); p0 += s0[i]; p1 += s0[i + 1]; p2 += s1[i]; p3 += s1[i + 1]; }
    S.l += (p0 + p1) + (p2 + p3);
    return dl_ret;
}
template <int KSTEPS, int VS = VSTP, bool VPREF = false>
DI void attn_step(const LAS unsigned char* Kt, const LAS unsigned char* Vt, const bf16x8 (&qf)[KSTEPS], SoftState& S, f32x16 (&o)[2], bool masked, int klo, int khi, bool first, int r32, int hi) {
    const f32x16 cinit = bcast16(-S.m); f32x16 s0 = cinit, s1 = cinit;
    { const LAS unsigned char* p0 = Kt + r32 * KSTR + hi * 16;
#pragma unroll
      for (int ks = 0; ks < KSTEPS; ++ks) { const bf16x8 a0 = *(const LAS bf16x8*)(p0 + ks * 32), a1 = *(const LAS bf16x8*)(p0 + 32 * KSTR + ks * 32);
          s0 = mfma32(a0, qf[ks], s0); s1 = mfma32(a1, qf[ks], s1); } }
    if constexpr (VPREF) { bf16x8 vfr[2][4]; load_vfrags<VS>(Vt, vfr, r32, hi); __builtin_amdgcn_sched_barrier(0);
        soft_update(s0, s1, S, o, masked, klo, khi, first, hi);
        __builtin_amdgcn_sched_barrier(0);
        pv_regs(s0, s1, vfr, o); }
    else { soft_update(s0, s1, S, o, masked, klo, khi, first, hi); pv_tile<VS>(s0, s1, Vt, o, r32, hi); }
}
template <int KSTEPS, int VS>
DI void attn_step2(const LAS unsigned char* Kt, const LAS unsigned char* Vt, const bf16x8 (&qf)[KSTEPS], SoftState& S, f32x16 (&o)[2], bool masked0, int khi0, bool masked1, int khi1, bool first, int r32, int hi) {
    const f32x16 cinit = bcast16(-S.m); f32x16 a0 = cinit, a1 = cinit, b0 = cinit, b1 = cinit;
    { const LAS unsigned char* p0 = Kt + r32 * KSTR + hi * 16;
#pragma unroll
      for (int ks = 0; ks < KSTEPS; ++ks) { const bf16x8 k0 = *(const LAS bf16x8*)(p0 + ks * 32), k1 = *(const LAS bf16x8*)(p0 + 32 * KSTR + ks * 32);
          a0 = mfma32(k0, qf[ks], a0); a1 = mfma32(k1, qf[ks], a1); }
#pragma unroll
      for (int ks = 0; ks < KSTEPS; ++ks) { const bf16x8 k0 = *(const LAS bf16x8*)(p0 + 64 * KSTR + ks * 32), k1 = *(const LAS bf16x8*)(p0 + 96 * KSTR + ks * 32);
          b0 = mfma32(k0, qf[ks], b0); b1 = mfma32(k1, qf[ks], b1); } }
    bf16x8 vfr[2][4]; load_vfrags<VS>(Vt, vfr, r32, hi); __builtin_amdgcn_sched_barrier(0);
    const float dl0 = soft_update(a0, a1, S, o, masked0, 0, khi0, first, hi);
    __builtin_amdgcn_sched_barrier(0);
    pv_regs(a0, a1, vfr, o);
    __builtin_amdgcn_sched_barrier(0);
    load_vfrags<VS>(Vt + 128, vfr, r32, hi); __builtin_amdgcn_sched_barrier(0);
    (void)soft_update(b0, b1, S, o, masked1, 0, khi1, false, hi, dl0);
    __builtin_amdgcn_sched_barrier(0);
    pv_regs(b0, b1, vfr, o);
}
struct StageRegs { u32x4 a, b, c, d, e; };
#define SLD16(base_ptr, off_elems) ({ const __attribute__((address_space(1))) char* b__ = (const __attribute__((address_space(1))) char*)(base_ptr); unsigned o__ = (unsigned)(off_elems) * 2u; \
    asm volatile("" : "+s"(b__), "+v"(o__)); *(const __attribute__((address_space(1))) u32x4*)(b__ + o__); })
template <class LoadF, class StoreF, class StepF>
DI void attn_pipeline(const int wave_, int jbeg, int jend, LoadF ld, StoreF st, StepF step) {
    if (jbeg > jend) return;
    StageRegs RA;
    ld(jbeg, RA); st(0, RA);
    __builtin_amdgcn_s_waitcnt(0x0F70);
    __syncthreads();
    for (int j = jbeg; j <= jend; j += 2) {
        if (j + 1 <= jend) ld(j + 1, RA);
        step(j, 0);
        if (j + 1 <= jend) st(1, RA);
        __syncthreads();
        if (STAGGER && wave_ >= 4) __builtin_amdgcn_s_sleep(STAGGER);
        if (j + 1 > jend) break;
        if (j + 2 <= jend) ld(j + 2, RA);
        step(j + 1, 1);
        if (j + 2 <= jend) st(0, RA);
        __syncthreads();
        if (STAGGER && wave_ >= 4) __builtin_amdgcn_s_sleep(STAGGER);
    }
}
#define AS_GLOBAL(T, p) ((T*)(__attribute__((address_space(1))) T*)(p))
DI const float* inp(const Args& a, int k) { asm volatile("" : "+s"(k)); return AS_GLOBAL(const float, a.in[k]); }
__global__ void __launch_bounds__(NTHR, 2) fwd(Args args) {
    extern __shared__ __attribute__((aligned(16))) unsigned char lds_raw[];
    LAS unsigned char* lds = (LAS unsigned char*)lds_raw;
    LAS float* ldsf = (LAS float*)lds;
    volatile LAS unsigned* LCTL = (volatile LAS unsigned*)(lds + LDS_CTL);
    const int wave = __builtin_amdgcn_readfirstlane((int)threadIdx.x >> 6);
    const int G = gridDim.x, bid = blockIdx.x;
#define LAUNDER_TID() int tid = tid_of(wave); asm volatile("" : "+v"(tid)); const int lane = tid & 63; (void)lane
#define WS_PTRS() __attribute__((address_space(1))) unsigned char* wsg_ = (__attribute__((address_space(1))) unsigned char*)args.ws; asm volatile("" : "+s"(wsg_)); unsigned char* ws = (unsigned char*)wsg_; float* const out_ = AS_GLOBAL(float, args.out); \
    unsigned* ctl = (unsigned*)(ws + WS_CTL); float* ssp_base = (float*)(ws + WS_SSP); float* hb = (float*)(ws + WS_HB); \
    bf16_t* XB = (bf16_t*)(ws + WS_XB); bf16_t* Y = (bf16_t*)(ws + WS_Y); bf16_t* PB = (bf16_t*)(ws + WS_PB); bf16_t* ACT = (bf16_t*)(ws + WS_ACT); \
    const float2* cs64 = (const float2*)(ws + WS_CS64); const float2* cs32 = (const float2*)(ws + WS_CS32); \
    float* LRA = out_; float* LRU_ = out_ + (size_t)M * 256; \
    float* LA = (float*)(ws + WS_LA); float* LH = (float*)(ws + WS_LH); float* CIN = (float*)(ws + WS_CIN); \
    float* KVC = (float*)(ws + WS_KVC); float* DEC = (float*)(ws + WS_DEC); float* SST = (float*)(ws + WS_SST); \
    bf16_t* MQ = (bf16_t*)(ws + WS_MQ); bf16_t* MKN = (bf16_t*)(ws + WS_MKN); bf16_t* MVT = (bf16_t*)(ws + WS_MV); bf16_t* MKR = (bf16_t*)(ws + WS_MKR); \
    bf16_t* VST = (bf16_t*)(ws + WS_VST); bf16_t* KSF = (bf16_t*)(ws + WS_KSF); (void)KSF; bf16_t* VWT = (bf16_t*)(ws + WS_VWT); bf16_t* KCMPB = (bf16_t*)(ws + WS_KCMPB); bf16_t* VCMPT = (bf16_t*)(ws + WS_VCMPT); \
    const float* ssq_mix = ssp_base + (size_t)(l_ == 0 ? 0 : 2) * 4 * M; float* ssq_out = ssp_base + (size_t)(1 + 3 * l_) * 4 * M; float* ssq_down = ssp_base + (size_t)(2 + 3 * l_) * 4 * M; float* ssq_d = ssp_base + (size_t)(3 + 3 * l_) * 4 * M; \
    (void)ctl; (void)hb; (void)XB; (void)Y; (void)PB; (void)ACT; (void)cs64; (void)cs32; (void)LRA; (void)LRU_; (void)LA; (void)LH; (void)CIN; (void)KVC; (void)DEC; (void)SST; (void)MQ; (void)MKN; (void)MVT; (void)MKR; (void)VST; (void)VWT; (void)KCMPB; (void)VCMPT; (void)ssq_mix; (void)ssq_out; (void)ssq_down; (void)ssq_d
    unsigned* ctl0 = (unsigned*)(AS_GLOBAL(unsigned char, args.ws) + WS_CTL);
    { LAUNDER_TID(); if (tid < 16) LCTL[tid] = 0u; }
    __syncthreads();
    const int lo = args.ph_lo, hi = args.ph_hi;
    XcdBarrier bar; bar.bar = ctl0 + CW_BAR; bar.x = 0; bar.st = LCTL;
    if (hi - lo > 1) bar = xcd_barrier_post(ctl0 + CW_BAR, LCTL, tid_of(wave));
#define IN(k) (lo <= (k) && (k) < hi)
#define SEAM(k) do { if (IN(k) && IN((k) + 1)) { XcdBarrier b_ = bar; asm volatile("" : "+s"(b_.bar), "+s"(b_.x)); xcd_barrier(b_, tid_of(wave)); } } while (0)

    if (IN(0)) {
        const int l_ = 0; WS_PTRS();
      _Pragma("unroll 1") for (int rep = 0; rep < REP_P0; ++rep) {
        LAUNDER_TID();
        const int gw = bid * 8 + wave, NGW = G * 8;
        LAS float* scr = ldsf + wave * 4224; LAS float* scr64 = scr;
        constexpr int I_IN = 16 * 36, I_OUT = 16 * 16, I_GU = 16 * 88, I_DN = 44 * 16, I_L = I_IN + I_OUT + I_GU + I_DN;
        for (int it = gw; it < 2 * I_L; it += NGW) {
            const int l = it / I_L; int r = it % I_L;
            if (r < I_IN) { p0_transpose_item64<0>(inp(args, 3) + (size_t)l * DM * NINS, DM, NINS, inp(args, 2) + l * DM, (bf16_t*)(ws + WS_WIN) + (size_t)l * NIN * DM, scr64, r / 36, r % 36, lane); continue; } r -= I_IN;
            if (r < I_OUT) { p0_transpose_item64<0, 768>(inp(args, 23) + (size_t)l * DM * DM, DM, DM, inp(args, 22) + l * DM, (bf16_t*)(ws + WS_WOUT) + (size_t)l * DM * DM, scr64, r / 16, r % 16, lane); continue; } r -= I_OUT;
            if (r < I_GU) { p0_transpose_item64<1>(inp(args, 25) + (size_t)l * DM * NGU, DM, NGU, inp(args, 24) + l * DM, (bf16_t*)(ws + WS_WGU) + (size_t)l * NGU * DM, scr64, r / 88, r % 88, lane); continue; } r -= I_GU;
            p0_transpose_item64<0>(inp(args, 26) + (size_t)l * FF * DM, FF, DM, nullptr, (bf16_t*)(ws + WS_WDN) + (size_t)l * DM * FF, scr64, r / 16, r % 16, lane);
        }
        { constexpr int I_UQ = 3 * 12, I_UKV = 2 * 16, I_W1 = 32 * 8, I_W2 = 4 * 2, I_S = 2 * I_UQ + 2 * I_UKV + 4 * I_W1 + 4 * I_W2;
          for (int it = gw; it < I_S; it += NGW) { int r = it;
              if (r < 2 * I_UQ) { const int l = r / I_UQ; r %= I_UQ; p0_transpose_item<0>(inp(args, 20) + (size_t)l * 192 * 384, 192, 384, inp(args, 18) + l * 192, (bf16_t*)(ws + WS_WUQT) + (size_t)l * 384 * 192, scr, r / 12, r % 12, lane); continue; } r -= 2 * I_UQ;
              if (r < 2 * I_UKV) { const int l = r / I_UKV; r %= I_UKV; p0_transpose_item<0>(inp(args, 21) + (size_t)l * 128 * 512, 128, 512, inp(args, 19) + l * 128, (bf16_t*)(ws + WS_WUKVT) + (size_t)l * 512 * 128, scr, r / 16, r % 16, lane); continue; } r -= 2 * I_UKV;
              if (r < 4 * I_W1) { const int lj = r / I_W1; r %= I_W1; p0_transpose_item<0>(inp(args, 12) + (size_t)lj * 2048 * 256, 2048, 256, nullptr, (bf16_t*)(ws + WS_W1T) + (size_t)lj * 256 * 2048, scr, r / 8, r % 8, lane); continue; } r -= 4 * I_W1;
              { const int lj = r / I_W2; r %= I_W2; p0_transpose_item<0>(inp(args, 14) + (size_t)lj * 256 * 64, 256, 64, nullptr, (bf16_t*)(ws + WS_W2T) + (size_t)lj * 64 * 256, scr, r / 2, r % 2, lane); } } }
        for (int e = bid * NTHR + tid; e < 2 * 2 * 4 * 64 * 64; e += G * NTHR) {
            const int k = e & 63, n = (e >> 6) & 63, h = (e >> 12) & 3, g = (e >> 14) & 1, l = e >> 15;
            ((bf16_t*)(ws + WS_WGT))[e] = f2bf((g == 0 ? inp(args, 6) : inp(args, 8))[(((size_t)l * 4 + h) * 64 + k) * 64 + n]); }
        for (int e = bid * NTHR + tid; e < 512; e += G * NTHR) ((float*)(ws + WS_SP))[e] = log1pf(expf(-inp(args, 10)[e]));
        for (int m = gw; m < M; m += NGW) {
            const f32x4* xr = (const f32x4*)(inp(args, 0) + (size_t)m * DM) + lane;
            f32x4 v[4]; float s = 0.f;
#pragma unroll
            for (int j = 0; j < 4; ++j) { v[j] = xr[64 * j]; s += v[j][0] * v[j][0] + v[j][1] * v[j][1] + v[j][2] * v[j][2] + v[j][3] * v[j][3]; }
            s = wave_sum(s);
            u32x2* o8 = (u32x2*)(XB + (size_t)m * DM) + lane;
#pragma unroll
            for (int j = 0; j < 4; ++j) { u32x2 w; w.x = pk2(v[j][0], v[j][1]); w.y = pk2(v[j][2], v[j][3]); o8[64 * j] = w; }
            if (lane < 4) ssp_base[(size_t)lane * M + m] = lane == 0 ? s : 0.f;
        }
        for (int e = bid * NTHR + tid; e < M * 32; e += G * NTHR) {
            const int m = e >> 5, i = e & 31; const float pos = (float)((const int*)inp(args, 1))[m];
            const float invf = __builtin_amdgcn_exp2f(-(float)(2 * i) * (13.287712379549449f / 64.f)); float sn, cs; { float rv = pos * invf * 0.15915494309189535f; rv -= floorf(rv); sn = __builtin_amdgcn_sinf(rv); cs = __builtin_amdgcn_cosf(rv); }
            ((float2*)(ws + WS_CS64))[e] = make_float2(cs, sn);
            if (i < 16) { const float invf2 = __builtin_amdgcn_exp2f(-(float)(2 * i) * (13.287712379549449f / 32.f)); float rv = pos * invf2 * 0.15915494309189535f; rv -= floorf(rv); sn = __builtin_amdgcn_sinf(rv); cs = __builtin_amdgcn_cosf(rv); ((float2*)(ws + WS_CS32))[m * 16 + i] = make_float2(cs, sn); }
        }
        for (int e = bid * NTHR + tid; e < 2 * 2 * 256; e += G * NTHR) {
            const int lj = e >> 8, c = e & 255; float a = inp(args, 13)[e];
            const float* pp = inp(args, 11) + (size_t)lj * 2048; const float* w1 = inp(args, 12) + (size_t)lj * 2048 * 256 + c;
            for (int i = 0; i < 2048; ++i) a += pp[i] * w1[(size_t)i * 256];
            hb[e] = a;
        }
      }
    }
    SEAM(0);

    for (int l = 0; l < 2; ++l) {
        const int pb = 1 + 6 * l;
        if (IN(pb)) {
        const int l_ = l; WS_PTRS();
            pg8::Gemm g{XB, (const bf16_t*)(ws + WS_WIN) + (size_t)l * NIN * DM, M, NIN, DM}; pg8::StaticOrder S; S.init(M, NIN, G, bid);
            pg8::EpiInProj E{PB, NIN, ssq_mix};
            _Pragma("unroll 1") for (int rep = 0; rep < REP_G16; ++rep) pg8::gemm_phase<pg8::EpiInProj, pg8::StaticOrder, true, true>(lds, g, S, E, wave);
        }
        SEAM(pb);
        if (IN(pb + 1)) {
        const int l_ = l; WS_PTRS();
        LAUNDER_TID();
            constexpr int N_J1 = 1024, N_J2 = 512, N_J3 = 512, N_J4 = 512, N_J4B = 128;
            {
            for (int r_ = bid; r_ < N_J4B * REP_J4B; r_ += G) { const int r = r_ % N_J4B;
                    const int j = r & 1, g32 = (r >> 1) & 15, b = r >> 5; const int colb = j == 0 ? C_KC : C_VC; const int r32 = lane & 31, hi = lane >> 5;
                    LAS unsigned char* Tl = lds;
                    LAS unsigned char* Hl = lds + 69632;
#pragma unroll 1
                    for (int g3 = 0; g3 < 3; ++g3) {
                        u32x4 la_[3], lc_[3]; f32x4 lcs_[3][4];
#pragma unroll
                        for (int k = 0; k < 3; ++k) { const int e0 = tid + (3 * g3 + k) * NTHR, e = e0 < 528 * 8 ? e0 : 528 * 8 - 1, rr = e >> 3, c8 = e & 7, t = 512 * g32 + rr, tc = t < SEQ ? t : SEQ - 1;
                            const bf16_t* pr = PB + ((size_t)b * SEQ + tc) * NIN + colb;
                            if (j == 0) { la_[k] = *(const u32x4*)(pr + 8 * (c8 & 3)); lc_[k] = *(const u32x4*)(pr + 32 + 8 * (c8 & 3)); const f32x4* cs4 = (const f32x4*)(cs64 + ((size_t)b * SEQ + tc) * 32 + 8 * (c8 & 3));
#pragma unroll
                                for (int q = 0; q < 4; ++q) lcs_[k][q] = cs4[q]; }
                            else { la_[k] = *(const u32x4*)(pr + 8 * c8); lc_[k] = la_[k];
#pragma unroll
                                for (int q = 0; q < 4; ++q) lcs_[k][q] = (f32x4){0.f, 0.f, 0.f, 0.f}; } }
                        __builtin_amdgcn_sched_barrier(0);
#pragma unroll
                        for (int k = 0; k < 3; ++k) { const int e0 = tid + (3 * g3 + k) * NTHR;
                            if (e0 < 528 * 8) { const int rr = e0 >> 3, c8 = e0 & 7, t = 512 * g32 + rr; u32x4 w = la_[k];
                                if (j == 0) { const u32x4 a = la_[k], c = lc_[k];
                                    const unsigned au[4] = {a.x, a.y, a.z, a.w}, cu[4] = {c.x, c.y, c.z, c.w}; unsigned ou[4];
#pragma unroll
                                    for (int q = 0; q < 4; ++q) { const f32x4 cq_ = lcs_[k][q]; const float2 s0 = {cq_[0], cq_[1]}, s1 = {cq_[2], cq_[3]}; const float x1a = bflo(au[q]), x1b = bfhi(au[q]), x2a = bflo(cu[q]), x2b = bfhi(cu[q]);
                                        ou[q] = c8 < 4 ? pk2(x1a * s0.x - x2a * s0.y, x1b * s1.x - x2b * s1.y) : pk2(x2a * s0.x + x1a * s0.y, x2b * s1.x + x1b * s1.y); }
                                    w.x = ou[0]; w.y = ou[1]; w.z = ou[2]; w.w = ou[3]; }
                                if (t >= SEQ) w = (u32x4){0u, 0u, 0u, 0u};
                                *(LAS u32x4*)(Tl + rr * 128 + (rr >> 4) * 16 + c8 * 16) = w; } }
                    }
                    __syncthreads();
                    { const bf16_t* w1t = (const bf16_t*)(ws + WS_W1T) + ((size_t)(l * 2 + j) * 256 + 32 * wave + r32) * 2048 + 8 * hi;
                      f32x16 acc;
#pragma unroll
                      for (int i = 0; i < 16; ++i) acc[i] = 0.f;
                      bf16x8 bwa[16], bwb[16];
#pragma unroll
                      for (int i = 0; i < 16; ++i) bwa[i] = *(const bf16x8*)(w1t + 16 * i);
#pragma unroll
                      for (int kc = 0; kc < 8; kc += 2) {
#pragma unroll
                          for (int i = 0; i < 16; ++i) bwb[i] = *(const bf16x8*)(w1t + 16 * (16 * (kc + 1) + i));
                          __builtin_amdgcn_sched_barrier(0);
#pragma unroll
                          for (int i = 0; i < 16; ++i) { const int kk = 16 * kc + i, rowt = 16 * r32 + (kk >> 2);
                              const bf16x8 a = *(const LAS bf16x8*)(Tl + rowt * 128 + (rowt >> 4) * 16 + 32 * (kk & 3) + 16 * hi); acc = mfma32(a, bwa[i], acc); }
                          __builtin_amdgcn_sched_barrier(0);
                          if (kc + 2 < 8) {
#pragma unroll
                              for (int i = 0; i < 16; ++i) bwa[i] = *(const bf16x8*)(w1t + 16 * (16 * (kc + 2) + i)); }
                          __builtin_amdgcn_sched_barrier(0);
#pragma unroll
                          for (int i = 0; i < 16; ++i) { const int kk = 16 * (kc + 1) + i, rowt = 16 * r32 + (kk >> 2);
                              const bf16x8 a = *(const LAS bf16x8*)(Tl + rowt * 128 + (rowt >> 4) * 16 + 32 * (kk & 3) + 16 * hi); acc = mfma32(a, bwb[i], acc); }
                      }
                      const float hbv = hb[(l * 2 + j) * 256 + 32 * wave + r32];
#pragma unroll
                      for (int i = 0; i < 16; ++i) { const int n = (i & 3) + 8 * (i >> 2) + 4 * hi; *(LAS bf16_t*)(Hl + n * 528 + (32 * wave + r32) * 2) = f2bf(gelu_tanh(acc[i] + hbv)); } }
                    __syncthreads();
                    if (wave < 2) { const bf16_t* w2t = (const bf16_t*)(ws + WS_W2T) + ((size_t)(l * 2 + j) * 64 + 32 * wave + r32) * 256 + 8 * hi;
                      f32x16 acc;
#pragma unroll
                      for (int i = 0; i < 16; ++i) acc[i] = 0.f;
#pragma unroll
                      for (int kk = 0; kk < 16; ++kk) acc[kk] = 0.f;
                      bf16x8 bw2[16];
#pragma unroll
                      for (int kk = 0; kk < 16; ++kk) bw2[kk] = *(const bf16x8*)(w2t + 16 * kk);
                      __builtin_amdgcn_sched_barrier(0);
#pragma unroll
                      for (int kk = 0; kk < 16; ++kk) { const bf16x8 a = *(const LAS bf16x8*)(Hl + r32 * 528 + 32 * kk + 16 * hi); acc = mfma32(a, bw2[kk], acc); }
                      const int dd = 32 * wave + r32;
#pragma unroll
                      for (int g = 0; g < 4; ++g) { const int n0 = 32 * g32 + 8 * g + 4 * hi; float v[4];
#pragma unroll
                          for (int q = 0; q < 4; ++q) v[q] = (n0 + q < 511) ? acc[4 * g + q] : 0.f;
                          if (j == 0) {
#pragma unroll
                              for (int q = 0; q < 4; ++q) KCMPB[((size_t)b * 512 + n0 + q) * 64 + dd] = f2bf(v[q]); }
                          else { u32x2 w; w.x = pk2(v[0], v[1]); w.y = pk2(v[2], v[3]); *(u32x2*)(VCMPT + ((size_t)b * 64 + dd) * 512 + n0) = w; } } }
                    __syncthreads();
            }
            if (bid < N_J3) {
                const int fr = lane & 15, kq = lane >> 4, hh = wave >> 1, odd = wave & 1;
                {
                    bf16x8 bq[3][6];
                    { const bf16_t* wq = (const bf16_t*)(ws + WS_WUQT) + (size_t)l * 384 * 192;
#pragma unroll
                      for (int nt = 0; nt < 3; ++nt)
#pragma unroll
                          for (int ks = 0; ks < 6; ++ks) bq[nt][ks] = *(const bf16x8*)(wq + (size_t)(48 * wave + 16 * nt + fr) * 192 + 32 * ks + 8 * kq); }
                    for (int r_ = bid; r_ < N_J3 * REP_J3; r_ += G) { const int r = r_ % N_J3;
                        const size_t row0 = (size_t)r * 64;
                        bf16x8 aq[6]; float2 csq[4];
#pragma unroll
                        for (int ks = 0; ks < 6; ++ks) aq[ks] = ld8x2(PB + (row0 + fr) * NIN + C_DCQ + 32 * ks + 8 * kq);
#pragma unroll
                        for (int i = 0; i < 4; ++i) csq[i] = cs32[(row0 + 4 * kq + i) * 16 + fr];
#pragma unroll 1
                        for (int mt = 0; mt < 4; ++mt) {
                            bf16x8 an[6]; float2 csn[4]; const int mn = mt < 3 ? mt + 1 : 3;
#pragma unroll
                            for (int ks = 0; ks < 6; ++ks) an[ks] = ld8x2(PB + (row0 + mn * 16 + fr) * NIN + C_DCQ + 32 * ks + 8 * kq);
#pragma unroll
                            for (int i = 0; i < 4; ++i) csn[i] = cs32[(row0 + mn * 16 + 4 * kq + i) * 16 + fr];
                            float2 kcs[4]; float kx1[4], kx2[4];
#pragma unroll
                            for (int q = 0; q < 4; ++q) { const int p = lane * 4 + q, tok = p >> 4, i = p & 15; const size_t row = row0 + mt * 16 + tok; const bf16_t* pr = PB + row * NIN + C_DKR;
                                kx1[q] = bf2f(pr[i]); kx2[q] = bf2f(pr[16 + i]); kcs[q] = cs32[row * 16 + i]; }
                            __builtin_amdgcn_sched_barrier(0);
                            float ssq_ = 0.f;
#pragma unroll
                            for (int ks = 0; ks < 6; ++ks) {
#pragma unroll
                                for (int e = 0; e < 8; ++e) { const float v = bf2f((bf16_t)aq[ks][e]); ssq_ += v * v; } }
                            ssq_ = x32f_sum(x16f_sum(ssq_));
                            const float rq_ = rsqrtf(ssq_ * (1.f / 192.f) + EPS);
                            f32x4 cq[3];
#pragma unroll
                            for (int nt = 0; nt < 3; ++nt) { cq[nt] = (f32x4){0.f, 0.f, 0.f, 0.f};
#pragma unroll
                                for (int ks = 0; ks < 6; ++ks) cq[nt] = __builtin_amdgcn_mfma_f32_16x16x32_bf16(aq[ks], bq[nt][ks], cq[nt], 0, 0, 0); }
                            const float SCQ = 0.10206207261596575f * LOG2E;
#pragma unroll
                            for (int i = 0; i < 4; ++i) {
                                const size_t row = row0 + mt * 16 + 4 * kq + i; const float rqi = shf(rq_, 4 * kq + i) * SCQ;
                                float q0 = cq[0][i] * rqi, q1 = cq[1][i] * rqi, q2 = cq[2][i] * rqi;
                                if (odd) { const float2 cs = csq[i]; const float x1 = q1, x2 = q2; q1 = x1 * cs.x - x2 * cs.y; q2 = x2 * cs.x + x1 * cs.y; }
                                bf16_t* mq = MQ + row * 384 + hh * 96 + 48 * odd + fr; mq[0] = f2bf(q0); mq[16] = f2bf(q1); mq[32] = f2bf(q2);
                            }
                            if (wave == mt) {
#pragma unroll
                                for (int q = 0; q < 4; ++q) { const int p = lane * 4 + q, tok = p >> 4, i = p & 15; const size_t row = row0 + mt * 16 + tok;
                                    MKR[row * 32 + i] = f2bf(kx1[q] * kcs[q].x - kx2[q] * kcs[q].y); MKR[row * 32 + 16 + i] = f2bf(kx2[q] * kcs[q].x + kx1[q] * kcs[q].y); } }
#pragma unroll
                            for (int ks = 0; ks < 6; ++ks) aq[ks] = an[ks];
#pragma unroll
                            for (int i = 0; i < 4; ++i) csq[i] = csn[i];
                        }
                    }
                }
                {
                    bf16x8 bkv[4][4];
                    { const bf16_t* wkv = (const bf16_t*)(ws + WS_WUKVT) + (size_t)l * 512 * 128;
#pragma unroll
                      for (int nt = 0; nt < 4; ++nt)
#pragma unroll
                          for (int ks = 0; ks < 4; ++ks) bkv[nt][ks] = *(const bf16x8*)(wkv + (size_t)(64 * wave + 16 * nt + fr) * 128 + 32 * ks + 8 * kq); }
                    for (int r_ = bid; r_ < N_J3 * REP_J3; r_ += G) { const int r = r_ % N_J3;
                        const size_t row0 = (size_t)r * 64; const size_t bb = row0 / SEQ, t0 = row0 % SEQ;
                        bf16x8 akv[4];
#pragma unroll
                        for (int ks = 0; ks < 4; ++ks) akv[ks] = ld8x2(PB + (row0 + fr) * NIN + C_DCKV + 32 * ks + 8 * kq);
#pragma unroll 1
                        for (int mt = 0; mt < 4; ++mt) {
                            bf16x8 akn[4]; const int mn = mt < 3 ? mt + 1 : 3;
#pragma unroll
                            for (int ks = 0; ks < 4; ++ks) akn[ks] = ld8x2(PB + (row0 + mn * 16 + fr) * NIN + C_DCKV + 32 * ks + 8 * kq);
                            __builtin_amdgcn_sched_barrier(0);
                            float sskv_ = 0.f;
#pragma unroll
                            for (int ks = 0; ks < 4; ++ks) {
#pragma unroll
                                for (int e = 0; e < 8; ++e) { const float v = bf2f((bf16_t)akv[ks][e]); sskv_ += v * v; } }
                            sskv_ = x32f_sum(x16f_sum(sskv_));
                            const float rk_ = rsqrtf(sskv_ * (1.f / 128.f) + EPS);
                            f32x4 ckv[4];
#pragma unroll
                            for (int nt = 0; nt < 4; ++nt) { ckv[nt] = (f32x4){0.f, 0.f, 0.f, 0.f};
#pragma unroll
                                for (int ks = 0; ks < 4; ++ks) ckv[nt] = __builtin_amdgcn_mfma_f32_16x16x32_bf16(akv[ks], bkv[nt][ks], ckv[nt], 0, 0, 0); }
                            float rki[4];
#pragma unroll
                            for (int i = 0; i < 4; ++i) rki[i] = shf(rk_, 4 * kq + i);
                            if (!odd) {
#pragma unroll
                                for (int i = 0; i < 4; ++i) { bf16_t* mk = MKN + (row0 + mt * 16 + 4 * kq + i) * 256 + hh * 64 + fr;
                                    mk[0] = f2bf(ckv[0][i] * rki[i]); mk[16] = f2bf(ckv[1][i] * rki[i]); mk[32] = f2bf(ckv[2][i] * rki[i]); mk[48] = f2bf(ckv[3][i] * rki[i]); } }
                            else {
#pragma unroll
                                for (int nt = 0; nt < 4; ++nt) { u32x2 w; w.x = pk2(ckv[nt][0] * rki[0], ckv[nt][1] * rki[1]); w.y = pk2(ckv[nt][2] * rki[2], ckv[nt][3] * rki[3]);
                                    *(u32x2*)(MVT + ((bb * 4 + hh) * 64 + 16 * nt + fr) * SEQ + t0 + mt * 16 + 4 * kq) = w; } }
#pragma unroll
                            for (int ks = 0; ks < 4; ++ks) akv[ks] = akn[ks];
                        }
                    }
                }
            }
            {
                const int r32 = lane & 31, hi = lane >> 5, gh = wave >> 1, gg = wave & 1, ch = tid & 255, half = tid >> 8;
                bf16x8 bW[2][4];
                { const bf16_t* wt = (const bf16_t*)(ws + WS_WGT) + (size_t)(((l * 2 + gg) * 4 + gh) * 64) * 64;
#pragma unroll
                  for (int nt = 0; nt < 2; ++nt)
#pragma unroll
                      for (int ks = 0; ks < 4; ++ks) bW[nt][ks] = *(const bf16x8*)(wt + (size_t)(32 * nt + r32) * 64 + 16 * ks + 8 * hi); }
                const float gbias0 = (gg == 0 ? inp(args, 7) : inp(args, 9))[l * 256 + gh * 64 + r32], gbias1 = (gg == 0 ? inp(args, 7) : inp(args, 9))[l * 256 + gh * 64 + 32 + r32];
                const float cw0 = inp(args, 4)[(l * 4 + 0) * 256 + ch], cw1 = inp(args, 4)[(l * 4 + 1) * 256 + ch], cw2 = inp(args, 4)[(l * 4 + 2) * 256 + ch], cw3 = inp(args, 4)[(l * 4 + 3) * 256 + ch], cb = inp(args, 5)[l * 256 + ch];
                const float sp = ((const float*)(ws + WS_SP))[l * 256 + ch];
                LAS float* xa = ldsf; LAS float* xc = ldsf + 35 * 256; LAS unsigned char* xcb = lds + 67 * 1024; LAS float* gR = (LAS float*)(lds + 67 * 1024 + 32 * 528); LAS float* gI = gR + 32 * 256;
            const bool j1bal = (G == 256 && REP_J1 == 1);
            for (int r_ = bid, k_ = 0; j1bal ? (k_ < (bid < 128 ? 3 : 5)) : (r_ < N_J1 * REP_J1); r_ += G, ++k_) { const int r = j1bal ? (bid < 128 ? bid + 128 * k_ : 384 + (bid - 128) + 128 * k_) : r_ % N_J1;
                    const int b = r >> 8, tb = r & 255, t0 = tb * 32;
                    {
                        u32x4 wv_[3];
#pragma unroll
                        for (int it = 0; it < 3; ++it) { const int c0_ = tid + it * NTHR, c = c0_ < 35 * 32 ? c0_ : 35 * 32 - 1, rr = c >> 5, c8 = c & 31, t = t0 - 3 + rr, tc = t >= 0 ? t : 0; wv_[it] = *(const u32x4*)(PB + ((size_t)b * SEQ + tc) * NIN + C_AX + 8 * c8); }
                        __builtin_amdgcn_sched_barrier(0);
#pragma unroll
                        for (int it = 0; it < 3; ++it) { const int c = tid + it * NTHR; if (c < 35 * 32) { const int rr = c >> 5, c8 = c & 31, t = t0 - 3 + rr; u32x4 w = wv_[it]; if (t < 0) w = (u32x4){0u, 0u, 0u, 0u};
                            LAS f32x4* d = (LAS f32x4*)(xa + rr * 256 + 8 * c8); d[0] = (f32x4){bflo(w.x), bfhi(w.x), bflo(w.y), bfhi(w.y)}; d[1] = (f32x4){bflo(w.z), bfhi(w.z), bflo(w.w), bfhi(w.w)}; } }
                    }
                    __syncthreads();
#pragma unroll 4
                    for (int tt = 0; tt < 16; ++tt) { const int rr = half * 16 + tt; const float v = cb + cw0 * xa[rr * 256 + ch] + cw1 * xa[(rr + 1) * 256 + ch] + cw2 * xa[(rr + 2) * 256 + ch] + cw3 * xa[(rr + 3) * 256 + ch];
                        xc[rr * 256 + ch] = v; *(LAS bf16_t*)(xcb + rr * 528 + ch * 2) = f2bf(v); }
                    __syncthreads();
                    { f32x16 acc[2];
#pragma unroll
                      for (int i = 0; i < 16; ++i) { acc[0][i] = 0.f; acc[1][i] = 0.f; }
#pragma unroll
                      for (int ks = 0; ks < 4; ++ks) { const bf16x8 a = *(const LAS bf16x8*)(xcb + r32 * 528 + (gh * 64 + 16 * ks + 8 * hi) * 2); acc[0] = mfma32(a, bW[0][ks], acc[0]); acc[1] = mfma32(a, bW[1][ks], acc[1]); }
                      LAS float* gd = gg == 0 ? gR : gI;
#pragma unroll
                      for (int i = 0; i < 16; ++i) { const int tok = (i & 3) + 8 * (i >> 2) + 4 * hi; gd[tok * 256 + gh * 64 + r32] = sigmoidf_(acc[0][i] + gbias0); gd[tok * 256 + gh * 64 + 32 + r32] = sigmoidf_(acc[1][i] + gbias1); } }
                    __syncthreads();
                    float hst = 0.f, Ac = 1.f;
#pragma unroll 4
                    for (int tt = 0; tt < 16; ++tt) {
                        const int rr = half * 16 + tt;
                        const float la = -8.f * gR[rr * 256 + ch] * sp, x2 = 2.f * la;
                        const float av = la > -0.25f ? 1.f + la * (1.f + la * (0.5f + la * (0.16666667f + la * (0.041666667f + la * 0.0083333333f)))) : __expf(la);
                        const float om = x2 > -0.5f ? -x2 * (1.f + x2 * (0.5f + x2 * (0.16666667f + x2 * (0.041666667f + x2 * (0.0083333333f + x2 * 0.0013888889f))))) : 1.f - __expf(x2);
                        const float u = __builtin_amdgcn_sqrtf(om) * (gI[rr * 256 + ch] * xc[rr * 256 + ch]);
                        hst = av * hst + u; Ac *= av;
                        { const size_t ao = ((size_t)b * SEQ + t0 + rr) * 256 + ch; LRA[ao] = av; LRU_[ao] = u; }
                    }
                    const size_t so = ((size_t)(b * 512 + tb * 2 + half)) * 256 + ch;
                    LA[so] = Ac; LH[so] = hst;
                    __syncthreads();
            }
            }
            {
                const int kk = tid & 127, tq = tid >> 7, r32 = lane & 31, hi = lane >> 5;
                float wg[16]; const float bg = inp(args, 16)[l * 128 + kk];
#pragma unroll
                for (int q = 0; q < 16; ++q) wg[q] = inp(args, 15)[(l * 16 + q) * 128 + kk];
                LAS float* glr = ldsf; LAS float* tot = ldsf + 1024; LAS unsigned char* KTl = lds + 8192; LAS unsigned char* VTl = lds + 8192 + 128 * VSTR;
                float* BCS = (float*)(ws + WS_BCS);
            for (int r_ = bid; r_ < N_J2 * REP_J2; r_ += G) { const int r = r_ % N_J2;
                    const int b = r >> 7, c = r & 127; const size_t row0 = (size_t)b * SEQ + 64 * c;
                    for (int e = tid; e < 1024; e += NTHR) glr[e] = bf2f(PB[(row0 + (e >> 4)) * NIN + C_GLR + (e & 15)]);
                    for (int e = tid; e < 2048; e += NTHR) { const int jj = e >> 5, hc = e & 31; const bf16_t* vsrc = PB + (row0 + jj) * NIN + C_CV + 8 * hc; const u32x2 wA = *(const u32x2*)vsrc, wB = *(const u32x2*)(vsrc + 4);
                        LAS bf16_t* d = (LAS bf16_t*)(VTl + (8 * hc) * VSTR) + jj;
                        d[0] = (bf16_t)wA.x; d[VSTR / 2] = (bf16_t)(wA.x >> 16); d[2 * (VSTR / 2)] = (bf16_t)wA.y; d[3 * (VSTR / 2)] = (bf16_t)(wA.y >> 16); d[4 * (VSTR / 2)] = (bf16_t)wB.x; d[5 * (VSTR / 2)] = (bf16_t)(wB.x >> 16); d[6 * (VSTR / 2)] = (bf16_t)wB.y; d[7 * (VSTR / 2)] = (bf16_t)(wB.y >> 16); }
                    __syncthreads();
                    bf16_t kraw[16];
#pragma unroll
                    for (int tt = 0; tt < 16; ++tt) kraw[tt] = PB[(row0 + 16 * tq + tt) * NIN + C_CK + kk];
                    float bv[16]; float run = 0.f;
#pragma unroll
                    for (int tt = 0; tt < 16; ++tt) { const LAS f32x4* g4 = (const LAS f32x4*)(glr + (16 * tq + tt) * 16); float z = bg;
#pragma unroll
                        for (int q = 0; q < 4; ++q) { const f32x4 g = g4[q]; z += g[0] * wg[4 * q] + g[1] * wg[4 * q + 1] + g[2] * wg[4 * q + 2] + g[3] * wg[4 * q + 3]; }
                        run += (fminf(z, 0.f) - __logf(1.f + __expf(-fabsf(z)))) * (1.f / 16.f); bv[tt] = run; }
                    tot[tq * 128 + kk] = run;
                    __syncthreads();
                    { const float t0_ = tot[kk], t1_ = tot[128 + kk], t2_ = tot[256 + kk], t3_ = tot[384 + kk]; const float off = tq == 0 ? 0.f : (tq == 1 ? t0_ : (tq == 2 ? t0_ + t1_ : (t0_ + t1_) + t2_)), blast = ((t0_ + t1_) + t2_) + t3_;
#pragma unroll
                      for (int tt = 0; tt < 16; ++tt) { const int t = 16 * tq + tt; const float bt = bv[tt] + off; BCS[(row0 + t) * 128 + kk] = bt;
                          *((LAS bf16_t*)(KTl + kk * VSTR) + t) = f2bf(bf2f(kraw[tt]) * __expf(blast - bt)); }
                      if (tq == 0) DEC[(size_t)(b * 128 + c) * 128 + kk] = __expf(blast); }
                    __syncthreads();
                    { const int h = wave >> 1, nt = wave & 1; f32x16 acc;
#pragma unroll
                      for (int i = 0; i < 16; ++i) acc[i] = 0.f;
                      const LAS unsigned char* ap = KTl + (h * 32 + r32) * VSTR + 16 * hi; const LAS unsigned char* bp = VTl + (h * 64 + 32 * nt + r32) * VSTR + 16 * hi;
#pragma unroll
                      for (int s = 0; s < 4; ++s) { const u32x2 a0 = *(const LAS u32x2*)(ap + 32 * s), a1 = *(const LAS u32x2*)(ap + 32 * s + 8), b0 = *(const LAS u32x2*)(bp + 32 * s), b1 = *(const LAS u32x2*)(bp + 32 * s + 8);
                          u32x4 aw, bw; aw.x = a0.x; aw.y = a0.y; aw.z = a1.x; aw.w = a1.y; bw.x = b0.x; bw.y = b0.y; bw.z = b1.x; bw.w = b1.y;
                          acc = mfma32(__builtin_bit_cast(bf16x8, aw), __builtin_bit_cast(bf16x8, bw), acc); }
                      float* o = KVC + ((size_t)(b * 128 + c) * 4 + h) * 2048 + 32 * nt + r32;
#pragma unroll
                      for (int i = 0; i < 16; ++i) o[((i & 3) + 8 * (i >> 2) + 4 * hi) * 64] = acc[i]; }
                    __syncthreads();
            }
            }
            for (int r = bid; r < N_J4; r += G) {
                    const size_t row0 = (size_t)r * 64;
                    u32x4 ra_[3], rc_[3]; f32x4 rcs_[3][4];
#pragma unroll
                    for (int it3 = 0; it3 < 3; ++it3) { const int e = tid + it3 * NTHR, tok = e / 24, p = e % 24, hd = p >> 2, c8 = p & 3; const int base = hd < 4 ? C_BQ + hd * 64 : (hd == 4 ? C_KS : C_KW);
                        const bf16_t* pr = PB + (row0 + tok) * NIN + base + 8 * c8; ra_[it3] = *(const u32x4*)pr; rc_[it3] = *(const u32x4*)(pr + 32); const f32x4* cs4 = (const f32x4*)(cs64 + (row0 + tok) * 32 + 8 * c8);
#pragma unroll
                        for (int q = 0; q < 4; ++q) rcs_[it3][q] = cs4[q]; }
                    __builtin_amdgcn_sched_barrier(0);
#pragma unroll
                    for (int it3 = 0; it3 < 3; ++it3) {
                        const int e = tid + it3 * NTHR, tok = e / 24, p = e % 24, hd = p >> 2, c8 = p & 3; const int base = hd < 4 ? C_BQ + hd * 64 : (hd == 4 ? C_KS : C_KW); const float sc = hd < 4 ? 0.125f * LOG2E : 1.f;
                        bf16_t* pr = PB + (row0 + tok) * NIN + base + 8 * c8; const u32x4 a = ra_[it3], c = rc_[it3];
                        const unsigned au[4] = {a.x, a.y, a.z, a.w}, cu[4] = {c.x, c.y, c.z, c.w}; unsigned o1[4], o2[4];
#pragma unroll
                        for (int q = 0; q < 4; ++q) { const f32x4 cq_ = rcs_[it3][q]; const float2 s0 = {cq_[0], cq_[1]}, s1 = {cq_[2], cq_[3]}; const float x1a = bflo(au[q]), x1b = bfhi(au[q]), x2a = bflo(cu[q]), x2b = bfhi(cu[q]);
                            o1[q] = pk2((x1a * s0.x - x2a * s0.y) * sc, (x1b * s1.x - x2b * s1.y) * sc); o2[q] = pk2((x2a * s0.x + x1a * s0.y) * sc, (x2b * s1.x + x1b * s1.y) * sc); }
                        u32x4 w1, w2; w1.x = o1[0]; w1.y = o1[1]; w1.z = o1[2]; w1.w = o1[3]; w2.x = o2[0]; w2.y = o2[1]; w2.z = o2[2]; w2.w = o2[3];
                        *(u32x4*)pr = w1; *(u32x4*)(pr + 32) = w2;
                        if (hd == 4) {
                            bf16_t* kf_ = KSF + (row0 / 64) * 4096 + (size_t)((((tok >> 5) * 4 + (c8 >> 1)) * 64 + (c8 & 1) * 32 + (tok & 31)) * 8); *(u32x4*)kf_ = w1; *(u32x4*)(kf_ + 2 * 64 * 8) = w2; } }
                    { LAS bf16_t* tl = (LAS bf16_t*)lds; const size_t bb = row0 / SEQ, t0 = row0 % SEQ;
                      for (int mtx = 0; mtx < 2; ++mtx) { const int tok = tid >> 3, c = tid & 7; const u32x4 w = *(const u32x4*)(PB + (row0 + tok) * NIN + (mtx ? C_VW : C_VS) + c * 8);
                          LAS bf16_t* dst = tl + mtx * 64 * 72 + tok * 72 + c * 8; dst[0] = (bf16_t)w.x; dst[1] = (bf16_t)(w.x >> 16); dst[2] = (bf16_t)w.y; dst[3] = (bf16_t)(w.y >> 16); dst[4] = (bf16_t)w.z; dst[5] = (bf16_t)(w.z >> 16); dst[6] = (bf16_t)w.w; dst[7] = (bf16_t)(w.w >> 16); }
                      __syncthreads();
                      for (int mtx = 0; mtx < 2; ++mtx) { const int d = tid >> 3, c8 = tid & 7; const LAS bf16_t* s = tl + mtx * 64 * 72 + (c8 * 8) * 72 + d;
                          u32x4 w; w.x = (unsigned)s[0] | ((unsigned)s[72] << 16); w.y = (unsigned)s[2 * 72] | ((unsigned)s[3 * 72] << 16); w.z = (unsigned)s[4 * 72] | ((unsigned)s[5 * 72] << 16); w.w = (unsigned)s[6 * 72] | ((unsigned)s[7 * 72] << 16);
                          if (mtx) *(u32x4*)(VWT + (bb * 64 + d) * SEQ + t0 + c8 * 8) = w;
                          else { const int s_ = c8 >> 1, h_ = c8 & 1; const LAS bf16_t* q = tl + (16 * s_ + 4 * h_) * 72 + d;
                              u32x4 f; f.x = (unsigned)q[0] | ((unsigned)q[72] << 16); f.y = (unsigned)q[2 * 72] | ((unsigned)q[3 * 72] << 16); f.z = (unsigned)q[8 * 72] | ((unsigned)q[9 * 72] << 16); f.w = (unsigned)q[10 * 72] | ((unsigned)q[11 * 72] << 16);
                              *(u32x4*)(VST + (row0 / 64) * 4096 + (size_t)((((d >> 5) * 4 + s_) * 64 + h_ * 32 + (d & 31)) * 8)) = f; } }
                      __syncthreads(); }
            }
            }
        }
        SEAM(pb + 1);
        if (IN(pb + 2)) {
        const int l_ = l; WS_PTRS();
        LAUNDER_TID();
            constexpr int Q_J5 = 2, Q_J6 = 64, Q_ATT = 1024 * REP_ATT, Q_J9 = 1024, Q_J10 = 512, Q_TOT = Q_J5 + Q_J6 + Q_ATT + Q_J9 + Q_J10;
            if (tid == 0) { LCTL[4] = 0u; LCTL[5] = 0u; }
            __syncthreads();
            const int tid_o = tid;
            unsigned ticket = 0u; bool have = true; if (tid == 0) ticket = __hip_atomic_fetch_add(ctl + CW_QUEUE + 64 * l, 1u, __ATOMIC_RELAXED, __HIP_MEMORY_SCOPE_AGENT);
            for (;;) {
                int tid = tid_o; asm volatile("" : "+v"(tid)); const int lane = tid & 63;
                if (tid == 0) { if (!have) ticket = __hip_atomic_fetch_add(ctl + CW_QUEUE + 64 * l, 1u, __ATOMIC_RELAXED, __HIP_MEMORY_SCOPE_AGENT); LCTL[2] = ticket; }
                __syncthreads();
                int r = __builtin_amdgcn_readfirstlane((int)LCTL[2]); const unsigned seen5 = LCTL[4], seen6 = LCTL[5];
                __syncthreads();
                if (r >= Q_TOT * REP_P3) break;
                have = r < Q_TOT * REP_P3 - G;
                if (have && tid == 0) ticket = __hip_atomic_fetch_add(ctl + CW_QUEUE + 64 * l, 1u, __ATOMIC_RELAXED, __HIP_MEMORY_SCOPE_AGENT);
                if (REP_P3 > 1 && r >= Q_TOT) r -= Q_TOT;
                if (r < Q_J5) {
                    const int e = r * NTHR + tid, b = e >> 8, ch = e & 255; float carry = 0.f;
                    float av[8], hv[8];
#pragma unroll
                    for (int q = 0; q < 8; ++q) { const size_t so = ((size_t)(b * 512 + q)) * 256 + ch; av[q] = LA[so]; hv[q] = LH[so]; }
#pragma unroll 1
                    for (int c0 = 0; c0 < 512; c0 += 8) { float an[8], hn[8]; const int cn = c0 + 8 < 512 ? c0 + 8 : c0;
#pragma unroll
                        for (int q = 0; q < 8; ++q) { const size_t so = ((size_t)(b * 512 + cn + q)) * 256 + ch; an[q] = LA[so]; hn[q] = LH[so]; }
                        __builtin_amdgcn_sched_barrier(0);
#pragma unroll
                        for (int q = 0; q < 8; ++q) { CIN[((size_t)(b * 512 + c0 + q)) * 256 + ch] = carry; carry = av[q] * carry + hv[q]; }
#pragma unroll
                        for (int q = 0; q < 8; ++q) { av[q] = an[q]; hv[q] = hn[q]; } }
                    asm volatile("s_waitcnt vmcnt(0)" ::: "memory"); __syncthreads();
                    if (tid == 0) { __builtin_amdgcn_fence(__ATOMIC_RELEASE, "agent"); asm volatile("s_waitcnt vmcnt(0)" ::: "memory"); (void)xb_add(ctl + CW_FLAG + 64 * (2 * l + 0), 1u); }
                    continue;
                }
                r -= Q_J5;
                if (r < Q_J6) {
                    const int e = r * NTHR + tid, b = e >> 13, rem = e & 8191; float Sv = 0.f;
                    float kv[8], dv[8];
#pragma unroll
                    for (int q = 0; q < 8; ++q) { kv[q] = KVC[(size_t)(b * 128 + q) * 8192 + rem]; dv[q] = DEC[(size_t)(b * 128 + q) * 128 + (rem >> 6)]; }
#pragma unroll 1
                    for (int c0 = 0; c0 < 128; c0 += 8) { float kn[8], dn[8]; const int cn = c0 + 8 < 128 ? c0 + 8 : c0;
#pragma unroll
                        for (int q = 0; q < 8; ++q) { kn[q] = KVC[(size_t)(b * 128 + cn + q) * 8192 + rem]; dn[q] = DEC[(size_t)(b * 128 + cn + q) * 128 + (rem >> 6)]; }
                        __builtin_amdgcn_sched_barrier(0);
#pragma unroll
                        for (int q = 0; q < 8; ++q) { SST[(size_t)(b * 128 + c0 + q) * 8192 + rem] = Sv; Sv = dv[q] * Sv + kv[q]; }
#pragma unroll
                        for (int q = 0; q < 8; ++q) { kv[q] = kn[q]; dv[q] = dn[q]; } }
                    asm volatile("s_waitcnt vmcnt(0)" ::: "memory"); __syncthreads();
                    if (tid == 0) { __builtin_amdgcn_fence(__ATOMIC_RELEASE, "agent"); asm volatile("s_waitcnt vmcnt(0)" ::: "memory"); (void)xb_add(ctl + CW_FLAG + 64 * (2 * l + 1), 1u); }
                    continue;
                }
                r -= Q_J6;
                if (r >= Q_ATT) {
                    r -= Q_ATT; const bool is9 = r < Q_J9;
                    if (!(is9 ? seen5 : seen6)) {
                        if (tid == 0) { unsigned* f = ctl + CW_FLAG + 64 * (2 * l + (is9 ? 0 : 1)); const unsigned target = is9 ? (unsigned)Q_J5 : (unsigned)Q_J6;
                            XB_SPIN(xb_ld(f) < target, ctl + CW_BAR); __builtin_amdgcn_fence(__ATOMIC_ACQUIRE, "agent"); asm volatile("s_waitcnt vmcnt(0)" ::: "memory"); LCTL[is9 ? 4 : 5] = 1u; }
                        __syncthreads(); }
                    if (is9) {
                    const int b = r >> 8, tb = r & 255, t0 = tb * 32, ch = tid & 255, half = tid >> 8;
                    LAS float* xa = ldsf;
                    float hst = CIN[((size_t)(b * 512 + tb * 2 + half)) * 256 + ch];
                    { float av[16], uv[16], gv[16];
#pragma unroll
                      for (int tt = 0; tt < 16; ++tt) { const size_t ro = (size_t)b * SEQ + t0 + half * 16 + tt; av[tt] = LRA[ro * 256 + ch]; uv[tt] = LRU_[ro * 256 + ch]; gv[tt] = bf2f(PB[ro * NIN + C_AG + ch]); }
                      __builtin_amdgcn_sched_barrier(0);
#pragma unroll
                      for (int tt = 0; tt < 16; ++tt) { hst = av[tt] * hst + uv[tt]; xa[(half * 16 + tt) * 256 + ch] = hst * gelu_tanh(gv[tt]); } }
                    __syncthreads();
                    for (int q = 0; q < 4; ++q) { const int rr = wave * 4 + q; const f32x4 v = ((const LAS f32x4*)(xa + rr * 256))[lane];
                        const float rinv = rsqrtf(wave_sum(v[0] * v[0] + v[1] * v[1] + v[2] * v[2] + v[3] * v[3]) * (1.f / 256.f) + EPS);
                        u32x2 w; w.x = pk2(v[0] * rinv, v[1] * rinv); w.y = pk2(v[2] * rinv, v[3] * rinv);
                        *(u32x2*)(Y + ((size_t)b * SEQ + t0 + rr) * DM + 256 + 4 * lane) = w; }
                    __syncthreads();
                    } else { r -= Q_J9;
                    const int b = r >> 7, c = r & 127; const size_t row0 = (size_t)b * SEQ + 64 * c;
                    LAS float* bL = ldsf; LAS float* glr = ldsf + 8192; LAS unsigned char* VTl = lds + 36864; LAS unsigned char* STl = lds + 71680; LAS float* SSX = (LAS float*)(lds + 92160);
                    const int r32_ = lane & 31, hi_ = lane >> 5, h_ = wave >> 1, i_ = 32 * (wave & 1) + r32_;
                    bf16x8 qv_[2], kv_[2][2]; u32x2 ogw_[2][4]; f32x4 gn_[2][4];
#pragma unroll
                    for (int ks = 0; ks < 2; ++ks) { const int k0 = h_ * 32 + 16 * ks + 8 * hi_; qv_[ks] = ld8x2(PB + (row0 + i_) * NIN + C_CQ + k0);
#pragma unroll
                        for (int jt = 0; jt < 2; ++jt) kv_[jt][ks] = ld8x2(PB + (row0 + 32 * jt + r32_) * NIN + C_CK + k0); }
                    { const float* gnp = inp(args, 17) + l * 64;
#pragma unroll
                      for (int dt = 0; dt < 2; ++dt)
#pragma unroll
                          for (int g = 0; g < 4; ++g) { const int v0 = 32 * dt + 8 * g + 4 * hi_; ogw_[dt][g] = *(const u32x2*)(PB + (row0 + i_) * NIN + C_OG + h_ * 64 + v0); gn_[dt][g] = *(const f32x4*)(gnp + v0); } }
                    {
                        f32x4 bv[4], sv[4]; u32x2 vA[4], vB[4];
                        const f32x4* bsrc = (const f32x4*)((const float*)(ws + WS_BCS) + row0 * 128); const f32x4* ssrc = (const f32x4*)(SST + (size_t)(b * 128 + c) * 8192);
#pragma unroll
                        for (int it = 0; it < 4; ++it) { const int e = tid + it * NTHR; bv[it] = bsrc[e]; sv[it] = ssrc[e];
                            const int jj = e >> 5, hc = e & 31, h = hc >> 3, c8 = hc & 7; const bf16_t* vsrc = PB + (row0 + jj) * NIN + C_CV + h * 64 + 8 * c8; vA[it] = *(const u32x2*)vsrc; vB[it] = *(const u32x2*)(vsrc + 4); }
                        __builtin_amdgcn_sched_barrier(0);
#pragma unroll
                        for (int it = 0; it < 4; ++it) { const int e = tid + it * NTHR; ((LAS f32x4*)bL)[e] = bv[it];
                            { const int jj = e >> 5, hc = e & 31, h = hc >> 3, c8 = hc & 7; u32x4 w; w.x = vA[it].x; w.y = vA[it].y; w.z = vB[it].x; w.w = vB[it].y;
                              LAS bf16_t* d = (LAS bf16_t*)(VTl + h * 8704 + (8 * c8) * VSTR) + jj;
                              d[0] = (bf16_t)w.x; d[VSTR / 2] = (bf16_t)(w.x >> 16); d[2 * (VSTR / 2)] = (bf16_t)w.y; d[3 * (VSTR / 2)] = (bf16_t)(w.y >> 16); d[4 * (VSTR / 2)] = (bf16_t)w.z; d[5 * (VSTR / 2)] = (bf16_t)(w.z >> 16); d[6 * (VSTR / 2)] = (bf16_t)w.w; d[7 * (VSTR / 2)] = (bf16_t)(w.w >> 16); }
                            { const int e4 = e * 4, h = e4 >> 11, k = (e4 >> 6) & 31, v = e4 & 63;
#pragma unroll
                              for (int u = 0; u < 4; ++u) *(LAS bf16_t*)(STl + h * 5120 + (v + u) * 80 + k * 2) = f2bf(sv[it][u]); } }
                    }
                    __syncthreads();
                    { const int r32 = lane & 31, hi = lane >> 5, h = wave >> 1, ih = wave & 1, i = 32 * ih + r32; const float SCG = 0.17677669529663687f;
                      bf16x8 qrel[2], qabs[2], kt[2][2];
#pragma unroll
                      for (int ks = 0; ks < 2; ++ks) { const int k0 = h * 32 + 16 * ks + 8 * hi; const bf16x8 qv = qv_[ks]; u32x4 wr_, wa_; unsigned* pr_ = (unsigned*)&wr_; unsigned* pa_ = (unsigned*)&wa_;
#pragma unroll
                          for (int e2 = 0; e2 < 4; ++e2) { const float b0 = bL[i * 128 + k0 + 2 * e2], b1 = bL[i * 128 + k0 + 2 * e2 + 1], f0 = bL[31 * 128 + k0 + 2 * e2], f1 = bL[31 * 128 + k0 + 2 * e2 + 1];
                              const float q0 = bf2f((bf16_t)qv[2 * e2]) * SCG, q1 = bf2f((bf16_t)qv[2 * e2 + 1]) * SCG;
                              pr_[e2] = cvtpk(q0 * __expf(b0 - f0), q1 * __expf(b1 - f1)); pa_[e2] = cvtpk(q0 * __expf(b0), q1 * __expf(b1)); }
                          qrel[ks] = __builtin_bit_cast(bf16x8, wr_); qabs[ks] = __builtin_bit_cast(bf16x8, wa_); }
#pragma unroll
                      for (int jt = 0; jt < 2; ++jt)
#pragma unroll
                          for (int ks = 0; ks < 2; ++ks) { const int jr = 32 * jt + r32, k0 = h * 32 + 16 * ks + 8 * hi; const bf16x8 kv = kv_[jt][ks]; u32x4 wk_; unsigned* pk_ = (unsigned*)&wk_;
#pragma unroll
                              for (int e2 = 0; e2 < 4; ++e2) { const float b0 = bL[jr * 128 + k0 + 2 * e2], b1 = bL[jr * 128 + k0 + 2 * e2 + 1], f0 = bL[31 * 128 + k0 + 2 * e2], f1 = bL[31 * 128 + k0 + 2 * e2 + 1];
                                  pk_[e2] = cvtpk(bf2f((bf16_t)kv[2 * e2]) * __expf(f0 - b0), bf2f((bf16_t)kv[2 * e2 + 1]) * __expf(f1 - b1)); }
                              kt[jt][ks] = __builtin_bit_cast(bf16x8, wk_); }
                      f32x16 o[2], s[2];
#pragma unroll
                      for (int q = 0; q < 16; ++q) { o[0][q] = 0.f; o[1][q] = 0.f; s[0][q] = 0.f; s[1][q] = 0.f; }
#pragma unroll
                      for (int ks = 0; ks < 2; ++ks) s[0] = mfma32(kt[0][ks], qrel[ks], s[0]);
                      if (ih) {
#pragma unroll
                          for (int ks = 0; ks < 2; ++ks) s[1] = mfma32(kt[1][ks], qrel[ks], s[1]); }
#pragma unroll
                      for (int q = 0; q < 16; ++q) { const int jr = (q & 3) + 8 * (q >> 2) + 4 * hi; if (jr > r32) { if (ih) s[1][q] = 0.f; else s[0][q] = 0.f; } }
                      const LAS unsigned char* VTh = VTl + h * 8704; const LAS unsigned char* STh = STl + h * 5120;
#pragma unroll
                      for (int dt = 0; dt < 2; ++dt) { const LAS unsigned char* vp = VTh + (32 * dt + r32) * VSTR + 8 * hi;
                          o[dt] = mfma32(vfrag(vp), pack8<0>(s[0]), o[dt]); o[dt] = mfma32(vfrag(vp + 32), pack8<8>(s[0]), o[dt]);
                          if (ih) { o[dt] = mfma32(vfrag(vp + 64), pack8<0>(s[1]), o[dt]); o[dt] = mfma32(vfrag(vp + 96), pack8<8>(s[1]), o[dt]); }
#pragma unroll
                          for (int ks = 0; ks < 2; ++ks) o[dt] = mfma32(*(const LAS bf16x8*)(STh + (32 * dt + r32) * 80 + 32 * ks + 16 * hi), qabs[ks], o[dt]); }
                      float ssh = 0.f;
#pragma unroll
                      for (int q = 0; q < 16; ++q) ssh += o[0][q] * o[0][q] + o[1][q] * o[1][q];
                      const float rh = rsqrtf(xhalf_sum(ssh) * (1.f / 64.f) + EPS); float ssg = 0.f;
#pragma unroll
                      for (int dt = 0; dt < 2; ++dt)
#pragma unroll
                          for (int g = 0; g < 4; ++g) { const int v0 = 32 * dt + 8 * g + 4 * hi; const u32x2 ogw = ogw_[dt][g]; const f32x4 gn = gn_[dt][g]; (void)v0;
                              const float og4[4] = {bflo(ogw.x), bfhi(ogw.x), bflo(ogw.y), bfhi(ogw.y)};
#pragma unroll
                              for (int q = 0; q < 4; ++q) { const float y = o[dt][4 * g + q] * rh * gn[q] * (og4[q] * sigmoidf_(og4[q])); o[dt][4 * g + q] = y; ssg += y * y; } }
                      ssg = xhalf_sum(ssg); if (hi == 0) SSX[i * 4 + h] = ssg;
                      __syncthreads();
                      const f32x4 s4 = *(const LAS f32x4*)(SSX + i * 4); const float rinv = rsqrtf((s4[0] + s4[1] + s4[2] + s4[3]) * (1.f / 256.f) + EPS);
#pragma unroll
                      for (int dt = 0; dt < 2; ++dt)
#pragma unroll
                          for (int g = 0; g < 4; ++g) { u32x2 w; w.x = cvtpk(o[dt][4 * g] * rinv, o[dt][4 * g + 1] * rinv); w.y = cvtpk(o[dt][4 * g + 2] * rinv, o[dt][4 * g + 3] * rinv);
                              *(u32x2*)(Y + (row0 + i) * DM + 768 + h * 64 + 32 * dt + 8 * g + 4 * hi) = w; } }
                    __syncthreads();
                    }
                    continue;
                }
                const int r32 = lane & 31, hi = lane >> 5;
                const int rep = r >> 10; r &= 1023;
                const int grp = r >> 5, within = r & 31;
                if (rep && ((REP_ONLY == 1 && within >= 16) || (REP_ONLY == 2 && within < 16))) continue;
              {
                if (within >= 16) {
                    const int idx = within - 16, b = idx & 3, tb = 127 - (4 * grp + (idx >> 2));
                    const int tl = 8 * wave + (r32 >> 2), head = r32 & 3, T = 64 * tb + tl; const size_t row = (size_t)b * SEQ + T; const bf16_t* prow = PB + row * NIN;
                    bf16_t gb0 = prow[C_BG + head * 3], gb1 = prow[C_BG + head * 3 + 1], gb2 = prow[C_BG + head * 3 + 2];
                    bf16x8 qf[4];
#pragma unroll
                    for (int ks = 0; ks < 4; ++ks) qf[ks] = *(const bf16x8*)(prow + C_BQ + head * 64 + 16 * ks + 8 * hi);
                    { unsigned t0_ = gb0, t1_ = gb1, t2_ = gb2; asm volatile("" : "+v"(t0_), "+v"(t1_), "+v"(t2_)); gb0 = (bf16_t)t0_; gb1 = (bf16_t)t1_; gb2 = (bf16_t)t2_; }
                    LAS float* impb = (LAS float*)(lds + AL_IMP) + wave * 1024; LAS unsigned* selm = (LAS unsigned*)(lds + AL_SELM) + wave * 32;
                    const int skey = tid >> 3, sch = tid & 7;
                    const unsigned koffP = (unsigned)(skey * NIN + sch * 8), voffS = (unsigned)(skey * SEQ + sch * 8), koffC = (unsigned)(skey * 64 + sch * 8), voffC = (unsigned)(skey * 512 + sch * 8);
                    auto stK = [&](int buf, const StageRegs& R) __attribute__((always_inline)) { *(LAS u32x4*)(lds + (buf ? AL_K1 : AL_K0) + skey * KSTR + sch * 16) = R.a; };
                    auto stKV = [&](int buf, const StageRegs& R) __attribute__((always_inline)) { *(LAS u32x4*)(lds + (buf ? AL_K1 : AL_K0) + skey * KSTR + sch * 16) = R.a;
                        LAS unsigned char* vd = lds + (buf ? AL_V1 : AL_V0) + skey * VSTP + (sch >> 1) * 32 + (sch & 1) * 8; u32x2 a, c; a.x = R.b.x; a.y = R.b.y; c.x = R.b.z; c.y = R.b.w; *(LAS u32x2*)vd = a; *(LAS u32x2*)(vd + 16) = c; };
                    f32x16 oacc[2], ob[2];
                    const int nv = T >= 31 ? ((T - 31) >> 4) + 1 : 0, ntc = (4 * tb + 3 + 63) >> 6;
                    float mC = NEGB, lC = 0.f;
                    { const bf16_t* kb_ = KCMPB + (size_t)b * 512 * 64;
                      attn_pipeline(wave, 0, ntc - 1, [&](int j, StageRegs& R) __attribute__((always_inline)) { R.a = SLD16(kb_ + (size_t)j * 64 * 64, koffC); }, stK,
                        [&](int j, int cb) __attribute__((always_inline)) { f32x16 s0, s1; qk_tile<4>(lds + (cb ? AL_K1 : AL_K0), qf, r32, hi, s0, s1); if (!__all(nv - 1 - 64 * j >= 63)) mask_tile(s0, s1, 0, nv - 1 - 64 * j, hi);
                            const float mx = tile_max(s0, s1), mn = fmaxf(mC, mx), ms = mn < -1e29f ? 0.f : mn, alpha = ex2(mC - ms); mC = mn; float ps = 0.f;
#pragma unroll
                            for (int i = 0; i < 16; ++i) ps += ex2(s0[i] - ms) + ex2(s1[i] - ms);
                            lC = lC * alpha + ps; }); }
                    { const float invC = 1.f / fmaxf(xhalf_sum(lC), 1e-30f), msC = mC < -1e29f ? 0.f : mC; float carry = 0.f;
#pragma unroll
                      for (int i = 0; i < 16; ++i) { ob[0][i] = 0.f; ob[1][i] = 0.f; }
                      const bf16_t* kb_ = KCMPB + (size_t)b * 512 * 64; const bf16_t* vb_ = VCMPT + (size_t)b * 64 * 512;
                      attn_pipeline(wave, 0, ntc - 1, [&](int j, StageRegs& R) __attribute__((always_inline)) { R.a = SLD16(kb_ + (size_t)j * 64 * 64, koffC); R.b = SLD16(vb_ + j * 64, voffC); }, stKV,
                        [&](int j, int cb) __attribute__((always_inline)) { f32x16 s0, s1; qk_tile<4>(lds + (cb ? AL_K1 : AL_K0), qf, r32, hi, s0, s1); if (!__all(nv - 1 - 64 * j >= 63)) mask_tile(s0, s1, 0, nv - 1 - 64 * j, hi);
#pragma unroll
                            for (int i = 0; i < 16; ++i) { s0[i] = ex2(s0[i] - msC) * invC; s1[i] = ex2(s1[i] - msC) * invC; }
                            float gs[8], pl[8];
#pragma unroll
                            for (int q = 0; q < 4; ++q) { gs[q] = (s0[4 * q] + s0[4 * q + 1]) + (s0[4 * q + 2] + s0[4 * q + 3]); gs[4 + q] = (s1[4 * q] + s1[4 * q + 1]) + (s1[4 * q + 2] + s1[4 * q + 3]);
                                pl[q] = x32f_other(s0[4 * q + 3]); pl[4 + q] = x32f_other(s1[4 * q + 3]); }
#pragma unroll
                            for (int q = 0; q < 8; ++q) { const float prev = hi ? pl[q] : (q > 0 ? pl[q > 0 ? q - 1 : 0] : carry); float x = quad_sum(gs[q] + prev);
                                if ((r32 & 3) == 0) impb[(r32 >> 2) * 128 + 16 * j + 2 * q + hi] = x; }
                            carry = pl[7];
                            pv_tile(s0, s1, lds + (cb ? AL_V1 : AL_V0), ob, r32, hi); }); }
                    LAS float* oav = (LAS float*)(lds + AL_OACC) + tid; const float g0 = sigmoidf_(bf2f(gb0));
#pragma unroll
                    for (int i = 0; i < 16; ++i) { oav[i * 512] = g0 * ob[0][i]; oav[(16 + i) * 512] = g0 * ob[1][i]; }
                    WSYNC();
                    for (int tk = 0; tk < 8; ++tk) {
                        const int cur = tb, j0 = lane, j1 = lane + 64; const float im0 = impb[tk * 128 + j0], im1 = impb[tk * 128 + j1];
                        const unsigned k0 = ((j0 == 0 || j0 == cur || j0 == cur - 1) ? 0xFF000000u : (j0 <= cur ? (__float_as_uint(im0) & ~127u) : 0u)) | (unsigned)(127 - j0);
                        const unsigned k1 = ((j1 == cur || j1 == cur - 1) ? 0xFF000000u : (j1 <= cur ? (__float_as_uint(im1) & ~127u) : 0u)) | (unsigned)(127 - j1);
                        unsigned T = 0u;
#pragma unroll 4
                        for (int bb = 31; bb >= 0; --bb) { const unsigned cand = T | (1u << bb); const int cnt = __popcll(__ballot(k0 >= cand)) + __popcll(__ballot(k1 >= cand)); if (cnt >= 16) T = cand; if (cnt == 16) break; }
                        const unsigned long long m0 = __ballot(k0 >= T), m1 = __ballot(k1 >= T);
                        if (lane == 0) { selm[tk * 4] = (unsigned)m0; selm[tk * 4 + 1] = (unsigned)(m0 >> 32); selm[tk * 4 + 2] = (unsigned)m1; selm[tk * 4 + 3] = (unsigned)(m1 >> 32); }
                    }
                    WSYNC();
                    const unsigned sm0 = selm[(r32 >> 2) * 4], sm1 = selm[(r32 >> 2) * 4 + 1], sm2 = selm[(r32 >> 2) * 4 + 2], sm3 = selm[(r32 >> 2) * 4 + 3];
                    { SoftState SB; soft_init(SB, ob);
                      unsigned u0 = sm0, u1 = sm1, u2 = sm2, u3 = sm3;
                      u0 = wave_or(u0); u1 = wave_or(u1); u2 = wave_or(u2); u3 = wave_or(u3);
                      unsigned long long Ulo = ((unsigned long long)(unsigned)__builtin_amdgcn_readfirstlane((int)u1) << 32) | (unsigned)__builtin_amdgcn_readfirstlane((int)u0), Uhi = ((unsigned long long)(unsigned)__builtin_amdgcn_readfirstlane((int)u3) << 32) | (unsigned)__builtin_amdgcn_readfirstlane((int)u2);
                      if (tb < 64) { if (tb < 63) Ulo &= (2ull << tb) - 1ull; Uhi = 0ull; } else if (tb < 127) Uhi &= (2ull << (tb - 64)) - 1ull;
                      const bf16_t* ksf = KSF + (size_t)b * 128 * 4096; const bf16_t* vsf = VST + (size_t)b * 128 * 4096; const unsigned lo8 = (unsigned)lane * 8u;
                      bf16x8 kf[2][4], vf[2][4];
                      int j = 0; Ulo &= ~1ull;
#pragma unroll
                      for (int f = 0; f < 8; ++f) kf[f >> 2][f & 3] = *(const bf16x8*)((ksf + f * 512) + lo8);
                      bool first = true;
                      for (;;) {
#pragma unroll
                          for (int f = 0; f < 8; ++f) vf[f >> 2][f & 3] = *(const bf16x8*)((vsf + (size_t)j * 4096 + f * 512) + lo8);
                          const unsigned wsel = j < 32 ? sm0 : (j < 64 ? sm1 : (j < 96 ? sm2 : sm3)); const bool bit = (wsel >> (j & 31)) & 1u;
                          const f32x16 cinit = bcast16(bit ? -SB.m : NEGB); f32x16 s0 = cinit, s1 = cinit;
#pragma unroll
                          for (int ks = 0; ks < 4; ++ks) { s0 = mfma32(kf[0][ks], qf[ks], s0); s1 = mfma32(kf[1][ks], qf[ks], s1); }
                          __builtin_amdgcn_sched_barrier(0);
                          const int jn = Ulo ? (int)__builtin_ctzll(Ulo) : (Uhi ? 64 + (int)__builtin_ctzll(Uhi) : -1);
                          if (Ulo) Ulo &= Ulo - 1ull; else Uhi &= Uhi - 1ull;
                          if (jn >= 0) {
#pragma unroll
                              for (int f = 0; f < 8; ++f) kf[f >> 2][f & 3] = *(const bf16x8*)((ksf + (size_t)jn * 4096 + f * 512) + lo8); }
                          soft_update(s0, s1, SB, ob, j == tb, 0, tl, first, hi);
                          { const bf16x8 p00 = pack8<0>(s0), p01 = pack8<8>(s0), p10 = pack8<0>(s1), p11 = pack8<8>(s1);
#pragma unroll
                            for (int dt = 0; dt < 2; ++dt) { ob[dt] = mfma32(vf[dt][0], p00, ob[dt]); ob[dt] = mfma32(vf[dt][1], p01, ob[dt]); ob[dt] = mfma32(vf[dt][2], p10, ob[dt]); ob[dt] = mfma32(vf[dt][3], p11, ob[dt]); } }
                          if (jn < 0) break;
                          j = jn; first = false;
                      }
                      const float sc = sigmoidf_(bf2f(gb1)) / fmaxf(xhalf_sum(SB.l), 1e-30f);
#pragma unroll
                      for (int i = 0; i < 16; ++i) { oav[i * 512] += sc * ob[0][i]; oav[(16 + i) * 512] += sc * ob[1][i]; } }
                    __syncthreads();
                    { SoftState SB; soft_init(SB, ob); const int jb0 = tb >= 8 ? tb - 8 : 0;
                      const bf16_t* kb_ = PB + (size_t)b * SEQ * NIN + C_KW; const bf16_t* vb_ = VWT + (size_t)b * 64 * SEQ;
                      attn_pipeline(wave, tb >= 8 ? tb - 8 : 0, tb, [&](int j, StageRegs& R) __attribute__((always_inline)) { R.a = SLD16(kb_ + (size_t)j * 64 * NIN, koffP); R.b = SLD16(vb_ + j * 64, voffS); }, stKV,
                        [&](int j, int cb) __attribute__((always_inline)) { attn_step<4>(lds + (cb ? AL_K1 : AL_K0), lds + (cb ? AL_V1 : AL_V0), qf, SB, ob, j == tb || j == tb - 8, j == tb - 8 ? tl + 1 : 0, j == tb ? tl : 63, j == jb0, r32, hi); });
                      const float sc = sigmoidf_(bf2f(gb2)) / fmaxf(xhalf_sum(SB.l), 1e-30f);
#pragma unroll
                      for (int i = 0; i < 16; ++i) { oacc[0][i] = oav[i * 512] + sc * ob[0][i]; oacc[1][i] = oav[(16 + i) * 512] + sc * ob[1][i]; } }
                    { float ss = 0.f;
#pragma unroll
                      for (int i = 0; i < 16; ++i) ss += oacc[0][i] * oacc[0][i] + oacc[1][i] * oacc[1][i];
                      ss = quad_sum(xhalf_sum(ss));
                      const float rinv = rsqrtf(ss * (1.f / 256.f) + EPS);
#pragma unroll
                      for (int dt = 0; dt < 2; ++dt)
#pragma unroll
                          for (int g = 0; g < 4; ++g) { u32x2 w; w.x = cvtpk(oacc[dt][4 * g] * rinv, oacc[dt][4 * g + 1] * rinv); w.y = cvtpk(oacc[dt][4 * g + 2] * rinv, oacc[dt][4 * g + 3] * rinv);
                              *(u32x2*)(Y + row * DM + 512 + head * 64 + 32 * dt + 8 * g + 4 * hi) = w; } }
                    __syncthreads();
                    continue;
                }
                {
                    const int qb = 31 - grp, b = within >> 2, h = within & 3;
                    const int T = 256 * qb + 32 * wave + r32; const size_t row = (size_t)b * SEQ + T;
                    bf16x8 qf[6];
#pragma unroll
                    for (int ks = 0; ks < 6; ++ks) qf[ks] = *(const bf16x8*)(MQ + row * 384 + h * 96 + 16 * ks + 8 * hi);
                    f32x16 o[2]; SoftState SM; soft_init(SM, o);
                    const int jd = 4 * qb + (wave >> 1);
                    const bf16_t* kn = MKN + (size_t)b * SEQ * 256 + h * 64; const bf16_t* kr = MKR + (size_t)b * SEQ * 32; const bf16_t* vt = MVT + (size_t)(b * 4 + h) * 64 * SEQ;
                    constexpr int VS2 = 272, AM_K0 = 0, AM_K1 = 128 * KSTR, AM_V0 = 2 * 128 * KSTR, AM_V1 = AM_V0 + 64 * VS2;
                    const int nk = tid >> 3, nc = tid & 7, rkey = tid >> 2, rch = tid & 3, vr = tid >> 4, vc = tid & 15;
                    const unsigned kob0 = (unsigned)(nk * 256 + nc * 8) * 2u, kob1 = (unsigned)(rkey * 32 + rch * 8) * 2u, vob_ = (unsigned)(vr * SEQ + vc * 8) * 2u;
                    attn_pipeline(wave, 0, 2 * qb + 1,
                        [&](int jj, StageRegs& R) __attribute__((always_inline)) {
                            typedef const __attribute__((address_space(1))) char* gcp; typedef const __attribute__((address_space(1))) u32x4 gq4;
                            gcp b0 = (gcp)(kn + (size_t)jj * 128 * 256), b1 = (gcp)(kn + (size_t)jj * 128 * 256 + 64 * 256), b2 = (gcp)(kr + (size_t)jj * 128 * 32), b3 = (gcp)(vt + jj * 128), b4 = (gcp)(vt + jj * 128 + 32 * SEQ);
                            unsigned o0 = kob0, o1 = kob1, o2 = vob_; asm volatile("" : "+s"(b0), "+s"(b1), "+s"(b2), "+s"(b3), "+s"(b4), "+v"(o0), "+v"(o1), "+v"(o2));
                            R.a = *(gq4*)(b0 + o0); R.b = *(gq4*)(b1 + o0); R.c = *(gq4*)(b2 + o1); R.d = *(gq4*)(b3 + o2); R.e = *(gq4*)(b4 + o2); },
                        [&](int buf, const StageRegs& R) __attribute__((always_inline)) { LAS unsigned char* kb_ = lds + (buf ? AM_K1 : AM_K0); LAS unsigned char* vb_ = lds + (buf ? AM_V1 : AM_V0) + vr * VS2 + (vc >> 1) * 32 + (vc & 1) * 8;
                            *(LAS u32x4*)(kb_ + nk * KSTR + nc * 16) = R.a; *(LAS u32x4*)(kb_ + (64 + nk) * KSTR + nc * 16) = R.b; *(LAS u32x4*)(kb_ + rkey * KSTR + 128 + rch * 16) = R.c;
                            u32x2 p, q; p.x = R.d.x; p.y = R.d.y; q.x = R.d.z; q.y = R.d.w; *(LAS u32x2*)vb_ = p; *(LAS u32x2*)(vb_ + 16) = q;
                            p.x = R.e.x; p.y = R.e.y; q.x = R.e.z; q.y = R.e.w; *(LAS u32x2*)(vb_ + 32 * VS2) = p; *(LAS u32x2*)(vb_ + 32 * VS2 + 16) = q; },
                        [&](int jj, int cb) __attribute__((always_inline)) {
                            const int kd = 32 * (wave & 1) + r32;
#pragma unroll
                            for (int hh = 0; hh < 2; ++hh) { const int j = 2 * jj + hh;
                                if (j <= jd) attn_step<6, VS2, true>(lds + (cb ? AM_K1 : AM_K0) + hh * 64 * KSTR, lds + (cb ? AM_V1 : AM_V0) + hh * 128, qf, SM, o, j == jd, 0, kd, j == 0, r32, hi); } });
                    { const float inv = 1.f / fmaxf(xhalf_sum(SM.l), 1e-30f); float ss = 0.f;
#pragma unroll
                      for (int dt = 0; dt < 2; ++dt)
#pragma unroll
                          for (int g = 0; g < 4; ++g) { const float v0 = o[dt][4 * g] * inv, v1 = o[dt][4 * g + 1] * inv, v2 = o[dt][4 * g + 2] * inv, v3 = o[dt][4 * g + 3] * inv; ss += v0 * v0 + v1 * v1 + v2 * v2 + v3 * v3;
                              u32x2 w; w.x = cvtpk(v0, v1); w.y = cvtpk(v2, v3); *(u32x2*)(Y + row * DM + h * 64 + 32 * dt + 8 * g + 4 * hi) = w; }
                      ss = xhalf_sum(ss); if (hi == 0) ssq_d[(size_t)h * M + row] = ss; }
                    __syncthreads();
                }
              }
            }
        }
        SEAM(pb + 2);
        if (IN(pb + 3)) {
        const int l_ = l; WS_PTRS();
            pg8::Gemm g{Y, (const bf16_t*)(ws + WS_WOUT) + (size_t)l * DM * DM, M, DM, DM}; pg8::StaticOrder S; S.init(M, DM, G, bid);
            pg8::EpiResid<true> E{XB, ssq_out, ssq_d, (LAS float*)(lds + 131072)};
            pg8::gemm_phase<pg8::EpiResid<true>, pg8::StaticOrder, true, true>(lds, g, S, E, wave);
            if (REP_G57) { pg8::EpiInProj E2{PB, DM, ssq_mix}; pg8::gemm_phase<pg8::EpiInProj, pg8::StaticOrder, true, true>(lds, g, S, E2, wave); }
        }
        SEAM(pb + 3);
        if (IN(pb + 4)) {
        const int l_ = l; WS_PTRS();
            pg8::Gemm g{XB, (const bf16_t*)(ws + WS_WGU) + (size_t)l * NGU * DM, M, NGU, DM}; pg8::StaticOrder S; S.init(M, NGU, G, bid);
            pg8::EpiSwiglu E{ACT, ssq_out};
            _Pragma("unroll 1") for (int rep = 0; rep < REP_G16; ++rep) pg8::gemm_phase<pg8::EpiSwiglu, pg8::StaticOrder, true, true>(lds, g, S, E, wave);
        }
        SEAM(pb + 4);
        if (IN(pb + 5)) {
        const int l_ = l; WS_PTRS();
            pg8::Gemm g{ACT, (const bf16_t*)(ws + WS_WDN) + (size_t)l * DM * FF, M, DM, FF}; pg8::StaticOrder S; S.init(M, DM, G, bid);
            pg8::EpiResid<false> E{XB, ssq_down, nullptr, (LAS float*)(lds + 131072)};
            pg8::gemm_phase<pg8::EpiResid<false>, pg8::StaticOrder, true, true>(lds, g, S, E, wave);
            if (REP_G57) { pg8::EpiInProj E2{Y, DM, ssq_mix}; pg8::gemm_phase<pg8::EpiInProj, pg8::StaticOrder, true, true>(lds, g, S, E2, wave); }
        }
        SEAM(pb + 5);
    }
    if (IN(13)) {
        const int l_ = 1; WS_PTRS();
        LAUNDER_TID();
        const float* ssqf = ssp_base + (size_t)5 * 4 * M; const int gw = bid * 8 + wave, NGW = G * 8;
        for (int m = gw; m < M; m += NGW) {
            const float rinv = rsqrtf(sum4p(ssqf, m) * (1.f / DM) + EPS);
            const u32x2* xr = (const u32x2*)(XB + (size_t)m * DM) + lane; f32x4* orow = (f32x4*)(out_ + (size_t)m * DM) + lane; const f32x4* gn = (const f32x4*)inp(args, 27) + lane;
#pragma unroll
            for (int j = 0; j < 4; ++j) { const u32x2 w = xr[64 * j]; const f32x4 g = gn[64 * j]; f32x4 v; v[0] = bflo(w.x) * rinv * g[0]; v[1] = bfhi(w.x) * rinv * g[1]; v[2] = bflo(w.y) * rinv * g[2]; v[3] = bfhi(w.y) * rinv * g[3]; orow[64 * j] = v; }
        }
    }
#undef IN
#undef SEAM
}

extern "C" void kernel_launch(void* const* d_in, const int* in_sizes, int n_in, void* d_out, int out_size, void* d_ws, size_t ws_size, hipStream_t stream) {
    static int grid = 0;
    if (grid == 0) {
        if (n_in != 28 || in_sizes[0] != M * DM || out_size != M * DM || ws_size < WS_END) { fprintf(stderr, "kernel_launch: unexpected shapes (n_in %d, ws %zu)\n", n_in, ws_size); grid = -1; return; }
        int dev = 0, cus = 0;
        if (hipGetDevice(&dev) != hipSuccess || hipDeviceGetAttribute(&cus, hipDeviceAttributeMultiprocessorCount, dev) != hipSuccess) { grid = -1; return; }
        if (hipFuncSetAttribute((const void*)fwd, hipFuncAttributeMaxDynamicSharedMemorySize, LDS_BYTES) != hipSuccess) { fprintf(stderr, "kernel_launch: hipFuncSetAttribute failed\n"); grid = -1; return; }
        int per_cu = 0;
        if (hipOccupancyMaxActiveBlocksPerMultiprocessor(&per_cu, (const void*)fwd, NTHR, LDS_BYTES) != hipSuccess || per_cu < 1) fprintf(stderr, "kernel_launch: occupancy query says %d\n", per_cu);
        (void)hipGetLastError();
        grid = cus;
    }
    if (grid < 0) return;
    (void)hipMemsetAsync((char*)d_ws + WS_CTL, 0, CTL_ZERO_BYTES, stream);
    Args a{};
    for (int i = 0; i < 28; ++i) a.in[i] = (const float*)d_in[i];
    a.out = (float*)d_out; a.ws = (unsigned char*)d_ws;
    if (MK_N_LAUNCHES == 1) { a.ph_lo = 0; a.ph_hi = 14; hipLaunchKernelGGL(fwd, dim3(grid), dim3(NTHR), LDS_BYTES, stream, a); }
    else for (int p = 0; p < 14; ++p) { a.ph_lo = p; a.ph_hi = p + 1; hipLaunchKernelGGL(fwd, dim3(grid), dim3(NTHR), LDS_BYTES, stream, a); }
}
```

```cpp
#include <hip/hip_runtime.h>
#include <cstdio>
#include <cstdint>

#ifndef MK_N_LAUNCHES
#define MK_N_LAUNCHES 1
#endif

#define REP_P0 1
#define REP_G16 1
#define REP_G57 0
#define REP_ATT 1
#define STAGGER 6
#define REP_J4B 1
#define REP_J3 1
#define REP_J1 1
#define REP_J2 1
#define REP_P3 1
#define REP_ONLY 0
#define LAS __attribute__((address_space(3)))
#define DI __device__ __forceinline__
typedef unsigned short bf16_t;
typedef short bf16x8 __attribute__((ext_vector_type(8)));
typedef float f32x4 __attribute__((ext_vector_type(4)));
typedef unsigned u32x4 __attribute__((ext_vector_type(4)));
typedef unsigned u32x2 __attribute__((ext_vector_type(2)));

constexpr int NB = 4, SEQ = 8192, M = NB * SEQ, DM = 1024, NIN = 2304, NINS = 2300, FF = 2816, NGU = 2 * FF;
constexpr float EPS = 1e-6f;
constexpr int C_AX = 0, C_AG = 256, C_BQ = 512, C_KC = 768, C_VC = 832, C_KS = 896, C_VS = 960, C_KW = 1024, C_VW = 1088, C_BG = 1152,
              C_CQ = 1164, C_CK = 1292, C_CV = 1420, C_GLR = 1676, C_OG = 1692, C_DCQ = 1948, C_DCKV = 2140, C_DKR = 2268;
constexpr size_t MiB = 1u << 20;
constexpr size_t WS_CTL = 0, CTL_ZERO_BYTES = 1 * MiB;
constexpr size_t WS_ACC = 64 * 1024;
constexpr size_t WS_SSQ0 = 1 * MiB;
constexpr size_t WS_HB = 1 * MiB + 256 * 1024;
constexpr size_t WS_WIN = 2 * MiB, WS_WOUT = 11 * MiB, WS_WGU = 15 * MiB, WS_WDN = 37 * MiB;
constexpr size_t WS_WUQT = 48 * MiB, WS_WUKVT = 48 * MiB + 512 * 1024, WS_W2T = 49 * MiB, WS_W1T = 50 * MiB;
constexpr size_t WS_WGT = 49 * MiB + 512 * 1024, WS_SP = 49 * MiB + 768 * 1024;
constexpr size_t WS_BCS = 352 * MiB;
constexpr size_t WS_CS64 = 64 * MiB, WS_CS32 = 72 * MiB;
constexpr size_t WS_XB = 80 * MiB, WS_Y = 144 * MiB, WS_PB = 208 * MiB, WS_ACT = 208 * MiB;
constexpr size_t WS_LA = 384 * MiB, WS_LH = 386 * MiB, WS_CIN = 388 * MiB;
constexpr size_t WS_KVC = 392 * MiB, WS_DEC = 408 * MiB, WS_SST = 410 * MiB;
constexpr size_t WS_MQ = 428 * MiB, WS_MKN = 452 * MiB, WS_MV = 468 * MiB, WS_MKR = 484 * MiB;
constexpr size_t WS_SSP = 500 * MiB;
constexpr size_t WS_KSF = 504 * MiB;
constexpr size_t WS_VST = 490 * MiB, WS_VWT = 494 * MiB, WS_KCMPB = 498 * MiB, WS_VCMPT = 499 * MiB, WS_END = 508 * MiB;
constexpr int CW_QUEUE = 64;
constexpr int CW_FLAG = 1024;
constexpr int CW_BAR = 4096;
constexpr int LDS_BYTES = 163840 - 256;
constexpr int LDS_CTL = LDS_BYTES - 64;
constexpr int NTHR = 512;

struct Args { const float* in[28]; float* out; unsigned char* ws; int ph_lo, ph_hi; };

DI float bf2f(bf16_t h) { return __uint_as_float(((unsigned)h) << 16); }
DI float bflo(unsigned u) { return __uint_as_float(u << 16); }
DI float bfhi(unsigned u) { return __uint_as_float(u & 0xffff0000u); }
DI bf16_t f2bf(float f) { unsigned u = __float_as_uint(f); return (bf16_t)((u + 0x7fffu + ((u >> 16) & 1u)) >> 16); }
DI unsigned pk2(float lo, float hi) { return (unsigned)f2bf(lo) | ((unsigned)f2bf(hi) << 16); }
DI float sum4p(const float* p, size_t row) { return (p[row] + p[(size_t)M + row]) + (p[2 * (size_t)M + row] + p[3 * (size_t)M + row]); }
DI int lane_id() { int l; asm volatile("v_mbcnt_lo_u32_b32 %0, -1, 0\n\tv_mbcnt_hi_u32_b32 %0, -1, %0" : "=v"(l)); return l; }
DI int tid_of(int wave) { return (wave << 6) + lane_id(); }
DI int shx(int v, int m) { return __builtin_amdgcn_ds_bpermute((lane_id() ^ m) << 2, v); }
DI unsigned shx(unsigned v, int m) { return (unsigned)__builtin_amdgcn_ds_bpermute((lane_id() ^ m) << 2, (int)v); }
DI float shx(float v, int m) { return __int_as_float(__builtin_amdgcn_ds_bpermute((lane_id() ^ m) << 2, __float_as_int(v))); }
DI float shf(float v, int src) { return __int_as_float(__builtin_amdgcn_ds_bpermute(src << 2, __float_as_int(v))); }
DI float wave_sum(float v) {
#pragma unroll
    for (int o = 1; o < 64; o <<= 1) v += shx(v, o);
    return v;
}
DI float wave_max(float v) {
#pragma unroll
    for (int o = 1; o < 64; o <<= 1) v = fmaxf(v, shx(v, o));
    return v;
}
DI int wave_min_i(int v) {
#pragma unroll
    for (int o = 1; o < 64; o <<= 1) { int w = shx(v, o); v = w < v ? w : v; }
    return v;
}
DI float sigmoidf_(float x) { return __builtin_amdgcn_rcpf(1.f + __builtin_amdgcn_exp2f(-1.4426950408889634f * x)); }
DI float gelu_tanh(float x) { const float u = 0.7978845608028654f * (x + 0.044715f * x * x * x); return x * sigmoidf_(2.f * u); }
#define WSYNC() do { asm volatile("s_waitcnt lgkmcnt(0)" ::: "memory"); __builtin_amdgcn_wave_barrier(); } while (0)

namespace pg8 {
constexpr int BM = 256, BK = 64, HALF = 128, HTB = HALF * BK * 2, NXCD = 8, WGM = 8;
__host__ __device__ __forceinline__ int lds_byte(int r, int c) { const int st = (r >> 4) * 2 + (c >> 5), rr = r & 15, cc = c & 31, ob = rr * 64 + cc * 2; return st * 1024 + (ob ^ (((ob >> 9) & 1) << 5)); }
__host__ __device__ __forceinline__ void stage_rc(int b, int& R, int& C) { const int st = b / 1024, sb = b % 1024, swz = sb ^ (((sb >> 9) & 1) << 5); R = (st >> 1) * 16 + swz / 64; C = (st & 1) * 32 + (swz % 64) / 2; }
__host__ __device__ __forceinline__ int perm32(int rho) { const int n = rho >> 4, i = rho & 15; return 8 * (i >> 2) + 4 * n + (i & 3); }
struct Unit { int pm, pn; };
struct Gemm { const bf16_t* A; const bf16_t* Bt; int M, N, K; };
struct StaticOrder {
    int nM, nN, nwg, G, c;
    __host__ __device__ void init(int M_, int N_, int G_, int c_) { nM = M_ / BM; nN = N_ / BM; nwg = nM * nN; G = G_; c = c_; }
    __host__ __device__ bool next(int i, Unit& u) const {
        const long L = (long)i * G + c; if (L >= nwg) return false;
        int wgid = (int)L; { const int q = nwg / NXCD, r = nwg % NXCD, xcd = wgid % NXCD, off = wgid / NXCD; wgid = (xcd < r ? xcd * (q + 1) : r * (q + 1) + (xcd - r) * q) + off; }
        const int nig = WGM * nN, gid = wgid / nig, fm = gid * WGM, gsz = (nM - fm) < WGM ? (nM - fm) : WGM;
        u.pm = fm + ((wgid % nig) % gsz); u.pn = (wgid % nig) / gsz; return true;
    }
    __device__ __forceinline__ void a_ready(const Unit&) const {}
    __device__ __forceinline__ void done(const Unit&) const {}
};
DI unsigned cvt_pk_bf16(float lo, float hi) { unsigned r; asm volatile("v_cvt_pk_bf16_f32 %0, %1, %2" : "=v"(r) : "v"(lo), "v"(hi)); return r; }
DI void row_stats8(float (&out)[2][4], const float* p, int row0, int fq) {
    const unsigned voff = (unsigned)(fq * M + row0) * 4u;
    float v0, v1, v2, v3, v4, v5, v6, v7;
    asm volatile("global_load_dword %0, %8, %9\n\tglobal_load_dword %1, %8, %9 offset:64\n\tglobal_load_dword %2, %8, %9 offset:128\n\tglobal_load_dword %3, %8, %9 offset:192\n\t"
                 "global_load_dword %4, %8, %9 offset:512\n\tglobal_load_dword %5, %8, %9 offset:576\n\tglobal_load_dword %6, %8, %9 offset:640\n\tglobal_load_dword %7, %8, %9 offset:704\n\ts_waitcnt vmcnt(0)"
                 : "=&v"(v0), "=&v"(v1), "=&v"(v2), "=&v"(v3), "=&v"(v4), "=&v"(v5), "=&v"(v6), "=&v"(v7) : "v"(voff), "s"(p) : "memory");
    const int l4 = lane_id() << 2;
    const float v[8] = {v0, v1, v2, v3, v4, v5, v6, v7};
#pragma unroll
    for (int i = 0; i < 8; ++i) {
        float t = v[i];
        t += __int_as_float(__builtin_amdgcn_ds_bpermute(l4 ^ 64, __float_as_int(t)));
        t += __int_as_float(__builtin_amdgcn_ds_bpermute(l4 ^ 128, __float_as_int(t)));
        out[i >> 2][i & 3] = t;
    }
}
DI void row_stats_lds(float (&out)[2][4], const LAS float* sb, int rl0) {
#pragma unroll
    for (int ai = 0; ai < 2; ++ai)
#pragma unroll
        for (int m = 0; m < 4; ++m) { const LAS float* q = sb + rl0 + ai * HALF + m * 16; out[ai][m] = (q[0] + q[256]) + (q[512] + q[768]); }
}

struct EpiInProj {
    static constexpr bool PERM = true, AFTER_DRAIN = false, MIDSCALE = false; static constexpr int NST = 16;
    bf16_t* O; int ldc; const float* ssq;
    static constexpr bool STAT = true; DI const float* stat() const { return ssq; }
    DI void operator()(const f32x4 (&acc)[2][2][4][2], const Unit& u, int wr, int wc, int fr, int fq, const LAS float* sb) const {
        int row0 = u.pm * BM + wr * 64 + fr; asm volatile("" : "+v"(row0)); const int col0 = u.pn * BM + wc * 32 + 8 * fq;
        float rinvs[2][4]; row_stats_lds(rinvs, sb, wr * 64 + fr);
#pragma unroll
        for (int ai = 0; ai < 2; ++ai)
#pragma unroll
            for (int m = 0; m < 4; ++m) {
                const int row = row0 + ai * HALF + m * 16;
                const float rinv = rsqrtf(rinvs[ai][m] * (1.f / DM) + EPS);
                bf16_t* rowp = O + (size_t)row * ldc + col0;
#pragma unroll
                for (int bj = 0; bj < 2; ++bj) {
                    f32x4 v0 = acc[ai][bj][m][0] * rinv, v1 = acc[ai][bj][m][1] * rinv;
                    u32x4 w; w.x = cvt_pk_bf16(v0[0], v0[1]); w.y = cvt_pk_bf16(v0[2], v0[3]); w.z = cvt_pk_bf16(v1[0], v1[1]); w.w = cvt_pk_bf16(v1[2], v1[3]);
                    *(u32x4*)(rowp + bj * HALF) = w;
                }
            }
    }
};
template <bool MS> struct EpiResid {
    static constexpr bool PERM = true, AFTER_DRAIN = false, MIDSCALE = MS; static constexpr int NST = 16;
    bf16_t* xb; float* ssq_part; const float* ssq_mid; LAS float* ssl;
    static constexpr bool STAT = MS; DI const float* stat() const { return ssq_mid; }
    DI void midscale(f32x4 (&acc)[2][2][4][2], const Unit& u, int wr, int fr, const LAS float* sb) const {
        float sm_[2][4]; row_stats_lds(sm_, sb, wr * 64 + (fr & 15));
#pragma unroll
        for (int ai = 0; ai < 2; ++ai)
#pragma unroll
            for (int m = 0; m < 4; ++m) { const float s = rsqrtf(sm_[ai][m] * (1.f / 256.f) + EPS);
#pragma unroll
                for (int bj = 0; bj < 2; ++bj) { acc[ai][bj][m][0] *= s; acc[ai][bj][m][1] *= s; } }
    }
    DI void operator()(const f32x4 (&acc)[2][2][4][2], const Unit& u, int wr, int wc, int fr, int fq, const LAS float*) const {
        int rl0 = wr * 64 + fr; asm volatile("" : "+v"(rl0));
        const int col0 = u.pn * BM + wc * 32 + 8 * fq;
        u32x4 xin[2][4][2];
#pragma unroll
        for (int ai = 0; ai < 2; ++ai)
#pragma unroll
            for (int m = 0; m < 4; ++m)
#pragma unroll
                for (int bj = 0; bj < 2; ++bj) xin[ai][m][bj] = *(const u32x4*)(xb + ((size_t)u.pm * BM + rl0 + ai * HALF + m * 16) * DM + col0 + bj * HALF);
        __builtin_amdgcn_sched_barrier(0);
#pragma unroll
        for (int ai = 0; ai < 2; ++ai)
#pragma unroll
            for (int m = 0; m < 4; ++m) {
                const int rl = rl0 + ai * HALF + m * 16; const size_t row = (size_t)u.pm * BM + rl;
                float part = 0.f;
#pragma unroll
                for (int bj = 0; bj < 2; ++bj) {
                    u32x4* px = (u32x4*)(xb + row * DM + col0 + bj * HALF); const u32x4 xo = xin[ai][m][bj];
                    const f32x4 a0 = acc[ai][bj][m][0], a1 = acc[ai][bj][m][1];
                    const float v0 = a0[0] + bflo(xo.x), v1 = a0[1] + bfhi(xo.x), v2 = a0[2] + bflo(xo.y), v3 = a0[3] + bfhi(xo.y), v4 = a1[0] + bflo(xo.z), v5 = a1[1] + bfhi(xo.z), v6 = a1[2] + bflo(xo.w), v7 = a1[3] + bfhi(xo.w);
                    u32x4 w; w.x = cvt_pk_bf16(v0, v1); w.y = cvt_pk_bf16(v2, v3); w.z = cvt_pk_bf16(v4, v5); w.w = cvt_pk_bf16(v6, v7);
                    *px = w;
                    part += (v0 * v0 + v1 * v1) + (v2 * v2 + v3 * v3) + (v4 * v4 + v5 * v5) + (v6 * v6 + v7 * v7);
                }
                part += shx(part, 16); part += shx(part, 32);
                if (fq == 0) ssl[rl * 4 + wc] = part;
            }
        asm volatile("s_waitcnt lgkmcnt(0)" ::: "memory"); __builtin_amdgcn_s_barrier();
        int tq = tid_of(wr * 4 + wc); asm volatile("" : "+v"(tq));
        if (tq < 256) { const f32x4 p = *(const LAS f32x4*)(ssl + tq * 4); ssq_part[(size_t)u.pn * M + (size_t)u.pm * BM + tq] = (p[0] + p[1]) + (p[2] + p[3]); }
    }
};
struct EpiSwiglu {
    static constexpr bool PERM = true, AFTER_DRAIN = false, MIDSCALE = false; static constexpr int NST = 8;
    bf16_t* act; const float* ssq;
    static constexpr bool STAT = true; DI const float* stat() const { return ssq; }
    DI void operator()(const f32x4 (&acc)[2][2][4][2], const Unit& u, int wr, int wc, int fr, int fq, const LAS float* sb) const {
        int row0 = u.pm * BM + wr * 64 + fr; asm volatile("" : "+v"(row0)); const int jst = u.pn * 128 + wc * 16 + 4 * (fq & 2) + (fq & 1) * 64;
        float rinvs[2][4]; row_stats_lds(rinvs, sb, wr * 64 + fr);
#pragma unroll
        for (int ai = 0; ai < 2; ++ai)
#pragma unroll
            for (int m = 0; m < 4; ++m) {
                const int row = row0 + ai * HALF + m * 16;
                const float rinv = rsqrtf(rinvs[ai][m] * (1.f / DM) + EPS);
                u32x2 w[2];
#pragma unroll
                for (int bj = 0; bj < 2; ++bj) {
                    const f32x4 g = acc[ai][bj][m][0] * rinv, up = acc[ai][bj][m][1] * rinv;
                    float a[4];
#pragma unroll
                    for (int i = 0; i < 4; ++i) a[i] = g[i] * up[i] * __builtin_amdgcn_rcpf(1.f + __builtin_amdgcn_exp2f(-1.4426950408889634f * g[i]));
                    w[bj].x = cvt_pk_bf16(a[0], a[1]); w[bj].y = cvt_pk_bf16(a[2], a[3]);
                }
                const auto rx = __builtin_amdgcn_permlane16_swap(w[0].x, w[1].x, false, false), ry = __builtin_amdgcn_permlane16_swap(w[0].y, w[1].y, false, false);
                u32x4 o; o.x = rx[0]; o.y = ry[0]; o.z = rx[1]; o.w = ry[1];
                *(u32x4*)(act + (size_t)row * FF + jst) = o;
            }
    }
};

DI void glds_sv(unsigned voff, const void* sbase, unsigned lds_dst) {
    unsigned keep;
    asm volatile("s_mov_b32 %0, m0\n\ts_mov_b32 m0, %3\n\ts_nop 0\n\tglobal_load_lds_dwordx4 %1, %2\n\ts_mov_b32 m0, %0" : "=&s"(keep) : "v"(voff), "s"(sbase), "s"(lds_dst) : "memory");
}
DI void glds_sv4(unsigned voff, const void* sbase, unsigned lds_dst) {
    unsigned keep;
    asm volatile("s_mov_b32 %0, m0\n\ts_mov_b32 m0, %3\n\ts_nop 0\n\tglobal_load_lds_dword %1, %2\n\ts_mov_b32 m0, %0" : "=&s"(keep) : "v"(voff), "s"(sbase), "s"(lds_dst) : "memory");
}
template <class Epi, class Sched, bool ALIGN_EPI = false, bool SP2 = false>
DI void gemm_phase(LAS unsigned char* lds, const Gemm g, const Sched& S, const Epi& E, const int wave_) {
    int wv_ = wave_; asm volatile("" : "+s"(wv_));
    int tid_ = tid_of(wv_); asm volatile("" : "+v"(tid_));
    const int tid = tid_, wid = wv_, lane = tid & 63, wr = wid >> 2, wc = wid & 3, fr = lane & 15, fq = lane >> 4;
    const int K = g.K, nt = K / BK;
    unsigned voffA[2], voffB[2];
#pragma unroll
    for (int i = 0; i < 2; ++i) { int R, C; stage_rc(tid * 16 + i * 8192, R, C); const int Rb = Epi::PERM ? ((R & ~31) + perm32(R & 31)) : R;
        voffA[i] = (unsigned)(R * K + C) * 2u; voffB[i] = (unsigned)(Rb * K + C) * 2u; }
    const size_t kstep = (size_t)(BK * 2);
    const size_t hstep = (size_t)HALF * K * 2;
    const size_t tstep = 2 * hstep;
    const unsigned ldsw = (unsigned)wid * 1024u;
    const unsigned statb = (unsigned)(size_t)lds + 131072u + 4096u; const LAS float* sbuf = (const LAS float*)(lds + 131072 + 4096);
    const unsigned ldsb = (unsigned)(size_t)lds + ldsw;
    const int aoff = lds_byte(wr * 64 + fr, fq * 8), boff = lds_byte(wc * 32 + fr, fq * 8);
#define PG8_SA(b, h) (((b) * 2 + (h)) * HTB)
#define PG8_SB(b, h) ((4 + (b) * 2 + (h)) * HTB)
#define PG8_STAGE(bufoff, gbase, voff) do { _Pragma("unroll") for (int _i = 0; _i < 2; ++_i) \
        glds_sv((voff)[_i], (const void*)(gbase), ldsb + (unsigned)((bufoff) + _i * 8192)); } while (0)
#define PG8_LDA(dst, b, h) do { _Pragma("unroll") for (int m = 0; m < 4; ++m) _Pragma("unroll") for (int k = 0; k < 2; ++k) dst[m][k] = *(const LAS bf16x8*)(lds + PG8_SA(b, h) + aoff + m * 2048 + k * 1024); } while (0)
#define PG8_LDB(dst, b, h) do { _Pragma("unroll") for (int n = 0; n < 2; ++n) _Pragma("unroll") for (int k = 0; k < 2; ++k) dst[n][k] = *(const LAS bf16x8*)(lds + PG8_SB(b, h) + boff + n * 2048 + k * 1024); } while (0)
#define PG8_MMA(ai, bj, At, Bt) do { __builtin_amdgcn_s_setprio(1); _Pragma("unroll") for (int m = 0; m < 4; ++m) _Pragma("unroll") for (int n = 0; n < 2; ++n) _Pragma("unroll") for (int k = 0; k < 2; ++k) \
        acc[ai][bj][m][n] = __builtin_amdgcn_mfma_f32_16x16x32_bf16(Bt[n][k], At[m][k], acc[ai][bj][m][n], 0, 0, 0); __builtin_amdgcn_s_setprio(0); } while (0)
#define PG8_WAIT_V(n) asm volatile("s_waitcnt vmcnt(" #n ")" ::: "memory")
#define PG8_WAIT_L(n) asm volatile("s_waitcnt lgkmcnt(" #n ")" ::: "memory")
#define PG8_WAIT_VF do { if constexpr (Epi::NST == 16) PG8_WAIT_V(24); else PG8_WAIT_V(16); } while (0)
#define PG8_BAR __builtin_amdgcn_s_barrier()
#define PG8_SCHED __builtin_amdgcn_sched_barrier(0)
    Unit cur, nxt; int ui = 0;
    if (!S.next(0, cur)) return;
    f32x4 acc[2][2][4][2];
#pragma unroll
    for (int a = 0; a < 2; ++a)
#pragma unroll
        for (int b = 0; b < 2; ++b)
#pragma unroll
            for (int m = 0; m < 4; ++m)
#pragma unroll
                for (int n = 0; n < 2; ++n) acc[a][b][m][n] = (f32x4){0.f, 0.f, 0.f, 0.f};
    bf16x8 At[4][2], B0[2][2], B1[2][2];
    const char* cA = (const char*)g.A + (size_t)cur.pm * tstep; const char* cB = (const char*)g.Bt + (size_t)cur.pn * tstep;
    S.a_ready(cur);
    if constexpr (SP2) {
        PG8_STAGE(PG8_SB(0, 0), cB, voffB); PG8_STAGE(PG8_SB(0, 1), cB + hstep, voffB); PG8_STAGE(PG8_SA(0, 0), cA, voffA); PG8_STAGE(PG8_SA(0, 1), cA + hstep, voffA);
        if (wr == 1) PG8_BAR;
        PG8_WAIT_V(2); PG8_BAR;
        PG8_STAGE(PG8_SB(1, 0), cB + kstep, voffB); PG8_STAGE(PG8_SA(1, 0), cA + kstep, voffA); PG8_STAGE(PG8_SB(1, 1), cB + hstep + kstep, voffB);
        PG8_WAIT_V(6); PG8_BAR;
        PG8_STAGE(PG8_SA(1, 1), cA + hstep + kstep, voffA);
#pragma unroll
        for (int i = 0; i < Epi::NST / 2; ++i) PG8_STAGE(PG8_SA(1, 1), cA + hstep + kstep, voffA);
    } else {
        PG8_STAGE(PG8_SB(0, 0), cB, voffB); PG8_STAGE(PG8_SA(0, 0), cA, voffA); PG8_STAGE(PG8_SB(0, 1), cB + hstep, voffB); PG8_STAGE(PG8_SA(0, 1), cA + hstep, voffA);
        if (wr == 1) PG8_BAR;
        PG8_WAIT_V(4); PG8_BAR;
        PG8_STAGE(PG8_SB(1, 0), cB + kstep, voffB); PG8_STAGE(PG8_SA(1, 0), cA + kstep, voffA); PG8_STAGE(PG8_SB(1, 1), cB + hstep + kstep, voffB);
        PG8_WAIT_V(6); PG8_BAR;
    }
    for (;;) {
        const bool has_next = S.next(ui + 1, nxt);
        const char* nA = has_next ? (const char*)g.A + (size_t)nxt.pm * tstep : cA; const char* nB = has_next ? (const char*)g.Bt + (size_t)nxt.pn * tstep : cB;
        static_assert(SP2, "only the SP2 schedule is kept");
#define PG8_STATDMA do { if constexpr (Epi::STAT) { const float* sp_ = E.stat() + (size_t)cur.pm * BM; int l4_ = lane_id() << 2; \
            _Pragma("unroll") for (int i_ = 0; i_ < 2; ++i_) { const int ix_ = wid * 2 + i_; glds_sv4((unsigned)l4_, sp_ + (size_t)(ix_ >> 2) * M + (ix_ & 3) * 64, statb + (unsigned)(ix_ * 256)); } } } while (0)
#define PG8_TRIP(t, WV, PRE2) do { \
            const bool last = ((t) == nt - 2); \
            const char* a2 = last ? nA : cA + (size_t)((t) + 2) * kstep; const char* b2 = last ? nB : cB + (size_t)((t) + 2) * kstep; \
            const char* a3 = a2 + kstep; const char* b3 = b2 + kstep; \
            if (last && has_next) S.a_ready(nxt); \
            PG8_LDB(B0, 0, 0); PG8_LDB(B1, 0, 1); PG8_SCHED; PG8_LDA(At, 0, 0); \
            WV; PG8_WAIT_L(0); PG8_BAR; PG8_MMA(0, 0, At, B0); PG8_MMA(0, 1, At, B1); PG8_BAR; PG8_SCHED; \
            PG8_LDA(At, 0, 1); PRE2; PG8_STAGE(PG8_SB(0, 0), b2, voffB); PG8_STAGE(PG8_SB(0, 1), b2 + hstep, voffB); PG8_STAGE(PG8_SA(0, 0), a2, voffA); \
            WV; PG8_WAIT_L(0); PG8_BAR; PG8_MMA(1, 0, At, B0); PG8_MMA(1, 1, At, B1); PG8_BAR; PG8_SCHED; \
            PG8_LDB(B0, 1, 0); PG8_LDB(B1, 1, 1); PG8_SCHED; PG8_LDA(At, 1, 0); PG8_STAGE(PG8_SA(0, 1), a2 + hstep, voffA); \
            WV; PG8_WAIT_L(0); PG8_BAR; PG8_MMA(0, 0, At, B0); PG8_MMA(0, 1, At, B1); PG8_BAR; PG8_SCHED; \
            PG8_LDA(At, 1, 1); PG8_STAGE(PG8_SB(1, 0), b3, voffB); PG8_STAGE(PG8_SB(1, 1), b3 + hstep, voffB); PG8_STAGE(PG8_SA(1, 0), a3, voffA); \
            PG8_WAIT_V(8); PG8_WAIT_L(0); PG8_BAR; PG8_MMA(1, 0, At, B0); PG8_MMA(1, 1, At, B1); PG8_BAR; PG8_SCHED; \
            PG8_STAGE(PG8_SA(1, 1), a3 + hstep, voffA); } while (0)
        PG8_TRIP(0, PG8_WAIT_VF, PG8_STATDMA);
        for (int t = 2; t < nt; t += 2) {
            PG8_TRIP(t, PG8_WAIT_V(8), (void)0);
            if constexpr (Epi::MIDSCALE) { if (t == 2) { int te = lane_id(); asm volatile("" : "+v"(te)); E.midscale(acc, cur, wr, te, sbuf); } }
        }
#undef PG8_TRIP
#undef PG8_STATDMA
        if constexpr (ALIGN_EPI) { if (wr == 0) PG8_BAR; }
        if constexpr (!Epi::AFTER_DRAIN) { int te = lane_id(); asm volatile("" : "+v"(te)); E(acc, cur, wr, wc, te & 15, te >> 4, sbuf); S.done(cur); }
        if (!has_next) break;
#pragma unroll
        for (int a = 0; a < 2; ++a)
#pragma unroll
            for (int b = 0; b < 2; ++b)
#pragma unroll
                for (int m = 0; m < 4; ++m)
#pragma unroll
                    for (int n = 0; n < 2; ++n) acc[a][b][m][n] = (f32x4){0.f, 0.f, 0.f, 0.f};
        cur = nxt; cA = nA; cB = nB; ++ui;
        if constexpr (ALIGN_EPI) { if (wr == 1) PG8_BAR; }
    }
    PG8_WAIT_V(0);
    if constexpr (!ALIGN_EPI) { if (wr == 0) PG8_BAR; }
    PG8_BAR;
#undef PG8_SA
#undef PG8_SB
#undef PG8_STAGE
#undef PG8_LDA
#undef PG8_LDB
#undef PG8_MMA
#undef PG8_WAIT_V
#undef PG8_WAIT_L
#undef PG8_WAIT_VF
#undef PG8_BAR
#undef PG8_SCHED
}
}

#define XB_TMO      128
#define XB_XCNT(j)  (256  + 64 * (j))
#define XB_XSUB(j)  (1280 + 64 * (j))
#define XB_XGEN(j)  (2304 + 64 * (j))
#define XB_TOP      3328
#define XB_TOPGEN   3392
#define XCD_BAR_WORDS 3456
#define XB_SPIN_CAP (1u << 18)
__device__ __forceinline__ unsigned xb_ld(unsigned* p)              { return __hip_atomic_load(p, __ATOMIC_RELAXED, __HIP_MEMORY_SCOPE_AGENT); }
__device__ __forceinline__ unsigned xb_add(unsigned* p, unsigned v) { return __hip_atomic_fetch_add(p, v, __ATOMIC_RELAXED, __HIP_MEMORY_SCOPE_AGENT); }
__device__ __forceinline__ unsigned xb_xcc_id() { return (unsigned)__builtin_amdgcn_s_getreg((3 << 11) | 20) & 0xFu; }
#define XB_SPIN(cond, bar) do { unsigned _sp = 0; while (cond) { __builtin_amdgcn_s_sleep(1); \
    if ((++_sp & 255u) == 0u) { if (xb_ld(&(bar)[XB_TMO])) break; if (_sp > XB_SPIN_CAP) { atomicAdd(&(bar)[XB_TMO], 1u); break; } } } } while (0)
struct XcdBarrier { unsigned* bar; unsigned x; volatile LAS unsigned* st; };
__device__ __forceinline__ XcdBarrier xcd_barrier_post(unsigned* bar, volatile LAS unsigned* st, const int tidx) {
    XcdBarrier b; b.bar = bar; b.x = xb_xcc_id(); b.st = st;
    if (tidx == 0) (void)xb_add(&bar[XB_XCNT(b.x)], 1u);
    return b;
}
__device__ __forceinline__ void xcd_barrier_complete(unsigned* bar, unsigned x, unsigned& nloc, unsigned& nx) {
    const unsigned G = gridDim.x * gridDim.y * gridDim.z;
    unsigned sum, cnt, mine, sp = 0u;
    for (;;) {
        sum = 0u; cnt = 0u; mine = 0u;
#pragma unroll
        for (unsigned j = 0; j < 16; ++j) { const unsigned c = xb_ld(&bar[XB_XCNT(j)]); sum += c; cnt += (c > 0u) ? 1u : 0u; mine = (j == x) ? c : mine; }
        if (sum == G) break;
        __builtin_amdgcn_s_sleep(1);
        if ((++sp & 255u) == 0u) { if (xb_ld(&bar[XB_TMO])) break; if (sp > XB_SPIN_CAP) { atomicAdd(&bar[XB_TMO], 1u); break; } }
    }
    nloc = mine > 0u ? mine : 1u; nx = cnt > 0u ? cnt : 1u;
}
__device__ __forceinline__ void xcd_barrier(const XcdBarrier& b, const int tidx) {
    asm volatile("s_waitcnt vmcnt(0)" ::: "memory");
    __syncthreads();
    if (tidx == 0) {
        unsigned* bar = b.bar;
        __builtin_amdgcn_s_waitcnt(0);
        unsigned nloc = b.st[0], nx = b.st[1];
        if (nloc == 0u) { xcd_barrier_complete(bar, b.x, nloc, nx); b.st[0] = nloc; b.st[1] = nx; }
        const unsigned old = xb_add(&bar[XB_XSUB(b.x)], 1u);
        const unsigned gen = old / nloc;
        if (old + 1u == (gen + 1u) * nloc) {
            __builtin_amdgcn_fence(__ATOMIC_RELEASE, "agent");
            asm volatile("s_waitcnt vmcnt(0)" ::: "memory");
            const unsigned og = xb_add(&bar[XB_TOP], 1u);
            const unsigned tg = og / nx;
            if (og + 1u == (tg + 1u) * nx) xb_add(&bar[XB_TOPGEN], 1u);
            else XB_SPIN(xb_ld(&bar[XB_TOPGEN]) == tg, bar);
            __builtin_amdgcn_fence(__ATOMIC_ACQUIRE, "agent");
            xb_add(&bar[XB_XGEN(b.x)], 1u);
            asm volatile("s_waitcnt vmcnt(0)" ::: "memory");
        } else {
            XB_SPIN(xb_ld(&bar[XB_XGEN(b.x)]) == gen, bar);
            __builtin_amdgcn_fence(__ATOMIC_ACQUIRE, "agent");
            asm volatile("s_waitcnt vmcnt(0)" ::: "memory");
        }
    }
    __syncthreads();
}

template <int MAP>
DI int colmap(int v, int Nsrc) {
    if (MAP == 0) return v < Nsrc ? v : -1;
    const int g8 = v >> 3, e = v & 7, j = 4 * g8 + (e & 3); return (e < 4) ? j : FF + j;
}
template <int MAP, int KROT = 0>
DI void p0_transpose_item64(const float* W, int K, int Nsrc, const float* gain, bf16_t* WT, LAS float* scr, int kb, int nb, int lane) {
    const int k0 = 64 * kb, n0 = 64 * nb, v = n0 + 4 * (lane & 15);
    const int sc = MAP == 0 ? (v < Nsrc ? v : -1) : ((v >> 3) * 4 + ((v >> 2) & 1) * FF);
    const int scc = sc >= 0 ? sc : 0; const float* gp = gain ? gain : W; f32x4 wv[16]; float gv[16];
#pragma unroll
    for (int i = 0; i < 16; ++i) { const int kk = 4 * i + (lane >> 4); int ksrc = k0 + kk + KROT; if (KROT && ksrc >= K) ksrc -= K; wv[i] = *(const f32x4*)(W + (size_t)ksrc * Nsrc + scc); gv[i] = gp[ksrc]; }
    __builtin_amdgcn_sched_barrier(0);
#pragma unroll
    for (int i = 0; i < 16; ++i) { const int kk = 4 * i + (lane >> 4); const float gm = sc >= 0 ? (gain ? gv[i] : 1.f) : 0.f; const f32x4 w = wv[i] * gm;
        LAS float* d = scr + kk * 65 + 4 * (lane & 15); d[0] = w[0]; d[1] = w[1]; d[2] = w[2]; d[3] = w[3]; }
    WSYNC();
    const int c = lane & 7;
#pragma unroll
    for (int j = 0; j < 8; ++j) { const int n = (lane >> 3) + 8 * j; const LAS float* s = scr + (8 * c) * 65 + n;
        u32x4 o; o.x = pk2(s[0 * 65], s[1 * 65]); o.y = pk2(s[2 * 65], s[3 * 65]); o.z = pk2(s[4 * 65], s[5 * 65]); o.w = pk2(s[6 * 65], s[7 * 65]);
        *(u32x4*)(WT + (size_t)(n0 + n) * K + k0 + 8 * c) = o; }
    WSYNC();
}
template <int MAP, int KROT = 0>
DI void p0_transpose_item(const float* W, int K, int Nsrc, const float* gain, bf16_t* WT, LAS float* scr, int kb, int nb, int lane) {
    const int k0 = 64 * kb, n0 = 32 * nb;
    const int sc = colmap<MAP>(n0 + (lane & 31), Nsrc);
    const int scc = sc >= 0 ? sc : 0; const float* gp = gain ? gain : W; float wv[32], gv[32];
#pragma unroll
    for (int i = 0; i < 32; ++i) { const int kk = 2 * i + (lane >> 5); int ksrc = k0 + kk + KROT; if (KROT && ksrc >= K) ksrc -= K; wv[i] = W[(size_t)ksrc * Nsrc + scc]; gv[i] = gp[ksrc]; }
    __builtin_amdgcn_sched_barrier(0);
#pragma unroll
    for (int i = 0; i < 32; ++i) { const int kk = 2 * i + (lane >> 5); const float gm = sc >= 0 ? (gain ? gv[i] : 1.f) : 0.f; scr[kk * 33 + (lane & 31)] = wv[i] * gm; }
    WSYNC();
    const int c = lane & 7;
#pragma unroll
    for (int j = 0; j < 4; ++j) { const int n = (lane >> 3) + 8 * j; const LAS float* s = scr + (8 * c) * 33 + n;
        u32x4 o; o.x = pk2(s[0 * 33], s[1 * 33]); o.y = pk2(s[2 * 33], s[3 * 33]); o.z = pk2(s[4 * 33], s[5 * 33]); o.w = pk2(s[6 * 33], s[7 * 33]);
        *(u32x4*)(WT + (size_t)(n0 + n) * K + k0 + 8 * c) = o; }
    WSYNC();
}


typedef float f32x16 __attribute__((ext_vector_type(16)));
typedef float f32x2v __attribute__((ext_vector_type(2)));
typedef __bf16 bf16x2_t __attribute__((ext_vector_type(2)));
constexpr int KSTR = 208, VSTR = 136;
constexpr int VSTP = 144;
constexpr int AL_K0 = 0, AL_K1 = 64 * KSTR, AL_V0 = 2 * 64 * KSTR, AL_V1 = AL_V0 + 64 * VSTP, AL_IMP = 45056, AL_SELM = AL_IMP + 32768, AL_OACC = AL_SELM + 1024;
constexpr float NEGB = -1e30f, LOG2E = 1.4426950408889634f;
DI unsigned cvtpk(float lo, float hi) { f32x2v v = {lo, hi}; bf16x2_t b = __builtin_convertvector(v, bf16x2_t); return __builtin_bit_cast(unsigned, b); }
DI f32x16 mfma32(bf16x8 a, bf16x8 b, f32x16 c) { return __builtin_amdgcn_mfma_f32_32x32x16_bf16(a, b, c, 0, 0, 0); }
DI float xhalf_max(float v) { auto rr = __builtin_amdgcn_permlane32_swap(__float_as_uint(v), __float_as_uint(v), false, false); return fmaxf(__uint_as_float(rr[0]), __uint_as_float(rr[1])); }
DI float xhalf_sum(float v) { auto rr = __builtin_amdgcn_permlane32_swap(__float_as_uint(v), __float_as_uint(v), false, false); return __uint_as_float(rr[0]) + __uint_as_float(rr[1]); }
DI float ex2(float x) { return __builtin_amdgcn_exp2f(x); }
template <int KSTEPS>
DI void qk_tile(const LAS unsigned char* Kt, const bf16x8 (&qf)[KSTEPS], int r32, int hi, f32x16& s0, f32x16& s1) {
    const LAS unsigned char* p0 = Kt + r32 * KSTR + hi * 16;
#pragma unroll
    for (int i = 0; i < 16; ++i) { s0[i] = 0.f; s1[i] = 0.f; }
#pragma unroll
    for (int ks = 0; ks < KSTEPS; ++ks) {
        const bf16x8 a0 = *(const LAS bf16x8*)(p0 + ks * 32), a1 = *(const LAS bf16x8*)(p0 + 32 * KSTR + ks * 32);
        s0 = mfma32(a0, qf[ks], s0); s1 = mfma32(a1, qf[ks], s1);
    }
}
DI void mask_tile(f32x16& s0, f32x16& s1, int klo, int khi, int hi) {
    const int lo_ = klo - 4 * hi, hi_ = khi - 4 * hi;
#pragma unroll
    for (int i = 0; i < 16; ++i) { const int kb = (i & 3) + 8 * (i >> 2); if (kb < lo_ || kb > hi_) s0[i] = NEGB; if (kb + 32 < lo_ || kb + 32 > hi_) s1[i] = NEGB; }
}
DI float tile_max(const f32x16& s0, const f32x16& s1) {
    float mx = fmaxf(s0[0], s1[0]);
#pragma unroll
    for (int i = 1; i < 16; ++i) mx = fmaxf(mx, fmaxf(s0[i], s1[i]));
    return xhalf_max(mx);
}
template <int BASE> DI bf16x8 pack8(const f32x16& s) { u32x4 p; p.x = cvtpk(s[BASE], s[BASE + 1]); p.y = cvtpk(s[BASE + 2], s[BASE + 3]); p.z = cvtpk(s[BASE + 4], s[BASE + 5]); p.w = cvtpk(s[BASE + 6], s[BASE + 7]); return __builtin_bit_cast(bf16x8, p); }
DI bf16x8 ld8x2(const bf16_t* p) { const u32x2 a = *(const u32x2*)p, b = *(const u32x2*)(p + 4); u32x4 w; w.x = a.x; w.y = a.y; w.z = b.x; w.w = b.y; return __builtin_bit_cast(bf16x8, w); }
DI bf16x8 vfrag(const LAS unsigned char* p) { const u32x2 a = *(const LAS u32x2*)p, b = *(const LAS u32x2*)(p + 16); u32x4 w; w.x = a.x; w.y = a.y; w.z = b.x; w.w = b.y; return __builtin_bit_cast(bf16x8, w); }
template <int VS = VSTP>
DI void pv_tile(const f32x16& s0, const f32x16& s1, const LAS unsigned char* Vt, f32x16 (&o)[2], int r32, int hi) {
    const bf16x8 p00 = pack8<0>(s0), p01 = pack8<8>(s0), p10 = pack8<0>(s1), p11 = pack8<8>(s1);
#pragma unroll
    for (int dt = 0; dt < 2; ++dt) { const LAS unsigned char* vp = Vt + (32 * dt + r32) * VS + 16 * hi;
        o[dt] = mfma32(*(const LAS bf16x8*)vp, p00, o[dt]); o[dt] = mfma32(*(const LAS bf16x8*)(vp + 32), p01, o[dt]); o[dt] = mfma32(*(const LAS bf16x8*)(vp + 64), p10, o[dt]); o[dt] = mfma32(*(const LAS bf16x8*)(vp + 96), p11, o[dt]); }
}
DI void softmax_pv(f32x16& s0, f32x16& s1, const LAS unsigned char* Vt, f32x16 (&o)[2], float& m, float& l, int r32, int hi) {
    const float mx = tile_max(s0, s1), mn = fmaxf(m, mx), ms = mn < -1e29f ? 0.f : mn, alpha = ex2(m - ms);
    m = mn; float psum = 0.f;
#pragma unroll
    for (int i = 0; i < 16; ++i) { s0[i] = ex2(s0[i] - ms); s1[i] = ex2(s1[i] - ms); psum += s0[i] + s1[i]; }
    l = l * alpha + psum;
    if (!__all(alpha == 1.f)) {
#pragma unroll
        for (int i = 0; i < 16; ++i) { o[0][i] *= alpha; o[1][i] *= alpha; } }
    pv_tile(s0, s1, Vt, o, r32, hi);
}
struct SoftState { float m, l; };
constexpr float SM_THR = 8.f;
DI void soft_init(SoftState& S, f32x16 (&o)[2]) { S.m = 0.f; S.l = 0.f;
#pragma unroll
    for (int i = 0; i < 16; ++i) { o[0][i] = 0.f; o[1][i] = 0.f; } }
DI f32x16 bcast16(float v) { f32x16 c;
#pragma unroll
    for (int i = 0; i < 16; ++i) c[i] = v;
    return c; }
DI float max3f(float a, float b, float c) { float r; asm("v_max3_f32 %0, %1, %2, %3" : "=v"(r) : "v"(a), "v"(b), "v"(c)); return r; }
template <int VS>
DI void load_vfrags(const LAS unsigned char* Vt, bf16x8 (&vfr)[2][4], int r32, int hi) {
#pragma unroll
    for (int dt = 0; dt < 2; ++dt) { const LAS unsigned char* vp = Vt + (32 * dt + r32) * VS + 16 * hi;
#pragma unroll
        for (int s = 0; s < 4; ++s) vfr[dt][s] = *(const LAS bf16x8*)(vp + 32 * s); }
}
DI void pv_regs(const f32x16& s0, const f32x16& s1, const bf16x8 (&vfr)[2][4], f32x16 (&o)[2]) {
    const bf16x8 p00 = pack8<0>(s0), p01 = pack8<8>(s0), p10 = pack8<0>(s1), p11 = pack8<8>(s1);
#pragma unroll
    for (int dt = 0; dt < 2; ++dt) { o[dt] = mfma32(vfr[dt][0], p00, o[dt]); o[dt] = mfma32(vfr[dt][1], p01, o[dt]); o[dt] = mfma32(vfr[dt][2], p10, o[dt]); o[dt] = mfma32(vfr[dt][3], p11, o[dt]); }
}
DI float soft_update(f32x16& s0, f32x16& s1, SoftState& S, f32x16 (&o)[2], bool masked, int klo, int khi, bool first, int hi, float adj = 0.f) {
    if (__any(adj != 0.f)) {
#pragma unroll
        for (int i = 0; i < 16; ++i) { s0[i] -= adj; s1[i] -= adj; } }
    float dl_ret = 0.f;
    if (__builtin_expect(masked, 0)) { asm volatile("; boundary tile mask" ::: "memory"); mask_tile(s0, s1, klo, khi, hi); }
    asm volatile("s_nop 15\n\ts_nop 7" : "+v"(s0), "+v"(s1));
    float rm;
    { float a = max3f(s0[0], s0[1], s0[2]), b = max3f(s1[0], s1[1], s1[2]);
#pragma unroll
      for (int i = 3; i < 15; i += 2) { a = max3f(a, s0[i], s0[i + 1]); b = max3f(b, s1[i], s1[i + 1]); }
      rm = xhalf_max(fmaxf(max3f(a, b, s0[15]), s1[15])); }
    if (first) {
        const float dl = rm < -1e29f ? 0.f : rm; S.m = dl; dl_ret = dl;
#pragma unroll
        for (int i = 0; i < 16; ++i) { s0[i] -= dl; s1[i] -= dl; }
    } else if (__any(rm > SM_THR)) {
        const float dl = fmaxf(rm, 0.f), alpha = ex2(-dl); S.m += dl; S.l *= alpha; dl_ret = dl;
#pragma unroll
        for (int i = 0; i < 16; ++i) { s0[i] -= dl; s1[i] -= dl; o[0][i] *= alpha; o[1][i] *= alpha; }
    }
    float p0 = 0.f, p1 = 0.f, p2 = 0.f, p3 = 0.f;
#pragma unroll
    for (int i = 0; i < 16; i += 2) { s0[i] = ex2(s0[i]); s0[i + 1] = ex2(s0[i + 1]); s1[i] = ex2(s1[i]); s1[i + 1] = ex2(s1[i + 1]); p0 += s0[i]; p1 += s0[i + 1]; p2 += s1[i]; p3 += s1[i + 1]; }
    S.l += (p0 + p1) + (p2 + p3);
    return dl_ret;
}
template <int KSTEPS, int VS = VSTP, bool VPREF = false>
DI void attn_step(const LAS unsigned char* Kt, const LAS unsigned char* Vt, const bf16x8 (&qf)[KSTEPS], SoftState& S, f32x16 (&o)[2], bool masked, int klo, int khi, bool first, int r32, int hi) {
    const f32x16 cinit = bcast16(-S.m); f32x16 s0 = cinit, s1 = cinit;
    { const LAS unsigned char* p0 = Kt + r32 * KSTR + hi * 16;
#pragma unroll
      for (int ks = 0; ks < KSTEPS; ++ks) { const bf16x8 a0 = *(const LAS bf16x8*)(p0 + ks * 32), a1 = *(const LAS bf16x8*)(p0 + 32 * KSTR + ks * 32);
          s0 = mfma32(a0, qf[ks], s0); s1 = mfma32(a1, qf[ks], s1); } }
    if constexpr (VPREF) { bf16x8 vfr[2][4]; load_vfrags<VS>(Vt, vfr, r32, hi); __builtin_amdgcn_sched_barrier(0);
        soft_update(s0, s1, S, o, masked, klo, khi, first, hi);
        __builtin_amdgcn_sched_barrier(0);
        pv_regs(s0, s1, vfr, o); }
    else { soft_update(s0, s1, S, o, masked, klo, khi, first, hi); pv_tile<VS>(s0, s1, Vt, o, r32, hi); }
}
template <int KSTEPS, int VS>
DI void attn_step2(const LAS unsigned char* Kt, const LAS unsigned char* Vt, const bf16x8 (&qf)[KSTEPS], SoftState& S, f32x16 (&o)[2], bool masked0, int khi0, bool masked1, int khi1, bool first, int r32, int hi) {
    const f32x16 cinit = bcast16(-S.m); f32x16 a0 = cinit, a1 = cinit, b0 = cinit, b1 = cinit;
    { const LAS unsigned char* p0 = Kt + r32 * KSTR + hi * 16;
#pragma unroll
      for (int ks = 0; ks < KSTEPS; ++ks) { const bf16x8 k0 = *(const LAS bf16x8*)(p0 + ks * 32), k1 = *(const LAS bf16x8*)(p0 + 32 * KSTR + ks * 32);
          a0 = mfma32(k0, qf[ks], a0); a1 = mfma32(k1, qf[ks], a1); }
#pragma unroll
      for (int ks = 0; ks < KSTEPS; ++ks) { const bf16x8 k0 = *(const LAS bf16x8*)(p0 + 64 * KSTR + ks * 32), k1 = *(const LAS bf16x8*)(p0 + 96 * KSTR + ks * 32);
          b0 = mfma32(k0, qf[ks], b0); b1 = mfma32(k1, qf[ks], b1); } }
    bf16x8 vfr[2][4]; load_vfrags<VS>(Vt, vfr, r32, hi); __builtin_amdgcn_sched_barrier(0);
    const float dl0 = soft_update(a0, a1, S, o, masked0, 0, khi0, first, hi);
    __builtin_amdgcn_sched_barrier(0);
    pv_regs(a0, a1, vfr, o);
    __builtin_amdgcn_sched_barrier(0);
    load_vfrags<VS>(Vt + 128, vfr, r32, hi); __builtin_amdgcn_sched_barrier(0);
    (void)soft_update(b0, b1, S, o, masked1, 0, khi1, false, hi, dl0);
    __builtin_amdgcn_sched_barrier(0);
    pv_regs(b0, b1, vfr, o);
}
struct StageRegs { u32x4 a, b, c, d, e; };
#define SLD16(base_ptr, off_elems) ({ const __attribute__((address_space(1))) char* b__ = (const __attribute__((address_space(1))) char*)(base_ptr); unsigned o__ = (unsigned)(off_elems) * 2u; \
    asm volatile("" : "+s"(b__), "+v"(o__)); *(const __attribute__((address_space(1))) u32x4*)(b__ + o__); })
template <class LoadF, class StoreF, class StepF>
DI void attn_pipeline(const int wave_, int jbeg, int jend, LoadF ld, StoreF st, StepF step) {
    if (jbeg > jend) return;
    StageRegs RA;
    ld(jbeg, RA); st(0, RA);
    __builtin_amdgcn_s_waitcnt(0x0F70);
    __syncthreads();
    for (int j = jbeg; j <= jend; j += 2) {
        if (j + 1 <= jend) ld(j + 1, RA);
        step(j, 0);
        if (j + 1 <= jend) st(1, RA);
        __syncthreads();
        if (STAGGER && wave_ >= 4) __builtin_amdgcn_s_sleep(STAGGER);
        if (j + 1 > jend) break;
        if (j + 2 <= jend) ld(j + 2, RA);
        step(j + 1, 1);
        if (j + 2 <= jend) st(0, RA);
        __syncthreads();
        if (STAGGER && wave_ >= 4) __builtin_amdgcn_s_sleep(STAGGER);
    }
}
#define AS_GLOBAL(T, p) ((T*)(__attribute__((address_space(1))) T*)(p))
DI const float* inp(const Args& a, int k) { asm volatile("" : "+s"(k)); return AS_GLOBAL(const float, a.in[k]); }
__global__ void __launch_bounds__(NTHR, 2) fwd(Args args) {
    extern __shared__ __attribute__((aligned(16))) unsigned char lds_raw[];
    LAS unsigned char* lds = (LAS unsigned char*)lds_raw;
    LAS float* ldsf = (LAS float*)lds;
    volatile LAS unsigned* LCTL = (volatile LAS unsigned*)(lds + LDS_CTL);
    const int wave = __builtin_amdgcn_readfirstlane((int)threadIdx.x >> 6);
    const int G = gridDim.x, bid = blockIdx.x;
#define LAUNDER_TID() int tid = tid_of(wave); asm volatile("" : "+v"(tid)); const int lane = tid & 63; (void)lane
#define WS_PTRS() __attribute__((address_space(1))) unsigned char* wsg_ = (__attribute__((address_space(1))) unsigned char*)args.ws; asm volatile("" : "+s"(wsg_)); unsigned char* ws = (unsigned char*)wsg_; float* const out_ = AS_GLOBAL(float, args.out); \
    unsigned* ctl = (unsigned*)(ws + WS_CTL); float* ssp_base = (float*)(ws + WS_SSP); float* hb = (float*)(ws + WS_HB); \
    bf16_t* XB = (bf16_t*)(ws + WS_XB); bf16_t* Y = (bf16_t*)(ws + WS_Y); bf16_t* PB = (bf16_t*)(ws + WS_PB); bf16_t* ACT = (bf16_t*)(ws + WS_ACT); \
    const float2* cs64 = (const float2*)(ws + WS_CS64); const float2* cs32 = (const float2*)(ws + WS_CS32); \
    float* LRA = out_; float* LRU_ = out_ + (size_t)M * 256; \
    float* LA = (float*)(ws + WS_LA); float* LH = (float*)(ws + WS_LH); float* CIN = (float*)(ws + WS_CIN); \
    float* KVC = (float*)(ws + WS_KVC); float* DEC = (float*)(ws + WS_DEC); float* SST = (float*)(ws + WS_SST); \
    bf16_t* MQ = (bf16_t*)(ws + WS_MQ); bf16_t* MKN = (bf16_t*)(ws + WS_MKN); bf16_t* MVT = (bf16_t*)(ws + WS_MV); bf16_t* MKR = (bf16_t*)(ws + WS_MKR); \
    bf16_t* VST = (bf16_t*)(ws + WS_VST); bf16_t* KSF = (bf16_t*)(ws + WS_KSF); (void)KSF; bf16_t* VWT = (bf16_t*)(ws + WS_VWT); bf16_t* KCMPB = (bf16_t*)(ws + WS_KCMPB); bf16_t* VCMPT = (bf16_t*)(ws + WS_VCMPT); \
    const float* ssq_mix = ssp_base + (size_t)(l_ == 0 ? 0 : 2) * 4 * M; float* ssq_out = ssp_base + (size_t)(1 + 3 * l_) * 4 * M; float* ssq_down = ssp_base + (size_t)(2 + 3 * l_) * 4 * M; float* ssq_d = ssp_base + (size_t)(3 + 3 * l_) * 4 * M; \
    (void)ctl; (void)hb; (void)XB; (void)Y; (void)PB; (void)ACT; (void)cs64; (void)cs32; (void)LRA; (void)LRU_; (void)LA; (void)LH; (void)CIN; (void)KVC; (void)DEC; (void)SST; (void)MQ; (void)MKN; (void)MVT; (void)MKR; (void)VST; (void)VWT; (void)KCMPB; (void)VCMPT; (void)ssq_mix; (void)ssq_out; (void)ssq_down; (void)ssq_d
    unsigned* ctl0 = (unsigned*)(AS_GLOBAL(unsigned char, args.ws) + WS_CTL);
    { LAUNDER_TID(); if (tid < 16) LCTL[tid] = 0u; }
    __syncthreads();
    const int lo = args.ph_lo, hi = args.ph_hi;
    XcdBarrier bar; bar.bar = ctl0 + CW_BAR; bar.x = 0; bar.st = LCTL;
    if (hi - lo > 1) bar = xcd_barrier_post(ctl0 + CW_BAR, LCTL, tid_of(wave));
#define IN(k) (lo <= (k) && (k) < hi)
#define SEAM(k) do { if (IN(k) && IN((k) + 1)) { XcdBarrier b_ = bar; asm volatile("" : "+s"(b_.bar), "+s"(b_.x)); xcd_barrier(b_, tid_of(wave)); } } while (0)

    if (IN(0)) {
        const int l_ = 0; WS_PTRS();
      _Pragma("unroll 1") for (int rep = 0; rep < REP_P0; ++rep) {
        LAUNDER_TID();
        const int gw = bid * 8 + wave, NGW = G * 8;
        LAS float* scr = ldsf + wave * 4224; LAS float* scr64 = scr;
        constexpr int I_IN = 16 * 36, I_OUT = 16 * 16, I_GU = 16 * 88, I_DN = 44 * 16, I_L = I_IN + I_OUT + I_GU + I_DN;
        for (int it = gw; it < 2 * I_L; it += NGW) {
            const int l = it / I_L; int r = it % I_L;
            if (r < I_IN) { p0_transpose_item64<0>(inp(args, 3) + (size_t)l * DM * NINS, DM, NINS, inp(args, 2) + l * DM, (bf16_t*)(ws + WS_WIN) + (size_t)l * NIN * DM, scr64, r / 36, r % 36, lane); continue; } r -= I_IN;
            if (r < I_OUT) { p0_transpose_item64<0, 768>(inp(args, 23) + (size_t)l * DM * DM, DM, DM, inp(args, 22) + l * DM, (bf16_t*)(ws + WS_WOUT) + (size_t)l * DM * DM, scr64, r / 16, r % 16, lane); continue; } r -= I_OUT;
            if (r < I_GU) { p0_transpose_item64<1>(inp(args, 25) + (size_t)l * DM * NGU, DM, NGU, inp(args, 24) + l * DM, (bf16_t*)(ws + WS_WGU) + (size_t)l * NGU * DM, scr64, r / 88, r % 88, lane); continue; } r -= I_GU;
            p0_transpose_item64<0>(inp(args, 26) + (size_t)l * FF * DM, FF, DM, nullptr, (bf16_t*)(ws + WS_WDN) + (size_t)l * DM * FF, scr64, r / 16, r % 16, lane);
        }
        { constexpr int I_UQ = 3 * 12, I_UKV = 2 * 16, I_W1 = 32 * 8, I_W2 = 4 * 2, I_S = 2 * I_UQ + 2 * I_UKV + 4 * I_W1 + 4 * I_W2;
          for (int it = gw; it < I_S; it += NGW) { int r = it;
              if (r < 2 * I_UQ) { const int l = r / I_UQ; r %= I_UQ; p0_transpose_item<0>(inp(args, 20) + (size_t)l * 192 * 384, 192, 384, inp(args, 18) + l * 192, (bf16_t*)(ws + WS_WUQT) + (size_t)l * 384 * 192, scr, r / 12, r % 12, lane); continue; } r -= 2 * I_UQ;
              if (r < 2 * I_UKV) { const int l = r / I_UKV; r %= I_UKV; p0_transpose_item<0>(inp(args, 21) + (size_t)l * 128 * 512, 128, 512, inp(args, 19) + l * 128, (bf16_t*)(ws + WS_WUKVT) + (size_t)l * 512 * 128, scr, r / 16, r % 16, lane); continue; } r -= 2 * I_UKV;
              if (r < 4 * I_W1) { const int lj = r / I_W1; r %= I_W1; p0_transpose_item<0>(inp(args, 12) + (size_t)lj * 2048 * 256, 2048, 256, nullptr, (bf16_t*)(ws + WS_W1T) + (size_t)lj * 256 * 2048, scr, r / 8, r % 8, lane); continue; } r -= 4 * I_W1;
              { const int lj = r / I_W2; r %= I_W2; p0_transpose_item<0>(inp(args, 14) + (size_t)lj * 256 * 64, 256, 64, nullptr, (bf16_t*)(ws + WS_W2T) + (size_t)lj * 64 * 256, scr, r / 2, r % 2, lane); } } }
        for (int e = bid * NTHR + tid; e < 2 * 2 * 4 * 64 * 64; e += G * NTHR) {
            const int k = e & 63, n = (e >> 6) & 63, h = (e >> 12) & 3, g = (e >> 14) & 1, l = e >> 15;
            ((bf16_t*)(ws + WS_WGT))[e] = f2bf((g == 0 ? inp(args, 6) : inp(args, 8))[(((size_t)l * 4 + h) * 64 + k) * 64 + n]); }
        for (int e = bid * NTHR + tid; e < 512; e += G * NTHR) ((float*)(ws + WS_SP))[e] = log1pf(expf(-inp(args, 10)[e]));
        for (int m0 = gw; m0 < M; m0 += 2 * NGW) {
            f32x4 v[2][4];
#pragma unroll
            for (int rr = 0; rr < 2; ++rr) { const int ml = m0 + rr * NGW < M ? m0 + rr * NGW : m0; const f32x4* xr = (const f32x4*)(inp(args, 0) + (size_t)ml * DM) + lane;
#pragma unroll
                for (int j = 0; j < 4; ++j) v[rr][j] = xr[64 * j]; }
            __builtin_amdgcn_sched_barrier(0);
#pragma unroll
            for (int rr = 0; rr < 2; ++rr) { const int m = m0 + rr * NGW; if (m >= M) break; float s = 0.f;
#pragma unroll
                for (int j = 0; j < 4; ++j) s += v[rr][j][0] * v[rr][j][0] + v[rr][j][1] * v[rr][j][1] + v[rr][j][2] * v[rr][j][2] + v[rr][j][3] * v[rr][j][3];
                s = wave_sum(s);
                u32x2* o8 = (u32x2*)(XB + (size_t)m * DM) + lane;
#pragma unroll
                for (int j = 0; j < 4; ++j) { u32x2 w; w.x = pk2(v[rr][j][0], v[rr][j][1]); w.y = pk2(v[rr][j][2], v[rr][j][3]); o8[64 * j] = w; }
                if (lane < 4) ssp_base[(size_t)lane * M + m] = lane == 0 ? s : 0.f; }
        }
        for (int e = bid * NTHR + tid; e < M * 32; e += G * NTHR) {
            const int m = e >> 5, i = e & 31; const float pos = (float)((const int*)inp(args, 1))[m];
            const float invf = __builtin_amdgcn_exp2f(-(float)(2 * i) * (13.287712379549449f / 64.f)); float sn, cs; { float rv = pos * invf * 0.15915494309189535f; rv -= floorf(rv); sn = __builtin_amdgcn_sinf(rv); cs = __builtin_amdgcn_cosf(rv); }
            ((float2*)(ws + WS_CS64))[e] = make_float2(cs, sn);
            if (i < 16) { const float invf2 = __builtin_amdgcn_exp2f(-(float)(2 * i) * (13.287712379549449f / 32.f)); float rv = pos * invf2 * 0.15915494309189535f; rv -= floorf(rv); sn = __builtin_amdgcn_sinf(rv); cs = __builtin_amdgcn_cosf(rv); ((float2*)(ws + WS_CS32))[m * 16 + i] = make_float2(cs, sn); }
        }
        for (int e = bid * NTHR + tid; e < 2 * 2 * 256; e += G * NTHR) {
            const int lj = e >> 8, c = e & 255; float a = inp(args, 13)[e];
            const float* pp = inp(args, 11) + (size_t)lj * 2048; const float* w1 = inp(args, 12) + (size_t)lj * 2048 * 256 + c;
            for (int i = 0; i < 2048; ++i) a += pp[i] * w1[(size_t)i * 256];
            hb[e] = a;
        }
      }
    }
    SEAM(0);

    for (int l = 0; l < 2; ++l) {
        const int pb = 1 + 6 * l;
        if (IN(pb)) {
        const int l_ = l; WS_PTRS();
            pg8::Gemm g{XB, (const bf16_t*)(ws + WS_WIN) + (size_t)l * NIN * DM, M, NIN, DM}; pg8::StaticOrder S; S.init(M, NIN, G, bid);
            pg8::EpiInProj E{PB, NIN, ssq_mix};
            _Pragma("unroll 1") for (int rep = 0; rep < REP_G16; ++rep) pg8::gemm_phase<pg8::EpiInProj, pg8::StaticOrder, true, true>(lds, g, S, E, wave);
        }
        SEAM(pb);
        if (IN(pb + 1)) {
        const int l_ = l; WS_PTRS();
        LAUNDER_TID();
            constexpr int N_J1 = 1024, N_J2 = 512, N_J3 = 512, N_J4 = 512, N_J4B = 128;
            {
            for (int r_ = bid; r_ < N_J4B * REP_J4B; r_ += G) { const int r = r_ % N_J4B;
                    const int j = r & 1, g32 = (r >> 1) & 15, b = r >> 5; const int colb = j == 0 ? C_KC : C_VC; const int r32 = lane & 31, hi = lane >> 5;
                    LAS unsigned char* Tl = lds;
                    LAS unsigned char* Hl = lds + 69632;
#pragma unroll 1
                    for (int g3 = 0; g3 < 3; ++g3) {
                        u32x4 la_[3], lc_[3]; f32x4 lcs_[3][4];
#pragma unroll
                        for (int k = 0; k < 3; ++k) { const int e0 = tid + (3 * g3 + k) * NTHR, e = e0 < 528 * 8 ? e0 : 528 * 8 - 1, rr = e >> 3, c8 = e & 7, t = 512 * g32 + rr, tc = t < SEQ ? t : SEQ - 1;
                            const bf16_t* pr = PB + ((size_t)b * SEQ + tc) * NIN + colb;
                            if (j == 0) { la_[k] = *(const u32x4*)(pr + 8 * (c8 & 3)); lc_[k] = *(const u32x4*)(pr + 32 + 8 * (c8 & 3)); const f32x4* cs4 = (const f32x4*)(cs64 + ((size_t)b * SEQ + tc) * 32 + 8 * (c8 & 3));
#pragma unroll
                                for (int q = 0; q < 4; ++q) lcs_[k][q] = cs4[q]; }
                            else { la_[k] = *(const u32x4*)(pr + 8 * c8); lc_[k] = la_[k];
#pragma unroll
                                for (int q = 0; q < 4; ++q) lcs_[k][q] = (f32x4){0.f, 0.f, 0.f, 0.f}; } }
                        __builtin_amdgcn_sched_barrier(0);
#pragma unroll
                        for (int k = 0; k < 3; ++k) { const int e0 = tid + (3 * g3 + k) * NTHR;
                            if (e0 < 528 * 8) { const int rr = e0 >> 3, c8 = e0 & 7, t = 512 * g32 + rr; u32x4 w = la_[k];
                                if (j == 0) { const u32x4 a = la_[k], c = lc_[k];
                                    const unsigned au[4] = {a.x, a.y, a.z, a.w}, cu[4] = {c.x, c.y, c.z, c.w}; unsigned ou[4];
#pragma unroll
                                    for (int q = 0; q < 4; ++q) { const f32x4 cq_ = lcs_[k][q]; const float2 s0 = {cq_[0], cq_[1]}, s1 = {cq_[2], cq_[3]}; const float x1a = bflo(au[q]), x1b = bfhi(au[q]), x2a = bflo(cu[q]), x2b = bfhi(cu[q]);
                                        ou[q] = c8 < 4 ? pk2(x1a * s0.x - x2a * s0.y, x1b * s1.x - x2b * s1.y) : pk2(x2a * s0.x + x1a * s0.y, x2b * s1.x + x1b * s1.y); }
                                    w.x = ou[0]; w.y = ou[1]; w.z = ou[2]; w.w = ou[3]; }
                                if (t >= SEQ) w = (u32x4){0u, 0u, 0u, 0u};
                                *(LAS u32x4*)(Tl + rr * 128 + (rr >> 4) * 16 + c8 * 16) = w; } }
                    }
                    __syncthreads();
                    { const bf16_t* w1t = (const bf16_t*)(ws + WS_W1T) + ((size_t)(l * 2 + j) * 256 + 32 * wave + r32) * 2048 + 8 * hi;
                      f32x16 acc;
#pragma unroll
                      for (int i = 0; i < 16; ++i) acc[i] = 0.f;
                      bf16x8 bwa[16], bwb[16];
#pragma unroll
                      for (int i = 0; i < 16; ++i) bwa[i] = *(const bf16x8*)(w1t + 16 * i);
#pragma unroll
                      for (int kc = 0; kc < 8; kc += 2) {
#pragma unroll
                          for (int i = 0; i < 16; ++i) bwb[i] = *(const bf16x8*)(w1t + 16 * (16 * (kc + 1) + i));
                          __builtin_amdgcn_sched_barrier(0);
#pragma unroll
                          for (int i = 0; i < 16; ++i) { const int kk = 16 * kc + i, rowt = 16 * r32 + (kk >> 2);
                              const bf16x8 a = *(const LAS bf16x8*)(Tl + rowt * 128 + (rowt >> 4) * 16 + 32 * (kk & 3) + 16 * hi); acc = mfma32(a, bwa[i], acc); }
                          __builtin_amdgcn_sched_barrier(0);
                          if (kc + 2 < 8) {
#pragma unroll
                              for (int i = 0; i < 16; ++i) bwa[i] = *(const bf16x8*)(w1t + 16 * (16 * (kc + 2) + i)); }
                          __builtin_amdgcn_sched_barrier(0);
#pragma unroll
                          for (int i = 0; i < 16; ++i) { const int kk = 16 * (kc + 1) + i, rowt = 16 * r32 + (kk >> 2);
                              const bf16x8 a = *(const LAS bf16x8*)(Tl + rowt * 128 + (rowt >> 4) * 16 + 32 * (kk & 3) + 16 * hi); acc = mfma32(a, bwb[i], acc); }
                      }
                      const float hbv = hb[(l * 2 + j) * 256 + 32 * wave + r32];
#pragma unroll
                      for (int i = 0; i < 16; ++i) { const int n = (i & 3) + 8 * (i >> 2) + 4 * hi; *(LAS bf16_t*)(Hl + n * 528 + (32 * wave + r32) * 2) = f2bf(gelu_tanh(acc[i] + hbv)); } }
                    __syncthreads();
                    if (wave < 2) { const bf16_t* w2t = (const bf16_t*)(ws + WS_W2T) + ((size_t)(l * 2 + j) * 64 + 32 * wave + r32) * 256 + 8 * hi;
                      f32x16 acc;
#pragma unroll
                      for (int i = 0; i < 16; ++i) acc[i] = 0.f;
#pragma unroll
                      for (int kk = 0; kk < 16; ++kk) acc[kk] = 0.f;
                      bf16x8 bw2[16];
#pragma unroll
                      for (int kk = 0; kk < 16; ++kk) bw2[kk] = *(const bf16x8*)(w2t + 16 * kk);
                      __builtin_amdgcn_sched_barrier(0);
#pragma unroll
                      for (int kk = 0; kk < 16; ++kk) { const bf16x8 a = *(const LAS bf16x8*)(Hl + r32 * 528 + 32 * kk + 16 * hi); acc = mfma32(a, bw2[kk], acc); }
                      const int dd = 32 * wave + r32;
#pragma unroll
                      for (int g = 0; g < 4; ++g) { const int n0 = 32 * g32 + 8 * g + 4 * hi; float v[4];
#pragma unroll
                          for (int q = 0; q < 4; ++q) v[q] = (n0 + q < 511) ? acc[4 * g + q] : 0.f;
                          if (j == 0) {
#pragma unroll
                              for (int q = 0; q < 4; ++q) KCMPB[((size_t)b * 512 + n0 + q) * 64 + dd] = f2bf(v[q]); }
                          else { u32x2 w; w.x = pk2(v[0], v[1]); w.y = pk2(v[2], v[3]); *(u32x2*)(VCMPT + ((size_t)b * 64 + dd) * 512 + n0) = w; } } }
                    __syncthreads();
            }
            if (bid < N_J3) {
                const int fr = lane & 15, kq = lane >> 4, hh = wave >> 1, odd = wave & 1;
                {
                    bf16x8 bq[3][6];
                    { const bf16_t* wq = (const bf16_t*)(ws + WS_WUQT) + (size_t)l * 384 * 192;
#pragma unroll
                      for (int nt = 0; nt < 3; ++nt)
#pragma unroll
                          for (int ks = 0; ks < 6; ++ks) bq[nt][ks] = *(const bf16x8*)(wq + (size_t)(48 * wave + 16 * nt + fr) * 192 + 32 * ks + 8 * kq); }
                    for (int r_ = bid; r_ < N_J3 * REP_J3; r_ += G) { const int r = r_ % N_J3;
                        const size_t row0 = (size_t)r * 64;
                        bf16x8 aq[6]; float2 csq[4];
#pragma unroll
                        for (int ks = 0; ks < 6; ++ks) aq[ks] = ld8x2(PB + (row0 + fr) * NIN + C_DCQ + 32 * ks + 8 * kq);
#pragma unroll
                        for (int i = 0; i < 4; ++i) csq[i] = cs32[(row0 + 4 * kq + i) * 16 + fr];
#pragma unroll 1
                        for (int mt = 0; mt < 4; ++mt) {
                            bf16x8 an[6]; float2 csn[4]; const int mn = mt < 3 ? mt + 1 : 3;
#pragma unroll
                            for (int ks = 0; ks < 6; ++ks) an[ks] = ld8x2(PB + (row0 + mn * 16 + fr) * NIN + C_DCQ + 32 * ks + 8 * kq);
#pragma unroll
                            for (int i = 0; i < 4; ++i) csn[i] = cs32[(row0 + mn * 16 + 4 * kq + i) * 16 + fr];
                            float2 kcs[4]; float kx1[4], kx2[4];
#pragma unroll
                            for (int q = 0; q < 4; ++q) { const int p = lane * 4 + q, tok = p >> 4, i = p & 15; const size_t row = row0 + mt * 16 + tok; const bf16_t* pr = PB + row * NIN + C_DKR;
                                kx1[q] = bf2f(pr[i]); kx2[q] = bf2f(pr[16 + i]); kcs[q] = cs32[row * 16 + i]; }
                            __builtin_amdgcn_sched_barrier(0);
                            float ssq_ = 0.f;
#pragma unroll
                            for (int ks = 0; ks < 6; ++ks) {
#pragma unroll
                                for (int e = 0; e < 8; ++e) { const float v = bf2f((bf16_t)aq[ks][e]); ssq_ += v * v; } }
                            ssq_ += shx(ssq_, 16); ssq_ += shx(ssq_, 32);
                            const float rq_ = rsqrtf(ssq_ * (1.f / 192.f) + EPS);
                            f32x4 cq[3];
#pragma unroll
                            for (int nt = 0; nt < 3; ++nt) { cq[nt] = (f32x4){0.f, 0.f, 0.f, 0.f};
#pragma unroll
                                for (int ks = 0; ks < 6; ++ks) cq[nt] = __builtin_amdgcn_mfma_f32_16x16x32_bf16(aq[ks], bq[nt][ks], cq[nt], 0, 0, 0); }
                            const float SCQ = 0.10206207261596575f * LOG2E;
#pragma unroll
                            for (int i = 0; i < 4; ++i) {
                                const size_t row = row0 + mt * 16 + 4 * kq + i; const float rqi = shf(rq_, 4 * kq + i) * SCQ;
                                float q0 = cq[0][i] * rqi, q1 = cq[1][i] * rqi, q2 = cq[2][i] * rqi;
                                if (odd) { const float2 cs = csq[i]; const float x1 = q1, x2 = q2; q1 = x1 * cs.x - x2 * cs.y; q2 = x2 * cs.x + x1 * cs.y; }
                                bf16_t* mq = MQ + row * 384 + hh * 96 + 48 * odd + fr; mq[0] = f2bf(q0); mq[16] = f2bf(q1); mq[32] = f2bf(q2);
                            }
                            if (wave == mt) {
#pragma unroll
                                for (int q = 0; q < 4; ++q) { const int p = lane * 4 + q, tok = p >> 4, i = p & 15; const size_t row = row0 + mt * 16 + tok;
                                    MKR[row * 32 + i] = f2bf(kx1[q] * kcs[q].x - kx2[q] * kcs[q].y); MKR[row * 32 + 16 + i] = f2bf(kx2[q] * kcs[q].x + kx1[q] * kcs[q].y); } }
#pragma unroll
                            for (int ks = 0; ks < 6; ++ks) aq[ks] = an[ks];
#pragma unroll
                            for (int i = 0; i < 4; ++i) csq[i] = csn[i];
                        }
                    }
                }
                {
                    bf16x8 bkv[4][4];
                    { const bf16_t* wkv = (const bf16_t*)(ws + WS_WUKVT) + (size_t)l * 512 * 128;
#pragma unroll
                      for (int nt = 0; nt < 4; ++nt)
#pragma unroll
                          for (int ks = 0; ks < 4; ++ks) bkv[nt][ks] = *(const bf16x8*)(wkv + (size_t)(64 * wave + 16 * nt + fr) * 128 + 32 * ks + 8 * kq); }
                    for (int r_ = bid; r_ < N_J3 * REP_J3; r_ += G) { const int r = r_ % N_J3;
                        const size_t row0 = (size_t)r * 64; const size_t bb = row0 / SEQ, t0 = row0 % SEQ;
                        bf16x8 akv[4];
#pragma unroll
                        for (int ks = 0; ks < 4; ++ks) akv[ks] = ld8x2(PB + (row0 + fr) * NIN + C_DCKV + 32 * ks + 8 * kq);
#pragma unroll 1
                        for (int mt = 0; mt < 4; ++mt) {
                            bf16x8 akn[4]; const int mn = mt < 3 ? mt + 1 : 3;
#pragma unroll
                            for (int ks = 0; ks < 4; ++ks) akn[ks] = ld8x2(PB + (row0 + mn * 16 + fr) * NIN + C_DCKV + 32 * ks + 8 * kq);
                            __builtin_amdgcn_sched_barrier(0);
                            float sskv_ = 0.f;
#pragma unroll
                            for (int ks = 0; ks < 4; ++ks) {
#pragma unroll
                                for (int e = 0; e < 8; ++e) { const float v = bf2f((bf16_t)akv[ks][e]); sskv_ += v * v; } }
                            sskv_ += shx(sskv_, 16); sskv_ += shx(sskv_, 32);
                            const float rk_ = rsqrtf(sskv_ * (1.f / 128.f) + EPS);
                            f32x4 ckv[4];
#pragma unroll
                            for (int nt = 0; nt < 4; ++nt) { ckv[nt] = (f32x4){0.f, 0.f, 0.f, 0.f};
#pragma unroll
                                for (int ks = 0; ks < 4; ++ks) ckv[nt] = __builtin_amdgcn_mfma_f32_16x16x32_bf16(akv[ks], bkv[nt][ks], ckv[nt], 0, 0, 0); }
                            float rki[4];
#pragma unroll
                            for (int i = 0; i < 4; ++i) rki[i] = shf(rk_, 4 * kq + i);
                            if (!odd) {
#pragma unroll
                                for (int i = 0; i < 4; ++i) { bf16_t* mk = MKN + (row0 + mt * 16 + 4 * kq + i) * 256 + hh * 64 + fr;
                                    mk[0] = f2bf(ckv[0][i] * rki[i]); mk[16] = f2bf(ckv[1][i] * rki[i]); mk[32] = f2bf(ckv[2][i] * rki[i]); mk[48] = f2bf(ckv[3][i] * rki[i]); } }
                            else {
#pragma unroll
                                for (int nt = 0; nt < 4; ++nt) { u32x2 w; w.x = pk2(ckv[nt][0] * rki[0], ckv[nt][1] * rki[1]); w.y = pk2(ckv[nt][2] * rki[2], ckv[nt][3] * rki[3]);
                                    *(u32x2*)(MVT + ((bb * 4 + hh) * 64 + 16 * nt + fr) * SEQ + t0 + mt * 16 + 4 * kq) = w; } }
#pragma unroll
                            for (int ks = 0; ks < 4; ++ks) akv[ks] = akn[ks];
                        }
                    }
                }
            }
            {
                const int r32 = lane & 31, hi = lane >> 5, gh = wave >> 1, gg = wave & 1, ch = tid & 255, half = tid >> 8;
                bf16x8 bW[2][4];
                { const bf16_t* wt = (const bf16_t*)(ws + WS_WGT) + (size_t)(((l * 2 + gg) * 4 + gh) * 64) * 64;
#pragma unroll
                  for (int nt = 0; nt < 2; ++nt)
#pragma unroll
                      for (int ks = 0; ks < 4; ++ks) bW[nt][ks] = *(const bf16x8*)(wt + (size_t)(32 * nt + r32) * 64 + 16 * ks + 8 * hi); }
                const float gbias0 = (gg == 0 ? inp(args, 7) : inp(args, 9))[l * 256 + gh * 64 + r32], gbias1 = (gg == 0 ? inp(args, 7) : inp(args, 9))[l * 256 + gh * 64 + 32 + r32];
                const float cw0 = inp(args, 4)[(l * 4 + 0) * 256 + ch], cw1 = inp(args, 4)[(l * 4 + 1) * 256 + ch], cw2 = inp(args, 4)[(l * 4 + 2) * 256 + ch], cw3 = inp(args, 4)[(l * 4 + 3) * 256 + ch], cb = inp(args, 5)[l * 256 + ch];
                const float sp = ((const float*)(ws + WS_SP))[l * 256 + ch];
                LAS float* xa = ldsf; LAS float* xc = ldsf + 35 * 256; LAS unsigned char* xcb = lds + 67 * 1024; LAS float* gR = (LAS float*)(lds + 67 * 1024 + 32 * 528); LAS float* gI = gR + 32 * 256;
            const bool j1bal = (G == 256 && REP_J1 == 1);
            for (int r_ = bid, k_ = 0; j1bal ? (k_ < (bid < 128 ? 3 : 5)) : (r_ < N_J1 * REP_J1); r_ += G, ++k_) { const int r = j1bal ? (bid < 128 ? bid + 128 * k_ : 384 + (bid - 128) + 128 * k_) : r_ % N_J1;
                    const int b = r >> 8, tb = r & 255, t0 = tb * 32;
                    {
                        u32x4 wv_[3];
#pragma unroll
                        for (int it = 0; it < 3; ++it) { const int c0_ = tid + it * NTHR, c = c0_ < 35 * 32 ? c0_ : 35 * 32 - 1, rr = c >> 5, c8 = c & 31, t = t0 - 3 + rr, tc = t >= 0 ? t : 0; wv_[it] = *(const u32x4*)(PB + ((size_t)b * SEQ + tc) * NIN + C_AX + 8 * c8); }
                        __builtin_amdgcn_sched_barrier(0);
#pragma unroll
                        for (int it = 0; it < 3; ++it) { const int c = tid + it * NTHR; if (c < 35 * 32) { const int rr = c >> 5, c8 = c & 31, t = t0 - 3 + rr; u32x4 w = wv_[it]; if (t < 0) w = (u32x4){0u, 0u, 0u, 0u};
                            LAS f32x4* d = (LAS f32x4*)(xa + rr * 256 + 8 * c8); d[0] = (f32x4){bflo(w.x), bfhi(w.x), bflo(w.y), bfhi(w.y)}; d[1] = (f32x4){bflo(w.z), bfhi(w.z), bflo(w.w), bfhi(w.w)}; } }
                    }
                    __syncthreads();
#pragma unroll 4
                    for (int tt = 0; tt < 16; ++tt) { const int rr = half * 16 + tt; const float v = cb + cw0 * xa[rr * 256 + ch] + cw1 * xa[(rr + 1) * 256 + ch] + cw2 * xa[(rr + 2) * 256 + ch] + cw3 * xa[(rr + 3) * 256 + ch];
                        xc[rr * 256 + ch] = v; *(LAS bf16_t*)(xcb + rr * 528 + ch * 2) = f2bf(v); }
                    __syncthreads();
                    { f32x16 acc[2];
#pragma unroll
                      for (int i = 0; i < 16; ++i) { acc[0][i] = 0.f; acc[1][i] = 0.f; }
#pragma unroll
                      for (int ks = 0; ks < 4; ++ks) { const bf16x8 a = *(const LAS bf16x8*)(xcb + r32 * 528 + (gh * 64 + 16 * ks + 8 * hi) * 2); acc[0] = mfma32(a, bW[0][ks], acc[0]); acc[1] = mfma32(a, bW[1][ks], acc[1]); }
                      LAS float* gd = gg == 0 ? gR : gI;
#pragma unroll
                      for (int i = 0; i < 16; ++i) { const int tok = (i & 3) + 8 * (i >> 2) + 4 * hi; gd[tok * 256 + gh * 64 + r32] = sigmoidf_(acc[0][i] + gbias0); gd[tok * 256 + gh * 64 + 32 + r32] = sigmoidf_(acc[1][i] + gbias1); } }
                    __syncthreads();
                    float hst = 0.f, Ac = 1.f;
#pragma unroll 4
                    for (int tt = 0; tt < 16; ++tt) {
                        const int rr = half * 16 + tt;
                        const float la = -8.f * gR[rr * 256 + ch] * sp, x2 = 2.f * la;
                        const float av = la > -0.25f ? 1.f + la * (1.f + la * (0.5f + la * (0.16666667f + la * (0.041666667f + la * 0.0083333333f)))) : __expf(la);
                        const float om = x2 > -0.5f ? -x2 * (1.f + x2 * (0.5f + x2 * (0.16666667f + x2 * (0.041666667f + x2 * (0.0083333333f + x2 * 0.0013888889f))))) : 1.f - __expf(x2);
                        const float u = __builtin_amdgcn_sqrtf(om) * (gI[rr * 256 + ch] * xc[rr * 256 + ch]);
                        hst = av * hst + u; Ac *= av;
                        { const size_t ao = ((size_t)b * SEQ + t0 + rr) * 256 + ch; LRA[ao] = av; LRU_[ao] = u; }
                    }
                    const size_t so = ((size_t)(b * 512 + tb * 2 + half)) * 256 + ch;
                    LA[so] = Ac; LH[so] = hst;
                    __syncthreads();
            }
            }
            {
                const int kk = tid & 127, tq = tid >> 7, r32 = lane & 31, hi = lane >> 5;
                float wg[16]; const float bg = inp(args, 16)[l * 128 + kk];
#pragma unroll
                for (int q = 0; q < 16; ++q) wg[q] = inp(args, 15)[(l * 16 + q) * 128 + kk];
                LAS float* glr = ldsf; LAS float* tot = ldsf + 1024; LAS unsigned char* KTl = lds + 8192; LAS unsigned char* VTl = lds + 8192 + 128 * VSTR;
                float* BCS = (float*)(ws + WS_BCS);
            for (int r_ = bid; r_ < N_J2 * REP_J2; r_ += G) { const int r = r_ % N_J2;
                    const int b = r >> 7, c = r & 127; const size_t row0 = (size_t)b * SEQ + 64 * c;
                    for (int e = tid; e < 1024; e += NTHR) glr[e] = bf2f(PB[(row0 + (e >> 4)) * NIN + C_GLR + (e & 15)]);
                    for (int e = tid; e < 2048; e += NTHR) { const int jj = e >> 5, hc = e & 31; const bf16_t* vsrc = PB + (row0 + jj) * NIN + C_CV + 8 * hc; const u32x2 wA = *(const u32x2*)vsrc, wB = *(const u32x2*)(vsrc + 4);
                        LAS bf16_t* d = (LAS bf16_t*)(VTl + (8 * hc) * VSTR) + jj;
                        d[0] = (bf16_t)wA.x; d[VSTR / 2] = (bf16_t)(wA.x >> 16); d[2 * (VSTR / 2)] = (bf16_t)wA.y; d[3 * (VSTR / 2)] = (bf16_t)(wA.y >> 16); d[4 * (VSTR / 2)] = (bf16_t)wB.x; d[5 * (VSTR / 2)] = (bf16_t)(wB.x >> 16); d[6 * (VSTR / 2)] = (bf16_t)wB.y; d[7 * (VSTR / 2)] = (bf16_t)(wB.y >> 16); }
                    __syncthreads();
                    bf16_t kraw[16];
#pragma unroll
                    for (int tt = 0; tt < 16; ++tt) kraw[tt] = PB[(row0 + 16 * tq + tt) * NIN + C_CK + kk];
                    float bv[16]; float run = 0.f;
#pragma unroll
                    for (int tt = 0; tt < 16; ++tt) { const LAS f32x4* g4 = (const LAS f32x4*)(glr + (16 * tq + tt) * 16); float z = bg;
#pragma unroll
                        for (int q = 0; q < 4; ++q) { const f32x4 g = g4[q]; z += g[0] * wg[4 * q] + g[1] * wg[4 * q + 1] + g[2] * wg[4 * q + 2] + g[3] * wg[4 * q + 3]; }
                        run += (fminf(z, 0.f) - __logf(1.f + __expf(-fabsf(z)))) * (1.f / 16.f); bv[tt] = run; }
                    tot[tq * 128 + kk] = run;
                    __syncthreads();
                    { const float t0_ = tot[kk], t1_ = tot[128 + kk], t2_ = tot[256 + kk], t3_ = tot[384 + kk]; const float off = tq == 0 ? 0.f : (tq == 1 ? t0_ : (tq == 2 ? t0_ + t1_ : (t0_ + t1_) + t2_)), blast = ((t0_ + t1_) + t2_) + t3_;
#pragma unroll
                      for (int tt = 0; tt < 16; ++tt) { const int t = 16 * tq + tt; const float bt = bv[tt] + off; BCS[(row0 + t) * 128 + kk] = bt;
                          *((LAS bf16_t*)(KTl + kk * VSTR) + t) = f2bf(bf2f(kraw[tt]) * __expf(blast - bt)); }
                      if (tq == 0) DEC[(size_t)(b * 128 + c) * 128 + kk] = __expf(blast); }
                    __syncthreads();
                    { const int h = wave >> 1, nt = wave & 1; f32x16 acc;
#pragma unroll
                      for (int i = 0; i < 16; ++i) acc[i] = 0.f;
                      const LAS unsigned char* ap = KTl + (h * 32 + r32) * VSTR + 16 * hi; const LAS unsigned char* bp = VTl + (h * 64 + 32 * nt + r32) * VSTR + 16 * hi;
#pragma unroll
                      for (int s = 0; s < 4; ++s) { const u32x2 a0 = *(const LAS u32x2*)(ap + 32 * s), a1 = *(const LAS u32x2*)(ap + 32 * s + 8), b0 = *(const LAS u32x2*)(bp + 32 * s), b1 = *(const LAS u32x2*)(bp + 32 * s + 8);
                          u32x4 aw, bw; aw.x = a0.x; aw.y = a0.y; aw.z = a1.x; aw.w = a1.y; bw.x = b0.x; bw.y = b0.y; bw.z = b1.x; bw.w = b1.y;
                          acc = mfma32(__builtin_bit_cast(bf16x8, aw), __builtin_bit_cast(bf16x8, bw), acc); }
                      float* o = KVC + ((size_t)(b * 128 + c) * 4 + h) * 2048 + 32 * nt + r32;
#pragma unroll
                      for (int i = 0; i < 16; ++i) o[((i & 3) + 8 * (i >> 2) + 4 * hi) * 64] = acc[i]; }
                    __syncthreads();
            }
            }
            for (int r = bid; r < N_J4; r += G) {
                    const size_t row0 = (size_t)r * 64;
                    u32x4 ra_[3], rc_[3]; f32x4 rcs_[3][4];
#pragma unroll
                    for (int it3 = 0; it3 < 3; ++it3) { const int e = tid + it3 * NTHR, tok = e / 24, p = e % 24, hd = p >> 2, c8 = p & 3; const int base = hd < 4 ? C_BQ + hd * 64 : (hd == 4 ? C_KS : C_KW);
                        const bf16_t* pr = PB + (row0 + tok) * NIN + base + 8 * c8; ra_[it3] = *(const u32x4*)pr; rc_[it3] = *(const u32x4*)(pr + 32); const f32x4* cs4 = (const f32x4*)(cs64 + (row0 + tok) * 32 + 8 * c8);
#pragma unroll
                        for (int q = 0; q < 4; ++q) rcs_[it3][q] = cs4[q]; }
                    __builtin_amdgcn_sched_barrier(0);
#pragma unroll
                    for (int it3 = 0; it3 < 3; ++it3) {
                        const int e = tid + it3 * NTHR, tok = e / 24, p = e % 24, hd = p >> 2, c8 = p & 3; const int base = hd < 4 ? C_BQ + hd * 64 : (hd == 4 ? C_KS : C_KW); const float sc = hd < 4 ? 0.125f * LOG2E : 1.f;
                        bf16_t* pr = PB + (row0 + tok) * NIN + base + 8 * c8; const u32x4 a = ra_[it3], c = rc_[it3];
                        const unsigned au[4] = {a.x, a.y, a.z, a.w}, cu[4] = {c.x, c.y, c.z, c.w}; unsigned o1[4], o2[4];
#pragma unroll
                        for (int q = 0; q < 4; ++q) { const f32x4 cq_ = rcs_[it3][q]; const float2 s0 = {cq_[0], cq_[1]}, s1 = {cq_[2], cq_[3]}; const float x1a = bflo(au[q]), x1b = bfhi(au[q]), x2a = bflo(cu[q]), x2b = bfhi(cu[q]);
                            o1[q] = pk2((x1a * s0.x - x2a * s0.y) * sc, (x1b * s1.x - x2b * s1.y) * sc); o2[q] = pk2((x2a * s0.x + x1a * s0.y) * sc, (x2b * s1.x + x1b * s1.y) * sc); }
                        u32x4 w1, w2; w1.x = o1[0]; w1.y = o1[1]; w1.z = o1[2]; w1.w = o1[3]; w2.x = o2[0]; w2.y = o2[1]; w2.z = o2[2]; w2.w = o2[3];
                        *(u32x4*)pr = w1; *(u32x4*)(pr + 32) = w2;
                        if (hd == 4) {
                            bf16_t* kf_ = KSF + (row0 / 64) * 4096 + (size_t)((((tok >> 5) * 4 + (c8 >> 1)) * 64 + (c8 & 1) * 32 + (tok & 31)) * 8); *(u32x4*)kf_ = w1; *(u32x4*)(kf_ + 2 * 64 * 8) = w2; } }
                    { LAS bf16_t* tl = (LAS bf16_t*)lds; const size_t bb = row0 / SEQ, t0 = row0 % SEQ;
                      for (int mtx = 0; mtx < 2; ++mtx) { const int tok = tid >> 3, c = tid & 7; const u32x4 w = *(const u32x4*)(PB + (row0 + tok) * NIN + (mtx ? C_VW : C_VS) + c * 8);
                          LAS bf16_t* dst = tl + mtx * 64 * 72 + tok * 72 + c * 8; dst[0] = (bf16_t)w.x; dst[1] = (bf16_t)(w.x >> 16); dst[2] = (bf16_t)w.y; dst[3] = (bf16_t)(w.y >> 16); dst[4] = (bf16_t)w.z; dst[5] = (bf16_t)(w.z >> 16); dst[6] = (bf16_t)w.w; dst[7] = (bf16_t)(w.w >> 16); }
                      __syncthreads();
                      for (int mtx = 0; mtx < 2; ++mtx) { const int d = tid >> 3, c8 = tid & 7; const LAS bf16_t* s = tl + mtx * 64 * 72 + (c8 * 8) * 72 + d;
                          u32x4 w; w.x = (unsigned)s[0] | ((unsigned)s[72] << 16); w.y = (unsigned)s[2 * 72] | ((unsigned)s[3 * 72] << 16); w.z = (unsigned)s[4 * 72] | ((unsigned)s[5 * 72] << 16); w.w = (unsigned)s[6 * 72] | ((unsigned)s[7 * 72] << 16);
                          if (mtx) *(u32x4*)(VWT + (bb * 64 + d) * SEQ + t0 + c8 * 8) = w;
                          else { const int s_ = c8 >> 1, h_ = c8 & 1; const LAS bf16_t* q = tl + (16 * s_ + 4 * h_) * 72 + d;
                              u32x4 f; f.x = (unsigned)q[0] | ((unsigned)q[72] << 16); f.y = (unsigned)q[2 * 72] | ((unsigned)q[3 * 72] << 16); f.z = (unsigned)q[8 * 72] | ((unsigned)q[9 * 72] << 16); f.w = (unsigned)q[10 * 72] | ((unsigned)q[11 * 72] << 16);
                              *(u32x4*)(VST + (row0 / 64) * 4096 + (size_t)((((d >> 5) * 4 + s_) * 64 + h_ * 32 + (d & 31)) * 8)) = f; } }
                      __syncthreads(); }
            }
            }
        }
        SEAM(pb + 1);
        if (IN(pb + 2)) {
        const int l_ = l; WS_PTRS();
        LAUNDER_TID();
            constexpr int Q_J5 = 2, Q_J6 = 64, Q_ATT = 1024 * REP_ATT, Q_J9 = 1024, Q_J10 = 512, Q_TOT = Q_J5 + Q_J6 + Q_ATT + Q_J9 + Q_J10;
            if (tid == 0) { LCTL[4] = 0u; LCTL[5] = 0u; }
            __syncthreads();
            const int tid_o = tid;
            unsigned ticket = 0u; bool have = true; if (tid == 0) ticket = __hip_atomic_fetch_add(ctl + CW_QUEUE + 64 * l, 1u, __ATOMIC_RELAXED, __HIP_MEMORY_SCOPE_AGENT);
            for (;;) {
                int tid = tid_o; asm volatile("" : "+v"(tid)); const int lane = tid & 63;
                if (tid == 0) { if (!have) ticket = __hip_atomic_fetch_add(ctl + CW_QUEUE + 64 * l, 1u, __ATOMIC_RELAXED, __HIP_MEMORY_SCOPE_AGENT); LCTL[2] = ticket; }
                __syncthreads();
                int r = __builtin_amdgcn_readfirstlane((int)LCTL[2]); const unsigned seen5 = LCTL[4], seen6 = LCTL[5];
                __syncthreads();
                if (r >= Q_TOT * REP_P3) break;
                have = r < Q_TOT * REP_P3 - G;
                if (have && tid == 0) ticket = __hip_atomic_fetch_add(ctl + CW_QUEUE + 64 * l, 1u, __ATOMIC_RELAXED, __HIP_MEMORY_SCOPE_AGENT);
                if (REP_P3 > 1 && r >= Q_TOT) r -= Q_TOT;
                if (r < Q_J5) {
                    const int e = r * NTHR + tid, b = e >> 8, ch = e & 255; float carry = 0.f;
                    float av[8], hv[8];
#pragma unroll
                    for (int q = 0; q < 8; ++q) { const size_t so = ((size_t)(b * 512 + q)) * 256 + ch; av[q] = LA[so]; hv[q] = LH[so]; }
#pragma unroll 1
                    for (int c0 = 0; c0 < 512; c0 += 8) { float an[8], hn[8]; const int cn = c0 + 8 < 512 ? c0 + 8 : c0;
#pragma unroll
                        for (int q = 0; q < 8; ++q) { const size_t so = ((size_t)(b * 512 + cn + q)) * 256 + ch; an[q] = LA[so]; hn[q] = LH[so]; }
                        __builtin_amdgcn_sched_barrier(0);
#pragma unroll
                        for (int q = 0; q < 8; ++q) { CIN[((size_t)(b * 512 + c0 + q)) * 256 + ch] = carry; carry = av[q] * carry + hv[q]; }
#pragma unroll
                        for (int q = 0; q < 8; ++q) { av[q] = an[q]; hv[q] = hn[q]; } }
                    asm volatile("s_waitcnt vmcnt(0)" ::: "memory"); __syncthreads();
                    if (tid == 0) { __builtin_amdgcn_fence(__ATOMIC_RELEASE, "agent"); asm volatile("s_waitcnt vmcnt(0)" ::: "memory"); (void)xb_add(ctl + CW_FLAG + 64 * (2 * l + 0), 1u); }
                    continue;
                }
                r -= Q_J5;
                if (r < Q_J6) {
                    const int e = r * NTHR + tid, b = e >> 13, rem = e & 8191; float Sv = 0.f;
                    float kv[8], dv[8];
#pragma unroll
                    for (int q = 0; q < 8; ++q) { kv[q] = KVC[(size_t)(b * 128 + q) * 8192 + rem]; dv[q] = DEC[(size_t)(b * 128 + q) * 128 + (rem >> 6)]; }
#pragma unroll 1
                    for (int c0 = 0; c0 < 128; c0 += 8) { float kn[8], dn[8]; const int cn = c0 + 8 < 128 ? c0 + 8 : c0;
#pragma unroll
                        for (int q = 0; q < 8; ++q) { kn[q] = KVC[(size_t)(b * 128 + cn + q) * 8192 + rem]; dn[q] = DEC[(size_t)(b * 128 + cn + q) * 128 + (rem >> 6)]; }
                        __builtin_amdgcn_sched_barrier(0);
#pragma unroll
                        for (int q = 0; q < 8; ++q) { SST[(size_t)(b * 128 + c0 + q) * 8192 + rem] = Sv; Sv = dv[q] * Sv + kv[q]; }
#pragma unroll
                        for (int q = 0; q < 8; ++q) { kv[q] = kn[q]; dv[q] = dn[q]; } }
                    asm volatile("s_waitcnt vmcnt(0)" ::: "memory"); __syncthreads();
                    if (tid == 0) { __builtin_amdgcn_fence(__ATOMIC_RELEASE, "agent"); asm volatile("s_waitcnt vmcnt(0)" ::: "memory"); (void)xb_add(ctl + CW_FLAG + 64 * (2 * l + 1), 1u); }
                    continue;
                }
                r -= Q_J6;
                if (r >= Q_ATT) {
                    r -= Q_ATT; const bool is9 = r < Q_J9;
                    if (!(is9 ? seen5 : seen6)) {
                        if (tid == 0) { unsigned* f = ctl + CW_FLAG + 64 * (2 * l + (is9 ? 0 : 1)); const unsigned target = is9 ? (unsigned)Q_J5 : (unsigned)Q_J6;
                            XB_SPIN(xb_ld(f) < target, ctl + CW_BAR); __builtin_amdgcn_fence(__ATOMIC_ACQUIRE, "agent"); asm volatile("s_waitcnt vmcnt(0)" ::: "memory"); LCTL[is9 ? 4 : 5] = 1u; }
                        __syncthreads(); }
                    if (is9) {
                    const int b = r >> 8, tb = r & 255, t0 = tb * 32, ch = tid & 255, half = tid >> 8;
                    LAS float* xa = ldsf;
                    float hst = CIN[((size_t)(b * 512 + tb * 2 + half)) * 256 + ch];
                    { float av[16], uv[16], gv[16];
#pragma unroll
                      for (int tt = 0; tt < 16; ++tt) { const size_t ro = (size_t)b * SEQ + t0 + half * 16 + tt; av[tt] = LRA[ro * 256 + ch]; uv[tt] = LRU_[ro * 256 + ch]; gv[tt] = bf2f(PB[ro * NIN + C_AG + ch]); }
                      __builtin_amdgcn_sched_barrier(0);
#pragma unroll
                      for (int tt = 0; tt < 16; ++tt) { hst = av[tt] * hst + uv[tt]; xa[(half * 16 + tt) * 256 + ch] = hst * gelu_tanh(gv[tt]); } }
                    __syncthreads();
                    for (int q = 0; q < 4; ++q) { const int rr = wave * 4 + q; const f32x4 v = ((const LAS f32x4*)(xa + rr * 256))[lane];
                        const float rinv = rsqrtf(wave_sum(v[0] * v[0] + v[1] * v[1] + v[2] * v[2] + v[3] * v[3]) * (1.f / 256.f) + EPS);
                        u32x2 w; w.x = pk2(v[0] * rinv, v[1] * rinv); w.y = pk2(v[2] * rinv, v[3] * rinv);
                        *(u32x2*)(Y + ((size_t)b * SEQ + t0 + rr) * DM + 256 + 4 * lane) = w; }
                    __syncthreads();
                    } else { r -= Q_J9;
                    const int b = r >> 7, c = r & 127; const size_t row0 = (size_t)b * SEQ + 64 * c;
                    LAS float* bL = ldsf; LAS float* glr = ldsf + 8192; LAS unsigned char* VTl = lds + 36864; LAS unsigned char* STl = lds + 71680; LAS float* SSX = (LAS float*)(lds + 92160);
                    const int r32_ = lane & 31, hi_ = lane >> 5, h_ = wave >> 1, i_ = 32 * (wave & 1) + r32_;
                    bf16x8 qv_[2], kv_[2][2]; u32x2 ogw_[2][4]; f32x4 gn_[2][4];
#pragma unroll
                    for (int ks = 0; ks < 2; ++ks) { const int k0 = h_ * 32 + 16 * ks + 8 * hi_; qv_[ks] = ld8x2(PB + (row0 + i_) * NIN + C_CQ + k0);
#pragma unroll
                        for (int jt = 0; jt < 2; ++jt) kv_[jt][ks] = ld8x2(PB + (row0 + 32 * jt + r32_) * NIN + C_CK + k0); }
                    { const float* gnp = inp(args, 17) + l * 64;
#pragma unroll
                      for (int dt = 0; dt < 2; ++dt)
#pragma unroll
                          for (int g = 0; g < 4; ++g) { const int v0 = 32 * dt + 8 * g + 4 * hi_; ogw_[dt][g] = *(const u32x2*)(PB + (row0 + i_) * NIN + C_OG + h_ * 64 + v0); gn_[dt][g] = *(const f32x4*)(gnp + v0); } }
                    {
                        f32x4 bv[4], sv[4]; u32x2 vA[4], vB[4];
                        const f32x4* bsrc = (const f32x4*)((const float*)(ws + WS_BCS) + row0 * 128); const f32x4* ssrc = (const f32x4*)(SST + (size_t)(b * 128 + c) * 8192);
#pragma unroll
                        for (int it = 0; it < 4; ++it) { const int e = tid + it * NTHR; bv[it] = bsrc[e]; sv[it] = ssrc[e];
                            const int jj = e >> 5, hc = e & 31, h = hc >> 3, c8 = hc & 7; const bf16_t* vsrc = PB + (row0 + jj) * NIN + C_CV + h * 64 + 8 * c8; vA[it] = *(const u32x2*)vsrc; vB[it] = *(const u32x2*)(vsrc + 4); }
                        __builtin_amdgcn_sched_barrier(0);
#pragma unroll
                        for (int it = 0; it < 4; ++it) { const int e = tid + it * NTHR; ((LAS f32x4*)bL)[e] = bv[it];
                            { const int jj = e >> 5, hc = e & 31, h = hc >> 3, c8 = hc & 7; u32x4 w; w.x = vA[it].x; w.y = vA[it].y; w.z = vB[it].x; w.w = vB[it].y;
                              LAS bf16_t* d = (LAS bf16_t*)(VTl + h * 8704 + (8 * c8) * VSTR) + jj;
                              d[0] = (bf16_t)w.x; d[VSTR / 2] = (bf16_t)(w.x >> 16); d[2 * (VSTR / 2)] = (bf16_t)w.y; d[3 * (VSTR / 2)] = (bf16_t)(w.y >> 16); d[4 * (VSTR / 2)] = (bf16_t)w.z; d[5 * (VSTR / 2)] = (bf16_t)(w.z >> 16); d[6 * (VSTR / 2)] = (bf16_t)w.w; d[7 * (VSTR / 2)] = (bf16_t)(w.w >> 16); }
                            { const int e4 = e * 4, h = e4 >> 11, k = (e4 >> 6) & 31, v = e4 & 63;
#pragma unroll
                              for (int u = 0; u < 4; ++u) *(LAS bf16_t*)(STl + h * 5120 + (v + u) * 80 + k * 2) = f2bf(sv[it][u]); } }
                    }
                    __syncthreads();
                    { const int r32 = lane & 31, hi = lane >> 5, h = wave >> 1, ih = wave & 1, i = 32 * ih + r32; const float SCG = 0.17677669529663687f;
                      bf16x8 qrel[2], qabs[2], kt[2][2];
#pragma unroll
                      for (int ks = 0; ks < 2; ++ks) { const int k0 = h * 32 + 16 * ks + 8 * hi; const bf16x8 qv = qv_[ks]; u32x4 wr_, wa_; unsigned* pr_ = (unsigned*)&wr_; unsigned* pa_ = (unsigned*)&wa_;
#pragma unroll
                          for (int e2 = 0; e2 < 4; ++e2) { const float b0 = bL[i * 128 + k0 + 2 * e2], b1 = bL[i * 128 + k0 + 2 * e2 + 1], f0 = bL[31 * 128 + k0 + 2 * e2], f1 = bL[31 * 128 + k0 + 2 * e2 + 1];
                              const float q0 = bf2f((bf16_t)qv[2 * e2]) * SCG, q1 = bf2f((bf16_t)qv[2 * e2 + 1]) * SCG;
                              pr_[e2] = cvtpk(q0 * __expf(b0 - f0), q1 * __expf(b1 - f1)); pa_[e2] = cvtpk(q0 * __expf(b0), q1 * __expf(b1)); }
                          qrel[ks] = __builtin_bit_cast(bf16x8, wr_); qabs[ks] = __builtin_bit_cast(bf16x8, wa_); }
#pragma unroll
                      for (int jt = 0; jt < 2; ++jt)
#pragma unroll
                          for (int ks = 0; ks < 2; ++ks) { const int jr = 32 * jt + r32, k0 = h * 32 + 16 * ks + 8 * hi; const bf16x8 kv = kv_[jt][ks]; u32x4 wk_; unsigned* pk_ = (unsigned*)&wk_;
#pragma unroll
                              for (int e2 = 0; e2 < 4; ++e2) { const float b0 = bL[jr * 128 + k0 + 2 * e2], b1 = bL[jr * 128 + k0 + 2 * e2 + 1], f0 = bL[31 * 128 + k0 + 2 * e2], f1 = bL[31 * 128 + k0 + 2 * e2 + 1];
                                  pk_[e2] = cvtpk(bf2f((bf16_t)kv[2 * e2]) * __expf(f0 - b0), bf2f((bf16_t)kv[2 * e2 + 1]) * __expf(f1 - b1)); }
                              kt[jt][ks] = __builtin_bit_cast(bf16x8, wk_); }
                      f32x16 o[2], s[2];
#pragma unroll
                      for (int q = 0; q < 16; ++q) { o[0][q] = 0.f; o[1][q] = 0.f; s[0][q] = 0.f; s[1][q] = 0.f; }
#pragma unroll
                      for (int ks = 0; ks < 2; ++ks) s[0] = mfma32(kt[0][ks], qrel[ks], s[0]);
                      if (ih) {
#pragma unroll
                          for (int ks = 0; ks < 2; ++ks) s[1] = mfma32(kt[1][ks], qrel[ks], s[1]); }
#pragma unroll
                      for (int q = 0; q < 16; ++q) { const int jr = (q & 3) + 8 * (q >> 2) + 4 * hi; if (jr > r32) { if (ih) s[1][q] = 0.f; else s[0][q] = 0.f; } }
                      const LAS unsigned char* VTh = VTl + h * 8704; const LAS unsigned char* STh = STl + h * 5120;
#pragma unroll
                      for (int dt = 0; dt < 2; ++dt) { const LAS unsigned char* vp = VTh + (32 * dt + r32) * VSTR + 8 * hi;
                          o[dt] = mfma32(vfrag(vp), pack8<0>(s[0]), o[dt]); o[dt] = mfma32(vfrag(vp + 32), pack8<8>(s[0]), o[dt]);
                          if (ih) { o[dt] = mfma32(vfrag(vp + 64), pack8<0>(s[1]), o[dt]); o[dt] = mfma32(vfrag(vp + 96), pack8<8>(s[1]), o[dt]); }
#pragma unroll
                          for (int ks = 0; ks < 2; ++ks) o[dt] = mfma32(*(const LAS bf16x8*)(STh + (32 * dt + r32) * 80 + 32 * ks + 16 * hi), qabs[ks], o[dt]); }
                      float ssh = 0.f;
#pragma unroll
                      for (int q = 0; q < 16; ++q) ssh += o[0][q] * o[0][q] + o[1][q] * o[1][q];
                      const float rh = rsqrtf(xhalf_sum(ssh) * (1.f / 64.f) + EPS); float ssg = 0.f;
#pragma unroll
                      for (int dt = 0; dt < 2; ++dt)
#pragma unroll
                          for (int g = 0; g < 4; ++g) { const int v0 = 32 * dt + 8 * g + 4 * hi; const u32x2 ogw = ogw_[dt][g]; const f32x4 gn = gn_[dt][g]; (void)v0;
                              const float og4[4] = {bflo(ogw.x), bfhi(ogw.x), bflo(ogw.y), bfhi(ogw.y)};
#pragma unroll
                              for (int q = 0; q < 4; ++q) { const float y = o[dt][4 * g + q] * rh * gn[q] * (og4[q] * sigmoidf_(og4[q])); o[dt][4 * g + q] = y; ssg += y * y; } }
                      ssg = xhalf_sum(ssg); if (hi == 0) SSX[i * 4 + h] = ssg;
                      __syncthreads();
                      const f32x4 s4 = *(const LAS f32x4*)(SSX + i * 4); const float rinv = rsqrtf((s4[0] + s4[1] + s4[2] + s4[3]) * (1.f / 256.f) + EPS);
#pragma unroll
                      for (int dt = 0; dt < 2; ++dt)
#pragma unroll
                          for (int g = 0; g < 4; ++g) { u32x2 w; w.x = cvtpk(o[dt][4 * g] * rinv, o[dt][4 * g + 1] * rinv); w.y = cvtpk(o[dt][4 * g + 2] * rinv, o[dt][4 * g + 3] * rinv);
                              *(u32x2*)(Y + (row0 + i) * DM + 768 + h * 64 + 32 * dt + 8 * g + 4 * hi) = w; } }
                    __syncthreads();
                    }
                    continue;
                }
                const int r32 = lane & 31, hi = lane >> 5;
                const int rep = r >> 10; r &= 1023;
                const int grp = r >> 5, within = r & 31;
                if (rep && ((REP_ONLY == 1 && within >= 16) || (REP_ONLY == 2 && within < 16))) continue;
              {
                if (within >= 16) {
                    const int idx = within - 16, b = idx & 3, tb = 127 - (4 * grp + (idx >> 2));
                    const int tl = 8 * wave + (r32 >> 2), head = r32 & 3, T = 64 * tb + tl; const size_t row = (size_t)b * SEQ + T; const bf16_t* prow = PB + row * NIN;
                    bf16_t gb0 = prow[C_BG + head * 3], gb1 = prow[C_BG + head * 3 + 1], gb2 = prow[C_BG + head * 3 + 2];
                    bf16x8 qf[4];
#pragma unroll
                    for (int ks = 0; ks < 4; ++ks) qf[ks] = *(const bf16x8*)(prow + C_BQ + head * 64 + 16 * ks + 8 * hi);
                    { unsigned t0_ = gb0, t1_ = gb1, t2_ = gb2; asm volatile("" : "+v"(t0_), "+v"(t1_), "+v"(t2_)); gb0 = (bf16_t)t0_; gb1 = (bf16_t)t1_; gb2 = (bf16_t)t2_; }
                    LAS float* impb = (LAS float*)(lds + AL_IMP) + wave * 1024; LAS unsigned* selm = (LAS unsigned*)(lds + AL_SELM) + wave * 32;
                    const int skey = tid >> 3, sch = tid & 7;
                    const unsigned koffP = (unsigned)(skey * NIN + sch * 8), voffS = (unsigned)(skey * SEQ + sch * 8), koffC = (unsigned)(skey * 64 + sch * 8), voffC = (unsigned)(skey * 512 + sch * 8);
                    auto stK = [&](int buf, const StageRegs& R) __attribute__((always_inline)) { *(LAS u32x4*)(lds + (buf ? AL_K1 : AL_K0) + skey * KSTR + sch * 16) = R.a; };
                    auto stKV = [&](int buf, const StageRegs& R) __attribute__((always_inline)) { *(LAS u32x4*)(lds + (buf ? AL_K1 : AL_K0) + skey * KSTR + sch * 16) = R.a;
                        LAS unsigned char* vd = lds + (buf ? AL_V1 : AL_V0) + skey * VSTP + (sch >> 1) * 32 + (sch & 1) * 8; u32x2 a, c; a.x = R.b.x; a.y = R.b.y; c.x = R.b.z; c.y = R.b.w; *(LAS u32x2*)vd = a; *(LAS u32x2*)(vd + 16) = c; };
                    f32x16 oacc[2], ob[2];
                    const int nv = T >= 31 ? ((T - 31) >> 4) + 1 : 0, ntc = (4 * tb + 3 + 63) >> 6;
                    float mC = NEGB, lC = 0.f;
                    { const bf16_t* kb_ = KCMPB + (size_t)b * 512 * 64;
                      attn_pipeline(wave, 0, ntc - 1, [&](int j, StageRegs& R) __attribute__((always_inline)) { R.a = SLD16(kb_ + (size_t)j * 64 * 64, koffC); }, stK,
                        [&](int j, int cb) __attribute__((always_inline)) { f32x16 s0, s1; qk_tile<4>(lds + (cb ? AL_K1 : AL_K0), qf, r32, hi, s0, s1); if (!__all(nv - 1 - 64 * j >= 63)) mask_tile(s0, s1, 0, nv - 1 - 64 * j, hi);
                            const float mx = tile_max(s0, s1), mn = fmaxf(mC, mx), ms = mn < -1e29f ? 0.f : mn, alpha = ex2(mC - ms); mC = mn; float ps = 0.f;
#pragma unroll
                            for (int i = 0; i < 16; ++i) ps += ex2(s0[i] - ms) + ex2(s1[i] - ms);
                            lC = lC * alpha + ps; }); }
                    { const float invC = 1.f / fmaxf(xhalf_sum(lC), 1e-30f), msC = mC < -1e29f ? 0.f : mC; float carry = 0.f;
#pragma unroll
                      for (int i = 0; i < 16; ++i) { ob[0][i] = 0.f; ob[1][i] = 0.f; }
                      const bf16_t* kb_ = KCMPB + (size_t)b * 512 * 64; const bf16_t* vb_ = VCMPT + (size_t)b * 64 * 512;
                      attn_pipeline(wave, 0, ntc - 1, [&](int j, StageRegs& R) __attribute__((always_inline)) { R.a = SLD16(kb_ + (size_t)j * 64 * 64, koffC); R.b = SLD16(vb_ + j * 64, voffC); }, stKV,
                        [&](int j, int cb) __attribute__((always_inline)) { f32x16 s0, s1; qk_tile<4>(lds + (cb ? AL_K1 : AL_K0), qf, r32, hi, s0, s1); if (!__all(nv - 1 - 64 * j >= 63)) mask_tile(s0, s1, 0, nv - 1 - 64 * j, hi);
#pragma unroll
                            for (int i = 0; i < 16; ++i) { s0[i] = ex2(s0[i] - msC) * invC; s1[i] = ex2(s1[i] - msC) * invC; }
                            float gs[8], pl[8];
#pragma unroll
                            for (int q = 0; q < 4; ++q) { gs[q] = (s0[4 * q] + s0[4 * q + 1]) + (s0[4 * q + 2] + s0[4 * q + 3]); gs[4 + q] = (s1[4 * q] + s1[4 * q + 1]) + (s1[4 * q + 2] + s1[4 * q + 3]);
                                pl[q] = shx(s0[4 * q + 3], 32); pl[4 + q] = shx(s1[4 * q + 3], 32); }
#pragma unroll
                            for (int q = 0; q < 8; ++q) { const float prev = hi ? pl[q] : (q > 0 ? pl[q > 0 ? q - 1 : 0] : carry); float x = gs[q] + prev; x += shx(x, 1); x += shx(x, 2);
                                if ((r32 & 3) == 0) impb[(r32 >> 2) * 128 + 16 * j + 2 * q + hi] = x; }
                            carry = pl[7];
                            pv_tile(s0, s1, lds + (cb ? AL_V1 : AL_V0), ob, r32, hi); }); }
                    LAS float* oav = (LAS float*)(lds + AL_OACC) + tid; const float g0 = sigmoidf_(bf2f(gb0));
#pragma unroll
                    for (int i = 0; i < 16; ++i) { oav[i * 512] = g0 * ob[0][i]; oav[(16 + i) * 512] = g0 * ob[1][i]; }
                    WSYNC();
                    for (int tk = 0; tk < 8; ++tk) {
                        const int cur = tb, j0 = lane, j1 = lane + 64; const float im0 = impb[tk * 128 + j0], im1 = impb[tk * 128 + j1];
                        const unsigned k0 = ((j0 == 0 || j0 == cur || j0 == cur - 1) ? 0xFF000000u : (j0 <= cur ? (__float_as_uint(im0) & ~127u) : 0u)) | (unsigned)(127 - j0);
                        const unsigned k1 = ((j1 == cur || j1 == cur - 1) ? 0xFF000000u : (j1 <= cur ? (__float_as_uint(im1) & ~127u) : 0u)) | (unsigned)(127 - j1);
                        unsigned T = 0u;
#pragma unroll 4
                        for (int bb = 31; bb >= 0; --bb) { const unsigned cand = T | (1u << bb); const int cnt = __popcll(__ballot(k0 >= cand)) + __popcll(__ballot(k1 >= cand)); if (cnt >= 16) T = cand; if (cnt == 16) break; }
                        const unsigned long long m0 = __ballot(k0 >= T), m1 = __ballot(k1 >= T);
                        if (lane == 0) { selm[tk * 4] = (unsigned)m0; selm[tk * 4 + 1] = (unsigned)(m0 >> 32); selm[tk * 4 + 2] = (unsigned)m1; selm[tk * 4 + 3] = (unsigned)(m1 >> 32); }
                    }
                    WSYNC();
                    const unsigned sm0 = selm[(r32 >> 2) * 4], sm1 = selm[(r32 >> 2) * 4 + 1], sm2 = selm[(r32 >> 2) * 4 + 2], sm3 = selm[(r32 >> 2) * 4 + 3];
                    { SoftState SB; soft_init(SB, ob);
                      unsigned u0 = sm0, u1 = sm1, u2 = sm2, u3 = sm3;
#pragma unroll
                      for (int o_ = 1; o_ < 64; o_ <<= 1) { u0 |= shx(u0, o_); u1 |= shx(u1, o_); u2 |= shx(u2, o_); u3 |= shx(u3, o_); }
                      unsigned long long Ulo = ((unsigned long long)(unsigned)__builtin_amdgcn_readfirstlane((int)u1) << 32) | (unsigned)__builtin_amdgcn_readfirstlane((int)u0), Uhi = ((unsigned long long)(unsigned)__builtin_amdgcn_readfirstlane((int)u3) << 32) | (unsigned)__builtin_amdgcn_readfirstlane((int)u2);
                      if (tb < 64) { if (tb < 63) Ulo &= (2ull << tb) - 1ull; Uhi = 0ull; } else if (tb < 127) Uhi &= (2ull << (tb - 64)) - 1ull;
                      const bf16_t* ksf = KSF + (size_t)b * 128 * 4096; const bf16_t* vsf = VST + (size_t)b * 128 * 4096; const unsigned lo8 = (unsigned)lane * 8u;
                      bf16x8 kf[2][4], vf[2][4];
                      int j = 0; Ulo &= ~1ull;
#pragma unroll
                      for (int f = 0; f < 8; ++f) kf[f >> 2][f & 3] = *(const bf16x8*)((ksf + f * 512) + lo8);
                      bool first = true;
                      for (;;) {
#pragma unroll
                          for (int f = 0; f < 8; ++f) vf[f >> 2][f & 3] = *(const bf16x8*)((vsf + (size_t)j * 4096 + f * 512) + lo8);
                          const unsigned wsel = j < 32 ? sm0 : (j < 64 ? sm1 : (j < 96 ? sm2 : sm3)); const bool bit = (wsel >> (j & 31)) & 1u;
                          const f32x16 cinit = bcast16(bit ? -SB.m : NEGB); f32x16 s0 = cinit, s1 = cinit;
#pragma unroll
                          for (int ks = 0; ks < 4; ++ks) { s0 = mfma32(kf[0][ks], qf[ks], s0); s1 = mfma32(kf[1][ks], qf[ks], s1); }
                          __builtin_amdgcn_sched_barrier(0);
                          const int jn = Ulo ? (int)__builtin_ctzll(Ulo) : (Uhi ? 64 + (int)__builtin_ctzll(Uhi) : -1);
                          if (Ulo) Ulo &= Ulo - 1ull; else Uhi &= Uhi - 1ull;
                          if (jn >= 0) {
#pragma unroll
                              for (int f = 0; f < 8; ++f) kf[f >> 2][f & 3] = *(const bf16x8*)((ksf + (size_t)jn * 4096 + f * 512) + lo8); }
                          soft_update(s0, s1, SB, ob, j == tb, 0, tl, first, hi);
                          { const bf16x8 p00 = pack8<0>(s0), p01 = pack8<8>(s0), p10 = pack8<0>(s1), p11 = pack8<8>(s1);
#pragma unroll
                            for (int dt = 0; dt < 2; ++dt) { ob[dt] = mfma32(vf[dt][0], p00, ob[dt]); ob[dt] = mfma32(vf[dt][1], p01, ob[dt]); ob[dt] = mfma32(vf[dt][2], p10, ob[dt]); ob[dt] = mfma32(vf[dt][3], p11, ob[dt]); } }
                          if (jn < 0) break;
                          j = jn; first = false;
                      }
                      const float sc = sigmoidf_(bf2f(gb1)) / fmaxf(xhalf_sum(SB.l), 1e-30f);
#pragma unroll
                      for (int i = 0; i < 16; ++i) { oav[i * 512] += sc * ob[0][i]; oav[(16 + i) * 512] += sc * ob[1][i]; } }
                    __syncthreads();
                    { SoftState SB; soft_init(SB, ob); const int jb0 = tb >= 8 ? tb - 8 : 0;
                      const bf16_t* kb_ = PB + (size_t)b * SEQ * NIN + C_KW; const bf16_t* vb_ = VWT + (size_t)b * 64 * SEQ;
                      attn_pipeline(wave, tb >= 8 ? tb - 8 : 0, tb, [&](int j, StageRegs& R) __attribute__((always_inline)) { R.a = SLD16(kb_ + (size_t)j * 64 * NIN, koffP); R.b = SLD16(vb_ + j * 64, voffS); }, stKV,
                        [&](int j, int cb) __attribute__((always_inline)) { attn_step<4>(lds + (cb ? AL_K1 : AL_K0), lds + (cb ? AL_V1 : AL_V0), qf, SB, ob, j == tb || j == tb - 8, j == tb - 8 ? tl + 1 : 0, j == tb ? tl : 63, j == jb0, r32, hi); });
                      const float sc = sigmoidf_(bf2f(gb2)) / fmaxf(xhalf_sum(SB.l), 1e-30f);
#pragma unroll
                      for (int i = 0; i < 16; ++i) { oacc[0][i] = oav[i * 512] + sc * ob[0][i]; oacc[1][i] = oav[(16 + i) * 512] + sc * ob[1][i]; } }
                    { float ss = 0.f;
#pragma unroll
                      for (int i = 0; i < 16; ++i) ss += oacc[0][i] * oacc[0][i] + oacc[1][i] * oacc[1][i];
                      ss = xhalf_sum(ss); ss += shx(ss, 1); ss += shx(ss, 2);
                      const float rinv = rsqrtf(ss * (1.f / 256.f) + EPS);
#pragma unroll
                      for (int dt = 0; dt < 2; ++dt)
#pragma unroll
                          for (int g = 0; g < 4; ++g) { u32x2 w; w.x = cvtpk(oacc[dt][4 * g] * rinv, oacc[dt][4 * g + 1] * rinv); w.y = cvtpk(oacc[dt][4 * g + 2] * rinv, oacc[dt][4 * g + 3] * rinv);
                              *(u32x2*)(Y + row * DM + 512 + head * 64 + 32 * dt + 8 * g + 4 * hi) = w; } }
                    __syncthreads();
                    continue;
                }
                {
                    const int qb = 31 - grp, b = within >> 2, h = within & 3;
                    const int T = 256 * qb + 32 * wave + r32; const size_t row = (size_t)b * SEQ + T;
                    bf16x8 qf[6];
#pragma unroll
                    for (int ks = 0; ks < 6; ++ks) qf[ks] = *(const bf16x8*)(MQ + row * 384 + h * 96 + 16 * ks + 8 * hi);
                    f32x16 o[2]; SoftState SM; soft_init(SM, o);
                    const int jd = 4 * qb + (wave >> 1);
                    const bf16_t* kn = MKN + (size_t)b * SEQ * 256 + h * 64; const bf16_t* kr = MKR + (size_t)b * SEQ * 32; const bf16_t* vt = MVT + (size_t)(b * 4 + h) * 64 * SEQ;
                    constexpr int VS2 = 272, AM_K0 = 0, AM_K1 = 128 * KSTR, AM_V0 = 2 * 128 * KSTR, AM_V1 = AM_V0 + 64 * VS2;
                    const int nk = tid >> 3, nc = tid & 7, rkey = tid >> 2, rch = tid & 3, vr = tid >> 4, vc = tid & 15;
                    const unsigned kob0 = (unsigned)(nk * 256 + nc * 8) * 2u, kob1 = (unsigned)(rkey * 32 + rch * 8) * 2u, vob_ = (unsigned)(vr * SEQ + vc * 8) * 2u;
                    attn_pipeline(wave, 0, 2 * qb + 1,
                        [&](int jj, StageRegs& R) __attribute__((always_inline)) {
                            typedef const __attribute__((address_space(1))) char* gcp; typedef const __attribute__((address_space(1))) u32x4 gq4;
                            gcp b0 = (gcp)(kn + (size_t)jj * 128 * 256), b1 = (gcp)(kn + (size_t)jj * 128 * 256 + 64 * 256), b2 = (gcp)(kr + (size_t)jj * 128 * 32), b3 = (gcp)(vt + jj * 128), b4 = (gcp)(vt + jj * 128 + 32 * SEQ);
                            unsigned o0 = kob0, o1 = kob1, o2 = vob_; asm volatile("" : "+s"(b0), "+s"(b1), "+s"(b2), "+s"(b3), "+s"(b4), "+v"(o0), "+v"(o1), "+v"(o2));
                            R.a = *(gq4*)(b0 + o0); R.b = *(gq4*)(b1 + o0); R.c = *(gq4*)(b2 + o1); R.d = *(gq4*)(b3 + o2); R.e = *(gq4*)(b4 + o2); },
                        [&](int buf, const StageRegs& R) __attribute__((always_inline)) { LAS unsigned char* kb_ = lds + (buf ? AM_K1 : AM_K0); LAS unsigned char* vb_ = lds + (buf ? AM_V1 : AM_V0) + vr * VS2 + (vc >> 1) * 32 + (vc & 1) * 8;
                            *(LAS u32x4*)(kb_ + nk * KSTR + nc * 16) = R.a; *(LAS u32x4*)(kb_ + (64 + nk) * KSTR + nc * 16) = R.b; *(LAS u32x4*)(kb_ + rkey * KSTR + 128 + rch * 16) = R.c;
                            u32x2 p, q; p.x = R.d.x; p.y = R.d.y; q.x = R.d.z; q.y = R.d.w; *(LAS u32x2*)vb_ = p; *(LAS u32x2*)(vb_ + 16) = q;
                            p.x = R.e.x; p.y = R.e.y; q.x = R.e.z; q.y = R.e.w; *(LAS u32x2*)(vb_ + 32 * VS2) = p; *(LAS u32x2*)(vb_ + 32 * VS2 + 16) = q; },
                        [&](int jj, int cb) __attribute__((always_inline)) {
                            const int kd = 32 * (wave & 1) + r32;
#pragma unroll
                            for (int hh = 0; hh < 2; ++hh) { const int j = 2 * jj + hh;
                                if (j <= jd) attn_step<6, VS2, true>(lds + (cb ? AM_K1 : AM_K0) + hh * 64 * KSTR, lds + (cb ? AM_V1 : AM_V0) + hh * 128, qf, SM, o, j == jd, 0, kd, j == 0, r32, hi); } });
                    { const float inv = 1.f / fmaxf(xhalf_sum(SM.l), 1e-30f); float ss = 0.f;
#pragma unroll
                      for (int dt = 0; dt < 2; ++dt)
#pragma unroll
                          for (int g = 0; g < 4; ++g) { const float v0 = o[dt][4 * g] * inv, v1 = o[dt][4 * g + 1] * inv, v2 = o[dt][4 * g + 2] * inv, v3 = o[dt][4 * g + 3] * inv; ss += v0 * v0 + v1 * v1 + v2 * v2 + v3 * v3;
                              u32x2 w; w.x = cvtpk(v0, v1); w.y = cvtpk(v2, v3); *(u32x2*)(Y + row * DM + h * 64 + 32 * dt + 8 * g + 4 * hi) = w; }
                      ss = xhalf_sum(ss); if (hi == 0) ssq_d[(size_t)h * M + row] = ss; }
                    __syncthreads();
                }
              }
            }
        }
        SEAM(pb + 2);
        if (IN(pb + 3)) {
        const int l_ = l; WS_PTRS();
            pg8::Gemm g{Y, (const bf16_t*)(ws + WS_WOUT) + (size_t)l * DM * DM, M, DM, DM}; pg8::StaticOrder S; S.init(M, DM, G, bid);
            pg8::EpiResid<true> E{XB, ssq_out, ssq_d, (LAS float*)(lds + 131072)};
            pg8::gemm_phase<pg8::EpiResid<true>, pg8::StaticOrder, true, true>(lds, g, S, E, wave);
            if (REP_G57) { pg8::EpiInProj E2{PB, DM, ssq_mix}; pg8::gemm_phase<pg8::EpiInProj, pg8::StaticOrder, true, true>(lds, g, S, E2, wave); }
        }
        SEAM(pb + 3);
        if (IN(pb + 4)) {
        const int l_ = l; WS_PTRS();
            pg8::Gemm g{XB, (const bf16_t*)(ws + WS_WGU) + (size_t)l * NGU * DM, M, NGU, DM}; pg8::StaticOrder S; S.init(M, NGU, G, bid);
            pg8::EpiSwiglu E{ACT, ssq_out};
            _Pragma("unroll 1") for (int rep = 0; rep < REP_G16; ++rep) pg8::gemm_phase<pg8::EpiSwiglu, pg8::StaticOrder, true, true>(lds, g, S, E, wave);
        }
        SEAM(pb + 4);
        if (IN(pb + 5)) {
        const int l_ = l; WS_PTRS();
            pg8::Gemm g{ACT, (const bf16_t*)(ws + WS_WDN) + (size_t)l * DM * FF, M, DM, FF}; pg8::StaticOrder S; S.init(M, DM, G, bid);
            pg8::EpiResid<false> E{XB, ssq_down, nullptr, (LAS float*)(lds + 131072)};
            pg8::gemm_phase<pg8::EpiResid<false>, pg8::StaticOrder, true, true>(lds, g, S, E, wave);
            if (REP_G57) { pg8::EpiInProj E2{Y, DM, ssq_mix}; pg8::gemm_phase<pg8::EpiInProj, pg8::StaticOrder, true, true>(lds, g, S, E2, wave); }
        }
        SEAM(pb + 5);
    }
    if (IN(13)) {
        const int l_ = 1; WS_PTRS();
        LAUNDER_TID();
        const float* ssqf = ssp_base + (size_t)5 * 4 * M; const int gw = bid * 8 + wave, NGW = G * 8;
        f32x4 gnv[4]; { const f32x4* gn = (const f32x4*)inp(args, 27) + lane;
#pragma unroll
          for (int j = 0; j < 4; ++j) gnv[j] = gn[64 * j]; }
        for (int m0 = gw; m0 < M; m0 += 2 * NGW) {
            u32x2 w_[2][4]; float sq_[2];
#pragma unroll
            for (int rr = 0; rr < 2; ++rr) { const int m = m0 + rr * NGW < M ? m0 + rr * NGW : m0; sq_[rr] = sum4p(ssqf, m); const u32x2* xr = (const u32x2*)(XB + (size_t)m * DM) + lane;
#pragma unroll
                for (int j = 0; j < 4; ++j) w_[rr][j] = xr[64 * j]; }
            __builtin_amdgcn_sched_barrier(0);
#pragma unroll
            for (int rr = 0; rr < 2; ++rr) { const int m = m0 + rr * NGW; if (m >= M) break; const float rinv = rsqrtf(sq_[rr] * (1.f / DM) + EPS); f32x4* orow = (f32x4*)(out_ + (size_t)m * DM) + lane;
#pragma unroll
                for (int j = 0; j < 4; ++j) { const u32x2 w = w_[rr][j]; const f32x4 g = gnv[j]; f32x4 v; v[0] = bflo(w.x) * rinv * g[0]; v[1] = bfhi(w.x) * rinv * g[1]; v[2] = bflo(w.y) * rinv * g[2]; v[3] = bfhi(w.y) * rinv * g[3]; orow[64 * j] = v; } }
        }
    }
#undef IN
#undef SEAM
}

extern "C" void kernel_launch(void* const* d_in, const int* in_sizes, int n_in, void* d_out, int out_size, void* d_ws, size_t ws_size, hipStream_t stream) {
    static int grid = 0;
    if (grid == 0) {
        if (n_in != 28 || in_sizes[0] != M * DM || out_size != M * DM || ws_size < WS_END) { fprintf(stderr, "kernel_launch: unexpected shapes (n_in %d, ws %zu)\n", n_in, ws_size); grid = -1; return; }
        int dev = 0, cus = 0;
        if (hipGetDevice(&dev) != hipSuccess || hipDeviceGetAttribute(&cus, hipDeviceAttributeMultiprocessorCount, dev) != hipSuccess) { grid = -1; return; }
        if (hipFuncSetAttribute((const void*)fwd, hipFuncAttributeMaxDynamicSharedMemorySize, LDS_BYTES) != hipSuccess) { fprintf(stderr, "kernel_launch: hipFuncSetAttribute failed\n"); grid = -1; return; }
        int per_cu = 0;
        if (hipOccupancyMaxActiveBlocksPerMultiprocessor(&per_cu, (const void*)fwd, NTHR, LDS_BYTES) != hipSuccess || per_cu < 1) fprintf(stderr, "kernel_launch: occupancy query says %d\n", per_cu);
        (void)hipGetLastError();
        grid = cus;
    }
    if (grid < 0) return;
    (void)hipMemsetAsync((char*)d_ws + WS_CTL, 0, CTL_ZERO_BYTES, stream);
    Args a{};
    for (int i = 0; i < 28; ++i) a.in[i] = (const float*)d_in[i];
    a.out = (float*)d_out; a.ws = (unsigned char*)d_ws;
    if (MK_N_LAUNCHES == 1) { a.ph_lo = 0; a.ph_hi = 14; hipLaunchKernelGGL(fwd, dim3(grid), dim3(NTHR), LDS_BYTES, stream, a); }
    else for (int p = 0; p < 14; ++p) { a.ph_lo = p; a.ph_hi = p + 1; hipLaunchKernelGGL(fwd, dim3(grid), dim3(NTHR), LDS_BYTES, stream, a); }
}
```
